# Optimizing an MI355X kernel written in HIP

```python
import math
import jax
import jax.numpy as jnp
from jax import lax
import numpy as np

D_MODEL = 1024
BATCH = 8
SEQ = 4096
DEPTH = 2

GRID_W = 64
CTX_LEN = 256
N_MIXERS = 2
N_ATTN_LAYERS = (DEPTH + 1) // 2
N_GLA_LAYERS = DEPTH // 2

ALPHA = (2.0 * DEPTH) ** 0.25
BETA = (8.0 * DEPTH) ** -0.25
LN_EPS = 1e-5

DIFF_HEADS = 8
DIFF_HEAD_DIM = D_MODEL // DIFF_HEADS // 2
Q_BLOCK = 128
ROPE_BASE = 10000.0
ROT_FREQS = DIFF_HEAD_DIM // 4

GLA_HEADS = 4
GLA_DK = D_MODEL // 2 // GLA_HEADS
GLA_DV = D_MODEL // GLA_HEADS
GLA_GATE_RANK = 16
GLA_TAU = 16.0
GLA_CHUNK = 64

N_EXPERTS = 16
N_GROUPS = 4
EXPERTS_PER_GROUP = N_EXPERTS // N_GROUPS
TOP_K = 2
D_EXPERT = D_MODEL // 2
MOE_BLOCK = 128

kernel_name = 'hybrid_diffattn_gla_grouped_moe_prefix'


def layer_norm(x, g, b):
    xf = x.astype(jnp.float32)
    mu = jnp.mean(xf, axis=-1, keepdims=True)
    var = jnp.mean(jnp.square(xf - mu), axis=-1, keepdims=True)
    y = (xf - mu) * lax.rsqrt(var + LN_EPS) * g.astype(jnp.float32) + b.astype(jnp.float32)
    return y.astype(x.dtype)


def rms_norm(x, g):
    xf = x.astype(jnp.float32)
    y = xf * lax.rsqrt(jnp.mean(jnp.square(xf), axis=-1, keepdims=True) + LN_EPS) * g.astype(jnp.float32)
    return y.astype(x.dtype)


def modulate(h, shift, scale):
    return h * (1.0 + scale) + shift


def rope_2d_tables(rows, dtype):
    row = jnp.repeat(jnp.arange(rows, dtype=jnp.float32), GRID_W)
    col = jnp.tile(jnp.arange(GRID_W, dtype=jnp.float32), rows)
    inv_freq = ROPE_BASE ** (-jnp.arange(ROT_FREQS, dtype=jnp.float32) / ROT_FREQS)
    ang_r = row[:, None] * inv_freq
    ang_c = col[:, None] * inv_freq
    ang = jnp.concatenate([ang_r, ang_r, ang_c, ang_c], axis=-1)
    return jnp.cos(ang).astype(dtype), jnp.sin(ang).astype(dtype)


def apply_rope_2d(x, cos, sin):
    xr = x.reshape(x.shape[:-1] + (2, 2, ROT_FREQS))
    rot = jnp.concatenate([-xr[..., 1:, :], xr[..., :1, :]], axis=-2).reshape(x.shape)
    return x * cos[None, :, None, None, :] + rot * sin[None, :, None, None, :]


def diff_attention(h_lat, h_ctx, w_qkv, w_o, lam_vecs, subln_g, lambda_init, cos, sin, need_ctx):
    B, S, _ = h_lat.shape

    def project(h):
        T = h.shape[1]
        q, k, v = jnp.split(h @ w_qkv, 3, axis=-1)
        q = q.reshape(B, T, DIFF_HEADS, 2, DIFF_HEAD_DIM)
        k = k.reshape(B, T, DIFF_HEADS, 2, DIFF_HEAD_DIM)
        v = v.reshape(B, T, DIFF_HEADS, 2 * DIFF_HEAD_DIM)
        return q, k, v

    q_l, k_l, v_l = project(h_lat)
    q_l = apply_rope_2d(q_l, cos, sin)
    k_l = apply_rope_2d(k_l, cos, sin)
    q_c, k_c, v_c = project(h_ctx)

    lf = lam_vecs.astype(jnp.float32)
    lam = jnp.exp(jnp.sum(lf[0] * lf[1])) - jnp.exp(jnp.sum(lf[2] * lf[3])) + lambda_init
    scale = DIFF_HEAD_DIM ** -0.5

    def diff_softmax(q, k, v):
        s = jnp.einsum('bqhmd,bkhmd->bhmqk', q, k, preferred_element_type=jnp.float32) * scale
        p = jax.nn.softmax(s, axis=-1)
        a = p[:, :, 0] - lam * p[:, :, 1]
        return jnp.einsum('bhqk,bkhe->bqhe', a.astype(v.dtype), v)

    k_all = jnp.concatenate([k_c, k_l], axis=1)
    v_all = jnp.concatenate([v_c, v_l], axis=1)
    n_blocks = S // Q_BLOCK
    q_blocks = q_l.reshape(B, n_blocks, Q_BLOCK, DIFF_HEADS, 2, DIFF_HEAD_DIM).swapaxes(0, 1)
    o_l = lax.map(lambda qb: diff_softmax(qb, k_all, v_all), q_blocks)
    o_l = o_l.swapaxes(0, 1).reshape(B, S, DIFF_HEADS, 2 * DIFF_HEAD_DIM)

    def finish(o):
        o = rms_norm(o, subln_g) * (1.0 - lambda_init)
        return o.reshape(o.shape[0], o.shape[1], DIFF_HEADS * 2 * DIFF_HEAD_DIM) @ w_o

    y_lat = finish(o_l)
    y_ctx = finish(diff_softmax(q_c, k_c, v_c)) if need_ctx else None
    return y_lat, y_ctx


def gla_chunked(q, k, v, g, h0):
    B, H, T, DK = q.shape
    DV = v.shape[-1]
    n_chunks = T // GLA_CHUNK

    def to_chunks(a):
        return a.astype(jnp.float32).reshape(B, H, n_chunks, GLA_CHUNK, a.shape[-1]).transpose(2, 0, 1, 3, 4)

    lower_tri = jnp.tril(jnp.ones((GLA_CHUNK, GLA_CHUNK), dtype=bool))[None, None, :, :, None]

    def chunk_step(state, inp):
        qb, kb, vb, gb = inp
        b = jnp.cumsum(gb, axis=2)
        rel = jnp.where(lower_tri, b[:, :, :, None, :] - b[:, :, None, :, :], -jnp.inf)
        scores = jnp.einsum('bhtd,bhsd,bhtsd->bhts', qb, kb, jnp.exp(rel))
        o = jnp.einsum('bhts,bhsv->bhtv', scores, vb) + jnp.einsum('bhtd,bhdv->bhtv', qb * jnp.exp(b), state)
        b_last = b[:, :, -1:, :]
        state = jnp.exp(b_last[:, :, 0, :, None]) * state + jnp.einsum('bhsd,bhsv->bhdv', kb * jnp.exp(b_last - b), vb)
        return state, o

    state, o = lax.scan(chunk_step, h0, (to_chunks(q), to_chunks(k), to_chunks(v), to_chunks(g)))
    o = o.transpose(1, 2, 0, 3, 4).reshape(B, H, T, DV)
    return o.astype(v.dtype), state


def gla_mixer(h_lat, h_ctx, w_in, wg_down, wg_up, bg, norm_g, w_o, need_ctx):
    B = h_lat.shape[0]
    dk_tot = GLA_HEADS * GLA_DK
    dv_tot = GLA_HEADS * GLA_DV

    def heads(a, dh):
        return a.reshape(B, a.shape[1], GLA_HEADS, dh).transpose(0, 2, 1, 3)

    def project(h):
        q, k, v, r = jnp.split(h @ w_in, [dk_tot, 2 * dk_tot, 2 * dk_tot + dv_tot], axis=-1)
        gates = [heads(jax.nn.log_sigmoid(((h @ wg_down[d]) @ wg_up[d] + bg[d]).astype(jnp.float32)) / GLA_TAU, GLA_DK)
                 for d in range(2)]
        return heads(q, GLA_DK) * (GLA_DK ** -0.5), heads(k, GLA_DK), heads(v, GLA_DV), r, gates[0], gates[1]

    q_l, k_l, v_l, r_l, gf_l, gb_l = project(h_lat)
    q_c, k_c, v_c, r_c, gf_c, gb_c = project(h_ctx)
    h0 = jnp.zeros((B, GLA_HEADS, GLA_DK, GLA_DV), jnp.float32)

    def flip(a):
        return jnp.flip(a, axis=2)

    o_cf, s_f = gla_chunked(q_c, k_c, v_c, gf_c, h0)
    o_cb, s_b = gla_chunked(flip(q_c), flip(k_c), flip(v_c), flip(gb_c), h0)
    o_lf, _ = gla_chunked(q_l, k_l, v_l, gf_l, s_f)
    o_lb, _ = gla_chunked(flip(q_l), flip(k_l), flip(v_l), flip(gb_l), s_b)

    def finish(o, r):
        T = o.shape[2]
        o = rms_norm(o.transpose(0, 2, 1, 3), norm_g).reshape(B, T, dv_tot)
        return (o * jax.nn.silu(r)) @ w_o

    y_lat = finish(o_lf + flip(o_lb), r_l)
    y_ctx = finish(o_cf + flip(o_cb), r_c) if need_ctx else None
    return y_lat, y_ctx


def grouped_top2_moe(h, router_w, router_b, w_gate, w_up, w_down):
    T, D = h.shape
    logits = jnp.einsum('td,de->te', h, router_w, preferred_element_type=jnp.float32)
    affinity = jax.nn.sigmoid(logits)
    select = (affinity + router_b.astype(jnp.float32)).reshape(T, N_GROUPS, EXPERTS_PER_GROUP)
    group_score = jnp.sum(lax.top_k(select, TOP_K)[0], axis=-1)
    group = jnp.argmax(group_score, axis=-1)
    in_group = select[jnp.arange(T), group]
    _, local = lax.top_k(in_group, TOP_K)
    expert = group[:, None] * EXPERTS_PER_GROUP + local
    weight = jnp.take_along_axis(affinity, expert, axis=-1)
    weight = weight / jnp.sum(weight, axis=-1, keepdims=True)

    n_assign = T * TOP_K
    flat_e = expert.reshape(-1)
    flat_w = weight.reshape(-1)
    flat_t = jnp.repeat(jnp.arange(T, dtype=jnp.int32), TOP_K)
    order = jnp.argsort(flat_e)
    se, st, sw = flat_e[order], flat_t[order], flat_w[order]
    counts = jnp.bincount(flat_e, length=N_EXPERTS)
    padded = (counts + MOE_BLOCK - 1) // MOE_BLOCK * MOE_BLOCK
    seg_start = jnp.cumsum(counts) - counts
    pad_end = jnp.cumsum(padded)
    pad_start = pad_end - padded
    dest = pad_start[se] + jnp.arange(n_assign) - seg_start[se]
    n_pad = n_assign + N_EXPERTS * MOE_BLOCK
    n_blocks = n_pad // MOE_BLOCK
    x_pad = jnp.zeros((n_pad, D), h.dtype).at[dest].set(h[st])
    tok_pad = jnp.full((n_pad,), T, jnp.int32).at[dest].set(st)
    w_pad = jnp.zeros((n_pad,), jnp.float32).at[dest].set(sw)
    block_expert = jnp.minimum(jnp.searchsorted(pad_end, jnp.arange(n_blocks) * MOE_BLOCK, side='right'), N_EXPERTS - 1)

    def expert_block(args):
        xb, e = args
        return (jax.nn.silu(xb @ w_gate[e]) * (xb @ w_up[e])) @ w_down[e]

    y_pad = lax.map(expert_block, (x_pad.reshape(n_blocks, MOE_BLOCK, D), block_expert)).reshape(n_pad, D)
    out = jnp.zeros((T + 1, D), h.dtype).at[tok_pad].add(y_pad * w_pad[:, None].astype(h.dtype))
    return out[:T]


def setup_inputs(seed: int = 0) -> dict:
    key = jax.random.key(seed)
    ks = jax.random.split(key, 24)

    def nrm(k, shape, scale):
        return jax.random.normal(k, shape, jnp.float32) * scale

    dk_tot = GLA_HEADS * GLA_DK
    dv_tot = GLA_HEADS * GLA_DV
    return {
        'x': nrm(ks[0], (BATCH, SEQ, D_MODEL), 1.0),
        'c': nrm(ks[1], (BATCH, D_MODEL), 1.0),
        'ctx': nrm(ks[2], (BATCH, CTX_LEN, D_MODEL), 1.0),
        'c_ctx': nrm(ks[3], (D_MODEL,), 1.0),
        'ada_w': nrm(ks[4], (DEPTH, D_MODEL, 6 * D_MODEL), D_MODEL ** -0.5),
        'ada_b': nrm(ks[5], (DEPTH, 6 * D_MODEL), 0.02),
        'ln_g': 1.0 + nrm(ks[6], (DEPTH, 2, D_MODEL), 0.02),
        'ln_b': nrm(ks[7], (DEPTH, 2, D_MODEL), 0.02),
        'attn_w_qkv': nrm(ks[8], (N_ATTN_LAYERS, D_MODEL, 3 * D_MODEL), D_MODEL ** -0.5),
        'attn_w_o': nrm(ks[9], (N_ATTN_LAYERS, D_MODEL, D_MODEL), BETA * D_MODEL ** -0.5),
        'attn_lambda': nrm(ks[10], (N_ATTN_LAYERS, 4, DIFF_HEAD_DIM), 0.1),
        'attn_subln_g': 1.0 + nrm(ks[11], (N_ATTN_LAYERS, 2 * DIFF_HEAD_DIM), 0.02),
        'gla_w_in': nrm(ks[12], (N_GLA_LAYERS, D_MODEL, 2 * dk_tot + 2 * dv_tot), D_MODEL ** -0.5),
        'gla_wg_down': nrm(ks[13], (N_GLA_LAYERS, 2, D_MODEL, GLA_GATE_RANK), D_MODEL ** -0.5),
        'gla_wg_up': nrm(ks[14], (N_GLA_LAYERS, 2, GLA_GATE_RANK, dk_tot), GLA_GATE_RANK ** -0.5),
        'gla_bg': nrm(ks[15], (N_GLA_LAYERS, 2, dk_tot), 0.1),
        'gla_norm_g': 1.0 + nrm(ks[16], (N_GLA_LAYERS, GLA_DV), 0.02),
        'gla_w_o': nrm(ks[17], (N_GLA_LAYERS, dv_tot, D_MODEL), BETA * dv_tot ** -0.5),
        'router_w': nrm(ks[18], (D_MODEL, N_EXPERTS), D_MODEL ** -0.5),
        'router_b': nrm(ks[19], (N_EXPERTS,), 0.01),
        'moe_w_gate': nrm(ks[20], (DEPTH, N_EXPERTS, D_MODEL, D_EXPERT), D_MODEL ** -0.5),
        'moe_w_up': nrm(ks[21], (DEPTH, N_EXPERTS, D_MODEL, D_EXPERT), D_MODEL ** -0.5),
        'moe_w_down': nrm(ks[22], (DEPTH, N_EXPERTS, D_EXPERT, D_MODEL), BETA * D_EXPERT ** -0.5),
    }


def reference(x, c, ctx, c_ctx, ada_w, ada_b, ln_g, ln_b, attn_w_qkv, attn_w_o, attn_lambda, attn_subln_g,
              gla_w_in, gla_wg_down, gla_wg_up, gla_bg, gla_norm_g, gla_w_o, router_w, router_b,
              moe_w_gate, moe_w_up, moe_w_down):
    B, S, D = x.shape
    C = ctx.shape[1]
    ROWS = S // GRID_W
    cos, sin = rope_2d_tables(ROWS, x.dtype)
    silu_c = jax.nn.silu(c)
    silu_cc = jax.nn.silu(c_ctx)

    for i in range(DEPTH):
        need_ctx = i < DEPTH - 1
        mod = (silu_c @ ada_w[i] + ada_b[i])[:, None, :]
        mod_c = silu_cc @ ada_w[i] + ada_b[i]
        sh_m, sc_m, g_m, sh_f, sc_f, g_f = jnp.split(mod, 6, axis=-1)
        csh_m, csc_m, cg_m, csh_f, csc_f, cg_f = jnp.split(mod_c, 6, axis=-1)

        h_lat = modulate(x, sh_m, sc_m)
        h_ctx = modulate(ctx, csh_m, csc_m)
        j = i // N_MIXERS
        if i % N_MIXERS == 0:
            y_lat, y_ctx = diff_attention(h_lat, h_ctx, attn_w_qkv[j], attn_w_o[j], attn_lambda[j], attn_subln_g[j],
                                          0.8 - 0.6 * math.exp(-0.3 * i), cos, sin, need_ctx)
        else:
            y_lat, y_ctx = gla_mixer(h_lat, h_ctx, gla_w_in[j], gla_wg_down[j], gla_wg_up[j], gla_bg[j],
                                     gla_norm_g[j], gla_w_o[j], need_ctx)
        x = layer_norm(ALPHA * x + g_m * y_lat, ln_g[i, 0], ln_b[i, 0])
        if need_ctx:
            ctx = layer_norm(ALPHA * ctx + cg_m * y_ctx, ln_g[i, 0], ln_b[i, 0])

        tokens = modulate(x, sh_f, sc_f).reshape(B * S, D)
        if need_ctx:
            tokens = jnp.concatenate([tokens, modulate(ctx, csh_f, csc_f).reshape(B * C, D)], axis=0)
        y = grouped_top2_moe(tokens, router_w, router_b, moe_w_gate[i], moe_w_up[i], moe_w_down[i])
        x = layer_norm(ALPHA * x + g_f * y[:B * S].reshape(B, S, D), ln_g[i, 1], ln_b[i, 1])
        if need_ctx:
            ctx = layer_norm(ALPHA * ctx + cg_f * y[B * S:].reshape(B, C, D), ln_g[i, 1], ln_b[i, 1])
    return x
```

```cpp
#include <hip/hip_runtime.h>
#include <cstdint>
#include <cstdio>

constexpr int BATCH = 8, SEQ = 4096, DM = 1024, CTXL = 256;
constexpr int NLAT = BATCH * SEQ, NCTX = BATCH * CTXL, NTOK = NLAT + NCTX;
constexpr float ALPHA = 1.4142135623730951f;
constexpr float LN_EPS = 1e-5f;
constexpr float LAMBDA_INIT0 = 0.2f;
constexpr float C2 = 0.125f * 1.4426950408889634f;
constexpr int NEXP = 16, DEXP = 512, MAXSLOT = 73728;
constexpr int NCHUNK = NTOK / 64;
constexpr int NIN = 3328;

typedef unsigned short bf16;
typedef float f32x4 __attribute__((ext_vector_type(4)));
typedef float f32x2 __attribute__((ext_vector_type(2)));
typedef unsigned u32x2 __attribute__((ext_vector_type(2)));
typedef unsigned u32x4 __attribute__((ext_vector_type(4)));

constexpr size_t MiB = 1u << 20;
constexpr size_t WS_CTL = 0, CTL_ZERO_BYTES = 1 * MiB;
constexpr size_t WS_MOD = 1 * MiB;
constexpr size_t WS_MISC = 1 * MiB + 512 * 1024;
constexpr size_t WS_WQKV = 2 * MiB, WS_WO = 8 * MiB, WS_GU0 = 10 * MiB, WS_DN0 = 42 * MiB;
constexpr size_t WS_XCTX = 58 * MiB;
constexpr size_t WS_WIN = 66 * MiB, WS_WGO = 73 * MiB, WS_GU1 = 75 * MiB, WS_DN1 = 107 * MiB;
constexpr size_t WS_H = 123 * MiB;
constexpr size_t WS_Q = 191 * MiB, WS_K = 259 * MiB, WS_V = 327 * MiB, WS_O2 = 395 * MiB;
constexpr size_t WS_LIST = 463 * MiB;
constexpr size_t WS_TOKR = 466 * MiB;
constexpr size_t WS_DEC = 468 * MiB;
constexpr size_t WS_ZZ = 471 * MiB;
constexpr size_t WS_END = 480 * MiB;
constexpr size_t WS_O1 = WS_H, WS_A2 = WS_Q, WS_Y = WS_K;
constexpr size_t WS_YM = 191 * MiB, WS_ACT = 335 * MiB;
constexpr size_t WS_QR = 191 * MiB, WS_KR = 225 * MiB, WS_V1 = 259 * MiB, WS_R = 327 * MiB;
constexpr size_t WS_QT = WS_H, WS_KT = 395 * MiB;
constexpr size_t WS_OGF = 191 * MiB, WS_OGB = 2 * MiB;
constexpr size_t WS_A2B = WS_H;
constexpr int CW_TMO = 0, CW_CODE = 1;
constexpr int CW_CNT = 64;
constexpr int CW_BAR = 4096;

__device__ __forceinline__ unsigned f2bf(float f) { unsigned u = __builtin_bit_cast(unsigned, f); return (u + 0x7fffu + ((u >> 16) & 1u)) >> 16; }
__device__ __forceinline__ unsigned pk2(float lo, float hi) { return f2bf(lo) | (f2bf(hi) << 16); }
__device__ __forceinline__ float bf2f(unsigned b) { return __builtin_bit_cast(float, b << 16); }
__device__ __forceinline__ float wave_sum(float v) {
#pragma unroll
    for (int o = 1; o < 64; o <<= 1) v += __shfl_xor(v, o);
    return v;
}
__device__ __forceinline__ float silu_f(float v) { return v / (1.f + __expf(-v)); }

struct Prm {
    const float *x, *c, *ctx, *cctx, *ada_w, *ada_b, *ln_g, *ln_b, *w_qkv, *w_o, *lam, *subln, *gw_in, *gwg_down, *gwg_up, *gbg, *gnorm, *gw_o, *rw, *rb, *mg, *mu, *md;
    float* out; unsigned char* ws;
    int ph_lo, ph_hi, li, pad;
};
__device__ __forceinline__ void ld_row_f32(const float* p, int lane, f32x4 (&v)[4]) {
#pragma unroll
    for (int j = 0; j < 4; ++j) v[j] = *(const f32x4*)(p + 4 * lane + 256 * j);
}
__device__ __forceinline__ void st_row_f32(float* p, int lane, const f32x4 (&v)[4]) {
#pragma unroll
    for (int j = 0; j < 4; ++j) *(f32x4*)(p + 4 * lane + 256 * j) = v[j];
}
__device__ __forceinline__ void ld_row_bf16(const bf16* p, int lane, f32x4 (&v)[4]) {
#pragma unroll
    for (int j = 0; j < 4; ++j) { const u32x2 u = *(const u32x2*)(p + 4 * lane + 256 * j); v[j] = (f32x4){bf2f(u.x & 0xffffu), bf2f(u.x >> 16), bf2f(u.y & 0xffffu), bf2f(u.y >> 16)}; }
}
__device__ __forceinline__ void st_row_bf16(bf16* p, int lane, const f32x4 (&v)[4]) {
#pragma unroll
    for (int j = 0; j < 4; ++j) { u32x2 u; u.x = pk2(v[j].x, v[j].y); u.y = pk2(v[j].z, v[j].w); *(u32x2*)(p + 4 * lane + 256 * j) = u; }
}
__device__ __forceinline__ void ln_row(f32x4 (&v)[4], const float* g, const float* b, int lane) {
    float s = 0.f;
#pragma unroll
    for (int j = 0; j < 4; ++j) s += (v[j].x + v[j].y) + (v[j].z + v[j].w);
    const float mean = wave_sum(s) * (1.f / DM); float q = 0.f;
#pragma unroll
    for (int j = 0; j < 4; ++j) { v[j] = v[j] - mean; q += (v[j].x * v[j].x + v[j].y * v[j].y) + (v[j].z * v[j].z + v[j].w * v[j].w); }
    const float rstd = 1.f / sqrtf(wave_sum(q) * (1.f / DM) + LN_EPS);
#pragma unroll
    for (int j = 0; j < 4; ++j) { const f32x4 gg = *(const f32x4*)(g + 4 * lane + 256 * j), bb = *(const f32x4*)(b + 4 * lane + 256 * j); v[j] = v[j] * rstd * gg + bb; }
}
__host__ __device__ __forceinline__ int gu_phys(int other, int sel) { return (other >> 4) * 32 + sel * 16 + (other & 15); }
#define GAS __attribute__((address_space(1)))
#define LAS __attribute__((address_space(3)))
constexpr int NWAVES = 8, NTHR = NWAVES * 64;
constexpr int RING_BYTES = 131072, LDSCTL_OFF = RING_BYTES, MISC_OFF = LDSCTL_OFF + 320, LDS_BYTES = 147456;
constexpr int LDSX_OFF = RING_BYTES + 1024;
#define LDS_WAIT() asm volatile("s_waitcnt lgkmcnt(0)" ::: "memory")
#define VM_WAIT() asm volatile("s_waitcnt vmcnt(0)" ::: "memory")

struct Frame {
    unsigned char* lds;
    unsigned* ctl;
    int tid, lane, wave, G, bid;
};

template <int MODE>
__device__ __forceinline__ void p0_transpose_item(const float* W, int K, int N, bf16* WT, int row_off, float* scr, int item, int lane) {
    const int nblk = N / 32, kb = item / nblk, nb = item % nblk, k0 = 64 * kb, n0 = 32 * nb;
#pragma unroll 8
    for (int i = 0; i < 32; ++i) { const int kk = 2 * i + (lane >> 5); scr[kk * 33 + (lane & 31)] = W[(size_t)(k0 + kk) * N + n0 + (lane & 31)]; }
    LDS_WAIT(); asm volatile("" ::: "memory");
    const int c = lane & 7;
#pragma unroll
    for (int j = 0; j < 4; ++j) { const int n = (lane >> 3) + 8 * j; const float* s = scr + (8 * c) * 33 + n;
        u32x4 o; o.x = pk2(s[0 * 33], s[1 * 33]); o.y = pk2(s[2 * 33], s[3 * 33]); o.z = pk2(s[4 * 33], s[5 * 33]); o.w = pk2(s[6 * 33], s[7 * 33]);
        const int nl = n0 + n; const int pr = (MODE == 0) ? (row_off + nl) : (row_off + gu_phys(nl, MODE - 1));
        *(u32x4*)(WT + (size_t)pr * K + k0 + 8 * c) = o; }
    LDS_WAIT(); asm volatile("" ::: "memory");
}
__device__ __forceinline__ void phase_prologue(const Frame& F, const Prm& p) {
    float* sil = (float*)F.lds;
    for (int i = F.tid; i < 9 * 1024; i += NTHR) { const int r = i >> 10, k = i & 1023; const float v = (r < 8) ? p.c[r * 1024 + k] : p.cctx[k]; sil[i] = silu_f(v); }
    __syncthreads();
    float* MOD = (float*)(p.ws + WS_MOD);
    if (F.wave == 0 && F.bid < 192) {
        const int layer = F.bid / 96, n = (F.bid % 96) * 64 + F.lane; const float* W = p.ada_w + (size_t)layer * 1024 * 6144 + n;
        float acc[9];
#pragma unroll
        for (int r = 0; r < 9; ++r) acc[r] = 0.f;
#pragma unroll 4
        for (int k = 0; k < 1024; k += 4) {
            const float w0 = W[(size_t)k * 6144], w1 = W[(size_t)(k + 1) * 6144], w2 = W[(size_t)(k + 2) * 6144], w3 = W[(size_t)(k + 3) * 6144];
#pragma unroll
            for (int r = 0; r < 9; ++r) { const f32x4 s = *(const f32x4*)(sil + r * 1024 + k); acc[r] += s.x * w0 + s.y * w1 + s.z * w2 + s.w * w3; }
        }
        const float bb = p.ada_b[layer * 6144 + n];
#pragma unroll
        for (int r = 0; r < 9; ++r) MOD[(layer * 9 + r) * 6144 + n] = acc[r] + bb;
    }
    float* misc = (float*)(p.ws + WS_MISC);
    if (F.bid == 255 % F.G && F.wave == 1) {
        const float a = wave_sum(p.lam[F.lane] * p.lam[64 + F.lane]), b = wave_sum(p.lam[128 + F.lane] * p.lam[192 + F.lane]);
        if (F.lane == 0) misc[0] = __expf(a) - __expf(b) + LAMBDA_INIT0;
        for (int i = F.lane; i < 1024; i += 64) { const int pos = i >> 4, f = i & 15; const float inv = powf(10000.f, -(float)f / 16.f); const float ang = (float)pos * inv;
            misc[1024 + 2 * i] = cosf(ang); misc[1024 + 2 * i + 1] = sinf(ang); }
    }
    float* scr = (float*)(F.lds + 36864 + F.wave * 8704);
    const int gw = F.bid * NWAVES + F.wave, NGW = F.G * NWAVES;
    constexpr int I_QKV = 16 * 96, I_SQ = 16 * 32, I_G = 16 * 16, I_D = 8 * 32;
    constexpr int I_MOE = 2 * I_G + I_D;
    constexpr int NITEMS = 2 * I_QKV + 2 * I_SQ + 32 * I_MOE;
    bf16* ws16 = (bf16*)p.ws;
    for (int it = gw; it < NITEMS; it += NGW) {
        int r = it;
        if (r < I_QKV) { p0_transpose_item<0>(p.w_qkv, 1024, 3072, (bf16*)(p.ws + WS_WQKV), 0, scr, r, F.lane); continue; } r -= I_QKV;
        if (r < I_QKV) { p0_transpose_item<0>(p.gw_in, 1024, 3072, (bf16*)(p.ws + WS_WIN), 0, scr, r, F.lane); continue; } r -= I_QKV;
        if (r < I_SQ) { p0_transpose_item<0>(p.w_o, 1024, 1024, (bf16*)(p.ws + WS_WO), 0, scr, r, F.lane); continue; } r -= I_SQ;
        if (r < I_SQ) { p0_transpose_item<0>(p.gw_o, 1024, 1024, (bf16*)(p.ws + WS_WGO), 0, scr, r, F.lane); continue; } r -= I_SQ;
        const int le = r / I_MOE, layer = le >> 4, e = le & 15; r -= le * I_MOE;
        bf16* GU = (bf16*)(p.ws + (layer ? WS_GU1 : WS_GU0)) + (size_t)e * 1024 * 1024; bf16* DN = (bf16*)(p.ws + (layer ? WS_DN1 : WS_DN0)) + (size_t)e * 1024 * 512;
        if (r < I_G) { p0_transpose_item<1>(p.mg + (size_t)le * 1024 * 512, 1024, 512, GU, 0, scr, r, F.lane); continue; } r -= I_G;
        if (r < I_G) { p0_transpose_item<2>(p.mu + (size_t)le * 1024 * 512, 1024, 512, GU, 0, scr, r, F.lane); continue; } r -= I_G;
        p0_transpose_item<0>(p.md + (size_t)le * 512 * 1024, 512, 1024, DN, 0, scr, r, F.lane);
    }
    (void)ws16;
    bf16* WIN = (bf16*)(p.ws + WS_WIN);
    for (int i = gw * 64 + F.lane; i < 32 * 1024; i += NGW * 64) { const int rr = i >> 10, k = i & 1023, dir = rr >> 4, j = rr & 15;
        WIN[(size_t)(3072 + rr) * 1024 + k] = (bf16)f2bf(p.gwg_down[(size_t)dir * 1024 * 16 + k * 16 + j]); }
    for (int i = gw * 64 + F.lane; i < 224 * 1024 / 8; i += NGW * 64) *(u32x4*)(WIN + (size_t)3104 * 1024 + (size_t)i * 8) = (u32x4){0u, 0u, 0u, 0u};
}

__device__ __forceinline__ void phase_modulate0(const Frame& F, const Prm& p) {
    const float* MOD = (const float*)(p.ws + WS_MOD); bf16* H = (bf16*)(p.ws + WS_H);
    const int gw = F.bid * NWAVES + F.wave, NGW = F.G * NWAVES, per = (NTOK + NGW - 1) / NGW;
    int curmod = -1; f32x4 sh[4], sc[4];
    for (int tok = gw * per; tok < (gw + 1) * per && tok < NTOK; ++tok) {
        const int mr = tok < NLAT ? tok / SEQ : 8; const float* src = tok < NLAT ? p.x + (size_t)tok * DM : p.ctx + (size_t)(tok - NLAT) * DM;
        if (mr != curmod) { curmod = mr; ld_row_f32(MOD + mr * 6144, F.lane, sh); ld_row_f32(MOD + mr * 6144 + 1024, F.lane, sc); }
        f32x4 v[4]; ld_row_f32(src, F.lane, v);
#pragma unroll
        for (int j = 0; j < 4; ++j) v[j] = v[j] * (1.f + sc[j]) + sh[j];
        st_row_bf16(H + (size_t)tok * DM, F.lane, v);
    }
}

__device__ __forceinline__ void phase_attn_combine(const Frame& F, const Prm& p) {
    const bf16* O1 = (const bf16*)(p.ws + WS_O1); const bf16* O2 = (const bf16*)(p.ws + WS_O2); bf16* A2 = (bf16*)(p.ws + WS_A2);
    const float lam = ((const float*)(p.ws + WS_MISC))[0];
    const f32x4 sg = *(const f32x4*)(p.subln + 4 * (F.lane & 31));
    const int gw = F.bid * NWAVES + F.wave, NGW = F.G * NWAVES;
    for (int tok = gw; tok < NTOK; tok += NGW) {
        f32x4 a[4], b[4]; ld_row_bf16(O1 + (size_t)tok * DM, F.lane, a); ld_row_bf16(O2 + (size_t)tok * DM, F.lane, b);
#pragma unroll
        for (int j = 0; j < 4; ++j) {
            f32x4 o = a[j] - lam * b[j]; float q = (o.x * o.x + o.y * o.y) + (o.z * o.z + o.w * o.w);
#pragma unroll
            for (int s = 1; s < 32; s <<= 1) q += __shfl_xor(q, s);
            const float r = (1.f - LAMBDA_INIT0) / sqrtf(q * (1.f / 128.f) + LN_EPS);
            a[j] = o * r * sg;
        }
        st_row_bf16(A2 + (size_t)tok * DM, F.lane, a);
    }
}

__device__ __forceinline__ void phase_ln_route(const Frame& F, const Prm& p, int layer) {
    const int nrows = layer ? NLAT : NTOK;
    const float* MOD = (const float*)(p.ws + WS_MOD) + layer * 9 * 6144;
    const bf16* Y = (const bf16*)(p.ws + WS_Y); bf16* HF = (bf16*)(p.ws + WS_H);
    float* XCTX = (float*)(p.ws + WS_XCTX);
    int* LIST = (int*)(p.ws + WS_LIST); int* TOKR = (int*)(p.ws + WS_TOKR);
    unsigned* CNT = F.ctl + CW_CNT + layer * 16;
    float* WrT = (float*)F.lds;
    int* rec = (int*)(F.lds + 65536);
    unsigned* lcnt = (unsigned*)(F.lds + 65536 + 8192); unsigned* lbase = lcnt + 16;
    for (int i = F.tid; i < 16 * 1024; i += NTHR) { const int k = i >> 4, e = i & 15; WrT[e * 1024 + k] = p.rw[i]; }
    if (F.tid < 16) lcnt[F.tid] = 0u;
    __syncthreads();
    const int per_wg = (nrows + F.G - 1) / F.G, per_w = (per_wg + NWAVES - 1) / NWAVES;
    const int row_lo = F.bid * per_wg, row_hi = min(nrows, row_lo + per_wg);
    const float* lng = p.ln_g + (layer * 2 + 0) * DM; const float* lnb = p.ln_b + (layer * 2 + 0) * DM;
    float rb[16];
#pragma unroll
    for (int e = 0; e < 16; ++e) rb[e] = p.rb[e];
    int curmod = -1; f32x4 gm[4], shf[4], scf[4];
    for (int i = 0; i < per_w; ++i) {
        const int lr = F.wave * per_w + i, tok = row_lo + lr; if (tok >= row_hi) break;
        const int mr = tok < NLAT ? tok / SEQ : 8;
        if (mr != curmod) { curmod = mr; ld_row_f32(MOD + mr * 6144 + 2048, F.lane, gm); ld_row_f32(MOD + mr * 6144 + 3072, F.lane, shf); ld_row_f32(MOD + mr * 6144 + 4096, F.lane, scf); }
        float* xdst = tok < NLAT ? p.out + (size_t)tok * DM : XCTX + (size_t)(tok - NLAT) * DM;
        const float* xsrc = layer ? (const float*)xdst : (tok < NLAT ? p.x + (size_t)tok * DM : p.ctx + (size_t)(tok - NLAT) * DM);
        f32x4 v[4], y[4]; ld_row_f32(xsrc, F.lane, v); ld_row_bf16(Y + (size_t)tok * DM, F.lane, y);
#pragma unroll
        for (int j = 0; j < 4; ++j) v[j] = ALPHA * v[j] + gm[j] * y[j];
        ln_row(v, lng, lnb, F.lane);
        st_row_f32(xdst, F.lane, v);
#pragma unroll
        for (int j = 0; j < 4; ++j) v[j] = v[j] * (1.f + scf[j]) + shf[j];
        st_row_bf16(HF + (size_t)tok * DM, F.lane, v);
        float part[16];
#pragma unroll
        for (int e = 0; e < 16; ++e) { float s = 0.f;
#pragma unroll
            for (int j = 0; j < 4; ++j) { const f32x4 w = *(const f32x4*)(WrT + e * 1024 + 4 * F.lane + 256 * j); s += (v[j].x * w.x + v[j].y * w.y) + (v[j].z * w.z + v[j].w * w.w); }
            part[e] = s; }
        {
#pragma unroll
            for (int e = 0; e < 8; ++e) { const bool up = (F.lane & 32) != 0; const float keep = up ? part[e + 8] : part[e], send = up ? part[e] : part[e + 8]; part[e] = keep + __shfl_xor(send, 32); }
#pragma unroll
            for (int e = 0; e < 4; ++e) { const bool up = (F.lane & 16) != 0; const float keep = up ? part[e + 4] : part[e], send = up ? part[e] : part[e + 4]; part[e] = keep + __shfl_xor(send, 16); }
#pragma unroll
            for (int e = 0; e < 2; ++e) { const bool up = (F.lane & 8) != 0; const float keep = up ? part[e + 2] : part[e], send = up ? part[e] : part[e + 2]; part[e] = keep + __shfl_xor(send, 8); }
            { const bool up = (F.lane & 4) != 0; const float keep = up ? part[1] : part[0], send = up ? part[0] : part[1]; part[0] = keep + __shfl_xor(send, 4); }
            part[0] += __shfl_xor(part[0], 2); part[0] += __shfl_xor(part[0], 1);
        }
        float aff[16], sel[16];
#pragma unroll
        for (int e = 0; e < 16; ++e) { const int src = ((e >> 3) & 1) * 32 + ((e >> 2) & 1) * 16 + ((e >> 1) & 1) * 8 + (e & 1) * 4; const float lg = __shfl(part[0], src); aff[e] = 1.f / (1.f + __expf(-lg)); sel[e] = aff[e] + rb[e]; }
        int bg = 0; float bgs = -3.0e38f;
#pragma unroll
        for (int g = 0; g < 4; ++g) { float m1 = -3.0e38f, m2 = -3.0e38f;
#pragma unroll
            for (int k = 0; k < 4; ++k) { const float s = sel[4 * g + k]; if (s > m1) { m2 = m1; m1 = s; } else if (s > m2) m2 = s; }
            const float gs = m1 + m2; if (gs > bgs) { bgs = gs; bg = g; } }
        int i1 = 0, i2 = 0; float s1 = -3.0e38f, s2 = -3.0e38f, a1 = 0.f, a2 = 0.f;
#pragma unroll
        for (int g = 0; g < 4; ++g) if (g == bg) {
#pragma unroll
            for (int k = 0; k < 4; ++k) { const float s = sel[4 * g + k], a = aff[4 * g + k];
                if (s > s1) { s2 = s1; i2 = i1; a2 = a1; s1 = s; i1 = 4 * g + k; a1 = a; } else if (s > s2) { s2 = s; i2 = 4 * g + k; a2 = a; } } }
        const float wsum = a1 + a2, w1 = a1 / wsum, w2 = a2 / wsum;
        if (F.lane == 0) { const unsigned l1 = atomicAdd(&lcnt[i1], 1u), l2 = atomicAdd(&lcnt[i2], 1u);
            rec[lr * 6 + 0] = i1; rec[lr * 6 + 1] = i2; rec[lr * 6 + 2] = (int)l1; rec[lr * 6 + 3] = (int)l2; rec[lr * 6 + 4] = __float_as_int(w1); rec[lr * 6 + 5] = __float_as_int(w2); }
    }
    __syncthreads();
    if (F.tid < 16) lbase[F.tid] = __hip_atomic_fetch_add(&CNT[F.tid], lcnt[F.tid], __ATOMIC_RELAXED, __HIP_MEMORY_SCOPE_AGENT);
    __syncthreads();
    for (int lr = F.tid; lr < row_hi - row_lo; lr += NTHR) { const int tok = row_lo + lr;
        const int e0 = rec[lr * 6], e1 = rec[lr * 6 + 1]; const int p0 = (int)lbase[e0] + rec[lr * 6 + 2], p1 = (int)lbase[e1] + rec[lr * 6 + 3];
        LIST[e0 * NTOK + p0] = tok; LIST[e1 * NTOK + p1] = tok;
        int* tr = TOKR + (size_t)tok * 8; tr[0] = e0; tr[1] = p0; tr[2] = e1; tr[3] = p1; tr[4] = rec[lr * 6 + 4]; tr[5] = rec[lr * 6 + 5]; }
    __syncthreads();
}

__device__ __forceinline__ void pad_bases(const unsigned* cnt, int (&pb)[17]) {
    int acc = 0;
#pragma unroll
    for (int e = 0; e < 16; ++e) { pb[e] = acc; const int c = (int)__hip_atomic_load(cnt + e, __ATOMIC_RELAXED, __HIP_MEMORY_SCOPE_AGENT); acc += (c + 255) & ~255; }
    pb[16] = acc;
}

__device__ __forceinline__ void phase_moe_combine(const Frame& F, const Prm& p, int layer) {
    const int nrows = layer ? NLAT : NTOK;
    const float* MOD = (const float*)(p.ws + WS_MOD) + layer * 9 * 6144; const float* MOD1 = (const float*)(p.ws + WS_MOD) + 9 * 6144;
    const bf16* YM = (const bf16*)(p.ws + WS_YM); bf16* H = (bf16*)(p.ws + WS_H); float* XCTX = (float*)(p.ws + WS_XCTX); const int* TOKR = (const int*)(p.ws + WS_TOKR);
    int pb[17]; pad_bases(F.ctl + CW_CNT + layer * 16, pb);
    int* pbl = (int*)F.lds; if (F.tid < 17) { int v = 0;
#pragma unroll
        for (int e = 0; e < 17; ++e) if (e == F.tid) v = pb[e];
        pbl[F.tid] = v; }
    __syncthreads();
    const float* lng = p.ln_g + (layer * 2 + 1) * DM; const float* lnb = p.ln_b + (layer * 2 + 1) * DM;
    const int gw = F.bid * NWAVES + F.wave, NGW = F.G * NWAVES, per = (nrows + NGW - 1) / NGW;
    int curmod = -1; f32x4 gf[4], sh1[4], sc1[4];
    for (int tok = gw * per; tok < (gw + 1) * per && tok < nrows; ++tok) {
        const int mr = tok < NLAT ? tok / SEQ : 8;
        if (mr != curmod) { curmod = mr; ld_row_f32(MOD + mr * 6144 + 5120, F.lane, gf); if (!layer) { ld_row_f32(MOD1 + mr * 6144, F.lane, sh1); ld_row_f32(MOD1 + mr * 6144 + 1024, F.lane, sc1); } }
        const int* tr = TOKR + (size_t)tok * 8; const int s0 = pbl[tr[0]] + tr[1], s1 = pbl[tr[2]] + tr[3]; const float w0 = __int_as_float(tr[4]), w1 = __int_as_float(tr[5]);
        float* xp = tok < NLAT ? p.out + (size_t)tok * DM : XCTX + (size_t)(tok - NLAT) * DM;
        f32x4 v[4], a[4], b[4]; ld_row_f32(xp, F.lane, v); ld_row_bf16(YM + (size_t)s0 * DM, F.lane, a); ld_row_bf16(YM + (size_t)s1 * DM, F.lane, b);
#pragma unroll
        for (int j = 0; j < 4; ++j) v[j] = ALPHA * v[j] + gf[j] * (w0 * a[j] + w1 * b[j]);
        ln_row(v, lng, lnb, F.lane);
        st_row_f32(xp, F.lane, v);
        if (!layer) {
#pragma unroll
            for (int j = 0; j < 4; ++j) v[j] = v[j] * (1.f + sc1[j]) + sh1[j];
            st_row_bf16(H + (size_t)tok * DM, F.lane, v);
        }
    }
}

__device__ __forceinline__ void phase_gla_prep(const Frame& F, const Prm& p) {
    const bf16* QR = (const bf16*)(p.ws + WS_QR); const bf16* KR = (const bf16*)(p.ws + WS_KR); const float* ZZ = (const float*)(p.ws + WS_ZZ);
    bf16* QT = (bf16*)(p.ws + WS_QT); bf16* KT = (bf16*)(p.ws + WS_KT); float* DEC = (float*)(p.ws + WS_DEC);
    const int gw = F.bid * NWAVES + F.wave, NGW = F.G * NWAVES;
    for (int task = gw; task < 2 * NCHUNK * 8; task += NGW) {
        const int dh = task & 7, chunk = (task >> 3) % NCHUNK, dir = task / (8 * NCHUNK);
        const int col = dh * 64 + F.lane, tok0 = chunk * 64;
        float wup[16];
#pragma unroll
        for (int j = 0; j < 16; ++j) wup[j] = p.gwg_up[(size_t)dir * 16 * 512 + j * 512 + col];
        const float bgv = p.gbg[dir * 512 + col];
        float b = 0.f;
#pragma unroll 4
        for (int tt = 0; tt < 64; ++tt) {
            const int t = dir ? 63 - tt : tt, tok = tok0 + t;
            const float* zr = ZZ + (size_t)tok * 32 + dir * 16; float z = bgv;
#pragma unroll
            for (int j = 0; j < 16; j += 4) { const f32x4 zv = *(const f32x4*)(zr + j); z += zv.x * wup[j] + zv.y * wup[j + 1] + zv.z * wup[j + 2] + zv.w * wup[j + 3]; }
            const float g = (fminf(z, 0.f) - log1pf(__expf(-fabsf(z)))) * (1.f / 16.f);
            b += g;
            const float q = bf2f(QR[(size_t)tok * 512 + col]), k = bf2f(KR[(size_t)tok * 512 + col]);
            QT[((size_t)dir * NTOK + tok) * 512 + col] = (bf16)f2bf(q * __expf(b)); KT[((size_t)dir * NTOK + tok) * 512 + col] = (bf16)f2bf(k * __expf(-b));
        }
        DEC[((size_t)dir * NCHUNK + chunk) * 512 + col] = __expf(b);
    }
}

__device__ __forceinline__ void phase_gla_post(const Frame& F, const Prm& p) {
    const bf16* OF = (const bf16*)(p.ws + WS_OGF); const bf16* OB = (const bf16*)(p.ws + WS_OGB); const bf16* R = (const bf16*)(p.ws + WS_R); bf16* A2 = (bf16*)(p.ws + WS_A2B);
    const f32x4 ng = *(const f32x4*)(p.gnorm + 4 * F.lane);
    const int gw = F.bid * NWAVES + F.wave, NGW = F.G * NWAVES;
    for (int tok = gw; tok < NLAT; tok += NGW) {
        f32x4 a[4], b[4], r[4]; ld_row_bf16(OF + (size_t)tok * DM, F.lane, a); ld_row_bf16(OB + (size_t)tok * DM, F.lane, b); ld_row_bf16(R + (size_t)tok * DM, F.lane, r);
#pragma unroll
        for (int j = 0; j < 4; ++j) {
            const f32x4 o = a[j] + b[j]; const float q = wave_sum((o.x * o.x + o.y * o.y) + (o.z * o.z + o.w * o.w));
            const float rs = 1.f / sqrtf(q * (1.f / 256.f) + LN_EPS);
            a[j] = (f32x4){o.x * rs * ng.x * silu_f(r[j].x), o.y * rs * ng.y * silu_f(r[j].y), o.z * rs * ng.z * silu_f(r[j].z), o.w * rs * ng.w * silu_f(r[j].w)};
        }
        st_row_bf16(A2 + (size_t)tok * DM, F.lane, a);
    }
}
namespace naive {
enum { EPI_QKV = 0, EPI_PLAIN = 1, EPI_GATEUP = 2, EPI_DOWN = 3, EPI_INPROJ = 4 };
struct NG { const bf16* A; const bf16* Bt; int M, N, K; int layer; bf16* O; };
template <int EPI> __global__ __launch_bounds__(256) void gemm_kernel(NG g, Prm p) {
    __shared__ float As[64][33], Bs[64][33], Cs[64][65]; __shared__ int rowsrc[64];
    const int tid = threadIdx.x, n0 = blockIdx.x * 64, m0 = blockIdx.y * 64, ty = tid >> 4, tx = tid & 15;
    const bf16* Bt = g.Bt; int e = 0, ebase = 0, ecnt = 0;
    if (EPI == EPI_GATEUP || EPI == EPI_DOWN) {
        const unsigned* cnt = (const unsigned*)(p.ws + WS_CTL) + CW_CNT + g.layer * 16; int acc = 0; bool found = false;
        for (int i = 0; i < 16; ++i) { const int c = (int)cnt[i], pc = (c + 255) & ~255; if (!found && m0 < acc + pc) { e = i; ebase = acc; ecnt = c; found = true; } acc += pc; }
        if (!found || m0 - ebase >= ecnt) return;
        Bt += (size_t)e * g.N * g.K;
    }
    if (tid < 64) { int r = m0 + tid;
        if (EPI == EPI_GATEUP) { const int li = m0 - ebase + tid; const int* LIST = (const int*)(p.ws + WS_LIST); r = (li < ecnt) ? LIST[e * NTOK + li] : 0; }
        rowsrc[tid] = r; }
    __syncthreads();
    float acc[4][4] = {};
    for (int k0 = 0; k0 < g.K; k0 += 32) {
        { const int r = tid >> 2, kc = (tid & 3) * 8; const u32x4 ua = *(const u32x4*)(g.A + (size_t)rowsrc[r] * g.K + k0 + kc), ub = *(const u32x4*)(Bt + (size_t)(n0 + r) * g.K + k0 + kc);
            const unsigned a4[4] = {ua.x, ua.y, ua.z, ua.w}, b4[4] = {ub.x, ub.y, ub.z, ub.w};
#pragma unroll
            for (int i = 0; i < 4; ++i) { As[r][kc + 2 * i] = bf2f(a4[i] & 0xffffu); As[r][kc + 2 * i + 1] = bf2f(a4[i] >> 16); Bs[r][kc + 2 * i] = bf2f(b4[i] & 0xffffu); Bs[r][kc + 2 * i + 1] = bf2f(b4[i] >> 16); } }
        __syncthreads();
#pragma unroll 8
        for (int kk = 0; kk < 32; ++kk) { float a[4], b[4];
#pragma unroll
            for (int i = 0; i < 4; ++i) { a[i] = As[4 * ty + i][kk]; b[i] = Bs[4 * tx + i][kk]; }
#pragma unroll
            for (int i = 0; i < 4; ++i)
#pragma unroll
                for (int j = 0; j < 4; ++j) acc[i][j] += a[i] * b[j]; }
        __syncthreads();
    }
#pragma unroll
    for (int i = 0; i < 4; ++i)
#pragma unroll
        for (int j = 0; j < 4; ++j) Cs[4 * ty + i][4 * tx + j] = acc[i][j];
    __syncthreads();
    const float* rope = (const float*)(p.ws + WS_MISC) + 1024;
    for (int idx = tid; idx < 4096; idx += 256) {
        const int r = idx >> 6, cc = idx & 63, n = n0 + cc, row = m0 + r; const float val = Cs[r][cc];
        if (EPI == EPI_QKV) {
            if (n < 2048) { float o = val;
                if (row < NLAT) { const int d = n & 63, s = row & (SEQ - 1), pos = (d & 32) ? (s & 63) : (s >> 6), f = d & 15; const float cs = rope[(pos * 16 + f) * 2], sn = rope[(pos * 16 + f) * 2 + 1];
                    o = (d & 16) ? val * cs + Cs[r][cc - 16] * sn : val * cs - Cs[r][cc + 16] * sn; }
                if (n < 1024) ((bf16*)(p.ws + WS_Q))[(size_t)row * DM + n] = (bf16)f2bf(o * C2); else ((bf16*)(p.ws + WS_K))[(size_t)row * DM + n - 1024] = (bf16)f2bf(o);
            } else ((bf16*)(p.ws + WS_V))[(size_t)row * DM + n - 2048] = (bf16)f2bf(val);
        } else if (EPI == EPI_PLAIN) { g.O[(size_t)row * g.N + n] = (bf16)f2bf(val);
        } else if (EPI == EPI_GATEUP) { if (!(cc & 16)) { const float gt = val, up = Cs[r][cc + 16]; const int other = (n >> 5) * 16 + (n & 15); ((bf16*)(p.ws + WS_ACT))[(size_t)row * DEXP + other] = (bf16)f2bf(silu_f(gt) * up); }
        } else if (EPI == EPI_DOWN) { ((bf16*)(p.ws + WS_YM))[(size_t)row * DM + n] = (bf16)f2bf(val);
        } else if (EPI == EPI_INPROJ) {
            if (n < 512) ((bf16*)(p.ws + WS_QR))[(size_t)row * 512 + n] = (bf16)f2bf(val * 0.08838834764831845f);
            else if (n < 1024) ((bf16*)(p.ws + WS_KR))[(size_t)row * 512 + n - 512] = (bf16)f2bf(val);
            else if (n < 2048) ((bf16*)(p.ws + WS_V1))[(size_t)row * DM + n - 1024] = (bf16)f2bf(val);
            else if (n < 3072) ((bf16*)(p.ws + WS_R))[(size_t)row * DM + n - 2048] = (bf16)f2bf(val);
            else if (n < 3104) ((float*)(p.ws + WS_ZZ))[(size_t)row * 32 + n - 3072] = val;
        }
    }
}
__global__ __launch_bounds__(256) void attn_kernel(Prm p) {
    __shared__ float Qs[64][65], Ks[32][65], Ps[64][33], Vs[32][129], al[64];
    const bf16* Q = (const bf16*)(p.ws + WS_Q); const bf16* K = (const bf16*)(p.ws + WS_K); const bf16* V = (const bf16*)(p.ws + WS_V);
    const int tid = threadIdx.x, ty = tid >> 4, tx = tid & 15, qb = blockIdx.x, hm = blockIdx.y, h = hm >> 1;
    const bool lat = qb < 512; const int b = lat ? qb >> 6 : (qb - 512) >> 2; const int tok0 = lat ? qb * 64 : NLAT + (qb - 512) * 64;
    bf16* O = (bf16*)(p.ws + ((hm & 1) ? WS_O2 : WS_O1));
    for (int i = tid; i < 4096; i += 256) { const int r = i >> 6, d = i & 63; Qs[r][d] = bf2f(Q[(size_t)(tok0 + r) * DM + hm * 64 + d]); }
    float o[4][8] = {}; float mrow = -3.0e38f, lrow = 0.f;
    const int nkt = lat ? (CTXL + SEQ) / 32 : CTXL / 32;
    for (int kt = 0; kt < nkt; ++kt) {
        const int key0 = (kt < CTXL / 32) ? NLAT + b * CTXL + kt * 32 : b * SEQ + (kt - CTXL / 32) * 32;
        __syncthreads();
        for (int i = tid; i < 2048; i += 256) { const int r = i >> 6, d = i & 63; Ks[r][d] = bf2f(K[(size_t)(key0 + r) * DM + hm * 64 + d]); }
        for (int i = tid; i < 4096; i += 256) { const int r = i >> 7, d = i & 127; Vs[r][d] = bf2f(V[(size_t)(key0 + r) * DM + h * 128 + d]); }
        __syncthreads();
        float s[4][2] = {};
        for (int d = 0; d < 64; ++d) { float a[4], bb[2];
#pragma unroll
            for (int i = 0; i < 4; ++i) a[i] = Qs[4 * ty + i][d];
            bb[0] = Ks[2 * tx][d]; bb[1] = Ks[2 * tx + 1][d];
#pragma unroll
            for (int i = 0; i < 4; ++i) { s[i][0] += a[i] * bb[0]; s[i][1] += a[i] * bb[1]; } }
#pragma unroll
        for (int i = 0; i < 4; ++i) { Ps[4 * ty + i][2 * tx] = s[i][0]; Ps[4 * ty + i][2 * tx + 1] = s[i][1]; }
        __syncthreads();
        if (tid < 64) { float mx = mrow;
            for (int j = 0; j < 32; ++j) mx = fmaxf(mx, Ps[tid][j]);
            const float a = exp2f(mrow - mx); float sum = 0.f;
            for (int j = 0; j < 32; ++j) { const float e = exp2f(Ps[tid][j] - mx); Ps[tid][j] = e; sum += e; }
            lrow = lrow * a + sum; mrow = mx; al[tid] = a; }
        __syncthreads();
#pragma unroll
        for (int i = 0; i < 4; ++i) { const float a = al[4 * ty + i];
#pragma unroll
            for (int j = 0; j < 8; ++j) o[i][j] *= a; }
        for (int kk = 0; kk < 32; ++kk) { float pv[4], vv[8];
#pragma unroll
            for (int i = 0; i < 4; ++i) pv[i] = Ps[4 * ty + i][kk];
#pragma unroll
            for (int j = 0; j < 8; ++j) vv[j] = Vs[kk][8 * tx + j];
#pragma unroll
            for (int i = 0; i < 4; ++i)
#pragma unroll
                for (int j = 0; j < 8; ++j) o[i][j] += pv[i] * vv[j]; }
    }
    __syncthreads();
    if (tid < 64) al[tid] = 1.f / lrow;
    __syncthreads();
#pragma unroll
    for (int i = 0; i < 4; ++i) { const float a = al[4 * ty + i];
#pragma unroll
        for (int j = 0; j < 8; ++j) O[(size_t)(tok0 + 4 * ty + i) * DM + h * 128 + 8 * tx + j] = (bf16)f2bf(o[i][j] * a); }
}
__global__ __launch_bounds__(256) void gla_scan_kernel(Prm p) {
    extern __shared__ __attribute__((aligned(16))) unsigned char sm[];
    float (*S)[33] = (float (*)[33])sm;
    float (*Qs)[129] = (float (*)[129])(sm + 128 * 33 * 4);
    float (*Ks)[129] = (float (*)[129])(sm + 128 * 33 * 4 + 64 * 129 * 4);
    float (*Vs)[33] = (float (*)[33])(sm + 128 * 33 * 4 + 2 * 64 * 129 * 4);
    float (*Ps)[65] = (float (*)[65])(sm + 128 * 33 * 4 + 2 * 64 * 129 * 4 + 64 * 33 * 4);
    float* dec = (float*)(sm + 128 * 33 * 4 + 2 * 64 * 129 * 4 + 64 * 33 * 4 + 64 * 65 * 4);
    const bf16* QT = (const bf16*)(p.ws + WS_QT); const bf16* KT = (const bf16*)(p.ws + WS_KT); const bf16* V = (const bf16*)(p.ws + WS_V1); const float* DEC = (const float*)(p.ws + WS_DEC);
    const int tid = threadIdx.x, ty = tid >> 4, tx = tid & 15, vs = blockIdx.x & 7, dir = (blockIdx.x >> 3) & 1, h = (blockIdx.x >> 4) & 3, b = blockIdx.x >> 6;
    bf16* OG = (bf16*)(p.ws + (dir ? WS_OGB : WS_OGF));
    for (int i = tid; i < 128 * 32; i += 256) S[i >> 5][i & 31] = 0.f;
    for (int step = 0; step < 68; ++step) {
        const bool lat = step >= 4; const int ci = lat ? step - 4 : step;
        const int chunk = lat ? b * 64 + (dir ? 63 - ci : ci) : 512 + b * 4 + (dir ? 3 - ci : ci); const int tok0 = chunk * 64;
        __syncthreads();
        for (int i = tid; i < 64 * 128; i += 256) { const int t = i >> 7, d = i & 127; const size_t off = ((size_t)dir * NTOK + tok0 + t) * 512 + h * 128 + d; Qs[t][d] = bf2f(QT[off]); Ks[t][d] = bf2f(KT[off]); }
        for (int i = tid; i < 64 * 32; i += 256) { const int t = i >> 5, v = i & 31; Vs[t][v] = bf2f(V[(size_t)(tok0 + t) * DM + h * 256 + vs * 32 + v]); }
        if (tid < 128) dec[tid] = DEC[((size_t)dir * NCHUNK + chunk) * 512 + h * 128 + tid];
        __syncthreads();
        if (lat) {
            float s[4][4] = {};
            for (int d = 0; d < 128; ++d) { float a[4], bb[4];
#pragma unroll
                for (int i = 0; i < 4; ++i) { a[i] = Qs[4 * ty + i][d]; bb[i] = Ks[4 * tx + i][d]; }
#pragma unroll
                for (int i = 0; i < 4; ++i)
#pragma unroll
                    for (int j = 0; j < 4; ++j) s[i][j] += a[i] * bb[j]; }
#pragma unroll
            for (int i = 0; i < 4; ++i)
#pragma unroll
                for (int j = 0; j < 4; ++j) { const int t = 4 * ty + i, sidx = 4 * tx + j; const bool keep = dir ? (sidx >= t) : (sidx <= t); Ps[t][sidx] = keep ? s[i][j] : 0.f; }
            __syncthreads();
            float o[4][2] = {};
            for (int sidx = 0; sidx < 64; ++sidx) { const float v0 = Vs[sidx][2 * tx], v1 = Vs[sidx][2 * tx + 1];
#pragma unroll
                for (int i = 0; i < 4; ++i) { const float pp = Ps[4 * ty + i][sidx]; o[i][0] += pp * v0; o[i][1] += pp * v1; } }
            for (int d = 0; d < 128; ++d) { const float s0 = S[d][2 * tx], s1 = S[d][2 * tx + 1];
#pragma unroll
                for (int i = 0; i < 4; ++i) { const float qq = Qs[4 * ty + i][d]; o[i][0] += qq * s0; o[i][1] += qq * s1; } }
#pragma unroll
            for (int i = 0; i < 4; ++i) { const size_t off = (size_t)(tok0 + 4 * ty + i) * DM + h * 256 + vs * 32 + 2 * tx; OG[off] = (bf16)f2bf(o[i][0]); OG[off + 1] = (bf16)f2bf(o[i][1]); }
            __syncthreads();
        }
        float u[8][2] = {};
        for (int sidx = 0; sidx < 64; ++sidx) { const float v0 = Vs[sidx][2 * tx], v1 = Vs[sidx][2 * tx + 1];
#pragma unroll
            for (int i = 0; i < 8; ++i) { const float kk = Ks[sidx][8 * ty + i]; u[i][0] += kk * v0; u[i][1] += kk * v1; } }
#pragma unroll
        for (int i = 0; i < 8; ++i) { const int d = 8 * ty + i; S[d][2 * tx] = dec[d] * (S[d][2 * tx] + u[i][0]); S[d][2 * tx + 1] = dec[d] * (S[d][2 * tx + 1] + u[i][1]); }
    }
}
constexpr int GLA_SCAN_LDS = 128 * 33 * 4 + 2 * 64 * 129 * 4 + 64 * 33 * 4 + 64 * 65 * 4 + 512;
}
#define PHASE_QKV(F, p) do {} while (0)
#define PHASE_ATTN(F, p) do {} while (0)
#define PHASE_WO(F, p, l) do {} while (0)
#define PHASE_MOE1(F, p, l) do {} while (0)
#define PHASE_MOE2(F, p, l) do {} while (0)
#define PHASE_INPROJ(F, p) do {} while (0)
#define PHASE_SCAN(F, p) do {} while (0)
typedef GAS unsigned gu32;
#define XB_TMO      128
#define XB_XCNT(j)  (256  + 64 * (j))
#define XB_XSUB(j)  (1280 + 64 * (j))
#define XB_XGEN(j)  (2304 + 64 * (j))
#define XB_TOP      3328
#define XB_TOPGEN   3392
#define XCD_BAR_WORDS 3456
#define XB_SPIN_CAP (1u << 20)
__device__ __forceinline__ unsigned xb_ld(unsigned* p)              { return __hip_atomic_load(p, __ATOMIC_RELAXED, __HIP_MEMORY_SCOPE_AGENT); }
__device__ __forceinline__ unsigned xb_add(unsigned* p, unsigned v) { return __hip_atomic_fetch_add(p, v, __ATOMIC_RELAXED, __HIP_MEMORY_SCOPE_AGENT); }
__device__ __forceinline__ unsigned xb_xcc_id() { return (unsigned)__builtin_amdgcn_s_getreg((3 << 11) | 20) & 0xFu; }
#define XB_SPIN(cond, bar) do { unsigned _sp = 0; while (cond) { __builtin_amdgcn_s_sleep(1); \
    if ((++_sp & 255u) == 0u) { if (xb_ld(&(bar)[XB_TMO])) break; if (_sp > XB_SPIN_CAP) { atomicAdd(&(bar)[XB_TMO], 1u); break; } } } } while (0)
struct XcdBarrier { unsigned* bar; unsigned x; volatile LAS unsigned* st; };
__device__ __forceinline__ XcdBarrier xcd_barrier_post(unsigned* bar, volatile LAS unsigned* st) {
    XcdBarrier b; b.bar = bar; b.x = xb_xcc_id(); b.st = st;
    if (threadIdx.x == 0) (void)xb_add(&bar[XB_XCNT(b.x)], 1u);
    return b;
}
__device__ __forceinline__ void xcd_barrier_complete(unsigned* bar, unsigned x, unsigned& nloc, unsigned& nx) {
    const unsigned G = gridDim.x * gridDim.y * gridDim.z;
    unsigned sum, cnt, mine, sp = 0u;
    for (;;) {
        sum = 0u; cnt = 0u; mine = 0u;
#pragma unroll
        for (unsigned j = 0; j < 16; ++j) { const unsigned c = xb_ld(&bar[XB_XCNT(j)]); sum += c; cnt += (c > 0u) ? 1u : 0u; mine = (j == x) ? c : mine; }
        if (sum == G) break;
        __builtin_amdgcn_s_sleep(1);
        if ((++sp & 255u) == 0u) { if (xb_ld(&bar[XB_TMO])) break; if (sp > XB_SPIN_CAP) { atomicAdd(&bar[XB_TMO], 1u); break; } }
    }
    nloc = mine > 0u ? mine : 1u; nx = cnt > 0u ? cnt : 1u;
}
__device__ __forceinline__ void xcd_barrier(const XcdBarrier& b) {
    asm volatile("s_waitcnt vmcnt(0)" ::: "memory");
    __syncthreads();
    if (threadIdx.x == 0) {
        unsigned* bar = b.bar;
        __builtin_amdgcn_s_waitcnt(0);
        unsigned nloc = b.st[0], nx = b.st[1];
        if (nloc == 0u) { xcd_barrier_complete(bar, b.x, nloc, nx); b.st[0] = nloc; b.st[1] = nx; }
        const unsigned old = xb_add(&bar[XB_XSUB(b.x)], 1u);
        const unsigned gen = old / nloc;
        if (old + 1u == (gen + 1u) * nloc) {
            __builtin_amdgcn_fence(__ATOMIC_RELEASE, "agent");
            asm volatile("s_waitcnt vmcnt(0)" ::: "memory");
            const unsigned og = xb_add(&bar[XB_TOP], 1u);
            const unsigned tg = og / nx;
            if (og + 1u == (tg + 1u) * nx) xb_add(&bar[XB_TOPGEN], 1u);
            else XB_SPIN(xb_ld(&bar[XB_TOPGEN]) == tg, bar);
            __builtin_amdgcn_fence(__ATOMIC_ACQUIRE, "agent");
            xb_add(&bar[XB_XGEN(b.x)], 1u);
            asm volatile("s_waitcnt vmcnt(0)" ::: "memory");
        } else {
            XB_SPIN(xb_ld(&bar[XB_XGEN(b.x)]) == gen, bar);
            __builtin_amdgcn_fence(__ATOMIC_ACQUIRE, "agent");
            asm volatile("s_waitcnt vmcnt(0)" ::: "memory");
        }
    }
    __syncthreads();
}

constexpr int NPHASE = 19;
#ifndef OPT_MASK
#define OPT_MASK 0u
#endif
__global__ void __launch_bounds__(NTHR, 2) mega_fwd(Prm p) {
    extern __shared__ __attribute__((aligned(16))) unsigned char lds[];
    Frame F; F.lds = lds; F.ctl = (unsigned*)(p.ws + WS_CTL);
    F.tid = threadIdx.x; F.lane = F.tid & 63; F.wave = __builtin_amdgcn_readfirstlane(F.tid >> 6); F.G = gridDim.x; F.bid = blockIdx.x;
    for (int u = F.tid; u < (LDS_BYTES - LDSCTL_OFF) / 4; u += NTHR) ((LAS unsigned*)(lds + LDSCTL_OFF))[u] = 0u;
    __syncthreads();
    const int lo = p.ph_lo, hi = p.ph_hi;
    const bool multi = (hi - lo) > 1;
    XcdBarrier bar; bar.bar = F.ctl + CW_BAR + p.li * XCD_BAR_WORDS; bar.x = 0; bar.st = nullptr;
    if (multi) bar = xcd_barrier_post(F.ctl + CW_BAR + p.li * XCD_BAR_WORDS, (volatile LAS unsigned*)(lds + MISC_OFF) + 8);
#define IN(k) (lo <= (k) && (k) < hi)
#define SEAM(k) do { if (IN(k) && IN((k) + 1)) xcd_barrier(bar); } while (0)
    if (IN(0)) { phase_prologue(F, p); } SEAM(0);
    if (IN(1)) { phase_modulate0(F, p); } SEAM(1);
    if (IN(2)) { PHASE_QKV(F, p); } SEAM(2);
    if (IN(3)) { PHASE_ATTN(F, p); } SEAM(3);
    if (IN(4)) { phase_attn_combine(F, p); } SEAM(4);
    if (IN(5)) { PHASE_WO(F, p, 0); } SEAM(5);
    if (IN(6)) { phase_ln_route(F, p, 0); } SEAM(6);
    if (IN(7)) { PHASE_MOE1(F, p, 0); } SEAM(7);
    if (IN(8)) { PHASE_MOE2(F, p, 0); } SEAM(8);
    if (IN(9)) { phase_moe_combine(F, p, 0); } SEAM(9);
    if (IN(10)) { PHASE_INPROJ(F, p); } SEAM(10);
    if (IN(11)) { phase_gla_prep(F, p); } SEAM(11);
    if (IN(12)) { PHASE_SCAN(F, p); } SEAM(12);
    if (IN(13)) { phase_gla_post(F, p); } SEAM(13);
    if (IN(14)) { PHASE_WO(F, p, 1); } SEAM(14);
    if (IN(15)) { phase_ln_route(F, p, 1); } SEAM(15);
    if (IN(16)) { PHASE_MOE1(F, p, 1); } SEAM(16);
    if (IN(17)) { PHASE_MOE2(F, p, 1); } SEAM(17);
    if (IN(18)) { phase_moe_combine(F, p, 1); }
#undef IN
#undef SEAM
}

static void launch_naive(int ph, const Prm& p, hipStream_t stream) {
    using namespace naive;
    const bf16* H = (const bf16*)(p.ws + WS_H);
    switch (ph) {
    case 2: { NG g{H, (const bf16*)(p.ws + WS_WQKV), NTOK, 3072, 1024, 0, nullptr}; hipLaunchKernelGGL(gemm_kernel<EPI_QKV>, dim3(3072 / 64, NTOK / 64), dim3(256), 0, stream, g, p); break; }
    case 3: hipLaunchKernelGGL(attn_kernel, dim3(544, 16), dim3(256), 0, stream, p); break;
    case 5: { NG g{(const bf16*)(p.ws + WS_A2), (const bf16*)(p.ws + WS_WO), NTOK, 1024, 1024, 0, (bf16*)(p.ws + WS_Y)}; hipLaunchKernelGGL(gemm_kernel<EPI_PLAIN>, dim3(16, NTOK / 64), dim3(256), 0, stream, g, p); break; }
    case 7: case 16: { const int l = ph == 16; NG g{H, (const bf16*)(p.ws + (l ? WS_GU1 : WS_GU0)), MAXSLOT, 1024, 1024, l, nullptr}; hipLaunchKernelGGL(gemm_kernel<EPI_GATEUP>, dim3(16, MAXSLOT / 64), dim3(256), 0, stream, g, p); break; }
    case 8: case 17: { const int l = ph == 17; NG g{(const bf16*)(p.ws + WS_ACT), (const bf16*)(p.ws + (l ? WS_DN1 : WS_DN0)), MAXSLOT, 1024, 512, l, nullptr}; hipLaunchKernelGGL(gemm_kernel<EPI_DOWN>, dim3(16, MAXSLOT / 64), dim3(256), 0, stream, g, p); break; }
    case 10: { NG g{H, (const bf16*)(p.ws + WS_WIN), NTOK, NIN, 1024, 0, nullptr}; hipLaunchKernelGGL(gemm_kernel<EPI_INPROJ>, dim3(NIN / 64, NTOK / 64), dim3(256), 0, stream, g, p); break; }
    case 12: hipLaunchKernelGGL(gla_scan_kernel, dim3(512), dim3(256), GLA_SCAN_LDS, stream, p); break;
    case 14: { NG g{(const bf16*)(p.ws + WS_A2B), (const bf16*)(p.ws + WS_WGO), NLAT, 1024, 1024, 0, (bf16*)(p.ws + WS_Y)}; hipLaunchKernelGGL(gemm_kernel<EPI_PLAIN>, dim3(16, NLAT / 64), dim3(256), 0, stream, g, p); break; }
    default: break;
    }
}
extern "C" void kernel_launch(void* const* d_in, const int* in_sizes, int n_in, void* d_out, int out_size, void* d_ws, size_t ws_size, hipStream_t stream) {
    static int grid = 0;
    if (grid == 0) {
        if (n_in != 23 || in_sizes[0] != NLAT * DM || out_size != NLAT * DM || ws_size < WS_END) { fprintf(stderr, "kernel_launch: unexpected shapes (n_in %d, in0 %d, out %d, ws %zu); nothing launched\n", n_in, n_in > 0 ? in_sizes[0] : -1, out_size, ws_size); grid = -1; return; }
        int dev = 0, cus = 0;
        if (hipGetDevice(&dev) != hipSuccess || hipDeviceGetAttribute(&cus, hipDeviceAttributeMultiprocessorCount, dev) != hipSuccess) { grid = -1; return; }
        if (hipFuncSetAttribute((const void*)mega_fwd, hipFuncAttributeMaxDynamicSharedMemorySize, LDS_BYTES) != hipSuccess) { fprintf(stderr, "kernel_launch: hipFuncSetAttribute failed\n"); grid = -1; return; }
        (void)hipFuncSetAttribute((const void*)naive::gla_scan_kernel, hipFuncAttributeMaxDynamicSharedMemorySize, naive::GLA_SCAN_LDS);
        int per_cu = 0;
        if (hipOccupancyMaxActiveBlocksPerMultiprocessor(&per_cu, (const void*)mega_fwd, NTHR, LDS_BYTES) != hipSuccess || per_cu < 1) fprintf(stderr, "kernel_launch: note: occupancy query reports %d\n", per_cu);
        (void)hipGetLastError();
        grid = cus;
    }
    if (grid < 0) return;
    (void)hipMemsetAsync((char*)d_ws + WS_CTL, 0, CTL_ZERO_BYTES, stream);
    Prm p{};
    const float** pp = (const float**)&p;
    for (int i = 0; i < 23; ++i) pp[i] = (const float*)d_in[i];
    p.out = (float*)d_out; p.ws = (unsigned char*)d_ws;
    const unsigned naive_phases = (1u << 2) | (1u << 3) | (1u << 5) | (1u << 7) | (1u << 8) | (1u << 10) | (1u << 12) | (1u << 14) | (1u << 16) | (1u << 17);
    const unsigned use_naive = naive_phases & ~(unsigned)(OPT_MASK);
    int ph = 0, li = 0;
    while (ph < NPHASE) {
        if (use_naive & (1u << ph)) { launch_naive(ph, p, stream); ++ph; continue; }
        int e = ph + 1;
#if defined(ONE_PER_PHASE)
#else
        while (e < NPHASE && !(use_naive & (1u << e))) ++e;
#endif
        p.ph_lo = ph; p.ph_hi = e; p.li = li++;
        hipLaunchKernelGGL(mega_fwd, dim3(grid), dim3(NTHR), LDS_BYTES, stream, p);
        ph = e;
    }
}
```

```cpp
#define OPT_MASK 0x345A4u
#include <hip/hip_runtime.h>
#include <cstdint>
#include <cstdio>

constexpr int BATCH = 8, SEQ = 4096, DM = 1024, CTXL = 256;
constexpr int NLAT = BATCH * SEQ, NCTX = BATCH * CTXL, NTOK = NLAT + NCTX;
constexpr float ALPHA = 1.4142135623730951f;
constexpr float LN_EPS = 1e-5f;
constexpr float LAMBDA_INIT0 = 0.2f;
constexpr float C2 = 0.125f * 1.4426950408889634f;
constexpr int NEXP = 16, DEXP = 512, MAXSLOT = 73728;
constexpr int NCHUNK = NTOK / 64;
constexpr int NIN = 3328;

typedef unsigned short bf16;
typedef float f32x4 __attribute__((ext_vector_type(4)));
typedef float f32x2 __attribute__((ext_vector_type(2)));
typedef unsigned u32x2 __attribute__((ext_vector_type(2)));
typedef unsigned u32x4 __attribute__((ext_vector_type(4)));

constexpr size_t MiB = 1u << 20;
constexpr size_t WS_CTL = 0, CTL_ZERO_BYTES = 1 * MiB;
constexpr size_t WS_MOD = 1 * MiB;
constexpr size_t WS_MISC = 1 * MiB + 512 * 1024;
constexpr size_t WS_WQKV = 2 * MiB, WS_WO = 8 * MiB, WS_GU0 = 10 * MiB, WS_DN0 = 42 * MiB;
constexpr size_t WS_XCTX = 58 * MiB;
constexpr size_t WS_WIN = 66 * MiB, WS_WGO = 73 * MiB, WS_GU1 = 75 * MiB, WS_DN1 = 107 * MiB;
constexpr size_t WS_H = 123 * MiB;
constexpr size_t WS_Q = 191 * MiB, WS_K = 259 * MiB, WS_V = 327 * MiB, WS_O2 = 395 * MiB;
constexpr size_t WS_LIST = 463 * MiB;
constexpr size_t WS_TOKR = 466 * MiB;
constexpr size_t WS_DEC = 468 * MiB;
constexpr size_t WS_ZZ = 471 * MiB;
constexpr size_t WS_END = 480 * MiB;
constexpr size_t WS_O1 = WS_H, WS_A2 = WS_Q, WS_Y = WS_K;
constexpr size_t WS_YM = 191 * MiB, WS_ACT = 335 * MiB;
constexpr size_t WS_QR = 191 * MiB, WS_KR = 225 * MiB, WS_V1 = 259 * MiB, WS_R = 327 * MiB;
constexpr size_t WS_QT = WS_H, WS_KT = 395 * MiB;
constexpr size_t WS_OGF = 191 * MiB, WS_OGB = 2 * MiB;
constexpr size_t WS_A2B = WS_H;
constexpr int CW_TMO = 0, CW_CODE = 1;
constexpr int CW_CNT = 64;
constexpr int CW_BAR = 4096;

__device__ __forceinline__ unsigned f2bf(float f) { unsigned u = __builtin_bit_cast(unsigned, f); return (u + 0x7fffu + ((u >> 16) & 1u)) >> 16; }
__device__ __forceinline__ unsigned pk2(float lo, float hi) { return f2bf(lo) | (f2bf(hi) << 16); }
__device__ __forceinline__ float bf2f(unsigned b) { return __builtin_bit_cast(float, b << 16); }
__device__ __forceinline__ float wave_sum(float v) {
#pragma unroll
    for (int o = 1; o < 64; o <<= 1) v += __shfl_xor(v, o);
    return v;
}
__device__ __forceinline__ float silu_f(float v) { return v / (1.f + __expf(-v)); }

struct Prm {
    const float *x, *c, *ctx, *cctx, *ada_w, *ada_b, *ln_g, *ln_b, *w_qkv, *w_o, *lam, *subln, *gw_in, *gwg_down, *gwg_up, *gbg, *gnorm, *gw_o, *rw, *rb, *mg, *mu, *md;
    float* out; unsigned char* ws;
    int ph_lo, ph_hi, li, pad;
};
__device__ __forceinline__ void ld_row_f32(const float* p, int lane, f32x4 (&v)[4]) {
#pragma unroll
    for (int j = 0; j < 4; ++j) v[j] = *(const f32x4*)(p + 4 * lane + 256 * j);
}
__device__ __forceinline__ void st_row_f32(float* p, int lane, const f32x4 (&v)[4]) {
#pragma unroll
    for (int j = 0; j < 4; ++j) *(f32x4*)(p + 4 * lane + 256 * j) = v[j];
}
__device__ __forceinline__ void ld_row_bf16(const bf16* p, int lane, f32x4 (&v)[4]) {
#pragma unroll
    for (int j = 0; j < 4; ++j) { const u32x2 u = *(const u32x2*)(p + 4 * lane + 256 * j); v[j] = (f32x4){bf2f(u.x & 0xffffu), bf2f(u.x >> 16), bf2f(u.y & 0xffffu), bf2f(u.y >> 16)}; }
}
__device__ __forceinline__ void st_row_bf16(bf16* p, int lane, const f32x4 (&v)[4]) {
#pragma unroll
    for (int j = 0; j < 4; ++j) { u32x2 u; u.x = pk2(v[j].x, v[j].y); u.y = pk2(v[j].z, v[j].w); *(u32x2*)(p + 4 * lane + 256 * j) = u; }
}
__device__ __forceinline__ void ln_row(f32x4 (&v)[4], const float* g, const float* b, int lane) {
    float s = 0.f;
#pragma unroll
    for (int j = 0; j < 4; ++j) s += (v[j].x + v[j].y) + (v[j].z + v[j].w);
    const float mean = wave_sum(s) * (1.f / DM); float q = 0.f;
#pragma unroll
    for (int j = 0; j < 4; ++j) { v[j] = v[j] - mean; q += (v[j].x * v[j].x + v[j].y * v[j].y) + (v[j].z * v[j].z + v[j].w * v[j].w); }
    const float rstd = 1.f / sqrtf(wave_sum(q) * (1.f / DM) + LN_EPS);
#pragma unroll
    for (int j = 0; j < 4; ++j) { const f32x4 gg = *(const f32x4*)(g + 4 * lane + 256 * j), bb = *(const f32x4*)(b + 4 * lane + 256 * j); v[j] = v[j] * rstd * gg + bb; }
}
__host__ __device__ __forceinline__ int gu_phys(int other, int sel) { return (other >> 4) * 32 + sel * 16 + (other & 15); }
#define GAS __attribute__((address_space(1)))
#define LAS __attribute__((address_space(3)))
constexpr int NWAVES = 8, NTHR = NWAVES * 64;
constexpr int RING_BYTES = 131072, LDSCTL_OFF = RING_BYTES, MISC_OFF = LDSCTL_OFF + 320, LDS_BYTES = 147456;
constexpr int LDSX_OFF = RING_BYTES + 1024;
#define LDS_WAIT() asm volatile("s_waitcnt lgkmcnt(0)" ::: "memory")
#define VM_WAIT() asm volatile("s_waitcnt vmcnt(0)" ::: "memory")

struct Frame {
    unsigned char* lds;
    unsigned* ctl;
    int tid, lane, wave, G, bid;
};

template <int MODE>
__device__ __forceinline__ void p0_transpose_item(const float* W, int K, int N, bf16* WT, int row_off, float* scr, int item, int lane) {
    const int nblk = N / 32, kb = item / nblk, nb = item % nblk, k0 = 64 * kb, n0 = 32 * nb;
#pragma unroll 8
    for (int i = 0; i < 32; ++i) { const int kk = 2 * i + (lane >> 5); scr[kk * 33 + (lane & 31)] = W[(size_t)(k0 + kk) * N + n0 + (lane & 31)]; }
    LDS_WAIT(); asm volatile("" ::: "memory");
    const int c = lane & 7;
#pragma unroll
    for (int j = 0; j < 4; ++j) { const int n = (lane >> 3) + 8 * j; const float* s = scr + (8 * c) * 33 + n;
        u32x4 o; o.x = pk2(s[0 * 33], s[1 * 33]); o.y = pk2(s[2 * 33], s[3 * 33]); o.z = pk2(s[4 * 33], s[5 * 33]); o.w = pk2(s[6 * 33], s[7 * 33]);
        const int nl = n0 + n; const int pr = (MODE == 0) ? (row_off + nl) : (row_off + gu_phys(nl, MODE - 1));
        *(u32x4*)(WT + (size_t)pr * K + k0 + 8 * c) = o; }
    LDS_WAIT(); asm volatile("" ::: "memory");
}
__device__ __forceinline__ void phase_prologue(const Frame& F, const Prm& p) {
    float* sil = (float*)F.lds;
    for (int i = F.tid; i < 9 * 1024; i += NTHR) { const int r = i >> 10, k = i & 1023; const float v = (r < 8) ? p.c[r * 1024 + k] : p.cctx[k]; sil[i] = silu_f(v); }
    __syncthreads();
    float* MOD = (float*)(p.ws + WS_MOD);
    if (F.wave == 0 && F.bid < 192) {
        const int layer = F.bid / 96, n = (F.bid % 96) * 64 + F.lane; const float* W = p.ada_w + (size_t)layer * 1024 * 6144 + n;
        float acc[9];
#pragma unroll
        for (int r = 0; r < 9; ++r) acc[r] = 0.f;
#pragma unroll 4
        for (int k = 0; k < 1024; k += 4) {
            const float w0 = W[(size_t)k * 6144], w1 = W[(size_t)(k + 1) * 6144], w2 = W[(size_t)(k + 2) * 6144], w3 = W[(size_t)(k + 3) * 6144];
#pragma unroll
            for (int r = 0; r < 9; ++r) { const f32x4 s = *(const f32x4*)(sil + r * 1024 + k); acc[r] += s.x * w0 + s.y * w1 + s.z * w2 + s.w * w3; }
        }
        const float bb = p.ada_b[layer * 6144 + n];
#pragma unroll
        for (int r = 0; r < 9; ++r) MOD[(layer * 9 + r) * 6144 + n] = acc[r] + bb;
    }
    float* misc = (float*)(p.ws + WS_MISC);
    if (F.bid == 255 % F.G && F.wave == 1) {
        const float a = wave_sum(p.lam[F.lane] * p.lam[64 + F.lane]), b = wave_sum(p.lam[128 + F.lane] * p.lam[192 + F.lane]);
        if (F.lane == 0) misc[0] = __expf(a) - __expf(b) + LAMBDA_INIT0;
        for (int i = F.lane; i < 1024; i += 64) { const int pos = i >> 4, f = i & 15; const float inv = powf(10000.f, -(float)f / 16.f); const float ang = (float)pos * inv;
            misc[1024 + 2 * i] = cosf(ang); misc[1024 + 2 * i + 1] = sinf(ang); }
    }
    float* scr = (float*)(F.lds + 36864 + F.wave * 8704);
    const int gw = F.bid * NWAVES + F.wave, NGW = F.G * NWAVES;
    constexpr int I_QKV = 16 * 96, I_SQ = 16 * 32, I_G = 16 * 16, I_D = 8 * 32;
    constexpr int I_MOE = 2 * I_G + I_D;
    constexpr int NITEMS = 2 * I_QKV + 2 * I_SQ + 32 * I_MOE;
    bf16* ws16 = (bf16*)p.ws;
    for (int it = gw; it < NITEMS; it += NGW) {
        int r = it;
        if (r < I_QKV) { p0_transpose_item<0>(p.w_qkv, 1024, 3072, (bf16*)(p.ws + WS_WQKV), 0, scr, r, F.lane); continue; } r -= I_QKV;
        if (r < I_QKV) { p0_transpose_item<0>(p.gw_in, 1024, 3072, (bf16*)(p.ws + WS_WIN), 0, scr, r, F.lane); continue; } r -= I_QKV;
        if (r < I_SQ) { p0_transpose_item<0>(p.w_o, 1024, 1024, (bf16*)(p.ws + WS_WO), 0, scr, r, F.lane); continue; } r -= I_SQ;
        if (r < I_SQ) { p0_transpose_item<0>(p.gw_o, 1024, 1024, (bf16*)(p.ws + WS_WGO), 0, scr, r, F.lane); continue; } r -= I_SQ;
        const int le = r / I_MOE, layer = le >> 4, e = le & 15; r -= le * I_MOE;
        bf16* GU = (bf16*)(p.ws + (layer ? WS_GU1 : WS_GU0)) + (size_t)e * 1024 * 1024; bf16* DN = (bf16*)(p.ws + (layer ? WS_DN1 : WS_DN0)) + (size_t)e * 1024 * 512;
        if (r < I_G) { p0_transpose_item<1>(p.mg + (size_t)le * 1024 * 512, 1024, 512, GU, 0, scr, r, F.lane); continue; } r -= I_G;
        if (r < I_G) { p0_transpose_item<2>(p.mu + (size_t)le * 1024 * 512, 1024, 512, GU, 0, scr, r, F.lane); continue; } r -= I_G;
        p0_transpose_item<0>(p.md + (size_t)le * 512 * 1024, 512, 1024, DN, 0, scr, r, F.lane);
    }
    (void)ws16;
    bf16* WIN = (bf16*)(p.ws + WS_WIN);
    for (int i = gw * 64 + F.lane; i < 32 * 1024; i += NGW * 64) { const int rr = i >> 10, k = i & 1023, dir = rr >> 4, j = rr & 15;
        WIN[(size_t)(3072 + rr) * 1024 + k] = (bf16)f2bf(p.gwg_down[(size_t)dir * 1024 * 16 + k * 16 + j]); }
    for (int i = gw * 64 + F.lane; i < 224 * 1024 / 8; i += NGW * 64) *(u32x4*)(WIN + (size_t)3104 * 1024 + (size_t)i * 8) = (u32x4){0u, 0u, 0u, 0u};
}

__device__ __forceinline__ void phase_modulate0(const Frame& F, const Prm& p) {
    const float* MOD = (const float*)(p.ws + WS_MOD); bf16* H = (bf16*)(p.ws + WS_H);
    const int gw = F.bid * NWAVES + F.wave, NGW = F.G * NWAVES, per = (NTOK + NGW - 1) / NGW;
    int curmod = -1; f32x4 sh[4], sc[4];
    for (int tok = gw * per; tok < (gw + 1) * per && tok < NTOK; ++tok) {
        const int mr = tok < NLAT ? tok / SEQ : 8; const float* src = tok < NLAT ? p.x + (size_t)tok * DM : p.ctx + (size_t)(tok - NLAT) * DM;
        if (mr != curmod) { curmod = mr; ld_row_f32(MOD + mr * 6144, F.lane, sh); ld_row_f32(MOD + mr * 6144 + 1024, F.lane, sc); }
        f32x4 v[4]; ld_row_f32(src, F.lane, v);
#pragma unroll
        for (int j = 0; j < 4; ++j) v[j] = v[j] * (1.f + sc[j]) + sh[j];
        st_row_bf16(H + (size_t)tok * DM, F.lane, v);
    }
}

__device__ __forceinline__ void phase_attn_combine(const Frame& F, const Prm& p) {
    const bf16* O1 = (const bf16*)(p.ws + WS_O1); const bf16* O2 = (const bf16*)(p.ws + WS_O2); bf16* A2 = (bf16*)(p.ws + WS_A2);
    const float lam = ((const float*)(p.ws + WS_MISC))[0];
    const f32x4 sg = *(const f32x4*)(p.subln + 4 * (F.lane & 31));
    const int gw = F.bid * NWAVES + F.wave, NGW = F.G * NWAVES;
    for (int tok = gw; tok < NTOK; tok += NGW) {
        f32x4 a[4], b[4]; ld_row_bf16(O1 + (size_t)tok * DM, F.lane, a); ld_row_bf16(O2 + (size_t)tok * DM, F.lane, b);
#pragma unroll
        for (int j = 0; j < 4; ++j) {
            f32x4 o = a[j] - lam * b[j]; float q = (o.x * o.x + o.y * o.y) + (o.z * o.z + o.w * o.w);
#pragma unroll
            for (int s = 1; s < 32; s <<= 1) q += __shfl_xor(q, s);
            const float r = (1.f - LAMBDA_INIT0) / sqrtf(q * (1.f / 128.f) + LN_EPS);
            a[j] = o * r * sg;
        }
        st_row_bf16(A2 + (size_t)tok * DM, F.lane, a);
    }
}

__device__ __forceinline__ void phase_ln_route(const Frame& F, const Prm& p, int layer) {
    const int nrows = layer ? NLAT : NTOK;
    const float* MOD = (const float*)(p.ws + WS_MOD) + layer * 9 * 6144;
    const bf16* Y = (const bf16*)(p.ws + WS_Y); bf16* HF = (bf16*)(p.ws + WS_H);
    float* XCTX = (float*)(p.ws + WS_XCTX);
    int* LIST = (int*)(p.ws + WS_LIST); int* TOKR = (int*)(p.ws + WS_TOKR);
    unsigned* CNT = F.ctl + CW_CNT + layer * 16;
    float* WrT = (float*)F.lds;
    int* rec = (int*)(F.lds + 65536);
    unsigned* lcnt = (unsigned*)(F.lds + 65536 + 8192); unsigned* lbase = lcnt + 16;
    for (int i = F.tid; i < 16 * 1024; i += NTHR) { const int k = i >> 4, e = i & 15; WrT[e * 1024 + k] = p.rw[i]; }
    if (F.tid < 16) lcnt[F.tid] = 0u;
    __syncthreads();
    const int per_wg = (nrows + F.G - 1) / F.G, per_w = (per_wg + NWAVES - 1) / NWAVES;
    const int row_lo = F.bid * per_wg, row_hi = min(nrows, row_lo + per_wg);
    const float* lng = p.ln_g + (layer * 2 + 0) * DM; const float* lnb = p.ln_b + (layer * 2 + 0) * DM;
    float rb[16];
#pragma unroll
    for (int e = 0; e < 16; ++e) rb[e] = p.rb[e];
    int curmod = -1; f32x4 gm[4], shf[4], scf[4];
    for (int i = 0; i < per_w; ++i) {
        const int lr = F.wave * per_w + i, tok = row_lo + lr; if (tok >= row_hi) break;
        const int mr = tok < NLAT ? tok / SEQ : 8;
        if (mr != curmod) { curmod = mr; ld_row_f32(MOD + mr * 6144 + 2048, F.lane, gm); ld_row_f32(MOD + mr * 6144 + 3072, F.lane, shf); ld_row_f32(MOD + mr * 6144 + 4096, F.lane, scf); }
        float* xdst = tok < NLAT ? p.out + (size_t)tok * DM : XCTX + (size_t)(tok - NLAT) * DM;
        const float* xsrc = layer ? (const float*)xdst : (tok < NLAT ? p.x + (size_t)tok * DM : p.ctx + (size_t)(tok - NLAT) * DM);
        f32x4 v[4], y[4]; ld_row_f32(xsrc, F.lane, v); ld_row_bf16(Y + (size_t)tok * DM, F.lane, y);
#pragma unroll
        for (int j = 0; j < 4; ++j) v[j] = ALPHA * v[j] + gm[j] * y[j];
        ln_row(v, lng, lnb, F.lane);
        st_row_f32(xdst, F.lane, v);
#pragma unroll
        for (int j = 0; j < 4; ++j) v[j] = v[j] * (1.f + scf[j]) + shf[j];
        st_row_bf16(HF + (size_t)tok * DM, F.lane, v);
        float part[16];
#pragma unroll
        for (int e = 0; e < 16; ++e) { float s = 0.f;
#pragma unroll
            for (int j = 0; j < 4; ++j) { const f32x4 w = *(const f32x4*)(WrT + e * 1024 + 4 * F.lane + 256 * j); s += (v[j].x * w.x + v[j].y * w.y) + (v[j].z * w.z + v[j].w * w.w); }
            part[e] = s; }
        {
#pragma unroll
            for (int e = 0; e < 8; ++e) { const bool up = (F.lane & 32) != 0; const float keep = up ? part[e + 8] : part[e], send = up ? part[e] : part[e + 8]; part[e] = keep + __shfl_xor(send, 32); }
#pragma unroll
            for (int e = 0; e < 4; ++e) { const bool up = (F.lane & 16) != 0; const float keep = up ? part[e + 4] : part[e], send = up ? part[e] : part[e + 4]; part[e] = keep + __shfl_xor(send, 16); }
#pragma unroll
            for (int e = 0; e < 2; ++e) { const bool up = (F.lane & 8) != 0; const float keep = up ? part[e + 2] : part[e], send = up ? part[e] : part[e + 2]; part[e] = keep + __shfl_xor(send, 8); }
            { const bool up = (F.lane & 4) != 0; const float keep = up ? part[1] : part[0], send = up ? part[0] : part[1]; part[0] = keep + __shfl_xor(send, 4); }
            part[0] += __shfl_xor(part[0], 2); part[0] += __shfl_xor(part[0], 1);
        }
        float aff[16], sel[16];
#pragma unroll
        for (int e = 0; e < 16; ++e) { const int src = ((e >> 3) & 1) * 32 + ((e >> 2) & 1) * 16 + ((e >> 1) & 1) * 8 + (e & 1) * 4; const float lg = __shfl(part[0], src); aff[e] = 1.f / (1.f + __expf(-lg)); sel[e] = aff[e] + rb[e]; }
        int bg = 0; float bgs = -3.0e38f;
#pragma unroll
        for (int g = 0; g < 4; ++g) { float m1 = -3.0e38f, m2 = -3.0e38f;
#pragma unroll
            for (int k = 0; k < 4; ++k) { const float s = sel[4 * g + k]; if (s > m1) { m2 = m1; m1 = s; } else if (s > m2) m2 = s; }
            const float gs = m1 + m2; if (gs > bgs) { bgs = gs; bg = g; } }
        int i1 = 0, i2 = 0; float s1 = -3.0e38f, s2 = -3.0e38f, a1 = 0.f, a2 = 0.f;
#pragma unroll
        for (int g = 0; g < 4; ++g) if (g == bg) {
#pragma unroll
            for (int k = 0; k < 4; ++k) { const float s = sel[4 * g + k], a = aff[4 * g + k];
                if (s > s1) { s2 = s1; i2 = i1; a2 = a1; s1 = s; i1 = 4 * g + k; a1 = a; } else if (s > s2) { s2 = s; i2 = 4 * g + k; a2 = a; } } }
        const float wsum = a1 + a2, w1 = a1 / wsum, w2 = a2 / wsum;
        if (F.lane == 0) { const unsigned l1 = atomicAdd(&lcnt[i1], 1u), l2 = atomicAdd(&lcnt[i2], 1u);
            rec[lr * 6 + 0] = i1; rec[lr * 6 + 1] = i2; rec[lr * 6 + 2] = (int)l1; rec[lr * 6 + 3] = (int)l2; rec[lr * 6 + 4] = __float_as_int(w1); rec[lr * 6 + 5] = __float_as_int(w2); }
    }
    __syncthreads();
    if (F.tid < 16) lbase[F.tid] = __hip_atomic_fetch_add(&CNT[F.tid], lcnt[F.tid], __ATOMIC_RELAXED, __HIP_MEMORY_SCOPE_AGENT);
    __syncthreads();
    for (int lr = F.tid; lr < row_hi - row_lo; lr += NTHR) { const int tok = row_lo + lr;
        const int e0 = rec[lr * 6], e1 = rec[lr * 6 + 1]; const int p0 = (int)lbase[e0] + rec[lr * 6 + 2], p1 = (int)lbase[e1] + rec[lr * 6 + 3];
        LIST[e0 * NTOK + p0] = tok; LIST[e1 * NTOK + p1] = tok;
        int* tr = TOKR + (size_t)tok * 8; tr[0] = e0; tr[1] = p0; tr[2] = e1; tr[3] = p1; tr[4] = rec[lr * 6 + 4]; tr[5] = rec[lr * 6 + 5]; }
    __syncthreads();
}

__device__ __forceinline__ void pad_bases(const unsigned* cnt, int (&pb)[17]) {
    int acc = 0;
#pragma unroll
    for (int e = 0; e < 16; ++e) { pb[e] = acc; const int c = (int)__hip_atomic_load(cnt + e, __ATOMIC_RELAXED, __HIP_MEMORY_SCOPE_AGENT); acc += (c + 255) & ~255; }
    pb[16] = acc;
}

__device__ __forceinline__ void phase_moe_combine(const Frame& F, const Prm& p, int layer) {
    const int nrows = layer ? NLAT : NTOK;
    const float* MOD = (const float*)(p.ws + WS_MOD) + layer * 9 * 6144; const float* MOD1 = (const float*)(p.ws + WS_MOD) + 9 * 6144;
    const bf16* YM = (const bf16*)(p.ws + WS_YM); bf16* H = (bf16*)(p.ws + WS_H); float* XCTX = (float*)(p.ws + WS_XCTX); const int* TOKR = (const int*)(p.ws + WS_TOKR);
    int pb[17]; pad_bases(F.ctl + CW_CNT + layer * 16, pb);
    int* pbl = (int*)F.lds; if (F.tid < 17) { int v = 0;
#pragma unroll
        for (int e = 0; e < 17; ++e) if (e == F.tid) v = pb[e];
        pbl[F.tid] = v; }
    __syncthreads();
    const float* lng = p.ln_g + (layer * 2 + 1) * DM; const float* lnb = p.ln_b + (layer * 2 + 1) * DM;
    const int gw = F.bid * NWAVES + F.wave, NGW = F.G * NWAVES, per = (nrows + NGW - 1) / NGW;
    int curmod = -1; f32x4 gf[4], sh1[4], sc1[4];
    for (int tok = gw * per; tok < (gw + 1) * per && tok < nrows; ++tok) {
        const int mr = tok < NLAT ? tok / SEQ : 8;
        if (mr != curmod) { curmod = mr; ld_row_f32(MOD + mr * 6144 + 5120, F.lane, gf); if (!layer) { ld_row_f32(MOD1 + mr * 6144, F.lane, sh1); ld_row_f32(MOD1 + mr * 6144 + 1024, F.lane, sc1); } }
        const int* tr = TOKR + (size_t)tok * 8; const int s0 = pbl[tr[0]] + tr[1], s1 = pbl[tr[2]] + tr[3]; const float w0 = __int_as_float(tr[4]), w1 = __int_as_float(tr[5]);
        float* xp = tok < NLAT ? p.out + (size_t)tok * DM : XCTX + (size_t)(tok - NLAT) * DM;
        f32x4 v[4], a[4], b[4]; ld_row_f32(xp, F.lane, v); ld_row_bf16(YM + (size_t)s0 * DM, F.lane, a); ld_row_bf16(YM + (size_t)s1 * DM, F.lane, b);
#pragma unroll
        for (int j = 0; j < 4; ++j) v[j] = ALPHA * v[j] + gf[j] * (w0 * a[j] + w1 * b[j]);
        ln_row(v, lng, lnb, F.lane);
        st_row_f32(xp, F.lane, v);
        if (!layer) {
#pragma unroll
            for (int j = 0; j < 4; ++j) v[j] = v[j] * (1.f + sc1[j]) + sh1[j];
            st_row_bf16(H + (size_t)tok * DM, F.lane, v);
        }
    }
}

__device__ __forceinline__ void phase_gla_prep(const Frame& F, const Prm& p) {
    const bf16* QR = (const bf16*)(p.ws + WS_QR); const bf16* KR = (const bf16*)(p.ws + WS_KR); const float* ZZ = (const float*)(p.ws + WS_ZZ);
    bf16* QT = (bf16*)(p.ws + WS_QT); bf16* KT = (bf16*)(p.ws + WS_KT); float* DEC = (float*)(p.ws + WS_DEC);
    const int gw = F.bid * NWAVES + F.wave, NGW = F.G * NWAVES;
    for (int task = gw; task < 2 * NCHUNK * 8; task += NGW) {
        const int dh = task & 7, chunk = (task >> 3) % NCHUNK, dir = task / (8 * NCHUNK);
        const int col = dh * 64 + F.lane, tok0 = chunk * 64;
        float wup[16];
#pragma unroll
        for (int j = 0; j < 16; ++j) wup[j] = p.gwg_up[(size_t)dir * 16 * 512 + j * 512 + col];
        const float bgv = p.gbg[dir * 512 + col];
        float b = 0.f;
#pragma unroll 4
        for (int tt = 0; tt < 64; ++tt) {
            const int t = dir ? 63 - tt : tt, tok = tok0 + t;
            const float* zr = ZZ + (size_t)tok * 32 + dir * 16; float z = bgv;
#pragma unroll
            for (int j = 0; j < 16; j += 4) { const f32x4 zv = *(const f32x4*)(zr + j); z += zv.x * wup[j] + zv.y * wup[j + 1] + zv.z * wup[j + 2] + zv.w * wup[j + 3]; }
            const float g = (fminf(z, 0.f) - log1pf(__expf(-fabsf(z)))) * (1.f / 16.f);
            b += g;
            const float q = bf2f(QR[(size_t)tok * 512 + col]), k = bf2f(KR[(size_t)tok * 512 + col]);
            QT[((size_t)dir * NTOK + tok) * 512 + col] = (bf16)f2bf(q * __expf(b)); KT[((size_t)dir * NTOK + tok) * 512 + col] = (bf16)f2bf(k * __expf(-b));
        }
        DEC[((size_t)dir * NCHUNK + chunk) * 512 + col] = __expf(b);
    }
}

__device__ __forceinline__ void phase_gla_post(const Frame& F, const Prm& p) {
    const bf16* OF = (const bf16*)(p.ws + WS_OGF); const bf16* OB = (const bf16*)(p.ws + WS_OGB); const bf16* R = (const bf16*)(p.ws + WS_R); bf16* A2 = (bf16*)(p.ws + WS_A2B);
    const f32x4 ng = *(const f32x4*)(p.gnorm + 4 * F.lane);
    const int gw = F.bid * NWAVES + F.wave, NGW = F.G * NWAVES;
    for (int tok = gw; tok < NLAT; tok += NGW) {
        f32x4 a[4], b[4], r[4]; ld_row_bf16(OF + (size_t)tok * DM, F.lane, a); ld_row_bf16(OB + (size_t)tok * DM, F.lane, b); ld_row_bf16(R + (size_t)tok * DM, F.lane, r);
#pragma unroll
        for (int j = 0; j < 4; ++j) {
            const f32x4 o = a[j] + b[j]; const float q = wave_sum((o.x * o.x + o.y * o.y) + (o.z * o.z + o.w * o.w));
            const float rs = 1.f / sqrtf(q * (1.f / 256.f) + LN_EPS);
            a[j] = (f32x4){o.x * rs * ng.x * silu_f(r[j].x), o.y * rs * ng.y * silu_f(r[j].y), o.z * rs * ng.z * silu_f(r[j].z), o.w * rs * ng.w * silu_f(r[j].w)};
        }
        st_row_bf16(A2 + (size_t)tok * DM, F.lane, a);
    }
}
namespace naive {
enum { EPI_QKV = 0, EPI_PLAIN = 1, EPI_GATEUP = 2, EPI_DOWN = 3, EPI_INPROJ = 4 };
struct NG { const bf16* A; const bf16* Bt; int M, N, K; int layer; bf16* O; };
template <int EPI> __global__ __launch_bounds__(256) void gemm_kernel(NG g, Prm p) {
    __shared__ float As[64][33], Bs[64][33], Cs[64][65]; __shared__ int rowsrc[64];
    const int tid = threadIdx.x, n0 = blockIdx.x * 64, m0 = blockIdx.y * 64, ty = tid >> 4, tx = tid & 15;
    const bf16* Bt = g.Bt; int e = 0, ebase = 0, ecnt = 0;
    if (EPI == EPI_GATEUP || EPI == EPI_DOWN) {
        const unsigned* cnt = (const unsigned*)(p.ws + WS_CTL) + CW_CNT + g.layer * 16; int acc = 0; bool found = false;
        for (int i = 0; i < 16; ++i) { const int c = (int)cnt[i], pc = (c + 255) & ~255; if (!found && m0 < acc + pc) { e = i; ebase = acc; ecnt = c; found = true; } acc += pc; }
        if (!found || m0 - ebase >= ecnt) return;
        Bt += (size_t)e * g.N * g.K;
    }
    if (tid < 64) { int r = m0 + tid;
        if (EPI == EPI_GATEUP) { const int li = m0 - ebase + tid; const int* LIST = (const int*)(p.ws + WS_LIST); r = (li < ecnt) ? LIST[e * NTOK + li] : 0; }
        rowsrc[tid] = r; }
    __syncthreads();
    float acc[4][4] = {};
    for (int k0 = 0; k0 < g.K; k0 += 32) {
        { const int r = tid >> 2, kc = (tid & 3) * 8; const u32x4 ua = *(const u32x4*)(g.A + (size_t)rowsrc[r] * g.K + k0 + kc), ub = *(const u32x4*)(Bt + (size_t)(n0 + r) * g.K + k0 + kc);
            const unsigned a4[4] = {ua.x, ua.y, ua.z, ua.w}, b4[4] = {ub.x, ub.y, ub.z, ub.w};
#pragma unroll
            for (int i = 0; i < 4; ++i) { As[r][kc + 2 * i] = bf2f(a4[i] & 0xffffu); As[r][kc + 2 * i + 1] = bf2f(a4[i] >> 16); Bs[r][kc + 2 * i] = bf2f(b4[i] & 0xffffu); Bs[r][kc + 2 * i + 1] = bf2f(b4[i] >> 16); } }
        __syncthreads();
#pragma unroll 8
        for (int kk = 0; kk < 32; ++kk) { float a[4], b[4];
#pragma unroll
            for (int i = 0; i < 4; ++i) { a[i] = As[4 * ty + i][kk]; b[i] = Bs[4 * tx + i][kk]; }
#pragma unroll
            for (int i = 0; i < 4; ++i)
#pragma unroll
                for (int j = 0; j < 4; ++j) acc[i][j] += a[i] * b[j]; }
        __syncthreads();
    }
#pragma unroll
    for (int i = 0; i < 4; ++i)
#pragma unroll
        for (int j = 0; j < 4; ++j) Cs[4 * ty + i][4 * tx + j] = acc[i][j];
    __syncthreads();
    const float* rope = (const float*)(p.ws + WS_MISC) + 1024;
    for (int idx = tid; idx < 4096; idx += 256) {
        const int r = idx >> 6, cc = idx & 63, n = n0 + cc, row = m0 + r; const float val = Cs[r][cc];
        if (EPI == EPI_QKV) {
            if (n < 2048) { float o = val;
                if (row < NLAT) { const int d = n & 63, s = row & (SEQ - 1), pos = (d & 32) ? (s & 63) : (s >> 6), f = d & 15; const float cs = rope[(pos * 16 + f) * 2], sn = rope[(pos * 16 + f) * 2 + 1];
                    o = (d & 16) ? val * cs + Cs[r][cc - 16] * sn : val * cs - Cs[r][cc + 16] * sn; }
                if (n < 1024) ((bf16*)(p.ws + WS_Q))[(size_t)row * DM + n] = (bf16)f2bf(o * C2); else ((bf16*)(p.ws + WS_K))[(size_t)row * DM + n - 1024] = (bf16)f2bf(o);
            } else ((bf16*)(p.ws + WS_V))[(size_t)row * DM + n - 2048] = (bf16)f2bf(val);
        } else if (EPI == EPI_PLAIN) { g.O[(size_t)row * g.N + n] = (bf16)f2bf(val);
        } else if (EPI == EPI_GATEUP) { if (!(cc & 16)) { const float gt = val, up = Cs[r][cc + 16]; const int other = (n >> 5) * 16 + (n & 15); ((bf16*)(p.ws + WS_ACT))[(size_t)row * DEXP + other] = (bf16)f2bf(silu_f(gt) * up); }
        } else if (EPI == EPI_DOWN) { ((bf16*)(p.ws + WS_YM))[(size_t)row * DM + n] = (bf16)f2bf(val);
        } else if (EPI == EPI_INPROJ) {
            if (n < 512) ((bf16*)(p.ws + WS_QR))[(size_t)row * 512 + n] = (bf16)f2bf(val * 0.08838834764831845f);
            else if (n < 1024) ((bf16*)(p.ws + WS_KR))[(size_t)row * 512 + n - 512] = (bf16)f2bf(val);
            else if (n < 2048) ((bf16*)(p.ws + WS_V1))[(size_t)row * DM + n - 1024] = (bf16)f2bf(val);
            else if (n < 3072) ((bf16*)(p.ws + WS_R))[(size_t)row * DM + n - 2048] = (bf16)f2bf(val);
            else if (n < 3104) ((float*)(p.ws + WS_ZZ))[(size_t)row * 32 + n - 3072] = val;
        }
    }
}
__global__ __launch_bounds__(256) void attn_kernel(Prm p) {
    __shared__ float Qs[64][65], Ks[32][65], Ps[64][33], Vs[32][129], al[64];
    const bf16* Q = (const bf16*)(p.ws + WS_Q); const bf16* K = (const bf16*)(p.ws + WS_K); const bf16* V = (const bf16*)(p.ws + WS_V);
    const int tid = threadIdx.x, ty = tid >> 4, tx = tid & 15, qb = blockIdx.x, hm = blockIdx.y, h = hm >> 1;
    const bool lat = qb < 512; const int b = lat ? qb >> 6 : (qb - 512) >> 2; const int tok0 = lat ? qb * 64 : NLAT + (qb - 512) * 64;
    bf16* O = (bf16*)(p.ws + ((hm & 1) ? WS_O2 : WS_O1));
    for (int i = tid; i < 4096; i += 256) { const int r = i >> 6, d = i & 63; Qs[r][d] = bf2f(Q[(size_t)(tok0 + r) * DM + hm * 64 + d]); }
    float o[4][8] = {}; float mrow = -3.0e38f, lrow = 0.f;
    const int nkt = lat ? (CTXL + SEQ) / 32 : CTXL / 32;
    for (int kt = 0; kt < nkt; ++kt) {
        const int key0 = (kt < CTXL / 32) ? NLAT + b * CTXL + kt * 32 : b * SEQ + (kt - CTXL / 32) * 32;
        __syncthreads();
        for (int i = tid; i < 2048; i += 256) { const int r = i >> 6, d = i & 63; Ks[r][d] = bf2f(K[(size_t)(key0 + r) * DM + hm * 64 + d]); }
        for (int i = tid; i < 4096; i += 256) { const int r = i >> 7, d = i & 127; Vs[r][d] = bf2f(V[(size_t)(key0 + r) * DM + h * 128 + d]); }
        __syncthreads();
        float s[4][2] = {};
        for (int d = 0; d < 64; ++d) { float a[4], bb[2];
#pragma unroll
            for (int i = 0; i < 4; ++i) a[i] = Qs[4 * ty + i][d];
            bb[0] = Ks[2 * tx][d]; bb[1] = Ks[2 * tx + 1][d];
#pragma unroll
            for (int i = 0; i < 4; ++i) { s[i][0] += a[i] * bb[0]; s[i][1] += a[i] * bb[1]; } }
#pragma unroll
        for (int i = 0; i < 4; ++i) { Ps[4 * ty + i][2 * tx] = s[i][0]; Ps[4 * ty + i][2 * tx + 1] = s[i][1]; }
        __syncthreads();
        if (tid < 64) { float mx = mrow;
            for (int j = 0; j < 32; ++j) mx = fmaxf(mx, Ps[tid][j]);
            const float a = exp2f(mrow - mx); float sum = 0.f;
            for (int j = 0; j < 32; ++j) { const float e = exp2f(Ps[tid][j] - mx); Ps[tid][j] = e; sum += e; }
            lrow = lrow * a + sum; mrow = mx; al[tid] = a; }
        __syncthreads();
#pragma unroll
        for (int i = 0; i < 4; ++i) { const float a = al[4 * ty + i];
#pragma unroll
            for (int j = 0; j < 8; ++j) o[i][j] *= a; }
        for (int kk = 0; kk < 32; ++kk) { float pv[4], vv[8];
#pragma unroll
            for (int i = 0; i < 4; ++i) pv[i] = Ps[4 * ty + i][kk];
#pragma unroll
            for (int j = 0; j < 8; ++j) vv[j] = Vs[kk][8 * tx + j];
#pragma unroll
            for (int i = 0; i < 4; ++i)
#pragma unroll
                for (int j = 0; j < 8; ++j) o[i][j] += pv[i] * vv[j]; }
    }
    __syncthreads();
    if (tid < 64) al[tid] = 1.f / lrow;
    __syncthreads();
#pragma unroll
    for (int i = 0; i < 4; ++i) { const float a = al[4 * ty + i];
#pragma unroll
        for (int j = 0; j < 8; ++j) O[(size_t)(tok0 + 4 * ty + i) * DM + h * 128 + 8 * tx + j] = (bf16)f2bf(o[i][j] * a); }
}
__global__ __launch_bounds__(256) void gla_scan_kernel(Prm p) {
    extern __shared__ __attribute__((aligned(16))) unsigned char sm[];
    float (*S)[33] = (float (*)[33])sm;
    float (*Qs)[129] = (float (*)[129])(sm + 128 * 33 * 4);
    float (*Ks)[129] = (float (*)[129])(sm + 128 * 33 * 4 + 64 * 129 * 4);
    float (*Vs)[33] = (float (*)[33])(sm + 128 * 33 * 4 + 2 * 64 * 129 * 4);
    float (*Ps)[65] = (float (*)[65])(sm + 128 * 33 * 4 + 2 * 64 * 129 * 4 + 64 * 33 * 4);
    float* dec = (float*)(sm + 128 * 33 * 4 + 2 * 64 * 129 * 4 + 64 * 33 * 4 + 64 * 65 * 4);
    const bf16* QT = (const bf16*)(p.ws + WS_QT); const bf16* KT = (const bf16*)(p.ws + WS_KT); const bf16* V = (const bf16*)(p.ws + WS_V1); const float* DEC = (const float*)(p.ws + WS_DEC);
    const int tid = threadIdx.x, ty = tid >> 4, tx = tid & 15, vs = blockIdx.x & 7, dir = (blockIdx.x >> 3) & 1, h = (blockIdx.x >> 4) & 3, b = blockIdx.x >> 6;
    bf16* OG = (bf16*)(p.ws + (dir ? WS_OGB : WS_OGF));
    for (int i = tid; i < 128 * 32; i += 256) S[i >> 5][i & 31] = 0.f;
    for (int step = 0; step < 68; ++step) {
        const bool lat = step >= 4; const int ci = lat ? step - 4 : step;
        const int chunk = lat ? b * 64 + (dir ? 63 - ci : ci) : 512 + b * 4 + (dir ? 3 - ci : ci); const int tok0 = chunk * 64;
        __syncthreads();
        for (int i = tid; i < 64 * 128; i += 256) { const int t = i >> 7, d = i & 127; const size_t off = ((size_t)dir * NTOK + tok0 + t) * 512 + h * 128 + d; Qs[t][d] = bf2f(QT[off]); Ks[t][d] = bf2f(KT[off]); }
        for (int i = tid; i < 64 * 32; i += 256) { const int t = i >> 5, v = i & 31; Vs[t][v] = bf2f(V[(size_t)(tok0 + t) * DM + h * 256 + vs * 32 + v]); }
        if (tid < 128) dec[tid] = DEC[((size_t)dir * NCHUNK + chunk) * 512 + h * 128 + tid];
        __syncthreads();
        if (lat) {
            float s[4][4] = {};
            for (int d = 0; d < 128; ++d) { float a[4], bb[4];
#pragma unroll
                for (int i = 0; i < 4; ++i) { a[i] = Qs[4 * ty + i][d]; bb[i] = Ks[4 * tx + i][d]; }
#pragma unroll
                for (int i = 0; i < 4; ++i)
#pragma unroll
                    for (int j = 0; j < 4; ++j) s[i][j] += a[i] * bb[j]; }
#pragma unroll
            for (int i = 0; i < 4; ++i)
#pragma unroll
                for (int j = 0; j < 4; ++j) { const int t = 4 * ty + i, sidx = 4 * tx + j; const bool keep = dir ? (sidx >= t) : (sidx <= t); Ps[t][sidx] = keep ? s[i][j] : 0.f; }
            __syncthreads();
            float o[4][2] = {};
            for (int sidx = 0; sidx < 64; ++sidx) { const float v0 = Vs[sidx][2 * tx], v1 = Vs[sidx][2 * tx + 1];
#pragma unroll
                for (int i = 0; i < 4; ++i) { const float pp = Ps[4 * ty + i][sidx]; o[i][0] += pp * v0; o[i][1] += pp * v1; } }
            for (int d = 0; d < 128; ++d) { const float s0 = S[d][2 * tx], s1 = S[d][2 * tx + 1];
#pragma unroll
                for (int i = 0; i < 4; ++i) { const float qq = Qs[4 * ty + i][d]; o[i][0] += qq * s0; o[i][1] += qq * s1; } }
#pragma unroll
            for (int i = 0; i < 4; ++i) { const size_t off = (size_t)(tok0 + 4 * ty + i) * DM + h * 256 + vs * 32 + 2 * tx; OG[off] = (bf16)f2bf(o[i][0]); OG[off + 1] = (bf16)f2bf(o[i][1]); }
            __syncthreads();
        }
        float u[8][2] = {};
        for (int sidx = 0; sidx < 64; ++sidx) { const float v0 = Vs[sidx][2 * tx], v1 = Vs[sidx][2 * tx + 1];
#pragma unroll
            for (int i = 0; i < 8; ++i) { const float kk = Ks[sidx][8 * ty + i]; u[i][0] += kk * v0; u[i][1] += kk * v1; } }
#pragma unroll
        for (int i = 0; i < 8; ++i) { const int d = 8 * ty + i; S[d][2 * tx] = dec[d] * (S[d][2 * tx] + u[i][0]); S[d][2 * tx + 1] = dec[d] * (S[d][2 * tx + 1] + u[i][1]); }
    }
}
constexpr int GLA_SCAN_LDS = 128 * 33 * 4 + 2 * 64 * 129 * 4 + 64 * 33 * 4 + 64 * 65 * 4 + 512;
}
namespace pg8 {
typedef short bf16x8 __attribute__((ext_vector_type(8)));
constexpr int BM = 256, BK = 64, HALF = 128, HTB = HALF * BK * 2, STAGE_BYTES = 8 * HTB, NXCD = 8, WGM = 8;
__host__ __device__ __forceinline__ int lds_byte(int r, int c) { const int st = (r >> 4) * 2 + (c >> 5), rr = r & 15, cc = c & 31, ob = rr * 64 + cc * 2; return st * 1024 + (ob ^ (((ob >> 9) & 1) << 5)); }
__host__ __device__ __forceinline__ void stage_rc(int b, int& R, int& C) { const int st = b / 1024, sb = b % 1024, swz = sb ^ (((sb >> 9) & 1) << 5); R = (st >> 1) * 16 + swz / 64; C = (st & 1) * 32 + (swz % 64) / 2; }
__device__ __forceinline__ unsigned cvt_pk_bf16(float lo, float hi) { unsigned r; asm volatile("v_cvt_pk_bf16_f32 %0, %1, %2" : "=v"(r) : "v"(lo), "v"(hi)); return r; }

struct Unit { int pm, pn; int row0; int e; int cnt; const bf16* Bt; };

struct DenseOrder {
    int nM, nN, nwg, G, c, K; const bf16* Bt;
    __device__ void init(int M, int N, int K_, const bf16* Bt_, int G_, int c_) { nM = M / BM; nN = N / BM; nwg = nM * nN; G = G_; c = c_; K = K_; Bt = Bt_; }
    __device__ bool next(int i, Unit& u) const {
        const long L = (long)i * G + c; if (L >= nwg) return false;
        int wgid = (int)L; { const int q = nwg / NXCD, r = nwg % NXCD, xcd = wgid % NXCD, off = wgid / NXCD; wgid = (xcd < r ? xcd * (q + 1) : r * (q + 1) + (xcd - r) * q) + off; }
        const int nig = WGM * nN, gid = wgid / nig, fm = gid * WGM, gsz = (nM - fm) < WGM ? (nM - fm) : WGM;
        u.pm = fm + ((wgid % nig) % gsz); u.pn = (wgid % nig) / gsz; u.row0 = u.pm * BM; u.e = 0; u.cnt = 0; u.Bt = Bt; return true;
    }
    __device__ __forceinline__ unsigned arow(const Unit& u, int r) const { return (unsigned)(u.row0 + r) * (unsigned)(K * 2); }
};
template <bool GATHER> struct MoeOrder {
    int cnt[16]; int nN, G, c, K; const bf16* Bt0; size_t bstride; const int* LIST;
    __device__ void init(const unsigned* cntw, int N, int K_, const bf16* Bt0_, const int* LIST_, int G_, int c_) {
#pragma unroll
        for (int e = 0; e < 16; ++e) cnt[e] = (int)__hip_atomic_load(cntw + e, __ATOMIC_RELAXED, __HIP_MEMORY_SCOPE_AGENT);
        nN = N / BM; G = G_; c = c_; K = K_; Bt0 = Bt0_; bstride = (size_t)N * K_; LIST = LIST_; }
    __device__ bool next(int i, Unit& u) const {
        int L = i * G + c, base = 0; bool found = false; u.pm = 0; u.pn = 0; u.row0 = 0; u.e = 0; u.cnt = 0; u.Bt = Bt0;
#pragma unroll
        for (int e = 0; e < 16; ++e) { const int mt = (cnt[e] + 255) >> 8, nu = mt * nN;
            if (!found) { if (L < nu) { found = true; u.e = e; u.cnt = cnt[e]; u.pm = L / nN; u.pn = L % nN; u.row0 = base + u.pm * BM; u.Bt = Bt0 + (size_t)e * bstride; } else { L -= nu; base += mt * BM; } } }
        return found;
    }
    __device__ __forceinline__ unsigned arow(const Unit& u, int r) const {
        if (GATHER) { const int li = u.pm * BM + r; int tok = 0; if (li < u.cnt) tok = LIST[u.e * NTOK + li];
            return (unsigned)tok * (unsigned)(K * 2); }
        return (unsigned)(u.row0 + r) * (unsigned)(K * 2);
    }
};

typedef f32x4 Acc[2][2][4][2];
__device__ __forceinline__ void st4bf(bf16* p, f32x4 v) { u32x2 w; w.x = cvt_pk_bf16(v.x, v.y); w.y = cvt_pk_bf16(v.z, v.w); *(u32x2*)p = w; }

struct EpiQKV {
    bf16 *Q; const float* rope;
    __device__ __forceinline__ void operator()(const Acc& acc, const Unit& u, int wr, int wc, int fr, int fq) const {
        const int reg = u.pn >> 2, cbase = (u.pn & 3) * BM + wc * 32 + 4 * fq; bf16* O = Q + (size_t)reg * ((WS_K - WS_Q) / 2);
        const bool dorope = (reg < 2) && (u.row0 < NLAT); const float sc = reg == 0 ? C2 : 1.f;
#pragma unroll
        for (int ai = 0; ai < 2; ++ai)
#pragma unroll
            for (int m = 0; m < 4; ++m) { const int row = u.row0 + ai * HALF + wr * 64 + m * 16 + fr; bf16* rowp = O + (size_t)row * DM + cbase;
                f32x4 cs = {1.f, 1.f, 1.f, 1.f}, sn = {0.f, 0.f, 0.f, 0.f};
                if (dorope) { const int s = row & (SEQ - 1), pos = (wc & 1) ? (s & 63) : (s >> 6); const f32x4 t0 = *(const f32x4*)(rope + (pos * 16 + 4 * fq) * 2), t1 = *(const f32x4*)(rope + (pos * 16 + 4 * fq) * 2 + 4);
                    cs = (f32x4){t0.x, t0.z, t1.x, t1.z}; sn = (f32x4){t0.y, t0.w, t1.y, t1.w}; }
#pragma unroll
                for (int bj = 0; bj < 2; ++bj) { const f32x4 a0 = acc[ai][bj][m][0], a1 = acc[ai][bj][m][1];
                    st4bf(rowp + bj * HALF, (a0 * cs - a1 * sn) * sc); st4bf(rowp + bj * HALF + 16, (a1 * cs + a0 * sn) * sc); } }
    }
};
struct EpiPlain {
    bf16* O;
    __device__ __forceinline__ void operator()(const Acc& acc, const Unit& u, int wr, int wc, int fr, int fq) const {
        const int cbase = u.pn * BM + wc * 32 + 4 * fq;
#pragma unroll
        for (int ai = 0; ai < 2; ++ai)
#pragma unroll
            for (int m = 0; m < 4; ++m) { bf16* rowp = O + (size_t)(u.row0 + ai * HALF + wr * 64 + m * 16 + fr) * DM + cbase;
#pragma unroll
                for (int bj = 0; bj < 2; ++bj)
#pragma unroll
                    for (int n = 0; n < 2; ++n) st4bf(rowp + bj * HALF + n * 16, acc[ai][bj][m][n]); }
    }
};
struct EpiInproj {
    bf16 *QR, *KR, *V, *R; float* ZZ;
    __device__ __forceinline__ void operator()(const Acc& acc, const Unit& u, int wr, int wc, int fr, int fq) const {
        const int pn = u.pn;
        if (pn == 12) { if (wc == 0) {
#pragma unroll
            for (int ai = 0; ai < 2; ++ai)
#pragma unroll
                for (int m = 0; m < 4; ++m) { float* rowp = ZZ + (size_t)(u.row0 + ai * HALF + wr * 64 + m * 16 + fr) * 32 + 4 * fq;
                    *(f32x4*)rowp = acc[ai][0][m][0]; *(f32x4*)(rowp + 16) = acc[ai][0][m][1]; } }
            return; }
        bf16* O; int ld, c0; float sc = 1.f;
        if (pn < 2) { O = QR; ld = 512; c0 = pn * BM; sc = 0.08838834764831845f; } else if (pn < 4) { O = KR; ld = 512; c0 = (pn - 2) * BM; } else if (pn < 8) { O = V; ld = DM; c0 = (pn - 4) * BM; } else { O = R; ld = DM; c0 = (pn - 8) * BM; }
        const int cbase = c0 + wc * 32 + 4 * fq;
#pragma unroll
        for (int ai = 0; ai < 2; ++ai)
#pragma unroll
            for (int m = 0; m < 4; ++m) { bf16* rowp = O + (size_t)(u.row0 + ai * HALF + wr * 64 + m * 16 + fr) * ld + cbase;
#pragma unroll
                for (int bj = 0; bj < 2; ++bj)
#pragma unroll
                    for (int n = 0; n < 2; ++n) st4bf(rowp + bj * HALF + n * 16, acc[ai][bj][m][n] * sc); }
    }
};
struct EpiGateUp {
    bf16* ACT;
    __device__ __forceinline__ void operator()(const Acc& acc, const Unit& u, int wr, int wc, int fr, int fq) const {
        const int obase = (u.pn * BM + wc * 32) / 2 + 4 * fq;
#pragma unroll
        for (int ai = 0; ai < 2; ++ai)
#pragma unroll
            for (int m = 0; m < 4; ++m) { bf16* rowp = ACT + (size_t)(u.row0 + ai * HALF + wr * 64 + m * 16 + fr) * DEXP + obase;
#pragma unroll
                for (int bj = 0; bj < 2; ++bj) { const f32x4 g = acc[ai][bj][m][0], up = acc[ai][bj][m][1]; f32x4 o;
#pragma unroll
                    for (int j = 0; j < 4; ++j) o[j] = g[j] * __builtin_amdgcn_rcpf(1.f + __expf(-g[j])) * up[j];
                    st4bf(rowp + bj * (HALF / 2), o); } }
    }
};

template <class Epi, class Sched>
__device__ __forceinline__ void gemm_phase(unsigned char* ldsg, const bf16* A, int K, const Sched& S, const Epi& E) {
    LAS unsigned char* lds = (LAS unsigned char*)ldsg;
    const int tid = threadIdx.x, wid = __builtin_amdgcn_readfirstlane(tid >> 6), lane = tid & 63, wr = wid >> 2, wc = wid & 3, fr = lane & 15, fq = lane >> 4;
    const int nt = K / BK;
    int Rr[2]; unsigned colb[2], voffB[2];
#pragma unroll
    for (int i = 0; i < 2; ++i) { int R, C; stage_rc(tid * 16 + i * 8192, R, C); Rr[i] = R; colb[i] = (unsigned)C * 2u; voffB[i] = (unsigned)(R * K + C) * 2u; }
    const size_t kstep = (size_t)(BK * 2);
    const size_t hstep = (size_t)HALF * K * 2;
    const size_t tstep = 2 * hstep;
    const unsigned ldsw = (unsigned)wid * 1024u;
    const int aoff = lds_byte(wr * 64 + fr, fq * 8), boff = lds_byte(wc * 32 + fr, fq * 8);
#define PG8_SA(b, h) (((b) * 2 + (h)) * HTB)
#define PG8_SB(b, h) ((4 + (b) * 2 + (h)) * HTB)
#define PG8_STAGE(bufoff, gbase, voff) do { _Pragma("unroll") for (int _i = 0; _i < 2; ++_i) \
        __builtin_amdgcn_global_load_lds((const unsigned*)((const char*)(gbase) + (voff)[_i]), (LAS unsigned*)(lds + (bufoff) + ldsw + _i * 8192), 16, 0, 0); } while (0)
#define PG8_LDA(dst, b, h) do { _Pragma("unroll") for (int m = 0; m < 4; ++m) _Pragma("unroll") for (int k = 0; k < 2; ++k) dst[m][k] = *(const LAS bf16x8*)(lds + PG8_SA(b, h) + aoff + m * 2048 + k * 1024); } while (0)
#define PG8_LDB(dst, b, h) do { _Pragma("unroll") for (int n = 0; n < 2; ++n) _Pragma("unroll") for (int k = 0; k < 2; ++k) dst[n][k] = *(const LAS bf16x8*)(lds + PG8_SB(b, h) + boff + n * 2048 + k * 1024); } while (0)
#define PG8_MMA(ai, bj, At, Bt) do { __builtin_amdgcn_s_setprio(1); _Pragma("unroll") for (int m = 0; m < 4; ++m) _Pragma("unroll") for (int n = 0; n < 2; ++n) _Pragma("unroll") for (int k = 0; k < 2; ++k) \
        acc[ai][bj][m][n] = __builtin_amdgcn_mfma_f32_16x16x32_bf16(Bt[n][k], At[m][k], acc[ai][bj][m][n], 0, 0, 0); __builtin_amdgcn_s_setprio(0); } while (0)
#define PG8_WAIT_V(n) asm volatile("s_waitcnt vmcnt(" #n ")" ::: "memory")
#define PG8_WAIT_L(n) asm volatile("s_waitcnt lgkmcnt(" #n ")" ::: "memory")
#define PG8_BAR __builtin_amdgcn_s_barrier()
#define PG8_SCHED __builtin_amdgcn_sched_barrier(0)
    Unit cur, nxt; int ui = 0;
    if (!S.next(0, cur)) return;
    Acc acc;
#pragma unroll
    for (int a = 0; a < 2; ++a)
#pragma unroll
        for (int b = 0; b < 2; ++b)
#pragma unroll
            for (int m = 0; m < 4; ++m)
#pragma unroll
                for (int n = 0; n < 2; ++n) acc[a][b][m][n] = (f32x4){0.f, 0.f, 0.f, 0.f};
    bf16x8 At[4][2], B0[2][2], B1[2][2];
    unsigned aC0[2], aC1[2], aN0[2], aN1[2];
#pragma unroll
    for (int i = 0; i < 2; ++i) { aC0[i] = S.arow(cur, Rr[i]) + colb[i]; aC1[i] = S.arow(cur, HALF + Rr[i]) + colb[i]; }
    const char* Ab = (const char*)A;
    const char* cB = (const char*)cur.Bt + (size_t)cur.pn * tstep;
    PG8_STAGE(PG8_SB(0, 0), cB, voffB); PG8_STAGE(PG8_SB(0, 1), cB + hstep, voffB); PG8_STAGE(PG8_SA(0, 0), Ab, aC0); PG8_STAGE(PG8_SA(0, 1), Ab, aC1);
    if (wr == 1) PG8_BAR;
    PG8_WAIT_V(2); PG8_BAR;
    PG8_STAGE(PG8_SB(1, 0), cB + kstep, voffB); PG8_STAGE(PG8_SA(1, 0), Ab + kstep, aC0); PG8_STAGE(PG8_SB(1, 1), cB + hstep + kstep, voffB);
    PG8_WAIT_V(6); PG8_BAR;
    for (;;) {
        const bool has_next = S.next(ui + 1, nxt);
        if (has_next) {
#pragma unroll
            for (int i = 0; i < 2; ++i) { aN0[i] = S.arow(nxt, Rr[i]) + colb[i]; aN1[i] = S.arow(nxt, HALF + Rr[i]) + colb[i]; }
        } else {
#pragma unroll
            for (int i = 0; i < 2; ++i) { aN0[i] = aC0[i]; aN1[i] = aC1[i]; }
        }
        const char* nB = has_next ? (const char*)nxt.Bt + (size_t)nxt.pn * tstep : cB;
        for (int t = 0; t < nt; t += 2) {
            const bool last = (t == nt - 2);
            const char* a1 = Ab + (size_t)(t + 1) * kstep;
            const char* a2 = last ? Ab : Ab + (size_t)(t + 2) * kstep; const char* b2 = last ? nB : cB + (size_t)(t + 2) * kstep;
            const char* a3 = a2 + kstep; const char* b3 = b2 + kstep;
            unsigned x0[2], x1[2];
#pragma unroll
            for (int i = 0; i < 2; ++i) { x0[i] = last ? aN0[i] : aC0[i]; x1[i] = last ? aN1[i] : aC1[i]; }
            PG8_LDB(B0, 0, 0); PG8_LDB(B1, 0, 1); PG8_SCHED; PG8_LDA(At, 0, 0); PG8_STAGE(PG8_SA(1, 1), a1, aC1);
            PG8_WAIT_V(8); PG8_WAIT_L(0); PG8_BAR; PG8_MMA(0, 0, At, B0); PG8_MMA(0, 1, At, B1); PG8_BAR; PG8_SCHED;
            PG8_LDA(At, 0, 1); PG8_STAGE(PG8_SB(0, 0), b2, voffB); PG8_STAGE(PG8_SB(0, 1), b2 + hstep, voffB); PG8_STAGE(PG8_SA(0, 0), a2, x0);
            PG8_WAIT_V(8); PG8_WAIT_L(0); PG8_BAR; PG8_MMA(1, 0, At, B0); PG8_MMA(1, 1, At, B1); PG8_BAR; PG8_SCHED;
            PG8_LDB(B0, 1, 0); PG8_LDB(B1, 1, 1); PG8_SCHED; PG8_LDA(At, 1, 0); PG8_STAGE(PG8_SA(0, 1), a2, x1);
            PG8_WAIT_V(8); PG8_WAIT_L(0); PG8_BAR; PG8_MMA(0, 0, At, B0); PG8_MMA(0, 1, At, B1); PG8_BAR; PG8_SCHED;
            PG8_LDA(At, 1, 1); PG8_STAGE(PG8_SB(1, 0), b3, voffB); PG8_STAGE(PG8_SB(1, 1), b3 + hstep, voffB); PG8_STAGE(PG8_SA(1, 0), a3, x0);
            PG8_WAIT_V(8); PG8_WAIT_L(0); PG8_BAR; PG8_MMA(1, 0, At, B0); PG8_MMA(1, 1, At, B1); PG8_BAR; PG8_SCHED;
        }
        if (wr == 0) PG8_BAR;
        E(acc, cur, wr, wc, fr, fq);
        if (!has_next) break;
#pragma unroll
        for (int a = 0; a < 2; ++a)
#pragma unroll
            for (int b = 0; b < 2; ++b)
#pragma unroll
                for (int m = 0; m < 4; ++m)
#pragma unroll
                    for (int n = 0; n < 2; ++n) acc[a][b][m][n] = (f32x4){0.f, 0.f, 0.f, 0.f};
        cur = nxt; cB = nB; ++ui;
#pragma unroll
        for (int i = 0; i < 2; ++i) { aC0[i] = aN0[i]; aC1[i] = aN1[i]; }
        if (wr == 1) PG8_BAR;
    }
    PG8_WAIT_V(0);
    PG8_BAR;
#undef PG8_SA
#undef PG8_SB
#undef PG8_STAGE
#undef PG8_LDA
#undef PG8_LDB
#undef PG8_MMA
#undef PG8_WAIT_V
#undef PG8_WAIT_L
#undef PG8_BAR
#undef PG8_SCHED
}
}

__device__ __forceinline__ int vcu_of(const Frame& F) { return (F.G % 8 == 0) ? (F.bid % 8) * (F.G / 8) + F.bid / 8 : F.bid; }
__device__ __forceinline__ void phase_qkv_opt(const Frame& F, const Prm& p) {
    pg8::DenseOrder S; S.init(NTOK, 3072, 1024, (const bf16*)(p.ws + WS_WQKV), F.G, F.bid);
    static_assert(WS_V - WS_K == WS_K - WS_Q, "Q|K|V equally spaced");
    pg8::EpiQKV E{(bf16*)(p.ws + WS_Q), (const float*)(p.ws + WS_MISC) + 1024};
    pg8::gemm_phase(F.lds, (const bf16*)(p.ws + WS_H), 1024, S, E);
}
__device__ __forceinline__ void phase_wo_opt(const Frame& F, const Prm& p, int layer) {
    pg8::DenseOrder S; S.init(layer ? NLAT : NTOK, 1024, 1024, (const bf16*)(p.ws + (layer ? WS_WGO : WS_WO)), F.G, F.bid);
    pg8::EpiPlain E{(bf16*)(p.ws + WS_Y)};
    pg8::gemm_phase(F.lds, (const bf16*)(p.ws + (layer ? WS_A2B : WS_A2)), 1024, S, E);
}
__device__ __forceinline__ void phase_inproj_opt(const Frame& F, const Prm& p) {
    pg8::DenseOrder S; S.init(NTOK, NIN, 1024, (const bf16*)(p.ws + WS_WIN), F.G, F.bid);
    pg8::EpiInproj E{(bf16*)(p.ws + WS_QR), (bf16*)(p.ws + WS_KR), (bf16*)(p.ws + WS_V1), (bf16*)(p.ws + WS_R), (float*)(p.ws + WS_ZZ)};
    pg8::gemm_phase(F.lds, (const bf16*)(p.ws + WS_H), 1024, S, E);
}
__device__ __forceinline__ void phase_moe1_opt(const Frame& F, const Prm& p, int layer) {
    pg8::MoeOrder<true> S; S.init(F.ctl + CW_CNT + layer * 16, 1024, 1024, (const bf16*)(p.ws + (layer ? WS_GU1 : WS_GU0)), (const int*)(p.ws + WS_LIST), F.G, vcu_of(F));
    pg8::EpiGateUp E{(bf16*)(p.ws + WS_ACT)};
    pg8::gemm_phase(F.lds, (const bf16*)(p.ws + WS_H), 1024, S, E);
}
__device__ __forceinline__ void phase_moe2_opt(const Frame& F, const Prm& p, int layer) {
    pg8::MoeOrder<false> S; S.init(F.ctl + CW_CNT + layer * 16, 1024, 512, (const bf16*)(p.ws + (layer ? WS_DN1 : WS_DN0)), nullptr, F.G, vcu_of(F));
    pg8::EpiPlain E{(bf16*)(p.ws + WS_YM)};
    pg8::gemm_phase(F.lds, (const bf16*)(p.ws + WS_ACT), 512, S, E);
}
#define PHASE_QKV(F, p) phase_qkv_opt(F, p)
#define PHASE_ATTN(F, p) do {} while (0)
#define PHASE_WO(F, p, l) phase_wo_opt(F, p, l)
#define PHASE_MOE1(F, p, l) phase_moe1_opt(F, p, l)
#define PHASE_MOE2(F, p, l) phase_moe2_opt(F, p, l)
#define PHASE_INPROJ(F, p) phase_inproj_opt(F, p)
#define PHASE_SCAN(F, p) do {} while (0)
typedef GAS unsigned gu32;
#define XB_TMO      128
#define XB_XCNT(j)  (256  + 64 * (j))
#define XB_XSUB(j)  (1280 + 64 * (j))
#define XB_XGEN(j)  (2304 + 64 * (j))
#define XB_TOP      3328
#define XB_TOPGEN   3392
#define XCD_BAR_WORDS 3456
#define XB_SPIN_CAP (1u << 20)
__device__ __forceinline__ unsigned xb_ld(unsigned* p)              { return __hip_atomic_load(p, __ATOMIC_RELAXED, __HIP_MEMORY_SCOPE_AGENT); }
__device__ __forceinline__ unsigned xb_add(unsigned* p, unsigned v) { return __hip_atomic_fetch_add(p, v, __ATOMIC_RELAXED, __HIP_MEMORY_SCOPE_AGENT); }
__device__ __forceinline__ unsigned xb_xcc_id() { return (unsigned)__builtin_amdgcn_s_getreg((3 << 11) | 20) & 0xFu; }
#define XB_SPIN(cond, bar) do { unsigned _sp = 0; while (cond) { __builtin_amdgcn_s_sleep(1); \
    if ((++_sp & 255u) == 0u) { if (xb_ld(&(bar)[XB_TMO])) break; if (_sp > XB_SPIN_CAP) { atomicAdd(&(bar)[XB_TMO], 1u); break; } } } } while (0)
struct XcdBarrier { unsigned* bar; unsigned x; volatile LAS unsigned* st; };
__device__ __forceinline__ XcdBarrier xcd_barrier_post(unsigned* bar, volatile LAS unsigned* st) {
    XcdBarrier b; b.bar = bar; b.x = xb_xcc_id(); b.st = st;
    if (threadIdx.x == 0) (void)xb_add(&bar[XB_XCNT(b.x)], 1u);
    return b;
}
__device__ __forceinline__ void xcd_barrier_complete(unsigned* bar, unsigned x, unsigned& nloc, unsigned& nx) {
    const unsigned G = gridDim.x * gridDim.y * gridDim.z;
    unsigned sum, cnt, mine, sp = 0u;
    for (;;) {
        sum = 0u; cnt = 0u; mine = 0u;
#pragma unroll
        for (unsigned j = 0; j < 16; ++j) { const unsigned c = xb_ld(&bar[XB_XCNT(j)]); sum += c; cnt += (c > 0u) ? 1u : 0u; mine = (j == x) ? c : mine; }
        if (sum == G) break;
        __builtin_amdgcn_s_sleep(1);
        if ((++sp & 255u) == 0u) { if (xb_ld(&bar[XB_TMO])) break; if (sp > XB_SPIN_CAP) { atomicAdd(&bar[XB_TMO], 1u); break; } }
    }
    nloc = mine > 0u ? mine : 1u; nx = cnt > 0u ? cnt : 1u;
}
__device__ __forceinline__ void xcd_barrier(const XcdBarrier& b) {
    asm volatile("s_waitcnt vmcnt(0)" ::: "memory");
    __syncthreads();
    if (threadIdx.x == 0) {
        unsigned* bar = b.bar;
        __builtin_amdgcn_s_waitcnt(0);
        unsigned nloc = b.st[0], nx = b.st[1];
        if (nloc == 0u) { xcd_barrier_complete(bar, b.x, nloc, nx); b.st[0] = nloc; b.st[1] = nx; }
        const unsigned old = xb_add(&bar[XB_XSUB(b.x)], 1u);
        const unsigned gen = old / nloc;
        if (old + 1u == (gen + 1u) * nloc) {
            __builtin_amdgcn_fence(__ATOMIC_RELEASE, "agent");
            asm volatile("s_waitcnt vmcnt(0)" ::: "memory");
            const unsigned og = xb_add(&bar[XB_TOP], 1u);
            const unsigned tg = og / nx;
            if (og + 1u == (tg + 1u) * nx) xb_add(&bar[XB_TOPGEN], 1u);
            else XB_SPIN(xb_ld(&bar[XB_TOPGEN]) == tg, bar);
            __builtin_amdgcn_fence(__ATOMIC_ACQUIRE, "agent");
            xb_add(&bar[XB_XGEN(b.x)], 1u);
            asm volatile("s_waitcnt vmcnt(0)" ::: "memory");
        } else {
            XB_SPIN(xb_ld(&bar[XB_XGEN(b.x)]) == gen, bar);
            __builtin_amdgcn_fence(__ATOMIC_ACQUIRE, "agent");
            asm volatile("s_waitcnt vmcnt(0)" ::: "memory");
        }
    }
    __syncthreads();
}

constexpr int NPHASE = 19;
#ifndef OPT_MASK
#define OPT_MASK 0u
#endif
__global__ void __launch_bounds__(NTHR, 2) mega_fwd(Prm p) {
    extern __shared__ __attribute__((aligned(16))) unsigned char lds[];
    Frame F; F.lds = lds; F.ctl = (unsigned*)(p.ws + WS_CTL);
    F.tid = threadIdx.x; F.lane = F.tid & 63; F.wave = __builtin_amdgcn_readfirstlane(F.tid >> 6); F.G = gridDim.x; F.bid = blockIdx.x;
    for (int u = F.tid; u < (LDS_BYTES - LDSCTL_OFF) / 4; u += NTHR) ((LAS unsigned*)(lds + LDSCTL_OFF))[u] = 0u;
    __syncthreads();
    const int lo = p.ph_lo, hi = p.ph_hi;
    const bool multi = (hi - lo) > 1;
    XcdBarrier bar; bar.bar = F.ctl + CW_BAR + p.li * XCD_BAR_WORDS; bar.x = 0; bar.st = nullptr;
    if (multi) bar = xcd_barrier_post(F.ctl + CW_BAR + p.li * XCD_BAR_WORDS, (volatile LAS unsigned*)(lds + MISC_OFF) + 8);
#define IN(k) (lo <= (k) && (k) < hi)
#define SEAM(k) do { if (IN(k) && IN((k) + 1)) xcd_barrier(bar); } while (0)
    if (IN(0)) { phase_prologue(F, p); } SEAM(0);
    if (IN(1)) { phase_modulate0(F, p); } SEAM(1);
    if (IN(2)) { PHASE_QKV(F, p); } SEAM(2);
    if (IN(3)) { PHASE_ATTN(F, p); } SEAM(3);
    if (IN(4)) { phase_attn_combine(F, p); } SEAM(4);
    if (IN(5)) { PHASE_WO(F, p, 0); } SEAM(5);
    if (IN(6)) { phase_ln_route(F, p, 0); } SEAM(6);
    if (IN(7)) { PHASE_MOE1(F, p, 0); } SEAM(7);
    if (IN(8)) { PHASE_MOE2(F, p, 0); } SEAM(8);
    if (IN(9)) { phase_moe_combine(F, p, 0); } SEAM(9);
    if (IN(10)) { PHASE_INPROJ(F, p); } SEAM(10);
    if (IN(11)) { phase_gla_prep(F, p); } SEAM(11);
    if (IN(12)) { PHASE_SCAN(F, p); } SEAM(12);
    if (IN(13)) { phase_gla_post(F, p); } SEAM(13);
    if (IN(14)) { PHASE_WO(F, p, 1); } SEAM(14);
    if (IN(15)) { phase_ln_route(F, p, 1); } SEAM(15);
    if (IN(16)) { PHASE_MOE1(F, p, 1); } SEAM(16);
    if (IN(17)) { PHASE_MOE2(F, p, 1); } SEAM(17);
    if (IN(18)) { phase_moe_combine(F, p, 1); }
#undef IN
#undef SEAM
}

static void launch_naive(int ph, const Prm& p, hipStream_t stream) {
    using namespace naive;
    const bf16* H = (const bf16*)(p.ws + WS_H);
    switch (ph) {
    case 2: { NG g{H, (const bf16*)(p.ws + WS_WQKV), NTOK, 3072, 1024, 0, nullptr}; hipLaunchKernelGGL(gemm_kernel<EPI_QKV>, dim3(3072 / 64, NTOK / 64), dim3(256), 0, stream, g, p); break; }
    case 3: hipLaunchKernelGGL(attn_kernel, dim3(544, 16), dim3(256), 0, stream, p); break;
    case 5: { NG g{(const bf16*)(p.ws + WS_A2), (const bf16*)(p.ws + WS_WO), NTOK, 1024, 1024, 0, (bf16*)(p.ws + WS_Y)}; hipLaunchKernelGGL(gemm_kernel<EPI_PLAIN>, dim3(16, NTOK / 64), dim3(256), 0, stream, g, p); break; }
    case 7: case 16: { const int l = ph == 16; NG g{H, (const bf16*)(p.ws + (l ? WS_GU1 : WS_GU0)), MAXSLOT, 1024, 1024, l, nullptr}; hipLaunchKernelGGL(gemm_kernel<EPI_GATEUP>, dim3(16, MAXSLOT / 64), dim3(256), 0, stream, g, p); break; }
    case 8: case 17: { const int l = ph == 17; NG g{(const bf16*)(p.ws + WS_ACT), (const bf16*)(p.ws + (l ? WS_DN1 : WS_DN0)), MAXSLOT, 1024, 512, l, nullptr}; hipLaunchKernelGGL(gemm_kernel<EPI_DOWN>, dim3(16, MAXSLOT / 64), dim3(256), 0, stream, g, p); break; }
    case 10: { NG g{H, (const bf16*)(p.ws + WS_WIN), NTOK, NIN, 1024, 0, nullptr}; hipLaunchKernelGGL(gemm_kernel<EPI_INPROJ>, dim3(NIN / 64, NTOK / 64), dim3(256), 0, stream, g, p); break; }
    case 12: hipLaunchKernelGGL(gla_scan_kernel, dim3(512), dim3(256), GLA_SCAN_LDS, stream, p); break;
    case 14: { NG g{(const bf16*)(p.ws + WS_A2B), (const bf16*)(p.ws + WS_WGO), NLAT, 1024, 1024, 0, (bf16*)(p.ws + WS_Y)}; hipLaunchKernelGGL(gemm_kernel<EPI_PLAIN>, dim3(16, NLAT / 64), dim3(256), 0, stream, g, p); break; }
    default: break;
    }
}
extern "C" void kernel_launch(void* const* d_in, const int* in_sizes, int n_in, void* d_out, int out_size, void* d_ws, size_t ws_size, hipStream_t stream) {
    static int grid = 0;
    if (grid == 0) {
        if (n_in != 23 || in_sizes[0] != NLAT * DM || out_size != NLAT * DM || ws_size < WS_END) { fprintf(stderr, "kernel_launch: unexpected shapes (n_in %d, in0 %d, out %d, ws %zu); nothing launched\n", n_in, n_in > 0 ? in_sizes[0] : -1, out_size, ws_size); grid = -1; return; }
        int dev = 0, cus = 0;
        if (hipGetDevice(&dev) != hipSuccess || hipDeviceGetAttribute(&cus, hipDeviceAttributeMultiprocessorCount, dev) != hipSuccess) { grid = -1; return; }
        if (hipFuncSetAttribute((const void*)mega_fwd, hipFuncAttributeMaxDynamicSharedMemorySize, LDS_BYTES) != hipSuccess) { fprintf(stderr, "kernel_launch: hipFuncSetAttribute failed\n"); grid = -1; return; }
        (void)hipFuncSetAttribute((const void*)naive::gla_scan_kernel, hipFuncAttributeMaxDynamicSharedMemorySize, naive::GLA_SCAN_LDS);
        int per_cu = 0;
        if (hipOccupancyMaxActiveBlocksPerMultiprocessor(&per_cu, (const void*)mega_fwd, NTHR, LDS_BYTES) != hipSuccess || per_cu < 1) fprintf(stderr, "kernel_launch: note: occupancy query reports %d\n", per_cu);
        (void)hipGetLastError();
        grid = cus;
    }
    if (grid < 0) return;
    (void)hipMemsetAsync((char*)d_ws + WS_CTL, 0, CTL_ZERO_BYTES, stream);
    Prm p{};
    const float** pp = (const float**)&p;
    for (int i = 0; i < 23; ++i) pp[i] = (const float*)d_in[i];
    p.out = (float*)d_out; p.ws = (unsigned char*)d_ws;
    const unsigned naive_phases = (1u << 2) | (1u << 3) | (1u << 5) | (1u << 7) | (1u << 8) | (1u << 10) | (1u << 12) | (1u << 14) | (1u << 16) | (1u << 17);
    const unsigned use_naive = naive_phases & ~(unsigned)(OPT_MASK);
    int ph = 0, li = 0;
    while (ph < NPHASE) {
        if (use_naive & (1u << ph)) { launch_naive(ph, p, stream); ++ph; continue; }
        int e = ph + 1;
#if defined(ONE_PER_PHASE)
#else
        while (e < NPHASE && !(use_naive & (1u << e))) ++e;
#endif
        p.ph_lo = ph; p.ph_hi = e; p.li = li++;
        hipLaunchKernelGGL(mega_fwd, dim3(grid), dim3(NTHR), LDS_BYTES, stream, p);
        ph = e;
    }
}
```

```cpp
#define OPT_MASK 0x345ACu
#include <hip/hip_runtime.h>
#include <cstdint>
#include <cstdio>

constexpr int BATCH = 8, SEQ = 4096, DM = 1024, CTXL = 256;
constexpr int NLAT = BATCH * SEQ, NCTX = BATCH * CTXL, NTOK = NLAT + NCTX;
constexpr float ALPHA = 1.4142135623730951f;
constexpr float LN_EPS = 1e-5f;
constexpr float LAMBDA_INIT0 = 0.2f;
constexpr float C2 = 0.125f * 1.4426950408889634f;
constexpr int NEXP = 16, DEXP = 512, MAXSLOT = 73728;
constexpr int NCHUNK = NTOK / 64;
constexpr int NIN = 3328;

typedef unsigned short bf16;
typedef float f32x4 __attribute__((ext_vector_type(4)));
typedef float f32x2 __attribute__((ext_vector_type(2)));
typedef unsigned u32x2 __attribute__((ext_vector_type(2)));
typedef unsigned u32x4 __attribute__((ext_vector_type(4)));

constexpr size_t MiB = 1u << 20;
constexpr size_t WS_CTL = 0, CTL_ZERO_BYTES = 1 * MiB;
constexpr size_t WS_MOD = 1 * MiB;
constexpr size_t WS_MISC = 1 * MiB + 512 * 1024;
constexpr size_t WS_WQKV = 2 * MiB, WS_WO = 8 * MiB, WS_GU0 = 10 * MiB, WS_DN0 = 42 * MiB;
constexpr size_t WS_XCTX = 58 * MiB;
constexpr size_t WS_WIN = 66 * MiB, WS_WGO = 73 * MiB, WS_GU1 = 75 * MiB, WS_DN1 = 107 * MiB;
constexpr size_t WS_H = 123 * MiB;
constexpr size_t WS_Q = 191 * MiB, WS_K = 259 * MiB, WS_V = 327 * MiB, WS_O2 = 395 * MiB;
constexpr size_t WS_LIST = 463 * MiB;
constexpr size_t WS_TOKR = 466 * MiB;
constexpr size_t WS_DEC = 468 * MiB;
constexpr size_t WS_ZZ = 471 * MiB;
constexpr size_t WS_END = 480 * MiB;
constexpr size_t WS_O1 = WS_H, WS_A2 = WS_Q, WS_Y = WS_K;
constexpr size_t WS_YM = 191 * MiB, WS_ACT = 335 * MiB;
constexpr size_t WS_QR = 191 * MiB, WS_KR = 225 * MiB, WS_V1 = 259 * MiB, WS_R = 327 * MiB;
constexpr size_t WS_QT = WS_H, WS_KT = 395 * MiB;
constexpr size_t WS_OGF = 191 * MiB, WS_OGB = 2 * MiB;
constexpr size_t WS_A2B = WS_H;
constexpr int CW_TMO = 0, CW_CODE = 1;
constexpr int CW_CNT = 64;
constexpr int CW_BAR = 4096;

__device__ __forceinline__ unsigned f2bf(float f) { unsigned u = __builtin_bit_cast(unsigned, f); return (u + 0x7fffu + ((u >> 16) & 1u)) >> 16; }
__device__ __forceinline__ unsigned pk2(float lo, float hi) { return f2bf(lo) | (f2bf(hi) << 16); }
__device__ __forceinline__ float bf2f(unsigned b) { return __builtin_bit_cast(float, b << 16); }
__device__ __forceinline__ float wave_sum(float v) {
#pragma unroll
    for (int o = 1; o < 64; o <<= 1) v += __shfl_xor(v, o);
    return v;
}
__device__ __forceinline__ float silu_f(float v) { return v / (1.f + __expf(-v)); }

struct Prm {
    const float *x, *c, *ctx, *cctx, *ada_w, *ada_b, *ln_g, *ln_b, *w_qkv, *w_o, *lam, *subln, *gw_in, *gwg_down, *gwg_up, *gbg, *gnorm, *gw_o, *rw, *rb, *mg, *mu, *md;
    float* out; unsigned char* ws;
    int ph_lo, ph_hi, li, pad;
};
__device__ __forceinline__ void ld_row_f32(const float* p, int lane, f32x4 (&v)[4]) {
#pragma unroll
    for (int j = 0; j < 4; ++j) v[j] = *(const f32x4*)(p + 4 * lane + 256 * j);
}
__device__ __forceinline__ void st_row_f32(float* p, int lane, const f32x4 (&v)[4]) {
#pragma unroll
    for (int j = 0; j < 4; ++j) *(f32x4*)(p + 4 * lane + 256 * j) = v[j];
}
__device__ __forceinline__ void ld_row_bf16(const bf16* p, int lane, f32x4 (&v)[4]) {
#pragma unroll
    for (int j = 0; j < 4; ++j) { const u32x2 u = *(const u32x2*)(p + 4 * lane + 256 * j); v[j] = (f32x4){bf2f(u.x & 0xffffu), bf2f(u.x >> 16), bf2f(u.y & 0xffffu), bf2f(u.y >> 16)}; }
}
__device__ __forceinline__ void st_row_bf16(bf16* p, int lane, const f32x4 (&v)[4]) {
#pragma unroll
    for (int j = 0; j < 4; ++j) { u32x2 u; u.x = pk2(v[j].x, v[j].y); u.y = pk2(v[j].z, v[j].w); *(u32x2*)(p + 4 * lane + 256 * j) = u; }
}
__device__ __forceinline__ void ln_row(f32x4 (&v)[4], const float* g, const float* b, int lane) {
    float s = 0.f;
#pragma unroll
    for (int j = 0; j < 4; ++j) s += (v[j].x + v[j].y) + (v[j].z + v[j].w);
    const float mean = wave_sum(s) * (1.f / DM); float q = 0.f;
#pragma unroll
    for (int j = 0; j < 4; ++j) { v[j] = v[j] - mean; q += (v[j].x * v[j].x + v[j].y * v[j].y) + (v[j].z * v[j].z + v[j].w * v[j].w); }
    const float rstd = 1.f / sqrtf(wave_sum(q) * (1.f / DM) + LN_EPS);
#pragma unroll
    for (int j = 0; j < 4; ++j) { const f32x4 gg = *(const f32x4*)(g + 4 * lane + 256 * j), bb = *(const f32x4*)(b + 4 * lane + 256 * j); v[j] = v[j] * rstd * gg + bb; }
}
__host__ __device__ __forceinline__ int gu_phys(int other, int sel) { return (other >> 4) * 32 + sel * 16 + (other & 15); }
#define GAS __attribute__((address_space(1)))
#define LAS __attribute__((address_space(3)))
constexpr int NWAVES = 8, NTHR = NWAVES * 64;
constexpr int RING_BYTES = 131072, LDSCTL_OFF = RING_BYTES, MISC_OFF = LDSCTL_OFF + 320, LDS_BYTES = 147456;
constexpr int LDSX_OFF = RING_BYTES + 1024;
#define LDS_WAIT() asm volatile("s_waitcnt lgkmcnt(0)" ::: "memory")
#define VM_WAIT() asm volatile("s_waitcnt vmcnt(0)" ::: "memory")

struct Frame {
    unsigned char* lds;
    unsigned* ctl;
    int tid, lane, wave, G, bid;
};

template <int MODE>
__device__ __forceinline__ void p0_transpose_item(const float* W, int K, int N, bf16* WT, int row_off, float* scr, int item, int lane) {
    const int nblk = N / 32, kb = item / nblk, nb = item % nblk, k0 = 64 * kb, n0 = 32 * nb;
#pragma unroll 8
    for (int i = 0; i < 32; ++i) { const int kk = 2 * i + (lane >> 5); scr[kk * 33 + (lane & 31)] = W[(size_t)(k0 + kk) * N + n0 + (lane & 31)]; }
    LDS_WAIT(); asm volatile("" ::: "memory");
    const int c = lane & 7;
#pragma unroll
    for (int j = 0; j < 4; ++j) { const int n = (lane >> 3) + 8 * j; const float* s = scr + (8 * c) * 33 + n;
        u32x4 o; o.x = pk2(s[0 * 33], s[1 * 33]); o.y = pk2(s[2 * 33], s[3 * 33]); o.z = pk2(s[4 * 33], s[5 * 33]); o.w = pk2(s[6 * 33], s[7 * 33]);
        const int nl = n0 + n; const int pr = (MODE == 0) ? (row_off + nl) : (row_off + gu_phys(nl, MODE - 1));
        *(u32x4*)(WT + (size_t)pr * K + k0 + 8 * c) = o; }
    LDS_WAIT(); asm volatile("" ::: "memory");
}
__device__ __forceinline__ void phase_prologue(const Frame& F, const Prm& p) {
    float* sil = (float*)F.lds;
    for (int i = F.tid; i < 9 * 1024; i += NTHR) { const int r = i >> 10, k = i & 1023; const float v = (r < 8) ? p.c[r * 1024 + k] : p.cctx[k]; sil[i] = silu_f(v); }
    __syncthreads();
    float* MOD = (float*)(p.ws + WS_MOD);
    if (F.wave == 0 && F.bid < 192) {
        const int layer = F.bid / 96, n = (F.bid % 96) * 64 + F.lane; const float* W = p.ada_w + (size_t)layer * 1024 * 6144 + n;
        float acc[9];
#pragma unroll
        for (int r = 0; r < 9; ++r) acc[r] = 0.f;
#pragma unroll 4
        for (int k = 0; k < 1024; k += 4) {
            const float w0 = W[(size_t)k * 6144], w1 = W[(size_t)(k + 1) * 6144], w2 = W[(size_t)(k + 2) * 6144], w3 = W[(size_t)(k + 3) * 6144];
#pragma unroll
            for (int r = 0; r < 9; ++r) { const f32x4 s = *(const f32x4*)(sil + r * 1024 + k); acc[r] += s.x * w0 + s.y * w1 + s.z * w2 + s.w * w3; }
        }
        const float bb = p.ada_b[layer * 6144 + n];
#pragma unroll
        for (int r = 0; r < 9; ++r) MOD[(layer * 9 + r) * 6144 + n] = acc[r] + bb;
    }
    float* misc = (float*)(p.ws + WS_MISC);
    if (F.bid == 255 % F.G && F.wave == 1) {
        const float a = wave_sum(p.lam[F.lane] * p.lam[64 + F.lane]), b = wave_sum(p.lam[128 + F.lane] * p.lam[192 + F.lane]);
        if (F.lane == 0) misc[0] = __expf(a) - __expf(b) + LAMBDA_INIT0;
        for (int i = F.lane; i < 1024; i += 64) { const int pos = i >> 4, f = i & 15; const float inv = powf(10000.f, -(float)f / 16.f); const float ang = (float)pos * inv;
            misc[1024 + 2 * i] = cosf(ang); misc[1024 + 2 * i + 1] = sinf(ang); }
    }
    float* scr = (float*)(F.lds + 36864 + F.wave * 8704);
    const int gw = F.bid * NWAVES + F.wave, NGW = F.G * NWAVES;
    constexpr int I_QKV = 16 * 96, I_SQ = 16 * 32, I_G = 16 * 16, I_D = 8 * 32;
    constexpr int I_MOE = 2 * I_G + I_D;
    constexpr int NITEMS = 2 * I_QKV + 2 * I_SQ + 32 * I_MOE;
    bf16* ws16 = (bf16*)p.ws;
    for (int it = gw; it < NITEMS; it += NGW) {
        int r = it;
        if (r < I_QKV) { p0_transpose_item<0>(p.w_qkv, 1024, 3072, (bf16*)(p.ws + WS_WQKV), 0, scr, r, F.lane); continue; } r -= I_QKV;
        if (r < I_QKV) { p0_transpose_item<0>(p.gw_in, 1024, 3072, (bf16*)(p.ws + WS_WIN), 0, scr, r, F.lane); continue; } r -= I_QKV;
        if (r < I_SQ) { p0_transpose_item<0>(p.w_o, 1024, 1024, (bf16*)(p.ws + WS_WO), 0, scr, r, F.lane); continue; } r -= I_SQ;
        if (r < I_SQ) { p0_transpose_item<0>(p.gw_o, 1024, 1024, (bf16*)(p.ws + WS_WGO), 0, scr, r, F.lane); continue; } r -= I_SQ;
        const int le = r / I_MOE, layer = le >> 4, e = le & 15; r -= le * I_MOE;
        bf16* GU = (bf16*)(p.ws + (layer ? WS_GU1 : WS_GU0)) + (size_t)e * 1024 * 1024; bf16* DN = (bf16*)(p.ws + (layer ? WS_DN1 : WS_DN0)) + (size_t)e * 1024 * 512;
        if (r < I_G) { p0_transpose_item<1>(p.mg + (size_t)le * 1024 * 512, 1024, 512, GU, 0, scr, r, F.lane); continue; } r -= I_G;
        if (r < I_G) { p0_transpose_item<2>(p.mu + (size_t)le * 1024 * 512, 1024, 512, GU, 0, scr, r, F.lane); continue; } r -= I_G;
        p0_transpose_item<0>(p.md + (size_t)le * 512 * 1024, 512, 1024, DN, 0, scr, r, F.lane);
    }
    (void)ws16;
    bf16* WIN = (bf16*)(p.ws + WS_WIN);
    for (int i = gw * 64 + F.lane; i < 32 * 1024; i += NGW * 64) { const int rr = i >> 10, k = i & 1023, dir = rr >> 4, j = rr & 15;
        WIN[(size_t)(3072 + rr) * 1024 + k] = (bf16)f2bf(p.gwg_down[(size_t)dir * 1024 * 16 + k * 16 + j]); }
    for (int i = gw * 64 + F.lane; i < 224 * 1024 / 8; i += NGW * 64) *(u32x4*)(WIN + (size_t)3104 * 1024 + (size_t)i * 8) = (u32x4){0u, 0u, 0u, 0u};
}

__device__ __forceinline__ void phase_modulate0(const Frame& F, const Prm& p) {
    const float* MOD = (const float*)(p.ws + WS_MOD); bf16* H = (bf16*)(p.ws + WS_H);
    const int gw = F.bid * NWAVES + F.wave, NGW = F.G * NWAVES, per = (NTOK + NGW - 1) / NGW;
    int curmod = -1; f32x4 sh[4], sc[4];
    for (int tok = gw * per; tok < (gw + 1) * per && tok < NTOK; ++tok) {
        const int mr = tok < NLAT ? tok / SEQ : 8; const float* src = tok < NLAT ? p.x + (size_t)tok * DM : p.ctx + (size_t)(tok - NLAT) * DM;
        if (mr != curmod) { curmod = mr; ld_row_f32(MOD + mr * 6144, F.lane, sh); ld_row_f32(MOD + mr * 6144 + 1024, F.lane, sc); }
        f32x4 v[4]; ld_row_f32(src, F.lane, v);
#pragma unroll
        for (int j = 0; j < 4; ++j) v[j] = v[j] * (1.f + sc[j]) + sh[j];
        st_row_bf16(H + (size_t)tok * DM, F.lane, v);
    }
}

__device__ __forceinline__ void phase_attn_combine(const Frame& F, const Prm& p) {
    const bf16* O1 = (const bf16*)(p.ws + WS_O1); const bf16* O2 = (const bf16*)(p.ws + WS_O2); bf16* A2 = (bf16*)(p.ws + WS_A2);
    const float lam = ((const float*)(p.ws + WS_MISC))[0];
    const f32x4 sg = *(const f32x4*)(p.subln + 4 * (F.lane & 31));
    const int gw = F.bid * NWAVES + F.wave, NGW = F.G * NWAVES;
    for (int tok = gw; tok < NTOK; tok += NGW) {
        f32x4 a[4], b[4]; ld_row_bf16(O1 + (size_t)tok * DM, F.lane, a); ld_row_bf16(O2 + (size_t)tok * DM, F.lane, b);
#pragma unroll
        for (int j = 0; j < 4; ++j) {
            f32x4 o = a[j] - lam * b[j]; float q = (o.x * o.x + o.y * o.y) + (o.z * o.z + o.w * o.w);
#pragma unroll
            for (int s = 1; s < 32; s <<= 1) q += __shfl_xor(q, s);
            const float r = (1.f - LAMBDA_INIT0) / sqrtf(q * (1.f / 128.f) + LN_EPS);
            a[j] = o * r * sg;
        }
        st_row_bf16(A2 + (size_t)tok * DM, F.lane, a);
    }
}

__device__ __forceinline__ void phase_ln_route(const Frame& F, const Prm& p, int layer) {
    const int nrows = layer ? NLAT : NTOK;
    const float* MOD = (const float*)(p.ws + WS_MOD) + layer * 9 * 6144;
    const bf16* Y = (const bf16*)(p.ws + WS_Y); bf16* HF = (bf16*)(p.ws + WS_H);
    float* XCTX = (float*)(p.ws + WS_XCTX);
    int* LIST = (int*)(p.ws + WS_LIST); int* TOKR = (int*)(p.ws + WS_TOKR);
    unsigned* CNT = F.ctl + CW_CNT + layer * 16;
    float* WrT = (float*)F.lds;
    int* rec = (int*)(F.lds + 65536);
    unsigned* lcnt = (unsigned*)(F.lds + 65536 + 8192); unsigned* lbase = lcnt + 16;
    for (int i = F.tid; i < 16 * 1024; i += NTHR) { const int k = i >> 4, e = i & 15; WrT[e * 1024 + k] = p.rw[i]; }
    if (F.tid < 16) lcnt[F.tid] = 0u;
    __syncthreads();
    const int per_wg = (nrows + F.G - 1) / F.G, per_w = (per_wg + NWAVES - 1) / NWAVES;
    const int row_lo = F.bid * per_wg, row_hi = min(nrows, row_lo + per_wg);
    const float* lng = p.ln_g + (layer * 2 + 0) * DM; const float* lnb = p.ln_b + (layer * 2 + 0) * DM;
    float rb[16];
#pragma unroll
    for (int e = 0; e < 16; ++e) rb[e] = p.rb[e];
    int curmod = -1; f32x4 gm[4], shf[4], scf[4];
    for (int i = 0; i < per_w; ++i) {
        const int lr = F.wave * per_w + i, tok = row_lo + lr; if (tok >= row_hi) break;
        const int mr = tok < NLAT ? tok / SEQ : 8;
        if (mr != curmod) { curmod = mr; ld_row_f32(MOD + mr * 6144 + 2048, F.lane, gm); ld_row_f32(MOD + mr * 6144 + 3072, F.lane, shf); ld_row_f32(MOD + mr * 6144 + 4096, F.lane, scf); }
        float* xdst = tok < NLAT ? p.out + (size_t)tok * DM : XCTX + (size_t)(tok - NLAT) * DM;
        const float* xsrc = layer ? (const float*)xdst : (tok < NLAT ? p.x + (size_t)tok * DM : p.ctx + (size_t)(tok - NLAT) * DM);
        f32x4 v[4], y[4]; ld_row_f32(xsrc, F.lane, v); ld_row_bf16(Y + (size_t)tok * DM, F.lane, y);
#pragma unroll
        for (int j = 0; j < 4; ++j) v[j] = ALPHA * v[j] + gm[j] * y[j];
        ln_row(v, lng, lnb, F.lane);
        st_row_f32(xdst, F.lane, v);
#pragma unroll
        for (int j = 0; j < 4; ++j) v[j] = v[j] * (1.f + scf[j]) + shf[j];
        st_row_bf16(HF + (size_t)tok * DM, F.lane, v);
        float part[16];
#pragma unroll
        for (int e = 0; e < 16; ++e) { float s = 0.f;
#pragma unroll
            for (int j = 0; j < 4; ++j) { const f32x4 w = *(const f32x4*)(WrT + e * 1024 + 4 * F.lane + 256 * j); s += (v[j].x * w.x + v[j].y * w.y) + (v[j].z * w.z + v[j].w * w.w); }
            part[e] = s; }
        {
#pragma unroll
            for (int e = 0; e < 8; ++e) { const bool up = (F.lane & 32) != 0; const float keep = up ? part[e + 8] : part[e], send = up ? part[e] : part[e + 8]; part[e] = keep + __shfl_xor(send, 32); }
#pragma unroll
            for (int e = 0; e < 4; ++e) { const bool up = (F.lane & 16) != 0; const float keep = up ? part[e + 4] : part[e], send = up ? part[e] : part[e + 4]; part[e] = keep + __shfl_xor(send, 16); }
#pragma unroll
            for (int e = 0; e < 2; ++e) { const bool up = (F.lane & 8) != 0; const float keep = up ? part[e + 2] : part[e], send = up ? part[e] : part[e + 2]; part[e] = keep + __shfl_xor(send, 8); }
            { const bool up = (F.lane & 4) != 0; const float keep = up ? part[1] : part[0], send = up ? part[0] : part[1]; part[0] = keep + __shfl_xor(send, 4); }
            part[0] += __shfl_xor(part[0], 2); part[0] += __shfl_xor(part[0], 1);
        }
        float aff[16], sel[16];
#pragma unroll
        for (int e = 0; e < 16; ++e) { const int src = ((e >> 3) & 1) * 32 + ((e >> 2) & 1) * 16 + ((e >> 1) & 1) * 8 + (e & 1) * 4; const float lg = __shfl(part[0], src); aff[e] = 1.f / (1.f + __expf(-lg)); sel[e] = aff[e] + rb[e]; }
        int bg = 0; float bgs = -3.0e38f;
#pragma unroll
        for (int g = 0; g < 4; ++g) { float m1 = -3.0e38f, m2 = -3.0e38f;
#pragma unroll
            for (int k = 0; k < 4; ++k) { const float s = sel[4 * g + k]; if (s > m1) { m2 = m1; m1 = s; } else if (s > m2) m2 = s; }
            const float gs = m1 + m2; if (gs > bgs) { bgs = gs; bg = g; } }
        int i1 = 0, i2 = 0; float s1 = -3.0e38f, s2 = -3.0e38f, a1 = 0.f, a2 = 0.f;
#pragma unroll
        for (int g = 0; g < 4; ++g) if (g == bg) {
#pragma unroll
            for (int k = 0; k < 4; ++k) { const float s = sel[4 * g + k], a = aff[4 * g + k];
                if (s > s1) { s2 = s1; i2 = i1; a2 = a1; s1 = s; i1 = 4 * g + k; a1 = a; } else if (s > s2) { s2 = s; i2 = 4 * g + k; a2 = a; } } }
        const float wsum = a1 + a2, w1 = a1 / wsum, w2 = a2 / wsum;
        if (F.lane == 0) { const unsigned l1 = atomicAdd(&lcnt[i1], 1u), l2 = atomicAdd(&lcnt[i2], 1u);
            rec[lr * 6 + 0] = i1; rec[lr * 6 + 1] = i2; rec[lr * 6 + 2] = (int)l1; rec[lr * 6 + 3] = (int)l2; rec[lr * 6 + 4] = __float_as_int(w1); rec[lr * 6 + 5] = __float_as_int(w2); }
    }
    __syncthreads();
    if (F.tid < 16) lbase[F.tid] = __hip_atomic_fetch_add(&CNT[F.tid], lcnt[F.tid], __ATOMIC_RELAXED, __HIP_MEMORY_SCOPE_AGENT);
    __syncthreads();
    for (int lr = F.tid; lr < row_hi - row_lo; lr += NTHR) { const int tok = row_lo + lr;
        const int e0 = rec[lr * 6], e1 = rec[lr * 6 + 1]; const int p0 = (int)lbase[e0] + rec[lr * 6 + 2], p1 = (int)lbase[e1] + rec[lr * 6 + 3];
        LIST[e0 * NTOK + p0] = tok; LIST[e1 * NTOK + p1] = tok;
        int* tr = TOKR + (size_t)tok * 8; tr[0] = e0; tr[1] = p0; tr[2] = e1; tr[3] = p1; tr[4] = rec[lr * 6 + 4]; tr[5] = rec[lr * 6 + 5]; }
    __syncthreads();
}

__device__ __forceinline__ void pad_bases(const unsigned* cnt, int (&pb)[17]) {
    int acc = 0;
#pragma unroll
    for (int e = 0; e < 16; ++e) { pb[e] = acc; const int c = (int)__hip_atomic_load(cnt + e, __ATOMIC_RELAXED, __HIP_MEMORY_SCOPE_AGENT); acc += (c + 255) & ~255; }
    pb[16] = acc;
}

__device__ __forceinline__ void phase_moe_combine(const Frame& F, const Prm& p, int layer) {
    const int nrows = layer ? NLAT : NTOK;
    const float* MOD = (const float*)(p.ws + WS_MOD) + layer * 9 * 6144; const float* MOD1 = (const float*)(p.ws + WS_MOD) + 9 * 6144;
    const bf16* YM = (const bf16*)(p.ws + WS_YM); bf16* H = (bf16*)(p.ws + WS_H); float* XCTX = (float*)(p.ws + WS_XCTX); const int* TOKR = (const int*)(p.ws + WS_TOKR);
    int pb[17]; pad_bases(F.ctl + CW_CNT + layer * 16, pb);
    int* pbl = (int*)F.lds; if (F.tid < 17) { int v = 0;
#pragma unroll
        for (int e = 0; e < 17; ++e) if (e == F.tid) v = pb[e];
        pbl[F.tid] = v; }
    __syncthreads();
    const float* lng = p.ln_g + (layer * 2 + 1) * DM; const float* lnb = p.ln_b + (layer * 2 + 1) * DM;
    const int gw = F.bid * NWAVES + F.wave, NGW = F.G * NWAVES, per = (nrows + NGW - 1) / NGW;
    int curmod = -1; f32x4 gf[4], sh1[4], sc1[4];
    for (int tok = gw * per; tok < (gw + 1) * per && tok < nrows; ++tok) {
        const int mr = tok < NLAT ? tok / SEQ : 8;
        if (mr != curmod) { curmod = mr; ld_row_f32(MOD + mr * 6144 + 5120, F.lane, gf); if (!layer) { ld_row_f32(MOD1 + mr * 6144, F.lane, sh1); ld_row_f32(MOD1 + mr * 6144 + 1024, F.lane, sc1); } }
        const int* tr = TOKR + (size_t)tok * 8; const int s0 = pbl[tr[0]] + tr[1], s1 = pbl[tr[2]] + tr[3]; const float w0 = __int_as_float(tr[4]), w1 = __int_as_float(tr[5]);
        float* xp = tok < NLAT ? p.out + (size_t)tok * DM : XCTX + (size_t)(tok - NLAT) * DM;
        f32x4 v[4], a[4], b[4]; ld_row_f32(xp, F.lane, v); ld_row_bf16(YM + (size_t)s0 * DM, F.lane, a); ld_row_bf16(YM + (size_t)s1 * DM, F.lane, b);
#pragma unroll
        for (int j = 0; j < 4; ++j) v[j] = ALPHA * v[j] + gf[j] * (w0 * a[j] + w1 * b[j]);
        ln_row(v, lng, lnb, F.lane);
        st_row_f32(xp, F.lane, v);
        if (!layer) {
#pragma unroll
            for (int j = 0; j < 4; ++j) v[j] = v[j] * (1.f + sc1[j]) + sh1[j];
            st_row_bf16(H + (size_t)tok * DM, F.lane, v);
        }
    }
}

__device__ __forceinline__ void phase_gla_prep(const Frame& F, const Prm& p) {
    const bf16* QR = (const bf16*)(p.ws + WS_QR); const bf16* KR = (const bf16*)(p.ws + WS_KR); const float* ZZ = (const float*)(p.ws + WS_ZZ);
    bf16* QT = (bf16*)(p.ws + WS_QT); bf16* KT = (bf16*)(p.ws + WS_KT); float* DEC = (float*)(p.ws + WS_DEC);
    const int gw = F.bid * NWAVES + F.wave, NGW = F.G * NWAVES;
    for (int task = gw; task < 2 * NCHUNK * 8; task += NGW) {
        const int dh = task & 7, chunk = (task >> 3) % NCHUNK, dir = task / (8 * NCHUNK);
        const int col = dh * 64 + F.lane, tok0 = chunk * 64;
        float wup[16];
#pragma unroll
        for (int j = 0; j < 16; ++j) wup[j] = p.gwg_up[(size_t)dir * 16 * 512 + j * 512 + col];
        const float bgv = p.gbg[dir * 512 + col];
        float b = 0.f;
#pragma unroll 4
        for (int tt = 0; tt < 64; ++tt) {
            const int t = dir ? 63 - tt : tt, tok = tok0 + t;
            const float* zr = ZZ + (size_t)tok * 32 + dir * 16; float z = bgv;
#pragma unroll
            for (int j = 0; j < 16; j += 4) { const f32x4 zv = *(const f32x4*)(zr + j); z += zv.x * wup[j] + zv.y * wup[j + 1] + zv.z * wup[j + 2] + zv.w * wup[j + 3]; }
            const float g = (fminf(z, 0.f) - log1pf(__expf(-fabsf(z)))) * (1.f / 16.f);
            b += g;
            const float q = bf2f(QR[(size_t)tok * 512 + col]), k = bf2f(KR[(size_t)tok * 512 + col]);
            QT[((size_t)dir * NTOK + tok) * 512 + col] = (bf16)f2bf(q * __expf(b)); KT[((size_t)dir * NTOK + tok) * 512 + col] = (bf16)f2bf(k * __expf(-b));
        }
        DEC[((size_t)dir * NCHUNK + chunk) * 512 + col] = __expf(b);
    }
}

__device__ __forceinline__ void phase_gla_post(const Frame& F, const Prm& p) {
    const bf16* OF = (const bf16*)(p.ws + WS_OGF); const bf16* OB = (const bf16*)(p.ws + WS_OGB); const bf16* R = (const bf16*)(p.ws + WS_R); bf16* A2 = (bf16*)(p.ws + WS_A2B);
    const f32x4 ng = *(const f32x4*)(p.gnorm + 4 * F.lane);
    const int gw = F.bid * NWAVES + F.wave, NGW = F.G * NWAVES;
    for (int tok = gw; tok < NLAT; tok += NGW) {
        f32x4 a[4], b[4], r[4]; ld_row_bf16(OF + (size_t)tok * DM, F.lane, a); ld_row_bf16(OB + (size_t)tok * DM, F.lane, b); ld_row_bf16(R + (size_t)tok * DM, F.lane, r);
#pragma unroll
        for (int j = 0; j < 4; ++j) {
            const f32x4 o = a[j] + b[j]; const float q = wave_sum((o.x * o.x + o.y * o.y) + (o.z * o.z + o.w * o.w));
            const float rs = 1.f / sqrtf(q * (1.f / 256.f) + LN_EPS);
            a[j] = (f32x4){o.x * rs * ng.x * silu_f(r[j].x), o.y * rs * ng.y * silu_f(r[j].y), o.z * rs * ng.z * silu_f(r[j].z), o.w * rs * ng.w * silu_f(r[j].w)};
        }
        st_row_bf16(A2 + (size_t)tok * DM, F.lane, a);
    }
}
namespace naive {
enum { EPI_QKV = 0, EPI_PLAIN = 1, EPI_GATEUP = 2, EPI_DOWN = 3, EPI_INPROJ = 4 };
struct NG { const bf16* A; const bf16* Bt; int M, N, K; int layer; bf16* O; };
template <int EPI> __global__ __launch_bounds__(256) void gemm_kernel(NG g, Prm p) {
    __shared__ float As[64][33], Bs[64][33], Cs[64][65]; __shared__ int rowsrc[64];
    const int tid = threadIdx.x, n0 = blockIdx.x * 64, m0 = blockIdx.y * 64, ty = tid >> 4, tx = tid & 15;
    const bf16* Bt = g.Bt; int e = 0, ebase = 0, ecnt = 0;
    if (EPI == EPI_GATEUP || EPI == EPI_DOWN) {
        const unsigned* cnt = (const unsigned*)(p.ws + WS_CTL) + CW_CNT + g.layer * 16; int acc = 0; bool found = false;
        for (int i = 0; i < 16; ++i) { const int c = (int)cnt[i], pc = (c + 255) & ~255; if (!found && m0 < acc + pc) { e = i; ebase = acc; ecnt = c; found = true; } acc += pc; }
        if (!found || m0 - ebase >= ecnt) return;
        Bt += (size_t)e * g.N * g.K;
    }
    if (tid < 64) { int r = m0 + tid;
        if (EPI == EPI_GATEUP) { const int li = m0 - ebase + tid; const int* LIST = (const int*)(p.ws + WS_LIST); r = (li < ecnt) ? LIST[e * NTOK + li] : 0; }
        rowsrc[tid] = r; }
    __syncthreads();
    float acc[4][4] = {};
    for (int k0 = 0; k0 < g.K; k0 += 32) {
        { const int r = tid >> 2, kc = (tid & 3) * 8; const u32x4 ua = *(const u32x4*)(g.A + (size_t)rowsrc[r] * g.K + k0 + kc), ub = *(const u32x4*)(Bt + (size_t)(n0 + r) * g.K + k0 + kc);
            const unsigned a4[4] = {ua.x, ua.y, ua.z, ua.w}, b4[4] = {ub.x, ub.y, ub.z, ub.w};
#pragma unroll
            for (int i = 0; i < 4; ++i) { As[r][kc + 2 * i] = bf2f(a4[i] & 0xffffu); As[r][kc + 2 * i + 1] = bf2f(a4[i] >> 16); Bs[r][kc + 2 * i] = bf2f(b4[i] & 0xffffu); Bs[r][kc + 2 * i + 1] = bf2f(b4[i] >> 16); } }
        __syncthreads();
#pragma unroll 8
        for (int kk = 0; kk < 32; ++kk) { float a[4], b[4];
#pragma unroll
            for (int i = 0; i < 4; ++i) { a[i] = As[4 * ty + i][kk]; b[i] = Bs[4 * tx + i][kk]; }
#pragma unroll
            for (int i = 0; i < 4; ++i)
#pragma unroll
                for (int j = 0; j < 4; ++j) acc[i][j] += a[i] * b[j]; }
        __syncthreads();
    }
#pragma unroll
    for (int i = 0; i < 4; ++i)
#pragma unroll
        for (int j = 0; j < 4; ++j) Cs[4 * ty + i][4 * tx + j] = acc[i][j];
    __syncthreads();
    const float* rope = (const float*)(p.ws + WS_MISC) + 1024;
    for (int idx = tid; idx < 4096; idx += 256) {
        const int r = idx >> 6, cc = idx & 63, n = n0 + cc, row = m0 + r; const float val = Cs[r][cc];
        if (EPI == EPI_QKV) {
            if (n < 2048) { float o = val;
                if (row < NLAT) { const int d = n & 63, s = row & (SEQ - 1), pos = (d & 32) ? (s & 63) : (s >> 6), f = d & 15; const float cs = rope[(pos * 16 + f) * 2], sn = rope[(pos * 16 + f) * 2 + 1];
                    o = (d & 16) ? val * cs + Cs[r][cc - 16] * sn : val * cs - Cs[r][cc + 16] * sn; }
                if (n < 1024) ((bf16*)(p.ws + WS_Q))[(size_t)row * DM + n] = (bf16)f2bf(o * C2); else ((bf16*)(p.ws + WS_K))[(size_t)row * DM + n - 1024] = (bf16)f2bf(o);
            } else ((bf16*)(p.ws + WS_V))[(size_t)row * DM + n - 2048] = (bf16)f2bf(val);
        } else if (EPI == EPI_PLAIN) { g.O[(size_t)row * g.N + n] = (bf16)f2bf(val);
        } else if (EPI == EPI_GATEUP) { if (!(cc & 16)) { const float gt = val, up = Cs[r][cc + 16]; const int other = (n >> 5) * 16 + (n & 15); ((bf16*)(p.ws + WS_ACT))[(size_t)row * DEXP + other] = (bf16)f2bf(silu_f(gt) * up); }
        } else if (EPI == EPI_DOWN) { ((bf16*)(p.ws + WS_YM))[(size_t)row * DM + n] = (bf16)f2bf(val);
        } else if (EPI == EPI_INPROJ) {
            if (n < 512) ((bf16*)(p.ws + WS_QR))[(size_t)row * 512 + n] = (bf16)f2bf(val * 0.08838834764831845f);
            else if (n < 1024) ((bf16*)(p.ws + WS_KR))[(size_t)row * 512 + n - 512] = (bf16)f2bf(val);
            else if (n < 2048) ((bf16*)(p.ws + WS_V1))[(size_t)row * DM + n - 1024] = (bf16)f2bf(val);
            else if (n < 3072) ((bf16*)(p.ws + WS_R))[(size_t)row * DM + n - 2048] = (bf16)f2bf(val);
            else if (n < 3104) ((float*)(p.ws + WS_ZZ))[(size_t)row * 32 + n - 3072] = val;
        }
    }
}
__global__ __launch_bounds__(256) void attn_kernel(Prm p) {
    __shared__ float Qs[64][65], Ks[32][65], Ps[64][33], Vs[32][129], al[64];
    const bf16* Q = (const bf16*)(p.ws + WS_Q); const bf16* K = (const bf16*)(p.ws + WS_K); const bf16* V = (const bf16*)(p.ws + WS_V);
    const int tid = threadIdx.x, ty = tid >> 4, tx = tid & 15, qb = blockIdx.x, hm = blockIdx.y, h = hm >> 1;
    const bool lat = qb < 512; const int b = lat ? qb >> 6 : (qb - 512) >> 2; const int tok0 = lat ? qb * 64 : NLAT + (qb - 512) * 64;
    bf16* O = (bf16*)(p.ws + ((hm & 1) ? WS_O2 : WS_O1));
    for (int i = tid; i < 4096; i += 256) { const int r = i >> 6, d = i & 63; Qs[r][d] = bf2f(Q[(size_t)(tok0 + r) * DM + hm * 64 + d]); }
    float o[4][8] = {}; float mrow = -3.0e38f, lrow = 0.f;
    const int nkt = lat ? (CTXL + SEQ) / 32 : CTXL / 32;
    for (int kt = 0; kt < nkt; ++kt) {
        const int key0 = (kt < CTXL / 32) ? NLAT + b * CTXL + kt * 32 : b * SEQ + (kt - CTXL / 32) * 32;
        __syncthreads();
        for (int i = tid; i < 2048; i += 256) { const int r = i >> 6, d = i & 63; Ks[r][d] = bf2f(K[(size_t)(key0 + r) * DM + hm * 64 + d]); }
        for (int i = tid; i < 4096; i += 256) { const int r = i >> 7, d = i & 127; Vs[r][d] = bf2f(V[(size_t)(key0 + r) * DM + h * 128 + d]); }
        __syncthreads();
        float s[4][2] = {};
        for (int d = 0; d < 64; ++d) { float a[4], bb[2];
#pragma unroll
            for (int i = 0; i < 4; ++i) a[i] = Qs[4 * ty + i][d];
            bb[0] = Ks[2 * tx][d]; bb[1] = Ks[2 * tx + 1][d];
#pragma unroll
            for (int i = 0; i < 4; ++i) { s[i][0] += a[i] * bb[0]; s[i][1] += a[i] * bb[1]; } }
#pragma unroll
        for (int i = 0; i < 4; ++i) { Ps[4 * ty + i][2 * tx] = s[i][0]; Ps[4 * ty + i][2 * tx + 1] = s[i][1]; }
        __syncthreads();
        if (tid < 64) { float mx = mrow;
            for (int j = 0; j < 32; ++j) mx = fmaxf(mx, Ps[tid][j]);
            const float a = exp2f(mrow - mx); float sum = 0.f;
            for (int j = 0; j < 32; ++j) { const float e = exp2f(Ps[tid][j] - mx); Ps[tid][j] = e; sum += e; }
            lrow = lrow * a + sum; mrow = mx; al[tid] = a; }
        __syncthreads();
#pragma unroll
        for (int i = 0; i < 4; ++i) { const float a = al[4 * ty + i];
#pragma unroll
            for (int j = 0; j < 8; ++j) o[i][j] *= a; }
        for (int kk = 0; kk < 32; ++kk) { float pv[4], vv[8];
#pragma unroll
            for (int i = 0; i < 4; ++i) pv[i] = Ps[4 * ty + i][kk];
#pragma unroll
            for (int j = 0; j < 8; ++j) vv[j] = Vs[kk][8 * tx + j];
#pragma unroll
            for (int i = 0; i < 4; ++i)
#pragma unroll
                for (int j = 0; j < 8; ++j) o[i][j] += pv[i] * vv[j]; }
    }
    __syncthreads();
    if (tid < 64) al[tid] = 1.f / lrow;
    __syncthreads();
#pragma unroll
    for (int i = 0; i < 4; ++i) { const float a = al[4 * ty + i];
#pragma unroll
        for (int j = 0; j < 8; ++j) O[(size_t)(tok0 + 4 * ty + i) * DM + h * 128 + 8 * tx + j] = (bf16)f2bf(o[i][j] * a); }
}
__global__ __launch_bounds__(256) void gla_scan_kernel(Prm p) {
    extern __shared__ __attribute__((aligned(16))) unsigned char sm[];
    float (*S)[33] = (float (*)[33])sm;
    float (*Qs)[129] = (float (*)[129])(sm + 128 * 33 * 4);
    float (*Ks)[129] = (float (*)[129])(sm + 128 * 33 * 4 + 64 * 129 * 4);
    float (*Vs)[33] = (float (*)[33])(sm + 128 * 33 * 4 + 2 * 64 * 129 * 4);
    float (*Ps)[65] = (float (*)[65])(sm + 128 * 33 * 4 + 2 * 64 * 129 * 4 + 64 * 33 * 4);
    float* dec = (float*)(sm + 128 * 33 * 4 + 2 * 64 * 129 * 4 + 64 * 33 * 4 + 64 * 65 * 4);
    const bf16* QT = (const bf16*)(p.ws + WS_QT); const bf16* KT = (const bf16*)(p.ws + WS_KT); const bf16* V = (const bf16*)(p.ws + WS_V1); const float* DEC = (const float*)(p.ws + WS_DEC);
    const int tid = threadIdx.x, ty = tid >> 4, tx = tid & 15, vs = blockIdx.x & 7, dir = (blockIdx.x >> 3) & 1, h = (blockIdx.x >> 4) & 3, b = blockIdx.x >> 6;
    bf16* OG = (bf16*)(p.ws + (dir ? WS_OGB : WS_OGF));
    for (int i = tid; i < 128 * 32; i += 256) S[i >> 5][i & 31] = 0.f;
    for (int step = 0; step < 68; ++step) {
        const bool lat = step >= 4; const int ci = lat ? step - 4 : step;
        const int chunk = lat ? b * 64 + (dir ? 63 - ci : ci) : 512 + b * 4 + (dir ? 3 - ci : ci); const int tok0 = chunk * 64;
        __syncthreads();
        for (int i = tid; i < 64 * 128; i += 256) { const int t = i >> 7, d = i & 127; const size_t off = ((size_t)dir * NTOK + tok0 + t) * 512 + h * 128 + d; Qs[t][d] = bf2f(QT[off]); Ks[t][d] = bf2f(KT[off]); }
        for (int i = tid; i < 64 * 32; i += 256) { const int t = i >> 5, v = i & 31; Vs[t][v] = bf2f(V[(size_t)(tok0 + t) * DM + h * 256 + vs * 32 + v]); }
        if (tid < 128) dec[tid] = DEC[((size_t)dir * NCHUNK + chunk) * 512 + h * 128 + tid];
        __syncthreads();
        if (lat) {
            float s[4][4] = {};
            for (int d = 0; d < 128; ++d) { float a[4], bb[4];
#pragma unroll
                for (int i = 0; i < 4; ++i) { a[i] = Qs[4 * ty + i][d]; bb[i] = Ks[4 * tx + i][d]; }
#pragma unroll
                for (int i = 0; i < 4; ++i)
#pragma unroll
                    for (int j = 0; j < 4; ++j) s[i][j] += a[i] * bb[j]; }
#pragma unroll
            for (int i = 0; i < 4; ++i)
#pragma unroll
                for (int j = 0; j < 4; ++j) { const int t = 4 * ty + i, sidx = 4 * tx + j; const bool keep = dir ? (sidx >= t) : (sidx <= t); Ps[t][sidx] = keep ? s[i][j] : 0.f; }
            __syncthreads();
            float o[4][2] = {};
            for (int sidx = 0; sidx < 64; ++sidx) { const float v0 = Vs[sidx][2 * tx], v1 = Vs[sidx][2 * tx + 1];
#pragma unroll
                for (int i = 0; i < 4; ++i) { const float pp = Ps[4 * ty + i][sidx]; o[i][0] += pp * v0; o[i][1] += pp * v1; } }
            for (int d = 0; d < 128; ++d) { const float s0 = S[d][2 * tx], s1 = S[d][2 * tx + 1];
#pragma unroll
                for (int i = 0; i < 4; ++i) { const float qq = Qs[4 * ty + i][d]; o[i][0] += qq * s0; o[i][1] += qq * s1; } }
#pragma unroll
            for (int i = 0; i < 4; ++i) { const size_t off = (size_t)(tok0 + 4 * ty + i) * DM + h * 256 + vs * 32 + 2 * tx; OG[off] = (bf16)f2bf(o[i][0]); OG[off + 1] = (bf16)f2bf(o[i][1]); }
            __syncthreads();
        }
        float u[8][2] = {};
        for (int sidx = 0; sidx < 64; ++sidx) { const float v0 = Vs[sidx][2 * tx], v1 = Vs[sidx][2 * tx + 1];
#pragma unroll
            for (int i = 0; i < 8; ++i) { const float kk = Ks[sidx][8 * ty + i]; u[i][0] += kk * v0; u[i][1] += kk * v1; } }
#pragma unroll
        for (int i = 0; i < 8; ++i) { const int d = 8 * ty + i; S[d][2 * tx] = dec[d] * (S[d][2 * tx] + u[i][0]); S[d][2 * tx + 1] = dec[d] * (S[d][2 * tx + 1] + u[i][1]); }
    }
}
constexpr int GLA_SCAN_LDS = 128 * 33 * 4 + 2 * 64 * 129 * 4 + 64 * 33 * 4 + 64 * 65 * 4 + 512;
}
namespace pg8 {
typedef short bf16x8 __attribute__((ext_vector_type(8)));
constexpr int BM = 256, BK = 64, HALF = 128, HTB = HALF * BK * 2, STAGE_BYTES = 8 * HTB, NXCD = 8, WGM = 8;
__host__ __device__ __forceinline__ int lds_byte(int r, int c) { const int st = (r >> 4) * 2 + (c >> 5), rr = r & 15, cc = c & 31, ob = rr * 64 + cc * 2; return st * 1024 + (ob ^ (((ob >> 9) & 1) << 5)); }
__host__ __device__ __forceinline__ void stage_rc(int b, int& R, int& C) { const int st = b / 1024, sb = b % 1024, swz = sb ^ (((sb >> 9) & 1) << 5); R = (st >> 1) * 16 + swz / 64; C = (st & 1) * 32 + (swz % 64) / 2; }
__device__ __forceinline__ unsigned cvt_pk_bf16(float lo, float hi) { unsigned r; asm volatile("v_cvt_pk_bf16_f32 %0, %1, %2" : "=v"(r) : "v"(lo), "v"(hi)); return r; }

struct Unit { int pm, pn; int row0; int e; int cnt; const bf16* Bt; };

struct DenseOrder {
    int nM, nN, nwg, G, c, K; const bf16* Bt;
    __device__ void init(int M, int N, int K_, const bf16* Bt_, int G_, int c_) { nM = M / BM; nN = N / BM; nwg = nM * nN; G = G_; c = c_; K = K_; Bt = Bt_; }
    __device__ bool next(int i, Unit& u) const {
        const long L = (long)i * G + c; if (L >= nwg) return false;
        int wgid = (int)L; { const int q = nwg / NXCD, r = nwg % NXCD, xcd = wgid % NXCD, off = wgid / NXCD; wgid = (xcd < r ? xcd * (q + 1) : r * (q + 1) + (xcd - r) * q) + off; }
        const int nig = WGM * nN, gid = wgid / nig, fm = gid * WGM, gsz = (nM - fm) < WGM ? (nM - fm) : WGM;
        u.pm = fm + ((wgid % nig) % gsz); u.pn = (wgid % nig) / gsz; u.row0 = u.pm * BM; u.e = 0; u.cnt = 0; u.Bt = Bt; return true;
    }
    __device__ __forceinline__ unsigned arow(const Unit& u, int r) const { return (unsigned)(u.row0 + r) * (unsigned)(K * 2); }
};
template <bool GATHER> struct MoeOrder {
    int cnt[16]; int nN, G, c, K; const bf16* Bt0; size_t bstride; const int* LIST;
    __device__ void init(const unsigned* cntw, int N, int K_, const bf16* Bt0_, const int* LIST_, int G_, int c_) {
#pragma unroll
        for (int e = 0; e < 16; ++e) cnt[e] = (int)__hip_atomic_load(cntw + e, __ATOMIC_RELAXED, __HIP_MEMORY_SCOPE_AGENT);
        nN = N / BM; G = G_; c = c_; K = K_; Bt0 = Bt0_; bstride = (size_t)N * K_; LIST = LIST_; }
    __device__ bool next(int i, Unit& u) const {
        int L = i * G + c, base = 0; bool found = false; u.pm = 0; u.pn = 0; u.row0 = 0; u.e = 0; u.cnt = 0; u.Bt = Bt0;
#pragma unroll
        for (int e = 0; e < 16; ++e) { const int mt = (cnt[e] + 255) >> 8, nu = mt * nN;
            if (!found) { if (L < nu) { found = true; u.e = e; u.cnt = cnt[e]; u.pm = L / nN; u.pn = L % nN; u.row0 = base + u.pm * BM; u.Bt = Bt0 + (size_t)e * bstride; } else { L -= nu; base += mt * BM; } } }
        return found;
    }
    __device__ __forceinline__ unsigned arow(const Unit& u, int r) const {
        if (GATHER) { const int li = u.pm * BM + r; int tok = 0; if (li < u.cnt) tok = LIST[u.e * NTOK + li];
            return (unsigned)tok * (unsigned)(K * 2); }
        return (unsigned)(u.row0 + r) * (unsigned)(K * 2);
    }
};

typedef f32x4 Acc[2][2][4][2];
__device__ __forceinline__ void st4bf(bf16* p, f32x4 v) { u32x2 w; w.x = cvt_pk_bf16(v.x, v.y); w.y = cvt_pk_bf16(v.z, v.w); *(u32x2*)p = w; }

struct EpiQKV {
    bf16 *Q; const float* rope;
    __device__ __forceinline__ void operator()(const Acc& acc, const Unit& u, int wr, int wc, int fr, int fq) const {
        const int reg = u.pn >> 2, cbase = (u.pn & 3) * BM + wc * 32 + 4 * fq; bf16* O = Q + (size_t)reg * ((WS_K - WS_Q) / 2);
        const bool dorope = (reg < 2) && (u.row0 < NLAT); const float sc = reg == 0 ? C2 : 1.f;
#pragma unroll
        for (int ai = 0; ai < 2; ++ai)
#pragma unroll
            for (int m = 0; m < 4; ++m) { const int row = u.row0 + ai * HALF + wr * 64 + m * 16 + fr; bf16* rowp = O + (size_t)row * DM + cbase;
                f32x4 cs = {1.f, 1.f, 1.f, 1.f}, sn = {0.f, 0.f, 0.f, 0.f};
                if (dorope) { const int s = row & (SEQ - 1), pos = (wc & 1) ? (s & 63) : (s >> 6); const f32x4 t0 = *(const f32x4*)(rope + (pos * 16 + 4 * fq) * 2), t1 = *(const f32x4*)(rope + (pos * 16 + 4 * fq) * 2 + 4);
                    cs = (f32x4){t0.x, t0.z, t1.x, t1.z}; sn = (f32x4){t0.y, t0.w, t1.y, t1.w}; }
#pragma unroll
                for (int bj = 0; bj < 2; ++bj) { const f32x4 a0 = acc[ai][bj][m][0], a1 = acc[ai][bj][m][1];
                    st4bf(rowp + bj * HALF, (a0 * cs - a1 * sn) * sc); st4bf(rowp + bj * HALF + 16, (a1 * cs + a0 * sn) * sc); } }
    }
};
struct EpiPlain {
    bf16* O;
    __device__ __forceinline__ void operator()(const Acc& acc, const Unit& u, int wr, int wc, int fr, int fq) const {
        const int cbase = u.pn * BM + wc * 32 + 4 * fq;
#pragma unroll
        for (int ai = 0; ai < 2; ++ai)
#pragma unroll
            for (int m = 0; m < 4; ++m) { bf16* rowp = O + (size_t)(u.row0 + ai * HALF + wr * 64 + m * 16 + fr) * DM + cbase;
#pragma unroll
                for (int bj = 0; bj < 2; ++bj)
#pragma unroll
                    for (int n = 0; n < 2; ++n) st4bf(rowp + bj * HALF + n * 16, acc[ai][bj][m][n]); }
    }
};
struct EpiInproj {
    bf16 *QR, *KR, *V, *R; float* ZZ;
    __device__ __forceinline__ void operator()(const Acc& acc, const Unit& u, int wr, int wc, int fr, int fq) const {
        const int pn = u.pn;
        if (pn == 12) { if (wc == 0) {
#pragma unroll
            for (int ai = 0; ai < 2; ++ai)
#pragma unroll
                for (int m = 0; m < 4; ++m) { float* rowp = ZZ + (size_t)(u.row0 + ai * HALF + wr * 64 + m * 16 + fr) * 32 + 4 * fq;
                    *(f32x4*)rowp = acc[ai][0][m][0]; *(f32x4*)(rowp + 16) = acc[ai][0][m][1]; } }
            return; }
        bf16* O; int ld, c0; float sc = 1.f;
        if (pn < 2) { O = QR; ld = 512; c0 = pn * BM; sc = 0.08838834764831845f; } else if (pn < 4) { O = KR; ld = 512; c0 = (pn - 2) * BM; } else if (pn < 8) { O = V; ld = DM; c0 = (pn - 4) * BM; } else { O = R; ld = DM; c0 = (pn - 8) * BM; }
        const int cbase = c0 + wc * 32 + 4 * fq;
#pragma unroll
        for (int ai = 0; ai < 2; ++ai)
#pragma unroll
            for (int m = 0; m < 4; ++m) { bf16* rowp = O + (size_t)(u.row0 + ai * HALF + wr * 64 + m * 16 + fr) * ld + cbase;
#pragma unroll
                for (int bj = 0; bj < 2; ++bj)
#pragma unroll
                    for (int n = 0; n < 2; ++n) st4bf(rowp + bj * HALF + n * 16, acc[ai][bj][m][n] * sc); }
    }
};
struct EpiGateUp {
    bf16* ACT;
    __device__ __forceinline__ void operator()(const Acc& acc, const Unit& u, int wr, int wc, int fr, int fq) const {
        const int obase = (u.pn * BM + wc * 32) / 2 + 4 * fq;
#pragma unroll
        for (int ai = 0; ai < 2; ++ai)
#pragma unroll
            for (int m = 0; m < 4; ++m) { bf16* rowp = ACT + (size_t)(u.row0 + ai * HALF + wr * 64 + m * 16 + fr) * DEXP + obase;
#pragma unroll
                for (int bj = 0; bj < 2; ++bj) { const f32x4 g = acc[ai][bj][m][0], up = acc[ai][bj][m][1]; f32x4 o;
#pragma unroll
                    for (int j = 0; j < 4; ++j) o[j] = g[j] * __builtin_amdgcn_rcpf(1.f + __expf(-g[j])) * up[j];
                    st4bf(rowp + bj * (HALF / 2), o); } }
    }
};

template <class Epi, class Sched>
__device__ __forceinline__ void gemm_phase(unsigned char* ldsg, const bf16* A, int K, const Sched& S, const Epi& E) {
    LAS unsigned char* lds = (LAS unsigned char*)ldsg;
    const int tid = threadIdx.x, wid = __builtin_amdgcn_readfirstlane(tid >> 6), lane = tid & 63, wr = wid >> 2, wc = wid & 3, fr = lane & 15, fq = lane >> 4;
    const int nt = K / BK;
    int Rr[2]; unsigned colb[2], voffB[2];
#pragma unroll
    for (int i = 0; i < 2; ++i) { int R, C; stage_rc(tid * 16 + i * 8192, R, C); Rr[i] = R; colb[i] = (unsigned)C * 2u; voffB[i] = (unsigned)(R * K + C) * 2u; }
    const size_t kstep = (size_t)(BK * 2);
    const size_t hstep = (size_t)HALF * K * 2;
    const size_t tstep = 2 * hstep;
    const unsigned ldsw = (unsigned)wid * 1024u;
    const int aoff = lds_byte(wr * 64 + fr, fq * 8), boff = lds_byte(wc * 32 + fr, fq * 8);
#define PG8_SA(b, h) (((b) * 2 + (h)) * HTB)
#define PG8_SB(b, h) ((4 + (b) * 2 + (h)) * HTB)
#define PG8_STAGE(bufoff, gbase, voff) do { _Pragma("unroll") for (int _i = 0; _i < 2; ++_i) \
        __builtin_amdgcn_global_load_lds((const unsigned*)((const char*)(gbase) + (voff)[_i]), (LAS unsigned*)(lds + (bufoff) + ldsw + _i * 8192), 16, 0, 0); } while (0)
#define PG8_LDA(dst, b, h) do { _Pragma("unroll") for (int m = 0; m < 4; ++m) _Pragma("unroll") for (int k = 0; k < 2; ++k) dst[m][k] = *(const LAS bf16x8*)(lds + PG8_SA(b, h) + aoff + m * 2048 + k * 1024); } while (0)
#define PG8_LDB(dst, b, h) do { _Pragma("unroll") for (int n = 0; n < 2; ++n) _Pragma("unroll") for (int k = 0; k < 2; ++k) dst[n][k] = *(const LAS bf16x8*)(lds + PG8_SB(b, h) + boff + n * 2048 + k * 1024); } while (0)
#define PG8_MMA(ai, bj, At, Bt) do { __builtin_amdgcn_s_setprio(1); _Pragma("unroll") for (int m = 0; m < 4; ++m) _Pragma("unroll") for (int n = 0; n < 2; ++n) _Pragma("unroll") for (int k = 0; k < 2; ++k) \
        acc[ai][bj][m][n] = __builtin_amdgcn_mfma_f32_16x16x32_bf16(Bt[n][k], At[m][k], acc[ai][bj][m][n], 0, 0, 0); __builtin_amdgcn_s_setprio(0); } while (0)
#define PG8_WAIT_V(n) asm volatile("s_waitcnt vmcnt(" #n ")" ::: "memory")
#define PG8_WAIT_L(n) asm volatile("s_waitcnt lgkmcnt(" #n ")" ::: "memory")
#define PG8_BAR __builtin_amdgcn_s_barrier()
#define PG8_SCHED __builtin_amdgcn_sched_barrier(0)
    Unit cur, nxt; int ui = 0;
    if (!S.next(0, cur)) return;
    Acc acc;
#pragma unroll
    for (int a = 0; a < 2; ++a)
#pragma unroll
        for (int b = 0; b < 2; ++b)
#pragma unroll
            for (int m = 0; m < 4; ++m)
#pragma unroll
                for (int n = 0; n < 2; ++n) acc[a][b][m][n] = (f32x4){0.f, 0.f, 0.f, 0.f};
    bf16x8 At[4][2], B0[2][2], B1[2][2];
    unsigned aC0[2], aC1[2], aN0[2], aN1[2];
#pragma unroll
    for (int i = 0; i < 2; ++i) { aC0[i] = S.arow(cur, Rr[i]) + colb[i]; aC1[i] = S.arow(cur, HALF + Rr[i]) + colb[i]; }
    const char* Ab = (const char*)A;
    const char* cB = (const char*)cur.Bt + (size_t)cur.pn * tstep;
    PG8_STAGE(PG8_SB(0, 0), cB, voffB); PG8_STAGE(PG8_SB(0, 1), cB + hstep, voffB); PG8_STAGE(PG8_SA(0, 0), Ab, aC0); PG8_STAGE(PG8_SA(0, 1), Ab, aC1);
    if (wr == 1) PG8_BAR;
    PG8_WAIT_V(2); PG8_BAR;
    PG8_STAGE(PG8_SB(1, 0), cB + kstep, voffB); PG8_STAGE(PG8_SA(1, 0), Ab + kstep, aC0); PG8_STAGE(PG8_SB(1, 1), cB + hstep + kstep, voffB);
    PG8_WAIT_V(6); PG8_BAR;
    for (;;) {
        const bool has_next = S.next(ui + 1, nxt);
        if (has_next) {
#pragma unroll
            for (int i = 0; i < 2; ++i) { aN0[i] = S.arow(nxt, Rr[i]) + colb[i]; aN1[i] = S.arow(nxt, HALF + Rr[i]) + colb[i]; }
        } else {
#pragma unroll
            for (int i = 0; i < 2; ++i) { aN0[i] = aC0[i]; aN1[i] = aC1[i]; }
        }
        const char* nB = has_next ? (const char*)nxt.Bt + (size_t)nxt.pn * tstep : cB;
        for (int t = 0; t < nt; t += 2) {
            const bool last = (t == nt - 2);
            const char* a1 = Ab + (size_t)(t + 1) * kstep;
            const char* a2 = last ? Ab : Ab + (size_t)(t + 2) * kstep; const char* b2 = last ? nB : cB + (size_t)(t + 2) * kstep;
            const char* a3 = a2 + kstep; const char* b3 = b2 + kstep;
            unsigned x0[2], x1[2];
#pragma unroll
            for (int i = 0; i < 2; ++i) { x0[i] = last ? aN0[i] : aC0[i]; x1[i] = last ? aN1[i] : aC1[i]; }
            PG8_LDB(B0, 0, 0); PG8_LDB(B1, 0, 1); PG8_SCHED; PG8_LDA(At, 0, 0); PG8_STAGE(PG8_SA(1, 1), a1, aC1);
            PG8_WAIT_V(8); PG8_WAIT_L(0); PG8_BAR; PG8_MMA(0, 0, At, B0); PG8_MMA(0, 1, At, B1); PG8_BAR; PG8_SCHED;
            PG8_LDA(At, 0, 1); PG8_STAGE(PG8_SB(0, 0), b2, voffB); PG8_STAGE(PG8_SB(0, 1), b2 + hstep, voffB); PG8_STAGE(PG8_SA(0, 0), a2, x0);
            PG8_WAIT_V(8); PG8_WAIT_L(0); PG8_BAR; PG8_MMA(1, 0, At, B0); PG8_MMA(1, 1, At, B1); PG8_BAR; PG8_SCHED;
            PG8_LDB(B0, 1, 0); PG8_LDB(B1, 1, 1); PG8_SCHED; PG8_LDA(At, 1, 0); PG8_STAGE(PG8_SA(0, 1), a2, x1);
            PG8_WAIT_V(8); PG8_WAIT_L(0); PG8_BAR; PG8_MMA(0, 0, At, B0); PG8_MMA(0, 1, At, B1); PG8_BAR; PG8_SCHED;
            PG8_LDA(At, 1, 1); PG8_STAGE(PG8_SB(1, 0), b3, voffB); PG8_STAGE(PG8_SB(1, 1), b3 + hstep, voffB); PG8_STAGE(PG8_SA(1, 0), a3, x0);
            PG8_WAIT_V(8); PG8_WAIT_L(0); PG8_BAR; PG8_MMA(1, 0, At, B0); PG8_MMA(1, 1, At, B1); PG8_BAR; PG8_SCHED;
        }
        if (wr == 0) PG8_BAR;
        E(acc, cur, wr, wc, fr, fq);
        if (!has_next) break;
#pragma unroll
        for (int a = 0; a < 2; ++a)
#pragma unroll
            for (int b = 0; b < 2; ++b)
#pragma unroll
                for (int m = 0; m < 4; ++m)
#pragma unroll
                    for (int n = 0; n < 2; ++n) acc[a][b][m][n] = (f32x4){0.f, 0.f, 0.f, 0.f};
        cur = nxt; cB = nB; ++ui;
#pragma unroll
        for (int i = 0; i < 2; ++i) { aC0[i] = aN0[i]; aC1[i] = aN1[i]; }
        if (wr == 1) PG8_BAR;
    }
    PG8_WAIT_V(0);
    PG8_BAR;
#undef PG8_SA
#undef PG8_SB
#undef PG8_STAGE
#undef PG8_LDA
#undef PG8_LDB
#undef PG8_MMA
#undef PG8_WAIT_V
#undef PG8_WAIT_L
#undef PG8_BAR
#undef PG8_SCHED
}
}

__device__ __forceinline__ int vcu_of(const Frame& F) { return (F.G % 8 == 0) ? (F.bid % 8) * (F.G / 8) + F.bid / 8 : F.bid; }
__device__ __forceinline__ void phase_qkv_opt(const Frame& F, const Prm& p) {
    pg8::DenseOrder S; S.init(NTOK, 3072, 1024, (const bf16*)(p.ws + WS_WQKV), F.G, F.bid);
    static_assert(WS_V - WS_K == WS_K - WS_Q, "Q|K|V equally spaced");
    pg8::EpiQKV E{(bf16*)(p.ws + WS_Q), (const float*)(p.ws + WS_MISC) + 1024};
    pg8::gemm_phase(F.lds, (const bf16*)(p.ws + WS_H), 1024, S, E);
}
__device__ __forceinline__ void phase_wo_opt(const Frame& F, const Prm& p, int layer) {
    pg8::DenseOrder S; S.init(layer ? NLAT : NTOK, 1024, 1024, (const bf16*)(p.ws + (layer ? WS_WGO : WS_WO)), F.G, F.bid);
    pg8::EpiPlain E{(bf16*)(p.ws + WS_Y)};
    pg8::gemm_phase(F.lds, (const bf16*)(p.ws + (layer ? WS_A2B : WS_A2)), 1024, S, E);
}
__device__ __forceinline__ void phase_inproj_opt(const Frame& F, const Prm& p) {
    pg8::DenseOrder S; S.init(NTOK, NIN, 1024, (const bf16*)(p.ws + WS_WIN), F.G, F.bid);
    pg8::EpiInproj E{(bf16*)(p.ws + WS_QR), (bf16*)(p.ws + WS_KR), (bf16*)(p.ws + WS_V1), (bf16*)(p.ws + WS_R), (float*)(p.ws + WS_ZZ)};
    pg8::gemm_phase(F.lds, (const bf16*)(p.ws + WS_H), 1024, S, E);
}
__device__ __forceinline__ void phase_moe1_opt(const Frame& F, const Prm& p, int layer) {
    pg8::MoeOrder<true> S; S.init(F.ctl + CW_CNT + layer * 16, 1024, 1024, (const bf16*)(p.ws + (layer ? WS_GU1 : WS_GU0)), (const int*)(p.ws + WS_LIST), F.G, vcu_of(F));
    pg8::EpiGateUp E{(bf16*)(p.ws + WS_ACT)};
    pg8::gemm_phase(F.lds, (const bf16*)(p.ws + WS_H), 1024, S, E);
}
__device__ __forceinline__ void phase_moe2_opt(const Frame& F, const Prm& p, int layer) {
    pg8::MoeOrder<false> S; S.init(F.ctl + CW_CNT + layer * 16, 1024, 512, (const bf16*)(p.ws + (layer ? WS_DN1 : WS_DN0)), nullptr, F.G, vcu_of(F));
    pg8::EpiPlain E{(bf16*)(p.ws + WS_YM)};
    pg8::gemm_phase(F.lds, (const bf16*)(p.ws + WS_ACT), 512, S, E);
}
namespace attn_body {
using bf16=unsigned short;
using bf16x8=__attribute__((ext_vector_type(8)))short;
using s16x4=__attribute__((ext_vector_type(4)))short;
using f32x16=__attribute__((ext_vector_type(16)))float;
using u32x4=__attribute__((ext_vector_type(4)))unsigned;
constexpr int D=64,DM=1024;
constexpr int NW=8,QBLK=32,QB=QBLK*NW,KVBLK=64;
constexpr int ATTN_PITCH=DM, ATTN_UNIT_ROWS=QB;
__device__ __forceinline__ int crow(int r,int hi){return (r&3)+8*(r>>2)+4*hi;}
#define SBAR() __builtin_amdgcn_sched_barrier(0)
__device__ __forceinline__ void cmask(f32x16&p0,f32x16&p1,int jb,int qrel,int hi){
  const float NEG=-INFINITY; int kb=64*jb+4*hi;
  #pragma unroll
  for(int r=0;r<16;++r){int kv=kb+(r&3)+8*(r>>2); if(kv>qrel)p0[r]=NEG; if(kv+32>qrel)p1[r]=NEG;}
}

constexpr int NSLOT=3, SLOTB=8192;
constexpr int LDS_K=0, LDS_V=NSLOT*SLOTB, LDS_WS=2*NSLOT*SLOTB, LDS_OST=LDS_WS+NW*64*4, LDS_BYTES=LDS_OST+NW*4096;
constexpr float C2=0.125f*1.4426950408889634f;
__device__ __forceinline__ void glds16(const void*gsrc,unsigned lds_dst){unsigned keep;
  asm volatile("s_mov_b32 %0, m0\n\ts_mov_b32 m0, %2\n\ts_nop 0\n\tglobal_load_lds_dwordx4 %1, off\n\ts_mov_b32 m0, %0":"=&s"(keep):"v"(gsrc),"s"(lds_dst):"memory");}
__device__ __forceinline__ float max3f(float a,float b,float c){float r;asm("v_max3_f32 %0, %1, %2, %3":"=v"(r):"v"(a),"v"(b),"v"(c));return r;}
__device__ __forceinline__ float max2f(float a,float b){float r;asm("v_max_f32_e32 %0, %1, %2":"=v"(r):"v"(a),"v"(b));return r;}
__device__ __forceinline__ float fadd_s(float a,float b){float r;asm("v_add_f32_e32 %0, %1, %2":"=v"(r):"v"(a),"v"(b));return r;}
__device__ __forceinline__ float fsub_s(float a,float b){float r;asm("v_sub_f32_e32 %0, %1, %2":"=v"(r):"v"(a),"v"(b));return r;}
typedef float f32x2_t __attribute__((ext_vector_type(2))); typedef __bf16 bf16x2_t __attribute__((ext_vector_type(2)));
__device__ __forceinline__ unsigned cvtpk_s(float lo,float hi){f32x2_t v={lo,hi};bf16x2_t b=__builtin_convertvector(v,bf16x2_t);return __builtin_bit_cast(unsigned,b);}
#define WAIT_BAR(N) asm volatile("s_waitcnt vmcnt(" #N ") lgkmcnt(0)\n\ts_barrier":::"memory")

__device__ __forceinline__ void qkt(f32x16&p0,f32x16&p1,const char*Kslot,const bf16x8*qr,const f32x16&negm,int r32,int hi){
  const char*kb=Kslot+hi*1024+r32*16;
  #pragma unroll
  for(int d0=0;d0<4;++d0){
    const bf16x8 b0=*reinterpret_cast<const bf16x8*>(kb+d0*2048);
    const bf16x8 b1=*reinterpret_cast<const bf16x8*>(kb+d0*2048+512);
    if(d0==0){p0=__builtin_amdgcn_mfma_f32_32x32x16_bf16(b0,qr[0],negm,0,0,0);p1=__builtin_amdgcn_mfma_f32_32x32x16_bf16(b1,qr[0],negm,0,0,0);}
    else{p0=__builtin_amdgcn_mfma_f32_32x32x16_bf16(b0,qr[d0],p0,0,0,0);p1=__builtin_amdgcn_mfma_f32_32x32x16_bf16(b1,qr[d0],p1,0,0,0);}}
}
typedef __attribute__((address_space(3))) const char* lds_cptr;
typedef short v4i16_t __attribute__((ext_vector_type(4)));
__device__ __forceinline__ void kload8(bf16x8*kf,lds_cptr kp){
  kf[0]=*(const __attribute__((address_space(3))) bf16x8*)(kp);      kf[1]=*(const __attribute__((address_space(3))) bf16x8*)(kp+512);
  kf[2]=*(const __attribute__((address_space(3))) bf16x8*)(kp+2048); kf[3]=*(const __attribute__((address_space(3))) bf16x8*)(kp+2560);
  kf[4]=*(const __attribute__((address_space(3))) bf16x8*)(kp+4096); kf[5]=*(const __attribute__((address_space(3))) bf16x8*)(kp+4608);
  kf[6]=*(const __attribute__((address_space(3))) bf16x8*)(kp+6144); kf[7]=*(const __attribute__((address_space(3))) bf16x8*)(kp+6656);
}
__device__ __forceinline__ void kload2(bf16x8*kf,lds_cptr kp,int j){ kf[2*j]=*(const __attribute__((address_space(3))) bf16x8*)(kp+j*2048); kf[2*j+1]=*(const __attribute__((address_space(3))) bf16x8*)(kp+j*2048+512); }
__device__ __forceinline__ s16x4 vtr(lds_cptr p){ return __builtin_bit_cast(s16x4,__builtin_amdgcn_ds_read_tr16_b64_v4i16((__attribute__((address_space(3))) v4i16_t*)p)); }
__device__ __forceinline__ float rowmax(const f32x16&p0,const f32x16&p1){
  float a=max3f(p0[0],p0[1],p1[0]),b=max3f(p0[2],p0[3],p1[1]);a=max3f(a,p1[2],p1[3]);
  #pragma unroll
  for(int r=4;r<16;r+=4){a=max3f(a,p0[r],p0[r+1]);b=max3f(b,p0[r+2],p0[r+3]);a=max3f(a,p1[r],p1[r+1]);b=max3f(b,p1[r+2],p1[r+3]);}
  const float m=max2f(a,b);
  auto rr=__builtin_amdgcn_permlane32_swap(__float_as_uint(m),__float_as_uint(m),false,false);
  return max2f(__uint_as_float(rr[0]),__uint_as_float(rr[1]));
}
__device__ __forceinline__ void pv(f32x16*o,int vb,bf16x8 pa0,bf16x8 pa1,bf16x8 pa2,bf16x8 pa3){
  #pragma unroll
  for(int d0=0;d0<2;++d0){s16x4 lo[4],hi[4];
    #pragma unroll
    for(int ks=0;ks<4;++ks){
      asm volatile("ds_read_b64_tr_b16 %0,%1 offset:%c2":"=&v"(lo[ks]):"v"(vb),"i"(d0*4096+ks*1024):"memory");
      asm volatile("ds_read_b64_tr_b16 %0,%1 offset:%c2":"=&v"(hi[ks]):"v"(vb),"i"(d0*4096+ks*1024+512):"memory");}
    asm volatile("s_waitcnt lgkmcnt(0)":::"memory");SBAR();
    #define PK(k) (bf16x8){lo[k][0],lo[k][1],lo[k][2],lo[k][3],hi[k][0],hi[k][1],hi[k][2],hi[k][3]}
    o[d0]=__builtin_amdgcn_mfma_f32_32x32x16_bf16(pa0,PK(0),o[d0],0,0,0);
    o[d0]=__builtin_amdgcn_mfma_f32_32x32x16_bf16(pa1,PK(1),o[d0],0,0,0);
    o[d0]=__builtin_amdgcn_mfma_f32_32x32x16_bf16(pa2,PK(2),o[d0],0,0,0);
    o[d0]=__builtin_amdgcn_mfma_f32_32x32x16_bf16(pa3,PK(3),o[d0],0,0,0);
    #undef PK
  }
}

#ifndef ATTN_STORE16
#define ATTN_STORE16(p,v) (*(u32x4*)(p)=(v))
#endif
template<int THRL> __device__ __forceinline__ void attn_unit(long qrow0,int qcol,int vcol,long kctx,long klat,int NT,const bf16*Q,const bf16*__restrict__ K,const bf16*__restrict__ V,bf16*O,char*shm){
  const int tid=threadIdx.x,lane=tid&63,r32=lane&31,hi=lane>>5; const int wid=__builtin_amdgcn_readfirstlane(tid>>6);

  const bf16*Qw=Q+(qrow0+wid*QBLK)*DM+qcol;
  const bf16*Kh=K+qcol,*Vh=V+vcol;
  const unsigned lds0=(unsigned)(uintptr_t)shm;
  float*wsf=(float*)(shm+LDS_WS)+wid*64;
  const bf16*ksrc=Kh+(long)lane*DM+wid*8;
  const bf16*vsrc=Vh+(long)(16*(wid&3)+(lane>>2))*DM+(wid>>2)*32+(lane&3)*8;
  const unsigned kdst=lds0+LDS_K+wid*1024, vdst=lds0+LDS_V+wid*1024;
  #define KVROW(t) ((t)<4?kctx+(long)(t)*KVBLK:klat+(long)((t)-4)*KVBLK)
  #define DMA_K(t,slot) glds16(ksrc+KVROW(t)*DM,(unsigned)__builtin_amdgcn_readfirstlane(kdst+(slot)))
  #define DMA_V(t,slot) glds16(vsrc+KVROW(t)*DM,(unsigned)__builtin_amdgcn_readfirstlane(vdst+(slot)))
  const int vb0=(int)(lds0+LDS_V)+((lane>>4)&1)*32+(lane&3)*8+(4*hi+((lane&15)>>2))*64;
  const char*Kbase=shm+LDS_K; bf16x8 kf[8];
  const lds_cptr shm3=(lds_cptr)shm; const lds_cptr kp0=shm3+LDS_K+hi*1024+r32*16; const lds_cptr vp0=shm3+LDS_V+((lane>>4)&1)*32+(lane&3)*8+(4*hi+((lane&15)>>2))*64;
  DMA_K(0,0);DMA_V(0,0);DMA_K(1,SLOTB);
  bf16x8 qr[4];
  #pragma unroll
  for(int d0=0;d0<4;++d0)qr[d0]=*reinterpret_cast<const bf16x8*>(&Qw[(long)r32*DM+d0*16+hi*8]);
  float mhat=0.f,l_reg=0.f;f32x16 o[2];o[0]=f32x16{};o[1]=f32x16{};f32x16 negm=f32x16{};asm volatile("":"+v"(negm));
  const int qrel=wid*QBLK+r32;
  #define CMASK(P0,P1,t) do{}while(0)
  bool resc=false;
  #define START(P0,P1) do{ const float rm=rowmax(P0,P1); resc=false; \
    { const float dl=rm; mhat=fadd_s(mhat,dl); \
      _Pragma("unroll") for(int r=0;r<16;++r){P0[r]=fsub_s(P0[r],dl);P1[r]=fsub_s(P1[r],dl);} \
      _Pragma("unroll") for(int r=0;r<16;++r)negm[r]=-mhat; asm volatile("":"+v"(negm)); } \
    _Pragma("unroll") for(int r=0;r<16;++r)P0[r]=__builtin_amdgcn_exp2f(P0[r]); }while(0)
  #define RESC() do{ if(resc){ asm volatile("s_waitcnt lgkmcnt(0)":::"memory"); \
      _Pragma("unroll") for(int d_=0;d_<2;++d_) _Pragma("unroll") for(int r=0;r<16;++r)o[d_][r]*=wsf[crow(r,hi)]; } }while(0)
  f32x16 pA0,pA1,pB0,pB1;
  int sl_prev=0,sl_cur=0,sl_next=SLOTB;
  #define ROT() do{sl_prev=sl_cur;sl_cur=sl_next;sl_next=(sl_next==(NSLOT-1)*SLOTB)?0:sl_next+SLOTB;}while(0)
  DMA_K(2,2*SLOTB);
  WAIT_BAR(3);
  qkt(pA0,pA1,Kbase,qr,negm,r32,hi);asm volatile("s_nop 15\n\ts_nop 7":"+v"(pA0),"+v"(pA1));CMASK(pA0,pA1,0);
  START(pA0,pA1);
  _Pragma("unroll") for(int r=0;r<16;++r)pA1[r]=__builtin_amdgcn_exp2f(pA1[r]);
  WAIT_BAR(0);
  DMA_K(3,0);DMA_V(1,SLOTB);
  ROT();
  kload8(kf,kp0+sl_cur);
  WAIT_BAR(2);
  s16x4 vlo[8],vhi[8]; u32x4 pw0,pw1,pw2,pw3;
  #define PKW(P,B) cvtpk_s(P[B],P[B+1])
  #define PAF(k) __builtin_bit_cast(bf16x8,pw##k)
  #define VFR(i) (bf16x8){vlo[i][0],vlo[i][1],vlo[i][2],vlo[i][3],vhi[i][0],vhi[i][1],vhi[i][2],vhi[i][3]}
  #define PIN(x) asm volatile("":"+v"(x))
  #define MX3(a,b,c) __builtin_fmaxf(__builtin_fmaxf((a),(b)),(c))
  #define GAPA(MF,A0,A1,A2,A3,W0,W1,PW) do{ MF; sacc+=A0; sacc+=A1; sacc+=A2; sacc+=A3; PIN(sacc); W0; W1; PIN(PW); SBAR(); }while(0)
  #define EX(v) __builtin_amdgcn_exp2f(v)
  #define GAPB(MF,X,B) do{ MF; X[B]=EX(X[B]); X[B+1]=EX(X[B+1]); X[B+2]=EX(X[B+2]); X[B+3]=EX(X[B+3]); PIN(X); SBAR(); }while(0)
  #define VRD(i) do{ vlo[i]=vtr(vp_+(((i)>>2)*4096+((i)&3)*1024)); vhi[i]=vtr(vp_+(((i)>>2)*4096+((i)&3)*1024+512)); }while(0)
  #define KRD(G,j) do{ if(G){ kload2(kf,kp0+sl_next,j); SBAR(); } }while(0)
  #define STEP(C0,C1,P0,P1,t,GK,GV,GL) do{ SBAR(); \
    const lds_cptr vp_=vp0+sl_prev; \
    VRD(0); SBAR(); float sacc=(P0[0]+P0[1]); \
    GAPA(C0=__builtin_amdgcn_mfma_f32_32x32x16_bf16(kf[0],qr[0],negm,0,0,0), P0[2],P0[3],P0[4],P0[5],     pw0[0]=PKW(P0,0), pw0[1]=PKW(P0,2), pw0); \
    VRD(4); SBAR(); GAPA(C1=__builtin_amdgcn_mfma_f32_32x32x16_bf16(kf[1],qr[0],negm,0,0,0), P0[6],P0[7],P0[8],P0[9],     pw0[2]=PKW(P0,4), pw0[3]=PKW(P0,6), pw0); \
    VRD(1); SBAR(); GAPA(C0=__builtin_amdgcn_mfma_f32_32x32x16_bf16(kf[2],qr[1],C0,0,0,0),   P0[10],P0[11],P0[12],P0[13], pw1[0]=PKW(P0,8), pw1[1]=PKW(P0,10), pw1); \
    VRD(5); SBAR(); GAPA(C1=__builtin_amdgcn_mfma_f32_32x32x16_bf16(kf[3],qr[1],C1,0,0,0),   P0[14],P0[15],P1[0],P1[1],   pw1[2]=PKW(P0,12),pw1[3]=PKW(P0,14), pw1); \
    VRD(2); SBAR(); GAPA(C0=__builtin_amdgcn_mfma_f32_32x32x16_bf16(kf[4],qr[2],C0,0,0,0),   P1[2],P1[3],P1[4],P1[5],     pw2[0]=PKW(P1,0), pw2[1]=PKW(P1,2), pw2); \
    VRD(6); SBAR(); GAPA(C1=__builtin_amdgcn_mfma_f32_32x32x16_bf16(kf[5],qr[2],C1,0,0,0),   P1[6],P1[7],P1[8],P1[9],     pw2[2]=PKW(P1,4), pw2[3]=PKW(P1,6), pw2); \
    VRD(3); SBAR(); GAPA(C0=__builtin_amdgcn_mfma_f32_32x32x16_bf16(kf[6],qr[3],C0,0,0,0),   P1[10],P1[11],P1[12],P1[13], pw3[0]=PKW(P1,8), pw3[1]=PKW(P1,10), pw3); \
    VRD(7); SBAR(); GAPA(C1=__builtin_amdgcn_mfma_f32_32x32x16_bf16(kf[7],qr[3],C1,0,0,0),   P1[14],P1[15],0.f,0.f,       pw3[2]=PKW(P1,12),pw3[3]=PKW(P1,14), pw3); \
    l_reg+=sacc; \
    if(GK){DMA_K((t)+3,sl_cur);} if(GV){DMA_V((t)+1,sl_next);} \
    CMASK(C0,C1,t); \
    { float a=MX3(C0[0],C0[1],C1[0]),b=MX3(C0[2],C0[3],C1[1]); a=MX3(a,C1[2],C1[3]); \
      _Pragma("unroll") for(int r=4;r<16;r+=4){a=MX3(a,C0[r],C0[r+1]);b=MX3(b,C0[r+2],C0[r+3]);a=MX3(a,C1[r],C1[r+1]);b=MX3(b,C1[r+2],C1[r+3]);} \
      float rm=__builtin_fmaxf(a,b); { auto rr=__builtin_amdgcn_permlane32_swap(__float_as_uint(rm),__float_as_uint(rm),false,false); rm=__builtin_fmaxf(__uint_as_float(rr[0]),__uint_as_float(rr[1])); } \
      resc=false; \
      if(__builtin_expect(__any(rm>(float)THRL),0)){ const float dl=__builtin_fmaxf(rm,0.f); mhat+=dl; \
        _Pragma("unroll") for(int r=0;r<16;++r){C0[r]-=dl;C1[r]-=dl;} \
        _Pragma("unroll") for(int r=0;r<16;++r)negm[r]=-mhat; asm volatile("":"+v"(negm)); \
        const float f=__builtin_amdgcn_exp2f(-dl); l_reg*=f; if(hi==0)wsf[r32]=f; resc=true; } } \
    SBAR(); \
    GAPB(o[0]=__builtin_amdgcn_mfma_f32_32x32x16_bf16(PAF(0),VFR(0),o[0],0,0,0), C0,0); \
    GAPB(o[1]=__builtin_amdgcn_mfma_f32_32x32x16_bf16(PAF(0),VFR(4),o[1],0,0,0), C0,4); \
    KRD(GL,0); GAPB(o[0]=__builtin_amdgcn_mfma_f32_32x32x16_bf16(PAF(1),VFR(1),o[0],0,0,0), C0,8); \
    KRD(GL,1); GAPB(o[1]=__builtin_amdgcn_mfma_f32_32x32x16_bf16(PAF(1),VFR(5),o[1],0,0,0), C0,12); \
    KRD(GL,2); GAPB(o[0]=__builtin_amdgcn_mfma_f32_32x32x16_bf16(PAF(2),VFR(2),o[0],0,0,0), C1,0); \
    KRD(GL,3); GAPB(o[1]=__builtin_amdgcn_mfma_f32_32x32x16_bf16(PAF(2),VFR(6),o[1],0,0,0), C1,4); \
    GAPB(o[0]=__builtin_amdgcn_mfma_f32_32x32x16_bf16(PAF(3),VFR(3),o[0],0,0,0), C1,8); \
    GAPB(o[1]=__builtin_amdgcn_mfma_f32_32x32x16_bf16(PAF(3),VFR(7),o[1],0,0,0), C1,12); \
    }while(0)
  int t=1;
  #undef CMASK
  #define CMASK(P0,P1,t) do{}while(0)
  for(;t+5<NT;t+=2){
    STEP(pB0,pB1,pA0,pA1,t,true,true,true);     WAIT_BAR(2); RESC(); ROT();
    STEP(pA0,pA1,pB0,pB1,t+1,true,true,true);   WAIT_BAR(2); RESC(); ROT();
  }
  #undef CMASK
  #define CMASK(P0,P1,t) do{}while(0)
  #define ENDW(tt) do{ if((tt)+3<NT){WAIT_BAR(2);} else if((tt)+2<NT){WAIT_BAR(1);} else {WAIT_BAR(0);} }while(0)
  for(;t+1<NT;t+=2){
    STEP(pB0,pB1,pA0,pA1,t,(t+3<NT),(t+1<NT),(t+1<NT));       ENDW(t);   RESC(); ROT();
    STEP(pA0,pA1,pB0,pB1,t+1,(t+4<NT),(t+2<NT),(t+2<NT));     ENDW(t+1); RESC(); ROT();
  }
  STEP(pB0,pB1,pA0,pA1,NT-1,false,false,false); RESC();
  { float sacc=pB0[0]+pB0[1]; _Pragma("unroll") for(int r=2;r<16;++r)sacc+=pB0[r]; _Pragma("unroll") for(int r=0;r<16;++r)sacc+=pB1[r]; l_reg+=sacc;
    pw0=(u32x4){PKW(pB0,0),PKW(pB0,2),PKW(pB0,4),PKW(pB0,6)};pw1=(u32x4){PKW(pB0,8),PKW(pB0,10),PKW(pB0,12),PKW(pB0,14)};pw2=(u32x4){PKW(pB1,0),PKW(pB1,2),PKW(pB1,4),PKW(pB1,6)};pw3=(u32x4){PKW(pB1,8),PKW(pB1,10),PKW(pB1,12),PKW(pB1,14)};
    SBAR(); pv(o,vb0+sl_cur,PAF(0),PAF(1),PAF(2),PAF(3)); }
  #undef PKW
  #undef PAF
  #undef VFR
  #undef PIN
  #undef MX3
  #undef GAPA
  #undef GAPB
  #undef EX
  #undef VRD
  #undef KRD
  #undef STEP
  #undef ENDW
  {auto rr=__builtin_amdgcn_permlane32_swap(__float_as_uint(l_reg),__float_as_uint(l_reg),false,false);l_reg=__uint_as_float(rr[0])+__uint_as_float(rr[1]);}
  if(hi==0)wsf[32+r32]=l_reg;asm volatile("s_waitcnt lgkmcnt(0)":::"memory");
  float rli[16];
  #pragma unroll
  for(int r=0;r<16;++r)rli[r]=__builtin_amdgcn_rcpf(wsf[32+crow(r,hi)]);
  bf16*Ow=O+(qrow0+wid*QBLK)*DM+vcol;
  { bf16*stg=(bf16*)(shm+LDS_OST)+wid*2048;
    #pragma unroll
    for(int r=0;r<16;++r){const int orow=crow(r,hi);
      #pragma unroll
      for(int d0=0;d0<2;++d0)stg[orow*64+d0*32+r32]=(bf16)f2bf(o[d0][r]*rli[r]);}
    asm volatile("s_waitcnt lgkmcnt(0)":::"memory");
    #pragma unroll
    for(int i=0;i<4;++i){const int row=i*8+(lane>>3),ch=lane&7; const u32x4 v=*(const u32x4*)(stg+row*64+ch*8); ATTN_STORE16(Ow+(long)row*DM+ch*8,v);} }
  asm volatile("s_waitcnt lgkmcnt(0)\n\ts_barrier":::"memory");
  #undef DMA_K
  #undef DMA_V
  #undef CMASK
  #undef START
  #undef RESC
  #undef ROT
}
constexpr int ATTN_LDS_BYTES=LDS_BYTES;
#undef SBAR
#undef WAIT_BAR
#undef KVROW
}
__device__ __forceinline__ void phase_attn_opt(const Frame& F, const Prm& p) {
    const bf16* Q = (const bf16*)(p.ws + WS_Q); const bf16* K = (const bf16*)(p.ws + WS_K); const bf16* V = (const bf16*)(p.ws + WS_V); bf16* O1 = (bf16*)(p.ws + WS_O1);
    for (int bv = vcu_of(F); bv < 256; bv += F.G) {
        const int b = bv >> 5, vh = bv & 31, h = vh >> 2, m = (vh >> 1) & 1, vhalf = vh & 1;
        const int qcol = (h * 2 + m) * 64, vcol = h * 128 + vhalf * 64; bf16* O = O1 + (size_t)m * ((WS_O2 - WS_O1) / 2);
        const long kctx = NLAT + b * CTXL, klat = (long)b * SEQ;
        for (int i = 0; i < 17; ++i) {
            const long qrow0 = i < 16 ? klat + i * 256 : kctx; const int NT = i < 16 ? 68 : 4;
            attn_body::attn_unit<8>(qrow0, qcol, vcol, kctx, klat, NT, Q, K, V, O, (char*)F.lds);
        }
    }
}
#define PHASE_QKV(F, p) phase_qkv_opt(F, p)
#define PHASE_ATTN(F, p) phase_attn_opt(F, p)
#define PHASE_WO(F, p, l) phase_wo_opt(F, p, l)
#define PHASE_MOE1(F, p, l) phase_moe1_opt(F, p, l)
#define PHASE_MOE2(F, p, l) phase_moe2_opt(F, p, l)
#define PHASE_INPROJ(F, p) phase_inproj_opt(F, p)
#define PHASE_SCAN(F, p) do {} while (0)
typedef GAS unsigned gu32;
#define XB_TMO      128
#define XB_XCNT(j)  (256  + 64 * (j))
#define XB_XSUB(j)  (1280 + 64 * (j))
#define XB_XGEN(j)  (2304 + 64 * (j))
#define XB_TOP      3328
#define XB_TOPGEN   3392
#define XCD_BAR_WORDS 3456
#define XB_SPIN_CAP (1u << 20)
__device__ __forceinline__ unsigned xb_ld(unsigned* p)              { return __hip_atomic_load(p, __ATOMIC_RELAXED, __HIP_MEMORY_SCOPE_AGENT); }
__device__ __forceinline__ unsigned xb_add(unsigned* p, unsigned v) { return __hip_atomic_fetch_add(p, v, __ATOMIC_RELAXED, __HIP_MEMORY_SCOPE_AGENT); }
__device__ __forceinline__ unsigned xb_xcc_id() { return (unsigned)__builtin_amdgcn_s_getreg((3 << 11) | 20) & 0xFu; }
#define XB_SPIN(cond, bar) do { unsigned _sp = 0; while (cond) { __builtin_amdgcn_s_sleep(1); \
    if ((++_sp & 255u) == 0u) { if (xb_ld(&(bar)[XB_TMO])) break; if (_sp > XB_SPIN_CAP) { atomicAdd(&(bar)[XB_TMO], 1u); break; } } } } while (0)
struct XcdBarrier { unsigned* bar; unsigned x; volatile LAS unsigned* st; };
__device__ __forceinline__ XcdBarrier xcd_barrier_post(unsigned* bar, volatile LAS unsigned* st) {
    XcdBarrier b; b.bar = bar; b.x = xb_xcc_id(); b.st = st;
    if (threadIdx.x == 0) (void)xb_add(&bar[XB_XCNT(b.x)], 1u);
    return b;
}
__device__ __forceinline__ void xcd_barrier_complete(unsigned* bar, unsigned x, unsigned& nloc, unsigned& nx) {
    const unsigned G = gridDim.x * gridDim.y * gridDim.z;
    unsigned sum, cnt, mine, sp = 0u;
    for (;;) {
        sum = 0u; cnt = 0u; mine = 0u;
#pragma unroll
        for (unsigned j = 0; j < 16; ++j) { const unsigned c = xb_ld(&bar[XB_XCNT(j)]); sum += c; cnt += (c > 0u) ? 1u : 0u; mine = (j == x) ? c : mine; }
        if (sum == G) break;
        __builtin_amdgcn_s_sleep(1);
        if ((++sp & 255u) == 0u) { if (xb_ld(&bar[XB_TMO])) break; if (sp > XB_SPIN_CAP) { atomicAdd(&bar[XB_TMO], 1u); break; } }
    }
    nloc = mine > 0u ? mine : 1u; nx = cnt > 0u ? cnt : 1u;
}
__device__ __forceinline__ void xcd_barrier(const XcdBarrier& b) {
    asm volatile("s_waitcnt vmcnt(0)" ::: "memory");
    __syncthreads();
    if (threadIdx.x == 0) {
        unsigned* bar = b.bar;
        __builtin_amdgcn_s_waitcnt(0);
        unsigned nloc = b.st[0], nx = b.st[1];
        if (nloc == 0u) { xcd_barrier_complete(bar, b.x, nloc, nx); b.st[0] = nloc; b.st[1] = nx; }
        const unsigned old = xb_add(&bar[XB_XSUB(b.x)], 1u);
        const unsigned gen = old / nloc;
        if (old + 1u == (gen + 1u) * nloc) {
            __builtin_amdgcn_fence(__ATOMIC_RELEASE, "agent");
            asm volatile("s_waitcnt vmcnt(0)" ::: "memory");
            const unsigned og = xb_add(&bar[XB_TOP], 1u);
            const unsigned tg = og / nx;
            if (og + 1u == (tg + 1u) * nx) xb_add(&bar[XB_TOPGEN], 1u);
            else XB_SPIN(xb_ld(&bar[XB_TOPGEN]) == tg, bar);
            __builtin_amdgcn_fence(__ATOMIC_ACQUIRE, "agent");
            xb_add(&bar[XB_XGEN(b.x)], 1u);
            asm volatile("s_waitcnt vmcnt(0)" ::: "memory");
        } else {
            XB_SPIN(xb_ld(&bar[XB_XGEN(b.x)]) == gen, bar);
            __builtin_amdgcn_fence(__ATOMIC_ACQUIRE, "agent");
            asm volatile("s_waitcnt vmcnt(0)" ::: "memory");
        }
    }
    __syncthreads();
}

constexpr int NPHASE = 19;
#ifndef OPT_MASK
#define OPT_MASK 0u
#endif
__global__ void __launch_bounds__(NTHR, 2) mega_fwd(Prm p) {
    extern __shared__ __attribute__((aligned(16))) unsigned char lds[];
    Frame F; F.lds = lds; F.ctl = (unsigned*)(p.ws + WS_CTL);
    F.tid = threadIdx.x; F.lane = F.tid & 63; F.wave = __builtin_amdgcn_readfirstlane(F.tid >> 6); F.G = gridDim.x; F.bid = blockIdx.x;
    for (int u = F.tid; u < (LDS_BYTES - LDSCTL_OFF) / 4; u += NTHR) ((LAS unsigned*)(lds + LDSCTL_OFF))[u] = 0u;
    __syncthreads();
    const int lo = p.ph_lo, hi = p.ph_hi;
    const bool multi = (hi - lo) > 1;
    XcdBarrier bar; bar.bar = F.ctl + CW_BAR + p.li * XCD_BAR_WORDS; bar.x = 0; bar.st = nullptr;
    if (multi) bar = xcd_barrier_post(F.ctl + CW_BAR + p.li * XCD_BAR_WORDS, (volatile LAS unsigned*)(lds + MISC_OFF) + 8);
#define IN(k) (lo <= (k) && (k) < hi)
#define SEAM(k) do { if (IN(k) && IN((k) + 1)) xcd_barrier(bar); } while (0)
    if (IN(0)) { phase_prologue(F, p); } SEAM(0);
    if (IN(1)) { phase_modulate0(F, p); } SEAM(1);
    if (IN(2)) { PHASE_QKV(F, p); } SEAM(2);
    if (IN(3)) { PHASE_ATTN(F, p); } SEAM(3);
    if (IN(4)) { phase_attn_combine(F, p); } SEAM(4);
    if (IN(5)) { PHASE_WO(F, p, 0); } SEAM(5);
    if (IN(6)) { phase_ln_route(F, p, 0); } SEAM(6);
    if (IN(7)) { PHASE_MOE1(F, p, 0); } SEAM(7);
    if (IN(8)) { PHASE_MOE2(F, p, 0); } SEAM(8);
    if (IN(9)) { phase_moe_combine(F, p, 0); } SEAM(9);
    if (IN(10)) { PHASE_INPROJ(F, p); } SEAM(10);
    if (IN(11)) { phase_gla_prep(F, p); } SEAM(11);
    if (IN(12)) { PHASE_SCAN(F, p); } SEAM(12);
    if (IN(13)) { phase_gla_post(F, p); } SEAM(13);
    if (IN(14)) { PHASE_WO(F, p, 1); } SEAM(14);
    if (IN(15)) { phase_ln_route(F, p, 1); } SEAM(15);
    if (IN(16)) { PHASE_MOE1(F, p, 1); } SEAM(16);
    if (IN(17)) { PHASE_MOE2(F, p, 1); } SEAM(17);
    if (IN(18)) { phase_moe_combine(F, p, 1); }
#undef IN
#undef SEAM
}

static void launch_naive(int ph, const Prm& p, hipStream_t stream) {
    using namespace naive;
    const bf16* H = (const bf16*)(p.ws + WS_H);
    switch (ph) {
    case 2: { NG g{H, (const bf16*)(p.ws + WS_WQKV), NTOK, 3072, 1024, 0, nullptr}; hipLaunchKernelGGL(gemm_kernel<EPI_QKV>, dim3(3072 / 64, NTOK / 64), dim3(256), 0, stream, g, p); break; }
    case 3: hipLaunchKernelGGL(attn_kernel, dim3(544, 16), dim3(256), 0, stream, p); break;
    case 5: { NG g{(const bf16*)(p.ws + WS_A2), (const bf16*)(p.ws + WS_WO), NTOK, 1024, 1024, 0, (bf16*)(p.ws + WS_Y)}; hipLaunchKernelGGL(gemm_kernel<EPI_PLAIN>, dim3(16, NTOK / 64), dim3(256), 0, stream, g, p); break; }
    case 7: case 16: { const int l = ph == 16; NG g{H, (const bf16*)(p.ws + (l ? WS_GU1 : WS_GU0)), MAXSLOT, 1024, 1024, l, nullptr}; hipLaunchKernelGGL(gemm_kernel<EPI_GATEUP>, dim3(16, MAXSLOT / 64), dim3(256), 0, stream, g, p); break; }
    case 8: case 17: { const int l = ph == 17; NG g{(const bf16*)(p.ws + WS_ACT), (const bf16*)(p.ws + (l ? WS_DN1 : WS_DN0)), MAXSLOT, 1024, 512, l, nullptr}; hipLaunchKernelGGL(gemm_kernel<EPI_DOWN>, dim3(16, MAXSLOT / 64), dim3(256), 0, stream, g, p); break; }
    case 10: { NG g{H, (const bf16*)(p.ws + WS_WIN), NTOK, NIN, 1024, 0, nullptr}; hipLaunchKernelGGL(gemm_kernel<EPI_INPROJ>, dim3(NIN / 64, NTOK / 64), dim3(256), 0, stream, g, p); break; }
    case 12: hipLaunchKernelGGL(gla_scan_kernel, dim3(512), dim3(256), GLA_SCAN_LDS, stream, p); break;
    case 14: { NG g{(const bf16*)(p.ws + WS_A2B), (const bf16*)(p.ws + WS_WGO), NLAT, 1024, 1024, 0, (bf16*)(p.ws + WS_Y)}; hipLaunchKernelGGL(gemm_kernel<EPI_PLAIN>, dim3(16, NLAT / 64), dim3(256), 0, stream, g, p); break; }
    default: break;
    }
}
extern "C" void kernel_launch(void* const* d_in, const int* in_sizes, int n_in, void* d_out, int out_size, void* d_ws, size_t ws_size, hipStream_t stream) {
    static int grid = 0;
    if (grid == 0) {
        if (n_in != 23 || in_sizes[0] != NLAT * DM || out_size != NLAT * DM || ws_size < WS_END) { fprintf(stderr, "kernel_launch: unexpected shapes (n_in %d, in0 %d, out %d, ws %zu); nothing launched\n", n_in, n_in > 0 ? in_sizes[0] : -1, out_size, ws_size); grid = -1; return; }
        int dev = 0, cus = 0;
        if (hipGetDevice(&dev) != hipSuccess || hipDeviceGetAttribute(&cus, hipDeviceAttributeMultiprocessorCount, dev) != hipSuccess) { grid = -1; return; }
        if (hipFuncSetAttribute((const void*)mega_fwd, hipFuncAttributeMaxDynamicSharedMemorySize, LDS_BYTES) != hipSuccess) { fprintf(stderr, "kernel_launch: hipFuncSetAttribute failed\n"); grid = -1; return; }
        (void)hipFuncSetAttribute((const void*)naive::gla_scan_kernel, hipFuncAttributeMaxDynamicSharedMemorySize, naive::GLA_SCAN_LDS);
        int per_cu = 0;
        if (hipOccupancyMaxActiveBlocksPerMultiprocessor(&per_cu, (const void*)mega_fwd, NTHR, LDS_BYTES) != hipSuccess || per_cu < 1) fprintf(stderr, "kernel_launch: note: occupancy query reports %d\n", per_cu);
        (void)hipGetLastError();
        grid = cus;
    }
    if (grid < 0) return;
    (void)hipMemsetAsync((char*)d_ws + WS_CTL, 0, CTL_ZERO_BYTES, stream);
    Prm p{};
    const float** pp = (const float**)&p;
    for (int i = 0; i < 23; ++i) pp[i] = (const float*)d_in[i];
    p.out = (float*)d_out; p.ws = (unsigned char*)d_ws;
    const unsigned naive_phases = (1u << 2) | (1u << 3) | (1u << 5) | (1u << 7) | (1u << 8) | (1u << 10) | (1u << 12) | (1u << 14) | (1u << 16) | (1u << 17);
    const unsigned use_naive = naive_phases & ~(unsigned)(OPT_MASK);
    int ph = 0, li = 0;
    while (ph < NPHASE) {
        if (use_naive & (1u << ph)) { launch_naive(ph, p, stream); ++ph; continue; }
        int e = ph + 1;
#if defined(ONE_PER_PHASE)
#else
        while (e < NPHASE && !(use_naive & (1u << e))) ++e;
#endif
        p.ph_lo = ph; p.ph_hi = e; p.li = li++;
        hipLaunchKernelGGL(mega_fwd, dim3(grid), dim3(NTHR), LDS_BYTES, stream, p);
        ph = e;
    }
}
```

```cpp
#define OPT_MASK 0x355ACu
#include <hip/hip_runtime.h>
#include <cstdint>
#include <cstdio>

constexpr int BATCH = 8, SEQ = 4096, DM = 1024, CTXL = 256;
constexpr int NLAT = BATCH * SEQ, NCTX = BATCH * CTXL, NTOK = NLAT + NCTX;
constexpr float ALPHA = 1.4142135623730951f;
constexpr float LN_EPS = 1e-5f;
constexpr float LAMBDA_INIT0 = 0.2f;
constexpr float C2 = 0.125f * 1.4426950408889634f;
constexpr int NEXP = 16, DEXP = 512, MAXSLOT = 73728;
constexpr int NCHUNK = NTOK / 64;
constexpr int NIN = 3328;

typedef unsigned short bf16;
typedef float f32x4 __attribute__((ext_vector_type(4)));
typedef float f32x2 __attribute__((ext_vector_type(2)));
typedef unsigned u32x2 __attribute__((ext_vector_type(2)));
typedef unsigned u32x4 __attribute__((ext_vector_type(4)));

constexpr size_t MiB = 1u << 20;
constexpr size_t WS_CTL = 0, CTL_ZERO_BYTES = 1 * MiB;
constexpr size_t WS_MOD = 1 * MiB;
constexpr size_t WS_MISC = 1 * MiB + 512 * 1024;
constexpr size_t WS_WQKV = 2 * MiB, WS_WO = 8 * MiB, WS_GU0 = 10 * MiB, WS_DN0 = 42 * MiB;
constexpr size_t WS_XCTX = 58 * MiB;
constexpr size_t WS_WIN = 66 * MiB, WS_WGO = 73 * MiB, WS_GU1 = 75 * MiB, WS_DN1 = 107 * MiB;
constexpr size_t WS_H = 123 * MiB;
constexpr size_t WS_Q = 191 * MiB, WS_K = 259 * MiB, WS_V = 327 * MiB, WS_O2 = 395 * MiB;
constexpr size_t WS_LIST = 463 * MiB;
constexpr size_t WS_TOKR = 466 * MiB;
constexpr size_t WS_DEC = 468 * MiB;
constexpr size_t WS_ZZ = 471 * MiB;
constexpr size_t WS_END = 480 * MiB;
constexpr size_t WS_O1 = WS_H, WS_A2 = WS_Q, WS_Y = WS_K;
constexpr size_t WS_YM = 191 * MiB, WS_ACT = 335 * MiB;
constexpr size_t WS_QR = 191 * MiB, WS_KR = 225 * MiB, WS_V1 = 259 * MiB, WS_R = 327 * MiB;
constexpr size_t WS_QT = WS_H, WS_KT = 395 * MiB;
constexpr size_t WS_OGF = 191 * MiB, WS_OGB = 2 * MiB;
constexpr size_t WS_A2B = WS_H;
constexpr int CW_TMO = 0, CW_CODE = 1;
constexpr int CW_CNT = 64;
constexpr int CW_BAR = 4096;

__device__ __forceinline__ unsigned f2bf(float f) { unsigned u = __builtin_bit_cast(unsigned, f); return (u + 0x7fffu + ((u >> 16) & 1u)) >> 16; }
__device__ __forceinline__ unsigned pk2(float lo, float hi) { return f2bf(lo) | (f2bf(hi) << 16); }
__device__ __forceinline__ float bf2f(unsigned b) { return __builtin_bit_cast(float, b << 16); }
__device__ __forceinline__ float wave_sum(float v) {
#pragma unroll
    for (int o = 1; o < 64; o <<= 1) v += __shfl_xor(v, o);
    return v;
}
__device__ __forceinline__ float silu_f(float v) { return v / (1.f + __expf(-v)); }

struct Prm {
    const float *x, *c, *ctx, *cctx, *ada_w, *ada_b, *ln_g, *ln_b, *w_qkv, *w_o, *lam, *subln, *gw_in, *gwg_down, *gwg_up, *gbg, *gnorm, *gw_o, *rw, *rb, *mg, *mu, *md;
    float* out; unsigned char* ws;
    int ph_lo, ph_hi, li, pad;
};
__device__ __forceinline__ void ld_row_f32(const float* p, int lane, f32x4 (&v)[4]) {
#pragma unroll
    for (int j = 0; j < 4; ++j) v[j] = *(const f32x4*)(p + 4 * lane + 256 * j);
}
__device__ __forceinline__ void st_row_f32(float* p, int lane, const f32x4 (&v)[4]) {
#pragma unroll
    for (int j = 0; j < 4; ++j) *(f32x4*)(p + 4 * lane + 256 * j) = v[j];
}
__device__ __forceinline__ void ld_row_bf16(const bf16* p, int lane, f32x4 (&v)[4]) {
#pragma unroll
    for (int j = 0; j < 4; ++j) { const u32x2 u = *(const u32x2*)(p + 4 * lane + 256 * j); v[j] = (f32x4){bf2f(u.x & 0xffffu), bf2f(u.x >> 16), bf2f(u.y & 0xffffu), bf2f(u.y >> 16)}; }
}
__device__ __forceinline__ void st_row_bf16(bf16* p, int lane, const f32x4 (&v)[4]) {
#pragma unroll
    for (int j = 0; j < 4; ++j) { u32x2 u; u.x = pk2(v[j].x, v[j].y); u.y = pk2(v[j].z, v[j].w); *(u32x2*)(p + 4 * lane + 256 * j) = u; }
}
__device__ __forceinline__ void ln_row(f32x4 (&v)[4], const float* g, const float* b, int lane) {
    float s = 0.f;
#pragma unroll
    for (int j = 0; j < 4; ++j) s += (v[j].x + v[j].y) + (v[j].z + v[j].w);
    const float mean = wave_sum(s) * (1.f / DM); float q = 0.f;
#pragma unroll
    for (int j = 0; j < 4; ++j) { v[j] = v[j] - mean; q += (v[j].x * v[j].x + v[j].y * v[j].y) + (v[j].z * v[j].z + v[j].w * v[j].w); }
    const float rstd = 1.f / sqrtf(wave_sum(q) * (1.f / DM) + LN_EPS);
#pragma unroll
    for (int j = 0; j < 4; ++j) { const f32x4 gg = *(const f32x4*)(g + 4 * lane + 256 * j), bb = *(const f32x4*)(b + 4 * lane + 256 * j); v[j] = v[j] * rstd * gg + bb; }
}
__host__ __device__ __forceinline__ int gu_phys(int other, int sel) { return (other >> 4) * 32 + sel * 16 + (other & 15); }
#define GAS __attribute__((address_space(1)))
#define LAS __attribute__((address_space(3)))
constexpr int NWAVES = 8, NTHR = NWAVES * 64;
constexpr int RING_BYTES = 131072, LDSCTL_OFF = RING_BYTES, MISC_OFF = LDSCTL_OFF + 320, LDS_BYTES = 147456;
constexpr int LDSX_OFF = RING_BYTES + 1024;
#define LDS_WAIT() asm volatile("s_waitcnt lgkmcnt(0)" ::: "memory")
#define VM_WAIT() asm volatile("s_waitcnt vmcnt(0)" ::: "memory")

struct Frame {
    unsigned char* lds;
    unsigned* ctl;
    int tid, lane, wave, G, bid;
};

template <int MODE>
__device__ __forceinline__ void p0_transpose_item(const float* W, int K, int N, bf16* WT, int row_off, float* scr, int item, int lane) {
    const int nblk = N / 32, kb = item / nblk, nb = item % nblk, k0 = 64 * kb, n0 = 32 * nb;
#pragma unroll 8
    for (int i = 0; i < 32; ++i) { const int kk = 2 * i + (lane >> 5); scr[kk * 33 + (lane & 31)] = W[(size_t)(k0 + kk) * N + n0 + (lane & 31)]; }
    LDS_WAIT(); asm volatile("" ::: "memory");
    const int c = lane & 7;
#pragma unroll
    for (int j = 0; j < 4; ++j) { const int n = (lane >> 3) + 8 * j; const float* s = scr + (8 * c) * 33 + n;
        u32x4 o; o.x = pk2(s[0 * 33], s[1 * 33]); o.y = pk2(s[2 * 33], s[3 * 33]); o.z = pk2(s[4 * 33], s[5 * 33]); o.w = pk2(s[6 * 33], s[7 * 33]);
        const int nl = n0 + n; const int pr = (MODE == 0) ? (row_off + nl) : (row_off + gu_phys(nl, MODE - 1));
        *(u32x4*)(WT + (size_t)pr * K + k0 + 8 * c) = o; }
    LDS_WAIT(); asm volatile("" ::: "memory");
}
__device__ __forceinline__ void phase_prologue(const Frame& F, const Prm& p) {
    float* sil = (float*)F.lds;
    for (int i = F.tid; i < 9 * 1024; i += NTHR) { const int r = i >> 10, k = i & 1023; const float v = (r < 8) ? p.c[r * 1024 + k] : p.cctx[k]; sil[i] = silu_f(v); }
    __syncthreads();
    float* MOD = (float*)(p.ws + WS_MOD);
    if (F.wave == 0 && F.bid < 192) {
        const int layer = F.bid / 96, n = (F.bid % 96) * 64 + F.lane; const float* W = p.ada_w + (size_t)layer * 1024 * 6144 + n;
        float acc[9];
#pragma unroll
        for (int r = 0; r < 9; ++r) acc[r] = 0.f;
#pragma unroll 4
        for (int k = 0; k < 1024; k += 4) {
            const float w0 = W[(size_t)k * 6144], w1 = W[(size_t)(k + 1) * 6144], w2 = W[(size_t)(k + 2) * 6144], w3 = W[(size_t)(k + 3) * 6144];
#pragma unroll
            for (int r = 0; r < 9; ++r) { const f32x4 s = *(const f32x4*)(sil + r * 1024 + k); acc[r] += s.x * w0 + s.y * w1 + s.z * w2 + s.w * w3; }
        }
        const float bb = p.ada_b[layer * 6144 + n];
#pragma unroll
        for (int r = 0; r < 9; ++r) MOD[(layer * 9 + r) * 6144 + n] = acc[r] + bb;
    }
    float* misc = (float*)(p.ws + WS_MISC);
    if (F.bid == 255 % F.G && F.wave == 1) {
        const float a = wave_sum(p.lam[F.lane] * p.lam[64 + F.lane]), b = wave_sum(p.lam[128 + F.lane] * p.lam[192 + F.lane]);
        if (F.lane == 0) misc[0] = __expf(a) - __expf(b) + LAMBDA_INIT0;
        for (int i = F.lane; i < 1024; i += 64) { const int pos = i >> 4, f = i & 15; const float inv = powf(10000.f, -(float)f / 16.f); const float ang = (float)pos * inv;
            misc[1024 + 2 * i] = cosf(ang); misc[1024 + 2 * i + 1] = sinf(ang); }
    }
    float* scr = (float*)(F.lds + 36864 + F.wave * 8704);
    const int gw = F.bid * NWAVES + F.wave, NGW = F.G * NWAVES;
    constexpr int I_QKV = 16 * 96, I_SQ = 16 * 32, I_G = 16 * 16, I_D = 8 * 32;
    constexpr int I_MOE = 2 * I_G + I_D;
    constexpr int NITEMS = 2 * I_QKV + 2 * I_SQ + 32 * I_MOE;
    bf16* ws16 = (bf16*)p.ws;
    for (int it = gw; it < NITEMS; it += NGW) {
        int r = it;
        if (r < I_QKV) { p0_transpose_item<0>(p.w_qkv, 1024, 3072, (bf16*)(p.ws + WS_WQKV), 0, scr, r, F.lane); continue; } r -= I_QKV;
        if (r < I_QKV) { p0_transpose_item<0>(p.gw_in, 1024, 3072, (bf16*)(p.ws + WS_WIN), 0, scr, r, F.lane); continue; } r -= I_QKV;
        if (r < I_SQ) { p0_transpose_item<0>(p.w_o, 1024, 1024, (bf16*)(p.ws + WS_WO), 0, scr, r, F.lane); continue; } r -= I_SQ;
        if (r < I_SQ) { p0_transpose_item<0>(p.gw_o, 1024, 1024, (bf16*)(p.ws + WS_WGO), 0, scr, r, F.lane); continue; } r -= I_SQ;
        const int le = r / I_MOE, layer = le >> 4, e = le & 15; r -= le * I_MOE;
        bf16* GU = (bf16*)(p.ws + (layer ? WS_GU1 : WS_GU0)) + (size_t)e * 1024 * 1024; bf16* DN = (bf16*)(p.ws + (layer ? WS_DN1 : WS_DN0)) + (size_t)e * 1024 * 512;
        if (r < I_G) { p0_transpose_item<1>(p.mg + (size_t)le * 1024 * 512, 1024, 512, GU, 0, scr, r, F.lane); continue; } r -= I_G;
        if (r < I_G) { p0_transpose_item<2>(p.mu + (size_t)le * 1024 * 512, 1024, 512, GU, 0, scr, r, F.lane); continue; } r -= I_G;
        p0_transpose_item<0>(p.md + (size_t)le * 512 * 1024, 512, 1024, DN, 0, scr, r, F.lane);
    }
    (void)ws16;
    bf16* WIN = (bf16*)(p.ws + WS_WIN);
    for (int i = gw * 64 + F.lane; i < 32 * 1024; i += NGW * 64) { const int rr = i >> 10, k = i & 1023, dir = rr >> 4, j = rr & 15;
        WIN[(size_t)(3072 + rr) * 1024 + k] = (bf16)f2bf(p.gwg_down[(size_t)dir * 1024 * 16 + k * 16 + j]); }
    for (int i = gw * 64 + F.lane; i < 224 * 1024 / 8; i += NGW * 64) *(u32x4*)(WIN + (size_t)3104 * 1024 + (size_t)i * 8) = (u32x4){0u, 0u, 0u, 0u};
}

__device__ __forceinline__ void phase_modulate0(const Frame& F, const Prm& p) {
    const float* MOD = (const float*)(p.ws + WS_MOD); bf16* H = (bf16*)(p.ws + WS_H);
    const int gw = F.bid * NWAVES + F.wave, NGW = F.G * NWAVES, per = (NTOK + NGW - 1) / NGW;
    int curmod = -1; f32x4 sh[4], sc[4];
    for (int tok = gw * per; tok < (gw + 1) * per && tok < NTOK; ++tok) {
        const int mr = tok < NLAT ? tok / SEQ : 8; const float* src = tok < NLAT ? p.x + (size_t)tok * DM : p.ctx + (size_t)(tok - NLAT) * DM;
        if (mr != curmod) { curmod = mr; ld_row_f32(MOD + mr * 6144, F.lane, sh); ld_row_f32(MOD + mr * 6144 + 1024, F.lane, sc); }
        f32x4 v[4]; ld_row_f32(src, F.lane, v);
#pragma unroll
        for (int j = 0; j < 4; ++j) v[j] = v[j] * (1.f + sc[j]) + sh[j];
        st_row_bf16(H + (size_t)tok * DM, F.lane, v);
    }
}

__device__ __forceinline__ void phase_attn_combine(const Frame& F, const Prm& p) {
    const bf16* O1 = (const bf16*)(p.ws + WS_O1); const bf16* O2 = (const bf16*)(p.ws + WS_O2); bf16* A2 = (bf16*)(p.ws + WS_A2);
    const float lam = ((const float*)(p.ws + WS_MISC))[0];
    const f32x4 sg = *(const f32x4*)(p.subln + 4 * (F.lane & 31));
    const int gw = F.bid * NWAVES + F.wave, NGW = F.G * NWAVES;
    for (int tok = gw; tok < NTOK; tok += NGW) {
        f32x4 a[4], b[4]; ld_row_bf16(O1 + (size_t)tok * DM, F.lane, a); ld_row_bf16(O2 + (size_t)tok * DM, F.lane, b);
#pragma unroll
        for (int j = 0; j < 4; ++j) {
            f32x4 o = a[j] - lam * b[j]; float q = (o.x * o.x + o.y * o.y) + (o.z * o.z + o.w * o.w);
#pragma unroll
            for (int s = 1; s < 32; s <<= 1) q += __shfl_xor(q, s);
            const float r = (1.f - LAMBDA_INIT0) / sqrtf(q * (1.f / 128.f) + LN_EPS);
            a[j] = o * r * sg;
        }
        st_row_bf16(A2 + (size_t)tok * DM, F.lane, a);
    }
}

__device__ __forceinline__ void phase_ln_route(const Frame& F, const Prm& p, int layer) {
    const int nrows = layer ? NLAT : NTOK;
    const float* MOD = (const float*)(p.ws + WS_MOD) + layer * 9 * 6144;
    const bf16* Y = (const bf16*)(p.ws + WS_Y); bf16* HF = (bf16*)(p.ws + WS_H);
    float* XCTX = (float*)(p.ws + WS_XCTX);
    int* LIST = (int*)(p.ws + WS_LIST); int* TOKR = (int*)(p.ws + WS_TOKR);
    unsigned* CNT = F.ctl + CW_CNT + layer * 16;
    float* WrT = (float*)F.lds;
    int* rec = (int*)(F.lds + 65536);
    unsigned* lcnt = (unsigned*)(F.lds + 65536 + 8192); unsigned* lbase = lcnt + 16;
    for (int i = F.tid; i < 16 * 1024; i += NTHR) { const int k = i >> 4, e = i & 15; WrT[e * 1024 + k] = p.rw[i]; }
    if (F.tid < 16) lcnt[F.tid] = 0u;
    __syncthreads();
    const int per_wg = (nrows + F.G - 1) / F.G, per_w = (per_wg + NWAVES - 1) / NWAVES;
    const int row_lo = F.bid * per_wg, row_hi = min(nrows, row_lo + per_wg);
    const float* lng = p.ln_g + (layer * 2 + 0) * DM; const float* lnb = p.ln_b + (layer * 2 + 0) * DM;
    float rb[16];
#pragma unroll
    for (int e = 0; e < 16; ++e) rb[e] = p.rb[e];
    int curmod = -1; f32x4 gm[4], shf[4], scf[4];
    for (int i = 0; i < per_w; ++i) {
        const int lr = F.wave * per_w + i, tok = row_lo + lr; if (tok >= row_hi) break;
        const int mr = tok < NLAT ? tok / SEQ : 8;
        if (mr != curmod) { curmod = mr; ld_row_f32(MOD + mr * 6144 + 2048, F.lane, gm); ld_row_f32(MOD + mr * 6144 + 3072, F.lane, shf); ld_row_f32(MOD + mr * 6144 + 4096, F.lane, scf); }
        float* xdst = tok < NLAT ? p.out + (size_t)tok * DM : XCTX + (size_t)(tok - NLAT) * DM;
        const float* xsrc = layer ? (const float*)xdst : (tok < NLAT ? p.x + (size_t)tok * DM : p.ctx + (size_t)(tok - NLAT) * DM);
        f32x4 v[4], y[4]; ld_row_f32(xsrc, F.lane, v); ld_row_bf16(Y + (size_t)tok * DM, F.lane, y);
#pragma unroll
        for (int j = 0; j < 4; ++j) v[j] = ALPHA * v[j] + gm[j] * y[j];
        ln_row(v, lng, lnb, F.lane);
        st_row_f32(xdst, F.lane, v);
#pragma unroll
        for (int j = 0; j < 4; ++j) v[j] = v[j] * (1.f + scf[j]) + shf[j];
        st_row_bf16(HF + (size_t)tok * DM, F.lane, v);
        float part[16];
#pragma unroll
        for (int e = 0; e < 16; ++e) { float s = 0.f;
#pragma unroll
            for (int j = 0; j < 4; ++j) { const f32x4 w = *(const f32x4*)(WrT + e * 1024 + 4 * F.lane + 256 * j); s += (v[j].x * w.x + v[j].y * w.y) + (v[j].z * w.z + v[j].w * w.w); }
            part[e] = s; }
        {
#pragma unroll
            for (int e = 0; e < 8; ++e) { const bool up = (F.lane & 32) != 0; const float keep = up ? part[e + 8] : part[e], send = up ? part[e] : part[e + 8]; part[e] = keep + __shfl_xor(send, 32); }
#pragma unroll
            for (int e = 0; e < 4; ++e) { const bool up = (F.lane & 16) != 0; const float keep = up ? part[e + 4] : part[e], send = up ? part[e] : part[e + 4]; part[e] = keep + __shfl_xor(send, 16); }
#pragma unroll
            for (int e = 0; e < 2; ++e) { const bool up = (F.lane & 8) != 0; const float keep = up ? part[e + 2] : part[e], send = up ? part[e] : part[e + 2]; part[e] = keep + __shfl_xor(send, 8); }
            { const bool up = (F.lane & 4) != 0; const float keep = up ? part[1] : part[0], send = up ? part[0] : part[1]; part[0] = keep + __shfl_xor(send, 4); }
            part[0] += __shfl_xor(part[0], 2); part[0] += __shfl_xor(part[0], 1);
        }
        float aff[16], sel[16];
#pragma unroll
        for (int e = 0; e < 16; ++e) { const int src = ((e >> 3) & 1) * 32 + ((e >> 2) & 1) * 16 + ((e >> 1) & 1) * 8 + (e & 1) * 4; const float lg = __shfl(part[0], src); aff[e] = 1.f / (1.f + __expf(-lg)); sel[e] = aff[e] + rb[e]; }
        int bg = 0; float bgs = -3.0e38f;
#pragma unroll
        for (int g = 0; g < 4; ++g) { float m1 = -3.0e38f, m2 = -3.0e38f;
#pragma unroll
            for (int k = 0; k < 4; ++k) { const float s = sel[4 * g + k]; if (s > m1) { m2 = m1; m1 = s; } else if (s > m2) m2 = s; }
            const float gs = m1 + m2; if (gs > bgs) { bgs = gs; bg = g; } }
        int i1 = 0, i2 = 0; float s1 = -3.0e38f, s2 = -3.0e38f, a1 = 0.f, a2 = 0.f;
#pragma unroll
        for (int g = 0; g < 4; ++g) if (g == bg) {
#pragma unroll
            for (int k = 0; k < 4; ++k) { const float s = sel[4 * g + k], a = aff[4 * g + k];
                if (s > s1) { s2 = s1; i2 = i1; a2 = a1; s1 = s; i1 = 4 * g + k; a1 = a; } else if (s > s2) { s2 = s; i2 = 4 * g + k; a2 = a; } } }
        const float wsum = a1 + a2, w1 = a1 / wsum, w2 = a2 / wsum;
        if (F.lane == 0) { const unsigned l1 = atomicAdd(&lcnt[i1], 1u), l2 = atomicAdd(&lcnt[i2], 1u);
            rec[lr * 6 + 0] = i1; rec[lr * 6 + 1] = i2; rec[lr * 6 + 2] = (int)l1; rec[lr * 6 + 3] = (int)l2; rec[lr * 6 + 4] = __float_as_int(w1); rec[lr * 6 + 5] = __float_as_int(w2); }
    }
    __syncthreads();
    if (F.tid < 16) lbase[F.tid] = __hip_atomic_fetch_add(&CNT[F.tid], lcnt[F.tid], __ATOMIC_RELAXED, __HIP_MEMORY_SCOPE_AGENT);
    __syncthreads();
    for (int lr = F.tid; lr < row_hi - row_lo; lr += NTHR) { const int tok = row_lo + lr;
        const int e0 = rec[lr * 6], e1 = rec[lr * 6 + 1]; const int p0 = (int)lbase[e0] + rec[lr * 6 + 2], p1 = (int)lbase[e1] + rec[lr * 6 + 3];
        LIST[e0 * NTOK + p0] = tok; LIST[e1 * NTOK + p1] = tok;
        int* tr = TOKR + (size_t)tok * 8; tr[0] = e0; tr[1] = p0; tr[2] = e1; tr[3] = p1; tr[4] = rec[lr * 6 + 4]; tr[5] = rec[lr * 6 + 5]; }
    __syncthreads();
}

__device__ __forceinline__ void pad_bases(const unsigned* cnt, int (&pb)[17]) {
    int acc = 0;
#pragma unroll
    for (int e = 0; e < 16; ++e) { pb[e] = acc; const int c = (int)__hip_atomic_load(cnt + e, __ATOMIC_RELAXED, __HIP_MEMORY_SCOPE_AGENT); acc += (c + 255) & ~255; }
    pb[16] = acc;
}

__device__ __forceinline__ void phase_moe_combine(const Frame& F, const Prm& p, int layer) {
    const int nrows = layer ? NLAT : NTOK;
    const float* MOD = (const float*)(p.ws + WS_MOD) + layer * 9 * 6144; const float* MOD1 = (const float*)(p.ws + WS_MOD) + 9 * 6144;
    const bf16* YM = (const bf16*)(p.ws + WS_YM); bf16* H = (bf16*)(p.ws + WS_H); float* XCTX = (float*)(p.ws + WS_XCTX); const int* TOKR = (const int*)(p.ws + WS_TOKR);
    int pb[17]; pad_bases(F.ctl + CW_CNT + layer * 16, pb);
    int* pbl = (int*)F.lds; if (F.tid < 17) { int v = 0;
#pragma unroll
        for (int e = 0; e < 17; ++e) if (e == F.tid) v = pb[e];
        pbl[F.tid] = v; }
    __syncthreads();
    const float* lng = p.ln_g + (layer * 2 + 1) * DM; const float* lnb = p.ln_b + (layer * 2 + 1) * DM;
    const int gw = F.bid * NWAVES + F.wave, NGW = F.G * NWAVES, per = (nrows + NGW - 1) / NGW;
    int curmod = -1; f32x4 gf[4], sh1[4], sc1[4];
    for (int tok = gw * per; tok < (gw + 1) * per && tok < nrows; ++tok) {
        const int mr = tok < NLAT ? tok / SEQ : 8;
        if (mr != curmod) { curmod = mr; ld_row_f32(MOD + mr * 6144 + 5120, F.lane, gf); if (!layer) { ld_row_f32(MOD1 + mr * 6144, F.lane, sh1); ld_row_f32(MOD1 + mr * 6144 + 1024, F.lane, sc1); } }
        const int* tr = TOKR + (size_t)tok * 8; const int s0 = pbl[tr[0]] + tr[1], s1 = pbl[tr[2]] + tr[3]; const float w0 = __int_as_float(tr[4]), w1 = __int_as_float(tr[5]);
        float* xp = tok < NLAT ? p.out + (size_t)tok * DM : XCTX + (size_t)(tok - NLAT) * DM;
        f32x4 v[4], a[4], b[4]; ld_row_f32(xp, F.lane, v); ld_row_bf16(YM + (size_t)s0 * DM, F.lane, a); ld_row_bf16(YM + (size_t)s1 * DM, F.lane, b);
#pragma unroll
        for (int j = 0; j < 4; ++j) v[j] = ALPHA * v[j] + gf[j] * (w0 * a[j] + w1 * b[j]);
        ln_row(v, lng, lnb, F.lane);
        st_row_f32(xp, F.lane, v);
        if (!layer) {
#pragma unroll
            for (int j = 0; j < 4; ++j) v[j] = v[j] * (1.f + sc1[j]) + sh1[j];
            st_row_bf16(H + (size_t)tok * DM, F.lane, v);
        }
    }
}

__device__ __forceinline__ void phase_gla_prep(const Frame& F, const Prm& p) {
    const bf16* QR = (const bf16*)(p.ws + WS_QR); const bf16* KR = (const bf16*)(p.ws + WS_KR); const float* ZZ = (const float*)(p.ws + WS_ZZ);
    bf16* QT = (bf16*)(p.ws + WS_QT); bf16* KT = (bf16*)(p.ws + WS_KT); float* DEC = (float*)(p.ws + WS_DEC);
    const int gw = F.bid * NWAVES + F.wave, NGW = F.G * NWAVES;
    for (int task = gw; task < 2 * NCHUNK * 8; task += NGW) {
        const int dh = task & 7, chunk = (task >> 3) % NCHUNK, dir = task / (8 * NCHUNK);
        const int col = dh * 64 + F.lane, tok0 = chunk * 64;
        float wup[16];
#pragma unroll
        for (int j = 0; j < 16; ++j) wup[j] = p.gwg_up[(size_t)dir * 16 * 512 + j * 512 + col];
        const float bgv = p.gbg[dir * 512 + col];
        float b = 0.f;
#pragma unroll 4
        for (int tt = 0; tt < 64; ++tt) {
            const int t = dir ? 63 - tt : tt, tok = tok0 + t;
            const float* zr = ZZ + (size_t)tok * 32 + dir * 16; float z = bgv;
#pragma unroll
            for (int j = 0; j < 16; j += 4) { const f32x4 zv = *(const f32x4*)(zr + j); z += zv.x * wup[j] + zv.y * wup[j + 1] + zv.z * wup[j + 2] + zv.w * wup[j + 3]; }
            const float g = (fminf(z, 0.f) - log1pf(__expf(-fabsf(z)))) * (1.f / 16.f);
            b += g;
            const float q = bf2f(QR[(size_t)tok * 512 + col]), k = bf2f(KR[(size_t)tok * 512 + col]);
            QT[((size_t)dir * NTOK + tok) * 512 + col] = (bf16)f2bf(q * __expf(b)); KT[((size_t)dir * NTOK + tok) * 512 + col] = (bf16)f2bf(k * __expf(-b));
        }
        DEC[((size_t)dir * NCHUNK + chunk) * 512 + col] = __expf(b);
    }
}

__device__ __forceinline__ void phase_gla_post(const Frame& F, const Prm& p) {
    const bf16* OF = (const bf16*)(p.ws + WS_OGF); const bf16* OB = (const bf16*)(p.ws + WS_OGB); const bf16* R = (const bf16*)(p.ws + WS_R); bf16* A2 = (bf16*)(p.ws + WS_A2B);
    const f32x4 ng = *(const f32x4*)(p.gnorm + 4 * F.lane);
    const int gw = F.bid * NWAVES + F.wave, NGW = F.G * NWAVES;
    for (int tok = gw; tok < NLAT; tok += NGW) {
        f32x4 a[4], b[4], r[4]; ld_row_bf16(OF + (size_t)tok * DM, F.lane, a); ld_row_bf16(OB + (size_t)tok * DM, F.lane, b); ld_row_bf16(R + (size_t)tok * DM, F.lane, r);
#pragma unroll
        for (int j = 0; j < 4; ++j) {
            const f32x4 o = a[j] + b[j]; const float q = wave_sum((o.x * o.x + o.y * o.y) + (o.z * o.z + o.w * o.w));
            const float rs = 1.f / sqrtf(q * (1.f / 256.f) + LN_EPS);
            a[j] = (f32x4){o.x * rs * ng.x * silu_f(r[j].x), o.y * rs * ng.y * silu_f(r[j].y), o.z * rs * ng.z * silu_f(r[j].z), o.w * rs * ng.w * silu_f(r[j].w)};
        }
        st_row_bf16(A2 + (size_t)tok * DM, F.lane, a);
    }
}
namespace naive {
enum { EPI_QKV = 0, EPI_PLAIN = 1, EPI_GATEUP = 2, EPI_DOWN = 3, EPI_INPROJ = 4 };
struct NG { const bf16* A; const bf16* Bt; int M, N, K; int layer; bf16* O; };
template <int EPI> __global__ __launch_bounds__(256) void gemm_kernel(NG g, Prm p) {
    __shared__ float As[64][33], Bs[64][33], Cs[64][65]; __shared__ int rowsrc[64];
    const int tid = threadIdx.x, n0 = blockIdx.x * 64, m0 = blockIdx.y * 64, ty = tid >> 4, tx = tid & 15;
    const bf16* Bt = g.Bt; int e = 0, ebase = 0, ecnt = 0;
    if (EPI == EPI_GATEUP || EPI == EPI_DOWN) {
        const unsigned* cnt = (const unsigned*)(p.ws + WS_CTL) + CW_CNT + g.layer * 16; int acc = 0; bool found = false;
        for (int i = 0; i < 16; ++i) { const int c = (int)cnt[i], pc = (c + 255) & ~255; if (!found && m0 < acc + pc) { e = i; ebase = acc; ecnt = c; found = true; } acc += pc; }
        if (!found || m0 - ebase >= ecnt) return;
        Bt += (size_t)e * g.N * g.K;
    }
    if (tid < 64) { int r = m0 + tid;
        if (EPI == EPI_GATEUP) { const int li = m0 - ebase + tid; const int* LIST = (const int*)(p.ws + WS_LIST); r = (li < ecnt) ? LIST[e * NTOK + li] : 0; }
        rowsrc[tid] = r; }
    __syncthreads();
    float acc[4][4] = {};
    for (int k0 = 0; k0 < g.K; k0 += 32) {
        { const int r = tid >> 2, kc = (tid & 3) * 8; const u32x4 ua = *(const u32x4*)(g.A + (size_t)rowsrc[r] * g.K + k0 + kc), ub = *(const u32x4*)(Bt + (size_t)(n0 + r) * g.K + k0 + kc);
            const unsigned a4[4] = {ua.x, ua.y, ua.z, ua.w}, b4[4] = {ub.x, ub.y, ub.z, ub.w};
#pragma unroll
            for (int i = 0; i < 4; ++i) { As[r][kc + 2 * i] = bf2f(a4[i] & 0xffffu); As[r][kc + 2 * i + 1] = bf2f(a4[i] >> 16); Bs[r][kc + 2 * i] = bf2f(b4[i] & 0xffffu); Bs[r][kc + 2 * i + 1] = bf2f(b4[i] >> 16); } }
        __syncthreads();
#pragma unroll 8
        for (int kk = 0; kk < 32; ++kk) { float a[4], b[4];
#pragma unroll
            for (int i = 0; i < 4; ++i) { a[i] = As[4 * ty + i][kk]; b[i] = Bs[4 * tx + i][kk]; }
#pragma unroll
            for (int i = 0; i < 4; ++i)
#pragma unroll
                for (int j = 0; j < 4; ++j) acc[i][j] += a[i] * b[j]; }
        __syncthreads();
    }
#pragma unroll
    for (int i = 0; i < 4; ++i)
#pragma unroll
        for (int j = 0; j < 4; ++j) Cs[4 * ty + i][4 * tx + j] = acc[i][j];
    __syncthreads();
    const float* rope = (const float*)(p.ws + WS_MISC) + 1024;
    for (int idx = tid; idx < 4096; idx += 256) {
        const int r = idx >> 6, cc = idx & 63, n = n0 + cc, row = m0 + r; const float val = Cs[r][cc];
        if (EPI == EPI_QKV) {
            if (n < 2048) { float o = val;
                if (row < NLAT) { const int d = n & 63, s = row & (SEQ - 1), pos = (d & 32) ? (s & 63) : (s >> 6), f = d & 15; const float cs = rope[(pos * 16 + f) * 2], sn = rope[(pos * 16 + f) * 2 + 1];
                    o = (d & 16) ? val * cs + Cs[r][cc - 16] * sn : val * cs - Cs[r][cc + 16] * sn; }
                if (n < 1024) ((bf16*)(p.ws + WS_Q))[(size_t)row * DM + n] = (bf16)f2bf(o * C2); else ((bf16*)(p.ws + WS_K))[(size_t)row * DM + n - 1024] = (bf16)f2bf(o);
            } else ((bf16*)(p.ws + WS_V))[(size_t)row * DM + n - 2048] = (bf16)f2bf(val);
        } else if (EPI == EPI_PLAIN) { g.O[(size_t)row * g.N + n] = (bf16)f2bf(val);
        } else if (EPI == EPI_GATEUP) { if (!(cc & 16)) { const float gt = val, up = Cs[r][cc + 16]; const int other = (n >> 5) * 16 + (n & 15); ((bf16*)(p.ws + WS_ACT))[(size_t)row * DEXP + other] = (bf16)f2bf(silu_f(gt) * up); }
        } else if (EPI == EPI_DOWN) { ((bf16*)(p.ws + WS_YM))[(size_t)row * DM + n] = (bf16)f2bf(val);
        } else if (EPI == EPI_INPROJ) {
            if (n < 512) ((bf16*)(p.ws + WS_QR))[(size_t)row * 512 + n] = (bf16)f2bf(val * 0.08838834764831845f);
            else if (n < 1024) ((bf16*)(p.ws + WS_KR))[(size_t)row * 512 + n - 512] = (bf16)f2bf(val);
            else if (n < 2048) ((bf16*)(p.ws + WS_V1))[(size_t)row * DM + n - 1024] = (bf16)f2bf(val);
            else if (n < 3072) ((bf16*)(p.ws + WS_R))[(size_t)row * DM + n - 2048] = (bf16)f2bf(val);
            else if (n < 3104) ((float*)(p.ws + WS_ZZ))[(size_t)row * 32 + n - 3072] = val;
        }
    }
}
__global__ __launch_bounds__(256) void attn_kernel(Prm p) {
    __shared__ float Qs[64][65], Ks[32][65], Ps[64][33], Vs[32][129], al[64];
    const bf16* Q = (const bf16*)(p.ws + WS_Q); const bf16* K = (const bf16*)(p.ws + WS_K); const bf16* V = (const bf16*)(p.ws + WS_V);
    const int tid = threadIdx.x, ty = tid >> 4, tx = tid & 15, qb = blockIdx.x, hm = blockIdx.y, h = hm >> 1;
    const bool lat = qb < 512; const int b = lat ? qb >> 6 : (qb - 512) >> 2; const int tok0 = lat ? qb * 64 : NLAT + (qb - 512) * 64;
    bf16* O = (bf16*)(p.ws + ((hm & 1) ? WS_O2 : WS_O1));
    for (int i = tid; i < 4096; i += 256) { const int r = i >> 6, d = i & 63; Qs[r][d] = bf2f(Q[(size_t)(tok0 + r) * DM + hm * 64 + d]); }
    float o[4][8] = {}; float mrow = -3.0e38f, lrow = 0.f;
    const int nkt = lat ? (CTXL + SEQ) / 32 : CTXL / 32;
    for (int kt = 0; kt < nkt; ++kt) {
        const int key0 = (kt < CTXL / 32) ? NLAT + b * CTXL + kt * 32 : b * SEQ + (kt - CTXL / 32) * 32;
        __syncthreads();
        for (int i = tid; i < 2048; i += 256) { const int r = i >> 6, d = i & 63; Ks[r][d] = bf2f(K[(size_t)(key0 + r) * DM + hm * 64 + d]); }
        for (int i = tid; i < 4096; i += 256) { const int r = i >> 7, d = i & 127; Vs[r][d] = bf2f(V[(size_t)(key0 + r) * DM + h * 128 + d]); }
        __syncthreads();
        float s[4][2] = {};
        for (int d = 0; d < 64; ++d) { float a[4], bb[2];
#pragma unroll
            for (int i = 0; i < 4; ++i) a[i] = Qs[4 * ty + i][d];
            bb[0] = Ks[2 * tx][d]; bb[1] = Ks[2 * tx + 1][d];
#pragma unroll
            for (int i = 0; i < 4; ++i) { s[i][0] += a[i] * bb[0]; s[i][1] += a[i] * bb[1]; } }
#pragma unroll
        for (int i = 0; i < 4; ++i) { Ps[4 * ty + i][2 * tx] = s[i][0]; Ps[4 * ty + i][2 * tx + 1] = s[i][1]; }
        __syncthreads();
        if (tid < 64) { float mx = mrow;
            for (int j = 0; j < 32; ++j) mx = fmaxf(mx, Ps[tid][j]);
            const float a = exp2f(mrow - mx); float sum = 0.f;
            for (int j = 0; j < 32; ++j) { const float e = exp2f(Ps[tid][j] - mx); Ps[tid][j] = e; sum += e; }
            lrow = lrow * a + sum; mrow = mx; al[tid] = a; }
        __syncthreads();
#pragma unroll
        for (int i = 0; i < 4; ++i) { const float a = al[4 * ty + i];
#pragma unroll
            for (int j = 0; j < 8; ++j) o[i][j] *= a; }
        for (int kk = 0; kk < 32; ++kk) { float pv[4], vv[8];
#pragma unroll
            for (int i = 0; i < 4; ++i) pv[i] = Ps[4 * ty + i][kk];
#pragma unroll
            for (int j = 0; j < 8; ++j) vv[j] = Vs[kk][8 * tx + j];
#pragma unroll
            for (int i = 0; i < 4; ++i)
#pragma unroll
                for (int j = 0; j < 8; ++j) o[i][j] += pv[i] * vv[j]; }
    }
    __syncthreads();
    if (tid < 64) al[tid] = 1.f / lrow;
    __syncthreads();
#pragma unroll
    for (int i = 0; i < 4; ++i) { const float a = al[4 * ty + i];
#pragma unroll
        for (int j = 0; j < 8; ++j) O[(size_t)(tok0 + 4 * ty + i) * DM + h * 128 + 8 * tx + j] = (bf16)f2bf(o[i][j] * a); }
}
__global__ __launch_bounds__(256) void gla_scan_kernel(Prm p) {
    extern __shared__ __attribute__((aligned(16))) unsigned char sm[];
    float (*S)[33] = (float (*)[33])sm;
    float (*Qs)[129] = (float (*)[129])(sm + 128 * 33 * 4);
    float (*Ks)[129] = (float (*)[129])(sm + 128 * 33 * 4 + 64 * 129 * 4);
    float (*Vs)[33] = (float (*)[33])(sm + 128 * 33 * 4 + 2 * 64 * 129 * 4);
    float (*Ps)[65] = (float (*)[65])(sm + 128 * 33 * 4 + 2 * 64 * 129 * 4 + 64 * 33 * 4);
    float* dec = (float*)(sm + 128 * 33 * 4 + 2 * 64 * 129 * 4 + 64 * 33 * 4 + 64 * 65 * 4);
    const bf16* QT = (const bf16*)(p.ws + WS_QT); const bf16* KT = (const bf16*)(p.ws + WS_KT); const bf16* V = (const bf16*)(p.ws + WS_V1); const float* DEC = (const float*)(p.ws + WS_DEC);
    const int tid = threadIdx.x, ty = tid >> 4, tx = tid & 15, vs = blockIdx.x & 7, dir = (blockIdx.x >> 3) & 1, h = (blockIdx.x >> 4) & 3, b = blockIdx.x >> 6;
    bf16* OG = (bf16*)(p.ws + (dir ? WS_OGB : WS_OGF));
    for (int i = tid; i < 128 * 32; i += 256) S[i >> 5][i & 31] = 0.f;
    for (int step = 0; step < 68; ++step) {
        const bool lat = step >= 4; const int ci = lat ? step - 4 : step;
        const int chunk = lat ? b * 64 + (dir ? 63 - ci : ci) : 512 + b * 4 + (dir ? 3 - ci : ci); const int tok0 = chunk * 64;
        __syncthreads();
        for (int i = tid; i < 64 * 128; i += 256) { const int t = i >> 7, d = i & 127; const size_t off = ((size_t)dir * NTOK + tok0 + t) * 512 + h * 128 + d; Qs[t][d] = bf2f(QT[off]); Ks[t][d] = bf2f(KT[off]); }
        for (int i = tid; i < 64 * 32; i += 256) { const int t = i >> 5, v = i & 31; Vs[t][v] = bf2f(V[(size_t)(tok0 + t) * DM + h * 256 + vs * 32 + v]); }
        if (tid < 128) dec[tid] = DEC[((size_t)dir * NCHUNK + chunk) * 512 + h * 128 + tid];
        __syncthreads();
        if (lat) {
            float s[4][4] = {};
            for (int d = 0; d < 128; ++d) { float a[4], bb[4];
#pragma unroll
                for (int i = 0; i < 4; ++i) { a[i] = Qs[4 * ty + i][d]; bb[i] = Ks[4 * tx + i][d]; }
#pragma unroll
                for (int i = 0; i < 4; ++i)
#pragma unroll
                    for (int j = 0; j < 4; ++j) s[i][j] += a[i] * bb[j]; }
#pragma unroll
            for (int i = 0; i < 4; ++i)
#pragma unroll
                for (int j = 0; j < 4; ++j) { const int t = 4 * ty + i, sidx = 4 * tx + j; const bool keep = dir ? (sidx >= t) : (sidx <= t); Ps[t][sidx] = keep ? s[i][j] : 0.f; }
            __syncthreads();
            float o[4][2] = {};
            for (int sidx = 0; sidx < 64; ++sidx) { const float v0 = Vs[sidx][2 * tx], v1 = Vs[sidx][2 * tx + 1];
#pragma unroll
                for (int i = 0; i < 4; ++i) { const float pp = Ps[4 * ty + i][sidx]; o[i][0] += pp * v0; o[i][1] += pp * v1; } }
            for (int d = 0; d < 128; ++d) { const float s0 = S[d][2 * tx], s1 = S[d][2 * tx + 1];
#pragma unroll
                for (int i = 0; i < 4; ++i) { const float qq = Qs[4 * ty + i][d]; o[i][0] += qq * s0; o[i][1] += qq * s1; } }
#pragma unroll
            for (int i = 0; i < 4; ++i) { const size_t off = (size_t)(tok0 + 4 * ty + i) * DM + h * 256 + vs * 32 + 2 * tx; OG[off] = (bf16)f2bf(o[i][0]); OG[off + 1] = (bf16)f2bf(o[i][1]); }
            __syncthreads();
        }
        float u[8][2] = {};
        for (int sidx = 0; sidx < 64; ++sidx) { const float v0 = Vs[sidx][2 * tx], v1 = Vs[sidx][2 * tx + 1];
#pragma unroll
            for (int i = 0; i < 8; ++i) { const float kk = Ks[sidx][8 * ty + i]; u[i][0] += kk * v0; u[i][1] += kk * v1; } }
#pragma unroll
        for (int i = 0; i < 8; ++i) { const int d = 8 * ty + i; S[d][2 * tx] = dec[d] * (S[d][2 * tx] + u[i][0]); S[d][2 * tx + 1] = dec[d] * (S[d][2 * tx + 1] + u[i][1]); }
    }
}
constexpr int GLA_SCAN_LDS = 128 * 33 * 4 + 2 * 64 * 129 * 4 + 64 * 33 * 4 + 64 * 65 * 4 + 512;
}
namespace pg8 {
typedef short bf16x8 __attribute__((ext_vector_type(8)));
constexpr int BM = 256, BK = 64, HALF = 128, HTB = HALF * BK * 2, STAGE_BYTES = 8 * HTB, NXCD = 8, WGM = 8;
__host__ __device__ __forceinline__ int lds_byte(int r, int c) { const int st = (r >> 4) * 2 + (c >> 5), rr = r & 15, cc = c & 31, ob = rr * 64 + cc * 2; return st * 1024 + (ob ^ (((ob >> 9) & 1) << 5)); }
__host__ __device__ __forceinline__ void stage_rc(int b, int& R, int& C) { const int st = b / 1024, sb = b % 1024, swz = sb ^ (((sb >> 9) & 1) << 5); R = (st >> 1) * 16 + swz / 64; C = (st & 1) * 32 + (swz % 64) / 2; }
typedef float f32x2_t __attribute__((ext_vector_type(2))); typedef __bf16 bf16x2_t __attribute__((ext_vector_type(2)));
__device__ __forceinline__ unsigned cvt_pk_bf16(float lo, float hi) { f32x2_t v = {lo, hi}; bf16x2_t b = __builtin_convertvector(v, bf16x2_t); return __builtin_bit_cast(unsigned, b); }

struct Unit { int pm, pn; int row0; int e; int cnt; const bf16* Bt; };

struct DenseOrder {
    int nM, nN, nwg, G, c, K; const bf16* Bt;
    __device__ void init(int M, int N, int K_, const bf16* Bt_, int G_, int c_) { nM = M / BM; nN = N / BM; nwg = nM * nN; G = G_; c = c_; K = K_; Bt = Bt_; }
    __device__ bool next(int i, Unit& u) const {
        const long L = (long)i * G + c; if (L >= nwg) return false;
        int wgid = (int)L; { const int q = nwg / NXCD, r = nwg % NXCD, xcd = wgid % NXCD, off = wgid / NXCD; wgid = (xcd < r ? xcd * (q + 1) : r * (q + 1) + (xcd - r) * q) + off; }
        const int nig = WGM * nN, gid = wgid / nig, fm = gid * WGM, gsz = (nM - fm) < WGM ? (nM - fm) : WGM;
        u.pm = fm + ((wgid % nig) % gsz); u.pn = (wgid % nig) / gsz; u.row0 = u.pm * BM; u.e = 0; u.cnt = 0; u.Bt = Bt; return true;
    }
    __device__ __forceinline__ unsigned arow(const Unit& u, int r) const { return (unsigned)(u.row0 + r) * (unsigned)(K * 2); }
};
template <bool GATHER> struct MoeOrder {
    int cnt[16]; int nN, G, c, K; const bf16* Bt0; size_t bstride; const int* LIST;
    __device__ void init(const unsigned* cntw, int N, int K_, const bf16* Bt0_, const int* LIST_, int G_, int c_) {
#pragma unroll
        for (int e = 0; e < 16; ++e) cnt[e] = (int)__hip_atomic_load(cntw + e, __ATOMIC_RELAXED, __HIP_MEMORY_SCOPE_AGENT);
        nN = N / BM; G = G_; c = c_; K = K_; Bt0 = Bt0_; bstride = (size_t)N * K_; LIST = LIST_; }
    __device__ bool next(int i, Unit& u) const {
        int L = i * G + c, base = 0; bool found = false; u.pm = 0; u.pn = 0; u.row0 = 0; u.e = 0; u.cnt = 0; u.Bt = Bt0;
#pragma unroll
        for (int e = 0; e < 16; ++e) { const int mt = (cnt[e] + 255) >> 8, nu = mt * nN;
            if (!found) { if (L < nu) { found = true; u.e = e; u.cnt = cnt[e]; u.pm = L / nN; u.pn = L % nN; u.row0 = base + u.pm * BM; u.Bt = Bt0 + (size_t)e * bstride; } else { L -= nu; base += mt * BM; } } }
        return found;
    }
    __device__ __forceinline__ unsigned arow(const Unit& u, int r) const {
        if (GATHER) { const int li = u.pm * BM + r; int tok = 0; if (li < u.cnt) tok = LIST[u.e * NTOK + li];
            return (unsigned)tok * (unsigned)(K * 2); }
        return (unsigned)(u.row0 + r) * (unsigned)(K * 2);
    }
};

typedef f32x4 Acc[2][2][4][2];
__device__ __forceinline__ void st4bf(bf16* p, f32x4 v) { u32x2 w; w.x = cvt_pk_bf16(v.x, v.y); w.y = cvt_pk_bf16(v.z, v.w); *(u32x2*)p = w; }

struct EpiQKV {
    bf16 *Q; const float* rope;
    __device__ __forceinline__ void operator()(const Acc& acc, const Unit& u, int wr, int wc, int fr, int fq) const {
        const int reg = u.pn >> 2, cbase = (u.pn & 3) * BM + wc * 32 + 4 * fq; bf16* O = Q + (size_t)reg * ((WS_K - WS_Q) / 2);
        const bool dorope = (reg < 2) && (u.row0 < NLAT); const float sc = reg == 0 ? C2 : 1.f;
#pragma unroll
        for (int ai = 0; ai < 2; ++ai)
#pragma unroll
            for (int m = 0; m < 4; ++m) { const int row = u.row0 + ai * HALF + wr * 64 + m * 16 + fr; bf16* rowp = O + (size_t)row * DM + cbase;
                f32x4 cs = {1.f, 1.f, 1.f, 1.f}, sn = {0.f, 0.f, 0.f, 0.f};
                if (dorope) { const int s = row & (SEQ - 1), pos = (wc & 1) ? (s & 63) : (s >> 6); const f32x4 t0 = *(const f32x4*)(rope + (pos * 16 + 4 * fq) * 2), t1 = *(const f32x4*)(rope + (pos * 16 + 4 * fq) * 2 + 4);
                    cs = (f32x4){t0.x, t0.z, t1.x, t1.z}; sn = (f32x4){t0.y, t0.w, t1.y, t1.w}; }
#pragma unroll
                for (int bj = 0; bj < 2; ++bj) { const f32x4 a0 = acc[ai][bj][m][0], a1 = acc[ai][bj][m][1];
                    st4bf(rowp + bj * HALF, (a0 * cs - a1 * sn) * sc); st4bf(rowp + bj * HALF + 16, (a1 * cs + a0 * sn) * sc); } }
    }
};
struct EpiPlain {
    bf16* O;
    __device__ __forceinline__ void operator()(const Acc& acc, const Unit& u, int wr, int wc, int fr, int fq) const {
        const int cbase = u.pn * BM + wc * 32 + 4 * fq;
#pragma unroll
        for (int ai = 0; ai < 2; ++ai)
#pragma unroll
            for (int m = 0; m < 4; ++m) { bf16* rowp = O + (size_t)(u.row0 + ai * HALF + wr * 64 + m * 16 + fr) * DM + cbase;
#pragma unroll
                for (int bj = 0; bj < 2; ++bj)
#pragma unroll
                    for (int n = 0; n < 2; ++n) st4bf(rowp + bj * HALF + n * 16, acc[ai][bj][m][n]); }
    }
};
struct EpiInproj {
    bf16 *QR, *KR, *V, *R; float* ZZ;
    __device__ __forceinline__ void operator()(const Acc& acc, const Unit& u, int wr, int wc, int fr, int fq) const {
        const int pn = u.pn;
        if (pn == 12) { if (wc == 0) {
#pragma unroll
            for (int ai = 0; ai < 2; ++ai)
#pragma unroll
                for (int m = 0; m < 4; ++m) { float* rowp = ZZ + (size_t)(u.row0 + ai * HALF + wr * 64 + m * 16 + fr) * 32 + 4 * fq;
                    *(f32x4*)rowp = acc[ai][0][m][0]; *(f32x4*)(rowp + 16) = acc[ai][0][m][1]; } }
            return; }
        bf16* O; int ld, c0; float sc = 1.f;
        if (pn < 2) { O = QR; ld = 512; c0 = pn * BM; sc = 0.08838834764831845f; } else if (pn < 4) { O = KR; ld = 512; c0 = (pn - 2) * BM; } else if (pn < 8) { O = V; ld = DM; c0 = (pn - 4) * BM; } else { O = R; ld = DM; c0 = (pn - 8) * BM; }
        const int cbase = c0 + wc * 32 + 4 * fq;
#pragma unroll
        for (int ai = 0; ai < 2; ++ai)
#pragma unroll
            for (int m = 0; m < 4; ++m) { bf16* rowp = O + (size_t)(u.row0 + ai * HALF + wr * 64 + m * 16 + fr) * ld + cbase;
#pragma unroll
                for (int bj = 0; bj < 2; ++bj)
#pragma unroll
                    for (int n = 0; n < 2; ++n) st4bf(rowp + bj * HALF + n * 16, acc[ai][bj][m][n] * sc); }
    }
};
struct EpiGateUp {
    bf16* ACT;
    __device__ __forceinline__ void operator()(const Acc& acc, const Unit& u, int wr, int wc, int fr, int fq) const {
        const int obase = (u.pn * BM + wc * 32) / 2 + 4 * fq;
#pragma unroll
        for (int ai = 0; ai < 2; ++ai)
#pragma unroll
            for (int m = 0; m < 4; ++m) { bf16* rowp = ACT + (size_t)(u.row0 + ai * HALF + wr * 64 + m * 16 + fr) * DEXP + obase;
#pragma unroll
                for (int bj = 0; bj < 2; ++bj) { const f32x4 g = acc[ai][bj][m][0], up = acc[ai][bj][m][1]; f32x4 o;
#pragma unroll
                    for (int j = 0; j < 4; ++j) o[j] = g[j] * __builtin_amdgcn_rcpf(1.f + __expf(-g[j])) * up[j];
                    st4bf(rowp + bj * (HALF / 2), o); } }
    }
};

template <class Epi, class Sched>
__device__ __forceinline__ void gemm_phase(unsigned char* ldsg, const bf16* A, int K, const Sched& S, const Epi& E) {
    LAS unsigned char* lds = (LAS unsigned char*)ldsg;
    const int tid = threadIdx.x, wid = __builtin_amdgcn_readfirstlane(tid >> 6), lane = tid & 63, wr = wid >> 2, wc = wid & 3, fr = lane & 15, fq = lane >> 4;
    const int nt = K / BK;
    int Rr[2]; unsigned colb[2], voffB[2];
#pragma unroll
    for (int i = 0; i < 2; ++i) { int R, C; stage_rc(tid * 16 + i * 8192, R, C); Rr[i] = R; colb[i] = (unsigned)C * 2u; voffB[i] = (unsigned)(R * K + C) * 2u; }
    const size_t kstep = (size_t)(BK * 2);
    const size_t hstep = (size_t)HALF * K * 2;
    const size_t tstep = 2 * hstep;
    const unsigned ldsw = (unsigned)wid * 1024u;
    const int aoff = lds_byte(wr * 64 + fr, fq * 8), boff = lds_byte(wc * 32 + fr, fq * 8);
#define PG8_SA(b, h) (((b) * 2 + (h)) * HTB)
#define PG8_SB(b, h) ((4 + (b) * 2 + (h)) * HTB)
#define PG8_STAGE(bufoff, gbase, voff) do { _Pragma("unroll") for (int _i = 0; _i < 2; ++_i) \
        __builtin_amdgcn_global_load_lds((const unsigned*)((const char*)(gbase) + (voff)[_i]), (LAS unsigned*)(lds + (bufoff) + ldsw + _i * 8192), 16, 0, 0); } while (0)
#define PG8_LDA(dst, b, h) do { _Pragma("unroll") for (int m = 0; m < 4; ++m) _Pragma("unroll") for (int k = 0; k < 2; ++k) dst[m][k] = *(const LAS bf16x8*)(lds + PG8_SA(b, h) + aoff + m * 2048 + k * 1024); } while (0)
#define PG8_LDB(dst, b, h) do { _Pragma("unroll") for (int n = 0; n < 2; ++n) _Pragma("unroll") for (int k = 0; k < 2; ++k) dst[n][k] = *(const LAS bf16x8*)(lds + PG8_SB(b, h) + boff + n * 2048 + k * 1024); } while (0)
#define PG8_MMA(ai, bj, At, Bt) do { __builtin_amdgcn_s_setprio(1); _Pragma("unroll") for (int m = 0; m < 4; ++m) _Pragma("unroll") for (int n = 0; n < 2; ++n) _Pragma("unroll") for (int k = 0; k < 2; ++k) \
        acc[ai][bj][m][n] = __builtin_amdgcn_mfma_f32_16x16x32_bf16(Bt[n][k], At[m][k], acc[ai][bj][m][n], 0, 0, 0); __builtin_amdgcn_s_setprio(0); } while (0)
#define PG8_WAIT_V(n) asm volatile("s_waitcnt vmcnt(" #n ")" ::: "memory")
#define PG8_WAIT_L(n) asm volatile("s_waitcnt lgkmcnt(" #n ")" ::: "memory")
#define PG8_BAR __builtin_amdgcn_s_barrier()
#define PG8_SCHED __builtin_amdgcn_sched_barrier(0)
    Unit cur, nxt; int ui = 0;
    if (!S.next(0, cur)) return;
    Acc acc;
#pragma unroll
    for (int a = 0; a < 2; ++a)
#pragma unroll
        for (int b = 0; b < 2; ++b)
#pragma unroll
            for (int m = 0; m < 4; ++m)
#pragma unroll
                for (int n = 0; n < 2; ++n) acc[a][b][m][n] = (f32x4){0.f, 0.f, 0.f, 0.f};
    bf16x8 At[4][2], B0[2][2], B1[2][2];
    unsigned aC0[2], aC1[2], aN0[2], aN1[2];
#pragma unroll
    for (int i = 0; i < 2; ++i) { aC0[i] = S.arow(cur, Rr[i]) + colb[i]; aC1[i] = S.arow(cur, HALF + Rr[i]) + colb[i]; }
    const char* Ab = (const char*)A;
    const char* cB = (const char*)cur.Bt + (size_t)cur.pn * tstep;
    PG8_STAGE(PG8_SB(0, 0), cB, voffB); PG8_STAGE(PG8_SB(0, 1), cB + hstep, voffB); PG8_STAGE(PG8_SA(0, 0), Ab, aC0); PG8_STAGE(PG8_SA(0, 1), Ab, aC1);
    if (wr == 1) PG8_BAR;
    PG8_WAIT_V(2); PG8_BAR;
    PG8_STAGE(PG8_SB(1, 0), cB + kstep, voffB); PG8_STAGE(PG8_SA(1, 0), Ab + kstep, aC0); PG8_STAGE(PG8_SB(1, 1), cB + hstep + kstep, voffB);
    PG8_WAIT_V(6); PG8_BAR;
    for (;;) {
        const bool has_next = S.next(ui + 1, nxt);
        if (has_next) {
#pragma unroll
            for (int i = 0; i < 2; ++i) { aN0[i] = S.arow(nxt, Rr[i]) + colb[i]; aN1[i] = S.arow(nxt, HALF + Rr[i]) + colb[i]; }
        } else {
#pragma unroll
            for (int i = 0; i < 2; ++i) { aN0[i] = aC0[i]; aN1[i] = aC1[i]; }
        }
        const char* nB = has_next ? (const char*)nxt.Bt + (size_t)nxt.pn * tstep : cB;
        for (int t = 0; t < nt; t += 2) {
            const bool last = (t == nt - 2);
            const char* a1 = Ab + (size_t)(t + 1) * kstep;
            const char* a2 = last ? Ab : Ab + (size_t)(t + 2) * kstep; const char* b2 = last ? nB : cB + (size_t)(t + 2) * kstep;
            const char* a3 = a2 + kstep; const char* b3 = b2 + kstep;
            unsigned x0[2], x1[2];
#pragma unroll
            for (int i = 0; i < 2; ++i) { x0[i] = last ? aN0[i] : aC0[i]; x1[i] = last ? aN1[i] : aC1[i]; }
            PG8_LDB(B0, 0, 0); PG8_LDB(B1, 0, 1); PG8_SCHED; PG8_LDA(At, 0, 0); PG8_STAGE(PG8_SA(1, 1), a1, aC1);
            PG8_WAIT_V(8); PG8_WAIT_L(0); PG8_BAR; PG8_MMA(0, 0, At, B0); PG8_MMA(0, 1, At, B1); PG8_BAR; PG8_SCHED;
            PG8_LDA(At, 0, 1); PG8_STAGE(PG8_SB(0, 0), b2, voffB); PG8_STAGE(PG8_SB(0, 1), b2 + hstep, voffB); PG8_STAGE(PG8_SA(0, 0), a2, x0);
            PG8_WAIT_V(8); PG8_WAIT_L(0); PG8_BAR; PG8_MMA(1, 0, At, B0); PG8_MMA(1, 1, At, B1); PG8_BAR; PG8_SCHED;
            PG8_LDB(B0, 1, 0); PG8_LDB(B1, 1, 1); PG8_SCHED; PG8_LDA(At, 1, 0); PG8_STAGE(PG8_SA(0, 1), a2, x1);
            PG8_WAIT_V(8); PG8_WAIT_L(0); PG8_BAR; PG8_MMA(0, 0, At, B0); PG8_MMA(0, 1, At, B1); PG8_BAR; PG8_SCHED;
            PG8_LDA(At, 1, 1); PG8_STAGE(PG8_SB(1, 0), b3, voffB); PG8_STAGE(PG8_SB(1, 1), b3 + hstep, voffB); PG8_STAGE(PG8_SA(1, 0), a3, x0);
            PG8_WAIT_V(8); PG8_WAIT_L(0); PG8_BAR; PG8_MMA(1, 0, At, B0); PG8_MMA(1, 1, At, B1); PG8_BAR; PG8_SCHED;
        }
        if (wr == 0) PG8_BAR;
        E(acc, cur, wr, wc, fr, fq);
        if (!has_next) break;
#pragma unroll
        for (int a = 0; a < 2; ++a)
#pragma unroll
            for (int b = 0; b < 2; ++b)
#pragma unroll
                for (int m = 0; m < 4; ++m)
#pragma unroll
                    for (int n = 0; n < 2; ++n) acc[a][b][m][n] = (f32x4){0.f, 0.f, 0.f, 0.f};
        cur = nxt; cB = nB; ++ui;
#pragma unroll
        for (int i = 0; i < 2; ++i) { aC0[i] = aN0[i]; aC1[i] = aN1[i]; }
        if (wr == 1) PG8_BAR;
    }
    PG8_WAIT_V(0);
    PG8_BAR;
#undef PG8_SA
#undef PG8_SB
#undef PG8_STAGE
#undef PG8_LDA
#undef PG8_LDB
#undef PG8_MMA
#undef PG8_WAIT_V
#undef PG8_WAIT_L
#undef PG8_BAR
#undef PG8_SCHED
}
}

__device__ __forceinline__ int vcu_of(const Frame& F) { return (F.G % 8 == 0) ? (F.bid % 8) * (F.G / 8) + F.bid / 8 : F.bid; }
__device__ __forceinline__ void phase_qkv_opt(const Frame& F, const Prm& p) {
    pg8::DenseOrder S; S.init(NTOK, 3072, 1024, (const bf16*)(p.ws + WS_WQKV), F.G, F.bid);
    static_assert(WS_V - WS_K == WS_K - WS_Q, "Q|K|V equally spaced");
    pg8::EpiQKV E{(bf16*)(p.ws + WS_Q), (const float*)(p.ws + WS_MISC) + 1024};
    pg8::gemm_phase(F.lds, (const bf16*)(p.ws + WS_H), 1024, S, E);
}
__device__ __forceinline__ void phase_wo_opt(const Frame& F, const Prm& p, int layer) {
    pg8::DenseOrder S; S.init(layer ? NLAT : NTOK, 1024, 1024, (const bf16*)(p.ws + (layer ? WS_WGO : WS_WO)), F.G, F.bid);
    pg8::EpiPlain E{(bf16*)(p.ws + WS_Y)};
    pg8::gemm_phase(F.lds, (const bf16*)(p.ws + (layer ? WS_A2B : WS_A2)), 1024, S, E);
}
__device__ __forceinline__ void phase_inproj_opt(const Frame& F, const Prm& p) {
    pg8::DenseOrder S; S.init(NTOK, NIN, 1024, (const bf16*)(p.ws + WS_WIN), F.G, F.bid);
    pg8::EpiInproj E{(bf16*)(p.ws + WS_QR), (bf16*)(p.ws + WS_KR), (bf16*)(p.ws + WS_V1), (bf16*)(p.ws + WS_R), (float*)(p.ws + WS_ZZ)};
    pg8::gemm_phase(F.lds, (const bf16*)(p.ws + WS_H), 1024, S, E);
}
__device__ __forceinline__ void phase_moe1_opt(const Frame& F, const Prm& p, int layer) {
    pg8::MoeOrder<true> S; S.init(F.ctl + CW_CNT + layer * 16, 1024, 1024, (const bf16*)(p.ws + (layer ? WS_GU1 : WS_GU0)), (const int*)(p.ws + WS_LIST), F.G, vcu_of(F));
    pg8::EpiGateUp E{(bf16*)(p.ws + WS_ACT)};
    pg8::gemm_phase(F.lds, (const bf16*)(p.ws + WS_H), 1024, S, E);
}
__device__ __forceinline__ void phase_moe2_opt(const Frame& F, const Prm& p, int layer) {
    pg8::MoeOrder<false> S; S.init(F.ctl + CW_CNT + layer * 16, 1024, 512, (const bf16*)(p.ws + (layer ? WS_DN1 : WS_DN0)), nullptr, F.G, vcu_of(F));
    pg8::EpiPlain E{(bf16*)(p.ws + WS_YM)};
    pg8::gemm_phase(F.lds, (const bf16*)(p.ws + WS_ACT), 512, S, E);
}
namespace attn_body {
using bf16=unsigned short;
using bf16x8=__attribute__((ext_vector_type(8)))short;
using s16x4=__attribute__((ext_vector_type(4)))short;
using f32x16=__attribute__((ext_vector_type(16)))float;
using u32x4=__attribute__((ext_vector_type(4)))unsigned;
constexpr int D=64,DM=1024;
constexpr int NW=8,QBLK=32,QB=QBLK*NW,KVBLK=64;
constexpr int ATTN_PITCH=DM, ATTN_UNIT_ROWS=QB;
__device__ __forceinline__ int crow(int r,int hi){return (r&3)+8*(r>>2)+4*hi;}
#define SBAR() __builtin_amdgcn_sched_barrier(0)
__device__ __forceinline__ void cmask(f32x16&p0,f32x16&p1,int jb,int qrel,int hi){
  const float NEG=-INFINITY; int kb=64*jb+4*hi;
  #pragma unroll
  for(int r=0;r<16;++r){int kv=kb+(r&3)+8*(r>>2); if(kv>qrel)p0[r]=NEG; if(kv+32>qrel)p1[r]=NEG;}
}

constexpr int NSLOT=3, SLOTB=8192;
constexpr int LDS_K=0, LDS_V=NSLOT*SLOTB, LDS_WS=2*NSLOT*SLOTB, LDS_OST=LDS_WS+NW*64*4, LDS_BYTES=LDS_OST+NW*4096;
constexpr float C2=0.125f*1.4426950408889634f;
__device__ __forceinline__ void glds16(const void*gsrc,unsigned lds_dst){unsigned keep;
  asm volatile("s_mov_b32 %0, m0\n\ts_mov_b32 m0, %2\n\ts_nop 0\n\tglobal_load_lds_dwordx4 %1, off\n\ts_mov_b32 m0, %0":"=&s"(keep):"v"(gsrc),"s"(lds_dst):"memory");}
__device__ __forceinline__ float max3f(float a,float b,float c){float r;asm("v_max3_f32 %0, %1, %2, %3":"=v"(r):"v"(a),"v"(b),"v"(c));return r;}
__device__ __forceinline__ float max2f(float a,float b){float r;asm("v_max_f32_e32 %0, %1, %2":"=v"(r):"v"(a),"v"(b));return r;}
__device__ __forceinline__ float fadd_s(float a,float b){float r;asm("v_add_f32_e32 %0, %1, %2":"=v"(r):"v"(a),"v"(b));return r;}
__device__ __forceinline__ float fsub_s(float a,float b){float r;asm("v_sub_f32_e32 %0, %1, %2":"=v"(r):"v"(a),"v"(b));return r;}
typedef float f32x2_t __attribute__((ext_vector_type(2))); typedef __bf16 bf16x2_t __attribute__((ext_vector_type(2)));
__device__ __forceinline__ unsigned cvtpk_s(float lo,float hi){f32x2_t v={lo,hi};bf16x2_t b=__builtin_convertvector(v,bf16x2_t);return __builtin_bit_cast(unsigned,b);}
#define WAIT_BAR(N) asm volatile("s_waitcnt vmcnt(" #N ") lgkmcnt(0)\n\ts_barrier":::"memory")

__device__ __forceinline__ void qkt(f32x16&p0,f32x16&p1,const char*Kslot,const bf16x8*qr,const f32x16&negm,int r32,int hi){
  const char*kb=Kslot+hi*1024+r32*16;
  #pragma unroll
  for(int d0=0;d0<4;++d0){
    const bf16x8 b0=*reinterpret_cast<const bf16x8*>(kb+d0*2048);
    const bf16x8 b1=*reinterpret_cast<const bf16x8*>(kb+d0*2048+512);
    if(d0==0){p0=__builtin_amdgcn_mfma_f32_32x32x16_bf16(b0,qr[0],negm,0,0,0);p1=__builtin_amdgcn_mfma_f32_32x32x16_bf16(b1,qr[0],negm,0,0,0);}
    else{p0=__builtin_amdgcn_mfma_f32_32x32x16_bf16(b0,qr[d0],p0,0,0,0);p1=__builtin_amdgcn_mfma_f32_32x32x16_bf16(b1,qr[d0],p1,0,0,0);}}
}
typedef __attribute__((address_space(3))) const char* lds_cptr;
typedef short v4i16_t __attribute__((ext_vector_type(4)));
__device__ __forceinline__ void kload8(bf16x8*kf,lds_cptr kp){
  kf[0]=*(const __attribute__((address_space(3))) bf16x8*)(kp);      kf[1]=*(const __attribute__((address_space(3))) bf16x8*)(kp+512);
  kf[2]=*(const __attribute__((address_space(3))) bf16x8*)(kp+2048); kf[3]=*(const __attribute__((address_space(3))) bf16x8*)(kp+2560);
  kf[4]=*(const __attribute__((address_space(3))) bf16x8*)(kp+4096); kf[5]=*(const __attribute__((address_space(3))) bf16x8*)(kp+4608);
  kf[6]=*(const __attribute__((address_space(3))) bf16x8*)(kp+6144); kf[7]=*(const __attribute__((address_space(3))) bf16x8*)(kp+6656);
}
__device__ __forceinline__ void kload2(bf16x8*kf,lds_cptr kp,int j){ kf[2*j]=*(const __attribute__((address_space(3))) bf16x8*)(kp+j*2048); kf[2*j+1]=*(const __attribute__((address_space(3))) bf16x8*)(kp+j*2048+512); }
__device__ __forceinline__ s16x4 vtr(lds_cptr p){ return __builtin_bit_cast(s16x4,__builtin_amdgcn_ds_read_tr16_b64_v4i16((__attribute__((address_space(3))) v4i16_t*)p)); }
__device__ __forceinline__ float rowmax(const f32x16&p0,const f32x16&p1){
  float a=max3f(p0[0],p0[1],p1[0]),b=max3f(p0[2],p0[3],p1[1]);a=max3f(a,p1[2],p1[3]);
  #pragma unroll
  for(int r=4;r<16;r+=4){a=max3f(a,p0[r],p0[r+1]);b=max3f(b,p0[r+2],p0[r+3]);a=max3f(a,p1[r],p1[r+1]);b=max3f(b,p1[r+2],p1[r+3]);}
  const float m=max2f(a,b);
  auto rr=__builtin_amdgcn_permlane32_swap(__float_as_uint(m),__float_as_uint(m),false,false);
  return max2f(__uint_as_float(rr[0]),__uint_as_float(rr[1]));
}
__device__ __forceinline__ void pv(f32x16*o,int vb,bf16x8 pa0,bf16x8 pa1,bf16x8 pa2,bf16x8 pa3){
  #pragma unroll
  for(int d0=0;d0<2;++d0){s16x4 lo[4],hi[4];
    #pragma unroll
    for(int ks=0;ks<4;++ks){
      asm volatile("ds_read_b64_tr_b16 %0,%1 offset:%c2":"=&v"(lo[ks]):"v"(vb),"i"(d0*4096+ks*1024):"memory");
      asm volatile("ds_read_b64_tr_b16 %0,%1 offset:%c2":"=&v"(hi[ks]):"v"(vb),"i"(d0*4096+ks*1024+512):"memory");}
    asm volatile("s_waitcnt lgkmcnt(0)":::"memory");SBAR();
    #define PK(k) (bf16x8){lo[k][0],lo[k][1],lo[k][2],lo[k][3],hi[k][0],hi[k][1],hi[k][2],hi[k][3]}
    o[d0]=__builtin_amdgcn_mfma_f32_32x32x16_bf16(pa0,PK(0),o[d0],0,0,0);
    o[d0]=__builtin_amdgcn_mfma_f32_32x32x16_bf16(pa1,PK(1),o[d0],0,0,0);
    o[d0]=__builtin_amdgcn_mfma_f32_32x32x16_bf16(pa2,PK(2),o[d0],0,0,0);
    o[d0]=__builtin_amdgcn_mfma_f32_32x32x16_bf16(pa3,PK(3),o[d0],0,0,0);
    #undef PK
  }
}

#ifndef ATTN_STORE16
#define ATTN_STORE16(p,v) (*(u32x4*)(p)=(v))
#endif
template<int THRL> __device__ __forceinline__ void attn_unit(long qrow0,int qcol,int vcol,long kctx,long klat,int NT,const bf16*Q,const bf16*__restrict__ K,const bf16*__restrict__ V,bf16*O,char*shm){
  const int tid=threadIdx.x,lane=tid&63,r32=lane&31,hi=lane>>5; const int wid=__builtin_amdgcn_readfirstlane(tid>>6);

  const bf16*Qw=Q+(qrow0+wid*QBLK)*DM+qcol;
  const bf16*Kh=K+qcol,*Vh=V+vcol;
  const unsigned lds0=(unsigned)(uintptr_t)shm;
  float*wsf=(float*)(shm+LDS_WS)+wid*64;
  const bf16*ksrc=Kh+(long)lane*DM+wid*8;
  const bf16*vsrc=Vh+(long)(16*(wid&3)+(lane>>2))*DM+(wid>>2)*32+(lane&3)*8;
  const unsigned kdst=lds0+LDS_K+wid*1024, vdst=lds0+LDS_V+wid*1024;
  #define KVROW(t) ((t)<4?kctx+(long)(t)*KVBLK:klat+(long)((t)-4)*KVBLK)
  #define DMA_K(t,slot) glds16(ksrc+KVROW(t)*DM,(unsigned)__builtin_amdgcn_readfirstlane(kdst+(slot)))
  #define DMA_V(t,slot) glds16(vsrc+KVROW(t)*DM,(unsigned)__builtin_amdgcn_readfirstlane(vdst+(slot)))
  const int vb0=(int)(lds0+LDS_V)+((lane>>4)&1)*32+(lane&3)*8+(4*hi+((lane&15)>>2))*64;
  const char*Kbase=shm+LDS_K; bf16x8 kf[8];
  const lds_cptr shm3=(lds_cptr)shm; const lds_cptr kp0=shm3+LDS_K+hi*1024+r32*16; const lds_cptr vp0=shm3+LDS_V+((lane>>4)&1)*32+(lane&3)*8+(4*hi+((lane&15)>>2))*64;
  DMA_K(0,0);DMA_V(0,0);DMA_K(1,SLOTB);
  bf16x8 qr[4];
  #pragma unroll
  for(int d0=0;d0<4;++d0)qr[d0]=*reinterpret_cast<const bf16x8*>(&Qw[(long)r32*DM+d0*16+hi*8]);
  float mhat=0.f,l_reg=0.f;f32x16 o[2];o[0]=f32x16{};o[1]=f32x16{};f32x16 negm=f32x16{};asm volatile("":"+v"(negm));
  const int qrel=wid*QBLK+r32;
  #define CMASK(P0,P1,t) do{}while(0)
  bool resc=false;
  #define START(P0,P1) do{ const float rm=rowmax(P0,P1); resc=false; \
    { const float dl=rm; mhat=fadd_s(mhat,dl); \
      _Pragma("unroll") for(int r=0;r<16;++r){P0[r]=fsub_s(P0[r],dl);P1[r]=fsub_s(P1[r],dl);} \
      _Pragma("unroll") for(int r=0;r<16;++r)negm[r]=-mhat; asm volatile("":"+v"(negm)); } \
    _Pragma("unroll") for(int r=0;r<16;++r)P0[r]=__builtin_amdgcn_exp2f(P0[r]); }while(0)
  #define RESC() do{ if(resc){ asm volatile("s_waitcnt lgkmcnt(0)":::"memory"); \
      _Pragma("unroll") for(int d_=0;d_<2;++d_) _Pragma("unroll") for(int r=0;r<16;++r)o[d_][r]*=wsf[crow(r,hi)]; } }while(0)
  f32x16 pA0,pA1,pB0,pB1;
  int sl_prev=0,sl_cur=0,sl_next=SLOTB;
  #define ROT() do{sl_prev=sl_cur;sl_cur=sl_next;sl_next=(sl_next==(NSLOT-1)*SLOTB)?0:sl_next+SLOTB;}while(0)
  DMA_K(2,2*SLOTB);
  WAIT_BAR(3);
  qkt(pA0,pA1,Kbase,qr,negm,r32,hi);asm volatile("s_nop 15\n\ts_nop 7":"+v"(pA0),"+v"(pA1));CMASK(pA0,pA1,0);
  START(pA0,pA1);
  _Pragma("unroll") for(int r=0;r<16;++r)pA1[r]=__builtin_amdgcn_exp2f(pA1[r]);
  WAIT_BAR(0);
  DMA_K(3,0);DMA_V(1,SLOTB);
  ROT();
  kload8(kf,kp0+sl_cur);
  WAIT_BAR(2);
  s16x4 vlo[8],vhi[8]; u32x4 pw0,pw1,pw2,pw3;
  #define PKW(P,B) cvtpk_s(P[B],P[B+1])
  #define PAF(k) __builtin_bit_cast(bf16x8,pw##k)
  #define VFR(i) (bf16x8){vlo[i][0],vlo[i][1],vlo[i][2],vlo[i][3],vhi[i][0],vhi[i][1],vhi[i][2],vhi[i][3]}
  #define PIN(x) asm volatile("":"+v"(x))
  #define MX3(a,b,c) __builtin_fmaxf(__builtin_fmaxf((a),(b)),(c))
  #define GAPA(MF,A0,A1,A2,A3,W0,W1,PW) do{ MF; sacc+=A0; sacc+=A1; sacc+=A2; sacc+=A3; PIN(sacc); W0; W1; PIN(PW); SBAR(); }while(0)
  #define EX(v) __builtin_amdgcn_exp2f(v)
  #define GAPB(MF,X,B) do{ MF; X[B]=EX(X[B]); X[B+1]=EX(X[B+1]); X[B+2]=EX(X[B+2]); X[B+3]=EX(X[B+3]); PIN(X); SBAR(); }while(0)
  #define VRD(i) do{ vlo[i]=vtr(vp_+(((i)>>2)*4096+((i)&3)*1024)); vhi[i]=vtr(vp_+(((i)>>2)*4096+((i)&3)*1024+512)); }while(0)
  #define KRD(G,j) do{ if(G){ kload2(kf,kp0+sl_next,j); SBAR(); } }while(0)
  #define STEP(C0,C1,P0,P1,t,GK,GV,GL) do{ SBAR(); \
    const lds_cptr vp_=vp0+sl_prev; \
    VRD(0); SBAR(); float sacc=(P0[0]+P0[1]); \
    GAPA(C0=__builtin_amdgcn_mfma_f32_32x32x16_bf16(kf[0],qr[0],negm,0,0,0), P0[2],P0[3],P0[4],P0[5],     pw0[0]=PKW(P0,0), pw0[1]=PKW(P0,2), pw0); \
    VRD(4); SBAR(); GAPA(C1=__builtin_amdgcn_mfma_f32_32x32x16_bf16(kf[1],qr[0],negm,0,0,0), P0[6],P0[7],P0[8],P0[9],     pw0[2]=PKW(P0,4), pw0[3]=PKW(P0,6), pw0); \
    VRD(1); SBAR(); GAPA(C0=__builtin_amdgcn_mfma_f32_32x32x16_bf16(kf[2],qr[1],C0,0,0,0),   P0[10],P0[11],P0[12],P0[13], pw1[0]=PKW(P0,8), pw1[1]=PKW(P0,10), pw1); \
    VRD(5); SBAR(); GAPA(C1=__builtin_amdgcn_mfma_f32_32x32x16_bf16(kf[3],qr[1],C1,0,0,0),   P0[14],P0[15],P1[0],P1[1],   pw1[2]=PKW(P0,12),pw1[3]=PKW(P0,14), pw1); \
    VRD(2); SBAR(); GAPA(C0=__builtin_amdgcn_mfma_f32_32x32x16_bf16(kf[4],qr[2],C0,0,0,0),   P1[2],P1[3],P1[4],P1[5],     pw2[0]=PKW(P1,0), pw2[1]=PKW(P1,2), pw2); \
    VRD(6); SBAR(); GAPA(C1=__builtin_amdgcn_mfma_f32_32x32x16_bf16(kf[5],qr[2],C1,0,0,0),   P1[6],P1[7],P1[8],P1[9],     pw2[2]=PKW(P1,4), pw2[3]=PKW(P1,6), pw2); \
    VRD(3); SBAR(); GAPA(C0=__builtin_amdgcn_mfma_f32_32x32x16_bf16(kf[6],qr[3],C0,0,0,0),   P1[10],P1[11],P1[12],P1[13], pw3[0]=PKW(P1,8), pw3[1]=PKW(P1,10), pw3); \
    VRD(7); SBAR(); GAPA(C1=__builtin_amdgcn_mfma_f32_32x32x16_bf16(kf[7],qr[3],C1,0,0,0),   P1[14],P1[15],0.f,0.f,       pw3[2]=PKW(P1,12),pw3[3]=PKW(P1,14), pw3); \
    l_reg+=sacc; \
    if(GK){DMA_K((t)+3,sl_cur);} if(GV){DMA_V((t)+1,sl_next);} \
    CMASK(C0,C1,t); \
    { float a=MX3(C0[0],C0[1],C1[0]),b=MX3(C0[2],C0[3],C1[1]); a=MX3(a,C1[2],C1[3]); \
      _Pragma("unroll") for(int r=4;r<16;r+=4){a=MX3(a,C0[r],C0[r+1]);b=MX3(b,C0[r+2],C0[r+3]);a=MX3(a,C1[r],C1[r+1]);b=MX3(b,C1[r+2],C1[r+3]);} \
      float rm=__builtin_fmaxf(a,b); { auto rr=__builtin_amdgcn_permlane32_swap(__float_as_uint(rm),__float_as_uint(rm),false,false); rm=__builtin_fmaxf(__uint_as_float(rr[0]),__uint_as_float(rr[1])); } \
      resc=false; \
      if(__builtin_expect(__any(rm>(float)THRL),0)){ const float dl=__builtin_fmaxf(rm,0.f); mhat+=dl; \
        _Pragma("unroll") for(int r=0;r<16;++r){C0[r]-=dl;C1[r]-=dl;} \
        _Pragma("unroll") for(int r=0;r<16;++r)negm[r]=-mhat; asm volatile("":"+v"(negm)); \
        const float f=__builtin_amdgcn_exp2f(-dl); l_reg*=f; if(hi==0)wsf[r32]=f; resc=true; } } \
    SBAR(); \
    GAPB(o[0]=__builtin_amdgcn_mfma_f32_32x32x16_bf16(PAF(0),VFR(0),o[0],0,0,0), C0,0); \
    GAPB(o[1]=__builtin_amdgcn_mfma_f32_32x32x16_bf16(PAF(0),VFR(4),o[1],0,0,0), C0,4); \
    KRD(GL,0); GAPB(o[0]=__builtin_amdgcn_mfma_f32_32x32x16_bf16(PAF(1),VFR(1),o[0],0,0,0), C0,8); \
    KRD(GL,1); GAPB(o[1]=__builtin_amdgcn_mfma_f32_32x32x16_bf16(PAF(1),VFR(5),o[1],0,0,0), C0,12); \
    KRD(GL,2); GAPB(o[0]=__builtin_amdgcn_mfma_f32_32x32x16_bf16(PAF(2),VFR(2),o[0],0,0,0), C1,0); \
    KRD(GL,3); GAPB(o[1]=__builtin_amdgcn_mfma_f32_32x32x16_bf16(PAF(2),VFR(6),o[1],0,0,0), C1,4); \
    GAPB(o[0]=__builtin_amdgcn_mfma_f32_32x32x16_bf16(PAF(3),VFR(3),o[0],0,0,0), C1,8); \
    GAPB(o[1]=__builtin_amdgcn_mfma_f32_32x32x16_bf16(PAF(3),VFR(7),o[1],0,0,0), C1,12); \
    }while(0)
  int t=1;
  #undef CMASK
  #define CMASK(P0,P1,t) do{}while(0)
  for(;t+5<NT;t+=2){
    STEP(pB0,pB1,pA0,pA1,t,true,true,true);     WAIT_BAR(2); RESC(); ROT();
    STEP(pA0,pA1,pB0,pB1,t+1,true,true,true);   WAIT_BAR(2); RESC(); ROT();
  }
  #undef CMASK
  #define CMASK(P0,P1,t) do{}while(0)
  #define ENDW(tt) do{ if((tt)+3<NT){WAIT_BAR(2);} else if((tt)+2<NT){WAIT_BAR(1);} else {WAIT_BAR(0);} }while(0)
  for(;t+1<NT;t+=2){
    STEP(pB0,pB1,pA0,pA1,t,(t+3<NT),(t+1<NT),(t+1<NT));       ENDW(t);   RESC(); ROT();
    STEP(pA0,pA1,pB0,pB1,t+1,(t+4<NT),(t+2<NT),(t+2<NT));     ENDW(t+1); RESC(); ROT();
  }
  STEP(pB0,pB1,pA0,pA1,NT-1,false,false,false); RESC();
  { float sacc=pB0[0]+pB0[1]; _Pragma("unroll") for(int r=2;r<16;++r)sacc+=pB0[r]; _Pragma("unroll") for(int r=0;r<16;++r)sacc+=pB1[r]; l_reg+=sacc;
    pw0=(u32x4){PKW(pB0,0),PKW(pB0,2),PKW(pB0,4),PKW(pB0,6)};pw1=(u32x4){PKW(pB0,8),PKW(pB0,10),PKW(pB0,12),PKW(pB0,14)};pw2=(u32x4){PKW(pB1,0),PKW(pB1,2),PKW(pB1,4),PKW(pB1,6)};pw3=(u32x4){PKW(pB1,8),PKW(pB1,10),PKW(pB1,12),PKW(pB1,14)};
    SBAR(); pv(o,vb0+sl_cur,PAF(0),PAF(1),PAF(2),PAF(3)); }
  #undef PKW
  #undef PAF
  #undef VFR
  #undef PIN
  #undef MX3
  #undef GAPA
  #undef GAPB
  #undef EX
  #undef VRD
  #undef KRD
  #undef STEP
  #undef ENDW
  {auto rr=__builtin_amdgcn_permlane32_swap(__float_as_uint(l_reg),__float_as_uint(l_reg),false,false);l_reg=__uint_as_float(rr[0])+__uint_as_float(rr[1]);}
  if(hi==0)wsf[32+r32]=l_reg;asm volatile("s_waitcnt lgkmcnt(0)":::"memory");
  float rli[16];
  #pragma unroll
  for(int r=0;r<16;++r)rli[r]=__builtin_amdgcn_rcpf(wsf[32+crow(r,hi)]);
  bf16*Ow=O+(qrow0+wid*QBLK)*DM+vcol;
  { bf16*stg=(bf16*)(shm+LDS_OST)+wid*2048;
    #pragma unroll
    for(int r=0;r<16;++r){const int orow=crow(r,hi);
      #pragma unroll
      for(int d0=0;d0<2;++d0)stg[orow*64+d0*32+r32]=(bf16)f2bf(o[d0][r]*rli[r]);}
    asm volatile("s_waitcnt lgkmcnt(0)":::"memory");
    #pragma unroll
    for(int i=0;i<4;++i){const int row=i*8+(lane>>3),ch=lane&7; const u32x4 v=*(const u32x4*)(stg+row*64+ch*8); ATTN_STORE16(Ow+(long)row*DM+ch*8,v);} }
  asm volatile("s_waitcnt lgkmcnt(0)\n\ts_barrier":::"memory");
  #undef DMA_K
  #undef DMA_V
  #undef CMASK
  #undef START
  #undef RESC
  #undef ROT
}
constexpr int ATTN_LDS_BYTES=LDS_BYTES;
#undef SBAR
#undef WAIT_BAR
#undef KVROW
}
__device__ __forceinline__ void phase_attn_opt(const Frame& F, const Prm& p) {
    const bf16* Q = (const bf16*)(p.ws + WS_Q); const bf16* K = (const bf16*)(p.ws + WS_K); const bf16* V = (const bf16*)(p.ws + WS_V); bf16* O1 = (bf16*)(p.ws + WS_O1);
    for (int bv = vcu_of(F); bv < 256; bv += F.G) {
        const int b = bv >> 5, vh = bv & 31, h = vh >> 2, m = (vh >> 1) & 1, vhalf = vh & 1;
        const int qcol = (h * 2 + m) * 64, vcol = h * 128 + vhalf * 64; bf16* O = O1 + (size_t)m * ((WS_O2 - WS_O1) / 2);
        const long kctx = NLAT + b * CTXL, klat = (long)b * SEQ;
        for (int i = 0; i < 17; ++i) {
            const long qrow0 = i < 16 ? klat + i * 256 : kctx; const int NT = i < 16 ? 68 : 4;
            attn_body::attn_unit<8>(qrow0, qcol, vcol, kctx, klat, NT, Q, K, V, O, (char*)F.lds);
        }
    }
}
namespace gla {
typedef short bf16x8 __attribute__((ext_vector_type(8)));
typedef short s16x4 __attribute__((ext_vector_type(4)));
typedef float f32x16 __attribute__((ext_vector_type(16)));
constexpr int PQ = 272, PK = 144;
constexpr int L_QS = 0, L_KS = 64 * PQ, L_KT = 2 * 64 * PQ, L_VT = L_KT + 128 * PK, L_SB = L_VT + 64 * PK, L_DEC = L_SB + 64 * PQ, L_END = L_DEC + 512;
__device__ __forceinline__ int crow(int i, int hh) { return (i & 3) + 8 * (i >> 2) + 4 * hh; }
typedef float f32x2_t __attribute__((ext_vector_type(2))); typedef __bf16 bf16x2_t __attribute__((ext_vector_type(2)));
__device__ __forceinline__ unsigned pk(float lo, float hi) { f32x2_t v = {lo, hi}; bf16x2_t b = __builtin_convertvector(v, bf16x2_t); return __builtin_bit_cast(unsigned, b); }

__device__ __forceinline__ void scan_unit(const Frame& F, const Prm& p, int unit) {
    const int dvs = unit & 3, dir = (unit >> 2) & 1, h = (unit >> 3) & 3, b = unit >> 5;
    LAS unsigned char* lds = (LAS unsigned char*)F.lds;
    const int lane = F.lane, w = F.wave, tid = F.tid, r = lane & 31, hh = lane >> 5;
    const bf16* QT = (const bf16*)(p.ws + WS_QT) + (size_t)dir * NTOK * 512 + h * 128 + 8 * w;
    const bf16* KT = (const bf16*)(p.ws + WS_KT) + (size_t)dir * NTOK * 512 + h * 128 + 8 * w;
    const bf16* V = (const bf16*)(p.ws + WS_V1) + h * 256 + dvs * 64 + 8 * w;
    const float* DEC = (const float*)(p.ws + WS_DEC) + (size_t)dir * NCHUNK * 512 + h * 128;
    bf16* OG = (bf16*)(p.ws + (dir ? WS_OGB : WS_OGF)) + h * 256 + dvs * 64;
    f32x16 S0 = {}, S1 = {};
    for (int i = tid; i < 64 * PQ / 16; i += NTHR) *(LAS u32x4*)(lds + L_SB + i * 16) = (u32x4){0u, 0u, 0u, 0u};
    u32x4 pq0, pq1, pk0, pk1, pv; float pdec = 0.f;
#define GLA_CHUNK(step) ((step) >= 4 ? b * 64 + (dir ? 63 - ((step) - 4) : (step) - 4) : 512 + b * 4 + (dir ? 3 - (step) : (step)))
#define GLA_LOAD(step) do { const size_t row_ = (size_t)GLA_CHUNK(step) * 64 + lane; \
        pq0 = *(const u32x4*)(QT + row_ * 512); pq1 = *(const u32x4*)(QT + row_ * 512 + 64); pk0 = *(const u32x4*)(KT + row_ * 512); pk1 = *(const u32x4*)(KT + row_ * 512 + 64); \
        pv = *(const u32x4*)(V + row_ * 1024); if (tid < 128) pdec = DEC[(size_t)GLA_CHUNK(step) * 512 + tid]; } while (0)
#define GLA_T16(base, x, j) do { *(LAS unsigned short*)(lds + (base) + (2 * (j)) * PK + 2 * lane) = (unsigned short)((x) & 0xffffu); *(LAS unsigned short*)(lds + (base) + (2 * (j) + 1) * PK + 2 * lane) = (unsigned short)((x) >> 16); } while (0)
#define GLA_STORE() do { \
        *(LAS u32x4*)(lds + L_QS + lane * PQ + 16 * w) = pq0; *(LAS u32x4*)(lds + L_QS + lane * PQ + 128 + 16 * w) = pq1; \
        *(LAS u32x4*)(lds + L_KS + lane * PQ + 16 * w) = pk0; *(LAS u32x4*)(lds + L_KS + lane * PQ + 128 + 16 * w) = pk1; \
        GLA_T16(L_KT + 8 * w * PK, pk0.x, 0); GLA_T16(L_KT + 8 * w * PK, pk0.y, 1); GLA_T16(L_KT + 8 * w * PK, pk0.z, 2); GLA_T16(L_KT + 8 * w * PK, pk0.w, 3); \
        GLA_T16(L_KT + (64 + 8 * w) * PK, pk1.x, 0); GLA_T16(L_KT + (64 + 8 * w) * PK, pk1.y, 1); GLA_T16(L_KT + (64 + 8 * w) * PK, pk1.z, 2); GLA_T16(L_KT + (64 + 8 * w) * PK, pk1.w, 3); \
        GLA_T16(L_VT + 8 * w * PK, pv.x, 0); GLA_T16(L_VT + 8 * w * PK, pv.y, 1); GLA_T16(L_VT + 8 * w * PK, pv.z, 2); GLA_T16(L_VT + 8 * w * PK, pv.w, 3); \
        if (tid < 128) *(LAS float*)(lds + L_DEC + 4 * tid) = pdec; } while (0)
    GLA_LOAD(0);
    GLA_STORE();
    __syncthreads();
    for (int step = 0; step < 68; ++step) {
        const bool lat = step >= 4; const int chunk = GLA_CHUNK(step);
        if (step + 1 < 68) GLA_LOAD(step + 1);
        if (w < 4) {
            if (lat) {
                const int tb = w >> 1, vb = w & 1;
                bf16x8 bq[8]; f32x16 sc0 = {}, sc1 = {};
#pragma unroll
                for (int ks = 0; ks < 8; ++ks) {
                    bq[ks] = *(const LAS bf16x8*)(lds + L_QS + (32 * tb + r) * PQ + (16 * ks + 8 * hh) * 2);
                    const bf16x8 a0 = *(const LAS bf16x8*)(lds + L_KS + r * PQ + (16 * ks + 8 * hh) * 2), a1 = *(const LAS bf16x8*)(lds + L_KS + (32 + r) * PQ + (16 * ks + 8 * hh) * 2);
                    sc0 = __builtin_amdgcn_mfma_f32_32x32x16_bf16(a0, bq[ks], sc0, 0, 0, 0); sc1 = __builtin_amdgcn_mfma_f32_32x32x16_bf16(a1, bq[ks], sc1, 0, 0, 0);
                }
                const int t = 32 * tb + r;
#pragma unroll
                for (int i = 0; i < 16; ++i) { const int s0 = crow(i, hh), s1 = 32 + s0; const bool k0 = dir ? (s0 >= t) : (s0 <= t), k1 = dir ? (s1 >= t) : (s1 <= t); sc0[i] = k0 ? sc0[i] : 0.f; sc1[i] = k1 ? sc1[i] : 0.f; }
                f32x16 o = {};
#pragma unroll
                for (int sb = 0; sb < 2; ++sb)
#pragma unroll
                    for (int sp = 0; sp < 2; ++sp) {
                        u32x4 pw;
                        if (sb == 0) { pw.x = pk(sc0[8 * sp + 0], sc0[8 * sp + 1]); pw.y = pk(sc0[8 * sp + 2], sc0[8 * sp + 3]); pw.z = pk(sc0[8 * sp + 4], sc0[8 * sp + 5]); pw.w = pk(sc0[8 * sp + 6], sc0[8 * sp + 7]); }
                        else { pw.x = pk(sc1[8 * sp + 0], sc1[8 * sp + 1]); pw.y = pk(sc1[8 * sp + 2], sc1[8 * sp + 3]); pw.z = pk(sc1[8 * sp + 4], sc1[8 * sp + 5]); pw.w = pk(sc1[8 * sp + 6], sc1[8 * sp + 7]); }
                        const s16x4 lo = *(const LAS s16x4*)(lds + L_VT + (32 * vb + r) * PK + (32 * sb + 16 * sp + 4 * hh) * 2), hi = *(const LAS s16x4*)(lds + L_VT + (32 * vb + r) * PK + (32 * sb + 16 * sp + 8 + 4 * hh) * 2);
                        const bf16x8 av = {lo[0], lo[1], lo[2], lo[3], hi[0], hi[1], hi[2], hi[3]};
                        o = __builtin_amdgcn_mfma_f32_32x32x16_bf16(av, __builtin_bit_cast(bf16x8, pw), o, 0, 0, 0);
                    }
#pragma unroll
                for (int ks = 0; ks < 8; ++ks) {
                    const bf16x8 as = *(const LAS bf16x8*)(lds + L_SB + (32 * vb + r) * PQ + (16 * ks + 8 * hh) * 2);
                    o = __builtin_amdgcn_mfma_f32_32x32x16_bf16(as, bq[ks], o, 0, 0, 0);
                }
                bf16* orow = OG + ((size_t)chunk * 64 + t) * DM + 32 * vb + 4 * hh;
#pragma unroll
                for (int g = 0; g < 4; ++g) { u32x2 wv; wv.x = pk(o[4 * g], o[4 * g + 1]); wv.y = pk(o[4 * g + 2], o[4 * g + 3]); *(u32x2*)(orow + 8 * g) = wv; }
            }
        } else {
            const int db = w - 4;
#pragma unroll
            for (int ks = 0; ks < 4; ++ks) {
                const bf16x8 a = *(const LAS bf16x8*)(lds + L_KT + (32 * db + r) * PK + (16 * ks + 8 * hh) * 2);
                const bf16x8 b0 = *(const LAS bf16x8*)(lds + L_VT + r * PK + (16 * ks + 8 * hh) * 2), b1 = *(const LAS bf16x8*)(lds + L_VT + (32 + r) * PK + (16 * ks + 8 * hh) * 2);
                S0 = __builtin_amdgcn_mfma_f32_32x32x16_bf16(a, b0, S0, 0, 0, 0); S1 = __builtin_amdgcn_mfma_f32_32x32x16_bf16(a, b1, S1, 0, 0, 0);
            }
#pragma unroll
            for (int i = 0; i < 16; ++i) { const float dc = *(const LAS float*)(lds + L_DEC + 4 * (32 * db + crow(i, hh))); S0[i] *= dc; S1[i] *= dc; }
        }
        __syncthreads();
        if (step + 1 < 68) {
            GLA_STORE();
            if (w >= 4) { const int db = w - 4;
#pragma unroll
                for (int g = 0; g < 4; ++g) { u32x2 w0, w1; w0.x = pk(S0[4 * g], S0[4 * g + 1]); w0.y = pk(S0[4 * g + 2], S0[4 * g + 3]); w1.x = pk(S1[4 * g], S1[4 * g + 1]); w1.y = pk(S1[4 * g + 2], S1[4 * g + 3]);
                    *(LAS u32x2*)(lds + L_SB + r * PQ + (32 * db + 8 * g + 4 * hh) * 2) = w0; *(LAS u32x2*)(lds + L_SB + (32 + r) * PQ + (32 * db + 8 * g + 4 * hh) * 2) = w1; } }
        }
        __syncthreads();
    }
#undef GLA_CHUNK
#undef GLA_LOAD
#undef GLA_T16
#undef GLA_STORE
}
}
__device__ __forceinline__ void phase_scan_opt(const Frame& F, const Prm& p) {
    for (int unit = vcu_of(F); unit < 256; unit += F.G) gla::scan_unit(F, p, unit);
}
#define PHASE_QKV(F, p) phase_qkv_opt(F, p)
#define PHASE_ATTN(F, p) phase_attn_opt(F, p)
#define PHASE_WO(F, p, l) phase_wo_opt(F, p, l)
#define PHASE_MOE1(F, p, l) phase_moe1_opt(F, p, l)
#define PHASE_MOE2(F, p, l) phase_moe2_opt(F, p, l)
#define PHASE_INPROJ(F, p) phase_inproj_opt(F, p)
#define PHASE_SCAN(F, p) phase_scan_opt(F, p)
typedef GAS unsigned gu32;
#define XB_TMO      128
#define XB_XCNT(j)  (256  + 64 * (j))
#define XB_XSUB(j)  (1280 + 64 * (j))
#define XB_XGEN(j)  (2304 + 64 * (j))
#define XB_TOP      3328
#define XB_TOPGEN   3392
#define XCD_BAR_WORDS 3456
#define XB_SPIN_CAP (1u << 20)
__device__ __forceinline__ unsigned xb_ld(unsigned* p)              { return __hip_atomic_load(p, __ATOMIC_RELAXED, __HIP_MEMORY_SCOPE_AGENT); }
__device__ __forceinline__ unsigned xb_add(unsigned* p, unsigned v) { return __hip_atomic_fetch_add(p, v, __ATOMIC_RELAXED, __HIP_MEMORY_SCOPE_AGENT); }
__device__ __forceinline__ unsigned xb_xcc_id() { return (unsigned)__builtin_amdgcn_s_getreg((3 << 11) | 20) & 0xFu; }
#define XB_SPIN(cond, bar) do { unsigned _sp = 0; while (cond) { __builtin_amdgcn_s_sleep(1); \
    if ((++_sp & 255u) == 0u) { if (xb_ld(&(bar)[XB_TMO])) break; if (_sp > XB_SPIN_CAP) { atomicAdd(&(bar)[XB_TMO], 1u); break; } } } } while (0)
struct XcdBarrier { unsigned* bar; unsigned x; volatile LAS unsigned* st; };
__device__ __forceinline__ XcdBarrier xcd_barrier_post(unsigned* bar, volatile LAS unsigned* st) {
    XcdBarrier b; b.bar = bar; b.x = xb_xcc_id(); b.st = st;
    if (threadIdx.x == 0) (void)xb_add(&bar[XB_XCNT(b.x)], 1u);
    return b;
}
__device__ __forceinline__ void xcd_barrier_complete(unsigned* bar, unsigned x, unsigned& nloc, unsigned& nx) {
    const unsigned G = gridDim.x * gridDim.y * gridDim.z;
    unsigned sum, cnt, mine, sp = 0u;
    for (;;) {
        sum = 0u; cnt = 0u; mine = 0u;
#pragma unroll
        for (unsigned j = 0; j < 16; ++j) { const unsigned c = xb_ld(&bar[XB_XCNT(j)]); sum += c; cnt += (c > 0u) ? 1u : 0u; mine = (j == x) ? c : mine; }
        if (sum == G) break;
        __builtin_amdgcn_s_sleep(1);
        if ((++sp & 255u) == 0u) { if (xb_ld(&bar[XB_TMO])) break; if (sp > XB_SPIN_CAP) { atomicAdd(&bar[XB_TMO], 1u); break; } }
    }
    nloc = mine > 0u ? mine : 1u; nx = cnt > 0u ? cnt : 1u;
}
__device__ __forceinline__ void xcd_barrier(const XcdBarrier& b) {
    asm volatile("s_waitcnt vmcnt(0)" ::: "memory");
    __syncthreads();
    if (threadIdx.x == 0) {
        unsigned* bar = b.bar;
        __builtin_amdgcn_s_waitcnt(0);
        unsigned nloc = b.st[0], nx = b.st[1];
        if (nloc == 0u) { xcd_barrier_complete(bar, b.x, nloc, nx); b.st[0] = nloc; b.st[1] = nx; }
        const unsigned old = xb_add(&bar[XB_XSUB(b.x)], 1u);
        const unsigned gen = old / nloc;
        if (old + 1u == (gen + 1u) * nloc) {
            __builtin_amdgcn_fence(__ATOMIC_RELEASE, "agent");
            asm volatile("s_waitcnt vmcnt(0)" ::: "memory");
            const unsigned og = xb_add(&bar[XB_TOP], 1u);
            const unsigned tg = og / nx;
            if (og + 1u == (tg + 1u) * nx) xb_add(&bar[XB_TOPGEN], 1u);
            else XB_SPIN(xb_ld(&bar[XB_TOPGEN]) == tg, bar);
            __builtin_amdgcn_fence(__ATOMIC_ACQUIRE, "agent");
            xb_add(&bar[XB_XGEN(b.x)], 1u);
            asm volatile("s_waitcnt vmcnt(0)" ::: "memory");
        } else {
            XB_SPIN(xb_ld(&bar[XB_XGEN(b.x)]) == gen, bar);
            __builtin_amdgcn_fence(__ATOMIC_ACQUIRE, "agent");
            asm volatile("s_waitcnt vmcnt(0)" ::: "memory");
        }
    }
    __syncthreads();
}

constexpr int NPHASE = 19;
#ifndef OPT_MASK
#define OPT_MASK 0u
#endif
__global__ void __launch_bounds__(NTHR, 2) mega_fwd(Prm p) {
    extern __shared__ __attribute__((aligned(16))) unsigned char lds[];
    Frame F; F.lds = lds; F.ctl = (unsigned*)(p.ws + WS_CTL);
    F.tid = threadIdx.x; F.lane = F.tid & 63; F.wave = __builtin_amdgcn_readfirstlane(F.tid >> 6); F.G = gridDim.x; F.bid = blockIdx.x;
    for (int u = F.tid; u < (LDS_BYTES - LDSCTL_OFF) / 4; u += NTHR) ((LAS unsigned*)(lds + LDSCTL_OFF))[u] = 0u;
    __syncthreads();
    const int lo = p.ph_lo, hi = p.ph_hi;
    const bool multi = (hi - lo) > 1;
    XcdBarrier bar; bar.bar = F.ctl + CW_BAR + p.li * XCD_BAR_WORDS; bar.x = 0; bar.st = nullptr;
    if (multi) bar = xcd_barrier_post(F.ctl + CW_BAR + p.li * XCD_BAR_WORDS, (volatile LAS unsigned*)(lds + MISC_OFF) + 8);
#define IN(k) (lo <= (k) && (k) < hi)
#define SEAM(k) do { if (IN(k) && IN((k) + 1)) xcd_barrier(bar); } while (0)
    if (IN(0)) { phase_prologue(F, p); } SEAM(0);
    if (IN(1)) { phase_modulate0(F, p); } SEAM(1);
    if (IN(2)) { PHASE_QKV(F, p); } SEAM(2);
    if (IN(3)) { PHASE_ATTN(F, p); } SEAM(3);
    if (IN(4)) { phase_attn_combine(F, p); } SEAM(4);
    if (IN(5)) { PHASE_WO(F, p, 0); } SEAM(5);
    if (IN(6)) { phase_ln_route(F, p, 0); } SEAM(6);
    if (IN(7)) { PHASE_MOE1(F, p, 0); } SEAM(7);
    if (IN(8)) { PHASE_MOE2(F, p, 0); } SEAM(8);
    if (IN(9)) { phase_moe_combine(F, p, 0); } SEAM(9);
    if (IN(10)) { PHASE_INPROJ(F, p); } SEAM(10);
    if (IN(11)) { phase_gla_prep(F, p); } SEAM(11);
    if (IN(12)) { PHASE_SCAN(F, p); } SEAM(12);
    if (IN(13)) { phase_gla_post(F, p); } SEAM(13);
    if (IN(14)) { PHASE_WO(F, p, 1); } SEAM(14);
    if (IN(15)) { phase_ln_route(F, p, 1); } SEAM(15);
    if (IN(16)) { PHASE_MOE1(F, p, 1); } SEAM(16);
    if (IN(17)) { PHASE_MOE2(F, p, 1); } SEAM(17);
    if (IN(18)) { phase_moe_combine(F, p, 1); }
#undef IN
#undef SEAM
}

static void launch_naive(int ph, const Prm& p, hipStream_t stream) {
    using namespace naive;
    const bf16* H = (const bf16*)(p.ws + WS_H);
    switch (ph) {
    case 2: { NG g{H, (const bf16*)(p.ws + WS_WQKV), NTOK, 3072, 1024, 0, nullptr}; hipLaunchKernelGGL(gemm_kernel<EPI_QKV>, dim3(3072 / 64, NTOK / 64), dim3(256), 0, stream, g, p); break; }
    case 3: hipLaunchKernelGGL(attn_kernel, dim3(544, 16), dim3(256), 0, stream, p); break;
    case 5: { NG g{(const bf16*)(p.ws + WS_A2), (const bf16*)(p.ws + WS_WO), NTOK, 1024, 1024, 0, (bf16*)(p.ws + WS_Y)}; hipLaunchKernelGGL(gemm_kernel<EPI_PLAIN>, dim3(16, NTOK / 64), dim3(256), 0, stream, g, p); break; }
    case 7: case 16: { const int l = ph == 16; NG g{H, (const bf16*)(p.ws + (l ? WS_GU1 : WS_GU0)), MAXSLOT, 1024, 1024, l, nullptr}; hipLaunchKernelGGL(gemm_kernel<EPI_GATEUP>, dim3(16, MAXSLOT / 64), dim3(256), 0, stream, g, p); break; }
    case 8: case 17: { const int l = ph == 17; NG g{(const bf16*)(p.ws + WS_ACT), (const bf16*)(p.ws + (l ? WS_DN1 : WS_DN0)), MAXSLOT, 1024, 512, l, nullptr}; hipLaunchKernelGGL(gemm_kernel<EPI_DOWN>, dim3(16, MAXSLOT / 64), dim3(256), 0, stream, g, p); break; }
    case 10: { NG g{H, (const bf16*)(p.ws + WS_WIN), NTOK, NIN, 1024, 0, nullptr}; hipLaunchKernelGGL(gemm_kernel<EPI_INPROJ>, dim3(NIN / 64, NTOK / 64), dim3(256), 0, stream, g, p); break; }
    case 12: hipLaunchKernelGGL(gla_scan_kernel, dim3(512), dim3(256), GLA_SCAN_LDS, stream, p); break;
    case 14: { NG g{(const bf16*)(p.ws + WS_A2B), (const bf16*)(p.ws + WS_WGO), NLAT, 1024, 1024, 0, (bf16*)(p.ws + WS_Y)}; hipLaunchKernelGGL(gemm_kernel<EPI_PLAIN>, dim3(16, NLAT / 64), dim3(256), 0, stream, g, p); break; }
    default: break;
    }
}
extern "C" void kernel_launch(void* const* d_in, const int* in_sizes, int n_in, void* d_out, int out_size, void* d_ws, size_t ws_size, hipStream_t stream) {
    static int grid = 0;
    if (grid == 0) {
        if (n_in != 23 || in_sizes[0] != NLAT * DM || out_size != NLAT * DM || ws_size < WS_END) { fprintf(stderr, "kernel_launch: unexpected shapes (n_in %d, in0 %d, out %d, ws %zu); nothing launched\n", n_in, n_in > 0 ? in_sizes[0] : -1, out_size, ws_size); grid = -1; return; }
        int dev = 0, cus = 0;
        if (hipGetDevice(&dev) != hipSuccess || hipDeviceGetAttribute(&cus, hipDeviceAttributeMultiprocessorCount, dev) != hipSuccess) { grid = -1; return; }
        if (hipFuncSetAttribute((const void*)mega_fwd, hipFuncAttributeMaxDynamicSharedMemorySize, LDS_BYTES) != hipSuccess) { fprintf(stderr, "kernel_launch: hipFuncSetAttribute failed\n"); grid = -1; return; }
        (void)hipFuncSetAttribute((const void*)naive::gla_scan_kernel, hipFuncAttributeMaxDynamicSharedMemorySize, naive::GLA_SCAN_LDS);
        int per_cu = 0;
        if (hipOccupancyMaxActiveBlocksPerMultiprocessor(&per_cu, (const void*)mega_fwd, NTHR, LDS_BYTES) != hipSuccess || per_cu < 1) fprintf(stderr, "kernel_launch: note: occupancy query reports %d\n", per_cu);
        (void)hipGetLastError();
        grid = cus;
    }
    if (grid < 0) return;
    (void)hipMemsetAsync((char*)d_ws + WS_CTL, 0, CTL_ZERO_BYTES, stream);
    Prm p{};
    const float** pp = (const float**)&p;
    for (int i = 0; i < 23; ++i) pp[i] = (const float*)d_in[i];
    p.out = (float*)d_out; p.ws = (unsigned char*)d_ws;
    const unsigned naive_phases = (1u << 2) | (1u << 3) | (1u << 5) | (1u << 7) | (1u << 8) | (1u << 10) | (1u << 12) | (1u << 14) | (1u << 16) | (1u << 17);
    const unsigned use_naive = naive_phases & ~(unsigned)(OPT_MASK);
    int ph = 0, li = 0;
    while (ph < NPHASE) {
        if (use_naive & (1u << ph)) { launch_naive(ph, p, stream); ++ph; continue; }
        int e = ph + 1;
#if defined(ONE_PER_PHASE)
#else
        while (e < NPHASE && !(use_naive & (1u << e))) ++e;
#endif
        p.ph_lo = ph; p.ph_hi = e; p.li = li++;
        hipLaunchKernelGGL(mega_fwd, dim3(grid), dim3(NTHR), LDS_BYTES, stream, p);
        ph = e;
    }
}
```

```cpp
#define OPT_MASK 0x355ACu
#include <hip/hip_runtime.h>
#include <cstdint>
#include <cstdio>

constexpr int BATCH = 8, SEQ = 4096, DM = 1024, CTXL = 256;
constexpr int NLAT = BATCH * SEQ, NCTX = BATCH * CTXL, NTOK = NLAT + NCTX;
constexpr float ALPHA = 1.4142135623730951f;
constexpr float LN_EPS = 1e-5f;
constexpr float LAMBDA_INIT0 = 0.2f;
constexpr float C2 = 0.125f * 1.4426950408889634f;
constexpr int NEXP = 16, DEXP = 512, MAXSLOT = 73728;
constexpr int NCHUNK = NTOK / 64;
constexpr int NIN = 3328;

typedef unsigned short bf16;
typedef float f32x4 __attribute__((ext_vector_type(4)));
typedef float f32x2 __attribute__((ext_vector_type(2)));
typedef unsigned u32x2 __attribute__((ext_vector_type(2)));
typedef unsigned u32x4 __attribute__((ext_vector_type(4)));

constexpr size_t MiB = 1u << 20;
constexpr size_t WS_CTL = 0, CTL_ZERO_BYTES = 1 * MiB;
constexpr size_t WS_MOD = 1 * MiB;
constexpr size_t WS_MISC = 1 * MiB + 512 * 1024;
constexpr size_t WS_WQKV = 2 * MiB, WS_WO = 8 * MiB, WS_GU0 = 10 * MiB, WS_DN0 = 42 * MiB;
constexpr size_t WS_XCTX = 58 * MiB;
constexpr size_t WS_WIN = 66 * MiB, WS_WGO = 73 * MiB, WS_GU1 = 75 * MiB, WS_DN1 = 107 * MiB;
constexpr size_t WS_H = 123 * MiB;
constexpr size_t WS_Q = 191 * MiB, WS_K = 259 * MiB, WS_V = 327 * MiB, WS_O2 = 395 * MiB;
constexpr size_t WS_LIST = 463 * MiB;
constexpr size_t WS_TOKR = 466 * MiB;
constexpr size_t WS_DEC = 468 * MiB;
constexpr size_t WS_ZZ = 471 * MiB;
constexpr size_t WS_END = 480 * MiB;
constexpr size_t WS_O1 = WS_H, WS_A2 = WS_Q, WS_Y = WS_K;
constexpr size_t WS_YM = 191 * MiB, WS_ACT = 335 * MiB;
constexpr size_t WS_QR = 191 * MiB, WS_KR = 225 * MiB, WS_V1 = 259 * MiB, WS_R = 327 * MiB;
constexpr size_t WS_QT = WS_H, WS_KT = 395 * MiB;
constexpr size_t WS_OGF = 191 * MiB, WS_OGB = 2 * MiB;
constexpr size_t WS_A2B = WS_H;
constexpr int CW_TMO = 0, CW_CODE = 1;
constexpr int CW_CNT = 64;
constexpr int CW_BAR = 4096;

__device__ __forceinline__ unsigned f2bf(float f) { unsigned u = __builtin_bit_cast(unsigned, f); return (u + 0x7fffu + ((u >> 16) & 1u)) >> 16; }
__device__ __forceinline__ unsigned pk2(float lo, float hi) { return f2bf(lo) | (f2bf(hi) << 16); }
__device__ __forceinline__ float bf2f(unsigned b) { return __builtin_bit_cast(float, b << 16); }
__device__ __forceinline__ float wave_sum(float v) {
#pragma unroll
    for (int o = 1; o < 64; o <<= 1) v += __shfl_xor(v, o);
    return v;
}
__device__ __forceinline__ float silu_f(float v) { return v / (1.f + __expf(-v)); }

struct Prm {
    const float *x, *c, *ctx, *cctx, *ada_w, *ada_b, *ln_g, *ln_b, *w_qkv, *w_o, *lam, *subln, *gw_in, *gwg_down, *gwg_up, *gbg, *gnorm, *gw_o, *rw, *rb, *mg, *mu, *md;
    float* out; unsigned char* ws;
    int ph_lo, ph_hi, li, pad;
};
__device__ __forceinline__ void ld_row_f32(const float* p, int lane, f32x4 (&v)[4]) {
#pragma unroll
    for (int j = 0; j < 4; ++j) v[j] = *(const f32x4*)(p + 4 * lane + 256 * j);
}
__device__ __forceinline__ void st_row_f32(float* p, int lane, const f32x4 (&v)[4]) {
#pragma unroll
    for (int j = 0; j < 4; ++j) *(f32x4*)(p + 4 * lane + 256 * j) = v[j];
}
__device__ __forceinline__ void ld_row_bf16(const bf16* p, int lane, f32x4 (&v)[4]) {
#pragma unroll
    for (int j = 0; j < 4; ++j) { const u32x2 u = *(const u32x2*)(p + 4 * lane + 256 * j); v[j] = (f32x4){bf2f(u.x & 0xffffu), bf2f(u.x >> 16), bf2f(u.y & 0xffffu), bf2f(u.y >> 16)}; }
}
__device__ __forceinline__ void st_row_bf16(bf16* p, int lane, const f32x4 (&v)[4]) {
#pragma unroll
    for (int j = 0; j < 4; ++j) { u32x2 u; u.x = pk2(v[j].x, v[j].y); u.y = pk2(v[j].z, v[j].w); *(u32x2*)(p + 4 * lane + 256 * j) = u; }
}
__device__ __forceinline__ void ln_row(f32x4 (&v)[4], const float* g, const float* b, int lane) {
    float s = 0.f;
#pragma unroll
    for (int j = 0; j < 4; ++j) s += (v[j].x + v[j].y) + (v[j].z + v[j].w);
    const float mean = wave_sum(s) * (1.f / DM); float q = 0.f;
#pragma unroll
    for (int j = 0; j < 4; ++j) { v[j] = v[j] - mean; q += (v[j].x * v[j].x + v[j].y * v[j].y) + (v[j].z * v[j].z + v[j].w * v[j].w); }
    const float rstd = 1.f / sqrtf(wave_sum(q) * (1.f / DM) + LN_EPS);
#pragma unroll
    for (int j = 0; j < 4; ++j) { const f32x4 gg = *(const f32x4*)(g + 4 * lane + 256 * j), bb = *(const f32x4*)(b + 4 * lane + 256 * j); v[j] = v[j] * rstd * gg + bb; }
}
__host__ __device__ __forceinline__ int gu_phys(int other, int sel) { return (other >> 4) * 32 + sel * 16 + (other & 15); }
#define GAS __attribute__((address_space(1)))
#define LAS __attribute__((address_space(3)))
constexpr int NWAVES = 8, NTHR = NWAVES * 64;
constexpr int RING_BYTES = 131072, LDSCTL_OFF = RING_BYTES, MISC_OFF = LDSCTL_OFF + 320, LDS_BYTES = 147456;
constexpr int LDSX_OFF = RING_BYTES + 1024;
#define LDS_WAIT() asm volatile("s_waitcnt lgkmcnt(0)" ::: "memory")
#define VM_WAIT() asm volatile("s_waitcnt vmcnt(0)" ::: "memory")

struct Frame {
    unsigned char* lds;
    unsigned* ctl;
    int tid, lane, wave, G, bid;
};

template <int MODE>
__device__ __forceinline__ void p0_transpose_item(const float* W, int K, int N, bf16* WT, int row_off, float* scr, int item, int lane) {
    const int nblk = N / 32, kb = item / nblk, nb = item % nblk, k0 = 64 * kb, n0 = 32 * nb;
#pragma unroll 8
    for (int i = 0; i < 32; ++i) { const int kk = 2 * i + (lane >> 5); scr[kk * 33 + (lane & 31)] = W[(size_t)(k0 + kk) * N + n0 + (lane & 31)]; }
    LDS_WAIT(); asm volatile("" ::: "memory");
    const int c = lane & 7;
#pragma unroll
    for (int j = 0; j < 4; ++j) { const int n = (lane >> 3) + 8 * j; const float* s = scr + (8 * c) * 33 + n;
        u32x4 o; o.x = pk2(s[0 * 33], s[1 * 33]); o.y = pk2(s[2 * 33], s[3 * 33]); o.z = pk2(s[4 * 33], s[5 * 33]); o.w = pk2(s[6 * 33], s[7 * 33]);
        const int nl = n0 + n; const int pr = (MODE == 0) ? (row_off + nl) : (row_off + gu_phys(nl, MODE - 1));
        *(u32x4*)(WT + (size_t)pr * K + k0 + 8 * c) = o; }
    LDS_WAIT(); asm volatile("" ::: "memory");
}
__device__ __forceinline__ void phase_prologue(const Frame& F, const Prm& p) {
    float* sil = (float*)F.lds;
    for (int i = F.tid; i < 9 * 1024; i += NTHR) { const int r = i >> 10, k = i & 1023; const float v = (r < 8) ? p.c[r * 1024 + k] : p.cctx[k]; sil[i] = silu_f(v); }
    __syncthreads();
    float* MOD = (float*)(p.ws + WS_MOD);
    if (F.bid < 192) {
        const int layer = F.bid / 96, n = (F.bid % 96) * 64 + F.lane; const float* W = p.ada_w + (size_t)layer * 1024 * 6144 + n;
        float acc[9];
#pragma unroll
        for (int r = 0; r < 9; ++r) acc[r] = 0.f;
        const int kb = F.wave * 128;
#pragma unroll 4
        for (int k = kb; k < kb + 128; k += 4) {
            const float w0 = W[(size_t)k * 6144], w1 = W[(size_t)(k + 1) * 6144], w2 = W[(size_t)(k + 2) * 6144], w3 = W[(size_t)(k + 3) * 6144];
#pragma unroll
            for (int r = 0; r < 9; ++r) { const f32x4 s = *(const f32x4*)(sil + r * 1024 + k); acc[r] += s.x * w0 + s.y * w1 + s.z * w2 + s.w * w3; }
        }
        float* red = (float*)(F.lds + 36864 + 8 * 8704);
#pragma unroll
        for (int r = 0; r < 9; ++r) red[(F.wave * 9 + r) * 64 + F.lane] = acc[r];
        __syncthreads();
        if (F.wave == 0) { const float bb = p.ada_b[layer * 6144 + n];
#pragma unroll
            for (int r = 0; r < 9; ++r) { float t = bb;
#pragma unroll
                for (int w = 0; w < 8; ++w) t += red[(w * 9 + r) * 64 + F.lane];
                MOD[(layer * 9 + r) * 6144 + n] = t; } }
    }
    float* misc = (float*)(p.ws + WS_MISC);
    if (F.bid == 255 % F.G && F.wave == 1) {
        const float a = wave_sum(p.lam[F.lane] * p.lam[64 + F.lane]), b = wave_sum(p.lam[128 + F.lane] * p.lam[192 + F.lane]);
        if (F.lane == 0) misc[0] = __expf(a) - __expf(b) + LAMBDA_INIT0;
        for (int i = F.lane; i < 1024; i += 64) { const int pos = i >> 4, f = i & 15; const float inv = powf(10000.f, -(float)f / 16.f); const float ang = (float)pos * inv;
            misc[1024 + 2 * i] = cosf(ang); misc[1024 + 2 * i + 1] = sinf(ang); }
    }
    float* scr = (float*)(F.lds + 36864 + F.wave * 8704);
    const int gw = F.bid * NWAVES + F.wave, NGW = F.G * NWAVES;
    constexpr int I_QKV = 16 * 96, I_SQ = 16 * 32, I_G = 16 * 16, I_D = 8 * 32;
    constexpr int I_MOE = 2 * I_G + I_D;
    constexpr int NITEMS = 2 * I_QKV + 2 * I_SQ + 32 * I_MOE;
    bf16* ws16 = (bf16*)p.ws;
    for (int it = gw; it < NITEMS; it += NGW) {
        int r = it;
        if (r < I_QKV) { p0_transpose_item<0>(p.w_qkv, 1024, 3072, (bf16*)(p.ws + WS_WQKV), 0, scr, r, F.lane); continue; } r -= I_QKV;
        if (r < I_QKV) { p0_transpose_item<0>(p.gw_in, 1024, 3072, (bf16*)(p.ws + WS_WIN), 0, scr, r, F.lane); continue; } r -= I_QKV;
        if (r < I_SQ) { p0_transpose_item<0>(p.w_o, 1024, 1024, (bf16*)(p.ws + WS_WO), 0, scr, r, F.lane); continue; } r -= I_SQ;
        if (r < I_SQ) { p0_transpose_item<0>(p.gw_o, 1024, 1024, (bf16*)(p.ws + WS_WGO), 0, scr, r, F.lane); continue; } r -= I_SQ;
        const int le = r / I_MOE, layer = le >> 4, e = le & 15; r -= le * I_MOE;
        bf16* GU = (bf16*)(p.ws + (layer ? WS_GU1 : WS_GU0)) + (size_t)e * 1024 * 1024; bf16* DN = (bf16*)(p.ws + (layer ? WS_DN1 : WS_DN0)) + (size_t)e * 1024 * 512;
        if (r < I_G) { p0_transpose_item<1>(p.mg + (size_t)le * 1024 * 512, 1024, 512, GU, 0, scr, r, F.lane); continue; } r -= I_G;
        if (r < I_G) { p0_transpose_item<2>(p.mu + (size_t)le * 1024 * 512, 1024, 512, GU, 0, scr, r, F.lane); continue; } r -= I_G;
        p0_transpose_item<0>(p.md + (size_t)le * 512 * 1024, 512, 1024, DN, 0, scr, r, F.lane);
    }
    (void)ws16;
    bf16* WIN = (bf16*)(p.ws + WS_WIN);
    for (int i = gw * 64 + F.lane; i < 32 * 1024; i += NGW * 64) { const int rr = i >> 10, k = i & 1023, dir = rr >> 4, j = rr & 15;
        WIN[(size_t)(3072 + rr) * 1024 + k] = (bf16)f2bf(p.gwg_down[(size_t)dir * 1024 * 16 + k * 16 + j]); }
    for (int i = gw * 64 + F.lane; i < 224 * 1024 / 8; i += NGW * 64) *(u32x4*)(WIN + (size_t)3104 * 1024 + (size_t)i * 8) = (u32x4){0u, 0u, 0u, 0u};
}

__device__ __forceinline__ void phase_modulate0(const Frame& F, const Prm& p) {
    const float* MOD = (const float*)(p.ws + WS_MOD); bf16* H = (bf16*)(p.ws + WS_H);
    const int gw = F.bid * NWAVES + F.wave, NGW = F.G * NWAVES, per = (NTOK + NGW - 1) / NGW;
    int curmod = -1; f32x4 sh[4], sc[4];
    for (int tok = gw * per; tok < (gw + 1) * per && tok < NTOK; ++tok) {
        const int mr = tok < NLAT ? tok / SEQ : 8; const float* src = tok < NLAT ? p.x + (size_t)tok * DM : p.ctx + (size_t)(tok - NLAT) * DM;
        if (mr != curmod) { curmod = mr; ld_row_f32(MOD + mr * 6144, F.lane, sh); ld_row_f32(MOD + mr * 6144 + 1024, F.lane, sc); }
        f32x4 v[4]; ld_row_f32(src, F.lane, v);
#pragma unroll
        for (int j = 0; j < 4; ++j) v[j] = v[j] * (1.f + sc[j]) + sh[j];
        st_row_bf16(H + (size_t)tok * DM, F.lane, v);
    }
}

__device__ __forceinline__ void phase_attn_combine(const Frame& F, const Prm& p) {
    const bf16* O1 = (const bf16*)(p.ws + WS_O1); const bf16* O2 = (const bf16*)(p.ws + WS_O2); bf16* A2 = (bf16*)(p.ws + WS_A2);
    const float lam = ((const float*)(p.ws + WS_MISC))[0];
    const f32x4 sg = *(const f32x4*)(p.subln + 4 * (F.lane & 31));
    const int gw = F.bid * NWAVES + F.wave, NGW = F.G * NWAVES;
    for (int tok = gw; tok < NTOK; tok += NGW) {
        f32x4 a[4], b[4]; ld_row_bf16(O1 + (size_t)tok * DM, F.lane, a); ld_row_bf16(O2 + (size_t)tok * DM, F.lane, b);
#pragma unroll
        for (int j = 0; j < 4; ++j) {
            f32x4 o = a[j] - lam * b[j]; float q = (o.x * o.x + o.y * o.y) + (o.z * o.z + o.w * o.w);
#pragma unroll
            for (int s = 1; s < 32; s <<= 1) q += __shfl_xor(q, s);
            const float r = (1.f - LAMBDA_INIT0) / sqrtf(q * (1.f / 128.f) + LN_EPS);
            a[j] = o * r * sg;
        }
        st_row_bf16(A2 + (size_t)tok * DM, F.lane, a);
    }
}

__device__ __forceinline__ void phase_ln_route(const Frame& F, const Prm& p, int layer) {
    const int nrows = layer ? NLAT : NTOK;
    const float* MOD = (const float*)(p.ws + WS_MOD) + layer * 9 * 6144;
    const bf16* Y = (const bf16*)(p.ws + WS_Y); bf16* HF = (bf16*)(p.ws + WS_H);
    float* XCTX = (float*)(p.ws + WS_XCTX);
    int* LIST = (int*)(p.ws + WS_LIST); int* TOKR = (int*)(p.ws + WS_TOKR);
    unsigned* CNT = F.ctl + CW_CNT + layer * 16;
    float* WrT = (float*)F.lds;
    int* rec = (int*)(F.lds + 65536);
    unsigned* lcnt = (unsigned*)(F.lds + 65536 + 8192); unsigned* lbase = lcnt + 16;
    for (int i = F.tid; i < 16 * 1024; i += NTHR) { const int k = i >> 4, e = i & 15; WrT[e * 1024 + k] = p.rw[i]; }
    if (F.tid < 16) lcnt[F.tid] = 0u;
    __syncthreads();
    const int per_wg = (nrows + F.G - 1) / F.G, per_w = (per_wg + NWAVES - 1) / NWAVES;
    const int row_lo = F.bid * per_wg, row_hi = min(nrows, row_lo + per_wg);
    const float* lng = p.ln_g + (layer * 2 + 0) * DM; const float* lnb = p.ln_b + (layer * 2 + 0) * DM;
    float rb[16];
#pragma unroll
    for (int e = 0; e < 16; ++e) rb[e] = p.rb[e];
    int curmod = -1; f32x4 gm[4], shf[4], scf[4];
    for (int i = 0; i < per_w; ++i) {
        const int lr = F.wave * per_w + i, tok = row_lo + lr; if (tok >= row_hi) break;
        const int mr = tok < NLAT ? tok / SEQ : 8;
        if (mr != curmod) { curmod = mr; ld_row_f32(MOD + mr * 6144 + 2048, F.lane, gm); ld_row_f32(MOD + mr * 6144 + 3072, F.lane, shf); ld_row_f32(MOD + mr * 6144 + 4096, F.lane, scf); }
        float* xdst = tok < NLAT ? p.out + (size_t)tok * DM : XCTX + (size_t)(tok - NLAT) * DM;
        const float* xsrc = layer ? (const float*)xdst : (tok < NLAT ? p.x + (size_t)tok * DM : p.ctx + (size_t)(tok - NLAT) * DM);
        f32x4 v[4], y[4]; ld_row_f32(xsrc, F.lane, v); ld_row_bf16(Y + (size_t)tok * DM, F.lane, y);
#pragma unroll
        for (int j = 0; j < 4; ++j) v[j] = ALPHA * v[j] + gm[j] * y[j];
        ln_row(v, lng, lnb, F.lane);
        st_row_f32(xdst, F.lane, v);
#pragma unroll
        for (int j = 0; j < 4; ++j) v[j] = v[j] * (1.f + scf[j]) + shf[j];
        st_row_bf16(HF + (size_t)tok * DM, F.lane, v);
        float part[16];
#pragma unroll
        for (int e = 0; e < 16; ++e) { float s = 0.f;
#pragma unroll
            for (int j = 0; j < 4; ++j) { const f32x4 w = *(const f32x4*)(WrT + e * 1024 + 4 * F.lane + 256 * j); s += (v[j].x * w.x + v[j].y * w.y) + (v[j].z * w.z + v[j].w * w.w); }
            part[e] = s; }
        {
#pragma unroll
            for (int e = 0; e < 8; ++e) { const bool up = (F.lane & 32) != 0; const float keep = up ? part[e + 8] : part[e], send = up ? part[e] : part[e + 8]; part[e] = keep + __shfl_xor(send, 32); }
#pragma unroll
            for (int e = 0; e < 4; ++e) { const bool up = (F.lane & 16) != 0; const float keep = up ? part[e + 4] : part[e], send = up ? part[e] : part[e + 4]; part[e] = keep + __shfl_xor(send, 16); }
#pragma unroll
            for (int e = 0; e < 2; ++e) { const bool up = (F.lane & 8) != 0; const float keep = up ? part[e + 2] : part[e], send = up ? part[e] : part[e + 2]; part[e] = keep + __shfl_xor(send, 8); }
            { const bool up = (F.lane & 4) != 0; const float keep = up ? part[1] : part[0], send = up ? part[0] : part[1]; part[0] = keep + __shfl_xor(send, 4); }
            part[0] += __shfl_xor(part[0], 2); part[0] += __shfl_xor(part[0], 1);
        }
        float aff[16], sel[16];
#pragma unroll
        for (int e = 0; e < 16; ++e) { const int src = ((e >> 3) & 1) * 32 + ((e >> 2) & 1) * 16 + ((e >> 1) & 1) * 8 + (e & 1) * 4; const float lg = __shfl(part[0], src); aff[e] = 1.f / (1.f + __expf(-lg)); sel[e] = aff[e] + rb[e]; }
        int bg = 0; float bgs = -3.0e38f;
#pragma unroll
        for (int g = 0; g < 4; ++g) { float m1 = -3.0e38f, m2 = -3.0e38f;
#pragma unroll
            for (int k = 0; k < 4; ++k) { const float s = sel[4 * g + k]; if (s > m1) { m2 = m1; m1 = s; } else if (s > m2) m2 = s; }
            const float gs = m1 + m2; if (gs > bgs) { bgs = gs; bg = g; } }
        int i1 = 0, i2 = 0; float s1 = -3.0e38f, s2 = -3.0e38f, a1 = 0.f, a2 = 0.f;
#pragma unroll
        for (int g = 0; g < 4; ++g) if (g == bg) {
#pragma unroll
            for (int k = 0; k < 4; ++k) { const float s = sel[4 * g + k], a = aff[4 * g + k];
                if (s > s1) { s2 = s1; i2 = i1; a2 = a1; s1 = s; i1 = 4 * g + k; a1 = a; } else if (s > s2) { s2 = s; i2 = 4 * g + k; a2 = a; } } }
        const float wsum = a1 + a2, w1 = a1 / wsum, w2 = a2 / wsum;
        if (F.lane == 0) { const unsigned l1 = atomicAdd(&lcnt[i1], 1u), l2 = atomicAdd(&lcnt[i2], 1u);
            rec[lr * 6 + 0] = i1; rec[lr * 6 + 1] = i2; rec[lr * 6 + 2] = (int)l1; rec[lr * 6 + 3] = (int)l2; rec[lr * 6 + 4] = __float_as_int(w1); rec[lr * 6 + 5] = __float_as_int(w2); }
    }
    __syncthreads();
    if (F.tid < 16) lbase[F.tid] = __hip_atomic_fetch_add(&CNT[F.tid], lcnt[F.tid], __ATOMIC_RELAXED, __HIP_MEMORY_SCOPE_AGENT);
    __syncthreads();
    for (int lr = F.tid; lr < row_hi - row_lo; lr += NTHR) { const int tok = row_lo + lr;
        const int e0 = rec[lr * 6], e1 = rec[lr * 6 + 1]; const int p0 = (int)lbase[e0] + rec[lr * 6 + 2], p1 = (int)lbase[e1] + rec[lr * 6 + 3];
        LIST[e0 * NTOK + p0] = tok; LIST[e1 * NTOK + p1] = tok;
        int* tr = TOKR + (size_t)tok * 8; tr[0] = e0; tr[1] = p0; tr[2] = e1; tr[3] = p1; tr[4] = rec[lr * 6 + 4]; tr[5] = rec[lr * 6 + 5]; }
    __syncthreads();
}

__device__ __forceinline__ void pad_bases(const unsigned* cnt, int (&pb)[17]) {
    int acc = 0;
#pragma unroll
    for (int e = 0; e < 16; ++e) { pb[e] = acc; const int c = (int)__hip_atomic_load(cnt + e, __ATOMIC_RELAXED, __HIP_MEMORY_SCOPE_AGENT); acc += (c + 255) & ~255; }
    pb[16] = acc;
}

__device__ __forceinline__ void phase_moe_combine(const Frame& F, const Prm& p, int layer) {
    const int nrows = layer ? NLAT : NTOK;
    const float* MOD = (const float*)(p.ws + WS_MOD) + layer * 9 * 6144; const float* MOD1 = (const float*)(p.ws + WS_MOD) + 9 * 6144;
    const bf16* YM = (const bf16*)(p.ws + WS_YM); bf16* H = (bf16*)(p.ws + WS_H); float* XCTX = (float*)(p.ws + WS_XCTX); const int* TOKR = (const int*)(p.ws + WS_TOKR);
    int pb[17]; pad_bases(F.ctl + CW_CNT + layer * 16, pb);
    int* pbl = (int*)F.lds; if (F.tid < 17) { int v = 0;
#pragma unroll
        for (int e = 0; e < 17; ++e) if (e == F.tid) v = pb[e];
        pbl[F.tid] = v; }
    __syncthreads();
    const float* lng = p.ln_g + (layer * 2 + 1) * DM; const float* lnb = p.ln_b + (layer * 2 + 1) * DM;
    const int gw = F.bid * NWAVES + F.wave, NGW = F.G * NWAVES, per = (nrows + NGW - 1) / NGW;
    int curmod = -1; f32x4 gf[4], sh1[4], sc1[4];
    for (int tok = gw * per; tok < (gw + 1) * per && tok < nrows; ++tok) {
        const int mr = tok < NLAT ? tok / SEQ : 8;
        if (mr != curmod) { curmod = mr; ld_row_f32(MOD + mr * 6144 + 5120, F.lane, gf); if (!layer) { ld_row_f32(MOD1 + mr * 6144, F.lane, sh1); ld_row_f32(MOD1 + mr * 6144 + 1024, F.lane, sc1); } }
        const int* tr = TOKR + (size_t)tok * 8; const int s0 = pbl[tr[0]] + tr[1], s1 = pbl[tr[2]] + tr[3]; const float w0 = __int_as_float(tr[4]), w1 = __int_as_float(tr[5]);
        float* xp = tok < NLAT ? p.out + (size_t)tok * DM : XCTX + (size_t)(tok - NLAT) * DM;
        f32x4 v[4], a[4], b[4]; ld_row_f32(xp, F.lane, v); ld_row_bf16(YM + (size_t)s0 * DM, F.lane, a); ld_row_bf16(YM + (size_t)s1 * DM, F.lane, b);
#pragma unroll
        for (int j = 0; j < 4; ++j) v[j] = ALPHA * v[j] + gf[j] * (w0 * a[j] + w1 * b[j]);
        ln_row(v, lng, lnb, F.lane);
        st_row_f32(xp, F.lane, v);
        if (!layer) {
#pragma unroll
            for (int j = 0; j < 4; ++j) v[j] = v[j] * (1.f + sc1[j]) + sh1[j];
            st_row_bf16(H + (size_t)tok * DM, F.lane, v);
        }
    }
}

__device__ __forceinline__ void phase_gla_prep(const Frame& F, const Prm& p) {
    const bf16* QR = (const bf16*)(p.ws + WS_QR); const bf16* KR = (const bf16*)(p.ws + WS_KR); const float* ZZ = (const float*)(p.ws + WS_ZZ);
    bf16* QT = (bf16*)(p.ws + WS_QT); bf16* KT = (bf16*)(p.ws + WS_KT); float* DEC = (float*)(p.ws + WS_DEC);
    const int gw = F.bid * NWAVES + F.wave, NGW = F.G * NWAVES;
    for (int task = gw; task < 2 * NCHUNK * 8; task += NGW) {
        const int dh = task & 7, chunk = (task >> 3) % NCHUNK, dir = __builtin_amdgcn_readfirstlane(task / (8 * NCHUNK));
        const int col = dh * 64 + F.lane, tok0 = chunk * 64;
        unsigned short qv[64], kv[64];
#pragma unroll
        for (int t = 0; t < 64; ++t) { qv[t] = QR[(size_t)(tok0 + t) * 512 + col]; kv[t] = KR[(size_t)(tok0 + t) * 512 + col]; }
        f32x4 zl[4];
#pragma unroll
        for (int j = 0; j < 4; ++j) zl[j] = *(const f32x4*)(ZZ + (size_t)(tok0 + F.lane) * 32 + dir * 16 + 4 * j);
        float wup[16];
#pragma unroll
        for (int j = 0; j < 16; ++j) wup[j] = p.gwg_up[(size_t)dir * 16 * 512 + j * 512 + col];
        const float bgv = p.gbg[dir * 512 + col];
        float b = 0.f;
        bf16* qo = QT + ((size_t)dir * NTOK + tok0) * 512 + col; bf16* ko = KT + ((size_t)dir * NTOK + tok0) * 512 + col;
#pragma unroll
        for (int tt = 0; tt < 64; ++tt) {
            float z = bgv;
#pragma unroll
            for (int j = 0; j < 4; ++j) { const int tl = dir ? 63 - tt : tt;
                const float z0 = __int_as_float(__builtin_amdgcn_readlane(__float_as_int(zl[j].x), tl)), z1 = __int_as_float(__builtin_amdgcn_readlane(__float_as_int(zl[j].y), tl));
                const float z2 = __int_as_float(__builtin_amdgcn_readlane(__float_as_int(zl[j].z), tl)), z3 = __int_as_float(__builtin_amdgcn_readlane(__float_as_int(zl[j].w), tl));
                z += z0 * wup[4 * j] + z1 * wup[4 * j + 1] + z2 * wup[4 * j + 2] + z3 * wup[4 * j + 3]; }
            const float g = (fminf(z, 0.f) - __logf(1.f + __expf(-fabsf(z)))) * (1.f / 16.f);
            b += g;
            const float e = __expf(b), ei = __builtin_amdgcn_rcpf(e);
            const float q = dir ? bf2f(qv[63 - tt]) : bf2f(qv[tt]), k = dir ? bf2f(kv[63 - tt]) : bf2f(kv[tt]);
            const int t = dir ? 63 - tt : tt;
            qo[(size_t)t * 512] = (bf16)f2bf(q * e); ko[(size_t)t * 512] = (bf16)f2bf(k * ei);
        }
        DEC[((size_t)dir * NCHUNK + chunk) * 512 + col] = __expf(b);
    }
}

__device__ __forceinline__ void phase_gla_post(const Frame& F, const Prm& p) {
    const bf16* OF = (const bf16*)(p.ws + WS_OGF); const bf16* OB = (const bf16*)(p.ws + WS_OGB); const bf16* R = (const bf16*)(p.ws + WS_R); bf16* A2 = (bf16*)(p.ws + WS_A2B);
    const f32x4 ng = *(const f32x4*)(p.gnorm + 4 * F.lane);
    const int gw = F.bid * NWAVES + F.wave, NGW = F.G * NWAVES;
    for (int tok = gw; tok < NLAT; tok += NGW) {
        f32x4 a[4], b[4], r[4]; ld_row_bf16(OF + (size_t)tok * DM, F.lane, a); ld_row_bf16(OB + (size_t)tok * DM, F.lane, b); ld_row_bf16(R + (size_t)tok * DM, F.lane, r);
#pragma unroll
        for (int j = 0; j < 4; ++j) {
            const f32x4 o = a[j] + b[j]; const float q = wave_sum((o.x * o.x + o.y * o.y) + (o.z * o.z + o.w * o.w));
            const float rs = 1.f / sqrtf(q * (1.f / 256.f) + LN_EPS);
            a[j] = (f32x4){o.x * rs * ng.x * silu_f(r[j].x), o.y * rs * ng.y * silu_f(r[j].y), o.z * rs * ng.z * silu_f(r[j].z), o.w * rs * ng.w * silu_f(r[j].w)};
        }
        st_row_bf16(A2 + (size_t)tok * DM, F.lane, a);
    }
}
namespace naive {
enum { EPI_QKV = 0, EPI_PLAIN = 1, EPI_GATEUP = 2, EPI_DOWN = 3, EPI_INPROJ = 4 };
struct NG { const bf16* A; const bf16* Bt; int M, N, K; int layer; bf16* O; };
template <int EPI> __global__ __launch_bounds__(256) void gemm_kernel(NG g, Prm p) {
    __shared__ float As[64][33], Bs[64][33], Cs[64][65]; __shared__ int rowsrc[64];
    const int tid = threadIdx.x, n0 = blockIdx.x * 64, m0 = blockIdx.y * 64, ty = tid >> 4, tx = tid & 15;
    const bf16* Bt = g.Bt; int e = 0, ebase = 0, ecnt = 0;
    if (EPI == EPI_GATEUP || EPI == EPI_DOWN) {
        const unsigned* cnt = (const unsigned*)(p.ws + WS_CTL) + CW_CNT + g.layer * 16; int acc = 0; bool found = false;
        for (int i = 0; i < 16; ++i) { const int c = (int)cnt[i], pc = (c + 255) & ~255; if (!found && m0 < acc + pc) { e = i; ebase = acc; ecnt = c; found = true; } acc += pc; }
        if (!found || m0 - ebase >= ecnt) return;
        Bt += (size_t)e * g.N * g.K;
    }
    if (tid < 64) { int r = m0 + tid;
        if (EPI == EPI_GATEUP) { const int li = m0 - ebase + tid; const int* LIST = (const int*)(p.ws + WS_LIST); r = (li < ecnt) ? LIST[e * NTOK + li] : 0; }
        rowsrc[tid] = r; }
    __syncthreads();
    float acc[4][4] = {};
    for (int k0 = 0; k0 < g.K; k0 += 32) {
        { const int r = tid >> 2, kc = (tid & 3) * 8; const u32x4 ua = *(const u32x4*)(g.A + (size_t)rowsrc[r] * g.K + k0 + kc), ub = *(const u32x4*)(Bt + (size_t)(n0 + r) * g.K + k0 + kc);
            const unsigned a4[4] = {ua.x, ua.y, ua.z, ua.w}, b4[4] = {ub.x, ub.y, ub.z, ub.w};
#pragma unroll
            for (int i = 0; i < 4; ++i) { As[r][kc + 2 * i] = bf2f(a4[i] & 0xffffu); As[r][kc + 2 * i + 1] = bf2f(a4[i] >> 16); Bs[r][kc + 2 * i] = bf2f(b4[i] & 0xffffu); Bs[r][kc + 2 * i + 1] = bf2f(b4[i] >> 16); } }
        __syncthreads();
#pragma unroll 8
        for (int kk = 0; kk < 32; ++kk) { float a[4], b[4];
#pragma unroll
            for (int i = 0; i < 4; ++i) { a[i] = As[4 * ty + i][kk]; b[i] = Bs[4 * tx + i][kk]; }
#pragma unroll
            for (int i = 0; i < 4; ++i)
#pragma unroll
                for (int j = 0; j < 4; ++j) acc[i][j] += a[i] * b[j]; }
        __syncthreads();
    }
#pragma unroll
    for (int i = 0; i < 4; ++i)
#pragma unroll
        for (int j = 0; j < 4; ++j) Cs[4 * ty + i][4 * tx + j] = acc[i][j];
    __syncthreads();
    const float* rope = (const float*)(p.ws + WS_MISC) + 1024;
    for (int idx = tid; idx < 4096; idx += 256) {
        const int r = idx >> 6, cc = idx & 63, n = n0 + cc, row = m0 + r; const float val = Cs[r][cc];
        if (EPI == EPI_QKV) {
            if (n < 2048) { float o = val;
                if (row < NLAT) { const int d = n & 63, s = row & (SEQ - 1), pos = (d & 32) ? (s & 63) : (s >> 6), f = d & 15; const float cs = rope[(pos * 16 + f) * 2], sn = rope[(pos * 16 + f) * 2 + 1];
                    o = (d & 16) ? val * cs + Cs[r][cc - 16] * sn : val * cs - Cs[r][cc + 16] * sn; }
                if (n < 1024) ((bf16*)(p.ws + WS_Q))[(size_t)row * DM + n] = (bf16)f2bf(o * C2); else ((bf16*)(p.ws + WS_K))[(size_t)row * DM + n - 1024] = (bf16)f2bf(o);
            } else ((bf16*)(p.ws + WS_V))[(size_t)row * DM + n - 2048] = (bf16)f2bf(val);
        } else if (EPI == EPI_PLAIN) { g.O[(size_t)row * g.N + n] = (bf16)f2bf(val);
        } else if (EPI == EPI_GATEUP) { if (!(cc & 16)) { const float gt = val, up = Cs[r][cc + 16]; const int other = (n >> 5) * 16 + (n & 15); ((bf16*)(p.ws + WS_ACT))[(size_t)row * DEXP + other] = (bf16)f2bf(silu_f(gt) * up); }
        } else if (EPI == EPI_DOWN) { ((bf16*)(p.ws + WS_YM))[(size_t)row * DM + n] = (bf16)f2bf(val);
        } else if (EPI == EPI_INPROJ) {
            if (n < 512) ((bf16*)(p.ws + WS_QR))[(size_t)row * 512 + n] = (bf16)f2bf(val * 0.08838834764831845f);
            else if (n < 1024) ((bf16*)(p.ws + WS_KR))[(size_t)row * 512 + n - 512] = (bf16)f2bf(val);
            else if (n < 2048) ((bf16*)(p.ws + WS_V1))[(size_t)row * DM + n - 1024] = (bf16)f2bf(val);
            else if (n < 3072) ((bf16*)(p.ws + WS_R))[(size_t)row * DM + n - 2048] = (bf16)f2bf(val);
            else if (n < 3104) ((float*)(p.ws + WS_ZZ))[(size_t)row * 32 + n - 3072] = val;
        }
    }
}
__global__ __launch_bounds__(256) void attn_kernel(Prm p) {
    __shared__ float Qs[64][65], Ks[32][65], Ps[64][33], Vs[32][129], al[64];
    const bf16* Q = (const bf16*)(p.ws + WS_Q); const bf16* K = (const bf16*)(p.ws + WS_K); const bf16* V = (const bf16*)(p.ws + WS_V);
    const int tid = threadIdx.x, ty = tid >> 4, tx = tid & 15, qb = blockIdx.x, hm = blockIdx.y, h = hm >> 1;
    const bool lat = qb < 512; const int b = lat ? qb >> 6 : (qb - 512) >> 2; const int tok0 = lat ? qb * 64 : NLAT + (qb - 512) * 64;
    bf16* O = (bf16*)(p.ws + ((hm & 1) ? WS_O2 : WS_O1));
    for (int i = tid; i < 4096; i += 256) { const int r = i >> 6, d = i & 63; Qs[r][d] = bf2f(Q[(size_t)(tok0 + r) * DM + hm * 64 + d]); }
    float o[4][8] = {}; float mrow = -3.0e38f, lrow = 0.f;
    const int nkt = lat ? (CTXL + SEQ) / 32 : CTXL / 32;
    for (int kt = 0; kt < nkt; ++kt) {
        const int key0 = (kt < CTXL / 32) ? NLAT + b * CTXL + kt * 32 : b * SEQ + (kt - CTXL / 32) * 32;
        __syncthreads();
        for (int i = tid; i < 2048; i += 256) { const int r = i >> 6, d = i & 63; Ks[r][d] = bf2f(K[(size_t)(key0 + r) * DM + hm * 64 + d]); }
        for (int i = tid; i < 4096; i += 256) { const int r = i >> 7, d = i & 127; Vs[r][d] = bf2f(V[(size_t)(key0 + r) * DM + h * 128 + d]); }
        __syncthreads();
        float s[4][2] = {};
        for (int d = 0; d < 64; ++d) { float a[4], bb[2];
#pragma unroll
            for (int i = 0; i < 4; ++i) a[i] = Qs[4 * ty + i][d];
            bb[0] = Ks[2 * tx][d]; bb[1] = Ks[2 * tx + 1][d];
#pragma unroll
            for (int i = 0; i < 4; ++i) { s[i][0] += a[i] * bb[0]; s[i][1] += a[i] * bb[1]; } }
#pragma unroll
        for (int i = 0; i < 4; ++i) { Ps[4 * ty + i][2 * tx] = s[i][0]; Ps[4 * ty + i][2 * tx + 1] = s[i][1]; }
        __syncthreads();
        if (tid < 64) { float mx = mrow;
            for (int j = 0; j < 32; ++j) mx = fmaxf(mx, Ps[tid][j]);
            const float a = exp2f(mrow - mx); float sum = 0.f;
            for (int j = 0; j < 32; ++j) { const float e = exp2f(Ps[tid][j] - mx); Ps[tid][j] = e; sum += e; }
            lrow = lrow * a + sum; mrow = mx; al[tid] = a; }
        __syncthreads();
#pragma unroll
        for (int i = 0; i < 4; ++i) { const float a = al[4 * ty + i];
#pragma unroll
            for (int j = 0; j < 8; ++j) o[i][j] *= a; }
        for (int kk = 0; kk < 32; ++kk) { float pv[4], vv[8];
#pragma unroll
            for (int i = 0; i < 4; ++i) pv[i] = Ps[4 * ty + i][kk];
#pragma unroll
            for (int j = 0; j < 8; ++j) vv[j] = Vs[kk][8 * tx + j];
#pragma unroll
            for (int i = 0; i < 4; ++i)
#pragma unroll
                for (int j = 0; j < 8; ++j) o[i][j] += pv[i] * vv[j]; }
    }
    __syncthreads();
    if (tid < 64) al[tid] = 1.f / lrow;
    __syncthreads();
#pragma unroll
    for (int i = 0; i < 4; ++i) { const float a = al[4 * ty + i];
#pragma unroll
        for (int j = 0; j < 8; ++j) O[(size_t)(tok0 + 4 * ty + i) * DM + h * 128 + 8 * tx + j] = (bf16)f2bf(o[i][j] * a); }
}
__global__ __launch_bounds__(256) void gla_scan_kernel(Prm p) {
    extern __shared__ __attribute__((aligned(16))) unsigned char sm[];
    float (*S)[33] = (float (*)[33])sm;
    float (*Qs)[129] = (float (*)[129])(sm + 128 * 33 * 4);
    float (*Ks)[129] = (float (*)[129])(sm + 128 * 33 * 4 + 64 * 129 * 4);
    float (*Vs)[33] = (float (*)[33])(sm + 128 * 33 * 4 + 2 * 64 * 129 * 4);
    float (*Ps)[65] = (float (*)[65])(sm + 128 * 33 * 4 + 2 * 64 * 129 * 4 + 64 * 33 * 4);
    float* dec = (float*)(sm + 128 * 33 * 4 + 2 * 64 * 129 * 4 + 64 * 33 * 4 + 64 * 65 * 4);
    const bf16* QT = (const bf16*)(p.ws + WS_QT); const bf16* KT = (const bf16*)(p.ws + WS_KT); const bf16* V = (const bf16*)(p.ws + WS_V1); const float* DEC = (const float*)(p.ws + WS_DEC);
    const int tid = threadIdx.x, ty = tid >> 4, tx = tid & 15, vs = blockIdx.x & 7, dir = (blockIdx.x >> 3) & 1, h = (blockIdx.x >> 4) & 3, b = blockIdx.x >> 6;
    bf16* OG = (bf16*)(p.ws + (dir ? WS_OGB : WS_OGF));
    for (int i = tid; i < 128 * 32; i += 256) S[i >> 5][i & 31] = 0.f;
    for (int step = 0; step < 68; ++step) {
        const bool lat = step >= 4; const int ci = lat ? step - 4 : step;
        const int chunk = lat ? b * 64 + (dir ? 63 - ci : ci) : 512 + b * 4 + (dir ? 3 - ci : ci); const int tok0 = chunk * 64;
        __syncthreads();
        for (int i = tid; i < 64 * 128; i += 256) { const int t = i >> 7, d = i & 127; const size_t off = ((size_t)dir * NTOK + tok0 + t) * 512 + h * 128 + d; Qs[t][d] = bf2f(QT[off]); Ks[t][d] = bf2f(KT[off]); }
        for (int i = tid; i < 64 * 32; i += 256) { const int t = i >> 5, v = i & 31; Vs[t][v] = bf2f(V[(size_t)(tok0 + t) * DM + h * 256 + vs * 32 + v]); }
        if (tid < 128) dec[tid] = DEC[((size_t)dir * NCHUNK + chunk) * 512 + h * 128 + tid];
        __syncthreads();
        if (lat) {
            float s[4][4] = {};
            for (int d = 0; d < 128; ++d) { float a[4], bb[4];
#pragma unroll
                for (int i = 0; i < 4; ++i) { a[i] = Qs[4 * ty + i][d]; bb[i] = Ks[4 * tx + i][d]; }
#pragma unroll
                for (int i = 0; i < 4; ++i)
#pragma unroll
                    for (int j = 0; j < 4; ++j) s[i][j] += a[i] * bb[j]; }
#pragma unroll
            for (int i = 0; i < 4; ++i)
#pragma unroll
                for (int j = 0; j < 4; ++j) { const int t = 4 * ty + i, sidx = 4 * tx + j; const bool keep = dir ? (sidx >= t) : (sidx <= t); Ps[t][sidx] = keep ? s[i][j] : 0.f; }
            __syncthreads();
            float o[4][2] = {};
            for (int sidx = 0; sidx < 64; ++sidx) { const float v0 = Vs[sidx][2 * tx], v1 = Vs[sidx][2 * tx + 1];
#pragma unroll
                for (int i = 0; i < 4; ++i) { const float pp = Ps[4 * ty + i][sidx]; o[i][0] += pp * v0; o[i][1] += pp * v1; } }
            for (int d = 0; d < 128; ++d) { const float s0 = S[d][2 * tx], s1 = S[d][2 * tx + 1];
#pragma unroll
                for (int i = 0; i < 4; ++i) { const float qq = Qs[4 * ty + i][d]; o[i][0] += qq * s0; o[i][1] += qq * s1; } }
#pragma unroll
            for (int i = 0; i < 4; ++i) { const size_t off = (size_t)(tok0 + 4 * ty + i) * DM + h * 256 + vs * 32 + 2 * tx; OG[off] = (bf16)f2bf(o[i][0]); OG[off + 1] = (bf16)f2bf(o[i][1]); }
            __syncthreads();
        }
        float u[8][2] = {};
        for (int sidx = 0; sidx < 64; ++sidx) { const float v0 = Vs[sidx][2 * tx], v1 = Vs[sidx][2 * tx + 1];
#pragma unroll
            for (int i = 0; i < 8; ++i) { const float kk = Ks[sidx][8 * ty + i]; u[i][0] += kk * v0; u[i][1] += kk * v1; } }
#pragma unroll
        for (int i = 0; i < 8; ++i) { const int d = 8 * ty + i; S[d][2 * tx] = dec[d] * (S[d][2 * tx] + u[i][0]); S[d][2 * tx + 1] = dec[d] * (S[d][2 * tx + 1] + u[i][1]); }
    }
}
constexpr int GLA_SCAN_LDS = 128 * 33 * 4 + 2 * 64 * 129 * 4 + 64 * 33 * 4 + 64 * 65 * 4 + 512;
}
namespace pg8 {
typedef short bf16x8 __attribute__((ext_vector_type(8)));
constexpr int BM = 256, BK = 64, HALF = 128, HTB = HALF * BK * 2, STAGE_BYTES = 8 * HTB, NXCD = 8, WGM = 8;
__host__ __device__ __forceinline__ int lds_byte(int r, int c) { const int st = (r >> 4) * 2 + (c >> 5), rr = r & 15, cc = c & 31, ob = rr * 64 + cc * 2; return st * 1024 + (ob ^ (((ob >> 9) & 1) << 5)); }
__host__ __device__ __forceinline__ void stage_rc(int b, int& R, int& C) { const int st = b / 1024, sb = b % 1024, swz = sb ^ (((sb >> 9) & 1) << 5); R = (st >> 1) * 16 + swz / 64; C = (st & 1) * 32 + (swz % 64) / 2; }
typedef float f32x2_t __attribute__((ext_vector_type(2))); typedef __bf16 bf16x2_t __attribute__((ext_vector_type(2)));
__device__ __forceinline__ unsigned cvt_pk_bf16(float lo, float hi) { f32x2_t v = {lo, hi}; bf16x2_t b = __builtin_convertvector(v, bf16x2_t); return __builtin_bit_cast(unsigned, b); }

struct Unit { int pm, pn; int row0; int e; int cnt; const bf16* Bt; };

struct DenseOrder {
    int nM, nN, nwg, G, c, K; const bf16* Bt;
    __device__ void init(int M, int N, int K_, const bf16* Bt_, int G_, int c_) { nM = M / BM; nN = N / BM; nwg = nM * nN; G = G_; c = c_; K = K_; Bt = Bt_; }
    __device__ bool next(int i, Unit& u) const {
        const long L = (long)i * G + c; if (L >= nwg) return false;
        int wgid = (int)L; { const int q = nwg / NXCD, r = nwg % NXCD, xcd = wgid % NXCD, off = wgid / NXCD; wgid = (xcd < r ? xcd * (q + 1) : r * (q + 1) + (xcd - r) * q) + off; }
        const int nig = WGM * nN, gid = wgid / nig, fm = gid * WGM, gsz = (nM - fm) < WGM ? (nM - fm) : WGM;
        u.pm = fm + ((wgid % nig) % gsz); u.pn = (wgid % nig) / gsz; u.row0 = u.pm * BM; u.e = 0; u.cnt = 0; u.Bt = Bt; return true;
    }
    __device__ __forceinline__ unsigned arow(const Unit& u, int r) const { return (unsigned)(u.row0 + r) * (unsigned)(K * 2); }
};
template <bool GATHER> struct MoeOrder {
    int cnt[16]; int nN, G, c, K; const bf16* Bt0; size_t bstride; const int* LIST;
    __device__ void init(const unsigned* cntw, int N, int K_, const bf16* Bt0_, const int* LIST_, int G_, int c_) {
#pragma unroll
        for (int e = 0; e < 16; ++e) cnt[e] = (int)__hip_atomic_load(cntw + e, __ATOMIC_RELAXED, __HIP_MEMORY_SCOPE_AGENT);
        nN = N / BM; G = G_; c = c_; K = K_; Bt0 = Bt0_; bstride = (size_t)N * K_; LIST = LIST_; }
    __device__ bool next(int i, Unit& u) const {
        int L = i * G + c, base = 0; bool found = false; u.pm = 0; u.pn = 0; u.row0 = 0; u.e = 0; u.cnt = 0; u.Bt = Bt0;
#pragma unroll
        for (int e = 0; e < 16; ++e) { const int mt = (cnt[e] + 255) >> 8, nu = mt * nN;
            if (!found) { if (L < nu) { found = true; u.e = e; u.cnt = cnt[e]; u.pm = L / nN; u.pn = L % nN; u.row0 = base + u.pm * BM; u.Bt = Bt0 + (size_t)e * bstride; } else { L -= nu; base += mt * BM; } } }
        return found;
    }
    __device__ __forceinline__ unsigned arow(const Unit& u, int r) const {
        if (GATHER) { const int li = u.pm * BM + r; int tok = 0; if (li < u.cnt) tok = LIST[u.e * NTOK + li];
            return (unsigned)tok * (unsigned)(K * 2); }
        return (unsigned)(u.row0 + r) * (unsigned)(K * 2);
    }
};

typedef f32x4 Acc[2][2][4][2];
__device__ __forceinline__ void st4bf(bf16* p, f32x4 v) { u32x2 w; w.x = cvt_pk_bf16(v.x, v.y); w.y = cvt_pk_bf16(v.z, v.w); *(u32x2*)p = w; }

struct EpiQKV {
    bf16 *Q; const float* rope;
    __device__ __forceinline__ void operator()(const Acc& acc, const Unit& u, int wr, int wc, int fr, int fq) const {
        const int reg = u.pn >> 2, cbase = (u.pn & 3) * BM + wc * 32 + 4 * fq; bf16* O = Q + (size_t)reg * ((WS_K - WS_Q) / 2);
        const bool dorope = (reg < 2) && (u.row0 < NLAT); const float sc = reg == 0 ? C2 : 1.f;
#pragma unroll
        for (int ai = 0; ai < 2; ++ai)
#pragma unroll
            for (int m = 0; m < 4; ++m) { const int row = u.row0 + ai * HALF + wr * 64 + m * 16 + fr; bf16* rowp = O + (size_t)row * DM + cbase;
                f32x4 cs = {1.f, 1.f, 1.f, 1.f}, sn = {0.f, 0.f, 0.f, 0.f};
                if (dorope) { const int s = row & (SEQ - 1), pos = (wc & 1) ? (s & 63) : (s >> 6); const f32x4 t0 = *(const f32x4*)(rope + (pos * 16 + 4 * fq) * 2), t1 = *(const f32x4*)(rope + (pos * 16 + 4 * fq) * 2 + 4);
                    cs = (f32x4){t0.x, t0.z, t1.x, t1.z}; sn = (f32x4){t0.y, t0.w, t1.y, t1.w}; }
#pragma unroll
                for (int bj = 0; bj < 2; ++bj) { const f32x4 a0 = acc[ai][bj][m][0], a1 = acc[ai][bj][m][1];
                    st4bf(rowp + bj * HALF, (a0 * cs - a1 * sn) * sc); st4bf(rowp + bj * HALF + 16, (a1 * cs + a0 * sn) * sc); } }
    }
};
struct EpiPlain {
    bf16* O;
    __device__ __forceinline__ void operator()(const Acc& acc, const Unit& u, int wr, int wc, int fr, int fq) const {
        const int cbase = u.pn * BM + wc * 32 + 4 * fq;
#pragma unroll
        for (int ai = 0; ai < 2; ++ai)
#pragma unroll
            for (int m = 0; m < 4; ++m) { bf16* rowp = O + (size_t)(u.row0 + ai * HALF + wr * 64 + m * 16 + fr) * DM + cbase;
#pragma unroll
                for (int bj = 0; bj < 2; ++bj)
#pragma unroll
                    for (int n = 0; n < 2; ++n) st4bf(rowp + bj * HALF + n * 16, acc[ai][bj][m][n]); }
    }
};
struct EpiInproj {
    bf16 *QR, *KR, *V, *R; float* ZZ;
    __device__ __forceinline__ void operator()(const Acc& acc, const Unit& u, int wr, int wc, int fr, int fq) const {
        const int pn = u.pn;
        if (pn == 12) { if (wc == 0) {
#pragma unroll
            for (int ai = 0; ai < 2; ++ai)
#pragma unroll
                for (int m = 0; m < 4; ++m) { float* rowp = ZZ + (size_t)(u.row0 + ai * HALF + wr * 64 + m * 16 + fr) * 32 + 4 * fq;
                    *(f32x4*)rowp = acc[ai][0][m][0]; *(f32x4*)(rowp + 16) = acc[ai][0][m][1]; } }
            return; }
        bf16* O; int ld, c0; float sc = 1.f;
        if (pn < 2) { O = QR; ld = 512; c0 = pn * BM; sc = 0.08838834764831845f; } else if (pn < 4) { O = KR; ld = 512; c0 = (pn - 2) * BM; } else if (pn < 8) { O = V; ld = DM; c0 = (pn - 4) * BM; } else { O = R; ld = DM; c0 = (pn - 8) * BM; }
        const int cbase = c0 + wc * 32 + 4 * fq;
#pragma unroll
        for (int ai = 0; ai < 2; ++ai)
#pragma unroll
            for (int m = 0; m < 4; ++m) { bf16* rowp = O + (size_t)(u.row0 + ai * HALF + wr * 64 + m * 16 + fr) * ld + cbase;
#pragma unroll
                for (int bj = 0; bj < 2; ++bj)
#pragma unroll
                    for (int n = 0; n < 2; ++n) st4bf(rowp + bj * HALF + n * 16, acc[ai][bj][m][n] * sc); }
    }
};
struct EpiGateUp {
    bf16* ACT;
    __device__ __forceinline__ void operator()(const Acc& acc, const Unit& u, int wr, int wc, int fr, int fq) const {
        const int obase = (u.pn * BM + wc * 32) / 2 + 4 * fq;
#pragma unroll
        for (int ai = 0; ai < 2; ++ai)
#pragma unroll
            for (int m = 0; m < 4; ++m) { bf16* rowp = ACT + (size_t)(u.row0 + ai * HALF + wr * 64 + m * 16 + fr) * DEXP + obase;
#pragma unroll
                for (int bj = 0; bj < 2; ++bj) { const f32x4 g = acc[ai][bj][m][0], up = acc[ai][bj][m][1]; f32x4 o;
#pragma unroll
                    for (int j = 0; j < 4; ++j) o[j] = g[j] * __builtin_amdgcn_rcpf(1.f + __expf(-g[j])) * up[j];
                    st4bf(rowp + bj * (HALF / 2), o); } }
    }
};

template <class Epi, class Sched>
__device__ __forceinline__ void gemm_phase(unsigned char* ldsg, const bf16* A, int K, const Sched& S, const Epi& E) {
    LAS unsigned char* lds = (LAS unsigned char*)ldsg;
    const int tid = threadIdx.x, wid = __builtin_amdgcn_readfirstlane(tid >> 6), lane = tid & 63, wr = wid >> 2, wc = wid & 3, fr = lane & 15, fq = lane >> 4;
    const int nt = K / BK;
    int Rr[2]; unsigned colb[2], voffB[2];
#pragma unroll
    for (int i = 0; i < 2; ++i) { int R, C; stage_rc(tid * 16 + i * 8192, R, C); Rr[i] = R; colb[i] = (unsigned)C * 2u; voffB[i] = (unsigned)(R * K + C) * 2u; }
    const size_t kstep = (size_t)(BK * 2);
    const size_t hstep = (size_t)HALF * K * 2;
    const size_t tstep = 2 * hstep;
    const unsigned ldsw = (unsigned)wid * 1024u;
    const int aoff = lds_byte(wr * 64 + fr, fq * 8), boff = lds_byte(wc * 32 + fr, fq * 8);
#define PG8_SA(b, h) (((b) * 2 + (h)) * HTB)
#define PG8_SB(b, h) ((4 + (b) * 2 + (h)) * HTB)
#define PG8_STAGE(bufoff, gbase, voff) do { _Pragma("unroll") for (int _i = 0; _i < 2; ++_i) \
        __builtin_amdgcn_global_load_lds((const unsigned*)((const char*)(gbase) + (voff)[_i]), (LAS unsigned*)(lds + (bufoff) + ldsw + _i * 8192), 16, 0, 0); } while (0)
#define PG8_LDA(dst, b, h) do { _Pragma("unroll") for (int m = 0; m < 4; ++m) _Pragma("unroll") for (int k = 0; k < 2; ++k) dst[m][k] = *(const LAS bf16x8*)(lds + PG8_SA(b, h) + aoff + m * 2048 + k * 1024); } while (0)
#define PG8_LDB(dst, b, h) do { _Pragma("unroll") for (int n = 0; n < 2; ++n) _Pragma("unroll") for (int k = 0; k < 2; ++k) dst[n][k] = *(const LAS bf16x8*)(lds + PG8_SB(b, h) + boff + n * 2048 + k * 1024); } while (0)
#define PG8_MMA(ai, bj, At, Bt) do { __builtin_amdgcn_s_setprio(1); _Pragma("unroll") for (int m = 0; m < 4; ++m) _Pragma("unroll") for (int n = 0; n < 2; ++n) _Pragma("unroll") for (int k = 0; k < 2; ++k) \
        acc[ai][bj][m][n] = __builtin_amdgcn_mfma_f32_16x16x32_bf16(Bt[n][k], At[m][k], acc[ai][bj][m][n], 0, 0, 0); __builtin_amdgcn_s_setprio(0); } while (0)
#define PG8_WAIT_V(n) asm volatile("s_waitcnt vmcnt(" #n ")" ::: "memory")
#define PG8_WAIT_L(n) asm volatile("s_waitcnt lgkmcnt(" #n ")" ::: "memory")
#define PG8_BAR __builtin_amdgcn_s_barrier()
#define PG8_SCHED __builtin_amdgcn_sched_barrier(0)
    Unit cur, nxt; int ui = 0;
    if (!S.next(0, cur)) return;
    Acc acc;
#pragma unroll
    for (int a = 0; a < 2; ++a)
#pragma unroll
        for (int b = 0; b < 2; ++b)
#pragma unroll
            for (int m = 0; m < 4; ++m)
#pragma unroll
                for (int n = 0; n < 2; ++n) acc[a][b][m][n] = (f32x4){0.f, 0.f, 0.f, 0.f};
    bf16x8 At[4][2], B0[2][2], B1[2][2];
    unsigned aC0[2], aC1[2], aN0[2], aN1[2];
#pragma unroll
    for (int i = 0; i < 2; ++i) { aC0[i] = S.arow(cur, Rr[i]) + colb[i]; aC1[i] = S.arow(cur, HALF + Rr[i]) + colb[i]; }
    const char* Ab = (const char*)A;
    const char* cB = (const char*)cur.Bt + (size_t)cur.pn * tstep;
    PG8_STAGE(PG8_SB(0, 0), cB, voffB); PG8_STAGE(PG8_SB(0, 1), cB + hstep, voffB); PG8_STAGE(PG8_SA(0, 0), Ab, aC0); PG8_STAGE(PG8_SA(0, 1), Ab, aC1);
    if (wr == 1) PG8_BAR;
    PG8_WAIT_V(2); PG8_BAR;
    PG8_STAGE(PG8_SB(1, 0), cB + kstep, voffB); PG8_STAGE(PG8_SA(1, 0), Ab + kstep, aC0); PG8_STAGE(PG8_SB(1, 1), cB + hstep + kstep, voffB);
    PG8_WAIT_V(6); PG8_BAR;
    for (;;) {
        const bool has_next = S.next(ui + 1, nxt);
        if (has_next) {
#pragma unroll
            for (int i = 0; i < 2; ++i) { aN0[i] = S.arow(nxt, Rr[i]) + colb[i]; aN1[i] = S.arow(nxt, HALF + Rr[i]) + colb[i]; }
        } else {
#pragma unroll
            for (int i = 0; i < 2; ++i) { aN0[i] = aC0[i]; aN1[i] = aC1[i]; }
        }
        const char* nB = has_next ? (const char*)nxt.Bt + (size_t)nxt.pn * tstep : cB;
        for (int t = 0; t < nt; t += 2) {
            const bool last = (t == nt - 2);
            const char* a1 = Ab + (size_t)(t + 1) * kstep;
            const char* a2 = last ? Ab : Ab + (size_t)(t + 2) * kstep; const char* b2 = last ? nB : cB + (size_t)(t + 2) * kstep;
            const char* a3 = a2 + kstep; const char* b3 = b2 + kstep;
            unsigned x0[2], x1[2];
#pragma unroll
            for (int i = 0; i < 2; ++i) { x0[i] = last ? aN0[i] : aC0[i]; x1[i] = last ? aN1[i] : aC1[i]; }
            PG8_LDB(B0, 0, 0); PG8_LDB(B1, 0, 1); PG8_SCHED; PG8_LDA(At, 0, 0); PG8_STAGE(PG8_SA(1, 1), a1, aC1);
            PG8_WAIT_V(8); PG8_WAIT_L(0); PG8_BAR; PG8_MMA(0, 0, At, B0); PG8_MMA(0, 1, At, B1); PG8_BAR; PG8_SCHED;
            PG8_LDA(At, 0, 1); PG8_STAGE(PG8_SB(0, 0), b2, voffB); PG8_STAGE(PG8_SB(0, 1), b2 + hstep, voffB); PG8_STAGE(PG8_SA(0, 0), a2, x0);
            PG8_WAIT_V(8); PG8_WAIT_L(0); PG8_BAR; PG8_MMA(1, 0, At, B0); PG8_MMA(1, 1, At, B1); PG8_BAR; PG8_SCHED;
            PG8_LDB(B0, 1, 0); PG8_LDB(B1, 1, 1); PG8_SCHED; PG8_LDA(At, 1, 0); PG8_STAGE(PG8_SA(0, 1), a2, x1);
            PG8_WAIT_V(8); PG8_WAIT_L(0); PG8_BAR; PG8_MMA(0, 0, At, B0); PG8_MMA(0, 1, At, B1); PG8_BAR; PG8_SCHED;
            PG8_LDA(At, 1, 1); PG8_STAGE(PG8_SB(1, 0), b3, voffB); PG8_STAGE(PG8_SB(1, 1), b3 + hstep, voffB); PG8_STAGE(PG8_SA(1, 0), a3, x0);
            PG8_WAIT_V(8); PG8_WAIT_L(0); PG8_BAR; PG8_MMA(1, 0, At, B0); PG8_MMA(1, 1, At, B1); PG8_BAR; PG8_SCHED;
        }
        if (wr == 0) PG8_BAR;
        E(acc, cur, wr, wc, fr, fq);
        if (!has_next) break;
#pragma unroll
        for (int a = 0; a < 2; ++a)
#pragma unroll
            for (int b = 0; b < 2; ++b)
#pragma unroll
                for (int m = 0; m < 4; ++m)
#pragma unroll
                    for (int n = 0; n < 2; ++n) acc[a][b][m][n] = (f32x4){0.f, 0.f, 0.f, 0.f};
        cur = nxt; cB = nB; ++ui;
#pragma unroll
        for (int i = 0; i < 2; ++i) { aC0[i] = aN0[i]; aC1[i] = aN1[i]; }
        if (wr == 1) PG8_BAR;
    }
    PG8_WAIT_V(0);
    PG8_BAR;
#undef PG8_SA
#undef PG8_SB
#undef PG8_STAGE
#undef PG8_LDA
#undef PG8_LDB
#undef PG8_MMA
#undef PG8_WAIT_V
#undef PG8_WAIT_L
#undef PG8_BAR
#undef PG8_SCHED
}
}

__device__ __forceinline__ int vcu_of(const Frame& F) { return (F.G % 8 == 0) ? (F.bid % 8) * (F.G / 8) + F.bid / 8 : F.bid; }
__device__ __forceinline__ void phase_qkv_opt(const Frame& F, const Prm& p) {
    pg8::DenseOrder S; S.init(NTOK, 3072, 1024, (const bf16*)(p.ws + WS_WQKV), F.G, F.bid);
    static_assert(WS_V - WS_K == WS_K - WS_Q, "Q|K|V equally spaced");
    pg8::EpiQKV E{(bf16*)(p.ws + WS_Q), (const float*)(p.ws + WS_MISC) + 1024};
    pg8::gemm_phase(F.lds, (const bf16*)(p.ws + WS_H), 1024, S, E);
}
__device__ __forceinline__ void phase_wo_opt(const Frame& F, const Prm& p, int layer) {
    pg8::DenseOrder S; S.init(layer ? NLAT : NTOK, 1024, 1024, (const bf16*)(p.ws + (layer ? WS_WGO : WS_WO)), F.G, F.bid);
    pg8::EpiPlain E{(bf16*)(p.ws + WS_Y)};
    pg8::gemm_phase(F.lds, (const bf16*)(p.ws + (layer ? WS_A2B : WS_A2)), 1024, S, E);
}
__device__ __forceinline__ void phase_inproj_opt(const Frame& F, const Prm& p) {
    pg8::DenseOrder S; S.init(NTOK, NIN, 1024, (const bf16*)(p.ws + WS_WIN), F.G, F.bid);
    pg8::EpiInproj E{(bf16*)(p.ws + WS_QR), (bf16*)(p.ws + WS_KR), (bf16*)(p.ws + WS_V1), (bf16*)(p.ws + WS_R), (float*)(p.ws + WS_ZZ)};
    pg8::gemm_phase(F.lds, (const bf16*)(p.ws + WS_H), 1024, S, E);
}
__device__ __forceinline__ void phase_moe1_opt(const Frame& F, const Prm& p, int layer) {
    pg8::MoeOrder<true> S; S.init(F.ctl + CW_CNT + layer * 16, 1024, 1024, (const bf16*)(p.ws + (layer ? WS_GU1 : WS_GU0)), (const int*)(p.ws + WS_LIST), F.G, vcu_of(F));
    pg8::EpiGateUp E{(bf16*)(p.ws + WS_ACT)};
    pg8::gemm_phase(F.lds, (const bf16*)(p.ws + WS_H), 1024, S, E);
}
__device__ __forceinline__ void phase_moe2_opt(const Frame& F, const Prm& p, int layer) {
    pg8::MoeOrder<false> S; S.init(F.ctl + CW_CNT + layer * 16, 1024, 512, (const bf16*)(p.ws + (layer ? WS_DN1 : WS_DN0)), nullptr, F.G, vcu_of(F));
    pg8::EpiPlain E{(bf16*)(p.ws + WS_YM)};
    pg8::gemm_phase(F.lds, (const bf16*)(p.ws + WS_ACT), 512, S, E);
}
namespace attn_body {
using bf16=unsigned short;
using bf16x8=__attribute__((ext_vector_type(8)))short;
using s16x4=__attribute__((ext_vector_type(4)))short;
using f32x16=__attribute__((ext_vector_type(16)))float;
using u32x4=__attribute__((ext_vector_type(4)))unsigned;
constexpr int D=64,DM=1024;
constexpr int NW=8,QBLK=32,QB=QBLK*NW,KVBLK=64;
constexpr int ATTN_PITCH=DM, ATTN_UNIT_ROWS=QB;
__device__ __forceinline__ int crow(int r,int hi){return (r&3)+8*(r>>2)+4*hi;}
#define SBAR() __builtin_amdgcn_sched_barrier(0)
__device__ __forceinline__ void cmask(f32x16&p0,f32x16&p1,int jb,int qrel,int hi){
  const float NEG=-INFINITY; int kb=64*jb+4*hi;
  #pragma unroll
  for(int r=0;r<16;++r){int kv=kb+(r&3)+8*(r>>2); if(kv>qrel)p0[r]=NEG; if(kv+32>qrel)p1[r]=NEG;}
}

constexpr int NSLOT=3, SLOTB=8192;
constexpr int LDS_K=0, LDS_V=NSLOT*SLOTB, LDS_WS=2*NSLOT*SLOTB, LDS_OST=LDS_WS+NW*64*4, LDS_BYTES=LDS_OST+NW*4096;
constexpr float C2=0.125f*1.4426950408889634f;
__device__ __forceinline__ void glds16(const void*gsrc,unsigned lds_dst){unsigned keep;
  asm volatile("s_mov_b32 %0, m0\n\ts_mov_b32 m0, %2\n\ts_nop 0\n\tglobal_load_lds_dwordx4 %1, off\n\ts_mov_b32 m0, %0":"=&s"(keep):"v"(gsrc),"s"(lds_dst):"memory");}
__device__ __forceinline__ float max3f(float a,float b,float c){float r;asm("v_max3_f32 %0, %1, %2, %3":"=v"(r):"v"(a),"v"(b),"v"(c));return r;}
__device__ __forceinline__ float max2f(float a,float b){float r;asm("v_max_f32_e32 %0, %1, %2":"=v"(r):"v"(a),"v"(b));return r;}
__device__ __forceinline__ float fadd_s(float a,float b){float r;asm("v_add_f32_e32 %0, %1, %2":"=v"(r):"v"(a),"v"(b));return r;}
__device__ __forceinline__ float fsub_s(float a,float b){float r;asm("v_sub_f32_e32 %0, %1, %2":"=v"(r):"v"(a),"v"(b));return r;}
typedef float f32x2_t __attribute__((ext_vector_type(2))); typedef __bf16 bf16x2_t __attribute__((ext_vector_type(2)));
__device__ __forceinline__ unsigned cvtpk_s(float lo,float hi){f32x2_t v={lo,hi};bf16x2_t b=__builtin_convertvector(v,bf16x2_t);return __builtin_bit_cast(unsigned,b);}
#define WAIT_BAR(N) asm volatile("s_waitcnt vmcnt(" #N ") lgkmcnt(0)\n\ts_barrier":::"memory")

__device__ __forceinline__ void qkt(f32x16&p0,f32x16&p1,const char*Kslot,const bf16x8*qr,const f32x16&negm,int r32,int hi){
  const char*kb=Kslot+hi*1024+r32*16;
  #pragma unroll
  for(int d0=0;d0<4;++d0){
    const bf16x8 b0=*reinterpret_cast<const bf16x8*>(kb+d0*2048);
    const bf16x8 b1=*reinterpret_cast<const bf16x8*>(kb+d0*2048+512);
    if(d0==0){p0=__builtin_amdgcn_mfma_f32_32x32x16_bf16(b0,qr[0],negm,0,0,0);p1=__builtin_amdgcn_mfma_f32_32x32x16_bf16(b1,qr[0],negm,0,0,0);}
    else{p0=__builtin_amdgcn_mfma_f32_32x32x16_bf16(b0,qr[d0],p0,0,0,0);p1=__builtin_amdgcn_mfma_f32_32x32x16_bf16(b1,qr[d0],p1,0,0,0);}}
}
typedef __attribute__((address_space(3))) const char* lds_cptr;
typedef short v4i16_t __attribute__((ext_vector_type(4)));
__device__ __forceinline__ void kload8(bf16x8*kf,lds_cptr kp){
  kf[0]=*(const __attribute__((address_space(3))) bf16x8*)(kp);      kf[1]=*(const __attribute__((address_space(3))) bf16x8*)(kp+512);
  kf[2]=*(const __attribute__((address_space(3))) bf16x8*)(kp+2048); kf[3]=*(const __attribute__((address_space(3))) bf16x8*)(kp+2560);
  kf[4]=*(const __attribute__((address_space(3))) bf16x8*)(kp+4096); kf[5]=*(const __attribute__((address_space(3))) bf16x8*)(kp+4608);
  kf[6]=*(const __attribute__((address_space(3))) bf16x8*)(kp+6144); kf[7]=*(const __attribute__((address_space(3))) bf16x8*)(kp+6656);
}
__device__ __forceinline__ void kload2(bf16x8*kf,lds_cptr kp,int j){ kf[2*j]=*(const __attribute__((address_space(3))) bf16x8*)(kp+j*2048); kf[2*j+1]=*(const __attribute__((address_space(3))) bf16x8*)(kp+j*2048+512); }
__device__ __forceinline__ s16x4 vtr(lds_cptr p){ return __builtin_bit_cast(s16x4,__builtin_amdgcn_ds_read_tr16_b64_v4i16((__attribute__((address_space(3))) v4i16_t*)p)); }
__device__ __forceinline__ float rowmax(const f32x16&p0,const f32x16&p1){
  float a=max3f(p0[0],p0[1],p1[0]),b=max3f(p0[2],p0[3],p1[1]);a=max3f(a,p1[2],p1[3]);
  #pragma unroll
  for(int r=4;r<16;r+=4){a=max3f(a,p0[r],p0[r+1]);b=max3f(b,p0[r+2],p0[r+3]);a=max3f(a,p1[r],p1[r+1]);b=max3f(b,p1[r+2],p1[r+3]);}
  const float m=max2f(a,b);
  auto rr=__builtin_amdgcn_permlane32_swap(__float_as_uint(m),__float_as_uint(m),false,false);
  return max2f(__uint_as_float(rr[0]),__uint_as_float(rr[1]));
}
__device__ __forceinline__ void pv(f32x16*o,int vb,bf16x8 pa0,bf16x8 pa1,bf16x8 pa2,bf16x8 pa3){
  #pragma unroll
  for(int d0=0;d0<2;++d0){s16x4 lo[4],hi[4];
    #pragma unroll
    for(int ks=0;ks<4;++ks){
      asm volatile("ds_read_b64_tr_b16 %0,%1 offset:%c2":"=&v"(lo[ks]):"v"(vb),"i"(d0*4096+ks*1024):"memory");
      asm volatile("ds_read_b64_tr_b16 %0,%1 offset:%c2":"=&v"(hi[ks]):"v"(vb),"i"(d0*4096+ks*1024+512):"memory");}
    asm volatile("s_waitcnt lgkmcnt(0)":::"memory");SBAR();
    #define PK(k) (bf16x8){lo[k][0],lo[k][1],lo[k][2],lo[k][3],hi[k][0],hi[k][1],hi[k][2],hi[k][3]}
    o[d0]=__builtin_amdgcn_mfma_f32_32x32x16_bf16(pa0,PK(0),o[d0],0,0,0);
    o[d0]=__builtin_amdgcn_mfma_f32_32x32x16_bf16(pa1,PK(1),o[d0],0,0,0);
    o[d0]=__builtin_amdgcn_mfma_f32_32x32x16_bf16(pa2,PK(2),o[d0],0,0,0);
    o[d0]=__builtin_amdgcn_mfma_f32_32x32x16_bf16(pa3,PK(3),o[d0],0,0,0);
    #undef PK
  }
}

#ifndef ATTN_STORE16
#define ATTN_STORE16(p,v) (*(u32x4*)(p)=(v))
#endif
template<int THRL> __device__ __forceinline__ void attn_unit(long qrow0,int qcol,int vcol,long kctx,long klat,int NT,const bf16*Q,const bf16*__restrict__ K,const bf16*__restrict__ V,bf16*O,char*shm){
  const int tid=threadIdx.x,lane=tid&63,r32=lane&31,hi=lane>>5; const int wid=__builtin_amdgcn_readfirstlane(tid>>6);

  const bf16*Qw=Q+(qrow0+wid*QBLK)*DM+qcol;
  const bf16*Kh=K+qcol,*Vh=V+vcol;
  const unsigned lds0=(unsigned)(uintptr_t)shm;
  float*wsf=(float*)(shm+LDS_WS)+wid*64;
  const bf16*ksrc=Kh+(long)lane*DM+wid*8;
  const bf16*vsrc=Vh+(long)(16*(wid&3)+(lane>>2))*DM+(wid>>2)*32+(lane&3)*8;
  const unsigned kdst=lds0+LDS_K+wid*1024, vdst=lds0+LDS_V+wid*1024;
  #define KVROW(t) ((t)<4?kctx+(long)(t)*KVBLK:klat+(long)((t)-4)*KVBLK)
  #define DMA_K(t,slot) glds16(ksrc+KVROW(t)*DM,(unsigned)__builtin_amdgcn_readfirstlane(kdst+(slot)))
  #define DMA_V(t,slot) glds16(vsrc+KVROW(t)*DM,(unsigned)__builtin_amdgcn_readfirstlane(vdst+(slot)))
  const int vb0=(int)(lds0+LDS_V)+((lane>>4)&1)*32+(lane&3)*8+(4*hi+((lane&15)>>2))*64;
  const char*Kbase=shm+LDS_K; bf16x8 kf[8];
  const lds_cptr shm3=(lds_cptr)shm; const lds_cptr kp0=shm3+LDS_K+hi*1024+r32*16; const lds_cptr vp0=shm3+LDS_V+((lane>>4)&1)*32+(lane&3)*8+(4*hi+((lane&15)>>2))*64;
  DMA_K(0,0);DMA_V(0,0);DMA_K(1,SLOTB);
  bf16x8 qr[4];
  #pragma unroll
  for(int d0=0;d0<4;++d0)qr[d0]=*reinterpret_cast<const bf16x8*>(&Qw[(long)r32*DM+d0*16+hi*8]);
  float mhat=0.f,l_reg=0.f;f32x16 o[2];o[0]=f32x16{};o[1]=f32x16{};f32x16 negm=f32x16{};asm volatile("":"+v"(negm));
  const int qrel=wid*QBLK+r32;
  #define CMASK(P0,P1,t) do{}while(0)
  bool resc=false;
  #define START(P0,P1) do{ const float rm=rowmax(P0,P1); resc=false; \
    { const float dl=rm; mhat=fadd_s(mhat,dl); \
      _Pragma("unroll") for(int r=0;r<16;++r){P0[r]=fsub_s(P0[r],dl);P1[r]=fsub_s(P1[r],dl);} \
      _Pragma("unroll") for(int r=0;r<16;++r)negm[r]=-mhat; asm volatile("":"+v"(negm)); } \
    _Pragma("unroll") for(int r=0;r<16;++r)P0[r]=__builtin_amdgcn_exp2f(P0[r]); }while(0)
  #define RESC() do{ if(resc){ asm volatile("s_waitcnt lgkmcnt(0)":::"memory"); \
      _Pragma("unroll") for(int d_=0;d_<2;++d_) _Pragma("unroll") for(int r=0;r<16;++r)o[d_][r]*=wsf[crow(r,hi)]; } }while(0)
  f32x16 pA0,pA1,pB0,pB1;
  int sl_prev=0,sl_cur=0,sl_next=SLOTB;
  #define ROT() do{sl_prev=sl_cur;sl_cur=sl_next;sl_next=(sl_next==(NSLOT-1)*SLOTB)?0:sl_next+SLOTB;}while(0)
  DMA_K(2,2*SLOTB);
  WAIT_BAR(3);
  qkt(pA0,pA1,Kbase,qr,negm,r32,hi);asm volatile("s_nop 15\n\ts_nop 7":"+v"(pA0),"+v"(pA1));CMASK(pA0,pA1,0);
  START(pA0,pA1);
  _Pragma("unroll") for(int r=0;r<16;++r)pA1[r]=__builtin_amdgcn_exp2f(pA1[r]);
  WAIT_BAR(0);
  DMA_K(3,0);DMA_V(1,SLOTB);
  ROT();
  kload8(kf,kp0+sl_cur);
  WAIT_BAR(2);
  s16x4 vlo[8],vhi[8]; u32x4 pw0,pw1,pw2,pw3;
  #define PKW(P,B) cvtpk_s(P[B],P[B+1])
  #define PAF(k) __builtin_bit_cast(bf16x8,pw##k)
  #define VFR(i) (bf16x8){vlo[i][0],vlo[i][1],vlo[i][2],vlo[i][3],vhi[i][0],vhi[i][1],vhi[i][2],vhi[i][3]}
  #define PIN(x) asm volatile("":"+v"(x))
  #define MX3(a,b,c) __builtin_fmaxf(__builtin_fmaxf((a),(b)),(c))
  #define GAPA(MF,A0,A1,A2,A3,W0,W1,PW) do{ MF; sacc+=A0; sacc+=A1; sacc+=A2; sacc+=A3; PIN(sacc); W0; W1; PIN(PW); SBAR(); }while(0)
  #define EX(v) __builtin_amdgcn_exp2f(v)
  #define GAPB(MF,X,B) do{ MF; X[B]=EX(X[B]); X[B+1]=EX(X[B+1]); X[B+2]=EX(X[B+2]); X[B+3]=EX(X[B+3]); PIN(X); SBAR(); }while(0)
  #define VRD(i) do{ vlo[i]=vtr(vp_+(((i)>>2)*4096+((i)&3)*1024)); vhi[i]=vtr(vp_+(((i)>>2)*4096+((i)&3)*1024+512)); }while(0)
  #define KRD(G,j) do{ if(G){ kload2(kf,kp0+sl_next,j); SBAR(); } }while(0)
  #define STEP(C0,C1,P0,P1,t,GK,GV,GL) do{ SBAR(); \
    const lds_cptr vp_=vp0+sl_prev; \
    VRD(0); SBAR(); float sacc=(P0[0]+P0[1]); \
    GAPA(C0=__builtin_amdgcn_mfma_f32_32x32x16_bf16(kf[0],qr[0],negm,0,0,0), P0[2],P0[3],P0[4],P0[5],     pw0[0]=PKW(P0,0), pw0[1]=PKW(P0,2), pw0); \
    VRD(4); SBAR(); GAPA(C1=__builtin_amdgcn_mfma_f32_32x32x16_bf16(kf[1],qr[0],negm,0,0,0), P0[6],P0[7],P0[8],P0[9],     pw0[2]=PKW(P0,4), pw0[3]=PKW(P0,6), pw0); \
    VRD(1); SBAR(); GAPA(C0=__builtin_amdgcn_mfma_f32_32x32x16_bf16(kf[2],qr[1],C0,0,0,0),   P0[10],P0[11],P0[12],P0[13], pw1[0]=PKW(P0,8), pw1[1]=PKW(P0,10), pw1); \
    VRD(5); SBAR(); GAPA(C1=__builtin_amdgcn_mfma_f32_32x32x16_bf16(kf[3],qr[1],C1,0,0,0),   P0[14],P0[15],P1[0],P1[1],   pw1[2]=PKW(P0,12),pw1[3]=PKW(P0,14), pw1); \
    VRD(2); SBAR(); GAPA(C0=__builtin_amdgcn_mfma_f32_32x32x16_bf16(kf[4],qr[2],C0,0,0,0),   P1[2],P1[3],P1[4],P1[5],     pw2[0]=PKW(P1,0), pw2[1]=PKW(P1,2), pw2); \
    VRD(6); SBAR(); GAPA(C1=__builtin_amdgcn_mfma_f32_32x32x16_bf16(kf[5],qr[2],C1,0,0,0),   P1[6],P1[7],P1[8],P1[9],     pw2[2]=PKW(P1,4), pw2[3]=PKW(P1,6), pw2); \
    VRD(3); SBAR(); GAPA(C0=__builtin_amdgcn_mfma_f32_32x32x16_bf16(kf[6],qr[3],C0,0,0,0),   P1[10],P1[11],P1[12],P1[13], pw3[0]=PKW(P1,8), pw3[1]=PKW(P1,10), pw3); \
    VRD(7); SBAR(); GAPA(C1=__builtin_amdgcn_mfma_f32_32x32x16_bf16(kf[7],qr[3],C1,0,0,0),   P1[14],P1[15],0.f,0.f,       pw3[2]=PKW(P1,12),pw3[3]=PKW(P1,14), pw3); \
    l_reg+=sacc; \
    if(GK){DMA_K((t)+3,sl_cur);} if(GV){DMA_V((t)+1,sl_next);} \
    CMASK(C0,C1,t); \
    { float a=MX3(C0[0],C0[1],C1[0]),b=MX3(C0[2],C0[3],C1[1]); a=MX3(a,C1[2],C1[3]); \
      _Pragma("unroll") for(int r=4;r<16;r+=4){a=MX3(a,C0[r],C0[r+1]);b=MX3(b,C0[r+2],C0[r+3]);a=MX3(a,C1[r],C1[r+1]);b=MX3(b,C1[r+2],C1[r+3]);} \
      float rm=__builtin_fmaxf(a,b); { auto rr=__builtin_amdgcn_permlane32_swap(__float_as_uint(rm),__float_as_uint(rm),false,false); rm=__builtin_fmaxf(__uint_as_float(rr[0]),__uint_as_float(rr[1])); } \
      resc=false; \
      if(__builtin_expect(__any(rm>(float)THRL),0)){ const float dl=__builtin_fmaxf(rm,0.f); mhat+=dl; \
        _Pragma("unroll") for(int r=0;r<16;++r){C0[r]-=dl;C1[r]-=dl;} \
        _Pragma("unroll") for(int r=0;r<16;++r)negm[r]=-mhat; asm volatile("":"+v"(negm)); \
        const float f=__builtin_amdgcn_exp2f(-dl); l_reg*=f; if(hi==0)wsf[r32]=f; resc=true; } } \
    SBAR(); \
    GAPB(o[0]=__builtin_amdgcn_mfma_f32_32x32x16_bf16(PAF(0),VFR(0),o[0],0,0,0), C0,0); \
    GAPB(o[1]=__builtin_amdgcn_mfma_f32_32x32x16_bf16(PAF(0),VFR(4),o[1],0,0,0), C0,4); \
    KRD(GL,0); GAPB(o[0]=__builtin_amdgcn_mfma_f32_32x32x16_bf16(PAF(1),VFR(1),o[0],0,0,0), C0,8); \
    KRD(GL,1); GAPB(o[1]=__builtin_amdgcn_mfma_f32_32x32x16_bf16(PAF(1),VFR(5),o[1],0,0,0), C0,12); \
    KRD(GL,2); GAPB(o[0]=__builtin_amdgcn_mfma_f32_32x32x16_bf16(PAF(2),VFR(2),o[0],0,0,0), C1,0); \
    KRD(GL,3); GAPB(o[1]=__builtin_amdgcn_mfma_f32_32x32x16_bf16(PAF(2),VFR(6),o[1],0,0,0), C1,4); \
    GAPB(o[0]=__builtin_amdgcn_mfma_f32_32x32x16_bf16(PAF(3),VFR(3),o[0],0,0,0), C1,8); \
    GAPB(o[1]=__builtin_amdgcn_mfma_f32_32x32x16_bf16(PAF(3),VFR(7),o[1],0,0,0), C1,12); \
    }while(0)
  int t=1;
  #undef CMASK
  #define CMASK(P0,P1,t) do{}while(0)
  for(;t+5<NT;t+=2){
    STEP(pB0,pB1,pA0,pA1,t,true,true,true);     WAIT_BAR(2); RESC(); ROT();
    STEP(pA0,pA1,pB0,pB1,t+1,true,true,true);   WAIT_BAR(2); RESC(); ROT();
  }
  #undef CMASK
  #define CMASK(P0,P1,t) do{}while(0)
  #define ENDW(tt) do{ if((tt)+3<NT){WAIT_BAR(2);} else if((tt)+2<NT){WAIT_BAR(1);} else {WAIT_BAR(0);} }while(0)
  for(;t+1<NT;t+=2){
    STEP(pB0,pB1,pA0,pA1,t,(t+3<NT),(t+1<NT),(t+1<NT));       ENDW(t);   RESC(); ROT();
    STEP(pA0,pA1,pB0,pB1,t+1,(t+4<NT),(t+2<NT),(t+2<NT));     ENDW(t+1); RESC(); ROT();
  }
  STEP(pB0,pB1,pA0,pA1,NT-1,false,false,false); RESC();
  { float sacc=pB0[0]+pB0[1]; _Pragma("unroll") for(int r=2;r<16;++r)sacc+=pB0[r]; _Pragma("unroll") for(int r=0;r<16;++r)sacc+=pB1[r]; l_reg+=sacc;
    pw0=(u32x4){PKW(pB0,0),PKW(pB0,2),PKW(pB0,4),PKW(pB0,6)};pw1=(u32x4){PKW(pB0,8),PKW(pB0,10),PKW(pB0,12),PKW(pB0,14)};pw2=(u32x4){PKW(pB1,0),PKW(pB1,2),PKW(pB1,4),PKW(pB1,6)};pw3=(u32x4){PKW(pB1,8),PKW(pB1,10),PKW(pB1,12),PKW(pB1,14)};
    SBAR(); pv(o,vb0+sl_cur,PAF(0),PAF(1),PAF(2),PAF(3)); }
  #undef PKW
  #undef PAF
  #undef VFR
  #undef PIN
  #undef MX3
  #undef GAPA
  #undef GAPB
  #undef EX
  #undef VRD
  #undef KRD
  #undef STEP
  #undef ENDW
  {auto rr=__builtin_amdgcn_permlane32_swap(__float_as_uint(l_reg),__float_as_uint(l_reg),false,false);l_reg=__uint_as_float(rr[0])+__uint_as_float(rr[1]);}
  if(hi==0)wsf[32+r32]=l_reg;asm volatile("s_waitcnt lgkmcnt(0)":::"memory");
  float rli[16];
  #pragma unroll
  for(int r=0;r<16;++r)rli[r]=__builtin_amdgcn_rcpf(wsf[32+crow(r,hi)]);
  bf16*Ow=O+(qrow0+wid*QBLK)*DM+vcol;
  { bf16*stg=(bf16*)(shm+LDS_OST)+wid*2048;
    #pragma unroll
    for(int r=0;r<16;++r){const int orow=crow(r,hi);
      #pragma unroll
      for(int d0=0;d0<2;++d0)stg[orow*64+d0*32+r32]=(bf16)f2bf(o[d0][r]*rli[r]);}
    asm volatile("s_waitcnt lgkmcnt(0)":::"memory");
    #pragma unroll
    for(int i=0;i<4;++i){const int row=i*8+(lane>>3),ch=lane&7; const u32x4 v=*(const u32x4*)(stg+row*64+ch*8); ATTN_STORE16(Ow+(long)row*DM+ch*8,v);} }
  asm volatile("s_waitcnt lgkmcnt(0)\n\ts_barrier":::"memory");
  #undef DMA_K
  #undef DMA_V
  #undef CMASK
  #undef START
  #undef RESC
  #undef ROT
}
constexpr int ATTN_LDS_BYTES=LDS_BYTES;
#undef SBAR
#undef WAIT_BAR
#undef KVROW
}
__device__ __forceinline__ void phase_attn_opt(const Frame& F, const Prm& p) {
    const bf16* Q = (const bf16*)(p.ws + WS_Q); const bf16* K = (const bf16*)(p.ws + WS_K); const bf16* V = (const bf16*)(p.ws + WS_V); bf16* O1 = (bf16*)(p.ws + WS_O1);
    for (int bv = vcu_of(F); bv < 256; bv += F.G) {
        const int b = bv >> 5, vh = bv & 31, h = vh >> 2, m = (vh >> 1) & 1, vhalf = vh & 1;
        const int qcol = (h * 2 + m) * 64, vcol = h * 128 + vhalf * 64; bf16* O = O1 + (size_t)m * ((WS_O2 - WS_O1) / 2);
        const long kctx = NLAT + b * CTXL, klat = (long)b * SEQ;
        for (int i = 0; i < 17; ++i) {
            const long qrow0 = i < 16 ? klat + i * 256 : kctx; const int NT = i < 16 ? 68 : 4;
            attn_body::attn_unit<8>(qrow0, qcol, vcol, kctx, klat, NT, Q, K, V, O, (char*)F.lds);
        }
    }
}
namespace gla {
typedef short bf16x8 __attribute__((ext_vector_type(8)));
typedef short s16x4 __attribute__((ext_vector_type(4)));
typedef float f32x16 __attribute__((ext_vector_type(16)));
constexpr int PQ = 272, PK = 144;
constexpr int L_QS = 0, L_KS = 64 * PQ, L_KT = 2 * 64 * PQ, L_VT = L_KT + 128 * PK, L_SB = L_VT + 64 * PK, L_DEC = L_SB + 64 * PQ, L_END = L_DEC + 512;
__device__ __forceinline__ int crow(int i, int hh) { return (i & 3) + 8 * (i >> 2) + 4 * hh; }
typedef float f32x2_t __attribute__((ext_vector_type(2))); typedef __bf16 bf16x2_t __attribute__((ext_vector_type(2)));
__device__ __forceinline__ unsigned pk(float lo, float hi) { f32x2_t v = {lo, hi}; bf16x2_t b = __builtin_convertvector(v, bf16x2_t); return __builtin_bit_cast(unsigned, b); }

__device__ __forceinline__ void scan_unit(const Frame& F, const Prm& p, int unit) {
    const int dvs = unit & 3, dir = (unit >> 2) & 1, h = (unit >> 3) & 3, b = unit >> 5;
    LAS unsigned char* lds = (LAS unsigned char*)F.lds;
    const int lane = F.lane, w = F.wave, tid = F.tid, r = lane & 31, hh = lane >> 5;
    const bf16* QT = (const bf16*)(p.ws + WS_QT) + (size_t)dir * NTOK * 512 + h * 128 + 8 * w;
    const bf16* KT = (const bf16*)(p.ws + WS_KT) + (size_t)dir * NTOK * 512 + h * 128 + 8 * w;
    const bf16* V = (const bf16*)(p.ws + WS_V1) + h * 256 + dvs * 64 + 8 * w;
    const float* DEC = (const float*)(p.ws + WS_DEC) + (size_t)dir * NCHUNK * 512 + h * 128;
    bf16* OG = (bf16*)(p.ws + (dir ? WS_OGB : WS_OGF)) + h * 256 + dvs * 64;
    f32x16 S0 = {}, S1 = {};
    for (int i = tid; i < 64 * PQ / 16; i += NTHR) *(LAS u32x4*)(lds + L_SB + i * 16) = (u32x4){0u, 0u, 0u, 0u};
    u32x4 pq0, pq1, pk0, pk1, pv; float pdec = 0.f;
#define GLA_CHUNK(step) ((step) >= 4 ? b * 64 + (dir ? 63 - ((step) - 4) : (step) - 4) : 512 + b * 4 + (dir ? 3 - (step) : (step)))
#define GLA_LOAD(step) do { const size_t row_ = (size_t)GLA_CHUNK(step) * 64 + lane; \
        pq0 = *(const u32x4*)(QT + row_ * 512); pq1 = *(const u32x4*)(QT + row_ * 512 + 64); pk0 = *(const u32x4*)(KT + row_ * 512); pk1 = *(const u32x4*)(KT + row_ * 512 + 64); \
        pv = *(const u32x4*)(V + row_ * 1024); if (tid < 128) pdec = DEC[(size_t)GLA_CHUNK(step) * 512 + tid]; } while (0)
#define GLA_T16(base, x, j) do { *(LAS unsigned short*)(lds + (base) + (2 * (j)) * PK + 2 * lane) = (unsigned short)((x) & 0xffffu); *(LAS unsigned short*)(lds + (base) + (2 * (j) + 1) * PK + 2 * lane) = (unsigned short)((x) >> 16); } while (0)
#define GLA_STORE() do { \
        *(LAS u32x4*)(lds + L_QS + lane * PQ + 16 * w) = pq0; *(LAS u32x4*)(lds + L_QS + lane * PQ + 128 + 16 * w) = pq1; \
        *(LAS u32x4*)(lds + L_KS + lane * PQ + 16 * w) = pk0; *(LAS u32x4*)(lds + L_KS + lane * PQ + 128 + 16 * w) = pk1; \
        GLA_T16(L_KT + 8 * w * PK, pk0.x, 0); GLA_T16(L_KT + 8 * w * PK, pk0.y, 1); GLA_T16(L_KT + 8 * w * PK, pk0.z, 2); GLA_T16(L_KT + 8 * w * PK, pk0.w, 3); \
        GLA_T16(L_KT + (64 + 8 * w) * PK, pk1.x, 0); GLA_T16(L_KT + (64 + 8 * w) * PK, pk1.y, 1); GLA_T16(L_KT + (64 + 8 * w) * PK, pk1.z, 2); GLA_T16(L_KT + (64 + 8 * w) * PK, pk1.w, 3); \
        GLA_T16(L_VT + 8 * w * PK, pv.x, 0); GLA_T16(L_VT + 8 * w * PK, pv.y, 1); GLA_T16(L_VT + 8 * w * PK, pv.z, 2); GLA_T16(L_VT + 8 * w * PK, pv.w, 3); \
        if (tid < 128) *(LAS float*)(lds + L_DEC + 4 * tid) = pdec; } while (0)
    GLA_LOAD(0);
    GLA_STORE();
    __syncthreads();
    for (int step = 0; step < 68; ++step) {
        const bool lat = step >= 4; const int chunk = GLA_CHUNK(step);
        if (step + 1 < 68) GLA_LOAD(step + 1);
        if (w < 4) {
            if (lat) {
                const int tb = w >> 1, vb = w & 1;
                bf16x8 bq[8]; f32x16 sc0 = {}, sc1 = {};
#pragma unroll
                for (int ks = 0; ks < 8; ++ks) {
                    bq[ks] = *(const LAS bf16x8*)(lds + L_QS + (32 * tb + r) * PQ + (16 * ks + 8 * hh) * 2);
                    const bf16x8 a0 = *(const LAS bf16x8*)(lds + L_KS + r * PQ + (16 * ks + 8 * hh) * 2), a1 = *(const LAS bf16x8*)(lds + L_KS + (32 + r) * PQ + (16 * ks + 8 * hh) * 2);
                    sc0 = __builtin_amdgcn_mfma_f32_32x32x16_bf16(a0, bq[ks], sc0, 0, 0, 0); sc1 = __builtin_amdgcn_mfma_f32_32x32x16_bf16(a1, bq[ks], sc1, 0, 0, 0);
                }
                const int t = 32 * tb + r;
#pragma unroll
                for (int i = 0; i < 16; ++i) { const int s0 = crow(i, hh), s1 = 32 + s0; const bool k0 = dir ? (s0 >= t) : (s0 <= t), k1 = dir ? (s1 >= t) : (s1 <= t); sc0[i] = k0 ? sc0[i] : 0.f; sc1[i] = k1 ? sc1[i] : 0.f; }
                f32x16 o = {};
#pragma unroll
                for (int sb = 0; sb < 2; ++sb)
#pragma unroll
                    for (int sp = 0; sp < 2; ++sp) {
                        u32x4 pw;
                        if (sb == 0) { pw.x = pk(sc0[8 * sp + 0], sc0[8 * sp + 1]); pw.y = pk(sc0[8 * sp + 2], sc0[8 * sp + 3]); pw.z = pk(sc0[8 * sp + 4], sc0[8 * sp + 5]); pw.w = pk(sc0[8 * sp + 6], sc0[8 * sp + 7]); }
                        else { pw.x = pk(sc1[8 * sp + 0], sc1[8 * sp + 1]); pw.y = pk(sc1[8 * sp + 2], sc1[8 * sp + 3]); pw.z = pk(sc1[8 * sp + 4], sc1[8 * sp + 5]); pw.w = pk(sc1[8 * sp + 6], sc1[8 * sp + 7]); }
                        const s16x4 lo = *(const LAS s16x4*)(lds + L_VT + (32 * vb + r) * PK + (32 * sb + 16 * sp + 4 * hh) * 2), hi = *(const LAS s16x4*)(lds + L_VT + (32 * vb + r) * PK + (32 * sb + 16 * sp + 8 + 4 * hh) * 2);
                        const bf16x8 av = {lo[0], lo[1], lo[2], lo[3], hi[0], hi[1], hi[2], hi[3]};
                        o = __builtin_amdgcn_mfma_f32_32x32x16_bf16(av, __builtin_bit_cast(bf16x8, pw), o, 0, 0, 0);
                    }
#pragma unroll
                for (int ks = 0; ks < 8; ++ks) {
                    const bf16x8 as = *(const LAS bf16x8*)(lds + L_SB + (32 * vb + r) * PQ + (16 * ks + 8 * hh) * 2);
                    o = __builtin_amdgcn_mfma_f32_32x32x16_bf16(as, bq[ks], o, 0, 0, 0);
                }
                bf16* orow = OG + ((size_t)chunk * 64 + t) * DM + 32 * vb + 4 * hh;
#pragma unroll
                for (int g = 0; g < 4; ++g) { u32x2 wv; wv.x = pk(o[4 * g], o[4 * g + 1]); wv.y = pk(o[4 * g + 2], o[4 * g + 3]); *(u32x2*)(orow + 8 * g) = wv; }
            }
        } else {
            const int db = w - 4;
#pragma unroll
            for (int ks = 0; ks < 4; ++ks) {
                const bf16x8 a = *(const LAS bf16x8*)(lds + L_KT + (32 * db + r) * PK + (16 * ks + 8 * hh) * 2);
                const bf16x8 b0 = *(const LAS bf16x8*)(lds + L_VT + r * PK + (16 * ks + 8 * hh) * 2), b1 = *(const LAS bf16x8*)(lds + L_VT + (32 + r) * PK + (16 * ks + 8 * hh) * 2);
                S0 = __builtin_amdgcn_mfma_f32_32x32x16_bf16(a, b0, S0, 0, 0, 0); S1 = __builtin_amdgcn_mfma_f32_32x32x16_bf16(a, b1, S1, 0, 0, 0);
            }
#pragma unroll
            for (int i = 0; i < 16; ++i) { const float dc = *(const LAS float*)(lds + L_DEC + 4 * (32 * db + crow(i, hh))); S0[i] *= dc; S1[i] *= dc; }
        }
        __syncthreads();
        if (step + 1 < 68) {
            GLA_STORE();
            if (w >= 4) { const int db = w - 4;
#pragma unroll
                for (int g = 0; g < 4; ++g) { u32x2 w0, w1; w0.x = pk(S0[4 * g], S0[4 * g + 1]); w0.y = pk(S0[4 * g + 2], S0[4 * g + 3]); w1.x = pk(S1[4 * g], S1[4 * g + 1]); w1.y = pk(S1[4 * g + 2], S1[4 * g + 3]);
                    *(LAS u32x2*)(lds + L_SB + r * PQ + (32 * db + 8 * g + 4 * hh) * 2) = w0; *(LAS u32x2*)(lds + L_SB + (32 + r) * PQ + (32 * db + 8 * g + 4 * hh) * 2) = w1; } }
        }
        __syncthreads();
    }
#undef GLA_CHUNK
#undef GLA_LOAD
#undef GLA_T16
#undef GLA_STORE
}
}
__device__ __forceinline__ void phase_scan_opt(const Frame& F, const Prm& p) {
    for (int unit = vcu_of(F); unit < 256; unit += F.G) gla::scan_unit(F, p, unit);
}
#define PHASE_QKV(F, p) phase_qkv_opt(F, p)
#define PHASE_ATTN(F, p) phase_attn_opt(F, p)
#define PHASE_WO(F, p, l) phase_wo_opt(F, p, l)
#define PHASE_MOE1(F, p, l) phase_moe1_opt(F, p, l)
#define PHASE_MOE2(F, p, l) phase_moe2_opt(F, p, l)
#define PHASE_INPROJ(F, p) phase_inproj_opt(F, p)
#define PHASE_SCAN(F, p) phase_scan_opt(F, p)
typedef GAS unsigned gu32;
#define XB_TMO      128
#define XB_XCNT(j)  (256  + 64 * (j))
#define XB_XSUB(j)  (1280 + 64 * (j))
#define XB_XGEN(j)  (2304 + 64 * (j))
#define XB_TOP      3328
#define XB_TOPGEN   3392
#define XCD_BAR_WORDS 3456
#define XB_SPIN_CAP (1u << 20)
__device__ __forceinline__ unsigned xb_ld(unsigned* p)              { return __hip_atomic_load(p, __ATOMIC_RELAXED, __HIP_MEMORY_SCOPE_AGENT); }
__device__ __forceinline__ unsigned xb_add(unsigned* p, unsigned v) { return __hip_atomic_fetch_add(p, v, __ATOMIC_RELAXED, __HIP_MEMORY_SCOPE_AGENT); }
__device__ __forceinline__ unsigned xb_xcc_id() { return (unsigned)__builtin_amdgcn_s_getreg((3 << 11) | 20) & 0xFu; }
#define XB_SPIN(cond, bar) do { unsigned _sp = 0; while (cond) { __builtin_amdgcn_s_sleep(1); \
    if ((++_sp & 255u) == 0u) { if (xb_ld(&(bar)[XB_TMO])) break; if (_sp > XB_SPIN_CAP) { atomicAdd(&(bar)[XB_TMO], 1u); break; } } } } while (0)
struct XcdBarrier { unsigned* bar; unsigned x; volatile LAS unsigned* st; };
__device__ __forceinline__ XcdBarrier xcd_barrier_post(unsigned* bar, volatile LAS unsigned* st) {
    XcdBarrier b; b.bar = bar; b.x = xb_xcc_id(); b.st = st;
    if (threadIdx.x == 0) (void)xb_add(&bar[XB_XCNT(b.x)], 1u);
    return b;
}
__device__ __forceinline__ void xcd_barrier_complete(unsigned* bar, unsigned x, unsigned& nloc, unsigned& nx) {
    const unsigned G = gridDim.x * gridDim.y * gridDim.z;
    unsigned sum, cnt, mine, sp = 0u;
    for (;;) {
        sum = 0u; cnt = 0u; mine = 0u;
#pragma unroll
        for (unsigned j = 0; j < 16; ++j) { const unsigned c = xb_ld(&bar[XB_XCNT(j)]); sum += c; cnt += (c > 0u) ? 1u : 0u; mine = (j == x) ? c : mine; }
        if (sum == G) break;
        __builtin_amdgcn_s_sleep(1);
        if ((++sp & 255u) == 0u) { if (xb_ld(&bar[XB_TMO])) break; if (sp > XB_SPIN_CAP) { atomicAdd(&bar[XB_TMO], 1u); break; } }
    }
    nloc = mine > 0u ? mine : 1u; nx = cnt > 0u ? cnt : 1u;
}
__device__ __forceinline__ void xcd_barrier(const XcdBarrier& b) {
    asm volatile("s_waitcnt vmcnt(0)" ::: "memory");
    __syncthreads();
    if (threadIdx.x == 0) {
        unsigned* bar = b.bar;
        __builtin_amdgcn_s_waitcnt(0);
        unsigned nloc = b.st[0], nx = b.st[1];
        if (nloc == 0u) { xcd_barrier_complete(bar, b.x, nloc, nx); b.st[0] = nloc; b.st[1] = nx; }
        const unsigned old = xb_add(&bar[XB_XSUB(b.x)], 1u);
        const unsigned gen = old / nloc;
        if (old + 1u == (gen + 1u) * nloc) {
            __builtin_amdgcn_fence(__ATOMIC_RELEASE, "agent");
            asm volatile("s_waitcnt vmcnt(0)" ::: "memory");
            const unsigned og = xb_add(&bar[XB_TOP], 1u);
            const unsigned tg = og / nx;
            if (og + 1u == (tg + 1u) * nx) xb_add(&bar[XB_TOPGEN], 1u);
            else XB_SPIN(xb_ld(&bar[XB_TOPGEN]) == tg, bar);
            __builtin_amdgcn_fence(__ATOMIC_ACQUIRE, "agent");
            xb_add(&bar[XB_XGEN(b.x)], 1u);
            asm volatile("s_waitcnt vmcnt(0)" ::: "memory");
        } else {
            XB_SPIN(xb_ld(&bar[XB_XGEN(b.x)]) == gen, bar);
            __builtin_amdgcn_fence(__ATOMIC_ACQUIRE, "agent");
            asm volatile("s_waitcnt vmcnt(0)" ::: "memory");
        }
    }
    __syncthreads();
}

constexpr int NPHASE = 19;
#ifndef OPT_MASK
#define OPT_MASK 0u
#endif
__global__ void __launch_bounds__(NTHR, 2) mega_fwd(Prm p) {
    extern __shared__ __attribute__((aligned(16))) unsigned char lds[];
    Frame F; F.lds = lds; F.ctl = (unsigned*)(p.ws + WS_CTL);
    F.tid = threadIdx.x; F.lane = F.tid & 63; F.wave = __builtin_amdgcn_readfirstlane(F.tid >> 6); F.G = gridDim.x; F.bid = blockIdx.x;
    for (int u = F.tid; u < (LDS_BYTES - LDSCTL_OFF) / 4; u += NTHR) ((LAS unsigned*)(lds + LDSCTL_OFF))[u] = 0u;
    __syncthreads();
    const int lo = p.ph_lo, hi = p.ph_hi;
    const bool multi = (hi - lo) > 1;
    XcdBarrier bar; bar.bar = F.ctl + CW_BAR + p.li * XCD_BAR_WORDS; bar.x = 0; bar.st = nullptr;
    if (multi) bar = xcd_barrier_post(F.ctl + CW_BAR + p.li * XCD_BAR_WORDS, (volatile LAS unsigned*)(lds + MISC_OFF) + 8);
#define IN(k) (lo <= (k) && (k) < hi)
#define SEAM(k) do { if (IN(k) && IN((k) + 1)) xcd_barrier(bar); } while (0)
#ifndef REP_MASK
#define REP_MASK 0u
#endif
#define REP(k, call) do { if (((REP_MASK) >> (k)) & 1u) { xcd_barrier(bar); call; } } while (0)
    if (IN(0)) { phase_prologue(F, p); REP(0, phase_prologue(F, p)); } SEAM(0);
    if (IN(1)) { phase_modulate0(F, p); REP(1, phase_modulate0(F, p)); } SEAM(1);
    if (IN(2)) { PHASE_QKV(F, p); REP(2, PHASE_QKV(F, p)); } SEAM(2);
    if (IN(3)) { PHASE_ATTN(F, p); REP(3, PHASE_ATTN(F, p)); } SEAM(3);
    if (IN(4)) { phase_attn_combine(F, p); REP(4, phase_attn_combine(F, p)); } SEAM(4);
    if (IN(5)) { PHASE_WO(F, p, 0); REP(5, PHASE_WO(F, p, 0)); } SEAM(5);
    if (IN(6)) { phase_ln_route(F, p, 0); REP(6, phase_ln_route(F, p, 0)); } SEAM(6);
    if (IN(7)) { PHASE_MOE1(F, p, 0); REP(7, PHASE_MOE1(F, p, 0)); } SEAM(7);
    if (IN(8)) { PHASE_MOE2(F, p, 0); REP(8, PHASE_MOE2(F, p, 0)); } SEAM(8);
    if (IN(9)) { phase_moe_combine(F, p, 0); REP(9, phase_moe_combine(F, p, 0)); } SEAM(9);
    if (IN(10)) { PHASE_INPROJ(F, p); REP(10, PHASE_INPROJ(F, p)); } SEAM(10);
    if (IN(11)) { phase_gla_prep(F, p); REP(11, phase_gla_prep(F, p)); } SEAM(11);
    if (IN(12)) { PHASE_SCAN(F, p); REP(12, PHASE_SCAN(F, p)); } SEAM(12);
    if (IN(13)) { phase_gla_post(F, p); REP(13, phase_gla_post(F, p)); } SEAM(13);
    if (IN(14)) { PHASE_WO(F, p, 1); REP(14, PHASE_WO(F, p, 1)); } SEAM(14);
    if (IN(15)) { phase_ln_route(F, p, 1); REP(15, phase_ln_route(F, p, 1)); } SEAM(15);
    if (IN(16)) { PHASE_MOE1(F, p, 1); REP(16, PHASE_MOE1(F, p, 1)); } SEAM(16);
    if (IN(17)) { PHASE_MOE2(F, p, 1); REP(17, PHASE_MOE2(F, p, 1)); } SEAM(17);
    if (IN(18)) { phase_moe_combine(F, p, 1); REP(18, phase_moe_combine(F, p, 1)); }
#undef IN
#undef SEAM
}

static void launch_naive(int ph, const Prm& p, hipStream_t stream) {
    using namespace naive;
    const bf16* H = (const bf16*)(p.ws + WS_H);
    switch (ph) {
    case 2: { NG g{H, (const bf16*)(p.ws + WS_WQKV), NTOK, 3072, 1024, 0, nullptr}; hipLaunchKernelGGL(gemm_kernel<EPI_QKV>, dim3(3072 / 64, NTOK / 64), dim3(256), 0, stream, g, p); break; }
    case 3: hipLaunchKernelGGL(attn_kernel, dim3(544, 16), dim3(256), 0, stream, p); break;
    case 5: { NG g{(const bf16*)(p.ws + WS_A2), (const bf16*)(p.ws + WS_WO), NTOK, 1024, 1024, 0, (bf16*)(p.ws + WS_Y)}; hipLaunchKernelGGL(gemm_kernel<EPI_PLAIN>, dim3(16, NTOK / 64), dim3(256), 0, stream, g, p); break; }
    case 7: case 16: { const int l = ph == 16; NG g{H, (const bf16*)(p.ws + (l ? WS_GU1 : WS_GU0)), MAXSLOT, 1024, 1024, l, nullptr}; hipLaunchKernelGGL(gemm_kernel<EPI_GATEUP>, dim3(16, MAXSLOT / 64), dim3(256), 0, stream, g, p); break; }
    case 8: case 17: { const int l = ph == 17; NG g{(const bf16*)(p.ws + WS_ACT), (const bf16*)(p.ws + (l ? WS_DN1 : WS_DN0)), MAXSLOT, 1024, 512, l, nullptr}; hipLaunchKernelGGL(gemm_kernel<EPI_DOWN>, dim3(16, MAXSLOT / 64), dim3(256), 0, stream, g, p); break; }
    case 10: { NG g{H, (const bf16*)(p.ws + WS_WIN), NTOK, NIN, 1024, 0, nullptr}; hipLaunchKernelGGL(gemm_kernel<EPI_INPROJ>, dim3(NIN / 64, NTOK / 64), dim3(256), 0, stream, g, p); break; }
    case 12: hipLaunchKernelGGL(gla_scan_kernel, dim3(512), dim3(256), GLA_SCAN_LDS, stream, p); break;
    case 14: { NG g{(const bf16*)(p.ws + WS_A2B), (const bf16*)(p.ws + WS_WGO), NLAT, 1024, 1024, 0, (bf16*)(p.ws + WS_Y)}; hipLaunchKernelGGL(gemm_kernel<EPI_PLAIN>, dim3(16, NLAT / 64), dim3(256), 0, stream, g, p); break; }
    default: break;
    }
}
extern "C" void kernel_launch(void* const* d_in, const int* in_sizes, int n_in, void* d_out, int out_size, void* d_ws, size_t ws_size, hipStream_t stream) {
    static int grid = 0;
    if (grid == 0) {
        if (n_in != 23 || in_sizes[0] != NLAT * DM || out_size != NLAT * DM || ws_size < WS_END) { fprintf(stderr, "kernel_launch: unexpected shapes (n_in %d, in0 %d, out %d, ws %zu); nothing launched\n", n_in, n_in > 0 ? in_sizes[0] : -1, out_size, ws_size); grid = -1; return; }
        int dev = 0, cus = 0;
        if (hipGetDevice(&dev) != hipSuccess || hipDeviceGetAttribute(&cus, hipDeviceAttributeMultiprocessorCount, dev) != hipSuccess) { grid = -1; return; }
        if (hipFuncSetAttribute((const void*)mega_fwd, hipFuncAttributeMaxDynamicSharedMemorySize, LDS_BYTES) != hipSuccess) { fprintf(stderr, "kernel_launch: hipFuncSetAttribute failed\n"); grid = -1; return; }
        (void)hipFuncSetAttribute((const void*)naive::gla_scan_kernel, hipFuncAttributeMaxDynamicSharedMemorySize, naive::GLA_SCAN_LDS);
        int per_cu = 0;
        if (hipOccupancyMaxActiveBlocksPerMultiprocessor(&per_cu, (const void*)mega_fwd, NTHR, LDS_BYTES) != hipSuccess || per_cu < 1) fprintf(stderr, "kernel_launch: note: occupancy query reports %d\n", per_cu);
        (void)hipGetLastError();
        grid = cus;
    }
    if (grid < 0) return;
    (void)hipMemsetAsync((char*)d_ws + WS_CTL, 0, CTL_ZERO_BYTES, stream);
    Prm p{};
    const float** pp = (const float**)&p;
    for (int i = 0; i < 23; ++i) pp[i] = (const float*)d_in[i];
    p.out = (float*)d_out; p.ws = (unsigned char*)d_ws;
    const unsigned naive_phases = (1u << 2) | (1u << 3) | (1u << 5) | (1u << 7) | (1u << 8) | (1u << 10) | (1u << 12) | (1u << 14) | (1u << 16) | (1u << 17);
    const unsigned use_naive = naive_phases & ~(unsigned)(OPT_MASK);
    int ph = 0, li = 0;
    while (ph < NPHASE) {
        if (use_naive & (1u << ph)) { launch_naive(ph, p, stream); ++ph; continue; }
        int e = ph + 1;
#if defined(ONE_PER_PHASE)
#else
        while (e < NPHASE && !(use_naive & (1u << e))) ++e;
#endif
        p.ph_lo = ph; p.ph_hi = e; p.li = li++;
        hipLaunchKernelGGL(mega_fwd, dim3(grid), dim3(NTHR), LDS_BYTES, stream, p);
        ph = e;
    }
}
```

```cpp
#define OPT_MASK 0x355ACu
#include <hip/hip_runtime.h>
#include <cstdint>
#include <cstdio>

constexpr int BATCH = 8, SEQ = 4096, DM = 1024, CTXL = 256;
constexpr int NLAT = BATCH * SEQ, NCTX = BATCH * CTXL, NTOK = NLAT + NCTX;
constexpr float ALPHA = 1.4142135623730951f;
constexpr float LN_EPS = 1e-5f;
constexpr float LAMBDA_INIT0 = 0.2f;
constexpr float C2 = 0.125f * 1.4426950408889634f;
constexpr int NEXP = 16, DEXP = 512, MAXSLOT = 73728;
constexpr int NCHUNK = NTOK / 64;
constexpr int NIN = 3328;

typedef unsigned short bf16;
typedef float f32x4 __attribute__((ext_vector_type(4)));
typedef float f32x2 __attribute__((ext_vector_type(2)));
typedef unsigned u32x2 __attribute__((ext_vector_type(2)));
typedef unsigned u32x4 __attribute__((ext_vector_type(4)));

constexpr size_t MiB = 1u << 20;
constexpr size_t WS_CTL = 0, CTL_ZERO_BYTES = 1 * MiB;
constexpr size_t WS_MOD = 1 * MiB;
constexpr size_t WS_MISC = 1 * MiB + 512 * 1024;
constexpr size_t WS_WQKV = 2 * MiB, WS_WO = 8 * MiB, WS_GU0 = 10 * MiB, WS_DN0 = 42 * MiB;
constexpr size_t WS_XCTX = 58 * MiB;
constexpr size_t WS_WIN = 66 * MiB, WS_WGO = 73 * MiB, WS_GU1 = 75 * MiB, WS_DN1 = 107 * MiB;
constexpr size_t WS_H = 123 * MiB;
constexpr size_t WS_Q = 191 * MiB, WS_K = 259 * MiB, WS_V = 327 * MiB, WS_O2 = 395 * MiB;
constexpr size_t WS_LIST = 463 * MiB;
constexpr size_t WS_TOKR = 466 * MiB;
constexpr size_t WS_DEC = 468 * MiB;
constexpr size_t WS_ZZ = 471 * MiB;
constexpr size_t WS_END = 480 * MiB;
constexpr size_t WS_O1 = WS_H, WS_A2 = WS_Q, WS_Y = WS_K;
constexpr size_t WS_YM = 191 * MiB, WS_ACT = 335 * MiB;
constexpr size_t WS_QR = 191 * MiB, WS_KR = 225 * MiB, WS_V1 = 259 * MiB, WS_R = 327 * MiB;
constexpr size_t WS_QT = WS_H, WS_KT = 395 * MiB;
constexpr size_t WS_OGF = 191 * MiB, WS_OGB = 2 * MiB;
constexpr size_t WS_A2B = WS_H;
constexpr int CW_TMO = 0, CW_CODE = 1;
constexpr int CW_CNT = 64;
constexpr int CW_BAR = 4096;

__device__ __forceinline__ unsigned f2bf(float f) { unsigned u = __builtin_bit_cast(unsigned, f); return (u + 0x7fffu + ((u >> 16) & 1u)) >> 16; }
__device__ __forceinline__ unsigned pk2(float lo, float hi) { return f2bf(lo) | (f2bf(hi) << 16); }
__device__ __forceinline__ float bf2f(unsigned b) { return __builtin_bit_cast(float, b << 16); }
__device__ __forceinline__ float wave_sum(float v) {
#pragma unroll
    for (int o = 1; o < 64; o <<= 1) v += __shfl_xor(v, o);
    return v;
}
__device__ __forceinline__ float silu_f(float v) { return v / (1.f + __expf(-v)); }

struct Prm {
    const float *x, *c, *ctx, *cctx, *ada_w, *ada_b, *ln_g, *ln_b, *w_qkv, *w_o, *lam, *subln, *gw_in, *gwg_down, *gwg_up, *gbg, *gnorm, *gw_o, *rw, *rb, *mg, *mu, *md;
    float* out; unsigned char* ws;
    int ph_lo, ph_hi, li, pad;
};
__device__ __forceinline__ void ld_row_f32(const float* p, int lane, f32x4 (&v)[4]) {
#pragma unroll
    for (int j = 0; j < 4; ++j) v[j] = *(const f32x4*)(p + 4 * lane + 256 * j);
}
__device__ __forceinline__ void st_row_f32(float* p, int lane, const f32x4 (&v)[4]) {
#pragma unroll
    for (int j = 0; j < 4; ++j) *(f32x4*)(p + 4 * lane + 256 * j) = v[j];
}
__device__ __forceinline__ void ld_row_bf16(const bf16* p, int lane, f32x4 (&v)[4]) {
#pragma unroll
    for (int j = 0; j < 4; ++j) { const u32x2 u = *(const u32x2*)(p + 4 * lane + 256 * j); v[j] = (f32x4){bf2f(u.x & 0xffffu), bf2f(u.x >> 16), bf2f(u.y & 0xffffu), bf2f(u.y >> 16)}; }
}
__device__ __forceinline__ void st_row_bf16(bf16* p, int lane, const f32x4 (&v)[4]) {
#pragma unroll
    for (int j = 0; j < 4; ++j) { u32x2 u; u.x = pk2(v[j].x, v[j].y); u.y = pk2(v[j].z, v[j].w); *(u32x2*)(p + 4 * lane + 256 * j) = u; }
}
__device__ __forceinline__ void ln_row(f32x4 (&v)[4], const float* g, const float* b, int lane) {
    float s = 0.f;
#pragma unroll
    for (int j = 0; j < 4; ++j) s += (v[j].x + v[j].y) + (v[j].z + v[j].w);
    const float mean = wave_sum(s) * (1.f / DM); float q = 0.f;
#pragma unroll
    for (int j = 0; j < 4; ++j) { v[j] = v[j] - mean; q += (v[j].x * v[j].x + v[j].y * v[j].y) + (v[j].z * v[j].z + v[j].w * v[j].w); }
    const float rstd = 1.f / sqrtf(wave_sum(q) * (1.f / DM) + LN_EPS);
#pragma unroll
    for (int j = 0; j < 4; ++j) { const f32x4 gg = *(const f32x4*)(g + 4 * lane + 256 * j), bb = *(const f32x4*)(b + 4 * lane + 256 * j); v[j] = v[j] * rstd * gg + bb; }
}
__host__ __device__ __forceinline__ int gu_phys(int other, int sel) { return (other >> 4) * 32 + sel * 16 + (other & 15); }
#define GAS __attribute__((address_space(1)))
#define LAS __attribute__((address_space(3)))
constexpr int NWAVES = 8, NTHR = NWAVES * 64;
constexpr int RING_BYTES = 131072, LDSCTL_OFF = RING_BYTES, MISC_OFF = LDSCTL_OFF + 320, LDS_BYTES = 147456;
constexpr int LDSX_OFF = RING_BYTES + 1024;
#define LDS_WAIT() asm volatile("s_waitcnt lgkmcnt(0)" ::: "memory")
#define VM_WAIT() asm volatile("s_waitcnt vmcnt(0)" ::: "memory")

struct Frame {
    unsigned char* lds;
    unsigned* ctl;
    int tid, lane, wave, G, bid;
};

template <int MODE>
__device__ __forceinline__ void p0_transpose_item(const float* W, int K, int N, bf16* WT, int row_off, float* scr, int item, int lane) {
    const int nblk = N / 32, kb = item / nblk, nb = item % nblk, k0 = 64 * kb, n0 = 32 * nb;
#pragma unroll 8
    for (int i = 0; i < 32; ++i) { const int kk = 2 * i + (lane >> 5); scr[kk * 33 + (lane & 31)] = W[(size_t)(k0 + kk) * N + n0 + (lane & 31)]; }
    LDS_WAIT(); asm volatile("" ::: "memory");
    const int c = lane & 7;
#pragma unroll
    for (int j = 0; j < 4; ++j) { const int n = (lane >> 3) + 8 * j; const float* s = scr + (8 * c) * 33 + n;
        u32x4 o; o.x = pk2(s[0 * 33], s[1 * 33]); o.y = pk2(s[2 * 33], s[3 * 33]); o.z = pk2(s[4 * 33], s[5 * 33]); o.w = pk2(s[6 * 33], s[7 * 33]);
        const int nl = n0 + n; const int pr = (MODE == 0) ? (row_off + nl) : (row_off + gu_phys(nl, MODE - 1));
        *(u32x4*)(WT + (size_t)pr * K + k0 + 8 * c) = o; }
    LDS_WAIT(); asm volatile("" ::: "memory");
}
__device__ __forceinline__ void phase_prologue(const Frame& F, const Prm& p) {
    float* sil = (float*)F.lds;
    for (int i = F.tid; i < 9 * 1024; i += NTHR) { const int r = i >> 10, k = i & 1023; const float v = (r < 8) ? p.c[r * 1024 + k] : p.cctx[k]; sil[i] = silu_f(v); }
    __syncthreads();
    float* MOD = (float*)(p.ws + WS_MOD);
    if (F.bid < 192) {
        const int layer = F.bid / 96, n = (F.bid % 96) * 64 + F.lane; const float* W = p.ada_w + (size_t)layer * 1024 * 6144 + n;
        float acc[9];
#pragma unroll
        for (int r = 0; r < 9; ++r) acc[r] = 0.f;
        const int kb = F.wave * 128;
#pragma unroll 4
        for (int k = kb; k < kb + 128; k += 4) {
            const float w0 = W[(size_t)k * 6144], w1 = W[(size_t)(k + 1) * 6144], w2 = W[(size_t)(k + 2) * 6144], w3 = W[(size_t)(k + 3) * 6144];
#pragma unroll
            for (int r = 0; r < 9; ++r) { const f32x4 s = *(const f32x4*)(sil + r * 1024 + k); acc[r] += s.x * w0 + s.y * w1 + s.z * w2 + s.w * w3; }
        }
        float* red = (float*)(F.lds + 36864 + 8 * 8704);
#pragma unroll
        for (int r = 0; r < 9; ++r) red[(F.wave * 9 + r) * 64 + F.lane] = acc[r];
        __syncthreads();
        if (F.wave == 0) { const float bb = p.ada_b[layer * 6144 + n];
#pragma unroll
            for (int r = 0; r < 9; ++r) { float t = bb;
#pragma unroll
                for (int w = 0; w < 8; ++w) t += red[(w * 9 + r) * 64 + F.lane];
                MOD[(layer * 9 + r) * 6144 + n] = t; } }
    }
    float* misc = (float*)(p.ws + WS_MISC);
    if (F.bid == 255 % F.G && F.wave == 1) {
        const float a = wave_sum(p.lam[F.lane] * p.lam[64 + F.lane]), b = wave_sum(p.lam[128 + F.lane] * p.lam[192 + F.lane]);
        if (F.lane == 0) misc[0] = __expf(a) - __expf(b) + LAMBDA_INIT0;
        for (int i = F.lane; i < 1024; i += 64) { const int pos = i >> 4, f = i & 15; const float inv = powf(10000.f, -(float)f / 16.f); const float ang = (float)pos * inv;
            misc[1024 + 2 * i] = cosf(ang); misc[1024 + 2 * i + 1] = sinf(ang); }
    }
    float* scr = (float*)(F.lds + 36864 + F.wave * 8704);
    const int gw = F.bid * NWAVES + F.wave, NGW = F.G * NWAVES;
    constexpr int I_QKV = 16 * 96, I_SQ = 16 * 32, I_G = 16 * 16, I_D = 8 * 32;
    constexpr int I_MOE = 2 * I_G + I_D;
    constexpr int NITEMS = 2 * I_QKV + 2 * I_SQ + 32 * I_MOE;
    bf16* ws16 = (bf16*)p.ws;
    for (int it = gw; it < NITEMS; it += NGW) {
        int r = it;
        if (r < I_QKV) { p0_transpose_item<0>(p.w_qkv, 1024, 3072, (bf16*)(p.ws + WS_WQKV), 0, scr, r, F.lane); continue; } r -= I_QKV;
        if (r < I_QKV) { p0_transpose_item<0>(p.gw_in, 1024, 3072, (bf16*)(p.ws + WS_WIN), 0, scr, r, F.lane); continue; } r -= I_QKV;
        if (r < I_SQ) { p0_transpose_item<0>(p.w_o, 1024, 1024, (bf16*)(p.ws + WS_WO), 0, scr, r, F.lane); continue; } r -= I_SQ;
        if (r < I_SQ) { p0_transpose_item<0>(p.gw_o, 1024, 1024, (bf16*)(p.ws + WS_WGO), 0, scr, r, F.lane); continue; } r -= I_SQ;
        const int le = r / I_MOE, layer = le >> 4, e = le & 15; r -= le * I_MOE;
        bf16* GU = (bf16*)(p.ws + (layer ? WS_GU1 : WS_GU0)) + (size_t)e * 1024 * 1024; bf16* DN = (bf16*)(p.ws + (layer ? WS_DN1 : WS_DN0)) + (size_t)e * 1024 * 512;
        if (r < I_G) { p0_transpose_item<1>(p.mg + (size_t)le * 1024 * 512, 1024, 512, GU, 0, scr, r, F.lane); continue; } r -= I_G;
        if (r < I_G) { p0_transpose_item<2>(p.mu + (size_t)le * 1024 * 512, 1024, 512, GU, 0, scr, r, F.lane); continue; } r -= I_G;
        p0_transpose_item<0>(p.md + (size_t)le * 512 * 1024, 512, 1024, DN, 0, scr, r, F.lane);
    }
    (void)ws16;
    bf16* WIN = (bf16*)(p.ws + WS_WIN);
    for (int i = gw * 64 + F.lane; i < 32 * 1024; i += NGW * 64) { const int rr = i >> 10, k = i & 1023, dir = rr >> 4, j = rr & 15;
        WIN[(size_t)(3072 + rr) * 1024 + k] = (bf16)f2bf(p.gwg_down[(size_t)dir * 1024 * 16 + k * 16 + j]); }
    for (int i = gw * 64 + F.lane; i < 224 * 1024 / 8; i += NGW * 64) *(u32x4*)(WIN + (size_t)3104 * 1024 + (size_t)i * 8) = (u32x4){0u, 0u, 0u, 0u};
}

__device__ __forceinline__ void phase_modulate0(const Frame& F, const Prm& p) {
    const float* MOD = (const float*)(p.ws + WS_MOD); bf16* H = (bf16*)(p.ws + WS_H);
    const int gw = F.bid * NWAVES + F.wave, NGW = F.G * NWAVES, per = (NTOK + NGW - 1) / NGW;
    int curmod = -1; f32x4 sh[4], sc[4];
    for (int tok = gw * per; tok < (gw + 1) * per && tok < NTOK; ++tok) {
        const int mr = tok < NLAT ? tok / SEQ : 8; const float* src = tok < NLAT ? p.x + (size_t)tok * DM : p.ctx + (size_t)(tok - NLAT) * DM;
        if (mr != curmod) { curmod = mr; ld_row_f32(MOD + mr * 6144, F.lane, sh); ld_row_f32(MOD + mr * 6144 + 1024, F.lane, sc); }
        f32x4 v[4]; ld_row_f32(src, F.lane, v);
#pragma unroll
        for (int j = 0; j < 4; ++j) v[j] = v[j] * (1.f + sc[j]) + sh[j];
        st_row_bf16(H + (size_t)tok * DM, F.lane, v);
    }
}

__device__ __forceinline__ void phase_attn_combine(const Frame& F, const Prm& p) {
    const bf16* O1 = (const bf16*)(p.ws + WS_O1); const bf16* O2 = (const bf16*)(p.ws + WS_O2); bf16* A2 = (bf16*)(p.ws + WS_A2);
    const float lam = ((const float*)(p.ws + WS_MISC))[0];
    const f32x4 sg = *(const f32x4*)(p.subln + 4 * (F.lane & 31));
    const int gw = F.bid * NWAVES + F.wave, NGW = F.G * NWAVES;
    for (int tok = gw; tok < NTOK; tok += NGW) {
        f32x4 a[4], b[4]; ld_row_bf16(O1 + (size_t)tok * DM, F.lane, a); ld_row_bf16(O2 + (size_t)tok * DM, F.lane, b);
#pragma unroll
        for (int j = 0; j < 4; ++j) {
            f32x4 o = a[j] - lam * b[j]; float q = (o.x * o.x + o.y * o.y) + (o.z * o.z + o.w * o.w);
#pragma unroll
            for (int s = 1; s < 32; s <<= 1) q += __shfl_xor(q, s);
            const float r = (1.f - LAMBDA_INIT0) / sqrtf(q * (1.f / 128.f) + LN_EPS);
            a[j] = o * r * sg;
        }
        st_row_bf16(A2 + (size_t)tok * DM, F.lane, a);
    }
}

__device__ __forceinline__ void phase_ln_route(const Frame& F, const Prm& p, int layer) {
    const int nrows = layer ? NLAT : NTOK;
    const float* MOD = (const float*)(p.ws + WS_MOD) + layer * 9 * 6144;
    const bf16* Y = (const bf16*)(p.ws + WS_Y); bf16* HF = (bf16*)(p.ws + WS_H);
    float* XCTX = (float*)(p.ws + WS_XCTX);
    int* LIST = (int*)(p.ws + WS_LIST); int* TOKR = (int*)(p.ws + WS_TOKR);
    unsigned* CNT = F.ctl + CW_CNT + layer * 16;
    float* WrT = (float*)F.lds;
    int* rec = (int*)(F.lds + 65536);
    unsigned* lcnt = (unsigned*)(F.lds + 65536 + 8192); unsigned* lbase = lcnt + 16;
    for (int i = F.tid; i < 16 * 1024; i += NTHR) { const int k = i >> 4, e = i & 15; WrT[e * 1024 + k] = p.rw[i]; }
    if (F.tid < 16) lcnt[F.tid] = 0u;
    __syncthreads();
    const int per_wg = (nrows + F.G - 1) / F.G, per_w = (per_wg + NWAVES - 1) / NWAVES;
    const int row_lo = F.bid * per_wg, row_hi = min(nrows, row_lo + per_wg);
    const float* lng = p.ln_g + (layer * 2 + 0) * DM; const float* lnb = p.ln_b + (layer * 2 + 0) * DM;
    float rb[16];
#pragma unroll
    for (int e = 0; e < 16; ++e) rb[e] = p.rb[e];
    int curmod = -1; f32x4 gm[4], shf[4], scf[4];
    for (int i = 0; i < per_w; ++i) {
        const int lr = F.wave * per_w + i, tok = row_lo + lr; if (tok >= row_hi) break;
        const int mr = tok < NLAT ? tok / SEQ : 8;
        if (mr != curmod) { curmod = mr; ld_row_f32(MOD + mr * 6144 + 2048, F.lane, gm); ld_row_f32(MOD + mr * 6144 + 3072, F.lane, shf); ld_row_f32(MOD + mr * 6144 + 4096, F.lane, scf); }
        float* xdst = tok < NLAT ? p.out + (size_t)tok * DM : XCTX + (size_t)(tok - NLAT) * DM;
        const float* xsrc = layer ? (const float*)xdst : (tok < NLAT ? p.x + (size_t)tok * DM : p.ctx + (size_t)(tok - NLAT) * DM);
        f32x4 v[4], y[4]; ld_row_f32(xsrc, F.lane, v); ld_row_bf16(Y + (size_t)tok * DM, F.lane, y);
#pragma unroll
        for (int j = 0; j < 4; ++j) v[j] = ALPHA * v[j] + gm[j] * y[j];
        ln_row(v, lng, lnb, F.lane);
        st_row_f32(xdst, F.lane, v);
#pragma unroll
        for (int j = 0; j < 4; ++j) v[j] = v[j] * (1.f + scf[j]) + shf[j];
        st_row_bf16(HF + (size_t)tok * DM, F.lane, v);
        float part[16];
#pragma unroll
        for (int e = 0; e < 16; ++e) { float s = 0.f;
#pragma unroll
            for (int j = 0; j < 4; ++j) { const f32x4 w = *(const f32x4*)(WrT + e * 1024 + 4 * F.lane + 256 * j); s += (v[j].x * w.x + v[j].y * w.y) + (v[j].z * w.z + v[j].w * w.w); }
            part[e] = s; }
        {
#pragma unroll
            for (int e = 0; e < 8; ++e) { const bool up = (F.lane & 32) != 0; const float keep = up ? part[e + 8] : part[e], send = up ? part[e] : part[e + 8]; part[e] = keep + __shfl_xor(send, 32); }
#pragma unroll
            for (int e = 0; e < 4; ++e) { const bool up = (F.lane & 16) != 0; const float keep = up ? part[e + 4] : part[e], send = up ? part[e] : part[e + 4]; part[e] = keep + __shfl_xor(send, 16); }
#pragma unroll
            for (int e = 0; e < 2; ++e) { const bool up = (F.lane & 8) != 0; const float keep = up ? part[e + 2] : part[e], send = up ? part[e] : part[e + 2]; part[e] = keep + __shfl_xor(send, 8); }
            { const bool up = (F.lane & 4) != 0; const float keep = up ? part[1] : part[0], send = up ? part[0] : part[1]; part[0] = keep + __shfl_xor(send, 4); }
            part[0] += __shfl_xor(part[0], 2); part[0] += __shfl_xor(part[0], 1);
        }
        float aff[16], sel[16];
#pragma unroll
        for (int e = 0; e < 16; ++e) { const int src = ((e >> 3) & 1) * 32 + ((e >> 2) & 1) * 16 + ((e >> 1) & 1) * 8 + (e & 1) * 4; const float lg = __shfl(part[0], src); aff[e] = 1.f / (1.f + __expf(-lg)); sel[e] = aff[e] + rb[e]; }
        int bg = 0; float bgs = -3.0e38f;
#pragma unroll
        for (int g = 0; g < 4; ++g) { float m1 = -3.0e38f, m2 = -3.0e38f;
#pragma unroll
            for (int k = 0; k < 4; ++k) { const float s = sel[4 * g + k]; if (s > m1) { m2 = m1; m1 = s; } else if (s > m2) m2 = s; }
            const float gs = m1 + m2; if (gs > bgs) { bgs = gs; bg = g; } }
        int i1 = 0, i2 = 0; float s1 = -3.0e38f, s2 = -3.0e38f, a1 = 0.f, a2 = 0.f;
#pragma unroll
        for (int g = 0; g < 4; ++g) if (g == bg) {
#pragma unroll
            for (int k = 0; k < 4; ++k) { const float s = sel[4 * g + k], a = aff[4 * g + k];
                if (s > s1) { s2 = s1; i2 = i1; a2 = a1; s1 = s; i1 = 4 * g + k; a1 = a; } else if (s > s2) { s2 = s; i2 = 4 * g + k; a2 = a; } } }
        const float wsum = a1 + a2, w1 = a1 / wsum, w2 = a2 / wsum;
        if (F.lane == 0) { const unsigned l1 = atomicAdd(&lcnt[i1], 1u), l2 = atomicAdd(&lcnt[i2], 1u);
            rec[lr * 6 + 0] = i1; rec[lr * 6 + 1] = i2; rec[lr * 6 + 2] = (int)l1; rec[lr * 6 + 3] = (int)l2; rec[lr * 6 + 4] = __float_as_int(w1); rec[lr * 6 + 5] = __float_as_int(w2); }
    }
    __syncthreads();
    if (F.tid < 16) lbase[F.tid] = __hip_atomic_fetch_add(&CNT[F.tid], lcnt[F.tid], __ATOMIC_RELAXED, __HIP_MEMORY_SCOPE_AGENT);
    __syncthreads();
    for (int lr = F.tid; lr < row_hi - row_lo; lr += NTHR) { const int tok = row_lo + lr;
        const int e0 = rec[lr * 6], e1 = rec[lr * 6 + 1]; const int p0 = (int)lbase[e0] + rec[lr * 6 + 2], p1 = (int)lbase[e1] + rec[lr * 6 + 3];
        LIST[e0 * NTOK + p0] = tok; LIST[e1 * NTOK + p1] = tok;
        int* tr = TOKR + (size_t)tok * 8; tr[0] = e0; tr[1] = p0; tr[2] = e1; tr[3] = p1; tr[4] = rec[lr * 6 + 4]; tr[5] = rec[lr * 6 + 5]; }
    __syncthreads();
}

__device__ __forceinline__ void pad_bases(const unsigned* cnt, int (&pb)[17]) {
    int acc = 0;
#pragma unroll
    for (int e = 0; e < 16; ++e) { pb[e] = acc; const int c = (int)__hip_atomic_load(cnt + e, __ATOMIC_RELAXED, __HIP_MEMORY_SCOPE_AGENT); acc += (c + 255) & ~255; }
    pb[16] = acc;
}

__device__ __forceinline__ void phase_moe_combine(const Frame& F, const Prm& p, int layer) {
    const int nrows = layer ? NLAT : NTOK;
    const float* MOD = (const float*)(p.ws + WS_MOD) + layer * 9 * 6144; const float* MOD1 = (const float*)(p.ws + WS_MOD) + 9 * 6144;
    const bf16* YM = (const bf16*)(p.ws + WS_YM); bf16* H = (bf16*)(p.ws + WS_H); float* XCTX = (float*)(p.ws + WS_XCTX); const int* TOKR = (const int*)(p.ws + WS_TOKR);
    int pb[17]; pad_bases(F.ctl + CW_CNT + layer * 16, pb);
    int* pbl = (int*)F.lds; if (F.tid < 17) { int v = 0;
#pragma unroll
        for (int e = 0; e < 17; ++e) if (e == F.tid) v = pb[e];
        pbl[F.tid] = v; }
    __syncthreads();
    const float* lng = p.ln_g + (layer * 2 + 1) * DM; const float* lnb = p.ln_b + (layer * 2 + 1) * DM;
    const int gw = F.bid * NWAVES + F.wave, NGW = F.G * NWAVES, per = (nrows + NGW - 1) / NGW;
    int curmod = -1; f32x4 gf[4], sh1[4], sc1[4];
    for (int tok = gw * per; tok < (gw + 1) * per && tok < nrows; ++tok) {
        const int mr = tok < NLAT ? tok / SEQ : 8;
        if (mr != curmod) { curmod = mr; ld_row_f32(MOD + mr * 6144 + 5120, F.lane, gf); if (!layer) { ld_row_f32(MOD1 + mr * 6144, F.lane, sh1); ld_row_f32(MOD1 + mr * 6144 + 1024, F.lane, sc1); } }
        const int* tr = TOKR + (size_t)tok * 8; const int s0 = pbl[tr[0]] + tr[1], s1 = pbl[tr[2]] + tr[3]; const float w0 = __int_as_float(tr[4]), w1 = __int_as_float(tr[5]);
        float* xp = tok < NLAT ? p.out + (size_t)tok * DM : XCTX + (size_t)(tok - NLAT) * DM;
        f32x4 v[4], a[4], b[4]; ld_row_f32(xp, F.lane, v); ld_row_bf16(YM + (size_t)s0 * DM, F.lane, a); ld_row_bf16(YM + (size_t)s1 * DM, F.lane, b);
#pragma unroll
        for (int j = 0; j < 4; ++j) v[j] = ALPHA * v[j] + gf[j] * (w0 * a[j] + w1 * b[j]);
        ln_row(v, lng, lnb, F.lane);
        st_row_f32(xp, F.lane, v);
        if (!layer) {
#pragma unroll
            for (int j = 0; j < 4; ++j) v[j] = v[j] * (1.f + sc1[j]) + sh1[j];
            st_row_bf16(H + (size_t)tok * DM, F.lane, v);
        }
    }
}

__device__ __forceinline__ void phase_gla_prep(const Frame& F, const Prm& p) {
    const bf16* QR = (const bf16*)(p.ws + WS_QR); const bf16* KR = (const bf16*)(p.ws + WS_KR); const float* ZZ = (const float*)(p.ws + WS_ZZ);
    bf16* QT = (bf16*)(p.ws + WS_QT); bf16* KT = (bf16*)(p.ws + WS_KT); float* DEC = (float*)(p.ws + WS_DEC);
    const int gw = F.bid * NWAVES + F.wave, NGW = F.G * NWAVES;
    for (int task = gw; task < 2 * NCHUNK * 8; task += NGW) {
        const int dh = task & 7, chunk = (task >> 3) % NCHUNK, dir = __builtin_amdgcn_readfirstlane(task / (8 * NCHUNK));
        const int col = dh * 64 + F.lane, tok0 = chunk * 64;
        unsigned short qv[64], kv[64];
#pragma unroll
        for (int t = 0; t < 64; ++t) { qv[t] = QR[(size_t)(tok0 + t) * 512 + col]; kv[t] = KR[(size_t)(tok0 + t) * 512 + col]; }
        f32x4 zl[4];
#pragma unroll
        for (int j = 0; j < 4; ++j) zl[j] = *(const f32x4*)(ZZ + (size_t)(tok0 + F.lane) * 32 + dir * 16 + 4 * j);
        float wup[16];
#pragma unroll
        for (int j = 0; j < 16; ++j) wup[j] = p.gwg_up[(size_t)dir * 16 * 512 + j * 512 + col];
        const float bgv = p.gbg[dir * 512 + col];
        float b = 0.f;
        bf16* qo = QT + ((size_t)dir * NTOK + tok0) * 512 + col; bf16* ko = KT + ((size_t)dir * NTOK + tok0) * 512 + col;
#pragma unroll
        for (int tt = 0; tt < 64; ++tt) {
            float z = bgv;
#pragma unroll
            for (int j = 0; j < 4; ++j) { const int tl = dir ? 63 - tt : tt;
                const float z0 = __int_as_float(__builtin_amdgcn_readlane(__float_as_int(zl[j].x), tl)), z1 = __int_as_float(__builtin_amdgcn_readlane(__float_as_int(zl[j].y), tl));
                const float z2 = __int_as_float(__builtin_amdgcn_readlane(__float_as_int(zl[j].z), tl)), z3 = __int_as_float(__builtin_amdgcn_readlane(__float_as_int(zl[j].w), tl));
                z += z0 * wup[4 * j] + z1 * wup[4 * j + 1] + z2 * wup[4 * j + 2] + z3 * wup[4 * j + 3]; }
            const float g = (fminf(z, 0.f) - __logf(1.f + __expf(-fabsf(z)))) * (1.f / 16.f);
            b += g;
            const float e = __expf(b), ei = __builtin_amdgcn_rcpf(e);
            const float q = dir ? bf2f(qv[63 - tt]) : bf2f(qv[tt]), k = dir ? bf2f(kv[63 - tt]) : bf2f(kv[tt]);
            const int t = dir ? 63 - tt : tt;
            qo[(size_t)t * 512] = (bf16)f2bf(q * e); ko[(size_t)t * 512] = (bf16)f2bf(k * ei);
        }
        DEC[((size_t)dir * NCHUNK + chunk) * 512 + col] = __expf(b);
    }
}

__device__ __forceinline__ void phase_gla_post(const Frame& F, const Prm& p) {
    const bf16* OF = (const bf16*)(p.ws + WS_OGF); const bf16* OB = (const bf16*)(p.ws + WS_OGB); const bf16* R = (const bf16*)(p.ws + WS_R); bf16* A2 = (bf16*)(p.ws + WS_A2B);
    const f32x4 ng = *(const f32x4*)(p.gnorm + 4 * F.lane);
    const int gw = F.bid * NWAVES + F.wave, NGW = F.G * NWAVES;
    for (int tok = gw; tok < NLAT; tok += NGW) {
        f32x4 a[4], b[4], r[4]; ld_row_bf16(OF + (size_t)tok * DM, F.lane, a); ld_row_bf16(OB + (size_t)tok * DM, F.lane, b); ld_row_bf16(R + (size_t)tok * DM, F.lane, r);
#pragma unroll
        for (int j = 0; j < 4; ++j) {
            const f32x4 o = a[j] + b[j]; const float q = wave_sum((o.x * o.x + o.y * o.y) + (o.z * o.z + o.w * o.w));
            const float rs = 1.f / sqrtf(q * (1.f / 256.f) + LN_EPS);
            a[j] = (f32x4){o.x * rs * ng.x * silu_f(r[j].x), o.y * rs * ng.y * silu_f(r[j].y), o.z * rs * ng.z * silu_f(r[j].z), o.w * rs * ng.w * silu_f(r[j].w)};
        }
        st_row_bf16(A2 + (size_t)tok * DM, F.lane, a);
    }
}
namespace naive {
enum { EPI_QKV = 0, EPI_PLAIN = 1, EPI_GATEUP = 2, EPI_DOWN = 3, EPI_INPROJ = 4 };
struct NG { const bf16* A; const bf16* Bt; int M, N, K; int layer; bf16* O; };
template <int EPI> __global__ __launch_bounds__(256) void gemm_kernel(NG g, Prm p) {
    __shared__ float As[64][33], Bs[64][33], Cs[64][65]; __shared__ int rowsrc[64];
    const int tid = threadIdx.x, n0 = blockIdx.x * 64, m0 = blockIdx.y * 64, ty = tid >> 4, tx = tid & 15;
    const bf16* Bt = g.Bt; int e = 0, ebase = 0, ecnt = 0;
    if (EPI == EPI_GATEUP || EPI == EPI_DOWN) {
        const unsigned* cnt = (const unsigned*)(p.ws + WS_CTL) + CW_CNT + g.layer * 16; int acc = 0; bool found = false;
        for (int i = 0; i < 16; ++i) { const int c = (int)cnt[i], pc = (c + 255) & ~255; if (!found && m0 < acc + pc) { e = i; ebase = acc; ecnt = c; found = true; } acc += pc; }
        if (!found || m0 - ebase >= ecnt) return;
        Bt += (size_t)e * g.N * g.K;
    }
    if (tid < 64) { int r = m0 + tid;
        if (EPI == EPI_GATEUP) { const int li = m0 - ebase + tid; const int* LIST = (const int*)(p.ws + WS_LIST); r = (li < ecnt) ? LIST[e * NTOK + li] : 0; }
        rowsrc[tid] = r; }
    __syncthreads();
    float acc[4][4] = {};
    for (int k0 = 0; k0 < g.K; k0 += 32) {
        { const int r = tid >> 2, kc = (tid & 3) * 8; const u32x4 ua = *(const u32x4*)(g.A + (size_t)rowsrc[r] * g.K + k0 + kc), ub = *(const u32x4*)(Bt + (size_t)(n0 + r) * g.K + k0 + kc);
            const unsigned a4[4] = {ua.x, ua.y, ua.z, ua.w}, b4[4] = {ub.x, ub.y, ub.z, ub.w};
#pragma unroll
            for (int i = 0; i < 4; ++i) { As[r][kc + 2 * i] = bf2f(a4[i] & 0xffffu); As[r][kc + 2 * i + 1] = bf2f(a4[i] >> 16); Bs[r][kc + 2 * i] = bf2f(b4[i] & 0xffffu); Bs[r][kc + 2 * i + 1] = bf2f(b4[i] >> 16); } }
        __syncthreads();
#pragma unroll 8
        for (int kk = 0; kk < 32; ++kk) { float a[4], b[4];
#pragma unroll
            for (int i = 0; i < 4; ++i) { a[i] = As[4 * ty + i][kk]; b[i] = Bs[4 * tx + i][kk]; }
#pragma unroll
            for (int i = 0; i < 4; ++i)
#pragma unroll
                for (int j = 0; j < 4; ++j) acc[i][j] += a[i] * b[j]; }
        __syncthreads();
    }
#pragma unroll
    for (int i = 0; i < 4; ++i)
#pragma unroll
        for (int j = 0; j < 4; ++j) Cs[4 * ty + i][4 * tx + j] = acc[i][j];
    __syncthreads();
    const float* rope = (const float*)(p.ws + WS_MISC) + 1024;
    for (int idx = tid; idx < 4096; idx += 256) {
        const int r = idx >> 6, cc = idx & 63, n = n0 + cc, row = m0 + r; const float val = Cs[r][cc];
        if (EPI == EPI_QKV) {
            if (n < 2048) { float o = val;
                if (row < NLAT) { const int d = n & 63, s = row & (SEQ - 1), pos = (d & 32) ? (s & 63) : (s >> 6), f = d & 15; const float cs = rope[(pos * 16 + f) * 2], sn = rope[(pos * 16 + f) * 2 + 1];
                    o = (d & 16) ? val * cs + Cs[r][cc - 16] * sn : val * cs - Cs[r][cc + 16] * sn; }
                if (n < 1024) ((bf16*)(p.ws + WS_Q))[(size_t)row * DM + n] = (bf16)f2bf(o * C2); else ((bf16*)(p.ws + WS_K))[(size_t)row * DM + n - 1024] = (bf16)f2bf(o);
            } else ((bf16*)(p.ws + WS_V))[(size_t)row * DM + n - 2048] = (bf16)f2bf(val);
        } else if (EPI == EPI_PLAIN) { g.O[(size_t)row * g.N + n] = (bf16)f2bf(val);
        } else if (EPI == EPI_GATEUP) { if (!(cc & 16)) { const float gt = val, up = Cs[r][cc + 16]; const int other = (n >> 5) * 16 + (n & 15); ((bf16*)(p.ws + WS_ACT))[(size_t)row * DEXP + other] = (bf16)f2bf(silu_f(gt) * up); }
        } else if (EPI == EPI_DOWN) { ((bf16*)(p.ws + WS_YM))[(size_t)row * DM + n] = (bf16)f2bf(val);
        } else if (EPI == EPI_INPROJ) {
            if (n < 512) ((bf16*)(p.ws + WS_QR))[(size_t)row * 512 + n] = (bf16)f2bf(val * 0.08838834764831845f);
            else if (n < 1024) ((bf16*)(p.ws + WS_KR))[(size_t)row * 512 + n - 512] = (bf16)f2bf(val);
            else if (n < 2048) ((bf16*)(p.ws + WS_V1))[(size_t)row * DM + n - 1024] = (bf16)f2bf(val);
            else if (n < 3072) ((bf16*)(p.ws + WS_R))[(size_t)row * DM + n - 2048] = (bf16)f2bf(val);
            else if (n < 3104) ((float*)(p.ws + WS_ZZ))[(size_t)row * 32 + n - 3072] = val;
        }
    }
}
__global__ __launch_bounds__(256) void attn_kernel(Prm p) {
    __shared__ float Qs[64][65], Ks[32][65], Ps[64][33], Vs[32][129], al[64];
    const bf16* Q = (const bf16*)(p.ws + WS_Q); const bf16* K = (const bf16*)(p.ws + WS_K); const bf16* V = (const bf16*)(p.ws + WS_V);
    const int tid = threadIdx.x, ty = tid >> 4, tx = tid & 15, qb = blockIdx.x, hm = blockIdx.y, h = hm >> 1;
    const bool lat = qb < 512; const int b = lat ? qb >> 6 : (qb - 512) >> 2; const int tok0 = lat ? qb * 64 : NLAT + (qb - 512) * 64;
    bf16* O = (bf16*)(p.ws + ((hm & 1) ? WS_O2 : WS_O1));
    for (int i = tid; i < 4096; i += 256) { const int r = i >> 6, d = i & 63; Qs[r][d] = bf2f(Q[(size_t)(tok0 + r) * DM + hm * 64 + d]); }
    float o[4][8] = {}; float mrow = -3.0e38f, lrow = 0.f;
    const int nkt = lat ? (CTXL + SEQ) / 32 : CTXL / 32;
    for (int kt = 0; kt < nkt; ++kt) {
        const int key0 = (kt < CTXL / 32) ? NLAT + b * CTXL + kt * 32 : b * SEQ + (kt - CTXL / 32) * 32;
        __syncthreads();
        for (int i = tid; i < 2048; i += 256) { const int r = i >> 6, d = i & 63; Ks[r][d] = bf2f(K[(size_t)(key0 + r) * DM + hm * 64 + d]); }
        for (int i = tid; i < 4096; i += 256) { const int r = i >> 7, d = i & 127; Vs[r][d] = bf2f(V[(size_t)(key0 + r) * DM + h * 128 + d]); }
        __syncthreads();
        float s[4][2] = {};
        for (int d = 0; d < 64; ++d) { float a[4], bb[2];
#pragma unroll
            for (int i = 0; i < 4; ++i) a[i] = Qs[4 * ty + i][d];
            bb[0] = Ks[2 * tx][d]; bb[1] = Ks[2 * tx + 1][d];
#pragma unroll
            for (int i = 0; i < 4; ++i) { s[i][0] += a[i] * bb[0]; s[i][1] += a[i] * bb[1]; } }
#pragma unroll
        for (int i = 0; i < 4; ++i) { Ps[4 * ty + i][2 * tx] = s[i][0]; Ps[4 * ty + i][2 * tx + 1] = s[i][1]; }
        __syncthreads();
        if (tid < 64) { float mx = mrow;
            for (int j = 0; j < 32; ++j) mx = fmaxf(mx, Ps[tid][j]);
            const float a = exp2f(mrow - mx); float sum = 0.f;
            for (int j = 0; j < 32; ++j) { const float e = exp2f(Ps[tid][j] - mx); Ps[tid][j] = e; sum += e; }
            lrow = lrow * a + sum; mrow = mx; al[tid] = a; }
        __syncthreads();
#pragma unroll
        for (int i = 0; i < 4; ++i) { const float a = al[4 * ty + i];
#pragma unroll
            for (int j = 0; j < 8; ++j) o[i][j] *= a; }
        for (int kk = 0; kk < 32; ++kk) { float pv[4], vv[8];
#pragma unroll
            for (int i = 0; i < 4; ++i) pv[i] = Ps[4 * ty + i][kk];
#pragma unroll
            for (int j = 0; j < 8; ++j) vv[j] = Vs[kk][8 * tx + j];
#pragma unroll
            for (int i = 0; i < 4; ++i)
#pragma unroll
                for (int j = 0; j < 8; ++j) o[i][j] += pv[i] * vv[j]; }
    }
    __syncthreads();
    if (tid < 64) al[tid] = 1.f / lrow;
    __syncthreads();
#pragma unroll
    for (int i = 0; i < 4; ++i) { const float a = al[4 * ty + i];
#pragma unroll
        for (int j = 0; j < 8; ++j) O[(size_t)(tok0 + 4 * ty + i) * DM + h * 128 + 8 * tx + j] = (bf16)f2bf(o[i][j] * a); }
}
__global__ __launch_bounds__(256) void gla_scan_kernel(Prm p) {
    extern __shared__ __attribute__((aligned(16))) unsigned char sm[];
    float (*S)[33] = (float (*)[33])sm;
    float (*Qs)[129] = (float (*)[129])(sm + 128 * 33 * 4);
    float (*Ks)[129] = (float (*)[129])(sm + 128 * 33 * 4 + 64 * 129 * 4);
    float (*Vs)[33] = (float (*)[33])(sm + 128 * 33 * 4 + 2 * 64 * 129 * 4);
    float (*Ps)[65] = (float (*)[65])(sm + 128 * 33 * 4 + 2 * 64 * 129 * 4 + 64 * 33 * 4);
    float* dec = (float*)(sm + 128 * 33 * 4 + 2 * 64 * 129 * 4 + 64 * 33 * 4 + 64 * 65 * 4);
    const bf16* QT = (const bf16*)(p.ws + WS_QT); const bf16* KT = (const bf16*)(p.ws + WS_KT); const bf16* V = (const bf16*)(p.ws + WS_V1); const float* DEC = (const float*)(p.ws + WS_DEC);
    const int tid = threadIdx.x, ty = tid >> 4, tx = tid & 15, vs = blockIdx.x & 7, dir = (blockIdx.x >> 3) & 1, h = (blockIdx.x >> 4) & 3, b = blockIdx.x >> 6;
    bf16* OG = (bf16*)(p.ws + (dir ? WS_OGB : WS_OGF));
    for (int i = tid; i < 128 * 32; i += 256) S[i >> 5][i & 31] = 0.f;
    for (int step = 0; step < 68; ++step) {
        const bool lat = step >= 4; const int ci = lat ? step - 4 : step;
        const int chunk = lat ? b * 64 + (dir ? 63 - ci : ci) : 512 + b * 4 + (dir ? 3 - ci : ci); const int tok0 = chunk * 64;
        __syncthreads();
        for (int i = tid; i < 64 * 128; i += 256) { const int t = i >> 7, d = i & 127; const size_t off = ((size_t)dir * NTOK + tok0 + t) * 512 + h * 128 + d; Qs[t][d] = bf2f(QT[off]); Ks[t][d] = bf2f(KT[off]); }
        for (int i = tid; i < 64 * 32; i += 256) { const int t = i >> 5, v = i & 31; Vs[t][v] = bf2f(V[(size_t)(tok0 + t) * DM + h * 256 + vs * 32 + v]); }
        if (tid < 128) dec[tid] = DEC[((size_t)dir * NCHUNK + chunk) * 512 + h * 128 + tid];
        __syncthreads();
        if (lat) {
            float s[4][4] = {};
            for (int d = 0; d < 128; ++d) { float a[4], bb[4];
#pragma unroll
                for (int i = 0; i < 4; ++i) { a[i] = Qs[4 * ty + i][d]; bb[i] = Ks[4 * tx + i][d]; }
#pragma unroll
                for (int i = 0; i < 4; ++i)
#pragma unroll
                    for (int j = 0; j < 4; ++j) s[i][j] += a[i] * bb[j]; }
#pragma unroll
            for (int i = 0; i < 4; ++i)
#pragma unroll
                for (int j = 0; j < 4; ++j) { const int t = 4 * ty + i, sidx = 4 * tx + j; const bool keep = dir ? (sidx >= t) : (sidx <= t); Ps[t][sidx] = keep ? s[i][j] : 0.f; }
            __syncthreads();
            float o[4][2] = {};
            for (int sidx = 0; sidx < 64; ++sidx) { const float v0 = Vs[sidx][2 * tx], v1 = Vs[sidx][2 * tx + 1];
#pragma unroll
                for (int i = 0; i < 4; ++i) { const float pp = Ps[4 * ty + i][sidx]; o[i][0] += pp * v0; o[i][1] += pp * v1; } }
            for (int d = 0; d < 128; ++d) { const float s0 = S[d][2 * tx], s1 = S[d][2 * tx + 1];
#pragma unroll
                for (int i = 0; i < 4; ++i) { const float qq = Qs[4 * ty + i][d]; o[i][0] += qq * s0; o[i][1] += qq * s1; } }
#pragma unroll
            for (int i = 0; i < 4; ++i) { const size_t off = (size_t)(tok0 + 4 * ty + i) * DM + h * 256 + vs * 32 + 2 * tx; OG[off] = (bf16)f2bf(o[i][0]); OG[off + 1] = (bf16)f2bf(o[i][1]); }
            __syncthreads();
        }
        float u[8][2] = {};
        for (int sidx = 0; sidx < 64; ++sidx) { const float v0 = Vs[sidx][2 * tx], v1 = Vs[sidx][2 * tx + 1];
#pragma unroll
            for (int i = 0; i < 8; ++i) { const float kk = Ks[sidx][8 * ty + i]; u[i][0] += kk * v0; u[i][1] += kk * v1; } }
#pragma unroll
        for (int i = 0; i < 8; ++i) { const int d = 8 * ty + i; S[d][2 * tx] = dec[d] * (S[d][2 * tx] + u[i][0]); S[d][2 * tx + 1] = dec[d] * (S[d][2 * tx + 1] + u[i][1]); }
    }
}
constexpr int GLA_SCAN_LDS = 128 * 33 * 4 + 2 * 64 * 129 * 4 + 64 * 33 * 4 + 64 * 65 * 4 + 512;
}
namespace pg8 {
typedef short bf16x8 __attribute__((ext_vector_type(8)));
constexpr int BM = 256, BK = 64, HALF = 128, HTB = HALF * BK * 2, STAGE_BYTES = 8 * HTB, NXCD = 8, WGM = 8;
__host__ __device__ __forceinline__ int lds_byte(int r, int c) { const int st = (r >> 4) * 2 + (c >> 5), rr = r & 15, cc = c & 31, ob = rr * 64 + cc * 2; return st * 1024 + (ob ^ (((ob >> 9) & 1) << 5)); }
__host__ __device__ __forceinline__ void stage_rc(int b, int& R, int& C) { const int st = b / 1024, sb = b % 1024, swz = sb ^ (((sb >> 9) & 1) << 5); R = (st >> 1) * 16 + swz / 64; C = (st & 1) * 32 + (swz % 64) / 2; }
typedef float f32x2_t __attribute__((ext_vector_type(2))); typedef __bf16 bf16x2_t __attribute__((ext_vector_type(2)));
__device__ __forceinline__ unsigned cvt_pk_bf16(float lo, float hi) { f32x2_t v = {lo, hi}; bf16x2_t b = __builtin_convertvector(v, bf16x2_t); return __builtin_bit_cast(unsigned, b); }

struct Unit { int pm, pn; int row0; int e; int cnt; const bf16* Bt; };

struct DenseOrder {
    int nM, nN, nwg, G, c, K; const bf16* Bt;
    __device__ void init(int M, int N, int K_, const bf16* Bt_, int G_, int c_) { nM = M / BM; nN = N / BM; nwg = nM * nN; G = G_; c = c_; K = K_; Bt = Bt_; }
    __device__ bool next(int i, Unit& u) const {
        const long L = (long)i * G + c; if (L >= nwg) return false;
        int wgid = (int)L; { const int q = nwg / NXCD, r = nwg % NXCD, xcd = wgid % NXCD, off = wgid / NXCD; wgid = (xcd < r ? xcd * (q + 1) : r * (q + 1) + (xcd - r) * q) + off; }
        const int nig = WGM * nN, gid = wgid / nig, fm = gid * WGM, gsz = (nM - fm) < WGM ? (nM - fm) : WGM;
        u.pm = fm + ((wgid % nig) % gsz); u.pn = (wgid % nig) / gsz; u.row0 = u.pm * BM; u.e = 0; u.cnt = 0; u.Bt = Bt; return true;
    }
    __device__ __forceinline__ unsigned arow(const Unit& u, int r) const { return (unsigned)(u.row0 + r) * (unsigned)(K * 2); }
};
template <bool GATHER> struct MoeOrder {
    int cnt[16]; int nN, G, c, K; const bf16* Bt0; size_t bstride; const int* LIST;
    __device__ void init(const unsigned* cntw, int N, int K_, const bf16* Bt0_, const int* LIST_, int G_, int c_) {
#pragma unroll
        for (int e = 0; e < 16; ++e) cnt[e] = (int)__hip_atomic_load(cntw + e, __ATOMIC_RELAXED, __HIP_MEMORY_SCOPE_AGENT);
        nN = N / BM; G = G_; c = c_; K = K_; Bt0 = Bt0_; bstride = (size_t)N * K_; LIST = LIST_; }
    __device__ bool next(int i, Unit& u) const {
        int L = i * G + c, base = 0; bool found = false; u.pm = 0; u.pn = 0; u.row0 = 0; u.e = 0; u.cnt = 0; u.Bt = Bt0;
#pragma unroll
        for (int e = 0; e < 16; ++e) { const int mt = (cnt[e] + 255) >> 8, nu = mt * nN;
            if (!found) { if (L < nu) { found = true; u.e = e; u.cnt = cnt[e]; u.pm = L / nN; u.pn = L % nN; u.row0 = base + u.pm * BM; u.Bt = Bt0 + (size_t)e * bstride; } else { L -= nu; base += mt * BM; } } }
        return found;
    }
    __device__ __forceinline__ unsigned arow(const Unit& u, int r) const {
        if (GATHER) { const int li = u.pm * BM + r; int tok = 0; if (li < u.cnt) tok = LIST[u.e * NTOK + li];
            return (unsigned)tok * (unsigned)(K * 2); }
        return (unsigned)(u.row0 + r) * (unsigned)(K * 2);
    }
};

typedef f32x4 Acc[2][2][4][2];
__device__ __forceinline__ void st4bf(bf16* p, f32x4 v) { u32x2 w; w.x = cvt_pk_bf16(v.x, v.y); w.y = cvt_pk_bf16(v.z, v.w); *(u32x2*)p = w; }

struct EpiQKV {
    bf16 *Q; const float* rope;
    __device__ __forceinline__ void operator()(const Acc& acc, const Unit& u, int wr, int wc, int fr, int fq) const {
        const int reg = u.pn >> 2, cbase = (u.pn & 3) * BM + wc * 32 + 4 * fq; bf16* O = Q + (size_t)reg * ((WS_K - WS_Q) / 2);
        const bool dorope = (reg < 2) && (u.row0 < NLAT); const float sc = reg == 0 ? C2 : 1.f;
#pragma unroll
        for (int ai = 0; ai < 2; ++ai)
#pragma unroll
            for (int m = 0; m < 4; ++m) { const int row = u.row0 + ai * HALF + wr * 64 + m * 16 + fr; bf16* rowp = O + (size_t)row * DM + cbase;
                f32x4 cs = {1.f, 1.f, 1.f, 1.f}, sn = {0.f, 0.f, 0.f, 0.f};
                if (dorope) { const int s = row & (SEQ - 1), pos = (wc & 1) ? (s & 63) : (s >> 6); const f32x4 t0 = *(const f32x4*)(rope + (pos * 16 + 4 * fq) * 2), t1 = *(const f32x4*)(rope + (pos * 16 + 4 * fq) * 2 + 4);
                    cs = (f32x4){t0.x, t0.z, t1.x, t1.z}; sn = (f32x4){t0.y, t0.w, t1.y, t1.w}; }
#pragma unroll
                for (int bj = 0; bj < 2; ++bj) { const f32x4 a0 = acc[ai][bj][m][0], a1 = acc[ai][bj][m][1];
                    st4bf(rowp + bj * HALF, (a0 * cs - a1 * sn) * sc); st4bf(rowp + bj * HALF + 16, (a1 * cs + a0 * sn) * sc); } }
    }
};
struct EpiPlain {
    bf16* O;
    __device__ __forceinline__ void operator()(const Acc& acc, const Unit& u, int wr, int wc, int fr, int fq) const {
        const int cbase = u.pn * BM + wc * 32 + 4 * fq;
#pragma unroll
        for (int ai = 0; ai < 2; ++ai)
#pragma unroll
            for (int m = 0; m < 4; ++m) { bf16* rowp = O + (size_t)(u.row0 + ai * HALF + wr * 64 + m * 16 + fr) * DM + cbase;
#pragma unroll
                for (int bj = 0; bj < 2; ++bj)
#pragma unroll
                    for (int n = 0; n < 2; ++n) st4bf(rowp + bj * HALF + n * 16, acc[ai][bj][m][n]); }
    }
};
struct EpiInproj {
    bf16 *QR, *KR, *V, *R; float* ZZ;
    __device__ __forceinline__ void operator()(const Acc& acc, const Unit& u, int wr, int wc, int fr, int fq) const {
        const int pn = u.pn;
        if (pn == 12) { if (wc == 0) {
#pragma unroll
            for (int ai = 0; ai < 2; ++ai)
#pragma unroll
                for (int m = 0; m < 4; ++m) { float* rowp = ZZ + (size_t)(u.row0 + ai * HALF + wr * 64 + m * 16 + fr) * 32 + 4 * fq;
                    *(f32x4*)rowp = acc[ai][0][m][0]; *(f32x4*)(rowp + 16) = acc[ai][0][m][1]; } }
            return; }
        bf16* O; int ld, c0; float sc = 1.f;
        if (pn < 2) { O = QR; ld = 512; c0 = pn * BM; sc = 0.08838834764831845f; } else if (pn < 4) { O = KR; ld = 512; c0 = (pn - 2) * BM; } else if (pn < 8) { O = V; ld = DM; c0 = (pn - 4) * BM; } else { O = R; ld = DM; c0 = (pn - 8) * BM; }
        const int cbase = c0 + wc * 32 + 4 * fq;
#pragma unroll
        for (int ai = 0; ai < 2; ++ai)
#pragma unroll
            for (int m = 0; m < 4; ++m) { bf16* rowp = O + (size_t)(u.row0 + ai * HALF + wr * 64 + m * 16 + fr) * ld + cbase;
#pragma unroll
                for (int bj = 0; bj < 2; ++bj)
#pragma unroll
                    for (int n = 0; n < 2; ++n) st4bf(rowp + bj * HALF + n * 16, acc[ai][bj][m][n] * sc); }
    }
};
struct EpiGateUp {
    bf16* ACT;
    __device__ __forceinline__ void operator()(const Acc& acc, const Unit& u, int wr, int wc, int fr, int fq) const {
        const int obase = (u.pn * BM + wc * 32) / 2 + 4 * fq;
#pragma unroll
        for (int ai = 0; ai < 2; ++ai)
#pragma unroll
            for (int m = 0; m < 4; ++m) { bf16* rowp = ACT + (size_t)(u.row0 + ai * HALF + wr * 64 + m * 16 + fr) * DEXP + obase;
#pragma unroll
                for (int bj = 0; bj < 2; ++bj) { const f32x4 g = acc[ai][bj][m][0], up = acc[ai][bj][m][1]; f32x4 o;
#pragma unroll
                    for (int j = 0; j < 4; ++j) o[j] = g[j] * __builtin_amdgcn_rcpf(1.f + __expf(-g[j])) * up[j];
                    st4bf(rowp + bj * (HALF / 2), o); } }
    }
};

template <class Epi, class Sched>
__device__ __forceinline__ void gemm_phase(unsigned char* ldsg, const bf16* A, int K, const Sched& S, const Epi& E) {
    LAS unsigned char* lds = (LAS unsigned char*)ldsg;
    const int tid = threadIdx.x, wid = __builtin_amdgcn_readfirstlane(tid >> 6), lane = tid & 63, wr = wid >> 2, wc = wid & 3, fr = lane & 15, fq = lane >> 4;
    const int nt = K / BK;
    int Rr[2]; unsigned colb[2], voffB[2];
#pragma unroll
    for (int i = 0; i < 2; ++i) { int R, C; stage_rc(tid * 16 + i * 8192, R, C); Rr[i] = R; colb[i] = (unsigned)C * 2u; voffB[i] = (unsigned)(R * K + C) * 2u; }
    const size_t kstep = (size_t)(BK * 2);
    const size_t hstep = (size_t)HALF * K * 2;
    const size_t tstep = 2 * hstep;
    const unsigned ldsw = (unsigned)wid * 1024u;
    const int aoff = lds_byte(wr * 64 + fr, fq * 8), boff = lds_byte(wc * 32 + fr, fq * 8);
#define PG8_SA(b, h) (((b) * 2 + (h)) * HTB)
#define PG8_SB(b, h) ((4 + (b) * 2 + (h)) * HTB)
#define PG8_STAGE(bufoff, gbase, voff) do { _Pragma("unroll") for (int _i = 0; _i < 2; ++_i) \
        __builtin_amdgcn_global_load_lds((const unsigned*)((const char*)(gbase) + (voff)[_i]), (LAS unsigned*)(lds + (bufoff) + ldsw + _i * 8192), 16, 0, 0); } while (0)
#define PG8_LDA(dst, b, h) do { _Pragma("unroll") for (int m = 0; m < 4; ++m) _Pragma("unroll") for (int k = 0; k < 2; ++k) dst[m][k] = *(const LAS bf16x8*)(lds + PG8_SA(b, h) + aoff + m * 2048 + k * 1024); } while (0)
#define PG8_LDB(dst, b, h) do { _Pragma("unroll") for (int n = 0; n < 2; ++n) _Pragma("unroll") for (int k = 0; k < 2; ++k) dst[n][k] = *(const LAS bf16x8*)(lds + PG8_SB(b, h) + boff + n * 2048 + k * 1024); } while (0)
#define PG8_MMA(ai, bj, At, Bt) do { __builtin_amdgcn_s_setprio(1); _Pragma("unroll") for (int m = 0; m < 4; ++m) _Pragma("unroll") for (int n = 0; n < 2; ++n) _Pragma("unroll") for (int k = 0; k < 2; ++k) \
        acc[ai][bj][m][n] = __builtin_amdgcn_mfma_f32_16x16x32_bf16(Bt[n][k], At[m][k], acc[ai][bj][m][n], 0, 0, 0); __builtin_amdgcn_s_setprio(0); } while (0)
#define PG8_WAIT_V(n) asm volatile("s_waitcnt vmcnt(" #n ")" ::: "memory")
#define PG8_WAIT_L(n) asm volatile("s_waitcnt lgkmcnt(" #n ")" ::: "memory")
#define PG8_BAR __builtin_amdgcn_s_barrier()
#define PG8_SCHED __builtin_amdgcn_sched_barrier(0)
    Unit cur, nxt; int ui = 0;
    if (!S.next(0, cur)) return;
    Acc acc;
#pragma unroll
    for (int a = 0; a < 2; ++a)
#pragma unroll
        for (int b = 0; b < 2; ++b)
#pragma unroll
            for (int m = 0; m < 4; ++m)
#pragma unroll
                for (int n = 0; n < 2; ++n) acc[a][b][m][n] = (f32x4){0.f, 0.f, 0.f, 0.f};
    bf16x8 At[4][2], B0[2][2], B1[2][2];
    unsigned aC0[2], aC1[2], aN0[2], aN1[2];
#pragma unroll
    for (int i = 0; i < 2; ++i) { aC0[i] = S.arow(cur, Rr[i]) + colb[i]; aC1[i] = S.arow(cur, HALF + Rr[i]) + colb[i]; }
    const char* Ab = (const char*)A;
    const char* cB = (const char*)cur.Bt + (size_t)cur.pn * tstep;
    PG8_STAGE(PG8_SB(0, 0), cB, voffB); PG8_STAGE(PG8_SB(0, 1), cB + hstep, voffB); PG8_STAGE(PG8_SA(0, 0), Ab, aC0); PG8_STAGE(PG8_SA(0, 1), Ab, aC1);
    if (wr == 1) PG8_BAR;
    PG8_WAIT_V(2); PG8_BAR;
    PG8_STAGE(PG8_SB(1, 0), cB + kstep, voffB); PG8_STAGE(PG8_SA(1, 0), Ab + kstep, aC0); PG8_STAGE(PG8_SB(1, 1), cB + hstep + kstep, voffB);
    PG8_WAIT_V(6); PG8_BAR;
    for (;;) {
        const bool has_next = S.next(ui + 1, nxt);
        if (has_next) {
#pragma unroll
            for (int i = 0; i < 2; ++i) { aN0[i] = S.arow(nxt, Rr[i]) + colb[i]; aN1[i] = S.arow(nxt, HALF + Rr[i]) + colb[i]; }
        } else {
#pragma unroll
            for (int i = 0; i < 2; ++i) { aN0[i] = aC0[i]; aN1[i] = aC1[i]; }
        }
        const char* nB = has_next ? (const char*)nxt.Bt + (size_t)nxt.pn * tstep : cB;
        for (int t = 0; t < nt; t += 2) {
            const bool last = (t == nt - 2);
            const char* a1 = Ab + (size_t)(t + 1) * kstep;
            const char* a2 = last ? Ab : Ab + (size_t)(t + 2) * kstep; const char* b2 = last ? nB : cB + (size_t)(t + 2) * kstep;
            const char* a3 = a2 + kstep; const char* b3 = b2 + kstep;
            unsigned x0[2], x1[2];
#pragma unroll
            for (int i = 0; i < 2; ++i) { x0[i] = last ? aN0[i] : aC0[i]; x1[i] = last ? aN1[i] : aC1[i]; }
            PG8_LDB(B0, 0, 0); PG8_LDB(B1, 0, 1); PG8_SCHED; PG8_LDA(At, 0, 0); PG8_STAGE(PG8_SA(1, 1), a1, aC1);
            PG8_WAIT_V(8); PG8_WAIT_L(0); PG8_BAR; PG8_MMA(0, 0, At, B0); PG8_MMA(0, 1, At, B1); PG8_BAR; PG8_SCHED;
            PG8_LDA(At, 0, 1); PG8_STAGE(PG8_SB(0, 0), b2, voffB); PG8_STAGE(PG8_SB(0, 1), b2 + hstep, voffB); PG8_STAGE(PG8_SA(0, 0), a2, x0);
            PG8_WAIT_V(8); PG8_WAIT_L(0); PG8_BAR; PG8_MMA(1, 0, At, B0); PG8_MMA(1, 1, At, B1); PG8_BAR; PG8_SCHED;
            PG8_LDB(B0, 1, 0); PG8_LDB(B1, 1, 1); PG8_SCHED; PG8_LDA(At, 1, 0); PG8_STAGE(PG8_SA(0, 1), a2, x1);
            PG8_WAIT_V(8); PG8_WAIT_L(0); PG8_BAR; PG8_MMA(0, 0, At, B0); PG8_MMA(0, 1, At, B1); PG8_BAR; PG8_SCHED;
            PG8_LDA(At, 1, 1); PG8_STAGE(PG8_SB(1, 0), b3, voffB); PG8_STAGE(PG8_SB(1, 1), b3 + hstep, voffB); PG8_STAGE(PG8_SA(1, 0), a3, x0);
            PG8_WAIT_V(8); PG8_WAIT_L(0); PG8_BAR; PG8_MMA(1, 0, At, B0); PG8_MMA(1, 1, At, B1); PG8_BAR; PG8_SCHED;
        }
        if (wr == 0) PG8_BAR;
        E(acc, cur, wr, wc, fr, fq);
        if (!has_next) break;
#pragma unroll
        for (int a = 0; a < 2; ++a)
#pragma unroll
            for (int b = 0; b < 2; ++b)
#pragma unroll
                for (int m = 0; m < 4; ++m)
#pragma unroll
                    for (int n = 0; n < 2; ++n) acc[a][b][m][n] = (f32x4){0.f, 0.f, 0.f, 0.f};
        cur = nxt; cB = nB; ++ui;
#pragma unroll
        for (int i = 0; i < 2; ++i) { aC0[i] = aN0[i]; aC1[i] = aN1[i]; }
        if (wr == 1) PG8_BAR;
    }
    PG8_WAIT_V(0);
    PG8_BAR;
#undef PG8_SA
#undef PG8_SB
#undef PG8_STAGE
#undef PG8_LDA
#undef PG8_LDB
#undef PG8_MMA
#undef PG8_WAIT_V
#undef PG8_WAIT_L
#undef PG8_BAR
#undef PG8_SCHED
}
}

__device__ __forceinline__ int vcu_of(const Frame& F) { return (F.G % 8 == 0) ? (F.bid % 8) * (F.G / 8) + F.bid / 8 : F.bid; }
__device__ __forceinline__ void phase_qkv_opt(const Frame& F, const Prm& p) {
    pg8::DenseOrder S; S.init(NTOK, 3072, 1024, (const bf16*)(p.ws + WS_WQKV), F.G, F.bid);
    static_assert(WS_V - WS_K == WS_K - WS_Q, "Q|K|V equally spaced");
    pg8::EpiQKV E{(bf16*)(p.ws + WS_Q), (const float*)(p.ws + WS_MISC) + 1024};
    pg8::gemm_phase(F.lds, (const bf16*)(p.ws + WS_H), 1024, S, E);
}
__device__ __forceinline__ void phase_wo_opt(const Frame& F, const Prm& p, int layer) {
    pg8::DenseOrder S; S.init(layer ? NLAT : NTOK, 1024, 1024, (const bf16*)(p.ws + (layer ? WS_WGO : WS_WO)), F.G, F.bid);
    pg8::EpiPlain E{(bf16*)(p.ws + WS_Y)};
    pg8::gemm_phase(F.lds, (const bf16*)(p.ws + (layer ? WS_A2B : WS_A2)), 1024, S, E);
}
__device__ __forceinline__ void phase_inproj_opt(const Frame& F, const Prm& p) {
    pg8::DenseOrder S; S.init(NTOK, NIN, 1024, (const bf16*)(p.ws + WS_WIN), F.G, F.bid);
    pg8::EpiInproj E{(bf16*)(p.ws + WS_QR), (bf16*)(p.ws + WS_KR), (bf16*)(p.ws + WS_V1), (bf16*)(p.ws + WS_R), (float*)(p.ws + WS_ZZ)};
    pg8::gemm_phase(F.lds, (const bf16*)(p.ws + WS_H), 1024, S, E);
}
__device__ __forceinline__ void phase_moe1_opt(const Frame& F, const Prm& p, int layer) {
    pg8::MoeOrder<true> S; S.init(F.ctl + CW_CNT + layer * 16, 1024, 1024, (const bf16*)(p.ws + (layer ? WS_GU1 : WS_GU0)), (const int*)(p.ws + WS_LIST), F.G, vcu_of(F));
    pg8::EpiGateUp E{(bf16*)(p.ws + WS_ACT)};
    pg8::gemm_phase(F.lds, (const bf16*)(p.ws + WS_H), 1024, S, E);
}
__device__ __forceinline__ void phase_moe2_opt(const Frame& F, const Prm& p, int layer) {
    pg8::MoeOrder<false> S; S.init(F.ctl + CW_CNT + layer * 16, 1024, 512, (const bf16*)(p.ws + (layer ? WS_DN1 : WS_DN0)), nullptr, F.G, vcu_of(F));
    pg8::EpiPlain E{(bf16*)(p.ws + WS_YM)};
    pg8::gemm_phase(F.lds, (const bf16*)(p.ws + WS_ACT), 512, S, E);
}
namespace attn_body {
using bf16=unsigned short;
using bf16x8=__attribute__((ext_vector_type(8)))short;
using s16x4=__attribute__((ext_vector_type(4)))short;
using f32x16=__attribute__((ext_vector_type(16)))float;
using u32x4=__attribute__((ext_vector_type(4)))unsigned;
constexpr int D=64,DM=1024;
constexpr int NW=8,QBLK=32,QB=QBLK*NW,KVBLK=64;
constexpr int ATTN_PITCH=DM, ATTN_UNIT_ROWS=QB;
__device__ __forceinline__ int crow(int r,int hi){return (r&3)+8*(r>>2)+4*hi;}
#define SBAR() __builtin_amdgcn_sched_barrier(0)
__device__ __forceinline__ void cmask(f32x16&p0,f32x16&p1,int jb,int qrel,int hi){
  const float NEG=-INFINITY; int kb=64*jb+4*hi;
  #pragma unroll
  for(int r=0;r<16;++r){int kv=kb+(r&3)+8*(r>>2); if(kv>qrel)p0[r]=NEG; if(kv+32>qrel)p1[r]=NEG;}
}

constexpr int NSLOT=3, SLOTB=8192;
constexpr int LDS_K=0, LDS_V=NSLOT*SLOTB, LDS_WS=2*NSLOT*SLOTB, LDS_OST=LDS_WS+NW*64*4, LDS_BYTES=LDS_OST+NW*4096;
constexpr float C2=0.125f*1.4426950408889634f;
__device__ __forceinline__ void glds16(const void*gsrc,unsigned lds_dst){unsigned keep;
  asm volatile("s_mov_b32 %0, m0\n\ts_mov_b32 m0, %2\n\ts_nop 0\n\tglobal_load_lds_dwordx4 %1, off\n\ts_mov_b32 m0, %0":"=&s"(keep):"v"(gsrc),"s"(lds_dst):"memory");}
__device__ __forceinline__ float max3f(float a,float b,float c){float r;asm("v_max3_f32 %0, %1, %2, %3":"=v"(r):"v"(a),"v"(b),"v"(c));return r;}
__device__ __forceinline__ float max2f(float a,float b){float r;asm("v_max_f32_e32 %0, %1, %2":"=v"(r):"v"(a),"v"(b));return r;}
__device__ __forceinline__ float fadd_s(float a,float b){float r;asm("v_add_f32_e32 %0, %1, %2":"=v"(r):"v"(a),"v"(b));return r;}
__device__ __forceinline__ float fsub_s(float a,float b){float r;asm("v_sub_f32_e32 %0, %1, %2":"=v"(r):"v"(a),"v"(b));return r;}
typedef float f32x2_t __attribute__((ext_vector_type(2))); typedef __bf16 bf16x2_t __attribute__((ext_vector_type(2)));
__device__ __forceinline__ unsigned cvtpk_s(float lo,float hi){f32x2_t v={lo,hi};bf16x2_t b=__builtin_convertvector(v,bf16x2_t);return __builtin_bit_cast(unsigned,b);}
#define WAIT_BAR(N) asm volatile("s_waitcnt vmcnt(" #N ") lgkmcnt(0)\n\ts_barrier":::"memory")

__device__ __forceinline__ void qkt(f32x16&p0,f32x16&p1,const char*Kslot,const bf16x8*qr,const f32x16&negm,int r32,int hi){
  const char*kb=Kslot+hi*1024+r32*16;
  #pragma unroll
  for(int d0=0;d0<4;++d0){
    const bf16x8 b0=*reinterpret_cast<const bf16x8*>(kb+d0*2048);
    const bf16x8 b1=*reinterpret_cast<const bf16x8*>(kb+d0*2048+512);
    if(d0==0){p0=__builtin_amdgcn_mfma_f32_32x32x16_bf16(b0,qr[0],negm,0,0,0);p1=__builtin_amdgcn_mfma_f32_32x32x16_bf16(b1,qr[0],negm,0,0,0);}
    else{p0=__builtin_amdgcn_mfma_f32_32x32x16_bf16(b0,qr[d0],p0,0,0,0);p1=__builtin_amdgcn_mfma_f32_32x32x16_bf16(b1,qr[d0],p1,0,0,0);}}
}
typedef __attribute__((address_space(3))) const char* lds_cptr;
typedef short v4i16_t __attribute__((ext_vector_type(4)));
__device__ __forceinline__ void kload8(bf16x8*kf,lds_cptr kp){
  kf[0]=*(const __attribute__((address_space(3))) bf16x8*)(kp);      kf[1]=*(const __attribute__((address_space(3))) bf16x8*)(kp+512);
  kf[2]=*(const __attribute__((address_space(3))) bf16x8*)(kp+2048); kf[3]=*(const __attribute__((address_space(3))) bf16x8*)(kp+2560);
  kf[4]=*(const __attribute__((address_space(3))) bf16x8*)(kp+4096); kf[5]=*(const __attribute__((address_space(3))) bf16x8*)(kp+4608);
  kf[6]=*(const __attribute__((address_space(3))) bf16x8*)(kp+6144); kf[7]=*(const __attribute__((address_space(3))) bf16x8*)(kp+6656);
}
__device__ __forceinline__ void kload2(bf16x8*kf,lds_cptr kp,int j){ kf[2*j]=*(const __attribute__((address_space(3))) bf16x8*)(kp+j*2048); kf[2*j+1]=*(const __attribute__((address_space(3))) bf16x8*)(kp+j*2048+512); }
__device__ __forceinline__ s16x4 vtr(lds_cptr p){ return __builtin_bit_cast(s16x4,__builtin_amdgcn_ds_read_tr16_b64_v4i16((__attribute__((address_space(3))) v4i16_t*)p)); }
__device__ __forceinline__ float rowmax(const f32x16&p0,const f32x16&p1){
  float a=max3f(p0[0],p0[1],p1[0]),b=max3f(p0[2],p0[3],p1[1]);a=max3f(a,p1[2],p1[3]);
  #pragma unroll
  for(int r=4;r<16;r+=4){a=max3f(a,p0[r],p0[r+1]);b=max3f(b,p0[r+2],p0[r+3]);a=max3f(a,p1[r],p1[r+1]);b=max3f(b,p1[r+2],p1[r+3]);}
  const float m=max2f(a,b);
  auto rr=__builtin_amdgcn_permlane32_swap(__float_as_uint(m),__float_as_uint(m),false,false);
  return max2f(__uint_as_float(rr[0]),__uint_as_float(rr[1]));
}
__device__ __forceinline__ void pv(f32x16*o,int vb,bf16x8 pa0,bf16x8 pa1,bf16x8 pa2,bf16x8 pa3){
  #pragma unroll
  for(int d0=0;d0<2;++d0){s16x4 lo[4],hi[4];
    #pragma unroll
    for(int ks=0;ks<4;++ks){
      asm volatile("ds_read_b64_tr_b16 %0,%1 offset:%c2":"=&v"(lo[ks]):"v"(vb),"i"(d0*4096+ks*1024):"memory");
      asm volatile("ds_read_b64_tr_b16 %0,%1 offset:%c2":"=&v"(hi[ks]):"v"(vb),"i"(d0*4096+ks*1024+512):"memory");}
    asm volatile("s_waitcnt lgkmcnt(0)":::"memory");SBAR();
    #define PK(k) (bf16x8){lo[k][0],lo[k][1],lo[k][2],lo[k][3],hi[k][0],hi[k][1],hi[k][2],hi[k][3]}
    o[d0]=__builtin_amdgcn_mfma_f32_32x32x16_bf16(pa0,PK(0),o[d0],0,0,0);
    o[d0]=__builtin_amdgcn_mfma_f32_32x32x16_bf16(pa1,PK(1),o[d0],0,0,0);
    o[d0]=__builtin_amdgcn_mfma_f32_32x32x16_bf16(pa2,PK(2),o[d0],0,0,0);
    o[d0]=__builtin_amdgcn_mfma_f32_32x32x16_bf16(pa3,PK(3),o[d0],0,0,0);
    #undef PK
  }
}

#ifndef ATTN_STORE16
#define ATTN_STORE16(p,v) (*(u32x4*)(p)=(v))
#endif
template<int THRL> __device__ __forceinline__ void attn_unit(long qrow0,int qcol,int vcol,long kctx,long klat,int NT,const bf16*Q,const bf16*__restrict__ K,const bf16*__restrict__ V,bf16*O,char*shm){
  const int tid=threadIdx.x,lane=tid&63,r32=lane&31,hi=lane>>5; const int wid=__builtin_amdgcn_readfirstlane(tid>>6);

  const bf16*Qw=Q+(qrow0+wid*QBLK)*DM+qcol;
  const bf16*Kh=K+qcol,*Vh=V+vcol;
  const unsigned lds0=(unsigned)(uintptr_t)shm;
  float*wsf=(float*)(shm+LDS_WS)+wid*64;
  const bf16*ksrc=Kh+(long)lane*DM+wid*8;
  const bf16*vsrc=Vh+(long)(16*(wid&3)+(lane>>2))*DM+(wid>>2)*32+(lane&3)*8;
  const unsigned kdst=lds0+LDS_K+wid*1024, vdst=lds0+LDS_V+wid*1024;
  #define KVROW(t) ((t)<4?kctx+(long)(t)*KVBLK:klat+(long)((t)-4)*KVBLK)
  #define DMA_K(t,slot) glds16(ksrc+KVROW(t)*DM,(unsigned)__builtin_amdgcn_readfirstlane(kdst+(slot)))
  #define DMA_V(t,slot) glds16(vsrc+KVROW(t)*DM,(unsigned)__builtin_amdgcn_readfirstlane(vdst+(slot)))
  const int vb0=(int)(lds0+LDS_V)+((lane>>4)&1)*32+(lane&3)*8+(4*hi+((lane&15)>>2))*64;
  const char*Kbase=shm+LDS_K; bf16x8 kf[8];
  const lds_cptr shm3=(lds_cptr)shm; const lds_cptr kp0=shm3+LDS_K+hi*1024+r32*16; const lds_cptr vp0=shm3+LDS_V+((lane>>4)&1)*32+(lane&3)*8+(4*hi+((lane&15)>>2))*64;
  DMA_K(0,0);DMA_V(0,0);DMA_K(1,SLOTB);
  bf16x8 qr[4];
  #pragma unroll
  for(int d0=0;d0<4;++d0)qr[d0]=*reinterpret_cast<const bf16x8*>(&Qw[(long)r32*DM+d0*16+hi*8]);
  float mhat=0.f,l_reg=0.f;f32x16 o[2];o[0]=f32x16{};o[1]=f32x16{};f32x16 negm=f32x16{};asm volatile("":"+v"(negm));
  const int qrel=wid*QBLK+r32;
  #define CMASK(P0,P1,t) do{}while(0)
  bool resc=false;
  #define START(P0,P1) do{ const float rm=rowmax(P0,P1); resc=false; \
    { const float dl=rm; mhat=fadd_s(mhat,dl); \
      _Pragma("unroll") for(int r=0;r<16;++r){P0[r]=fsub_s(P0[r],dl);P1[r]=fsub_s(P1[r],dl);} \
      _Pragma("unroll") for(int r=0;r<16;++r)negm[r]=-mhat; asm volatile("":"+v"(negm)); } \
    _Pragma("unroll") for(int r=0;r<16;++r)P0[r]=__builtin_amdgcn_exp2f(P0[r]); }while(0)
  #define RESC() do{ if(resc){ asm volatile("s_waitcnt lgkmcnt(0)":::"memory"); \
      _Pragma("unroll") for(int d_=0;d_<2;++d_) _Pragma("unroll") for(int r=0;r<16;++r)o[d_][r]*=wsf[crow(r,hi)]; } }while(0)
  f32x16 pA0,pA1,pB0,pB1;
  int sl_prev=0,sl_cur=0,sl_next=SLOTB;
  #define ROT() do{sl_prev=sl_cur;sl_cur=sl_next;sl_next=(sl_next==(NSLOT-1)*SLOTB)?0:sl_next+SLOTB;}while(0)
  DMA_K(2,2*SLOTB);
  WAIT_BAR(3);
  qkt(pA0,pA1,Kbase,qr,negm,r32,hi);asm volatile("s_nop 15\n\ts_nop 7":"+v"(pA0),"+v"(pA1));CMASK(pA0,pA1,0);
  START(pA0,pA1);
  _Pragma("unroll") for(int r=0;r<16;++r)pA1[r]=__builtin_amdgcn_exp2f(pA1[r]);
  WAIT_BAR(0);
  DMA_K(3,0);DMA_V(1,SLOTB);
  ROT();
  kload8(kf,kp0+sl_cur);
  WAIT_BAR(2);
  s16x4 vlo[8],vhi[8]; u32x4 pw0,pw1,pw2,pw3;
  #define PKW(P,B) cvtpk_s(P[B],P[B+1])
  #define PAF(k) __builtin_bit_cast(bf16x8,pw##k)
  #define VFR(i) (bf16x8){vlo[i][0],vlo[i][1],vlo[i][2],vlo[i][3],vhi[i][0],vhi[i][1],vhi[i][2],vhi[i][3]}
  #define PIN(x) asm volatile("":"+v"(x))
  #define MX3(a,b,c) __builtin_fmaxf(__builtin_fmaxf((a),(b)),(c))
  #define GAPA(MF,A0,A1,A2,A3,W0,W1,PW) do{ MF; sacc+=A0; sacc+=A1; sacc+=A2; sacc+=A3; PIN(sacc); W0; W1; PIN(PW); SBAR(); }while(0)
  #define EX(v) __builtin_amdgcn_exp2f(v)
  #define GAPB(MF,X,B) do{ MF; X[B]=EX(X[B]); X[B+1]=EX(X[B+1]); X[B+2]=EX(X[B+2]); X[B+3]=EX(X[B+3]); PIN(X); SBAR(); }while(0)
  #define VRD(i) do{ vlo[i]=vtr(vp_+(((i)>>2)*4096+((i)&3)*1024)); vhi[i]=vtr(vp_+(((i)>>2)*4096+((i)&3)*1024+512)); }while(0)
  #define KRD(G,j) do{ if(G){ kload2(kf,kp0+sl_next,j); SBAR(); } }while(0)
  #define STEP(C0,C1,P0,P1,t,GK,GV,GL) do{ SBAR(); \
    const lds_cptr vp_=vp0+sl_prev; \
    VRD(0); SBAR(); float sacc=(P0[0]+P0[1]); \
    GAPA(C0=__builtin_amdgcn_mfma_f32_32x32x16_bf16(kf[0],qr[0],negm,0,0,0), P0[2],P0[3],P0[4],P0[5],     pw0[0]=PKW(P0,0), pw0[1]=PKW(P0,2), pw0); \
    VRD(4); SBAR(); GAPA(C1=__builtin_amdgcn_mfma_f32_32x32x16_bf16(kf[1],qr[0],negm,0,0,0), P0[6],P0[7],P0[8],P0[9],     pw0[2]=PKW(P0,4), pw0[3]=PKW(P0,6), pw0); \
    VRD(1); SBAR(); GAPA(C0=__builtin_amdgcn_mfma_f32_32x32x16_bf16(kf[2],qr[1],C0,0,0,0),   P0[10],P0[11],P0[12],P0[13], pw1[0]=PKW(P0,8), pw1[1]=PKW(P0,10), pw1); \
    VRD(5); SBAR(); GAPA(C1=__builtin_amdgcn_mfma_f32_32x32x16_bf16(kf[3],qr[1],C1,0,0,0),   P0[14],P0[15],P1[0],P1[1],   pw1[2]=PKW(P0,12),pw1[3]=PKW(P0,14), pw1); \
    VRD(2); SBAR(); GAPA(C0=__builtin_amdgcn_mfma_f32_32x32x16_bf16(kf[4],qr[2],C0,0,0,0),   P1[2],P1[3],P1[4],P1[5],     pw2[0]=PKW(P1,0), pw2[1]=PKW(P1,2), pw2); \
    VRD(6); SBAR(); GAPA(C1=__builtin_amdgcn_mfma_f32_32x32x16_bf16(kf[5],qr[2],C1,0,0,0),   P1[6],P1[7],P1[8],P1[9],     pw2[2]=PKW(P1,4), pw2[3]=PKW(P1,6), pw2); \
    VRD(3); SBAR(); GAPA(C0=__builtin_amdgcn_mfma_f32_32x32x16_bf16(kf[6],qr[3],C0,0,0,0),   P1[10],P1[11],P1[12],P1[13], pw3[0]=PKW(P1,8), pw3[1]=PKW(P1,10), pw3); \
    VRD(7); SBAR(); GAPA(C1=__builtin_amdgcn_mfma_f32_32x32x16_bf16(kf[7],qr[3],C1,0,0,0),   P1[14],P1[15],0.f,0.f,       pw3[2]=PKW(P1,12),pw3[3]=PKW(P1,14), pw3); \
    l_reg+=sacc; \
    if(GK){DMA_K((t)+3,sl_cur);} if(GV){DMA_V((t)+1,sl_next);} \
    CMASK(C0,C1,t); \
    { float a=MX3(C0[0],C0[1],C1[0]),b=MX3(C0[2],C0[3],C1[1]); a=MX3(a,C1[2],C1[3]); \
      _Pragma("unroll") for(int r=4;r<16;r+=4){a=MX3(a,C0[r],C0[r+1]);b=MX3(b,C0[r+2],C0[r+3]);a=MX3(a,C1[r],C1[r+1]);b=MX3(b,C1[r+2],C1[r+3]);} \
      float rm=__builtin_fmaxf(a,b); { auto rr=__builtin_amdgcn_permlane32_swap(__float_as_uint(rm),__float_as_uint(rm),false,false); rm=__builtin_fmaxf(__uint_as_float(rr[0]),__uint_as_float(rr[1])); } \
      resc=false; \
      if(__builtin_expect(__any(rm>(float)THRL),0)){ const float dl=__builtin_fmaxf(rm,0.f); mhat+=dl; \
        _Pragma("unroll") for(int r=0;r<16;++r){C0[r]-=dl;C1[r]-=dl;} \
        _Pragma("unroll") for(int r=0;r<16;++r)negm[r]=-mhat; asm volatile("":"+v"(negm)); \
        const float f=__builtin_amdgcn_exp2f(-dl); l_reg*=f; if(hi==0)wsf[r32]=f; resc=true; } } \
    SBAR(); \
    GAPB(o[0]=__builtin_amdgcn_mfma_f32_32x32x16_bf16(PAF(0),VFR(0),o[0],0,0,0), C0,0); \
    GAPB(o[1]=__builtin_amdgcn_mfma_f32_32x32x16_bf16(PAF(0),VFR(4),o[1],0,0,0), C0,4); \
    KRD(GL,0); GAPB(o[0]=__builtin_amdgcn_mfma_f32_32x32x16_bf16(PAF(1),VFR(1),o[0],0,0,0), C0,8); \
    KRD(GL,1); GAPB(o[1]=__builtin_amdgcn_mfma_f32_32x32x16_bf16(PAF(1),VFR(5),o[1],0,0,0), C0,12); \
    KRD(GL,2); GAPB(o[0]=__builtin_amdgcn_mfma_f32_32x32x16_bf16(PAF(2),VFR(2),o[0],0,0,0), C1,0); \
    KRD(GL,3); GAPB(o[1]=__builtin_amdgcn_mfma_f32_32x32x16_bf16(PAF(2),VFR(6),o[1],0,0,0), C1,4); \
    GAPB(o[0]=__builtin_amdgcn_mfma_f32_32x32x16_bf16(PAF(3),VFR(3),o[0],0,0,0), C1,8); \
    GAPB(o[1]=__builtin_amdgcn_mfma_f32_32x32x16_bf16(PAF(3),VFR(7),o[1],0,0,0), C1,12); \
    }while(0)
  int t=1;
  #undef CMASK
  #define CMASK(P0,P1,t) do{}while(0)
  for(;t+5<NT;t+=2){
    STEP(pB0,pB1,pA0,pA1,t,true,true,true);     WAIT_BAR(2); RESC(); ROT();
    STEP(pA0,pA1,pB0,pB1,t+1,true,true,true);   WAIT_BAR(2); RESC(); ROT();
  }
  #undef CMASK
  #define CMASK(P0,P1,t) do{}while(0)
  #define ENDW(tt) do{ if((tt)+3<NT){WAIT_BAR(2);} else if((tt)+2<NT){WAIT_BAR(1);} else {WAIT_BAR(0);} }while(0)
  for(;t+1<NT;t+=2){
    STEP(pB0,pB1,pA0,pA1,t,(t+3<NT),(t+1<NT),(t+1<NT));       ENDW(t);   RESC(); ROT();
    STEP(pA0,pA1,pB0,pB1,t+1,(t+4<NT),(t+2<NT),(t+2<NT));     ENDW(t+1); RESC(); ROT();
  }
  STEP(pB0,pB1,pA0,pA1,NT-1,false,false,false); RESC();
  { float sacc=pB0[0]+pB0[1]; _Pragma("unroll") for(int r=2;r<16;++r)sacc+=pB0[r]; _Pragma("unroll") for(int r=0;r<16;++r)sacc+=pB1[r]; l_reg+=sacc;
    pw0=(u32x4){PKW(pB0,0),PKW(pB0,2),PKW(pB0,4),PKW(pB0,6)};pw1=(u32x4){PKW(pB0,8),PKW(pB0,10),PKW(pB0,12),PKW(pB0,14)};pw2=(u32x4){PKW(pB1,0),PKW(pB1,2),PKW(pB1,4),PKW(pB1,6)};pw3=(u32x4){PKW(pB1,8),PKW(pB1,10),PKW(pB1,12),PKW(pB1,14)};
    SBAR(); pv(o,vb0+sl_cur,PAF(0),PAF(1),PAF(2),PAF(3)); }
  #undef PKW
  #undef PAF
  #undef VFR
  #undef PIN
  #undef MX3
  #undef GAPA
  #undef GAPB
  #undef EX
  #undef VRD
  #undef KRD
  #undef STEP
  #undef ENDW
  {auto rr=__builtin_amdgcn_permlane32_swap(__float_as_uint(l_reg),__float_as_uint(l_reg),false,false);l_reg=__uint_as_float(rr[0])+__uint_as_float(rr[1]);}
  if(hi==0)wsf[32+r32]=l_reg;asm volatile("s_waitcnt lgkmcnt(0)":::"memory");
  float rli[16];
  #pragma unroll
  for(int r=0;r<16;++r)rli[r]=__builtin_amdgcn_rcpf(wsf[32+crow(r,hi)]);
  bf16*Ow=O+(qrow0+wid*QBLK)*DM+vcol;
  { bf16*stg=(bf16*)(shm+LDS_OST)+wid*2048;
    #pragma unroll
    for(int r=0;r<16;++r){const int orow=crow(r,hi);
      #pragma unroll
      for(int d0=0;d0<2;++d0)stg[orow*64+d0*32+r32]=(bf16)f2bf(o[d0][r]*rli[r]);}
    asm volatile("s_waitcnt lgkmcnt(0)":::"memory");
    #pragma unroll
    for(int i=0;i<4;++i){const int row=i*8+(lane>>3),ch=lane&7; const u32x4 v=*(const u32x4*)(stg+row*64+ch*8); ATTN_STORE16(Ow+(long)row*DM+ch*8,v);} }
  asm volatile("s_waitcnt lgkmcnt(0)\n\ts_barrier":::"memory");
  #undef DMA_K
  #undef DMA_V
  #undef CMASK
  #undef START
  #undef RESC
  #undef ROT
}
constexpr int ATTN_LDS_BYTES=LDS_BYTES;
#undef SBAR
#undef WAIT_BAR
#undef KVROW
}
namespace attn_body {
constexpr int V2SLOT = 16384;
constexpr int L2_K = 0, L2_V = NSLOT * SLOTB, L2_WS = L2_V + NSLOT * V2SLOT, L2_OST = L2_WS + NW * 64 * 4, L2_BYTES = L2_OST + NW * 4096;
#define SBAR() __builtin_amdgcn_sched_barrier(0)
#define WAIT_BAR(N) asm volatile("s_waitcnt vmcnt(" #N ") lgkmcnt(0)\n\ts_barrier":::"memory")
template<int THRL> __device__ __forceinline__ void attn_unit2(long qrow0,int qcol,int vcol,long kctx,long klat,int NT,const bf16*Q,const bf16*__restrict__ K,const bf16*__restrict__ V,bf16*O,char*shm){
  const int tid=threadIdx.x,lane=tid&63,r32=lane&31,hi=lane>>5; const int wid=__builtin_amdgcn_readfirstlane(tid>>6);
  const bf16*Qw=Q+(qrow0+wid*QBLK)*DM+qcol;
  const bf16*Kh=K+qcol,*Vh=V+vcol;
  const unsigned lds0=(unsigned)(uintptr_t)shm;
  float*wsf=(float*)(shm+L2_WS)+wid*64;
  const bf16*ksrc=Kh+(long)lane*DM+wid*8;
  const bf16*vsrc=Vh+(long)(16*(wid&3)+(lane>>2))*DM+(wid>>2)*32+(lane&3)*8;
  const unsigned kdst=lds0+L2_K+wid*1024, vdst=lds0+L2_V+wid*1024;
  #define KVROW(t) ((t)<4?kctx+(long)(t)*KVBLK:klat+(long)((t)-4)*KVBLK)
  #define DMA_K(t,slot) glds16(ksrc+KVROW(t)*DM,(unsigned)__builtin_amdgcn_readfirstlane(kdst+(slot)))
  #define DMA_V(t,slot) do{ glds16(vsrc+KVROW(t)*DM,(unsigned)__builtin_amdgcn_readfirstlane(vdst+2*(slot))); glds16(vsrc+KVROW(t)*DM+64,(unsigned)__builtin_amdgcn_readfirstlane(vdst+2*(slot)+8192)); }while(0)
  const char*Kbase=shm+L2_K; bf16x8 kf[8];
  const lds_cptr shm3=(lds_cptr)shm; const lds_cptr kp0=shm3+L2_K+hi*1024+r32*16; const lds_cptr vp0=shm3+L2_V+((lane>>4)&1)*32+(lane&3)*8+(4*hi+((lane&15)>>2))*64;
  DMA_K(0,0);DMA_V(0,0);DMA_K(1,SLOTB);
  bf16x8 qr[4];
  #pragma unroll
  for(int d0=0;d0<4;++d0)qr[d0]=*reinterpret_cast<const bf16x8*>(&Qw[(long)r32*DM+d0*16+hi*8]);
  float mhat=0.f,l_reg=0.f;f32x16 o[4];o[0]=f32x16{};o[1]=f32x16{};o[2]=f32x16{};o[3]=f32x16{};const f32x16 zero16=f32x16{};
  bool resc=false;
  #define START(P0,P1) do{ const float rm=rowmax(P0,P1); resc=false; mhat=rm; \
    _Pragma("unroll") for(int r=0;r<16;++r){P0[r]=fsub_s(P0[r],rm);P1[r]=fsub_s(P1[r],rm);} \
    _Pragma("unroll") for(int r=0;r<16;++r)P0[r]=__builtin_amdgcn_exp2f(P0[r]); }while(0)
  #define RESC() do{ if(resc){ asm volatile("s_waitcnt lgkmcnt(0)":::"memory"); \
      _Pragma("unroll") for(int d_=0;d_<4;++d_) _Pragma("unroll") for(int r=0;r<16;++r)o[d_][r]*=wsf[crow(r,hi)]; } }while(0)
  int sl_prev=0,sl_cur=0,sl_next=SLOTB;
  #define ROT() do{sl_prev=sl_cur;sl_cur=sl_next;sl_next=(sl_next==(NSLOT-1)*SLOTB)?0:sl_next+SLOTB;}while(0)
  DMA_K(2,2*SLOTB);
  WAIT_BAR(4);
  #define PKW(P,B) cvtpk_s(P[B],P[B+1])
  u32x4 pwA0,pwA1,pwA2,pwA3,pwB0,pwB1,pwB2,pwB3;
  { f32x16 p0,p1;
    qkt(p0,p1,Kbase,qr,zero16,r32,hi);asm volatile("s_nop 15\n\ts_nop 7":"+v"(p0),"+v"(p1));
    START(p0,p1);
    _Pragma("unroll") for(int r=0;r<16;++r)p1[r]=__builtin_amdgcn_exp2f(p1[r]);
    float sacc=p0[0]+p0[1]; _Pragma("unroll") for(int r=2;r<16;++r)sacc+=p0[r]; _Pragma("unroll") for(int r=0;r<16;++r)sacc+=p1[r]; l_reg+=sacc;
    pwA0=(u32x4){PKW(p0,0),PKW(p0,2),PKW(p0,4),PKW(p0,6)};pwA1=(u32x4){PKW(p0,8),PKW(p0,10),PKW(p0,12),PKW(p0,14)};pwA2=(u32x4){PKW(p1,0),PKW(p1,2),PKW(p1,4),PKW(p1,6)};pwA3=(u32x4){PKW(p1,8),PKW(p1,10),PKW(p1,12),PKW(p1,14)}; }
  WAIT_BAR(0);
  DMA_K(3,0);DMA_V(1,SLOTB);
  ROT();
  kload8(kf,kp0+sl_cur);
  WAIT_BAR(3);
  s16x4 vAl[4],vAh[4],vBl[4],vBh[4];
  #define PAFX(x) __builtin_bit_cast(bf16x8,x)
  #define VF(A,d) (bf16x8){A##l[d][0],A##l[d][1],A##l[d][2],A##l[d][3],A##h[d][0],A##h[d][1],A##h[d][2],A##h[d][3]}
  #define PIN(x) asm volatile("":"+v"(x))
  #define MX3(a,b,c) __builtin_fmaxf(__builtin_fmaxf((a),(b)),(c))
  #define EX(v) __builtin_amdgcn_exp2f(v)
  #define VRDL(A,d,ks) A##l[d]=vtr(vp_+((d)*4096+(ks)*1024))
  #define VRDH(A,d,ks) A##h[d]=vtr(vp_+((d)*4096+(ks)*1024+512))
  #define GAPP(MF,X,B,PWN,W,RD) do{ MF; X[B]=EX(X[B]-mhat); X[B+1]=EX(X[B+1]-mhat); sacc+=X[B]; sacc+=X[B+1]; PIN(sacc); PWN[W]=cvtpk_s(X[B],X[B+1]); PIN(PWN); RD; SBAR(); }while(0)
  #define MFQ(C,kf_,q_,acc_) C=__builtin_amdgcn_mfma_f32_32x32x16_bf16(kf_,q_,acc_,0,0,0)
  #define MFO(d,PW,A) o[d]=__builtin_amdgcn_mfma_f32_32x32x16_bf16(PAFX(PW),VF(A,d),o[d],0,0,0)
  #define KRD(G,j) do{ if(G){ kload2(kf,kp0+sl_next,j); } }while(0)
  #define STEP2(t,PI0,PI1,PI2,PI3,PO0,PO1,PO2,PO3,GK,GV,GL) do{ SBAR(); \
    const lds_cptr vp_=vp0+2*sl_prev; f32x16 C0,C1; float sacc=0.f; \
    VRDL(vA,0,0); SBAR(); MFQ(C0,kf[0],qr[0],zero16); SBAR(); \
    VRDH(vA,0,0); SBAR(); MFQ(C1,kf[1],qr[0],zero16); SBAR(); \
    VRDL(vA,1,0); SBAR(); MFQ(C0,kf[2],qr[1],C0); SBAR(); \
    VRDH(vA,1,0); SBAR(); MFQ(C1,kf[3],qr[1],C1); SBAR(); \
    VRDL(vA,2,0); SBAR(); MFQ(C0,kf[4],qr[2],C0); SBAR(); \
    VRDH(vA,2,0); SBAR(); MFQ(C1,kf[5],qr[2],C1); SBAR(); \
    VRDL(vA,3,0); SBAR(); MFQ(C0,kf[6],qr[3],C0); SBAR(); \
    VRDH(vA,3,0); SBAR(); MFQ(C1,kf[7],qr[3],C1); SBAR(); \
    if(GK){DMA_K((t)+3,sl_cur);} if(GV){DMA_V((t)+1,sl_next);} \
    { float a=MX3(C0[0],C0[1],C1[0]),b=MX3(C0[2],C0[3],C1[1]); a=MX3(a,C1[2],C1[3]); \
      _Pragma("unroll") for(int r=4;r<16;r+=4){a=MX3(a,C0[r],C0[r+1]);b=MX3(b,C0[r+2],C0[r+3]);a=MX3(a,C1[r],C1[r+1]);b=MX3(b,C1[r+2],C1[r+3]);} \
      float rm=__builtin_fmaxf(a,b); { auto rr=__builtin_amdgcn_permlane32_swap(__float_as_uint(rm),__float_as_uint(rm),false,false); rm=__builtin_fmaxf(__uint_as_float(rr[0]),__uint_as_float(rr[1])); } \
      resc=false; \
      if(__builtin_expect(__any(rm-mhat>(float)THRL),0)){ const float dl=__builtin_fmaxf(rm-mhat,0.f); mhat+=dl; \
        const float f=__builtin_amdgcn_exp2f(-dl); l_reg*=f; if(hi==0)wsf[r32]=f; resc=true; } } \
    SBAR(); \
    GAPP(MFO(0,PI0,vA),C0,0, PO0,0, VRDL(vB,0,1);VRDH(vB,0,1)); \
    GAPP(MFO(1,PI0,vA),C0,2, PO0,1, VRDL(vB,1,1);VRDH(vB,1,1)); \
    GAPP(MFO(2,PI0,vA),C0,4, PO0,2, VRDL(vB,2,1);VRDH(vB,2,1)); \
    GAPP(MFO(3,PI0,vA),C0,6, PO0,3, VRDL(vB,3,1);VRDH(vB,3,1)); \
    GAPP(MFO(0,PI1,vB),C0,8, PO1,0, VRDL(vA,0,2);VRDH(vA,0,2)); \
    GAPP(MFO(1,PI1,vB),C0,10,PO1,1, VRDL(vA,1,2);VRDH(vA,1,2)); \
    GAPP(MFO(2,PI1,vB),C0,12,PO1,2, VRDL(vA,2,2);VRDH(vA,2,2)); \
    GAPP(MFO(3,PI1,vB),C0,14,PO1,3, VRDL(vA,3,2);VRDH(vA,3,2)); \
    GAPP(MFO(0,PI2,vA),C1,0, PO2,0, VRDL(vB,0,3);VRDH(vB,0,3)); \
    GAPP(MFO(1,PI2,vA),C1,2, PO2,1, VRDL(vB,1,3);VRDH(vB,1,3)); \
    GAPP(MFO(2,PI2,vA),C1,4, PO2,2, VRDL(vB,2,3);VRDH(vB,2,3)); \
    GAPP(MFO(3,PI2,vA),C1,6, PO2,3, VRDL(vB,3,3);VRDH(vB,3,3)); \
    GAPP(MFO(0,PI3,vB),C1,8, PO3,0, KRD(GL,0)); \
    GAPP(MFO(1,PI3,vB),C1,10,PO3,1, KRD(GL,1)); \
    GAPP(MFO(2,PI3,vB),C1,12,PO3,2, KRD(GL,2)); \
    GAPP(MFO(3,PI3,vB),C1,14,PO3,3, KRD(GL,3)); \
    l_reg+=sacc; \
    }while(0)
  #define ENDW(tt) do{ if((tt)+3<NT){WAIT_BAR(3);} else if((tt)+2<NT){WAIT_BAR(2);} else {WAIT_BAR(0);} }while(0)
  int t=1;
  for(;t+5<NT;t+=2){
    STEP2(t,  pwA0,pwA1,pwA2,pwA3,pwB0,pwB1,pwB2,pwB3,true,true,true); WAIT_BAR(3); RESC(); ROT();
    STEP2(t+1,pwB0,pwB1,pwB2,pwB3,pwA0,pwA1,pwA2,pwA3,true,true,true); WAIT_BAR(3); RESC(); ROT();
  }
  for(;t+1<NT;t+=2){
    STEP2(t,  pwA0,pwA1,pwA2,pwA3,pwB0,pwB1,pwB2,pwB3,(t+3<NT),(t+1<NT),(t+1<NT)); ENDW(t);   RESC(); ROT();
    STEP2(t+1,pwB0,pwB1,pwB2,pwB3,pwA0,pwA1,pwA2,pwA3,(t+4<NT),(t+2<NT),(t+2<NT)); ENDW(t+1); RESC(); ROT();
  }
  STEP2(NT-1,pwA0,pwA1,pwA2,pwA3,pwB0,pwB1,pwB2,pwB3,false,false,false); RESC();
  { const lds_cptr vp_=vp0+2*sl_cur;
    #pragma unroll
    for(int ks=0;ks<4;++ks){
      #pragma unroll
      for(int d=0;d<4;++d){ const s16x4 lo=vtr(vp_+(d*4096+ks*1024)),hh=vtr(vp_+(d*4096+ks*1024+512)); const bf16x8 vf=(bf16x8){lo[0],lo[1],lo[2],lo[3],hh[0],hh[1],hh[2],hh[3]};
        const u32x4 pw=(ks==0)?pwB0:(ks==1)?pwB1:(ks==2)?pwB2:pwB3;
        o[d]=__builtin_amdgcn_mfma_f32_32x32x16_bf16(PAFX(pw),vf,o[d],0,0,0); } } }
  {auto rr=__builtin_amdgcn_permlane32_swap(__float_as_uint(l_reg),__float_as_uint(l_reg),false,false);l_reg=__uint_as_float(rr[0])+__uint_as_float(rr[1]);}
  if(hi==0)wsf[32+r32]=l_reg;asm volatile("s_waitcnt lgkmcnt(0)":::"memory");
  float rli[16];
  #pragma unroll
  for(int r=0;r<16;++r)rli[r]=__builtin_amdgcn_rcpf(wsf[32+crow(r,hi)]);
  bf16*Ow=O+(qrow0+wid*QBLK)*DM+vcol;
  { bf16*stg=(bf16*)(shm+L2_OST)+wid*2048;
    #pragma unroll
    for(int hf=0;hf<2;++hf){
      #pragma unroll
      for(int r=0;r<16;++r){const int orow=crow(r,hi);
        #pragma unroll
        for(int d0=0;d0<2;++d0)stg[orow*64+d0*32+r32]=(bf16)f2bf(o[2*hf+d0][r]*rli[r]);}
      asm volatile("s_waitcnt lgkmcnt(0)":::"memory");
      #pragma unroll
      for(int i=0;i<4;++i){const int row=i*8+(lane>>3),ch=lane&7; const u32x4 v=*(const u32x4*)(stg+row*64+ch*8); *(u32x4*)(Ow+(long)row*DM+hf*64+ch*8)=v;}
      asm volatile("s_waitcnt lgkmcnt(0)":::"memory"); } }
  asm volatile("s_waitcnt lgkmcnt(0)\n\ts_barrier":::"memory");
  #undef KVROW
  #undef DMA_K
  #undef DMA_V
  #undef START
  #undef RESC
  #undef ROT
  #undef PKW
  #undef PAFX
  #undef VF
  #undef PIN
  #undef MX3
  #undef EX
  #undef VRDL
  #undef VRDH
  #undef GAPP
  #undef MFQ
  #undef MFO
  #undef KRD
  #undef STEP2
  #undef ENDW
}
#undef SBAR
#undef WAIT_BAR
}
__device__ __forceinline__ void phase_attn2(const Frame& F, const Prm& p) {
    const bf16* Q = (const bf16*)(p.ws + WS_Q); const bf16* K = (const bf16*)(p.ws + WS_K); const bf16* V = (const bf16*)(p.ws + WS_V); bf16* O1 = (bf16*)(p.ws + WS_O1);
    for (int v = vcu_of(F); v < 256; v += F.G) {
        const int b = v >> 5, hm = (v >> 1) & 15, h = hm >> 1, m = hm & 1, half = v & 1;
        const int qcol = hm * 64, vcol = h * 128; bf16* O = O1 + (size_t)m * ((WS_O2 - WS_O1) / 2);
        const long kctx = NLAT + b * CTXL, klat = (long)b * SEQ;
        const int nu = half ? 8 : 9;
        for (int i = 0; i < nu; ++i) {
            const long qrow0 = i < 8 ? klat + (half * 8 + i) * 256 : kctx; const int NT = i < 8 ? 68 : 4;
            attn_body::attn_unit2<8>(qrow0, qcol, vcol, kctx, klat, NT, Q, K, V, O, (char*)F.lds);
        }
    }
}
namespace gla {
typedef short bf16x8 __attribute__((ext_vector_type(8)));
typedef short s16x4 __attribute__((ext_vector_type(4)));
typedef float f32x16 __attribute__((ext_vector_type(16)));
constexpr int PQ = 272, PK = 144;
constexpr int L_QS = 0, L_KS = 64 * PQ, L_KT = 2 * 64 * PQ, L_VT = L_KT + 128 * PK, L_SB = L_VT + 64 * PK, L_DEC = L_SB + 64 * PQ, L_END = L_DEC + 512;
__device__ __forceinline__ int crow(int i, int hh) { return (i & 3) + 8 * (i >> 2) + 4 * hh; }
typedef float f32x2_t __attribute__((ext_vector_type(2))); typedef __bf16 bf16x2_t __attribute__((ext_vector_type(2)));
__device__ __forceinline__ unsigned pk(float lo, float hi) { f32x2_t v = {lo, hi}; bf16x2_t b = __builtin_convertvector(v, bf16x2_t); return __builtin_bit_cast(unsigned, b); }

__device__ __forceinline__ void scan_unit(const Frame& F, const Prm& p, int unit) {
    const int dvs = unit & 3, dir = (unit >> 2) & 1, h = (unit >> 3) & 3, b = unit >> 5;
    LAS unsigned char* lds = (LAS unsigned char*)F.lds;
    const int lane = F.lane, w = F.wave, tid = F.tid, r = lane & 31, hh = lane >> 5;
    const bf16* QT = (const bf16*)(p.ws + WS_QT) + (size_t)dir * NTOK * 512 + h * 128 + 8 * w;
    const bf16* KT = (const bf16*)(p.ws + WS_KT) + (size_t)dir * NTOK * 512 + h * 128 + 8 * w;
    const bf16* V = (const bf16*)(p.ws + WS_V1) + h * 256 + dvs * 64 + 8 * w;
    const float* DEC = (const float*)(p.ws + WS_DEC) + (size_t)dir * NCHUNK * 512 + h * 128;
    bf16* OG = (bf16*)(p.ws + (dir ? WS_OGB : WS_OGF)) + h * 256 + dvs * 64;
    f32x16 S0 = {}, S1 = {};
    for (int i = tid; i < 64 * PQ / 16; i += NTHR) *(LAS u32x4*)(lds + L_SB + i * 16) = (u32x4){0u, 0u, 0u, 0u};
    u32x4 pq0, pq1, pk0, pk1, pv; float pdec = 0.f;
#define GLA_CHUNK(step) ((step) >= 4 ? b * 64 + (dir ? 63 - ((step) - 4) : (step) - 4) : 512 + b * 4 + (dir ? 3 - (step) : (step)))
#define GLA_LOAD(step) do { const size_t row_ = (size_t)GLA_CHUNK(step) * 64 + lane; \
        pq0 = *(const u32x4*)(QT + row_ * 512); pq1 = *(const u32x4*)(QT + row_ * 512 + 64); pk0 = *(const u32x4*)(KT + row_ * 512); pk1 = *(const u32x4*)(KT + row_ * 512 + 64); \
        pv = *(const u32x4*)(V + row_ * 1024); if (tid < 128) pdec = DEC[(size_t)GLA_CHUNK(step) * 512 + tid]; } while (0)
#define GLA_T16(base, x, j) do { *(LAS unsigned short*)(lds + (base) + (2 * (j)) * PK + 2 * lane) = (unsigned short)((x) & 0xffffu); *(LAS unsigned short*)(lds + (base) + (2 * (j) + 1) * PK + 2 * lane) = (unsigned short)((x) >> 16); } while (0)
#define GLA_STORE() do { \
        *(LAS u32x4*)(lds + L_QS + lane * PQ + 16 * w) = pq0; *(LAS u32x4*)(lds + L_QS + lane * PQ + 128 + 16 * w) = pq1; \
        *(LAS u32x4*)(lds + L_KS + lane * PQ + 16 * w) = pk0; *(LAS u32x4*)(lds + L_KS + lane * PQ + 128 + 16 * w) = pk1; \
        GLA_T16(L_KT + 8 * w * PK, pk0.x, 0); GLA_T16(L_KT + 8 * w * PK, pk0.y, 1); GLA_T16(L_KT + 8 * w * PK, pk0.z, 2); GLA_T16(L_KT + 8 * w * PK, pk0.w, 3); \
        GLA_T16(L_KT + (64 + 8 * w) * PK, pk1.x, 0); GLA_T16(L_KT + (64 + 8 * w) * PK, pk1.y, 1); GLA_T16(L_KT + (64 + 8 * w) * PK, pk1.z, 2); GLA_T16(L_KT + (64 + 8 * w) * PK, pk1.w, 3); \
        GLA_T16(L_VT + 8 * w * PK, pv.x, 0); GLA_T16(L_VT + 8 * w * PK, pv.y, 1); GLA_T16(L_VT + 8 * w * PK, pv.z, 2); GLA_T16(L_VT + 8 * w * PK, pv.w, 3); \
        if (tid < 128) *(LAS float*)(lds + L_DEC + 4 * tid) = pdec; } while (0)
    GLA_LOAD(0);
    GLA_STORE();
    __syncthreads();
    for (int step = 0; step < 68; ++step) {
        const bool lat = step >= 4; const int chunk = GLA_CHUNK(step);
        if (step + 1 < 68) GLA_LOAD(step + 1);
        if (w < 4) {
            if (lat) {
                const int tb = w >> 1, vb = w & 1;
                bf16x8 bq[8]; f32x16 sc0 = {}, sc1 = {};
#pragma unroll
                for (int ks = 0; ks < 8; ++ks) {
                    bq[ks] = *(const LAS bf16x8*)(lds + L_QS + (32 * tb + r) * PQ + (16 * ks + 8 * hh) * 2);
                    const bf16x8 a0 = *(const LAS bf16x8*)(lds + L_KS + r * PQ + (16 * ks + 8 * hh) * 2), a1 = *(const LAS bf16x8*)(lds + L_KS + (32 + r) * PQ + (16 * ks + 8 * hh) * 2);
                    sc0 = __builtin_amdgcn_mfma_f32_32x32x16_bf16(a0, bq[ks], sc0, 0, 0, 0); sc1 = __builtin_amdgcn_mfma_f32_32x32x16_bf16(a1, bq[ks], sc1, 0, 0, 0);
                }
                const int t = 32 * tb + r;
#pragma unroll
                for (int i = 0; i < 16; ++i) { const int s0 = crow(i, hh), s1 = 32 + s0; const bool k0 = dir ? (s0 >= t) : (s0 <= t), k1 = dir ? (s1 >= t) : (s1 <= t); sc0[i] = k0 ? sc0[i] : 0.f; sc1[i] = k1 ? sc1[i] : 0.f; }
                f32x16 o = {};
#pragma unroll
                for (int sb = 0; sb < 2; ++sb)
#pragma unroll
                    for (int sp = 0; sp < 2; ++sp) {
                        u32x4 pw;
                        if (sb == 0) { pw.x = pk(sc0[8 * sp + 0], sc0[8 * sp + 1]); pw.y = pk(sc0[8 * sp + 2], sc0[8 * sp + 3]); pw.z = pk(sc0[8 * sp + 4], sc0[8 * sp + 5]); pw.w = pk(sc0[8 * sp + 6], sc0[8 * sp + 7]); }
                        else { pw.x = pk(sc1[8 * sp + 0], sc1[8 * sp + 1]); pw.y = pk(sc1[8 * sp + 2], sc1[8 * sp + 3]); pw.z = pk(sc1[8 * sp + 4], sc1[8 * sp + 5]); pw.w = pk(sc1[8 * sp + 6], sc1[8 * sp + 7]); }
                        const s16x4 lo = *(const LAS s16x4*)(lds + L_VT + (32 * vb + r) * PK + (32 * sb + 16 * sp + 4 * hh) * 2), hi = *(const LAS s16x4*)(lds + L_VT + (32 * vb + r) * PK + (32 * sb + 16 * sp + 8 + 4 * hh) * 2);
                        const bf16x8 av = {lo[0], lo[1], lo[2], lo[3], hi[0], hi[1], hi[2], hi[3]};
                        o = __builtin_amdgcn_mfma_f32_32x32x16_bf16(av, __builtin_bit_cast(bf16x8, pw), o, 0, 0, 0);
                    }
#pragma unroll
                for (int ks = 0; ks < 8; ++ks) {
                    const bf16x8 as = *(const LAS bf16x8*)(lds + L_SB + (32 * vb + r) * PQ + (16 * ks + 8 * hh) * 2);
                    o = __builtin_amdgcn_mfma_f32_32x32x16_bf16(as, bq[ks], o, 0, 0, 0);
                }
                bf16* orow = OG + ((size_t)chunk * 64 + t) * DM + 32 * vb + 4 * hh;
#pragma unroll
                for (int g = 0; g < 4; ++g) { u32x2 wv; wv.x = pk(o[4 * g], o[4 * g + 1]); wv.y = pk(o[4 * g + 2], o[4 * g + 3]); *(u32x2*)(orow + 8 * g) = wv; }
            }
        } else {
            const int db = w - 4;
#pragma unroll
            for (int ks = 0; ks < 4; ++ks) {
                const bf16x8 a = *(const LAS bf16x8*)(lds + L_KT + (32 * db + r) * PK + (16 * ks + 8 * hh) * 2);
                const bf16x8 b0 = *(const LAS bf16x8*)(lds + L_VT + r * PK + (16 * ks + 8 * hh) * 2), b1 = *(const LAS bf16x8*)(lds + L_VT + (32 + r) * PK + (16 * ks + 8 * hh) * 2);
                S0 = __builtin_amdgcn_mfma_f32_32x32x16_bf16(a, b0, S0, 0, 0, 0); S1 = __builtin_amdgcn_mfma_f32_32x32x16_bf16(a, b1, S1, 0, 0, 0);
            }
#pragma unroll
            for (int i = 0; i < 16; ++i) { const float dc = *(const LAS float*)(lds + L_DEC + 4 * (32 * db + crow(i, hh))); S0[i] *= dc; S1[i] *= dc; }
        }
        __syncthreads();
        if (step + 1 < 68) {
            GLA_STORE();
            if (w >= 4) { const int db = w - 4;
#pragma unroll
                for (int g = 0; g < 4; ++g) { u32x2 w0, w1; w0.x = pk(S0[4 * g], S0[4 * g + 1]); w0.y = pk(S0[4 * g + 2], S0[4 * g + 3]); w1.x = pk(S1[4 * g], S1[4 * g + 1]); w1.y = pk(S1[4 * g + 2], S1[4 * g + 3]);
                    *(LAS u32x2*)(lds + L_SB + r * PQ + (32 * db + 8 * g + 4 * hh) * 2) = w0; *(LAS u32x2*)(lds + L_SB + (32 + r) * PQ + (32 * db + 8 * g + 4 * hh) * 2) = w1; } }
        }
        __syncthreads();
    }
#undef GLA_CHUNK
#undef GLA_LOAD
#undef GLA_T16
#undef GLA_STORE
}
}
__device__ __forceinline__ void phase_scan_opt(const Frame& F, const Prm& p) {
    for (int unit = vcu_of(F); unit < 256; unit += F.G) gla::scan_unit(F, p, unit);
}
#define PHASE_QKV(F, p) phase_qkv_opt(F, p)
#define PHASE_ATTN(F, p) phase_attn2(F, p)
#define PHASE_WO(F, p, l) phase_wo_opt(F, p, l)
#define PHASE_MOE1(F, p, l) phase_moe1_opt(F, p, l)
#define PHASE_MOE2(F, p, l) phase_moe2_opt(F, p, l)
#define PHASE_INPROJ(F, p) phase_inproj_opt(F, p)
#define PHASE_SCAN(F, p) phase_scan_opt(F, p)
typedef GAS unsigned gu32;
#define XB_TMO      128
#define XB_XCNT(j)  (256  + 64 * (j))
#define XB_XSUB(j)  (1280 + 64 * (j))
#define XB_XGEN(j)  (2304 + 64 * (j))
#define XB_TOP      3328
#define XB_TOPGEN   3392
#define XCD_BAR_WORDS 3456
#define XB_SPIN_CAP (1u << 20)
__device__ __forceinline__ unsigned xb_ld(unsigned* p)              { return __hip_atomic_load(p, __ATOMIC_RELAXED, __HIP_MEMORY_SCOPE_AGENT); }
__device__ __forceinline__ unsigned xb_add(unsigned* p, unsigned v) { return __hip_atomic_fetch_add(p, v, __ATOMIC_RELAXED, __HIP_MEMORY_SCOPE_AGENT); }
__device__ __forceinline__ unsigned xb_xcc_id() { return (unsigned)__builtin_amdgcn_s_getreg((3 << 11) | 20) & 0xFu; }
#define XB_SPIN(cond, bar) do { unsigned _sp = 0; while (cond) { __builtin_amdgcn_s_sleep(1); \
    if ((++_sp & 255u) == 0u) { if (xb_ld(&(bar)[XB_TMO])) break; if (_sp > XB_SPIN_CAP) { atomicAdd(&(bar)[XB_TMO], 1u); break; } } } } while (0)
struct XcdBarrier { unsigned* bar; unsigned x; volatile LAS unsigned* st; };
__device__ __forceinline__ XcdBarrier xcd_barrier_post(unsigned* bar, volatile LAS unsigned* st) {
    XcdBarrier b; b.bar = bar; b.x = xb_xcc_id(); b.st = st;
    if (threadIdx.x == 0) (void)xb_add(&bar[XB_XCNT(b.x)], 1u);
    return b;
}
__device__ __forceinline__ void xcd_barrier_complete(unsigned* bar, unsigned x, unsigned& nloc, unsigned& nx) {
    const unsigned G = gridDim.x * gridDim.y * gridDim.z;
    unsigned sum, cnt, mine, sp = 0u;
    for (;;) {
        sum = 0u; cnt = 0u; mine = 0u;
#pragma unroll
        for (unsigned j = 0; j < 16; ++j) { const unsigned c = xb_ld(&bar[XB_XCNT(j)]); sum += c; cnt += (c > 0u) ? 1u : 0u; mine = (j == x) ? c : mine; }
        if (sum == G) break;
        __builtin_amdgcn_s_sleep(1);
        if ((++sp & 255u) == 0u) { if (xb_ld(&bar[XB_TMO])) break; if (sp > XB_SPIN_CAP) { atomicAdd(&bar[XB_TMO], 1u); break; } }
    }
    nloc = mine > 0u ? mine : 1u; nx = cnt > 0u ? cnt : 1u;
}
__device__ __forceinline__ void xcd_barrier(const XcdBarrier& b) {
    asm volatile("s_waitcnt vmcnt(0)" ::: "memory");
    __syncthreads();
    if (threadIdx.x == 0) {
        unsigned* bar = b.bar;
        __builtin_amdgcn_s_waitcnt(0);
        unsigned nloc = b.st[0], nx = b.st[1];
        if (nloc == 0u) { xcd_barrier_complete(bar, b.x, nloc, nx); b.st[0] = nloc; b.st[1] = nx; }
        const unsigned old = xb_add(&bar[XB_XSUB(b.x)], 1u);
        const unsigned gen = old / nloc;
        if (old + 1u == (gen + 1u) * nloc) {
            __builtin_amdgcn_fence(__ATOMIC_RELEASE, "agent");
            asm volatile("s_waitcnt vmcnt(0)" ::: "memory");
            const unsigned og = xb_add(&bar[XB_TOP], 1u);
            const unsigned tg = og / nx;
            if (og + 1u == (tg + 1u) * nx) xb_add(&bar[XB_TOPGEN], 1u);
            else XB_SPIN(xb_ld(&bar[XB_TOPGEN]) == tg, bar);
            __builtin_amdgcn_fence(__ATOMIC_ACQUIRE, "agent");
            xb_add(&bar[XB_XGEN(b.x)], 1u);
            asm volatile("s_waitcnt vmcnt(0)" ::: "memory");
        } else {
            XB_SPIN(xb_ld(&bar[XB_XGEN(b.x)]) == gen, bar);
            __builtin_amdgcn_fence(__ATOMIC_ACQUIRE, "agent");
            asm volatile("s_waitcnt vmcnt(0)" ::: "memory");
        }
    }
    __syncthreads();
}

constexpr int NPHASE = 19;
#ifndef OPT_MASK
#define OPT_MASK 0u
#endif
__global__ void __launch_bounds__(NTHR, 2) mega_fwd(Prm p) {
    extern __shared__ __attribute__((aligned(16))) unsigned char lds[];
    Frame F; F.lds = lds; F.ctl = (unsigned*)(p.ws + WS_CTL);
    F.tid = threadIdx.x; F.lane = F.tid & 63; F.wave = __builtin_amdgcn_readfirstlane(F.tid >> 6); F.G = gridDim.x; F.bid = blockIdx.x;
    for (int u = F.tid; u < (LDS_BYTES - LDSCTL_OFF) / 4; u += NTHR) ((LAS unsigned*)(lds + LDSCTL_OFF))[u] = 0u;
    __syncthreads();
    const int lo = p.ph_lo, hi = p.ph_hi;
    const bool multi = (hi - lo) > 1;
    XcdBarrier bar; bar.bar = F.ctl + CW_BAR + p.li * XCD_BAR_WORDS; bar.x = 0; bar.st = nullptr;
    if (multi) bar = xcd_barrier_post(F.ctl + CW_BAR + p.li * XCD_BAR_WORDS, (volatile LAS unsigned*)(lds + MISC_OFF) + 8);
#define IN(k) (lo <= (k) && (k) < hi)
#define SEAM(k) do { if (IN(k) && IN((k) + 1)) xcd_barrier(bar); } while (0)
#ifndef REP_MASK
#define REP_MASK 0u
#endif
#define REP(k, call) do { if (((REP_MASK) >> (k)) & 1u) { xcd_barrier(bar); call; } } while (0)
    if (IN(0)) { phase_prologue(F, p); REP(0, phase_prologue(F, p)); } SEAM(0);
    if (IN(1)) { phase_modulate0(F, p); REP(1, phase_modulate0(F, p)); } SEAM(1);
    if (IN(2)) { PHASE_QKV(F, p); REP(2, PHASE_QKV(F, p)); } SEAM(2);
    if (IN(3)) { PHASE_ATTN(F, p); REP(3, PHASE_ATTN(F, p)); } SEAM(3);
    if (IN(4)) { phase_attn_combine(F, p); REP(4, phase_attn_combine(F, p)); } SEAM(4);
    if (IN(5)) { PHASE_WO(F, p, 0); REP(5, PHASE_WO(F, p, 0)); } SEAM(5);
    if (IN(6)) { phase_ln_route(F, p, 0); REP(6, phase_ln_route(F, p, 0)); } SEAM(6);
    if (IN(7)) { PHASE_MOE1(F, p, 0); REP(7, PHASE_MOE1(F, p, 0)); } SEAM(7);
    if (IN(8)) { PHASE_MOE2(F, p, 0); REP(8, PHASE_MOE2(F, p, 0)); } SEAM(8);
    if (IN(9)) { phase_moe_combine(F, p, 0); REP(9, phase_moe_combine(F, p, 0)); } SEAM(9);
    if (IN(10)) { PHASE_INPROJ(F, p); REP(10, PHASE_INPROJ(F, p)); } SEAM(10);
    if (IN(11)) { phase_gla_prep(F, p); REP(11, phase_gla_prep(F, p)); } SEAM(11);
    if (IN(12)) { PHASE_SCAN(F, p); REP(12, PHASE_SCAN(F, p)); } SEAM(12);
    if (IN(13)) { phase_gla_post(F, p); REP(13, phase_gla_post(F, p)); } SEAM(13);
    if (IN(14)) { PHASE_WO(F, p, 1); REP(14, PHASE_WO(F, p, 1)); } SEAM(14);
    if (IN(15)) { phase_ln_route(F, p, 1); REP(15, phase_ln_route(F, p, 1)); } SEAM(15);
    if (IN(16)) { PHASE_MOE1(F, p, 1); REP(16, PHASE_MOE1(F, p, 1)); } SEAM(16);
    if (IN(17)) { PHASE_MOE2(F, p, 1); REP(17, PHASE_MOE2(F, p, 1)); } SEAM(17);
    if (IN(18)) { phase_moe_combine(F, p, 1); REP(18, phase_moe_combine(F, p, 1)); }
#undef IN
#undef SEAM
}

static void launch_naive(int ph, const Prm& p, hipStream_t stream) {
    using namespace naive;
    const bf16* H = (const bf16*)(p.ws + WS_H);
    switch (ph) {
    case 2: { NG g{H, (const bf16*)(p.ws + WS_WQKV), NTOK, 3072, 1024, 0, nullptr}; hipLaunchKernelGGL(gemm_kernel<EPI_QKV>, dim3(3072 / 64, NTOK / 64), dim3(256), 0, stream, g, p); break; }
    case 3: hipLaunchKernelGGL(attn_kernel, dim3(544, 16), dim3(256), 0, stream, p); break;
    case 5: { NG g{(const bf16*)(p.ws + WS_A2), (const bf16*)(p.ws + WS_WO), NTOK, 1024, 1024, 0, (bf16*)(p.ws + WS_Y)}; hipLaunchKernelGGL(gemm_kernel<EPI_PLAIN>, dim3(16, NTOK / 64), dim3(256), 0, stream, g, p); break; }
    case 7: case 16: { const int l = ph == 16; NG g{H, (const bf16*)(p.ws + (l ? WS_GU1 : WS_GU0)), MAXSLOT, 1024, 1024, l, nullptr}; hipLaunchKernelGGL(gemm_kernel<EPI_GATEUP>, dim3(16, MAXSLOT / 64), dim3(256), 0, stream, g, p); break; }
    case 8: case 17: { const int l = ph == 17; NG g{(const bf16*)(p.ws + WS_ACT), (const bf16*)(p.ws + (l ? WS_DN1 : WS_DN0)), MAXSLOT, 1024, 512, l, nullptr}; hipLaunchKernelGGL(gemm_kernel<EPI_DOWN>, dim3(16, MAXSLOT / 64), dim3(256), 0, stream, g, p); break; }
    case 10: { NG g{H, (const bf16*)(p.ws + WS_WIN), NTOK, NIN, 1024, 0, nullptr}; hipLaunchKernelGGL(gemm_kernel<EPI_INPROJ>, dim3(NIN / 64, NTOK / 64), dim3(256), 0, stream, g, p); break; }
    case 12: hipLaunchKernelGGL(gla_scan_kernel, dim3(512), dim3(256), GLA_SCAN_LDS, stream, p); break;
    case 14: { NG g{(const bf16*)(p.ws + WS_A2B), (const bf16*)(p.ws + WS_WGO), NLAT, 1024, 1024, 0, (bf16*)(p.ws + WS_Y)}; hipLaunchKernelGGL(gemm_kernel<EPI_PLAIN>, dim3(16, NLAT / 64), dim3(256), 0, stream, g, p); break; }
    default: break;
    }
}
extern "C" void kernel_launch(void* const* d_in, const int* in_sizes, int n_in, void* d_out, int out_size, void* d_ws, size_t ws_size, hipStream_t stream) {
    static int grid = 0;
    if (grid == 0) {
        if (n_in != 23 || in_sizes[0] != NLAT * DM || out_size != NLAT * DM || ws_size < WS_END) { fprintf(stderr, "kernel_launch: unexpected shapes (n_in %d, in0 %d, out %d, ws %zu); nothing launched\n", n_in, n_in > 0 ? in_sizes[0] : -1, out_size, ws_size); grid = -1; return; }
        int dev = 0, cus = 0;
        if (hipGetDevice(&dev) != hipSuccess || hipDeviceGetAttribute(&cus, hipDeviceAttributeMultiprocessorCount, dev) != hipSuccess) { grid = -1; return; }
        if (hipFuncSetAttribute((const void*)mega_fwd, hipFuncAttributeMaxDynamicSharedMemorySize, LDS_BYTES) != hipSuccess) { fprintf(stderr, "kernel_launch: hipFuncSetAttribute failed\n"); grid = -1; return; }
        (void)hipFuncSetAttribute((const void*)naive::gla_scan_kernel, hipFuncAttributeMaxDynamicSharedMemorySize, naive::GLA_SCAN_LDS);
        int per_cu = 0;
        if (hipOccupancyMaxActiveBlocksPerMultiprocessor(&per_cu, (const void*)mega_fwd, NTHR, LDS_BYTES) != hipSuccess || per_cu < 1) fprintf(stderr, "kernel_launch: note: occupancy query reports %d\n", per_cu);
        (void)hipGetLastError();
        grid = cus;
    }
    if (grid < 0) return;
    (void)hipMemsetAsync((char*)d_ws + WS_CTL, 0, CTL_ZERO_BYTES, stream);
    Prm p{};
    const float** pp = (const float**)&p;
    for (int i = 0; i < 23; ++i) pp[i] = (const float*)d_in[i];
    p.out = (float*)d_out; p.ws = (unsigned char*)d_ws;
    const unsigned naive_phases = (1u << 2) | (1u << 3) | (1u << 5) | (1u << 7) | (1u << 8) | (1u << 10) | (1u << 12) | (1u << 14) | (1u << 16) | (1u << 17);
    const unsigned use_naive = naive_phases & ~(unsigned)(OPT_MASK);
    int ph = 0, li = 0;
    while (ph < NPHASE) {
        if (use_naive & (1u << ph)) { launch_naive(ph, p, stream); ++ph; continue; }
        int e = ph + 1;
#if defined(ONE_PER_PHASE)
#else
        while (e < NPHASE && !(use_naive & (1u << e))) ++e;
#endif
        p.ph_lo = ph; p.ph_hi = e; p.li = li++;
        hipLaunchKernelGGL(mega_fwd, dim3(grid), dim3(NTHR), LDS_BYTES, stream, p);
        ph = e;
    }
}
```

```cpp
#define OPT_MASK 0x355ACu
#include <hip/hip_runtime.h>
#include <cstdint>
#include <cstdio>

constexpr int BATCH = 8, SEQ = 4096, DM = 1024, CTXL = 256;
constexpr int NLAT = BATCH * SEQ, NCTX = BATCH * CTXL, NTOK = NLAT + NCTX;
constexpr float ALPHA = 1.4142135623730951f;
constexpr float LN_EPS = 1e-5f;
constexpr float LAMBDA_INIT0 = 0.2f;
constexpr float C2 = 0.125f * 1.4426950408889634f;
constexpr int NEXP = 16, DEXP = 512, MAXSLOT = 73728;
constexpr int NCHUNK = NTOK / 64;
constexpr int NIN = 3328;

typedef unsigned short bf16;
typedef float f32x4 __attribute__((ext_vector_type(4)));
typedef float f32x2 __attribute__((ext_vector_type(2)));
typedef unsigned u32x2 __attribute__((ext_vector_type(2)));
typedef unsigned u32x4 __attribute__((ext_vector_type(4)));

constexpr size_t MiB = 1u << 20;
constexpr size_t WS_CTL = 0, CTL_ZERO_BYTES = 1 * MiB;
constexpr size_t WS_MOD = 1 * MiB;
constexpr size_t WS_MISC = 1 * MiB + 512 * 1024;
constexpr size_t WS_WQKV = 2 * MiB, WS_WO = 8 * MiB, WS_GU0 = 10 * MiB, WS_DN0 = 42 * MiB;
constexpr size_t WS_XCTX = 58 * MiB;
constexpr size_t WS_WIN = 66 * MiB, WS_WGO = 73 * MiB, WS_GU1 = 75 * MiB, WS_DN1 = 107 * MiB;
constexpr size_t WS_H = 123 * MiB;
constexpr size_t WS_Q = 191 * MiB, WS_K = 259 * MiB, WS_V = 327 * MiB, WS_O2 = 395 * MiB;
constexpr size_t WS_LIST = 463 * MiB;
constexpr size_t WS_TOKR = 466 * MiB;
constexpr size_t WS_DEC = 468 * MiB;
constexpr size_t WS_ZZ = 471 * MiB;
constexpr size_t WS_END = 480 * MiB;
constexpr size_t WS_O1 = WS_H, WS_A2 = WS_Q, WS_Y = WS_K;
constexpr size_t WS_YM = 191 * MiB, WS_ACT = 335 * MiB;
constexpr size_t WS_QR = 191 * MiB, WS_KR = 225 * MiB, WS_V1 = 259 * MiB, WS_R = 327 * MiB;
constexpr size_t WS_QT = WS_H, WS_KT = 395 * MiB;
constexpr size_t WS_OGF = 191 * MiB, WS_OGB = 2 * MiB;
constexpr size_t WS_A2B = WS_H;
constexpr int CW_TMO = 0, CW_CODE = 1;
constexpr int CW_CNT = 64;
constexpr int CW_BAR = 4096;

__device__ __forceinline__ unsigned f2bf(float f) { unsigned u = __builtin_bit_cast(unsigned, f); return (u + 0x7fffu + ((u >> 16) & 1u)) >> 16; }
__device__ __forceinline__ unsigned pk2(float lo, float hi) { return f2bf(lo) | (f2bf(hi) << 16); }
__device__ __forceinline__ float bf2f(unsigned b) { return __builtin_bit_cast(float, b << 16); }
__device__ __forceinline__ float wave_sum(float v) {
#pragma unroll
    for (int o = 1; o < 64; o <<= 1) v += __shfl_xor(v, o);
    return v;
}
__device__ __forceinline__ float silu_f(float v) { return v / (1.f + __expf(-v)); }

struct Prm {
    const float *x, *c, *ctx, *cctx, *ada_w, *ada_b, *ln_g, *ln_b, *w_qkv, *w_o, *lam, *subln, *gw_in, *gwg_down, *gwg_up, *gbg, *gnorm, *gw_o, *rw, *rb, *mg, *mu, *md;
    float* out; unsigned char* ws;
    int ph_lo, ph_hi, li, pad;
};
__device__ __forceinline__ void ld_row_f32(const float* p, int lane, f32x4 (&v)[4]) {
#pragma unroll
    for (int j = 0; j < 4; ++j) v[j] = *(const f32x4*)(p + 4 * lane + 256 * j);
}
__device__ __forceinline__ void st_row_f32(float* p, int lane, const f32x4 (&v)[4]) {
#pragma unroll
    for (int j = 0; j < 4; ++j) *(f32x4*)(p + 4 * lane + 256 * j) = v[j];
}
__device__ __forceinline__ void ld_row_bf16(const bf16* p, int lane, f32x4 (&v)[4]) {
#pragma unroll
    for (int j = 0; j < 4; ++j) { const u32x2 u = *(const u32x2*)(p + 4 * lane + 256 * j); v[j] = (f32x4){bf2f(u.x & 0xffffu), bf2f(u.x >> 16), bf2f(u.y & 0xffffu), bf2f(u.y >> 16)}; }
}
__device__ __forceinline__ void st_row_bf16(bf16* p, int lane, const f32x4 (&v)[4]) {
#pragma unroll
    for (int j = 0; j < 4; ++j) { u32x2 u; u.x = pk2(v[j].x, v[j].y); u.y = pk2(v[j].z, v[j].w); *(u32x2*)(p + 4 * lane + 256 * j) = u; }
}
__device__ __forceinline__ void ln_row(f32x4 (&v)[4], const float* g, const float* b, int lane) {
    float s = 0.f;
#pragma unroll
    for (int j = 0; j < 4; ++j) s += (v[j].x + v[j].y) + (v[j].z + v[j].w);
    const float mean = wave_sum(s) * (1.f / DM); float q = 0.f;
#pragma unroll
    for (int j = 0; j < 4; ++j) { v[j] = v[j] - mean; q += (v[j].x * v[j].x + v[j].y * v[j].y) + (v[j].z * v[j].z + v[j].w * v[j].w); }
    const float rstd = 1.f / sqrtf(wave_sum(q) * (1.f / DM) + LN_EPS);
#pragma unroll
    for (int j = 0; j < 4; ++j) { const f32x4 gg = *(const f32x4*)(g + 4 * lane + 256 * j), bb = *(const f32x4*)(b + 4 * lane + 256 * j); v[j] = v[j] * rstd * gg + bb; }
}
__host__ __device__ __forceinline__ int gu_phys(int other, int sel) { return (other >> 4) * 32 + sel * 16 + (other & 15); }
__host__ __device__ __forceinline__ int perm16b(int L) { return (L & ~31) | (16 * ((L >> 2) & 1) + 4 * ((L >> 3) & 3) + (L & 3)); }
__host__ __device__ __forceinline__ int perm16b_inv(int P) { return (P & ~31) | (8 * ((P >> 2) & 3) + 4 * ((P >> 4) & 1) + (P & 3)); }
#define GAS __attribute__((address_space(1)))
#define LAS __attribute__((address_space(3)))
constexpr int NWAVES = 8, NTHR = NWAVES * 64;
constexpr int RING_BYTES = 131072, LDSCTL_OFF = RING_BYTES, MISC_OFF = LDSCTL_OFF + 320, LDS_BYTES = 147456;
constexpr int LDSX_OFF = RING_BYTES + 1024;
#define LDS_WAIT() asm volatile("s_waitcnt lgkmcnt(0)" ::: "memory")
#define VM_WAIT() asm volatile("s_waitcnt vmcnt(0)" ::: "memory")

struct Frame {
    unsigned char* lds;
    unsigned* ctl;
    int tid, lane, wave, G, bid;
};

template <int MODE>
__device__ __forceinline__ void p0_transpose_item(const float* W, int K, int N, bf16* WT, int row_off, float* scr, int item, int lane) {
    const int nblk = N / 32, kb = item / nblk, nb = item % nblk, k0 = 64 * kb, n0 = 32 * nb;
#pragma unroll 8
    for (int i = 0; i < 32; ++i) { const int kk = 2 * i + (lane >> 5); scr[kk * 33 + (lane & 31)] = W[(size_t)(k0 + kk) * N + n0 + (lane & 31)]; }
    LDS_WAIT(); asm volatile("" ::: "memory");
    const int c = lane & 7;
#pragma unroll
    for (int j = 0; j < 4; ++j) { const int n = (lane >> 3) + 8 * j; const float* s = scr + (8 * c) * 33 + n;
        u32x4 o; o.x = pk2(s[0 * 33], s[1 * 33]); o.y = pk2(s[2 * 33], s[3 * 33]); o.z = pk2(s[4 * 33], s[5 * 33]); o.w = pk2(s[6 * 33], s[7 * 33]);
        const int nl = n0 + n; const int pr = (MODE == 0) ? (row_off + nl) : (MODE == 3) ? (row_off + perm16b(nl)) : (row_off + gu_phys(nl, MODE - 1));
        *(u32x4*)(WT + (size_t)pr * K + k0 + 8 * c) = o; }
    LDS_WAIT(); asm volatile("" ::: "memory");
}
__device__ __forceinline__ void phase_prologue(const Frame& F, const Prm& p) {
    float* sil = (float*)F.lds;
    for (int i = F.tid; i < 9 * 1024; i += NTHR) { const int r = i >> 10, k = i & 1023; const float v = (r < 8) ? p.c[r * 1024 + k] : p.cctx[k]; sil[i] = silu_f(v); }
    __syncthreads();
    float* MOD = (float*)(p.ws + WS_MOD);
    if (F.bid < 192) {
        const int layer = F.bid / 96, n = (F.bid % 96) * 64 + F.lane; const float* W = p.ada_w + (size_t)layer * 1024 * 6144 + n;
        float acc[9];
#pragma unroll
        for (int r = 0; r < 9; ++r) acc[r] = 0.f;
        const int kb = F.wave * 128;
#pragma unroll 4
        for (int k = kb; k < kb + 128; k += 4) {
            const float w0 = W[(size_t)k * 6144], w1 = W[(size_t)(k + 1) * 6144], w2 = W[(size_t)(k + 2) * 6144], w3 = W[(size_t)(k + 3) * 6144];
#pragma unroll
            for (int r = 0; r < 9; ++r) { const f32x4 s = *(const f32x4*)(sil + r * 1024 + k); acc[r] += s.x * w0 + s.y * w1 + s.z * w2 + s.w * w3; }
        }
        float* red = (float*)(F.lds + 36864 + 8 * 8704);
#pragma unroll
        for (int r = 0; r < 9; ++r) red[(F.wave * 9 + r) * 64 + F.lane] = acc[r];
        __syncthreads();
        if (F.wave == 0) { const float bb = p.ada_b[layer * 6144 + n];
#pragma unroll
            for (int r = 0; r < 9; ++r) { float t = bb;
#pragma unroll
                for (int w = 0; w < 8; ++w) t += red[(w * 9 + r) * 64 + F.lane];
                MOD[(layer * 9 + r) * 6144 + n] = t; } }
    }
    float* misc = (float*)(p.ws + WS_MISC);
    if (F.bid == 255 % F.G && F.wave == 1) {
        const float a = wave_sum(p.lam[F.lane] * p.lam[64 + F.lane]), b = wave_sum(p.lam[128 + F.lane] * p.lam[192 + F.lane]);
        if (F.lane == 0) misc[0] = __expf(a) - __expf(b) + LAMBDA_INIT0;
        for (int i = F.lane; i < 1024; i += 64) { const int pos = i >> 4, f = i & 15; const float inv = powf(10000.f, -(float)f / 16.f); const float ang = (float)pos * inv;
            misc[1024 + 2 * i] = cosf(ang); misc[1024 + 2 * i + 1] = sinf(ang); }
    }
    float* scr = (float*)(F.lds + 36864 + F.wave * 8704);
    const int gw = F.bid * NWAVES + F.wave, NGW = F.G * NWAVES;
    constexpr int I_QKV = 16 * 96, I_SQ = 16 * 32, I_G = 16 * 16, I_D = 8 * 32;
    constexpr int I_MOE = 2 * I_G + I_D;
    constexpr int NITEMS = 2 * I_QKV + 2 * I_SQ + 32 * I_MOE;
    bf16* ws16 = (bf16*)p.ws;
    for (int it = gw; it < NITEMS; it += NGW) {
        int r = it;
        if (r < I_QKV) { if ((r % 96) < 64) p0_transpose_item<0>(p.w_qkv, 1024, 3072, (bf16*)(p.ws + WS_WQKV), 0, scr, r, F.lane); else p0_transpose_item<3>(p.w_qkv, 1024, 3072, (bf16*)(p.ws + WS_WQKV), 0, scr, r, F.lane); continue; } r -= I_QKV;
        if (r < I_QKV) { p0_transpose_item<3>(p.gw_in, 1024, 3072, (bf16*)(p.ws + WS_WIN), 0, scr, r, F.lane); continue; } r -= I_QKV;
        if (r < I_SQ) { p0_transpose_item<3>(p.w_o, 1024, 1024, (bf16*)(p.ws + WS_WO), 0, scr, r, F.lane); continue; } r -= I_SQ;
        if (r < I_SQ) { p0_transpose_item<3>(p.gw_o, 1024, 1024, (bf16*)(p.ws + WS_WGO), 0, scr, r, F.lane); continue; } r -= I_SQ;
        const int le = r / I_MOE, layer = le >> 4, e = le & 15; r -= le * I_MOE;
        bf16* GU = (bf16*)(p.ws + (layer ? WS_GU1 : WS_GU0)) + (size_t)e * 1024 * 1024; bf16* DN = (bf16*)(p.ws + (layer ? WS_DN1 : WS_DN0)) + (size_t)e * 1024 * 512;
        if (r < I_G) { p0_transpose_item<1>(p.mg + (size_t)le * 1024 * 512, 1024, 512, GU, 0, scr, r, F.lane); continue; } r -= I_G;
        if (r < I_G) { p0_transpose_item<2>(p.mu + (size_t)le * 1024 * 512, 1024, 512, GU, 0, scr, r, F.lane); continue; } r -= I_G;
        p0_transpose_item<3>(p.md + (size_t)le * 512 * 1024, 512, 1024, DN, 0, scr, r, F.lane);
    }
    (void)ws16;
    bf16* WIN = (bf16*)(p.ws + WS_WIN);
    for (int i = gw * 64 + F.lane; i < 32 * 1024; i += NGW * 64) { const int rr = i >> 10, k = i & 1023, dir = rr >> 4, j = rr & 15;
        WIN[(size_t)(3072 + rr) * 1024 + k] = (bf16)f2bf(p.gwg_down[(size_t)dir * 1024 * 16 + k * 16 + j]); }
    for (int i = gw * 64 + F.lane; i < 224 * 1024 / 8; i += NGW * 64) *(u32x4*)(WIN + (size_t)3104 * 1024 + (size_t)i * 8) = (u32x4){0u, 0u, 0u, 0u};
}

__device__ __forceinline__ void phase_modulate0(const Frame& F, const Prm& p) {
    const float* MOD = (const float*)(p.ws + WS_MOD); bf16* H = (bf16*)(p.ws + WS_H);
    const int gw = F.bid * NWAVES + F.wave, NGW = F.G * NWAVES, per = (NTOK + NGW - 1) / NGW;
    int curmod = -1; f32x4 sh[4], sc[4];
    for (int tok = gw * per; tok < (gw + 1) * per && tok < NTOK; ++tok) {
        const int mr = tok < NLAT ? tok / SEQ : 8; const float* src = tok < NLAT ? p.x + (size_t)tok * DM : p.ctx + (size_t)(tok - NLAT) * DM;
        if (mr != curmod) { curmod = mr; ld_row_f32(MOD + mr * 6144, F.lane, sh); ld_row_f32(MOD + mr * 6144 + 1024, F.lane, sc); }
        f32x4 v[4]; ld_row_f32(src, F.lane, v);
#pragma unroll
        for (int j = 0; j < 4; ++j) v[j] = v[j] * (1.f + sc[j]) + sh[j];
        st_row_bf16(H + (size_t)tok * DM, F.lane, v);
    }
}

__device__ __forceinline__ void phase_attn_combine(const Frame& F, const Prm& p) {
    const bf16* O1 = (const bf16*)(p.ws + WS_O1); const bf16* O2 = (const bf16*)(p.ws + WS_O2); bf16* A2 = (bf16*)(p.ws + WS_A2);
    const float lam = ((const float*)(p.ws + WS_MISC))[0];
    const f32x4 sg = *(const f32x4*)(p.subln + 4 * (F.lane & 31));
    const int gw = F.bid * NWAVES + F.wave, NGW = F.G * NWAVES;
    for (int tok = gw; tok < NTOK; tok += NGW) {
        f32x4 a[4], b[4]; ld_row_bf16(O1 + (size_t)tok * DM, F.lane, a); ld_row_bf16(O2 + (size_t)tok * DM, F.lane, b);
#pragma unroll
        for (int j = 0; j < 4; ++j) {
            f32x4 o = a[j] - lam * b[j]; float q = (o.x * o.x + o.y * o.y) + (o.z * o.z + o.w * o.w);
#pragma unroll
            for (int s = 1; s < 32; s <<= 1) q += __shfl_xor(q, s);
            const float r = (1.f - LAMBDA_INIT0) / sqrtf(q * (1.f / 128.f) + LN_EPS);
            a[j] = o * r * sg;
        }
        st_row_bf16(A2 + (size_t)tok * DM, F.lane, a);
    }
}

__device__ __forceinline__ void phase_ln_route(const Frame& F, const Prm& p, int layer) {
    const int nrows = layer ? NLAT : NTOK;
    const float* MOD = (const float*)(p.ws + WS_MOD) + layer * 9 * 6144;
    const bf16* Y = (const bf16*)(p.ws + WS_Y); bf16* HF = (bf16*)(p.ws + WS_H);
    float* XCTX = (float*)(p.ws + WS_XCTX);
    int* LIST = (int*)(p.ws + WS_LIST); int* TOKR = (int*)(p.ws + WS_TOKR);
    unsigned* CNT = F.ctl + CW_CNT + layer * 16;
    float* WrT = (float*)F.lds;
    int* rec = (int*)(F.lds + 65536);
    unsigned* lcnt = (unsigned*)(F.lds + 65536 + 8192); unsigned* lbase = lcnt + 16;
    for (int i = F.tid; i < 16 * 1024; i += NTHR) { const int k = i >> 4, e = i & 15; WrT[e * 1024 + k] = p.rw[i]; }
    if (F.tid < 16) lcnt[F.tid] = 0u;
    __syncthreads();
    const int per_wg = (nrows + F.G - 1) / F.G, per_w = (per_wg + NWAVES - 1) / NWAVES;
    const int row_lo = F.bid * per_wg, row_hi = min(nrows, row_lo + per_wg);
    const float* lng = p.ln_g + (layer * 2 + 0) * DM; const float* lnb = p.ln_b + (layer * 2 + 0) * DM;
    float rb[16];
#pragma unroll
    for (int e = 0; e < 16; ++e) rb[e] = p.rb[e];
    int curmod = -1; f32x4 gm[4], shf[4], scf[4];
    for (int i = 0; i < per_w; ++i) {
        const int lr = F.wave * per_w + i, tok = row_lo + lr; if (tok >= row_hi) break;
        const int mr = tok < NLAT ? tok / SEQ : 8;
        if (mr != curmod) { curmod = mr; ld_row_f32(MOD + mr * 6144 + 2048, F.lane, gm); ld_row_f32(MOD + mr * 6144 + 3072, F.lane, shf); ld_row_f32(MOD + mr * 6144 + 4096, F.lane, scf); }
        float* xdst = tok < NLAT ? p.out + (size_t)tok * DM : XCTX + (size_t)(tok - NLAT) * DM;
        const float* xsrc = layer ? (const float*)xdst : (tok < NLAT ? p.x + (size_t)tok * DM : p.ctx + (size_t)(tok - NLAT) * DM);
        f32x4 v[4], y[4]; ld_row_f32(xsrc, F.lane, v); ld_row_bf16(Y + (size_t)tok * DM, F.lane, y);
#pragma unroll
        for (int j = 0; j < 4; ++j) v[j] = ALPHA * v[j] + gm[j] * y[j];
        ln_row(v, lng, lnb, F.lane);
        st_row_f32(xdst, F.lane, v);
#pragma unroll
        for (int j = 0; j < 4; ++j) v[j] = v[j] * (1.f + scf[j]) + shf[j];
        st_row_bf16(HF + (size_t)tok * DM, F.lane, v);
        float part[16];
#pragma unroll
        for (int e = 0; e < 16; ++e) { float s = 0.f;
#pragma unroll
            for (int j = 0; j < 4; ++j) { const f32x4 w = *(const f32x4*)(WrT + e * 1024 + 4 * F.lane + 256 * j); s += (v[j].x * w.x + v[j].y * w.y) + (v[j].z * w.z + v[j].w * w.w); }
            part[e] = s; }
        {
#pragma unroll
            for (int e = 0; e < 8; ++e) { const bool up = (F.lane & 32) != 0; const float keep = up ? part[e + 8] : part[e], send = up ? part[e] : part[e + 8]; part[e] = keep + __shfl_xor(send, 32); }
#pragma unroll
            for (int e = 0; e < 4; ++e) { const bool up = (F.lane & 16) != 0; const float keep = up ? part[e + 4] : part[e], send = up ? part[e] : part[e + 4]; part[e] = keep + __shfl_xor(send, 16); }
#pragma unroll
            for (int e = 0; e < 2; ++e) { const bool up = (F.lane & 8) != 0; const float keep = up ? part[e + 2] : part[e], send = up ? part[e] : part[e + 2]; part[e] = keep + __shfl_xor(send, 8); }
            { const bool up = (F.lane & 4) != 0; const float keep = up ? part[1] : part[0], send = up ? part[0] : part[1]; part[0] = keep + __shfl_xor(send, 4); }
            part[0] += __shfl_xor(part[0], 2); part[0] += __shfl_xor(part[0], 1);
        }
        float aff[16], sel[16];
#pragma unroll
        for (int e = 0; e < 16; ++e) { const int src = ((e >> 3) & 1) * 32 + ((e >> 2) & 1) * 16 + ((e >> 1) & 1) * 8 + (e & 1) * 4; const float lg = __shfl(part[0], src); aff[e] = 1.f / (1.f + __expf(-lg)); sel[e] = aff[e] + rb[e]; }
        int bg = 0; float bgs = -3.0e38f;
#pragma unroll
        for (int g = 0; g < 4; ++g) { float m1 = -3.0e38f, m2 = -3.0e38f;
#pragma unroll
            for (int k = 0; k < 4; ++k) { const float s = sel[4 * g + k]; if (s > m1) { m2 = m1; m1 = s; } else if (s > m2) m2 = s; }
            const float gs = m1 + m2; if (gs > bgs) { bgs = gs; bg = g; } }
        int i1 = 0, i2 = 0; float s1 = -3.0e38f, s2 = -3.0e38f, a1 = 0.f, a2 = 0.f;
#pragma unroll
        for (int g = 0; g < 4; ++g) if (g == bg) {
#pragma unroll
            for (int k = 0; k < 4; ++k) { const float s = sel[4 * g + k], a = aff[4 * g + k];
                if (s > s1) { s2 = s1; i2 = i1; a2 = a1; s1 = s; i1 = 4 * g + k; a1 = a; } else if (s > s2) { s2 = s; i2 = 4 * g + k; a2 = a; } } }
        const float wsum = a1 + a2, w1 = a1 / wsum, w2 = a2 / wsum;
        if (F.lane == 0) { const unsigned l1 = atomicAdd(&lcnt[i1], 1u), l2 = atomicAdd(&lcnt[i2], 1u);
            rec[lr * 6 + 0] = i1; rec[lr * 6 + 1] = i2; rec[lr * 6 + 2] = (int)l1; rec[lr * 6 + 3] = (int)l2; rec[lr * 6 + 4] = __float_as_int(w1); rec[lr * 6 + 5] = __float_as_int(w2); }
    }
    __syncthreads();
    if (F.tid < 16) lbase[F.tid] = __hip_atomic_fetch_add(&CNT[F.tid], lcnt[F.tid], __ATOMIC_RELAXED, __HIP_MEMORY_SCOPE_AGENT);
    __syncthreads();
    for (int lr = F.tid; lr < row_hi - row_lo; lr += NTHR) { const int tok = row_lo + lr;
        const int e0 = rec[lr * 6], e1 = rec[lr * 6 + 1]; const int p0 = (int)lbase[e0] + rec[lr * 6 + 2], p1 = (int)lbase[e1] + rec[lr * 6 + 3];
        LIST[e0 * NTOK + p0] = tok; LIST[e1 * NTOK + p1] = tok;
        int* tr = TOKR + (size_t)tok * 8; tr[0] = e0; tr[1] = p0; tr[2] = e1; tr[3] = p1; tr[4] = rec[lr * 6 + 4]; tr[5] = rec[lr * 6 + 5]; }
    __syncthreads();
}

__device__ __forceinline__ void pad_bases(const unsigned* cnt, int (&pb)[17]) {
    int acc = 0;
#pragma unroll
    for (int e = 0; e < 16; ++e) { pb[e] = acc; const int c = (int)__hip_atomic_load(cnt + e, __ATOMIC_RELAXED, __HIP_MEMORY_SCOPE_AGENT); acc += (c + 255) & ~255; }
    pb[16] = acc;
}

__device__ __forceinline__ void phase_moe_combine(const Frame& F, const Prm& p, int layer) {
    const int nrows = layer ? NLAT : NTOK;
    const float* MOD = (const float*)(p.ws + WS_MOD) + layer * 9 * 6144; const float* MOD1 = (const float*)(p.ws + WS_MOD) + 9 * 6144;
    const bf16* YM = (const bf16*)(p.ws + WS_YM); bf16* H = (bf16*)(p.ws + WS_H); float* XCTX = (float*)(p.ws + WS_XCTX); const int* TOKR = (const int*)(p.ws + WS_TOKR);
    int pb[17]; pad_bases(F.ctl + CW_CNT + layer * 16, pb);
    int* pbl = (int*)F.lds; if (F.tid < 17) { int v = 0;
#pragma unroll
        for (int e = 0; e < 17; ++e) if (e == F.tid) v = pb[e];
        pbl[F.tid] = v; }
    __syncthreads();
    const float* lng = p.ln_g + (layer * 2 + 1) * DM; const float* lnb = p.ln_b + (layer * 2 + 1) * DM;
    const int gw = F.bid * NWAVES + F.wave, NGW = F.G * NWAVES, per = (nrows + NGW - 1) / NGW;
    int curmod = -1; f32x4 gf[4], sh1[4], sc1[4];
    for (int tok = gw * per; tok < (gw + 1) * per && tok < nrows; ++tok) {
        const int mr = tok < NLAT ? tok / SEQ : 8;
        if (mr != curmod) { curmod = mr; ld_row_f32(MOD + mr * 6144 + 5120, F.lane, gf); if (!layer) { ld_row_f32(MOD1 + mr * 6144, F.lane, sh1); ld_row_f32(MOD1 + mr * 6144 + 1024, F.lane, sc1); } }
        const int* tr = TOKR + (size_t)tok * 8; const int s0 = pbl[tr[0]] + tr[1], s1 = pbl[tr[2]] + tr[3]; const float w0 = __int_as_float(tr[4]), w1 = __int_as_float(tr[5]);
        float* xp = tok < NLAT ? p.out + (size_t)tok * DM : XCTX + (size_t)(tok - NLAT) * DM;
        f32x4 v[4], a[4], b[4]; ld_row_f32(xp, F.lane, v); ld_row_bf16(YM + (size_t)s0 * DM, F.lane, a); ld_row_bf16(YM + (size_t)s1 * DM, F.lane, b);
#pragma unroll
        for (int j = 0; j < 4; ++j) v[j] = ALPHA * v[j] + gf[j] * (w0 * a[j] + w1 * b[j]);
        ln_row(v, lng, lnb, F.lane);
        st_row_f32(xp, F.lane, v);
        if (!layer) {
#pragma unroll
            for (int j = 0; j < 4; ++j) v[j] = v[j] * (1.f + sc1[j]) + sh1[j];
            st_row_bf16(H + (size_t)tok * DM, F.lane, v);
        }
    }
}

__device__ __forceinline__ void phase_gla_prep(const Frame& F, const Prm& p) {
    const bf16* QR = (const bf16*)(p.ws + WS_QR); const bf16* KR = (const bf16*)(p.ws + WS_KR); const float* ZZ = (const float*)(p.ws + WS_ZZ);
    bf16* QT = (bf16*)(p.ws + WS_QT); bf16* KT = (bf16*)(p.ws + WS_KT); float* DEC = (float*)(p.ws + WS_DEC);
    const int gw = F.bid * NWAVES + F.wave, NGW = F.G * NWAVES;
    for (int task = gw; task < 2 * NCHUNK * 8; task += NGW) {
        const int dh = task & 7, chunk = (task >> 3) % NCHUNK, dir = __builtin_amdgcn_readfirstlane(task / (8 * NCHUNK));
        const int col = dh * 64 + F.lane, tok0 = chunk * 64;
        unsigned short qv[64], kv[64];
#pragma unroll
        for (int t = 0; t < 64; ++t) { qv[t] = QR[(size_t)(tok0 + t) * 512 + col]; kv[t] = KR[(size_t)(tok0 + t) * 512 + col]; }
        f32x4 zl[4];
#pragma unroll
        for (int j = 0; j < 4; ++j) zl[j] = *(const f32x4*)(ZZ + (size_t)(tok0 + F.lane) * 32 + dir * 16 + 4 * j);
        float wup[16];
#pragma unroll
        for (int j = 0; j < 16; ++j) wup[j] = p.gwg_up[(size_t)dir * 16 * 512 + j * 512 + col];
        const float bgv = p.gbg[dir * 512 + col];
        float b = 0.f;
        bf16* qo = QT + ((size_t)dir * NTOK + tok0) * 512 + col; bf16* ko = KT + ((size_t)dir * NTOK + tok0) * 512 + col;
#pragma unroll
        for (int tt = 0; tt < 64; ++tt) {
            float z = bgv;
#pragma unroll
            for (int j = 0; j < 4; ++j) { const int tl = dir ? 63 - tt : tt;
                const float z0 = __int_as_float(__builtin_amdgcn_readlane(__float_as_int(zl[j].x), tl)), z1 = __int_as_float(__builtin_amdgcn_readlane(__float_as_int(zl[j].y), tl));
                const float z2 = __int_as_float(__builtin_amdgcn_readlane(__float_as_int(zl[j].z), tl)), z3 = __int_as_float(__builtin_amdgcn_readlane(__float_as_int(zl[j].w), tl));
                z += z0 * wup[4 * j] + z1 * wup[4 * j + 1] + z2 * wup[4 * j + 2] + z3 * wup[4 * j + 3]; }
            const float g = (fminf(z, 0.f) - __logf(1.f + __expf(-fabsf(z)))) * (1.f / 16.f);
            b += g;
            const float e = __expf(b), ei = __builtin_amdgcn_rcpf(e);
            const float q = dir ? bf2f(qv[63 - tt]) : bf2f(qv[tt]), k = dir ? bf2f(kv[63 - tt]) : bf2f(kv[tt]);
            const int t = dir ? 63 - tt : tt;
            qo[(size_t)t * 512] = (bf16)f2bf(q * e); ko[(size_t)t * 512] = (bf16)f2bf(k * ei);
        }
        DEC[((size_t)dir * NCHUNK + chunk) * 512 + col] = __expf(b);
    }
}

__device__ __forceinline__ void phase_gla_post(const Frame& F, const Prm& p) {
    const bf16* OF = (const bf16*)(p.ws + WS_OGF); const bf16* OB = (const bf16*)(p.ws + WS_OGB); const bf16* R = (const bf16*)(p.ws + WS_R); bf16* A2 = (bf16*)(p.ws + WS_A2B);
    const f32x4 ng = *(const f32x4*)(p.gnorm + 4 * F.lane);
    const int gw = F.bid * NWAVES + F.wave, NGW = F.G * NWAVES;
    for (int tok = gw; tok < NLAT; tok += NGW) {
        f32x4 a[4], b[4], r[4]; ld_row_bf16(OF + (size_t)tok * DM, F.lane, a); ld_row_bf16(OB + (size_t)tok * DM, F.lane, b); ld_row_bf16(R + (size_t)tok * DM, F.lane, r);
#pragma unroll
        for (int j = 0; j < 4; ++j) {
            const f32x4 o = a[j] + b[j]; const float q = wave_sum((o.x * o.x + o.y * o.y) + (o.z * o.z + o.w * o.w));
            const float rs = 1.f / sqrtf(q * (1.f / 256.f) + LN_EPS);
            a[j] = (f32x4){o.x * rs * ng.x * silu_f(r[j].x), o.y * rs * ng.y * silu_f(r[j].y), o.z * rs * ng.z * silu_f(r[j].z), o.w * rs * ng.w * silu_f(r[j].w)};
        }
        st_row_bf16(A2 + (size_t)tok * DM, F.lane, a);
    }
}
namespace naive {
enum { EPI_QKV = 0, EPI_PLAIN = 1, EPI_GATEUP = 2, EPI_DOWN = 3, EPI_INPROJ = 4 };
struct NG { const bf16* A; const bf16* Bt; int M, N, K; int layer; bf16* O; };
template <int EPI> __global__ __launch_bounds__(256) void gemm_kernel(NG g, Prm p) {
    __shared__ float As[64][33], Bs[64][33], Cs[64][65]; __shared__ int rowsrc[64];
    const int tid = threadIdx.x, n0 = blockIdx.x * 64, m0 = blockIdx.y * 64, ty = tid >> 4, tx = tid & 15;
    const bf16* Bt = g.Bt; int e = 0, ebase = 0, ecnt = 0;
    if (EPI == EPI_GATEUP || EPI == EPI_DOWN) {
        const unsigned* cnt = (const unsigned*)(p.ws + WS_CTL) + CW_CNT + g.layer * 16; int acc = 0; bool found = false;
        for (int i = 0; i < 16; ++i) { const int c = (int)cnt[i], pc = (c + 255) & ~255; if (!found && m0 < acc + pc) { e = i; ebase = acc; ecnt = c; found = true; } acc += pc; }
        if (!found || m0 - ebase >= ecnt) return;
        Bt += (size_t)e * g.N * g.K;
    }
    if (tid < 64) { int r = m0 + tid;
        if (EPI == EPI_GATEUP) { const int li = m0 - ebase + tid; const int* LIST = (const int*)(p.ws + WS_LIST); r = (li < ecnt) ? LIST[e * NTOK + li] : 0; }
        rowsrc[tid] = r; }
    __syncthreads();
    float acc[4][4] = {};
    for (int k0 = 0; k0 < g.K; k0 += 32) {
        { const int r = tid >> 2, kc = (tid & 3) * 8; const u32x4 ua = *(const u32x4*)(g.A + (size_t)rowsrc[r] * g.K + k0 + kc), ub = *(const u32x4*)(Bt + (size_t)(n0 + r) * g.K + k0 + kc);
            const unsigned a4[4] = {ua.x, ua.y, ua.z, ua.w}, b4[4] = {ub.x, ub.y, ub.z, ub.w};
#pragma unroll
            for (int i = 0; i < 4; ++i) { As[r][kc + 2 * i] = bf2f(a4[i] & 0xffffu); As[r][kc + 2 * i + 1] = bf2f(a4[i] >> 16); Bs[r][kc + 2 * i] = bf2f(b4[i] & 0xffffu); Bs[r][kc + 2 * i + 1] = bf2f(b4[i] >> 16); } }
        __syncthreads();
#pragma unroll 8
        for (int kk = 0; kk < 32; ++kk) { float a[4], b[4];
#pragma unroll
            for (int i = 0; i < 4; ++i) { a[i] = As[4 * ty + i][kk]; b[i] = Bs[4 * tx + i][kk]; }
#pragma unroll
            for (int i = 0; i < 4; ++i)
#pragma unroll
                for (int j = 0; j < 4; ++j) acc[i][j] += a[i] * b[j]; }
        __syncthreads();
    }
#pragma unroll
    for (int i = 0; i < 4; ++i)
#pragma unroll
        for (int j = 0; j < 4; ++j) Cs[4 * ty + i][4 * tx + j] = acc[i][j];
    __syncthreads();
    const float* rope = (const float*)(p.ws + WS_MISC) + 1024;
    for (int idx = tid; idx < 4096; idx += 256) {
        const int r = idx >> 6, cc = idx & 63, row = m0 + r; int n = n0 + cc; const float val = Cs[r][cc];
        if (EPI == EPI_PLAIN || EPI == EPI_DOWN || (EPI == EPI_INPROJ && n < 3072) || (EPI == EPI_QKV && n >= 2048)) n = perm16b_inv(n);
        if (EPI == EPI_QKV) {
            if (n < 2048) { float o = val;
                if (row < NLAT) { const int d = n & 63, s = row & (SEQ - 1), pos = (d & 32) ? (s & 63) : (s >> 6), f = d & 15; const float cs = rope[(pos * 16 + f) * 2], sn = rope[(pos * 16 + f) * 2 + 1];
                    o = (d & 16) ? val * cs + Cs[r][cc - 16] * sn : val * cs - Cs[r][cc + 16] * sn; }
                if (n < 1024) ((bf16*)(p.ws + WS_Q))[(size_t)row * DM + n] = (bf16)f2bf(o * C2); else ((bf16*)(p.ws + WS_K))[(size_t)row * DM + n - 1024] = (bf16)f2bf(o);
            } else ((bf16*)(p.ws + WS_V))[(size_t)row * DM + n - 2048] = (bf16)f2bf(val);
        } else if (EPI == EPI_PLAIN) { g.O[(size_t)row * g.N + n] = (bf16)f2bf(val);
        } else if (EPI == EPI_GATEUP) { if (!(cc & 16)) { const float gt = val, up = Cs[r][cc + 16]; const int other = (n >> 5) * 16 + (n & 15); ((bf16*)(p.ws + WS_ACT))[(size_t)row * DEXP + other] = (bf16)f2bf(silu_f(gt) * up); }
        } else if (EPI == EPI_DOWN) { ((bf16*)(p.ws + WS_YM))[(size_t)row * DM + n] = (bf16)f2bf(val);
        } else if (EPI == EPI_INPROJ) {
            if (n < 512) ((bf16*)(p.ws + WS_QR))[(size_t)row * 512 + n] = (bf16)f2bf(val * 0.08838834764831845f);
            else if (n < 1024) ((bf16*)(p.ws + WS_KR))[(size_t)row * 512 + n - 512] = (bf16)f2bf(val);
            else if (n < 2048) ((bf16*)(p.ws + WS_V1))[(size_t)row * DM + n - 1024] = (bf16)f2bf(val);
            else if (n < 3072) ((bf16*)(p.ws + WS_R))[(size_t)row * DM + n - 2048] = (bf16)f2bf(val);
            else if (n < 3104) ((float*)(p.ws + WS_ZZ))[(size_t)row * 32 + n - 3072] = val;
        }
    }
}
__global__ __launch_bounds__(256) void attn_kernel(Prm p) {
    __shared__ float Qs[64][65], Ks[32][65], Ps[64][33], Vs[32][129], al[64];
    const bf16* Q = (const bf16*)(p.ws + WS_Q); const bf16* K = (const bf16*)(p.ws + WS_K); const bf16* V = (const bf16*)(p.ws + WS_V);
    const int tid = threadIdx.x, ty = tid >> 4, tx = tid & 15, qb = blockIdx.x, hm = blockIdx.y, h = hm >> 1;
    const bool lat = qb < 512; const int b = lat ? qb >> 6 : (qb - 512) >> 2; const int tok0 = lat ? qb * 64 : NLAT + (qb - 512) * 64;
    bf16* O = (bf16*)(p.ws + ((hm & 1) ? WS_O2 : WS_O1));
    for (int i = tid; i < 4096; i += 256) { const int r = i >> 6, d = i & 63; Qs[r][d] = bf2f(Q[(size_t)(tok0 + r) * DM + hm * 64 + d]); }
    float o[4][8] = {}; float mrow = -3.0e38f, lrow = 0.f;
    const int nkt = lat ? (CTXL + SEQ) / 32 : CTXL / 32;
    for (int kt = 0; kt < nkt; ++kt) {
        const int key0 = (kt < CTXL / 32) ? NLAT + b * CTXL + kt * 32 : b * SEQ + (kt - CTXL / 32) * 32;
        __syncthreads();
        for (int i = tid; i < 2048; i += 256) { const int r = i >> 6, d = i & 63; Ks[r][d] = bf2f(K[(size_t)(key0 + r) * DM + hm * 64 + d]); }
        for (int i = tid; i < 4096; i += 256) { const int r = i >> 7, d = i & 127; Vs[r][d] = bf2f(V[(size_t)(key0 + r) * DM + h * 128 + d]); }
        __syncthreads();
        float s[4][2] = {};
        for (int d = 0; d < 64; ++d) { float a[4], bb[2];
#pragma unroll
            for (int i = 0; i < 4; ++i) a[i] = Qs[4 * ty + i][d];
            bb[0] = Ks[2 * tx][d]; bb[1] = Ks[2 * tx + 1][d];
#pragma unroll
            for (int i = 0; i < 4; ++i) { s[i][0] += a[i] * bb[0]; s[i][1] += a[i] * bb[1]; } }
#pragma unroll
        for (int i = 0; i < 4; ++i) { Ps[4 * ty + i][2 * tx] = s[i][0]; Ps[4 * ty + i][2 * tx + 1] = s[i][1]; }
        __syncthreads();
        if (tid < 64) { float mx = mrow;
            for (int j = 0; j < 32; ++j) mx = fmaxf(mx, Ps[tid][j]);
            const float a = exp2f(mrow - mx); float sum = 0.f;
            for (int j = 0; j < 32; ++j) { const float e = exp2f(Ps[tid][j] - mx); Ps[tid][j] = e; sum += e; }
            lrow = lrow * a + sum; mrow = mx; al[tid] = a; }
        __syncthreads();
#pragma unroll
        for (int i = 0; i < 4; ++i) { const float a = al[4 * ty + i];
#pragma unroll
            for (int j = 0; j < 8; ++j) o[i][j] *= a; }
        for (int kk = 0; kk < 32; ++kk) { float pv[4], vv[8];
#pragma unroll
            for (int i = 0; i < 4; ++i) pv[i] = Ps[4 * ty + i][kk];
#pragma unroll
            for (int j = 0; j < 8; ++j) vv[j] = Vs[kk][8 * tx + j];
#pragma unroll
            for (int i = 0; i < 4; ++i)
#pragma unroll
                for (int j = 0; j < 8; ++j) o[i][j] += pv[i] * vv[j]; }
    }
    __syncthreads();
    if (tid < 64) al[tid] = 1.f / lrow;
    __syncthreads();
#pragma unroll
    for (int i = 0; i < 4; ++i) { const float a = al[4 * ty + i];
#pragma unroll
        for (int j = 0; j < 8; ++j) O[(size_t)(tok0 + 4 * ty + i) * DM + h * 128 + 8 * tx + j] = (bf16)f2bf(o[i][j] * a); }
}
__global__ __launch_bounds__(256) void gla_scan_kernel(Prm p) {
    extern __shared__ __attribute__((aligned(16))) unsigned char sm[];
    float (*S)[33] = (float (*)[33])sm;
    float (*Qs)[129] = (float (*)[129])(sm + 128 * 33 * 4);
    float (*Ks)[129] = (float (*)[129])(sm + 128 * 33 * 4 + 64 * 129 * 4);
    float (*Vs)[33] = (float (*)[33])(sm + 128 * 33 * 4 + 2 * 64 * 129 * 4);
    float (*Ps)[65] = (float (*)[65])(sm + 128 * 33 * 4 + 2 * 64 * 129 * 4 + 64 * 33 * 4);
    float* dec = (float*)(sm + 128 * 33 * 4 + 2 * 64 * 129 * 4 + 64 * 33 * 4 + 64 * 65 * 4);
    const bf16* QT = (const bf16*)(p.ws + WS_QT); const bf16* KT = (const bf16*)(p.ws + WS_KT); const bf16* V = (const bf16*)(p.ws + WS_V1); const float* DEC = (const float*)(p.ws + WS_DEC);
    const int tid = threadIdx.x, ty = tid >> 4, tx = tid & 15, vs = blockIdx.x & 7, dir = (blockIdx.x >> 3) & 1, h = (blockIdx.x >> 4) & 3, b = blockIdx.x >> 6;
    bf16* OG = (bf16*)(p.ws + (dir ? WS_OGB : WS_OGF));
    for (int i = tid; i < 128 * 32; i += 256) S[i >> 5][i & 31] = 0.f;
    for (int step = 0; step < 68; ++step) {
        const bool lat = step >= 4; const int ci = lat ? step - 4 : step;
        const int chunk = lat ? b * 64 + (dir ? 63 - ci : ci) : 512 + b * 4 + (dir ? 3 - ci : ci); const int tok0 = chunk * 64;
        __syncthreads();
        for (int i = tid; i < 64 * 128; i += 256) { const int t = i >> 7, d = i & 127; const size_t off = ((size_t)dir * NTOK + tok0 + t) * 512 + h * 128 + d; Qs[t][d] = bf2f(QT[off]); Ks[t][d] = bf2f(KT[off]); }
        for (int i = tid; i < 64 * 32; i += 256) { const int t = i >> 5, v = i & 31; Vs[t][v] = bf2f(V[(size_t)(tok0 + t) * DM + h * 256 + vs * 32 + v]); }
        if (tid < 128) dec[tid] = DEC[((size_t)dir * NCHUNK + chunk) * 512 + h * 128 + tid];
        __syncthreads();
        if (lat) {
            float s[4][4] = {};
            for (int d = 0; d < 128; ++d) { float a[4], bb[4];
#pragma unroll
                for (int i = 0; i < 4; ++i) { a[i] = Qs[4 * ty + i][d]; bb[i] = Ks[4 * tx + i][d]; }
#pragma unroll
                for (int i = 0; i < 4; ++i)
#pragma unroll
                    for (int j = 0; j < 4; ++j) s[i][j] += a[i] * bb[j]; }
#pragma unroll
            for (int i = 0; i < 4; ++i)
#pragma unroll
                for (int j = 0; j < 4; ++j) { const int t = 4 * ty + i, sidx = 4 * tx + j; const bool keep = dir ? (sidx >= t) : (sidx <= t); Ps[t][sidx] = keep ? s[i][j] : 0.f; }
            __syncthreads();
            float o[4][2] = {};
            for (int sidx = 0; sidx < 64; ++sidx) { const float v0 = Vs[sidx][2 * tx], v1 = Vs[sidx][2 * tx + 1];
#pragma unroll
                for (int i = 0; i < 4; ++i) { const float pp = Ps[4 * ty + i][sidx]; o[i][0] += pp * v0; o[i][1] += pp * v1; } }
            for (int d = 0; d < 128; ++d) { const float s0 = S[d][2 * tx], s1 = S[d][2 * tx + 1];
#pragma unroll
                for (int i = 0; i < 4; ++i) { const float qq = Qs[4 * ty + i][d]; o[i][0] += qq * s0; o[i][1] += qq * s1; } }
#pragma unroll
            for (int i = 0; i < 4; ++i) { const size_t off = (size_t)(tok0 + 4 * ty + i) * DM + h * 256 + vs * 32 + 2 * tx; OG[off] = (bf16)f2bf(o[i][0]); OG[off + 1] = (bf16)f2bf(o[i][1]); }
            __syncthreads();
        }
        float u[8][2] = {};
        for (int sidx = 0; sidx < 64; ++sidx) { const float v0 = Vs[sidx][2 * tx], v1 = Vs[sidx][2 * tx + 1];
#pragma unroll
            for (int i = 0; i < 8; ++i) { const float kk = Ks[sidx][8 * ty + i]; u[i][0] += kk * v0; u[i][1] += kk * v1; } }
#pragma unroll
        for (int i = 0; i < 8; ++i) { const int d = 8 * ty + i; S[d][2 * tx] = dec[d] * (S[d][2 * tx] + u[i][0]); S[d][2 * tx + 1] = dec[d] * (S[d][2 * tx + 1] + u[i][1]); }
    }
}
constexpr int GLA_SCAN_LDS = 128 * 33 * 4 + 2 * 64 * 129 * 4 + 64 * 33 * 4 + 64 * 65 * 4 + 512;
}
namespace pg8 {
typedef short bf16x8 __attribute__((ext_vector_type(8)));
constexpr int BM = 256, BK = 64, HALF = 128, HTB = HALF * BK * 2, STAGE_BYTES = 8 * HTB, NXCD = 8, WGM = 8;
__host__ __device__ __forceinline__ int lds_byte(int r, int c) { const int st = (r >> 4) * 2 + (c >> 5), rr = r & 15, cc = c & 31, ob = rr * 64 + cc * 2; return st * 1024 + (ob ^ (((ob >> 9) & 1) << 5)); }
__host__ __device__ __forceinline__ void stage_rc(int b, int& R, int& C) { const int st = b / 1024, sb = b % 1024, swz = sb ^ (((sb >> 9) & 1) << 5); R = (st >> 1) * 16 + swz / 64; C = (st & 1) * 32 + (swz % 64) / 2; }
typedef float f32x2_t __attribute__((ext_vector_type(2))); typedef __bf16 bf16x2_t __attribute__((ext_vector_type(2)));
__device__ __forceinline__ unsigned cvt_pk_bf16(float lo, float hi) { f32x2_t v = {lo, hi}; bf16x2_t b = __builtin_convertvector(v, bf16x2_t); return __builtin_bit_cast(unsigned, b); }

struct Unit { int pm, pn; int row0; int e; int cnt; const bf16* Bt; };

struct DenseOrder {
    int nM, nN, nwg, G, c, K; const bf16* Bt;
    __device__ void init(int M, int N, int K_, const bf16* Bt_, int G_, int c_) { nM = M / BM; nN = N / BM; nwg = nM * nN; G = G_; c = c_; K = K_; Bt = Bt_; }
    __device__ bool next(int i, Unit& u) const {
        const long L = (long)i * G + c; if (L >= nwg) return false;
        int wgid = (int)L; { const int q = nwg / NXCD, r = nwg % NXCD, xcd = wgid % NXCD, off = wgid / NXCD; wgid = (xcd < r ? xcd * (q + 1) : r * (q + 1) + (xcd - r) * q) + off; }
        const int nig = WGM * nN, gid = wgid / nig, fm = gid * WGM, gsz = (nM - fm) < WGM ? (nM - fm) : WGM;
        u.pm = fm + ((wgid % nig) % gsz); u.pn = (wgid % nig) / gsz; u.row0 = u.pm * BM; u.e = 0; u.cnt = 0; u.Bt = Bt; return true;
    }
    __device__ __forceinline__ unsigned arow(const Unit& u, int r) const { return (unsigned)(u.row0 + r) * (unsigned)(K * 2); }
};
template <bool GATHER> struct MoeOrder {
    int cnt[16]; int nN, G, c, K; const bf16* Bt0; size_t bstride; const int* LIST;
    __device__ void init(const unsigned* cntw, int N, int K_, const bf16* Bt0_, const int* LIST_, int G_, int c_) {
#pragma unroll
        for (int e = 0; e < 16; ++e) cnt[e] = (int)__hip_atomic_load(cntw + e, __ATOMIC_RELAXED, __HIP_MEMORY_SCOPE_AGENT);
        nN = N / BM; G = G_; c = c_; K = K_; Bt0 = Bt0_; bstride = (size_t)N * K_; LIST = LIST_; }
    __device__ bool next(int i, Unit& u) const {
        int L = i * G + c, base = 0; bool found = false; u.pm = 0; u.pn = 0; u.row0 = 0; u.e = 0; u.cnt = 0; u.Bt = Bt0;
#pragma unroll
        for (int e = 0; e < 16; ++e) { const int mt = (cnt[e] + 255) >> 8, nu = mt * nN;
            if (!found) { if (L < nu) { found = true; u.e = e; u.cnt = cnt[e]; u.pm = L / nN; u.pn = L % nN; u.row0 = base + u.pm * BM; u.Bt = Bt0 + (size_t)e * bstride; } else { L -= nu; base += mt * BM; } } }
        return found;
    }
    __device__ __forceinline__ unsigned arow(const Unit& u, int r) const {
        if (GATHER) { const int li = u.pm * BM + r; int tok = 0; if (li < u.cnt) tok = LIST[u.e * NTOK + li];
            return (unsigned)tok * (unsigned)(K * 2); }
        return (unsigned)(u.row0 + r) * (unsigned)(K * 2);
    }
};

typedef f32x4 Acc[2][2][4][2];
__device__ __forceinline__ void st4bf(bf16* p, f32x4 v) { u32x2 w; w.x = cvt_pk_bf16(v.x, v.y); w.y = cvt_pk_bf16(v.z, v.w); *(u32x2*)p = w; }
__device__ __forceinline__ void st8bf(bf16* p, f32x4 a, f32x4 b) { u32x4 w; w.x = cvt_pk_bf16(a.x, a.y); w.y = cvt_pk_bf16(a.z, a.w); w.z = cvt_pk_bf16(b.x, b.y); w.w = cvt_pk_bf16(b.z, b.w); *(u32x4*)p = w; }

struct EpiQKV {
    bf16 *Q; const LAS float* rope;
    __device__ __forceinline__ void operator()(const Acc& acc, const Unit& u, int wr, int wc, int fr, int fq) const {
        const int reg = u.pn >> 2; bf16* O = Q + (size_t)reg * ((WS_K - WS_Q) / 2);
        if (reg == 2) { const int cbase = (u.pn & 3) * BM + wc * 32 + 8 * fq;
#pragma unroll
            for (int ai = 0; ai < 2; ++ai)
#pragma unroll
                for (int m = 0; m < 4; ++m) { bf16* rowp = O + (size_t)(u.row0 + ai * HALF + wr * 64 + m * 16 + fr) * DM + cbase;
#pragma unroll
                    for (int bj = 0; bj < 2; ++bj) st8bf(rowp + bj * HALF, acc[ai][bj][m][0], acc[ai][bj][m][1]); }
            return; }
        const int cbase = (u.pn & 3) * BM + wc * 32 + 4 * fq;
        const bool dorope = (u.row0 < NLAT); const float sc = reg == 0 ? C2 : 1.f;
#pragma unroll
        for (int ai = 0; ai < 2; ++ai)
#pragma unroll
            for (int m = 0; m < 4; ++m) { const int row = u.row0 + ai * HALF + wr * 64 + m * 16 + fr; bf16* rowp = O + (size_t)row * DM + cbase;
                f32x4 cs = {1.f, 1.f, 1.f, 1.f}, sn = {0.f, 0.f, 0.f, 0.f};
                if (dorope) { const int s = row & (SEQ - 1), pos = (wc & 1) ? (s & 63) : (s >> 6); const f32x4 t0 = *(const LAS f32x4*)(rope + (pos * 16 + 4 * fq) * 2), t1 = *(const LAS f32x4*)(rope + (pos * 16 + 4 * fq) * 2 + 4);
                    cs = (f32x4){t0.x, t0.z, t1.x, t1.z}; sn = (f32x4){t0.y, t0.w, t1.y, t1.w}; }
#pragma unroll
                for (int bj = 0; bj < 2; ++bj) { const f32x4 a0 = acc[ai][bj][m][0], a1 = acc[ai][bj][m][1];
                    st4bf(rowp + bj * HALF, (a0 * cs - a1 * sn) * sc); st4bf(rowp + bj * HALF + 16, (a1 * cs + a0 * sn) * sc); } }
    }
};
struct EpiPlain {
    bf16* O;
    __device__ __forceinline__ void operator()(const Acc& acc, const Unit& u, int wr, int wc, int fr, int fq) const {
        const int cbase = u.pn * BM + wc * 32 + 8 * fq;
#pragma unroll
        for (int ai = 0; ai < 2; ++ai)
#pragma unroll
            for (int m = 0; m < 4; ++m) { bf16* rowp = O + (size_t)(u.row0 + ai * HALF + wr * 64 + m * 16 + fr) * DM + cbase;
#pragma unroll
                for (int bj = 0; bj < 2; ++bj) st8bf(rowp + bj * HALF, acc[ai][bj][m][0], acc[ai][bj][m][1]); }
    }
};
struct EpiInproj {
    bf16 *QR, *KR, *V, *R; float* ZZ;
    __device__ __forceinline__ void operator()(const Acc& acc, const Unit& u, int wr, int wc, int fr, int fq) const {
        const int pn = u.pn;
        if (pn == 12) { if (wc == 0) {
#pragma unroll
            for (int ai = 0; ai < 2; ++ai)
#pragma unroll
                for (int m = 0; m < 4; ++m) { float* rowp = ZZ + (size_t)(u.row0 + ai * HALF + wr * 64 + m * 16 + fr) * 32 + 4 * fq;
                    *(f32x4*)rowp = acc[ai][0][m][0]; *(f32x4*)(rowp + 16) = acc[ai][0][m][1]; } }
            return; }
        bf16* O; int ld, c0; float sc = 1.f;
        if (pn < 2) { O = QR; ld = 512; c0 = pn * BM; sc = 0.08838834764831845f; } else if (pn < 4) { O = KR; ld = 512; c0 = (pn - 2) * BM; } else if (pn < 8) { O = V; ld = DM; c0 = (pn - 4) * BM; } else { O = R; ld = DM; c0 = (pn - 8) * BM; }
        const int cbase = c0 + wc * 32 + 8 * fq;
#pragma unroll
        for (int ai = 0; ai < 2; ++ai)
#pragma unroll
            for (int m = 0; m < 4; ++m) { bf16* rowp = O + (size_t)(u.row0 + ai * HALF + wr * 64 + m * 16 + fr) * ld + cbase;
#pragma unroll
                for (int bj = 0; bj < 2; ++bj) st8bf(rowp + bj * HALF, acc[ai][bj][m][0] * sc, acc[ai][bj][m][1] * sc); }
    }
};
struct EpiGateUp {
    bf16* ACT;
    __device__ __forceinline__ void operator()(const Acc& acc, const Unit& u, int wr, int wc, int fr, int fq) const {
        const int obase = (u.pn * BM + wc * 32) / 2 + 4 * fq;
#pragma unroll
        for (int ai = 0; ai < 2; ++ai)
#pragma unroll
            for (int m = 0; m < 4; ++m) { bf16* rowp = ACT + (size_t)(u.row0 + ai * HALF + wr * 64 + m * 16 + fr) * DEXP + obase;
#pragma unroll
                for (int bj = 0; bj < 2; ++bj) { const f32x4 g = acc[ai][bj][m][0], up = acc[ai][bj][m][1]; f32x4 o;
#pragma unroll
                    for (int j = 0; j < 4; ++j) o[j] = g[j] * __builtin_amdgcn_rcpf(1.f + __expf(-g[j])) * up[j];
                    st4bf(rowp + bj * (HALF / 2), o); } }
    }
};

template <class Epi, class Sched>
__device__ __forceinline__ void gemm_phase(unsigned char* ldsg, const bf16* A, int K, const Sched& S, const Epi& E) {
    LAS unsigned char* lds = (LAS unsigned char*)ldsg;
    const int tid = threadIdx.x, wid = __builtin_amdgcn_readfirstlane(tid >> 6), lane = tid & 63, wr = wid >> 2, wc = wid & 3, fr = lane & 15, fq = lane >> 4;
    const int nt = K / BK;
    int Rr[2]; unsigned colb[2], voffB[2];
#pragma unroll
    for (int i = 0; i < 2; ++i) { int R, C; stage_rc(tid * 16 + i * 8192, R, C); Rr[i] = R; colb[i] = (unsigned)C * 2u; voffB[i] = (unsigned)(R * K + C) * 2u; }
    const size_t kstep = (size_t)(BK * 2);
    const size_t hstep = (size_t)HALF * K * 2;
    const size_t tstep = 2 * hstep;
    const unsigned ldsw = (unsigned)wid * 1024u;
    const int aoff = lds_byte(wr * 64 + fr, fq * 8), boff = lds_byte(wc * 32 + fr, fq * 8);
#define PG8_SA(b, h) (((b) * 2 + (h)) * HTB)
#define PG8_SB(b, h) ((4 + (b) * 2 + (h)) * HTB)
#define PG8_STAGE(bufoff, gbase, voff) do { _Pragma("unroll") for (int _i = 0; _i < 2; ++_i) \
        __builtin_amdgcn_global_load_lds((const unsigned*)((const char*)(gbase) + (voff)[_i]), (LAS unsigned*)(lds + (bufoff) + ldsw + _i * 8192), 16, 0, 0); } while (0)
#define PG8_LDA(dst, b, h) do { _Pragma("unroll") for (int m = 0; m < 4; ++m) _Pragma("unroll") for (int k = 0; k < 2; ++k) dst[m][k] = *(const LAS bf16x8*)(lds + PG8_SA(b, h) + aoff + m * 2048 + k * 1024); } while (0)
#define PG8_LDB(dst, b, h) do { _Pragma("unroll") for (int n = 0; n < 2; ++n) _Pragma("unroll") for (int k = 0; k < 2; ++k) dst[n][k] = *(const LAS bf16x8*)(lds + PG8_SB(b, h) + boff + n * 2048 + k * 1024); } while (0)
#define PG8_MMA(ai, bj, At, Bt) do { __builtin_amdgcn_s_setprio(1); _Pragma("unroll") for (int m = 0; m < 4; ++m) _Pragma("unroll") for (int n = 0; n < 2; ++n) _Pragma("unroll") for (int k = 0; k < 2; ++k) \
        acc[ai][bj][m][n] = __builtin_amdgcn_mfma_f32_16x16x32_bf16(Bt[n][k], At[m][k], acc[ai][bj][m][n], 0, 0, 0); __builtin_amdgcn_s_setprio(0); } while (0)
#define PG8_WAIT_V(n) asm volatile("s_waitcnt vmcnt(" #n ")" ::: "memory")
#define PG8_WAIT_L(n) asm volatile("s_waitcnt lgkmcnt(" #n ")" ::: "memory")
#define PG8_BAR __builtin_amdgcn_s_barrier()
#define PG8_SCHED __builtin_amdgcn_sched_barrier(0)
    Unit cur, nxt; int ui = 0;
    if (!S.next(0, cur)) return;
    Acc acc;
#pragma unroll
    for (int a = 0; a < 2; ++a)
#pragma unroll
        for (int b = 0; b < 2; ++b)
#pragma unroll
            for (int m = 0; m < 4; ++m)
#pragma unroll
                for (int n = 0; n < 2; ++n) acc[a][b][m][n] = (f32x4){0.f, 0.f, 0.f, 0.f};
    bf16x8 At[4][2], B0[2][2], B1[2][2];
    unsigned aC0[2], aC1[2], aN0[2], aN1[2];
#pragma unroll
    for (int i = 0; i < 2; ++i) { aC0[i] = S.arow(cur, Rr[i]) + colb[i]; aC1[i] = S.arow(cur, HALF + Rr[i]) + colb[i]; }
    const char* Ab = (const char*)A;
    const char* cB = (const char*)cur.Bt + (size_t)cur.pn * tstep;
    PG8_STAGE(PG8_SB(0, 0), cB, voffB); PG8_STAGE(PG8_SB(0, 1), cB + hstep, voffB); PG8_STAGE(PG8_SA(0, 0), Ab, aC0); PG8_STAGE(PG8_SA(0, 1), Ab, aC1);
    if (wr == 1) PG8_BAR;
    PG8_WAIT_V(2); PG8_BAR;
    PG8_STAGE(PG8_SB(1, 0), cB + kstep, voffB); PG8_STAGE(PG8_SA(1, 0), Ab + kstep, aC0); PG8_STAGE(PG8_SB(1, 1), cB + hstep + kstep, voffB);
    PG8_WAIT_V(6); PG8_BAR;
    for (;;) {
        const bool has_next = S.next(ui + 1, nxt);
        if (has_next) {
#pragma unroll
            for (int i = 0; i < 2; ++i) { aN0[i] = S.arow(nxt, Rr[i]) + colb[i]; aN1[i] = S.arow(nxt, HALF + Rr[i]) + colb[i]; }
        } else {
#pragma unroll
            for (int i = 0; i < 2; ++i) { aN0[i] = aC0[i]; aN1[i] = aC1[i]; }
        }
        const char* nB = has_next ? (const char*)nxt.Bt + (size_t)nxt.pn * tstep : cB;
        for (int t = 0; t < nt; t += 2) {
            const bool last = (t == nt - 2);
            const char* a1 = Ab + (size_t)(t + 1) * kstep;
            const char* a2 = last ? Ab : Ab + (size_t)(t + 2) * kstep; const char* b2 = last ? nB : cB + (size_t)(t + 2) * kstep;
            const char* a3 = a2 + kstep; const char* b3 = b2 + kstep;
            unsigned x0[2], x1[2];
#pragma unroll
            for (int i = 0; i < 2; ++i) { x0[i] = last ? aN0[i] : aC0[i]; x1[i] = last ? aN1[i] : aC1[i]; }
            PG8_LDB(B0, 0, 0); PG8_LDB(B1, 0, 1); PG8_SCHED; PG8_LDA(At, 0, 0); PG8_STAGE(PG8_SA(1, 1), a1, aC1);
            PG8_WAIT_V(8); PG8_WAIT_L(0); PG8_BAR; PG8_MMA(0, 0, At, B0); PG8_MMA(0, 1, At, B1); PG8_BAR; PG8_SCHED;
            PG8_LDA(At, 0, 1); PG8_STAGE(PG8_SB(0, 0), b2, voffB); PG8_STAGE(PG8_SB(0, 1), b2 + hstep, voffB); PG8_STAGE(PG8_SA(0, 0), a2, x0);
            PG8_WAIT_V(8); PG8_WAIT_L(0); PG8_BAR; PG8_MMA(1, 0, At, B0); PG8_MMA(1, 1, At, B1); PG8_BAR; PG8_SCHED;
            PG8_LDB(B0, 1, 0); PG8_LDB(B1, 1, 1); PG8_SCHED; PG8_LDA(At, 1, 0); PG8_STAGE(PG8_SA(0, 1), a2, x1);
            PG8_WAIT_V(8); PG8_WAIT_L(0); PG8_BAR; PG8_MMA(0, 0, At, B0); PG8_MMA(0, 1, At, B1); PG8_BAR; PG8_SCHED;
            PG8_LDA(At, 1, 1); PG8_STAGE(PG8_SB(1, 0), b3, voffB); PG8_STAGE(PG8_SB(1, 1), b3 + hstep, voffB); PG8_STAGE(PG8_SA(1, 0), a3, x0);
            PG8_WAIT_V(8); PG8_WAIT_L(0); PG8_BAR; PG8_MMA(1, 0, At, B0); PG8_MMA(1, 1, At, B1); PG8_BAR; PG8_SCHED;
        }
        if (wr == 0) PG8_BAR;
        E(acc, cur, wr, wc, fr, fq);
        if (!has_next) break;
#pragma unroll
        for (int a = 0; a < 2; ++a)
#pragma unroll
            for (int b = 0; b < 2; ++b)
#pragma unroll
                for (int m = 0; m < 4; ++m)
#pragma unroll
                    for (int n = 0; n < 2; ++n) acc[a][b][m][n] = (f32x4){0.f, 0.f, 0.f, 0.f};
        cur = nxt; cB = nB; ++ui;
#pragma unroll
        for (int i = 0; i < 2; ++i) { aC0[i] = aN0[i]; aC1[i] = aN1[i]; }
        if (wr == 1) PG8_BAR;
    }
    PG8_WAIT_V(0);
    PG8_BAR;
#undef PG8_SA
#undef PG8_SB
#undef PG8_STAGE
#undef PG8_LDA
#undef PG8_LDB
#undef PG8_MMA
#undef PG8_WAIT_V
#undef PG8_WAIT_L
#undef PG8_BAR
#undef PG8_SCHED
}
}

__device__ __forceinline__ int vcu_of(const Frame& F) { return (F.G % 8 == 0) ? (F.bid % 8) * (F.G / 8) + F.bid / 8 : F.bid; }
__device__ __forceinline__ void phase_qkv_opt(const Frame& F, const Prm& p) {
    pg8::DenseOrder S; S.init(NTOK, 3072, 1024, (const bf16*)(p.ws + WS_WQKV), F.G, F.bid);
    static_assert(WS_V - WS_K == WS_K - WS_Q, "Q|K|V equally spaced");
    LAS float* ropel = (LAS float*)((LAS unsigned char*)F.lds + LDSX_OFF);
    const float* ropeg = (const float*)(p.ws + WS_MISC) + 1024;
    for (int i = F.tid; i < 2048; i += NTHR) ropel[i] = ropeg[i];
    __syncthreads();
    pg8::EpiQKV E{(bf16*)(p.ws + WS_Q), ropel};
    pg8::gemm_phase(F.lds, (const bf16*)(p.ws + WS_H), 1024, S, E);
}
__device__ __forceinline__ void phase_wo_opt(const Frame& F, const Prm& p, int layer) {
    pg8::DenseOrder S; S.init(layer ? NLAT : NTOK, 1024, 1024, (const bf16*)(p.ws + (layer ? WS_WGO : WS_WO)), F.G, F.bid);
    pg8::EpiPlain E{(bf16*)(p.ws + WS_Y)};
    pg8::gemm_phase(F.lds, (const bf16*)(p.ws + (layer ? WS_A2B : WS_A2)), 1024, S, E);
}
__device__ __forceinline__ void phase_inproj_opt(const Frame& F, const Prm& p) {
    pg8::DenseOrder S; S.init(NTOK, NIN, 1024, (const bf16*)(p.ws + WS_WIN), F.G, F.bid);
    pg8::EpiInproj E{(bf16*)(p.ws + WS_QR), (bf16*)(p.ws + WS_KR), (bf16*)(p.ws + WS_V1), (bf16*)(p.ws + WS_R), (float*)(p.ws + WS_ZZ)};
    pg8::gemm_phase(F.lds, (const bf16*)(p.ws + WS_H), 1024, S, E);
}
__device__ __forceinline__ void phase_moe1_opt(const Frame& F, const Prm& p, int layer) {
    pg8::MoeOrder<true> S; S.init(F.ctl + CW_CNT + layer * 16, 1024, 1024, (const bf16*)(p.ws + (layer ? WS_GU1 : WS_GU0)), (const int*)(p.ws + WS_LIST), F.G, vcu_of(F));
    pg8::EpiGateUp E{(bf16*)(p.ws + WS_ACT)};
    pg8::gemm_phase(F.lds, (const bf16*)(p.ws + WS_H), 1024, S, E);
}
__device__ __forceinline__ void phase_moe2_opt(const Frame& F, const Prm& p, int layer) {
    pg8::MoeOrder<false> S; S.init(F.ctl + CW_CNT + layer * 16, 1024, 512, (const bf16*)(p.ws + (layer ? WS_DN1 : WS_DN0)), nullptr, F.G, vcu_of(F));
    pg8::EpiPlain E{(bf16*)(p.ws + WS_YM)};
    pg8::gemm_phase(F.lds, (const bf16*)(p.ws + WS_ACT), 512, S, E);
}
namespace attn_body {
using bf16=unsigned short;
using bf16x8=__attribute__((ext_vector_type(8)))short;
using s16x4=__attribute__((ext_vector_type(4)))short;
using f32x16=__attribute__((ext_vector_type(16)))float;
using u32x4=__attribute__((ext_vector_type(4)))unsigned;
constexpr int D=64,DM=1024;
constexpr int NW=8,QBLK=32,QB=QBLK*NW,KVBLK=64;
constexpr int ATTN_PITCH=DM, ATTN_UNIT_ROWS=QB;
__device__ __forceinline__ int crow(int r,int hi){return (r&3)+8*(r>>2)+4*hi;}
#define SBAR() __builtin_amdgcn_sched_barrier(0)
__device__ __forceinline__ void cmask(f32x16&p0,f32x16&p1,int jb,int qrel,int hi){
  const float NEG=-INFINITY; int kb=64*jb+4*hi;
  #pragma unroll
  for(int r=0;r<16;++r){int kv=kb+(r&3)+8*(r>>2); if(kv>qrel)p0[r]=NEG; if(kv+32>qrel)p1[r]=NEG;}
}

constexpr int NSLOT=3, SLOTB=8192;
constexpr int LDS_K=0, LDS_V=NSLOT*SLOTB, LDS_WS=2*NSLOT*SLOTB, LDS_OST=LDS_WS+NW*64*4, LDS_BYTES=LDS_OST+NW*4096;
constexpr float C2=0.125f*1.4426950408889634f;
__device__ __forceinline__ void glds16(const void*gsrc,unsigned lds_dst){unsigned keep;
  asm volatile("s_mov_b32 %0, m0\n\ts_mov_b32 m0, %2\n\ts_nop 0\n\tglobal_load_lds_dwordx4 %1, off\n\ts_mov_b32 m0, %0":"=&s"(keep):"v"(gsrc),"s"(lds_dst):"memory");}
__device__ __forceinline__ float max3f(float a,float b,float c){float r;asm("v_max3_f32 %0, %1, %2, %3":"=v"(r):"v"(a),"v"(b),"v"(c));return r;}
__device__ __forceinline__ float max2f(float a,float b){float r;asm("v_max_f32_e32 %0, %1, %2":"=v"(r):"v"(a),"v"(b));return r;}
__device__ __forceinline__ float fadd_s(float a,float b){float r;asm("v_add_f32_e32 %0, %1, %2":"=v"(r):"v"(a),"v"(b));return r;}
__device__ __forceinline__ float fsub_s(float a,float b){float r;asm("v_sub_f32_e32 %0, %1, %2":"=v"(r):"v"(a),"v"(b));return r;}
typedef float f32x2_t __attribute__((ext_vector_type(2))); typedef __bf16 bf16x2_t __attribute__((ext_vector_type(2)));
__device__ __forceinline__ unsigned cvtpk_s(float lo,float hi){f32x2_t v={lo,hi};bf16x2_t b=__builtin_convertvector(v,bf16x2_t);return __builtin_bit_cast(unsigned,b);}
#define WAIT_BAR(N) asm volatile("s_waitcnt vmcnt(" #N ") lgkmcnt(0)\n\ts_barrier":::"memory")

__device__ __forceinline__ void qkt(f32x16&p0,f32x16&p1,const char*Kslot,const bf16x8*qr,const f32x16&negm,int r32,int hi){
  const char*kb=Kslot+hi*1024+r32*16;
  #pragma unroll
  for(int d0=0;d0<4;++d0){
    const bf16x8 b0=*reinterpret_cast<const bf16x8*>(kb+d0*2048);
    const bf16x8 b1=*reinterpret_cast<const bf16x8*>(kb+d0*2048+512);
    if(d0==0){p0=__builtin_amdgcn_mfma_f32_32x32x16_bf16(b0,qr[0],negm,0,0,0);p1=__builtin_amdgcn_mfma_f32_32x32x16_bf16(b1,qr[0],negm,0,0,0);}
    else{p0=__builtin_amdgcn_mfma_f32_32x32x16_bf16(b0,qr[d0],p0,0,0,0);p1=__builtin_amdgcn_mfma_f32_32x32x16_bf16(b1,qr[d0],p1,0,0,0);}}
}
typedef __attribute__((address_space(3))) const char* lds_cptr;
typedef short v4i16_t __attribute__((ext_vector_type(4)));
__device__ __forceinline__ void kload8(bf16x8*kf,lds_cptr kp){
  kf[0]=*(const __attribute__((address_space(3))) bf16x8*)(kp);      kf[1]=*(const __attribute__((address_space(3))) bf16x8*)(kp+512);
  kf[2]=*(const __attribute__((address_space(3))) bf16x8*)(kp+2048); kf[3]=*(const __attribute__((address_space(3))) bf16x8*)(kp+2560);
  kf[4]=*(const __attribute__((address_space(3))) bf16x8*)(kp+4096); kf[5]=*(const __attribute__((address_space(3))) bf16x8*)(kp+4608);
  kf[6]=*(const __attribute__((address_space(3))) bf16x8*)(kp+6144); kf[7]=*(const __attribute__((address_space(3))) bf16x8*)(kp+6656);
}
__device__ __forceinline__ void kload2(bf16x8*kf,lds_cptr kp,int j){ kf[2*j]=*(const __attribute__((address_space(3))) bf16x8*)(kp+j*2048); kf[2*j+1]=*(const __attribute__((address_space(3))) bf16x8*)(kp+j*2048+512); }
__device__ __forceinline__ s16x4 vtr(lds_cptr p){ return __builtin_bit_cast(s16x4,__builtin_amdgcn_ds_read_tr16_b64_v4i16((__attribute__((address_space(3))) v4i16_t*)p)); }
__device__ __forceinline__ float rowmax(const f32x16&p0,const f32x16&p1){
  float a=max3f(p0[0],p0[1],p1[0]),b=max3f(p0[2],p0[3],p1[1]);a=max3f(a,p1[2],p1[3]);
  #pragma unroll
  for(int r=4;r<16;r+=4){a=max3f(a,p0[r],p0[r+1]);b=max3f(b,p0[r+2],p0[r+3]);a=max3f(a,p1[r],p1[r+1]);b=max3f(b,p1[r+2],p1[r+3]);}
  const float m=max2f(a,b);
  auto rr=__builtin_amdgcn_permlane32_swap(__float_as_uint(m),__float_as_uint(m),false,false);
  return max2f(__uint_as_float(rr[0]),__uint_as_float(rr[1]));
}
__device__ __forceinline__ void pv(f32x16*o,int vb,bf16x8 pa0,bf16x8 pa1,bf16x8 pa2,bf16x8 pa3){
  #pragma unroll
  for(int d0=0;d0<2;++d0){s16x4 lo[4],hi[4];
    #pragma unroll
    for(int ks=0;ks<4;++ks){
      asm volatile("ds_read_b64_tr_b16 %0,%1 offset:%c2":"=&v"(lo[ks]):"v"(vb),"i"(d0*4096+ks*1024):"memory");
      asm volatile("ds_read_b64_tr_b16 %0,%1 offset:%c2":"=&v"(hi[ks]):"v"(vb),"i"(d0*4096+ks*1024+512):"memory");}
    asm volatile("s_waitcnt lgkmcnt(0)":::"memory");SBAR();
    #define PK(k) (bf16x8){lo[k][0],lo[k][1],lo[k][2],lo[k][3],hi[k][0],hi[k][1],hi[k][2],hi[k][3]}
    o[d0]=__builtin_amdgcn_mfma_f32_32x32x16_bf16(pa0,PK(0),o[d0],0,0,0);
    o[d0]=__builtin_amdgcn_mfma_f32_32x32x16_bf16(pa1,PK(1),o[d0],0,0,0);
    o[d0]=__builtin_amdgcn_mfma_f32_32x32x16_bf16(pa2,PK(2),o[d0],0,0,0);
    o[d0]=__builtin_amdgcn_mfma_f32_32x32x16_bf16(pa3,PK(3),o[d0],0,0,0);
    #undef PK
  }
}

#ifndef ATTN_STORE16
#define ATTN_STORE16(p,v) (*(u32x4*)(p)=(v))
#endif
template<int THRL> __device__ __forceinline__ void attn_unit(long qrow0,int qcol,int vcol,long kctx,long klat,int NT,const bf16*Q,const bf16*__restrict__ K,const bf16*__restrict__ V,bf16*O,char*shm){
  const int tid=threadIdx.x,lane=tid&63,r32=lane&31,hi=lane>>5; const int wid=__builtin_amdgcn_readfirstlane(tid>>6);

  const bf16*Qw=Q+(qrow0+wid*QBLK)*DM+qcol;
  const bf16*Kh=K+qcol,*Vh=V+vcol;
  const unsigned lds0=(unsigned)(uintptr_t)shm;
  float*wsf=(float*)(shm+LDS_WS)+wid*64;
  const bf16*ksrc=Kh+(long)lane*DM+wid*8;
  const bf16*vsrc=Vh+(long)(16*(wid&3)+(lane>>2))*DM+(wid>>2)*32+(lane&3)*8;
  const unsigned kdst=lds0+LDS_K+wid*1024, vdst=lds0+LDS_V+wid*1024;
  #define KVROW(t) ((t)<4?kctx+(long)(t)*KVBLK:klat+(long)((t)-4)*KVBLK)
  #define DMA_K(t,slot) glds16(ksrc+KVROW(t)*DM,(unsigned)__builtin_amdgcn_readfirstlane(kdst+(slot)))
  #define DMA_V(t,slot) glds16(vsrc+KVROW(t)*DM,(unsigned)__builtin_amdgcn_readfirstlane(vdst+(slot)))
  const int vb0=(int)(lds0+LDS_V)+((lane>>4)&1)*32+(lane&3)*8+(4*hi+((lane&15)>>2))*64;
  const char*Kbase=shm+LDS_K; bf16x8 kf[8];
  const lds_cptr shm3=(lds_cptr)shm; const lds_cptr kp0=shm3+LDS_K+hi*1024+r32*16; const lds_cptr vp0=shm3+LDS_V+((lane>>4)&1)*32+(lane&3)*8+(4*hi+((lane&15)>>2))*64;
  DMA_K(0,0);DMA_V(0,0);DMA_K(1,SLOTB);
  bf16x8 qr[4];
  #pragma unroll
  for(int d0=0;d0<4;++d0)qr[d0]=*reinterpret_cast<const bf16x8*>(&Qw[(long)r32*DM+d0*16+hi*8]);
  float mhat=0.f,l_reg=0.f;f32x16 o[2];o[0]=f32x16{};o[1]=f32x16{};f32x16 negm=f32x16{};asm volatile("":"+v"(negm));
  const int qrel=wid*QBLK+r32;
  #define CMASK(P0,P1,t) do{}while(0)
  bool resc=false;
  #define START(P0,P1) do{ const float rm=rowmax(P0,P1); resc=false; \
    { const float dl=rm; mhat=fadd_s(mhat,dl); \
      _Pragma("unroll") for(int r=0;r<16;++r){P0[r]=fsub_s(P0[r],dl);P1[r]=fsub_s(P1[r],dl);} \
      _Pragma("unroll") for(int r=0;r<16;++r)negm[r]=-mhat; asm volatile("":"+v"(negm)); } \
    _Pragma("unroll") for(int r=0;r<16;++r)P0[r]=__builtin_amdgcn_exp2f(P0[r]); }while(0)
  #define RESC() do{ if(resc){ asm volatile("s_waitcnt lgkmcnt(0)":::"memory"); \
      _Pragma("unroll") for(int d_=0;d_<2;++d_) _Pragma("unroll") for(int r=0;r<16;++r)o[d_][r]*=wsf[crow(r,hi)]; } }while(0)
  f32x16 pA0,pA1,pB0,pB1;
  int sl_prev=0,sl_cur=0,sl_next=SLOTB;
  #define ROT() do{sl_prev=sl_cur;sl_cur=sl_next;sl_next=(sl_next==(NSLOT-1)*SLOTB)?0:sl_next+SLOTB;}while(0)
  DMA_K(2,2*SLOTB);
  WAIT_BAR(3);
  qkt(pA0,pA1,Kbase,qr,negm,r32,hi);asm volatile("s_nop 15\n\ts_nop 7":"+v"(pA0),"+v"(pA1));CMASK(pA0,pA1,0);
  START(pA0,pA1);
  _Pragma("unroll") for(int r=0;r<16;++r)pA1[r]=__builtin_amdgcn_exp2f(pA1[r]);
  WAIT_BAR(0);
  DMA_K(3,0);DMA_V(1,SLOTB);
  ROT();
  kload8(kf,kp0+sl_cur);
  WAIT_BAR(2);
  s16x4 vlo[8],vhi[8]; u32x4 pw0,pw1,pw2,pw3;
  #define PKW(P,B) cvtpk_s(P[B],P[B+1])
  #define PAF(k) __builtin_bit_cast(bf16x8,pw##k)
  #define VFR(i) (bf16x8){vlo[i][0],vlo[i][1],vlo[i][2],vlo[i][3],vhi[i][0],vhi[i][1],vhi[i][2],vhi[i][3]}
  #define PIN(x) asm volatile("":"+v"(x))
  #define MX3(a,b,c) __builtin_fmaxf(__builtin_fmaxf((a),(b)),(c))
  #define GAPA(MF,A0,A1,A2,A3,W0,W1,PW) do{ MF; sacc+=A0; sacc+=A1; sacc+=A2; sacc+=A3; PIN(sacc); W0; W1; PIN(PW); SBAR(); }while(0)
  #define EX(v) __builtin_amdgcn_exp2f(v)
  #define GAPB(MF,X,B) do{ MF; X[B]=EX(X[B]); X[B+1]=EX(X[B+1]); X[B+2]=EX(X[B+2]); X[B+3]=EX(X[B+3]); PIN(X); SBAR(); }while(0)
  #define VRD(i) do{ vlo[i]=vtr(vp_+(((i)>>2)*4096+((i)&3)*1024)); vhi[i]=vtr(vp_+(((i)>>2)*4096+((i)&3)*1024+512)); }while(0)
  #define KRD(G,j) do{ if(G){ kload2(kf,kp0+sl_next,j); SBAR(); } }while(0)
  #define STEP(C0,C1,P0,P1,t,GK,GV,GL) do{ SBAR(); \
    const lds_cptr vp_=vp0+sl_prev; \
    VRD(0); SBAR(); float sacc=(P0[0]+P0[1]); \
    GAPA(C0=__builtin_amdgcn_mfma_f32_32x32x16_bf16(kf[0],qr[0],negm,0,0,0), P0[2],P0[3],P0[4],P0[5],     pw0[0]=PKW(P0,0), pw0[1]=PKW(P0,2), pw0); \
    VRD(4); SBAR(); GAPA(C1=__builtin_amdgcn_mfma_f32_32x32x16_bf16(kf[1],qr[0],negm,0,0,0), P0[6],P0[7],P0[8],P0[9],     pw0[2]=PKW(P0,4), pw0[3]=PKW(P0,6), pw0); \
    VRD(1); SBAR(); GAPA(C0=__builtin_amdgcn_mfma_f32_32x32x16_bf16(kf[2],qr[1],C0,0,0,0),   P0[10],P0[11],P0[12],P0[13], pw1[0]=PKW(P0,8), pw1[1]=PKW(P0,10), pw1); \
    VRD(5); SBAR(); GAPA(C1=__builtin_amdgcn_mfma_f32_32x32x16_bf16(kf[3],qr[1],C1,0,0,0),   P0[14],P0[15],P1[0],P1[1],   pw1[2]=PKW(P0,12),pw1[3]=PKW(P0,14), pw1); \
    VRD(2); SBAR(); GAPA(C0=__builtin_amdgcn_mfma_f32_32x32x16_bf16(kf[4],qr[2],C0,0,0,0),   P1[2],P1[3],P1[4],P1[5],     pw2[0]=PKW(P1,0), pw2[1]=PKW(P1,2), pw2); \
    VRD(6); SBAR(); GAPA(C1=__builtin_amdgcn_mfma_f32_32x32x16_bf16(kf[5],qr[2],C1,0,0,0),   P1[6],P1[7],P1[8],P1[9],     pw2[2]=PKW(P1,4), pw2[3]=PKW(P1,6), pw2); \
    VRD(3); SBAR(); GAPA(C0=__builtin_amdgcn_mfma_f32_32x32x16_bf16(kf[6],qr[3],C0,0,0,0),   P1[10],P1[11],P1[12],P1[13], pw3[0]=PKW(P1,8), pw3[1]=PKW(P1,10), pw3); \
    VRD(7); SBAR(); GAPA(C1=__builtin_amdgcn_mfma_f32_32x32x16_bf16(kf[7],qr[3],C1,0,0,0),   P1[14],P1[15],0.f,0.f,       pw3[2]=PKW(P1,12),pw3[3]=PKW(P1,14), pw3); \
    l_reg+=sacc; \
    if(GK){DMA_K((t)+3,sl_cur);} if(GV){DMA_V((t)+1,sl_next);} \
    CMASK(C0,C1,t); \
    { float a=MX3(C0[0],C0[1],C1[0]),b=MX3(C0[2],C0[3],C1[1]); a=MX3(a,C1[2],C1[3]); \
      _Pragma("unroll") for(int r=4;r<16;r+=4){a=MX3(a,C0[r],C0[r+1]);b=MX3(b,C0[r+2],C0[r+3]);a=MX3(a,C1[r],C1[r+1]);b=MX3(b,C1[r+2],C1[r+3]);} \
      float rm=__builtin_fmaxf(a,b); { auto rr=__builtin_amdgcn_permlane32_swap(__float_as_uint(rm),__float_as_uint(rm),false,false); rm=__builtin_fmaxf(__uint_as_float(rr[0]),__uint_as_float(rr[1])); } \
      resc=false; \
      if(__builtin_expect(__any(rm>(float)THRL),0)){ const float dl=__builtin_fmaxf(rm,0.f); mhat+=dl; \
        _Pragma("unroll") for(int r=0;r<16;++r){C0[r]-=dl;C1[r]-=dl;} \
        _Pragma("unroll") for(int r=0;r<16;++r)negm[r]=-mhat; asm volatile("":"+v"(negm)); \
        const float f=__builtin_amdgcn_exp2f(-dl); l_reg*=f; if(hi==0)wsf[r32]=f; resc=true; } } \
    SBAR(); \
    GAPB(o[0]=__builtin_amdgcn_mfma_f32_32x32x16_bf16(PAF(0),VFR(0),o[0],0,0,0), C0,0); \
    GAPB(o[1]=__builtin_amdgcn_mfma_f32_32x32x16_bf16(PAF(0),VFR(4),o[1],0,0,0), C0,4); \
    KRD(GL,0); GAPB(o[0]=__builtin_amdgcn_mfma_f32_32x32x16_bf16(PAF(1),VFR(1),o[0],0,0,0), C0,8); \
    KRD(GL,1); GAPB(o[1]=__builtin_amdgcn_mfma_f32_32x32x16_bf16(PAF(1),VFR(5),o[1],0,0,0), C0,12); \
    KRD(GL,2); GAPB(o[0]=__builtin_amdgcn_mfma_f32_32x32x16_bf16(PAF(2),VFR(2),o[0],0,0,0), C1,0); \
    KRD(GL,3); GAPB(o[1]=__builtin_amdgcn_mfma_f32_32x32x16_bf16(PAF(2),VFR(6),o[1],0,0,0), C1,4); \
    GAPB(o[0]=__builtin_amdgcn_mfma_f32_32x32x16_bf16(PAF(3),VFR(3),o[0],0,0,0), C1,8); \
    GAPB(o[1]=__builtin_amdgcn_mfma_f32_32x32x16_bf16(PAF(3),VFR(7),o[1],0,0,0), C1,12); \
    }while(0)
  int t=1;
  #undef CMASK
  #define CMASK(P0,P1,t) do{}while(0)
  for(;t+5<NT;t+=2){
    STEP(pB0,pB1,pA0,pA1,t,true,true,true);     WAIT_BAR(2); RESC(); ROT();
    STEP(pA0,pA1,pB0,pB1,t+1,true,true,true);   WAIT_BAR(2); RESC(); ROT();
  }
  #undef CMASK
  #define CMASK(P0,P1,t) do{}while(0)
  #define ENDW(tt) do{ if((tt)+3<NT){WAIT_BAR(2);} else if((tt)+2<NT){WAIT_BAR(1);} else {WAIT_BAR(0);} }while(0)
  for(;t+1<NT;t+=2){
    STEP(pB0,pB1,pA0,pA1,t,(t+3<NT),(t+1<NT),(t+1<NT));       ENDW(t);   RESC(); ROT();
    STEP(pA0,pA1,pB0,pB1,t+1,(t+4<NT),(t+2<NT),(t+2<NT));     ENDW(t+1); RESC(); ROT();
  }
  STEP(pB0,pB1,pA0,pA1,NT-1,false,false,false); RESC();
  { float sacc=pB0[0]+pB0[1]; _Pragma("unroll") for(int r=2;r<16;++r)sacc+=pB0[r]; _Pragma("unroll") for(int r=0;r<16;++r)sacc+=pB1[r]; l_reg+=sacc;
    pw0=(u32x4){PKW(pB0,0),PKW(pB0,2),PKW(pB0,4),PKW(pB0,6)};pw1=(u32x4){PKW(pB0,8),PKW(pB0,10),PKW(pB0,12),PKW(pB0,14)};pw2=(u32x4){PKW(pB1,0),PKW(pB1,2),PKW(pB1,4),PKW(pB1,6)};pw3=(u32x4){PKW(pB1,8),PKW(pB1,10),PKW(pB1,12),PKW(pB1,14)};
    SBAR(); pv(o,vb0+sl_cur,PAF(0),PAF(1),PAF(2),PAF(3)); }
  #undef PKW
  #undef PAF
  #undef VFR
  #undef PIN
  #undef MX3
  #undef GAPA
  #undef GAPB
  #undef EX
  #undef VRD
  #undef KRD
  #undef STEP
  #undef ENDW
  {auto rr=__builtin_amdgcn_permlane32_swap(__float_as_uint(l_reg),__float_as_uint(l_reg),false,false);l_reg=__uint_as_float(rr[0])+__uint_as_float(rr[1]);}
  if(hi==0)wsf[32+r32]=l_reg;asm volatile("s_waitcnt lgkmcnt(0)":::"memory");
  float rli[16];
  #pragma unroll
  for(int r=0;r<16;++r)rli[r]=__builtin_amdgcn_rcpf(wsf[32+crow(r,hi)]);
  bf16*Ow=O+(qrow0+wid*QBLK)*DM+vcol;
  { bf16*stg=(bf16*)(shm+LDS_OST)+wid*2048;
    #pragma unroll
    for(int r=0;r<16;++r){const int orow=crow(r,hi);
      #pragma unroll
      for(int d0=0;d0<2;++d0)stg[orow*64+d0*32+r32]=(bf16)f2bf(o[d0][r]*rli[r]);}
    asm volatile("s_waitcnt lgkmcnt(0)":::"memory");
    #pragma unroll
    for(int i=0;i<4;++i){const int row=i*8+(lane>>3),ch=lane&7; const u32x4 v=*(const u32x4*)(stg+row*64+ch*8); ATTN_STORE16(Ow+(long)row*DM+ch*8,v);} }
  asm volatile("s_waitcnt lgkmcnt(0)\n\ts_barrier":::"memory");
  #undef DMA_K
  #undef DMA_V
  #undef CMASK
  #undef START
  #undef RESC
  #undef ROT
}
constexpr int ATTN_LDS_BYTES=LDS_BYTES;
#undef SBAR
#undef WAIT_BAR
#undef KVROW
}
namespace attn_body {
constexpr int V2SLOT = 16384;
constexpr int L2_K = 0, L2_V = NSLOT * SLOTB, L2_WS = L2_V + NSLOT * V2SLOT, L2_OST = L2_WS + NW * 64 * 4, L2_BYTES = L2_OST + NW * 4096;
#define SBAR() __builtin_amdgcn_sched_barrier(0)
#define WAIT_BAR(N) asm volatile("s_waitcnt vmcnt(" #N ") lgkmcnt(0)\n\ts_barrier":::"memory")
template<int THRL> __device__ __forceinline__ void attn_unit2(long qrow0,int qcol,int vcol,long kctx,long klat,int NT,const bf16*Q,const bf16*__restrict__ K,const bf16*__restrict__ V,bf16*O,char*shm){
  const int tid=threadIdx.x,lane=tid&63,r32=lane&31,hi=lane>>5; const int wid=__builtin_amdgcn_readfirstlane(tid>>6);
  const bf16*Qw=Q+(qrow0+wid*QBLK)*DM+qcol;
  const bf16*Kh=K+qcol,*Vh=V+vcol;
  const unsigned lds0=(unsigned)(uintptr_t)shm;
  float*wsf=(float*)(shm+L2_WS)+wid*64;
  const bf16*ksrc=Kh+(long)lane*DM+wid*8;
  const bf16*vsrc=Vh+(long)(16*(wid&3)+(lane>>2))*DM+(wid>>2)*32+(lane&3)*8;
  const unsigned kdst=lds0+L2_K+wid*1024, vdst=lds0+L2_V+wid*1024;
  #define KVROW(t) ((t)<4?kctx+(long)(t)*KVBLK:klat+(long)((t)-4)*KVBLK)
  #define DMA_K(t,slot) glds16(ksrc+KVROW(t)*DM,(unsigned)__builtin_amdgcn_readfirstlane(kdst+(slot)))
  #define DMA_V(t,slot) do{ glds16(vsrc+KVROW(t)*DM,(unsigned)__builtin_amdgcn_readfirstlane(vdst+2*(slot))); glds16(vsrc+KVROW(t)*DM+64,(unsigned)__builtin_amdgcn_readfirstlane(vdst+2*(slot)+8192)); }while(0)
  const char*Kbase=shm+L2_K; bf16x8 kf[8];
  const lds_cptr shm3=(lds_cptr)shm; const lds_cptr kp0=shm3+L2_K+hi*1024+r32*16; const lds_cptr vp0=shm3+L2_V+((lane>>4)&1)*32+(lane&3)*8+(4*hi+((lane&15)>>2))*64;
  DMA_K(0,0);DMA_V(0,0);DMA_K(1,SLOTB);
  bf16x8 qr[4];
  #pragma unroll
  for(int d0=0;d0<4;++d0)qr[d0]=*reinterpret_cast<const bf16x8*>(&Qw[(long)r32*DM+d0*16+hi*8]);
  float mhat=0.f,l_reg=0.f;f32x16 o[4];o[0]=f32x16{};o[1]=f32x16{};o[2]=f32x16{};o[3]=f32x16{};const f32x16 zero16=f32x16{};
  bool resc=false;
  #define START(P0,P1) do{ const float rm=rowmax(P0,P1); resc=false; mhat=rm; \
    _Pragma("unroll") for(int r=0;r<16;++r){P0[r]=fsub_s(P0[r],rm);P1[r]=fsub_s(P1[r],rm);} \
    _Pragma("unroll") for(int r=0;r<16;++r)P0[r]=__builtin_amdgcn_exp2f(P0[r]); }while(0)
  #define RESC() do{ if(resc){ asm volatile("s_waitcnt lgkmcnt(0)":::"memory"); \
      _Pragma("unroll") for(int d_=0;d_<4;++d_) _Pragma("unroll") for(int r=0;r<16;++r)o[d_][r]*=wsf[crow(r,hi)]; } }while(0)
  int sl_prev=0,sl_cur=0,sl_next=SLOTB;
  #define ROT() do{sl_prev=sl_cur;sl_cur=sl_next;sl_next=(sl_next==(NSLOT-1)*SLOTB)?0:sl_next+SLOTB;}while(0)
  DMA_K(2,2*SLOTB);
  WAIT_BAR(4);
  #define PKW(P,B) cvtpk_s(P[B],P[B+1])
  u32x4 pwA0,pwA1,pwA2,pwA3,pwB0,pwB1,pwB2,pwB3;
  { f32x16 p0,p1;
    qkt(p0,p1,Kbase,qr,zero16,r32,hi);asm volatile("s_nop 15\n\ts_nop 7":"+v"(p0),"+v"(p1));
    START(p0,p1);
    _Pragma("unroll") for(int r=0;r<16;++r)p1[r]=__builtin_amdgcn_exp2f(p1[r]);
    float sacc=p0[0]+p0[1]; _Pragma("unroll") for(int r=2;r<16;++r)sacc+=p0[r]; _Pragma("unroll") for(int r=0;r<16;++r)sacc+=p1[r]; l_reg+=sacc;
    pwA0=(u32x4){PKW(p0,0),PKW(p0,2),PKW(p0,4),PKW(p0,6)};pwA1=(u32x4){PKW(p0,8),PKW(p0,10),PKW(p0,12),PKW(p0,14)};pwA2=(u32x4){PKW(p1,0),PKW(p1,2),PKW(p1,4),PKW(p1,6)};pwA3=(u32x4){PKW(p1,8),PKW(p1,10),PKW(p1,12),PKW(p1,14)}; }
  WAIT_BAR(0);
  DMA_K(3,0);DMA_V(1,SLOTB);
  ROT();
  kload8(kf,kp0+sl_cur);
  WAIT_BAR(3);
  s16x4 vAl[4],vAh[4],vBl[4],vBh[4];
  #define PAFX(x) __builtin_bit_cast(bf16x8,x)
  #define VF(A,d) (bf16x8){A##l[d][0],A##l[d][1],A##l[d][2],A##l[d][3],A##h[d][0],A##h[d][1],A##h[d][2],A##h[d][3]}
  #define PIN(x) asm volatile("":"+v"(x))
  #define MX3(a,b,c) __builtin_fmaxf(__builtin_fmaxf((a),(b)),(c))
  #define EX(v) __builtin_amdgcn_exp2f(v)
  #define VRDL(A,d,ks) A##l[d]=vtr(vp_+((d)*4096+(ks)*1024))
  #define VRDH(A,d,ks) A##h[d]=vtr(vp_+((d)*4096+(ks)*1024+512))
  #define GAPP(MF,X,B,PWN,W,RD) do{ MF; X[B]=EX(X[B]-mhat); X[B+1]=EX(X[B+1]-mhat); sacc+=X[B]; sacc+=X[B+1]; PIN(sacc); PWN[W]=cvtpk_s(X[B],X[B+1]); PIN(PWN); RD; SBAR(); }while(0)
  #define MFQ(C,kf_,q_,acc_) C=__builtin_amdgcn_mfma_f32_32x32x16_bf16(kf_,q_,acc_,0,0,0)
  #define MFO(d,PW,A) o[d]=__builtin_amdgcn_mfma_f32_32x32x16_bf16(PAFX(PW),VF(A,d),o[d],0,0,0)
  #define KRD(G,j) do{ if(G){ kload2(kf,kp0+sl_next,j); } }while(0)
  #define STEP2(t,PI0,PI1,PI2,PI3,PO0,PO1,PO2,PO3,GK,GV,GL) do{ SBAR(); \
    const lds_cptr vp_=vp0+2*sl_prev; f32x16 C0,C1; float sacc=0.f; \
    VRDL(vA,0,0); SBAR(); MFQ(C0,kf[0],qr[0],zero16); SBAR(); \
    VRDH(vA,0,0); SBAR(); MFQ(C1,kf[1],qr[0],zero16); SBAR(); \
    VRDL(vA,1,0); SBAR(); MFQ(C0,kf[2],qr[1],C0); SBAR(); \
    VRDH(vA,1,0); SBAR(); MFQ(C1,kf[3],qr[1],C1); SBAR(); \
    VRDL(vA,2,0); SBAR(); MFQ(C0,kf[4],qr[2],C0); SBAR(); \
    VRDH(vA,2,0); SBAR(); MFQ(C1,kf[5],qr[2],C1); SBAR(); \
    VRDL(vA,3,0); SBAR(); MFQ(C0,kf[6],qr[3],C0); SBAR(); \
    VRDH(vA,3,0); SBAR(); MFQ(C1,kf[7],qr[3],C1); SBAR(); \
    if(GK){DMA_K((t)+3,sl_cur);} if(GV){DMA_V((t)+1,sl_next);} \
    { float a=MX3(C0[0],C0[1],C1[0]),b=MX3(C0[2],C0[3],C1[1]); a=MX3(a,C1[2],C1[3]); \
      _Pragma("unroll") for(int r=4;r<16;r+=4){a=MX3(a,C0[r],C0[r+1]);b=MX3(b,C0[r+2],C0[r+3]);a=MX3(a,C1[r],C1[r+1]);b=MX3(b,C1[r+2],C1[r+3]);} \
      float rm=__builtin_fmaxf(a,b); { auto rr=__builtin_amdgcn_permlane32_swap(__float_as_uint(rm),__float_as_uint(rm),false,false); rm=__builtin_fmaxf(__uint_as_float(rr[0]),__uint_as_float(rr[1])); } \
      resc=false; \
      if(__builtin_expect(__any(rm-mhat>(float)THRL),0)){ const float dl=__builtin_fmaxf(rm-mhat,0.f); mhat+=dl; \
        const float f=__builtin_amdgcn_exp2f(-dl); l_reg*=f; if(hi==0)wsf[r32]=f; resc=true; } } \
    SBAR(); \
    GAPP(MFO(0,PI0,vA),C0,0, PO0,0, VRDL(vB,0,1);VRDH(vB,0,1)); \
    GAPP(MFO(1,PI0,vA),C0,2, PO0,1, VRDL(vB,1,1);VRDH(vB,1,1)); \
    GAPP(MFO(2,PI0,vA),C0,4, PO0,2, VRDL(vB,2,1);VRDH(vB,2,1)); \
    GAPP(MFO(3,PI0,vA),C0,6, PO0,3, VRDL(vB,3,1);VRDH(vB,3,1)); \
    GAPP(MFO(0,PI1,vB),C0,8, PO1,0, VRDL(vA,0,2);VRDH(vA,0,2)); \
    GAPP(MFO(1,PI1,vB),C0,10,PO1,1, VRDL(vA,1,2);VRDH(vA,1,2)); \
    GAPP(MFO(2,PI1,vB),C0,12,PO1,2, VRDL(vA,2,2);VRDH(vA,2,2)); \
    GAPP(MFO(3,PI1,vB),C0,14,PO1,3, VRDL(vA,3,2);VRDH(vA,3,2)); \
    GAPP(MFO(0,PI2,vA),C1,0, PO2,0, VRDL(vB,0,3);VRDH(vB,0,3)); \
    GAPP(MFO(1,PI2,vA),C1,2, PO2,1, VRDL(vB,1,3);VRDH(vB,1,3)); \
    GAPP(MFO(2,PI2,vA),C1,4, PO2,2, VRDL(vB,2,3);VRDH(vB,2,3)); \
    GAPP(MFO(3,PI2,vA),C1,6, PO2,3, VRDL(vB,3,3);VRDH(vB,3,3)); \
    GAPP(MFO(0,PI3,vB),C1,8, PO3,0, KRD(GL,0)); \
    GAPP(MFO(1,PI3,vB),C1,10,PO3,1, KRD(GL,1)); \
    GAPP(MFO(2,PI3,vB),C1,12,PO3,2, KRD(GL,2)); \
    GAPP(MFO(3,PI3,vB),C1,14,PO3,3, KRD(GL,3)); \
    l_reg+=sacc; \
    }while(0)
  #define ENDW(tt) do{ if((tt)+3<NT){WAIT_BAR(3);} else if((tt)+2<NT){WAIT_BAR(2);} else {WAIT_BAR(0);} }while(0)
  int t=1;
  for(;t+5<NT;t+=2){
    STEP2(t,  pwA0,pwA1,pwA2,pwA3,pwB0,pwB1,pwB2,pwB3,true,true,true); WAIT_BAR(3); RESC(); ROT();
    STEP2(t+1,pwB0,pwB1,pwB2,pwB3,pwA0,pwA1,pwA2,pwA3,true,true,true); WAIT_BAR(3); RESC(); ROT();
  }
  for(;t+1<NT;t+=2){
    STEP2(t,  pwA0,pwA1,pwA2,pwA3,pwB0,pwB1,pwB2,pwB3,(t+3<NT),(t+1<NT),(t+1<NT)); ENDW(t);   RESC(); ROT();
    STEP2(t+1,pwB0,pwB1,pwB2,pwB3,pwA0,pwA1,pwA2,pwA3,(t+4<NT),(t+2<NT),(t+2<NT)); ENDW(t+1); RESC(); ROT();
  }
  STEP2(NT-1,pwA0,pwA1,pwA2,pwA3,pwB0,pwB1,pwB2,pwB3,false,false,false); RESC();
  { const lds_cptr vp_=vp0+2*sl_cur;
    #pragma unroll
    for(int ks=0;ks<4;++ks){
      #pragma unroll
      for(int d=0;d<4;++d){ const s16x4 lo=vtr(vp_+(d*4096+ks*1024)),hh=vtr(vp_+(d*4096+ks*1024+512)); const bf16x8 vf=(bf16x8){lo[0],lo[1],lo[2],lo[3],hh[0],hh[1],hh[2],hh[3]};
        const u32x4 pw=(ks==0)?pwB0:(ks==1)?pwB1:(ks==2)?pwB2:pwB3;
        o[d]=__builtin_amdgcn_mfma_f32_32x32x16_bf16(PAFX(pw),vf,o[d],0,0,0); } } }
  {auto rr=__builtin_amdgcn_permlane32_swap(__float_as_uint(l_reg),__float_as_uint(l_reg),false,false);l_reg=__uint_as_float(rr[0])+__uint_as_float(rr[1]);}
  if(hi==0)wsf[32+r32]=l_reg;asm volatile("s_waitcnt lgkmcnt(0)":::"memory");
  float rli[16];
  #pragma unroll
  for(int r=0;r<16;++r)rli[r]=__builtin_amdgcn_rcpf(wsf[32+crow(r,hi)]);
  bf16*Ow=O+(qrow0+wid*QBLK)*DM+vcol;
  { bf16*stg=(bf16*)(shm+L2_OST)+wid*2048;
    #pragma unroll
    for(int hf=0;hf<2;++hf){
      #pragma unroll
      for(int r=0;r<16;++r){const int orow=crow(r,hi);
        #pragma unroll
        for(int d0=0;d0<2;++d0)stg[orow*64+d0*32+r32]=(bf16)f2bf(o[2*hf+d0][r]*rli[r]);}
      asm volatile("s_waitcnt lgkmcnt(0)":::"memory");
      #pragma unroll
      for(int i=0;i<4;++i){const int row=i*8+(lane>>3),ch=lane&7; const u32x4 v=*(const u32x4*)(stg+row*64+ch*8); *(u32x4*)(Ow+(long)row*DM+hf*64+ch*8)=v;}
      asm volatile("s_waitcnt lgkmcnt(0)":::"memory"); } }
  asm volatile("s_waitcnt lgkmcnt(0)\n\ts_barrier":::"memory");
  #undef KVROW
  #undef DMA_K
  #undef DMA_V
  #undef START
  #undef RESC
  #undef ROT
  #undef PKW
  #undef PAFX
  #undef VF
  #undef PIN
  #undef MX3
  #undef EX
  #undef VRDL
  #undef VRDH
  #undef GAPP
  #undef MFQ
  #undef MFO
  #undef KRD
  #undef STEP2
  #undef ENDW
}
#undef SBAR
#undef WAIT_BAR
}
__device__ __forceinline__ void phase_attn2(const Frame& F, const Prm& p) {
    const bf16* Q = (const bf16*)(p.ws + WS_Q); const bf16* K = (const bf16*)(p.ws + WS_K); const bf16* V = (const bf16*)(p.ws + WS_V); bf16* O1 = (bf16*)(p.ws + WS_O1);
    for (int v = vcu_of(F); v < 256; v += F.G) {
        const int b = v >> 5, hm = (v >> 1) & 15, h = hm >> 1, m = hm & 1, half = v & 1;
        const int qcol = hm * 64, vcol = h * 128; bf16* O = O1 + (size_t)m * ((WS_O2 - WS_O1) / 2);
        const long kctx = NLAT + b * CTXL, klat = (long)b * SEQ;
        const int nu = half ? 8 : 9;
        for (int i = 0; i < nu; ++i) {
            const long qrow0 = i < 8 ? klat + (half * 8 + i) * 256 : kctx; const int NT = i < 8 ? 68 : 4;
            attn_body::attn_unit2<8>(qrow0, qcol, vcol, kctx, klat, NT, Q, K, V, O, (char*)F.lds);
        }
    }
}
namespace gla {
typedef short bf16x8 __attribute__((ext_vector_type(8)));
typedef short s16x4 __attribute__((ext_vector_type(4)));
typedef float f32x16 __attribute__((ext_vector_type(16)));
constexpr int PQ = 272, PK = 144;
constexpr int L_QS = 0, L_KS = 64 * PQ, L_KT = 2 * 64 * PQ, L_VT = L_KT + 128 * PK, L_SB = L_VT + 64 * PK, L_DEC = L_SB + 64 * PQ, L_END = L_DEC + 512;
__device__ __forceinline__ int crow(int i, int hh) { return (i & 3) + 8 * (i >> 2) + 4 * hh; }
typedef float f32x2_t __attribute__((ext_vector_type(2))); typedef __bf16 bf16x2_t __attribute__((ext_vector_type(2)));
__device__ __forceinline__ unsigned pk(float lo, float hi) { f32x2_t v = {lo, hi}; bf16x2_t b = __builtin_convertvector(v, bf16x2_t); return __builtin_bit_cast(unsigned, b); }

__device__ __forceinline__ void scan_unit(const Frame& F, const Prm& p, int unit) {
    const int dvs = unit & 3, dir = (unit >> 2) & 1, h = (unit >> 3) & 3, b = unit >> 5;
    LAS unsigned char* lds = (LAS unsigned char*)F.lds;
    const int lane = F.lane, w = F.wave, tid = F.tid, r = lane & 31, hh = lane >> 5;
    const bf16* QT = (const bf16*)(p.ws + WS_QT) + (size_t)dir * NTOK * 512 + h * 128 + 8 * w;
    const bf16* KT = (const bf16*)(p.ws + WS_KT) + (size_t)dir * NTOK * 512 + h * 128 + 8 * w;
    const bf16* V = (const bf16*)(p.ws + WS_V1) + h * 256 + dvs * 64 + 8 * w;
    const float* DEC = (const float*)(p.ws + WS_DEC) + (size_t)dir * NCHUNK * 512 + h * 128;
    bf16* OG = (bf16*)(p.ws + (dir ? WS_OGB : WS_OGF)) + h * 256 + dvs * 64;
    f32x16 S0 = {}, S1 = {};
    for (int i = tid; i < 64 * PQ / 16; i += NTHR) *(LAS u32x4*)(lds + L_SB + i * 16) = (u32x4){0u, 0u, 0u, 0u};
    u32x4 pq0, pq1, pk0, pk1, pv; float pdec = 0.f;
#define GLA_CHUNK(step) ((step) >= 4 ? b * 64 + (dir ? 63 - ((step) - 4) : (step) - 4) : 512 + b * 4 + (dir ? 3 - (step) : (step)))
#define GLA_LOAD(step) do { const size_t row_ = (size_t)GLA_CHUNK(step) * 64 + lane; \
        pq0 = *(const u32x4*)(QT + row_ * 512); pq1 = *(const u32x4*)(QT + row_ * 512 + 64); pk0 = *(const u32x4*)(KT + row_ * 512); pk1 = *(const u32x4*)(KT + row_ * 512 + 64); \
        pv = *(const u32x4*)(V + row_ * 1024); if (tid < 128) pdec = DEC[(size_t)GLA_CHUNK(step) * 512 + tid]; } while (0)
#define GLA_T16(base, x, j) do { *(LAS unsigned short*)(lds + (base) + (2 * (j)) * PK + 2 * lane) = (unsigned short)((x) & 0xffffu); *(LAS unsigned short*)(lds + (base) + (2 * (j) + 1) * PK + 2 * lane) = (unsigned short)((x) >> 16); } while (0)
#define GLA_STORE() do { \
        *(LAS u32x4*)(lds + L_QS + lane * PQ + 16 * w) = pq0; *(LAS u32x4*)(lds + L_QS + lane * PQ + 128 + 16 * w) = pq1; \
        *(LAS u32x4*)(lds + L_KS + lane * PQ + 16 * w) = pk0; *(LAS u32x4*)(lds + L_KS + lane * PQ + 128 + 16 * w) = pk1; \
        GLA_T16(L_KT + 8 * w * PK, pk0.x, 0); GLA_T16(L_KT + 8 * w * PK, pk0.y, 1); GLA_T16(L_KT + 8 * w * PK, pk0.z, 2); GLA_T16(L_KT + 8 * w * PK, pk0.w, 3); \
        GLA_T16(L_KT + (64 + 8 * w) * PK, pk1.x, 0); GLA_T16(L_KT + (64 + 8 * w) * PK, pk1.y, 1); GLA_T16(L_KT + (64 + 8 * w) * PK, pk1.z, 2); GLA_T16(L_KT + (64 + 8 * w) * PK, pk1.w, 3); \
        GLA_T16(L_VT + 8 * w * PK, pv.x, 0); GLA_T16(L_VT + 8 * w * PK, pv.y, 1); GLA_T16(L_VT + 8 * w * PK, pv.z, 2); GLA_T16(L_VT + 8 * w * PK, pv.w, 3); \
        if (tid < 128) *(LAS float*)(lds + L_DEC + 4 * tid) = pdec; } while (0)
    GLA_LOAD(0);
    GLA_STORE();
    __syncthreads();
    for (int step = 0; step < 68; ++step) {
        const bool lat = step >= 4; const int chunk = GLA_CHUNK(step);
        if (step + 1 < 68) GLA_LOAD(step + 1);
        if (w < 4) {
            if (lat) {
                const int tb = w >> 1, vb = w & 1;
                bf16x8 bq[8]; f32x16 sc0 = {}, sc1 = {};
#pragma unroll
                for (int ks = 0; ks < 8; ++ks) {
                    bq[ks] = *(const LAS bf16x8*)(lds + L_QS + (32 * tb + r) * PQ + (16 * ks + 8 * hh) * 2);
                    const bf16x8 a0 = *(const LAS bf16x8*)(lds + L_KS + r * PQ + (16 * ks + 8 * hh) * 2), a1 = *(const LAS bf16x8*)(lds + L_KS + (32 + r) * PQ + (16 * ks + 8 * hh) * 2);
                    sc0 = __builtin_amdgcn_mfma_f32_32x32x16_bf16(a0, bq[ks], sc0, 0, 0, 0); sc1 = __builtin_amdgcn_mfma_f32_32x32x16_bf16(a1, bq[ks], sc1, 0, 0, 0);
                }
                const int t = 32 * tb + r;
#pragma unroll
                for (int i = 0; i < 16; ++i) { const int s0 = crow(i, hh), s1 = 32 + s0; const bool k0 = dir ? (s0 >= t) : (s0 <= t), k1 = dir ? (s1 >= t) : (s1 <= t); sc0[i] = k0 ? sc0[i] : 0.f; sc1[i] = k1 ? sc1[i] : 0.f; }
                f32x16 o = {};
#pragma unroll
                for (int sb = 0; sb < 2; ++sb)
#pragma unroll
                    for (int sp = 0; sp < 2; ++sp) {
                        u32x4 pw;
                        if (sb == 0) { pw.x = pk(sc0[8 * sp + 0], sc0[8 * sp + 1]); pw.y = pk(sc0[8 * sp + 2], sc0[8 * sp + 3]); pw.z = pk(sc0[8 * sp + 4], sc0[8 * sp + 5]); pw.w = pk(sc0[8 * sp + 6], sc0[8 * sp + 7]); }
                        else { pw.x = pk(sc1[8 * sp + 0], sc1[8 * sp + 1]); pw.y = pk(sc1[8 * sp + 2], sc1[8 * sp + 3]); pw.z = pk(sc1[8 * sp + 4], sc1[8 * sp + 5]); pw.w = pk(sc1[8 * sp + 6], sc1[8 * sp + 7]); }
                        const s16x4 lo = *(const LAS s16x4*)(lds + L_VT + (32 * vb + r) * PK + (32 * sb + 16 * sp + 4 * hh) * 2), hi = *(const LAS s16x4*)(lds + L_VT + (32 * vb + r) * PK + (32 * sb + 16 * sp + 8 + 4 * hh) * 2);
                        const bf16x8 av = {lo[0], lo[1], lo[2], lo[3], hi[0], hi[1], hi[2], hi[3]};
                        o = __builtin_amdgcn_mfma_f32_32x32x16_bf16(av, __builtin_bit_cast(bf16x8, pw), o, 0, 0, 0);
                    }
#pragma unroll
                for (int ks = 0; ks < 8; ++ks) {
                    const bf16x8 as = *(const LAS bf16x8*)(lds + L_SB + (32 * vb + r) * PQ + (16 * ks + 8 * hh) * 2);
                    o = __builtin_amdgcn_mfma_f32_32x32x16_bf16(as, bq[ks], o, 0, 0, 0);
                }
                bf16* orow = OG + ((size_t)chunk * 64 + t) * DM + 32 * vb + 4 * hh;
#pragma unroll
                for (int g = 0; g < 4; ++g) { u32x2 wv; wv.x = pk(o[4 * g], o[4 * g + 1]); wv.y = pk(o[4 * g + 2], o[4 * g + 3]); *(u32x2*)(orow + 8 * g) = wv; }
            }
        } else {
            const int db = w - 4;
#pragma unroll
            for (int ks = 0; ks < 4; ++ks) {
                const bf16x8 a = *(const LAS bf16x8*)(lds + L_KT + (32 * db + r) * PK + (16 * ks + 8 * hh) * 2);
                const bf16x8 b0 = *(const LAS bf16x8*)(lds + L_VT + r * PK + (16 * ks + 8 * hh) * 2), b1 = *(const LAS bf16x8*)(lds + L_VT + (32 + r) * PK + (16 * ks + 8 * hh) * 2);
                S0 = __builtin_amdgcn_mfma_f32_32x32x16_bf16(a, b0, S0, 0, 0, 0); S1 = __builtin_amdgcn_mfma_f32_32x32x16_bf16(a, b1, S1, 0, 0, 0);
            }
#pragma unroll
            for (int i = 0; i < 16; ++i) { const float dc = *(const LAS float*)(lds + L_DEC + 4 * (32 * db + crow(i, hh))); S0[i] *= dc; S1[i] *= dc; }
        }
        __syncthreads();
        if (step + 1 < 68) {
            GLA_STORE();
            if (w >= 4) { const int db = w - 4;
#pragma unroll
                for (int g = 0; g < 4; ++g) { u32x2 w0, w1; w0.x = pk(S0[4 * g], S0[4 * g + 1]); w0.y = pk(S0[4 * g + 2], S0[4 * g + 3]); w1.x = pk(S1[4 * g], S1[4 * g + 1]); w1.y = pk(S1[4 * g + 2], S1[4 * g + 3]);
                    *(LAS u32x2*)(lds + L_SB + r * PQ + (32 * db + 8 * g + 4 * hh) * 2) = w0; *(LAS u32x2*)(lds + L_SB + (32 + r) * PQ + (32 * db + 8 * g + 4 * hh) * 2) = w1; } }
        }
        __syncthreads();
    }
#undef GLA_CHUNK
#undef GLA_LOAD
#undef GLA_T16
#undef GLA_STORE
}
}
__device__ __forceinline__ void phase_scan_opt(const Frame& F, const Prm& p) {
    for (int unit = vcu_of(F); unit < 256; unit += F.G) gla::scan_unit(F, p, unit);
}
#define PHASE_QKV(F, p) phase_qkv_opt(F, p)
#define PHASE_ATTN(F, p) phase_attn2(F, p)
#define PHASE_WO(F, p, l) phase_wo_opt(F, p, l)
#define PHASE_MOE1(F, p, l) phase_moe1_opt(F, p, l)
#define PHASE_MOE2(F, p, l) phase_moe2_opt(F, p, l)
#define PHASE_INPROJ(F, p) phase_inproj_opt(F, p)
#define PHASE_SCAN(F, p) phase_scan_opt(F, p)
typedef GAS unsigned gu32;
#define XB_TMO      128
#define XB_XCNT(j)  (256  + 64 * (j))
#define XB_XSUB(j)  (1280 + 64 * (j))
#define XB_XGEN(j)  (2304 + 64 * (j))
#define XB_TOP      3328
#define XB_TOPGEN   3392
#define XCD_BAR_WORDS 3456
#define XB_SPIN_CAP (1u << 20)
__device__ __forceinline__ unsigned xb_ld(unsigned* p)              { return __hip_atomic_load(p, __ATOMIC_RELAXED, __HIP_MEMORY_SCOPE_AGENT); }
__device__ __forceinline__ unsigned xb_add(unsigned* p, unsigned v) { return __hip_atomic_fetch_add(p, v, __ATOMIC_RELAXED, __HIP_MEMORY_SCOPE_AGENT); }
__device__ __forceinline__ unsigned xb_xcc_id() { return (unsigned)__builtin_amdgcn_s_getreg((3 << 11) | 20) & 0xFu; }
#define XB_SPIN(cond, bar) do { unsigned _sp = 0; while (cond) { __builtin_amdgcn_s_sleep(1); \
    if ((++_sp & 255u) == 0u) { if (xb_ld(&(bar)[XB_TMO])) break; if (_sp > XB_SPIN_CAP) { atomicAdd(&(bar)[XB_TMO], 1u); break; } } } } while (0)
struct XcdBarrier { unsigned* bar; unsigned x; volatile LAS unsigned* st; };
__device__ __forceinline__ XcdBarrier xcd_barrier_post(unsigned* bar, volatile LAS unsigned* st) {
    XcdBarrier b; b.bar = bar; b.x = xb_xcc_id(); b.st = st;
    if (threadIdx.x == 0) (void)xb_add(&bar[XB_XCNT(b.x)], 1u);
    return b;
}
__device__ __forceinline__ void xcd_barrier_complete(unsigned* bar, unsigned x, unsigned& nloc, unsigned& nx) {
    const unsigned G = gridDim.x * gridDim.y * gridDim.z;
    unsigned sum, cnt, mine, sp = 0u;
    for (;;) {
        sum = 0u; cnt = 0u; mine = 0u;
#pragma unroll
        for (unsigned j = 0; j < 16; ++j) { const unsigned c = xb_ld(&bar[XB_XCNT(j)]); sum += c; cnt += (c > 0u) ? 1u : 0u; mine = (j == x) ? c : mine; }
        if (sum == G) break;
        __builtin_amdgcn_s_sleep(1);
        if ((++sp & 255u) == 0u) { if (xb_ld(&bar[XB_TMO])) break; if (sp > XB_SPIN_CAP) { atomicAdd(&bar[XB_TMO], 1u); break; } }
    }
    nloc = mine > 0u ? mine : 1u; nx = cnt > 0u ? cnt : 1u;
}
__device__ __forceinline__ void xcd_barrier(const XcdBarrier& b) {
    asm volatile("s_waitcnt vmcnt(0)" ::: "memory");
    __syncthreads();
    if (threadIdx.x == 0) {
        unsigned* bar = b.bar;
        __builtin_amdgcn_s_waitcnt(0);
        unsigned nloc = b.st[0], nx = b.st[1];
        if (nloc == 0u) { xcd_barrier_complete(bar, b.x, nloc, nx); b.st[0] = nloc; b.st[1] = nx; }
        const unsigned old = xb_add(&bar[XB_XSUB(b.x)], 1u);
        const unsigned gen = old / nloc;
        if (old + 1u == (gen + 1u) * nloc) {
            __builtin_amdgcn_fence(__ATOMIC_RELEASE, "agent");
            asm volatile("s_waitcnt vmcnt(0)" ::: "memory");
            const unsigned og = xb_add(&bar[XB_TOP], 1u);
            const unsigned tg = og / nx;
            if (og + 1u == (tg + 1u) * nx) xb_add(&bar[XB_TOPGEN], 1u);
            else XB_SPIN(xb_ld(&bar[XB_TOPGEN]) == tg, bar);
            __builtin_amdgcn_fence(__ATOMIC_ACQUIRE, "agent");
            xb_add(&bar[XB_XGEN(b.x)], 1u);
            asm volatile("s_waitcnt vmcnt(0)" ::: "memory");
        } else {
            XB_SPIN(xb_ld(&bar[XB_XGEN(b.x)]) == gen, bar);
            __builtin_amdgcn_fence(__ATOMIC_ACQUIRE, "agent");
            asm volatile("s_waitcnt vmcnt(0)" ::: "memory");
        }
    }
    __syncthreads();
}

constexpr int NPHASE = 19;
#ifndef OPT_MASK
#define OPT_MASK 0u
#endif
__global__ void __launch_bounds__(NTHR, 2) mega_fwd(Prm p) {
    extern __shared__ __attribute__((aligned(16))) unsigned char lds[];
    Frame F; F.lds = lds; F.ctl = (unsigned*)(p.ws + WS_CTL);
    F.tid = threadIdx.x; F.lane = F.tid & 63; F.wave = __builtin_amdgcn_readfirstlane(F.tid >> 6); F.G = gridDim.x; F.bid = blockIdx.x;
    for (int u = F.tid; u < (LDS_BYTES - LDSCTL_OFF) / 4; u += NTHR) ((LAS unsigned*)(lds + LDSCTL_OFF))[u] = 0u;
    __syncthreads();
    const int lo = p.ph_lo, hi = p.ph_hi;
    const bool multi = (hi - lo) > 1;
    XcdBarrier bar; bar.bar = F.ctl + CW_BAR + p.li * XCD_BAR_WORDS; bar.x = 0; bar.st = nullptr;
    if (multi) bar = xcd_barrier_post(F.ctl + CW_BAR + p.li * XCD_BAR_WORDS, (volatile LAS unsigned*)(lds + MISC_OFF) + 8);
#define IN(k) (lo <= (k) && (k) < hi)
#define SEAM(k) do { if (IN(k) && IN((k) + 1)) xcd_barrier(bar); } while (0)
#ifndef REP_MASK
#define REP_MASK 0u
#endif
#define REP(k, call) do { if (((REP_MASK) >> (k)) & 1u) { xcd_barrier(bar); call; } } while (0)
    if (IN(0)) { phase_prologue(F, p); REP(0, phase_prologue(F, p)); } SEAM(0);
    if (IN(1)) { phase_modulate0(F, p); REP(1, phase_modulate0(F, p)); } SEAM(1);
    if (IN(2)) { PHASE_QKV(F, p); REP(2, PHASE_QKV(F, p)); } SEAM(2);
    if (IN(3)) { PHASE_ATTN(F, p); REP(3, PHASE_ATTN(F, p)); } SEAM(3);
    if (IN(4)) { phase_attn_combine(F, p); REP(4, phase_attn_combine(F, p)); } SEAM(4);
    if (IN(5)) { PHASE_WO(F, p, 0); REP(5, PHASE_WO(F, p, 0)); } SEAM(5);
    if (IN(6)) { phase_ln_route(F, p, 0); REP(6, phase_ln_route(F, p, 0)); } SEAM(6);
    if (IN(7)) { PHASE_MOE1(F, p, 0); REP(7, PHASE_MOE1(F, p, 0)); } SEAM(7);
    if (IN(8)) { PHASE_MOE2(F, p, 0); REP(8, PHASE_MOE2(F, p, 0)); } SEAM(8);
    if (IN(9)) { phase_moe_combine(F, p, 0); REP(9, phase_moe_combine(F, p, 0)); } SEAM(9);
    if (IN(10)) { PHASE_INPROJ(F, p); REP(10, PHASE_INPROJ(F, p)); } SEAM(10);
    if (IN(11)) { phase_gla_prep(F, p); REP(11, phase_gla_prep(F, p)); } SEAM(11);
    if (IN(12)) { PHASE_SCAN(F, p); REP(12, PHASE_SCAN(F, p)); } SEAM(12);
    if (IN(13)) { phase_gla_post(F, p); REP(13, phase_gla_post(F, p)); } SEAM(13);
    if (IN(14)) { PHASE_WO(F, p, 1); REP(14, PHASE_WO(F, p, 1)); } SEAM(14);
    if (IN(15)) { phase_ln_route(F, p, 1); REP(15, phase_ln_route(F, p, 1)); } SEAM(15);
    if (IN(16)) { PHASE_MOE1(F, p, 1); REP(16, PHASE_MOE1(F, p, 1)); } SEAM(16);
    if (IN(17)) { PHASE_MOE2(F, p, 1); REP(17, PHASE_MOE2(F, p, 1)); } SEAM(17);
    if (IN(18)) { phase_moe_combine(F, p, 1); REP(18, phase_moe_combine(F, p, 1)); }
#undef IN
#undef SEAM
}

static void launch_naive(int ph, const Prm& p, hipStream_t stream) {
    using namespace naive;
    const bf16* H = (const bf16*)(p.ws + WS_H);
    switch (ph) {
    case 2: { NG g{H, (const bf16*)(p.ws + WS_WQKV), NTOK, 3072, 1024, 0, nullptr}; hipLaunchKernelGGL(gemm_kernel<EPI_QKV>, dim3(3072 / 64, NTOK / 64), dim3(256), 0, stream, g, p); break; }
    case 3: hipLaunchKernelGGL(attn_kernel, dim3(544, 16), dim3(256), 0, stream, p); break;
    case 5: { NG g{(const bf16*)(p.ws + WS_A2), (const bf16*)(p.ws + WS_WO), NTOK, 1024, 1024, 0, (bf16*)(p.ws + WS_Y)}; hipLaunchKernelGGL(gemm_kernel<EPI_PLAIN>, dim3(16, NTOK / 64), dim3(256), 0, stream, g, p); break; }
    case 7: case 16: { const int l = ph == 16; NG g{H, (const bf16*)(p.ws + (l ? WS_GU1 : WS_GU0)), MAXSLOT, 1024, 1024, l, nullptr}; hipLaunchKernelGGL(gemm_kernel<EPI_GATEUP>, dim3(16, MAXSLOT / 64), dim3(256), 0, stream, g, p); break; }
    case 8: case 17: { const int l = ph == 17; NG g{(const bf16*)(p.ws + WS_ACT), (const bf16*)(p.ws + (l ? WS_DN1 : WS_DN0)), MAXSLOT, 1024, 512, l, nullptr}; hipLaunchKernelGGL(gemm_kernel<EPI_DOWN>, dim3(16, MAXSLOT / 64), dim3(256), 0, stream, g, p); break; }
    case 10: { NG g{H, (const bf16*)(p.ws + WS_WIN), NTOK, NIN, 1024, 0, nullptr}; hipLaunchKernelGGL(gemm_kernel<EPI_INPROJ>, dim3(NIN / 64, NTOK / 64), dim3(256), 0, stream, g, p); break; }
    case 12: hipLaunchKernelGGL(gla_scan_kernel, dim3(512), dim3(256), GLA_SCAN_LDS, stream, p); break;
    case 14: { NG g{(const bf16*)(p.ws + WS_A2B), (const bf16*)(p.ws + WS_WGO), NLAT, 1024, 1024, 0, (bf16*)(p.ws + WS_Y)}; hipLaunchKernelGGL(gemm_kernel<EPI_PLAIN>, dim3(16, NLAT / 64), dim3(256), 0, stream, g, p); break; }
    default: break;
    }
}
extern "C" void kernel_launch(void* const* d_in, const int* in_sizes, int n_in, void* d_out, int out_size, void* d_ws, size_t ws_size, hipStream_t stream) {
    static int grid = 0;
    if (grid == 0) {
        if (n_in != 23 || in_sizes[0] != NLAT * DM || out_size != NLAT * DM || ws_size < WS_END) { fprintf(stderr, "kernel_launch: unexpected shapes (n_in %d, in0 %d, out %d, ws %zu); nothing launched\n", n_in, n_in > 0 ? in_sizes[0] : -1, out_size, ws_size); grid = -1; return; }
        int dev = 0, cus = 0;
        if (hipGetDevice(&dev) != hipSuccess || hipDeviceGetAttribute(&cus, hipDeviceAttributeMultiprocessorCount, dev) != hipSuccess) { grid = -1; return; }
        if (hipFuncSetAttribute((const void*)mega_fwd, hipFuncAttributeMaxDynamicSharedMemorySize, LDS_BYTES) != hipSuccess) { fprintf(stderr, "kernel_launch: hipFuncSetAttribute failed\n"); grid = -1; return; }
        (void)hipFuncSetAttribute((const void*)naive::gla_scan_kernel, hipFuncAttributeMaxDynamicSharedMemorySize, naive::GLA_SCAN_LDS);
        int per_cu = 0;
        if (hipOccupancyMaxActiveBlocksPerMultiprocessor(&per_cu, (const void*)mega_fwd, NTHR, LDS_BYTES) != hipSuccess || per_cu < 1) fprintf(stderr, "kernel_launch: note: occupancy query reports %d\n", per_cu);
        (void)hipGetLastError();
        grid = cus;
    }
    if (grid < 0) return;
    (void)hipMemsetAsync((char*)d_ws + WS_CTL, 0, CTL_ZERO_BYTES, stream);
    Prm p{};
    const float** pp = (const float**)&p;
    for (int i = 0; i < 23; ++i) pp[i] = (const float*)d_in[i];
    p.out = (float*)d_out; p.ws = (unsigned char*)d_ws;
    const unsigned naive_phases = (1u << 2) | (1u << 3) | (1u << 5) | (1u << 7) | (1u << 8) | (1u << 10) | (1u << 12) | (1u << 14) | (1u << 16) | (1u << 17);
    const unsigned use_naive = naive_phases & ~(unsigned)(OPT_MASK);
    int ph = 0, li = 0;
    while (ph < NPHASE) {
        if (use_naive & (1u << ph)) { launch_naive(ph, p, stream); ++ph; continue; }
        int e = ph + 1;
#if defined(ONE_PER_PHASE)
#else
        while (e < NPHASE && !(use_naive & (1u << e))) ++e;
#endif
        p.ph_lo = ph; p.ph_hi = e; p.li = li++;
        hipLaunchKernelGGL(mega_fwd, dim3(grid), dim3(NTHR), LDS_BYTES, stream, p);
        ph = e;
    }
}
```

```cpp
#define OPT_MASK 0x355ACu
#include <hip/hip_runtime.h>
#include <cstdint>
#include <cstdio>

constexpr int BATCH = 8, SEQ = 4096, DM = 1024, CTXL = 256;
constexpr int NLAT = BATCH * SEQ, NCTX = BATCH * CTXL, NTOK = NLAT + NCTX;
constexpr float ALPHA = 1.4142135623730951f;
constexpr float LN_EPS = 1e-5f;
constexpr float LAMBDA_INIT0 = 0.2f;
constexpr float C2 = 0.125f * 1.4426950408889634f;
constexpr int NEXP = 16, DEXP = 512, MAXSLOT = 73728;
constexpr int NCHUNK = NTOK / 64;
constexpr int NIN = 3328;

typedef unsigned short bf16;
typedef float f32x4 __attribute__((ext_vector_type(4)));
typedef float f32x2 __attribute__((ext_vector_type(2)));
typedef unsigned u32x2 __attribute__((ext_vector_type(2)));
typedef unsigned u32x4 __attribute__((ext_vector_type(4)));

constexpr size_t MiB = 1u << 20;
constexpr size_t WS_CTL = 0, CTL_ZERO_BYTES = 1 * MiB;
constexpr size_t WS_MOD = 1 * MiB;
constexpr size_t WS_MISC = 1 * MiB + 512 * 1024;
constexpr size_t WS_WQKV = 2 * MiB, WS_WO = 8 * MiB, WS_GU0 = 10 * MiB, WS_DN0 = 42 * MiB;
constexpr size_t WS_XCTX = 58 * MiB;
constexpr size_t WS_WIN = 66 * MiB, WS_WGO = 73 * MiB, WS_GU1 = 75 * MiB, WS_DN1 = 107 * MiB;
constexpr size_t WS_H = 123 * MiB;
constexpr size_t WS_Q = 191 * MiB, WS_K = 259 * MiB, WS_V = 327 * MiB, WS_O2 = 395 * MiB;
constexpr size_t WS_LIST = 463 * MiB;
constexpr size_t WS_TOKR = 466 * MiB;
constexpr size_t WS_DEC = 468 * MiB;
constexpr size_t WS_ZZ = 471 * MiB;
constexpr size_t WS_END = 480 * MiB;
constexpr size_t WS_O1 = WS_H, WS_A2 = WS_Q, WS_Y = WS_K;
constexpr size_t WS_YM = 191 * MiB, WS_ACT = 335 * MiB;
constexpr size_t WS_QR = 191 * MiB, WS_KR = 225 * MiB, WS_V1 = 259 * MiB, WS_R = 327 * MiB;
constexpr size_t WS_QT = WS_H, WS_KT = 395 * MiB;
constexpr size_t WS_OGF = 191 * MiB, WS_OGB = 2 * MiB;
constexpr size_t WS_A2B = WS_H;
constexpr int CW_TMO = 0, CW_CODE = 1;
constexpr int CW_CNT = 64;
constexpr int CW_BAR = 4096;

__device__ __forceinline__ unsigned f2bf(float f) { unsigned u = __builtin_bit_cast(unsigned, f); return (u + 0x7fffu + ((u >> 16) & 1u)) >> 16; }
__device__ __forceinline__ unsigned pk2(float lo, float hi) { return f2bf(lo) | (f2bf(hi) << 16); }
__device__ __forceinline__ float bf2f(unsigned b) { return __builtin_bit_cast(float, b << 16); }
__device__ __forceinline__ float wave_sum(float v) {
#pragma unroll
    for (int o = 1; o < 64; o <<= 1) v += __shfl_xor(v, o);
    return v;
}
__device__ __forceinline__ float silu_f(float v) { return v / (1.f + __expf(-v)); }

struct Prm {
    const float *x, *c, *ctx, *cctx, *ada_w, *ada_b, *ln_g, *ln_b, *w_qkv, *w_o, *lam, *subln, *gw_in, *gwg_down, *gwg_up, *gbg, *gnorm, *gw_o, *rw, *rb, *mg, *mu, *md;
    float* out; unsigned char* ws;
    int ph_lo, ph_hi, li, pad;
};
__device__ __forceinline__ void ld_row_f32(const float* p, int lane, f32x4 (&v)[4]) {
#pragma unroll
    for (int j = 0; j < 4; ++j) v[j] = *(const f32x4*)(p + 4 * lane + 256 * j);
}
__device__ __forceinline__ void st_row_f32(float* p, int lane, const f32x4 (&v)[4]) {
#pragma unroll
    for (int j = 0; j < 4; ++j) *(f32x4*)(p + 4 * lane + 256 * j) = v[j];
}
__device__ __forceinline__ void ld_row_bf16(const bf16* p, int lane, f32x4 (&v)[4]) {
#pragma unroll
    for (int j = 0; j < 4; ++j) { const u32x2 u = *(const u32x2*)(p + 4 * lane + 256 * j); v[j] = (f32x4){bf2f(u.x & 0xffffu), bf2f(u.x >> 16), bf2f(u.y & 0xffffu), bf2f(u.y >> 16)}; }
}
__device__ __forceinline__ void st_row_bf16(bf16* p, int lane, const f32x4 (&v)[4]) {
#pragma unroll
    for (int j = 0; j < 4; ++j) { u32x2 u; u.x = pk2(v[j].x, v[j].y); u.y = pk2(v[j].z, v[j].w); *(u32x2*)(p + 4 * lane + 256 * j) = u; }
}
__device__ __forceinline__ void ln_row(f32x4 (&v)[4], const float* g, const float* b, int lane) {
    float s = 0.f;
#pragma unroll
    for (int j = 0; j < 4; ++j) s += (v[j].x + v[j].y) + (v[j].z + v[j].w);
    const float mean = wave_sum(s) * (1.f / DM); float q = 0.f;
#pragma unroll
    for (int j = 0; j < 4; ++j) { v[j] = v[j] - mean; q += (v[j].x * v[j].x + v[j].y * v[j].y) + (v[j].z * v[j].z + v[j].w * v[j].w); }
    const float rstd = 1.f / sqrtf(wave_sum(q) * (1.f / DM) + LN_EPS);
#pragma unroll
    for (int j = 0; j < 4; ++j) { const f32x4 gg = *(const f32x4*)(g + 4 * lane + 256 * j), bb = *(const f32x4*)(b + 4 * lane + 256 * j); v[j] = v[j] * rstd * gg + bb; }
}
__host__ __device__ __forceinline__ int gu_phys(int other, int sel) { return (other >> 4) * 32 + sel * 16 + (other & 15); }
__host__ __device__ __forceinline__ int perm16b(int L) { return (L & ~31) | (16 * ((L >> 2) & 1) + 4 * ((L >> 3) & 3) + (L & 3)); }
__host__ __device__ __forceinline__ int perm16b_inv(int P) { return (P & ~31) | (8 * ((P >> 2) & 3) + 4 * ((P >> 4) & 1) + (P & 3)); }
__device__ __forceinline__ unsigned pk4_fp8(float a, float b, float c, float d) { int w = 0; w = __builtin_amdgcn_cvt_pk_fp8_f32(a, b, w, false); w = __builtin_amdgcn_cvt_pk_fp8_f32(c, d, w, true); return (unsigned)w; }
constexpr float W8_SCALE = 64.f, W8_INV = 1.f / 64.f;
__device__ __forceinline__ void st_row_fp8(unsigned char* p, int lane, const f32x4 (&v)[4]) {
#pragma unroll
    for (int j = 0; j < 4; ++j) *(unsigned*)(p + 4 * lane + 256 * j) = pk4_fp8(v[j].x, v[j].y, v[j].z, v[j].w);
}
#define GAS __attribute__((address_space(1)))
#define LAS __attribute__((address_space(3)))
constexpr int NWAVES = 8, NTHR = NWAVES * 64;
constexpr int RING_BYTES = 131072, LDSCTL_OFF = RING_BYTES, MISC_OFF = LDSCTL_OFF + 320, LDS_BYTES = 147456;
constexpr int LDSX_OFF = RING_BYTES + 1024;
#define LDS_WAIT() asm volatile("s_waitcnt lgkmcnt(0)" ::: "memory")
#define VM_WAIT() asm volatile("s_waitcnt vmcnt(0)" ::: "memory")

struct Frame {
    unsigned char* lds;
    unsigned* ctl;
    int tid, lane, wave, G, bid;
};

template <int MODE>
__device__ __forceinline__ void p0_transpose_item(const float* W, int K, int N, bf16* WT, int row_off, float* scr, int item, int lane) {
    const int nblk = N / 32, kb = item / nblk, nb = item % nblk, k0 = 64 * kb, n0 = 32 * nb;
#pragma unroll 8
    for (int i = 0; i < 32; ++i) { const int kk = 2 * i + (lane >> 5); scr[kk * 33 + (lane & 31)] = W[(size_t)(k0 + kk) * N + n0 + (lane & 31)]; }
    LDS_WAIT(); asm volatile("" ::: "memory");
    const int c = lane & 7;
#pragma unroll
    for (int j = 0; j < 4; ++j) { const int n = (lane >> 3) + 8 * j; const float* s = scr + (8 * c) * 33 + n;
        u32x4 o; o.x = pk2(s[0 * 33], s[1 * 33]); o.y = pk2(s[2 * 33], s[3 * 33]); o.z = pk2(s[4 * 33], s[5 * 33]); o.w = pk2(s[6 * 33], s[7 * 33]);
        const int nl = n0 + n; const int pr = (MODE == 0) ? (row_off + nl) : (MODE == 3) ? (row_off + perm16b(nl)) : (row_off + gu_phys(nl, MODE - 1));
        *(u32x4*)(WT + (size_t)pr * K + k0 + 8 * c) = o; }
    LDS_WAIT(); asm volatile("" ::: "memory");
}
template <int MODE>
__device__ __forceinline__ void p0_transpose_item8(const float* W, int K, int N, unsigned char* WT, float* scr, int item, int lane) {
    const int nblk = N / 32, kb = item / nblk, nb = item % nblk, k0 = 64 * kb, n0 = 32 * nb;
#pragma unroll 8
    for (int i = 0; i < 32; ++i) { const int kk = 2 * i + (lane >> 5); scr[kk * 33 + (lane & 31)] = W[(size_t)(k0 + kk) * N + n0 + (lane & 31)]; }
    LDS_WAIT(); asm volatile("" ::: "memory");
    const int c = lane & 7;
#pragma unroll
    for (int j = 0; j < 4; ++j) { const int n = (lane >> 3) + 8 * j; const float* s = scr + (8 * c) * 33 + n;
        u32x2 o; o.x = pk4_fp8(s[0 * 33] * W8_SCALE, s[1 * 33] * W8_SCALE, s[2 * 33] * W8_SCALE, s[3 * 33] * W8_SCALE); o.y = pk4_fp8(s[4 * 33] * W8_SCALE, s[5 * 33] * W8_SCALE, s[6 * 33] * W8_SCALE, s[7 * 33] * W8_SCALE);
        const int nl = n0 + n; const int pr = (MODE == 3) ? perm16b(nl) : gu_phys(nl, MODE - 1);
        *(u32x2*)(WT + (size_t)pr * K + k0 + 8 * c) = o; }
    LDS_WAIT(); asm volatile("" ::: "memory");
}
__device__ __forceinline__ void phase_prologue(const Frame& F, const Prm& p) {
    float* sil = (float*)F.lds;
    for (int i = F.tid; i < 9 * 1024; i += NTHR) { const int r = i >> 10, k = i & 1023; const float v = (r < 8) ? p.c[r * 1024 + k] : p.cctx[k]; sil[i] = silu_f(v); }
    __syncthreads();
    float* MOD = (float*)(p.ws + WS_MOD);
    if (F.bid < 192) {
        const int layer = F.bid / 96, n = (F.bid % 96) * 64 + F.lane; const float* W = p.ada_w + (size_t)layer * 1024 * 6144 + n;
        float acc[9];
#pragma unroll
        for (int r = 0; r < 9; ++r) acc[r] = 0.f;
        const int kb = F.wave * 128;
#pragma unroll 4
        for (int k = kb; k < kb + 128; k += 4) {
            const float w0 = W[(size_t)k * 6144], w1 = W[(size_t)(k + 1) * 6144], w2 = W[(size_t)(k + 2) * 6144], w3 = W[(size_t)(k + 3) * 6144];
#pragma unroll
            for (int r = 0; r < 9; ++r) { const f32x4 s = *(const f32x4*)(sil + r * 1024 + k); acc[r] += s.x * w0 + s.y * w1 + s.z * w2 + s.w * w3; }
        }
        float* red = (float*)(F.lds + 36864 + 8 * 8704);
#pragma unroll
        for (int r = 0; r < 9; ++r) red[(F.wave * 9 + r) * 64 + F.lane] = acc[r];
        __syncthreads();
        if (F.wave == 0) { const float bb = p.ada_b[layer * 6144 + n];
#pragma unroll
            for (int r = 0; r < 9; ++r) { float t = bb;
#pragma unroll
                for (int w = 0; w < 8; ++w) t += red[(w * 9 + r) * 64 + F.lane];
                MOD[(layer * 9 + r) * 6144 + n] = t; } }
    }
    float* misc = (float*)(p.ws + WS_MISC);
    if (F.bid == 255 % F.G && F.wave == 1) {
        const float a = wave_sum(p.lam[F.lane] * p.lam[64 + F.lane]), b = wave_sum(p.lam[128 + F.lane] * p.lam[192 + F.lane]);
        if (F.lane == 0) misc[0] = __expf(a) - __expf(b) + LAMBDA_INIT0;
        for (int i = F.lane; i < 1024; i += 64) { const int pos = i >> 4, f = i & 15; const float inv = powf(10000.f, -(float)f / 16.f); const float ang = (float)pos * inv;
            misc[1024 + 2 * i] = cosf(ang); misc[1024 + 2 * i + 1] = sinf(ang); }
    }
    float* scr = (float*)(F.lds + 36864 + F.wave * 8704);
    const int gw = F.bid * NWAVES + F.wave, NGW = F.G * NWAVES;
    constexpr int I_QKV = 16 * 96, I_SQ = 16 * 32, I_G = 16 * 16, I_D = 8 * 32;
    constexpr int I_MOE = 2 * I_G + I_D;
    constexpr int NITEMS = 2 * I_QKV + 2 * I_SQ + 32 * I_MOE;
    bf16* ws16 = (bf16*)p.ws;
    for (int it = gw; it < NITEMS; it += NGW) {
        int r = it;
        if (r < I_QKV) { if ((r % 96) < 64) p0_transpose_item<0>(p.w_qkv, 1024, 3072, (bf16*)(p.ws + WS_WQKV), 0, scr, r, F.lane); else p0_transpose_item<3>(p.w_qkv, 1024, 3072, (bf16*)(p.ws + WS_WQKV), 0, scr, r, F.lane); continue; } r -= I_QKV;
        if (r < I_QKV) { p0_transpose_item<3>(p.gw_in, 1024, 3072, (bf16*)(p.ws + WS_WIN), 0, scr, r, F.lane); continue; } r -= I_QKV;
        if (r < I_SQ) { p0_transpose_item<3>(p.w_o, 1024, 1024, (bf16*)(p.ws + WS_WO), 0, scr, r, F.lane); continue; } r -= I_SQ;
        if (r < I_SQ) { p0_transpose_item<3>(p.gw_o, 1024, 1024, (bf16*)(p.ws + WS_WGO), 0, scr, r, F.lane); continue; } r -= I_SQ;
        const int le = r / I_MOE, layer = le >> 4, e = le & 15; r -= le * I_MOE;
        unsigned char* GU = p.ws + (layer ? WS_GU1 : WS_GU0) + (size_t)e * 1024 * 1024; unsigned char* DN = p.ws + (layer ? WS_DN1 : WS_DN0) + (size_t)e * 1024 * 512;
        if (r < I_G) { p0_transpose_item8<1>(p.mg + (size_t)le * 1024 * 512, 1024, 512, GU, scr, r, F.lane); continue; } r -= I_G;
        if (r < I_G) { p0_transpose_item8<2>(p.mu + (size_t)le * 1024 * 512, 1024, 512, GU, scr, r, F.lane); continue; } r -= I_G;
        p0_transpose_item8<3>(p.md + (size_t)le * 512 * 1024, 512, 1024, DN, scr, r, F.lane);
    }
    (void)ws16;
    bf16* WIN = (bf16*)(p.ws + WS_WIN);
    for (int i = gw * 64 + F.lane; i < 32 * 1024; i += NGW * 64) { const int rr = i >> 10, k = i & 1023, dir = rr >> 4, j = rr & 15;
        WIN[(size_t)(3072 + rr) * 1024 + k] = (bf16)f2bf(p.gwg_down[(size_t)dir * 1024 * 16 + k * 16 + j]); }
    for (int i = gw * 64 + F.lane; i < 224 * 1024 / 8; i += NGW * 64) *(u32x4*)(WIN + (size_t)3104 * 1024 + (size_t)i * 8) = (u32x4){0u, 0u, 0u, 0u};
}

__device__ __forceinline__ void phase_modulate0(const Frame& F, const Prm& p) {
    const float* MOD = (const float*)(p.ws + WS_MOD); bf16* H = (bf16*)(p.ws + WS_H);
    const int gw = F.bid * NWAVES + F.wave, NGW = F.G * NWAVES, per = (NTOK + NGW - 1) / NGW;
    int curmod = -1; f32x4 sh[4], sc[4];
    for (int tok = gw * per; tok < (gw + 1) * per && tok < NTOK; ++tok) {
        const int mr = tok < NLAT ? tok / SEQ : 8; const float* src = tok < NLAT ? p.x + (size_t)tok * DM : p.ctx + (size_t)(tok - NLAT) * DM;
        if (mr != curmod) { curmod = mr; ld_row_f32(MOD + mr * 6144, F.lane, sh); ld_row_f32(MOD + mr * 6144 + 1024, F.lane, sc); }
        f32x4 v[4]; ld_row_f32(src, F.lane, v);
#pragma unroll
        for (int j = 0; j < 4; ++j) v[j] = v[j] * (1.f + sc[j]) + sh[j];
        st_row_bf16(H + (size_t)tok * DM, F.lane, v);
    }
}

__device__ __forceinline__ void phase_attn_combine(const Frame& F, const Prm& p) {
    const bf16* O1 = (const bf16*)(p.ws + WS_O1); const bf16* O2 = (const bf16*)(p.ws + WS_O2); bf16* A2 = (bf16*)(p.ws + WS_A2);
    const float lam = ((const float*)(p.ws + WS_MISC))[0];
    const f32x4 sg = *(const f32x4*)(p.subln + 4 * (F.lane & 31));
    const int gw = F.bid * NWAVES + F.wave, NGW = F.G * NWAVES;
    for (int tok = gw; tok < NTOK; tok += NGW) {
        f32x4 a[4], b[4]; ld_row_bf16(O1 + (size_t)tok * DM, F.lane, a); ld_row_bf16(O2 + (size_t)tok * DM, F.lane, b);
#pragma unroll
        for (int j = 0; j < 4; ++j) {
            f32x4 o = a[j] - lam * b[j]; float q = (o.x * o.x + o.y * o.y) + (o.z * o.z + o.w * o.w);
#pragma unroll
            for (int s = 1; s < 32; s <<= 1) q += __shfl_xor(q, s);
            const float r = (1.f - LAMBDA_INIT0) / sqrtf(q * (1.f / 128.f) + LN_EPS);
            a[j] = o * r * sg;
        }
        st_row_bf16(A2 + (size_t)tok * DM, F.lane, a);
    }
}

__device__ __forceinline__ void phase_ln_route(const Frame& F, const Prm& p, int layer) {
    const int nrows = layer ? NLAT : NTOK;
    const float* MOD = (const float*)(p.ws + WS_MOD) + layer * 9 * 6144;
    const bf16* Y = (const bf16*)(p.ws + WS_Y); unsigned char* HF = p.ws + WS_H;
    float* XCTX = (float*)(p.ws + WS_XCTX);
    int* LIST = (int*)(p.ws + WS_LIST); int* TOKR = (int*)(p.ws + WS_TOKR);
    unsigned* CNT = F.ctl + CW_CNT + layer * 16;
    float* WrT = (float*)F.lds;
    int* rec = (int*)(F.lds + 65536);
    unsigned* lcnt = (unsigned*)(F.lds + 65536 + 8192); unsigned* lbase = lcnt + 16;
    for (int i = F.tid; i < 16 * 1024; i += NTHR) { const int k = i >> 4, e = i & 15; WrT[e * 1024 + k] = p.rw[i]; }
    if (F.tid < 16) lcnt[F.tid] = 0u;
    __syncthreads();
    const int per_wg = (nrows + F.G - 1) / F.G, per_w = (per_wg + NWAVES - 1) / NWAVES;
    const int row_lo = F.bid * per_wg, row_hi = min(nrows, row_lo + per_wg);
    const float* lng = p.ln_g + (layer * 2 + 0) * DM; const float* lnb = p.ln_b + (layer * 2 + 0) * DM;
    float rb[16];
#pragma unroll
    for (int e = 0; e < 16; ++e) rb[e] = p.rb[e];
    int curmod = -1; f32x4 gm[4], shf[4], scf[4];
    for (int i = 0; i < per_w; ++i) {
        const int lr = F.wave * per_w + i, tok = row_lo + lr; if (tok >= row_hi) break;
        const int mr = tok < NLAT ? tok / SEQ : 8;
        if (mr != curmod) { curmod = mr; ld_row_f32(MOD + mr * 6144 + 2048, F.lane, gm); ld_row_f32(MOD + mr * 6144 + 3072, F.lane, shf); ld_row_f32(MOD + mr * 6144 + 4096, F.lane, scf); }
        float* xdst = tok < NLAT ? p.out + (size_t)tok * DM : XCTX + (size_t)(tok - NLAT) * DM;
        const float* xsrc = layer ? (const float*)xdst : (tok < NLAT ? p.x + (size_t)tok * DM : p.ctx + (size_t)(tok - NLAT) * DM);
        f32x4 v[4], y[4]; ld_row_f32(xsrc, F.lane, v); ld_row_bf16(Y + (size_t)tok * DM, F.lane, y);
#pragma unroll
        for (int j = 0; j < 4; ++j) v[j] = ALPHA * v[j] + gm[j] * y[j];
        ln_row(v, lng, lnb, F.lane);
        st_row_f32(xdst, F.lane, v);
#pragma unroll
        for (int j = 0; j < 4; ++j) v[j] = v[j] * (1.f + scf[j]) + shf[j];
        st_row_fp8(HF + (size_t)tok * DM, F.lane, v);
        float part[16];
#pragma unroll
        for (int e = 0; e < 16; ++e) { float s = 0.f;
#pragma unroll
            for (int j = 0; j < 4; ++j) { const f32x4 w = *(const f32x4*)(WrT + e * 1024 + 4 * F.lane + 256 * j); s += (v[j].x * w.x + v[j].y * w.y) + (v[j].z * w.z + v[j].w * w.w); }
            part[e] = s; }
        {
#pragma unroll
            for (int e = 0; e < 8; ++e) { const bool up = (F.lane & 32) != 0; const float keep = up ? part[e + 8] : part[e], send = up ? part[e] : part[e + 8]; part[e] = keep + __shfl_xor(send, 32); }
#pragma unroll
            for (int e = 0; e < 4; ++e) { const bool up = (F.lane & 16) != 0; const float keep = up ? part[e + 4] : part[e], send = up ? part[e] : part[e + 4]; part[e] = keep + __shfl_xor(send, 16); }
#pragma unroll
            for (int e = 0; e < 2; ++e) { const bool up = (F.lane & 8) != 0; const float keep = up ? part[e + 2] : part[e], send = up ? part[e] : part[e + 2]; part[e] = keep + __shfl_xor(send, 8); }
            { const bool up = (F.lane & 4) != 0; const float keep = up ? part[1] : part[0], send = up ? part[0] : part[1]; part[0] = keep + __shfl_xor(send, 4); }
            part[0] += __shfl_xor(part[0], 2); part[0] += __shfl_xor(part[0], 1);
        }
        float aff[16], sel[16];
#pragma unroll
        for (int e = 0; e < 16; ++e) { const int src = ((e >> 3) & 1) * 32 + ((e >> 2) & 1) * 16 + ((e >> 1) & 1) * 8 + (e & 1) * 4; const float lg = __shfl(part[0], src); aff[e] = 1.f / (1.f + __expf(-lg)); sel[e] = aff[e] + rb[e]; }
        int bg = 0; float bgs = -3.0e38f;
#pragma unroll
        for (int g = 0; g < 4; ++g) { float m1 = -3.0e38f, m2 = -3.0e38f;
#pragma unroll
            for (int k = 0; k < 4; ++k) { const float s = sel[4 * g + k]; if (s > m1) { m2 = m1; m1 = s; } else if (s > m2) m2 = s; }
            const float gs = m1 + m2; if (gs > bgs) { bgs = gs; bg = g; } }
        int i1 = 0, i2 = 0; float s1 = -3.0e38f, s2 = -3.0e38f, a1 = 0.f, a2 = 0.f;
#pragma unroll
        for (int g = 0; g < 4; ++g) if (g == bg) {
#pragma unroll
            for (int k = 0; k < 4; ++k) { const float s = sel[4 * g + k], a = aff[4 * g + k];
                if (s > s1) { s2 = s1; i2 = i1; a2 = a1; s1 = s; i1 = 4 * g + k; a1 = a; } else if (s > s2) { s2 = s; i2 = 4 * g + k; a2 = a; } } }
        const float wsum = a1 + a2, w1 = a1 / wsum, w2 = a2 / wsum;
        if (F.lane == 0) { const unsigned l1 = atomicAdd(&lcnt[i1], 1u), l2 = atomicAdd(&lcnt[i2], 1u);
            rec[lr * 6 + 0] = i1; rec[lr * 6 + 1] = i2; rec[lr * 6 + 2] = (int)l1; rec[lr * 6 + 3] = (int)l2; rec[lr * 6 + 4] = __float_as_int(w1); rec[lr * 6 + 5] = __float_as_int(w2); }
    }
    __syncthreads();
    if (F.tid < 16) lbase[F.tid] = __hip_atomic_fetch_add(&CNT[F.tid], lcnt[F.tid], __ATOMIC_RELAXED, __HIP_MEMORY_SCOPE_AGENT);
    __syncthreads();
    for (int lr = F.tid; lr < row_hi - row_lo; lr += NTHR) { const int tok = row_lo + lr;
        const int e0 = rec[lr * 6], e1 = rec[lr * 6 + 1]; const int p0 = (int)lbase[e0] + rec[lr * 6 + 2], p1 = (int)lbase[e1] + rec[lr * 6 + 3];
        LIST[e0 * NTOK + p0] = tok; LIST[e1 * NTOK + p1] = tok;
        int* tr = TOKR + (size_t)tok * 8; tr[0] = e0; tr[1] = p0; tr[2] = e1; tr[3] = p1; tr[4] = rec[lr * 6 + 4]; tr[5] = rec[lr * 6 + 5]; }
    __syncthreads();
}

__device__ __forceinline__ void pad_bases(const unsigned* cnt, int (&pb)[17]) {
    int acc = 0;
#pragma unroll
    for (int e = 0; e < 16; ++e) { pb[e] = acc; const int c = (int)__hip_atomic_load(cnt + e, __ATOMIC_RELAXED, __HIP_MEMORY_SCOPE_AGENT); acc += (c + 255) & ~255; }
    pb[16] = acc;
}

__device__ __forceinline__ void phase_moe_combine(const Frame& F, const Prm& p, int layer) {
    const int nrows = layer ? NLAT : NTOK;
    const float* MOD = (const float*)(p.ws + WS_MOD) + layer * 9 * 6144; const float* MOD1 = (const float*)(p.ws + WS_MOD) + 9 * 6144;
    const bf16* YM = (const bf16*)(p.ws + WS_YM); bf16* H = (bf16*)(p.ws + WS_H); float* XCTX = (float*)(p.ws + WS_XCTX); const int* TOKR = (const int*)(p.ws + WS_TOKR);
    int pb[17]; pad_bases(F.ctl + CW_CNT + layer * 16, pb);
    int* pbl = (int*)F.lds; if (F.tid < 17) { int v = 0;
#pragma unroll
        for (int e = 0; e < 17; ++e) if (e == F.tid) v = pb[e];
        pbl[F.tid] = v; }
    __syncthreads();
    const float* lng = p.ln_g + (layer * 2 + 1) * DM; const float* lnb = p.ln_b + (layer * 2 + 1) * DM;
    const int gw = F.bid * NWAVES + F.wave, NGW = F.G * NWAVES, per = (nrows + NGW - 1) / NGW;
    int curmod = -1; f32x4 gf[4], sh1[4], sc1[4];
    for (int tok = gw * per; tok < (gw + 1) * per && tok < nrows; ++tok) {
        const int mr = tok < NLAT ? tok / SEQ : 8;
        if (mr != curmod) { curmod = mr; ld_row_f32(MOD + mr * 6144 + 5120, F.lane, gf); if (!layer) { ld_row_f32(MOD1 + mr * 6144, F.lane, sh1); ld_row_f32(MOD1 + mr * 6144 + 1024, F.lane, sc1); } }
        const int* tr = TOKR + (size_t)tok * 8; const int s0 = pbl[tr[0]] + tr[1], s1 = pbl[tr[2]] + tr[3]; const float w0 = __int_as_float(tr[4]), w1 = __int_as_float(tr[5]);
        float* xp = tok < NLAT ? p.out + (size_t)tok * DM : XCTX + (size_t)(tok - NLAT) * DM;
        f32x4 v[4], a[4], b[4]; ld_row_f32(xp, F.lane, v); ld_row_bf16(YM + (size_t)s0 * DM, F.lane, a); ld_row_bf16(YM + (size_t)s1 * DM, F.lane, b);
#pragma unroll
        for (int j = 0; j < 4; ++j) v[j] = ALPHA * v[j] + gf[j] * (w0 * a[j] + w1 * b[j]);
        ln_row(v, lng, lnb, F.lane);
        st_row_f32(xp, F.lane, v);
        if (!layer) {
#pragma unroll
            for (int j = 0; j < 4; ++j) v[j] = v[j] * (1.f + sc1[j]) + sh1[j];
            st_row_bf16(H + (size_t)tok * DM, F.lane, v);
        }
    }
}

__device__ __forceinline__ void phase_gla_prep(const Frame& F, const Prm& p) {
    const bf16* QR = (const bf16*)(p.ws + WS_QR); const bf16* KR = (const bf16*)(p.ws + WS_KR); const float* ZZ = (const float*)(p.ws + WS_ZZ);
    bf16* QT = (bf16*)(p.ws + WS_QT); bf16* KT = (bf16*)(p.ws + WS_KT); float* DEC = (float*)(p.ws + WS_DEC);
    const int gw = F.bid * NWAVES + F.wave, NGW = F.G * NWAVES;
    for (int task = gw; task < 2 * NCHUNK * 8; task += NGW) {
        const int dh = task & 7, chunk = (task >> 3) % NCHUNK, dir = __builtin_amdgcn_readfirstlane(task / (8 * NCHUNK));
        const int col = dh * 64 + F.lane, tok0 = chunk * 64;
        unsigned short qv[64], kv[64];
#pragma unroll
        for (int t = 0; t < 64; ++t) { qv[t] = QR[(size_t)(tok0 + t) * 512 + col]; kv[t] = KR[(size_t)(tok0 + t) * 512 + col]; }
        f32x4 zl[4];
#pragma unroll
        for (int j = 0; j < 4; ++j) zl[j] = *(const f32x4*)(ZZ + (size_t)(tok0 + F.lane) * 32 + dir * 16 + 4 * j);
        float wup[16];
#pragma unroll
        for (int j = 0; j < 16; ++j) wup[j] = p.gwg_up[(size_t)dir * 16 * 512 + j * 512 + col];
        const float bgv = p.gbg[dir * 512 + col];
        float b = 0.f;
        bf16* qo = QT + ((size_t)dir * NTOK + tok0) * 512 + col; bf16* ko = KT + ((size_t)dir * NTOK + tok0) * 512 + col;
#pragma unroll
        for (int tt = 0; tt < 64; ++tt) {
            float z = bgv;
#pragma unroll
            for (int j = 0; j < 4; ++j) { const int tl = dir ? 63 - tt : tt;
                const float z0 = __int_as_float(__builtin_amdgcn_readlane(__float_as_int(zl[j].x), tl)), z1 = __int_as_float(__builtin_amdgcn_readlane(__float_as_int(zl[j].y), tl));
                const float z2 = __int_as_float(__builtin_amdgcn_readlane(__float_as_int(zl[j].z), tl)), z3 = __int_as_float(__builtin_amdgcn_readlane(__float_as_int(zl[j].w), tl));
                z += z0 * wup[4 * j] + z1 * wup[4 * j + 1] + z2 * wup[4 * j + 2] + z3 * wup[4 * j + 3]; }
            const float g = (fminf(z, 0.f) - __logf(1.f + __expf(-fabsf(z)))) * (1.f / 16.f);
            b += g;
            const float e = __expf(b), ei = __builtin_amdgcn_rcpf(e);
            const float q = dir ? bf2f(qv[63 - tt]) : bf2f(qv[tt]), k = dir ? bf2f(kv[63 - tt]) : bf2f(kv[tt]);
            const int t = dir ? 63 - tt : tt;
            qo[(size_t)t * 512] = (bf16)f2bf(q * e); ko[(size_t)t * 512] = (bf16)f2bf(k * ei);
        }
        DEC[((size_t)dir * NCHUNK + chunk) * 512 + col] = __expf(b);
    }
}

__device__ __forceinline__ void phase_gla_post(const Frame& F, const Prm& p) {
    const bf16* OF = (const bf16*)(p.ws + WS_OGF); const bf16* OB = (const bf16*)(p.ws + WS_OGB); const bf16* R = (const bf16*)(p.ws + WS_R); bf16* A2 = (bf16*)(p.ws + WS_A2B);
    const f32x4 ng = *(const f32x4*)(p.gnorm + 4 * F.lane);
    const int gw = F.bid * NWAVES + F.wave, NGW = F.G * NWAVES;
    for (int tok = gw; tok < NLAT; tok += NGW) {
        f32x4 a[4], b[4], r[4]; ld_row_bf16(OF + (size_t)tok * DM, F.lane, a); ld_row_bf16(OB + (size_t)tok * DM, F.lane, b); ld_row_bf16(R + (size_t)tok * DM, F.lane, r);
#pragma unroll
        for (int j = 0; j < 4; ++j) {
            const f32x4 o = a[j] + b[j]; const float q = wave_sum((o.x * o.x + o.y * o.y) + (o.z * o.z + o.w * o.w));
            const float rs = 1.f / sqrtf(q * (1.f / 256.f) + LN_EPS);
            a[j] = (f32x4){o.x * rs * ng.x * silu_f(r[j].x), o.y * rs * ng.y * silu_f(r[j].y), o.z * rs * ng.z * silu_f(r[j].z), o.w * rs * ng.w * silu_f(r[j].w)};
        }
        st_row_bf16(A2 + (size_t)tok * DM, F.lane, a);
    }
}
namespace naive {
enum { EPI_QKV = 0, EPI_PLAIN = 1, EPI_GATEUP = 2, EPI_DOWN = 3, EPI_INPROJ = 4 };
struct NG { const bf16* A; const bf16* Bt; int M, N, K; int layer; bf16* O; };
template <int EPI> __global__ __launch_bounds__(256) void gemm_kernel(NG g, Prm p) {
    __shared__ float As[64][33], Bs[64][33], Cs[64][65]; __shared__ int rowsrc[64];
    const int tid = threadIdx.x, n0 = blockIdx.x * 64, m0 = blockIdx.y * 64, ty = tid >> 4, tx = tid & 15;
    const bf16* Bt = g.Bt; int e = 0, ebase = 0, ecnt = 0;
    if (EPI == EPI_GATEUP || EPI == EPI_DOWN) {
        const unsigned* cnt = (const unsigned*)(p.ws + WS_CTL) + CW_CNT + g.layer * 16; int acc = 0; bool found = false;
        for (int i = 0; i < 16; ++i) { const int c = (int)cnt[i], pc = (c + 255) & ~255; if (!found && m0 < acc + pc) { e = i; ebase = acc; ecnt = c; found = true; } acc += pc; }
        if (!found || m0 - ebase >= ecnt) return;
        Bt += (size_t)e * g.N * g.K;
    }
    if (tid < 64) { int r = m0 + tid;
        if (EPI == EPI_GATEUP) { const int li = m0 - ebase + tid; const int* LIST = (const int*)(p.ws + WS_LIST); r = (li < ecnt) ? LIST[e * NTOK + li] : 0; }
        rowsrc[tid] = r; }
    __syncthreads();
    float acc[4][4] = {};
    for (int k0 = 0; k0 < g.K; k0 += 32) {
        { const int r = tid >> 2, kc = (tid & 3) * 8; const u32x4 ua = *(const u32x4*)(g.A + (size_t)rowsrc[r] * g.K + k0 + kc), ub = *(const u32x4*)(Bt + (size_t)(n0 + r) * g.K + k0 + kc);
            const unsigned a4[4] = {ua.x, ua.y, ua.z, ua.w}, b4[4] = {ub.x, ub.y, ub.z, ub.w};
#pragma unroll
            for (int i = 0; i < 4; ++i) { As[r][kc + 2 * i] = bf2f(a4[i] & 0xffffu); As[r][kc + 2 * i + 1] = bf2f(a4[i] >> 16); Bs[r][kc + 2 * i] = bf2f(b4[i] & 0xffffu); Bs[r][kc + 2 * i + 1] = bf2f(b4[i] >> 16); } }
        __syncthreads();
#pragma unroll 8
        for (int kk = 0; kk < 32; ++kk) { float a[4], b[4];
#pragma unroll
            for (int i = 0; i < 4; ++i) { a[i] = As[4 * ty + i][kk]; b[i] = Bs[4 * tx + i][kk]; }
#pragma unroll
            for (int i = 0; i < 4; ++i)
#pragma unroll
                for (int j = 0; j < 4; ++j) acc[i][j] += a[i] * b[j]; }
        __syncthreads();
    }
#pragma unroll
    for (int i = 0; i < 4; ++i)
#pragma unroll
        for (int j = 0; j < 4; ++j) Cs[4 * ty + i][4 * tx + j] = acc[i][j];
    __syncthreads();
    const float* rope = (const float*)(p.ws + WS_MISC) + 1024;
    for (int idx = tid; idx < 4096; idx += 256) {
        const int r = idx >> 6, cc = idx & 63, row = m0 + r; int n = n0 + cc; const float val = Cs[r][cc];
        if (EPI == EPI_PLAIN || EPI == EPI_DOWN || (EPI == EPI_INPROJ && n < 3072) || (EPI == EPI_QKV && n >= 2048)) n = perm16b_inv(n);
        if (EPI == EPI_QKV) {
            if (n < 2048) { float o = val;
                if (row < NLAT) { const int d = n & 63, s = row & (SEQ - 1), pos = (d & 32) ? (s & 63) : (s >> 6), f = d & 15; const float cs = rope[(pos * 16 + f) * 2], sn = rope[(pos * 16 + f) * 2 + 1];
                    o = (d & 16) ? val * cs + Cs[r][cc - 16] * sn : val * cs - Cs[r][cc + 16] * sn; }
                if (n < 1024) ((bf16*)(p.ws + WS_Q))[(size_t)row * DM + n] = (bf16)f2bf(o * C2); else ((bf16*)(p.ws + WS_K))[(size_t)row * DM + n - 1024] = (bf16)f2bf(o);
            } else ((bf16*)(p.ws + WS_V))[(size_t)row * DM + n - 2048] = (bf16)f2bf(val);
        } else if (EPI == EPI_PLAIN) { g.O[(size_t)row * g.N + n] = (bf16)f2bf(val);
        } else if (EPI == EPI_GATEUP) { if (!(cc & 16)) { const float gt = val, up = Cs[r][cc + 16]; const int other = (n >> 5) * 16 + (n & 15); ((bf16*)(p.ws + WS_ACT))[(size_t)row * DEXP + other] = (bf16)f2bf(silu_f(gt) * up); }
        } else if (EPI == EPI_DOWN) { ((bf16*)(p.ws + WS_YM))[(size_t)row * DM + n] = (bf16)f2bf(val);
        } else if (EPI == EPI_INPROJ) {
            if (n < 512) ((bf16*)(p.ws + WS_QR))[(size_t)row * 512 + n] = (bf16)f2bf(val * 0.08838834764831845f);
            else if (n < 1024) ((bf16*)(p.ws + WS_KR))[(size_t)row * 512 + n - 512] = (bf16)f2bf(val);
            else if (n < 2048) ((bf16*)(p.ws + WS_V1))[(size_t)row * DM + n - 1024] = (bf16)f2bf(val);
            else if (n < 3072) ((bf16*)(p.ws + WS_R))[(size_t)row * DM + n - 2048] = (bf16)f2bf(val);
            else if (n < 3104) ((float*)(p.ws + WS_ZZ))[(size_t)row * 32 + n - 3072] = val;
        }
    }
}
__global__ __launch_bounds__(256) void attn_kernel(Prm p) {
    __shared__ float Qs[64][65], Ks[32][65], Ps[64][33], Vs[32][129], al[64];
    const bf16* Q = (const bf16*)(p.ws + WS_Q); const bf16* K = (const bf16*)(p.ws + WS_K); const bf16* V = (const bf16*)(p.ws + WS_V);
    const int tid = threadIdx.x, ty = tid >> 4, tx = tid & 15, qb = blockIdx.x, hm = blockIdx.y, h = hm >> 1;
    const bool lat = qb < 512; const int b = lat ? qb >> 6 : (qb - 512) >> 2; const int tok0 = lat ? qb * 64 : NLAT + (qb - 512) * 64;
    bf16* O = (bf16*)(p.ws + ((hm & 1) ? WS_O2 : WS_O1));
    for (int i = tid; i < 4096; i += 256) { const int r = i >> 6, d = i & 63; Qs[r][d] = bf2f(Q[(size_t)(tok0 + r) * DM + hm * 64 + d]); }
    float o[4][8] = {}; float mrow = -3.0e38f, lrow = 0.f;
    const int nkt = lat ? (CTXL + SEQ) / 32 : CTXL / 32;
    for (int kt = 0; kt < nkt; ++kt) {
        const int key0 = (kt < CTXL / 32) ? NLAT + b * CTXL + kt * 32 : b * SEQ + (kt - CTXL / 32) * 32;
        __syncthreads();
        for (int i = tid; i < 2048; i += 256) { const int r = i >> 6, d = i & 63; Ks[r][d] = bf2f(K[(size_t)(key0 + r) * DM + hm * 64 + d]); }
        for (int i = tid; i < 4096; i += 256) { const int r = i >> 7, d = i & 127; Vs[r][d] = bf2f(V[(size_t)(key0 + r) * DM + h * 128 + d]); }
        __syncthreads();
        float s[4][2] = {};
        for (int d = 0; d < 64; ++d) { float a[4], bb[2];
#pragma unroll
            for (int i = 0; i < 4; ++i) a[i] = Qs[4 * ty + i][d];
            bb[0] = Ks[2 * tx][d]; bb[1] = Ks[2 * tx + 1][d];
#pragma unroll
            for (int i = 0; i < 4; ++i) { s[i][0] += a[i] * bb[0]; s[i][1] += a[i] * bb[1]; } }
#pragma unroll
        for (int i = 0; i < 4; ++i) { Ps[4 * ty + i][2 * tx] = s[i][0]; Ps[4 * ty + i][2 * tx + 1] = s[i][1]; }
        __syncthreads();
        if (tid < 64) { float mx = mrow;
            for (int j = 0; j < 32; ++j) mx = fmaxf(mx, Ps[tid][j]);
            const float a = exp2f(mrow - mx); float sum = 0.f;
            for (int j = 0; j < 32; ++j) { const float e = exp2f(Ps[tid][j] - mx); Ps[tid][j] = e; sum += e; }
            lrow = lrow * a + sum; mrow = mx; al[tid] = a; }
        __syncthreads();
#pragma unroll
        for (int i = 0; i < 4; ++i) { const float a = al[4 * ty + i];
#pragma unroll
            for (int j = 0; j < 8; ++j) o[i][j] *= a; }
        for (int kk = 0; kk < 32; ++kk) { float pv[4], vv[8];
#pragma unroll
            for (int i = 0; i < 4; ++i) pv[i] = Ps[4 * ty + i][kk];
#pragma unroll
            for (int j = 0; j < 8; ++j) vv[j] = Vs[kk][8 * tx + j];
#pragma unroll
            for (int i = 0; i < 4; ++i)
#pragma unroll
                for (int j = 0; j < 8; ++j) o[i][j] += pv[i] * vv[j]; }
    }
    __syncthreads();
    if (tid < 64) al[tid] = 1.f / lrow;
    __syncthreads();
#pragma unroll
    for (int i = 0; i < 4; ++i) { const float a = al[4 * ty + i];
#pragma unroll
        for (int j = 0; j < 8; ++j) O[(size_t)(tok0 + 4 * ty + i) * DM + h * 128 + 8 * tx + j] = (bf16)f2bf(o[i][j] * a); }
}
__global__ __launch_bounds__(256) void gla_scan_kernel(Prm p) {
    extern __shared__ __attribute__((aligned(16))) unsigned char sm[];
    float (*S)[33] = (float (*)[33])sm;
    float (*Qs)[129] = (float (*)[129])(sm + 128 * 33 * 4);
    float (*Ks)[129] = (float (*)[129])(sm + 128 * 33 * 4 + 64 * 129 * 4);
    float (*Vs)[33] = (float (*)[33])(sm + 128 * 33 * 4 + 2 * 64 * 129 * 4);
    float (*Ps)[65] = (float (*)[65])(sm + 128 * 33 * 4 + 2 * 64 * 129 * 4 + 64 * 33 * 4);
    float* dec = (float*)(sm + 128 * 33 * 4 + 2 * 64 * 129 * 4 + 64 * 33 * 4 + 64 * 65 * 4);
    const bf16* QT = (const bf16*)(p.ws + WS_QT); const bf16* KT = (const bf16*)(p.ws + WS_KT); const bf16* V = (const bf16*)(p.ws + WS_V1); const float* DEC = (const float*)(p.ws + WS_DEC);
    const int tid = threadIdx.x, ty = tid >> 4, tx = tid & 15, vs = blockIdx.x & 7, dir = (blockIdx.x >> 3) & 1, h = (blockIdx.x >> 4) & 3, b = blockIdx.x >> 6;
    bf16* OG = (bf16*)(p.ws + (dir ? WS_OGB : WS_OGF));
    for (int i = tid; i < 128 * 32; i += 256) S[i >> 5][i & 31] = 0.f;
    for (int step = 0; step < 68; ++step) {
        const bool lat = step >= 4; const int ci = lat ? step - 4 : step;
        const int chunk = lat ? b * 64 + (dir ? 63 - ci : ci) : 512 + b * 4 + (dir ? 3 - ci : ci); const int tok0 = chunk * 64;
        __syncthreads();
        for (int i = tid; i < 64 * 128; i += 256) { const int t = i >> 7, d = i & 127; const size_t off = ((size_t)dir * NTOK + tok0 + t) * 512 + h * 128 + d; Qs[t][d] = bf2f(QT[off]); Ks[t][d] = bf2f(KT[off]); }
        for (int i = tid; i < 64 * 32; i += 256) { const int t = i >> 5, v = i & 31; Vs[t][v] = bf2f(V[(size_t)(tok0 + t) * DM + h * 256 + vs * 32 + v]); }
        if (tid < 128) dec[tid] = DEC[((size_t)dir * NCHUNK + chunk) * 512 + h * 128 + tid];
        __syncthreads();
        if (lat) {
            float s[4][4] = {};
            for (int d = 0; d < 128; ++d) { float a[4], bb[4];
#pragma unroll
                for (int i = 0; i < 4; ++i) { a[i] = Qs[4 * ty + i][d]; bb[i] = Ks[4 * tx + i][d]; }
#pragma unroll
                for (int i = 0; i < 4; ++i)
#pragma unroll
                    for (int j = 0; j < 4; ++j) s[i][j] += a[i] * bb[j]; }
#pragma unroll
            for (int i = 0; i < 4; ++i)
#pragma unroll
                for (int j = 0; j < 4; ++j) { const int t = 4 * ty + i, sidx = 4 * tx + j; const bool keep = dir ? (sidx >= t) : (sidx <= t); Ps[t][sidx] = keep ? s[i][j] : 0.f; }
            __syncthreads();
            float o[4][2] = {};
            for (int sidx = 0; sidx < 64; ++sidx) { const float v0 = Vs[sidx][2 * tx], v1 = Vs[sidx][2 * tx + 1];
#pragma unroll
                for (int i = 0; i < 4; ++i) { const float pp = Ps[4 * ty + i][sidx]; o[i][0] += pp * v0; o[i][1] += pp * v1; } }
            for (int d = 0; d < 128; ++d) { const float s0 = S[d][2 * tx], s1 = S[d][2 * tx + 1];
#pragma unroll
                for (int i = 0; i < 4; ++i) { const float qq = Qs[4 * ty + i][d]; o[i][0] += qq * s0; o[i][1] += qq * s1; } }
#pragma unroll
            for (int i = 0; i < 4; ++i) { const size_t off = (size_t)(tok0 + 4 * ty + i) * DM + h * 256 + vs * 32 + 2 * tx; OG[off] = (bf16)f2bf(o[i][0]); OG[off + 1] = (bf16)f2bf(o[i][1]); }
            __syncthreads();
        }
        float u[8][2] = {};
        for (int sidx = 0; sidx < 64; ++sidx) { const float v0 = Vs[sidx][2 * tx], v1 = Vs[sidx][2 * tx + 1];
#pragma unroll
            for (int i = 0; i < 8; ++i) { const float kk = Ks[sidx][8 * ty + i]; u[i][0] += kk * v0; u[i][1] += kk * v1; } }
#pragma unroll
        for (int i = 0; i < 8; ++i) { const int d = 8 * ty + i; S[d][2 * tx] = dec[d] * (S[d][2 * tx] + u[i][0]); S[d][2 * tx + 1] = dec[d] * (S[d][2 * tx + 1] + u[i][1]); }
    }
}
constexpr int GLA_SCAN_LDS = 128 * 33 * 4 + 2 * 64 * 129 * 4 + 64 * 33 * 4 + 64 * 65 * 4 + 512;
}
namespace pg8 {
typedef short bf16x8 __attribute__((ext_vector_type(8)));
constexpr int BM = 256, BK = 64, HALF = 128, HTB = HALF * BK * 2, STAGE_BYTES = 8 * HTB, NXCD = 8, WGM = 8;
__host__ __device__ __forceinline__ int lds_byte(int r, int c) { const int st = (r >> 4) * 2 + (c >> 5), rr = r & 15, cc = c & 31, ob = rr * 64 + cc * 2; return st * 1024 + (ob ^ (((ob >> 9) & 1) << 5)); }
__host__ __device__ __forceinline__ void stage_rc(int b, int& R, int& C) { const int st = b / 1024, sb = b % 1024, swz = sb ^ (((sb >> 9) & 1) << 5); R = (st >> 1) * 16 + swz / 64; C = (st & 1) * 32 + (swz % 64) / 2; }
typedef float f32x2_t __attribute__((ext_vector_type(2))); typedef __bf16 bf16x2_t __attribute__((ext_vector_type(2)));
__device__ __forceinline__ unsigned cvt_pk_bf16(float lo, float hi) { f32x2_t v = {lo, hi}; bf16x2_t b = __builtin_convertvector(v, bf16x2_t); return __builtin_bit_cast(unsigned, b); }

struct Unit { int pm, pn; int row0; int e; int cnt; const bf16* Bt; };

struct DenseOrder {
    int nM, nN, nwg, G, c, K; const bf16* Bt;
    __device__ void init(int M, int N, int K_, const bf16* Bt_, int G_, int c_) { nM = M / BM; nN = N / BM; nwg = nM * nN; G = G_; c = c_; K = K_; Bt = Bt_; }
    __device__ bool next(int i, Unit& u) const {
        const long L = (long)i * G + c; if (L >= nwg) return false;
        int wgid = (int)L; { const int q = nwg / NXCD, r = nwg % NXCD, xcd = wgid % NXCD, off = wgid / NXCD; wgid = (xcd < r ? xcd * (q + 1) : r * (q + 1) + (xcd - r) * q) + off; }
        const int nig = WGM * nN, gid = wgid / nig, fm = gid * WGM, gsz = (nM - fm) < WGM ? (nM - fm) : WGM;
        u.pm = fm + ((wgid % nig) % gsz); u.pn = (wgid % nig) / gsz; u.row0 = u.pm * BM; u.e = 0; u.cnt = 0; u.Bt = Bt; return true;
    }
    __device__ __forceinline__ unsigned arow(const Unit& u, int r) const { return (unsigned)(u.row0 + r) * (unsigned)(K * 2); }
};
template <bool GATHER> struct MoeOrder {
    int cnt[16]; int nN, G, c, K; const bf16* Bt0; size_t bstride; const int* LIST;
    __device__ void init(const unsigned* cntw, int N, int K_, const bf16* Bt0_, const int* LIST_, int G_, int c_) {
#pragma unroll
        for (int e = 0; e < 16; ++e) cnt[e] = (int)__hip_atomic_load(cntw + e, __ATOMIC_RELAXED, __HIP_MEMORY_SCOPE_AGENT);
        nN = N / BM; G = G_; c = c_; K = K_; Bt0 = Bt0_; bstride = (size_t)N * K_; LIST = LIST_; }
    __device__ bool next(int i, Unit& u) const {
        int L = i * G + c, base = 0; bool found = false; u.pm = 0; u.pn = 0; u.row0 = 0; u.e = 0; u.cnt = 0; u.Bt = Bt0;
#pragma unroll
        for (int e = 0; e < 16; ++e) { const int mt = (cnt[e] + 255) >> 8, nu = mt * nN;
            if (!found) { if (L < nu) { found = true; u.e = e; u.cnt = cnt[e]; u.pm = L / nN; u.pn = L % nN; u.row0 = base + u.pm * BM; u.Bt = Bt0 + (size_t)e * bstride; } else { L -= nu; base += mt * BM; } } }
        return found;
    }
    __device__ __forceinline__ unsigned arow(const Unit& u, int r) const {
        if (GATHER) { const int li = u.pm * BM + r; int tok = 0; if (li < u.cnt) tok = LIST[u.e * NTOK + li];
            return (unsigned)tok * (unsigned)(K * 2); }
        return (unsigned)(u.row0 + r) * (unsigned)(K * 2);
    }
};

typedef f32x4 Acc[2][2][4][2];
__device__ __forceinline__ void st4bf(bf16* p, f32x4 v) { u32x2 w; w.x = cvt_pk_bf16(v.x, v.y); w.y = cvt_pk_bf16(v.z, v.w); *(u32x2*)p = w; }
__device__ __forceinline__ void st8bf(bf16* p, f32x4 a, f32x4 b) { u32x4 w; w.x = cvt_pk_bf16(a.x, a.y); w.y = cvt_pk_bf16(a.z, a.w); w.z = cvt_pk_bf16(b.x, b.y); w.w = cvt_pk_bf16(b.z, b.w); *(u32x4*)p = w; }

struct EpiQKV {
    bf16 *Q; const LAS float* rope;
    __device__ __forceinline__ void operator()(const Acc& acc, const Unit& u, int wr, int wc, int fr, int fq) const {
        const int reg = u.pn >> 2; bf16* O = Q + (size_t)reg * ((WS_K - WS_Q) / 2);
        if (reg == 2) { const int cbase = (u.pn & 3) * BM + wc * 32 + 8 * fq;
#pragma unroll
            for (int ai = 0; ai < 2; ++ai)
#pragma unroll
                for (int m = 0; m < 4; ++m) { bf16* rowp = O + (size_t)(u.row0 + ai * HALF + wr * 64 + m * 16 + fr) * DM + cbase;
#pragma unroll
                    for (int bj = 0; bj < 2; ++bj) st8bf(rowp + bj * HALF, acc[ai][bj][m][0], acc[ai][bj][m][1]); }
            return; }
        const int cbase = (u.pn & 3) * BM + wc * 32 + 4 * fq;
        const bool dorope = (u.row0 < NLAT); const float sc = reg == 0 ? C2 : 1.f;
#pragma unroll
        for (int ai = 0; ai < 2; ++ai)
#pragma unroll
            for (int m = 0; m < 4; ++m) { const int row = u.row0 + ai * HALF + wr * 64 + m * 16 + fr; bf16* rowp = O + (size_t)row * DM + cbase;
                f32x4 cs = {1.f, 1.f, 1.f, 1.f}, sn = {0.f, 0.f, 0.f, 0.f};
                if (dorope) { const int s = row & (SEQ - 1), pos = (wc & 1) ? (s & 63) : (s >> 6); const f32x4 t0 = *(const LAS f32x4*)(rope + (pos * 16 + 4 * fq) * 2), t1 = *(const LAS f32x4*)(rope + (pos * 16 + 4 * fq) * 2 + 4);
                    cs = (f32x4){t0.x, t0.z, t1.x, t1.z}; sn = (f32x4){t0.y, t0.w, t1.y, t1.w}; }
#pragma unroll
                for (int bj = 0; bj < 2; ++bj) { const f32x4 a0 = acc[ai][bj][m][0], a1 = acc[ai][bj][m][1];
                    st4bf(rowp + bj * HALF, (a0 * cs - a1 * sn) * sc); st4bf(rowp + bj * HALF + 16, (a1 * cs + a0 * sn) * sc); } }
    }
};
struct EpiPlain {
    bf16* O; float sc;
    __device__ __forceinline__ void operator()(const Acc& acc, const Unit& u, int wr, int wc, int fr, int fq) const {
        const int cbase = u.pn * BM + wc * 32 + 8 * fq;
#pragma unroll
        for (int ai = 0; ai < 2; ++ai)
#pragma unroll
            for (int m = 0; m < 4; ++m) { bf16* rowp = O + (size_t)(u.row0 + ai * HALF + wr * 64 + m * 16 + fr) * DM + cbase;
#pragma unroll
                for (int bj = 0; bj < 2; ++bj) st8bf(rowp + bj * HALF, acc[ai][bj][m][0] * sc, acc[ai][bj][m][1] * sc); }
    }
};
struct EpiInproj {
    bf16 *QR, *KR, *V, *R; float* ZZ;
    __device__ __forceinline__ void operator()(const Acc& acc, const Unit& u, int wr, int wc, int fr, int fq) const {
        const int pn = u.pn;
        if (pn == 12) { if (wc == 0) {
#pragma unroll
            for (int ai = 0; ai < 2; ++ai)
#pragma unroll
                for (int m = 0; m < 4; ++m) { float* rowp = ZZ + (size_t)(u.row0 + ai * HALF + wr * 64 + m * 16 + fr) * 32 + 4 * fq;
                    *(f32x4*)rowp = acc[ai][0][m][0]; *(f32x4*)(rowp + 16) = acc[ai][0][m][1]; } }
            return; }
        bf16* O; int ld, c0; float sc = 1.f;
        if (pn < 2) { O = QR; ld = 512; c0 = pn * BM; sc = 0.08838834764831845f; } else if (pn < 4) { O = KR; ld = 512; c0 = (pn - 2) * BM; } else if (pn < 8) { O = V; ld = DM; c0 = (pn - 4) * BM; } else { O = R; ld = DM; c0 = (pn - 8) * BM; }
        const int cbase = c0 + wc * 32 + 8 * fq;
#pragma unroll
        for (int ai = 0; ai < 2; ++ai)
#pragma unroll
            for (int m = 0; m < 4; ++m) { bf16* rowp = O + (size_t)(u.row0 + ai * HALF + wr * 64 + m * 16 + fr) * ld + cbase;
#pragma unroll
                for (int bj = 0; bj < 2; ++bj) st8bf(rowp + bj * HALF, acc[ai][bj][m][0] * sc, acc[ai][bj][m][1] * sc); }
    }
};
struct EpiGateUp {
    unsigned char* ACT;
    __device__ __forceinline__ void operator()(const Acc& acc, const Unit& u, int wr, int wc, int fr, int fq) const {
        const int obase = (u.pn * BM + wc * 32) / 2 + 4 * fq;
#pragma unroll
        for (int ai = 0; ai < 2; ++ai)
#pragma unroll
            for (int m = 0; m < 4; ++m) { unsigned char* rowp = ACT + (size_t)(u.row0 + ai * HALF + wr * 64 + m * 16 + fr) * DEXP + obase;
#pragma unroll
                for (int bj = 0; bj < 2; ++bj) { const f32x4 g = acc[ai][bj][m][0] * W8_INV, up = acc[ai][bj][m][1] * W8_INV; f32x4 o;
#pragma unroll
                    for (int j = 0; j < 4; ++j) o[j] = g[j] * __builtin_amdgcn_rcpf(1.f + __expf(-g[j])) * up[j];
                    *(unsigned*)(rowp + bj * (HALF / 2)) = pk4_fp8(o[0], o[1], o[2], o[3]); } }
    }
};

typedef int i32x8 __attribute__((ext_vector_type(8)));
typedef int i32x4 __attribute__((ext_vector_type(4)));
__device__ __forceinline__ i32x8 cat8(bf16x8 lo, bf16x8 hi) { return __builtin_shufflevector(__builtin_bit_cast(i32x4, lo), __builtin_bit_cast(i32x4, hi), 0, 1, 2, 3, 4, 5, 6, 7); }
template <class Epi, class Sched, bool FP8 = false>
__device__ __forceinline__ void gemm_phase(unsigned char* ldsg, const bf16* A, int K, const Sched& S, const Epi& E) {
    LAS unsigned char* lds = (LAS unsigned char*)ldsg;
    const int tid = threadIdx.x, wid = __builtin_amdgcn_readfirstlane(tid >> 6), lane = tid & 63, wr = wid >> 2, wc = wid & 3, fr = lane & 15, fq = lane >> 4;
    const int nt = K / BK;
    int Rr[2]; unsigned colb[2], voffB[2];
#pragma unroll
    for (int i = 0; i < 2; ++i) { int R, C; stage_rc(tid * 16 + i * 8192, R, C); Rr[i] = R; colb[i] = (unsigned)C * 2u; voffB[i] = (unsigned)(R * K + C) * 2u; }
    const size_t kstep = (size_t)(BK * 2);
    const size_t hstep = (size_t)HALF * K * 2;
    const size_t tstep = 2 * hstep;
    const unsigned ldsw = (unsigned)wid * 1024u;
    const int aoff = lds_byte(wr * 64 + fr, fq * 8), boff = lds_byte(wc * 32 + fr, fq * 8);
#define PG8_SA(b, h) (((b) * 2 + (h)) * HTB)
#define PG8_SB(b, h) ((4 + (b) * 2 + (h)) * HTB)
#define PG8_STAGE(bufoff, gbase, voff) do { _Pragma("unroll") for (int _i = 0; _i < 2; ++_i) \
        __builtin_amdgcn_global_load_lds((const unsigned*)((const char*)(gbase) + (voff)[_i]), (LAS unsigned*)(lds + (bufoff) + ldsw + _i * 8192), 16, 0, 0); } while (0)
#define PG8_LDA(dst, b, h) do { if constexpr (FP8) { _Pragma("unroll") for (int m = 0; m < 4; ++m) dst##8[m] = cat8(*(const LAS bf16x8*)(lds + PG8_SA(b, h) + aoff + m * 2048), *(const LAS bf16x8*)(lds + PG8_SA(b, h) + aoff + m * 2048 + 1024)); } \
        else { _Pragma("unroll") for (int m = 0; m < 4; ++m) _Pragma("unroll") for (int k = 0; k < 2; ++k) dst[m][k] = *(const LAS bf16x8*)(lds + PG8_SA(b, h) + aoff + m * 2048 + k * 1024); } } while (0)
#define PG8_LDB(dst, b, h) do { if constexpr (FP8) { _Pragma("unroll") for (int n = 0; n < 2; ++n) dst##8[n] = cat8(*(const LAS bf16x8*)(lds + PG8_SB(b, h) + boff + n * 2048), *(const LAS bf16x8*)(lds + PG8_SB(b, h) + boff + n * 2048 + 1024)); } \
        else { _Pragma("unroll") for (int n = 0; n < 2; ++n) _Pragma("unroll") for (int k = 0; k < 2; ++k) dst[n][k] = *(const LAS bf16x8*)(lds + PG8_SB(b, h) + boff + n * 2048 + k * 1024); } } while (0)
#define PG8_MMA(ai, bj, At, Bt) do { __builtin_amdgcn_s_setprio(1); \
        if constexpr (FP8) { _Pragma("unroll") for (int m = 0; m < 4; ++m) _Pragma("unroll") for (int n = 0; n < 2; ++n) \
            asm volatile("v_mfma_scale_f32_16x16x128_f8f6f4 %0, %1, %2, %0, %3, %3 op_sel_hi:[0,0,0]" : "+v"(acc[ai][bj][m][n]) : "v"(Bt##8[n]), "v"(At##8[m]), "v"(sc8)); } \
        else { _Pragma("unroll") for (int m = 0; m < 4; ++m) _Pragma("unroll") for (int n = 0; n < 2; ++n) _Pragma("unroll") for (int k = 0; k < 2; ++k) \
            acc[ai][bj][m][n] = __builtin_amdgcn_mfma_f32_16x16x32_bf16(Bt[n][k], At[m][k], acc[ai][bj][m][n], 0, 0, 0); } \
        __builtin_amdgcn_s_setprio(0); } while (0)
#define PG8_WAIT_V(n) asm volatile("s_waitcnt vmcnt(" #n ")" ::: "memory")
#define PG8_WAIT_L(n) asm volatile("s_waitcnt lgkmcnt(" #n ")" ::: "memory")
#define PG8_BAR __builtin_amdgcn_s_barrier()
#define PG8_SCHED __builtin_amdgcn_sched_barrier(0)
    Unit cur, nxt; int ui = 0;
    if (!S.next(0, cur)) return;
    Acc acc;
#pragma unroll
    for (int a = 0; a < 2; ++a)
#pragma unroll
        for (int b = 0; b < 2; ++b)
#pragma unroll
            for (int m = 0; m < 4; ++m)
#pragma unroll
                for (int n = 0; n < 2; ++n) acc[a][b][m][n] = (f32x4){0.f, 0.f, 0.f, 0.f};
    const int sc8 = 0x7f7f7f7f;
    bf16x8 At[4][2], B0[2][2], B1[2][2]; i32x8 At8[4], B08[2], B18[2];
    unsigned aC0[2], aC1[2], aN0[2], aN1[2];
#pragma unroll
    for (int i = 0; i < 2; ++i) { aC0[i] = S.arow(cur, Rr[i]) + colb[i]; aC1[i] = S.arow(cur, HALF + Rr[i]) + colb[i]; }
    const char* Ab = (const char*)A;
    const char* cB = (const char*)cur.Bt + (size_t)cur.pn * tstep;
    PG8_STAGE(PG8_SB(0, 0), cB, voffB); PG8_STAGE(PG8_SB(0, 1), cB + hstep, voffB); PG8_STAGE(PG8_SA(0, 0), Ab, aC0); PG8_STAGE(PG8_SA(0, 1), Ab, aC1);
    if (wr == 1) PG8_BAR;
    PG8_WAIT_V(2); PG8_BAR;
    PG8_STAGE(PG8_SB(1, 0), cB + kstep, voffB); PG8_STAGE(PG8_SA(1, 0), Ab + kstep, aC0); PG8_STAGE(PG8_SB(1, 1), cB + hstep + kstep, voffB);
    PG8_WAIT_V(6); PG8_BAR;
    for (;;) {
        const bool has_next = S.next(ui + 1, nxt);
        if (has_next) {
#pragma unroll
            for (int i = 0; i < 2; ++i) { aN0[i] = S.arow(nxt, Rr[i]) + colb[i]; aN1[i] = S.arow(nxt, HALF + Rr[i]) + colb[i]; }
        } else {
#pragma unroll
            for (int i = 0; i < 2; ++i) { aN0[i] = aC0[i]; aN1[i] = aC1[i]; }
        }
        const char* nB = has_next ? (const char*)nxt.Bt + (size_t)nxt.pn * tstep : cB;
        for (int t = 0; t < nt; t += 2) {
            const bool last = (t == nt - 2);
            const char* a1 = Ab + (size_t)(t + 1) * kstep;
            const char* a2 = last ? Ab : Ab + (size_t)(t + 2) * kstep; const char* b2 = last ? nB : cB + (size_t)(t + 2) * kstep;
            const char* a3 = a2 + kstep; const char* b3 = b2 + kstep;
            unsigned x0[2], x1[2];
#pragma unroll
            for (int i = 0; i < 2; ++i) { x0[i] = last ? aN0[i] : aC0[i]; x1[i] = last ? aN1[i] : aC1[i]; }
            PG8_LDB(B0, 0, 0); PG8_LDB(B1, 0, 1); PG8_SCHED; PG8_LDA(At, 0, 0); PG8_STAGE(PG8_SA(1, 1), a1, aC1);
            PG8_WAIT_V(8); PG8_WAIT_L(0); PG8_BAR; PG8_MMA(0, 0, At, B0); PG8_MMA(0, 1, At, B1); PG8_BAR; PG8_SCHED;
            PG8_LDA(At, 0, 1); PG8_STAGE(PG8_SB(0, 0), b2, voffB); PG8_STAGE(PG8_SB(0, 1), b2 + hstep, voffB); PG8_STAGE(PG8_SA(0, 0), a2, x0);
            PG8_WAIT_V(8); PG8_WAIT_L(0); PG8_BAR; PG8_MMA(1, 0, At, B0); PG8_MMA(1, 1, At, B1); PG8_BAR; PG8_SCHED;
            PG8_LDB(B0, 1, 0); PG8_LDB(B1, 1, 1); PG8_SCHED; PG8_LDA(At, 1, 0); PG8_STAGE(PG8_SA(0, 1), a2, x1);
            PG8_WAIT_V(8); PG8_WAIT_L(0); PG8_BAR; PG8_MMA(0, 0, At, B0); PG8_MMA(0, 1, At, B1); PG8_BAR; PG8_SCHED;
            PG8_LDA(At, 1, 1); PG8_STAGE(PG8_SB(1, 0), b3, voffB); PG8_STAGE(PG8_SB(1, 1), b3 + hstep, voffB); PG8_STAGE(PG8_SA(1, 0), a3, x0);
            PG8_WAIT_V(8); PG8_WAIT_L(0); PG8_BAR; PG8_MMA(1, 0, At, B0); PG8_MMA(1, 1, At, B1); PG8_BAR; PG8_SCHED;
        }
        if (wr == 0) PG8_BAR;
        if constexpr (FP8) asm volatile("s_nop 15\n\ts_nop 7" ::: "memory");
        E(acc, cur, wr, wc, fr, fq);
        if (!has_next) break;
#pragma unroll
        for (int a = 0; a < 2; ++a)
#pragma unroll
            for (int b = 0; b < 2; ++b)
#pragma unroll
                for (int m = 0; m < 4; ++m)
#pragma unroll
                    for (int n = 0; n < 2; ++n) acc[a][b][m][n] = (f32x4){0.f, 0.f, 0.f, 0.f};
        cur = nxt; cB = nB; ++ui;
#pragma unroll
        for (int i = 0; i < 2; ++i) { aC0[i] = aN0[i]; aC1[i] = aN1[i]; }
        if (wr == 1) PG8_BAR;
    }
    PG8_WAIT_V(0);
    PG8_BAR;
#undef PG8_SA
#undef PG8_SB
#undef PG8_STAGE
#undef PG8_LDA
#undef PG8_LDB
#undef PG8_MMA
#undef PG8_WAIT_V
#undef PG8_WAIT_L
#undef PG8_BAR
#undef PG8_SCHED
}
}

__device__ __forceinline__ int vcu_of(const Frame& F) { return (F.G % 8 == 0) ? (F.bid % 8) * (F.G / 8) + F.bid / 8 : F.bid; }
__device__ __forceinline__ void phase_qkv_opt(const Frame& F, const Prm& p) {
    pg8::DenseOrder S; S.init(NTOK, 3072, 1024, (const bf16*)(p.ws + WS_WQKV), F.G, F.bid);
    static_assert(WS_V - WS_K == WS_K - WS_Q, "Q|K|V equally spaced");
    LAS float* ropel = (LAS float*)((LAS unsigned char*)F.lds + LDSX_OFF);
    const float* ropeg = (const float*)(p.ws + WS_MISC) + 1024;
    for (int i = F.tid; i < 2048; i += NTHR) ropel[i] = ropeg[i];
    __syncthreads();
    pg8::EpiQKV E{(bf16*)(p.ws + WS_Q), ropel};
    pg8::gemm_phase(F.lds, (const bf16*)(p.ws + WS_H), 1024, S, E);
}
__device__ __forceinline__ void phase_wo_opt(const Frame& F, const Prm& p, int layer) {
    pg8::DenseOrder S; S.init(layer ? NLAT : NTOK, 1024, 1024, (const bf16*)(p.ws + (layer ? WS_WGO : WS_WO)), F.G, F.bid);
    pg8::EpiPlain E{(bf16*)(p.ws + WS_Y), 1.f};
    pg8::gemm_phase(F.lds, (const bf16*)(p.ws + (layer ? WS_A2B : WS_A2)), 1024, S, E);
}
__device__ __forceinline__ void phase_inproj_opt(const Frame& F, const Prm& p) {
    pg8::DenseOrder S; S.init(NTOK, NIN, 1024, (const bf16*)(p.ws + WS_WIN), F.G, F.bid);
    pg8::EpiInproj E{(bf16*)(p.ws + WS_QR), (bf16*)(p.ws + WS_KR), (bf16*)(p.ws + WS_V1), (bf16*)(p.ws + WS_R), (float*)(p.ws + WS_ZZ)};
    pg8::gemm_phase(F.lds, (const bf16*)(p.ws + WS_H), 1024, S, E);
}
__device__ __forceinline__ void phase_moe1_opt(const Frame& F, const Prm& p, int layer) {
    pg8::MoeOrder<true> S; S.init(F.ctl + CW_CNT + layer * 16, 1024, 512, (const bf16*)(p.ws + (layer ? WS_GU1 : WS_GU0)), (const int*)(p.ws + WS_LIST), F.G, vcu_of(F));
    pg8::EpiGateUp E{p.ws + WS_ACT};
    pg8::gemm_phase<pg8::EpiGateUp, pg8::MoeOrder<true>, true>(F.lds, (const bf16*)(p.ws + WS_H), 512, S, E);
}
__device__ __forceinline__ void phase_moe2_opt(const Frame& F, const Prm& p, int layer) {
    pg8::MoeOrder<false> S; S.init(F.ctl + CW_CNT + layer * 16, 1024, 256, (const bf16*)(p.ws + (layer ? WS_DN1 : WS_DN0)), nullptr, F.G, vcu_of(F));
    pg8::EpiPlain E{(bf16*)(p.ws + WS_YM), W8_INV};
    pg8::gemm_phase<pg8::EpiPlain, pg8::MoeOrder<false>, true>(F.lds, (const bf16*)(p.ws + WS_ACT), 256, S, E);
}
namespace attn_body {
using bf16=unsigned short;
using bf16x8=__attribute__((ext_vector_type(8)))short;
using s16x4=__attribute__((ext_vector_type(4)))short;
using f32x16=__attribute__((ext_vector_type(16)))float;
using u32x4=__attribute__((ext_vector_type(4)))unsigned;
constexpr int D=64,DM=1024;
constexpr int NW=8,QBLK=32,QB=QBLK*NW,KVBLK=64;
constexpr int ATTN_PITCH=DM, ATTN_UNIT_ROWS=QB;
__device__ __forceinline__ int crow(int r,int hi){return (r&3)+8*(r>>2)+4*hi;}
#define SBAR() __builtin_amdgcn_sched_barrier(0)
__device__ __forceinline__ void cmask(f32x16&p0,f32x16&p1,int jb,int qrel,int hi){
  const float NEG=-INFINITY; int kb=64*jb+4*hi;
  #pragma unroll
  for(int r=0;r<16;++r){int kv=kb+(r&3)+8*(r>>2); if(kv>qrel)p0[r]=NEG; if(kv+32>qrel)p1[r]=NEG;}
}

constexpr int NSLOT=3, SLOTB=8192;
constexpr int LDS_K=0, LDS_V=NSLOT*SLOTB, LDS_WS=2*NSLOT*SLOTB, LDS_OST=LDS_WS+NW*64*4, LDS_BYTES=LDS_OST+NW*4096;
constexpr float C2=0.125f*1.4426950408889634f;
__device__ __forceinline__ void glds16(const void*gsrc,unsigned lds_dst){unsigned keep;
  asm volatile("s_mov_b32 %0, m0\n\ts_mov_b32 m0, %2\n\ts_nop 0\n\tglobal_load_lds_dwordx4 %1, off\n\ts_mov_b32 m0, %0":"=&s"(keep):"v"(gsrc),"s"(lds_dst):"memory");}
__device__ __forceinline__ float max3f(float a,float b,float c){float r;asm("v_max3_f32 %0, %1, %2, %3":"=v"(r):"v"(a),"v"(b),"v"(c));return r;}
__device__ __forceinline__ float max2f(float a,float b){float r;asm("v_max_f32_e32 %0, %1, %2":"=v"(r):"v"(a),"v"(b));return r;}
__device__ __forceinline__ float fadd_s(float a,float b){float r;asm("v_add_f32_e32 %0, %1, %2":"=v"(r):"v"(a),"v"(b));return r;}
__device__ __forceinline__ float fsub_s(float a,float b){float r;asm("v_sub_f32_e32 %0, %1, %2":"=v"(r):"v"(a),"v"(b));return r;}
typedef float f32x2_t __attribute__((ext_vector_type(2))); typedef __bf16 bf16x2_t __attribute__((ext_vector_type(2)));
__device__ __forceinline__ unsigned cvtpk_s(float lo,float hi){f32x2_t v={lo,hi};bf16x2_t b=__builtin_convertvector(v,bf16x2_t);return __builtin_bit_cast(unsigned,b);}
#define WAIT_BAR(N) asm volatile("s_waitcnt vmcnt(" #N ") lgkmcnt(0)\n\ts_barrier":::"memory")

__device__ __forceinline__ void qkt(f32x16&p0,f32x16&p1,const char*Kslot,const bf16x8*qr,const f32x16&negm,int r32,int hi){
  const char*kb=Kslot+hi*1024+r32*16;
  #pragma unroll
  for(int d0=0;d0<4;++d0){
    const bf16x8 b0=*reinterpret_cast<const bf16x8*>(kb+d0*2048);
    const bf16x8 b1=*reinterpret_cast<const bf16x8*>(kb+d0*2048+512);
    if(d0==0){p0=__builtin_amdgcn_mfma_f32_32x32x16_bf16(b0,qr[0],negm,0,0,0);p1=__builtin_amdgcn_mfma_f32_32x32x16_bf16(b1,qr[0],negm,0,0,0);}
    else{p0=__builtin_amdgcn_mfma_f32_32x32x16_bf16(b0,qr[d0],p0,0,0,0);p1=__builtin_amdgcn_mfma_f32_32x32x16_bf16(b1,qr[d0],p1,0,0,0);}}
}
typedef __attribute__((address_space(3))) const char* lds_cptr;
typedef short v4i16_t __attribute__((ext_vector_type(4)));
__device__ __forceinline__ void kload8(bf16x8*kf,lds_cptr kp){
  kf[0]=*(const __attribute__((address_space(3))) bf16x8*)(kp);      kf[1]=*(const __attribute__((address_space(3))) bf16x8*)(kp+512);
  kf[2]=*(const __attribute__((address_space(3))) bf16x8*)(kp+2048); kf[3]=*(const __attribute__((address_space(3))) bf16x8*)(kp+2560);
  kf[4]=*(const __attribute__((address_space(3))) bf16x8*)(kp+4096); kf[5]=*(const __attribute__((address_space(3))) bf16x8*)(kp+4608);
  kf[6]=*(const __attribute__((address_space(3))) bf16x8*)(kp+6144); kf[7]=*(const __attribute__((address_space(3))) bf16x8*)(kp+6656);
}
__device__ __forceinline__ void kload2(bf16x8*kf,lds_cptr kp,int j){ kf[2*j]=*(const __attribute__((address_space(3))) bf16x8*)(kp+j*2048); kf[2*j+1]=*(const __attribute__((address_space(3))) bf16x8*)(kp+j*2048+512); }
__device__ __forceinline__ s16x4 vtr(lds_cptr p){ return __builtin_bit_cast(s16x4,__builtin_amdgcn_ds_read_tr16_b64_v4i16((__attribute__((address_space(3))) v4i16_t*)p)); }
__device__ __forceinline__ float rowmax(const f32x16&p0,const f32x16&p1){
  float a=max3f(p0[0],p0[1],p1[0]),b=max3f(p0[2],p0[3],p1[1]);a=max3f(a,p1[2],p1[3]);
  #pragma unroll
  for(int r=4;r<16;r+=4){a=max3f(a,p0[r],p0[r+1]);b=max3f(b,p0[r+2],p0[r+3]);a=max3f(a,p1[r],p1[r+1]);b=max3f(b,p1[r+2],p1[r+3]);}
  const float m=max2f(a,b);
  auto rr=__builtin_amdgcn_permlane32_swap(__float_as_uint(m),__float_as_uint(m),false,false);
  return max2f(__uint_as_float(rr[0]),__uint_as_float(rr[1]));
}
__device__ __forceinline__ void pv(f32x16*o,int vb,bf16x8 pa0,bf16x8 pa1,bf16x8 pa2,bf16x8 pa3){
  #pragma unroll
  for(int d0=0;d0<2;++d0){s16x4 lo[4],hi[4];
    #pragma unroll
    for(int ks=0;ks<4;++ks){
      asm volatile("ds_read_b64_tr_b16 %0,%1 offset:%c2":"=&v"(lo[ks]):"v"(vb),"i"(d0*4096+ks*1024):"memory");
      asm volatile("ds_read_b64_tr_b16 %0,%1 offset:%c2":"=&v"(hi[ks]):"v"(vb),"i"(d0*4096+ks*1024+512):"memory");}
    asm volatile("s_waitcnt lgkmcnt(0)":::"memory");SBAR();
    #define PK(k) (bf16x8){lo[k][0],lo[k][1],lo[k][2],lo[k][3],hi[k][0],hi[k][1],hi[k][2],hi[k][3]}
    o[d0]=__builtin_amdgcn_mfma_f32_32x32x16_bf16(pa0,PK(0),o[d0],0,0,0);
    o[d0]=__builtin_amdgcn_mfma_f32_32x32x16_bf16(pa1,PK(1),o[d0],0,0,0);
    o[d0]=__builtin_amdgcn_mfma_f32_32x32x16_bf16(pa2,PK(2),o[d0],0,0,0);
    o[d0]=__builtin_amdgcn_mfma_f32_32x32x16_bf16(pa3,PK(3),o[d0],0,0,0);
    #undef PK
  }
}

#ifndef ATTN_STORE16
#define ATTN_STORE16(p,v) (*(u32x4*)(p)=(v))
#endif
template<int THRL> __device__ __forceinline__ void attn_unit(long qrow0,int qcol,int vcol,long kctx,long klat,int NT,const bf16*Q,const bf16*__restrict__ K,const bf16*__restrict__ V,bf16*O,char*shm){
  const int tid=threadIdx.x,lane=tid&63,r32=lane&31,hi=lane>>5; const int wid=__builtin_amdgcn_readfirstlane(tid>>6);

  const bf16*Qw=Q+(qrow0+wid*QBLK)*DM+qcol;
  const bf16*Kh=K+qcol,*Vh=V+vcol;
  const unsigned lds0=(unsigned)(uintptr_t)shm;
  float*wsf=(float*)(shm+LDS_WS)+wid*64;
  const bf16*ksrc=Kh+(long)lane*DM+wid*8;
  const bf16*vsrc=Vh+(long)(16*(wid&3)+(lane>>2))*DM+(wid>>2)*32+(lane&3)*8;
  const unsigned kdst=lds0+LDS_K+wid*1024, vdst=lds0+LDS_V+wid*1024;
  #define KVROW(t) ((t)<4?kctx+(long)(t)*KVBLK:klat+(long)((t)-4)*KVBLK)
  #define DMA_K(t,slot) glds16(ksrc+KVROW(t)*DM,(unsigned)__builtin_amdgcn_readfirstlane(kdst+(slot)))
  #define DMA_V(t,slot) glds16(vsrc+KVROW(t)*DM,(unsigned)__builtin_amdgcn_readfirstlane(vdst+(slot)))
  const int vb0=(int)(lds0+LDS_V)+((lane>>4)&1)*32+(lane&3)*8+(4*hi+((lane&15)>>2))*64;
  const char*Kbase=shm+LDS_K; bf16x8 kf[8];
  const lds_cptr shm3=(lds_cptr)shm; const lds_cptr kp0=shm3+LDS_K+hi*1024+r32*16; const lds_cptr vp0=shm3+LDS_V+((lane>>4)&1)*32+(lane&3)*8+(4*hi+((lane&15)>>2))*64;
  DMA_K(0,0);DMA_V(0,0);DMA_K(1,SLOTB);
  bf16x8 qr[4];
  #pragma unroll
  for(int d0=0;d0<4;++d0)qr[d0]=*reinterpret_cast<const bf16x8*>(&Qw[(long)r32*DM+d0*16+hi*8]);
  float mhat=0.f,l_reg=0.f;f32x16 o[2];o[0]=f32x16{};o[1]=f32x16{};f32x16 negm=f32x16{};asm volatile("":"+v"(negm));
  const int qrel=wid*QBLK+r32;
  #define CMASK(P0,P1,t) do{}while(0)
  bool resc=false;
  #define START(P0,P1) do{ const float rm=rowmax(P0,P1); resc=false; \
    { const float dl=rm; mhat=fadd_s(mhat,dl); \
      _Pragma("unroll") for(int r=0;r<16;++r){P0[r]=fsub_s(P0[r],dl);P1[r]=fsub_s(P1[r],dl);} \
      _Pragma("unroll") for(int r=0;r<16;++r)negm[r]=-mhat; asm volatile("":"+v"(negm)); } \
    _Pragma("unroll") for(int r=0;r<16;++r)P0[r]=__builtin_amdgcn_exp2f(P0[r]); }while(0)
  #define RESC() do{ if(resc){ asm volatile("s_waitcnt lgkmcnt(0)":::"memory"); \
      _Pragma("unroll") for(int d_=0;d_<2;++d_) _Pragma("unroll") for(int r=0;r<16;++r)o[d_][r]*=wsf[crow(r,hi)]; } }while(0)
  f32x16 pA0,pA1,pB0,pB1;
  int sl_prev=0,sl_cur=0,sl_next=SLOTB;
  #define ROT() do{sl_prev=sl_cur;sl_cur=sl_next;sl_next=(sl_next==(NSLOT-1)*SLOTB)?0:sl_next+SLOTB;}while(0)
  DMA_K(2,2*SLOTB);
  WAIT_BAR(3);
  qkt(pA0,pA1,Kbase,qr,negm,r32,hi);asm volatile("s_nop 15\n\ts_nop 7":"+v"(pA0),"+v"(pA1));CMASK(pA0,pA1,0);
  START(pA0,pA1);
  _Pragma("unroll") for(int r=0;r<16;++r)pA1[r]=__builtin_amdgcn_exp2f(pA1[r]);
  WAIT_BAR(0);
  DMA_K(3,0);DMA_V(1,SLOTB);
  ROT();
  kload8(kf,kp0+sl_cur);
  WAIT_BAR(2);
  s16x4 vlo[8],vhi[8]; u32x4 pw0,pw1,pw2,pw3;
  #define PKW(P,B) cvtpk_s(P[B],P[B+1])
  #define PAF(k) __builtin_bit_cast(bf16x8,pw##k)
  #define VFR(i) (bf16x8){vlo[i][0],vlo[i][1],vlo[i][2],vlo[i][3],vhi[i][0],vhi[i][1],vhi[i][2],vhi[i][3]}
  #define PIN(x) asm volatile("":"+v"(x))
  #define MX3(a,b,c) __builtin_fmaxf(__builtin_fmaxf((a),(b)),(c))
  #define GAPA(MF,A0,A1,A2,A3,W0,W1,PW) do{ MF; sacc+=A0; sacc+=A1; sacc+=A2; sacc+=A3; PIN(sacc); W0; W1; PIN(PW); SBAR(); }while(0)
  #define EX(v) __builtin_amdgcn_exp2f(v)
  #define GAPB(MF,X,B) do{ MF; X[B]=EX(X[B]); X[B+1]=EX(X[B+1]); X[B+2]=EX(X[B+2]); X[B+3]=EX(X[B+3]); PIN(X); SBAR(); }while(0)
  #define VRD(i) do{ vlo[i]=vtr(vp_+(((i)>>2)*4096+((i)&3)*1024)); vhi[i]=vtr(vp_+(((i)>>2)*4096+((i)&3)*1024+512)); }while(0)
  #define KRD(G,j) do{ if(G){ kload2(kf,kp0+sl_next,j); SBAR(); } }while(0)
  #define STEP(C0,C1,P0,P1,t,GK,GV,GL) do{ SBAR(); \
    const lds_cptr vp_=vp0+sl_prev; \
    VRD(0); SBAR(); float sacc=(P0[0]+P0[1]); \
    GAPA(C0=__builtin_amdgcn_mfma_f32_32x32x16_bf16(kf[0],qr[0],negm,0,0,0), P0[2],P0[3],P0[4],P0[5],     pw0[0]=PKW(P0,0), pw0[1]=PKW(P0,2), pw0); \
    VRD(4); SBAR(); GAPA(C1=__builtin_amdgcn_mfma_f32_32x32x16_bf16(kf[1],qr[0],negm,0,0,0), P0[6],P0[7],P0[8],P0[9],     pw0[2]=PKW(P0,4), pw0[3]=PKW(P0,6), pw0); \
    VRD(1); SBAR(); GAPA(C0=__builtin_amdgcn_mfma_f32_32x32x16_bf16(kf[2],qr[1],C0,0,0,0),   P0[10],P0[11],P0[12],P0[13], pw1[0]=PKW(P0,8), pw1[1]=PKW(P0,10), pw1); \
    VRD(5); SBAR(); GAPA(C1=__builtin_amdgcn_mfma_f32_32x32x16_bf16(kf[3],qr[1],C1,0,0,0),   P0[14],P0[15],P1[0],P1[1],   pw1[2]=PKW(P0,12),pw1[3]=PKW(P0,14), pw1); \
    VRD(2); SBAR(); GAPA(C0=__builtin_amdgcn_mfma_f32_32x32x16_bf16(kf[4],qr[2],C0,0,0,0),   P1[2],P1[3],P1[4],P1[5],     pw2[0]=PKW(P1,0), pw2[1]=PKW(P1,2), pw2); \
    VRD(6); SBAR(); GAPA(C1=__builtin_amdgcn_mfma_f32_32x32x16_bf16(kf[5],qr[2],C1,0,0,0),   P1[6],P1[7],P1[8],P1[9],     pw2[2]=PKW(P1,4), pw2[3]=PKW(P1,6), pw2); \
    VRD(3); SBAR(); GAPA(C0=__builtin_amdgcn_mfma_f32_32x32x16_bf16(kf[6],qr[3],C0,0,0,0),   P1[10],P1[11],P1[12],P1[13], pw3[0]=PKW(P1,8), pw3[1]=PKW(P1,10), pw3); \
    VRD(7); SBAR(); GAPA(C1=__builtin_amdgcn_mfma_f32_32x32x16_bf16(kf[7],qr[3],C1,0,0,0),   P1[14],P1[15],0.f,0.f,       pw3[2]=PKW(P1,12),pw3[3]=PKW(P1,14), pw3); \
    l_reg+=sacc; \
    if(GK){DMA_K((t)+3,sl_cur);} if(GV){DMA_V((t)+1,sl_next);} \
    CMASK(C0,C1,t); \
    { float a=MX3(C0[0],C0[1],C1[0]),b=MX3(C0[2],C0[3],C1[1]); a=MX3(a,C1[2],C1[3]); \
      _Pragma("unroll") for(int r=4;r<16;r+=4){a=MX3(a,C0[r],C0[r+1]);b=MX3(b,C0[r+2],C0[r+3]);a=MX3(a,C1[r],C1[r+1]);b=MX3(b,C1[r+2],C1[r+3]);} \
      float rm=__builtin_fmaxf(a,b); { auto rr=__builtin_amdgcn_permlane32_swap(__float_as_uint(rm),__float_as_uint(rm),false,false); rm=__builtin_fmaxf(__uint_as_float(rr[0]),__uint_as_float(rr[1])); } \
      resc=false; \
      if(__builtin_expect(__any(rm>(float)THRL),0)){ const float dl=__builtin_fmaxf(rm,0.f); mhat+=dl; \
        _Pragma("unroll") for(int r=0;r<16;++r){C0[r]-=dl;C1[r]-=dl;} \
        _Pragma("unroll") for(int r=0;r<16;++r)negm[r]=-mhat; asm volatile("":"+v"(negm)); \
        const float f=__builtin_amdgcn_exp2f(-dl); l_reg*=f; if(hi==0)wsf[r32]=f; resc=true; } } \
    SBAR(); \
    GAPB(o[0]=__builtin_amdgcn_mfma_f32_32x32x16_bf16(PAF(0),VFR(0),o[0],0,0,0), C0,0); \
    GAPB(o[1]=__builtin_amdgcn_mfma_f32_32x32x16_bf16(PAF(0),VFR(4),o[1],0,0,0), C0,4); \
    KRD(GL,0); GAPB(o[0]=__builtin_amdgcn_mfma_f32_32x32x16_bf16(PAF(1),VFR(1),o[0],0,0,0), C0,8); \
    KRD(GL,1); GAPB(o[1]=__builtin_amdgcn_mfma_f32_32x32x16_bf16(PAF(1),VFR(5),o[1],0,0,0), C0,12); \
    KRD(GL,2); GAPB(o[0]=__builtin_amdgcn_mfma_f32_32x32x16_bf16(PAF(2),VFR(2),o[0],0,0,0), C1,0); \
    KRD(GL,3); GAPB(o[1]=__builtin_amdgcn_mfma_f32_32x32x16_bf16(PAF(2),VFR(6),o[1],0,0,0), C1,4); \
    GAPB(o[0]=__builtin_amdgcn_mfma_f32_32x32x16_bf16(PAF(3),VFR(3),o[0],0,0,0), C1,8); \
    GAPB(o[1]=__builtin_amdgcn_mfma_f32_32x32x16_bf16(PAF(3),VFR(7),o[1],0,0,0), C1,12); \
    }while(0)
  int t=1;
  #undef CMASK
  #define CMASK(P0,P1,t) do{}while(0)
  for(;t+5<NT;t+=2){
    STEP(pB0,pB1,pA0,pA1,t,true,true,true);     WAIT_BAR(2); RESC(); ROT();
    STEP(pA0,pA1,pB0,pB1,t+1,true,true,true);   WAIT_BAR(2); RESC(); ROT();
  }
  #undef CMASK
  #define CMASK(P0,P1,t) do{}while(0)
  #define ENDW(tt) do{ if((tt)+3<NT){WAIT_BAR(2);} else if((tt)+2<NT){WAIT_BAR(1);} else {WAIT_BAR(0);} }while(0)
  for(;t+1<NT;t+=2){
    STEP(pB0,pB1,pA0,pA1,t,(t+3<NT),(t+1<NT),(t+1<NT));       ENDW(t);   RESC(); ROT();
    STEP(pA0,pA1,pB0,pB1,t+1,(t+4<NT),(t+2<NT),(t+2<NT));     ENDW(t+1); RESC(); ROT();
  }
  STEP(pB0,pB1,pA0,pA1,NT-1,false,false,false); RESC();
  { float sacc=pB0[0]+pB0[1]; _Pragma("unroll") for(int r=2;r<16;++r)sacc+=pB0[r]; _Pragma("unroll") for(int r=0;r<16;++r)sacc+=pB1[r]; l_reg+=sacc;
    pw0=(u32x4){PKW(pB0,0),PKW(pB0,2),PKW(pB0,4),PKW(pB0,6)};pw1=(u32x4){PKW(pB0,8),PKW(pB0,10),PKW(pB0,12),PKW(pB0,14)};pw2=(u32x4){PKW(pB1,0),PKW(pB1,2),PKW(pB1,4),PKW(pB1,6)};pw3=(u32x4){PKW(pB1,8),PKW(pB1,10),PKW(pB1,12),PKW(pB1,14)};
    SBAR(); pv(o,vb0+sl_cur,PAF(0),PAF(1),PAF(2),PAF(3)); }
  #undef PKW
  #undef PAF
  #undef VFR
  #undef PIN
  #undef MX3
  #undef GAPA
  #undef GAPB
  #undef EX
  #undef VRD
  #undef KRD
  #undef STEP
  #undef ENDW
  {auto rr=__builtin_amdgcn_permlane32_swap(__float_as_uint(l_reg),__float_as_uint(l_reg),false,false);l_reg=__uint_as_float(rr[0])+__uint_as_float(rr[1]);}
  if(hi==0)wsf[32+r32]=l_reg;asm volatile("s_waitcnt lgkmcnt(0)":::"memory");
  float rli[16];
  #pragma unroll
  for(int r=0;r<16;++r)rli[r]=__builtin_amdgcn_rcpf(wsf[32+crow(r,hi)]);
  bf16*Ow=O+(qrow0+wid*QBLK)*DM+vcol;
  { bf16*stg=(bf16*)(shm+LDS_OST)+wid*2048;
    #pragma unroll
    for(int r=0;r<16;++r){const int orow=crow(r,hi);
      #pragma unroll
      for(int d0=0;d0<2;++d0)stg[orow*64+d0*32+r32]=(bf16)f2bf(o[d0][r]*rli[r]);}
    asm volatile("s_waitcnt lgkmcnt(0)":::"memory");
    #pragma unroll
    for(int i=0;i<4;++i){const int row=i*8+(lane>>3),ch=lane&7; const u32x4 v=*(const u32x4*)(stg+row*64+ch*8); ATTN_STORE16(Ow+(long)row*DM+ch*8,v);} }
  asm volatile("s_waitcnt lgkmcnt(0)\n\ts_barrier":::"memory");
  #undef DMA_K
  #undef DMA_V
  #undef CMASK
  #undef START
  #undef RESC
  #undef ROT
}
constexpr int ATTN_LDS_BYTES=LDS_BYTES;
#undef SBAR
#undef WAIT_BAR
#undef KVROW
}
namespace attn_body {
constexpr int V2SLOT = 16384;
constexpr int L2_K = 0, L2_V = NSLOT * SLOTB, L2_WS = L2_V + NSLOT * V2SLOT, L2_OST = L2_WS + NW * 64 * 4, L2_BYTES = L2_OST + NW * 4096;
#define SBAR() __builtin_amdgcn_sched_barrier(0)
#define WAIT_BAR(N) asm volatile("s_waitcnt vmcnt(" #N ") lgkmcnt(0)\n\ts_barrier":::"memory")
template<int THRL> __device__ __forceinline__ void attn_unit2(long qrow0,int qcol,int vcol,long kctx,long klat,int NT,const bf16*Q,const bf16*__restrict__ K,const bf16*__restrict__ V,bf16*O,char*shm){
  const int tid=threadIdx.x,lane=tid&63,r32=lane&31,hi=lane>>5; const int wid=__builtin_amdgcn_readfirstlane(tid>>6);
  const bf16*Qw=Q+(qrow0+wid*QBLK)*DM+qcol;
  const bf16*Kh=K+qcol,*Vh=V+vcol;
  const unsigned lds0=(unsigned)(uintptr_t)shm;
  float*wsf=(float*)(shm+L2_WS)+wid*64;
  const bf16*ksrc=Kh+(long)lane*DM+wid*8;
  const bf16*vsrc=Vh+(long)(16*(wid&3)+(lane>>2))*DM+(wid>>2)*32+(lane&3)*8;
  const unsigned kdst=lds0+L2_K+wid*1024, vdst=lds0+L2_V+wid*1024;
  #define KVROW(t) ((t)<4?kctx+(long)(t)*KVBLK:klat+(long)((t)-4)*KVBLK)
  #define DMA_K(t,slot) glds16(ksrc+KVROW(t)*DM,(unsigned)__builtin_amdgcn_readfirstlane(kdst+(slot)))
  #define DMA_V(t,slot) do{ glds16(vsrc+KVROW(t)*DM,(unsigned)__builtin_amdgcn_readfirstlane(vdst+2*(slot))); glds16(vsrc+KVROW(t)*DM+64,(unsigned)__builtin_amdgcn_readfirstlane(vdst+2*(slot)+8192)); }while(0)
  const char*Kbase=shm+L2_K; bf16x8 kf[8];
  const lds_cptr shm3=(lds_cptr)shm; const lds_cptr kp0=shm3+L2_K+hi*1024+r32*16; const lds_cptr vp0=shm3+L2_V+((lane>>4)&1)*32+(lane&3)*8+(4*hi+((lane&15)>>2))*64;
  DMA_K(0,0);DMA_V(0,0);DMA_K(1,SLOTB);
  bf16x8 qr[4];
  #pragma unroll
  for(int d0=0;d0<4;++d0)qr[d0]=*reinterpret_cast<const bf16x8*>(&Qw[(long)r32*DM+d0*16+hi*8]);
  float mhat=0.f,l_reg=0.f;f32x16 o[4];o[0]=f32x16{};o[1]=f32x16{};o[2]=f32x16{};o[3]=f32x16{};const f32x16 zero16=f32x16{};
  bool resc=false;
  #define START(P0,P1) do{ const float rm=rowmax(P0,P1); resc=false; mhat=rm; \
    _Pragma("unroll") for(int r=0;r<16;++r){P0[r]=fsub_s(P0[r],rm);P1[r]=fsub_s(P1[r],rm);} \
    _Pragma("unroll") for(int r=0;r<16;++r)P0[r]=__builtin_amdgcn_exp2f(P0[r]); }while(0)
  #define RESC() do{ if(resc){ asm volatile("s_waitcnt lgkmcnt(0)":::"memory"); \
      _Pragma("unroll") for(int d_=0;d_<4;++d_) _Pragma("unroll") for(int r=0;r<16;++r)o[d_][r]*=wsf[crow(r,hi)]; } }while(0)
  int sl_prev=0,sl_cur=0,sl_next=SLOTB;
  #define ROT() do{sl_prev=sl_cur;sl_cur=sl_next;sl_next=(sl_next==(NSLOT-1)*SLOTB)?0:sl_next+SLOTB;}while(0)
  DMA_K(2,2*SLOTB);
  WAIT_BAR(4);
  #define PKW(P,B) cvtpk_s(P[B],P[B+1])
  u32x4 pwA0,pwA1,pwA2,pwA3,pwB0,pwB1,pwB2,pwB3;
  { f32x16 p0,p1;
    qkt(p0,p1,Kbase,qr,zero16,r32,hi);asm volatile("s_nop 15\n\ts_nop 7":"+v"(p0),"+v"(p1));
    START(p0,p1);
    _Pragma("unroll") for(int r=0;r<16;++r)p1[r]=__builtin_amdgcn_exp2f(p1[r]);
    float sacc=p0[0]+p0[1]; _Pragma("unroll") for(int r=2;r<16;++r)sacc+=p0[r]; _Pragma("unroll") for(int r=0;r<16;++r)sacc+=p1[r]; l_reg+=sacc;
    pwA0=(u32x4){PKW(p0,0),PKW(p0,2),PKW(p0,4),PKW(p0,6)};pwA1=(u32x4){PKW(p0,8),PKW(p0,10),PKW(p0,12),PKW(p0,14)};pwA2=(u32x4){PKW(p1,0),PKW(p1,2),PKW(p1,4),PKW(p1,6)};pwA3=(u32x4){PKW(p1,8),PKW(p1,10),PKW(p1,12),PKW(p1,14)}; }
  WAIT_BAR(0);
  DMA_K(3,0);DMA_V(1,SLOTB);
  ROT();
  kload8(kf,kp0+sl_cur);
  WAIT_BAR(3);
  s16x4 vAl[4],vAh[4],vBl[4],vBh[4];
  #define PAFX(x) __builtin_bit_cast(bf16x8,x)
  #define VF(A,d) (bf16x8){A##l[d][0],A##l[d][1],A##l[d][2],A##l[d][3],A##h[d][0],A##h[d][1],A##h[d][2],A##h[d][3]}
  #define PIN(x) asm volatile("":"+v"(x))
  #define MX3(a,b,c) __builtin_fmaxf(__builtin_fmaxf((a),(b)),(c))
  #define EX(v) __builtin_amdgcn_exp2f(v)
  #define VRDL(A,d,ks) A##l[d]=vtr(vp_+((d)*4096+(ks)*1024))
  #define VRDH(A,d,ks) A##h[d]=vtr(vp_+((d)*4096+(ks)*1024+512))
  #define GAPP(MF,X,B,PWN,W,RD) do{ MF; X[B]=EX(X[B]-mhat); X[B+1]=EX(X[B+1]-mhat); sacc+=X[B]; sacc+=X[B+1]; PIN(sacc); PWN[W]=cvtpk_s(X[B],X[B+1]); PIN(PWN); RD; SBAR(); }while(0)
  #define MFQ(C,kf_,q_,acc_) C=__builtin_amdgcn_mfma_f32_32x32x16_bf16(kf_,q_,acc_,0,0,0)
  #define MFO(d,PW,A) o[d]=__builtin_amdgcn_mfma_f32_32x32x16_bf16(PAFX(PW),VF(A,d),o[d],0,0,0)
  #define KRD(G,j) do{ if(G){ kload2(kf,kp0+sl_next,j); } }while(0)
  #define STEP2(t,PI0,PI1,PI2,PI3,PO0,PO1,PO2,PO3,GK,GV,GL) do{ SBAR(); \
    const lds_cptr vp_=vp0+2*sl_prev; f32x16 C0,C1; float sacc=0.f; \
    VRDL(vA,0,0); SBAR(); MFQ(C0,kf[0],qr[0],zero16); SBAR(); \
    VRDH(vA,0,0); SBAR(); MFQ(C1,kf[1],qr[0],zero16); SBAR(); \
    VRDL(vA,1,0); SBAR(); MFQ(C0,kf[2],qr[1],C0); SBAR(); \
    VRDH(vA,1,0); SBAR(); MFQ(C1,kf[3],qr[1],C1); SBAR(); \
    VRDL(vA,2,0); SBAR(); MFQ(C0,kf[4],qr[2],C0); SBAR(); \
    VRDH(vA,2,0); SBAR(); MFQ(C1,kf[5],qr[2],C1); SBAR(); \
    VRDL(vA,3,0); SBAR(); MFQ(C0,kf[6],qr[3],C0); SBAR(); \
    VRDH(vA,3,0); SBAR(); MFQ(C1,kf[7],qr[3],C1); SBAR(); \
    if(GK){DMA_K((t)+3,sl_cur);} if(GV){DMA_V((t)+1,sl_next);} \
    { float a=MX3(C0[0],C0[1],C1[0]),b=MX3(C0[2],C0[3],C1[1]); a=MX3(a,C1[2],C1[3]); \
      _Pragma("unroll") for(int r=4;r<16;r+=4){a=MX3(a,C0[r],C0[r+1]);b=MX3(b,C0[r+2],C0[r+3]);a=MX3(a,C1[r],C1[r+1]);b=MX3(b,C1[r+2],C1[r+3]);} \
      float rm=__builtin_fmaxf(a,b); { auto rr=__builtin_amdgcn_permlane32_swap(__float_as_uint(rm),__float_as_uint(rm),false,false); rm=__builtin_fmaxf(__uint_as_float(rr[0]),__uint_as_float(rr[1])); } \
      resc=false; \
      if(__builtin_expect(__any(rm-mhat>(float)THRL),0)){ const float dl=__builtin_fmaxf(rm-mhat,0.f); mhat+=dl; \
        const float f=__builtin_amdgcn_exp2f(-dl); l_reg*=f; if(hi==0)wsf[r32]=f; resc=true; } } \
    SBAR(); \
    GAPP(MFO(0,PI0,vA),C0,0, PO0,0, VRDL(vB,0,1);VRDH(vB,0,1)); \
    GAPP(MFO(1,PI0,vA),C0,2, PO0,1, VRDL(vB,1,1);VRDH(vB,1,1)); \
    GAPP(MFO(2,PI0,vA),C0,4, PO0,2, VRDL(vB,2,1);VRDH(vB,2,1)); \
    GAPP(MFO(3,PI0,vA),C0,6, PO0,3, VRDL(vB,3,1);VRDH(vB,3,1)); \
    GAPP(MFO(0,PI1,vB),C0,8, PO1,0, VRDL(vA,0,2);VRDH(vA,0,2)); \
    GAPP(MFO(1,PI1,vB),C0,10,PO1,1, VRDL(vA,1,2);VRDH(vA,1,2)); \
    GAPP(MFO(2,PI1,vB),C0,12,PO1,2, VRDL(vA,2,2);VRDH(vA,2,2)); \
    GAPP(MFO(3,PI1,vB),C0,14,PO1,3, VRDL(vA,3,2);VRDH(vA,3,2)); \
    GAPP(MFO(0,PI2,vA),C1,0, PO2,0, VRDL(vB,0,3);VRDH(vB,0,3)); \
    GAPP(MFO(1,PI2,vA),C1,2, PO2,1, VRDL(vB,1,3);VRDH(vB,1,3)); \
    GAPP(MFO(2,PI2,vA),C1,4, PO2,2, VRDL(vB,2,3);VRDH(vB,2,3)); \
    GAPP(MFO(3,PI2,vA),C1,6, PO2,3, VRDL(vB,3,3);VRDH(vB,3,3)); \
    GAPP(MFO(0,PI3,vB),C1,8, PO3,0, KRD(GL,0)); \
    GAPP(MFO(1,PI3,vB),C1,10,PO3,1, KRD(GL,1)); \
    GAPP(MFO(2,PI3,vB),C1,12,PO3,2, KRD(GL,2)); \
    GAPP(MFO(3,PI3,vB),C1,14,PO3,3, KRD(GL,3)); \
    l_reg+=sacc; \
    }while(0)
  #define ENDW(tt) do{ if((tt)+3<NT){WAIT_BAR(3);} else if((tt)+2<NT){WAIT_BAR(2);} else {WAIT_BAR(0);} }while(0)
  int t=1;
  for(;t+5<NT;t+=2){
    STEP2(t,  pwA0,pwA1,pwA2,pwA3,pwB0,pwB1,pwB2,pwB3,true,true,true); WAIT_BAR(3); RESC(); ROT();
    STEP2(t+1,pwB0,pwB1,pwB2,pwB3,pwA0,pwA1,pwA2,pwA3,true,true,true); WAIT_BAR(3); RESC(); ROT();
  }
  for(;t+1<NT;t+=2){
    STEP2(t,  pwA0,pwA1,pwA2,pwA3,pwB0,pwB1,pwB2,pwB3,(t+3<NT),(t+1<NT),(t+1<NT)); ENDW(t);   RESC(); ROT();
    STEP2(t+1,pwB0,pwB1,pwB2,pwB3,pwA0,pwA1,pwA2,pwA3,(t+4<NT),(t+2<NT),(t+2<NT)); ENDW(t+1); RESC(); ROT();
  }
  STEP2(NT-1,pwA0,pwA1,pwA2,pwA3,pwB0,pwB1,pwB2,pwB3,false,false,false); RESC();
  { const lds_cptr vp_=vp0+2*sl_cur;
    #pragma unroll
    for(int ks=0;ks<4;++ks){
      #pragma unroll
      for(int d=0;d<4;++d){ const s16x4 lo=vtr(vp_+(d*4096+ks*1024)),hh=vtr(vp_+(d*4096+ks*1024+512)); const bf16x8 vf=(bf16x8){lo[0],lo[1],lo[2],lo[3],hh[0],hh[1],hh[2],hh[3]};
        const u32x4 pw=(ks==0)?pwB0:(ks==1)?pwB1:(ks==2)?pwB2:pwB3;
        o[d]=__builtin_amdgcn_mfma_f32_32x32x16_bf16(PAFX(pw),vf,o[d],0,0,0); } } }
  {auto rr=__builtin_amdgcn_permlane32_swap(__float_as_uint(l_reg),__float_as_uint(l_reg),false,false);l_reg=__uint_as_float(rr[0])+__uint_as_float(rr[1]);}
  if(hi==0)wsf[32+r32]=l_reg;asm volatile("s_waitcnt lgkmcnt(0)":::"memory");
  float rli[16];
  #pragma unroll
  for(int r=0;r<16;++r)rli[r]=__builtin_amdgcn_rcpf(wsf[32+crow(r,hi)]);
  bf16*Ow=O+(qrow0+wid*QBLK)*DM+vcol;
  { bf16*stg=(bf16*)(shm+L2_OST)+wid*2048;
    #pragma unroll
    for(int hf=0;hf<2;++hf){
      #pragma unroll
      for(int r=0;r<16;++r){const int orow=crow(r,hi);
        #pragma unroll
        for(int d0=0;d0<2;++d0)stg[orow*64+d0*32+r32]=(bf16)f2bf(o[2*hf+d0][r]*rli[r]);}
      asm volatile("s_waitcnt lgkmcnt(0)":::"memory");
      #pragma unroll
      for(int i=0;i<4;++i){const int row=i*8+(lane>>3),ch=lane&7; const u32x4 v=*(const u32x4*)(stg+row*64+ch*8); *(u32x4*)(Ow+(long)row*DM+hf*64+ch*8)=v;}
      asm volatile("s_waitcnt lgkmcnt(0)":::"memory"); } }
  asm volatile("s_waitcnt lgkmcnt(0)\n\ts_barrier":::"memory");
  #undef KVROW
  #undef DMA_K
  #undef DMA_V
  #undef START
  #undef RESC
  #undef ROT
  #undef PKW
  #undef PAFX
  #undef VF
  #undef PIN
  #undef MX3
  #undef EX
  #undef VRDL
  #undef VRDH
  #undef GAPP
  #undef MFQ
  #undef MFO
  #undef KRD
  #undef STEP2
  #undef ENDW
}
#undef SBAR
#undef WAIT_BAR
}
__device__ __forceinline__ void phase_attn2(const Frame& F, const Prm& p) {
    const bf16* Q = (const bf16*)(p.ws + WS_Q); const bf16* K = (const bf16*)(p.ws + WS_K); const bf16* V = (const bf16*)(p.ws + WS_V); bf16* O1 = (bf16*)(p.ws + WS_O1);
    for (int v = vcu_of(F); v < 256; v += F.G) {
        const int b = v >> 5, hm = (v >> 1) & 15, h = hm >> 1, m = hm & 1, half = v & 1;
        const int qcol = hm * 64, vcol = h * 128; bf16* O = O1 + (size_t)m * ((WS_O2 - WS_O1) / 2);
        const long kctx = NLAT + b * CTXL, klat = (long)b * SEQ;
        const int nu = half ? 8 : 9;
        for (int i = 0; i < nu; ++i) {
            const long qrow0 = i < 8 ? klat + (half * 8 + i) * 256 : kctx; const int NT = i < 8 ? 68 : 4;
            attn_body::attn_unit2<8>(qrow0, qcol, vcol, kctx, klat, NT, Q, K, V, O, (char*)F.lds);
        }
    }
}
namespace gla3 {
typedef short bf16x8 __attribute__((ext_vector_type(8)));
typedef short s16x4 __attribute__((ext_vector_type(4)));
typedef float f32x16 __attribute__((ext_vector_type(16)));
constexpr int CH = 64 * 16 + 64;
constexpr int L_QS = 0, L_KS = 16 * CH, L_VS = 32 * CH, L_SB = 40 * CH, L_X = 56 * CH, L_DEC = L_X + 16384, L_END = L_DEC + 512;
__device__ __forceinline__ int crow(int i, int hh) { return (i & 3) + 8 * (i >> 2) + 4 * hh; }
typedef float f32x2_t __attribute__((ext_vector_type(2))); typedef __bf16 bf16x2_t __attribute__((ext_vector_type(2)));
__device__ __forceinline__ unsigned pk(float lo, float hi) { f32x2_t v = {lo, hi}; bf16x2_t b = __builtin_convertvector(v, bf16x2_t); return __builtin_bit_cast(unsigned, b); }
typedef short v4i16_t __attribute__((ext_vector_type(4)));
__device__ __forceinline__ s16x4 trrd(LAS const unsigned char* p) { return __builtin_bit_cast(s16x4, __builtin_amdgcn_ds_read_tr16_b64_v4i16((LAS v4i16_t*)p)); }
#define GLA_FR(lo, hi) (bf16x8){lo[0], lo[1], lo[2], lo[3], hi[0], hi[1], hi[2], hi[3]}

__device__ __forceinline__ void scan_unit(const Frame& F, const Prm& p, int unit) {
    const int dvs = unit & 3, dir = (unit >> 2) & 1, h = (unit >> 3) & 3, b = unit >> 5;
    LAS unsigned char* lds = (LAS unsigned char*)F.lds;
    const int lane = F.lane, w = F.wave, tid = F.tid, r = lane & 31, hh = lane >> 5;
    const bf16* QT = (const bf16*)(p.ws + WS_QT) + (size_t)dir * NTOK * 512 + h * 128;
    const bf16* KT = (const bf16*)(p.ws + WS_KT) + (size_t)dir * NTOK * 512 + h * 128;
    const bf16* V = (const bf16*)(p.ws + WS_V1) + h * 256 + dvs * 64;
    const float* DEC = (const float*)(p.ws + WS_DEC) + (size_t)dir * NCHUNK * 512 + h * 128;
    bf16* OG = (bf16*)(p.ws + (dir ? WS_OGB : WS_OGF)) + h * 256 + dvs * 64;
    const int g1 = (lane >> 4) & 1, q4 = (lane & 15) >> 2, p4 = lane & 3;
    const int trb = (2 * g1 + (p4 >> 1)) * CH + q4 * 16 + 8 * (p4 & 1);
    const int trN = trb + 128 * hh, trP = trb + 64 * hh;
    f32x16 S0 = {}, S1 = {};
    for (int i = tid; i < 16 * CH / 16; i += NTHR) *(LAS u32x4*)(lds + L_SB + i * 16) = (u32x4){0u, 0u, 0u, 0u};
    u32x4 pq0[2], pq1[2], pk0[2], pk1[2], pv[2]; float pdec[2] = {0.f, 0.f};
#define GLA_CHUNK(step) ((step) >= 4 ? b * 64 + (dir ? 63 - ((step) - 4) : (step) - 4) : 512 + b * 4 + (dir ? 3 - (step) : (step)))
    const int qrow = 8 * w + (lane >> 4), qch = lane & 15, vrow = 8 * w + (lane >> 3), vch = lane & 7;
#define GLA_LOAD(step, u) do { const size_t t0_ = (size_t)GLA_CHUNK(step) * 64; \
        pq0[u] = *(const u32x4*)(QT + (t0_ + qrow) * 512 + 8 * qch); pq1[u] = *(const u32x4*)(QT + (t0_ + qrow + 4) * 512 + 8 * qch); \
        pk0[u] = *(const u32x4*)(KT + (t0_ + qrow) * 512 + 8 * qch); pk1[u] = *(const u32x4*)(KT + (t0_ + qrow + 4) * 512 + 8 * qch); \
        pv[u] = *(const u32x4*)(V + (t0_ + vrow) * 1024 + 8 * vch); if (tid < 128) pdec[u] = DEC[(size_t)GLA_CHUNK(step) * 512 + tid]; } while (0)
#define GLA_STORE(u) do { \
        *(LAS u32x4*)(lds + L_QS + qch * CH + qrow * 16) = pq0[u]; *(LAS u32x4*)(lds + L_QS + qch * CH + (qrow + 4) * 16) = pq1[u]; \
        *(LAS u32x4*)(lds + L_KS + qch * CH + qrow * 16) = pk0[u]; *(LAS u32x4*)(lds + L_KS + qch * CH + (qrow + 4) * 16) = pk1[u]; \
        *(LAS u32x4*)(lds + L_VS + vch * CH + vrow * 16) = pv[u]; \
        if (tid < 128) *(LAS float*)(lds + L_DEC + 4 * tid) = pdec[u]; } while (0)
    GLA_LOAD(0, 0);
    GLA_LOAD(1, 1);
    GLA_STORE(0);
    __syncthreads();
    const int tb = (w & 3) >> 1, vb = w & 1;
    for (int sp2 = 0; sp2 < 34; ++sp2) {
#pragma unroll
    for (int u = 0; u < 2; ++u) {
        const int step = 2 * sp2 + u;
        const bool lat = step >= 4; const int chunk = GLA_CHUNK(step);
        if (step + 2 < 68) GLA_LOAD(step + 2, u);
        f32x16 o = {};
        if (w < 4) {
            if (lat) {
                const bool n0 = dir ? (tb == 0) : true, n1 = dir ? true : (tb == 1);
                f32x16 sc0 = {}, sc1 = {};
#define GLA_BQ(ks) (*(const LAS bf16x8*)(lds + L_QS + (2 * (ks) + hh) * CH + (32 * tb + r) * 16))
#define GLA_A0(ks) (*(const LAS bf16x8*)(lds + L_KS + (2 * (ks) + hh) * CH + r * 16))
#define GLA_A1(ks) (*(const LAS bf16x8*)(lds + L_KS + (2 * (ks) + hh) * CH + (32 + r) * 16))
                if (n0 && n1) {
#pragma unroll
                    for (int ks = 0; ks < 8; ++ks) { const bf16x8 bq = GLA_BQ(ks); sc0 = __builtin_amdgcn_mfma_f32_32x32x16_bf16(GLA_A0(ks), bq, sc0, 0, 0, 0); sc1 = __builtin_amdgcn_mfma_f32_32x32x16_bf16(GLA_A1(ks), bq, sc1, 0, 0, 0); }
                } else if (n0) {
#pragma unroll
                    for (int ks = 0; ks < 8; ++ks) sc0 = __builtin_amdgcn_mfma_f32_32x32x16_bf16(GLA_A0(ks), GLA_BQ(ks), sc0, 0, 0, 0);
                } else {
#pragma unroll
                    for (int ks = 0; ks < 8; ++ks) sc1 = __builtin_amdgcn_mfma_f32_32x32x16_bf16(GLA_A1(ks), GLA_BQ(ks), sc1, 0, 0, 0);
                }
#undef GLA_BQ
#undef GLA_A0
#undef GLA_A1
                const int t = 32 * tb + r;
#pragma unroll
                for (int i = 0; i < 16; ++i) { const int s0 = crow(i, hh), s1 = 32 + s0; const bool k0 = dir ? (s0 >= t) : (s0 <= t), k1 = dir ? (s1 >= t) : (s1 <= t); sc0[i] = k0 ? sc0[i] : 0.f; sc1[i] = k1 ? sc1[i] : 0.f; }
#pragma unroll
                for (int sb = 0; sb < 2; ++sb) { if (sb == 0 ? n0 : n1) {
#pragma unroll
                    for (int sp = 0; sp < 2; ++sp) {
                        u32x4 pw;
                        if (sb == 0) { pw.x = pk(sc0[8 * sp + 0], sc0[8 * sp + 1]); pw.y = pk(sc0[8 * sp + 2], sc0[8 * sp + 3]); pw.z = pk(sc0[8 * sp + 4], sc0[8 * sp + 5]); pw.w = pk(sc0[8 * sp + 6], sc0[8 * sp + 7]); }
                        else { pw.x = pk(sc1[8 * sp + 0], sc1[8 * sp + 1]); pw.y = pk(sc1[8 * sp + 2], sc1[8 * sp + 3]); pw.z = pk(sc1[8 * sp + 4], sc1[8 * sp + 5]); pw.w = pk(sc1[8 * sp + 6], sc1[8 * sp + 7]); }
                        LAS const unsigned char* vp = lds + L_VS + trP + (4 * vb) * CH + (32 * sb + 16 * sp) * 16;
                        const s16x4 lo = trrd(vp), hi = trrd(vp + 8 * 16);
                        o = __builtin_amdgcn_mfma_f32_32x32x16_bf16(GLA_FR(lo, hi), __builtin_bit_cast(bf16x8, pw), o, 0, 0, 0);
                    } } }
            }
        } else {
            const int db = w - 4;
            if (lat) {
                f32x16 o2 = {};
#pragma unroll
                for (int ks = 0; ks < 8; ++ks) {
                    const bf16x8 as = *(const LAS bf16x8*)(lds + L_SB + (2 * ks + hh) * CH + (32 * vb + r) * 16);
                    const bf16x8 bq = *(const LAS bf16x8*)(lds + L_QS + (2 * ks + hh) * CH + (32 * tb + r) * 16);
                    o2 = __builtin_amdgcn_mfma_f32_32x32x16_bf16(as, bq, o2, 0, 0, 0);
                }
#pragma unroll
                for (int g = 0; g < 4; ++g) *(LAS f32x4*)(lds + L_X + (w & 3) * 4096 + g * 1024 + lane * 16) = (f32x4){o2[4 * g], o2[4 * g + 1], o2[4 * g + 2], o2[4 * g + 3]};
            }
#pragma unroll
            for (int ks = 0; ks < 4; ++ks) {
                LAS const unsigned char* kp = lds + L_KS + trN + (4 * db) * CH + (16 * ks) * 16;
                LAS const unsigned char* vp = lds + L_VS + trN + (16 * ks) * 16;
                const s16x4 al = trrd(kp), ah = trrd(kp + 4 * 16);
                const s16x4 b0l = trrd(vp), b0h = trrd(vp + 4 * 16), b1l = trrd(vp + 4 * CH), b1h = trrd(vp + 4 * CH + 4 * 16);
                S0 = __builtin_amdgcn_mfma_f32_32x32x16_bf16(GLA_FR(al, ah), GLA_FR(b0l, b0h), S0, 0, 0, 0); S1 = __builtin_amdgcn_mfma_f32_32x32x16_bf16(GLA_FR(al, ah), GLA_FR(b1l, b1h), S1, 0, 0, 0);
            }
#pragma unroll
            for (int i = 0; i < 16; ++i) { const float dc = *(const LAS float*)(lds + L_DEC + 4 * (32 * db + crow(i, hh))); S0[i] *= dc; S1[i] *= dc; }
        }
        __syncthreads();
        if (w < 4 && lat) {
            bf16* orow = OG + ((size_t)chunk * 64 + 32 * tb + r) * DM + 32 * vb + 4 * hh;
#pragma unroll
            for (int g = 0; g < 4; ++g) { const f32x4 x = *(const LAS f32x4*)(lds + L_X + w * 4096 + g * 1024 + lane * 16);
                u32x2 wv; wv.x = pk(o[4 * g] + x.x, o[4 * g + 1] + x.y); wv.y = pk(o[4 * g + 2] + x.z, o[4 * g + 3] + x.w); *(u32x2*)(orow + 8 * g) = wv; }
        }
        if (step + 1 < 68) {
            GLA_STORE(u ^ 1);
            if (w >= 4) { const int db = w - 4;
#pragma unroll
                for (int g = 0; g < 4; ++g) { u32x2 w0, w1; w0.x = pk(S0[4 * g], S0[4 * g + 1]); w0.y = pk(S0[4 * g + 2], S0[4 * g + 3]); w1.x = pk(S1[4 * g], S1[4 * g + 1]); w1.y = pk(S1[4 * g + 2], S1[4 * g + 3]);
                    *(LAS u32x2*)(lds + L_SB + (4 * db + g) * CH + r * 16 + 8 * hh) = w0; *(LAS u32x2*)(lds + L_SB + (4 * db + g) * CH + (32 + r) * 16 + 8 * hh) = w1; } }
        }
        __syncthreads();
    }
    }
#undef GLA_CHUNK
#undef GLA_LOAD
#undef GLA_STORE
}
#undef GLA_FR
}
__device__ __forceinline__ void phase_scan_opt(const Frame& F, const Prm& p) {
    for (int unit = vcu_of(F); unit < 256; unit += F.G) gla3::scan_unit(F, p, unit);
}
#define PHASE_QKV(F, p) phase_qkv_opt(F, p)
#define PHASE_ATTN(F, p) phase_attn2(F, p)
#define PHASE_WO(F, p, l) phase_wo_opt(F, p, l)
#define PHASE_MOE1(F, p, l) phase_moe1_opt(F, p, l)
#define PHASE_MOE2(F, p, l) phase_moe2_opt(F, p, l)
#define PHASE_INPROJ(F, p) phase_inproj_opt(F, p)
#define PHASE_SCAN(F, p) phase_scan_opt(F, p)
typedef GAS unsigned gu32;
#define XB_TMO      128
#define XB_XCNT(j)  (256  + 64 * (j))
#define XB_XSUB(j)  (1280 + 64 * (j))
#define XB_XGEN(j)  (2304 + 64 * (j))
#define XB_TOP      3328
#define XB_TOPGEN   3392
#define XCD_BAR_WORDS 3456
#define XB_SPIN_CAP (1u << 20)
__device__ __forceinline__ unsigned xb_ld(unsigned* p)              { return __hip_atomic_load(p, __ATOMIC_RELAXED, __HIP_MEMORY_SCOPE_AGENT); }
__device__ __forceinline__ unsigned xb_add(unsigned* p, unsigned v) { return __hip_atomic_fetch_add(p, v, __ATOMIC_RELAXED, __HIP_MEMORY_SCOPE_AGENT); }
__device__ __forceinline__ unsigned xb_xcc_id() { return (unsigned)__builtin_amdgcn_s_getreg((3 << 11) | 20) & 0xFu; }
#define XB_SPIN(cond, bar) do { unsigned _sp = 0; while (cond) { __builtin_amdgcn_s_sleep(1); \
    if ((++_sp & 255u) == 0u) { if (xb_ld(&(bar)[XB_TMO])) break; if (_sp > XB_SPIN_CAP) { atomicAdd(&(bar)[XB_TMO], 1u); break; } } } } while (0)
struct XcdBarrier { unsigned* bar; unsigned x; volatile LAS unsigned* st; };
__device__ __forceinline__ XcdBarrier xcd_barrier_post(unsigned* bar, volatile LAS unsigned* st) {
    XcdBarrier b; b.bar = bar; b.x = xb_xcc_id(); b.st = st;
    if (threadIdx.x == 0) (void)xb_add(&bar[XB_XCNT(b.x)], 1u);
    return b;
}
__device__ __forceinline__ void xcd_barrier_complete(unsigned* bar, unsigned x, unsigned& nloc, unsigned& nx) {
    const unsigned G = gridDim.x * gridDim.y * gridDim.z;
    unsigned sum, cnt, mine, sp = 0u;
    for (;;) {
        sum = 0u; cnt = 0u; mine = 0u;
#pragma unroll
        for (unsigned j = 0; j < 16; ++j) { const unsigned c = xb_ld(&bar[XB_XCNT(j)]); sum += c; cnt += (c > 0u) ? 1u : 0u; mine = (j == x) ? c : mine; }
        if (sum == G) break;
        __builtin_amdgcn_s_sleep(1);
        if ((++sp & 255u) == 0u) { if (xb_ld(&bar[XB_TMO])) break; if (sp > XB_SPIN_CAP) { atomicAdd(&bar[XB_TMO], 1u); break; } }
    }
    nloc = mine > 0u ? mine : 1u; nx = cnt > 0u ? cnt : 1u;
}
__device__ __forceinline__ void xcd_barrier(const XcdBarrier& b) {
    asm volatile("s_waitcnt vmcnt(0)" ::: "memory");
    __syncthreads();
    if (threadIdx.x == 0) {
        unsigned* bar = b.bar;
        __builtin_amdgcn_s_waitcnt(0);
        unsigned nloc = b.st[0], nx = b.st[1];
        if (nloc == 0u) { xcd_barrier_complete(bar, b.x, nloc, nx); b.st[0] = nloc; b.st[1] = nx; }
        const unsigned old = xb_add(&bar[XB_XSUB(b.x)], 1u);
        const unsigned gen = old / nloc;
        if (old + 1u == (gen + 1u) * nloc) {
            __builtin_amdgcn_fence(__ATOMIC_RELEASE, "agent");
            asm volatile("s_waitcnt vmcnt(0)" ::: "memory");
            const unsigned og = xb_add(&bar[XB_TOP], 1u);
            const unsigned tg = og / nx;
            if (og + 1u == (tg + 1u) * nx) xb_add(&bar[XB_TOPGEN], 1u);
            else XB_SPIN(xb_ld(&bar[XB_TOPGEN]) == tg, bar);
            __builtin_amdgcn_fence(__ATOMIC_ACQUIRE, "agent");
            xb_add(&bar[XB_XGEN(b.x)], 1u);
            asm volatile("s_waitcnt vmcnt(0)" ::: "memory");
        } else {
            XB_SPIN(xb_ld(&bar[XB_XGEN(b.x)]) == gen, bar);
            __builtin_amdgcn_fence(__ATOMIC_ACQUIRE, "agent");
            asm volatile("s_waitcnt vmcnt(0)" ::: "memory");
        }
    }
    __syncthreads();
}

constexpr int NPHASE = 19;
#ifndef OPT_MASK
#define OPT_MASK 0u
#endif
__global__ void __launch_bounds__(NTHR, 2) mega_fwd(Prm p) {
    extern __shared__ __attribute__((aligned(16))) unsigned char lds[];
    Frame F; F.lds = lds; F.ctl = (unsigned*)(p.ws + WS_CTL);
    F.tid = threadIdx.x; F.lane = F.tid & 63; F.wave = __builtin_amdgcn_readfirstlane(F.tid >> 6); F.G = gridDim.x; F.bid = blockIdx.x;
    for (int u = F.tid; u < (LDS_BYTES - LDSCTL_OFF) / 4; u += NTHR) ((LAS unsigned*)(lds + LDSCTL_OFF))[u] = 0u;
    __syncthreads();
    const int lo = p.ph_lo, hi = p.ph_hi;
    const bool multi = (hi - lo) > 1;
    XcdBarrier bar; bar.bar = F.ctl + CW_BAR + p.li * XCD_BAR_WORDS; bar.x = 0; bar.st = nullptr;
    if (multi) bar = xcd_barrier_post(F.ctl + CW_BAR + p.li * XCD_BAR_WORDS, (volatile LAS unsigned*)(lds + MISC_OFF) + 8);
#define IN(k) (lo <= (k) && (k) < hi)
#define SEAM(k) do { if (IN(k) && IN((k) + 1)) xcd_barrier(bar); } while (0)
#ifndef REP_MASK
#define REP_MASK 0u
#endif
#define REP(k, call) do { if (((REP_MASK) >> (k)) & 1u) { xcd_barrier(bar); call; } } while (0)
    if (IN(0)) { phase_prologue(F, p); REP(0, phase_prologue(F, p)); } SEAM(0);
    if (IN(1)) { phase_modulate0(F, p); REP(1, phase_modulate0(F, p)); } SEAM(1);
    if (IN(2)) { PHASE_QKV(F, p); REP(2, PHASE_QKV(F, p)); } SEAM(2);
    if (IN(3)) { PHASE_ATTN(F, p); REP(3, PHASE_ATTN(F, p)); } SEAM(3);
    if (IN(4)) { phase_attn_combine(F, p); REP(4, phase_attn_combine(F, p)); } SEAM(4);
    if (IN(5)) { PHASE_WO(F, p, 0); REP(5, PHASE_WO(F, p, 0)); } SEAM(5);
    if (IN(6)) { phase_ln_route(F, p, 0); REP(6, phase_ln_route(F, p, 0)); } SEAM(6);
    if (IN(7)) { PHASE_MOE1(F, p, 0); REP(7, PHASE_MOE1(F, p, 0)); } SEAM(7);
    if (IN(8)) { PHASE_MOE2(F, p, 0); REP(8, PHASE_MOE2(F, p, 0)); } SEAM(8);
    if (IN(9)) { phase_moe_combine(F, p, 0); REP(9, phase_moe_combine(F, p, 0)); } SEAM(9);
    if (IN(10)) { PHASE_INPROJ(F, p); REP(10, PHASE_INPROJ(F, p)); } SEAM(10);
    if (IN(11)) { phase_gla_prep(F, p); REP(11, phase_gla_prep(F, p)); } SEAM(11);
    if (IN(12)) { PHASE_SCAN(F, p); REP(12, PHASE_SCAN(F, p)); } SEAM(12);
    if (IN(13)) { phase_gla_post(F, p); REP(13, phase_gla_post(F, p)); } SEAM(13);
    if (IN(14)) { PHASE_WO(F, p, 1); REP(14, PHASE_WO(F, p, 1)); } SEAM(14);
    if (IN(15)) { phase_ln_route(F, p, 1); REP(15, phase_ln_route(F, p, 1)); } SEAM(15);
    if (IN(16)) { PHASE_MOE1(F, p, 1); REP(16, PHASE_MOE1(F, p, 1)); } SEAM(16);
    if (IN(17)) { PHASE_MOE2(F, p, 1); REP(17, PHASE_MOE2(F, p, 1)); } SEAM(17);
    if (IN(18)) { phase_moe_combine(F, p, 1); REP(18, phase_moe_combine(F, p, 1)); }
#undef IN
#undef SEAM
}

static void launch_naive(int ph, const Prm& p, hipStream_t stream) {
    using namespace naive;
    const bf16* H = (const bf16*)(p.ws + WS_H);
    switch (ph) {
    case 2: { NG g{H, (const bf16*)(p.ws + WS_WQKV), NTOK, 3072, 1024, 0, nullptr}; hipLaunchKernelGGL(gemm_kernel<EPI_QKV>, dim3(3072 / 64, NTOK / 64), dim3(256), 0, stream, g, p); break; }
    case 3: hipLaunchKernelGGL(attn_kernel, dim3(544, 16), dim3(256), 0, stream, p); break;
    case 5: { NG g{(const bf16*)(p.ws + WS_A2), (const bf16*)(p.ws + WS_WO), NTOK, 1024, 1024, 0, (bf16*)(p.ws + WS_Y)}; hipLaunchKernelGGL(gemm_kernel<EPI_PLAIN>, dim3(16, NTOK / 64), dim3(256), 0, stream, g, p); break; }
    case 7: case 16: { const int l = ph == 16; NG g{H, (const bf16*)(p.ws + (l ? WS_GU1 : WS_GU0)), MAXSLOT, 1024, 1024, l, nullptr}; hipLaunchKernelGGL(gemm_kernel<EPI_GATEUP>, dim3(16, MAXSLOT / 64), dim3(256), 0, stream, g, p); break; }
    case 8: case 17: { const int l = ph == 17; NG g{(const bf16*)(p.ws + WS_ACT), (const bf16*)(p.ws + (l ? WS_DN1 : WS_DN0)), MAXSLOT, 1024, 512, l, nullptr}; hipLaunchKernelGGL(gemm_kernel<EPI_DOWN>, dim3(16, MAXSLOT / 64), dim3(256), 0, stream, g, p); break; }
    case 10: { NG g{H, (const bf16*)(p.ws + WS_WIN), NTOK, NIN, 1024, 0, nullptr}; hipLaunchKernelGGL(gemm_kernel<EPI_INPROJ>, dim3(NIN / 64, NTOK / 64), dim3(256), 0, stream, g, p); break; }
    case 12: hipLaunchKernelGGL(gla_scan_kernel, dim3(512), dim3(256), GLA_SCAN_LDS, stream, p); break;
    case 14: { NG g{(const bf16*)(p.ws + WS_A2B), (const bf16*)(p.ws + WS_WGO), NLAT, 1024, 1024, 0, (bf16*)(p.ws + WS_Y)}; hipLaunchKernelGGL(gemm_kernel<EPI_PLAIN>, dim3(16, NLAT / 64), dim3(256), 0, stream, g, p); break; }
    default: break;
    }
}
extern "C" void kernel_launch(void* const* d_in, const int* in_sizes, int n_in, void* d_out, int out_size, void* d_ws, size_t ws_size, hipStream_t stream) {
    static int grid = 0;
    if (grid == 0) {
        if (n_in != 23 || in_sizes[0] != NLAT * DM || out_size != NLAT * DM || ws_size < WS_END) { fprintf(stderr, "kernel_launch: unexpected shapes (n_in %d, in0 %d, out %d, ws %zu); nothing launched\n", n_in, n_in > 0 ? in_sizes[0] : -1, out_size, ws_size); grid = -1; return; }
        int dev = 0, cus = 0;
        if (hipGetDevice(&dev) != hipSuccess || hipDeviceGetAttribute(&cus, hipDeviceAttributeMultiprocessorCount, dev) != hipSuccess) { grid = -1; return; }
        if (hipFuncSetAttribute((const void*)mega_fwd, hipFuncAttributeMaxDynamicSharedMemorySize, LDS_BYTES) != hipSuccess) { fprintf(stderr, "kernel_launch: hipFuncSetAttribute failed\n"); grid = -1; return; }
        (void)hipFuncSetAttribute((const void*)naive::gla_scan_kernel, hipFuncAttributeMaxDynamicSharedMemorySize, naive::GLA_SCAN_LDS);
        int per_cu = 0;
        if (hipOccupancyMaxActiveBlocksPerMultiprocessor(&per_cu, (const void*)mega_fwd, NTHR, LDS_BYTES) != hipSuccess || per_cu < 1) fprintf(stderr, "kernel_launch: note: occupancy query reports %d\n", per_cu);
        (void)hipGetLastError();
        grid = cus;
    }
    if (grid < 0) return;
    (void)hipMemsetAsync((char*)d_ws + WS_CTL, 0, CTL_ZERO_BYTES, stream);
    Prm p{};
    const float** pp = (const float**)&p;
    for (int i = 0; i < 23; ++i) pp[i] = (const float*)d_in[i];
    p.out = (float*)d_out; p.ws = (unsigned char*)d_ws;
    const unsigned naive_phases = (1u << 2) | (1u << 3) | (1u << 5) | (1u << 7) | (1u << 8) | (1u << 10) | (1u << 12) | (1u << 14) | (1u << 16) | (1u << 17);
    const unsigned use_naive = naive_phases & ~(unsigned)(OPT_MASK);
    int ph = 0, li = 0;
    while (ph < NPHASE) {
        if (use_naive & (1u << ph)) { launch_naive(ph, p, stream); ++ph; continue; }
        int e = ph + 1;
#if defined(ONE_PER_PHASE)
#else
        while (e < NPHASE && !(use_naive & (1u << e))) ++e;
#endif
        p.ph_lo = ph; p.ph_hi = e; p.li = li++;
        hipLaunchKernelGGL(mega_fwd, dim3(grid), dim3(NTHR), LDS_BYTES, stream, p);
        ph = e;
    }
}
```

```cpp
#define OPT_MASK 0x355ACu
#include <hip/hip_runtime.h>
#include <cstdint>
#include <cstdio>

constexpr int BATCH = 8, SEQ = 4096, DM = 1024, CTXL = 256;
constexpr int NLAT = BATCH * SEQ, NCTX = BATCH * CTXL, NTOK = NLAT + NCTX;
constexpr float ALPHA = 1.4142135623730951f;
constexpr float LN_EPS = 1e-5f;
constexpr float LAMBDA_INIT0 = 0.2f;
constexpr float C2 = 0.125f * 1.4426950408889634f;
constexpr int NEXP = 16, DEXP = 512, MAXSLOT = 73728;
constexpr int NCHUNK = NTOK / 64;
constexpr int NIN = 3328;

typedef unsigned short bf16;
typedef float f32x4 __attribute__((ext_vector_type(4)));
typedef float f32x2 __attribute__((ext_vector_type(2)));
typedef unsigned u32x2 __attribute__((ext_vector_type(2)));
typedef unsigned u32x4 __attribute__((ext_vector_type(4)));

constexpr size_t MiB = 1u << 20;
constexpr size_t WS_CTL = 0, CTL_ZERO_BYTES = 1 * MiB;
constexpr size_t WS_MOD = 1 * MiB;
constexpr size_t WS_MISC = 1 * MiB + 512 * 1024;
constexpr size_t WS_WQKV = 2 * MiB, WS_WO = 8 * MiB, WS_GU0 = 10 * MiB, WS_DN0 = 42 * MiB;
constexpr size_t WS_XCTX = 58 * MiB;
constexpr size_t WS_WIN = 66 * MiB, WS_WGO = 73 * MiB, WS_GU1 = 75 * MiB, WS_DN1 = 107 * MiB;
constexpr size_t WS_H = 123 * MiB;
constexpr size_t WS_Q = 191 * MiB, WS_K = 259 * MiB, WS_V = 327 * MiB, WS_O2 = 395 * MiB;
constexpr size_t WS_LIST = 463 * MiB;
constexpr size_t WS_TOKR = 466 * MiB;
constexpr size_t WS_DEC = 468 * MiB;
constexpr size_t WS_ZZ = 471 * MiB;
constexpr size_t WS_END = 480 * MiB;
constexpr size_t WS_O1 = WS_H, WS_A2 = WS_Q, WS_Y = WS_K;
constexpr size_t WS_YM = 191 * MiB, WS_ACT = 335 * MiB;
constexpr size_t WS_QR = 191 * MiB, WS_KR = 225 * MiB, WS_V1 = 259 * MiB, WS_R = 327 * MiB;
constexpr size_t WS_QT = WS_H, WS_KT = 395 * MiB;
constexpr size_t WS_OGF = 191 * MiB, WS_OGB = 2 * MiB;
constexpr size_t WS_A2B = WS_H;
constexpr int CW_TMO = 0, CW_CODE = 1;
constexpr int CW_CNT = 64;
constexpr int CW_BAR = 4096;

__device__ __forceinline__ unsigned f2bf(float f) { unsigned u = __builtin_bit_cast(unsigned, f); return (u + 0x7fffu + ((u >> 16) & 1u)) >> 16; }
__device__ __forceinline__ unsigned pk2(float lo, float hi) { return f2bf(lo) | (f2bf(hi) << 16); }
__device__ __forceinline__ float bf2f(unsigned b) { return __builtin_bit_cast(float, b << 16); }
__device__ __forceinline__ float wave_sum(float v) {
#pragma unroll
    for (int o = 1; o < 64; o <<= 1) v += __shfl_xor(v, o);
    return v;
}
__device__ __forceinline__ float silu_f(float v) { return v / (1.f + __expf(-v)); }

struct Prm {
    const float *x, *c, *ctx, *cctx, *ada_w, *ada_b, *ln_g, *ln_b, *w_qkv, *w_o, *lam, *subln, *gw_in, *gwg_down, *gwg_up, *gbg, *gnorm, *gw_o, *rw, *rb, *mg, *mu, *md;
    float* out; unsigned char* ws;
    int ph_lo, ph_hi, li, pad;
};
__device__ __forceinline__ void ld_row_f32(const float* p, int lane, f32x4 (&v)[4]) {
#pragma unroll
    for (int j = 0; j < 4; ++j) v[j] = *(const f32x4*)(p + 4 * lane + 256 * j);
}
__device__ __forceinline__ void st_row_f32(float* p, int lane, const f32x4 (&v)[4]) {
#pragma unroll
    for (int j = 0; j < 4; ++j) *(f32x4*)(p + 4 * lane + 256 * j) = v[j];
}
__device__ __forceinline__ void ld_row_bf16(const bf16* p, int lane, f32x4 (&v)[4]) {
#pragma unroll
    for (int j = 0; j < 4; ++j) { const u32x2 u = *(const u32x2*)(p + 4 * lane + 256 * j); v[j] = (f32x4){bf2f(u.x & 0xffffu), bf2f(u.x >> 16), bf2f(u.y & 0xffffu), bf2f(u.y >> 16)}; }
}
__device__ __forceinline__ void st_row_bf16(bf16* p, int lane, const f32x4 (&v)[4]) {
#pragma unroll
    for (int j = 0; j < 4; ++j) { u32x2 u; u.x = pk2(v[j].x, v[j].y); u.y = pk2(v[j].z, v[j].w); *(u32x2*)(p + 4 * lane + 256 * j) = u; }
}
__device__ __forceinline__ void ln_row(f32x4 (&v)[4], const float* g, const float* b, int lane) {
    float s = 0.f;
#pragma unroll
    for (int j = 0; j < 4; ++j) s += (v[j].x + v[j].y) + (v[j].z + v[j].w);
    const float mean = wave_sum(s) * (1.f / DM); float q = 0.f;
#pragma unroll
    for (int j = 0; j < 4; ++j) { v[j] = v[j] - mean; q += (v[j].x * v[j].x + v[j].y * v[j].y) + (v[j].z * v[j].z + v[j].w * v[j].w); }
    const float rstd = 1.f / sqrtf(wave_sum(q) * (1.f / DM) + LN_EPS);
#pragma unroll
    for (int j = 0; j < 4; ++j) { const f32x4 gg = *(const f32x4*)(g + 4 * lane + 256 * j), bb = *(const f32x4*)(b + 4 * lane + 256 * j); v[j] = v[j] * rstd * gg + bb; }
}
__host__ __device__ __forceinline__ int gu_phys(int other, int sel) { return (other >> 4) * 32 + sel * 16 + (other & 15); }
__host__ __device__ __forceinline__ int perm16b(int L) { return (L & ~31) | (16 * ((L >> 2) & 1) + 4 * ((L >> 3) & 3) + (L & 3)); }
__host__ __device__ __forceinline__ int perm16b_inv(int P) { return (P & ~31) | (8 * ((P >> 2) & 3) + 4 * ((P >> 4) & 1) + (P & 3)); }
__device__ __forceinline__ unsigned pk4_fp8(float a, float b, float c, float d) { int w = 0; w = __builtin_amdgcn_cvt_pk_fp8_f32(a, b, w, false); w = __builtin_amdgcn_cvt_pk_fp8_f32(c, d, w, true); return (unsigned)w; }
constexpr float W8_SCALE = 64.f, W8_INV = 1.f / 64.f;
__device__ __forceinline__ void st_row_fp8(unsigned char* p, int lane, const f32x4 (&v)[4]) {
#pragma unroll
    for (int j = 0; j < 4; ++j) *(unsigned*)(p + 4 * lane + 256 * j) = pk4_fp8(v[j].x, v[j].y, v[j].z, v[j].w);
}
#define GAS __attribute__((address_space(1)))
#define LAS __attribute__((address_space(3)))
constexpr int NWAVES = 8, NTHR = NWAVES * 64;
constexpr int RING_BYTES = 131072, LDSCTL_OFF = RING_BYTES, MISC_OFF = LDSCTL_OFF + 320, LDS_BYTES = 147456;
constexpr int LDSX_OFF = RING_BYTES + 1024;
#define LDS_WAIT() asm volatile("s_waitcnt lgkmcnt(0)" ::: "memory")
#define VM_WAIT() asm volatile("s_waitcnt vmcnt(0)" ::: "memory")

struct Frame {
    unsigned char* lds;
    unsigned* ctl;
    int tid, lane, wave, G, bid;
};

template <int MODE>
__device__ __forceinline__ void p0_transpose_item(const float* W, int K, int N, bf16* WT, int row_off, float* scr, int item, int lane) {
    const int nblk = N / 32, kb = item / nblk, nb = item % nblk, k0 = 64 * kb, n0 = 32 * nb;
#pragma unroll 8
    for (int i = 0; i < 32; ++i) { const int kk = 2 * i + (lane >> 5); scr[kk * 33 + (lane & 31)] = W[(size_t)(k0 + kk) * N + n0 + (lane & 31)]; }
    LDS_WAIT(); asm volatile("" ::: "memory");
    const int c = lane & 7;
#pragma unroll
    for (int j = 0; j < 4; ++j) { const int n = (lane >> 3) + 8 * j; const float* s = scr + (8 * c) * 33 + n;
        u32x4 o; o.x = pk2(s[0 * 33], s[1 * 33]); o.y = pk2(s[2 * 33], s[3 * 33]); o.z = pk2(s[4 * 33], s[5 * 33]); o.w = pk2(s[6 * 33], s[7 * 33]);
        const int nl = n0 + n; const int pr = (MODE == 0) ? (row_off + nl) : (MODE == 3) ? (row_off + perm16b(nl)) : (row_off + gu_phys(nl, MODE - 1));
        *(u32x4*)(WT + (size_t)pr * K + k0 + 8 * c) = o; }
    LDS_WAIT(); asm volatile("" ::: "memory");
}
template <int MODE>
__device__ __forceinline__ void p0_transpose_item8(const float* W, int K, int N, unsigned char* WT, float* scr, int item, int lane) {
    const int nblk = N / 32, kb = item / nblk, nb = item % nblk, k0 = 64 * kb, n0 = 32 * nb;
#pragma unroll 8
    for (int i = 0; i < 32; ++i) { const int kk = 2 * i + (lane >> 5); scr[kk * 33 + (lane & 31)] = W[(size_t)(k0 + kk) * N + n0 + (lane & 31)]; }
    LDS_WAIT(); asm volatile("" ::: "memory");
    const int c = lane & 7;
#pragma unroll
    for (int j = 0; j < 4; ++j) { const int n = (lane >> 3) + 8 * j; const float* s = scr + (8 * c) * 33 + n;
        u32x2 o; o.x = pk4_fp8(s[0 * 33] * W8_SCALE, s[1 * 33] * W8_SCALE, s[2 * 33] * W8_SCALE, s[3 * 33] * W8_SCALE); o.y = pk4_fp8(s[4 * 33] * W8_SCALE, s[5 * 33] * W8_SCALE, s[6 * 33] * W8_SCALE, s[7 * 33] * W8_SCALE);
        const int nl = n0 + n; const int pr = (MODE == 3) ? perm16b(nl) : (MODE == 0) ? nl : gu_phys(nl, MODE - 1);
        *(u32x2*)(WT + (size_t)pr * K + k0 + 8 * c) = o; }
    LDS_WAIT(); asm volatile("" ::: "memory");
}
__device__ __forceinline__ void phase_prologue(const Frame& F, const Prm& p) {
    float* sil = (float*)F.lds;
    for (int i = F.tid; i < 9 * 1024; i += NTHR) { const int r = i >> 10, k = i & 1023; const float v = (r < 8) ? p.c[r * 1024 + k] : p.cctx[k]; sil[i] = silu_f(v); }
    __syncthreads();
    float* MOD = (float*)(p.ws + WS_MOD);
    if (F.bid < 192) {
        const int layer = F.bid / 96, n = (F.bid % 96) * 64 + F.lane; const float* W = p.ada_w + (size_t)layer * 1024 * 6144 + n;
        float acc[9];
#pragma unroll
        for (int r = 0; r < 9; ++r) acc[r] = 0.f;
        const int kb = F.wave * 128;
#pragma unroll 4
        for (int k = kb; k < kb + 128; k += 4) {
            const float w0 = W[(size_t)k * 6144], w1 = W[(size_t)(k + 1) * 6144], w2 = W[(size_t)(k + 2) * 6144], w3 = W[(size_t)(k + 3) * 6144];
#pragma unroll
            for (int r = 0; r < 9; ++r) { const f32x4 s = *(const f32x4*)(sil + r * 1024 + k); acc[r] += s.x * w0 + s.y * w1 + s.z * w2 + s.w * w3; }
        }
        float* red = (float*)(F.lds + 36864 + 8 * 8704);
#pragma unroll
        for (int r = 0; r < 9; ++r) red[(F.wave * 9 + r) * 64 + F.lane] = acc[r];
        __syncthreads();
        if (F.wave == 0) { const float bb = p.ada_b[layer * 6144 + n];
#pragma unroll
            for (int r = 0; r < 9; ++r) { float t = bb;
#pragma unroll
                for (int w = 0; w < 8; ++w) t += red[(w * 9 + r) * 64 + F.lane];
                MOD[(layer * 9 + r) * 6144 + n] = t; } }
    }
    float* misc = (float*)(p.ws + WS_MISC);
    if (F.bid == 255 % F.G && F.wave == 1) {
        const float a = wave_sum(p.lam[F.lane] * p.lam[64 + F.lane]), b = wave_sum(p.lam[128 + F.lane] * p.lam[192 + F.lane]);
        if (F.lane == 0) misc[0] = __expf(a) - __expf(b) + LAMBDA_INIT0;
        for (int i = F.lane; i < 1024; i += 64) { const int pos = i >> 4, f = i & 15; const float inv = powf(10000.f, -(float)f / 16.f); const float ang = (float)pos * inv;
            misc[1024 + 2 * i] = cosf(ang); misc[1024 + 2 * i + 1] = sinf(ang); }
    }
    float* scr = (float*)(F.lds + 36864 + F.wave * 8704);
    const int gw = F.bid * NWAVES + F.wave, NGW = F.G * NWAVES;
    constexpr int I_QKV = 16 * 96, I_SQ = 16 * 32, I_G = 16 * 16, I_D = 8 * 32;
    constexpr int I_MOE = 2 * I_G + I_D;
    constexpr int NITEMS = 2 * I_QKV + 2 * I_SQ + 32 * I_MOE;
    bf16* ws16 = (bf16*)p.ws;
    for (int it = gw; it < NITEMS; it += NGW) {
        int r = it;
        if (r < I_QKV) { if ((r % 96) < 64) p0_transpose_item<0>(p.w_qkv, 1024, 3072, (bf16*)(p.ws + WS_WQKV), 0, scr, r, F.lane); else p0_transpose_item<3>(p.w_qkv, 1024, 3072, (bf16*)(p.ws + WS_WQKV), 0, scr, r, F.lane); continue; } r -= I_QKV;
        if (r < I_QKV) { p0_transpose_item8<3>(p.gw_in, 1024, 3072, p.ws + WS_WIN, scr, r, F.lane); continue; } r -= I_QKV;
        if (r < I_SQ) { p0_transpose_item<3>(p.w_o, 1024, 1024, (bf16*)(p.ws + WS_WO), 0, scr, r, F.lane); continue; } r -= I_SQ;
        if (r < I_SQ) { p0_transpose_item8<3>(p.gw_o, 1024, 1024, p.ws + WS_WGO, scr, r, F.lane); continue; } r -= I_SQ;
        const int le = r / I_MOE, layer = le >> 4, e = le & 15; r -= le * I_MOE;
        unsigned char* GU = p.ws + (layer ? WS_GU1 : WS_GU0) + (size_t)e * 1024 * 1024; unsigned char* DN = p.ws + (layer ? WS_DN1 : WS_DN0) + (size_t)e * 1024 * 512;
        if (r < I_G) { p0_transpose_item8<1>(p.mg + (size_t)le * 1024 * 512, 1024, 512, GU, scr, r, F.lane); continue; } r -= I_G;
        if (r < I_G) { p0_transpose_item8<2>(p.mu + (size_t)le * 1024 * 512, 1024, 512, GU, scr, r, F.lane); continue; } r -= I_G;
        p0_transpose_item8<3>(p.md + (size_t)le * 512 * 1024, 512, 1024, DN, scr, r, F.lane);
    }
    (void)ws16;
    unsigned char* WIN = p.ws + WS_WIN;
    for (int i = gw * 64 + F.lane; i < 32 * 256; i += NGW * 64) { const int rr = i >> 8, k = (i & 255) * 4, dir = rr >> 4, j = rr & 15; const float* s = p.gwg_down + (size_t)dir * 1024 * 16 + j;
        *(unsigned*)(WIN + (size_t)(3072 + rr) * 1024 + k) = pk4_fp8(s[(size_t)k * 16] * W8_SCALE, s[(size_t)(k + 1) * 16] * W8_SCALE, s[(size_t)(k + 2) * 16] * W8_SCALE, s[(size_t)(k + 3) * 16] * W8_SCALE); }
    for (int i = gw * 64 + F.lane; i < 224 * 1024 / 16; i += NGW * 64) *(u32x4*)(WIN + (size_t)3104 * 1024 + (size_t)i * 16) = (u32x4){0u, 0u, 0u, 0u};
}

__device__ __forceinline__ void phase_modulate0(const Frame& F, const Prm& p) {
    const float* MOD = (const float*)(p.ws + WS_MOD); bf16* H = (bf16*)(p.ws + WS_H);
    const int gw = F.bid * NWAVES + F.wave, NGW = F.G * NWAVES, per = (NTOK + NGW - 1) / NGW;
    int curmod = -1; f32x4 sh[4], sc[4];
    for (int tok = gw * per; tok < (gw + 1) * per && tok < NTOK; ++tok) {
        const int mr = tok < NLAT ? tok / SEQ : 8; const float* src = tok < NLAT ? p.x + (size_t)tok * DM : p.ctx + (size_t)(tok - NLAT) * DM;
        if (mr != curmod) { curmod = mr; ld_row_f32(MOD + mr * 6144, F.lane, sh); ld_row_f32(MOD + mr * 6144 + 1024, F.lane, sc); }
        f32x4 v[4]; ld_row_f32(src, F.lane, v);
#pragma unroll
        for (int j = 0; j < 4; ++j) v[j] = v[j] * (1.f + sc[j]) + sh[j];
        st_row_bf16(H + (size_t)tok * DM, F.lane, v);
    }
}

__device__ __forceinline__ void phase_attn_combine(const Frame& F, const Prm& p) {
    const bf16* O1 = (const bf16*)(p.ws + WS_O1); const bf16* O2 = (const bf16*)(p.ws + WS_O2); bf16* A2 = (bf16*)(p.ws + WS_A2);
    const float lam = ((const float*)(p.ws + WS_MISC))[0];
    const f32x4 sg = *(const f32x4*)(p.subln + 4 * (F.lane & 31));
    const int gw = F.bid * NWAVES + F.wave, NGW = F.G * NWAVES;
    for (int tok = gw; tok < NTOK; tok += NGW) {
        f32x4 a[4], b[4]; ld_row_bf16(O1 + (size_t)tok * DM, F.lane, a); ld_row_bf16(O2 + (size_t)tok * DM, F.lane, b);
#pragma unroll
        for (int j = 0; j < 4; ++j) {
            f32x4 o = a[j] - lam * b[j]; float q = (o.x * o.x + o.y * o.y) + (o.z * o.z + o.w * o.w);
#pragma unroll
            for (int s = 1; s < 32; s <<= 1) q += __shfl_xor(q, s);
            const float r = (1.f - LAMBDA_INIT0) / sqrtf(q * (1.f / 128.f) + LN_EPS);
            a[j] = o * r * sg;
        }
        st_row_bf16(A2 + (size_t)tok * DM, F.lane, a);
    }
}

__device__ __forceinline__ void phase_ln_route(const Frame& F, const Prm& p, int layer) {
    const int nrows = layer ? NLAT : NTOK;
    const float* MOD = (const float*)(p.ws + WS_MOD) + layer * 9 * 6144;
    const bf16* Y = (const bf16*)(p.ws + WS_Y); unsigned char* HF = p.ws + WS_H;
    float* XCTX = (float*)(p.ws + WS_XCTX);
    int* LIST = (int*)(p.ws + WS_LIST); int* TOKR = (int*)(p.ws + WS_TOKR);
    unsigned* CNT = F.ctl + CW_CNT + layer * 16;
    float* WrT = (float*)F.lds;
    int* rec = (int*)(F.lds + 65536);
    unsigned* lcnt = (unsigned*)(F.lds + 65536 + 8192); unsigned* lbase = lcnt + 16;
    for (int i = F.tid; i < 16 * 1024; i += NTHR) { const int k = i >> 4, e = i & 15; WrT[e * 1024 + k] = p.rw[i]; }
    if (F.tid < 16) lcnt[F.tid] = 0u;
    __syncthreads();
    const int per_wg = (nrows + F.G - 1) / F.G, per_w = (per_wg + NWAVES - 1) / NWAVES;
    const int row_lo = F.bid * per_wg, row_hi = min(nrows, row_lo + per_wg);
    const float* lng = p.ln_g + (layer * 2 + 0) * DM; const float* lnb = p.ln_b + (layer * 2 + 0) * DM;
    float rb[16];
#pragma unroll
    for (int e = 0; e < 16; ++e) rb[e] = p.rb[e];
    int curmod = -1; f32x4 gm[4], shf[4], scf[4];
    for (int i = 0; i < per_w; ++i) {
        const int lr = F.wave * per_w + i, tok = row_lo + lr; if (tok >= row_hi) break;
        const int mr = tok < NLAT ? tok / SEQ : 8;
        if (mr != curmod) { curmod = mr; ld_row_f32(MOD + mr * 6144 + 2048, F.lane, gm); ld_row_f32(MOD + mr * 6144 + 3072, F.lane, shf); ld_row_f32(MOD + mr * 6144 + 4096, F.lane, scf); }
        float* xdst = tok < NLAT ? p.out + (size_t)tok * DM : XCTX + (size_t)(tok - NLAT) * DM;
        const float* xsrc = layer ? (const float*)xdst : (tok < NLAT ? p.x + (size_t)tok * DM : p.ctx + (size_t)(tok - NLAT) * DM);
        f32x4 v[4], y[4]; ld_row_f32(xsrc, F.lane, v); ld_row_bf16(Y + (size_t)tok * DM, F.lane, y);
#pragma unroll
        for (int j = 0; j < 4; ++j) v[j] = ALPHA * v[j] + gm[j] * y[j];
        ln_row(v, lng, lnb, F.lane);
        st_row_f32(xdst, F.lane, v);
#pragma unroll
        for (int j = 0; j < 4; ++j) v[j] = v[j] * (1.f + scf[j]) + shf[j];
        st_row_fp8(HF + (size_t)tok * DM, F.lane, v);
        float part[16];
#pragma unroll
        for (int e = 0; e < 16; ++e) { float s = 0.f;
#pragma unroll
            for (int j = 0; j < 4; ++j) { const f32x4 w = *(const f32x4*)(WrT + e * 1024 + 4 * F.lane + 256 * j); s += (v[j].x * w.x + v[j].y * w.y) + (v[j].z * w.z + v[j].w * w.w); }
            part[e] = s; }
        {
#pragma unroll
            for (int e = 0; e < 8; ++e) { const bool up = (F.lane & 32) != 0; const float keep = up ? part[e + 8] : part[e], send = up ? part[e] : part[e + 8]; part[e] = keep + __shfl_xor(send, 32); }
#pragma unroll
            for (int e = 0; e < 4; ++e) { const bool up = (F.lane & 16) != 0; const float keep = up ? part[e + 4] : part[e], send = up ? part[e] : part[e + 4]; part[e] = keep + __shfl_xor(send, 16); }
#pragma unroll
            for (int e = 0; e < 2; ++e) { const bool up = (F.lane & 8) != 0; const float keep = up ? part[e + 2] : part[e], send = up ? part[e] : part[e + 2]; part[e] = keep + __shfl_xor(send, 8); }
            { const bool up = (F.lane & 4) != 0; const float keep = up ? part[1] : part[0], send = up ? part[0] : part[1]; part[0] = keep + __shfl_xor(send, 4); }
            part[0] += __shfl_xor(part[0], 2); part[0] += __shfl_xor(part[0], 1);
        }
        float aff[16], sel[16];
#pragma unroll
        for (int e = 0; e < 16; ++e) { const int src = ((e >> 3) & 1) * 32 + ((e >> 2) & 1) * 16 + ((e >> 1) & 1) * 8 + (e & 1) * 4; const float lg = __shfl(part[0], src); aff[e] = 1.f / (1.f + __expf(-lg)); sel[e] = aff[e] + rb[e]; }
        int bg = 0; float bgs = -3.0e38f;
#pragma unroll
        for (int g = 0; g < 4; ++g) { float m1 = -3.0e38f, m2 = -3.0e38f;
#pragma unroll
            for (int k = 0; k < 4; ++k) { const float s = sel[4 * g + k]; if (s > m1) { m2 = m1; m1 = s; } else if (s > m2) m2 = s; }
            const float gs = m1 + m2; if (gs > bgs) { bgs = gs; bg = g; } }
        int i1 = 0, i2 = 0; float s1 = -3.0e38f, s2 = -3.0e38f, a1 = 0.f, a2 = 0.f;
#pragma unroll
        for (int g = 0; g < 4; ++g) if (g == bg) {
#pragma unroll
            for (int k = 0; k < 4; ++k) { const float s = sel[4 * g + k], a = aff[4 * g + k];
                if (s > s1) { s2 = s1; i2 = i1; a2 = a1; s1 = s; i1 = 4 * g + k; a1 = a; } else if (s > s2) { s2 = s; i2 = 4 * g + k; a2 = a; } } }
        const float wsum = a1 + a2, w1 = a1 / wsum, w2 = a2 / wsum;
        if (F.lane == 0) { const unsigned l1 = atomicAdd(&lcnt[i1], 1u), l2 = atomicAdd(&lcnt[i2], 1u);
            rec[lr * 6 + 0] = i1; rec[lr * 6 + 1] = i2; rec[lr * 6 + 2] = (int)l1; rec[lr * 6 + 3] = (int)l2; rec[lr * 6 + 4] = __float_as_int(w1); rec[lr * 6 + 5] = __float_as_int(w2); }
    }
    __syncthreads();
    if (F.tid < 16) lbase[F.tid] = __hip_atomic_fetch_add(&CNT[F.tid], lcnt[F.tid], __ATOMIC_RELAXED, __HIP_MEMORY_SCOPE_AGENT);
    __syncthreads();
    for (int lr = F.tid; lr < row_hi - row_lo; lr += NTHR) { const int tok = row_lo + lr;
        const int e0 = rec[lr * 6], e1 = rec[lr * 6 + 1]; const int p0 = (int)lbase[e0] + rec[lr * 6 + 2], p1 = (int)lbase[e1] + rec[lr * 6 + 3];
        LIST[e0 * NTOK + p0] = tok; LIST[e1 * NTOK + p1] = tok;
        int* tr = TOKR + (size_t)tok * 8; tr[0] = e0; tr[1] = p0; tr[2] = e1; tr[3] = p1; tr[4] = rec[lr * 6 + 4]; tr[5] = rec[lr * 6 + 5]; }
    __syncthreads();
}

__device__ __forceinline__ void pad_bases(const unsigned* cnt, int (&pb)[17]) {
    int acc = 0;
#pragma unroll
    for (int e = 0; e < 16; ++e) { pb[e] = acc; const int c = (int)__hip_atomic_load(cnt + e, __ATOMIC_RELAXED, __HIP_MEMORY_SCOPE_AGENT); acc += (c + 255) & ~255; }
    pb[16] = acc;
}

__device__ __forceinline__ void phase_moe_combine(const Frame& F, const Prm& p, int layer) {
    const int nrows = layer ? NLAT : NTOK;
    const float* MOD = (const float*)(p.ws + WS_MOD) + layer * 9 * 6144; const float* MOD1 = (const float*)(p.ws + WS_MOD) + 9 * 6144;
    const bf16* YM = (const bf16*)(p.ws + WS_YM); unsigned char* H = p.ws + WS_H;   float* XCTX = (float*)(p.ws + WS_XCTX); const int* TOKR = (const int*)(p.ws + WS_TOKR);
    int pb[17]; pad_bases(F.ctl + CW_CNT + layer * 16, pb);
    int* pbl = (int*)F.lds; if (F.tid < 17) { int v = 0;
#pragma unroll
        for (int e = 0; e < 17; ++e) if (e == F.tid) v = pb[e];
        pbl[F.tid] = v; }
    __syncthreads();
    const float* lng = p.ln_g + (layer * 2 + 1) * DM; const float* lnb = p.ln_b + (layer * 2 + 1) * DM;
    const int gw = F.bid * NWAVES + F.wave, NGW = F.G * NWAVES, per = (nrows + NGW - 1) / NGW;
    int curmod = -1; f32x4 gf[4], sh1[4], sc1[4];
    for (int tok = gw * per; tok < (gw + 1) * per && tok < nrows; ++tok) {
        const int mr = tok < NLAT ? tok / SEQ : 8;
        if (mr != curmod) { curmod = mr; ld_row_f32(MOD + mr * 6144 + 5120, F.lane, gf); if (!layer) { ld_row_f32(MOD1 + mr * 6144, F.lane, sh1); ld_row_f32(MOD1 + mr * 6144 + 1024, F.lane, sc1); } }
        const int* tr = TOKR + (size_t)tok * 8; const int s0 = pbl[tr[0]] + tr[1], s1 = pbl[tr[2]] + tr[3]; const float w0 = __int_as_float(tr[4]), w1 = __int_as_float(tr[5]);
        float* xp = tok < NLAT ? p.out + (size_t)tok * DM : XCTX + (size_t)(tok - NLAT) * DM;
        f32x4 v[4], a[4], b[4]; ld_row_f32(xp, F.lane, v); ld_row_bf16(YM + (size_t)s0 * DM, F.lane, a); ld_row_bf16(YM + (size_t)s1 * DM, F.lane, b);
#pragma unroll
        for (int j = 0; j < 4; ++j) v[j] = ALPHA * v[j] + gf[j] * (w0 * a[j] + w1 * b[j]);
        ln_row(v, lng, lnb, F.lane);
        st_row_f32(xp, F.lane, v);
        if (!layer) {
#pragma unroll
            for (int j = 0; j < 4; ++j) v[j] = v[j] * (1.f + sc1[j]) + sh1[j];
            st_row_fp8(H + (size_t)tok * DM, F.lane, v);
        }
    }
}

__device__ __forceinline__ void phase_gla_prep(const Frame& F, const Prm& p) {
    const bf16* QR = (const bf16*)(p.ws + WS_QR); const bf16* KR = (const bf16*)(p.ws + WS_KR); const float* ZZ = (const float*)(p.ws + WS_ZZ);
    bf16* QT = (bf16*)(p.ws + WS_QT); bf16* KT = (bf16*)(p.ws + WS_KT); float* DEC = (float*)(p.ws + WS_DEC);
    const int gw = F.bid * NWAVES + F.wave, NGW = F.G * NWAVES;
    for (int task = gw; task < 2 * NCHUNK * 8; task += NGW) {
        const int dh = task & 7, chunk = (task >> 3) % NCHUNK, dir = __builtin_amdgcn_readfirstlane(task / (8 * NCHUNK));
        const int col = dh * 64 + F.lane, tok0 = chunk * 64;
        unsigned short qv[64], kv[64];
#pragma unroll
        for (int t = 0; t < 64; ++t) { qv[t] = QR[(size_t)(tok0 + t) * 512 + col]; kv[t] = KR[(size_t)(tok0 + t) * 512 + col]; }
        f32x4 zl[4];
#pragma unroll
        for (int j = 0; j < 4; ++j) zl[j] = *(const f32x4*)(ZZ + (size_t)(tok0 + F.lane) * 32 + dir * 16 + 4 * j);
        float wup[16];
#pragma unroll
        for (int j = 0; j < 16; ++j) wup[j] = p.gwg_up[(size_t)dir * 16 * 512 + j * 512 + col];
        const float bgv = p.gbg[dir * 512 + col];
        float b = 0.f;
        bf16* qo = QT + ((size_t)dir * NTOK + tok0) * 512 + col; bf16* ko = KT + ((size_t)dir * NTOK + tok0) * 512 + col;
#pragma unroll
        for (int tt = 0; tt < 64; ++tt) {
            float z = bgv;
#pragma unroll
            for (int j = 0; j < 4; ++j) { const int tl = dir ? 63 - tt : tt;
                const float z0 = __int_as_float(__builtin_amdgcn_readlane(__float_as_int(zl[j].x), tl)), z1 = __int_as_float(__builtin_amdgcn_readlane(__float_as_int(zl[j].y), tl));
                const float z2 = __int_as_float(__builtin_amdgcn_readlane(__float_as_int(zl[j].z), tl)), z3 = __int_as_float(__builtin_amdgcn_readlane(__float_as_int(zl[j].w), tl));
                z += z0 * wup[4 * j] + z1 * wup[4 * j + 1] + z2 * wup[4 * j + 2] + z3 * wup[4 * j + 3]; }
            const float g = (fminf(z, 0.f) - __logf(1.f + __expf(-fabsf(z)))) * (1.f / 16.f);
            b += g;
            const float e = __expf(b), ei = __builtin_amdgcn_rcpf(e);
            const float q = dir ? bf2f(qv[63 - tt]) : bf2f(qv[tt]), k = dir ? bf2f(kv[63 - tt]) : bf2f(kv[tt]);
            const int t = dir ? 63 - tt : tt;
            qo[(size_t)t * 512] = (bf16)f2bf(q * e); ko[(size_t)t * 512] = (bf16)f2bf(k * ei);
        }
        DEC[((size_t)dir * NCHUNK + chunk) * 512 + col] = __expf(b);
    }
}

__device__ __forceinline__ void phase_gla_post(const Frame& F, const Prm& p) {
    const bf16* OF = (const bf16*)(p.ws + WS_OGF); const bf16* OB = (const bf16*)(p.ws + WS_OGB); const bf16* R = (const bf16*)(p.ws + WS_R); unsigned char* A2 = p.ws + WS_A2B;
    const f32x4 ng = *(const f32x4*)(p.gnorm + 4 * F.lane);
    const int gw = F.bid * NWAVES + F.wave, NGW = F.G * NWAVES;
    for (int tok = gw; tok < NLAT; tok += NGW) {
        f32x4 a[4], b[4], r[4]; ld_row_bf16(OF + (size_t)tok * DM, F.lane, a); ld_row_bf16(OB + (size_t)tok * DM, F.lane, b); ld_row_bf16(R + (size_t)tok * DM, F.lane, r);
#pragma unroll
        for (int j = 0; j < 4; ++j) {
            const f32x4 o = a[j] + b[j]; const float q = wave_sum((o.x * o.x + o.y * o.y) + (o.z * o.z + o.w * o.w));
            const float rs = 1.f / sqrtf(q * (1.f / 256.f) + LN_EPS);
            a[j] = (f32x4){o.x * rs * ng.x * silu_f(r[j].x), o.y * rs * ng.y * silu_f(r[j].y), o.z * rs * ng.z * silu_f(r[j].z), o.w * rs * ng.w * silu_f(r[j].w)};
        }
        st_row_fp8(A2 + (size_t)tok * DM, F.lane, a);
    }
}
namespace pg8 {
typedef short bf16x8 __attribute__((ext_vector_type(8)));
constexpr int BM = 256, BK = 64, HALF = 128, HTB = HALF * BK * 2, STAGE_BYTES = 8 * HTB, NXCD = 8, WGM = 8;
__host__ __device__ __forceinline__ int lds_byte(int r, int c) { const int st = (r >> 4) * 2 + (c >> 5), rr = r & 15, cc = c & 31, ob = rr * 64 + cc * 2; return st * 1024 + (ob ^ (((ob >> 9) & 1) << 5)); }
__host__ __device__ __forceinline__ void stage_rc(int b, int& R, int& C) { const int st = b / 1024, sb = b % 1024, swz = sb ^ (((sb >> 9) & 1) << 5); R = (st >> 1) * 16 + swz / 64; C = (st & 1) * 32 + (swz % 64) / 2; }
typedef float f32x2_t __attribute__((ext_vector_type(2))); typedef __bf16 bf16x2_t __attribute__((ext_vector_type(2)));
__device__ __forceinline__ unsigned cvt_pk_bf16(float lo, float hi) { f32x2_t v = {lo, hi}; bf16x2_t b = __builtin_convertvector(v, bf16x2_t); return __builtin_bit_cast(unsigned, b); }

struct Unit { int pm, pn; int row0; int e; int cnt; const bf16* Bt; };

struct DenseOrder {
    int nM, nN, nwg, G, c, K; const bf16* Bt;
    __device__ void init(int M, int N, int K_, const bf16* Bt_, int G_, int c_) { nM = M / BM; nN = N / BM; nwg = nM * nN; G = G_; c = c_; K = K_; Bt = Bt_; }
    __device__ bool next(int i, Unit& u) const {
        const long L = (long)i * G + c; if (L >= nwg) return false;
        int wgid = (int)L; { const int q = nwg / NXCD, r = nwg % NXCD, xcd = wgid % NXCD, off = wgid / NXCD; wgid = (xcd < r ? xcd * (q + 1) : r * (q + 1) + (xcd - r) * q) + off; }
        const int nig = WGM * nN, gid = wgid / nig, fm = gid * WGM, gsz = (nM - fm) < WGM ? (nM - fm) : WGM;
        u.pm = fm + ((wgid % nig) % gsz); u.pn = (wgid % nig) / gsz; u.row0 = u.pm * BM; u.e = 0; u.cnt = 0; u.Bt = Bt; return true;
    }
    __device__ __forceinline__ unsigned arow(const Unit& u, int r) const { return (unsigned)(u.row0 + r) * (unsigned)(K * 2); }
};
template <bool GATHER> struct MoeOrder {
    int cnt[16]; int nN, G, c, K; const bf16* Bt0; size_t bstride; const int* LIST;
    __device__ void init(const unsigned* cntw, int N, int K_, const bf16* Bt0_, const int* LIST_, int G_, int c_) {
#pragma unroll
        for (int e = 0; e < 16; ++e) cnt[e] = (int)__hip_atomic_load(cntw + e, __ATOMIC_RELAXED, __HIP_MEMORY_SCOPE_AGENT);
        nN = N / BM; G = G_; c = c_; K = K_; Bt0 = Bt0_; bstride = (size_t)N * K_; LIST = LIST_; }
    __device__ bool next(int i, Unit& u) const {
        int L = i * G + c, base = 0; bool found = false; u.pm = 0; u.pn = 0; u.row0 = 0; u.e = 0; u.cnt = 0; u.Bt = Bt0;
#pragma unroll
        for (int e = 0; e < 16; ++e) { const int mt = (cnt[e] + 255) >> 8, nu = mt * nN;
            if (!found) { if (L < nu) { found = true; u.e = e; u.cnt = cnt[e]; u.pm = L / nN; u.pn = L % nN; u.row0 = base + u.pm * BM; u.Bt = Bt0 + (size_t)e * bstride; } else { L -= nu; base += mt * BM; } } }
        return found;
    }
    __device__ __forceinline__ unsigned arow(const Unit& u, int r) const {
        if (GATHER) { const int li = u.pm * BM + r; int tok = 0; if (li < u.cnt) tok = LIST[u.e * NTOK + li];
            return (unsigned)tok * (unsigned)(K * 2); }
        return (unsigned)(u.row0 + r) * (unsigned)(K * 2);
    }
};

typedef f32x4 Acc[2][2][4][2];
__device__ __forceinline__ void st4bf(bf16* p, f32x4 v) { u32x2 w; w.x = cvt_pk_bf16(v.x, v.y); w.y = cvt_pk_bf16(v.z, v.w); *(u32x2*)p = w; }
__device__ __forceinline__ void st8bf(bf16* p, f32x4 a, f32x4 b) { u32x4 w; w.x = cvt_pk_bf16(a.x, a.y); w.y = cvt_pk_bf16(a.z, a.w); w.z = cvt_pk_bf16(b.x, b.y); w.w = cvt_pk_bf16(b.z, b.w); *(u32x4*)p = w; }

struct EpiQKV {
    bf16 *Q; const LAS float* rope;
    __device__ __forceinline__ void operator()(const Acc& acc, const Unit& u, int wr, int wc, int fr, int fq) const {
        const int reg = u.pn >> 2; bf16* O = Q + (size_t)reg * ((WS_K - WS_Q) / 2);
        if (reg == 2) { const int cbase = (u.pn & 3) * BM + wc * 32 + 8 * fq;
#pragma unroll
            for (int ai = 0; ai < 2; ++ai)
#pragma unroll
                for (int m = 0; m < 4; ++m) { bf16* rowp = O + (size_t)(u.row0 + ai * HALF + wr * 64 + m * 16 + fr) * DM + cbase;
#pragma unroll
                    for (int bj = 0; bj < 2; ++bj) st8bf(rowp + bj * HALF, acc[ai][bj][m][0], acc[ai][bj][m][1]); }
            return; }
        const int cbase = (u.pn & 3) * BM + wc * 32 + 4 * fq;
        const bool dorope = (u.row0 < NLAT); const float sc = reg == 0 ? C2 : 1.f;
#pragma unroll
        for (int ai = 0; ai < 2; ++ai)
#pragma unroll
            for (int m = 0; m < 4; ++m) { const int row = u.row0 + ai * HALF + wr * 64 + m * 16 + fr; bf16* rowp = O + (size_t)row * DM + cbase;
                f32x4 cs = {1.f, 1.f, 1.f, 1.f}, sn = {0.f, 0.f, 0.f, 0.f};
                if (dorope) { const int s = row & (SEQ - 1), pos = (wc & 1) ? (s & 63) : (s >> 6); const f32x4 t0 = *(const LAS f32x4*)(rope + (pos * 16 + 4 * fq) * 2), t1 = *(const LAS f32x4*)(rope + (pos * 16 + 4 * fq) * 2 + 4);
                    cs = (f32x4){t0.x, t0.z, t1.x, t1.z}; sn = (f32x4){t0.y, t0.w, t1.y, t1.w}; }
#pragma unroll
                for (int bj = 0; bj < 2; ++bj) { const f32x4 a0 = acc[ai][bj][m][0], a1 = acc[ai][bj][m][1];
                    st4bf(rowp + bj * HALF, (a0 * cs - a1 * sn) * sc); st4bf(rowp + bj * HALF + 16, (a1 * cs + a0 * sn) * sc); } }
    }
};
struct EpiPlain {
    bf16* O; float sc;
    __device__ __forceinline__ void operator()(const Acc& acc, const Unit& u, int wr, int wc, int fr, int fq) const {
        const int cbase = u.pn * BM + wc * 32 + 8 * fq;
#pragma unroll
        for (int ai = 0; ai < 2; ++ai)
#pragma unroll
            for (int m = 0; m < 4; ++m) { bf16* rowp = O + (size_t)(u.row0 + ai * HALF + wr * 64 + m * 16 + fr) * DM + cbase;
#pragma unroll
                for (int bj = 0; bj < 2; ++bj) st8bf(rowp + bj * HALF, acc[ai][bj][m][0] * sc, acc[ai][bj][m][1] * sc); }
    }
};
struct EpiInproj {
    bf16 *QR, *KR, *V, *R; float* ZZ; float wsc;
    __device__ __forceinline__ void operator()(const Acc& acc, const Unit& u, int wr, int wc, int fr, int fq) const {
        const int pn = u.pn;
        if (pn == 12) { if (wc == 0) {
#pragma unroll
            for (int ai = 0; ai < 2; ++ai)
#pragma unroll
                for (int m = 0; m < 4; ++m) { float* rowp = ZZ + (size_t)(u.row0 + ai * HALF + wr * 64 + m * 16 + fr) * 32 + 4 * fq;
                    *(f32x4*)rowp = acc[ai][0][m][0] * wsc; *(f32x4*)(rowp + 16) = acc[ai][0][m][1] * wsc; } }
            return; }
        bf16* O; int ld, c0; float sc = wsc;
        if (pn < 2) { O = QR; ld = 512; c0 = pn * BM; sc = 0.08838834764831845f * wsc; } else if (pn < 4) { O = KR; ld = 512; c0 = (pn - 2) * BM; } else if (pn < 8) { O = V; ld = DM; c0 = (pn - 4) * BM; } else { O = R; ld = DM; c0 = (pn - 8) * BM; }
        const int cbase = c0 + wc * 32 + 8 * fq;
#pragma unroll
        for (int ai = 0; ai < 2; ++ai)
#pragma unroll
            for (int m = 0; m < 4; ++m) { bf16* rowp = O + (size_t)(u.row0 + ai * HALF + wr * 64 + m * 16 + fr) * ld + cbase;
#pragma unroll
                for (int bj = 0; bj < 2; ++bj) st8bf(rowp + bj * HALF, acc[ai][bj][m][0] * sc, acc[ai][bj][m][1] * sc); }
    }
};
struct EpiGateUp {
    unsigned char* ACT;
    __device__ __forceinline__ void operator()(const Acc& acc, const Unit& u, int wr, int wc, int fr, int fq) const {
        const int obase = (u.pn * BM + wc * 32) / 2 + 4 * fq;
#pragma unroll
        for (int ai = 0; ai < 2; ++ai)
#pragma unroll
            for (int m = 0; m < 4; ++m) { unsigned char* rowp = ACT + (size_t)(u.row0 + ai * HALF + wr * 64 + m * 16 + fr) * DEXP + obase;
#pragma unroll
                for (int bj = 0; bj < 2; ++bj) { const f32x4 g = acc[ai][bj][m][0] * W8_INV, up = acc[ai][bj][m][1] * W8_INV; f32x4 o;
#pragma unroll
                    for (int j = 0; j < 4; ++j) o[j] = g[j] * __builtin_amdgcn_rcpf(1.f + __expf(-g[j])) * up[j];
                    *(unsigned*)(rowp + bj * (HALF / 2)) = pk4_fp8(o[0], o[1], o[2], o[3]); } }
    }
};

typedef int i32x8 __attribute__((ext_vector_type(8)));
typedef int i32x4 __attribute__((ext_vector_type(4)));
__device__ __forceinline__ i32x8 cat8(bf16x8 lo, bf16x8 hi) { return __builtin_shufflevector(__builtin_bit_cast(i32x4, lo), __builtin_bit_cast(i32x4, hi), 0, 1, 2, 3, 4, 5, 6, 7); }
template <class Epi, class Sched, bool FP8 = false>
__device__ __forceinline__ void gemm_phase(unsigned char* ldsg, const bf16* A, int K, const Sched& S, const Epi& E) {
    LAS unsigned char* lds = (LAS unsigned char*)ldsg;
    const int tid = threadIdx.x, wid = __builtin_amdgcn_readfirstlane(tid >> 6), lane = tid & 63, wr = wid >> 2, wc = wid & 3, fr = lane & 15, fq = lane >> 4;
    const int nt = K / BK;
    int Rr[2]; unsigned colb[2], voffB[2];
#pragma unroll
    for (int i = 0; i < 2; ++i) { int R, C; stage_rc(tid * 16 + i * 8192, R, C); Rr[i] = R; colb[i] = (unsigned)C * 2u; voffB[i] = (unsigned)(R * K + C) * 2u; }
    const size_t kstep = (size_t)(BK * 2);
    const size_t hstep = (size_t)HALF * K * 2;
    const size_t tstep = 2 * hstep;
    const unsigned ldsw = (unsigned)wid * 1024u;
    const int aoff = lds_byte(wr * 64 + fr, fq * 8), boff = lds_byte(wc * 32 + fr, fq * 8);
#define PG8_SA(b, h) (((b) * 2 + (h)) * HTB)
#define PG8_SB(b, h) ((4 + (b) * 2 + (h)) * HTB)
#define PG8_STAGE(bufoff, gbase, voff) do { _Pragma("unroll") for (int _i = 0; _i < 2; ++_i) \
        __builtin_amdgcn_global_load_lds((const unsigned*)((const char*)(gbase) + (voff)[_i]), (LAS unsigned*)(lds + (bufoff) + ldsw + _i * 8192), 16, 0, 0); } while (0)
#define PG8_LDA(dst, b, h) do { if constexpr (FP8) { _Pragma("unroll") for (int m = 0; m < 4; ++m) dst##8[m] = cat8(*(const LAS bf16x8*)(lds + PG8_SA(b, h) + aoff + m * 2048), *(const LAS bf16x8*)(lds + PG8_SA(b, h) + aoff + m * 2048 + 1024)); } \
        else { _Pragma("unroll") for (int m = 0; m < 4; ++m) _Pragma("unroll") for (int k = 0; k < 2; ++k) dst[m][k] = *(const LAS bf16x8*)(lds + PG8_SA(b, h) + aoff + m * 2048 + k * 1024); } } while (0)
#define PG8_LDB(dst, b, h) do { if constexpr (FP8) { _Pragma("unroll") for (int n = 0; n < 2; ++n) dst##8[n] = cat8(*(const LAS bf16x8*)(lds + PG8_SB(b, h) + boff + n * 2048), *(const LAS bf16x8*)(lds + PG8_SB(b, h) + boff + n * 2048 + 1024)); } \
        else { _Pragma("unroll") for (int n = 0; n < 2; ++n) _Pragma("unroll") for (int k = 0; k < 2; ++k) dst[n][k] = *(const LAS bf16x8*)(lds + PG8_SB(b, h) + boff + n * 2048 + k * 1024); } } while (0)
#define PG8_MMA(ai, bj, At, Bt) do { __builtin_amdgcn_s_setprio(1); \
        if constexpr (FP8) { _Pragma("unroll") for (int m = 0; m < 4; ++m) _Pragma("unroll") for (int n = 0; n < 2; ++n) \
            asm volatile("v_mfma_scale_f32_16x16x128_f8f6f4 %0, %1, %2, %0, %3, %3 op_sel_hi:[0,0,0]" : "+v"(acc[ai][bj][m][n]) : "v"(Bt##8[n]), "v"(At##8[m]), "v"(sc8)); } \
        else { _Pragma("unroll") for (int m = 0; m < 4; ++m) _Pragma("unroll") for (int n = 0; n < 2; ++n) _Pragma("unroll") for (int k = 0; k < 2; ++k) \
            acc[ai][bj][m][n] = __builtin_amdgcn_mfma_f32_16x16x32_bf16(Bt[n][k], At[m][k], acc[ai][bj][m][n], 0, 0, 0); } \
        __builtin_amdgcn_s_setprio(0); } while (0)
#define PG8_WAIT_V(n) asm volatile("s_waitcnt vmcnt(" #n ")" ::: "memory")
#define PG8_WAIT_L(n) asm volatile("s_waitcnt lgkmcnt(" #n ")" ::: "memory")
#define PG8_BAR __builtin_amdgcn_s_barrier()
#define PG8_SCHED __builtin_amdgcn_sched_barrier(0)
    Unit cur, nxt; int ui = 0;
    if (!S.next(0, cur)) return;
    Acc acc;
#pragma unroll
    for (int a = 0; a < 2; ++a)
#pragma unroll
        for (int b = 0; b < 2; ++b)
#pragma unroll
            for (int m = 0; m < 4; ++m)
#pragma unroll
                for (int n = 0; n < 2; ++n) acc[a][b][m][n] = (f32x4){0.f, 0.f, 0.f, 0.f};
    const int sc8 = 0x7f7f7f7f;
    bf16x8 At[4][2], B0[2][2], B1[2][2]; i32x8 At8[4], B08[2], B18[2];
    unsigned aC0[2], aC1[2], aN0[2], aN1[2];
#pragma unroll
    for (int i = 0; i < 2; ++i) { aC0[i] = S.arow(cur, Rr[i]) + colb[i]; aC1[i] = S.arow(cur, HALF + Rr[i]) + colb[i]; }
    const char* Ab = (const char*)A;
    const char* cB = (const char*)cur.Bt + (size_t)cur.pn * tstep;
    PG8_STAGE(PG8_SB(0, 0), cB, voffB); PG8_STAGE(PG8_SB(0, 1), cB + hstep, voffB); PG8_STAGE(PG8_SA(0, 0), Ab, aC0); PG8_STAGE(PG8_SA(0, 1), Ab, aC1);
    if (wr == 1) PG8_BAR;
    PG8_WAIT_V(2); PG8_BAR;
    PG8_STAGE(PG8_SB(1, 0), cB + kstep, voffB); PG8_STAGE(PG8_SA(1, 0), Ab + kstep, aC0); PG8_STAGE(PG8_SB(1, 1), cB + hstep + kstep, voffB);
    PG8_WAIT_V(6); PG8_BAR;
    for (;;) {
        const bool has_next = S.next(ui + 1, nxt);
        if (has_next) {
#pragma unroll
            for (int i = 0; i < 2; ++i) { aN0[i] = S.arow(nxt, Rr[i]) + colb[i]; aN1[i] = S.arow(nxt, HALF + Rr[i]) + colb[i]; }
        } else {
#pragma unroll
            for (int i = 0; i < 2; ++i) { aN0[i] = aC0[i]; aN1[i] = aC1[i]; }
        }
        const char* nB = has_next ? (const char*)nxt.Bt + (size_t)nxt.pn * tstep : cB;
        for (int t = 0; t < nt; t += 2) {
            const bool last = (t == nt - 2);
            const char* a1 = Ab + (size_t)(t + 1) * kstep;
            const char* a2 = last ? Ab : Ab + (size_t)(t + 2) * kstep; const char* b2 = last ? nB : cB + (size_t)(t + 2) * kstep;
            const char* a3 = a2 + kstep; const char* b3 = b2 + kstep;
            unsigned x0[2], x1[2];
#pragma unroll
            for (int i = 0; i < 2; ++i) { x0[i] = last ? aN0[i] : aC0[i]; x1[i] = last ? aN1[i] : aC1[i]; }
            PG8_LDB(B0, 0, 0); PG8_LDB(B1, 0, 1); PG8_SCHED; PG8_LDA(At, 0, 0); PG8_STAGE(PG8_SA(1, 1), a1, aC1);
            PG8_WAIT_V(8); PG8_WAIT_L(0); PG8_BAR; PG8_MMA(0, 0, At, B0); PG8_MMA(0, 1, At, B1); PG8_BAR; PG8_SCHED;
            PG8_LDA(At, 0, 1); PG8_STAGE(PG8_SB(0, 0), b2, voffB); PG8_STAGE(PG8_SB(0, 1), b2 + hstep, voffB); PG8_STAGE(PG8_SA(0, 0), a2, x0);
            PG8_WAIT_V(8); PG8_WAIT_L(0); PG8_BAR; PG8_MMA(1, 0, At, B0); PG8_MMA(1, 1, At, B1); PG8_BAR; PG8_SCHED;
            PG8_LDB(B0, 1, 0); PG8_LDB(B1, 1, 1); PG8_SCHED; PG8_LDA(At, 1, 0); PG8_STAGE(PG8_SA(0, 1), a2, x1);
            PG8_WAIT_V(8); PG8_WAIT_L(0); PG8_BAR; PG8_MMA(0, 0, At, B0); PG8_MMA(0, 1, At, B1); PG8_BAR; PG8_SCHED;
            PG8_LDA(At, 1, 1); PG8_STAGE(PG8_SB(1, 0), b3, voffB); PG8_STAGE(PG8_SB(1, 1), b3 + hstep, voffB); PG8_STAGE(PG8_SA(1, 0), a3, x0);
            PG8_WAIT_V(8); PG8_WAIT_L(0); PG8_BAR; PG8_MMA(1, 0, At, B0); PG8_MMA(1, 1, At, B1); PG8_BAR; PG8_SCHED;
        }
        if (wr == 0) PG8_BAR;
        if constexpr (FP8) asm volatile("s_nop 15\n\ts_nop 7" ::: "memory");
        E(acc, cur, wr, wc, fr, fq);
        if (!has_next) break;
#pragma unroll
        for (int a = 0; a < 2; ++a)
#pragma unroll
            for (int b = 0; b < 2; ++b)
#pragma unroll
                for (int m = 0; m < 4; ++m)
#pragma unroll
                    for (int n = 0; n < 2; ++n) acc[a][b][m][n] = (f32x4){0.f, 0.f, 0.f, 0.f};
        cur = nxt; cB = nB; ++ui;
#pragma unroll
        for (int i = 0; i < 2; ++i) { aC0[i] = aN0[i]; aC1[i] = aN1[i]; }
        if (wr == 1) PG8_BAR;
    }
    PG8_WAIT_V(0);
    PG8_BAR;
#undef PG8_SA
#undef PG8_SB
#undef PG8_STAGE
#undef PG8_LDA
#undef PG8_LDB
#undef PG8_MMA
#undef PG8_WAIT_V
#undef PG8_WAIT_L
#undef PG8_BAR
#undef PG8_SCHED
}
}

__device__ __forceinline__ int vcu_of(const Frame& F) { return (F.G % 8 == 0) ? (F.bid % 8) * (F.G / 8) + F.bid / 8 : F.bid; }
__device__ __forceinline__ void phase_qkv_opt(const Frame& F, const Prm& p) {
    pg8::DenseOrder S; S.init(NTOK, 3072, 1024, (const bf16*)(p.ws + WS_WQKV), F.G, F.bid);
    static_assert(WS_V - WS_K == WS_K - WS_Q, "Q|K|V equally spaced");
    LAS float* ropel = (LAS float*)((LAS unsigned char*)F.lds + LDSX_OFF);
    const float* ropeg = (const float*)(p.ws + WS_MISC) + 1024;
    for (int i = F.tid; i < 2048; i += NTHR) ropel[i] = ropeg[i];
    __syncthreads();
    pg8::EpiQKV E{(bf16*)(p.ws + WS_Q), ropel};
    pg8::gemm_phase(F.lds, (const bf16*)(p.ws + WS_H), 1024, S, E);
}
__device__ __forceinline__ void phase_wo_opt(const Frame& F, const Prm& p, int layer) {
    if (layer) {
        pg8::DenseOrder S; S.init(NLAT, 1024, 512, (const bf16*)(p.ws + WS_WGO), F.G, F.bid);
        pg8::EpiPlain E{(bf16*)(p.ws + WS_Y), W8_INV};
        pg8::gemm_phase<pg8::EpiPlain, pg8::DenseOrder, true>(F.lds, (const bf16*)(p.ws + WS_A2B), 512, S, E);
    } else {
        pg8::DenseOrder S; S.init(NTOK, 1024, 1024, (const bf16*)(p.ws + WS_WO), F.G, F.bid);
        pg8::EpiPlain E{(bf16*)(p.ws + WS_Y), 1.f};
        pg8::gemm_phase(F.lds, (const bf16*)(p.ws + WS_A2), 1024, S, E);
    }
}
__device__ __forceinline__ void phase_inproj_opt(const Frame& F, const Prm& p) {
    pg8::DenseOrder S; S.init(NTOK, NIN, 512, (const bf16*)(p.ws + WS_WIN), F.G, F.bid);
    pg8::EpiInproj E{(bf16*)(p.ws + WS_QR), (bf16*)(p.ws + WS_KR), (bf16*)(p.ws + WS_V1), (bf16*)(p.ws + WS_R), (float*)(p.ws + WS_ZZ), W8_INV};
    pg8::gemm_phase<pg8::EpiInproj, pg8::DenseOrder, true>(F.lds, (const bf16*)(p.ws + WS_H), 512, S, E);
}
__device__ __forceinline__ void phase_moe1_opt(const Frame& F, const Prm& p, int layer) {
    pg8::MoeOrder<true> S; S.init(F.ctl + CW_CNT + layer * 16, 1024, 512, (const bf16*)(p.ws + (layer ? WS_GU1 : WS_GU0)), (const int*)(p.ws + WS_LIST), F.G, vcu_of(F));
    pg8::EpiGateUp E{p.ws + WS_ACT};
    pg8::gemm_phase<pg8::EpiGateUp, pg8::MoeOrder<true>, true>(F.lds, (const bf16*)(p.ws + WS_H), 512, S, E);
}
__device__ __forceinline__ void phase_moe2_opt(const Frame& F, const Prm& p, int layer) {
    pg8::MoeOrder<false> S; S.init(F.ctl + CW_CNT + layer * 16, 1024, 256, (const bf16*)(p.ws + (layer ? WS_DN1 : WS_DN0)), nullptr, F.G, vcu_of(F));
    pg8::EpiPlain E{(bf16*)(p.ws + WS_YM), W8_INV};
    pg8::gemm_phase<pg8::EpiPlain, pg8::MoeOrder<false>, true>(F.lds, (const bf16*)(p.ws + WS_ACT), 256, S, E);
}
namespace attn_body {
using bf16=unsigned short;
using bf16x8=__attribute__((ext_vector_type(8)))short;
using s16x4=__attribute__((ext_vector_type(4)))short;
using f32x16=__attribute__((ext_vector_type(16)))float;
using u32x4=__attribute__((ext_vector_type(4)))unsigned;
constexpr int D=64,DM=1024;
constexpr int NW=8,QBLK=32,QB=QBLK*NW,KVBLK=64;
constexpr int ATTN_PITCH=DM, ATTN_UNIT_ROWS=QB;
__device__ __forceinline__ int crow(int r,int hi){return (r&3)+8*(r>>2)+4*hi;}
#define SBAR() __builtin_amdgcn_sched_barrier(0)
__device__ __forceinline__ void cmask(f32x16&p0,f32x16&p1,int jb,int qrel,int hi){
  const float NEG=-INFINITY; int kb=64*jb+4*hi;
  #pragma unroll
  for(int r=0;r<16;++r){int kv=kb+(r&3)+8*(r>>2); if(kv>qrel)p0[r]=NEG; if(kv+32>qrel)p1[r]=NEG;}
}

constexpr int NSLOT=3, SLOTB=8192;
constexpr int LDS_K=0, LDS_V=NSLOT*SLOTB, LDS_WS=2*NSLOT*SLOTB, LDS_OST=LDS_WS+NW*64*4, LDS_BYTES=LDS_OST+NW*4096;
constexpr float C2=0.125f*1.4426950408889634f;
__device__ __forceinline__ void glds16(const void*gsrc,unsigned lds_dst){unsigned keep;
  asm volatile("s_mov_b32 %0, m0\n\ts_mov_b32 m0, %2\n\ts_nop 0\n\tglobal_load_lds_dwordx4 %1, off\n\ts_mov_b32 m0, %0":"=&s"(keep):"v"(gsrc),"s"(lds_dst):"memory");}
__device__ __forceinline__ float max3f(float a,float b,float c){float r;asm("v_max3_f32 %0, %1, %2, %3":"=v"(r):"v"(a),"v"(b),"v"(c));return r;}
__device__ __forceinline__ float max2f(float a,float b){float r;asm("v_max_f32_e32 %0, %1, %2":"=v"(r):"v"(a),"v"(b));return r;}
__device__ __forceinline__ float fadd_s(float a,float b){float r;asm("v_add_f32_e32 %0, %1, %2":"=v"(r):"v"(a),"v"(b));return r;}
__device__ __forceinline__ float fsub_s(float a,float b){float r;asm("v_sub_f32_e32 %0, %1, %2":"=v"(r):"v"(a),"v"(b));return r;}
typedef float f32x2_t __attribute__((ext_vector_type(2))); typedef __bf16 bf16x2_t __attribute__((ext_vector_type(2)));
__device__ __forceinline__ unsigned cvtpk_s(float lo,float hi){f32x2_t v={lo,hi};bf16x2_t b=__builtin_convertvector(v,bf16x2_t);return __builtin_bit_cast(unsigned,b);}
#define WAIT_BAR(N) asm volatile("s_waitcnt vmcnt(" #N ") lgkmcnt(0)\n\ts_barrier":::"memory")

__device__ __forceinline__ void qkt(f32x16&p0,f32x16&p1,const char*Kslot,const bf16x8*qr,const f32x16&negm,int r32,int hi){
  const char*kb=Kslot+hi*1024+r32*16;
  #pragma unroll
  for(int d0=0;d0<4;++d0){
    const bf16x8 b0=*reinterpret_cast<const bf16x8*>(kb+d0*2048);
    const bf16x8 b1=*reinterpret_cast<const bf16x8*>(kb+d0*2048+512);
    if(d0==0){p0=__builtin_amdgcn_mfma_f32_32x32x16_bf16(b0,qr[0],negm,0,0,0);p1=__builtin_amdgcn_mfma_f32_32x32x16_bf16(b1,qr[0],negm,0,0,0);}
    else{p0=__builtin_amdgcn_mfma_f32_32x32x16_bf16(b0,qr[d0],p0,0,0,0);p1=__builtin_amdgcn_mfma_f32_32x32x16_bf16(b1,qr[d0],p1,0,0,0);}}
}
typedef __attribute__((address_space(3))) const char* lds_cptr;
typedef short v4i16_t __attribute__((ext_vector_type(4)));
__device__ __forceinline__ void kload8(bf16x8*kf,lds_cptr kp){
  kf[0]=*(const __attribute__((address_space(3))) bf16x8*)(kp);      kf[1]=*(const __attribute__((address_space(3))) bf16x8*)(kp+512);
  kf[2]=*(const __attribute__((address_space(3))) bf16x8*)(kp+2048); kf[3]=*(const __attribute__((address_space(3))) bf16x8*)(kp+2560);
  kf[4]=*(const __attribute__((address_space(3))) bf16x8*)(kp+4096); kf[5]=*(const __attribute__((address_space(3))) bf16x8*)(kp+4608);
  kf[6]=*(const __attribute__((address_space(3))) bf16x8*)(kp+6144); kf[7]=*(const __attribute__((address_space(3))) bf16x8*)(kp+6656);
}
__device__ __forceinline__ void kload2(bf16x8*kf,lds_cptr kp,int j){ kf[2*j]=*(const __attribute__((address_space(3))) bf16x8*)(kp+j*2048); kf[2*j+1]=*(const __attribute__((address_space(3))) bf16x8*)(kp+j*2048+512); }
__device__ __forceinline__ s16x4 vtr(lds_cptr p){ return __builtin_bit_cast(s16x4,__builtin_amdgcn_ds_read_tr16_b64_v4i16((__attribute__((address_space(3))) v4i16_t*)p)); }
__device__ __forceinline__ float rowmax(const f32x16&p0,const f32x16&p1){
  float a=max3f(p0[0],p0[1],p1[0]),b=max3f(p0[2],p0[3],p1[1]);a=max3f(a,p1[2],p1[3]);
  #pragma unroll
  for(int r=4;r<16;r+=4){a=max3f(a,p0[r],p0[r+1]);b=max3f(b,p0[r+2],p0[r+3]);a=max3f(a,p1[r],p1[r+1]);b=max3f(b,p1[r+2],p1[r+3]);}
  const float m=max2f(a,b);
  auto rr=__builtin_amdgcn_permlane32_swap(__float_as_uint(m),__float_as_uint(m),false,false);
  return max2f(__uint_as_float(rr[0]),__uint_as_float(rr[1]));
}
__device__ __forceinline__ void pv(f32x16*o,int vb,bf16x8 pa0,bf16x8 pa1,bf16x8 pa2,bf16x8 pa3){
  #pragma unroll
  for(int d0=0;d0<2;++d0){s16x4 lo[4],hi[4];
    #pragma unroll
    for(int ks=0;ks<4;++ks){
      asm volatile("ds_read_b64_tr_b16 %0,%1 offset:%c2":"=&v"(lo[ks]):"v"(vb),"i"(d0*4096+ks*1024):"memory");
      asm volatile("ds_read_b64_tr_b16 %0,%1 offset:%c2":"=&v"(hi[ks]):"v"(vb),"i"(d0*4096+ks*1024+512):"memory");}
    asm volatile("s_waitcnt lgkmcnt(0)":::"memory");SBAR();
    #define PK(k) (bf16x8){lo[k][0],lo[k][1],lo[k][2],lo[k][3],hi[k][0],hi[k][1],hi[k][2],hi[k][3]}
    o[d0]=__builtin_amdgcn_mfma_f32_32x32x16_bf16(pa0,PK(0),o[d0],0,0,0);
    o[d0]=__builtin_amdgcn_mfma_f32_32x32x16_bf16(pa1,PK(1),o[d0],0,0,0);
    o[d0]=__builtin_amdgcn_mfma_f32_32x32x16_bf16(pa2,PK(2),o[d0],0,0,0);
    o[d0]=__builtin_amdgcn_mfma_f32_32x32x16_bf16(pa3,PK(3),o[d0],0,0,0);
    #undef PK
  }
}

#ifndef ATTN_STORE16
#define ATTN_STORE16(p,v) (*(u32x4*)(p)=(v))
#endif
template<int THRL> __device__ __forceinline__ void attn_unit(long qrow0,int qcol,int vcol,long kctx,long klat,int NT,const bf16*Q,const bf16*__restrict__ K,const bf16*__restrict__ V,bf16*O,char*shm){
  const int tid=threadIdx.x,lane=tid&63,r32=lane&31,hi=lane>>5; const int wid=__builtin_amdgcn_readfirstlane(tid>>6);

  const bf16*Qw=Q+(qrow0+wid*QBLK)*DM+qcol;
  const bf16*Kh=K+qcol,*Vh=V+vcol;
  const unsigned lds0=(unsigned)(uintptr_t)shm;
  float*wsf=(float*)(shm+LDS_WS)+wid*64;
  const bf16*ksrc=Kh+(long)lane*DM+wid*8;
  const bf16*vsrc=Vh+(long)(16*(wid&3)+(lane>>2))*DM+(wid>>2)*32+(lane&3)*8;
  const unsigned kdst=lds0+LDS_K+wid*1024, vdst=lds0+LDS_V+wid*1024;
  #define KVROW(t) ((t)<4?kctx+(long)(t)*KVBLK:klat+(long)((t)-4)*KVBLK)
  #define DMA_K(t,slot) glds16(ksrc+KVROW(t)*DM,(unsigned)__builtin_amdgcn_readfirstlane(kdst+(slot)))
  #define DMA_V(t,slot) glds16(vsrc+KVROW(t)*DM,(unsigned)__builtin_amdgcn_readfirstlane(vdst+(slot)))
  const int vb0=(int)(lds0+LDS_V)+((lane>>4)&1)*32+(lane&3)*8+(4*hi+((lane&15)>>2))*64;
  const char*Kbase=shm+LDS_K; bf16x8 kf[8];
  const lds_cptr shm3=(lds_cptr)shm; const lds_cptr kp0=shm3+LDS_K+hi*1024+r32*16; const lds_cptr vp0=shm3+LDS_V+((lane>>4)&1)*32+(lane&3)*8+(4*hi+((lane&15)>>2))*64;
  DMA_K(0,0);DMA_V(0,0);DMA_K(1,SLOTB);
  bf16x8 qr[4];
  #pragma unroll
  for(int d0=0;d0<4;++d0)qr[d0]=*reinterpret_cast<const bf16x8*>(&Qw[(long)r32*DM+d0*16+hi*8]);
  float mhat=0.f,l_reg=0.f;f32x16 o[2];o[0]=f32x16{};o[1]=f32x16{};f32x16 negm=f32x16{};asm volatile("":"+v"(negm));
  const int qrel=wid*QBLK+r32;
  #define CMASK(P0,P1,t) do{}while(0)
  bool resc=false;
  #define START(P0,P1) do{ const float rm=rowmax(P0,P1); resc=false; \
    { const float dl=rm; mhat=fadd_s(mhat,dl); \
      _Pragma("unroll") for(int r=0;r<16;++r){P0[r]=fsub_s(P0[r],dl);P1[r]=fsub_s(P1[r],dl);} \
      _Pragma("unroll") for(int r=0;r<16;++r)negm[r]=-mhat; asm volatile("":"+v"(negm)); } \
    _Pragma("unroll") for(int r=0;r<16;++r)P0[r]=__builtin_amdgcn_exp2f(P0[r]); }while(0)
  #define RESC() do{ if(resc){ asm volatile("s_waitcnt lgkmcnt(0)":::"memory"); \
      _Pragma("unroll") for(int d_=0;d_<2;++d_) _Pragma("unroll") for(int r=0;r<16;++r)o[d_][r]*=wsf[crow(r,hi)]; } }while(0)
  f32x16 pA0,pA1,pB0,pB1;
  int sl_prev=0,sl_cur=0,sl_next=SLOTB;
  #define ROT() do{sl_prev=sl_cur;sl_cur=sl_next;sl_next=(sl_next==(NSLOT-1)*SLOTB)?0:sl_next+SLOTB;}while(0)
  DMA_K(2,2*SLOTB);
  WAIT_BAR(3);
  qkt(pA0,pA1,Kbase,qr,negm,r32,hi);asm volatile("s_nop 15\n\ts_nop 7":"+v"(pA0),"+v"(pA1));CMASK(pA0,pA1,0);
  START(pA0,pA1);
  _Pragma("unroll") for(int r=0;r<16;++r)pA1[r]=__builtin_amdgcn_exp2f(pA1[r]);
  WAIT_BAR(0);
  DMA_K(3,0);DMA_V(1,SLOTB);
  ROT();
  kload8(kf,kp0+sl_cur);
  WAIT_BAR(2);
  s16x4 vlo[8],vhi[8]; u32x4 pw0,pw1,pw2,pw3;
  #define PKW(P,B) cvtpk_s(P[B],P[B+1])
  #define PAF(k) __builtin_bit_cast(bf16x8,pw##k)
  #define VFR(i) (bf16x8){vlo[i][0],vlo[i][1],vlo[i][2],vlo[i][3],vhi[i][0],vhi[i][1],vhi[i][2],vhi[i][3]}
  #define PIN(x) asm volatile("":"+v"(x))
  #define MX3(a,b,c) __builtin_fmaxf(__builtin_fmaxf((a),(b)),(c))
  #define GAPA(MF,A0,A1,A2,A3,W0,W1,PW) do{ MF; sacc+=A0; sacc+=A1; sacc+=A2; sacc+=A3; PIN(sacc); W0; W1; PIN(PW); SBAR(); }while(0)
  #define EX(v) __builtin_amdgcn_exp2f(v)
  #define GAPB(MF,X,B) do{ MF; X[B]=EX(X[B]); X[B+1]=EX(X[B+1]); X[B+2]=EX(X[B+2]); X[B+3]=EX(X[B+3]); PIN(X); SBAR(); }while(0)
  #define VRD(i) do{ vlo[i]=vtr(vp_+(((i)>>2)*4096+((i)&3)*1024)); vhi[i]=vtr(vp_+(((i)>>2)*4096+((i)&3)*1024+512)); }while(0)
  #define KRD(G,j) do{ if(G){ kload2(kf,kp0+sl_next,j); SBAR(); } }while(0)
  #define STEP(C0,C1,P0,P1,t,GK,GV,GL) do{ SBAR(); \
    const lds_cptr vp_=vp0+sl_prev; \
    VRD(0); SBAR(); float sacc=(P0[0]+P0[1]); \
    GAPA(C0=__builtin_amdgcn_mfma_f32_32x32x16_bf16(kf[0],qr[0],negm,0,0,0), P0[2],P0[3],P0[4],P0[5],     pw0[0]=PKW(P0,0), pw0[1]=PKW(P0,2), pw0); \
    VRD(4); SBAR(); GAPA(C1=__builtin_amdgcn_mfma_f32_32x32x16_bf16(kf[1],qr[0],negm,0,0,0), P0[6],P0[7],P0[8],P0[9],     pw0[2]=PKW(P0,4), pw0[3]=PKW(P0,6), pw0); \
    VRD(1); SBAR(); GAPA(C0=__builtin_amdgcn_mfma_f32_32x32x16_bf16(kf[2],qr[1],C0,0,0,0),   P0[10],P0[11],P0[12],P0[13], pw1[0]=PKW(P0,8), pw1[1]=PKW(P0,10), pw1); \
    VRD(5); SBAR(); GAPA(C1=__builtin_amdgcn_mfma_f32_32x32x16_bf16(kf[3],qr[1],C1,0,0,0),   P0[14],P0[15],P1[0],P1[1],   pw1[2]=PKW(P0,12),pw1[3]=PKW(P0,14), pw1); \
    VRD(2); SBAR(); GAPA(C0=__builtin_amdgcn_mfma_f32_32x32x16_bf16(kf[4],qr[2],C0,0,0,0),   P1[2],P1[3],P1[4],P1[5],     pw2[0]=PKW(P1,0), pw2[1]=PKW(P1,2), pw2); \
    VRD(6); SBAR(); GAPA(C1=__builtin_amdgcn_mfma_f32_32x32x16_bf16(kf[5],qr[2],C1,0,0,0),   P1[6],P1[7],P1[8],P1[9],     pw2[2]=PKW(P1,4), pw2[3]=PKW(P1,6), pw2); \
    VRD(3); SBAR(); GAPA(C0=__builtin_amdgcn_mfma_f32_32x32x16_bf16(kf[6],qr[3],C0,0,0,0),   P1[10],P1[11],P1[12],P1[13], pw3[0]=PKW(P1,8), pw3[1]=PKW(P1,10), pw3); \
    VRD(7); SBAR(); GAPA(C1=__builtin_amdgcn_mfma_f32_32x32x16_bf16(kf[7],qr[3],C1,0,0,0),   P1[14],P1[15],0.f,0.f,       pw3[2]=PKW(P1,12),pw3[3]=PKW(P1,14), pw3); \
    l_reg+=sacc; \
    if(GK){DMA_K((t)+3,sl_cur);} if(GV){DMA_V((t)+1,sl_next);} \
    CMASK(C0,C1,t); \
    { float a=MX3(C0[0],C0[1],C1[0]),b=MX3(C0[2],C0[3],C1[1]); a=MX3(a,C1[2],C1[3]); \
      _Pragma("unroll") for(int r=4;r<16;r+=4){a=MX3(a,C0[r],C0[r+1]);b=MX3(b,C0[r+2],C0[r+3]);a=MX3(a,C1[r],C1[r+1]);b=MX3(b,C1[r+2],C1[r+3]);} \
      float rm=__builtin_fmaxf(a,b); { auto rr=__builtin_amdgcn_permlane32_swap(__float_as_uint(rm),__float_as_uint(rm),false,false); rm=__builtin_fmaxf(__uint_as_float(rr[0]),__uint_as_float(rr[1])); } \
      resc=false; \
      if(__builtin_expect(__any(rm>(float)THRL),0)){ const float dl=__builtin_fmaxf(rm,0.f); mhat+=dl; \
        _Pragma("unroll") for(int r=0;r<16;++r){C0[r]-=dl;C1[r]-=dl;} \
        _Pragma("unroll") for(int r=0;r<16;++r)negm[r]=-mhat; asm volatile("":"+v"(negm)); \
        const float f=__builtin_amdgcn_exp2f(-dl); l_reg*=f; if(hi==0)wsf[r32]=f; resc=true; } } \
    SBAR(); \
    GAPB(o[0]=__builtin_amdgcn_mfma_f32_32x32x16_bf16(PAF(0),VFR(0),o[0],0,0,0), C0,0); \
    GAPB(o[1]=__builtin_amdgcn_mfma_f32_32x32x16_bf16(PAF(0),VFR(4),o[1],0,0,0), C0,4); \
    KRD(GL,0); GAPB(o[0]=__builtin_amdgcn_mfma_f32_32x32x16_bf16(PAF(1),VFR(1),o[0],0,0,0), C0,8); \
    KRD(GL,1); GAPB(o[1]=__builtin_amdgcn_mfma_f32_32x32x16_bf16(PAF(1),VFR(5),o[1],0,0,0), C0,12); \
    KRD(GL,2); GAPB(o[0]=__builtin_amdgcn_mfma_f32_32x32x16_bf16(PAF(2),VFR(2),o[0],0,0,0), C1,0); \
    KRD(GL,3); GAPB(o[1]=__builtin_amdgcn_mfma_f32_32x32x16_bf16(PAF(2),VFR(6),o[1],0,0,0), C1,4); \
    GAPB(o[0]=__builtin_amdgcn_mfma_f32_32x32x16_bf16(PAF(3),VFR(3),o[0],0,0,0), C1,8); \
    GAPB(o[1]=__builtin_amdgcn_mfma_f32_32x32x16_bf16(PAF(3),VFR(7),o[1],0,0,0), C1,12); \
    }while(0)
  int t=1;
  #undef CMASK
  #define CMASK(P0,P1,t) do{}while(0)
  for(;t+5<NT;t+=2){
    STEP(pB0,pB1,pA0,pA1,t,true,true,true);     WAIT_BAR(2); RESC(); ROT();
    STEP(pA0,pA1,pB0,pB1,t+1,true,true,true);   WAIT_BAR(2); RESC(); ROT();
  }
  #undef CMASK
  #define CMASK(P0,P1,t) do{}while(0)
  #define ENDW(tt) do{ if((tt)+3<NT){WAIT_BAR(2);} else if((tt)+2<NT){WAIT_BAR(1);} else {WAIT_BAR(0);} }while(0)
  for(;t+1<NT;t+=2){
    STEP(pB0,pB1,pA0,pA1,t,(t+3<NT),(t+1<NT),(t+1<NT));       ENDW(t);   RESC(); ROT();
    STEP(pA0,pA1,pB0,pB1,t+1,(t+4<NT),(t+2<NT),(t+2<NT));     ENDW(t+1); RESC(); ROT();
  }
  STEP(pB0,pB1,pA0,pA1,NT-1,false,false,false); RESC();
  { float sacc=pB0[0]+pB0[1]; _Pragma("unroll") for(int r=2;r<16;++r)sacc+=pB0[r]; _Pragma("unroll") for(int r=0;r<16;++r)sacc+=pB1[r]; l_reg+=sacc;
    pw0=(u32x4){PKW(pB0,0),PKW(pB0,2),PKW(pB0,4),PKW(pB0,6)};pw1=(u32x4){PKW(pB0,8),PKW(pB0,10),PKW(pB0,12),PKW(pB0,14)};pw2=(u32x4){PKW(pB1,0),PKW(pB1,2),PKW(pB1,4),PKW(pB1,6)};pw3=(u32x4){PKW(pB1,8),PKW(pB1,10),PKW(pB1,12),PKW(pB1,14)};
    SBAR(); pv(o,vb0+sl_cur,PAF(0),PAF(1),PAF(2),PAF(3)); }
  #undef PKW
  #undef PAF
  #undef VFR
  #undef PIN
  #undef MX3
  #undef GAPA
  #undef GAPB
  #undef EX
  #undef VRD
  #undef KRD
  #undef STEP
  #undef ENDW
  {auto rr=__builtin_amdgcn_permlane32_swap(__float_as_uint(l_reg),__float_as_uint(l_reg),false,false);l_reg=__uint_as_float(rr[0])+__uint_as_float(rr[1]);}
  if(hi==0)wsf[32+r32]=l_reg;asm volatile("s_waitcnt lgkmcnt(0)":::"memory");
  float rli[16];
  #pragma unroll
  for(int r=0;r<16;++r)rli[r]=__builtin_amdgcn_rcpf(wsf[32+crow(r,hi)]);
  bf16*Ow=O+(qrow0+wid*QBLK)*DM+vcol;
  { bf16*stg=(bf16*)(shm+LDS_OST)+wid*2048;
    #pragma unroll
    for(int r=0;r<16;++r){const int orow=crow(r,hi);
      #pragma unroll
      for(int d0=0;d0<2;++d0)stg[orow*64+d0*32+r32]=(bf16)f2bf(o[d0][r]*rli[r]);}
    asm volatile("s_waitcnt lgkmcnt(0)":::"memory");
    #pragma unroll
    for(int i=0;i<4;++i){const int row=i*8+(lane>>3),ch=lane&7; const u32x4 v=*(const u32x4*)(stg+row*64+ch*8); ATTN_STORE16(Ow+(long)row*DM+ch*8,v);} }
  asm volatile("s_waitcnt lgkmcnt(0)\n\ts_barrier":::"memory");
  #undef DMA_K
  #undef DMA_V
  #undef CMASK
  #undef START
  #undef RESC
  #undef ROT
}
constexpr int ATTN_LDS_BYTES=LDS_BYTES;
#undef SBAR
#undef WAIT_BAR
#undef KVROW
}
namespace attn_body {
constexpr int V2SLOT = 16384;
constexpr int L2_K = 0, L2_V = NSLOT * SLOTB, L2_WS = L2_V + NSLOT * V2SLOT, L2_OST = L2_WS + NW * 64 * 4, L2_BYTES = L2_OST + NW * 4096;
#define SBAR() __builtin_amdgcn_sched_barrier(0)
#define WAIT_BAR(N) asm volatile("s_waitcnt vmcnt(" #N ") lgkmcnt(0)\n\ts_barrier":::"memory")
template<int THRL> __device__ __forceinline__ void attn_unit2(long qrow0,int qcol,int vcol,long kctx,long klat,int NT,const bf16*Q,const bf16*__restrict__ K,const bf16*__restrict__ V,bf16*O,char*shm){
  const int tid=threadIdx.x,lane=tid&63,r32=lane&31,hi=lane>>5; const int wid=__builtin_amdgcn_readfirstlane(tid>>6);
  const bf16*Qw=Q+(qrow0+wid*QBLK)*DM+qcol;
  const bf16*Kh=K+qcol,*Vh=V+vcol;
  const unsigned lds0=(unsigned)(uintptr_t)shm;
  float*wsf=(float*)(shm+L2_WS)+wid*64;
  const bf16*ksrc=Kh+(long)lane*DM+wid*8;
  const bf16*vsrc=Vh+(long)(16*(wid&3)+(lane>>2))*DM+(wid>>2)*32+(lane&3)*8;
  const unsigned kdst=lds0+L2_K+wid*1024, vdst=lds0+L2_V+wid*1024;
  #define KVROW(t) ((t)<4?kctx+(long)(t)*KVBLK:klat+(long)((t)-4)*KVBLK)
  #define DMA_K(t,slot) glds16(ksrc+KVROW(t)*DM,(unsigned)__builtin_amdgcn_readfirstlane(kdst+(slot)))
  #define DMA_V(t,slot) do{ glds16(vsrc+KVROW(t)*DM,(unsigned)__builtin_amdgcn_readfirstlane(vdst+2*(slot))); glds16(vsrc+KVROW(t)*DM+64,(unsigned)__builtin_amdgcn_readfirstlane(vdst+2*(slot)+8192)); }while(0)
  const char*Kbase=shm+L2_K; bf16x8 kf[8];
  const lds_cptr shm3=(lds_cptr)shm; const lds_cptr kp0=shm3+L2_K+hi*1024+r32*16; const lds_cptr vp0=shm3+L2_V+((lane>>4)&1)*32+(lane&3)*8+(4*hi+((lane&15)>>2))*64;
  DMA_K(0,0);DMA_V(0,0);DMA_K(1,SLOTB);
  bf16x8 qr[4];
  #pragma unroll
  for(int d0=0;d0<4;++d0)qr[d0]=*reinterpret_cast<const bf16x8*>(&Qw[(long)r32*DM+d0*16+hi*8]);
  float mhat=0.f,l_reg=0.f;f32x16 o[4];o[0]=f32x16{};o[1]=f32x16{};o[2]=f32x16{};o[3]=f32x16{};const f32x16 zero16=f32x16{};
  bool resc=false;
  #define START(P0,P1) do{ const float rm=rowmax(P0,P1); resc=false; mhat=rm; \
    _Pragma("unroll") for(int r=0;r<16;++r){P0[r]=fsub_s(P0[r],rm);P1[r]=fsub_s(P1[r],rm);} \
    _Pragma("unroll") for(int r=0;r<16;++r)P0[r]=__builtin_amdgcn_exp2f(P0[r]); }while(0)
  #define RESC() do{ if(resc){ asm volatile("s_waitcnt lgkmcnt(0)":::"memory"); \
      _Pragma("unroll") for(int d_=0;d_<4;++d_) _Pragma("unroll") for(int r=0;r<16;++r)o[d_][r]*=wsf[crow(r,hi)]; } }while(0)
  int sl_prev=0,sl_cur=0,sl_next=SLOTB;
  #define ROT() do{sl_prev=sl_cur;sl_cur=sl_next;sl_next=(sl_next==(NSLOT-1)*SLOTB)?0:sl_next+SLOTB;}while(0)
  DMA_K(2,2*SLOTB);
  WAIT_BAR(4);
  #define PKW(P,B) cvtpk_s(P[B],P[B+1])
  u32x4 pwA0,pwA1,pwA2,pwA3,pwB0,pwB1,pwB2,pwB3;
  { f32x16 p0,p1;
    qkt(p0,p1,Kbase,qr,zero16,r32,hi);asm volatile("s_nop 15\n\ts_nop 7":"+v"(p0),"+v"(p1));
    START(p0,p1);
    _Pragma("unroll") for(int r=0;r<16;++r)p1[r]=__builtin_amdgcn_exp2f(p1[r]);
    float sacc=p0[0]+p0[1]; _Pragma("unroll") for(int r=2;r<16;++r)sacc+=p0[r]; _Pragma("unroll") for(int r=0;r<16;++r)sacc+=p1[r]; l_reg+=sacc;
    pwA0=(u32x4){PKW(p0,0),PKW(p0,2),PKW(p0,4),PKW(p0,6)};pwA1=(u32x4){PKW(p0,8),PKW(p0,10),PKW(p0,12),PKW(p0,14)};pwA2=(u32x4){PKW(p1,0),PKW(p1,2),PKW(p1,4),PKW(p1,6)};pwA3=(u32x4){PKW(p1,8),PKW(p1,10),PKW(p1,12),PKW(p1,14)}; }
  WAIT_BAR(0);
  DMA_K(3,0);DMA_V(1,SLOTB);
  ROT();
  kload8(kf,kp0+sl_cur);
  WAIT_BAR(3);
  s16x4 vAl[4],vAh[4],vBl[4],vBh[4];
  #define PAFX(x) __builtin_bit_cast(bf16x8,x)
  #define VF(A,d) (bf16x8){A##l[d][0],A##l[d][1],A##l[d][2],A##l[d][3],A##h[d][0],A##h[d][1],A##h[d][2],A##h[d][3]}
  #define PIN(x) asm volatile("":"+v"(x))
  #define MX3(a,b,c) __builtin_fmaxf(__builtin_fmaxf((a),(b)),(c))
  #define EX(v) __builtin_amdgcn_exp2f(v)
  #define VRDL(A,d,ks) A##l[d]=vtr(vp_+((d)*4096+(ks)*1024))
  #define VRDH(A,d,ks) A##h[d]=vtr(vp_+((d)*4096+(ks)*1024+512))
  #define GAPP(MF,X,B,PWN,W,RD) do{ MF; X[B]=EX(X[B]-mhat); X[B+1]=EX(X[B+1]-mhat); sacc+=X[B]; sacc+=X[B+1]; PIN(sacc); PWN[W]=cvtpk_s(X[B],X[B+1]); PIN(PWN); RD; SBAR(); }while(0)
  #define MFQ(C,kf_,q_,acc_) C=__builtin_amdgcn_mfma_f32_32x32x16_bf16(kf_,q_,acc_,0,0,0)
  #define MFO(d,PW,A) o[d]=__builtin_amdgcn_mfma_f32_32x32x16_bf16(PAFX(PW),VF(A,d),o[d],0,0,0)
  #define KRD(G,j) do{ if(G){ kload2(kf,kp0+sl_next,j); } }while(0)
  #define STEP2(t,PI0,PI1,PI2,PI3,PO0,PO1,PO2,PO3,GK,GV,GL) do{ SBAR(); \
    const lds_cptr vp_=vp0+2*sl_prev; f32x16 C0,C1; float sacc=0.f; \
    VRDL(vA,0,0); SBAR(); MFQ(C0,kf[0],qr[0],zero16); SBAR(); \
    VRDH(vA,0,0); SBAR(); MFQ(C1,kf[1],qr[0],zero16); SBAR(); \
    VRDL(vA,1,0); SBAR(); MFQ(C0,kf[2],qr[1],C0); SBAR(); \
    VRDH(vA,1,0); SBAR(); MFQ(C1,kf[3],qr[1],C1); SBAR(); \
    VRDL(vA,2,0); SBAR(); MFQ(C0,kf[4],qr[2],C0); SBAR(); \
    VRDH(vA,2,0); SBAR(); MFQ(C1,kf[5],qr[2],C1); SBAR(); \
    VRDL(vA,3,0); SBAR(); MFQ(C0,kf[6],qr[3],C0); SBAR(); \
    VRDH(vA,3,0); SBAR(); MFQ(C1,kf[7],qr[3],C1); SBAR(); \
    if(GK){DMA_K((t)+3,sl_cur);} if(GV){DMA_V((t)+1,sl_next);} \
    { float a=MX3(C0[0],C0[1],C1[0]),b=MX3(C0[2],C0[3],C1[1]); a=MX3(a,C1[2],C1[3]); \
      _Pragma("unroll") for(int r=4;r<16;r+=4){a=MX3(a,C0[r],C0[r+1]);b=MX3(b,C0[r+2],C0[r+3]);a=MX3(a,C1[r],C1[r+1]);b=MX3(b,C1[r+2],C1[r+3]);} \
      float rm=__builtin_fmaxf(a,b); { auto rr=__builtin_amdgcn_permlane32_swap(__float_as_uint(rm),__float_as_uint(rm),false,false); rm=__builtin_fmaxf(__uint_as_float(rr[0]),__uint_as_float(rr[1])); } \
      resc=false; \
      if(__builtin_expect(__any(rm-mhat>(float)THRL),0)){ const float dl=__builtin_fmaxf(rm-mhat,0.f); mhat+=dl; \
        const float f=__builtin_amdgcn_exp2f(-dl); l_reg*=f; if(hi==0)wsf[r32]=f; resc=true; } } \
    SBAR(); \
    GAPP(MFO(0,PI0,vA),C0,0, PO0,0, VRDL(vB,0,1);VRDH(vB,0,1)); \
    GAPP(MFO(1,PI0,vA),C0,2, PO0,1, VRDL(vB,1,1);VRDH(vB,1,1)); \
    GAPP(MFO(2,PI0,vA),C0,4, PO0,2, VRDL(vB,2,1);VRDH(vB,2,1)); \
    GAPP(MFO(3,PI0,vA),C0,6, PO0,3, VRDL(vB,3,1);VRDH(vB,3,1)); \
    GAPP(MFO(0,PI1,vB),C0,8, PO1,0, VRDL(vA,0,2);VRDH(vA,0,2)); \
    GAPP(MFO(1,PI1,vB),C0,10,PO1,1, VRDL(vA,1,2);VRDH(vA,1,2)); \
    GAPP(MFO(2,PI1,vB),C0,12,PO1,2, VRDL(vA,2,2);VRDH(vA,2,2)); \
    GAPP(MFO(3,PI1,vB),C0,14,PO1,3, VRDL(vA,3,2);VRDH(vA,3,2)); \
    GAPP(MFO(0,PI2,vA),C1,0, PO2,0, VRDL(vB,0,3);VRDH(vB,0,3)); \
    GAPP(MFO(1,PI2,vA),C1,2, PO2,1, VRDL(vB,1,3);VRDH(vB,1,3)); \
    GAPP(MFO(2,PI2,vA),C1,4, PO2,2, VRDL(vB,2,3);VRDH(vB,2,3)); \
    GAPP(MFO(3,PI2,vA),C1,6, PO2,3, VRDL(vB,3,3);VRDH(vB,3,3)); \
    GAPP(MFO(0,PI3,vB),C1,8, PO3,0, KRD(GL,0)); \
    GAPP(MFO(1,PI3,vB),C1,10,PO3,1, KRD(GL,1)); \
    GAPP(MFO(2,PI3,vB),C1,12,PO3,2, KRD(GL,2)); \
    GAPP(MFO(3,PI3,vB),C1,14,PO3,3, KRD(GL,3)); \
    l_reg+=sacc; \
    }while(0)
  #define ENDW(tt) do{ if((tt)+3<NT){WAIT_BAR(3);} else if((tt)+2<NT){WAIT_BAR(2);} else {WAIT_BAR(0);} }while(0)
  int t=1;
  for(;t+5<NT;t+=2){
    STEP2(t,  pwA0,pwA1,pwA2,pwA3,pwB0,pwB1,pwB2,pwB3,true,true,true); WAIT_BAR(3); RESC(); ROT();
    STEP2(t+1,pwB0,pwB1,pwB2,pwB3,pwA0,pwA1,pwA2,pwA3,true,true,true); WAIT_BAR(3); RESC(); ROT();
  }
  for(;t+1<NT;t+=2){
    STEP2(t,  pwA0,pwA1,pwA2,pwA3,pwB0,pwB1,pwB2,pwB3,(t+3<NT),(t+1<NT),(t+1<NT)); ENDW(t);   RESC(); ROT();
    STEP2(t+1,pwB0,pwB1,pwB2,pwB3,pwA0,pwA1,pwA2,pwA3,(t+4<NT),(t+2<NT),(t+2<NT)); ENDW(t+1); RESC(); ROT();
  }
  STEP2(NT-1,pwA0,pwA1,pwA2,pwA3,pwB0,pwB1,pwB2,pwB3,false,false,false); RESC();
  { const lds_cptr vp_=vp0+2*sl_cur;
    #pragma unroll
    for(int ks=0;ks<4;++ks){
      #pragma unroll
      for(int d=0;d<4;++d){ const s16x4 lo=vtr(vp_+(d*4096+ks*1024)),hh=vtr(vp_+(d*4096+ks*1024+512)); const bf16x8 vf=(bf16x8){lo[0],lo[1],lo[2],lo[3],hh[0],hh[1],hh[2],hh[3]};
        const u32x4 pw=(ks==0)?pwB0:(ks==1)?pwB1:(ks==2)?pwB2:pwB3;
        o[d]=__builtin_amdgcn_mfma_f32_32x32x16_bf16(PAFX(pw),vf,o[d],0,0,0); } } }
  {auto rr=__builtin_amdgcn_permlane32_swap(__float_as_uint(l_reg),__float_as_uint(l_reg),false,false);l_reg=__uint_as_float(rr[0])+__uint_as_float(rr[1]);}
  if(hi==0)wsf[32+r32]=l_reg;asm volatile("s_waitcnt lgkmcnt(0)":::"memory");
  float rli[16];
  #pragma unroll
  for(int r=0;r<16;++r)rli[r]=__builtin_amdgcn_rcpf(wsf[32+crow(r,hi)]);
  bf16*Ow=O+(qrow0+wid*QBLK)*DM+vcol;
  { bf16*stg=(bf16*)(shm+L2_OST)+wid*2048;
    #pragma unroll
    for(int hf=0;hf<2;++hf){
      #pragma unroll
      for(int r=0;r<16;++r){const int orow=crow(r,hi);
        #pragma unroll
        for(int d0=0;d0<2;++d0)stg[orow*64+d0*32+r32]=(bf16)f2bf(o[2*hf+d0][r]*rli[r]);}
      asm volatile("s_waitcnt lgkmcnt(0)":::"memory");
      #pragma unroll
      for(int i=0;i<4;++i){const int row=i*8+(lane>>3),ch=lane&7; const u32x4 v=*(const u32x4*)(stg+row*64+ch*8); *(u32x4*)(Ow+(long)row*DM+hf*64+ch*8)=v;}
      asm volatile("s_waitcnt lgkmcnt(0)":::"memory"); } }
  asm volatile("s_waitcnt lgkmcnt(0)\n\ts_barrier":::"memory");
  #undef KVROW
  #undef DMA_K
  #undef DMA_V
  #undef START
  #undef RESC
  #undef ROT
  #undef PKW
  #undef PAFX
  #undef VF
  #undef PIN
  #undef MX3
  #undef EX
  #undef VRDL
  #undef VRDH
  #undef GAPP
  #undef MFQ
  #undef MFO
  #undef KRD
  #undef STEP2
  #undef ENDW
}
#undef SBAR
#undef WAIT_BAR
}
__device__ __forceinline__ void phase_attn2(const Frame& F, const Prm& p) {
    const bf16* Q = (const bf16*)(p.ws + WS_Q); const bf16* K = (const bf16*)(p.ws + WS_K); const bf16* V = (const bf16*)(p.ws + WS_V); bf16* O1 = (bf16*)(p.ws + WS_O1);
    for (int v = vcu_of(F); v < 256; v += F.G) {
        const int b = v >> 5, hm = (v >> 1) & 15, h = hm >> 1, m = hm & 1, half = v & 1;
        const int qcol = hm * 64, vcol = h * 128; bf16* O = O1 + (size_t)m * ((WS_O2 - WS_O1) / 2);
        const long kctx = NLAT + b * CTXL, klat = (long)b * SEQ;
        const int nu = half ? 8 : 9;
        for (int i = 0; i < nu; ++i) {
            const long qrow0 = i < 8 ? klat + (half * 8 + i) * 256 : kctx; const int NT = i < 8 ? 68 : 4;
            attn_body::attn_unit2<8>(qrow0, qcol, vcol, kctx, klat, NT, Q, K, V, O, (char*)F.lds);
        }
    }
}
namespace gla3 {
typedef short bf16x8 __attribute__((ext_vector_type(8)));
typedef short s16x4 __attribute__((ext_vector_type(4)));
typedef float f32x16 __attribute__((ext_vector_type(16)));
constexpr int CH = 64 * 16 + 64;
constexpr int L_QS = 0, L_KS = 16 * CH, L_VS = 32 * CH, L_SB = 40 * CH, L_X = 56 * CH, L_DEC = L_X + 16384, L_END = L_DEC + 512;
__device__ __forceinline__ int crow(int i, int hh) { return (i & 3) + 8 * (i >> 2) + 4 * hh; }
typedef float f32x2_t __attribute__((ext_vector_type(2))); typedef __bf16 bf16x2_t __attribute__((ext_vector_type(2)));
__device__ __forceinline__ unsigned pk(float lo, float hi) { f32x2_t v = {lo, hi}; bf16x2_t b = __builtin_convertvector(v, bf16x2_t); return __builtin_bit_cast(unsigned, b); }
typedef short v4i16_t __attribute__((ext_vector_type(4)));
__device__ __forceinline__ s16x4 trrd(LAS const unsigned char* p) { return __builtin_bit_cast(s16x4, __builtin_amdgcn_ds_read_tr16_b64_v4i16((LAS v4i16_t*)p)); }
#define GLA_FR(lo, hi) (bf16x8){lo[0], lo[1], lo[2], lo[3], hi[0], hi[1], hi[2], hi[3]}

__device__ __forceinline__ void scan_unit(const Frame& F, const Prm& p, int unit) {
    const int dvs = unit & 3, dir = (unit >> 2) & 1, h = (unit >> 3) & 3, b = unit >> 5;
    LAS unsigned char* lds = (LAS unsigned char*)F.lds;
    const int lane = F.lane, w = F.wave, tid = F.tid, r = lane & 31, hh = lane >> 5;
    const bf16* QT = (const bf16*)(p.ws + WS_QT) + (size_t)dir * NTOK * 512 + h * 128;
    const bf16* KT = (const bf16*)(p.ws + WS_KT) + (size_t)dir * NTOK * 512 + h * 128;
    const bf16* V = (const bf16*)(p.ws + WS_V1) + h * 256 + dvs * 64;
    const float* DEC = (const float*)(p.ws + WS_DEC) + (size_t)dir * NCHUNK * 512 + h * 128;
    bf16* OG = (bf16*)(p.ws + (dir ? WS_OGB : WS_OGF)) + h * 256 + dvs * 64;
    const int g1 = (lane >> 4) & 1, q4 = (lane & 15) >> 2, p4 = lane & 3;
    const int trb = (2 * g1 + (p4 >> 1)) * CH + q4 * 16 + 8 * (p4 & 1);
    const int trN = trb + 128 * hh, trP = trb + 64 * hh;
    f32x16 S0 = {}, S1 = {};
    for (int i = tid; i < 16 * CH / 16; i += NTHR) *(LAS u32x4*)(lds + L_SB + i * 16) = (u32x4){0u, 0u, 0u, 0u};
    u32x4 pq0[2], pq1[2], pk0[2], pk1[2], pv[2]; float pdec[2] = {0.f, 0.f};
#define GLA_CHUNK(step) ((step) >= 4 ? b * 64 + (dir ? 63 - ((step) - 4) : (step) - 4) : 512 + b * 4 + (dir ? 3 - (step) : (step)))
    const int qrow = 8 * w + (lane >> 4), qch = lane & 15, vrow = 8 * w + (lane >> 3), vch = lane & 7;
#define GLA_LOAD(step, u) do { const size_t t0_ = (size_t)GLA_CHUNK(step) * 64; \
        pq0[u] = *(const u32x4*)(QT + (t0_ + qrow) * 512 + 8 * qch); pq1[u] = *(const u32x4*)(QT + (t0_ + qrow + 4) * 512 + 8 * qch); \
        pk0[u] = *(const u32x4*)(KT + (t0_ + qrow) * 512 + 8 * qch); pk1[u] = *(const u32x4*)(KT + (t0_ + qrow + 4) * 512 + 8 * qch); \
        pv[u] = *(const u32x4*)(V + (t0_ + vrow) * 1024 + 8 * vch); if (tid < 128) pdec[u] = DEC[(size_t)GLA_CHUNK(step) * 512 + tid]; } while (0)
#define GLA_STORE(u) do { \
        *(LAS u32x4*)(lds + L_QS + qch * CH + qrow * 16) = pq0[u]; *(LAS u32x4*)(lds + L_QS + qch * CH + (qrow + 4) * 16) = pq1[u]; \
        *(LAS u32x4*)(lds + L_KS + qch * CH + qrow * 16) = pk0[u]; *(LAS u32x4*)(lds + L_KS + qch * CH + (qrow + 4) * 16) = pk1[u]; \
        *(LAS u32x4*)(lds + L_VS + vch * CH + vrow * 16) = pv[u]; \
        if (tid < 128) *(LAS float*)(lds + L_DEC + 4 * tid) = pdec[u]; } while (0)
    GLA_LOAD(0, 0);
    GLA_LOAD(1, 1);
    GLA_STORE(0);
    __syncthreads();
    const int tb = (w & 3) >> 1, vb = w & 1;
    for (int sp2 = 0; sp2 < 34; ++sp2) {
#pragma unroll
    for (int u = 0; u < 2; ++u) {
        const int step = 2 * sp2 + u;
        const bool lat = step >= 4; const int chunk = GLA_CHUNK(step);
        if (step + 2 < 68) GLA_LOAD(step + 2, u);
        f32x16 o = {};
        if (w < 4) {
            if (lat) {
                const bool n0 = dir ? (tb == 0) : true, n1 = dir ? true : (tb == 1);
                f32x16 sc0 = {}, sc1 = {};
#define GLA_BQ(ks) (*(const LAS bf16x8*)(lds + L_QS + (2 * (ks) + hh) * CH + (32 * tb + r) * 16))
#define GLA_A0(ks) (*(const LAS bf16x8*)(lds + L_KS + (2 * (ks) + hh) * CH + r * 16))
#define GLA_A1(ks) (*(const LAS bf16x8*)(lds + L_KS + (2 * (ks) + hh) * CH + (32 + r) * 16))
                if (n0 && n1) {
#pragma unroll
                    for (int ks = 0; ks < 8; ++ks) { const bf16x8 bq = GLA_BQ(ks); sc0 = __builtin_amdgcn_mfma_f32_32x32x16_bf16(GLA_A0(ks), bq, sc0, 0, 0, 0); sc1 = __builtin_amdgcn_mfma_f32_32x32x16_bf16(GLA_A1(ks), bq, sc1, 0, 0, 0); }
                } else if (n0) {
#pragma unroll
                    for (int ks = 0; ks < 8; ++ks) sc0 = __builtin_amdgcn_mfma_f32_32x32x16_bf16(GLA_A0(ks), GLA_BQ(ks), sc0, 0, 0, 0);
                } else {
#pragma unroll
                    for (int ks = 0; ks < 8; ++ks) sc1 = __builtin_amdgcn_mfma_f32_32x32x16_bf16(GLA_A1(ks), GLA_BQ(ks), sc1, 0, 0, 0);
                }
#undef GLA_BQ
#undef GLA_A0
#undef GLA_A1
                const int t = 32 * tb + r;
#pragma unroll
                for (int i = 0; i < 16; ++i) { const int s0 = crow(i, hh), s1 = 32 + s0; const bool k0 = dir ? (s0 >= t) : (s0 <= t), k1 = dir ? (s1 >= t) : (s1 <= t); sc0[i] = k0 ? sc0[i] : 0.f; sc1[i] = k1 ? sc1[i] : 0.f; }
#pragma unroll
                for (int sb = 0; sb < 2; ++sb) { if (sb == 0 ? n0 : n1) {
#pragma unroll
                    for (int sp = 0; sp < 2; ++sp) {
                        u32x4 pw;
                        if (sb == 0) { pw.x = pk(sc0[8 * sp + 0], sc0[8 * sp + 1]); pw.y = pk(sc0[8 * sp + 2], sc0[8 * sp + 3]); pw.z = pk(sc0[8 * sp + 4], sc0[8 * sp + 5]); pw.w = pk(sc0[8 * sp + 6], sc0[8 * sp + 7]); }
                        else { pw.x = pk(sc1[8 * sp + 0], sc1[8 * sp + 1]); pw.y = pk(sc1[8 * sp + 2], sc1[8 * sp + 3]); pw.z = pk(sc1[8 * sp + 4], sc1[8 * sp + 5]); pw.w = pk(sc1[8 * sp + 6], sc1[8 * sp + 7]); }
                        LAS const unsigned char* vp = lds + L_VS + trP + (4 * vb) * CH + (32 * sb + 16 * sp) * 16;
                        const s16x4 lo = trrd(vp), hi = trrd(vp + 8 * 16);
                        o = __builtin_amdgcn_mfma_f32_32x32x16_bf16(GLA_FR(lo, hi), __builtin_bit_cast(bf16x8, pw), o, 0, 0, 0);
                    } } }
            }
        } else {
            const int db = w - 4;
            if (lat) {
                f32x16 o2 = {};
#pragma unroll
                for (int ks = 0; ks < 8; ++ks) {
                    const bf16x8 as = *(const LAS bf16x8*)(lds + L_SB + (2 * ks + hh) * CH + (32 * vb + r) * 16);
                    const bf16x8 bq = *(const LAS bf16x8*)(lds + L_QS + (2 * ks + hh) * CH + (32 * tb + r) * 16);
                    o2 = __builtin_amdgcn_mfma_f32_32x32x16_bf16(as, bq, o2, 0, 0, 0);
                }
#pragma unroll
                for (int g = 0; g < 4; ++g) *(LAS f32x4*)(lds + L_X + (w & 3) * 4096 + g * 1024 + lane * 16) = (f32x4){o2[4 * g], o2[4 * g + 1], o2[4 * g + 2], o2[4 * g + 3]};
            }
#pragma unroll
            for (int ks = 0; ks < 4; ++ks) {
                LAS const unsigned char* kp = lds + L_KS + trN + (4 * db) * CH + (16 * ks) * 16;
                LAS const unsigned char* vp = lds + L_VS + trN + (16 * ks) * 16;
                const s16x4 al = trrd(kp), ah = trrd(kp + 4 * 16);
                const s16x4 b0l = trrd(vp), b0h = trrd(vp + 4 * 16), b1l = trrd(vp + 4 * CH), b1h = trrd(vp + 4 * CH + 4 * 16);
                S0 = __builtin_amdgcn_mfma_f32_32x32x16_bf16(GLA_FR(al, ah), GLA_FR(b0l, b0h), S0, 0, 0, 0); S1 = __builtin_amdgcn_mfma_f32_32x32x16_bf16(GLA_FR(al, ah), GLA_FR(b1l, b1h), S1, 0, 0, 0);
            }
#pragma unroll
            for (int i = 0; i < 16; ++i) { const float dc = *(const LAS float*)(lds + L_DEC + 4 * (32 * db + crow(i, hh))); S0[i] *= dc; S1[i] *= dc; }
        }
        __syncthreads();
        if (w < 4 && lat) {
            bf16* orow = OG + ((size_t)chunk * 64 + 32 * tb + r) * DM + 32 * vb + 4 * hh;
#pragma unroll
            for (int g = 0; g < 4; ++g) { const f32x4 x = *(const LAS f32x4*)(lds + L_X + w * 4096 + g * 1024 + lane * 16);
                u32x2 wv; wv.x = pk(o[4 * g] + x.x, o[4 * g + 1] + x.y); wv.y = pk(o[4 * g + 2] + x.z, o[4 * g + 3] + x.w); *(u32x2*)(orow + 8 * g) = wv; }
        }
        if (step + 1 < 68) {
            GLA_STORE(u ^ 1);
            if (w >= 4) { const int db = w - 4;
#pragma unroll
                for (int g = 0; g < 4; ++g) { u32x2 w0, w1; w0.x = pk(S0[4 * g], S0[4 * g + 1]); w0.y = pk(S0[4 * g + 2], S0[4 * g + 3]); w1.x = pk(S1[4 * g], S1[4 * g + 1]); w1.y = pk(S1[4 * g + 2], S1[4 * g + 3]);
                    *(LAS u32x2*)(lds + L_SB + (4 * db + g) * CH + r * 16 + 8 * hh) = w0; *(LAS u32x2*)(lds + L_SB + (4 * db + g) * CH + (32 + r) * 16 + 8 * hh) = w1; } }
        }
        __syncthreads();
    }
    }
#undef GLA_CHUNK
#undef GLA_LOAD
#undef GLA_STORE
}
#undef GLA_FR
}
__device__ __forceinline__ void phase_scan_opt(const Frame& F, const Prm& p) {
    for (int unit = vcu_of(F); unit < 256; unit += F.G) gla3::scan_unit(F, p, unit);
}
#define PHASE_QKV(F, p) phase_qkv_opt(F, p)
#define PHASE_ATTN(F, p) phase_attn2(F, p)
#define PHASE_WO(F, p, l) phase_wo_opt(F, p, l)
#define PHASE_MOE1(F, p, l) phase_moe1_opt(F, p, l)
#define PHASE_MOE2(F, p, l) phase_moe2_opt(F, p, l)
#define PHASE_INPROJ(F, p) phase_inproj_opt(F, p)
#define PHASE_SCAN(F, p) phase_scan_opt(F, p)
typedef GAS unsigned gu32;
#define XB_TMO      128
#define XB_XCNT(j)  (256  + 64 * (j))
#define XB_XSUB(j)  (1280 + 64 * (j))
#define XB_XGEN(j)  (2304 + 64 * (j))
#define XB_TOP      3328
#define XB_TOPGEN   3392
#define XCD_BAR_WORDS 3456
#define XB_SPIN_CAP (1u << 20)
__device__ __forceinline__ unsigned xb_ld(unsigned* p)              { return __hip_atomic_load(p, __ATOMIC_RELAXED, __HIP_MEMORY_SCOPE_AGENT); }
__device__ __forceinline__ unsigned xb_add(unsigned* p, unsigned v) { return __hip_atomic_fetch_add(p, v, __ATOMIC_RELAXED, __HIP_MEMORY_SCOPE_AGENT); }
__device__ __forceinline__ unsigned xb_xcc_id() { return (unsigned)__builtin_amdgcn_s_getreg((3 << 11) | 20) & 0xFu; }
#define XB_SPIN(cond, bar) do { unsigned _sp = 0; while (cond) { __builtin_amdgcn_s_sleep(1); \
    if ((++_sp & 255u) == 0u) { if (xb_ld(&(bar)[XB_TMO])) break; if (_sp > XB_SPIN_CAP) { atomicAdd(&(bar)[XB_TMO], 1u); break; } } } } while (0)
struct XcdBarrier { unsigned* bar; unsigned x; volatile LAS unsigned* st; };
__device__ __forceinline__ XcdBarrier xcd_barrier_post(unsigned* bar, volatile LAS unsigned* st) {
    XcdBarrier b; b.bar = bar; b.x = xb_xcc_id(); b.st = st;
    if (threadIdx.x == 0) (void)xb_add(&bar[XB_XCNT(b.x)], 1u);
    return b;
}
__device__ __forceinline__ void xcd_barrier_complete(unsigned* bar, unsigned x, unsigned& nloc, unsigned& nx) {
    const unsigned G = gridDim.x * gridDim.y * gridDim.z;
    unsigned sum, cnt, mine, sp = 0u;
    for (;;) {
        sum = 0u; cnt = 0u; mine = 0u;
#pragma unroll
        for (unsigned j = 0; j < 16; ++j) { const unsigned c = xb_ld(&bar[XB_XCNT(j)]); sum += c; cnt += (c > 0u) ? 1u : 0u; mine = (j == x) ? c : mine; }
        if (sum == G) break;
        __builtin_amdgcn_s_sleep(1);
        if ((++sp & 255u) == 0u) { if (xb_ld(&bar[XB_TMO])) break; if (sp > XB_SPIN_CAP) { atomicAdd(&bar[XB_TMO], 1u); break; } }
    }
    nloc = mine > 0u ? mine : 1u; nx = cnt > 0u ? cnt : 1u;
}
__device__ __forceinline__ void xcd_barrier(const XcdBarrier& b) {
    asm volatile("s_waitcnt vmcnt(0)" ::: "memory");
    __syncthreads();
    if (threadIdx.x == 0) {
        unsigned* bar = b.bar;
        __builtin_amdgcn_s_waitcnt(0);
        unsigned nloc = b.st[0], nx = b.st[1];
        if (nloc == 0u) { xcd_barrier_complete(bar, b.x, nloc, nx); b.st[0] = nloc; b.st[1] = nx; }
        const unsigned old = xb_add(&bar[XB_XSUB(b.x)], 1u);
        const unsigned gen = old / nloc;
        if (old + 1u == (gen + 1u) * nloc) {
            __builtin_amdgcn_fence(__ATOMIC_RELEASE, "agent");
            asm volatile("s_waitcnt vmcnt(0)" ::: "memory");
            const unsigned og = xb_add(&bar[XB_TOP], 1u);
            const unsigned tg = og / nx;
            if (og + 1u == (tg + 1u) * nx) xb_add(&bar[XB_TOPGEN], 1u);
            else XB_SPIN(xb_ld(&bar[XB_TOPGEN]) == tg, bar);
            __builtin_amdgcn_fence(__ATOMIC_ACQUIRE, "agent");
            xb_add(&bar[XB_XGEN(b.x)], 1u);
            asm volatile("s_waitcnt vmcnt(0)" ::: "memory");
        } else {
            XB_SPIN(xb_ld(&bar[XB_XGEN(b.x)]) == gen, bar);
            __builtin_amdgcn_fence(__ATOMIC_ACQUIRE, "agent");
            asm volatile("s_waitcnt vmcnt(0)" ::: "memory");
        }
    }
    __syncthreads();
}

constexpr int NPHASE = 19;
#ifndef OPT_MASK
#define OPT_MASK 0u
#endif
__global__ void __launch_bounds__(NTHR, 2) mega_fwd(Prm p) {
    extern __shared__ __attribute__((aligned(16))) unsigned char lds[];
    Frame F; F.lds = lds; F.ctl = (unsigned*)(p.ws + WS_CTL);
    F.tid = threadIdx.x; F.lane = F.tid & 63; F.wave = __builtin_amdgcn_readfirstlane(F.tid >> 6); F.G = gridDim.x; F.bid = blockIdx.x;
    for (int u = F.tid; u < (LDS_BYTES - LDSCTL_OFF) / 4; u += NTHR) ((LAS unsigned*)(lds + LDSCTL_OFF))[u] = 0u;
    __syncthreads();
    const int lo = p.ph_lo, hi = p.ph_hi;
    const bool multi = (hi - lo) > 1;
    XcdBarrier bar; bar.bar = F.ctl + CW_BAR + p.li * XCD_BAR_WORDS; bar.x = 0; bar.st = nullptr;
    if (multi) bar = xcd_barrier_post(F.ctl + CW_BAR + p.li * XCD_BAR_WORDS, (volatile LAS unsigned*)(lds + MISC_OFF) + 8);
#define IN(k) (lo <= (k) && (k) < hi)
#define SEAM(k) do { if (IN(k) && IN((k) + 1)) xcd_barrier(bar); } while (0)
#ifndef REP_MASK
#define REP_MASK 0u
#endif
#define REP(k, call) do { if (((REP_MASK) >> (k)) & 1u) { xcd_barrier(bar); call; } } while (0)
    if (IN(0)) { phase_prologue(F, p); REP(0, phase_prologue(F, p)); } SEAM(0);
    if (IN(1)) { phase_modulate0(F, p); REP(1, phase_modulate0(F, p)); } SEAM(1);
    if (IN(2)) { PHASE_QKV(F, p); REP(2, PHASE_QKV(F, p)); } SEAM(2);
    if (IN(3)) { PHASE_ATTN(F, p); REP(3, PHASE_ATTN(F, p)); } SEAM(3);
    if (IN(4)) { phase_attn_combine(F, p); REP(4, phase_attn_combine(F, p)); } SEAM(4);
    if (IN(5)) { PHASE_WO(F, p, 0); REP(5, PHASE_WO(F, p, 0)); } SEAM(5);
    if (IN(6)) { phase_ln_route(F, p, 0); REP(6, phase_ln_route(F, p, 0)); } SEAM(6);
    if (IN(7)) { PHASE_MOE1(F, p, 0); REP(7, PHASE_MOE1(F, p, 0)); } SEAM(7);
    if (IN(8)) { PHASE_MOE2(F, p, 0); REP(8, PHASE_MOE2(F, p, 0)); } SEAM(8);
    if (IN(9)) { phase_moe_combine(F, p, 0); REP(9, phase_moe_combine(F, p, 0)); } SEAM(9);
    if (IN(10)) { PHASE_INPROJ(F, p); REP(10, PHASE_INPROJ(F, p)); } SEAM(10);
    if (IN(11)) { phase_gla_prep(F, p); REP(11, phase_gla_prep(F, p)); } SEAM(11);
    if (IN(12)) { PHASE_SCAN(F, p); REP(12, PHASE_SCAN(F, p)); } SEAM(12);
    if (IN(13)) { phase_gla_post(F, p); REP(13, phase_gla_post(F, p)); } SEAM(13);
    if (IN(14)) { PHASE_WO(F, p, 1); REP(14, PHASE_WO(F, p, 1)); } SEAM(14);
    if (IN(15)) { phase_ln_route(F, p, 1); REP(15, phase_ln_route(F, p, 1)); } SEAM(15);
    if (IN(16)) { PHASE_MOE1(F, p, 1); REP(16, PHASE_MOE1(F, p, 1)); } SEAM(16);
    if (IN(17)) { PHASE_MOE2(F, p, 1); REP(17, PHASE_MOE2(F, p, 1)); } SEAM(17);
    if (IN(18)) { phase_moe_combine(F, p, 1); REP(18, phase_moe_combine(F, p, 1)); }
#undef IN
#undef SEAM
}

extern "C" void kernel_launch(void* const* d_in, const int* in_sizes, int n_in, void* d_out, int out_size, void* d_ws, size_t ws_size, hipStream_t stream) {
    static int grid = 0;
    if (grid == 0) {
        if (n_in != 23 || in_sizes[0] != NLAT * DM || out_size != NLAT * DM || ws_size < WS_END) { fprintf(stderr, "kernel_launch: unexpected shapes (n_in %d, in0 %d, out %d, ws %zu); nothing launched\n", n_in, n_in > 0 ? in_sizes[0] : -1, out_size, ws_size); grid = -1; return; }
        int dev = 0, cus = 0;
        if (hipGetDevice(&dev) != hipSuccess || hipDeviceGetAttribute(&cus, hipDeviceAttributeMultiprocessorCount, dev) != hipSuccess) { grid = -1; return; }
        if (hipFuncSetAttribute((const void*)mega_fwd, hipFuncAttributeMaxDynamicSharedMemorySize, LDS_BYTES) != hipSuccess) { fprintf(stderr, "kernel_launch: hipFuncSetAttribute failed\n"); grid = -1; return; }
        int per_cu = 0;
        if (hipOccupancyMaxActiveBlocksPerMultiprocessor(&per_cu, (const void*)mega_fwd, NTHR, LDS_BYTES) != hipSuccess || per_cu < 1) fprintf(stderr, "kernel_launch: note: occupancy query reports %d\n", per_cu);
        (void)hipGetLastError();
        grid = cus;
    }
    if (grid < 0) return;
    (void)hipMemsetAsync((char*)d_ws + WS_CTL, 0, CTL_ZERO_BYTES, stream);
    Prm p{};
    const float** pp = (const float**)&p;
    for (int i = 0; i < 23; ++i) pp[i] = (const float*)d_in[i];
    p.out = (float*)d_out; p.ws = (unsigned char*)d_ws;
    p.ph_lo = 0; p.ph_hi = NPHASE; p.li = 0;
    hipLaunchKernelGGL(mega_fwd, dim3(grid), dim3(NTHR), LDS_BYTES, stream, p);
}
```

```cpp
#define OPT_MASK 0x355ACu
#include <hip/hip_runtime.h>
#include <cstdint>
#include <cstdio>

constexpr int BATCH = 8, SEQ = 4096, DM = 1024, CTXL = 256;
constexpr int NLAT = BATCH * SEQ, NCTX = BATCH * CTXL, NTOK = NLAT + NCTX;
constexpr float ALPHA = 1.4142135623730951f;
constexpr float LN_EPS = 1e-5f;
constexpr float LAMBDA_INIT0 = 0.2f;
constexpr float C2 = 0.125f * 1.4426950408889634f;
constexpr int NEXP = 16, DEXP = 512, MAXSLOT = 73728;
constexpr int NCHUNK = NTOK / 64;
constexpr int NIN = 3328;

typedef unsigned short bf16;
typedef float f32x4 __attribute__((ext_vector_type(4)));
typedef float f32x2 __attribute__((ext_vector_type(2)));
typedef unsigned u32x2 __attribute__((ext_vector_type(2)));
typedef unsigned u32x4 __attribute__((ext_vector_type(4)));

constexpr size_t MiB = 1u << 20;
constexpr size_t WS_CTL = 0, CTL_ZERO_BYTES = 1 * MiB;
constexpr size_t WS_MOD = 1 * MiB;
constexpr size_t WS_MISC = 1 * MiB + 512 * 1024;
constexpr size_t WS_WQKV = 2 * MiB, WS_WO = 8 * MiB, WS_GU0 = 10 * MiB, WS_DN0 = 42 * MiB;
constexpr size_t WS_XCTX = 58 * MiB;
constexpr size_t WS_WIN = 66 * MiB, WS_WGO = 73 * MiB, WS_GU1 = 75 * MiB, WS_DN1 = 107 * MiB;
constexpr size_t WS_H = 123 * MiB;
constexpr size_t WS_Q = 191 * MiB, WS_K = 259 * MiB, WS_V = 327 * MiB, WS_O2 = 395 * MiB;
constexpr size_t WS_LIST = 463 * MiB;
constexpr size_t WS_TOKR = 466 * MiB;
constexpr size_t WS_DEC = 468 * MiB;
constexpr size_t WS_ZZ = 471 * MiB;
constexpr size_t WS_END = 480 * MiB;
constexpr size_t WS_O1 = WS_H, WS_A2 = WS_Q, WS_Y = WS_K;
constexpr size_t WS_YM = 191 * MiB, WS_ACT = 335 * MiB;
constexpr size_t WS_QR = 191 * MiB, WS_KR = 225 * MiB, WS_V1 = 259 * MiB, WS_R = 327 * MiB;
constexpr size_t WS_QT = WS_H, WS_KT = 395 * MiB;
constexpr size_t WS_OGF = 191 * MiB, WS_OGB = 2 * MiB;
constexpr size_t WS_A2B = WS_H;
constexpr int CW_TMO = 0, CW_CODE = 1;
constexpr int CW_CNT = 64;
constexpr int CW_BAR = 4096;

__device__ __forceinline__ unsigned f2bf(float f) { unsigned u = __builtin_bit_cast(unsigned, f); return (u + 0x7fffu + ((u >> 16) & 1u)) >> 16; }
__device__ __forceinline__ unsigned pk2(float lo, float hi) { return f2bf(lo) | (f2bf(hi) << 16); }
__device__ __forceinline__ float bf2f(unsigned b) { return __builtin_bit_cast(float, b << 16); }
__device__ __forceinline__ float wave_sum(float v) {
#pragma unroll
    for (int o = 1; o < 64; o <<= 1) v += __shfl_xor(v, o);
    return v;
}
__device__ __forceinline__ float silu_f(float v) { return v / (1.f + __expf(-v)); }

struct Prm {
    const float *x, *c, *ctx, *cctx, *ada_w, *ada_b, *ln_g, *ln_b, *w_qkv, *w_o, *lam, *subln, *gw_in, *gwg_down, *gwg_up, *gbg, *gnorm, *gw_o, *rw, *rb, *mg, *mu, *md;
    float* out; unsigned char* ws;
    int ph_lo, ph_hi, li, pad;
};
__device__ __forceinline__ void ld_row_f32(const float* p, int lane, f32x4 (&v)[4]) {
#pragma unroll
    for (int j = 0; j < 4; ++j) v[j] = *(const f32x4*)(p + 4 * lane + 256 * j);
}
__device__ __forceinline__ void st_row_f32(float* p, int lane, const f32x4 (&v)[4]) {
#pragma unroll
    for (int j = 0; j < 4; ++j) *(f32x4*)(p + 4 * lane + 256 * j) = v[j];
}
__device__ __forceinline__ void ld_row_bf16(const bf16* p, int lane, f32x4 (&v)[4]) {
#pragma unroll
    for (int j = 0; j < 4; ++j) { const u32x2 u = *(const u32x2*)(p + 4 * lane + 256 * j); v[j] = (f32x4){bf2f(u.x & 0xffffu), bf2f(u.x >> 16), bf2f(u.y & 0xffffu), bf2f(u.y >> 16)}; }
}
__device__ __forceinline__ void st_row_bf16(bf16* p, int lane, const f32x4 (&v)[4]) {
#pragma unroll
    for (int j = 0; j < 4; ++j) { u32x2 u; u.x = pk2(v[j].x, v[j].y); u.y = pk2(v[j].z, v[j].w); *(u32x2*)(p + 4 * lane + 256 * j) = u; }
}
__device__ __forceinline__ void ln_row(f32x4 (&v)[4], const float* g, const float* b, int lane) {
    float s = 0.f;
#pragma unroll
    for (int j = 0; j < 4; ++j) s += (v[j].x + v[j].y) + (v[j].z + v[j].w);
    const float mean = wave_sum(s) * (1.f / DM); float q = 0.f;
#pragma unroll
    for (int j = 0; j < 4; ++j) { v[j] = v[j] - mean; q += (v[j].x * v[j].x + v[j].y * v[j].y) + (v[j].z * v[j].z + v[j].w * v[j].w); }
    const float rstd = 1.f / sqrtf(wave_sum(q) * (1.f / DM) + LN_EPS);
#pragma unroll
    for (int j = 0; j < 4; ++j) { const f32x4 gg = *(const f32x4*)(g + 4 * lane + 256 * j), bb = *(const f32x4*)(b + 4 * lane + 256 * j); v[j] = v[j] * rstd * gg + bb; }
}
__host__ __device__ __forceinline__ int gu_phys(int other, int sel) { return (other >> 4) * 32 + sel * 16 + (other & 15); }
__host__ __device__ __forceinline__ int perm16b(int L) { return (L & ~31) | (16 * ((L >> 2) & 1) + 4 * ((L >> 3) & 3) + (L & 3)); }
__host__ __device__ __forceinline__ int perm16b_inv(int P) { return (P & ~31) | (8 * ((P >> 2) & 3) + 4 * ((P >> 4) & 1) + (P & 3)); }
__device__ __forceinline__ unsigned pk4_fp8(float a, float b, float c, float d) { int w = 0; w = __builtin_amdgcn_cvt_pk_fp8_f32(a, b, w, false); w = __builtin_amdgcn_cvt_pk_fp8_f32(c, d, w, true); return (unsigned)w; }
constexpr float W8_SCALE = 64.f, W8_INV = 1.f / 64.f;
__device__ __forceinline__ void st_row_fp8(unsigned char* p, int lane, const f32x4 (&v)[4]) {
#pragma unroll
    for (int j = 0; j < 4; ++j) *(unsigned*)(p + 4 * lane + 256 * j) = pk4_fp8(v[j].x, v[j].y, v[j].z, v[j].w);
}
#define GAS __attribute__((address_space(1)))
#define LAS __attribute__((address_space(3)))
constexpr int NWAVES = 8, NTHR = NWAVES * 64;
constexpr int RING_BYTES = 131072, LDSCTL_OFF = RING_BYTES, MISC_OFF = LDSCTL_OFF + 320, LDS_BYTES = 147456;
constexpr int LDSX_OFF = RING_BYTES + 1024;
#define LDS_WAIT() asm volatile("s_waitcnt lgkmcnt(0)" ::: "memory")
#define VM_WAIT() asm volatile("s_waitcnt vmcnt(0)" ::: "memory")

struct Frame {
    unsigned char* lds;
    unsigned* ctl;
    int tid, lane, wave, G, bid;
};

template <int MODE>
__device__ __forceinline__ void p0_transpose_item(const float* W, int K, int N, bf16* WT, int row_off, float* scr, int item, int lane) {
    const int nblk = N / 32, kb = item / nblk, nb = item % nblk, k0 = 64 * kb, n0 = 32 * nb;
#pragma unroll 8
    for (int i = 0; i < 32; ++i) { const int kk = 2 * i + (lane >> 5); scr[kk * 33 + (lane & 31)] = W[(size_t)(k0 + kk) * N + n0 + (lane & 31)]; }
    LDS_WAIT(); asm volatile("" ::: "memory");
    const int c = lane & 7;
#pragma unroll
    for (int j = 0; j < 4; ++j) { const int n = (lane >> 3) + 8 * j; const float* s = scr + (8 * c) * 33 + n;
        u32x4 o; o.x = pk2(s[0 * 33], s[1 * 33]); o.y = pk2(s[2 * 33], s[3 * 33]); o.z = pk2(s[4 * 33], s[5 * 33]); o.w = pk2(s[6 * 33], s[7 * 33]);
        const int nl = n0 + n; const int pr = (MODE == 0) ? (row_off + nl) : (MODE == 3) ? (row_off + perm16b(nl)) : (row_off + gu_phys(nl, MODE - 1));
        *(u32x4*)(WT + (size_t)pr * K + k0 + 8 * c) = o; }
    LDS_WAIT(); asm volatile("" ::: "memory");
}
template <int MODE>
__device__ __forceinline__ void p0_transpose_item8(const float* W, int K, int N, unsigned char* WT, float* scr, int item, int lane) {
    const int nblk = N / 32, kb = item / nblk, nb = item % nblk, k0 = 64 * kb, n0 = 32 * nb;
#pragma unroll 8
    for (int i = 0; i < 32; ++i) { const int kk = 2 * i + (lane >> 5); scr[kk * 33 + (lane & 31)] = W[(size_t)(k0 + kk) * N + n0 + (lane & 31)]; }
    LDS_WAIT(); asm volatile("" ::: "memory");
    const int c = lane & 7;
#pragma unroll
    for (int j = 0; j < 4; ++j) { const int n = (lane >> 3) + 8 * j; const float* s = scr + (8 * c) * 33 + n;
        u32x2 o; o.x = pk4_fp8(s[0 * 33] * W8_SCALE, s[1 * 33] * W8_SCALE, s[2 * 33] * W8_SCALE, s[3 * 33] * W8_SCALE); o.y = pk4_fp8(s[4 * 33] * W8_SCALE, s[5 * 33] * W8_SCALE, s[6 * 33] * W8_SCALE, s[7 * 33] * W8_SCALE);
        const int nl = n0 + n; const int pr = (MODE == 3) ? perm16b(nl) : (MODE == 0) ? nl : gu_phys(nl, MODE - 1);
        *(u32x2*)(WT + (size_t)pr * K + k0 + 8 * c) = o; }
    LDS_WAIT(); asm volatile("" ::: "memory");
}
__device__ __forceinline__ void phase_prologue(const Frame& F, const Prm& p) {
    float* sil = (float*)F.lds;
    for (int i = F.tid; i < 9 * 1024; i += NTHR) { const int r = i >> 10, k = i & 1023; const float v = (r < 8) ? p.c[r * 1024 + k] : p.cctx[k]; sil[i] = silu_f(v); }
    __syncthreads();
    float* MOD = (float*)(p.ws + WS_MOD);
    if (F.bid < 192) {
        const int layer = F.bid / 96, n = (F.bid % 96) * 64 + F.lane; const float* W = p.ada_w + (size_t)layer * 1024 * 6144 + n;
        float acc[9];
#pragma unroll
        for (int r = 0; r < 9; ++r) acc[r] = 0.f;
        const int kb = F.wave * 128;
#pragma unroll 4
        for (int k = kb; k < kb + 128; k += 4) {
            const float w0 = W[(size_t)k * 6144], w1 = W[(size_t)(k + 1) * 6144], w2 = W[(size_t)(k + 2) * 6144], w3 = W[(size_t)(k + 3) * 6144];
#pragma unroll
            for (int r = 0; r < 9; ++r) { const f32x4 s = *(const f32x4*)(sil + r * 1024 + k); acc[r] += s.x * w0 + s.y * w1 + s.z * w2 + s.w * w3; }
        }
        float* red = (float*)(F.lds + 36864 + 8 * 8704);
#pragma unroll
        for (int r = 0; r < 9; ++r) red[(F.wave * 9 + r) * 64 + F.lane] = acc[r];
        __syncthreads();
        if (F.wave == 0) { const float bb = p.ada_b[layer * 6144 + n];
#pragma unroll
            for (int r = 0; r < 9; ++r) { float t = bb;
#pragma unroll
                for (int w = 0; w < 8; ++w) t += red[(w * 9 + r) * 64 + F.lane];
                MOD[(layer * 9 + r) * 6144 + n] = t; } }
    }
    float* misc = (float*)(p.ws + WS_MISC);
    if (F.bid == 255 % F.G && F.wave == 1) {
        const float a = wave_sum(p.lam[F.lane] * p.lam[64 + F.lane]), b = wave_sum(p.lam[128 + F.lane] * p.lam[192 + F.lane]);
        if (F.lane == 0) misc[0] = __expf(a) - __expf(b) + LAMBDA_INIT0;
        for (int i = F.lane; i < 1024; i += 64) { const int pos = i >> 4, f = i & 15; const float inv = powf(10000.f, -(float)f / 16.f); const float ang = (float)pos * inv;
            misc[1024 + 2 * i] = cosf(ang); misc[1024 + 2 * i + 1] = sinf(ang); }
    }
    float* scr = (float*)(F.lds + 36864 + F.wave * 8704);
    const int gw = F.bid * NWAVES + F.wave, NGW = F.G * NWAVES;
    constexpr int I_QKV = 16 * 96, I_SQ = 16 * 32, I_G = 16 * 16, I_D = 8 * 32;
    constexpr int I_MOE = 2 * I_G + I_D;
    constexpr int NITEMS = 2 * I_QKV + 2 * I_SQ + 32 * I_MOE;
    bf16* ws16 = (bf16*)p.ws;
    for (int it = gw; it < NITEMS; it += NGW) {
        int r = it;
        if (r < I_QKV) { if ((r % 96) < 64) p0_transpose_item8<0>(p.w_qkv, 1024, 3072, p.ws + WS_WQKV, scr, r, F.lane); else p0_transpose_item8<3>(p.w_qkv, 1024, 3072, p.ws + WS_WQKV, scr, r, F.lane); continue; } r -= I_QKV;
        if (r < I_QKV) { p0_transpose_item8<3>(p.gw_in, 1024, 3072, p.ws + WS_WIN, scr, r, F.lane); continue; } r -= I_QKV;
        if (r < I_SQ) { p0_transpose_item8<3>(p.w_o, 1024, 1024, p.ws + WS_WO, scr, r, F.lane); continue; } r -= I_SQ;
        if (r < I_SQ) { p0_transpose_item8<3>(p.gw_o, 1024, 1024, p.ws + WS_WGO, scr, r, F.lane); continue; } r -= I_SQ;
        const int le = r / I_MOE, layer = le >> 4, e = le & 15; r -= le * I_MOE;
        unsigned char* GU = p.ws + (layer ? WS_GU1 : WS_GU0) + (size_t)e * 1024 * 1024; unsigned char* DN = p.ws + (layer ? WS_DN1 : WS_DN0) + (size_t)e * 1024 * 512;
        if (r < I_G) { p0_transpose_item8<1>(p.mg + (size_t)le * 1024 * 512, 1024, 512, GU, scr, r, F.lane); continue; } r -= I_G;
        if (r < I_G) { p0_transpose_item8<2>(p.mu + (size_t)le * 1024 * 512, 1024, 512, GU, scr, r, F.lane); continue; } r -= I_G;
        p0_transpose_item8<3>(p.md + (size_t)le * 512 * 1024, 512, 1024, DN, scr, r, F.lane);
    }
    (void)ws16;
    unsigned char* WIN = p.ws + WS_WIN;
    for (int i = gw * 64 + F.lane; i < 32 * 256; i += NGW * 64) { const int rr = i >> 8, k = (i & 255) * 4, dir = rr >> 4, j = rr & 15; const float* s = p.gwg_down + (size_t)dir * 1024 * 16 + j;
        *(unsigned*)(WIN + (size_t)(3072 + rr) * 1024 + k) = pk4_fp8(s[(size_t)k * 16] * W8_SCALE, s[(size_t)(k + 1) * 16] * W8_SCALE, s[(size_t)(k + 2) * 16] * W8_SCALE, s[(size_t)(k + 3) * 16] * W8_SCALE); }
    for (int i = gw * 64 + F.lane; i < 224 * 1024 / 16; i += NGW * 64) *(u32x4*)(WIN + (size_t)3104 * 1024 + (size_t)i * 16) = (u32x4){0u, 0u, 0u, 0u};
}

__device__ __forceinline__ void phase_modulate0(const Frame& F, const Prm& p) {
    const float* MOD = (const float*)(p.ws + WS_MOD); unsigned char* H = p.ws + WS_H;
    const int gw = F.bid * NWAVES + F.wave, NGW = F.G * NWAVES, per = (NTOK + NGW - 1) / NGW;
    int curmod = -1; f32x4 sh[4], sc[4];
    for (int tok = gw * per; tok < (gw + 1) * per && tok < NTOK; ++tok) {
        const int mr = tok < NLAT ? tok / SEQ : 8; const float* src = tok < NLAT ? p.x + (size_t)tok * DM : p.ctx + (size_t)(tok - NLAT) * DM;
        if (mr != curmod) { curmod = mr; ld_row_f32(MOD + mr * 6144, F.lane, sh); ld_row_f32(MOD + mr * 6144 + 1024, F.lane, sc); }
        f32x4 v[4]; ld_row_f32(src, F.lane, v);
#pragma unroll
        for (int j = 0; j < 4; ++j) v[j] = v[j] * (1.f + sc[j]) + sh[j];
        st_row_fp8(H + (size_t)tok * DM, F.lane, v);
    }
}

__device__ __forceinline__ void phase_attn_combine(const Frame& F, const Prm& p) {
    const bf16* O1 = (const bf16*)(p.ws + WS_O1); const bf16* O2 = (const bf16*)(p.ws + WS_O2); unsigned char* A2 = p.ws + WS_A2;
    const float lam = ((const float*)(p.ws + WS_MISC))[0];
    const f32x4 sg = *(const f32x4*)(p.subln + 4 * (F.lane & 31));
    const int gw = F.bid * NWAVES + F.wave, NGW = F.G * NWAVES;
    for (int tok = gw; tok < NTOK; tok += NGW) {
        f32x4 a[4], b[4]; ld_row_bf16(O1 + (size_t)tok * DM, F.lane, a); ld_row_bf16(O2 + (size_t)tok * DM, F.lane, b);
#pragma unroll
        for (int j = 0; j < 4; ++j) {
            f32x4 o = a[j] - lam * b[j]; float q = (o.x * o.x + o.y * o.y) + (o.z * o.z + o.w * o.w);
#pragma unroll
            for (int s = 1; s < 32; s <<= 1) q += __shfl_xor(q, s);
            const float r = (1.f - LAMBDA_INIT0) / sqrtf(q * (1.f / 128.f) + LN_EPS);
            a[j] = o * r * sg;
        }
        st_row_fp8(A2 + (size_t)tok * DM, F.lane, a);
    }
}

__device__ __forceinline__ void phase_ln_route(const Frame& F, const Prm& p, int layer) {
    const int nrows = layer ? NLAT : NTOK;
    const float* MOD = (const float*)(p.ws + WS_MOD) + layer * 9 * 6144;
    const bf16* Y = (const bf16*)(p.ws + WS_Y); unsigned char* HF = p.ws + WS_H;
    float* XCTX = (float*)(p.ws + WS_XCTX);
    int* LIST = (int*)(p.ws + WS_LIST); int* TOKR = (int*)(p.ws + WS_TOKR);
    unsigned* CNT = F.ctl + CW_CNT + layer * 16;
    float* WrT = (float*)F.lds;
    int* rec = (int*)(F.lds + 65536);
    unsigned* lcnt = (unsigned*)(F.lds + 65536 + 8192); unsigned* lbase = lcnt + 16;
    for (int i = F.tid; i < 16 * 1024; i += NTHR) { const int k = i >> 4, e = i & 15; WrT[e * 1024 + k] = p.rw[i]; }
    if (F.tid < 16) lcnt[F.tid] = 0u;
    __syncthreads();
    const int per_wg = (nrows + F.G - 1) / F.G, per_w = (per_wg + NWAVES - 1) / NWAVES;
    const int row_lo = F.bid * per_wg, row_hi = min(nrows, row_lo + per_wg);
    const float* lng = p.ln_g + (layer * 2 + 0) * DM; const float* lnb = p.ln_b + (layer * 2 + 0) * DM;
    float rb[16];
#pragma unroll
    for (int e = 0; e < 16; ++e) rb[e] = p.rb[e];
    int curmod = -1; f32x4 gm[4], shf[4], scf[4];
    for (int i = 0; i < per_w; ++i) {
        const int lr = F.wave * per_w + i, tok = row_lo + lr; if (tok >= row_hi) break;
        const int mr = tok < NLAT ? tok / SEQ : 8;
        if (mr != curmod) { curmod = mr; ld_row_f32(MOD + mr * 6144 + 2048, F.lane, gm); ld_row_f32(MOD + mr * 6144 + 3072, F.lane, shf); ld_row_f32(MOD + mr * 6144 + 4096, F.lane, scf); }
        float* xdst = tok < NLAT ? p.out + (size_t)tok * DM : XCTX + (size_t)(tok - NLAT) * DM;
        const float* xsrc = layer ? (const float*)xdst : (tok < NLAT ? p.x + (size_t)tok * DM : p.ctx + (size_t)(tok - NLAT) * DM);
        f32x4 v[4], y[4]; ld_row_f32(xsrc, F.lane, v); ld_row_bf16(Y + (size_t)tok * DM, F.lane, y);
#pragma unroll
        for (int j = 0; j < 4; ++j) v[j] = ALPHA * v[j] + gm[j] * y[j];
        ln_row(v, lng, lnb, F.lane);
        st_row_f32(xdst, F.lane, v);
#pragma unroll
        for (int j = 0; j < 4; ++j) v[j] = v[j] * (1.f + scf[j]) + shf[j];
        st_row_fp8(HF + (size_t)tok * DM, F.lane, v);
        float part[16];
#pragma unroll
        for (int e = 0; e < 16; ++e) { float s = 0.f;
#pragma unroll
            for (int j = 0; j < 4; ++j) { const f32x4 w = *(const f32x4*)(WrT + e * 1024 + 4 * F.lane + 256 * j); s += (v[j].x * w.x + v[j].y * w.y) + (v[j].z * w.z + v[j].w * w.w); }
            part[e] = s; }
        {
#pragma unroll
            for (int e = 0; e < 8; ++e) { const bool up = (F.lane & 32) != 0; const float keep = up ? part[e + 8] : part[e], send = up ? part[e] : part[e + 8]; part[e] = keep + __shfl_xor(send, 32); }
#pragma unroll
            for (int e = 0; e < 4; ++e) { const bool up = (F.lane & 16) != 0; const float keep = up ? part[e + 4] : part[e], send = up ? part[e] : part[e + 4]; part[e] = keep + __shfl_xor(send, 16); }
#pragma unroll
            for (int e = 0; e < 2; ++e) { const bool up = (F.lane & 8) != 0; const float keep = up ? part[e + 2] : part[e], send = up ? part[e] : part[e + 2]; part[e] = keep + __shfl_xor(send, 8); }
            { const bool up = (F.lane & 4) != 0; const float keep = up ? part[1] : part[0], send = up ? part[0] : part[1]; part[0] = keep + __shfl_xor(send, 4); }
            part[0] += __shfl_xor(part[0], 2); part[0] += __shfl_xor(part[0], 1);
        }
        float aff[16], sel[16];
#pragma unroll
        for (int e = 0; e < 16; ++e) { const int src = ((e >> 3) & 1) * 32 + ((e >> 2) & 1) * 16 + ((e >> 1) & 1) * 8 + (e & 1) * 4; const float lg = __shfl(part[0], src); aff[e] = 1.f / (1.f + __expf(-lg)); sel[e] = aff[e] + rb[e]; }
        int bg = 0; float bgs = -3.0e38f;
#pragma unroll
        for (int g = 0; g < 4; ++g) { float m1 = -3.0e38f, m2 = -3.0e38f;
#pragma unroll
            for (int k = 0; k < 4; ++k) { const float s = sel[4 * g + k]; if (s > m1) { m2 = m1; m1 = s; } else if (s > m2) m2 = s; }
            const float gs = m1 + m2; if (gs > bgs) { bgs = gs; bg = g; } }
        int i1 = 0, i2 = 0; float s1 = -3.0e38f, s2 = -3.0e38f, a1 = 0.f, a2 = 0.f;
#pragma unroll
        for (int g = 0; g < 4; ++g) if (g == bg) {
#pragma unroll
            for (int k = 0; k < 4; ++k) { const float s = sel[4 * g + k], a = aff[4 * g + k];
                if (s > s1) { s2 = s1; i2 = i1; a2 = a1; s1 = s; i1 = 4 * g + k; a1 = a; } else if (s > s2) { s2 = s; i2 = 4 * g + k; a2 = a; } } }
        const float wsum = a1 + a2, w1 = a1 / wsum, w2 = a2 / wsum;
        if (F.lane == 0) { const unsigned l1 = atomicAdd(&lcnt[i1], 1u), l2 = atomicAdd(&lcnt[i2], 1u);
            rec[lr * 6 + 0] = i1; rec[lr * 6 + 1] = i2; rec[lr * 6 + 2] = (int)l1; rec[lr * 6 + 3] = (int)l2; rec[lr * 6 + 4] = __float_as_int(w1); rec[lr * 6 + 5] = __float_as_int(w2); }
    }
    __syncthreads();
    if (F.tid < 16) lbase[F.tid] = __hip_atomic_fetch_add(&CNT[F.tid], lcnt[F.tid], __ATOMIC_RELAXED, __HIP_MEMORY_SCOPE_AGENT);
    __syncthreads();
    for (int lr = F.tid; lr < row_hi - row_lo; lr += NTHR) { const int tok = row_lo + lr;
        const int e0 = rec[lr * 6], e1 = rec[lr * 6 + 1]; const int p0 = (int)lbase[e0] + rec[lr * 6 + 2], p1 = (int)lbase[e1] + rec[lr * 6 + 3];
        LIST[e0 * NTOK + p0] = tok; LIST[e1 * NTOK + p1] = tok;
        int* tr = TOKR + (size_t)tok * 8; tr[0] = e0; tr[1] = p0; tr[2] = e1; tr[3] = p1; tr[4] = rec[lr * 6 + 4]; tr[5] = rec[lr * 6 + 5]; }
    __syncthreads();
}

__device__ __forceinline__ void pad_bases(const unsigned* cnt, int (&pb)[17]) {
    int acc = 0;
#pragma unroll
    for (int e = 0; e < 16; ++e) { pb[e] = acc; const int c = (int)__hip_atomic_load(cnt + e, __ATOMIC_RELAXED, __HIP_MEMORY_SCOPE_AGENT); acc += (c + 255) & ~255; }
    pb[16] = acc;
}

__device__ __forceinline__ void phase_moe_combine(const Frame& F, const Prm& p, int layer) {
    const int nrows = layer ? NLAT : NTOK;
    const float* MOD = (const float*)(p.ws + WS_MOD) + layer * 9 * 6144; const float* MOD1 = (const float*)(p.ws + WS_MOD) + 9 * 6144;
    const bf16* YM = (const bf16*)(p.ws + WS_YM); unsigned char* H = p.ws + WS_H;   float* XCTX = (float*)(p.ws + WS_XCTX); const int* TOKR = (const int*)(p.ws + WS_TOKR);
    int pb[17]; pad_bases(F.ctl + CW_CNT + layer * 16, pb);
    int* pbl = (int*)F.lds; if (F.tid < 17) { int v = 0;
#pragma unroll
        for (int e = 0; e < 17; ++e) if (e == F.tid) v = pb[e];
        pbl[F.tid] = v; }
    __syncthreads();
    const float* lng = p.ln_g + (layer * 2 + 1) * DM; const float* lnb = p.ln_b + (layer * 2 + 1) * DM;
    const int gw = F.bid * NWAVES + F.wave, NGW = F.G * NWAVES, per = (nrows + NGW - 1) / NGW;
    int curmod = -1; f32x4 gf[4], sh1[4], sc1[4];
    for (int tok = gw * per; tok < (gw + 1) * per && tok < nrows; ++tok) {
        const int mr = tok < NLAT ? tok / SEQ : 8;
        if (mr != curmod) { curmod = mr; ld_row_f32(MOD + mr * 6144 + 5120, F.lane, gf); if (!layer) { ld_row_f32(MOD1 + mr * 6144, F.lane, sh1); ld_row_f32(MOD1 + mr * 6144 + 1024, F.lane, sc1); } }
        const int* tr = TOKR + (size_t)tok * 8; const int s0 = pbl[tr[0]] + tr[1], s1 = pbl[tr[2]] + tr[3]; const float w0 = __int_as_float(tr[4]), w1 = __int_as_float(tr[5]);
        float* xp = tok < NLAT ? p.out + (size_t)tok * DM : XCTX + (size_t)(tok - NLAT) * DM;
        f32x4 v[4], a[4], b[4]; ld_row_f32(xp, F.lane, v); ld_row_bf16(YM + (size_t)s0 * DM, F.lane, a); ld_row_bf16(YM + (size_t)s1 * DM, F.lane, b);
#pragma unroll
        for (int j = 0; j < 4; ++j) v[j] = ALPHA * v[j] + gf[j] * (w0 * a[j] + w1 * b[j]);
        ln_row(v, lng, lnb, F.lane);
        st_row_f32(xp, F.lane, v);
        if (!layer) {
#pragma unroll
            for (int j = 0; j < 4; ++j) v[j] = v[j] * (1.f + sc1[j]) + sh1[j];
            st_row_fp8(H + (size_t)tok * DM, F.lane, v);
        }
    }
}

__device__ __forceinline__ void phase_gla_prep(const Frame& F, const Prm& p) {
    const bf16* QR = (const bf16*)(p.ws + WS_QR); const bf16* KR = (const bf16*)(p.ws + WS_KR); const float* ZZ = (const float*)(p.ws + WS_ZZ);
    bf16* QT = (bf16*)(p.ws + WS_QT); bf16* KT = (bf16*)(p.ws + WS_KT); float* DEC = (float*)(p.ws + WS_DEC);
    const int gw = F.bid * NWAVES + F.wave, NGW = F.G * NWAVES;
    for (int task = gw; task < 2 * NCHUNK * 8; task += NGW) {
        const int dh = task & 7, chunk = (task >> 3) % NCHUNK, dir = __builtin_amdgcn_readfirstlane(task / (8 * NCHUNK));
        const int col = dh * 64 + F.lane, tok0 = chunk * 64;
        unsigned short qv[64], kv[64];
#pragma unroll
        for (int t = 0; t < 64; ++t) { qv[t] = QR[(size_t)(tok0 + t) * 512 + col]; kv[t] = KR[(size_t)(tok0 + t) * 512 + col]; }
        f32x4 zl[4];
#pragma unroll
        for (int j = 0; j < 4; ++j) zl[j] = *(const f32x4*)(ZZ + (size_t)(tok0 + F.lane) * 32 + dir * 16 + 4 * j);
        float wup[16];
#pragma unroll
        for (int j = 0; j < 16; ++j) wup[j] = p.gwg_up[(size_t)dir * 16 * 512 + j * 512 + col];
        const float bgv = p.gbg[dir * 512 + col];
        float b = 0.f;
        bf16* qo = QT + ((size_t)dir * NTOK + tok0) * 512 + col; bf16* ko = KT + ((size_t)dir * NTOK + tok0) * 512 + col;
#pragma unroll
        for (int tt = 0; tt < 64; ++tt) {
            float z = bgv;
#pragma unroll
            for (int j = 0; j < 4; ++j) { const int tl = dir ? 63 - tt : tt;
                const float z0 = __int_as_float(__builtin_amdgcn_readlane(__float_as_int(zl[j].x), tl)), z1 = __int_as_float(__builtin_amdgcn_readlane(__float_as_int(zl[j].y), tl));
                const float z2 = __int_as_float(__builtin_amdgcn_readlane(__float_as_int(zl[j].z), tl)), z3 = __int_as_float(__builtin_amdgcn_readlane(__float_as_int(zl[j].w), tl));
                z += z0 * wup[4 * j] + z1 * wup[4 * j + 1] + z2 * wup[4 * j + 2] + z3 * wup[4 * j + 3]; }
            const float g = (fminf(z, 0.f) - __logf(1.f + __expf(-fabsf(z)))) * (1.f / 16.f);
            b += g;
            const float e = __expf(b), ei = __builtin_amdgcn_rcpf(e);
            const float q = dir ? bf2f(qv[63 - tt]) : bf2f(qv[tt]), k = dir ? bf2f(kv[63 - tt]) : bf2f(kv[tt]);
            const int t = dir ? 63 - tt : tt;
            qo[(size_t)t * 512] = (bf16)f2bf(q * e); ko[(size_t)t * 512] = (bf16)f2bf(k * ei);
        }
        DEC[((size_t)dir * NCHUNK + chunk) * 512 + col] = __expf(b);
    }
}

__device__ __forceinline__ void phase_gla_post(const Frame& F, const Prm& p) {
    const bf16* OF = (const bf16*)(p.ws + WS_OGF); const bf16* OB = (const bf16*)(p.ws + WS_OGB); const bf16* R = (const bf16*)(p.ws + WS_R); unsigned char* A2 = p.ws + WS_A2B;
    const f32x4 ng = *(const f32x4*)(p.gnorm + 4 * F.lane);
    const int gw = F.bid * NWAVES + F.wave, NGW = F.G * NWAVES;
    for (int tok = gw; tok < NLAT; tok += NGW) {
        f32x4 a[4], b[4], r[4]; ld_row_bf16(OF + (size_t)tok * DM, F.lane, a); ld_row_bf16(OB + (size_t)tok * DM, F.lane, b); ld_row_bf16(R + (size_t)tok * DM, F.lane, r);
#pragma unroll
        for (int j = 0; j < 4; ++j) {
            const f32x4 o = a[j] + b[j]; const float q = wave_sum((o.x * o.x + o.y * o.y) + (o.z * o.z + o.w * o.w));
            const float rs = 1.f / sqrtf(q * (1.f / 256.f) + LN_EPS);
            a[j] = (f32x4){o.x * rs * ng.x * silu_f(r[j].x), o.y * rs * ng.y * silu_f(r[j].y), o.z * rs * ng.z * silu_f(r[j].z), o.w * rs * ng.w * silu_f(r[j].w)};
        }
        st_row_fp8(A2 + (size_t)tok * DM, F.lane, a);
    }
}
namespace pg8 {
typedef short bf16x8 __attribute__((ext_vector_type(8)));
constexpr int BM = 256, BK = 64, HALF = 128, HTB = HALF * BK * 2, STAGE_BYTES = 8 * HTB, NXCD = 8, WGM = 8;
__host__ __device__ __forceinline__ int lds_byte(int r, int c) { const int st = (r >> 4) * 2 + (c >> 5), rr = r & 15, cc = c & 31, ob = rr * 64 + cc * 2; return st * 1024 + (ob ^ (((ob >> 9) & 1) << 5)); }
__host__ __device__ __forceinline__ void stage_rc(int b, int& R, int& C) { const int st = b / 1024, sb = b % 1024, swz = sb ^ (((sb >> 9) & 1) << 5); R = (st >> 1) * 16 + swz / 64; C = (st & 1) * 32 + (swz % 64) / 2; }
typedef float f32x2_t __attribute__((ext_vector_type(2))); typedef __bf16 bf16x2_t __attribute__((ext_vector_type(2)));
__device__ __forceinline__ unsigned cvt_pk_bf16(float lo, float hi) { f32x2_t v = {lo, hi}; bf16x2_t b = __builtin_convertvector(v, bf16x2_t); return __builtin_bit_cast(unsigned, b); }

struct Unit { int pm, pn; int row0; int e; int cnt; const bf16* Bt; };

struct DenseOrder {
    int nM, nN, nwg, G, c, K; const bf16* Bt;
    __device__ void init(int M, int N, int K_, const bf16* Bt_, int G_, int c_) { nM = M / BM; nN = N / BM; nwg = nM * nN; G = G_; c = c_; K = K_; Bt = Bt_; }
    __device__ bool next(int i, Unit& u) const {
        const long L = (long)i * G + c; if (L >= nwg) return false;
        int wgid = (int)L; { const int q = nwg / NXCD, r = nwg % NXCD, xcd = wgid % NXCD, off = wgid / NXCD; wgid = (xcd < r ? xcd * (q + 1) : r * (q + 1) + (xcd - r) * q) + off; }
        const int nig = WGM * nN, gid = wgid / nig, fm = gid * WGM, gsz = (nM - fm) < WGM ? (nM - fm) : WGM;
        u.pm = fm + ((wgid % nig) % gsz); u.pn = (wgid % nig) / gsz; u.row0 = u.pm * BM; u.e = 0; u.cnt = 0; u.Bt = Bt; return true;
    }
    __device__ __forceinline__ unsigned arow(const Unit& u, int r) const { return (unsigned)(u.row0 + r) * (unsigned)(K * 2); }
};
template <bool GATHER> struct MoeOrder {
    int cnt[16]; int nN, G, c, K; const bf16* Bt0; size_t bstride; const int* LIST;
    __device__ void init(const unsigned* cntw, int N, int K_, const bf16* Bt0_, const int* LIST_, int G_, int c_) {
#pragma unroll
        for (int e = 0; e < 16; ++e) cnt[e] = (int)__hip_atomic_load(cntw + e, __ATOMIC_RELAXED, __HIP_MEMORY_SCOPE_AGENT);
        nN = N / BM; G = G_; c = c_; K = K_; Bt0 = Bt0_; bstride = (size_t)N * K_; LIST = LIST_; }
    __device__ bool next(int i, Unit& u) const {
        int L = i * G + c, base = 0; bool found = false; u.pm = 0; u.pn = 0; u.row0 = 0; u.e = 0; u.cnt = 0; u.Bt = Bt0;
#pragma unroll
        for (int e = 0; e < 16; ++e) { const int mt = (cnt[e] + 255) >> 8, nu = mt * nN;
            if (!found) { if (L < nu) { found = true; u.e = e; u.cnt = cnt[e]; u.pm = L / nN; u.pn = L % nN; u.row0 = base + u.pm * BM; u.Bt = Bt0 + (size_t)e * bstride; } else { L -= nu; base += mt * BM; } } }
        return found;
    }
    __device__ __forceinline__ unsigned arow(const Unit& u, int r) const {
        if (GATHER) { const int li = u.pm * BM + r; int tok = 0; if (li < u.cnt) tok = LIST[u.e * NTOK + li];
            return (unsigned)tok * (unsigned)(K * 2); }
        return (unsigned)(u.row0 + r) * (unsigned)(K * 2);
    }
};

typedef f32x4 Acc[2][2][4][2];
__device__ __forceinline__ void st4bf(bf16* p, f32x4 v) { u32x2 w; w.x = cvt_pk_bf16(v.x, v.y); w.y = cvt_pk_bf16(v.z, v.w); *(u32x2*)p = w; }
__device__ __forceinline__ void st8bf(bf16* p, f32x4 a, f32x4 b) { u32x4 w; w.x = cvt_pk_bf16(a.x, a.y); w.y = cvt_pk_bf16(a.z, a.w); w.z = cvt_pk_bf16(b.x, b.y); w.w = cvt_pk_bf16(b.z, b.w); *(u32x4*)p = w; }

struct EpiQKV {
    bf16 *Q; const LAS float* rope; float wsc;
    __device__ __forceinline__ void operator()(const Acc& acc, const Unit& u, int wr, int wc, int fr, int fq) const {
        const int reg = u.pn >> 2; bf16* O = Q + (size_t)reg * ((WS_K - WS_Q) / 2);
        if (reg == 2) { const int cbase = (u.pn & 3) * BM + wc * 32 + 8 * fq;
#pragma unroll
            for (int ai = 0; ai < 2; ++ai)
#pragma unroll
                for (int m = 0; m < 4; ++m) { bf16* rowp = O + (size_t)(u.row0 + ai * HALF + wr * 64 + m * 16 + fr) * DM + cbase;
#pragma unroll
                    for (int bj = 0; bj < 2; ++bj) st8bf(rowp + bj * HALF, acc[ai][bj][m][0] * wsc, acc[ai][bj][m][1] * wsc); }
            return; }
        const int cbase = (u.pn & 3) * BM + wc * 32 + 4 * fq;
        const bool dorope = (u.row0 < NLAT); const float sc = (reg == 0 ? C2 : 1.f) * wsc;
#pragma unroll
        for (int ai = 0; ai < 2; ++ai)
#pragma unroll
            for (int m = 0; m < 4; ++m) { const int row = u.row0 + ai * HALF + wr * 64 + m * 16 + fr; bf16* rowp = O + (size_t)row * DM + cbase;
                f32x4 cs = {1.f, 1.f, 1.f, 1.f}, sn = {0.f, 0.f, 0.f, 0.f};
                if (dorope) { const int s = row & (SEQ - 1), pos = (wc & 1) ? (s & 63) : (s >> 6); const f32x4 t0 = *(const LAS f32x4*)(rope + (pos * 16 + 4 * fq) * 2), t1 = *(const LAS f32x4*)(rope + (pos * 16 + 4 * fq) * 2 + 4);
                    cs = (f32x4){t0.x, t0.z, t1.x, t1.z}; sn = (f32x4){t0.y, t0.w, t1.y, t1.w}; }
#pragma unroll
                for (int bj = 0; bj < 2; ++bj) { const f32x4 a0 = acc[ai][bj][m][0], a1 = acc[ai][bj][m][1];
                    st4bf(rowp + bj * HALF, (a0 * cs - a1 * sn) * sc); st4bf(rowp + bj * HALF + 16, (a1 * cs + a0 * sn) * sc); } }
    }
};
struct EpiPlain {
    bf16* O; float sc;
    __device__ __forceinline__ void operator()(const Acc& acc, const Unit& u, int wr, int wc, int fr, int fq) const {
        const int cbase = u.pn * BM + wc * 32 + 8 * fq;
#pragma unroll
        for (int ai = 0; ai < 2; ++ai)
#pragma unroll
            for (int m = 0; m < 4; ++m) { bf16* rowp = O + (size_t)(u.row0 + ai * HALF + wr * 64 + m * 16 + fr) * DM + cbase;
#pragma unroll
                for (int bj = 0; bj < 2; ++bj) st8bf(rowp + bj * HALF, acc[ai][bj][m][0] * sc, acc[ai][bj][m][1] * sc); }
    }
};
struct EpiInproj {
    bf16 *QR, *KR, *V, *R; float* ZZ; float wsc;
    __device__ __forceinline__ void operator()(const Acc& acc, const Unit& u, int wr, int wc, int fr, int fq) const {
        const int pn = u.pn;
        if (pn == 12) { if (wc == 0) {
#pragma unroll
            for (int ai = 0; ai < 2; ++ai)
#pragma unroll
                for (int m = 0; m < 4; ++m) { float* rowp = ZZ + (size_t)(u.row0 + ai * HALF + wr * 64 + m * 16 + fr) * 32 + 4 * fq;
                    *(f32x4*)rowp = acc[ai][0][m][0] * wsc; *(f32x4*)(rowp + 16) = acc[ai][0][m][1] * wsc; } }
            return; }
        bf16* O; int ld, c0; float sc = wsc;
        if (pn < 2) { O = QR; ld = 512; c0 = pn * BM; sc = 0.08838834764831845f * wsc; } else if (pn < 4) { O = KR; ld = 512; c0 = (pn - 2) * BM; } else if (pn < 8) { O = V; ld = DM; c0 = (pn - 4) * BM; } else { O = R; ld = DM; c0 = (pn - 8) * BM; }
        const int cbase = c0 + wc * 32 + 8 * fq;
#pragma unroll
        for (int ai = 0; ai < 2; ++ai)
#pragma unroll
            for (int m = 0; m < 4; ++m) { bf16* rowp = O + (size_t)(u.row0 + ai * HALF + wr * 64 + m * 16 + fr) * ld + cbase;
#pragma unroll
                for (int bj = 0; bj < 2; ++bj) st8bf(rowp + bj * HALF, acc[ai][bj][m][0] * sc, acc[ai][bj][m][1] * sc); }
    }
};
struct EpiGateUp {
    unsigned char* ACT;
    __device__ __forceinline__ void operator()(const Acc& acc, const Unit& u, int wr, int wc, int fr, int fq) const {
        const int obase = (u.pn * BM + wc * 32) / 2 + 4 * fq;
#pragma unroll
        for (int ai = 0; ai < 2; ++ai)
#pragma unroll
            for (int m = 0; m < 4; ++m) { unsigned char* rowp = ACT + (size_t)(u.row0 + ai * HALF + wr * 64 + m * 16 + fr) * DEXP + obase;
#pragma unroll
                for (int bj = 0; bj < 2; ++bj) { const f32x4 g = acc[ai][bj][m][0] * W8_INV, up = acc[ai][bj][m][1] * W8_INV; f32x4 o;
#pragma unroll
                    for (int j = 0; j < 4; ++j) o[j] = g[j] * __builtin_amdgcn_rcpf(1.f + __expf(-g[j])) * up[j];
                    *(unsigned*)(rowp + bj * (HALF / 2)) = pk4_fp8(o[0], o[1], o[2], o[3]); } }
    }
};

typedef int i32x8 __attribute__((ext_vector_type(8)));
typedef int i32x4 __attribute__((ext_vector_type(4)));
__device__ __forceinline__ i32x8 cat8(bf16x8 lo, bf16x8 hi) { return __builtin_shufflevector(__builtin_bit_cast(i32x4, lo), __builtin_bit_cast(i32x4, hi), 0, 1, 2, 3, 4, 5, 6, 7); }
template <class Epi, class Sched, bool FP8 = false>
__device__ __forceinline__ void gemm_phase(unsigned char* ldsg, const bf16* A, int K, const Sched& S, const Epi& E) {
    LAS unsigned char* lds = (LAS unsigned char*)ldsg;
    const int tid = threadIdx.x, wid = __builtin_amdgcn_readfirstlane(tid >> 6), lane = tid & 63, wr = wid >> 2, wc = wid & 3, fr = lane & 15, fq = lane >> 4;
    const int nt = K / BK;
    int Rr[2]; unsigned colb[2], voffB[2];
#pragma unroll
    for (int i = 0; i < 2; ++i) { int R, C; stage_rc(tid * 16 + i * 8192, R, C); Rr[i] = R; colb[i] = (unsigned)C * 2u; voffB[i] = (unsigned)(R * K + C) * 2u; }
    const size_t kstep = (size_t)(BK * 2);
    const size_t hstep = (size_t)HALF * K * 2;
    const size_t tstep = 2 * hstep;
    const unsigned ldsw = (unsigned)wid * 1024u;
    const int aoff = lds_byte(wr * 64 + fr, fq * 8), boff = lds_byte(wc * 32 + fr, fq * 8);
#define PG8_SA(b, h) (((b) * 2 + (h)) * HTB)
#define PG8_SB(b, h) ((4 + (b) * 2 + (h)) * HTB)
#define PG8_STAGE(bufoff, gbase, voff) do { _Pragma("unroll") for (int _i = 0; _i < 2; ++_i) \
        __builtin_amdgcn_global_load_lds((const unsigned*)((const char*)(gbase) + (voff)[_i]), (LAS unsigned*)(lds + (bufoff) + ldsw + _i * 8192), 16, 0, 0); } while (0)
#define PG8_LDA(dst, b, h) do { if constexpr (FP8) { _Pragma("unroll") for (int m = 0; m < 4; ++m) dst##8[m] = cat8(*(const LAS bf16x8*)(lds + PG8_SA(b, h) + aoff + m * 2048), *(const LAS bf16x8*)(lds + PG8_SA(b, h) + aoff + m * 2048 + 1024)); } \
        else { _Pragma("unroll") for (int m = 0; m < 4; ++m) _Pragma("unroll") for (int k = 0; k < 2; ++k) dst[m][k] = *(const LAS bf16x8*)(lds + PG8_SA(b, h) + aoff + m * 2048 + k * 1024); } } while (0)
#define PG8_LDB(dst, b, h) do { if constexpr (FP8) { _Pragma("unroll") for (int n = 0; n < 2; ++n) dst##8[n] = cat8(*(const LAS bf16x8*)(lds + PG8_SB(b, h) + boff + n * 2048), *(const LAS bf16x8*)(lds + PG8_SB(b, h) + boff + n * 2048 + 1024)); } \
        else { _Pragma("unroll") for (int n = 0; n < 2; ++n) _Pragma("unroll") for (int k = 0; k < 2; ++k) dst[n][k] = *(const LAS bf16x8*)(lds + PG8_SB(b, h) + boff + n * 2048 + k * 1024); } } while (0)
#define PG8_MMA(ai, bj, At, Bt) do { __builtin_amdgcn_s_setprio(1); \
        if constexpr (FP8) { _Pragma("unroll") for (int m = 0; m < 4; ++m) _Pragma("unroll") for (int n = 0; n < 2; ++n) \
            asm volatile("v_mfma_scale_f32_16x16x128_f8f6f4 %0, %1, %2, %0, %3, %3 op_sel_hi:[0,0,0]" : "+v"(acc[ai][bj][m][n]) : "v"(Bt##8[n]), "v"(At##8[m]), "v"(sc8)); } \
        else { _Pragma("unroll") for (int m = 0; m < 4; ++m) _Pragma("unroll") for (int n = 0; n < 2; ++n) _Pragma("unroll") for (int k = 0; k < 2; ++k) \
            acc[ai][bj][m][n] = __builtin_amdgcn_mfma_f32_16x16x32_bf16(Bt[n][k], At[m][k], acc[ai][bj][m][n], 0, 0, 0); } \
        __builtin_amdgcn_s_setprio(0); } while (0)
#define PG8_WAIT_V(n) asm volatile("s_waitcnt vmcnt(" #n ")" ::: "memory")
#define PG8_WAIT_L(n) asm volatile("s_waitcnt lgkmcnt(" #n ")" ::: "memory")
#define PG8_BAR __builtin_amdgcn_s_barrier()
#define PG8_SCHED __builtin_amdgcn_sched_barrier(0)
    Unit cur, nxt; int ui = 0;
    if (!S.next(0, cur)) return;
    Acc acc;
#pragma unroll
    for (int a = 0; a < 2; ++a)
#pragma unroll
        for (int b = 0; b < 2; ++b)
#pragma unroll
            for (int m = 0; m < 4; ++m)
#pragma unroll
                for (int n = 0; n < 2; ++n) acc[a][b][m][n] = (f32x4){0.f, 0.f, 0.f, 0.f};
    const int sc8 = 0x7f7f7f7f;
    bf16x8 At[4][2], B0[2][2], B1[2][2]; i32x8 At8[4], B08[2], B18[2];
    unsigned aC0[2], aC1[2], aN0[2], aN1[2];
#pragma unroll
    for (int i = 0; i < 2; ++i) { aC0[i] = S.arow(cur, Rr[i]) + colb[i]; aC1[i] = S.arow(cur, HALF + Rr[i]) + colb[i]; }
    const char* Ab = (const char*)A;
    const char* cB = (const char*)cur.Bt + (size_t)cur.pn * tstep;
    PG8_STAGE(PG8_SB(0, 0), cB, voffB); PG8_STAGE(PG8_SB(0, 1), cB + hstep, voffB); PG8_STAGE(PG8_SA(0, 0), Ab, aC0); PG8_STAGE(PG8_SA(0, 1), Ab, aC1);
    if (wr == 1) PG8_BAR;
    PG8_WAIT_V(2); PG8_BAR;
    PG8_STAGE(PG8_SB(1, 0), cB + kstep, voffB); PG8_STAGE(PG8_SA(1, 0), Ab + kstep, aC0); PG8_STAGE(PG8_SB(1, 1), cB + hstep + kstep, voffB);
    PG8_WAIT_V(6); PG8_BAR;
    for (;;) {
        const bool has_next = S.next(ui + 1, nxt);
        if (has_next) {
#pragma unroll
            for (int i = 0; i < 2; ++i) { aN0[i] = S.arow(nxt, Rr[i]) + colb[i]; aN1[i] = S.arow(nxt, HALF + Rr[i]) + colb[i]; }
        } else {
#pragma unroll
            for (int i = 0; i < 2; ++i) { aN0[i] = aC0[i]; aN1[i] = aC1[i]; }
        }
        const char* nB = has_next ? (const char*)nxt.Bt + (size_t)nxt.pn * tstep : cB;
        for (int t = 0; t < nt; t += 2) {
            const bool last = (t == nt - 2);
            const char* a1 = Ab + (size_t)(t + 1) * kstep;
            const char* a2 = last ? Ab : Ab + (size_t)(t + 2) * kstep; const char* b2 = last ? nB : cB + (size_t)(t + 2) * kstep;
            const char* a3 = a2 + kstep; const char* b3 = b2 + kstep;
            unsigned x0[2], x1[2];
#pragma unroll
            for (int i = 0; i < 2; ++i) { x0[i] = last ? aN0[i] : aC0[i]; x1[i] = last ? aN1[i] : aC1[i]; }
            PG8_LDB(B0, 0, 0); PG8_LDB(B1, 0, 1); PG8_SCHED; PG8_LDA(At, 0, 0); PG8_STAGE(PG8_SA(1, 1), a1, aC1);
            PG8_WAIT_V(8); PG8_WAIT_L(0); PG8_BAR; PG8_MMA(0, 0, At, B0); PG8_MMA(0, 1, At, B1); PG8_BAR; PG8_SCHED;
            PG8_LDA(At, 0, 1); PG8_STAGE(PG8_SB(0, 0), b2, voffB); PG8_STAGE(PG8_SB(0, 1), b2 + hstep, voffB); PG8_STAGE(PG8_SA(0, 0), a2, x0);
            PG8_WAIT_V(8); PG8_WAIT_L(0); PG8_BAR; PG8_MMA(1, 0, At, B0); PG8_MMA(1, 1, At, B1); PG8_BAR; PG8_SCHED;
            PG8_LDB(B0, 1, 0); PG8_LDB(B1, 1, 1); PG8_SCHED; PG8_LDA(At, 1, 0); PG8_STAGE(PG8_SA(0, 1), a2, x1);
            PG8_WAIT_V(8); PG8_WAIT_L(0); PG8_BAR; PG8_MMA(0, 0, At, B0); PG8_MMA(0, 1, At, B1); PG8_BAR; PG8_SCHED;
            PG8_LDA(At, 1, 1); PG8_STAGE(PG8_SB(1, 0), b3, voffB); PG8_STAGE(PG8_SB(1, 1), b3 + hstep, voffB); PG8_STAGE(PG8_SA(1, 0), a3, x0);
            PG8_WAIT_V(8); PG8_WAIT_L(0); PG8_BAR; PG8_MMA(1, 0, At, B0); PG8_MMA(1, 1, At, B1); PG8_BAR; PG8_SCHED;
        }
        if (wr == 0) PG8_BAR;
        if constexpr (FP8) asm volatile("s_nop 15\n\ts_nop 7" ::: "memory");
        E(acc, cur, wr, wc, fr, fq);
        if (!has_next) break;
#pragma unroll
        for (int a = 0; a < 2; ++a)
#pragma unroll
            for (int b = 0; b < 2; ++b)
#pragma unroll
                for (int m = 0; m < 4; ++m)
#pragma unroll
                    for (int n = 0; n < 2; ++n) acc[a][b][m][n] = (f32x4){0.f, 0.f, 0.f, 0.f};
        cur = nxt; cB = nB; ++ui;
#pragma unroll
        for (int i = 0; i < 2; ++i) { aC0[i] = aN0[i]; aC1[i] = aN1[i]; }
        if (wr == 1) PG8_BAR;
    }
    PG8_WAIT_V(0);
    PG8_BAR;
#undef PG8_SA
#undef PG8_SB
#undef PG8_STAGE
#undef PG8_LDA
#undef PG8_LDB
#undef PG8_MMA
#undef PG8_WAIT_V
#undef PG8_WAIT_L
#undef PG8_BAR
#undef PG8_SCHED
}
}

__device__ __forceinline__ int vcu_of(const Frame& F) { return (F.G % 8 == 0) ? (F.bid % 8) * (F.G / 8) + F.bid / 8 : F.bid; }
__device__ __forceinline__ void phase_qkv_opt(const Frame& F, const Prm& p) {
    pg8::DenseOrder S; S.init(NTOK, 3072, 512, (const bf16*)(p.ws + WS_WQKV), F.G, F.bid);
    static_assert(WS_V - WS_K == WS_K - WS_Q, "Q|K|V equally spaced");
    LAS float* ropel = (LAS float*)((LAS unsigned char*)F.lds + LDSX_OFF);
    const float* ropeg = (const float*)(p.ws + WS_MISC) + 1024;
    for (int i = F.tid; i < 2048; i += NTHR) ropel[i] = ropeg[i];
    __syncthreads();
    pg8::EpiQKV E{(bf16*)(p.ws + WS_Q), ropel, W8_INV};
    pg8::gemm_phase<pg8::EpiQKV, pg8::DenseOrder, true>(F.lds, (const bf16*)(p.ws + WS_H), 512, S, E);
}
__device__ __forceinline__ void phase_wo_opt(const Frame& F, const Prm& p, int layer) {
    if (layer) {
        pg8::DenseOrder S; S.init(NLAT, 1024, 512, (const bf16*)(p.ws + WS_WGO), F.G, F.bid);
        pg8::EpiPlain E{(bf16*)(p.ws + WS_Y), W8_INV};
        pg8::gemm_phase<pg8::EpiPlain, pg8::DenseOrder, true>(F.lds, (const bf16*)(p.ws + WS_A2B), 512, S, E);
    } else {
        pg8::DenseOrder S; S.init(NTOK, 1024, 512, (const bf16*)(p.ws + WS_WO), F.G, F.bid);
        pg8::EpiPlain E{(bf16*)(p.ws + WS_Y), W8_INV};
        pg8::gemm_phase<pg8::EpiPlain, pg8::DenseOrder, true>(F.lds, (const bf16*)(p.ws + WS_A2), 512, S, E);
    }
}
__device__ __forceinline__ void phase_inproj_opt(const Frame& F, const Prm& p) {
    pg8::DenseOrder S; S.init(NTOK, NIN, 512, (const bf16*)(p.ws + WS_WIN), F.G, F.bid);
    pg8::EpiInproj E{(bf16*)(p.ws + WS_QR), (bf16*)(p.ws + WS_KR), (bf16*)(p.ws + WS_V1), (bf16*)(p.ws + WS_R), (float*)(p.ws + WS_ZZ), W8_INV};
    pg8::gemm_phase<pg8::EpiInproj, pg8::DenseOrder, true>(F.lds, (const bf16*)(p.ws + WS_H), 512, S, E);
}
__device__ __forceinline__ void phase_moe1_opt(const Frame& F, const Prm& p, int layer) {
    pg8::MoeOrder<true> S; S.init(F.ctl + CW_CNT + layer * 16, 1024, 512, (const bf16*)(p.ws + (layer ? WS_GU1 : WS_GU0)), (const int*)(p.ws + WS_LIST), F.G, vcu_of(F));
    pg8::EpiGateUp E{p.ws + WS_ACT};
    pg8::gemm_phase<pg8::EpiGateUp, pg8::MoeOrder<true>, true>(F.lds, (const bf16*)(p.ws + WS_H), 512, S, E);
}
__device__ __forceinline__ void phase_moe2_opt(const Frame& F, const Prm& p, int layer) {
    pg8::MoeOrder<false> S; S.init(F.ctl + CW_CNT + layer * 16, 1024, 256, (const bf16*)(p.ws + (layer ? WS_DN1 : WS_DN0)), nullptr, F.G, vcu_of(F));
    pg8::EpiPlain E{(bf16*)(p.ws + WS_YM), W8_INV};
    pg8::gemm_phase<pg8::EpiPlain, pg8::MoeOrder<false>, true>(F.lds, (const bf16*)(p.ws + WS_ACT), 256, S, E);
}
namespace attn_body {
using bf16=unsigned short;
using bf16x8=__attribute__((ext_vector_type(8)))short;
using s16x4=__attribute__((ext_vector_type(4)))short;
using f32x16=__attribute__((ext_vector_type(16)))float;
using u32x4=__attribute__((ext_vector_type(4)))unsigned;
constexpr int D=64,DM=1024;
constexpr int NW=8,QBLK=32,QB=QBLK*NW,KVBLK=64;
constexpr int ATTN_PITCH=DM, ATTN_UNIT_ROWS=QB;
__device__ __forceinline__ int crow(int r,int hi){return (r&3)+8*(r>>2)+4*hi;}
#define SBAR() __builtin_amdgcn_sched_barrier(0)
__device__ __forceinline__ void cmask(f32x16&p0,f32x16&p1,int jb,int qrel,int hi){
  const float NEG=-INFINITY; int kb=64*jb+4*hi;
  #pragma unroll
  for(int r=0;r<16;++r){int kv=kb+(r&3)+8*(r>>2); if(kv>qrel)p0[r]=NEG; if(kv+32>qrel)p1[r]=NEG;}
}

constexpr int NSLOT=3, SLOTB=8192;
constexpr int LDS_K=0, LDS_V=NSLOT*SLOTB, LDS_WS=2*NSLOT*SLOTB, LDS_OST=LDS_WS+NW*64*4, LDS_BYTES=LDS_OST+NW*4096;
constexpr float C2=0.125f*1.4426950408889634f;
__device__ __forceinline__ void glds16(const void*gsrc,unsigned lds_dst){unsigned keep;
  asm volatile("s_mov_b32 %0, m0\n\ts_mov_b32 m0, %2\n\ts_nop 0\n\tglobal_load_lds_dwordx4 %1, off\n\ts_mov_b32 m0, %0":"=&s"(keep):"v"(gsrc),"s"(lds_dst):"memory");}
__device__ __forceinline__ float max3f(float a,float b,float c){float r;asm("v_max3_f32 %0, %1, %2, %3":"=v"(r):"v"(a),"v"(b),"v"(c));return r;}
__device__ __forceinline__ float max2f(float a,float b){float r;asm("v_max_f32_e32 %0, %1, %2":"=v"(r):"v"(a),"v"(b));return r;}
__device__ __forceinline__ float fadd_s(float a,float b){float r;asm("v_add_f32_e32 %0, %1, %2":"=v"(r):"v"(a),"v"(b));return r;}
__device__ __forceinline__ float fsub_s(float a,float b){float r;asm("v_sub_f32_e32 %0, %1, %2":"=v"(r):"v"(a),"v"(b));return r;}
typedef float f32x2_t __attribute__((ext_vector_type(2))); typedef __bf16 bf16x2_t __attribute__((ext_vector_type(2)));
__device__ __forceinline__ unsigned cvtpk_s(float lo,float hi){f32x2_t v={lo,hi};bf16x2_t b=__builtin_convertvector(v,bf16x2_t);return __builtin_bit_cast(unsigned,b);}
#define WAIT_BAR(N) asm volatile("s_waitcnt vmcnt(" #N ") lgkmcnt(0)\n\ts_barrier":::"memory")

__device__ __forceinline__ void qkt(f32x16&p0,f32x16&p1,const char*Kslot,const bf16x8*qr,const f32x16&negm,int r32,int hi){
  const char*kb=Kslot+hi*1024+r32*16;
  #pragma unroll
  for(int d0=0;d0<4;++d0){
    const bf16x8 b0=*reinterpret_cast<const bf16x8*>(kb+d0*2048);
    const bf16x8 b1=*reinterpret_cast<const bf16x8*>(kb+d0*2048+512);
    if(d0==0){p0=__builtin_amdgcn_mfma_f32_32x32x16_bf16(b0,qr[0],negm,0,0,0);p1=__builtin_amdgcn_mfma_f32_32x32x16_bf16(b1,qr[0],negm,0,0,0);}
    else{p0=__builtin_amdgcn_mfma_f32_32x32x16_bf16(b0,qr[d0],p0,0,0,0);p1=__builtin_amdgcn_mfma_f32_32x32x16_bf16(b1,qr[d0],p1,0,0,0);}}
}
typedef __attribute__((address_space(3))) const char* lds_cptr;
typedef short v4i16_t __attribute__((ext_vector_type(4)));
__device__ __forceinline__ void kload8(bf16x8*kf,lds_cptr kp){
  kf[0]=*(const __attribute__((address_space(3))) bf16x8*)(kp);      kf[1]=*(const __attribute__((address_space(3))) bf16x8*)(kp+512);
  kf[2]=*(const __attribute__((address_space(3))) bf16x8*)(kp+2048); kf[3]=*(const __attribute__((address_space(3))) bf16x8*)(kp+2560);
  kf[4]=*(const __attribute__((address_space(3))) bf16x8*)(kp+4096); kf[5]=*(const __attribute__((address_space(3))) bf16x8*)(kp+4608);
  kf[6]=*(const __attribute__((address_space(3))) bf16x8*)(kp+6144); kf[7]=*(const __attribute__((address_space(3))) bf16x8*)(kp+6656);
}
__device__ __forceinline__ void kload2(bf16x8*kf,lds_cptr kp,int j){ kf[2*j]=*(const __attribute__((address_space(3))) bf16x8*)(kp+j*2048); kf[2*j+1]=*(const __attribute__((address_space(3))) bf16x8*)(kp+j*2048+512); }
__device__ __forceinline__ s16x4 vtr(lds_cptr p){ return __builtin_bit_cast(s16x4,__builtin_amdgcn_ds_read_tr16_b64_v4i16((__attribute__((address_space(3))) v4i16_t*)p)); }
__device__ __forceinline__ float rowmax(const f32x16&p0,const f32x16&p1){
  float a=max3f(p0[0],p0[1],p1[0]),b=max3f(p0[2],p0[3],p1[1]);a=max3f(a,p1[2],p1[3]);
  #pragma unroll
  for(int r=4;r<16;r+=4){a=max3f(a,p0[r],p0[r+1]);b=max3f(b,p0[r+2],p0[r+3]);a=max3f(a,p1[r],p1[r+1]);b=max3f(b,p1[r+2],p1[r+3]);}
  const float m=max2f(a,b);
  auto rr=__builtin_amdgcn_permlane32_swap(__float_as_uint(m),__float_as_uint(m),false,false);
  return max2f(__uint_as_float(rr[0]),__uint_as_float(rr[1]));
}
__device__ __forceinline__ void pv(f32x16*o,int vb,bf16x8 pa0,bf16x8 pa1,bf16x8 pa2,bf16x8 pa3){
  #pragma unroll
  for(int d0=0;d0<2;++d0){s16x4 lo[4],hi[4];
    #pragma unroll
    for(int ks=0;ks<4;++ks){
      asm volatile("ds_read_b64_tr_b16 %0,%1 offset:%c2":"=&v"(lo[ks]):"v"(vb),"i"(d0*4096+ks*1024):"memory");
      asm volatile("ds_read_b64_tr_b16 %0,%1 offset:%c2":"=&v"(hi[ks]):"v"(vb),"i"(d0*4096+ks*1024+512):"memory");}
    asm volatile("s_waitcnt lgkmcnt(0)":::"memory");SBAR();
    #define PK(k) (bf16x8){lo[k][0],lo[k][1],lo[k][2],lo[k][3],hi[k][0],hi[k][1],hi[k][2],hi[k][3]}
    o[d0]=__builtin_amdgcn_mfma_f32_32x32x16_bf16(pa0,PK(0),o[d0],0,0,0);
    o[d0]=__builtin_amdgcn_mfma_f32_32x32x16_bf16(pa1,PK(1),o[d0],0,0,0);
    o[d0]=__builtin_amdgcn_mfma_f32_32x32x16_bf16(pa2,PK(2),o[d0],0,0,0);
    o[d0]=__builtin_amdgcn_mfma_f32_32x32x16_bf16(pa3,PK(3),o[d0],0,0,0);
    #undef PK
  }
}

#ifndef ATTN_STORE16
#define ATTN_STORE16(p,v) (*(u32x4*)(p)=(v))
#endif
template<int THRL> __device__ __forceinline__ void attn_unit(long qrow0,int qcol,int vcol,long kctx,long klat,int NT,const bf16*Q,const bf16*__restrict__ K,const bf16*__restrict__ V,bf16*O,char*shm){
  const int tid=threadIdx.x,lane=tid&63,r32=lane&31,hi=lane>>5; const int wid=__builtin_amdgcn_readfirstlane(tid>>6);

  const bf16*Qw=Q+(qrow0+wid*QBLK)*DM+qcol;
  const bf16*Kh=K+qcol,*Vh=V+vcol;
  const unsigned lds0=(unsigned)(uintptr_t)shm;
  float*wsf=(float*)(shm+LDS_WS)+wid*64;
  const bf16*ksrc=Kh+(long)lane*DM+wid*8;
  const bf16*vsrc=Vh+(long)(16*(wid&3)+(lane>>2))*DM+(wid>>2)*32+(lane&3)*8;
  const unsigned kdst=lds0+LDS_K+wid*1024, vdst=lds0+LDS_V+wid*1024;
  #define KVROW(t) ((t)<4?kctx+(long)(t)*KVBLK:klat+(long)((t)-4)*KVBLK)
  #define DMA_K(t,slot) glds16(ksrc+KVROW(t)*DM,(unsigned)__builtin_amdgcn_readfirstlane(kdst+(slot)))
  #define DMA_V(t,slot) glds16(vsrc+KVROW(t)*DM,(unsigned)__builtin_amdgcn_readfirstlane(vdst+(slot)))
  const int vb0=(int)(lds0+LDS_V)+((lane>>4)&1)*32+(lane&3)*8+(4*hi+((lane&15)>>2))*64;
  const char*Kbase=shm+LDS_K; bf16x8 kf[8];
  const lds_cptr shm3=(lds_cptr)shm; const lds_cptr kp0=shm3+LDS_K+hi*1024+r32*16; const lds_cptr vp0=shm3+LDS_V+((lane>>4)&1)*32+(lane&3)*8+(4*hi+((lane&15)>>2))*64;
  DMA_K(0,0);DMA_V(0,0);DMA_K(1,SLOTB);
  bf16x8 qr[4];
  #pragma unroll
  for(int d0=0;d0<4;++d0)qr[d0]=*reinterpret_cast<const bf16x8*>(&Qw[(long)r32*DM+d0*16+hi*8]);
  float mhat=0.f,l_reg=0.f;f32x16 o[2];o[0]=f32x16{};o[1]=f32x16{};f32x16 negm=f32x16{};asm volatile("":"+v"(negm));
  const int qrel=wid*QBLK+r32;
  #define CMASK(P0,P1,t) do{}while(0)
  bool resc=false;
  #define START(P0,P1) do{ const float rm=rowmax(P0,P1); resc=false; \
    { const float dl=rm; mhat=fadd_s(mhat,dl); \
      _Pragma("unroll") for(int r=0;r<16;++r){P0[r]=fsub_s(P0[r],dl);P1[r]=fsub_s(P1[r],dl);} \
      _Pragma("unroll") for(int r=0;r<16;++r)negm[r]=-mhat; asm volatile("":"+v"(negm)); } \
    _Pragma("unroll") for(int r=0;r<16;++r)P0[r]=__builtin_amdgcn_exp2f(P0[r]); }while(0)
  #define RESC() do{ if(resc){ asm volatile("s_waitcnt lgkmcnt(0)":::"memory"); \
      _Pragma("unroll") for(int d_=0;d_<2;++d_) _Pragma("unroll") for(int r=0;r<16;++r)o[d_][r]*=wsf[crow(r,hi)]; } }while(0)
  f32x16 pA0,pA1,pB0,pB1;
  int sl_prev=0,sl_cur=0,sl_next=SLOTB;
  #define ROT() do{sl_prev=sl_cur;sl_cur=sl_next;sl_next=(sl_next==(NSLOT-1)*SLOTB)?0:sl_next+SLOTB;}while(0)
  DMA_K(2,2*SLOTB);
  WAIT_BAR(3);
  qkt(pA0,pA1,Kbase,qr,negm,r32,hi);asm volatile("s_nop 15\n\ts_nop 7":"+v"(pA0),"+v"(pA1));CMASK(pA0,pA1,0);
  START(pA0,pA1);
  _Pragma("unroll") for(int r=0;r<16;++r)pA1[r]=__builtin_amdgcn_exp2f(pA1[r]);
  WAIT_BAR(0);
  DMA_K(3,0);DMA_V(1,SLOTB);
  ROT();
  kload8(kf,kp0+sl_cur);
  WAIT_BAR(2);
  s16x4 vlo[8],vhi[8]; u32x4 pw0,pw1,pw2,pw3;
  #define PKW(P,B) cvtpk_s(P[B],P[B+1])
  #define PAF(k) __builtin_bit_cast(bf16x8,pw##k)
  #define VFR(i) (bf16x8){vlo[i][0],vlo[i][1],vlo[i][2],vlo[i][3],vhi[i][0],vhi[i][1],vhi[i][2],vhi[i][3]}
  #define PIN(x) asm volatile("":"+v"(x))
  #define MX3(a,b,c) __builtin_fmaxf(__builtin_fmaxf((a),(b)),(c))
  #define GAPA(MF,A0,A1,A2,A3,W0,W1,PW) do{ MF; sacc+=A0; sacc+=A1; sacc+=A2; sacc+=A3; PIN(sacc); W0; W1; PIN(PW); SBAR(); }while(0)
  #define EX(v) __builtin_amdgcn_exp2f(v)
  #define GAPB(MF,X,B) do{ MF; X[B]=EX(X[B]); X[B+1]=EX(X[B+1]); X[B+2]=EX(X[B+2]); X[B+3]=EX(X[B+3]); PIN(X); SBAR(); }while(0)
  #define VRD(i) do{ vlo[i]=vtr(vp_+(((i)>>2)*4096+((i)&3)*1024)); vhi[i]=vtr(vp_+(((i)>>2)*4096+((i)&3)*1024+512)); }while(0)
  #define KRD(G,j) do{ if(G){ kload2(kf,kp0+sl_next,j); SBAR(); } }while(0)
  #define STEP(C0,C1,P0,P1,t,GK,GV,GL) do{ SBAR(); \
    const lds_cptr vp_=vp0+sl_prev; \
    VRD(0); SBAR(); float sacc=(P0[0]+P0[1]); \
    GAPA(C0=__builtin_amdgcn_mfma_f32_32x32x16_bf16(kf[0],qr[0],negm,0,0,0), P0[2],P0[3],P0[4],P0[5],     pw0[0]=PKW(P0,0), pw0[1]=PKW(P0,2), pw0); \
    VRD(4); SBAR(); GAPA(C1=__builtin_amdgcn_mfma_f32_32x32x16_bf16(kf[1],qr[0],negm,0,0,0), P0[6],P0[7],P0[8],P0[9],     pw0[2]=PKW(P0,4), pw0[3]=PKW(P0,6), pw0); \
    VRD(1); SBAR(); GAPA(C0=__builtin_amdgcn_mfma_f32_32x32x16_bf16(kf[2],qr[1],C0,0,0,0),   P0[10],P0[11],P0[12],P0[13], pw1[0]=PKW(P0,8), pw1[1]=PKW(P0,10), pw1); \
    VRD(5); SBAR(); GAPA(C1=__builtin_amdgcn_mfma_f32_32x32x16_bf16(kf[3],qr[1],C1,0,0,0),   P0[14],P0[15],P1[0],P1[1],   pw1[2]=PKW(P0,12),pw1[3]=PKW(P0,14), pw1); \
    VRD(2); SBAR(); GAPA(C0=__builtin_amdgcn_mfma_f32_32x32x16_bf16(kf[4],qr[2],C0,0,0,0),   P1[2],P1[3],P1[4],P1[5],     pw2[0]=PKW(P1,0), pw2[1]=PKW(P1,2), pw2); \
    VRD(6); SBAR(); GAPA(C1=__builtin_amdgcn_mfma_f32_32x32x16_bf16(kf[5],qr[2],C1,0,0,0),   P1[6],P1[7],P1[8],P1[9],     pw2[2]=PKW(P1,4), pw2[3]=PKW(P1,6), pw2); \
    VRD(3); SBAR(); GAPA(C0=__builtin_amdgcn_mfma_f32_32x32x16_bf16(kf[6],qr[3],C0,0,0,0),   P1[10],P1[11],P1[12],P1[13], pw3[0]=PKW(P1,8), pw3[1]=PKW(P1,10), pw3); \
    VRD(7); SBAR(); GAPA(C1=__builtin_amdgcn_mfma_f32_32x32x16_bf16(kf[7],qr[3],C1,0,0,0),   P1[14],P1[15],0.f,0.f,       pw3[2]=PKW(P1,12),pw3[3]=PKW(P1,14), pw3); \
    l_reg+=sacc; \
    if(GK){DMA_K((t)+3,sl_cur);} if(GV){DMA_V((t)+1,sl_next);} \
    CMASK(C0,C1,t); \
    { float a=MX3(C0[0],C0[1],C1[0]),b=MX3(C0[2],C0[3],C1[1]); a=MX3(a,C1[2],C1[3]); \
      _Pragma("unroll") for(int r=4;r<16;r+=4){a=MX3(a,C0[r],C0[r+1]);b=MX3(b,C0[r+2],C0[r+3]);a=MX3(a,C1[r],C1[r+1]);b=MX3(b,C1[r+2],C1[r+3]);} \
      float rm=__builtin_fmaxf(a,b); { auto rr=__builtin_amdgcn_permlane32_swap(__float_as_uint(rm),__float_as_uint(rm),false,false); rm=__builtin_fmaxf(__uint_as_float(rr[0]),__uint_as_float(rr[1])); } \
      resc=false; \
      if(__builtin_expect(__any(rm>(float)THRL),0)){ const float dl=__builtin_fmaxf(rm,0.f); mhat+=dl; \
        _Pragma("unroll") for(int r=0;r<16;++r){C0[r]-=dl;C1[r]-=dl;} \
        _Pragma("unroll") for(int r=0;r<16;++r)negm[r]=-mhat; asm volatile("":"+v"(negm)); \
        const float f=__builtin_amdgcn_exp2f(-dl); l_reg*=f; if(hi==0)wsf[r32]=f; resc=true; } } \
    SBAR(); \
    GAPB(o[0]=__builtin_amdgcn_mfma_f32_32x32x16_bf16(PAF(0),VFR(0),o[0],0,0,0), C0,0); \
    GAPB(o[1]=__builtin_amdgcn_mfma_f32_32x32x16_bf16(PAF(0),VFR(4),o[1],0,0,0), C0,4); \
    KRD(GL,0); GAPB(o[0]=__builtin_amdgcn_mfma_f32_32x32x16_bf16(PAF(1),VFR(1),o[0],0,0,0), C0,8); \
    KRD(GL,1); GAPB(o[1]=__builtin_amdgcn_mfma_f32_32x32x16_bf16(PAF(1),VFR(5),o[1],0,0,0), C0,12); \
    KRD(GL,2); GAPB(o[0]=__builtin_amdgcn_mfma_f32_32x32x16_bf16(PAF(2),VFR(2),o[0],0,0,0), C1,0); \
    KRD(GL,3); GAPB(o[1]=__builtin_amdgcn_mfma_f32_32x32x16_bf16(PAF(2),VFR(6),o[1],0,0,0), C1,4); \
    GAPB(o[0]=__builtin_amdgcn_mfma_f32_32x32x16_bf16(PAF(3),VFR(3),o[0],0,0,0), C1,8); \
    GAPB(o[1]=__builtin_amdgcn_mfma_f32_32x32x16_bf16(PAF(3),VFR(7),o[1],0,0,0), C1,12); \
    }while(0)
  int t=1;
  #undef CMASK
  #define CMASK(P0,P1,t) do{}while(0)
  for(;t+5<NT;t+=2){
    STEP(pB0,pB1,pA0,pA1,t,true,true,true);     WAIT_BAR(2); RESC(); ROT();
    STEP(pA0,pA1,pB0,pB1,t+1,true,true,true);   WAIT_BAR(2); RESC(); ROT();
  }
  #undef CMASK
  #define CMASK(P0,P1,t) do{}while(0)
  #define ENDW(tt) do{ if((tt)+3<NT){WAIT_BAR(2);} else if((tt)+2<NT){WAIT_BAR(1);} else {WAIT_BAR(0);} }while(0)
  for(;t+1<NT;t+=2){
    STEP(pB0,pB1,pA0,pA1,t,(t+3<NT),(t+1<NT),(t+1<NT));       ENDW(t);   RESC(); ROT();
    STEP(pA0,pA1,pB0,pB1,t+1,(t+4<NT),(t+2<NT),(t+2<NT));     ENDW(t+1); RESC(); ROT();
  }
  STEP(pB0,pB1,pA0,pA1,NT-1,false,false,false); RESC();
  { float sacc=pB0[0]+pB0[1]; _Pragma("unroll") for(int r=2;r<16;++r)sacc+=pB0[r]; _Pragma("unroll") for(int r=0;r<16;++r)sacc+=pB1[r]; l_reg+=sacc;
    pw0=(u32x4){PKW(pB0,0),PKW(pB0,2),PKW(pB0,4),PKW(pB0,6)};pw1=(u32x4){PKW(pB0,8),PKW(pB0,10),PKW(pB0,12),PKW(pB0,14)};pw2=(u32x4){PKW(pB1,0),PKW(pB1,2),PKW(pB1,4),PKW(pB1,6)};pw3=(u32x4){PKW(pB1,8),PKW(pB1,10),PKW(pB1,12),PKW(pB1,14)};
    SBAR(); pv(o,vb0+sl_cur,PAF(0),PAF(1),PAF(2),PAF(3)); }
  #undef PKW
  #undef PAF
  #undef VFR
  #undef PIN
  #undef MX3
  #undef GAPA
  #undef GAPB
  #undef EX
  #undef VRD
  #undef KRD
  #undef STEP
  #undef ENDW
  {auto rr=__builtin_amdgcn_permlane32_swap(__float_as_uint(l_reg),__float_as_uint(l_reg),false,false);l_reg=__uint_as_float(rr[0])+__uint_as_float(rr[1]);}
  if(hi==0)wsf[32+r32]=l_reg;asm volatile("s_waitcnt lgkmcnt(0)":::"memory");
  float rli[16];
  #pragma unroll
  for(int r=0;r<16;++r)rli[r]=__builtin_amdgcn_rcpf(wsf[32+crow(r,hi)]);
  bf16*Ow=O+(qrow0+wid*QBLK)*DM+vcol;
  { bf16*stg=(bf16*)(shm+LDS_OST)+wid*2048;
    #pragma unroll
    for(int r=0;r<16;++r){const int orow=crow(r,hi);
      #pragma unroll
      for(int d0=0;d0<2;++d0)stg[orow*64+d0*32+r32]=(bf16)f2bf(o[d0][r]*rli[r]);}
    asm volatile("s_waitcnt lgkmcnt(0)":::"memory");
    #pragma unroll
    for(int i=0;i<4;++i){const int row=i*8+(lane>>3),ch=lane&7; const u32x4 v=*(const u32x4*)(stg+row*64+ch*8); ATTN_STORE16(Ow+(long)row*DM+ch*8,v);} }
  asm volatile("s_waitcnt lgkmcnt(0)\n\ts_barrier":::"memory");
  #undef DMA_K
  #undef DMA_V
  #undef CMASK
  #undef START
  #undef RESC
  #undef ROT
}
constexpr int ATTN_LDS_BYTES=LDS_BYTES;
#undef SBAR
#undef WAIT_BAR
#undef KVROW
}
namespace attn_body {
constexpr int V2SLOT = 16384;
constexpr int L2_K = 0, L2_V = NSLOT * SLOTB, L2_WS = L2_V + NSLOT * V2SLOT, L2_OST = L2_WS + NW * 64 * 4, L2_BYTES = L2_OST + NW * 4096;
#define SBAR() __builtin_amdgcn_sched_barrier(0)
#define WAIT_BAR(N) asm volatile("s_waitcnt vmcnt(" #N ") lgkmcnt(0)\n\ts_barrier":::"memory")
template<int THRL> __device__ __forceinline__ void attn_unit2(long qrow0,int qcol,int vcol,long kctx,long klat,int NT,const bf16*Q,const bf16*__restrict__ K,const bf16*__restrict__ V,bf16*O,char*shm){
  const int tid=threadIdx.x,lane=tid&63,r32=lane&31,hi=lane>>5; const int wid=__builtin_amdgcn_readfirstlane(tid>>6);
  const bf16*Qw=Q+(qrow0+wid*QBLK)*DM+qcol;
  const bf16*Kh=K+qcol,*Vh=V+vcol;
  const unsigned lds0=(unsigned)(uintptr_t)shm;
  float*wsf=(float*)(shm+L2_WS)+wid*64;
  const bf16*ksrc=Kh+(long)lane*DM+wid*8;
  const bf16*vsrc=Vh+(long)(16*(wid&3)+(lane>>2))*DM+(wid>>2)*32+(lane&3)*8;
  const unsigned kdst=lds0+L2_K+wid*1024, vdst=lds0+L2_V+wid*1024;
  #define KVROW(t) ((t)<4?kctx+(long)(t)*KVBLK:klat+(long)((t)-4)*KVBLK)
  #define DMA_K(t,slot) glds16(ksrc+KVROW(t)*DM,(unsigned)__builtin_amdgcn_readfirstlane(kdst+(slot)))
  #define DMA_V(t,slot) do{ glds16(vsrc+KVROW(t)*DM,(unsigned)__builtin_amdgcn_readfirstlane(vdst+2*(slot))); glds16(vsrc+KVROW(t)*DM+64,(unsigned)__builtin_amdgcn_readfirstlane(vdst+2*(slot)+8192)); }while(0)
  const char*Kbase=shm+L2_K; bf16x8 kf[8];
  const lds_cptr shm3=(lds_cptr)shm; const lds_cptr kp0=shm3+L2_K+hi*1024+r32*16; const lds_cptr vp0=shm3+L2_V+((lane>>4)&1)*32+(lane&3)*8+(4*hi+((lane&15)>>2))*64;
  DMA_K(0,0);DMA_V(0,0);DMA_K(1,SLOTB);
  bf16x8 qr[4];
  #pragma unroll
  for(int d0=0;d0<4;++d0)qr[d0]=*reinterpret_cast<const bf16x8*>(&Qw[(long)r32*DM+d0*16+hi*8]);
  float mhat=0.f,l_reg=0.f;f32x16 o[4];o[0]=f32x16{};o[1]=f32x16{};o[2]=f32x16{};o[3]=f32x16{};const f32x16 zero16=f32x16{};
  bool resc=false;
  #define START(P0,P1) do{ const float rm=rowmax(P0,P1); resc=false; mhat=rm; \
    _Pragma("unroll") for(int r=0;r<16;++r){P0[r]=fsub_s(P0[r],rm);P1[r]=fsub_s(P1[r],rm);} \
    _Pragma("unroll") for(int r=0;r<16;++r)P0[r]=__builtin_amdgcn_exp2f(P0[r]); }while(0)
  #define RESC() do{ if(resc){ asm volatile("s_waitcnt lgkmcnt(0)":::"memory"); \
      _Pragma("unroll") for(int d_=0;d_<4;++d_) _Pragma("unroll") for(int r=0;r<16;++r)o[d_][r]*=wsf[crow(r,hi)]; } }while(0)
  int sl_prev=0,sl_cur=0,sl_next=SLOTB;
  #define ROT() do{sl_prev=sl_cur;sl_cur=sl_next;sl_next=(sl_next==(NSLOT-1)*SLOTB)?0:sl_next+SLOTB;}while(0)
  DMA_K(2,2*SLOTB);
  WAIT_BAR(4);
  #define PKW(P,B) cvtpk_s(P[B],P[B+1])
  u32x4 pwA0,pwA1,pwA2,pwA3,pwB0,pwB1,pwB2,pwB3;
  { f32x16 p0,p1;
    qkt(p0,p1,Kbase,qr,zero16,r32,hi);asm volatile("s_nop 15\n\ts_nop 7":"+v"(p0),"+v"(p1));
    START(p0,p1);
    _Pragma("unroll") for(int r=0;r<16;++r)p1[r]=__builtin_amdgcn_exp2f(p1[r]);
    float sacc=p0[0]+p0[1]; _Pragma("unroll") for(int r=2;r<16;++r)sacc+=p0[r]; _Pragma("unroll") for(int r=0;r<16;++r)sacc+=p1[r]; l_reg+=sacc;
    pwA0=(u32x4){PKW(p0,0),PKW(p0,2),PKW(p0,4),PKW(p0,6)};pwA1=(u32x4){PKW(p0,8),PKW(p0,10),PKW(p0,12),PKW(p0,14)};pwA2=(u32x4){PKW(p1,0),PKW(p1,2),PKW(p1,4),PKW(p1,6)};pwA3=(u32x4){PKW(p1,8),PKW(p1,10),PKW(p1,12),PKW(p1,14)}; }
  WAIT_BAR(0);
  DMA_K(3,0);DMA_V(1,SLOTB);
  ROT();
  kload8(kf,kp0+sl_cur);
  WAIT_BAR(3);
  s16x4 vAl[4],vAh[4],vBl[4],vBh[4];
  #define PAFX(x) __builtin_bit_cast(bf16x8,x)
  #define VF(A,d) (bf16x8){A##l[d][0],A##l[d][1],A##l[d][2],A##l[d][3],A##h[d][0],A##h[d][1],A##h[d][2],A##h[d][3]}
  #define PIN(x) asm volatile("":"+v"(x))
  #define MX3(a,b,c) __builtin_fmaxf(__builtin_fmaxf((a),(b)),(c))
  #define EX(v) __builtin_amdgcn_exp2f(v)
  #define VRDL(A,d,ks) A##l[d]=vtr(vp_+((d)*4096+(ks)*1024))
  #define VRDH(A,d,ks) A##h[d]=vtr(vp_+((d)*4096+(ks)*1024+512))
  #define GAPP(MF,X,B,PWN,W,RD) do{ MF; X[B]=EX(X[B]-mhat); X[B+1]=EX(X[B+1]-mhat); sacc+=X[B]; sacc+=X[B+1]; PIN(sacc); PWN[W]=cvtpk_s(X[B],X[B+1]); PIN(PWN); RD; SBAR(); }while(0)
  #define MFQ(C,kf_,q_,acc_) C=__builtin_amdgcn_mfma_f32_32x32x16_bf16(kf_,q_,acc_,0,0,0)
  #define MFO(d,PW,A) o[d]=__builtin_amdgcn_mfma_f32_32x32x16_bf16(PAFX(PW),VF(A,d),o[d],0,0,0)
  #define KRD(G,j) do{ if(G){ kload2(kf,kp0+sl_next,j); } }while(0)
  #define STEP2(t,PI0,PI1,PI2,PI3,PO0,PO1,PO2,PO3,GK,GV,GL) do{ SBAR(); \
    const lds_cptr vp_=vp0+2*sl_prev; f32x16 C0,C1; float sacc=0.f; \
    VRDL(vA,0,0); SBAR(); MFQ(C0,kf[0],qr[0],zero16); SBAR(); \
    VRDH(vA,0,0); SBAR(); MFQ(C1,kf[1],qr[0],zero16); SBAR(); \
    VRDL(vA,1,0); SBAR(); MFQ(C0,kf[2],qr[1],C0); SBAR(); \
    VRDH(vA,1,0); SBAR(); MFQ(C1,kf[3],qr[1],C1); SBAR(); \
    VRDL(vA,2,0); SBAR(); MFQ(C0,kf[4],qr[2],C0); SBAR(); \
    VRDH(vA,2,0); SBAR(); MFQ(C1,kf[5],qr[2],C1); SBAR(); \
    VRDL(vA,3,0); SBAR(); MFQ(C0,kf[6],qr[3],C0); SBAR(); \
    VRDH(vA,3,0); SBAR(); MFQ(C1,kf[7],qr[3],C1); SBAR(); \
    if(GK){DMA_K((t)+3,sl_cur);} if(GV){DMA_V((t)+1,sl_next);} \
    { float a=MX3(C0[0],C0[1],C1[0]),b=MX3(C0[2],C0[3],C1[1]); a=MX3(a,C1[2],C1[3]); \
      _Pragma("unroll") for(int r=4;r<16;r+=4){a=MX3(a,C0[r],C0[r+1]);b=MX3(b,C0[r+2],C0[r+3]);a=MX3(a,C1[r],C1[r+1]);b=MX3(b,C1[r+2],C1[r+3]);} \
      float rm=__builtin_fmaxf(a,b); { auto rr=__builtin_amdgcn_permlane32_swap(__float_as_uint(rm),__float_as_uint(rm),false,false); rm=__builtin_fmaxf(__uint_as_float(rr[0]),__uint_as_float(rr[1])); } \
      resc=false; \
      if(__builtin_expect(__any(rm-mhat>(float)THRL),0)){ const float dl=__builtin_fmaxf(rm-mhat,0.f); mhat+=dl; \
        const float f=__builtin_amdgcn_exp2f(-dl); l_reg*=f; if(hi==0)wsf[r32]=f; resc=true; } } \
    SBAR(); \
    GAPP(MFO(0,PI0,vA),C0,0, PO0,0, VRDL(vB,0,1);VRDH(vB,0,1)); \
    GAPP(MFO(1,PI0,vA),C0,2, PO0,1, VRDL(vB,1,1);VRDH(vB,1,1)); \
    GAPP(MFO(2,PI0,vA),C0,4, PO0,2, VRDL(vB,2,1);VRDH(vB,2,1)); \
    GAPP(MFO(3,PI0,vA),C0,6, PO0,3, VRDL(vB,3,1);VRDH(vB,3,1)); \
    GAPP(MFO(0,PI1,vB),C0,8, PO1,0, VRDL(vA,0,2);VRDH(vA,0,2)); \
    GAPP(MFO(1,PI1,vB),C0,10,PO1,1, VRDL(vA,1,2);VRDH(vA,1,2)); \
    GAPP(MFO(2,PI1,vB),C0,12,PO1,2, VRDL(vA,2,2);VRDH(vA,2,2)); \
    GAPP(MFO(3,PI1,vB),C0,14,PO1,3, VRDL(vA,3,2);VRDH(vA,3,2)); \
    GAPP(MFO(0,PI2,vA),C1,0, PO2,0, VRDL(vB,0,3);VRDH(vB,0,3)); \
    GAPP(MFO(1,PI2,vA),C1,2, PO2,1, VRDL(vB,1,3);VRDH(vB,1,3)); \
    GAPP(MFO(2,PI2,vA),C1,4, PO2,2, VRDL(vB,2,3);VRDH(vB,2,3)); \
    GAPP(MFO(3,PI2,vA),C1,6, PO2,3, VRDL(vB,3,3);VRDH(vB,3,3)); \
    GAPP(MFO(0,PI3,vB),C1,8, PO3,0, KRD(GL,0)); \
    GAPP(MFO(1,PI3,vB),C1,10,PO3,1, KRD(GL,1)); \
    GAPP(MFO(2,PI3,vB),C1,12,PO3,2, KRD(GL,2)); \
    GAPP(MFO(3,PI3,vB),C1,14,PO3,3, KRD(GL,3)); \
    l_reg+=sacc; \
    }while(0)
  #define ENDW(tt) do{ if((tt)+3<NT){WAIT_BAR(3);} else if((tt)+2<NT){WAIT_BAR(2);} else {WAIT_BAR(0);} }while(0)
  int t=1;
  for(;t+5<NT;t+=2){
    STEP2(t,  pwA0,pwA1,pwA2,pwA3,pwB0,pwB1,pwB2,pwB3,true,true,true); WAIT_BAR(3); RESC(); ROT();
    STEP2(t+1,pwB0,pwB1,pwB2,pwB3,pwA0,pwA1,pwA2,pwA3,true,true,true); WAIT_BAR(3); RESC(); ROT();
  }
  for(;t+1<NT;t+=2){
    STEP2(t,  pwA0,pwA1,pwA2,pwA3,pwB0,pwB1,pwB2,pwB3,(t+3<NT),(t+1<NT),(t+1<NT)); ENDW(t);   RESC(); ROT();
    STEP2(t+1,pwB0,pwB1,pwB2,pwB3,pwA0,pwA1,pwA2,pwA3,(t+4<NT),(t+2<NT),(t+2<NT)); ENDW(t+1); RESC(); ROT();
  }
  STEP2(NT-1,pwA0,pwA1,pwA2,pwA3,pwB0,pwB1,pwB2,pwB3,false,false,false); RESC();
  { const lds_cptr vp_=vp0+2*sl_cur;
    #pragma unroll
    for(int ks=0;ks<4;++ks){
      #pragma unroll
      for(int d=0;d<4;++d){ const s16x4 lo=vtr(vp_+(d*4096+ks*1024)),hh=vtr(vp_+(d*4096+ks*1024+512)); const bf16x8 vf=(bf16x8){lo[0],lo[1],lo[2],lo[3],hh[0],hh[1],hh[2],hh[3]};
        const u32x4 pw=(ks==0)?pwB0:(ks==1)?pwB1:(ks==2)?pwB2:pwB3;
        o[d]=__builtin_amdgcn_mfma_f32_32x32x16_bf16(PAFX(pw),vf,o[d],0,0,0); } } }
  {auto rr=__builtin_amdgcn_permlane32_swap(__float_as_uint(l_reg),__float_as_uint(l_reg),false,false);l_reg=__uint_as_float(rr[0])+__uint_as_float(rr[1]);}
  if(hi==0)wsf[32+r32]=l_reg;asm volatile("s_waitcnt lgkmcnt(0)":::"memory");
  float rli[16];
  #pragma unroll
  for(int r=0;r<16;++r)rli[r]=__builtin_amdgcn_rcpf(wsf[32+crow(r,hi)]);
  bf16*Ow=O+(qrow0+wid*QBLK)*DM+vcol;
  { bf16*stg=(bf16*)(shm+L2_OST)+wid*2048;
    #pragma unroll
    for(int hf=0;hf<2;++hf){
      #pragma unroll
      for(int r=0;r<16;++r){const int orow=crow(r,hi);
        #pragma unroll
        for(int d0=0;d0<2;++d0)stg[orow*64+d0*32+r32]=(bf16)f2bf(o[2*hf+d0][r]*rli[r]);}
      asm volatile("s_waitcnt lgkmcnt(0)":::"memory");
      #pragma unroll
      for(int i=0;i<4;++i){const int row=i*8+(lane>>3),ch=lane&7; const u32x4 v=*(const u32x4*)(stg+row*64+ch*8); *(u32x4*)(Ow+(long)row*DM+hf*64+ch*8)=v;}
      asm volatile("s_waitcnt lgkmcnt(0)":::"memory"); } }
  asm volatile("s_waitcnt lgkmcnt(0)\n\ts_barrier":::"memory");
  #undef KVROW
  #undef DMA_K
  #undef DMA_V
  #undef START
  #undef RESC
  #undef ROT
  #undef PKW
  #undef PAFX
  #undef VF
  #undef PIN
  #undef MX3
  #undef EX
  #undef VRDL
  #undef VRDH
  #undef GAPP
  #undef MFQ
  #undef MFO
  #undef KRD
  #undef STEP2
  #undef ENDW
}
#undef SBAR
#undef WAIT_BAR
}
__device__ __forceinline__ void phase_attn2(const Frame& F, const Prm& p) {
    const bf16* Q = (const bf16*)(p.ws + WS_Q); const bf16* K = (const bf16*)(p.ws + WS_K); const bf16* V = (const bf16*)(p.ws + WS_V); bf16* O1 = (bf16*)(p.ws + WS_O1);
    for (int v = vcu_of(F); v < 256; v += F.G) {
        const int b = v >> 5, hm = (v >> 1) & 15, h = hm >> 1, m = hm & 1, half = v & 1;
        const int qcol = hm * 64, vcol = h * 128; bf16* O = O1 + (size_t)m * ((WS_O2 - WS_O1) / 2);
        const long kctx = NLAT + b * CTXL, klat = (long)b * SEQ;
        const int nu = half ? 8 : 9;
        for (int i = 0; i < nu; ++i) {
            const long qrow0 = i < 8 ? klat + (half * 8 + i) * 256 : kctx; const int NT = i < 8 ? 68 : 4;
            attn_body::attn_unit2<8>(qrow0, qcol, vcol, kctx, klat, NT, Q, K, V, O, (char*)F.lds);
        }
    }
}
namespace gla3 {
typedef short bf16x8 __attribute__((ext_vector_type(8)));
typedef short s16x4 __attribute__((ext_vector_type(4)));
typedef float f32x16 __attribute__((ext_vector_type(16)));
constexpr int CH = 64 * 16 + 64;
constexpr int L_QS = 0, L_KS = 16 * CH, L_VS = 32 * CH, L_SB = 40 * CH, L_X = 56 * CH, L_DEC = L_X + 16384, L_END = L_DEC + 512;
__device__ __forceinline__ int crow(int i, int hh) { return (i & 3) + 8 * (i >> 2) + 4 * hh; }
typedef float f32x2_t __attribute__((ext_vector_type(2))); typedef __bf16 bf16x2_t __attribute__((ext_vector_type(2)));
__device__ __forceinline__ unsigned pk(float lo, float hi) { f32x2_t v = {lo, hi}; bf16x2_t b = __builtin_convertvector(v, bf16x2_t); return __builtin_bit_cast(unsigned, b); }
typedef short v4i16_t __attribute__((ext_vector_type(4)));
__device__ __forceinline__ s16x4 trrd(LAS const unsigned char* p) { return __builtin_bit_cast(s16x4, __builtin_amdgcn_ds_read_tr16_b64_v4i16((LAS v4i16_t*)p)); }
#define GLA_FR(lo, hi) (bf16x8){lo[0], lo[1], lo[2], lo[3], hi[0], hi[1], hi[2], hi[3]}

__device__ __forceinline__ void scan_unit(const Frame& F, const Prm& p, int unit) {
    const int dvs = unit & 3, dir = (unit >> 2) & 1, h = (unit >> 3) & 3, b = unit >> 5;
    LAS unsigned char* lds = (LAS unsigned char*)F.lds;
    const int lane = F.lane, w = F.wave, tid = F.tid, r = lane & 31, hh = lane >> 5;
    const bf16* QT = (const bf16*)(p.ws + WS_QT) + (size_t)dir * NTOK * 512 + h * 128;
    const bf16* KT = (const bf16*)(p.ws + WS_KT) + (size_t)dir * NTOK * 512 + h * 128;
    const bf16* V = (const bf16*)(p.ws + WS_V1) + h * 256 + dvs * 64;
    const float* DEC = (const float*)(p.ws + WS_DEC) + (size_t)dir * NCHUNK * 512 + h * 128;
    bf16* OG = (bf16*)(p.ws + (dir ? WS_OGB : WS_OGF)) + h * 256 + dvs * 64;
    const int g1 = (lane >> 4) & 1, q4 = (lane & 15) >> 2, p4 = lane & 3;
    const int trb = (2 * g1 + (p4 >> 1)) * CH + q4 * 16 + 8 * (p4 & 1);
    const int trN = trb + 128 * hh, trP = trb + 64 * hh;
    f32x16 S0 = {}, S1 = {};
    for (int i = tid; i < 16 * CH / 16; i += NTHR) *(LAS u32x4*)(lds + L_SB + i * 16) = (u32x4){0u, 0u, 0u, 0u};
    u32x4 pq0[2], pq1[2], pk0[2], pk1[2], pv[2]; float pdec[2] = {0.f, 0.f};
#define GLA_CHUNK(step) ((step) >= 4 ? b * 64 + (dir ? 63 - ((step) - 4) : (step) - 4) : 512 + b * 4 + (dir ? 3 - (step) : (step)))
    const int qrow = 8 * w + (lane >> 4), qch = lane & 15, vrow = 8 * w + (lane >> 3), vch = lane & 7;
#define GLA_LOAD(step, u) do { const size_t t0_ = (size_t)GLA_CHUNK(step) * 64; \
        pq0[u] = *(const u32x4*)(QT + (t0_ + qrow) * 512 + 8 * qch); pq1[u] = *(const u32x4*)(QT + (t0_ + qrow + 4) * 512 + 8 * qch); \
        pk0[u] = *(const u32x4*)(KT + (t0_ + qrow) * 512 + 8 * qch); pk1[u] = *(const u32x4*)(KT + (t0_ + qrow + 4) * 512 + 8 * qch); \
        pv[u] = *(const u32x4*)(V + (t0_ + vrow) * 1024 + 8 * vch); if (tid < 128) pdec[u] = DEC[(size_t)GLA_CHUNK(step) * 512 + tid]; } while (0)
#define GLA_STORE(u) do { \
        *(LAS u32x4*)(lds + L_QS + qch * CH + qrow * 16) = pq0[u]; *(LAS u32x4*)(lds + L_QS + qch * CH + (qrow + 4) * 16) = pq1[u]; \
        *(LAS u32x4*)(lds + L_KS + qch * CH + qrow * 16) = pk0[u]; *(LAS u32x4*)(lds + L_KS + qch * CH + (qrow + 4) * 16) = pk1[u]; \
        *(LAS u32x4*)(lds + L_VS + vch * CH + vrow * 16) = pv[u]; \
        if (tid < 128) *(LAS float*)(lds + L_DEC + 4 * tid) = pdec[u]; } while (0)
    GLA_LOAD(0, 0);
    GLA_LOAD(1, 1);
    GLA_STORE(0);
    __syncthreads();
    const int tb = (w & 3) >> 1, vb = w & 1;
    for (int sp2 = 0; sp2 < 34; ++sp2) {
#pragma unroll
    for (int u = 0; u < 2; ++u) {
        const int step = 2 * sp2 + u;
        const bool lat = step >= 4; const int chunk = GLA_CHUNK(step);
        if (step + 2 < 68) GLA_LOAD(step + 2, u);
        f32x16 o = {};
        if (w < 4) {
            if (lat) {
                const bool n0 = dir ? (tb == 0) : true, n1 = dir ? true : (tb == 1);
                f32x16 sc0 = {}, sc1 = {};
#define GLA_BQ(ks) (*(const LAS bf16x8*)(lds + L_QS + (2 * (ks) + hh) * CH + (32 * tb + r) * 16))
#define GLA_A0(ks) (*(const LAS bf16x8*)(lds + L_KS + (2 * (ks) + hh) * CH + r * 16))
#define GLA_A1(ks) (*(const LAS bf16x8*)(lds + L_KS + (2 * (ks) + hh) * CH + (32 + r) * 16))
                if (n0 && n1) {
#pragma unroll
                    for (int ks = 0; ks < 8; ++ks) { const bf16x8 bq = GLA_BQ(ks); sc0 = __builtin_amdgcn_mfma_f32_32x32x16_bf16(GLA_A0(ks), bq, sc0, 0, 0, 0); sc1 = __builtin_amdgcn_mfma_f32_32x32x16_bf16(GLA_A1(ks), bq, sc1, 0, 0, 0); }
                } else if (n0) {
#pragma unroll
                    for (int ks = 0; ks < 8; ++ks) sc0 = __builtin_amdgcn_mfma_f32_32x32x16_bf16(GLA_A0(ks), GLA_BQ(ks), sc0, 0, 0, 0);
                } else {
#pragma unroll
                    for (int ks = 0; ks < 8; ++ks) sc1 = __builtin_amdgcn_mfma_f32_32x32x16_bf16(GLA_A1(ks), GLA_BQ(ks), sc1, 0, 0, 0);
                }
#undef GLA_BQ
#undef GLA_A0
#undef GLA_A1
                const int t = 32 * tb + r;
#pragma unroll
                for (int i = 0; i < 16; ++i) { const int s0 = crow(i, hh), s1 = 32 + s0; const bool k0 = dir ? (s0 >= t) : (s0 <= t), k1 = dir ? (s1 >= t) : (s1 <= t); sc0[i] = k0 ? sc0[i] : 0.f; sc1[i] = k1 ? sc1[i] : 0.f; }
#pragma unroll
                for (int sb = 0; sb < 2; ++sb) { if (sb == 0 ? n0 : n1) {
#pragma unroll
                    for (int sp = 0; sp < 2; ++sp) {
                        u32x4 pw;
                        if (sb == 0) { pw.x = pk(sc0[8 * sp + 0], sc0[8 * sp + 1]); pw.y = pk(sc0[8 * sp + 2], sc0[8 * sp + 3]); pw.z = pk(sc0[8 * sp + 4], sc0[8 * sp + 5]); pw.w = pk(sc0[8 * sp + 6], sc0[8 * sp + 7]); }
                        else { pw.x = pk(sc1[8 * sp + 0], sc1[8 * sp + 1]); pw.y = pk(sc1[8 * sp + 2], sc1[8 * sp + 3]); pw.z = pk(sc1[8 * sp + 4], sc1[8 * sp + 5]); pw.w = pk(sc1[8 * sp + 6], sc1[8 * sp + 7]); }
                        LAS const unsigned char* vp = lds + L_VS + trP + (4 * vb) * CH + (32 * sb + 16 * sp) * 16;
                        const s16x4 lo = trrd(vp), hi = trrd(vp + 8 * 16);
                        o = __builtin_amdgcn_mfma_f32_32x32x16_bf16(GLA_FR(lo, hi), __builtin_bit_cast(bf16x8, pw), o, 0, 0, 0);
                    } } }
            }
        } else {
            const int db = w - 4;
            if (lat) {
                f32x16 o2 = {};
#pragma unroll
                for (int ks = 0; ks < 8; ++ks) {
                    const bf16x8 as = *(const LAS bf16x8*)(lds + L_SB + (2 * ks + hh) * CH + (32 * vb + r) * 16);
                    const bf16x8 bq = *(const LAS bf16x8*)(lds + L_QS + (2 * ks + hh) * CH + (32 * tb + r) * 16);
                    o2 = __builtin_amdgcn_mfma_f32_32x32x16_bf16(as, bq, o2, 0, 0, 0);
                }
#pragma unroll
                for (int g = 0; g < 4; ++g) *(LAS f32x4*)(lds + L_X + (w & 3) * 4096 + g * 1024 + lane * 16) = (f32x4){o2[4 * g], o2[4 * g + 1], o2[4 * g + 2], o2[4 * g + 3]};
            }
#pragma unroll
            for (int ks = 0; ks < 4; ++ks) {
                LAS const unsigned char* kp = lds + L_KS + trN + (4 * db) * CH + (16 * ks) * 16;
                LAS const unsigned char* vp = lds + L_VS + trN + (16 * ks) * 16;
                const s16x4 al = trrd(kp), ah = trrd(kp + 4 * 16);
                const s16x4 b0l = trrd(vp), b0h = trrd(vp + 4 * 16), b1l = trrd(vp + 4 * CH), b1h = trrd(vp + 4 * CH + 4 * 16);
                S0 = __builtin_amdgcn_mfma_f32_32x32x16_bf16(GLA_FR(al, ah), GLA_FR(b0l, b0h), S0, 0, 0, 0); S1 = __builtin_amdgcn_mfma_f32_32x32x16_bf16(GLA_FR(al, ah), GLA_FR(b1l, b1h), S1, 0, 0, 0);
            }
#pragma unroll
            for (int i = 0; i < 16; ++i) { const float dc = *(const LAS float*)(lds + L_DEC + 4 * (32 * db + crow(i, hh))); S0[i] *= dc; S1[i] *= dc; }
        }
        __syncthreads();
        if (w < 4 && lat) {
            bf16* orow = OG + ((size_t)chunk * 64 + 32 * tb + r) * DM + 32 * vb + 4 * hh;
#pragma unroll
            for (int g = 0; g < 4; ++g) { const f32x4 x = *(const LAS f32x4*)(lds + L_X + w * 4096 + g * 1024 + lane * 16);
                u32x2 wv; wv.x = pk(o[4 * g] + x.x, o[4 * g + 1] + x.y); wv.y = pk(o[4 * g + 2] + x.z, o[4 * g + 3] + x.w); *(u32x2*)(orow + 8 * g) = wv; }
        }
        if (step + 1 < 68) {
            GLA_STORE(u ^ 1);
            if (w >= 4) { const int db = w - 4;
#pragma unroll
                for (int g = 0; g < 4; ++g) { u32x2 w0, w1; w0.x = pk(S0[4 * g], S0[4 * g + 1]); w0.y = pk(S0[4 * g + 2], S0[4 * g + 3]); w1.x = pk(S1[4 * g], S1[4 * g + 1]); w1.y = pk(S1[4 * g + 2], S1[4 * g + 3]);
                    *(LAS u32x2*)(lds + L_SB + (4 * db + g) * CH + r * 16 + 8 * hh) = w0; *(LAS u32x2*)(lds + L_SB + (4 * db + g) * CH + (32 + r) * 16 + 8 * hh) = w1; } }
        }
        __syncthreads();
    }
    }
#undef GLA_CHUNK
#undef GLA_LOAD
#undef GLA_STORE
}
#undef GLA_FR
}
__device__ __forceinline__ void phase_scan_opt(const Frame& F, const Prm& p) {
    for (int unit = vcu_of(F); unit < 256; unit += F.G) gla3::scan_unit(F, p, unit);
}
#define PHASE_QKV(F, p) phase_qkv_opt(F, p)
#define PHASE_ATTN(F, p) phase_attn2(F, p)
#define PHASE_WO(F, p, l) phase_wo_opt(F, p, l)
#define PHASE_MOE1(F, p, l) phase_moe1_opt(F, p, l)
#define PHASE_MOE2(F, p, l) phase_moe2_opt(F, p, l)
#define PHASE_INPROJ(F, p) phase_inproj_opt(F, p)
#define PHASE_SCAN(F, p) phase_scan_opt(F, p)
typedef GAS unsigned gu32;
#define XB_TMO      128
#define XB_XCNT(j)  (256  + 64 * (j))
#define XB_XSUB(j)  (1280 + 64 * (j))
#define XB_XGEN(j)  (2304 + 64 * (j))
#define XB_TOP      3328
#define XB_TOPGEN   3392
#define XCD_BAR_WORDS 3456
#define XB_SPIN_CAP (1u << 20)
__device__ __forceinline__ unsigned xb_ld(unsigned* p)              { return __hip_atomic_load(p, __ATOMIC_RELAXED, __HIP_MEMORY_SCOPE_AGENT); }
__device__ __forceinline__ unsigned xb_add(unsigned* p, unsigned v) { return __hip_atomic_fetch_add(p, v, __ATOMIC_RELAXED, __HIP_MEMORY_SCOPE_AGENT); }
__device__ __forceinline__ unsigned xb_xcc_id() { return (unsigned)__builtin_amdgcn_s_getreg((3 << 11) | 20) & 0xFu; }
#define XB_SPIN(cond, bar) do { unsigned _sp = 0; while (cond) { __builtin_amdgcn_s_sleep(1); \
    if ((++_sp & 255u) == 0u) { if (xb_ld(&(bar)[XB_TMO])) break; if (_sp > XB_SPIN_CAP) { atomicAdd(&(bar)[XB_TMO], 1u); break; } } } } while (0)
struct XcdBarrier { unsigned* bar; unsigned x; volatile LAS unsigned* st; };
__device__ __forceinline__ XcdBarrier xcd_barrier_post(unsigned* bar, volatile LAS unsigned* st) {
    XcdBarrier b; b.bar = bar; b.x = xb_xcc_id(); b.st = st;
    if (threadIdx.x == 0) (void)xb_add(&bar[XB_XCNT(b.x)], 1u);
    return b;
}
__device__ __forceinline__ void xcd_barrier_complete(unsigned* bar, unsigned x, unsigned& nloc, unsigned& nx) {
    const unsigned G = gridDim.x * gridDim.y * gridDim.z;
    unsigned sum, cnt, mine, sp = 0u;
    for (;;) {
        sum = 0u; cnt = 0u; mine = 0u;
#pragma unroll
        for (unsigned j = 0; j < 16; ++j) { const unsigned c = xb_ld(&bar[XB_XCNT(j)]); sum += c; cnt += (c > 0u) ? 1u : 0u; mine = (j == x) ? c : mine; }
        if (sum == G) break;
        __builtin_amdgcn_s_sleep(1);
        if ((++sp & 255u) == 0u) { if (xb_ld(&bar[XB_TMO])) break; if (sp > XB_SPIN_CAP) { atomicAdd(&bar[XB_TMO], 1u); break; } }
    }
    nloc = mine > 0u ? mine : 1u; nx = cnt > 0u ? cnt : 1u;
}
__device__ __forceinline__ void xcd_barrier(const XcdBarrier& b) {
    asm volatile("s_waitcnt vmcnt(0)" ::: "memory");
    __syncthreads();
    if (threadIdx.x == 0) {
        unsigned* bar = b.bar;
        __builtin_amdgcn_s_waitcnt(0);
        unsigned nloc = b.st[0], nx = b.st[1];
        if (nloc == 0u) { xcd_barrier_complete(bar, b.x, nloc, nx); b.st[0] = nloc; b.st[1] = nx; }
        const unsigned old = xb_add(&bar[XB_XSUB(b.x)], 1u);
        const unsigned gen = old / nloc;
        if (old + 1u == (gen + 1u) * nloc) {
            __builtin_amdgcn_fence(__ATOMIC_RELEASE, "agent");
            asm volatile("s_waitcnt vmcnt(0)" ::: "memory");
            const unsigned og = xb_add(&bar[XB_TOP], 1u);
            const unsigned tg = og / nx;
            if (og + 1u == (tg + 1u) * nx) xb_add(&bar[XB_TOPGEN], 1u);
            else XB_SPIN(xb_ld(&bar[XB_TOPGEN]) == tg, bar);
            __builtin_amdgcn_fence(__ATOMIC_ACQUIRE, "agent");
            xb_add(&bar[XB_XGEN(b.x)], 1u);
            asm volatile("s_waitcnt vmcnt(0)" ::: "memory");
        } else {
            XB_SPIN(xb_ld(&bar[XB_XGEN(b.x)]) == gen, bar);
            __builtin_amdgcn_fence(__ATOMIC_ACQUIRE, "agent");
            asm volatile("s_waitcnt vmcnt(0)" ::: "memory");
        }
    }
    __syncthreads();
}

constexpr int NPHASE = 19;
#ifndef OPT_MASK
#define OPT_MASK 0u
#endif
__global__ void __launch_bounds__(NTHR, 2) mega_fwd(Prm p) {
    extern __shared__ __attribute__((aligned(16))) unsigned char lds[];
    Frame F; F.lds = lds; F.ctl = (unsigned*)(p.ws + WS_CTL);
    F.tid = threadIdx.x; F.lane = F.tid & 63; F.wave = __builtin_amdgcn_readfirstlane(F.tid >> 6); F.G = gridDim.x; F.bid = blockIdx.x;
    for (int u = F.tid; u < (LDS_BYTES - LDSCTL_OFF) / 4; u += NTHR) ((LAS unsigned*)(lds + LDSCTL_OFF))[u] = 0u;
    __syncthreads();
    const int lo = p.ph_lo, hi = p.ph_hi;
    const bool multi = (hi - lo) > 1;
    XcdBarrier bar; bar.bar = F.ctl + CW_BAR + p.li * XCD_BAR_WORDS; bar.x = 0; bar.st = nullptr;
    if (multi) bar = xcd_barrier_post(F.ctl + CW_BAR + p.li * XCD_BAR_WORDS, (volatile LAS unsigned*)(lds + MISC_OFF) + 8);
#define IN(k) (lo <= (k) && (k) < hi)
#define SEAM(k) do { if (IN(k) && IN((k) + 1)) xcd_barrier(bar); } while (0)
#ifndef REP_MASK
#define REP_MASK 0u
#endif
#define REP(k, call) do { if (((REP_MASK) >> (k)) & 1u) { xcd_barrier(bar); call; } } while (0)
    if (IN(0)) { phase_prologue(F, p); REP(0, phase_prologue(F, p)); } SEAM(0);
    if (IN(1)) { phase_modulate0(F, p); REP(1, phase_modulate0(F, p)); } SEAM(1);
    if (IN(2)) { PHASE_QKV(F, p); REP(2, PHASE_QKV(F, p)); } SEAM(2);
    if (IN(3)) { PHASE_ATTN(F, p); REP(3, PHASE_ATTN(F, p)); } SEAM(3);
    if (IN(4)) { phase_attn_combine(F, p); REP(4, phase_attn_combine(F, p)); } SEAM(4);
    if (IN(5)) { PHASE_WO(F, p, 0); REP(5, PHASE_WO(F, p, 0)); } SEAM(5);
    if (IN(6)) { phase_ln_route(F, p, 0); REP(6, phase_ln_route(F, p, 0)); } SEAM(6);
    if (IN(7)) { PHASE_MOE1(F, p, 0); REP(7, PHASE_MOE1(F, p, 0)); } SEAM(7);
    if (IN(8)) { PHASE_MOE2(F, p, 0); REP(8, PHASE_MOE2(F, p, 0)); } SEAM(8);
    if (IN(9)) { phase_moe_combine(F, p, 0); REP(9, phase_moe_combine(F, p, 0)); } SEAM(9);
    if (IN(10)) { PHASE_INPROJ(F, p); REP(10, PHASE_INPROJ(F, p)); } SEAM(10);
    if (IN(11)) { phase_gla_prep(F, p); REP(11, phase_gla_prep(F, p)); } SEAM(11);
    if (IN(12)) { PHASE_SCAN(F, p); REP(12, PHASE_SCAN(F, p)); } SEAM(12);
    if (IN(13)) { phase_gla_post(F, p); REP(13, phase_gla_post(F, p)); } SEAM(13);
    if (IN(14)) { PHASE_WO(F, p, 1); REP(14, PHASE_WO(F, p, 1)); } SEAM(14);
    if (IN(15)) { phase_ln_route(F, p, 1); REP(15, phase_ln_route(F, p, 1)); } SEAM(15);
    if (IN(16)) { PHASE_MOE1(F, p, 1); REP(16, PHASE_MOE1(F, p, 1)); } SEAM(16);
    if (IN(17)) { PHASE_MOE2(F, p, 1); REP(17, PHASE_MOE2(F, p, 1)); } SEAM(17);
    if (IN(18)) { phase_moe_combine(F, p, 1); REP(18, phase_moe_combine(F, p, 1)); }
#undef IN
#undef SEAM
}

extern "C" void kernel_launch(void* const* d_in, const int* in_sizes, int n_in, void* d_out, int out_size, void* d_ws, size_t ws_size, hipStream_t stream) {
    static int grid = 0;
    if (grid == 0) {
        if (n_in != 23 || in_sizes[0] != NLAT * DM || out_size != NLAT * DM || ws_size < WS_END) { fprintf(stderr, "kernel_launch: unexpected shapes (n_in %d, in0 %d, out %d, ws %zu); nothing launched\n", n_in, n_in > 0 ? in_sizes[0] : -1, out_size, ws_size); grid = -1; return; }
        int dev = 0, cus = 0;
        if (hipGetDevice(&dev) != hipSuccess || hipDeviceGetAttribute(&cus, hipDeviceAttributeMultiprocessorCount, dev) != hipSuccess) { grid = -1; return; }
        if (hipFuncSetAttribute((const void*)mega_fwd, hipFuncAttributeMaxDynamicSharedMemorySize, LDS_BYTES) != hipSuccess) { fprintf(stderr, "kernel_launch: hipFuncSetAttribute failed\n"); grid = -1; return; }
        int per_cu = 0;
        if (hipOccupancyMaxActiveBlocksPerMultiprocessor(&per_cu, (const void*)mega_fwd, NTHR, LDS_BYTES) != hipSuccess || per_cu < 1) fprintf(stderr, "kernel_launch: note: occupancy query reports %d\n", per_cu);
        (void)hipGetLastError();
        grid = cus;
    }
    if (grid < 0) return;
    (void)hipMemsetAsync((char*)d_ws + WS_CTL, 0, CTL_ZERO_BYTES, stream);
    Prm p{};
    const float** pp = (const float**)&p;
    for (int i = 0; i < 23; ++i) pp[i] = (const float*)d_in[i];
    p.out = (float*)d_out; p.ws = (unsigned char*)d_ws;
    p.ph_lo = 0; p.ph_hi = NPHASE; p.li = 0;
    hipLaunchKernelGGL(mega_fwd, dim3(grid), dim3(NTHR), LDS_BYTES, stream, p);
}
```

```cpp
#define OPT_MASK 0x355ACu
#include <hip/hip_runtime.h>
#include <cstdint>
#include <cstdio>

constexpr int BATCH = 8, SEQ = 4096, DM = 1024, CTXL = 256;
constexpr int NLAT = BATCH * SEQ, NCTX = BATCH * CTXL, NTOK = NLAT + NCTX;
constexpr float ALPHA = 1.4142135623730951f;
constexpr float LN_EPS = 1e-5f;
constexpr float LAMBDA_INIT0 = 0.2f;
constexpr float C2 = 0.125f * 1.4426950408889634f;
constexpr int NEXP = 16, DEXP = 512, MAXSLOT = 73728;
constexpr int NCHUNK = NTOK / 64;
constexpr int NIN = 3328;

typedef unsigned short bf16;
typedef float f32x4 __attribute__((ext_vector_type(4)));
typedef float f32x2 __attribute__((ext_vector_type(2)));
typedef unsigned u32x2 __attribute__((ext_vector_type(2)));
typedef unsigned u32x4 __attribute__((ext_vector_type(4)));

constexpr size_t MiB = 1u << 20;
constexpr size_t WS_CTL = 0, CTL_ZERO_BYTES = 1 * MiB;
constexpr size_t WS_MOD = 1 * MiB;
constexpr size_t WS_MISC = 1 * MiB + 512 * 1024;
constexpr size_t WS_WQKV = 2 * MiB, WS_WO = 5 * MiB, WS_GU0 = 6 * MiB, WS_DN0 = 22 * MiB, WS_WIN = 30 * MiB, WS_WGO = 34 * MiB, WS_GU1 = 35 * MiB, WS_DN1 = 51 * MiB;
constexpr size_t WS_XB = 59 * MiB;
constexpr size_t WS_H = 127 * MiB;
constexpr size_t WS_Q = 195 * MiB, WS_K = 263 * MiB, WS_V = 331 * MiB, WS_O2 = 399 * MiB;
constexpr size_t WS_LIST = 467 * MiB;
constexpr size_t WS_TOKR = 470 * MiB;
constexpr size_t WS_DEC = 472 * MiB;
constexpr size_t WS_ZZ = 475 * MiB;
constexpr size_t WS_END = 480 * MiB;
constexpr size_t WS_O1 = WS_H, WS_A2 = WS_H, WS_Y = WS_K;
constexpr size_t WS_YM = 195 * MiB, WS_ACT = 339 * MiB;
constexpr size_t WS_QR = 195 * MiB, WS_KR = 229 * MiB, WS_V1 = 263 * MiB, WS_R = 331 * MiB;
constexpr size_t WS_QT = WS_H, WS_KT = 399 * MiB;
constexpr size_t WS_A2B = WS_H;
constexpr size_t OUT_OGB = 64 * MiB;
constexpr int CW_TMO = 0, CW_CODE = 1;
constexpr int CW_CNT = 64;
constexpr int CW_BAR = 4096;

__device__ __forceinline__ unsigned f2bf(float f) { unsigned u = __builtin_bit_cast(unsigned, f); return (u + 0x7fffu + ((u >> 16) & 1u)) >> 16; }
__device__ __forceinline__ unsigned pk2(float lo, float hi) { return f2bf(lo) | (f2bf(hi) << 16); }
__device__ __forceinline__ float bf2f(unsigned b) { return __builtin_bit_cast(float, b << 16); }
__device__ __forceinline__ float wave_sum(float v) {
#pragma unroll
    for (int o = 1; o < 64; o <<= 1) v += __shfl_xor(v, o);
    return v;
}
__device__ __forceinline__ float silu_f(float v) { return v / (1.f + __expf(-v)); }

struct Prm {
    const float *x, *c, *ctx, *cctx, *ada_w, *ada_b, *ln_g, *ln_b, *w_qkv, *w_o, *lam, *subln, *gw_in, *gwg_down, *gwg_up, *gbg, *gnorm, *gw_o, *rw, *rb, *mg, *mu, *md;
    float* out; unsigned char* ws;
    int ph_lo, ph_hi, li, pad;
};
__device__ __forceinline__ void ld_row_f32(const float* p, int lane, f32x4 (&v)[4]) {
#pragma unroll
    for (int j = 0; j < 4; ++j) v[j] = *(const f32x4*)(p + 4 * lane + 256 * j);
}
__device__ __forceinline__ void st_row_f32(float* p, int lane, const f32x4 (&v)[4]) {
#pragma unroll
    for (int j = 0; j < 4; ++j) *(f32x4*)(p + 4 * lane + 256 * j) = v[j];
}
__device__ __forceinline__ void ld_row_bf16(const bf16* p, int lane, f32x4 (&v)[4]) {
#pragma unroll
    for (int j = 0; j < 4; ++j) { const u32x2 u = *(const u32x2*)(p + 4 * lane + 256 * j); v[j] = (f32x4){bf2f(u.x & 0xffffu), bf2f(u.x >> 16), bf2f(u.y & 0xffffu), bf2f(u.y >> 16)}; }
}
__device__ __forceinline__ void st_row_bf16(bf16* p, int lane, const f32x4 (&v)[4]) {
#pragma unroll
    for (int j = 0; j < 4; ++j) { u32x2 u; u.x = pk2(v[j].x, v[j].y); u.y = pk2(v[j].z, v[j].w); *(u32x2*)(p + 4 * lane + 256 * j) = u; }
}
__device__ __forceinline__ void ln_row(f32x4 (&v)[4], const float* g, const float* b, int lane) {
    float s = 0.f;
#pragma unroll
    for (int j = 0; j < 4; ++j) s += (v[j].x + v[j].y) + (v[j].z + v[j].w);
    const float mean = wave_sum(s) * (1.f / DM); float q = 0.f;
#pragma unroll
    for (int j = 0; j < 4; ++j) { v[j] = v[j] - mean; q += (v[j].x * v[j].x + v[j].y * v[j].y) + (v[j].z * v[j].z + v[j].w * v[j].w); }
    const float rstd = 1.f / sqrtf(wave_sum(q) * (1.f / DM) + LN_EPS);
#pragma unroll
    for (int j = 0; j < 4; ++j) { const f32x4 gg = *(const f32x4*)(g + 4 * lane + 256 * j), bb = *(const f32x4*)(b + 4 * lane + 256 * j); v[j] = v[j] * rstd * gg + bb; }
}
__host__ __device__ __forceinline__ int gu_phys(int other, int sel) { return (other >> 4) * 32 + sel * 16 + (other & 15); }
__host__ __device__ __forceinline__ int perm16b(int L) { return (L & ~31) | (16 * ((L >> 2) & 1) + 4 * ((L >> 3) & 3) + (L & 3)); }
__host__ __device__ __forceinline__ int perm16b_inv(int P) { return (P & ~31) | (8 * ((P >> 2) & 3) + 4 * ((P >> 4) & 1) + (P & 3)); }
__device__ __forceinline__ unsigned pk4_fp8(float a, float b, float c, float d) { int w = 0; w = __builtin_amdgcn_cvt_pk_fp8_f32(a, b, w, false); w = __builtin_amdgcn_cvt_pk_fp8_f32(c, d, w, true); return (unsigned)w; }
constexpr float W8_SCALE = 64.f, W8_INV = 1.f / 64.f;
__device__ __forceinline__ void st_row_fp8(unsigned char* p, int lane, const f32x4 (&v)[4]) {
#pragma unroll
    for (int j = 0; j < 4; ++j) *(unsigned*)(p + 4 * lane + 256 * j) = pk4_fp8(v[j].x, v[j].y, v[j].z, v[j].w);
}
__device__ __forceinline__ void ld_row_fp8(const unsigned char* p, int lane, f32x4 (&v)[4]) {
#pragma unroll
    for (int j = 0; j < 4; ++j) { const int w = *(const int*)(p + 4 * lane + 256 * j); const f32x2 lo = __builtin_amdgcn_cvt_pk_f32_fp8(w, false), hi = __builtin_amdgcn_cvt_pk_f32_fp8(w, true); v[j] = (f32x4){lo.x, lo.y, hi.x, hi.y}; }
}
#define GAS __attribute__((address_space(1)))
#define LAS __attribute__((address_space(3)))
constexpr int NWAVES = 8, NTHR = NWAVES * 64;
constexpr int RING_BYTES = 131072, LDS_BYTES = 147456, LDSCTL_OFF = LDS_BYTES - 1024, MISC_OFF = LDSCTL_OFF + 320;
constexpr int LDSX_OFF = RING_BYTES + 1024;
#define LDS_WAIT() asm volatile("s_waitcnt lgkmcnt(0)" ::: "memory")
#define VM_WAIT() asm volatile("s_waitcnt vmcnt(0)" ::: "memory")

struct Frame {
    unsigned char* lds;
    unsigned* ctl;
    int tid, lane, wave, G, bid;
};

template <int MODE>
__device__ __forceinline__ void p0_transpose_item(const float* W, int K, int N, bf16* WT, int row_off, float* scr, int item, int lane) {
    const int nblk = N / 32, kb = item / nblk, nb = item % nblk, k0 = 64 * kb, n0 = 32 * nb;
#pragma unroll 8
    for (int i = 0; i < 32; ++i) { const int kk = 2 * i + (lane >> 5); scr[kk * 33 + (lane & 31)] = W[(size_t)(k0 + kk) * N + n0 + (lane & 31)]; }
    LDS_WAIT(); asm volatile("" ::: "memory");
    const int c = lane & 7;
#pragma unroll
    for (int j = 0; j < 4; ++j) { const int n = (lane >> 3) + 8 * j; const float* s = scr + (8 * c) * 33 + n;
        u32x4 o; o.x = pk2(s[0 * 33], s[1 * 33]); o.y = pk2(s[2 * 33], s[3 * 33]); o.z = pk2(s[4 * 33], s[5 * 33]); o.w = pk2(s[6 * 33], s[7 * 33]);
        const int nl = n0 + n; const int pr = (MODE == 0) ? (row_off + nl) : (MODE == 3) ? (row_off + perm16b(nl)) : (row_off + gu_phys(nl, MODE - 1));
        *(u32x4*)(WT + (size_t)pr * K + k0 + 8 * c) = o; }
    LDS_WAIT(); asm volatile("" ::: "memory");
}
template <int MODE>
__device__ __forceinline__ void p0_transpose_item8(const float* W, int K, int N, unsigned char* WT, float* scr, int item, int lane) {
    const int nblk = N / 32, kb = item / nblk, nb = item % nblk, k0 = 64 * kb, n0 = 32 * nb;
#pragma unroll 8
    for (int i = 0; i < 32; ++i) { const int kk = 2 * i + (lane >> 5); scr[kk * 33 + (lane & 31)] = W[(size_t)(k0 + kk) * N + n0 + (lane & 31)]; }
    LDS_WAIT(); asm volatile("" ::: "memory");
    const int c = lane & 7;
#pragma unroll
    for (int j = 0; j < 4; ++j) { const int n = (lane >> 3) + 8 * j; const float* s = scr + (8 * c) * 33 + n;
        u32x2 o; o.x = pk4_fp8(s[0 * 33] * W8_SCALE, s[1 * 33] * W8_SCALE, s[2 * 33] * W8_SCALE, s[3 * 33] * W8_SCALE); o.y = pk4_fp8(s[4 * 33] * W8_SCALE, s[5 * 33] * W8_SCALE, s[6 * 33] * W8_SCALE, s[7 * 33] * W8_SCALE);
        const int nl = n0 + n; const int pr = (MODE == 3) ? perm16b(nl) : (MODE == 0) ? nl : gu_phys(nl, MODE - 1);
        *(u32x2*)(WT + (size_t)pr * K + k0 + 8 * c) = o; }
    LDS_WAIT(); asm volatile("" ::: "memory");
}
__device__ __forceinline__ void phase_prologue(const Frame& F, const Prm& p) {
    float* sil = (float*)F.lds;
    for (int i = F.tid; i < 9 * 1024; i += NTHR) { const int r = i >> 10, k = i & 1023; const float v = (r < 8) ? p.c[r * 1024 + k] : p.cctx[k]; sil[i] = silu_f(v); }
    __syncthreads();
    float* MOD = (float*)(p.ws + WS_MOD);
    if (F.bid < 192) {
        const int layer = F.bid / 96, n = (F.bid % 96) * 64 + F.lane; const float* W = p.ada_w + (size_t)layer * 1024 * 6144 + n;
        float acc[9];
#pragma unroll
        for (int r = 0; r < 9; ++r) acc[r] = 0.f;
        const int kb = F.wave * 128;
#pragma unroll 4
        for (int k = kb; k < kb + 128; k += 4) {
            const float w0 = W[(size_t)k * 6144], w1 = W[(size_t)(k + 1) * 6144], w2 = W[(size_t)(k + 2) * 6144], w3 = W[(size_t)(k + 3) * 6144];
#pragma unroll
            for (int r = 0; r < 9; ++r) { const f32x4 s = *(const f32x4*)(sil + r * 1024 + k); acc[r] += s.x * w0 + s.y * w1 + s.z * w2 + s.w * w3; }
        }
        float* red = (float*)(F.lds + 36864 + 8 * 8704);
#pragma unroll
        for (int r = 0; r < 9; ++r) red[(F.wave * 9 + r) * 64 + F.lane] = acc[r];
        __syncthreads();
        if (F.wave == 0) { const float bb = p.ada_b[layer * 6144 + n];
#pragma unroll
            for (int r = 0; r < 9; ++r) { float t = bb;
#pragma unroll
                for (int w = 0; w < 8; ++w) t += red[(w * 9 + r) * 64 + F.lane];
                MOD[(layer * 9 + r) * 6144 + n] = t; } }
    }
    float* misc = (float*)(p.ws + WS_MISC);
    if (F.bid == 255 % F.G && F.wave == 1) {
        const float a = wave_sum(p.lam[F.lane] * p.lam[64 + F.lane]), b = wave_sum(p.lam[128 + F.lane] * p.lam[192 + F.lane]);
        if (F.lane == 0) misc[0] = __expf(a) - __expf(b) + LAMBDA_INIT0;
        for (int i = F.lane; i < 1024; i += 64) { const int pos = i >> 4, f = i & 15; const float inv = powf(10000.f, -(float)f / 16.f); const float ang = (float)pos * inv;
            misc[1024 + 2 * i] = cosf(ang); misc[1024 + 2 * i + 1] = sinf(ang); }
    }
    float* scr = (float*)(F.lds + 36864 + F.wave * 8704);
    const int gw = F.bid * NWAVES + F.wave, NGW = F.G * NWAVES;
    constexpr int I_QKV = 16 * 96, I_SQ = 16 * 32, I_G = 16 * 16, I_D = 8 * 32;
    constexpr int I_MOE = 2 * I_G + I_D;
    constexpr int NITEMS = 2 * I_QKV + 2 * I_SQ + 32 * I_MOE;
    bf16* ws16 = (bf16*)p.ws;
    for (int it = gw; it < NITEMS; it += NGW) {
        int r = it;
        if (r < I_QKV) { if ((r % 96) < 64) p0_transpose_item8<0>(p.w_qkv, 1024, 3072, p.ws + WS_WQKV, scr, r, F.lane); else p0_transpose_item8<3>(p.w_qkv, 1024, 3072, p.ws + WS_WQKV, scr, r, F.lane); continue; } r -= I_QKV;
        if (r < I_QKV) { p0_transpose_item8<3>(p.gw_in, 1024, 3072, p.ws + WS_WIN, scr, r, F.lane); continue; } r -= I_QKV;
        if (r < I_SQ) { p0_transpose_item8<3>(p.w_o, 1024, 1024, p.ws + WS_WO, scr, r, F.lane); continue; } r -= I_SQ;
        if (r < I_SQ) { p0_transpose_item8<3>(p.gw_o, 1024, 1024, p.ws + WS_WGO, scr, r, F.lane); continue; } r -= I_SQ;
        const int le = r / I_MOE, layer = le >> 4, e = le & 15; r -= le * I_MOE;
        unsigned char* GU = p.ws + (layer ? WS_GU1 : WS_GU0) + (size_t)e * 1024 * 1024; unsigned char* DN = p.ws + (layer ? WS_DN1 : WS_DN0) + (size_t)e * 1024 * 512;
        if (r < I_G) { p0_transpose_item8<1>(p.mg + (size_t)le * 1024 * 512, 1024, 512, GU, scr, r, F.lane); continue; } r -= I_G;
        if (r < I_G) { p0_transpose_item8<2>(p.mu + (size_t)le * 1024 * 512, 1024, 512, GU, scr, r, F.lane); continue; } r -= I_G;
        p0_transpose_item8<3>(p.md + (size_t)le * 512 * 1024, 512, 1024, DN, scr, r, F.lane);
    }
    (void)ws16;
    unsigned char* WIN = p.ws + WS_WIN;
    for (int i = gw * 64 + F.lane; i < 32 * 256; i += NGW * 64) { const int rr = i >> 8, k = (i & 255) * 4, dir = rr >> 4, j = rr & 15; const float* s = p.gwg_down + (size_t)dir * 1024 * 16 + j;
        *(unsigned*)(WIN + (size_t)(3072 + rr) * 1024 + k) = pk4_fp8(s[(size_t)k * 16] * W8_SCALE, s[(size_t)(k + 1) * 16] * W8_SCALE, s[(size_t)(k + 2) * 16] * W8_SCALE, s[(size_t)(k + 3) * 16] * W8_SCALE); }
    for (int i = gw * 64 + F.lane; i < 224 * 1024 / 16; i += NGW * 64) *(u32x4*)(WIN + (size_t)3104 * 1024 + (size_t)i * 16) = (u32x4){0u, 0u, 0u, 0u};
}

__device__ __forceinline__ void phase_modulate0(const Frame& F, const Prm& p) {
    const float* MOD = (const float*)(p.ws + WS_MOD); unsigned char* H = p.ws + WS_H;
    const int gw = F.bid * NWAVES + F.wave, NGW = F.G * NWAVES, per = (NTOK + NGW - 1) / NGW;
    int curmod = -1; f32x4 sh[4], sc[4];
    const int t0 = gw * per, t1 = min(NTOK, (gw + 1) * per);
    f32x4 v[4], vn[4];
    if (t0 < t1) ld_row_f32(t0 < NLAT ? p.x + (size_t)t0 * DM : p.ctx + (size_t)(t0 - NLAT) * DM, F.lane, v);
    for (int tok = t0; tok < t1; ++tok) {
        if (tok + 1 < t1) ld_row_f32(tok + 1 < NLAT ? p.x + (size_t)(tok + 1) * DM : p.ctx + (size_t)(tok + 1 - NLAT) * DM, F.lane, vn);
        const int mr = tok < NLAT ? tok / SEQ : 8;
        if (mr != curmod) { curmod = mr; ld_row_f32(MOD + mr * 6144, F.lane, sh); ld_row_f32(MOD + mr * 6144 + 1024, F.lane, sc); }
#pragma unroll
        for (int j = 0; j < 4; ++j) v[j] = v[j] * (1.f + sc[j]) + sh[j];
        st_row_fp8(H + (size_t)tok * DM, F.lane, v);
#pragma unroll
        for (int j = 0; j < 4; ++j) v[j] = vn[j];
    }
}

__device__ __forceinline__ void phase_attn_combine(const Frame& F, const Prm& p) {
    const bf16* O1 = (const bf16*)(p.ws + WS_O1); const bf16* O2 = (const bf16*)(p.ws + WS_O2); unsigned char* A2 = p.ws + WS_A2;
    const float lam = ((const float*)(p.ws + WS_MISC))[0];
    const f32x4 sg = *(const f32x4*)(p.subln + 4 * (F.lane & 31));
    const int gw = F.bid * NWAVES + F.wave, NGW = F.G * NWAVES;
    f32x4 a[4], b[4], an[4], bn[4];
    if (gw < NTOK) { ld_row_bf16(O1 + (size_t)gw * DM, F.lane, a); ld_row_bf16(O2 + (size_t)gw * DM, F.lane, b); }
    for (int tok = gw; tok < NTOK; tok += NGW) {
        if (tok + NGW < NTOK) { ld_row_bf16(O1 + (size_t)(tok + NGW) * DM, F.lane, an); ld_row_bf16(O2 + (size_t)(tok + NGW) * DM, F.lane, bn); }
#pragma unroll
        for (int j = 0; j < 4; ++j) {
            f32x4 o = a[j] - lam * b[j]; float q = (o.x * o.x + o.y * o.y) + (o.z * o.z + o.w * o.w);
#pragma unroll
            for (int s = 1; s < 32; s <<= 1) q += __shfl_xor(q, s);
            const float rr = (1.f - LAMBDA_INIT0) / sqrtf(q * (1.f / 128.f) + LN_EPS);
            a[j] = o * rr * sg;
        }
        st_row_fp8(A2 + (size_t)tok * DM, F.lane, a);
#pragma unroll
        for (int j = 0; j < 4; ++j) { a[j] = an[j]; b[j] = bn[j]; }
    }
}

__device__ __forceinline__ void phase_ln_route(const Frame& F, const Prm& p, int layer) {
    const int nrows = layer ? NLAT : NTOK;
    const float* MOD = (const float*)(p.ws + WS_MOD) + layer * 9 * 6144;
    const bf16* Y = (const bf16*)(p.ws + WS_Y); unsigned char* HF = p.ws + WS_H;
    bf16* XB = (bf16*)(p.ws + WS_XB);
    int* LIST = (int*)(p.ws + WS_LIST); int* TOKR = (int*)(p.ws + WS_TOKR);
    unsigned* CNT = F.ctl + CW_CNT + layer * 16;
    float* WrT = (float*)F.lds;
    int* rec = (int*)(F.lds + 65536);
    unsigned* lcnt = (unsigned*)(F.lds + 65536 + 8192); unsigned* lbase = lcnt + 16;
    for (int i = F.tid; i < 16 * 1024; i += NTHR) { const int k = i >> 4, e = i & 15; WrT[e * 1024 + k] = p.rw[i]; }
    if (F.tid < 16) lcnt[F.tid] = 0u;
    __syncthreads();
    const int per_wg = (nrows + F.G - 1) / F.G, per_w = (per_wg + NWAVES - 1) / NWAVES;
    const int row_lo = F.bid * per_wg, row_hi = min(nrows, row_lo + per_wg);
    const float* lng = p.ln_g + (layer * 2 + 0) * DM; const float* lnb = p.ln_b + (layer * 2 + 0) * DM;
    float rb[16];
#pragma unroll
    for (int e = 0; e < 16; ++e) rb[e] = p.rb[e];
    int curmod = -1; f32x4 gm[4], shf[4], scf[4];
    f32x4 v[4], y[4], vn[4], yn[4];
#define LNR_LOAD(tok_, V, Yv) do { if (layer) ld_row_bf16(XB + (size_t)(tok_) * DM, F.lane, V); else ld_row_f32((tok_) < NLAT ? p.x + (size_t)(tok_) * DM : p.ctx + (size_t)((tok_) - NLAT) * DM, F.lane, V); \
        ld_row_bf16(Y + (size_t)(tok_) * DM, F.lane, Yv); } while (0)
    if (row_lo + F.wave * per_w < row_hi) LNR_LOAD(row_lo + F.wave * per_w, v, y);
    for (int i = 0; i < per_w; ++i) {
        const int lr = F.wave * per_w + i, tok = row_lo + lr; if (tok >= row_hi) break;
        if (i + 1 < per_w && tok + 1 < row_hi) LNR_LOAD(tok + 1, vn, yn);
        const int mr = tok < NLAT ? tok / SEQ : 8;
        if (mr != curmod) { curmod = mr; ld_row_f32(MOD + mr * 6144 + 2048, F.lane, gm); ld_row_f32(MOD + mr * 6144 + 3072, F.lane, shf); ld_row_f32(MOD + mr * 6144 + 4096, F.lane, scf); }
        bf16* xdst = XB + (size_t)tok * DM;
#pragma unroll
        for (int j = 0; j < 4; ++j) v[j] = ALPHA * v[j] + gm[j] * y[j];
        ln_row(v, lng, lnb, F.lane);
        st_row_bf16(xdst, F.lane, v);
#pragma unroll
        for (int j = 0; j < 4; ++j) v[j] = v[j] * (1.f + scf[j]) + shf[j];
        st_row_fp8(HF + (size_t)tok * DM, F.lane, v);
        float part[16];
#pragma unroll
        for (int e = 0; e < 16; ++e) { float s = 0.f;
#pragma unroll
            for (int j = 0; j < 4; ++j) { const f32x4 w = *(const f32x4*)(WrT + e * 1024 + 4 * F.lane + 256 * j); s += (v[j].x * w.x + v[j].y * w.y) + (v[j].z * w.z + v[j].w * w.w); }
            part[e] = s; }
        {
#pragma unroll
            for (int e = 0; e < 8; ++e) { const bool up = (F.lane & 32) != 0; const float keep = up ? part[e + 8] : part[e], send = up ? part[e] : part[e + 8]; part[e] = keep + __shfl_xor(send, 32); }
#pragma unroll
            for (int e = 0; e < 4; ++e) { const bool up = (F.lane & 16) != 0; const float keep = up ? part[e + 4] : part[e], send = up ? part[e] : part[e + 4]; part[e] = keep + __shfl_xor(send, 16); }
#pragma unroll
            for (int e = 0; e < 2; ++e) { const bool up = (F.lane & 8) != 0; const float keep = up ? part[e + 2] : part[e], send = up ? part[e] : part[e + 2]; part[e] = keep + __shfl_xor(send, 8); }
            { const bool up = (F.lane & 4) != 0; const float keep = up ? part[1] : part[0], send = up ? part[0] : part[1]; part[0] = keep + __shfl_xor(send, 4); }
            part[0] += __shfl_xor(part[0], 2); part[0] += __shfl_xor(part[0], 1);
        }
        float aff[16], sel[16];
#pragma unroll
        for (int e = 0; e < 16; ++e) { const int src = ((e >> 3) & 1) * 32 + ((e >> 2) & 1) * 16 + ((e >> 1) & 1) * 8 + (e & 1) * 4; const float lg = __shfl(part[0], src); aff[e] = 1.f / (1.f + __expf(-lg)); sel[e] = aff[e] + rb[e]; }
        int bg = 0; float bgs = -3.0e38f;
#pragma unroll
        for (int g = 0; g < 4; ++g) { float m1 = -3.0e38f, m2 = -3.0e38f;
#pragma unroll
            for (int k = 0; k < 4; ++k) { const float s = sel[4 * g + k]; if (s > m1) { m2 = m1; m1 = s; } else if (s > m2) m2 = s; }
            const float gs = m1 + m2; if (gs > bgs) { bgs = gs; bg = g; } }
        int i1 = 0, i2 = 0; float s1 = -3.0e38f, s2 = -3.0e38f, a1 = 0.f, a2 = 0.f;
#pragma unroll
        for (int g = 0; g < 4; ++g) if (g == bg) {
#pragma unroll
            for (int k = 0; k < 4; ++k) { const float s = sel[4 * g + k], a = aff[4 * g + k];
                if (s > s1) { s2 = s1; i2 = i1; a2 = a1; s1 = s; i1 = 4 * g + k; a1 = a; } else if (s > s2) { s2 = s; i2 = 4 * g + k; a2 = a; } } }
        const float wsum = a1 + a2, w1 = a1 / wsum, w2 = a2 / wsum;
        if (F.lane == 0) { const unsigned l1 = atomicAdd(&lcnt[i1], 1u), l2 = atomicAdd(&lcnt[i2], 1u);
            rec[lr * 6 + 0] = i1; rec[lr * 6 + 1] = i2; rec[lr * 6 + 2] = (int)l1; rec[lr * 6 + 3] = (int)l2; rec[lr * 6 + 4] = __float_as_int(w1); rec[lr * 6 + 5] = __float_as_int(w2); }
#pragma unroll
        for (int j = 0; j < 4; ++j) { v[j] = vn[j]; y[j] = yn[j]; }
    }
#undef LNR_LOAD
    __syncthreads();
    if (F.tid < 16) lbase[F.tid] = __hip_atomic_fetch_add(&CNT[F.tid], lcnt[F.tid], __ATOMIC_RELAXED, __HIP_MEMORY_SCOPE_AGENT);
    __syncthreads();
    for (int lr = F.tid; lr < row_hi - row_lo; lr += NTHR) { const int tok = row_lo + lr;
        const int e0 = rec[lr * 6], e1 = rec[lr * 6 + 1]; const int p0 = (int)lbase[e0] + rec[lr * 6 + 2], p1 = (int)lbase[e1] + rec[lr * 6 + 3];
        LIST[e0 * NTOK + p0] = tok; LIST[e1 * NTOK + p1] = tok;
        int* tr = TOKR + (size_t)tok * 8; tr[0] = e0; tr[1] = p0; tr[2] = e1; tr[3] = p1; tr[4] = rec[lr * 6 + 4]; tr[5] = rec[lr * 6 + 5]; }
    __syncthreads();
}

__device__ __forceinline__ void pad_bases(const unsigned* cnt, int (&pb)[17]) {
    int acc = 0;
#pragma unroll
    for (int e = 0; e < 16; ++e) { pb[e] = acc; const int c = (int)__hip_atomic_load(cnt + e, __ATOMIC_RELAXED, __HIP_MEMORY_SCOPE_AGENT); acc += (c + 255) & ~255; }
    pb[16] = acc;
}

__device__ __forceinline__ void phase_moe_combine(const Frame& F, const Prm& p, int layer) {
    const int nrows = layer ? NLAT : NTOK;
    const float* MOD = (const float*)(p.ws + WS_MOD) + layer * 9 * 6144; const float* MOD1 = (const float*)(p.ws + WS_MOD) + 9 * 6144;
    const unsigned char* YM = p.ws + WS_YM;   unsigned char* H = p.ws + WS_H;   bf16* XB = (bf16*)(p.ws + WS_XB); const int* TOKR = (const int*)(p.ws + WS_TOKR);
    int pb[17]; pad_bases(F.ctl + CW_CNT + layer * 16, pb);
    int* pbl = (int*)F.lds; if (F.tid < 17) { int v = 0;
#pragma unroll
        for (int e = 0; e < 17; ++e) if (e == F.tid) v = pb[e];
        pbl[F.tid] = v; }
    __syncthreads();
    const float* lng = p.ln_g + (layer * 2 + 1) * DM; const float* lnb = p.ln_b + (layer * 2 + 1) * DM;
    const int gw = F.bid * NWAVES + F.wave, NGW = F.G * NWAVES, per = (nrows + NGW - 1) / NGW;
    int curmod = -1; f32x4 gf[4], sh1[4], sc1[4];
    typedef int i32x4r __attribute__((ext_vector_type(4)));
    const int t0 = gw * per, t1 = min(nrows, (gw + 1) * per);
    i32x4r ra = {0, 0, 0, 0}, rb = {0, 0, 0, 0}, rc = {0, 0, 0, 0}; f32x2 wa = {0.f, 0.f}, wb = {0.f, 0.f}, wc = {0.f, 0.f};
#define MC_REC(tok_, R, W) do { const int* tr_ = TOKR + (size_t)(tok_) * 8; R = *(const i32x4r*)tr_; W = *(const f32x2*)(tr_ + 4); } while (0)
#define MC_ROWS(tok_, R, V, A, B) do { ld_row_bf16(XB + (size_t)(tok_) * DM, F.lane, V); ld_row_fp8(YM + (size_t)(pbl[R.x] + R.y) * DM, F.lane, A); ld_row_fp8(YM + (size_t)(pbl[R.z] + R.w) * DM, F.lane, B); } while (0)
    f32x4 v[4], a[4], b[4], vn[4], an[4], bn[4];
    if (t0 < t1) { MC_REC(t0, ra, wa); if (t0 + 1 < t1) MC_REC(t0 + 1, rb, wb); MC_ROWS(t0, ra, v, a, b); }
    for (int tok = t0; tok < t1; ++tok) {
        if (tok + 1 < t1) MC_ROWS(tok + 1, rb, vn, an, bn);
        if (tok + 2 < t1) MC_REC(tok + 2, rc, wc);
        const int mr = tok < NLAT ? tok / SEQ : 8;
        if (mr != curmod) { curmod = mr; ld_row_f32(MOD + mr * 6144 + 5120, F.lane, gf); if (!layer) { ld_row_f32(MOD1 + mr * 6144, F.lane, sh1); ld_row_f32(MOD1 + mr * 6144 + 1024, F.lane, sc1); } }
        const float w0 = wa.x, w1 = wa.y;
        bf16* xp = XB + (size_t)tok * DM;
#pragma unroll
        for (int j = 0; j < 4; ++j) v[j] = ALPHA * v[j] + gf[j] * (w0 * a[j] + w1 * b[j]);
        ln_row(v, lng, lnb, F.lane);
        if (layer) st_row_f32(p.out + (size_t)tok * DM, F.lane, v); else st_row_bf16(xp, F.lane, v);
        if (!layer) {
#pragma unroll
            for (int j = 0; j < 4; ++j) v[j] = v[j] * (1.f + sc1[j]) + sh1[j];
            st_row_fp8(H + (size_t)tok * DM, F.lane, v);
        }
#pragma unroll
        for (int j = 0; j < 4; ++j) { v[j] = vn[j]; a[j] = an[j]; b[j] = bn[j]; }
        ra = rb; wa = wb; rb = rc; wb = wc;
    }
#undef MC_REC
#undef MC_ROWS
}

__device__ __forceinline__ void phase_gla_prep(const Frame& F, const Prm& p) {
    const bf16* QR = (const bf16*)(p.ws + WS_QR); const bf16* KR = (const bf16*)(p.ws + WS_KR); const float* ZZ = (const float*)(p.ws + WS_ZZ);
    bf16* QT = (bf16*)(p.ws + WS_QT); bf16* KT = (bf16*)(p.ws + WS_KT); float* DEC = (float*)(p.ws + WS_DEC);
    const int gw = F.bid * NWAVES + F.wave, NGW = F.G * NWAVES;
    for (int task = gw; task < 2 * NCHUNK * 8; task += NGW) {
        const int dh = task & 7, chunk = (task >> 3) % NCHUNK, dir = __builtin_amdgcn_readfirstlane(task / (8 * NCHUNK));
        const int col = dh * 64 + F.lane, tok0 = chunk * 64;
        unsigned short qv[64], kv[64];
#pragma unroll
        for (int t = 0; t < 64; ++t) { qv[t] = QR[(size_t)(tok0 + t) * 512 + col]; kv[t] = KR[(size_t)(tok0 + t) * 512 + col]; }
        f32x4 zl[4];
#pragma unroll
        for (int j = 0; j < 4; ++j) zl[j] = *(const f32x4*)(ZZ + (size_t)(tok0 + F.lane) * 32 + dir * 16 + 4 * j);
        float wup[16];
#pragma unroll
        for (int j = 0; j < 16; ++j) wup[j] = p.gwg_up[(size_t)dir * 16 * 512 + j * 512 + col];
        const float bgv = p.gbg[dir * 512 + col];
        float b = 0.f;
        bf16* qo = QT + ((size_t)dir * NTOK + tok0) * 512 + col; bf16* ko = KT + ((size_t)dir * NTOK + tok0) * 512 + col;
#pragma unroll
        for (int tt = 0; tt < 64; ++tt) {
            float z = bgv;
#pragma unroll
            for (int j = 0; j < 4; ++j) { const int tl = dir ? 63 - tt : tt;
                const float z0 = __int_as_float(__builtin_amdgcn_readlane(__float_as_int(zl[j].x), tl)), z1 = __int_as_float(__builtin_amdgcn_readlane(__float_as_int(zl[j].y), tl));
                const float z2 = __int_as_float(__builtin_amdgcn_readlane(__float_as_int(zl[j].z), tl)), z3 = __int_as_float(__builtin_amdgcn_readlane(__float_as_int(zl[j].w), tl));
                z += z0 * wup[4 * j] + z1 * wup[4 * j + 1] + z2 * wup[4 * j + 2] + z3 * wup[4 * j + 3]; }
            const float g = (fminf(z, 0.f) - __logf(1.f + __expf(-fabsf(z)))) * (1.f / 16.f);
            b += g;
            const float e = __expf(b), ei = __builtin_amdgcn_rcpf(e);
            const float q = dir ? bf2f(qv[63 - tt]) : bf2f(qv[tt]), k = dir ? bf2f(kv[63 - tt]) : bf2f(kv[tt]);
            const int t = dir ? 63 - tt : tt;
            qo[(size_t)t * 512] = (bf16)f2bf(q * e); ko[(size_t)t * 512] = (bf16)f2bf(k * ei);
        }
        DEC[((size_t)dir * NCHUNK + chunk) * 512 + col] = __expf(b);
    }
}

__device__ __forceinline__ void phase_gla_post(const Frame& F, const Prm& p) {
    const bf16* OF = (const bf16*)p.out; const bf16* OB = (const bf16*)((const unsigned char*)p.out + OUT_OGB); const bf16* R = (const bf16*)(p.ws + WS_R); unsigned char* A2 = p.ws + WS_A2B;
    const f32x4 ng = *(const f32x4*)(p.gnorm + 4 * F.lane);
    const int gw = F.bid * NWAVES + F.wave, NGW = F.G * NWAVES;
    f32x4 a[4], b[4], r[4], an[4], bn[4], rn[4];
    if (gw < NLAT) { ld_row_bf16(OF + (size_t)gw * DM, F.lane, a); ld_row_bf16(OB + (size_t)gw * DM, F.lane, b); ld_row_bf16(R + (size_t)gw * DM, F.lane, r); }
    for (int tok = gw; tok < NLAT; tok += NGW) {
        if (tok + NGW < NLAT) { ld_row_bf16(OF + (size_t)(tok + NGW) * DM, F.lane, an); ld_row_bf16(OB + (size_t)(tok + NGW) * DM, F.lane, bn); ld_row_bf16(R + (size_t)(tok + NGW) * DM, F.lane, rn); }
#pragma unroll
        for (int j = 0; j < 4; ++j) {
            const f32x4 o = a[j] + b[j]; const float q = wave_sum((o.x * o.x + o.y * o.y) + (o.z * o.z + o.w * o.w));
            const float rs = 1.f / sqrtf(q * (1.f / 256.f) + LN_EPS);
            a[j] = (f32x4){o.x * rs * ng.x * silu_f(r[j].x), o.y * rs * ng.y * silu_f(r[j].y), o.z * rs * ng.z * silu_f(r[j].z), o.w * rs * ng.w * silu_f(r[j].w)};
        }
        st_row_fp8(A2 + (size_t)tok * DM, F.lane, a);
#pragma unroll
        for (int j = 0; j < 4; ++j) { a[j] = an[j]; b[j] = bn[j]; r[j] = rn[j]; }
    }
}
namespace pg8 {
typedef short bf16x8 __attribute__((ext_vector_type(8)));
constexpr int BM = 256, BK = 64, HALF = 128, HTB = HALF * BK * 2, STAGE_BYTES = 8 * HTB, NXCD = 8, WGM = 8;
__host__ __device__ __forceinline__ int lds_byte(int r, int c) { const int st = (r >> 4) * 2 + (c >> 5), rr = r & 15, cc = c & 31, ob = rr * 64 + cc * 2; return st * 1024 + (ob ^ (((ob >> 9) & 1) << 5)); }
__host__ __device__ __forceinline__ void stage_rc(int b, int& R, int& C) { const int st = b / 1024, sb = b % 1024, swz = sb ^ (((sb >> 9) & 1) << 5); R = (st >> 1) * 16 + swz / 64; C = (st & 1) * 32 + (swz % 64) / 2; }
typedef float f32x2_t __attribute__((ext_vector_type(2))); typedef __bf16 bf16x2_t __attribute__((ext_vector_type(2)));
__device__ __forceinline__ unsigned cvt_pk_bf16(float lo, float hi) { f32x2_t v = {lo, hi}; bf16x2_t b = __builtin_convertvector(v, bf16x2_t); return __builtin_bit_cast(unsigned, b); }

struct Unit { int pm, pn; int row0; int e; int cnt; const bf16* Bt; };

struct DenseOrder {
    int nM, nN, nwg, G, c, K; const bf16* Bt;
    __device__ void init(int M, int N, int K_, const bf16* Bt_, int G_, int c_) { nM = M / BM; nN = N / BM; nwg = nM * nN; G = G_; c = c_; K = K_; Bt = Bt_; }
    __device__ bool next(int i, Unit& u) const {
        const long L = (long)i * G + c; if (L >= nwg) return false;
        int wgid = (int)L; { const int q = nwg / NXCD, r = nwg % NXCD, xcd = wgid % NXCD, off = wgid / NXCD; wgid = (xcd < r ? xcd * (q + 1) : r * (q + 1) + (xcd - r) * q) + off; }
        const int nig = WGM * nN, gid = wgid / nig, fm = gid * WGM, gsz = (nM - fm) < WGM ? (nM - fm) : WGM;
        u.pm = fm + ((wgid % nig) % gsz); u.pn = (wgid % nig) / gsz; u.row0 = u.pm * BM; u.e = 0; u.cnt = 0; u.Bt = Bt; return true;
    }
    __device__ __forceinline__ unsigned arow(const Unit& u, int r) const { return (unsigned)(u.row0 + r) * (unsigned)(K * 2); }
};
template <bool GATHER> struct MoeOrder {
    int cnt[16]; int nN, G, c, K; const bf16* Bt0; size_t bstride; const int* LIST;
    __device__ void init(const unsigned* cntw, int N, int K_, const bf16* Bt0_, const int* LIST_, int G_, int c_) {
#pragma unroll
        for (int e = 0; e < 16; ++e) cnt[e] = (int)__hip_atomic_load(cntw + e, __ATOMIC_RELAXED, __HIP_MEMORY_SCOPE_AGENT);
        nN = N / BM; G = G_; c = c_; K = K_; Bt0 = Bt0_; bstride = (size_t)N * K_; LIST = LIST_; }
    __device__ bool next(int i, Unit& u) const {
        int L = i * G + c, base = 0; bool found = false; u.pm = 0; u.pn = 0; u.row0 = 0; u.e = 0; u.cnt = 0; u.Bt = Bt0;
#pragma unroll
        for (int e = 0; e < 16; ++e) { const int mt = (cnt[e] + 255) >> 8, nu = mt * nN;
            if (!found) { if (L < nu) { found = true; u.e = e; u.cnt = cnt[e]; u.pm = L / nN; u.pn = L % nN; u.row0 = base + u.pm * BM; u.Bt = Bt0 + (size_t)e * bstride; } else { L -= nu; base += mt * BM; } } }
        return found;
    }
    __device__ __forceinline__ unsigned arow(const Unit& u, int r) const {
        if (GATHER) { const int li = u.pm * BM + r; int tok = 0; if (li < u.cnt) tok = LIST[u.e * NTOK + li];
            return (unsigned)tok * (unsigned)(K * 2); }
        return (unsigned)(u.row0 + r) * (unsigned)(K * 2);
    }
};

typedef f32x4 Acc[2][2][4][2];
__device__ __forceinline__ void st4bf(bf16* p, f32x4 v) { u32x2 w; w.x = cvt_pk_bf16(v.x, v.y); w.y = cvt_pk_bf16(v.z, v.w); *(u32x2*)p = w; }
__device__ __forceinline__ void st8bf(bf16* p, f32x4 a, f32x4 b) { u32x4 w; w.x = cvt_pk_bf16(a.x, a.y); w.y = cvt_pk_bf16(a.z, a.w); w.z = cvt_pk_bf16(b.x, b.y); w.w = cvt_pk_bf16(b.z, b.w); *(u32x4*)p = w; }

struct EpiQKV {
    bf16 *Q; const LAS float* rope; float wsc;
    __device__ __forceinline__ void operator()(const Acc& acc, const Unit& u, int wr, int wc, int fr, int fq) const {
        const int reg = u.pn >> 2; bf16* O = Q + (size_t)reg * ((WS_K - WS_Q) / 2);
        if (reg == 2) { const int cbase = (u.pn & 3) * BM + wc * 32 + 8 * fq;
#pragma unroll
            for (int ai = 0; ai < 2; ++ai)
#pragma unroll
                for (int m = 0; m < 4; ++m) { bf16* rowp = O + (size_t)(u.row0 + ai * HALF + wr * 64 + m * 16 + fr) * DM + cbase;
#pragma unroll
                    for (int bj = 0; bj < 2; ++bj) st8bf(rowp + bj * HALF, acc[ai][bj][m][0] * wsc, acc[ai][bj][m][1] * wsc); }
            return; }
        const int cbase = (u.pn & 3) * BM + wc * 32 + 4 * fq;
        const bool dorope = (u.row0 < NLAT); const float sc = (reg == 0 ? C2 : 1.f) * wsc;
#pragma unroll
        for (int ai = 0; ai < 2; ++ai)
#pragma unroll
            for (int m = 0; m < 4; ++m) { const int row = u.row0 + ai * HALF + wr * 64 + m * 16 + fr; bf16* rowp = O + (size_t)row * DM + cbase;
                f32x4 cs = {1.f, 1.f, 1.f, 1.f}, sn = {0.f, 0.f, 0.f, 0.f};
                if (dorope) { const int s = row & (SEQ - 1), pos = (wc & 1) ? (s & 63) : (s >> 6); const f32x4 t0 = *(const LAS f32x4*)(rope + (pos * 16 + 4 * fq) * 2), t1 = *(const LAS f32x4*)(rope + (pos * 16 + 4 * fq) * 2 + 4);
                    cs = (f32x4){t0.x, t0.z, t1.x, t1.z}; sn = (f32x4){t0.y, t0.w, t1.y, t1.w}; }
#pragma unroll
                for (int bj = 0; bj < 2; ++bj) { const f32x4 a0 = acc[ai][bj][m][0], a1 = acc[ai][bj][m][1];
                    st4bf(rowp + bj * HALF, (a0 * cs - a1 * sn) * sc); st4bf(rowp + bj * HALF + 16, (a1 * cs + a0 * sn) * sc); } }
    }
};
struct EpiPlain {
    bf16* O; float sc;
    __device__ __forceinline__ void operator()(const Acc& acc, const Unit& u, int wr, int wc, int fr, int fq) const {
        const int cbase = u.pn * BM + wc * 32 + 8 * fq;
#pragma unroll
        for (int ai = 0; ai < 2; ++ai)
#pragma unroll
            for (int m = 0; m < 4; ++m) { bf16* rowp = O + (size_t)(u.row0 + ai * HALF + wr * 64 + m * 16 + fr) * DM + cbase;
#pragma unroll
                for (int bj = 0; bj < 2; ++bj) st8bf(rowp + bj * HALF, acc[ai][bj][m][0] * sc, acc[ai][bj][m][1] * sc); }
    }
};
struct EpiPlain8 {
    unsigned char* O; float sc;
    __device__ __forceinline__ void operator()(const Acc& acc, const Unit& u, int wr, int wc, int fr, int fq) const {
        const int cbase = u.pn * BM + wc * 32 + 8 * fq;
#pragma unroll
        for (int ai = 0; ai < 2; ++ai)
#pragma unroll
            for (int m = 0; m < 4; ++m) { unsigned char* rowp = O + (size_t)(u.row0 + ai * HALF + wr * 64 + m * 16 + fr) * DM + cbase;
#pragma unroll
                for (int bj = 0; bj < 2; ++bj) { const f32x4 a = acc[ai][bj][m][0] * sc, b = acc[ai][bj][m][1] * sc; u32x2 w; w.x = pk4_fp8(a.x, a.y, a.z, a.w); w.y = pk4_fp8(b.x, b.y, b.z, b.w); *(u32x2*)(rowp + bj * HALF) = w; } }
    }
};
struct EpiInproj {
    bf16 *QR, *KR, *V, *R; float* ZZ; float wsc;
    __device__ __forceinline__ void operator()(const Acc& acc, const Unit& u, int wr, int wc, int fr, int fq) const {
        const int pn = u.pn;
        if (pn == 12) { if (wc == 0) {
#pragma unroll
            for (int ai = 0; ai < 2; ++ai)
#pragma unroll
                for (int m = 0; m < 4; ++m) { float* rowp = ZZ + (size_t)(u.row0 + ai * HALF + wr * 64 + m * 16 + fr) * 32 + 4 * fq;
                    *(f32x4*)rowp = acc[ai][0][m][0] * wsc; *(f32x4*)(rowp + 16) = acc[ai][0][m][1] * wsc; } }
            return; }
        bf16* O; int ld, c0; float sc = wsc;
        if (pn < 2) { O = QR; ld = 512; c0 = pn * BM; sc = 0.08838834764831845f * wsc; } else if (pn < 4) { O = KR; ld = 512; c0 = (pn - 2) * BM; } else if (pn < 8) { O = V; ld = DM; c0 = (pn - 4) * BM; } else { O = R; ld = DM; c0 = (pn - 8) * BM; }
        const int cbase = c0 + wc * 32 + 8 * fq;
#pragma unroll
        for (int ai = 0; ai < 2; ++ai)
#pragma unroll
            for (int m = 0; m < 4; ++m) { bf16* rowp = O + (size_t)(u.row0 + ai * HALF + wr * 64 + m * 16 + fr) * ld + cbase;
#pragma unroll
                for (int bj = 0; bj < 2; ++bj) st8bf(rowp + bj * HALF, acc[ai][bj][m][0] * sc, acc[ai][bj][m][1] * sc); }
    }
};
struct EpiGateUp {
    unsigned char* ACT;
    __device__ __forceinline__ void operator()(const Acc& acc, const Unit& u, int wr, int wc, int fr, int fq) const {
        const int obase = (u.pn * BM + wc * 32) / 2 + 4 * fq;
#pragma unroll
        for (int ai = 0; ai < 2; ++ai)
#pragma unroll
            for (int m = 0; m < 4; ++m) { unsigned char* rowp = ACT + (size_t)(u.row0 + ai * HALF + wr * 64 + m * 16 + fr) * DEXP + obase;
#pragma unroll
                for (int bj = 0; bj < 2; ++bj) { const f32x4 g = acc[ai][bj][m][0] * W8_INV, up = acc[ai][bj][m][1] * W8_INV; f32x4 o;
#pragma unroll
                    for (int j = 0; j < 4; ++j) o[j] = g[j] * __builtin_amdgcn_rcpf(1.f + __expf(-g[j])) * up[j];
                    *(unsigned*)(rowp + bj * (HALF / 2)) = pk4_fp8(o[0], o[1], o[2], o[3]); } }
    }
};

typedef int i32x8 __attribute__((ext_vector_type(8)));
typedef int i32x4 __attribute__((ext_vector_type(4)));
__device__ __forceinline__ i32x8 cat8(bf16x8 lo, bf16x8 hi) { return __builtin_shufflevector(__builtin_bit_cast(i32x4, lo), __builtin_bit_cast(i32x4, hi), 0, 1, 2, 3, 4, 5, 6, 7); }
template <class Epi, class Sched, bool FP8 = false>
__device__ __forceinline__ void gemm_phase(unsigned char* ldsg, const bf16* A, int K, const Sched& S, const Epi& E) {
    LAS unsigned char* lds = (LAS unsigned char*)ldsg;
    const int tid = threadIdx.x, wid = __builtin_amdgcn_readfirstlane(tid >> 6), lane = tid & 63, wr = wid >> 2, wc = wid & 3, fr = lane & 15, fq = lane >> 4;
    const int nt = K / BK;
    int Rr[2]; unsigned colb[2], voffB[2];
#pragma unroll
    for (int i = 0; i < 2; ++i) { int R, C; stage_rc(tid * 16 + i * 8192, R, C); Rr[i] = R; colb[i] = (unsigned)C * 2u; voffB[i] = (unsigned)(R * K + C) * 2u; }
    const size_t kstep = (size_t)(BK * 2);
    const size_t hstep = (size_t)HALF * K * 2;
    const size_t tstep = 2 * hstep;
    const unsigned ldsw = (unsigned)wid * 1024u;
    const int aoff = lds_byte(wr * 64 + fr, fq * 8), boff = lds_byte(wc * 32 + fr, fq * 8);
#define PG8_SA(b, h) (((b) * 2 + (h)) * HTB)
#define PG8_SB(b, h) ((4 + (b) * 2 + (h)) * HTB)
#define PG8_STAGE(bufoff, gbase, voff) do { _Pragma("unroll") for (int _i = 0; _i < 2; ++_i) \
        __builtin_amdgcn_global_load_lds((const unsigned*)((const char*)(gbase) + (voff)[_i]), (LAS unsigned*)(lds + (bufoff) + ldsw + _i * 8192), 16, 0, 0); } while (0)
#define PG8_LDA(dst, b, h) do { if constexpr (FP8) { _Pragma("unroll") for (int m = 0; m < 4; ++m) dst##8[m] = cat8(*(const LAS bf16x8*)(lds + PG8_SA(b, h) + aoff + m * 2048), *(const LAS bf16x8*)(lds + PG8_SA(b, h) + aoff + m * 2048 + 1024)); } \
        else { _Pragma("unroll") for (int m = 0; m < 4; ++m) _Pragma("unroll") for (int k = 0; k < 2; ++k) dst[m][k] = *(const LAS bf16x8*)(lds + PG8_SA(b, h) + aoff + m * 2048 + k * 1024); } } while (0)
#define PG8_LDB(dst, b, h) do { if constexpr (FP8) { _Pragma("unroll") for (int n = 0; n < 2; ++n) dst##8[n] = cat8(*(const LAS bf16x8*)(lds + PG8_SB(b, h) + boff + n * 2048), *(const LAS bf16x8*)(lds + PG8_SB(b, h) + boff + n * 2048 + 1024)); } \
        else { _Pragma("unroll") for (int n = 0; n < 2; ++n) _Pragma("unroll") for (int k = 0; k < 2; ++k) dst[n][k] = *(const LAS bf16x8*)(lds + PG8_SB(b, h) + boff + n * 2048 + k * 1024); } } while (0)
#define PG8_MMA(ai, bj, At, Bt) do { __builtin_amdgcn_s_setprio(1); \
        if constexpr (FP8) { _Pragma("unroll") for (int m = 0; m < 4; ++m) _Pragma("unroll") for (int n = 0; n < 2; ++n) \
            asm volatile("v_mfma_scale_f32_16x16x128_f8f6f4 %0, %1, %2, %0, %3, %3 op_sel_hi:[0,0,0]" : "+v"(acc[ai][bj][m][n]) : "v"(Bt##8[n]), "v"(At##8[m]), "v"(sc8)); } \
        else { _Pragma("unroll") for (int m = 0; m < 4; ++m) _Pragma("unroll") for (int n = 0; n < 2; ++n) _Pragma("unroll") for (int k = 0; k < 2; ++k) \
            acc[ai][bj][m][n] = __builtin_amdgcn_mfma_f32_16x16x32_bf16(Bt[n][k], At[m][k], acc[ai][bj][m][n], 0, 0, 0); } \
        __builtin_amdgcn_s_setprio(0); } while (0)
#define PG8_WAIT_V(n) asm volatile("s_waitcnt vmcnt(" #n ")" ::: "memory")
#define PG8_WAIT_L(n) asm volatile("s_waitcnt lgkmcnt(" #n ")" ::: "memory")
#define PG8_BAR __builtin_amdgcn_s_barrier()
#define PG8_SCHED __builtin_amdgcn_sched_barrier(0)
    Unit cur, nxt; int ui = 0;
    if (!S.next(0, cur)) return;
    Acc acc;
#pragma unroll
    for (int a = 0; a < 2; ++a)
#pragma unroll
        for (int b = 0; b < 2; ++b)
#pragma unroll
            for (int m = 0; m < 4; ++m)
#pragma unroll
                for (int n = 0; n < 2; ++n) acc[a][b][m][n] = (f32x4){0.f, 0.f, 0.f, 0.f};
    const int sc8 = 0x7f7f7f7f;
    bf16x8 At[4][2], B0[2][2], B1[2][2]; i32x8 At8[4], B08[2], B18[2];
    unsigned aC0[2], aC1[2], aN0[2], aN1[2];
#pragma unroll
    for (int i = 0; i < 2; ++i) { aC0[i] = S.arow(cur, Rr[i]) + colb[i]; aC1[i] = S.arow(cur, HALF + Rr[i]) + colb[i]; }
    const char* Ab = (const char*)A;
    const char* cB = (const char*)cur.Bt + (size_t)cur.pn * tstep;
    PG8_STAGE(PG8_SB(0, 0), cB, voffB); PG8_STAGE(PG8_SB(0, 1), cB + hstep, voffB); PG8_STAGE(PG8_SA(0, 0), Ab, aC0); PG8_STAGE(PG8_SA(0, 1), Ab, aC1);
    if (wr == 1) PG8_BAR;
    PG8_WAIT_V(2); PG8_BAR;
    PG8_STAGE(PG8_SB(1, 0), cB + kstep, voffB); PG8_STAGE(PG8_SA(1, 0), Ab + kstep, aC0); PG8_STAGE(PG8_SB(1, 1), cB + hstep + kstep, voffB);
    PG8_WAIT_V(6); PG8_BAR;
    for (;;) {
        const bool has_next = S.next(ui + 1, nxt);
        if (has_next) {
#pragma unroll
            for (int i = 0; i < 2; ++i) { aN0[i] = S.arow(nxt, Rr[i]) + colb[i]; aN1[i] = S.arow(nxt, HALF + Rr[i]) + colb[i]; }
        } else {
#pragma unroll
            for (int i = 0; i < 2; ++i) { aN0[i] = aC0[i]; aN1[i] = aC1[i]; }
        }
        const char* nB = has_next ? (const char*)nxt.Bt + (size_t)nxt.pn * tstep : cB;
        for (int t = 0; t < nt; t += 2) {
            const bool last = (t == nt - 2);
            const char* a1 = Ab + (size_t)(t + 1) * kstep;
            const char* a2 = last ? Ab : Ab + (size_t)(t + 2) * kstep; const char* b2 = last ? nB : cB + (size_t)(t + 2) * kstep;
            const char* a3 = a2 + kstep; const char* b3 = b2 + kstep;
            unsigned x0[2], x1[2];
#pragma unroll
            for (int i = 0; i < 2; ++i) { x0[i] = last ? aN0[i] : aC0[i]; x1[i] = last ? aN1[i] : aC1[i]; }
            PG8_LDB(B0, 0, 0); PG8_LDB(B1, 0, 1); PG8_SCHED; PG8_LDA(At, 0, 0); PG8_STAGE(PG8_SA(1, 1), a1, aC1);
            PG8_WAIT_V(8); PG8_WAIT_L(0); PG8_BAR; PG8_MMA(0, 0, At, B0); PG8_MMA(0, 1, At, B1); PG8_BAR; PG8_SCHED;
            PG8_LDA(At, 0, 1); PG8_STAGE(PG8_SB(0, 0), b2, voffB); PG8_STAGE(PG8_SB(0, 1), b2 + hstep, voffB); PG8_STAGE(PG8_SA(0, 0), a2, x0);
            PG8_WAIT_V(8); PG8_WAIT_L(0); PG8_BAR; PG8_MMA(1, 0, At, B0); PG8_MMA(1, 1, At, B1); PG8_BAR; PG8_SCHED;
            PG8_LDB(B0, 1, 0); PG8_LDB(B1, 1, 1); PG8_SCHED; PG8_LDA(At, 1, 0); PG8_STAGE(PG8_SA(0, 1), a2, x1);
            PG8_WAIT_V(8); PG8_WAIT_L(0); PG8_BAR; PG8_MMA(0, 0, At, B0); PG8_MMA(0, 1, At, B1); PG8_BAR; PG8_SCHED;
            PG8_LDA(At, 1, 1); PG8_STAGE(PG8_SB(1, 0), b3, voffB); PG8_STAGE(PG8_SB(1, 1), b3 + hstep, voffB); PG8_STAGE(PG8_SA(1, 0), a3, x0);
            PG8_WAIT_V(8); PG8_WAIT_L(0); PG8_BAR; PG8_MMA(1, 0, At, B0); PG8_MMA(1, 1, At, B1); PG8_BAR; PG8_SCHED;
        }
        if (wr == 0) PG8_BAR;
        if constexpr (FP8) asm volatile("s_nop 15\n\ts_nop 7" ::: "memory");
        E(acc, cur, wr, wc, fr, fq);
        if (!has_next) break;
#pragma unroll
        for (int a = 0; a < 2; ++a)
#pragma unroll
            for (int b = 0; b < 2; ++b)
#pragma unroll
                for (int m = 0; m < 4; ++m)
#pragma unroll
                    for (int n = 0; n < 2; ++n) acc[a][b][m][n] = (f32x4){0.f, 0.f, 0.f, 0.f};
        cur = nxt; cB = nB; ++ui;
#pragma unroll
        for (int i = 0; i < 2; ++i) { aC0[i] = aN0[i]; aC1[i] = aN1[i]; }
        if (wr == 1) PG8_BAR;
    }
    PG8_WAIT_V(0);
    PG8_BAR;
#undef PG8_SA
#undef PG8_SB
#undef PG8_STAGE
#undef PG8_LDA
#undef PG8_LDB
#undef PG8_MMA
#undef PG8_WAIT_V
#undef PG8_WAIT_L
#undef PG8_BAR
#undef PG8_SCHED
}
}

__device__ __forceinline__ int vcu_of(const Frame& F) { return (F.G % 8 == 0) ? (F.bid % 8) * (F.G / 8) + F.bid / 8 : F.bid; }
__device__ __forceinline__ void phase_qkv_opt(const Frame& F, const Prm& p) {
    pg8::DenseOrder S; S.init(NTOK, 3072, 512, (const bf16*)(p.ws + WS_WQKV), F.G, F.bid);
    static_assert(WS_V - WS_K == WS_K - WS_Q, "Q|K|V equally spaced");
    LAS float* ropel = (LAS float*)((LAS unsigned char*)F.lds + LDSX_OFF);
    const float* ropeg = (const float*)(p.ws + WS_MISC) + 1024;
    for (int i = F.tid; i < 2048; i += NTHR) ropel[i] = ropeg[i];
    __syncthreads();
    pg8::EpiQKV E{(bf16*)(p.ws + WS_Q), ropel, W8_INV};
    pg8::gemm_phase<pg8::EpiQKV, pg8::DenseOrder, true>(F.lds, (const bf16*)(p.ws + WS_H), 512, S, E);
}
__device__ __forceinline__ void phase_wo_opt(const Frame& F, const Prm& p, int layer) {
    if (layer) {
        pg8::DenseOrder S; S.init(NLAT, 1024, 512, (const bf16*)(p.ws + WS_WGO), F.G, F.bid);
        pg8::EpiPlain E{(bf16*)(p.ws + WS_Y), W8_INV};
        pg8::gemm_phase<pg8::EpiPlain, pg8::DenseOrder, true>(F.lds, (const bf16*)(p.ws + WS_A2B), 512, S, E);
    } else {
        pg8::DenseOrder S; S.init(NTOK, 1024, 512, (const bf16*)(p.ws + WS_WO), F.G, F.bid);
        pg8::EpiPlain E{(bf16*)(p.ws + WS_Y), W8_INV};
        pg8::gemm_phase<pg8::EpiPlain, pg8::DenseOrder, true>(F.lds, (const bf16*)(p.ws + WS_A2), 512, S, E);
    }
}
__device__ __forceinline__ void phase_inproj_opt(const Frame& F, const Prm& p) {
    pg8::DenseOrder S; S.init(NTOK, NIN, 512, (const bf16*)(p.ws + WS_WIN), F.G, F.bid);
    pg8::EpiInproj E{(bf16*)(p.ws + WS_QR), (bf16*)(p.ws + WS_KR), (bf16*)(p.ws + WS_V1), (bf16*)(p.ws + WS_R), (float*)(p.ws + WS_ZZ), W8_INV};
    pg8::gemm_phase<pg8::EpiInproj, pg8::DenseOrder, true>(F.lds, (const bf16*)(p.ws + WS_H), 512, S, E);
}
__device__ __forceinline__ void phase_moe1_opt(const Frame& F, const Prm& p, int layer) {
    pg8::MoeOrder<true> S; S.init(F.ctl + CW_CNT + layer * 16, 1024, 512, (const bf16*)(p.ws + (layer ? WS_GU1 : WS_GU0)), (const int*)(p.ws + WS_LIST), F.G, vcu_of(F));
    pg8::EpiGateUp E{p.ws + WS_ACT};
    pg8::gemm_phase<pg8::EpiGateUp, pg8::MoeOrder<true>, true>(F.lds, (const bf16*)(p.ws + WS_H), 512, S, E);
}
__device__ __forceinline__ void phase_moe2_opt(const Frame& F, const Prm& p, int layer) {
    pg8::MoeOrder<false> S; S.init(F.ctl + CW_CNT + layer * 16, 1024, 256, (const bf16*)(p.ws + (layer ? WS_DN1 : WS_DN0)), nullptr, F.G, vcu_of(F));
    pg8::EpiPlain8 E{p.ws + WS_YM, W8_INV};
    pg8::gemm_phase<pg8::EpiPlain8, pg8::MoeOrder<false>, true>(F.lds, (const bf16*)(p.ws + WS_ACT), 256, S, E);
}
namespace attn_body {
using bf16=unsigned short;
using bf16x8=__attribute__((ext_vector_type(8)))short;
using s16x4=__attribute__((ext_vector_type(4)))short;
using f32x16=__attribute__((ext_vector_type(16)))float;
using u32x4=__attribute__((ext_vector_type(4)))unsigned;
constexpr int D=64,DM=1024;
constexpr int NW=8,QBLK=32,QB=QBLK*NW,KVBLK=64;
constexpr int ATTN_PITCH=DM, ATTN_UNIT_ROWS=QB;
__device__ __forceinline__ int crow(int r,int hi){return (r&3)+8*(r>>2)+4*hi;}
#define SBAR() __builtin_amdgcn_sched_barrier(0)
__device__ __forceinline__ void cmask(f32x16&p0,f32x16&p1,int jb,int qrel,int hi){
  const float NEG=-INFINITY; int kb=64*jb+4*hi;
  #pragma unroll
  for(int r=0;r<16;++r){int kv=kb+(r&3)+8*(r>>2); if(kv>qrel)p0[r]=NEG; if(kv+32>qrel)p1[r]=NEG;}
}

constexpr int NSLOT=3, SLOTB=8192;
constexpr int LDS_K=0, LDS_V=NSLOT*SLOTB, LDS_WS=2*NSLOT*SLOTB, LDS_OST=LDS_WS+NW*64*4, LDS_BYTES=LDS_OST+NW*4096;
constexpr float C2=0.125f*1.4426950408889634f;
__device__ __forceinline__ void glds16(const void*gsrc,unsigned lds_dst){unsigned keep;
  asm volatile("s_mov_b32 %0, m0\n\ts_mov_b32 m0, %2\n\ts_nop 0\n\tglobal_load_lds_dwordx4 %1, off\n\ts_mov_b32 m0, %0":"=&s"(keep):"v"(gsrc),"s"(lds_dst):"memory");}
__device__ __forceinline__ float max3f(float a,float b,float c){float r;asm("v_max3_f32 %0, %1, %2, %3":"=v"(r):"v"(a),"v"(b),"v"(c));return r;}
__device__ __forceinline__ float max2f(float a,float b){float r;asm("v_max_f32_e32 %0, %1, %2":"=v"(r):"v"(a),"v"(b));return r;}
__device__ __forceinline__ float fadd_s(float a,float b){float r;asm("v_add_f32_e32 %0, %1, %2":"=v"(r):"v"(a),"v"(b));return r;}
__device__ __forceinline__ float fsub_s(float a,float b){float r;asm("v_sub_f32_e32 %0, %1, %2":"=v"(r):"v"(a),"v"(b));return r;}
typedef float f32x2_t __attribute__((ext_vector_type(2))); typedef __bf16 bf16x2_t __attribute__((ext_vector_type(2)));
__device__ __forceinline__ unsigned cvtpk_s(float lo,float hi){f32x2_t v={lo,hi};bf16x2_t b=__builtin_convertvector(v,bf16x2_t);return __builtin_bit_cast(unsigned,b);}
#define WAIT_BAR(N) asm volatile("s_waitcnt vmcnt(" #N ") lgkmcnt(0)\n\ts_barrier":::"memory")

__device__ __forceinline__ void qkt(f32x16&p0,f32x16&p1,const char*Kslot,const bf16x8*qr,const f32x16&negm,int r32,int hi){
  const char*kb=Kslot+hi*1024+r32*16;
  #pragma unroll
  for(int d0=0;d0<4;++d0){
    const bf16x8 b0=*reinterpret_cast<const bf16x8*>(kb+d0*2048);
    const bf16x8 b1=*reinterpret_cast<const bf16x8*>(kb+d0*2048+512);
    if(d0==0){p0=__builtin_amdgcn_mfma_f32_32x32x16_bf16(b0,qr[0],negm,0,0,0);p1=__builtin_amdgcn_mfma_f32_32x32x16_bf16(b1,qr[0],negm,0,0,0);}
    else{p0=__builtin_amdgcn_mfma_f32_32x32x16_bf16(b0,qr[d0],p0,0,0,0);p1=__builtin_amdgcn_mfma_f32_32x32x16_bf16(b1,qr[d0],p1,0,0,0);}}
}
typedef __attribute__((address_space(3))) const char* lds_cptr;
typedef short v4i16_t __attribute__((ext_vector_type(4)));
__device__ __forceinline__ void kload8(bf16x8*kf,lds_cptr kp){
  kf[0]=*(const __attribute__((address_space(3))) bf16x8*)(kp);      kf[1]=*(const __attribute__((address_space(3))) bf16x8*)(kp+512);
  kf[2]=*(const __attribute__((address_space(3))) bf16x8*)(kp+2048); kf[3]=*(const __attribute__((address_space(3))) bf16x8*)(kp+2560);
  kf[4]=*(const __attribute__((address_space(3))) bf16x8*)(kp+4096); kf[5]=*(const __attribute__((address_space(3))) bf16x8*)(kp+4608);
  kf[6]=*(const __attribute__((address_space(3))) bf16x8*)(kp+6144); kf[7]=*(const __attribute__((address_space(3))) bf16x8*)(kp+6656);
}
__device__ __forceinline__ void kload2(bf16x8*kf,lds_cptr kp,int j){ kf[2*j]=*(const __attribute__((address_space(3))) bf16x8*)(kp+j*2048); kf[2*j+1]=*(const __attribute__((address_space(3))) bf16x8*)(kp+j*2048+512); }
__device__ __forceinline__ s16x4 vtr(lds_cptr p){ return __builtin_bit_cast(s16x4,__builtin_amdgcn_ds_read_tr16_b64_v4i16((__attribute__((address_space(3))) v4i16_t*)p)); }
__device__ __forceinline__ float rowmax(const f32x16&p0,const f32x16&p1){
  float a=max3f(p0[0],p0[1],p1[0]),b=max3f(p0[2],p0[3],p1[1]);a=max3f(a,p1[2],p1[3]);
  #pragma unroll
  for(int r=4;r<16;r+=4){a=max3f(a,p0[r],p0[r+1]);b=max3f(b,p0[r+2],p0[r+3]);a=max3f(a,p1[r],p1[r+1]);b=max3f(b,p1[r+2],p1[r+3]);}
  const float m=max2f(a,b);
  auto rr=__builtin_amdgcn_permlane32_swap(__float_as_uint(m),__float_as_uint(m),false,false);
  return max2f(__uint_as_float(rr[0]),__uint_as_float(rr[1]));
}
__device__ __forceinline__ void pv(f32x16*o,int vb,bf16x8 pa0,bf16x8 pa1,bf16x8 pa2,bf16x8 pa3){
  #pragma unroll
  for(int d0=0;d0<2;++d0){s16x4 lo[4],hi[4];
    #pragma unroll
    for(int ks=0;ks<4;++ks){
      asm volatile("ds_read_b64_tr_b16 %0,%1 offset:%c2":"=&v"(lo[ks]):"v"(vb),"i"(d0*4096+ks*1024):"memory");
      asm volatile("ds_read_b64_tr_b16 %0,%1 offset:%c2":"=&v"(hi[ks]):"v"(vb),"i"(d0*4096+ks*1024+512):"memory");}
    asm volatile("s_waitcnt lgkmcnt(0)":::"memory");SBAR();
    #define PK(k) (bf16x8){lo[k][0],lo[k][1],lo[k][2],lo[k][3],hi[k][0],hi[k][1],hi[k][2],hi[k][3]}
    o[d0]=__builtin_amdgcn_mfma_f32_32x32x16_bf16(pa0,PK(0),o[d0],0,0,0);
    o[d0]=__builtin_amdgcn_mfma_f32_32x32x16_bf16(pa1,PK(1),o[d0],0,0,0);
    o[d0]=__builtin_amdgcn_mfma_f32_32x32x16_bf16(pa2,PK(2),o[d0],0,0,0);
    o[d0]=__builtin_amdgcn_mfma_f32_32x32x16_bf16(pa3,PK(3),o[d0],0,0,0);
    #undef PK
  }
}

#ifndef ATTN_STORE16
#define ATTN_STORE16(p,v) (*(u32x4*)(p)=(v))
#endif
template<int THRL> __device__ __forceinline__ void attn_unit(long qrow0,int qcol,int vcol,long kctx,long klat,int NT,const bf16*Q,const bf16*__restrict__ K,const bf16*__restrict__ V,bf16*O,char*shm){
  const int tid=threadIdx.x,lane=tid&63,r32=lane&31,hi=lane>>5; const int wid=__builtin_amdgcn_readfirstlane(tid>>6);

  const bf16*Qw=Q+(qrow0+wid*QBLK)*DM+qcol;
  const bf16*Kh=K+qcol,*Vh=V+vcol;
  const unsigned lds0=(unsigned)(uintptr_t)shm;
  float*wsf=(float*)(shm+LDS_WS)+wid*64;
  const bf16*ksrc=Kh+(long)lane*DM+wid*8;
  const bf16*vsrc=Vh+(long)(16*(wid&3)+(lane>>2))*DM+(wid>>2)*32+(lane&3)*8;
  const unsigned kdst=lds0+LDS_K+wid*1024, vdst=lds0+LDS_V+wid*1024;
  #define KVROW(t) ((t)<4?kctx+(long)(t)*KVBLK:klat+(long)((t)-4)*KVBLK)
  #define DMA_K(t,slot) glds16(ksrc+KVROW(t)*DM,(unsigned)__builtin_amdgcn_readfirstlane(kdst+(slot)))
  #define DMA_V(t,slot) glds16(vsrc+KVROW(t)*DM,(unsigned)__builtin_amdgcn_readfirstlane(vdst+(slot)))
  const int vb0=(int)(lds0+LDS_V)+((lane>>4)&1)*32+(lane&3)*8+(4*hi+((lane&15)>>2))*64;
  const char*Kbase=shm+LDS_K; bf16x8 kf[8];
  const lds_cptr shm3=(lds_cptr)shm; const lds_cptr kp0=shm3+LDS_K+hi*1024+r32*16; const lds_cptr vp0=shm3+LDS_V+((lane>>4)&1)*32+(lane&3)*8+(4*hi+((lane&15)>>2))*64;
  DMA_K(0,0);DMA_V(0,0);DMA_K(1,SLOTB);
  bf16x8 qr[4];
  #pragma unroll
  for(int d0=0;d0<4;++d0)qr[d0]=*reinterpret_cast<const bf16x8*>(&Qw[(long)r32*DM+d0*16+hi*8]);
  float mhat=0.f,l_reg=0.f;f32x16 o[2];o[0]=f32x16{};o[1]=f32x16{};f32x16 negm=f32x16{};asm volatile("":"+v"(negm));
  const int qrel=wid*QBLK+r32;
  #define CMASK(P0,P1,t) do{}while(0)
  bool resc=false;
  #define START(P0,P1) do{ const float rm=rowmax(P0,P1); resc=false; \
    { const float dl=rm; mhat=fadd_s(mhat,dl); \
      _Pragma("unroll") for(int r=0;r<16;++r){P0[r]=fsub_s(P0[r],dl);P1[r]=fsub_s(P1[r],dl);} \
      _Pragma("unroll") for(int r=0;r<16;++r)negm[r]=-mhat; asm volatile("":"+v"(negm)); } \
    _Pragma("unroll") for(int r=0;r<16;++r)P0[r]=__builtin_amdgcn_exp2f(P0[r]); }while(0)
  #define RESC() do{ if(resc){ asm volatile("s_waitcnt lgkmcnt(0)":::"memory"); \
      _Pragma("unroll") for(int d_=0;d_<2;++d_) _Pragma("unroll") for(int r=0;r<16;++r)o[d_][r]*=wsf[crow(r,hi)]; } }while(0)
  f32x16 pA0,pA1,pB0,pB1;
  int sl_prev=0,sl_cur=0,sl_next=SLOTB;
  #define ROT() do{sl_prev=sl_cur;sl_cur=sl_next;sl_next=(sl_next==(NSLOT-1)*SLOTB)?0:sl_next+SLOTB;}while(0)
  DMA_K(2,2*SLOTB);
  WAIT_BAR(3);
  qkt(pA0,pA1,Kbase,qr,negm,r32,hi);asm volatile("s_nop 15\n\ts_nop 7":"+v"(pA0),"+v"(pA1));CMASK(pA0,pA1,0);
  START(pA0,pA1);
  _Pragma("unroll") for(int r=0;r<16;++r)pA1[r]=__builtin_amdgcn_exp2f(pA1[r]);
  WAIT_BAR(0);
  DMA_K(3,0);DMA_V(1,SLOTB);
  ROT();
  kload8(kf,kp0+sl_cur);
  WAIT_BAR(2);
  s16x4 vlo[8],vhi[8]; u32x4 pw0,pw1,pw2,pw3;
  #define PKW(P,B) cvtpk_s(P[B],P[B+1])
  #define PAF(k) __builtin_bit_cast(bf16x8,pw##k)
  #define VFR(i) (bf16x8){vlo[i][0],vlo[i][1],vlo[i][2],vlo[i][3],vhi[i][0],vhi[i][1],vhi[i][2],vhi[i][3]}
  #define PIN(x) asm volatile("":"+v"(x))
  #define MX3(a,b,c) __builtin_fmaxf(__builtin_fmaxf((a),(b)),(c))
  #define GAPA(MF,A0,A1,A2,A3,W0,W1,PW) do{ MF; sacc+=A0; sacc+=A1; sacc+=A2; sacc+=A3; PIN(sacc); W0; W1; PIN(PW); SBAR(); }while(0)
  #define EX(v) __builtin_amdgcn_exp2f(v)
  #define GAPB(MF,X,B) do{ MF; X[B]=EX(X[B]); X[B+1]=EX(X[B+1]); X[B+2]=EX(X[B+2]); X[B+3]=EX(X[B+3]); PIN(X); SBAR(); }while(0)
  #define VRD(i) do{ vlo[i]=vtr(vp_+(((i)>>2)*4096+((i)&3)*1024)); vhi[i]=vtr(vp_+(((i)>>2)*4096+((i)&3)*1024+512)); }while(0)
  #define KRD(G,j) do{ if(G){ kload2(kf,kp0+sl_next,j); SBAR(); } }while(0)
  #define STEP(C0,C1,P0,P1,t,GK,GV,GL) do{ SBAR(); \
    const lds_cptr vp_=vp0+sl_prev; \
    VRD(0); SBAR(); float sacc=(P0[0]+P0[1]); \
    GAPA(C0=__builtin_amdgcn_mfma_f32_32x32x16_bf16(kf[0],qr[0],negm,0,0,0), P0[2],P0[3],P0[4],P0[5],     pw0[0]=PKW(P0,0), pw0[1]=PKW(P0,2), pw0); \
    VRD(4); SBAR(); GAPA(C1=__builtin_amdgcn_mfma_f32_32x32x16_bf16(kf[1],qr[0],negm,0,0,0), P0[6],P0[7],P0[8],P0[9],     pw0[2]=PKW(P0,4), pw0[3]=PKW(P0,6), pw0); \
    VRD(1); SBAR(); GAPA(C0=__builtin_amdgcn_mfma_f32_32x32x16_bf16(kf[2],qr[1],C0,0,0,0),   P0[10],P0[11],P0[12],P0[13], pw1[0]=PKW(P0,8), pw1[1]=PKW(P0,10), pw1); \
    VRD(5); SBAR(); GAPA(C1=__builtin_amdgcn_mfma_f32_32x32x16_bf16(kf[3],qr[1],C1,0,0,0),   P0[14],P0[15],P1[0],P1[1],   pw1[2]=PKW(P0,12),pw1[3]=PKW(P0,14), pw1); \
    VRD(2); SBAR(); GAPA(C0=__builtin_amdgcn_mfma_f32_32x32x16_bf16(kf[4],qr[2],C0,0,0,0),   P1[2],P1[3],P1[4],P1[5],     pw2[0]=PKW(P1,0), pw2[1]=PKW(P1,2), pw2); \
    VRD(6); SBAR(); GAPA(C1=__builtin_amdgcn_mfma_f32_32x32x16_bf16(kf[5],qr[2],C1,0,0,0),   P1[6],P1[7],P1[8],P1[9],     pw2[2]=PKW(P1,4), pw2[3]=PKW(P1,6), pw2); \
    VRD(3); SBAR(); GAPA(C0=__builtin_amdgcn_mfma_f32_32x32x16_bf16(kf[6],qr[3],C0,0,0,0),   P1[10],P1[11],P1[12],P1[13], pw3[0]=PKW(P1,8), pw3[1]=PKW(P1,10), pw3); \
    VRD(7); SBAR(); GAPA(C1=__builtin_amdgcn_mfma_f32_32x32x16_bf16(kf[7],qr[3],C1,0,0,0),   P1[14],P1[15],0.f,0.f,       pw3[2]=PKW(P1,12),pw3[3]=PKW(P1,14), pw3); \
    l_reg+=sacc; \
    if(GK){DMA_K((t)+3,sl_cur);} if(GV){DMA_V((t)+1,sl_next);} \
    CMASK(C0,C1,t); \
    { float a=MX3(C0[0],C0[1],C1[0]),b=MX3(C0[2],C0[3],C1[1]); a=MX3(a,C1[2],C1[3]); \
      _Pragma("unroll") for(int r=4;r<16;r+=4){a=MX3(a,C0[r],C0[r+1]);b=MX3(b,C0[r+2],C0[r+3]);a=MX3(a,C1[r],C1[r+1]);b=MX3(b,C1[r+2],C1[r+3]);} \
      float rm=__builtin_fmaxf(a,b); { auto rr=__builtin_amdgcn_permlane32_swap(__float_as_uint(rm),__float_as_uint(rm),false,false); rm=__builtin_fmaxf(__uint_as_float(rr[0]),__uint_as_float(rr[1])); } \
      resc=false; \
      if(__builtin_expect(__any(rm>(float)THRL),0)){ const float dl=__builtin_fmaxf(rm,0.f); mhat+=dl; \
        _Pragma("unroll") for(int r=0;r<16;++r){C0[r]-=dl;C1[r]-=dl;} \
        _Pragma("unroll") for(int r=0;r<16;++r)negm[r]=-mhat; asm volatile("":"+v"(negm)); \
        const float f=__builtin_amdgcn_exp2f(-dl); l_reg*=f; if(hi==0)wsf[r32]=f; resc=true; } } \
    SBAR(); \
    GAPB(o[0]=__builtin_amdgcn_mfma_f32_32x32x16_bf16(PAF(0),VFR(0),o[0],0,0,0), C0,0); \
    GAPB(o[1]=__builtin_amdgcn_mfma_f32_32x32x16_bf16(PAF(0),VFR(4),o[1],0,0,0), C0,4); \
    KRD(GL,0); GAPB(o[0]=__builtin_amdgcn_mfma_f32_32x32x16_bf16(PAF(1),VFR(1),o[0],0,0,0), C0,8); \
    KRD(GL,1); GAPB(o[1]=__builtin_amdgcn_mfma_f32_32x32x16_bf16(PAF(1),VFR(5),o[1],0,0,0), C0,12); \
    KRD(GL,2); GAPB(o[0]=__builtin_amdgcn_mfma_f32_32x32x16_bf16(PAF(2),VFR(2),o[0],0,0,0), C1,0); \
    KRD(GL,3); GAPB(o[1]=__builtin_amdgcn_mfma_f32_32x32x16_bf16(PAF(2),VFR(6),o[1],0,0,0), C1,4); \
    GAPB(o[0]=__builtin_amdgcn_mfma_f32_32x32x16_bf16(PAF(3),VFR(3),o[0],0,0,0), C1,8); \
    GAPB(o[1]=__builtin_amdgcn_mfma_f32_32x32x16_bf16(PAF(3),VFR(7),o[1],0,0,0), C1,12); \
    }while(0)
  int t=1;
  #undef CMASK
  #define CMASK(P0,P1,t) do{}while(0)
  for(;t+5<NT;t+=2){
    STEP(pB0,pB1,pA0,pA1,t,true,true,true);     WAIT_BAR(2); RESC(); ROT();
    STEP(pA0,pA1,pB0,pB1,t+1,true,true,true);   WAIT_BAR(2); RESC(); ROT();
  }
  #undef CMASK
  #define CMASK(P0,P1,t) do{}while(0)
  #define ENDW(tt) do{ if((tt)+3<NT){WAIT_BAR(2);} else if((tt)+2<NT){WAIT_BAR(1);} else {WAIT_BAR(0);} }while(0)
  for(;t+1<NT;t+=2){
    STEP(pB0,pB1,pA0,pA1,t,(t+3<NT),(t+1<NT),(t+1<NT));       ENDW(t);   RESC(); ROT();
    STEP(pA0,pA1,pB0,pB1,t+1,(t+4<NT),(t+2<NT),(t+2<NT));     ENDW(t+1); RESC(); ROT();
  }
  STEP(pB0,pB1,pA0,pA1,NT-1,false,false,false); RESC();
  { float sacc=pB0[0]+pB0[1]; _Pragma("unroll") for(int r=2;r<16;++r)sacc+=pB0[r]; _Pragma("unroll") for(int r=0;r<16;++r)sacc+=pB1[r]; l_reg+=sacc;
    pw0=(u32x4){PKW(pB0,0),PKW(pB0,2),PKW(pB0,4),PKW(pB0,6)};pw1=(u32x4){PKW(pB0,8),PKW(pB0,10),PKW(pB0,12),PKW(pB0,14)};pw2=(u32x4){PKW(pB1,0),PKW(pB1,2),PKW(pB1,4),PKW(pB1,6)};pw3=(u32x4){PKW(pB1,8),PKW(pB1,10),PKW(pB1,12),PKW(pB1,14)};
    SBAR(); pv(o,vb0+sl_cur,PAF(0),PAF(1),PAF(2),PAF(3)); }
  #undef PKW
  #undef PAF
  #undef VFR
  #undef PIN
  #undef MX3
  #undef GAPA
  #undef GAPB
  #undef EX
  #undef VRD
  #undef KRD
  #undef STEP
  #undef ENDW
  {auto rr=__builtin_amdgcn_permlane32_swap(__float_as_uint(l_reg),__float_as_uint(l_reg),false,false);l_reg=__uint_as_float(rr[0])+__uint_as_float(rr[1]);}
  if(hi==0)wsf[32+r32]=l_reg;asm volatile("s_waitcnt lgkmcnt(0)":::"memory");
  float rli[16];
  #pragma unroll
  for(int r=0;r<16;++r)rli[r]=__builtin_amdgcn_rcpf(wsf[32+crow(r,hi)]);
  bf16*Ow=O+(qrow0+wid*QBLK)*DM+vcol;
  { bf16*stg=(bf16*)(shm+LDS_OST)+wid*2048;
    #pragma unroll
    for(int r=0;r<16;++r){const int orow=crow(r,hi);
      #pragma unroll
      for(int d0=0;d0<2;++d0)stg[orow*64+d0*32+r32]=(bf16)f2bf(o[d0][r]*rli[r]);}
    asm volatile("s_waitcnt lgkmcnt(0)":::"memory");
    #pragma unroll
    for(int i=0;i<4;++i){const int row=i*8+(lane>>3),ch=lane&7; const u32x4 v=*(const u32x4*)(stg+row*64+ch*8); ATTN_STORE16(Ow+(long)row*DM+ch*8,v);} }
  asm volatile("s_waitcnt lgkmcnt(0)\n\ts_barrier":::"memory");
  #undef DMA_K
  #undef DMA_V
  #undef CMASK
  #undef START
  #undef RESC
  #undef ROT
}
constexpr int ATTN_LDS_BYTES=LDS_BYTES;
#undef SBAR
#undef WAIT_BAR
#undef KVROW
}
namespace attn_body {
constexpr int V2SLOT = 16384;
constexpr int L2_K = 0, L2_V = NSLOT * SLOTB, L2_WS = L2_V + NSLOT * V2SLOT, L2_ST = L2_WS + NW * 64 * 4, L2_BYTES = L2_ST + NW * 8192;
#define SBAR() __builtin_amdgcn_sched_barrier(0)
#define WAIT_BAR(N) asm volatile("s_waitcnt vmcnt(" #N ") lgkmcnt(0)\n\ts_barrier":::"memory")
template<int THRL> __device__ __forceinline__ void attn_unit2(long qrow0,int qcol,int vcol,long kctx,long klat,int NT,const bf16*Q,const bf16*__restrict__ K,const bf16*__restrict__ V,int m,float lam,const float*subln,unsigned char*A2,int acol,char*shm){
  const int tid=threadIdx.x,lane=tid&63,r32=lane&31,hi=lane>>5; const int wid=__builtin_amdgcn_readfirstlane(tid>>6);
  const bf16*Qw=Q+(qrow0+wid*QBLK)*DM+qcol;
  const bf16*Kh=K+qcol,*Vh=V+vcol;
  const unsigned lds0=(unsigned)(uintptr_t)shm;
  float*wsf=(float*)(shm+L2_WS)+wid*64;
  const bf16*ksrc=Kh+(long)lane*DM+wid*8;
  const bf16*vsrc=Vh+(long)(16*(wid&3)+(lane>>2))*DM+(wid>>2)*32+(lane&3)*8;
  const unsigned kdst=lds0+L2_K+wid*1024, vdst=lds0+L2_V+wid*1024;
  #define KVROW(t) ((t)<4?kctx+(long)(t)*KVBLK:klat+(long)((t)-4)*KVBLK)
  #define DMA_K(t,slot) glds16(ksrc+KVROW(t)*DM,(unsigned)__builtin_amdgcn_readfirstlane(kdst+(slot)))
  #define DMA_V(t,slot) do{ glds16(vsrc+KVROW(t)*DM,(unsigned)__builtin_amdgcn_readfirstlane(vdst+2*(slot))); glds16(vsrc+KVROW(t)*DM+64,(unsigned)__builtin_amdgcn_readfirstlane(vdst+2*(slot)+8192)); }while(0)
  const char*Kbase=shm+L2_K; bf16x8 kf[8];
  const lds_cptr shm3=(lds_cptr)shm; const lds_cptr kp0=shm3+L2_K+hi*1024+r32*16; const lds_cptr vp0=shm3+L2_V+((lane>>4)&1)*32+(lane&3)*8+(4*hi+((lane&15)>>2))*64;
  DMA_K(0,0);DMA_V(0,0);DMA_K(1,SLOTB);
  bf16x8 qr[4];
  #pragma unroll
  for(int d0=0;d0<4;++d0)qr[d0]=*reinterpret_cast<const bf16x8*>(&Qw[(long)r32*DM+d0*16+hi*8]);
  float mhat=0.f,l_reg=0.f;f32x16 o[4];o[0]=f32x16{};o[1]=f32x16{};o[2]=f32x16{};o[3]=f32x16{};const f32x16 zero16=f32x16{};
  bool resc=false;
  #define START(P0,P1) do{ const float rm=rowmax(P0,P1); resc=false; mhat=rm; \
    _Pragma("unroll") for(int r=0;r<16;++r){P0[r]=fsub_s(P0[r],rm);P1[r]=fsub_s(P1[r],rm);} \
    _Pragma("unroll") for(int r=0;r<16;++r)P0[r]=__builtin_amdgcn_exp2f(P0[r]); }while(0)
  #define RESC() do{ if(resc){ asm volatile("s_waitcnt lgkmcnt(0)":::"memory"); \
      _Pragma("unroll") for(int d_=0;d_<4;++d_) _Pragma("unroll") for(int r=0;r<16;++r)o[d_][r]*=wsf[crow(r,hi)]; } }while(0)
  int sl_prev=0,sl_cur=0,sl_next=SLOTB;
  #define ROT() do{sl_prev=sl_cur;sl_cur=sl_next;sl_next=(sl_next==(NSLOT-1)*SLOTB)?0:sl_next+SLOTB;}while(0)
  DMA_K(2,2*SLOTB);
  WAIT_BAR(4);
  #define PKW(P,B) cvtpk_s(P[B],P[B+1])
  u32x4 pwA0,pwA1,pwA2,pwA3,pwB0,pwB1,pwB2,pwB3;
  { f32x16 p0,p1;
    qkt(p0,p1,Kbase,qr,zero16,r32,hi);asm volatile("s_nop 15\n\ts_nop 7":"+v"(p0),"+v"(p1));
    START(p0,p1);
    _Pragma("unroll") for(int r=0;r<16;++r)p1[r]=__builtin_amdgcn_exp2f(p1[r]);
    float sacc=p0[0]+p0[1]; _Pragma("unroll") for(int r=2;r<16;++r)sacc+=p0[r]; _Pragma("unroll") for(int r=0;r<16;++r)sacc+=p1[r]; l_reg+=sacc;
    pwA0=(u32x4){PKW(p0,0),PKW(p0,2),PKW(p0,4),PKW(p0,6)};pwA1=(u32x4){PKW(p0,8),PKW(p0,10),PKW(p0,12),PKW(p0,14)};pwA2=(u32x4){PKW(p1,0),PKW(p1,2),PKW(p1,4),PKW(p1,6)};pwA3=(u32x4){PKW(p1,8),PKW(p1,10),PKW(p1,12),PKW(p1,14)}; }
  WAIT_BAR(0);
  DMA_K(3,0);DMA_V(1,SLOTB);
  ROT();
  kload8(kf,kp0+sl_cur);
  WAIT_BAR(3);
  s16x4 vAl[4],vAh[4],vBl[4],vBh[4];
  #define PAFX(x) __builtin_bit_cast(bf16x8,x)
  #define VF(A,d) (bf16x8){A##l[d][0],A##l[d][1],A##l[d][2],A##l[d][3],A##h[d][0],A##h[d][1],A##h[d][2],A##h[d][3]}
  #define PIN(x) asm volatile("":"+v"(x))
  #define MX3(a,b,c) __builtin_fmaxf(__builtin_fmaxf((a),(b)),(c))
  #define EX(v) __builtin_amdgcn_exp2f(v)
  #define VRDL(A,d,ks) A##l[d]=vtr(vp_+((d)*4096+(ks)*1024))
  #define VRDH(A,d,ks) A##h[d]=vtr(vp_+((d)*4096+(ks)*1024+512))
  #define GAPP(MF,X,B,PWN,W,RD) do{ MF; X[B]=EX(X[B]-mhat); X[B+1]=EX(X[B+1]-mhat); sacc+=X[B]; sacc+=X[B+1]; PIN(sacc); PWN[W]=cvtpk_s(X[B],X[B+1]); PIN(PWN); RD; SBAR(); }while(0)
  #define MFQ(C,kf_,q_,acc_) C=__builtin_amdgcn_mfma_f32_32x32x16_bf16(kf_,q_,acc_,0,0,0)
  #define MFO(d,PW,A) o[d]=__builtin_amdgcn_mfma_f32_32x32x16_bf16(PAFX(PW),VF(A,d),o[d],0,0,0)
  #define KRD(G,j) do{ if(G){ kload2(kf,kp0+sl_next,j); } }while(0)
  #define STEP2(t,PI0,PI1,PI2,PI3,PO0,PO1,PO2,PO3,GK,GV,GL) do{ SBAR(); \
    const lds_cptr vp_=vp0+2*sl_prev; f32x16 C0,C1; float sacc=0.f; \
    VRDL(vA,0,0); SBAR(); MFQ(C0,kf[0],qr[0],zero16); SBAR(); \
    VRDH(vA,0,0); SBAR(); MFQ(C1,kf[1],qr[0],zero16); SBAR(); \
    VRDL(vA,1,0); SBAR(); MFQ(C0,kf[2],qr[1],C0); SBAR(); \
    VRDH(vA,1,0); SBAR(); MFQ(C1,kf[3],qr[1],C1); SBAR(); \
    VRDL(vA,2,0); SBAR(); MFQ(C0,kf[4],qr[2],C0); SBAR(); \
    VRDH(vA,2,0); SBAR(); MFQ(C1,kf[5],qr[2],C1); SBAR(); \
    VRDL(vA,3,0); SBAR(); MFQ(C0,kf[6],qr[3],C0); SBAR(); \
    VRDH(vA,3,0); SBAR(); MFQ(C1,kf[7],qr[3],C1); SBAR(); \
    if(GK){DMA_K((t)+3,sl_cur);} if(GV){DMA_V((t)+1,sl_next);} \
    { float a=MX3(C0[0],C0[1],C1[0]),b=MX3(C0[2],C0[3],C1[1]); a=MX3(a,C1[2],C1[3]); \
      _Pragma("unroll") for(int r=4;r<16;r+=4){a=MX3(a,C0[r],C0[r+1]);b=MX3(b,C0[r+2],C0[r+3]);a=MX3(a,C1[r],C1[r+1]);b=MX3(b,C1[r+2],C1[r+3]);} \
      float rm=__builtin_fmaxf(a,b); { auto rr=__builtin_amdgcn_permlane32_swap(__float_as_uint(rm),__float_as_uint(rm),false,false); rm=__builtin_fmaxf(__uint_as_float(rr[0]),__uint_as_float(rr[1])); } \
      resc=false; \
      if(__builtin_expect(__any(rm-mhat>(float)THRL),0)){ const float dl=__builtin_fmaxf(rm-mhat,0.f); mhat+=dl; \
        const float f=__builtin_amdgcn_exp2f(-dl); l_reg*=f; if(hi==0)wsf[r32]=f; resc=true; } } \
    __builtin_amdgcn_s_setprio(1); SBAR(); \
    GAPP(MFO(0,PI0,vA),C0,0, PO0,0, VRDL(vB,0,1);VRDH(vB,0,1)); \
    GAPP(MFO(1,PI0,vA),C0,2, PO0,1, VRDL(vB,1,1);VRDH(vB,1,1)); \
    GAPP(MFO(2,PI0,vA),C0,4, PO0,2, VRDL(vB,2,1);VRDH(vB,2,1)); \
    GAPP(MFO(3,PI0,vA),C0,6, PO0,3, VRDL(vB,3,1);VRDH(vB,3,1)); \
    GAPP(MFO(0,PI1,vB),C0,8, PO1,0, VRDL(vA,0,2);VRDH(vA,0,2)); \
    GAPP(MFO(1,PI1,vB),C0,10,PO1,1, VRDL(vA,1,2);VRDH(vA,1,2)); \
    GAPP(MFO(2,PI1,vB),C0,12,PO1,2, VRDL(vA,2,2);VRDH(vA,2,2)); \
    GAPP(MFO(3,PI1,vB),C0,14,PO1,3, VRDL(vA,3,2);VRDH(vA,3,2)); \
    GAPP(MFO(0,PI2,vA),C1,0, PO2,0, VRDL(vB,0,3);VRDH(vB,0,3)); \
    GAPP(MFO(1,PI2,vA),C1,2, PO2,1, VRDL(vB,1,3);VRDH(vB,1,3)); \
    GAPP(MFO(2,PI2,vA),C1,4, PO2,2, VRDL(vB,2,3);VRDH(vB,2,3)); \
    GAPP(MFO(3,PI2,vA),C1,6, PO2,3, VRDL(vB,3,3);VRDH(vB,3,3)); \
    GAPP(MFO(0,PI3,vB),C1,8, PO3,0, KRD(GL,0)); \
    GAPP(MFO(1,PI3,vB),C1,10,PO3,1, KRD(GL,1)); \
    GAPP(MFO(2,PI3,vB),C1,12,PO3,2, KRD(GL,2)); \
    GAPP(MFO(3,PI3,vB),C1,14,PO3,3, KRD(GL,3)); \
    __builtin_amdgcn_s_setprio(0); l_reg+=sacc; \
    }while(0)
  #define ENDW(tt) do{ if((tt)+3<NT){WAIT_BAR(3);} else if((tt)+2<NT){WAIT_BAR(2);} else {WAIT_BAR(0);} }while(0)
  int t=1;
  for(;t+5<NT;t+=2){
    STEP2(t,  pwA0,pwA1,pwA2,pwA3,pwB0,pwB1,pwB2,pwB3,true,true,true); WAIT_BAR(3); RESC(); ROT();
    STEP2(t+1,pwB0,pwB1,pwB2,pwB3,pwA0,pwA1,pwA2,pwA3,true,true,true); WAIT_BAR(3); RESC(); ROT();
  }
  for(;t+1<NT;t+=2){
    STEP2(t,  pwA0,pwA1,pwA2,pwA3,pwB0,pwB1,pwB2,pwB3,(t+3<NT),(t+1<NT),(t+1<NT)); ENDW(t);   RESC(); ROT();
    STEP2(t+1,pwB0,pwB1,pwB2,pwB3,pwA0,pwA1,pwA2,pwA3,(t+4<NT),(t+2<NT),(t+2<NT)); ENDW(t+1); RESC(); ROT();
  }
  STEP2(NT-1,pwA0,pwA1,pwA2,pwA3,pwB0,pwB1,pwB2,pwB3,false,false,false); RESC();
  { const lds_cptr vp_=vp0+2*sl_cur;
    #pragma unroll
    for(int ks=0;ks<4;++ks){
      #pragma unroll
      for(int d=0;d<4;++d){ const s16x4 lo=vtr(vp_+(d*4096+ks*1024)),hh=vtr(vp_+(d*4096+ks*1024+512)); const bf16x8 vf=(bf16x8){lo[0],lo[1],lo[2],lo[3],hh[0],hh[1],hh[2],hh[3]};
        const u32x4 pw=(ks==0)?pwB0:(ks==1)?pwB1:(ks==2)?pwB2:pwB3;
        o[d]=__builtin_amdgcn_mfma_f32_32x32x16_bf16(PAFX(pw),vf,o[d],0,0,0); } } }
  {auto rr=__builtin_amdgcn_permlane32_swap(__float_as_uint(l_reg),__float_as_uint(l_reg),false,false);l_reg=__uint_as_float(rr[0])+__uint_as_float(rr[1]);}
  if(hi==0)wsf[32+r32]=l_reg;asm volatile("s_waitcnt lgkmcnt(0)":::"memory");
  float rli[16];
  #pragma unroll
  for(int r=0;r<16;++r)rli[r]=__builtin_amdgcn_rcpf(wsf[32+crow(r,hi)]);
  unsigned short*stash=(unsigned short*)(shm+L2_ST)+wid*4096;
  if(m==0){
    #pragma unroll
    for(int d0=0;d0<4;++d0){
      #pragma unroll
      for(int r=0;r<16;++r)stash[(d0*16+r)*64+lane]=(unsigned short)f2bf(o[d0][r]*rli[r]);}
    asm volatile("s_waitcnt lgkmcnt(0)":::"memory");
  } else {
    float ss[16];
    #pragma unroll
    for(int r=0;r<16;++r)ss[r]=0.f;
    #pragma unroll
    for(int d0=0;d0<4;++d0){
      #pragma unroll
      for(int r=0;r<16;++r){ const float o1=bf2f(stash[(d0*16+r)*64+lane]); const float df=o1-lam*(o[d0][r]*rli[r]); o[d0][r]=df; ss[r]+=df*df; } }
    #pragma unroll
    for(int r=0;r<16;++r){ float q=ss[r];
      #pragma unroll
      for(int s_=1;s_<32;s_<<=1)q+=__shfl_xor(q,s_);
      ss[r]=(1.f-LAMBDA_INIT0)/sqrtf(q*(1.f/128.f)+LN_EPS); }
    asm volatile("s_waitcnt lgkmcnt(0)":::"memory");
    unsigned char*stg=(unsigned char*)stash;
    #pragma unroll
    for(int d0=0;d0<4;++d0){ const float sgv=subln[d0*32+r32];
      #pragma unroll
      for(int r=0;r<16;++r){ const int w8=__builtin_amdgcn_cvt_pk_fp8_f32(o[d0][r]*ss[r]*sgv,0.f,0,false); stg[crow(r,hi)*128+d0*32+r32]=(unsigned char)(w8&0xff); } }
    asm volatile("s_waitcnt lgkmcnt(0)":::"memory");
    unsigned char*Aw=A2+(qrow0+wid*QBLK)*DM+acol;
    #pragma unroll
    for(int i=0;i<4;++i){const int row=i*8+(lane>>3),ch=lane&7; const u32x4 v=*(const u32x4*)(stg+row*128+ch*16); *(u32x4*)(Aw+(long)row*DM+ch*16)=v;}
    asm volatile("s_waitcnt lgkmcnt(0)":::"memory");
  }
  asm volatile("s_waitcnt lgkmcnt(0)\n\ts_barrier":::"memory");
  #undef KVROW
  #undef DMA_K
  #undef DMA_V
  #undef START
  #undef RESC
  #undef ROT
  #undef PKW
  #undef PAFX
  #undef VF
  #undef PIN
  #undef MX3
  #undef EX
  #undef VRDL
  #undef VRDH
  #undef GAPP
  #undef MFQ
  #undef MFO
  #undef KRD
  #undef STEP2
  #undef ENDW
}
#undef SBAR
#undef WAIT_BAR
}
__device__ __forceinline__ void phase_attn2(const Frame& F, const Prm& p) {
    const bf16* Q = (const bf16*)(p.ws + WS_Q); const bf16* K = (const bf16*)(p.ws + WS_K); const bf16* V = (const bf16*)(p.ws + WS_V); unsigned char* A2 = p.ws + WS_O1;
    const float lam = ((const float*)(p.ws + WS_MISC))[0];
    for (int v = vcu_of(F); v < 256; v += F.G) {
        const int b = v >> 5, h = (v >> 2) & 7, part = v & 3;
        const long kctx = NLAT + b * CTXL, klat = (long)b * SEQ;
        const int nu = part ? 4 : 5;
        for (int i = 0; i < nu; ++i) {
            const long qrow0 = i < 4 ? klat + (part * 4 + i) * 256 : kctx; const int NT = i < 4 ? 68 : 4;
            for (int m = 0; m < 2; ++m)
                attn_body::attn_unit2<8>(qrow0, (2 * h + m) * 64, h * 128, kctx, klat, NT, Q, K, V, m, lam, p.subln, A2, h * 128, (char*)F.lds);
        }
    }
}
namespace gla3 {
typedef short bf16x8 __attribute__((ext_vector_type(8)));
typedef short s16x4 __attribute__((ext_vector_type(4)));
typedef float f32x16 __attribute__((ext_vector_type(16)));
constexpr int CH = 64 * 16 + 64;
constexpr int L_QS = 0, L_KS = 16 * CH, L_VS = 32 * CH, L_SB = 40 * CH, L_X = 56 * CH, L_DEC = L_X + 16384, L_END = L_DEC + 512;
__device__ __forceinline__ int crow(int i, int hh) { return (i & 3) + 8 * (i >> 2) + 4 * hh; }
typedef float f32x2_t __attribute__((ext_vector_type(2))); typedef __bf16 bf16x2_t __attribute__((ext_vector_type(2)));
__device__ __forceinline__ unsigned pk(float lo, float hi) { f32x2_t v = {lo, hi}; bf16x2_t b = __builtin_convertvector(v, bf16x2_t); return __builtin_bit_cast(unsigned, b); }
typedef short v4i16_t __attribute__((ext_vector_type(4)));
__device__ __forceinline__ s16x4 trrd(LAS const unsigned char* p) { return __builtin_bit_cast(s16x4, __builtin_amdgcn_ds_read_tr16_b64_v4i16((LAS v4i16_t*)p)); }
#define GLA_FR(lo, hi) (bf16x8){lo[0], lo[1], lo[2], lo[3], hi[0], hi[1], hi[2], hi[3]}

__device__ __forceinline__ void scan_unit(const Frame& F, const Prm& p, int unit) {
    const int dvs = unit & 3, dir = (unit >> 2) & 1, h = (unit >> 3) & 3, b = unit >> 5;
    LAS unsigned char* lds = (LAS unsigned char*)F.lds;
    const int lane = F.lane, w = F.wave, tid = F.tid, r = lane & 31, hh = lane >> 5;
    const bf16* QT = (const bf16*)(p.ws + WS_QT) + (size_t)dir * NTOK * 512 + h * 128;
    const bf16* KT = (const bf16*)(p.ws + WS_KT) + (size_t)dir * NTOK * 512 + h * 128;
    const bf16* V = (const bf16*)(p.ws + WS_V1) + h * 256 + dvs * 64;
    const float* DEC = (const float*)(p.ws + WS_DEC) + (size_t)dir * NCHUNK * 512 + h * 128;
    bf16* OG = (bf16*)((unsigned char*)p.out + (dir ? OUT_OGB : 0)) + h * 256 + dvs * 64;
    const int g1 = (lane >> 4) & 1, q4 = (lane & 15) >> 2, p4 = lane & 3;
    const int trb = (2 * g1 + (p4 >> 1)) * CH + q4 * 16 + 8 * (p4 & 1);
    const int trN = trb + 128 * hh, trP = trb + 64 * hh;
    f32x16 S0 = {}, S1 = {};
    for (int i = tid; i < 16 * CH / 16; i += NTHR) *(LAS u32x4*)(lds + L_SB + i * 16) = (u32x4){0u, 0u, 0u, 0u};
    u32x4 pq0[2], pq1[2], pk0[2], pk1[2], pv[2]; float pdec[2] = {0.f, 0.f};
#define GLA_CHUNK(step) ((step) >= 4 ? b * 64 + (dir ? 63 - ((step) - 4) : (step) - 4) : 512 + b * 4 + (dir ? 3 - (step) : (step)))
    const int qrow = 8 * w + (lane >> 4), qch = lane & 15, vrow = 8 * w + (lane >> 3), vch = lane & 7;
#define GLA_LOAD(step, u) do { const size_t t0_ = (size_t)GLA_CHUNK(step) * 64; \
        pq0[u] = *(const u32x4*)(QT + (t0_ + qrow) * 512 + 8 * qch); pq1[u] = *(const u32x4*)(QT + (t0_ + qrow + 4) * 512 + 8 * qch); \
        pk0[u] = *(const u32x4*)(KT + (t0_ + qrow) * 512 + 8 * qch); pk1[u] = *(const u32x4*)(KT + (t0_ + qrow + 4) * 512 + 8 * qch); \
        pv[u] = *(const u32x4*)(V + (t0_ + vrow) * 1024 + 8 * vch); if (tid < 128) pdec[u] = DEC[(size_t)GLA_CHUNK(step) * 512 + tid]; } while (0)
#define GLA_STORE(u) do { \
        *(LAS u32x4*)(lds + L_QS + qch * CH + qrow * 16) = pq0[u]; *(LAS u32x4*)(lds + L_QS + qch * CH + (qrow + 4) * 16) = pq1[u]; \
        *(LAS u32x4*)(lds + L_KS + qch * CH + qrow * 16) = pk0[u]; *(LAS u32x4*)(lds + L_KS + qch * CH + (qrow + 4) * 16) = pk1[u]; \
        *(LAS u32x4*)(lds + L_VS + vch * CH + vrow * 16) = pv[u]; \
        if (tid < 128) *(LAS float*)(lds + L_DEC + 4 * tid) = pdec[u]; } while (0)
    GLA_LOAD(0, 0);
    GLA_LOAD(1, 1);
    GLA_STORE(0);
    __syncthreads();
    const int tb = (w & 3) >> 1, vb = w & 1;
    for (int sp2 = 0; sp2 < 34; ++sp2) {
#pragma unroll
    for (int u = 0; u < 2; ++u) {
        const int step = 2 * sp2 + u;
        const bool lat = step >= 4; const int chunk = GLA_CHUNK(step);
        if (step + 2 < 68) GLA_LOAD(step + 2, u);
        f32x16 o = {};
        if (w < 4) {
            if (lat) {
                const bool n0 = dir ? (tb == 0) : true, n1 = dir ? true : (tb == 1);
                f32x16 sc0 = {}, sc1 = {};
#define GLA_BQ(ks) (*(const LAS bf16x8*)(lds + L_QS + (2 * (ks) + hh) * CH + (32 * tb + r) * 16))
#define GLA_A0(ks) (*(const LAS bf16x8*)(lds + L_KS + (2 * (ks) + hh) * CH + r * 16))
#define GLA_A1(ks) (*(const LAS bf16x8*)(lds + L_KS + (2 * (ks) + hh) * CH + (32 + r) * 16))
                if (n0 && n1) {
#pragma unroll
                    for (int ks = 0; ks < 8; ++ks) { const bf16x8 bq = GLA_BQ(ks); sc0 = __builtin_amdgcn_mfma_f32_32x32x16_bf16(GLA_A0(ks), bq, sc0, 0, 0, 0); sc1 = __builtin_amdgcn_mfma_f32_32x32x16_bf16(GLA_A1(ks), bq, sc1, 0, 0, 0); }
                } else if (n0) {
#pragma unroll
                    for (int ks = 0; ks < 8; ++ks) sc0 = __builtin_amdgcn_mfma_f32_32x32x16_bf16(GLA_A0(ks), GLA_BQ(ks), sc0, 0, 0, 0);
                } else {
#pragma unroll
                    for (int ks = 0; ks < 8; ++ks) sc1 = __builtin_amdgcn_mfma_f32_32x32x16_bf16(GLA_A1(ks), GLA_BQ(ks), sc1, 0, 0, 0);
                }
#undef GLA_BQ
#undef GLA_A0
#undef GLA_A1
                const int t = 32 * tb + r;
#pragma unroll
                for (int i = 0; i < 16; ++i) { const int s0 = crow(i, hh), s1 = 32 + s0; const bool k0 = dir ? (s0 >= t) : (s0 <= t), k1 = dir ? (s1 >= t) : (s1 <= t); sc0[i] = k0 ? sc0[i] : 0.f; sc1[i] = k1 ? sc1[i] : 0.f; }
#pragma unroll
                for (int sb = 0; sb < 2; ++sb) { if (sb == 0 ? n0 : n1) {
#pragma unroll
                    for (int sp = 0; sp < 2; ++sp) {
                        u32x4 pw;
                        if (sb == 0) { pw.x = pk(sc0[8 * sp + 0], sc0[8 * sp + 1]); pw.y = pk(sc0[8 * sp + 2], sc0[8 * sp + 3]); pw.z = pk(sc0[8 * sp + 4], sc0[8 * sp + 5]); pw.w = pk(sc0[8 * sp + 6], sc0[8 * sp + 7]); }
                        else { pw.x = pk(sc1[8 * sp + 0], sc1[8 * sp + 1]); pw.y = pk(sc1[8 * sp + 2], sc1[8 * sp + 3]); pw.z = pk(sc1[8 * sp + 4], sc1[8 * sp + 5]); pw.w = pk(sc1[8 * sp + 6], sc1[8 * sp + 7]); }
                        LAS const unsigned char* vp = lds + L_VS + trP + (4 * vb) * CH + (32 * sb + 16 * sp) * 16;
                        const s16x4 lo = trrd(vp), hi = trrd(vp + 8 * 16);
                        o = __builtin_amdgcn_mfma_f32_32x32x16_bf16(GLA_FR(lo, hi), __builtin_bit_cast(bf16x8, pw), o, 0, 0, 0);
                    } } }
            }
        } else {
            const int db = w - 4;
            if (lat) {
                f32x16 o2 = {};
#pragma unroll
                for (int ks = 0; ks < 8; ++ks) {
                    const bf16x8 as = *(const LAS bf16x8*)(lds + L_SB + (2 * ks + hh) * CH + (32 * vb + r) * 16);
                    const bf16x8 bq = *(const LAS bf16x8*)(lds + L_QS + (2 * ks + hh) * CH + (32 * tb + r) * 16);
                    o2 = __builtin_amdgcn_mfma_f32_32x32x16_bf16(as, bq, o2, 0, 0, 0);
                }
#pragma unroll
                for (int g = 0; g < 4; ++g) *(LAS f32x4*)(lds + L_X + (w & 3) * 4096 + g * 1024 + lane * 16) = (f32x4){o2[4 * g], o2[4 * g + 1], o2[4 * g + 2], o2[4 * g + 3]};
            }
#pragma unroll
            for (int ks = 0; ks < 4; ++ks) {
                LAS const unsigned char* kp = lds + L_KS + trN + (4 * db) * CH + (16 * ks) * 16;
                LAS const unsigned char* vp = lds + L_VS + trN + (16 * ks) * 16;
                const s16x4 al = trrd(kp), ah = trrd(kp + 4 * 16);
                const s16x4 b0l = trrd(vp), b0h = trrd(vp + 4 * 16), b1l = trrd(vp + 4 * CH), b1h = trrd(vp + 4 * CH + 4 * 16);
                S0 = __builtin_amdgcn_mfma_f32_32x32x16_bf16(GLA_FR(al, ah), GLA_FR(b0l, b0h), S0, 0, 0, 0); S1 = __builtin_amdgcn_mfma_f32_32x32x16_bf16(GLA_FR(al, ah), GLA_FR(b1l, b1h), S1, 0, 0, 0);
            }
#pragma unroll
            for (int i = 0; i < 16; ++i) { const float dc = *(const LAS float*)(lds + L_DEC + 4 * (32 * db + crow(i, hh))); S0[i] *= dc; S1[i] *= dc; }
        }
        __syncthreads();
        if (w < 4 && lat) {
            bf16* orow = OG + ((size_t)chunk * 64 + 32 * tb + r) * DM + 32 * vb + 4 * hh;
#pragma unroll
            for (int g = 0; g < 4; ++g) { const f32x4 x = *(const LAS f32x4*)(lds + L_X + w * 4096 + g * 1024 + lane * 16);
                u32x2 wv; wv.x = pk(o[4 * g] + x.x, o[4 * g + 1] + x.y); wv.y = pk(o[4 * g + 2] + x.z, o[4 * g + 3] + x.w); *(u32x2*)(orow + 8 * g) = wv; }
        }
        if (step + 1 < 68) {
            GLA_STORE(u ^ 1);
            if (w >= 4) { const int db = w - 4;
#pragma unroll
                for (int g = 0; g < 4; ++g) { u32x2 w0, w1; w0.x = pk(S0[4 * g], S0[4 * g + 1]); w0.y = pk(S0[4 * g + 2], S0[4 * g + 3]); w1.x = pk(S1[4 * g], S1[4 * g + 1]); w1.y = pk(S1[4 * g + 2], S1[4 * g + 3]);
                    *(LAS u32x2*)(lds + L_SB + (4 * db + g) * CH + r * 16 + 8 * hh) = w0; *(LAS u32x2*)(lds + L_SB + (4 * db + g) * CH + (32 + r) * 16 + 8 * hh) = w1; } }
        }
        __syncthreads();
    }
    }
#undef GLA_CHUNK
#undef GLA_LOAD
#undef GLA_STORE
}
#undef GLA_FR
}
__device__ __forceinline__ void phase_scan_opt(const Frame& F, const Prm& p) {
    for (int unit = vcu_of(F); unit < 256; unit += F.G) gla3::scan_unit(F, p, unit);
}
#define PHASE_QKV(F, p) phase_qkv_opt(F, p)
#define PHASE_ATTN(F, p) phase_attn2(F, p)
#define PHASE_WO(F, p, l) phase_wo_opt(F, p, l)
#define PHASE_MOE1(F, p, l) phase_moe1_opt(F, p, l)
#define PHASE_MOE2(F, p, l) phase_moe2_opt(F, p, l)
#define PHASE_INPROJ(F, p) phase_inproj_opt(F, p)
#define PHASE_SCAN(F, p) phase_scan_opt(F, p)
typedef GAS unsigned gu32;
#define XB_TMO      128
#define XB_XCNT(j)  (256  + 64 * (j))
#define XB_XSUB(j)  (1280 + 64 * (j))
#define XB_XGEN(j)  (2304 + 64 * (j))
#define XB_TOP      3328
#define XB_TOPGEN   3392
#define XCD_BAR_WORDS 3456
#define XB_SPIN_CAP (1u << 20)
__device__ __forceinline__ unsigned xb_ld(unsigned* p)              { return __hip_atomic_load(p, __ATOMIC_RELAXED, __HIP_MEMORY_SCOPE_AGENT); }
__device__ __forceinline__ unsigned xb_add(unsigned* p, unsigned v) { return __hip_atomic_fetch_add(p, v, __ATOMIC_RELAXED, __HIP_MEMORY_SCOPE_AGENT); }
__device__ __forceinline__ unsigned xb_xcc_id() { return (unsigned)__builtin_amdgcn_s_getreg((3 << 11) | 20) & 0xFu; }
#define XB_SPIN(cond, bar) do { unsigned _sp = 0; while (cond) { __builtin_amdgcn_s_sleep(1); \
    if ((++_sp & 255u) == 0u) { if (xb_ld(&(bar)[XB_TMO])) break; if (_sp > XB_SPIN_CAP) { atomicAdd(&(bar)[XB_TMO], 1u); break; } } } } while (0)
struct XcdBarrier { unsigned* bar; unsigned x; volatile LAS unsigned* st; };
__device__ __forceinline__ XcdBarrier xcd_barrier_post(unsigned* bar, volatile LAS unsigned* st) {
    XcdBarrier b; b.bar = bar; b.x = xb_xcc_id(); b.st = st;
    if (threadIdx.x == 0) (void)xb_add(&bar[XB_XCNT(b.x)], 1u);
    return b;
}
__device__ __forceinline__ void xcd_barrier_complete(unsigned* bar, unsigned x, unsigned& nloc, unsigned& nx) {
    const unsigned G = gridDim.x * gridDim.y * gridDim.z;
    unsigned sum, cnt, mine, sp = 0u;
    for (;;) {
        sum = 0u; cnt = 0u; mine = 0u;
#pragma unroll
        for (unsigned j = 0; j < 16; ++j) { const unsigned c = xb_ld(&bar[XB_XCNT(j)]); sum += c; cnt += (c > 0u) ? 1u : 0u; mine = (j == x) ? c : mine; }
        if (sum == G) break;
        __builtin_amdgcn_s_sleep(1);
        if ((++sp & 255u) == 0u) { if (xb_ld(&bar[XB_TMO])) break; if (sp > XB_SPIN_CAP) { atomicAdd(&bar[XB_TMO], 1u); break; } }
    }
    nloc = mine > 0u ? mine : 1u; nx = cnt > 0u ? cnt : 1u;
}
__device__ __forceinline__ void xcd_barrier(const XcdBarrier& b) {
    asm volatile("s_waitcnt vmcnt(0)" ::: "memory");
    __syncthreads();
    if (threadIdx.x == 0) {
        unsigned* bar = b.bar;
        __builtin_amdgcn_s_waitcnt(0);
        unsigned nloc = b.st[0], nx = b.st[1];
        if (nloc == 0u) { xcd_barrier_complete(bar, b.x, nloc, nx); b.st[0] = nloc; b.st[1] = nx; }
        const unsigned old = xb_add(&bar[XB_XSUB(b.x)], 1u);
        const unsigned gen = old / nloc;
        if (old + 1u == (gen + 1u) * nloc) {
            __builtin_amdgcn_fence(__ATOMIC_RELEASE, "agent");
            asm volatile("s_waitcnt vmcnt(0)" ::: "memory");
            const unsigned og = xb_add(&bar[XB_TOP], 1u);
            const unsigned tg = og / nx;
            if (og + 1u == (tg + 1u) * nx) xb_add(&bar[XB_TOPGEN], 1u);
            else XB_SPIN(xb_ld(&bar[XB_TOPGEN]) == tg, bar);
            __builtin_amdgcn_fence(__ATOMIC_ACQUIRE, "agent");
            xb_add(&bar[XB_XGEN(b.x)], 1u);
            asm volatile("s_waitcnt vmcnt(0)" ::: "memory");
        } else {
            XB_SPIN(xb_ld(&bar[XB_XGEN(b.x)]) == gen, bar);
            __builtin_amdgcn_fence(__ATOMIC_ACQUIRE, "agent");
            asm volatile("s_waitcnt vmcnt(0)" ::: "memory");
        }
    }
    __syncthreads();
}

constexpr int NPHASE = 19;
#ifndef OPT_MASK
#define OPT_MASK 0u
#endif
__global__ void __launch_bounds__(NTHR, 2) mega_fwd(Prm p) {
    extern __shared__ __attribute__((aligned(16))) unsigned char lds[];
    Frame F; F.lds = lds; F.ctl = (unsigned*)(p.ws + WS_CTL);
    F.tid = threadIdx.x; F.lane = F.tid & 63; F.wave = __builtin_amdgcn_readfirstlane(F.tid >> 6); F.G = gridDim.x; F.bid = blockIdx.x;
    for (int u = F.tid; u < (LDS_BYTES - LDSCTL_OFF) / 4; u += NTHR) ((LAS unsigned*)(lds + LDSCTL_OFF))[u] = 0u;
    __syncthreads();
    const int lo = p.ph_lo, hi = p.ph_hi;
    const bool multi = (hi - lo) > 1;
    XcdBarrier bar; bar.bar = F.ctl + CW_BAR + p.li * XCD_BAR_WORDS; bar.x = 0; bar.st = nullptr;
    if (multi) bar = xcd_barrier_post(F.ctl + CW_BAR + p.li * XCD_BAR_WORDS, (volatile LAS unsigned*)(lds + MISC_OFF) + 8);
#define IN(k) (lo <= (k) && (k) < hi)
#define SEAM(k) do { if (IN(k) && IN((k) + 1)) xcd_barrier(bar); } while (0)
#ifndef REP_MASK
#define REP_MASK 0u
#endif
#define REP(k, call) do { if (((REP_MASK) >> (k)) & 1u) { xcd_barrier(bar); call; } } while (0)
    if (IN(0)) { phase_prologue(F, p); REP(0, phase_prologue(F, p)); } SEAM(0);
    if (IN(1)) { phase_modulate0(F, p); REP(1, phase_modulate0(F, p)); } SEAM(1);
    if (IN(2)) { PHASE_QKV(F, p); REP(2, PHASE_QKV(F, p)); } SEAM(2);
    if (IN(3)) { PHASE_ATTN(F, p); REP(3, PHASE_ATTN(F, p)); } SEAM(3);
    if (IN(5)) { PHASE_WO(F, p, 0); REP(5, PHASE_WO(F, p, 0)); } SEAM(5);
    if (IN(6)) { phase_ln_route(F, p, 0); REP(6, phase_ln_route(F, p, 0)); } SEAM(6);
    if (IN(7)) { PHASE_MOE1(F, p, 0); REP(7, PHASE_MOE1(F, p, 0)); } SEAM(7);
    if (IN(8)) { PHASE_MOE2(F, p, 0); REP(8, PHASE_MOE2(F, p, 0)); } SEAM(8);
    if (IN(9)) { phase_moe_combine(F, p, 0); REP(9, phase_moe_combine(F, p, 0)); } SEAM(9);
    if (IN(10)) { PHASE_INPROJ(F, p); REP(10, PHASE_INPROJ(F, p)); } SEAM(10);
    if (IN(11)) { phase_gla_prep(F, p); REP(11, phase_gla_prep(F, p)); } SEAM(11);
    if (IN(12)) { PHASE_SCAN(F, p); REP(12, PHASE_SCAN(F, p)); } SEAM(12);
    if (IN(13)) { phase_gla_post(F, p); REP(13, phase_gla_post(F, p)); } SEAM(13);
    if (IN(14)) { PHASE_WO(F, p, 1); REP(14, PHASE_WO(F, p, 1)); } SEAM(14);
    if (IN(15)) { phase_ln_route(F, p, 1); REP(15, phase_ln_route(F, p, 1)); } SEAM(15);
    if (IN(16)) { PHASE_MOE1(F, p, 1); REP(16, PHASE_MOE1(F, p, 1)); } SEAM(16);
    if (IN(17)) { PHASE_MOE2(F, p, 1); REP(17, PHASE_MOE2(F, p, 1)); } SEAM(17);
    if (IN(18)) { phase_moe_combine(F, p, 1); REP(18, phase_moe_combine(F, p, 1)); }
#undef IN
#undef SEAM
}

extern "C" void kernel_launch(void* const* d_in, const int* in_sizes, int n_in, void* d_out, int out_size, void* d_ws, size_t ws_size, hipStream_t stream) {
    static int grid = 0;
    if (grid == 0) {
        if (n_in != 23 || in_sizes[0] != NLAT * DM || out_size != NLAT * DM || ws_size < WS_END) { fprintf(stderr, "kernel_launch: unexpected shapes (n_in %d, in0 %d, out %d, ws %zu); nothing launched\n", n_in, n_in > 0 ? in_sizes[0] : -1, out_size, ws_size); grid = -1; return; }
        int dev = 0, cus = 0;
        if (hipGetDevice(&dev) != hipSuccess || hipDeviceGetAttribute(&cus, hipDeviceAttributeMultiprocessorCount, dev) != hipSuccess) { grid = -1; return; }
        if (hipFuncSetAttribute((const void*)mega_fwd, hipFuncAttributeMaxDynamicSharedMemorySize, LDS_BYTES) != hipSuccess) { fprintf(stderr, "kernel_launch: hipFuncSetAttribute failed\n"); grid = -1; return; }
        int per_cu = 0;
        if (hipOccupancyMaxActiveBlocksPerMultiprocessor(&per_cu, (const void*)mega_fwd, NTHR, LDS_BYTES) != hipSuccess || per_cu < 1) fprintf(stderr, "kernel_launch: note: occupancy query reports %d\n", per_cu);
        (void)hipGetLastError();
        grid = cus;
    }
    if (grid < 0) return;
    (void)hipMemsetAsync((char*)d_ws + WS_CTL, 0, CTL_ZERO_BYTES, stream);
    Prm p{};
    const float** pp = (const float**)&p;
    for (int i = 0; i < 23; ++i) pp[i] = (const float*)d_in[i];
    p.out = (float*)d_out; p.ws = (unsigned char*)d_ws;
    p.ph_lo = 0; p.ph_hi = NPHASE; p.li = 0;
    hipLaunchKernelGGL(mega_fwd, dim3(grid), dim3(NTHR), LDS_BYTES, stream, p);
}
```

```cpp
#define OPT_MASK 0x355ACu
#include <hip/hip_runtime.h>
#include <cstdint>
#include <cstdio>

constexpr int BATCH = 8, SEQ = 4096, DM = 1024, CTXL = 256;
constexpr int NLAT = BATCH * SEQ, NCTX = BATCH * CTXL, NTOK = NLAT + NCTX;
constexpr float ALPHA = 1.4142135623730951f;
constexpr float LN_EPS = 1e-5f;
constexpr float LAMBDA_INIT0 = 0.2f;
constexpr float C2 = 0.125f * 1.4426950408889634f;
constexpr int NEXP = 16, DEXP = 512, MAXSLOT = 73728;
constexpr int NCHUNK = NTOK / 64;
constexpr int NIN = 3328;

typedef unsigned short bf16;
typedef float f32x4 __attribute__((ext_vector_type(4)));
typedef float f32x2 __attribute__((ext_vector_type(2)));
typedef unsigned u32x2 __attribute__((ext_vector_type(2)));
typedef unsigned u32x4 __attribute__((ext_vector_type(4)));

constexpr size_t MiB = 1u << 20;
constexpr size_t WS_CTL = 0, CTL_ZERO_BYTES = 1 * MiB;
constexpr size_t WS_MOD = 1 * MiB;
constexpr size_t WS_MISC = 1 * MiB + 512 * 1024;
constexpr size_t WS_WQKV = 2 * MiB, WS_WO = 5 * MiB, WS_GU0 = 6 * MiB, WS_DN0 = 22 * MiB, WS_WIN = 30 * MiB, WS_WGO = 34 * MiB, WS_GU1 = 35 * MiB, WS_DN1 = 51 * MiB;
constexpr size_t WS_XB = 59 * MiB;
constexpr size_t WS_H = 127 * MiB;
constexpr size_t WS_Q = 195 * MiB, WS_K = 263 * MiB, WS_V = 331 * MiB, WS_O2 = 399 * MiB;
constexpr size_t WS_LIST = 467 * MiB;
constexpr size_t WS_TOKR = 470 * MiB;
constexpr size_t WS_DEC = 472 * MiB;
constexpr size_t WS_ZZ = 475 * MiB;
constexpr size_t WS_END = 480 * MiB;
constexpr size_t WS_O1 = WS_H, WS_A2 = WS_H, WS_Y = WS_K;
constexpr size_t WS_YM = 195 * MiB, WS_ACT = 339 * MiB;
constexpr size_t WS_QR = 195 * MiB, WS_KR = 229 * MiB, WS_V1 = 263 * MiB, WS_R = 331 * MiB;
constexpr size_t WS_QT = WS_H, WS_KT = 399 * MiB;
constexpr size_t WS_A2B = WS_H;
constexpr size_t OUT_OGB = 64 * MiB;
constexpr int CW_TMO = 0, CW_CODE = 1;
constexpr int CW_CNT = 64;
constexpr int CW_KM = 128;
constexpr int CW_BAR = 4096;

__device__ __forceinline__ unsigned f2bf(float f) { unsigned u = __builtin_bit_cast(unsigned, f); return (u + 0x7fffu + ((u >> 16) & 1u)) >> 16; }
__device__ __forceinline__ unsigned pk2(float lo, float hi) { return f2bf(lo) | (f2bf(hi) << 16); }
__device__ __forceinline__ float bf2f(unsigned b) { return __builtin_bit_cast(float, b << 16); }
__device__ __forceinline__ float wave_sum(float v) {
#pragma unroll
    for (int o = 1; o < 64; o <<= 1) v += __shfl_xor(v, o);
    return v;
}
__device__ __forceinline__ float silu_f(float v) { return v / (1.f + __expf(-v)); }

struct Prm {
    const float *x, *c, *ctx, *cctx, *ada_w, *ada_b, *ln_g, *ln_b, *w_qkv, *w_o, *lam, *subln, *gw_in, *gwg_down, *gwg_up, *gbg, *gnorm, *gw_o, *rw, *rb, *mg, *mu, *md;
    float* out; unsigned char* ws;
    int ph_lo, ph_hi, li, pad;
};
__device__ __forceinline__ void ld_row_f32(const float* p, int lane, f32x4 (&v)[4]) {
#pragma unroll
    for (int j = 0; j < 4; ++j) v[j] = *(const f32x4*)(p + 4 * lane + 256 * j);
}
__device__ __forceinline__ void st_row_f32(float* p, int lane, const f32x4 (&v)[4]) {
#pragma unroll
    for (int j = 0; j < 4; ++j) *(f32x4*)(p + 4 * lane + 256 * j) = v[j];
}
__device__ __forceinline__ void ld_row_bf16(const bf16* p, int lane, f32x4 (&v)[4]) {
#pragma unroll
    for (int j = 0; j < 4; ++j) { const u32x2 u = *(const u32x2*)(p + 4 * lane + 256 * j); v[j] = (f32x4){bf2f(u.x & 0xffffu), bf2f(u.x >> 16), bf2f(u.y & 0xffffu), bf2f(u.y >> 16)}; }
}
__device__ __forceinline__ void st_row_bf16(bf16* p, int lane, const f32x4 (&v)[4]) {
#pragma unroll
    for (int j = 0; j < 4; ++j) { u32x2 u; u.x = pk2(v[j].x, v[j].y); u.y = pk2(v[j].z, v[j].w); *(u32x2*)(p + 4 * lane + 256 * j) = u; }
}
__device__ __forceinline__ void ln_row(f32x4 (&v)[4], const float* g, const float* b, int lane) {
    float s = 0.f;
#pragma unroll
    for (int j = 0; j < 4; ++j) s += (v[j].x + v[j].y) + (v[j].z + v[j].w);
    const float mean = wave_sum(s) * (1.f / DM); float q = 0.f;
#pragma unroll
    for (int j = 0; j < 4; ++j) { v[j] = v[j] - mean; q += (v[j].x * v[j].x + v[j].y * v[j].y) + (v[j].z * v[j].z + v[j].w * v[j].w); }
    const float rstd = 1.f / sqrtf(wave_sum(q) * (1.f / DM) + LN_EPS);
#pragma unroll
    for (int j = 0; j < 4; ++j) { const f32x4 gg = *(const f32x4*)(g + 4 * lane + 256 * j), bb = *(const f32x4*)(b + 4 * lane + 256 * j); v[j] = v[j] * rstd * gg + bb; }
}
__host__ __device__ __forceinline__ int gu_phys(int other, int sel) { return (other >> 4) * 32 + sel * 16 + (other & 15); }
__host__ __device__ __forceinline__ int perm16b(int L) { return (L & ~31) | (16 * ((L >> 2) & 1) + 4 * ((L >> 3) & 3) + (L & 3)); }
__host__ __device__ __forceinline__ int perm16b_inv(int P) { return (P & ~31) | (8 * ((P >> 2) & 3) + 4 * ((P >> 4) & 1) + (P & 3)); }
__device__ __forceinline__ unsigned pk4_fp8(float a, float b, float c, float d) { int w = 0; w = __builtin_amdgcn_cvt_pk_fp8_f32(a, b, w, false); w = __builtin_amdgcn_cvt_pk_fp8_f32(c, d, w, true); return (unsigned)w; }
constexpr float W8_SCALE = 64.f, W8_INV = 1.f / 64.f;
__device__ __forceinline__ void st_row_fp8(unsigned char* p, int lane, const f32x4 (&v)[4]) {
#pragma unroll
    for (int j = 0; j < 4; ++j) *(unsigned*)(p + 4 * lane + 256 * j) = pk4_fp8(v[j].x, v[j].y, v[j].z, v[j].w);
}
__device__ __forceinline__ void ld_row_fp8(const unsigned char* p, int lane, f32x4 (&v)[4]) {
#pragma unroll
    for (int j = 0; j < 4; ++j) { const int w = *(const int*)(p + 4 * lane + 256 * j); const f32x2 lo = __builtin_amdgcn_cvt_pk_f32_fp8(w, false), hi = __builtin_amdgcn_cvt_pk_f32_fp8(w, true); v[j] = (f32x4){lo.x, lo.y, hi.x, hi.y}; }
}
#define GAS __attribute__((address_space(1)))
#define LAS __attribute__((address_space(3)))
constexpr int NWAVES = 8, NTHR = NWAVES * 64;
constexpr int RING_BYTES = 131072, LDS_BYTES = 147456, LDSCTL_OFF = LDS_BYTES - 1024, MISC_OFF = LDSCTL_OFF + 320;
constexpr int LDSX_OFF = RING_BYTES + 1024;
#define LDS_WAIT() asm volatile("s_waitcnt lgkmcnt(0)" ::: "memory")
#define VM_WAIT() asm volatile("s_waitcnt vmcnt(0)" ::: "memory")

struct Frame {
    unsigned char* lds;
    unsigned* ctl;
    int tid, lane, wave, G, bid;
};

template <int MODE>
__device__ __forceinline__ void p0_transpose_item(const float* W, int K, int N, bf16* WT, int row_off, float* scr, int item, int lane) {
    const int nblk = N / 32, kb = item / nblk, nb = item % nblk, k0 = 64 * kb, n0 = 32 * nb;
#pragma unroll 8
    for (int i = 0; i < 32; ++i) { const int kk = 2 * i + (lane >> 5); scr[kk * 33 + (lane & 31)] = W[(size_t)(k0 + kk) * N + n0 + (lane & 31)]; }
    LDS_WAIT(); asm volatile("" ::: "memory");
    const int c = lane & 7;
#pragma unroll
    for (int j = 0; j < 4; ++j) { const int n = (lane >> 3) + 8 * j; const float* s = scr + (8 * c) * 33 + n;
        u32x4 o; o.x = pk2(s[0 * 33], s[1 * 33]); o.y = pk2(s[2 * 33], s[3 * 33]); o.z = pk2(s[4 * 33], s[5 * 33]); o.w = pk2(s[6 * 33], s[7 * 33]);
        const int nl = n0 + n; const int pr = (MODE == 0) ? (row_off + nl) : (MODE == 3) ? (row_off + perm16b(nl)) : (row_off + gu_phys(nl, MODE - 1));
        *(u32x4*)(WT + (size_t)pr * K + k0 + 8 * c) = o; }
    LDS_WAIT(); asm volatile("" ::: "memory");
}
template <int MODE>
__device__ __forceinline__ void p0_transpose_item8(const float* W, int K, int N, unsigned char* WT, float* scr, int item, int lane) {
    const int nblk = N / 32, kb = item / nblk, nb = item % nblk, k0 = 64 * kb, n0 = 32 * nb;
#pragma unroll 8
    for (int i = 0; i < 32; ++i) { const int kk = 2 * i + (lane >> 5); scr[kk * 33 + (lane & 31)] = W[(size_t)(k0 + kk) * N + n0 + (lane & 31)]; }
    LDS_WAIT(); asm volatile("" ::: "memory");
    const int c = lane & 7;
#pragma unroll
    for (int j = 0; j < 4; ++j) { const int n = (lane >> 3) + 8 * j; const float* s = scr + (8 * c) * 33 + n;
        u32x2 o; o.x = pk4_fp8(s[0 * 33] * W8_SCALE, s[1 * 33] * W8_SCALE, s[2 * 33] * W8_SCALE, s[3 * 33] * W8_SCALE); o.y = pk4_fp8(s[4 * 33] * W8_SCALE, s[5 * 33] * W8_SCALE, s[6 * 33] * W8_SCALE, s[7 * 33] * W8_SCALE);
        const int nl = n0 + n; const int pr = (MODE == 3) ? perm16b(nl) : (MODE == 0) ? nl : gu_phys(nl, MODE - 1);
        *(u32x2*)(WT + (size_t)pr * K + k0 + 8 * c) = o; }
    LDS_WAIT(); asm volatile("" ::: "memory");
}
__device__ __forceinline__ void phase_prologue(const Frame& F, const Prm& p) {
    float* sil = (float*)F.lds;
    for (int i = F.tid; i < 9 * 1024; i += NTHR) { const int r = i >> 10, k = i & 1023; const float v = (r < 8) ? p.c[r * 1024 + k] : p.cctx[k]; sil[i] = silu_f(v); }
    __syncthreads();
    float* MOD = (float*)(p.ws + WS_MOD);
    if (F.bid < 192) {
        const int layer = F.bid / 96, n = (F.bid % 96) * 64 + F.lane; const float* W = p.ada_w + (size_t)layer * 1024 * 6144 + n;
        float acc[9];
#pragma unroll
        for (int r = 0; r < 9; ++r) acc[r] = 0.f;
        const int kb = F.wave * 128;
#pragma unroll 4
        for (int k = kb; k < kb + 128; k += 4) {
            const float w0 = W[(size_t)k * 6144], w1 = W[(size_t)(k + 1) * 6144], w2 = W[(size_t)(k + 2) * 6144], w3 = W[(size_t)(k + 3) * 6144];
#pragma unroll
            for (int r = 0; r < 9; ++r) { const f32x4 s = *(const f32x4*)(sil + r * 1024 + k); acc[r] += s.x * w0 + s.y * w1 + s.z * w2 + s.w * w3; }
        }
        float* red = (float*)(F.lds + 36864 + 8 * 8704);
#pragma unroll
        for (int r = 0; r < 9; ++r) red[(F.wave * 9 + r) * 64 + F.lane] = acc[r];
        __syncthreads();
        if (F.wave == 0) { const float bb = p.ada_b[layer * 6144 + n];
#pragma unroll
            for (int r = 0; r < 9; ++r) { float t = bb;
#pragma unroll
                for (int w = 0; w < 8; ++w) t += red[(w * 9 + r) * 64 + F.lane];
                MOD[(layer * 9 + r) * 6144 + n] = t; } }
    }
    float* misc = (float*)(p.ws + WS_MISC);
    if (F.bid == 255 % F.G && F.wave == 1) {
        const float a = wave_sum(p.lam[F.lane] * p.lam[64 + F.lane]), b = wave_sum(p.lam[128 + F.lane] * p.lam[192 + F.lane]);
        if (F.lane == 0) misc[0] = __expf(a) - __expf(b) + LAMBDA_INIT0;
        for (int i = F.lane; i < 1024; i += 64) { const int pos = i >> 4, f = i & 15; const float inv = powf(10000.f, -(float)f / 16.f); const float ang = (float)pos * inv;
            misc[1024 + 2 * i] = cosf(ang); misc[1024 + 2 * i + 1] = sinf(ang); }
    }
    float* scr = (float*)(F.lds + 36864 + F.wave * 8704);
    const int gw = F.bid * NWAVES + F.wave, NGW = F.G * NWAVES;
    constexpr int I_QKV = 16 * 96, I_SQ = 16 * 32, I_G = 16 * 16, I_D = 8 * 32;
    constexpr int I_MOE = 2 * I_G + I_D;
    constexpr int NITEMS = 2 * I_QKV + 2 * I_SQ + 32 * I_MOE;
    bf16* ws16 = (bf16*)p.ws;
    for (int it = gw; it < NITEMS; it += NGW) {
        int r = it;
        if (r < I_QKV) { if ((r % 96) < 64) p0_transpose_item8<0>(p.w_qkv, 1024, 3072, p.ws + WS_WQKV, scr, r, F.lane); else p0_transpose_item8<3>(p.w_qkv, 1024, 3072, p.ws + WS_WQKV, scr, r, F.lane); continue; } r -= I_QKV;
        if (r < I_QKV) { p0_transpose_item8<3>(p.gw_in, 1024, 3072, p.ws + WS_WIN, scr, r, F.lane); continue; } r -= I_QKV;
        if (r < I_SQ) { p0_transpose_item8<3>(p.w_o, 1024, 1024, p.ws + WS_WO, scr, r, F.lane); continue; } r -= I_SQ;
        if (r < I_SQ) { p0_transpose_item8<3>(p.gw_o, 1024, 1024, p.ws + WS_WGO, scr, r, F.lane); continue; } r -= I_SQ;
        const int le = r / I_MOE, layer = le >> 4, e = le & 15; r -= le * I_MOE;
        unsigned char* GU = p.ws + (layer ? WS_GU1 : WS_GU0) + (size_t)e * 1024 * 1024; unsigned char* DN = p.ws + (layer ? WS_DN1 : WS_DN0) + (size_t)e * 1024 * 512;
        if (r < I_G) { p0_transpose_item8<1>(p.mg + (size_t)le * 1024 * 512, 1024, 512, GU, scr, r, F.lane); continue; } r -= I_G;
        if (r < I_G) { p0_transpose_item8<2>(p.mu + (size_t)le * 1024 * 512, 1024, 512, GU, scr, r, F.lane); continue; } r -= I_G;
        p0_transpose_item8<3>(p.md + (size_t)le * 512 * 1024, 512, 1024, DN, scr, r, F.lane);
    }
    (void)ws16;
    unsigned char* WIN = p.ws + WS_WIN;
    for (int i = gw * 64 + F.lane; i < 32 * 256; i += NGW * 64) { const int rr = i >> 8, k = (i & 255) * 4, dir = rr >> 4, j = rr & 15; const float* s = p.gwg_down + (size_t)dir * 1024 * 16 + j;
        *(unsigned*)(WIN + (size_t)(3072 + rr) * 1024 + k) = pk4_fp8(s[(size_t)k * 16] * W8_SCALE, s[(size_t)(k + 1) * 16] * W8_SCALE, s[(size_t)(k + 2) * 16] * W8_SCALE, s[(size_t)(k + 3) * 16] * W8_SCALE); }
    for (int i = gw * 64 + F.lane; i < 224 * 1024 / 16; i += NGW * 64) *(u32x4*)(WIN + (size_t)3104 * 1024 + (size_t)i * 16) = (u32x4){0u, 0u, 0u, 0u};
}

__device__ __forceinline__ void phase_modulate0(const Frame& F, const Prm& p) {
    const float* MOD = (const float*)(p.ws + WS_MOD); unsigned char* H = p.ws + WS_H;
    const int gw = F.bid * NWAVES + F.wave, NGW = F.G * NWAVES, per = (NTOK + NGW - 1) / NGW;
    int curmod = -1; f32x4 sh[4], sc[4];
    const int t0 = gw * per, t1 = min(NTOK, (gw + 1) * per);
    f32x4 v[4], vn[4];
    if (t0 < t1) ld_row_f32(t0 < NLAT ? p.x + (size_t)t0 * DM : p.ctx + (size_t)(t0 - NLAT) * DM, F.lane, v);
    for (int tok = t0; tok < t1; ++tok) {
        if (tok + 1 < t1) ld_row_f32(tok + 1 < NLAT ? p.x + (size_t)(tok + 1) * DM : p.ctx + (size_t)(tok + 1 - NLAT) * DM, F.lane, vn);
        const int mr = tok < NLAT ? tok / SEQ : 8;
        if (mr != curmod) { curmod = mr; ld_row_f32(MOD + mr * 6144, F.lane, sh); ld_row_f32(MOD + mr * 6144 + 1024, F.lane, sc); }
#pragma unroll
        for (int j = 0; j < 4; ++j) v[j] = v[j] * (1.f + sc[j]) + sh[j];
        st_row_fp8(H + (size_t)tok * DM, F.lane, v);
#pragma unroll
        for (int j = 0; j < 4; ++j) v[j] = vn[j];
    }
}

__device__ __forceinline__ void phase_attn_combine(const Frame& F, const Prm& p) {
    const bf16* O1 = (const bf16*)(p.ws + WS_O1); const bf16* O2 = (const bf16*)(p.ws + WS_O2); unsigned char* A2 = p.ws + WS_A2;
    const float lam = ((const float*)(p.ws + WS_MISC))[0];
    const f32x4 sg = *(const f32x4*)(p.subln + 4 * (F.lane & 31));
    const int gw = F.bid * NWAVES + F.wave, NGW = F.G * NWAVES;
    f32x4 a[4], b[4], an[4], bn[4];
    if (gw < NTOK) { ld_row_bf16(O1 + (size_t)gw * DM, F.lane, a); ld_row_bf16(O2 + (size_t)gw * DM, F.lane, b); }
    for (int tok = gw; tok < NTOK; tok += NGW) {
        if (tok + NGW < NTOK) { ld_row_bf16(O1 + (size_t)(tok + NGW) * DM, F.lane, an); ld_row_bf16(O2 + (size_t)(tok + NGW) * DM, F.lane, bn); }
#pragma unroll
        for (int j = 0; j < 4; ++j) {
            f32x4 o = a[j] - lam * b[j]; float q = (o.x * o.x + o.y * o.y) + (o.z * o.z + o.w * o.w);
#pragma unroll
            for (int s = 1; s < 32; s <<= 1) q += __shfl_xor(q, s);
            const float rr = (1.f - LAMBDA_INIT0) / sqrtf(q * (1.f / 128.f) + LN_EPS);
            a[j] = o * rr * sg;
        }
        st_row_fp8(A2 + (size_t)tok * DM, F.lane, a);
#pragma unroll
        for (int j = 0; j < 4; ++j) { a[j] = an[j]; b[j] = bn[j]; }
    }
}

__device__ __forceinline__ void phase_ln_route(const Frame& F, const Prm& p, int layer) {
    const int nrows = layer ? NLAT : NTOK;
    const float* MOD = (const float*)(p.ws + WS_MOD) + layer * 9 * 6144;
    const bf16* Y = (const bf16*)(p.ws + WS_Y); unsigned char* HF = p.ws + WS_H;
    bf16* XB = (bf16*)(p.ws + WS_XB);
    int* LIST = (int*)(p.ws + WS_LIST); int* TOKR = (int*)(p.ws + WS_TOKR);
    unsigned* CNT = F.ctl + CW_CNT + layer * 16;
    float* WrT = (float*)F.lds;
    int* rec = (int*)(F.lds + 65536);
    unsigned* lcnt = (unsigned*)(F.lds + 65536 + 8192); unsigned* lbase = lcnt + 16;
    for (int i = F.tid; i < 16 * 1024; i += NTHR) { const int k = i >> 4, e = i & 15; WrT[e * 1024 + k] = p.rw[i]; }
    if (F.tid < 16) lcnt[F.tid] = 0u;
    __syncthreads();
    const int per_wg = (nrows + F.G - 1) / F.G, per_w = (per_wg + NWAVES - 1) / NWAVES;
    const int row_lo = F.bid * per_wg, row_hi = min(nrows, row_lo + per_wg);
    const float* lng = p.ln_g + (layer * 2 + 0) * DM; const float* lnb = p.ln_b + (layer * 2 + 0) * DM;
    float rb[16];
#pragma unroll
    for (int e = 0; e < 16; ++e) rb[e] = p.rb[e];
    int curmod = -1; f32x4 gm[4], shf[4], scf[4];
    f32x4 v[4], y[4], vn[4], yn[4];
#define LNR_LOAD(tok_, V, Yv) do { if (layer) ld_row_bf16(XB + (size_t)(tok_) * DM, F.lane, V); else ld_row_f32((tok_) < NLAT ? p.x + (size_t)(tok_) * DM : p.ctx + (size_t)((tok_) - NLAT) * DM, F.lane, V); \
        ld_row_bf16(Y + (size_t)(tok_) * DM, F.lane, Yv); } while (0)
    if (row_lo + F.wave * per_w < row_hi) LNR_LOAD(row_lo + F.wave * per_w, v, y);
    for (int i = 0; i < per_w; ++i) {
        const int lr = F.wave * per_w + i, tok = row_lo + lr; if (tok >= row_hi) break;
        if (i + 1 < per_w && tok + 1 < row_hi) LNR_LOAD(tok + 1, vn, yn);
        const int mr = tok < NLAT ? tok / SEQ : 8;
        if (mr != curmod) { curmod = mr; ld_row_f32(MOD + mr * 6144 + 2048, F.lane, gm); ld_row_f32(MOD + mr * 6144 + 3072, F.lane, shf); ld_row_f32(MOD + mr * 6144 + 4096, F.lane, scf); }
        bf16* xdst = XB + (size_t)tok * DM;
#pragma unroll
        for (int j = 0; j < 4; ++j) v[j] = ALPHA * v[j] + gm[j] * y[j];
        ln_row(v, lng, lnb, F.lane);
        st_row_bf16(xdst, F.lane, v);
#pragma unroll
        for (int j = 0; j < 4; ++j) v[j] = v[j] * (1.f + scf[j]) + shf[j];
        st_row_fp8(HF + (size_t)tok * DM, F.lane, v);
        float part[16];
#pragma unroll
        for (int e = 0; e < 16; ++e) { float s = 0.f;
#pragma unroll
            for (int j = 0; j < 4; ++j) { const f32x4 w = *(const f32x4*)(WrT + e * 1024 + 4 * F.lane + 256 * j); s += (v[j].x * w.x + v[j].y * w.y) + (v[j].z * w.z + v[j].w * w.w); }
            part[e] = s; }
        {
#pragma unroll
            for (int e = 0; e < 8; ++e) { const bool up = (F.lane & 32) != 0; const float keep = up ? part[e + 8] : part[e], send = up ? part[e] : part[e + 8]; part[e] = keep + __shfl_xor(send, 32); }
#pragma unroll
            for (int e = 0; e < 4; ++e) { const bool up = (F.lane & 16) != 0; const float keep = up ? part[e + 4] : part[e], send = up ? part[e] : part[e + 4]; part[e] = keep + __shfl_xor(send, 16); }
#pragma unroll
            for (int e = 0; e < 2; ++e) { const bool up = (F.lane & 8) != 0; const float keep = up ? part[e + 2] : part[e], send = up ? part[e] : part[e + 2]; part[e] = keep + __shfl_xor(send, 8); }
            { const bool up = (F.lane & 4) != 0; const float keep = up ? part[1] : part[0], send = up ? part[0] : part[1]; part[0] = keep + __shfl_xor(send, 4); }
            part[0] += __shfl_xor(part[0], 2); part[0] += __shfl_xor(part[0], 1);
        }
        float aff[16], sel[16];
#pragma unroll
        for (int e = 0; e < 16; ++e) { const int src = ((e >> 3) & 1) * 32 + ((e >> 2) & 1) * 16 + ((e >> 1) & 1) * 8 + (e & 1) * 4; const float lg = __shfl(part[0], src); aff[e] = 1.f / (1.f + __expf(-lg)); sel[e] = aff[e] + rb[e]; }
        int bg = 0; float bgs = -3.0e38f;
#pragma unroll
        for (int g = 0; g < 4; ++g) { float m1 = -3.0e38f, m2 = -3.0e38f;
#pragma unroll
            for (int k = 0; k < 4; ++k) { const float s = sel[4 * g + k]; if (s > m1) { m2 = m1; m1 = s; } else if (s > m2) m2 = s; }
            const float gs = m1 + m2; if (gs > bgs) { bgs = gs; bg = g; } }
        int i1 = 0, i2 = 0; float s1 = -3.0e38f, s2 = -3.0e38f, a1 = 0.f, a2 = 0.f;
#pragma unroll
        for (int g = 0; g < 4; ++g) if (g == bg) {
#pragma unroll
            for (int k = 0; k < 4; ++k) { const float s = sel[4 * g + k], a = aff[4 * g + k];
                if (s > s1) { s2 = s1; i2 = i1; a2 = a1; s1 = s; i1 = 4 * g + k; a1 = a; } else if (s > s2) { s2 = s; i2 = 4 * g + k; a2 = a; } } }
        const float wsum = a1 + a2, w1 = a1 / wsum, w2 = a2 / wsum;
        if (F.lane == 0) { const unsigned l1 = atomicAdd(&lcnt[i1], 1u), l2 = atomicAdd(&lcnt[i2], 1u);
            rec[lr * 6 + 0] = i1; rec[lr * 6 + 1] = i2; rec[lr * 6 + 2] = (int)l1; rec[lr * 6 + 3] = (int)l2; rec[lr * 6 + 4] = __float_as_int(w1); rec[lr * 6 + 5] = __float_as_int(w2); }
#pragma unroll
        for (int j = 0; j < 4; ++j) { v[j] = vn[j]; y[j] = yn[j]; }
    }
#undef LNR_LOAD
    __syncthreads();
    if (F.tid < 16) lbase[F.tid] = __hip_atomic_fetch_add(&CNT[F.tid], lcnt[F.tid], __ATOMIC_RELAXED, __HIP_MEMORY_SCOPE_AGENT);
    __syncthreads();
    for (int lr = F.tid; lr < row_hi - row_lo; lr += NTHR) { const int tok = row_lo + lr;
        const int e0 = rec[lr * 6], e1 = rec[lr * 6 + 1]; const int p0 = (int)lbase[e0] + rec[lr * 6 + 2], p1 = (int)lbase[e1] + rec[lr * 6 + 3];
        LIST[e0 * NTOK + p0] = tok; LIST[e1 * NTOK + p1] = tok;
        int* tr = TOKR + (size_t)tok * 8; tr[0] = e0; tr[1] = p0; tr[2] = e1; tr[3] = p1; tr[4] = rec[lr * 6 + 4]; tr[5] = rec[lr * 6 + 5]; }
    __syncthreads();
}

__device__ __forceinline__ void pad_bases(const unsigned* cnt, int (&pb)[17]) {
    int acc = 0;
#pragma unroll
    for (int e = 0; e < 16; ++e) { pb[e] = acc; const int c = (int)__hip_atomic_load(cnt + e, __ATOMIC_RELAXED, __HIP_MEMORY_SCOPE_AGENT); acc += (c + 255) & ~255; }
    pb[16] = acc;
}

__device__ __forceinline__ void phase_moe_combine(const Frame& F, const Prm& p, int layer) {
    const int nrows = layer ? NLAT : NTOK;
    const float* MOD = (const float*)(p.ws + WS_MOD) + layer * 9 * 6144; const float* MOD1 = (const float*)(p.ws + WS_MOD) + 9 * 6144;
    const unsigned char* YM = p.ws + WS_YM;   unsigned char* H = p.ws + WS_H;   bf16* XB = (bf16*)(p.ws + WS_XB); const int* TOKR = (const int*)(p.ws + WS_TOKR);
    int pb[17]; pad_bases(F.ctl + CW_CNT + layer * 16, pb);
    int* pbl = (int*)F.lds; if (F.tid < 17) { int v = 0;
#pragma unroll
        for (int e = 0; e < 17; ++e) if (e == F.tid) v = pb[e];
        pbl[F.tid] = v; }
    __syncthreads();
    const float* lng = p.ln_g + (layer * 2 + 1) * DM; const float* lnb = p.ln_b + (layer * 2 + 1) * DM;
    const int gw = F.bid * NWAVES + F.wave, NGW = F.G * NWAVES, per = (nrows + NGW - 1) / NGW;
    int curmod = -1; f32x4 gf[4], sh1[4], sc1[4];
    typedef int i32x4r __attribute__((ext_vector_type(4)));
    const int t0 = gw * per, t1 = min(nrows, (gw + 1) * per);
    i32x4r ra = {0, 0, 0, 0}, rb = {0, 0, 0, 0}, rc = {0, 0, 0, 0}; f32x2 wa = {0.f, 0.f}, wb = {0.f, 0.f}, wc = {0.f, 0.f};
#define MC_REC(tok_, R, W) do { const int* tr_ = TOKR + (size_t)(tok_) * 8; R = *(const i32x4r*)tr_; W = *(const f32x2*)(tr_ + 4); } while (0)
#define MC_ROWS(tok_, R, V, A, B) do { ld_row_bf16(XB + (size_t)(tok_) * DM, F.lane, V); ld_row_fp8(YM + (size_t)(pbl[R.x] + R.y) * DM, F.lane, A); ld_row_fp8(YM + (size_t)(pbl[R.z] + R.w) * DM, F.lane, B); } while (0)
    f32x4 v[4], a[4], b[4], vn[4], an[4], bn[4];
    if (t0 < t1) { MC_REC(t0, ra, wa); if (t0 + 1 < t1) MC_REC(t0 + 1, rb, wb); MC_ROWS(t0, ra, v, a, b); }
    for (int tok = t0; tok < t1; ++tok) {
        if (tok + 1 < t1) MC_ROWS(tok + 1, rb, vn, an, bn);
        if (tok + 2 < t1) MC_REC(tok + 2, rc, wc);
        const int mr = tok < NLAT ? tok / SEQ : 8;
        if (mr != curmod) { curmod = mr; ld_row_f32(MOD + mr * 6144 + 5120, F.lane, gf); if (!layer) { ld_row_f32(MOD1 + mr * 6144, F.lane, sh1); ld_row_f32(MOD1 + mr * 6144 + 1024, F.lane, sc1); } }
        const float w0 = wa.x, w1 = wa.y;
        bf16* xp = XB + (size_t)tok * DM;
#pragma unroll
        for (int j = 0; j < 4; ++j) v[j] = ALPHA * v[j] + gf[j] * (w0 * a[j] + w1 * b[j]);
        ln_row(v, lng, lnb, F.lane);
        if (layer) st_row_f32(p.out + (size_t)tok * DM, F.lane, v); else st_row_bf16(xp, F.lane, v);
        if (!layer) {
#pragma unroll
            for (int j = 0; j < 4; ++j) v[j] = v[j] * (1.f + sc1[j]) + sh1[j];
            st_row_fp8(H + (size_t)tok * DM, F.lane, v);
        }
#pragma unroll
        for (int j = 0; j < 4; ++j) { v[j] = vn[j]; a[j] = an[j]; b[j] = bn[j]; }
        ra = rb; wa = wb; rb = rc; wb = wc;
    }
#undef MC_REC
#undef MC_ROWS
}

__device__ __forceinline__ void phase_gla_prep(const Frame& F, const Prm& p) {
    const bf16* QR = (const bf16*)(p.ws + WS_QR); const bf16* KR = (const bf16*)(p.ws + WS_KR); const float* ZZ = (const float*)(p.ws + WS_ZZ);
    bf16* QT = (bf16*)(p.ws + WS_QT); bf16* KT = (bf16*)(p.ws + WS_KT); float* DEC = (float*)(p.ws + WS_DEC);
    const int gw = F.bid * NWAVES + F.wave, NGW = F.G * NWAVES;
    for (int task = gw; task < 2 * NCHUNK * 8; task += NGW) {
        const int dh = task & 7, chunk = (task >> 3) % NCHUNK, dir = __builtin_amdgcn_readfirstlane(task / (8 * NCHUNK));
        const int col = dh * 64 + F.lane, tok0 = chunk * 64;
        LAS float* zt = (LAS float*)((LAS unsigned char*)F.lds + F.wave * 4096);
#pragma unroll
        for (int j = 0; j < 4; ++j) *(LAS f32x4*)(zt + F.lane * 16 + 4 * j) = *(const f32x4*)(ZZ + (size_t)(tok0 + F.lane) * 32 + dir * 16 + 4 * j);
        float wup[16];
#pragma unroll
        for (int j = 0; j < 16; ++j) wup[j] = p.gwg_up[(size_t)dir * 16 * 512 + j * 512 + col];
        const float bgv = p.gbg[dir * 512 + col];
        float b = 0.f;
        const bf16* qi = QR + ((size_t)dh * NTOK + tok0) * 64 + F.lane; const bf16* ki = KR + ((size_t)dh * NTOK + tok0) * 64 + F.lane;
        bf16* qo = QT + (((size_t)dir * 8 + dh) * NTOK + tok0) * 64 + F.lane; bf16* ko = KT + (((size_t)dir * 8 + dh) * NTOK + tok0) * 64 + F.lane;
        unsigned short qa[8], ka[8], qb[8], kb[8];
#define GP_LOAD(blk, Q_, K_) do { _Pragma("unroll") for (int i_ = 0; i_ < 8; ++i_) { const int t_ = dir ? 63 - (8 * (blk) + i_) : 8 * (blk) + i_; Q_[i_] = qi[(size_t)t_ * 64]; K_[i_] = ki[(size_t)t_ * 64]; } } while (0)
#define GP_PROC(blk, Q_, K_) do { _Pragma("unroll") for (int i_ = 0; i_ < 8; ++i_) { const int tl = dir ? 63 - (8 * (blk) + i_) : 8 * (blk) + i_;     \
            float z = bgv; \
            _Pragma("unroll") for (int j = 0; j < 4; ++j) { const f32x4 zv = *(const LAS f32x4*)(zt + tl * 16 + 4 * j); \
                z += zv.x * wup[4 * j] + zv.y * wup[4 * j + 1] + zv.z * wup[4 * j + 2] + zv.w * wup[4 * j + 3]; } \
            const float g = (fminf(z, 0.f) - __logf(1.f + __expf(-fabsf(z)))) * (1.f / 16.f);     \
            b += g; \
            const float e = __expf(b), ei = __builtin_amdgcn_rcpf(e); \
            qo[(size_t)tl * 64] = (bf16)f2bf(bf2f(Q_[i_]) * e); ko[(size_t)tl * 64] = (bf16)f2bf(bf2f(K_[i_]) * ei); } } while (0)
        GP_LOAD(0, qa, ka);
        for (int b2 = 0; b2 < 4; ++b2) {
            GP_LOAD(2 * b2 + 1, qb, kb);
            GP_PROC(2 * b2, qa, ka);
            if (b2 < 3) GP_LOAD(2 * b2 + 2, qa, ka);
            GP_PROC(2 * b2 + 1, qb, kb);
        }
#undef GP_LOAD
#undef GP_PROC
        DEC[((size_t)dir * NCHUNK + chunk) * 512 + col] = __expf(b);
    }
}

__device__ __forceinline__ void phase_gla_post(const Frame& F, const Prm& p) {
    const bf16* OF = (const bf16*)p.out; const bf16* OB = (const bf16*)((const unsigned char*)p.out + OUT_OGB); const bf16* R = (const bf16*)(p.ws + WS_R); unsigned char* A2 = p.ws + WS_A2B;
    const f32x4 ng = *(const f32x4*)(p.gnorm + 4 * F.lane);
    const int gw = F.bid * NWAVES + F.wave, NGW = F.G * NWAVES;
    f32x4 a[4], b[4], r[4], an[4], bn[4], rn[4];
    if (gw < NLAT) { ld_row_bf16(OF + (size_t)gw * DM, F.lane, a); ld_row_bf16(OB + (size_t)gw * DM, F.lane, b); ld_row_bf16(R + (size_t)gw * DM, F.lane, r); }
    for (int tok = gw; tok < NLAT; tok += NGW) {
        if (tok + NGW < NLAT) { ld_row_bf16(OF + (size_t)(tok + NGW) * DM, F.lane, an); ld_row_bf16(OB + (size_t)(tok + NGW) * DM, F.lane, bn); ld_row_bf16(R + (size_t)(tok + NGW) * DM, F.lane, rn); }
#pragma unroll
        for (int j = 0; j < 4; ++j) {
            const f32x4 o = a[j] + b[j]; const float q = wave_sum((o.x * o.x + o.y * o.y) + (o.z * o.z + o.w * o.w));
            const float rs = 1.f / sqrtf(q * (1.f / 256.f) + LN_EPS);
            a[j] = (f32x4){o.x * rs * ng.x * silu_f(r[j].x), o.y * rs * ng.y * silu_f(r[j].y), o.z * rs * ng.z * silu_f(r[j].z), o.w * rs * ng.w * silu_f(r[j].w)};
        }
        st_row_fp8(A2 + (size_t)tok * DM, F.lane, a);
#pragma unroll
        for (int j = 0; j < 4; ++j) { a[j] = an[j]; b[j] = bn[j]; r[j] = rn[j]; }
    }
}
namespace pg8 {
typedef short bf16x8 __attribute__((ext_vector_type(8)));
constexpr int BM = 256, BK = 64, HALF = 128, HTB = HALF * BK * 2, STAGE_BYTES = 8 * HTB, NXCD = 8, WGM = 8;
__host__ __device__ __forceinline__ int lds_byte(int r, int c) { const int st = (r >> 4) * 2 + (c >> 5), rr = r & 15, cc = c & 31, ob = rr * 64 + cc * 2; return st * 1024 + (ob ^ (((ob >> 9) & 1) << 5)); }
__host__ __device__ __forceinline__ void stage_rc(int b, int& R, int& C) { const int st = b / 1024, sb = b % 1024, swz = sb ^ (((sb >> 9) & 1) << 5); R = (st >> 1) * 16 + swz / 64; C = (st & 1) * 32 + (swz % 64) / 2; }
typedef float f32x2_t __attribute__((ext_vector_type(2))); typedef __bf16 bf16x2_t __attribute__((ext_vector_type(2)));
__device__ __forceinline__ unsigned cvt_pk_bf16(float lo, float hi) { f32x2_t v = {lo, hi}; bf16x2_t b = __builtin_convertvector(v, bf16x2_t); return __builtin_bit_cast(unsigned, b); }

struct Unit { int pm, pn; int row0; int e; int cnt; const bf16* Bt; };

struct DenseOrder {
    int nM, nN, nwg, G, c, K; const bf16* Bt;
    __device__ void init(int M, int N, int K_, const bf16* Bt_, int G_, int c_) { nM = M / BM; nN = N / BM; nwg = nM * nN; G = G_; c = c_; K = K_; Bt = Bt_; }
    __device__ bool next(int i, Unit& u) const {
        const long L = (long)i * G + c; if (L >= nwg) return false;
        int wgid = (int)L; { const int q = nwg / NXCD, r = nwg % NXCD, xcd = wgid % NXCD, off = wgid / NXCD; wgid = (xcd < r ? xcd * (q + 1) : r * (q + 1) + (xcd - r) * q) + off; }
        const int nig = WGM * nN, gid = wgid / nig, fm = gid * WGM, gsz = (nM - fm) < WGM ? (nM - fm) : WGM;
        u.pm = fm + ((wgid % nig) % gsz); u.pn = (wgid % nig) / gsz; u.row0 = u.pm * BM; u.e = 0; u.cnt = 0; u.Bt = Bt; return true;
    }
    __device__ __forceinline__ unsigned arow(const Unit& u, int r) const { return (unsigned)(u.row0 + r) * (unsigned)(K * 2); }
};
template <bool GATHER> struct MoeOrder {
    int cnt[16]; int nN, G, c, K; const bf16* Bt0; size_t bstride; const int* LIST;
    __device__ void init(const unsigned* cntw, int N, int K_, const bf16* Bt0_, const int* LIST_, int G_, int c_) {
#pragma unroll
        for (int e = 0; e < 16; ++e) cnt[e] = (int)__hip_atomic_load(cntw + e, __ATOMIC_RELAXED, __HIP_MEMORY_SCOPE_AGENT);
        nN = N / BM; G = G_; c = c_; K = K_; Bt0 = Bt0_; bstride = (size_t)N * K_; LIST = LIST_; }
    __device__ bool next(int i, Unit& u) const {
        int L = i * G + c, base = 0; bool found = false; u.pm = 0; u.pn = 0; u.row0 = 0; u.e = 0; u.cnt = 0; u.Bt = Bt0;
#pragma unroll
        for (int e = 0; e < 16; ++e) { const int mt = (cnt[e] + 255) >> 8, nu = mt * nN;
            if (!found) { if (L < nu) { found = true; u.e = e; u.cnt = cnt[e]; u.pm = L / nN; u.pn = L % nN; u.row0 = base + u.pm * BM; u.Bt = Bt0 + (size_t)e * bstride; } else { L -= nu; base += mt * BM; } } }
        return found;
    }
    __device__ __forceinline__ unsigned arow(const Unit& u, int r) const {
        if (GATHER) { const int li = u.pm * BM + r; int tok = 0; if (li < u.cnt) tok = LIST[u.e * NTOK + li];
            return (unsigned)tok * (unsigned)(K * 2); }
        return (unsigned)(u.row0 + r) * (unsigned)(K * 2);
    }
};

typedef f32x4 Acc[2][2][4][2];
__device__ __forceinline__ void st4bf(bf16* p, f32x4 v) { u32x2 w; w.x = cvt_pk_bf16(v.x, v.y); w.y = cvt_pk_bf16(v.z, v.w); *(u32x2*)p = w; }
__device__ __forceinline__ void sink4(f32x4 v) { u32x2 w; w.x = cvt_pk_bf16(v.x, v.y); w.y = cvt_pk_bf16(v.z, v.w); asm volatile("" :: "v"(w)); }
__device__ __forceinline__ void st8bf(bf16* p, f32x4 a, f32x4 b) { u32x4 w; w.x = cvt_pk_bf16(a.x, a.y); w.y = cvt_pk_bf16(a.z, a.w); w.z = cvt_pk_bf16(b.x, b.y); w.w = cvt_pk_bf16(b.z, b.w); *(u32x4*)p = w; }

struct EpiQKV {
    bf16 *Q; const LAS float* rope; float wsc; unsigned* km; bool nostore;
    __device__ __forceinline__ void operator()(const Acc& acc, const Unit& u, int wr, int wc, int fr, int fq) const {
        const int reg = u.pn >> 2; bf16* O = Q + (size_t)reg * ((WS_K - WS_Q) / 2);
        if (reg == 2) { const int cbase = (u.pn & 3) * BM + wc * 32 + 8 * fq;
#pragma unroll
            for (int ai = 0; ai < 2; ++ai)
#pragma unroll
                for (int m = 0; m < 4; ++m) { bf16* rowp = O + (size_t)(u.row0 + ai * HALF + wr * 64 + m * 16 + fr) * DM + cbase;
#pragma unroll
                    for (int bj = 0; bj < 2; ++bj) { if (nostore) { sink4(acc[ai][bj][m][0] * wsc); sink4(acc[ai][bj][m][1] * wsc); } else st8bf(rowp + bj * HALF, acc[ai][bj][m][0] * wsc, acc[ai][bj][m][1] * wsc); } }
            return; }
        const int cbase = (u.pn & 3) * BM + wc * 32 + 4 * fq;
        const bool dorope = (u.row0 < NLAT); const float sc = (reg == 0 ? C2 : 1.f) * wsc; float kn[2] = {0.f, 0.f};
#pragma unroll
        for (int ai = 0; ai < 2; ++ai)
#pragma unroll
            for (int m = 0; m < 4; ++m) { const int row = u.row0 + ai * HALF + wr * 64 + m * 16 + fr; bf16* rowp = O + (size_t)row * DM + cbase;
                f32x4 cs = {1.f, 1.f, 1.f, 1.f}, sn = {0.f, 0.f, 0.f, 0.f};
                if (dorope) { const int s = row & (SEQ - 1), pos = (wc & 1) ? (s & 63) : (s >> 6); const f32x4 t0 = *(const LAS f32x4*)(rope + (pos * 16 + 4 * fq) * 2), t1 = *(const LAS f32x4*)(rope + (pos * 16 + 4 * fq) * 2 + 4);
                    cs = (f32x4){t0.x, t0.z, t1.x, t1.z}; sn = (f32x4){t0.y, t0.w, t1.y, t1.w}; }
#pragma unroll
                for (int bj = 0; bj < 2; ++bj) { const f32x4 a0 = acc[ai][bj][m][0], a1 = acc[ai][bj][m][1];
                    const f32x4 o0 = (a0 * cs - a1 * sn) * sc, o1 = (a1 * cs + a0 * sn) * sc;
                    if (nostore) { sink4(o0); sink4(o1); } else { st4bf(rowp + bj * HALF, o0); st4bf(rowp + bj * HALF + 16, o1); }
                    if (reg == 1) { const float ps = (o0.x * o0.x + o0.y * o0.y) + (o0.z * o0.z + o0.w * o0.w) + (o1.x * o1.x + o1.y * o1.y) + (o1.z * o1.z + o1.w * o1.w);
                        kn[bj] = fmaxf(kn[bj], ps); } } }
        if (reg == 1) {
            const int b = u.row0 < NLAT ? u.row0 / SEQ : (u.row0 - NLAT) / CTXL;
#pragma unroll
            for (int bj = 0; bj < 2; ++bj) { float v = kn[bj];
#pragma unroll
                for (int s = 1; s < 64; s <<= 1) v = fmaxf(v, __shfl_xor(v, s));
                if (fr == 0 && fq == 0) __hip_atomic_fetch_max(km + b * 16 + 4 * (u.pn & 3) + 2 * bj + (wc >> 1), __float_as_uint(8.f * v), __ATOMIC_RELAXED, __HIP_MEMORY_SCOPE_AGENT); } }
    }
};
struct EpiPlain {
    bf16* O; float sc;
    __device__ __forceinline__ void operator()(const Acc& acc, const Unit& u, int wr, int wc, int fr, int fq) const {
        const int cbase = u.pn * BM + wc * 32 + 8 * fq;
#pragma unroll
        for (int ai = 0; ai < 2; ++ai)
#pragma unroll
            for (int m = 0; m < 4; ++m) { bf16* rowp = O + (size_t)(u.row0 + ai * HALF + wr * 64 + m * 16 + fr) * DM + cbase;
#pragma unroll
                for (int bj = 0; bj < 2; ++bj) st8bf(rowp + bj * HALF, acc[ai][bj][m][0] * sc, acc[ai][bj][m][1] * sc); }
    }
};
struct EpiPlain8 {
    unsigned char* O; float sc;
    __device__ __forceinline__ void operator()(const Acc& acc, const Unit& u, int wr, int wc, int fr, int fq) const {
        const int cbase = u.pn * BM + wc * 32 + 8 * fq;
#pragma unroll
        for (int ai = 0; ai < 2; ++ai)
#pragma unroll
            for (int m = 0; m < 4; ++m) { unsigned char* rowp = O + (size_t)(u.row0 + ai * HALF + wr * 64 + m * 16 + fr) * DM + cbase;
#pragma unroll
                for (int bj = 0; bj < 2; ++bj) { const f32x4 a = acc[ai][bj][m][0] * sc, b = acc[ai][bj][m][1] * sc; u32x2 w; w.x = pk4_fp8(a.x, a.y, a.z, a.w); w.y = pk4_fp8(b.x, b.y, b.z, b.w); *(u32x2*)(rowp + bj * HALF) = w; } }
    }
};
struct EpiInproj {
    bf16 *QR, *KR, *V, *R; float* ZZ; float wsc;
    __device__ __forceinline__ void operator()(const Acc& acc, const Unit& u, int wr, int wc, int fr, int fq) const {
        const int pn = u.pn;
        if (pn == 12) { if (wc == 0) {
#pragma unroll
            for (int ai = 0; ai < 2; ++ai)
#pragma unroll
                for (int m = 0; m < 4; ++m) { float* rowp = ZZ + (size_t)(u.row0 + ai * HALF + wr * 64 + m * 16 + fr) * 32 + 4 * fq;
                    *(f32x4*)rowp = acc[ai][0][m][0] * wsc; *(f32x4*)(rowp + 16) = acc[ai][0][m][1] * wsc; } }
            return; }
        float sc = wsc;
        if (pn < 4) {
            bf16* O = pn < 2 ? QR : KR; if (pn < 2) sc = 0.08838834764831845f * wsc;
            const int cb = (pn & 1) * BM + wc * 32 + 8 * fq;
#pragma unroll
            for (int ai = 0; ai < 2; ++ai)
#pragma unroll
                for (int m = 0; m < 4; ++m) { const size_t row = (size_t)(u.row0 + ai * HALF + wr * 64 + m * 16 + fr);
#pragma unroll
                    for (int bj = 0; bj < 2; ++bj) { const int col = cb + bj * HALF; st8bf(O + ((size_t)(col >> 6) * NTOK + row) * 64 + (col & 63), acc[ai][bj][m][0] * sc, acc[ai][bj][m][1] * sc); } }
            return; }
        bf16* O; int c0;
        if (pn < 8) { O = V; c0 = (pn - 4) * BM; } else { O = R; c0 = (pn - 8) * BM; }
        const int cbase = c0 + wc * 32 + 8 * fq;
#pragma unroll
        for (int ai = 0; ai < 2; ++ai)
#pragma unroll
            for (int m = 0; m < 4; ++m) { bf16* rowp = O + (size_t)(u.row0 + ai * HALF + wr * 64 + m * 16 + fr) * DM + cbase;
#pragma unroll
                for (int bj = 0; bj < 2; ++bj) st8bf(rowp + bj * HALF, acc[ai][bj][m][0] * sc, acc[ai][bj][m][1] * sc); }
    }
};
struct EpiGateUp {
    unsigned char* ACT;
    __device__ __forceinline__ void operator()(const Acc& acc, const Unit& u, int wr, int wc, int fr, int fq) const {
        const int obase = (u.pn * BM + wc * 32) / 2 + 4 * fq;
#pragma unroll
        for (int ai = 0; ai < 2; ++ai)
#pragma unroll
            for (int m = 0; m < 4; ++m) { unsigned char* rowp = ACT + (size_t)(u.row0 + ai * HALF + wr * 64 + m * 16 + fr) * DEXP + obase;
#pragma unroll
                for (int bj = 0; bj < 2; ++bj) { const f32x4 g = acc[ai][bj][m][0] * W8_INV, up = acc[ai][bj][m][1] * W8_INV; f32x4 o;
#pragma unroll
                    for (int j = 0; j < 4; ++j) o[j] = g[j] * __builtin_amdgcn_rcpf(1.f + __expf(-g[j])) * up[j];
                    *(unsigned*)(rowp + bj * (HALF / 2)) = pk4_fp8(o[0], o[1], o[2], o[3]); } }
    }
};

typedef int i32x8 __attribute__((ext_vector_type(8)));
typedef int i32x4 __attribute__((ext_vector_type(4)));
__device__ __forceinline__ i32x8 cat8(bf16x8 lo, bf16x8 hi) { return __builtin_shufflevector(__builtin_bit_cast(i32x4, lo), __builtin_bit_cast(i32x4, hi), 0, 1, 2, 3, 4, 5, 6, 7); }
template <class Epi, class Sched, bool FP8 = false>
__device__ __forceinline__ void gemm_phase(unsigned char* ldsg, const bf16* A, int K, const Sched& S, const Epi& E) {
    LAS unsigned char* lds = (LAS unsigned char*)ldsg;
    const int tid = threadIdx.x, wid = __builtin_amdgcn_readfirstlane(tid >> 6), lane = tid & 63, wr = wid >> 2, wc = wid & 3, fr = lane & 15, fq = lane >> 4;
    const int nt = K / BK;
    int Rr[2]; unsigned colb[2], voffB[2];
#pragma unroll
    for (int i = 0; i < 2; ++i) { int R, C; stage_rc(tid * 16 + i * 8192, R, C); Rr[i] = R; colb[i] = (unsigned)C * 2u; voffB[i] = (unsigned)(R * K + C) * 2u; }
    const size_t kstep = (size_t)(BK * 2);
    const size_t hstep = (size_t)HALF * K * 2;
    const size_t tstep = 2 * hstep;
    const unsigned ldsw = (unsigned)wid * 1024u;
    const int aoff = lds_byte(wr * 64 + fr, fq * 8), boff = lds_byte(wc * 32 + fr, fq * 8);
#define PG8_SA(b, h) (((b) * 2 + (h)) * HTB)
#define PG8_SB(b, h) ((4 + (b) * 2 + (h)) * HTB)
#define PG8_STAGE(bufoff, gbase, voff) do { _Pragma("unroll") for (int _i = 0; _i < 2; ++_i) \
        __builtin_amdgcn_global_load_lds((const unsigned*)((const char*)(gbase) + (voff)[_i]), (LAS unsigned*)(lds + (bufoff) + ldsw + _i * 8192), 16, 0, 0); } while (0)
#define PG8_LDA(dst, b, h) do { if constexpr (FP8) { _Pragma("unroll") for (int m = 0; m < 4; ++m) dst##8[m] = cat8(*(const LAS bf16x8*)(lds + PG8_SA(b, h) + aoff + m * 2048), *(const LAS bf16x8*)(lds + PG8_SA(b, h) + aoff + m * 2048 + 1024)); } \
        else { _Pragma("unroll") for (int m = 0; m < 4; ++m) _Pragma("unroll") for (int k = 0; k < 2; ++k) dst[m][k] = *(const LAS bf16x8*)(lds + PG8_SA(b, h) + aoff + m * 2048 + k * 1024); } } while (0)
#define PG8_LDB(dst, b, h) do { if constexpr (FP8) { _Pragma("unroll") for (int n = 0; n < 2; ++n) dst##8[n] = cat8(*(const LAS bf16x8*)(lds + PG8_SB(b, h) + boff + n * 2048), *(const LAS bf16x8*)(lds + PG8_SB(b, h) + boff + n * 2048 + 1024)); } \
        else { _Pragma("unroll") for (int n = 0; n < 2; ++n) _Pragma("unroll") for (int k = 0; k < 2; ++k) dst[n][k] = *(const LAS bf16x8*)(lds + PG8_SB(b, h) + boff + n * 2048 + k * 1024); } } while (0)
#define PG8_MMA(ai, bj, At, Bt) do { __builtin_amdgcn_s_setprio(1); \
        if constexpr (FP8) { _Pragma("unroll") for (int m = 0; m < 4; ++m) _Pragma("unroll") for (int n = 0; n < 2; ++n) \
            asm volatile("v_mfma_scale_f32_16x16x128_f8f6f4 %0, %1, %2, %0, %3, %3 op_sel_hi:[0,0,0]" : "+v"(acc[ai][bj][m][n]) : "v"(Bt##8[n]), "v"(At##8[m]), "v"(sc8)); } \
        else { _Pragma("unroll") for (int m = 0; m < 4; ++m) _Pragma("unroll") for (int n = 0; n < 2; ++n) _Pragma("unroll") for (int k = 0; k < 2; ++k) \
            acc[ai][bj][m][n] = __builtin_amdgcn_mfma_f32_16x16x32_bf16(Bt[n][k], At[m][k], acc[ai][bj][m][n], 0, 0, 0); } \
        __builtin_amdgcn_s_setprio(0); } while (0)
#define PG8_WAIT_V(n) asm volatile("s_waitcnt vmcnt(" #n ")" ::: "memory")
#define PG8_WAIT_L(n) asm volatile("s_waitcnt lgkmcnt(" #n ")" ::: "memory")
#define PG8_BAR __builtin_amdgcn_s_barrier()
#define PG8_SCHED __builtin_amdgcn_sched_barrier(0)
    Unit cur, nxt; int ui = 0;
    if (!S.next(0, cur)) return;
    Acc acc;
#pragma unroll
    for (int a = 0; a < 2; ++a)
#pragma unroll
        for (int b = 0; b < 2; ++b)
#pragma unroll
            for (int m = 0; m < 4; ++m)
#pragma unroll
                for (int n = 0; n < 2; ++n) acc[a][b][m][n] = (f32x4){0.f, 0.f, 0.f, 0.f};
    const int sc8 = 0x7f7f7f7f;
    bf16x8 At[4][2], B0[2][2], B1[2][2]; i32x8 At8[4], B08[2], B18[2];
    unsigned aC0[2], aC1[2], aN0[2], aN1[2];
#pragma unroll
    for (int i = 0; i < 2; ++i) { aC0[i] = S.arow(cur, Rr[i]) + colb[i]; aC1[i] = S.arow(cur, HALF + Rr[i]) + colb[i]; }
    const char* Ab = (const char*)A;
    const char* cB = (const char*)cur.Bt + (size_t)cur.pn * tstep;
    PG8_STAGE(PG8_SB(0, 0), cB, voffB); PG8_STAGE(PG8_SB(0, 1), cB + hstep, voffB); PG8_STAGE(PG8_SA(0, 0), Ab, aC0); PG8_STAGE(PG8_SA(0, 1), Ab, aC1);
    if (wr == 1) PG8_BAR;
    PG8_WAIT_V(2); PG8_BAR;
    PG8_STAGE(PG8_SB(1, 0), cB + kstep, voffB); PG8_STAGE(PG8_SA(1, 0), Ab + kstep, aC0); PG8_STAGE(PG8_SB(1, 1), cB + hstep + kstep, voffB);
    PG8_WAIT_V(6); PG8_BAR;
    for (;;) {
        const bool has_next = S.next(ui + 1, nxt);
        if (has_next) {
#pragma unroll
            for (int i = 0; i < 2; ++i) { aN0[i] = S.arow(nxt, Rr[i]) + colb[i]; aN1[i] = S.arow(nxt, HALF + Rr[i]) + colb[i]; }
        } else {
#pragma unroll
            for (int i = 0; i < 2; ++i) { aN0[i] = aC0[i]; aN1[i] = aC1[i]; }
        }
        const char* nB = has_next ? (const char*)nxt.Bt + (size_t)nxt.pn * tstep : cB;
        for (int t = 0; t < nt; t += 2) {
            const bool last = (t == nt - 2);
            const char* a1 = Ab + (size_t)(t + 1) * kstep;
            const char* a2 = last ? Ab : Ab + (size_t)(t + 2) * kstep; const char* b2 = last ? nB : cB + (size_t)(t + 2) * kstep;
            const char* a3 = a2 + kstep; const char* b3 = b2 + kstep;
            unsigned x0[2], x1[2];
#pragma unroll
            for (int i = 0; i < 2; ++i) { x0[i] = last ? aN0[i] : aC0[i]; x1[i] = last ? aN1[i] : aC1[i]; }
            PG8_LDB(B0, 0, 0); PG8_LDB(B1, 0, 1); PG8_SCHED; PG8_LDA(At, 0, 0); PG8_STAGE(PG8_SA(1, 1), a1, aC1);
            PG8_WAIT_V(8); PG8_WAIT_L(0); PG8_BAR; PG8_MMA(0, 0, At, B0); PG8_MMA(0, 1, At, B1); PG8_BAR; PG8_SCHED;
            PG8_LDA(At, 0, 1); PG8_STAGE(PG8_SB(0, 0), b2, voffB); PG8_STAGE(PG8_SB(0, 1), b2 + hstep, voffB); PG8_STAGE(PG8_SA(0, 0), a2, x0);
            PG8_WAIT_V(8); PG8_WAIT_L(0); PG8_BAR; PG8_MMA(1, 0, At, B0); PG8_MMA(1, 1, At, B1); PG8_BAR; PG8_SCHED;
            PG8_LDB(B0, 1, 0); PG8_LDB(B1, 1, 1); PG8_SCHED; PG8_LDA(At, 1, 0); PG8_STAGE(PG8_SA(0, 1), a2, x1);
            PG8_WAIT_V(8); PG8_WAIT_L(0); PG8_BAR; PG8_MMA(0, 0, At, B0); PG8_MMA(0, 1, At, B1); PG8_BAR; PG8_SCHED;
            PG8_LDA(At, 1, 1); PG8_STAGE(PG8_SB(1, 0), b3, voffB); PG8_STAGE(PG8_SB(1, 1), b3 + hstep, voffB); PG8_STAGE(PG8_SA(1, 0), a3, x0);
            PG8_WAIT_V(8); PG8_WAIT_L(0); PG8_BAR; PG8_MMA(1, 0, At, B0); PG8_MMA(1, 1, At, B1); PG8_BAR; PG8_SCHED;
        }
        if (wr == 0) PG8_BAR;
        if constexpr (FP8) asm volatile("s_nop 15\n\ts_nop 7" ::: "memory");
        E(acc, cur, wr, wc, fr, fq);
        if (!has_next) break;
#pragma unroll
        for (int a = 0; a < 2; ++a)
#pragma unroll
            for (int b = 0; b < 2; ++b)
#pragma unroll
                for (int m = 0; m < 4; ++m)
#pragma unroll
                    for (int n = 0; n < 2; ++n) acc[a][b][m][n] = (f32x4){0.f, 0.f, 0.f, 0.f};
        cur = nxt; cB = nB; ++ui;
#pragma unroll
        for (int i = 0; i < 2; ++i) { aC0[i] = aN0[i]; aC1[i] = aN1[i]; }
        if (wr == 1) PG8_BAR;
    }
    PG8_WAIT_V(0);
    PG8_BAR;
#undef PG8_SA
#undef PG8_SB
#undef PG8_STAGE
#undef PG8_LDA
#undef PG8_LDB
#undef PG8_MMA
#undef PG8_WAIT_V
#undef PG8_WAIT_L
#undef PG8_BAR
#undef PG8_SCHED
}
}

__device__ __forceinline__ int vcu_of(const Frame& F) { return (F.G % 8 == 0) ? (F.bid % 8) * (F.G / 8) + F.bid / 8 : F.bid; }
__device__ __forceinline__ void phase_qkv_opt(const Frame& F, const Prm& p, bool nostore = false) {
    pg8::DenseOrder S; S.init(NTOK, 3072, 512, (const bf16*)(p.ws + WS_WQKV), F.G, F.bid);
    static_assert(WS_V - WS_K == WS_K - WS_Q, "Q|K|V equally spaced");
    LAS float* ropel = (LAS float*)((LAS unsigned char*)F.lds + LDSX_OFF);
    const float* ropeg = (const float*)(p.ws + WS_MISC) + 1024;
    for (int i = F.tid; i < 2048; i += NTHR) ropel[i] = ropeg[i];
    __syncthreads();
    pg8::EpiQKV E{(bf16*)(p.ws + WS_Q), ropel, W8_INV, F.ctl + CW_KM, nostore};
    pg8::gemm_phase<pg8::EpiQKV, pg8::DenseOrder, true>(F.lds, (const bf16*)(p.ws + WS_H), 512, S, E);
}
__device__ __forceinline__ void phase_wo_opt(const Frame& F, const Prm& p, int layer) {
    if (layer) {
        pg8::DenseOrder S; S.init(NLAT, 1024, 512, (const bf16*)(p.ws + WS_WGO), F.G, F.bid);
        pg8::EpiPlain E{(bf16*)(p.ws + WS_Y), W8_INV};
        pg8::gemm_phase<pg8::EpiPlain, pg8::DenseOrder, true>(F.lds, (const bf16*)(p.ws + WS_A2B), 512, S, E);
    } else {
        pg8::DenseOrder S; S.init(NTOK, 1024, 512, (const bf16*)(p.ws + WS_WO), F.G, F.bid);
        pg8::EpiPlain E{(bf16*)(p.ws + WS_Y), W8_INV};
        pg8::gemm_phase<pg8::EpiPlain, pg8::DenseOrder, true>(F.lds, (const bf16*)(p.ws + WS_A2), 512, S, E);
    }
}
__device__ __forceinline__ void phase_inproj_opt(const Frame& F, const Prm& p) {
    pg8::DenseOrder S; S.init(NTOK, NIN, 512, (const bf16*)(p.ws + WS_WIN), F.G, F.bid);
    pg8::EpiInproj E{(bf16*)(p.ws + WS_QR), (bf16*)(p.ws + WS_KR), (bf16*)(p.ws + WS_V1), (bf16*)(p.ws + WS_R), (float*)(p.ws + WS_ZZ), W8_INV};
    pg8::gemm_phase<pg8::EpiInproj, pg8::DenseOrder, true>(F.lds, (const bf16*)(p.ws + WS_H), 512, S, E);
}
__device__ __forceinline__ void phase_moe1_opt(const Frame& F, const Prm& p, int layer) {
    pg8::MoeOrder<true> S; S.init(F.ctl + CW_CNT + layer * 16, 1024, 512, (const bf16*)(p.ws + (layer ? WS_GU1 : WS_GU0)), (const int*)(p.ws + WS_LIST), F.G, vcu_of(F));
    pg8::EpiGateUp E{p.ws + WS_ACT};
    pg8::gemm_phase<pg8::EpiGateUp, pg8::MoeOrder<true>, true>(F.lds, (const bf16*)(p.ws + WS_H), 512, S, E);
}
__device__ __forceinline__ void phase_moe2_opt(const Frame& F, const Prm& p, int layer) {
    pg8::MoeOrder<false> S; S.init(F.ctl + CW_CNT + layer * 16, 1024, 256, (const bf16*)(p.ws + (layer ? WS_DN1 : WS_DN0)), nullptr, F.G, vcu_of(F));
    pg8::EpiPlain8 E{p.ws + WS_YM, W8_INV};
    pg8::gemm_phase<pg8::EpiPlain8, pg8::MoeOrder<false>, true>(F.lds, (const bf16*)(p.ws + WS_ACT), 256, S, E);
}
namespace attn_body {
using bf16=unsigned short;
using bf16x8=__attribute__((ext_vector_type(8)))short;
using s16x4=__attribute__((ext_vector_type(4)))short;
using f32x16=__attribute__((ext_vector_type(16)))float;
using u32x4=__attribute__((ext_vector_type(4)))unsigned;
constexpr int D=64,DM=1024;
constexpr int NW=8,QBLK=32,QB=QBLK*NW,KVBLK=64;
constexpr int ATTN_PITCH=DM, ATTN_UNIT_ROWS=QB;
__device__ __forceinline__ int crow(int r,int hi){return (r&3)+8*(r>>2)+4*hi;}
#define SBAR() __builtin_amdgcn_sched_barrier(0)
__device__ __forceinline__ void cmask(f32x16&p0,f32x16&p1,int jb,int qrel,int hi){
  const float NEG=-INFINITY; int kb=64*jb+4*hi;
  #pragma unroll
  for(int r=0;r<16;++r){int kv=kb+(r&3)+8*(r>>2); if(kv>qrel)p0[r]=NEG; if(kv+32>qrel)p1[r]=NEG;}
}

constexpr int NSLOT=3, SLOTB=8192;
constexpr int LDS_K=0, LDS_V=NSLOT*SLOTB, LDS_WS=2*NSLOT*SLOTB, LDS_OST=LDS_WS+NW*64*4, LDS_BYTES=LDS_OST+NW*4096;
constexpr float C2=0.125f*1.4426950408889634f;
__device__ __forceinline__ void glds16(const void*gsrc,unsigned lds_dst){unsigned keep;
  asm volatile("s_mov_b32 %0, m0\n\ts_mov_b32 m0, %2\n\ts_nop 0\n\tglobal_load_lds_dwordx4 %1, off\n\ts_mov_b32 m0, %0":"=&s"(keep):"v"(gsrc),"s"(lds_dst):"memory");}
__device__ __forceinline__ float max3f(float a,float b,float c){float r;asm("v_max3_f32 %0, %1, %2, %3":"=v"(r):"v"(a),"v"(b),"v"(c));return r;}
__device__ __forceinline__ float max2f(float a,float b){float r;asm("v_max_f32_e32 %0, %1, %2":"=v"(r):"v"(a),"v"(b));return r;}
__device__ __forceinline__ float fadd_s(float a,float b){float r;asm("v_add_f32_e32 %0, %1, %2":"=v"(r):"v"(a),"v"(b));return r;}
__device__ __forceinline__ float fsub_s(float a,float b){float r;asm("v_sub_f32_e32 %0, %1, %2":"=v"(r):"v"(a),"v"(b));return r;}
typedef float f32x2_t __attribute__((ext_vector_type(2))); typedef __bf16 bf16x2_t __attribute__((ext_vector_type(2)));
__device__ __forceinline__ unsigned cvtpk_s(float lo,float hi){f32x2_t v={lo,hi};bf16x2_t b=__builtin_convertvector(v,bf16x2_t);return __builtin_bit_cast(unsigned,b);}
#define WAIT_BAR(N) asm volatile("s_waitcnt vmcnt(" #N ") lgkmcnt(0)\n\ts_barrier":::"memory")

__device__ __forceinline__ void qkt(f32x16&p0,f32x16&p1,const char*Kslot,const bf16x8*qr,const f32x16&negm,int r32,int hi){
  const char*kb=Kslot+hi*1024+r32*16;
  #pragma unroll
  for(int d0=0;d0<4;++d0){
    const bf16x8 b0=*reinterpret_cast<const bf16x8*>(kb+d0*2048);
    const bf16x8 b1=*reinterpret_cast<const bf16x8*>(kb+d0*2048+512);
    if(d0==0){p0=__builtin_amdgcn_mfma_f32_32x32x16_bf16(b0,qr[0],negm,0,0,0);p1=__builtin_amdgcn_mfma_f32_32x32x16_bf16(b1,qr[0],negm,0,0,0);}
    else{p0=__builtin_amdgcn_mfma_f32_32x32x16_bf16(b0,qr[d0],p0,0,0,0);p1=__builtin_amdgcn_mfma_f32_32x32x16_bf16(b1,qr[d0],p1,0,0,0);}}
}
typedef __attribute__((address_space(3))) const char* lds_cptr;
typedef short v4i16_t __attribute__((ext_vector_type(4)));
__device__ __forceinline__ void kload8(bf16x8*kf,lds_cptr kp){
  kf[0]=*(const __attribute__((address_space(3))) bf16x8*)(kp);      kf[1]=*(const __attribute__((address_space(3))) bf16x8*)(kp+512);
  kf[2]=*(const __attribute__((address_space(3))) bf16x8*)(kp+2048); kf[3]=*(const __attribute__((address_space(3))) bf16x8*)(kp+2560);
  kf[4]=*(const __attribute__((address_space(3))) bf16x8*)(kp+4096); kf[5]=*(const __attribute__((address_space(3))) bf16x8*)(kp+4608);
  kf[6]=*(const __attribute__((address_space(3))) bf16x8*)(kp+6144); kf[7]=*(const __attribute__((address_space(3))) bf16x8*)(kp+6656);
}
__device__ __forceinline__ void kload2(bf16x8*kf,lds_cptr kp,int j){ kf[2*j]=*(const __attribute__((address_space(3))) bf16x8*)(kp+j*2048); kf[2*j+1]=*(const __attribute__((address_space(3))) bf16x8*)(kp+j*2048+512); }
__device__ __forceinline__ s16x4 vtr(lds_cptr p){ return __builtin_bit_cast(s16x4,__builtin_amdgcn_ds_read_tr16_b64_v4i16((__attribute__((address_space(3))) v4i16_t*)p)); }
__device__ __forceinline__ float rowmax(const f32x16&p0,const f32x16&p1){
  float a=max3f(p0[0],p0[1],p1[0]),b=max3f(p0[2],p0[3],p1[1]);a=max3f(a,p1[2],p1[3]);
  #pragma unroll
  for(int r=4;r<16;r+=4){a=max3f(a,p0[r],p0[r+1]);b=max3f(b,p0[r+2],p0[r+3]);a=max3f(a,p1[r],p1[r+1]);b=max3f(b,p1[r+2],p1[r+3]);}
  const float m=max2f(a,b);
  auto rr=__builtin_amdgcn_permlane32_swap(__float_as_uint(m),__float_as_uint(m),false,false);
  return max2f(__uint_as_float(rr[0]),__uint_as_float(rr[1]));
}
__device__ __forceinline__ void pv(f32x16*o,int vb,bf16x8 pa0,bf16x8 pa1,bf16x8 pa2,bf16x8 pa3){
  #pragma unroll
  for(int d0=0;d0<2;++d0){s16x4 lo[4],hi[4];
    #pragma unroll
    for(int ks=0;ks<4;++ks){
      asm volatile("ds_read_b64_tr_b16 %0,%1 offset:%c2":"=&v"(lo[ks]):"v"(vb),"i"(d0*4096+ks*1024):"memory");
      asm volatile("ds_read_b64_tr_b16 %0,%1 offset:%c2":"=&v"(hi[ks]):"v"(vb),"i"(d0*4096+ks*1024+512):"memory");}
    asm volatile("s_waitcnt lgkmcnt(0)":::"memory");SBAR();
    #define PK(k) (bf16x8){lo[k][0],lo[k][1],lo[k][2],lo[k][3],hi[k][0],hi[k][1],hi[k][2],hi[k][3]}
    o[d0]=__builtin_amdgcn_mfma_f32_32x32x16_bf16(pa0,PK(0),o[d0],0,0,0);
    o[d0]=__builtin_amdgcn_mfma_f32_32x32x16_bf16(pa1,PK(1),o[d0],0,0,0);
    o[d0]=__builtin_amdgcn_mfma_f32_32x32x16_bf16(pa2,PK(2),o[d0],0,0,0);
    o[d0]=__builtin_amdgcn_mfma_f32_32x32x16_bf16(pa3,PK(3),o[d0],0,0,0);
    #undef PK
  }
}

#ifndef ATTN_STORE16
#define ATTN_STORE16(p,v) (*(u32x4*)(p)=(v))
#endif
template<int THRL> __device__ __forceinline__ void attn_unit(long qrow0,int qcol,int vcol,long kctx,long klat,int NT,const bf16*Q,const bf16*__restrict__ K,const bf16*__restrict__ V,bf16*O,char*shm){
  const int tid=threadIdx.x,lane=tid&63,r32=lane&31,hi=lane>>5; const int wid=__builtin_amdgcn_readfirstlane(tid>>6);

  const bf16*Qw=Q+(qrow0+wid*QBLK)*DM+qcol;
  const bf16*Kh=K+qcol,*Vh=V+vcol;
  const unsigned lds0=(unsigned)(uintptr_t)shm;
  float*wsf=(float*)(shm+LDS_WS)+wid*64;
  const bf16*ksrc=Kh+(long)lane*DM+wid*8;
  const bf16*vsrc=Vh+(long)(16*(wid&3)+(lane>>2))*DM+(wid>>2)*32+(lane&3)*8;
  const unsigned kdst=lds0+LDS_K+wid*1024, vdst=lds0+LDS_V+wid*1024;
  #define KVROW(t) ((t)<4?kctx+(long)(t)*KVBLK:klat+(long)((t)-4)*KVBLK)
  #define DMA_K(t,slot) glds16(ksrc+KVROW(t)*DM,(unsigned)__builtin_amdgcn_readfirstlane(kdst+(slot)))
  #define DMA_V(t,slot) glds16(vsrc+KVROW(t)*DM,(unsigned)__builtin_amdgcn_readfirstlane(vdst+(slot)))
  const int vb0=(int)(lds0+LDS_V)+((lane>>4)&1)*32+(lane&3)*8+(4*hi+((lane&15)>>2))*64;
  const char*Kbase=shm+LDS_K; bf16x8 kf[8];
  const lds_cptr shm3=(lds_cptr)shm; const lds_cptr kp0=shm3+LDS_K+hi*1024+r32*16; const lds_cptr vp0=shm3+LDS_V+((lane>>4)&1)*32+(lane&3)*8+(4*hi+((lane&15)>>2))*64;
  DMA_K(0,0);DMA_V(0,0);DMA_K(1,SLOTB);
  bf16x8 qr[4];
  #pragma unroll
  for(int d0=0;d0<4;++d0)qr[d0]=*reinterpret_cast<const bf16x8*>(&Qw[(long)r32*DM+d0*16+hi*8]);
  float mhat=0.f,l_reg=0.f;f32x16 o[2];o[0]=f32x16{};o[1]=f32x16{};f32x16 negm=f32x16{};asm volatile("":"+v"(negm));
  const int qrel=wid*QBLK+r32;
  #define CMASK(P0,P1,t) do{}while(0)
  bool resc=false;
  #define START(P0,P1) do{ const float rm=rowmax(P0,P1); resc=false; \
    { const float dl=rm; mhat=fadd_s(mhat,dl); \
      _Pragma("unroll") for(int r=0;r<16;++r){P0[r]=fsub_s(P0[r],dl);P1[r]=fsub_s(P1[r],dl);} \
      _Pragma("unroll") for(int r=0;r<16;++r)negm[r]=-mhat; asm volatile("":"+v"(negm)); } \
    _Pragma("unroll") for(int r=0;r<16;++r)P0[r]=__builtin_amdgcn_exp2f(P0[r]); }while(0)
  #define RESC() do{ if(resc){ asm volatile("s_waitcnt lgkmcnt(0)":::"memory"); \
      _Pragma("unroll") for(int d_=0;d_<2;++d_) _Pragma("unroll") for(int r=0;r<16;++r)o[d_][r]*=wsf[crow(r,hi)]; } }while(0)
  f32x16 pA0,pA1,pB0,pB1;
  int sl_prev=0,sl_cur=0,sl_next=SLOTB;
  #define ROT() do{sl_prev=sl_cur;sl_cur=sl_next;sl_next=(sl_next==(NSLOT-1)*SLOTB)?0:sl_next+SLOTB;}while(0)
  DMA_K(2,2*SLOTB);
  WAIT_BAR(3);
  qkt(pA0,pA1,Kbase,qr,negm,r32,hi);asm volatile("s_nop 15\n\ts_nop 7":"+v"(pA0),"+v"(pA1));CMASK(pA0,pA1,0);
  START(pA0,pA1);
  _Pragma("unroll") for(int r=0;r<16;++r)pA1[r]=__builtin_amdgcn_exp2f(pA1[r]);
  WAIT_BAR(0);
  DMA_K(3,0);DMA_V(1,SLOTB);
  ROT();
  kload8(kf,kp0+sl_cur);
  WAIT_BAR(2);
  s16x4 vlo[8],vhi[8]; u32x4 pw0,pw1,pw2,pw3;
  #define PKW(P,B) cvtpk_s(P[B],P[B+1])
  #define PAF(k) __builtin_bit_cast(bf16x8,pw##k)
  #define VFR(i) (bf16x8){vlo[i][0],vlo[i][1],vlo[i][2],vlo[i][3],vhi[i][0],vhi[i][1],vhi[i][2],vhi[i][3]}
  #define PIN(x) asm volatile("":"+v"(x))
  #define MX3(a,b,c) __builtin_fmaxf(__builtin_fmaxf((a),(b)),(c))
  #define GAPA(MF,A0,A1,A2,A3,W0,W1,PW) do{ MF; sacc+=A0; sacc+=A1; sacc+=A2; sacc+=A3; PIN(sacc); W0; W1; PIN(PW); SBAR(); }while(0)
  #define EX(v) __builtin_amdgcn_exp2f(v)
  #define GAPB(MF,X,B) do{ MF; X[B]=EX(X[B]); X[B+1]=EX(X[B+1]); X[B+2]=EX(X[B+2]); X[B+3]=EX(X[B+3]); PIN(X); SBAR(); }while(0)
  #define VRD(i) do{ vlo[i]=vtr(vp_+(((i)>>2)*4096+((i)&3)*1024)); vhi[i]=vtr(vp_+(((i)>>2)*4096+((i)&3)*1024+512)); }while(0)
  #define KRD(G,j) do{ if(G){ kload2(kf,kp0+sl_next,j); SBAR(); } }while(0)
  #define STEP(C0,C1,P0,P1,t,GK,GV,GL) do{ SBAR(); \
    const lds_cptr vp_=vp0+sl_prev; \
    VRD(0); SBAR(); float sacc=(P0[0]+P0[1]); \
    GAPA(C0=__builtin_amdgcn_mfma_f32_32x32x16_bf16(kf[0],qr[0],negm,0,0,0), P0[2],P0[3],P0[4],P0[5],     pw0[0]=PKW(P0,0), pw0[1]=PKW(P0,2), pw0); \
    VRD(4); SBAR(); GAPA(C1=__builtin_amdgcn_mfma_f32_32x32x16_bf16(kf[1],qr[0],negm,0,0,0), P0[6],P0[7],P0[8],P0[9],     pw0[2]=PKW(P0,4), pw0[3]=PKW(P0,6), pw0); \
    VRD(1); SBAR(); GAPA(C0=__builtin_amdgcn_mfma_f32_32x32x16_bf16(kf[2],qr[1],C0,0,0,0),   P0[10],P0[11],P0[12],P0[13], pw1[0]=PKW(P0,8), pw1[1]=PKW(P0,10), pw1); \
    VRD(5); SBAR(); GAPA(C1=__builtin_amdgcn_mfma_f32_32x32x16_bf16(kf[3],qr[1],C1,0,0,0),   P0[14],P0[15],P1[0],P1[1],   pw1[2]=PKW(P0,12),pw1[3]=PKW(P0,14), pw1); \
    VRD(2); SBAR(); GAPA(C0=__builtin_amdgcn_mfma_f32_32x32x16_bf16(kf[4],qr[2],C0,0,0,0),   P1[2],P1[3],P1[4],P1[5],     pw2[0]=PKW(P1,0), pw2[1]=PKW(P1,2), pw2); \
    VRD(6); SBAR(); GAPA(C1=__builtin_amdgcn_mfma_f32_32x32x16_bf16(kf[5],qr[2],C1,0,0,0),   P1[6],P1[7],P1[8],P1[9],     pw2[2]=PKW(P1,4), pw2[3]=PKW(P1,6), pw2); \
    VRD(3); SBAR(); GAPA(C0=__builtin_amdgcn_mfma_f32_32x32x16_bf16(kf[6],qr[3],C0,0,0,0),   P1[10],P1[11],P1[12],P1[13], pw3[0]=PKW(P1,8), pw3[1]=PKW(P1,10), pw3); \
    VRD(7); SBAR(); GAPA(C1=__builtin_amdgcn_mfma_f32_32x32x16_bf16(kf[7],qr[3],C1,0,0,0),   P1[14],P1[15],0.f,0.f,       pw3[2]=PKW(P1,12),pw3[3]=PKW(P1,14), pw3); \
    l_reg+=sacc; \
    if(GK){DMA_K((t)+3,sl_cur);} if(GV){DMA_V((t)+1,sl_next);} \
    CMASK(C0,C1,t); \
    { float a=MX3(C0[0],C0[1],C1[0]),b=MX3(C0[2],C0[3],C1[1]); a=MX3(a,C1[2],C1[3]); \
      _Pragma("unroll") for(int r=4;r<16;r+=4){a=MX3(a,C0[r],C0[r+1]);b=MX3(b,C0[r+2],C0[r+3]);a=MX3(a,C1[r],C1[r+1]);b=MX3(b,C1[r+2],C1[r+3]);} \
      float rm=__builtin_fmaxf(a,b); { auto rr=__builtin_amdgcn_permlane32_swap(__float_as_uint(rm),__float_as_uint(rm),false,false); rm=__builtin_fmaxf(__uint_as_float(rr[0]),__uint_as_float(rr[1])); } \
      resc=false; \
      if(__builtin_expect(__any(rm>(float)THRL),0)){ const float dl=__builtin_fmaxf(rm,0.f); mhat+=dl; \
        _Pragma("unroll") for(int r=0;r<16;++r){C0[r]-=dl;C1[r]-=dl;} \
        _Pragma("unroll") for(int r=0;r<16;++r)negm[r]=-mhat; asm volatile("":"+v"(negm)); \
        const float f=__builtin_amdgcn_exp2f(-dl); l_reg*=f; if(hi==0)wsf[r32]=f; resc=true; } } \
    SBAR(); \
    GAPB(o[0]=__builtin_amdgcn_mfma_f32_32x32x16_bf16(PAF(0),VFR(0),o[0],0,0,0), C0,0); \
    GAPB(o[1]=__builtin_amdgcn_mfma_f32_32x32x16_bf16(PAF(0),VFR(4),o[1],0,0,0), C0,4); \
    KRD(GL,0); GAPB(o[0]=__builtin_amdgcn_mfma_f32_32x32x16_bf16(PAF(1),VFR(1),o[0],0,0,0), C0,8); \
    KRD(GL,1); GAPB(o[1]=__builtin_amdgcn_mfma_f32_32x32x16_bf16(PAF(1),VFR(5),o[1],0,0,0), C0,12); \
    KRD(GL,2); GAPB(o[0]=__builtin_amdgcn_mfma_f32_32x32x16_bf16(PAF(2),VFR(2),o[0],0,0,0), C1,0); \
    KRD(GL,3); GAPB(o[1]=__builtin_amdgcn_mfma_f32_32x32x16_bf16(PAF(2),VFR(6),o[1],0,0,0), C1,4); \
    GAPB(o[0]=__builtin_amdgcn_mfma_f32_32x32x16_bf16(PAF(3),VFR(3),o[0],0,0,0), C1,8); \
    GAPB(o[1]=__builtin_amdgcn_mfma_f32_32x32x16_bf16(PAF(3),VFR(7),o[1],0,0,0), C1,12); \
    }while(0)
  int t=1;
  #undef CMASK
  #define CMASK(P0,P1,t) do{}while(0)
  for(;t+5<NT;t+=2){
    STEP(pB0,pB1,pA0,pA1,t,true,true,true);     WAIT_BAR(2); RESC(); ROT();
    STEP(pA0,pA1,pB0,pB1,t+1,true,true,true);   WAIT_BAR(2); RESC(); ROT();
  }
  #undef CMASK
  #define CMASK(P0,P1,t) do{}while(0)
  #define ENDW(tt) do{ if((tt)+3<NT){WAIT_BAR(2);} else if((tt)+2<NT){WAIT_BAR(1);} else {WAIT_BAR(0);} }while(0)
  for(;t+1<NT;t+=2){
    STEP(pB0,pB1,pA0,pA1,t,(t+3<NT),(t+1<NT),(t+1<NT));       ENDW(t);   RESC(); ROT();
    STEP(pA0,pA1,pB0,pB1,t+1,(t+4<NT),(t+2<NT),(t+2<NT));     ENDW(t+1); RESC(); ROT();
  }
  STEP(pB0,pB1,pA0,pA1,NT-1,false,false,false); RESC();
  { float sacc=pB0[0]+pB0[1]; _Pragma("unroll") for(int r=2;r<16;++r)sacc+=pB0[r]; _Pragma("unroll") for(int r=0;r<16;++r)sacc+=pB1[r]; l_reg+=sacc;
    pw0=(u32x4){PKW(pB0,0),PKW(pB0,2),PKW(pB0,4),PKW(pB0,6)};pw1=(u32x4){PKW(pB0,8),PKW(pB0,10),PKW(pB0,12),PKW(pB0,14)};pw2=(u32x4){PKW(pB1,0),PKW(pB1,2),PKW(pB1,4),PKW(pB1,6)};pw3=(u32x4){PKW(pB1,8),PKW(pB1,10),PKW(pB1,12),PKW(pB1,14)};
    SBAR(); pv(o,vb0+sl_cur,PAF(0),PAF(1),PAF(2),PAF(3)); }
  #undef PKW
  #undef PAF
  #undef VFR
  #undef PIN
  #undef MX3
  #undef GAPA
  #undef GAPB
  #undef EX
  #undef VRD
  #undef KRD
  #undef STEP
  #undef ENDW
  {auto rr=__builtin_amdgcn_permlane32_swap(__float_as_uint(l_reg),__float_as_uint(l_reg),false,false);l_reg=__uint_as_float(rr[0])+__uint_as_float(rr[1]);}
  if(hi==0)wsf[32+r32]=l_reg;asm volatile("s_waitcnt lgkmcnt(0)":::"memory");
  float rli[16];
  #pragma unroll
  for(int r=0;r<16;++r)rli[r]=__builtin_amdgcn_rcpf(wsf[32+crow(r,hi)]);
  bf16*Ow=O+(qrow0+wid*QBLK)*DM+vcol;
  { bf16*stg=(bf16*)(shm+LDS_OST)+wid*2048;
    #pragma unroll
    for(int r=0;r<16;++r){const int orow=crow(r,hi);
      #pragma unroll
      for(int d0=0;d0<2;++d0)stg[orow*64+d0*32+r32]=(bf16)f2bf(o[d0][r]*rli[r]);}
    asm volatile("s_waitcnt lgkmcnt(0)":::"memory");
    #pragma unroll
    for(int i=0;i<4;++i){const int row=i*8+(lane>>3),ch=lane&7; const u32x4 v=*(const u32x4*)(stg+row*64+ch*8); ATTN_STORE16(Ow+(long)row*DM+ch*8,v);} }
  asm volatile("s_waitcnt lgkmcnt(0)\n\ts_barrier":::"memory");
  #undef DMA_K
  #undef DMA_V
  #undef CMASK
  #undef START
  #undef RESC
  #undef ROT
}
constexpr int ATTN_LDS_BYTES=LDS_BYTES;
#undef SBAR
#undef WAIT_BAR
#undef KVROW
}
namespace attn_body {
constexpr int V2SLOT = 16384;
constexpr int L2_K = 0, L2_V = NSLOT * SLOTB, L2_WS = L2_V + NSLOT * V2SLOT, L2_ST = L2_WS + NW * 64 * 4, L2_BYTES = L2_ST + NW * 8192;
#define SBAR() __builtin_amdgcn_sched_barrier(0)
#define WAIT_BAR(N) asm volatile("s_waitcnt vmcnt(" #N ") lgkmcnt(0)\n\ts_barrier":::"memory")
template<int THRL> __device__ __forceinline__ void attn_unit2(long qrow0,int qcol,int vcol,long kctx,long klat,int NT,const bf16*Q,const bf16*__restrict__ K,const bf16*__restrict__ V,int m,float lam,const float*subln,unsigned char*A2,int acol,float km,char*shm){
  const int tid=threadIdx.x,lane=tid&63,r32=lane&31,hi=lane>>5; const int wid=__builtin_amdgcn_readfirstlane(tid>>6);
  const bf16*Qw=Q+(qrow0+wid*QBLK)*DM+qcol;
  const bf16*Kh=K+qcol,*Vh=V+vcol;
  const unsigned lds0=(unsigned)(uintptr_t)shm;
  float*wsf=(float*)(shm+L2_WS)+wid*64;
  const bf16*ksrc=Kh+(long)lane*DM+wid*8;
  const bf16*vsrc=Vh+(long)(16*(wid&3)+(lane>>2))*DM+(wid>>2)*32+(lane&3)*8;
  const unsigned kdst=lds0+L2_K+wid*1024, vdst=lds0+L2_V+wid*1024;
  #define KVROW(t) ((t)<4?kctx+(long)(t)*KVBLK:klat+(long)((t)-4)*KVBLK)
  #define DMA_K(t,slot) glds16(ksrc+KVROW(t)*DM,(unsigned)__builtin_amdgcn_readfirstlane(kdst+(slot)))
  #define DMA_V(t,slot) do{ glds16(vsrc+KVROW(t)*DM,(unsigned)__builtin_amdgcn_readfirstlane(vdst+2*(slot))); glds16(vsrc+KVROW(t)*DM+64,(unsigned)__builtin_amdgcn_readfirstlane(vdst+2*(slot)+8192)); }while(0)
  const char*Kbase=shm+L2_K; bf16x8 kf[8];
  const lds_cptr shm3=(lds_cptr)shm; const lds_cptr kp0=shm3+L2_K+hi*1024+r32*16; const lds_cptr vp0=shm3+L2_V+((lane>>4)&1)*32+(lane&3)*8+(4*hi+((lane&15)>>2))*64;
  DMA_K(0,0);DMA_V(0,0);DMA_K(1,SLOTB);
  bf16x8 qr[4];
  #pragma unroll
  for(int d0=0;d0<4;++d0)qr[d0]=*reinterpret_cast<const bf16x8*>(&Qw[(long)r32*DM+d0*16+hi*8]);
  bool FAST; { float qn=0.f;
    #pragma unroll
    for(int d0=0;d0<4;++d0){ const u32x4 u=__builtin_bit_cast(u32x4,qr[d0]); const unsigned a4[4]={u.x,u.y,u.z,u.w};
      #pragma unroll
      for(int i=0;i<4;++i){ const float lo=__uint_as_float(a4[i]<<16),h2=__uint_as_float(a4[i]&0xffff0000u); qn+=lo*lo+h2*h2; } }
    qn+=__shfl_xor(qn,32); FAST=__all(qn*km<=96.f*96.f)!=0; }
  float mhat=0.f,l_reg=0.f;f32x16 o[4];o[0]=f32x16{};o[1]=f32x16{};o[2]=f32x16{};o[3]=f32x16{};const f32x16 zero16=f32x16{};
  bool resc=false;
  #define START(P0,P1) do{ resc=false; if(FAST){ mhat=0.f; } else { const float rm=rowmax(P0,P1); mhat=rm; \
    _Pragma("unroll") for(int r=0;r<16;++r){P0[r]=fsub_s(P0[r],rm);P1[r]=fsub_s(P1[r],rm);} } \
    _Pragma("unroll") for(int r=0;r<16;++r)P0[r]=__builtin_amdgcn_exp2f(P0[r]); }while(0)
  #define RESC() do{ if(resc){ asm volatile("s_waitcnt lgkmcnt(0)":::"memory"); \
      _Pragma("unroll") for(int d_=0;d_<4;++d_) _Pragma("unroll") for(int r=0;r<16;++r)o[d_][r]*=wsf[crow(r,hi)]; } }while(0)
  int sl_prev=0,sl_cur=0,sl_next=SLOTB;
  #define ROT() do{sl_prev=sl_cur;sl_cur=sl_next;sl_next=(sl_next==(NSLOT-1)*SLOTB)?0:sl_next+SLOTB;}while(0)
  DMA_K(2,2*SLOTB);
  WAIT_BAR(4);
  #define PKW(P,B) cvtpk_s(P[B],P[B+1])
  u32x4 pwA0,pwA1,pwA2,pwA3,pwB0,pwB1,pwB2,pwB3;
  { f32x16 p0,p1;
    qkt(p0,p1,Kbase,qr,zero16,r32,hi);asm volatile("s_nop 15\n\ts_nop 7":"+v"(p0),"+v"(p1));
    START(p0,p1);
    _Pragma("unroll") for(int r=0;r<16;++r)p1[r]=__builtin_amdgcn_exp2f(p1[r]);
    float sacc=p0[0]+p0[1]; _Pragma("unroll") for(int r=2;r<16;++r)sacc+=p0[r]; _Pragma("unroll") for(int r=0;r<16;++r)sacc+=p1[r]; l_reg+=sacc;
    pwA0=(u32x4){PKW(p0,0),PKW(p0,2),PKW(p0,4),PKW(p0,6)};pwA1=(u32x4){PKW(p0,8),PKW(p0,10),PKW(p0,12),PKW(p0,14)};pwA2=(u32x4){PKW(p1,0),PKW(p1,2),PKW(p1,4),PKW(p1,6)};pwA3=(u32x4){PKW(p1,8),PKW(p1,10),PKW(p1,12),PKW(p1,14)}; }
  WAIT_BAR(0);
  DMA_K(3,0);DMA_V(1,SLOTB);
  ROT();
  kload8(kf,kp0+sl_cur);
  WAIT_BAR(3);
  s16x4 vAl[4],vAh[4],vBl[4],vBh[4];
  #define PAFX(x) __builtin_bit_cast(bf16x8,x)
  #define VF(A,d) (bf16x8){A##l[d][0],A##l[d][1],A##l[d][2],A##l[d][3],A##h[d][0],A##h[d][1],A##h[d][2],A##h[d][3]}
  #define PIN(x) asm volatile("":"+v"(x))
  #define MX3(a,b,c) __builtin_fmaxf(__builtin_fmaxf((a),(b)),(c))
  #define EX(v) __builtin_amdgcn_exp2f(v)
  #define VRDL(A,d,ks) A##l[d]=vtr(vp_+((d)*4096+(ks)*1024))
  #define VRDH(A,d,ks) A##h[d]=vtr(vp_+((d)*4096+(ks)*1024+512))
  #define GAPF(MF,X,B,PWN,W,RD) do{ MF; X[B]=EX(X[B]); X[B+1]=EX(X[B+1]); sacc+=X[B]; sacc+=X[B+1]; PIN(sacc); PWN[W]=cvtpk_s(X[B],X[B+1]); PIN(PWN); RD; SBAR(); }while(0)
  #define GAPP(MF,X,B,PWN,W,RD) do{ MF; X[B]=EX(X[B]-mhat); X[B+1]=EX(X[B+1]-mhat); sacc+=X[B]; sacc+=X[B+1]; PIN(sacc); PWN[W]=cvtpk_s(X[B],X[B+1]); PIN(PWN); RD; SBAR(); }while(0)
  #define MFQ(C,kf_,q_,acc_) C=__builtin_amdgcn_mfma_f32_32x32x16_bf16(kf_,q_,acc_,0,0,0)
  #define MFO(d,PW,A) o[d]=__builtin_amdgcn_mfma_f32_32x32x16_bf16(PAFX(PW),VF(A,d),o[d],0,0,0)
  #define KRD(G,j) do{ if(G){ kload2(kf,kp0+sl_next,j); } }while(0)
  #define PHASEB(G,PI0,PI1,PI2,PI3,PO0,PO1,PO2,PO3,GL) do{ \
    G(MFO(0,PI0,vA),C0,0, PO0,0, VRDL(vB,0,1);VRDH(vB,0,1)); \
    G(MFO(1,PI0,vA),C0,2, PO0,1, VRDL(vB,1,1);VRDH(vB,1,1)); \
    G(MFO(2,PI0,vA),C0,4, PO0,2, VRDL(vB,2,1);VRDH(vB,2,1)); \
    G(MFO(3,PI0,vA),C0,6, PO0,3, VRDL(vB,3,1);VRDH(vB,3,1)); \
    G(MFO(0,PI1,vB),C0,8, PO1,0, VRDL(vA,0,2);VRDH(vA,0,2)); \
    G(MFO(1,PI1,vB),C0,10,PO1,1, VRDL(vA,1,2);VRDH(vA,1,2)); \
    G(MFO(2,PI1,vB),C0,12,PO1,2, VRDL(vA,2,2);VRDH(vA,2,2)); \
    G(MFO(3,PI1,vB),C0,14,PO1,3, VRDL(vA,3,2);VRDH(vA,3,2)); \
    G(MFO(0,PI2,vA),C1,0, PO2,0, VRDL(vB,0,3);VRDH(vB,0,3)); \
    G(MFO(1,PI2,vA),C1,2, PO2,1, VRDL(vB,1,3);VRDH(vB,1,3)); \
    G(MFO(2,PI2,vA),C1,4, PO2,2, VRDL(vB,2,3);VRDH(vB,2,3)); \
    G(MFO(3,PI2,vA),C1,6, PO2,3, VRDL(vB,3,3);VRDH(vB,3,3)); \
    G(MFO(0,PI3,vB),C1,8, PO3,0, KRD(GL,0)); \
    G(MFO(1,PI3,vB),C1,10,PO3,1, KRD(GL,1)); \
    G(MFO(2,PI3,vB),C1,12,PO3,2, KRD(GL,2)); \
    G(MFO(3,PI3,vB),C1,14,PO3,3, KRD(GL,3)); \
    }while(0)
  #define STEP2(t,PI0,PI1,PI2,PI3,PO0,PO1,PO2,PO3,GK,GV,GL) do{ SBAR(); \
    const lds_cptr vp_=vp0+2*sl_prev; f32x16 C0,C1; float sacc=0.f; \
    VRDL(vA,0,0); SBAR(); MFQ(C0,kf[0],qr[0],zero16); SBAR(); \
    VRDH(vA,0,0); SBAR(); MFQ(C1,kf[1],qr[0],zero16); SBAR(); \
    VRDL(vA,1,0); SBAR(); MFQ(C0,kf[2],qr[1],C0); SBAR(); \
    VRDH(vA,1,0); SBAR(); MFQ(C1,kf[3],qr[1],C1); SBAR(); \
    VRDL(vA,2,0); SBAR(); MFQ(C0,kf[4],qr[2],C0); SBAR(); \
    VRDH(vA,2,0); SBAR(); MFQ(C1,kf[5],qr[2],C1); SBAR(); \
    VRDL(vA,3,0); SBAR(); MFQ(C0,kf[6],qr[3],C0); SBAR(); \
    VRDH(vA,3,0); SBAR(); MFQ(C1,kf[7],qr[3],C1); SBAR(); \
    if(GK){DMA_K((t)+3,sl_cur);} if(GV){DMA_V((t)+1,sl_next);} \
    if(!FAST){ float a=MX3(C0[0],C0[1],C1[0]),b=MX3(C0[2],C0[3],C1[1]); a=MX3(a,C1[2],C1[3]); \
      _Pragma("unroll") for(int r=4;r<16;r+=4){a=MX3(a,C0[r],C0[r+1]);b=MX3(b,C0[r+2],C0[r+3]);a=MX3(a,C1[r],C1[r+1]);b=MX3(b,C1[r+2],C1[r+3]);} \
      float rm=__builtin_fmaxf(a,b); { auto rr=__builtin_amdgcn_permlane32_swap(__float_as_uint(rm),__float_as_uint(rm),false,false); rm=__builtin_fmaxf(__uint_as_float(rr[0]),__uint_as_float(rr[1])); } \
      resc=false; \
      if(__builtin_expect(__any(rm-mhat>(float)THRL),0)){ const float dl=__builtin_fmaxf(rm-mhat,0.f); mhat+=dl; \
        const float f=__builtin_amdgcn_exp2f(-dl); l_reg*=f; if(hi==0)wsf[r32]=f; resc=true; } } \
    __builtin_amdgcn_s_setprio(1); SBAR(); \
    PHASEB(GAPP,PI0,PI1,PI2,PI3,PO0,PO1,PO2,PO3,GL); \
    __builtin_amdgcn_s_setprio(0); l_reg+=sacc; \
    }while(0)
  #define ENDW(tt) do{ if((tt)+3<NT){WAIT_BAR(3);} else if((tt)+2<NT){WAIT_BAR(2);} else {WAIT_BAR(0);} }while(0)
  int t=1;
  for(;t+5<NT;t+=2){
    STEP2(t,  pwA0,pwA1,pwA2,pwA3,pwB0,pwB1,pwB2,pwB3,true,true,true); WAIT_BAR(3); RESC(); ROT();
    STEP2(t+1,pwB0,pwB1,pwB2,pwB3,pwA0,pwA1,pwA2,pwA3,true,true,true); WAIT_BAR(3); RESC(); ROT();
  }
  for(;t+1<NT;t+=2){
    STEP2(t,  pwA0,pwA1,pwA2,pwA3,pwB0,pwB1,pwB2,pwB3,(t+3<NT),(t+1<NT),(t+1<NT)); ENDW(t);   RESC(); ROT();
    STEP2(t+1,pwB0,pwB1,pwB2,pwB3,pwA0,pwA1,pwA2,pwA3,(t+4<NT),(t+2<NT),(t+2<NT)); ENDW(t+1); RESC(); ROT();
  }
  STEP2(NT-1,pwA0,pwA1,pwA2,pwA3,pwB0,pwB1,pwB2,pwB3,false,false,false); RESC();
  { const lds_cptr vp_=vp0+2*sl_cur;
    #pragma unroll
    for(int ks=0;ks<4;++ks){
      #pragma unroll
      for(int d=0;d<4;++d){ const s16x4 lo=vtr(vp_+(d*4096+ks*1024)),hh=vtr(vp_+(d*4096+ks*1024+512)); const bf16x8 vf=(bf16x8){lo[0],lo[1],lo[2],lo[3],hh[0],hh[1],hh[2],hh[3]};
        const u32x4 pw=(ks==0)?pwB0:(ks==1)?pwB1:(ks==2)?pwB2:pwB3;
        o[d]=__builtin_amdgcn_mfma_f32_32x32x16_bf16(PAFX(pw),vf,o[d],0,0,0); } } }
  {auto rr=__builtin_amdgcn_permlane32_swap(__float_as_uint(l_reg),__float_as_uint(l_reg),false,false);l_reg=__uint_as_float(rr[0])+__uint_as_float(rr[1]);}
  if(hi==0)wsf[32+r32]=l_reg;asm volatile("s_waitcnt lgkmcnt(0)":::"memory");
  float rli[16];
  #pragma unroll
  for(int r=0;r<16;++r)rli[r]=__builtin_amdgcn_rcpf(wsf[32+crow(r,hi)]);
  unsigned short*stash=(unsigned short*)(shm+L2_ST)+wid*4096;
  if(m==0){
    #pragma unroll
    for(int d0=0;d0<4;++d0){
      #pragma unroll
      for(int r=0;r<16;++r)stash[(d0*16+r)*64+lane]=(unsigned short)f2bf(o[d0][r]*rli[r]);}
    asm volatile("s_waitcnt lgkmcnt(0)":::"memory");
  } else {
    float ss[16];
    #pragma unroll
    for(int r=0;r<16;++r)ss[r]=0.f;
    #pragma unroll
    for(int d0=0;d0<4;++d0){
      #pragma unroll
      for(int r=0;r<16;++r){ const float o1=bf2f(stash[(d0*16+r)*64+lane]); const float df=o1-lam*(o[d0][r]*rli[r]); o[d0][r]=df; ss[r]+=df*df; } }
    #pragma unroll
    for(int r=0;r<16;++r){ float q=ss[r];
      #pragma unroll
      for(int s_=1;s_<32;s_<<=1)q+=__shfl_xor(q,s_);
      ss[r]=(1.f-LAMBDA_INIT0)/sqrtf(q*(1.f/128.f)+LN_EPS); }
    asm volatile("s_waitcnt lgkmcnt(0)":::"memory");
    unsigned char*stg=(unsigned char*)stash;
    #pragma unroll
    for(int d0=0;d0<4;++d0){ const float sgv=subln[d0*32+r32];
      #pragma unroll
      for(int r=0;r<16;++r){ const int w8=__builtin_amdgcn_cvt_pk_fp8_f32(o[d0][r]*ss[r]*sgv,0.f,0,false); stg[crow(r,hi)*128+d0*32+r32]=(unsigned char)(w8&0xff); } }
    asm volatile("s_waitcnt lgkmcnt(0)":::"memory");
    unsigned char*Aw=A2+(qrow0+wid*QBLK)*DM+acol;
    #pragma unroll
    for(int i=0;i<4;++i){const int row=i*8+(lane>>3),ch=lane&7; const u32x4 v=*(const u32x4*)(stg+row*128+ch*16); *(u32x4*)(Aw+(long)row*DM+ch*16)=v;}
    asm volatile("s_waitcnt lgkmcnt(0)":::"memory");
  }
  asm volatile("s_waitcnt lgkmcnt(0)\n\ts_barrier":::"memory");
  #undef KVROW
  #undef DMA_K
  #undef DMA_V
  #undef START
  #undef RESC
  #undef ROT
  #undef PKW
  #undef PAFX
  #undef VF
  #undef PIN
  #undef MX3
  #undef EX
  #undef VRDL
  #undef VRDH
  #undef GAPP
  #undef GAPF
  #undef PHASEB
  #undef MFQ
  #undef MFO
  #undef KRD
  #undef STEP2
  #undef ENDW
}
#undef SBAR
#undef WAIT_BAR
}
__device__ __forceinline__ void phase_attn2(const Frame& F, const Prm& p) {
    const bf16* Q = (const bf16*)(p.ws + WS_Q); const bf16* K = (const bf16*)(p.ws + WS_K); const bf16* V = (const bf16*)(p.ws + WS_V); unsigned char* A2 = p.ws + WS_O1;
    const float lam = ((const float*)(p.ws + WS_MISC))[0];
    for (int v = vcu_of(F); v < 256; v += F.G) {
        const int b = v >> 5, h = (v >> 2) & 7, part = v & 3;
        const long kctx = NLAT + b * CTXL, klat = (long)b * SEQ;
        const int nu = part ? 4 : 5;
        for (int i = 0; i < nu; ++i) {
            const long qrow0 = i < 4 ? klat + (part * 4 + i) * 256 : kctx; const int NT = i < 4 ? 68 : 4;
            for (int m = 0; m < 2; ++m) {
                const int hm = 2 * h + m;
                const float km = __uint_as_float(__hip_atomic_load(F.ctl + CW_KM + b * 16 + hm, __ATOMIC_RELAXED, __HIP_MEMORY_SCOPE_AGENT));
                attn_body::attn_unit2<8>(qrow0, hm * 64, h * 128, kctx, klat, NT, Q, K, V, m, lam, p.subln, A2, h * 128, km, (char*)F.lds);
            }
        }
    }
}
namespace gla3 {
typedef short bf16x8 __attribute__((ext_vector_type(8)));
typedef short s16x4 __attribute__((ext_vector_type(4)));
typedef float f32x16 __attribute__((ext_vector_type(16)));
constexpr int CH = 64 * 16 + 64;
constexpr int L_QS = 0, L_KS = 16 * CH, L_VS = 32 * CH, L_SB = 40 * CH, L_X = 56 * CH, L_DEC = L_X + 16384, L_END = L_DEC + 512;
__device__ __forceinline__ int crow(int i, int hh) { return (i & 3) + 8 * (i >> 2) + 4 * hh; }
typedef float f32x2_t __attribute__((ext_vector_type(2))); typedef __bf16 bf16x2_t __attribute__((ext_vector_type(2)));
__device__ __forceinline__ unsigned pk(float lo, float hi) { f32x2_t v = {lo, hi}; bf16x2_t b = __builtin_convertvector(v, bf16x2_t); return __builtin_bit_cast(unsigned, b); }
typedef short v4i16_t __attribute__((ext_vector_type(4)));
__device__ __forceinline__ s16x4 trrd(LAS const unsigned char* p) { return __builtin_bit_cast(s16x4, __builtin_amdgcn_ds_read_tr16_b64_v4i16((LAS v4i16_t*)p)); }
#define GLA_FR(lo, hi) (bf16x8){lo[0], lo[1], lo[2], lo[3], hi[0], hi[1], hi[2], hi[3]}

__device__ __forceinline__ void scan_unit(const Frame& F, const Prm& p, int unit) {
    const int dvs = unit & 3, dir = (unit >> 2) & 1, h = (unit >> 3) & 3, b = unit >> 5;
    LAS unsigned char* lds = (LAS unsigned char*)F.lds;
    const int lane = F.lane, w = F.wave, tid = F.tid, r = lane & 31, hh = lane >> 5;
    const bf16* QT = (const bf16*)(p.ws + WS_QT) + ((size_t)dir * 8 + 2 * h) * NTOK * 64;
    const bf16* KT = (const bf16*)(p.ws + WS_KT) + ((size_t)dir * 8 + 2 * h) * NTOK * 64;
    const bf16* V = (const bf16*)(p.ws + WS_V1) + h * 256 + dvs * 64;
    const float* DEC = (const float*)(p.ws + WS_DEC) + (size_t)dir * NCHUNK * 512 + h * 128;
    bf16* OG = (bf16*)((unsigned char*)p.out + (dir ? OUT_OGB : 0)) + h * 256 + dvs * 64;
    const int g1 = (lane >> 4) & 1, q4 = (lane & 15) >> 2, p4 = lane & 3;
    const int trb = (2 * g1 + (p4 >> 1)) * CH + q4 * 16 + 8 * (p4 & 1);
    const int trN = trb + 128 * hh, trP = trb + 64 * hh;
    f32x16 S0 = {}, S1 = {};
    for (int i = tid; i < 16 * CH / 16; i += NTHR) *(LAS u32x4*)(lds + L_SB + i * 16) = (u32x4){0u, 0u, 0u, 0u};
    u32x4 pq0[2], pq1[2], pk0[2], pk1[2], pv[2]; float pdec[2] = {0.f, 0.f};
#define GLA_CHUNK(step) ((step) >= 4 ? b * 64 + (dir ? 63 - ((step) - 4) : (step) - 4) : 512 + b * 4 + (dir ? 3 - (step) : (step)))
    const int qrow = 8 * w + (lane >> 4), qch = lane & 15, vrow = 8 * w + (lane >> 3), vch = lane & 7;
    const size_t qgo = (size_t)(qch >> 3) * NTOK * 64 + (qch & 7) * 8;
#define GLA_LOAD(step, u) do { const size_t t0_ = (size_t)GLA_CHUNK(step) * 64; \
        pq0[u] = *(const u32x4*)(QT + qgo + (t0_ + qrow) * 64); pq1[u] = *(const u32x4*)(QT + qgo + (t0_ + qrow + 4) * 64); \
        pk0[u] = *(const u32x4*)(KT + qgo + (t0_ + qrow) * 64); pk1[u] = *(const u32x4*)(KT + qgo + (t0_ + qrow + 4) * 64); \
        pv[u] = *(const u32x4*)(V + (t0_ + vrow) * 1024 + 8 * vch); if (tid < 128) pdec[u] = DEC[(size_t)GLA_CHUNK(step) * 512 + tid]; } while (0)
#define GLA_STORE(u) do { \
        *(LAS u32x4*)(lds + L_QS + qch * CH + qrow * 16) = pq0[u]; *(LAS u32x4*)(lds + L_QS + qch * CH + (qrow + 4) * 16) = pq1[u]; \
        *(LAS u32x4*)(lds + L_KS + qch * CH + qrow * 16) = pk0[u]; *(LAS u32x4*)(lds + L_KS + qch * CH + (qrow + 4) * 16) = pk1[u]; \
        *(LAS u32x4*)(lds + L_VS + vch * CH + vrow * 16) = pv[u]; \
        if (tid < 128) *(LAS float*)(lds + L_DEC + 4 * tid) = pdec[u]; } while (0)
    GLA_LOAD(0, 0);
    GLA_LOAD(1, 1);
    GLA_STORE(0);
    __syncthreads();
    const int tb = (w & 3) >> 1, vb = w & 1;
    for (int sp2 = 0; sp2 < 34; ++sp2) {
#pragma unroll
    for (int u = 0; u < 2; ++u) {
        const int step = 2 * sp2 + u;
        const bool lat = step >= 4; const int chunk = GLA_CHUNK(step);
        if (step + 2 < 68) GLA_LOAD(step + 2, u);
        f32x16 o = {};
        if (w < 4) {
            if (lat) {
                const bool n0 = dir ? (tb == 0) : true, n1 = dir ? true : (tb == 1);
                f32x16 sc0 = {}, sc1 = {};
#define GLA_BQ(ks) (*(const LAS bf16x8*)(lds + L_QS + (2 * (ks) + hh) * CH + (32 * tb + r) * 16))
#define GLA_A0(ks) (*(const LAS bf16x8*)(lds + L_KS + (2 * (ks) + hh) * CH + r * 16))
#define GLA_A1(ks) (*(const LAS bf16x8*)(lds + L_KS + (2 * (ks) + hh) * CH + (32 + r) * 16))
                if (n0 && n1) {
#pragma unroll
                    for (int ks = 0; ks < 8; ++ks) { const bf16x8 bq = GLA_BQ(ks); sc0 = __builtin_amdgcn_mfma_f32_32x32x16_bf16(GLA_A0(ks), bq, sc0, 0, 0, 0); sc1 = __builtin_amdgcn_mfma_f32_32x32x16_bf16(GLA_A1(ks), bq, sc1, 0, 0, 0); }
                } else if (n0) {
#pragma unroll
                    for (int ks = 0; ks < 8; ++ks) sc0 = __builtin_amdgcn_mfma_f32_32x32x16_bf16(GLA_A0(ks), GLA_BQ(ks), sc0, 0, 0, 0);
                } else {
#pragma unroll
                    for (int ks = 0; ks < 8; ++ks) sc1 = __builtin_amdgcn_mfma_f32_32x32x16_bf16(GLA_A1(ks), GLA_BQ(ks), sc1, 0, 0, 0);
                }
#undef GLA_BQ
#undef GLA_A0
#undef GLA_A1
                const int t = 32 * tb + r;
#pragma unroll
                for (int i = 0; i < 16; ++i) { const int s0 = crow(i, hh), s1 = 32 + s0; const bool k0 = dir ? (s0 >= t) : (s0 <= t), k1 = dir ? (s1 >= t) : (s1 <= t); sc0[i] = k0 ? sc0[i] : 0.f; sc1[i] = k1 ? sc1[i] : 0.f; }
#pragma unroll
                for (int sb = 0; sb < 2; ++sb) { if (sb == 0 ? n0 : n1) {
#pragma unroll
                    for (int sp = 0; sp < 2; ++sp) {
                        u32x4 pw;
                        if (sb == 0) { pw.x = pk(sc0[8 * sp + 0], sc0[8 * sp + 1]); pw.y = pk(sc0[8 * sp + 2], sc0[8 * sp + 3]); pw.z = pk(sc0[8 * sp + 4], sc0[8 * sp + 5]); pw.w = pk(sc0[8 * sp + 6], sc0[8 * sp + 7]); }
                        else { pw.x = pk(sc1[8 * sp + 0], sc1[8 * sp + 1]); pw.y = pk(sc1[8 * sp + 2], sc1[8 * sp + 3]); pw.z = pk(sc1[8 * sp + 4], sc1[8 * sp + 5]); pw.w = pk(sc1[8 * sp + 6], sc1[8 * sp + 7]); }
                        LAS const unsigned char* vp = lds + L_VS + trP + (4 * vb) * CH + (32 * sb + 16 * sp) * 16;
                        const s16x4 lo = trrd(vp), hi = trrd(vp + 8 * 16);
                        o = __builtin_amdgcn_mfma_f32_32x32x16_bf16(GLA_FR(lo, hi), __builtin_bit_cast(bf16x8, pw), o, 0, 0, 0);
                    } } }
            }
        } else {
            const int db = w - 4;
            if (lat) {
                f32x16 o2 = {};
#pragma unroll
                for (int ks = 0; ks < 8; ++ks) {
                    const bf16x8 as = *(const LAS bf16x8*)(lds + L_SB + (2 * ks + hh) * CH + (32 * vb + r) * 16);
                    const bf16x8 bq = *(const LAS bf16x8*)(lds + L_QS + (2 * ks + hh) * CH + (32 * tb + r) * 16);
                    o2 = __builtin_amdgcn_mfma_f32_32x32x16_bf16(as, bq, o2, 0, 0, 0);
                }
#pragma unroll
                for (int g = 0; g < 4; ++g) *(LAS f32x4*)(lds + L_X + (w & 3) * 4096 + g * 1024 + lane * 16) = (f32x4){o2[4 * g], o2[4 * g + 1], o2[4 * g + 2], o2[4 * g + 3]};
            }
#pragma unroll
            for (int ks = 0; ks < 4; ++ks) {
                LAS const unsigned char* kp = lds + L_KS + trN + (4 * db) * CH + (16 * ks) * 16;
                LAS const unsigned char* vp = lds + L_VS + trN + (16 * ks) * 16;
                const s16x4 al = trrd(kp), ah = trrd(kp + 4 * 16);
                const s16x4 b0l = trrd(vp), b0h = trrd(vp + 4 * 16), b1l = trrd(vp + 4 * CH), b1h = trrd(vp + 4 * CH + 4 * 16);
                S0 = __builtin_amdgcn_mfma_f32_32x32x16_bf16(GLA_FR(al, ah), GLA_FR(b0l, b0h), S0, 0, 0, 0); S1 = __builtin_amdgcn_mfma_f32_32x32x16_bf16(GLA_FR(al, ah), GLA_FR(b1l, b1h), S1, 0, 0, 0);
            }
#pragma unroll
            for (int i = 0; i < 16; ++i) { const float dc = *(const LAS float*)(lds + L_DEC + 4 * (32 * db + crow(i, hh))); S0[i] *= dc; S1[i] *= dc; }
        }
        __syncthreads();
        if (w < 4 && lat) {
            bf16* orow = OG + ((size_t)chunk * 64 + 32 * tb + r) * DM + 32 * vb + 4 * hh;
#pragma unroll
            for (int g = 0; g < 4; ++g) { const f32x4 x = *(const LAS f32x4*)(lds + L_X + w * 4096 + g * 1024 + lane * 16);
                u32x2 wv; wv.x = pk(o[4 * g] + x.x, o[4 * g + 1] + x.y); wv.y = pk(o[4 * g + 2] + x.z, o[4 * g + 3] + x.w); *(u32x2*)(orow + 8 * g) = wv; }
        }
        if (step + 1 < 68) {
            GLA_STORE(u ^ 1);
            if (w >= 4) { const int db = w - 4;
#pragma unroll
                for (int g = 0; g < 4; ++g) { u32x2 w0, w1; w0.x = pk(S0[4 * g], S0[4 * g + 1]); w0.y = pk(S0[4 * g + 2], S0[4 * g + 3]); w1.x = pk(S1[4 * g], S1[4 * g + 1]); w1.y = pk(S1[4 * g + 2], S1[4 * g + 3]);
                    *(LAS u32x2*)(lds + L_SB + (4 * db + g) * CH + r * 16 + 8 * hh) = w0; *(LAS u32x2*)(lds + L_SB + (4 * db + g) * CH + (32 + r) * 16 + 8 * hh) = w1; } }
        }
        __syncthreads();
    }
    }
#undef GLA_CHUNK
#undef GLA_LOAD
#undef GLA_STORE
}
#undef GLA_FR
}
__device__ __forceinline__ void phase_scan_opt(const Frame& F, const Prm& p) {
    for (int unit = vcu_of(F); unit < 256; unit += F.G) gla3::scan_unit(F, p, unit);
}
#define PHASE_QKV(F, p) phase_qkv_opt(F, p)
#define PHASE_ATTN(F, p) phase_attn2(F, p)
#define PHASE_WO(F, p, l) phase_wo_opt(F, p, l)
#define PHASE_MOE1(F, p, l) phase_moe1_opt(F, p, l)
#define PHASE_MOE2(F, p, l) phase_moe2_opt(F, p, l)
#define PHASE_INPROJ(F, p) phase_inproj_opt(F, p)
#define PHASE_SCAN(F, p) phase_scan_opt(F, p)
typedef GAS unsigned gu32;
#define XB_TMO      128
#define XB_XCNT(j)  (256  + 64 * (j))
#define XB_XSUB(j)  (1280 + 64 * (j))
#define XB_XGEN(j)  (2304 + 64 * (j))
#define XB_TOP      3328
#define XB_TOPGEN   3392
#define XCD_BAR_WORDS 3456
#define XB_SPIN_CAP (1u << 20)
__device__ __forceinline__ unsigned xb_ld(unsigned* p)              { return __hip_atomic_load(p, __ATOMIC_RELAXED, __HIP_MEMORY_SCOPE_AGENT); }
__device__ __forceinline__ unsigned xb_add(unsigned* p, unsigned v) { return __hip_atomic_fetch_add(p, v, __ATOMIC_RELAXED, __HIP_MEMORY_SCOPE_AGENT); }
__device__ __forceinline__ unsigned xb_xcc_id() { return (unsigned)__builtin_amdgcn_s_getreg((3 << 11) | 20) & 0xFu; }
#define XB_SPIN(cond, bar) do { unsigned _sp = 0; while (cond) { __builtin_amdgcn_s_sleep(1); \
    if ((++_sp & 255u) == 0u) { if (xb_ld(&(bar)[XB_TMO])) break; if (_sp > XB_SPIN_CAP) { atomicAdd(&(bar)[XB_TMO], 1u); break; } } } } while (0)
struct XcdBarrier { unsigned* bar; unsigned x; volatile LAS unsigned* st; };
__device__ __forceinline__ XcdBarrier xcd_barrier_post(unsigned* bar, volatile LAS unsigned* st) {
    XcdBarrier b; b.bar = bar; b.x = xb_xcc_id(); b.st = st;
    if (threadIdx.x == 0) (void)xb_add(&bar[XB_XCNT(b.x)], 1u);
    return b;
}
__device__ __forceinline__ void xcd_barrier_complete(unsigned* bar, unsigned x, unsigned& nloc, unsigned& nx) {
    const unsigned G = gridDim.x * gridDim.y * gridDim.z;
    unsigned sum, cnt, mine, sp = 0u;
    for (;;) {
        sum = 0u; cnt = 0u; mine = 0u;
#pragma unroll
        for (unsigned j = 0; j < 16; ++j) { const unsigned c = xb_ld(&bar[XB_XCNT(j)]); sum += c; cnt += (c > 0u) ? 1u : 0u; mine = (j == x) ? c : mine; }
        if (sum == G) break;
        __builtin_amdgcn_s_sleep(1);
        if ((++sp & 255u) == 0u) { if (xb_ld(&bar[XB_TMO])) break; if (sp > XB_SPIN_CAP) { atomicAdd(&bar[XB_TMO], 1u); break; } }
    }
    nloc = mine > 0u ? mine : 1u; nx = cnt > 0u ? cnt : 1u;
}
__device__ __forceinline__ void xcd_barrier(const XcdBarrier& b) {
    asm volatile("s_waitcnt vmcnt(0)" ::: "memory");
    __syncthreads();
    if (threadIdx.x == 0) {
        unsigned* bar = b.bar;
        __builtin_amdgcn_s_waitcnt(0);
        unsigned nloc = b.st[0], nx = b.st[1];
        if (nloc == 0u) { xcd_barrier_complete(bar, b.x, nloc, nx); b.st[0] = nloc; b.st[1] = nx; }
        const unsigned old = xb_add(&bar[XB_XSUB(b.x)], 1u);
        const unsigned gen = old / nloc;
        if (old + 1u == (gen + 1u) * nloc) {
            __builtin_amdgcn_fence(__ATOMIC_RELEASE, "agent");
            asm volatile("s_waitcnt vmcnt(0)" ::: "memory");
            const unsigned og = xb_add(&bar[XB_TOP], 1u);
            const unsigned tg = og / nx;
            if (og + 1u == (tg + 1u) * nx) xb_add(&bar[XB_TOPGEN], 1u);
            else XB_SPIN(xb_ld(&bar[XB_TOPGEN]) == tg, bar);
            __builtin_amdgcn_fence(__ATOMIC_ACQUIRE, "agent");
            xb_add(&bar[XB_XGEN(b.x)], 1u);
            asm volatile("s_waitcnt vmcnt(0)" ::: "memory");
        } else {
            XB_SPIN(xb_ld(&bar[XB_XGEN(b.x)]) == gen, bar);
            __builtin_amdgcn_fence(__ATOMIC_ACQUIRE, "agent");
            asm volatile("s_waitcnt vmcnt(0)" ::: "memory");
        }
    }
    __syncthreads();
}

constexpr int NPHASE = 19;
#ifndef OPT_MASK
#define OPT_MASK 0u
#endif
__global__ void __launch_bounds__(NTHR, 2) mega_fwd(Prm p) {
    extern __shared__ __attribute__((aligned(16))) unsigned char lds[];
    Frame F; F.lds = lds; F.ctl = (unsigned*)(p.ws + WS_CTL);
    F.tid = threadIdx.x; F.lane = F.tid & 63; F.wave = __builtin_amdgcn_readfirstlane(F.tid >> 6); F.G = gridDim.x; F.bid = blockIdx.x;
    for (int u = F.tid; u < (LDS_BYTES - LDSCTL_OFF) / 4; u += NTHR) ((LAS unsigned*)(lds + LDSCTL_OFF))[u] = 0u;
    __syncthreads();
    const int lo = p.ph_lo, hi = p.ph_hi;
    const bool multi = (hi - lo) > 1;
    XcdBarrier bar; bar.bar = F.ctl + CW_BAR + p.li * XCD_BAR_WORDS; bar.x = 0; bar.st = nullptr;
    if (multi) bar = xcd_barrier_post(F.ctl + CW_BAR + p.li * XCD_BAR_WORDS, (volatile LAS unsigned*)(lds + MISC_OFF) + 8);
#define IN(k) (lo <= (k) && (k) < hi)
#define SEAM(k) do { if (IN(k) && IN((k) + 1)) xcd_barrier(bar); } while (0)
#ifndef REP_MASK
#define REP_MASK 0u
#endif
#define REP(k, call) do { if (((REP_MASK) >> (k)) & 1u) { xcd_barrier(bar); call; } } while (0)
    if (IN(0)) { phase_prologue(F, p); REP(0, phase_prologue(F, p)); } SEAM(0);
    if (IN(1)) { phase_modulate0(F, p); REP(1, phase_modulate0(F, p)); } SEAM(1);
#ifdef PROBE_QKV_NOSTORE
    if (IN(2)) { PHASE_QKV(F, p); xcd_barrier(bar); phase_qkv_opt(F, p, true); } SEAM(2);
#else
    if (IN(2)) { PHASE_QKV(F, p); REP(2, PHASE_QKV(F, p)); } SEAM(2);
#endif
    if (IN(3)) { PHASE_ATTN(F, p); REP(3, PHASE_ATTN(F, p)); } SEAM(3);
    if (IN(5)) { PHASE_WO(F, p, 0); REP(5, PHASE_WO(F, p, 0)); } SEAM(5);
    if (IN(6)) { phase_ln_route(F, p, 0); REP(6, phase_ln_route(F, p, 0)); } SEAM(6);
    if (IN(7)) { PHASE_MOE1(F, p, 0); REP(7, PHASE_MOE1(F, p, 0)); } SEAM(7);
    if (IN(8)) { PHASE_MOE2(F, p, 0); REP(8, PHASE_MOE2(F, p, 0)); } SEAM(8);
    if (IN(9)) { phase_moe_combine(F, p, 0); REP(9, phase_moe_combine(F, p, 0)); } SEAM(9);
    if (IN(10)) { PHASE_INPROJ(F, p); REP(10, PHASE_INPROJ(F, p)); } SEAM(10);
    if (IN(11)) { phase_gla_prep(F, p); REP(11, phase_gla_prep(F, p)); } SEAM(11);
    if (IN(12)) { PHASE_SCAN(F, p); REP(12, PHASE_SCAN(F, p)); } SEAM(12);
    if (IN(13)) { phase_gla_post(F, p); REP(13, phase_gla_post(F, p)); } SEAM(13);
    if (IN(14)) { PHASE_WO(F, p, 1); REP(14, PHASE_WO(F, p, 1)); } SEAM(14);
    if (IN(15)) { phase_ln_route(F, p, 1); REP(15, phase_ln_route(F, p, 1)); } SEAM(15);
    if (IN(16)) { PHASE_MOE1(F, p, 1); REP(16, PHASE_MOE1(F, p, 1)); } SEAM(16);
    if (IN(17)) { PHASE_MOE2(F, p, 1); REP(17, PHASE_MOE2(F, p, 1)); } SEAM(17);
    if (IN(18)) { phase_moe_combine(F, p, 1); REP(18, phase_moe_combine(F, p, 1)); }
#undef IN
#undef SEAM
}

extern "C" void kernel_launch(void* const* d_in, const int* in_sizes, int n_in, void* d_out, int out_size, void* d_ws, size_t ws_size, hipStream_t stream) {
    static int grid = 0;
    if (grid == 0) {
        if (n_in != 23 || in_sizes[0] != NLAT * DM || out_size != NLAT * DM || ws_size < WS_END) { fprintf(stderr, "kernel_launch: unexpected shapes (n_in %d, in0 %d, out %d, ws %zu); nothing launched\n", n_in, n_in > 0 ? in_sizes[0] : -1, out_size, ws_size); grid = -1; return; }
        int dev = 0, cus = 0;
        if (hipGetDevice(&dev) != hipSuccess || hipDeviceGetAttribute(&cus, hipDeviceAttributeMultiprocessorCount, dev) != hipSuccess) { grid = -1; return; }
        if (hipFuncSetAttribute((const void*)mega_fwd, hipFuncAttributeMaxDynamicSharedMemorySize, LDS_BYTES) != hipSuccess) { fprintf(stderr, "kernel_launch: hipFuncSetAttribute failed\n"); grid = -1; return; }
        int per_cu = 0;
        if (hipOccupancyMaxActiveBlocksPerMultiprocessor(&per_cu, (const void*)mega_fwd, NTHR, LDS_BYTES) != hipSuccess || per_cu < 1) fprintf(stderr, "kernel_launch: note: occupancy query reports %d\n", per_cu);
        (void)hipGetLastError();
        grid = cus;
    }
    if (grid < 0) return;
    (void)hipMemsetAsync((char*)d_ws + WS_CTL, 0, CTL_ZERO_BYTES, stream);
    Prm p{};
    const float** pp = (const float**)&p;
    for (int i = 0; i < 23; ++i) pp[i] = (const float*)d_in[i];
    p.out = (float*)d_out; p.ws = (unsigned char*)d_ws;
    p.ph_lo = 0; p.ph_hi = NPHASE; p.li = 0;
    hipLaunchKernelGGL(mega_fwd, dim3(grid), dim3(NTHR), LDS_BYTES, stream, p);
}
```

```cpp
#define OPT_MASK 0x355ACu
#include <hip/hip_runtime.h>
#include <cstdint>
#include <cstdio>

constexpr int BATCH = 8, SEQ = 4096, DM = 1024, CTXL = 256;
constexpr int NLAT = BATCH * SEQ, NCTX = BATCH * CTXL, NTOK = NLAT + NCTX;
constexpr float ALPHA = 1.4142135623730951f;
constexpr float LN_EPS = 1e-5f;
constexpr float LAMBDA_INIT0 = 0.2f;
constexpr float C2 = 0.125f * 1.4426950408889634f;
constexpr int NEXP = 16, DEXP = 512, MAXSLOT = 73728;
constexpr int NCHUNK = NTOK / 64;
constexpr int NIN = 3328;

typedef unsigned short bf16;
typedef float f32x4 __attribute__((ext_vector_type(4)));
typedef float f32x2 __attribute__((ext_vector_type(2)));
typedef unsigned u32x2 __attribute__((ext_vector_type(2)));
typedef unsigned u32x4 __attribute__((ext_vector_type(4)));

constexpr size_t MiB = 1u << 20;
constexpr size_t WS_CTL = 0, CTL_ZERO_BYTES = 1 * MiB;
constexpr size_t WS_MOD = 1 * MiB;
constexpr size_t WS_MISC = 1 * MiB + 512 * 1024;
constexpr size_t WS_WQKV = 2 * MiB, WS_WO = 5 * MiB, WS_GU0 = 6 * MiB, WS_DN0 = 22 * MiB, WS_WIN = 30 * MiB, WS_WGO = 34 * MiB, WS_GU1 = 35 * MiB, WS_DN1 = 51 * MiB;
constexpr size_t WS_XB = 59 * MiB;
constexpr size_t WS_H = 127 * MiB;
constexpr size_t WS_Q = 195 * MiB, WS_K = 263 * MiB, WS_V = 331 * MiB, WS_O2 = 399 * MiB;
constexpr size_t WS_LIST = 467 * MiB;
constexpr size_t WS_TOKR = 470 * MiB;
constexpr size_t WS_DEC = 472 * MiB;
constexpr size_t WS_ZZ = 475 * MiB;
constexpr size_t WS_END = 480 * MiB;
constexpr size_t WS_O1 = WS_H, WS_A2 = WS_H, WS_Y = WS_K;
constexpr size_t WS_YM = 195 * MiB, WS_ACT = 339 * MiB;
constexpr size_t WS_QR = 195 * MiB, WS_KR = 229 * MiB, WS_V1 = 263 * MiB, WS_R = 331 * MiB;
constexpr size_t WS_QT = WS_H, WS_KT = 399 * MiB;
constexpr size_t WS_A2B = WS_H;
constexpr size_t OUT_OGB = 64 * MiB;
constexpr int CW_TMO = 0, CW_CODE = 1;
constexpr int CW_CNT = 64;
constexpr int CW_KM = 128;
constexpr int CW_BAR = 4096;

__device__ __forceinline__ unsigned f2bf(float f) { unsigned u = __builtin_bit_cast(unsigned, f); return (u + 0x7fffu + ((u >> 16) & 1u)) >> 16; }
__device__ __forceinline__ unsigned pk2(float lo, float hi) { return f2bf(lo) | (f2bf(hi) << 16); }
__device__ __forceinline__ float bf2f(unsigned b) { return __builtin_bit_cast(float, b << 16); }
__device__ __forceinline__ float wave_sum(float v) {
#pragma unroll
    for (int o = 1; o < 64; o <<= 1) v += __shfl_xor(v, o);
    return v;
}
__device__ __forceinline__ float silu_f(float v) { return v / (1.f + __expf(-v)); }

struct Prm {
    const float *x, *c, *ctx, *cctx, *ada_w, *ada_b, *ln_g, *ln_b, *w_qkv, *w_o, *lam, *subln, *gw_in, *gwg_down, *gwg_up, *gbg, *gnorm, *gw_o, *rw, *rb, *mg, *mu, *md;
    float* out; unsigned char* ws;
    int ph_lo, ph_hi, li, pad;
};
__device__ __forceinline__ void ld_row_f32(const float* p, int lane, f32x4 (&v)[4]) {
#pragma unroll
    for (int j = 0; j < 4; ++j) v[j] = *(const f32x4*)(p + 4 * lane + 256 * j);
}
__device__ __forceinline__ void st_row_f32(float* p, int lane, const f32x4 (&v)[4]) {
#pragma unroll
    for (int j = 0; j < 4; ++j) *(f32x4*)(p + 4 * lane + 256 * j) = v[j];
}
__device__ __forceinline__ void ld_row_bf16(const bf16* p, int lane, f32x4 (&v)[4]) {
#pragma unroll
    for (int j = 0; j < 4; ++j) { const u32x2 u = *(const u32x2*)(p + 4 * lane + 256 * j); v[j] = (f32x4){bf2f(u.x & 0xffffu), bf2f(u.x >> 16), bf2f(u.y & 0xffffu), bf2f(u.y >> 16)}; }
}
__device__ __forceinline__ void st_row_bf16(bf16* p, int lane, const f32x4 (&v)[4]) {
#pragma unroll
    for (int j = 0; j < 4; ++j) { u32x2 u; u.x = pk2(v[j].x, v[j].y); u.y = pk2(v[j].z, v[j].w); *(u32x2*)(p + 4 * lane + 256 * j) = u; }
}
__device__ __forceinline__ void ln_row(f32x4 (&v)[4], const float* g, const float* b, int lane) {
    float s = 0.f;
#pragma unroll
    for (int j = 0; j < 4; ++j) s += (v[j].x + v[j].y) + (v[j].z + v[j].w);
    const float mean = wave_sum(s) * (1.f / DM); float q = 0.f;
#pragma unroll
    for (int j = 0; j < 4; ++j) { v[j] = v[j] - mean; q += (v[j].x * v[j].x + v[j].y * v[j].y) + (v[j].z * v[j].z + v[j].w * v[j].w); }
    const float rstd = 1.f / sqrtf(wave_sum(q) * (1.f / DM) + LN_EPS);
#pragma unroll
    for (int j = 0; j < 4; ++j) { const f32x4 gg = *(const f32x4*)(g + 4 * lane + 256 * j), bb = *(const f32x4*)(b + 4 * lane + 256 * j); v[j] = v[j] * rstd * gg + bb; }
}
__host__ __device__ __forceinline__ int gu_phys(int other, int sel) { return (other >> 4) * 32 + sel * 16 + (other & 15); }
__host__ __device__ __forceinline__ int perm16b(int L) { return (L & ~31) | (16 * ((L >> 2) & 1) + 4 * ((L >> 3) & 3) + (L & 3)); }
__host__ __device__ __forceinline__ int perm16b_inv(int P) { return (P & ~31) | (8 * ((P >> 2) & 3) + 4 * ((P >> 4) & 1) + (P & 3)); }
__device__ __forceinline__ unsigned pk4_fp8(float a, float b, float c, float d) { int w = 0; w = __builtin_amdgcn_cvt_pk_fp8_f32(a, b, w, false); w = __builtin_amdgcn_cvt_pk_fp8_f32(c, d, w, true); return (unsigned)w; }
constexpr float W8_SCALE = 64.f, W8_INV = 1.f / 64.f;
__device__ __forceinline__ void st_row_fp8(unsigned char* p, int lane, const f32x4 (&v)[4]) {
#pragma unroll
    for (int j = 0; j < 4; ++j) *(unsigned*)(p + 4 * lane + 256 * j) = pk4_fp8(v[j].x, v[j].y, v[j].z, v[j].w);
}
__device__ __forceinline__ void ld_row_fp8(const unsigned char* p, int lane, f32x4 (&v)[4]) {
#pragma unroll
    for (int j = 0; j < 4; ++j) { const int w = *(const int*)(p + 4 * lane + 256 * j); const f32x2 lo = __builtin_amdgcn_cvt_pk_f32_fp8(w, false), hi = __builtin_amdgcn_cvt_pk_f32_fp8(w, true); v[j] = (f32x4){lo.x, lo.y, hi.x, hi.y}; }
}
#define GAS __attribute__((address_space(1)))
#define LAS __attribute__((address_space(3)))
constexpr int NWAVES = 8, NTHR = NWAVES * 64;
constexpr int RING_BYTES = 131072, LDS_BYTES = 147456, LDSCTL_OFF = LDS_BYTES - 1024, MISC_OFF = LDSCTL_OFF + 320;
constexpr int LDSX_OFF = RING_BYTES + 1024;
#define LDS_WAIT() asm volatile("s_waitcnt lgkmcnt(0)" ::: "memory")
#define VM_WAIT() asm volatile("s_waitcnt vmcnt(0)" ::: "memory")

struct Frame {
    unsigned char* lds;
    unsigned* ctl;
    int tid, lane, wave, G, bid;
};

template <int MODE>
__device__ __forceinline__ void p0_transpose_item(const float* W, int K, int N, bf16* WT, int row_off, float* scr, int item, int lane) {
    const int nblk = N / 32, kb = item / nblk, nb = item % nblk, k0 = 64 * kb, n0 = 32 * nb;
#pragma unroll 8
    for (int i = 0; i < 32; ++i) { const int kk = 2 * i + (lane >> 5); scr[kk * 33 + (lane & 31)] = W[(size_t)(k0 + kk) * N + n0 + (lane & 31)]; }
    LDS_WAIT(); asm volatile("" ::: "memory");
    const int c = lane & 7;
#pragma unroll
    for (int j = 0; j < 4; ++j) { const int n = (lane >> 3) + 8 * j; const float* s = scr + (8 * c) * 33 + n;
        u32x4 o; o.x = pk2(s[0 * 33], s[1 * 33]); o.y = pk2(s[2 * 33], s[3 * 33]); o.z = pk2(s[4 * 33], s[5 * 33]); o.w = pk2(s[6 * 33], s[7 * 33]);
        const int nl = n0 + n; const int pr = (MODE == 0) ? (row_off + nl) : (MODE == 3) ? (row_off + perm16b(nl)) : (row_off + gu_phys(nl, MODE - 1));
        *(u32x4*)(WT + (size_t)pr * K + k0 + 8 * c) = o; }
    LDS_WAIT(); asm volatile("" ::: "memory");
}
template <int MODE>
__device__ __forceinline__ void p0_transpose_item8(const float* W, int K, int N, unsigned char* WT, float* scr, int item, int lane) {
    const int nblk = N / 32, kb = item / nblk, nb = item % nblk, k0 = 64 * kb, n0 = 32 * nb;
#pragma unroll 8
    for (int i = 0; i < 32; ++i) { const int kk = 2 * i + (lane >> 5); scr[kk * 33 + (lane & 31)] = W[(size_t)(k0 + kk) * N + n0 + (lane & 31)]; }
    LDS_WAIT(); asm volatile("" ::: "memory");
    const int c = lane & 7;
#pragma unroll
    for (int j = 0; j < 4; ++j) { const int n = (lane >> 3) + 8 * j; const float* s = scr + (8 * c) * 33 + n;
        u32x2 o; o.x = pk4_fp8(s[0 * 33] * W8_SCALE, s[1 * 33] * W8_SCALE, s[2 * 33] * W8_SCALE, s[3 * 33] * W8_SCALE); o.y = pk4_fp8(s[4 * 33] * W8_SCALE, s[5 * 33] * W8_SCALE, s[6 * 33] * W8_SCALE, s[7 * 33] * W8_SCALE);
        const int nl = n0 + n; const int pr = (MODE == 3) ? perm16b(nl) : (MODE == 0) ? nl : gu_phys(nl, MODE - 1);
        *(u32x2*)(WT + (size_t)pr * K + k0 + 8 * c) = o; }
    LDS_WAIT(); asm volatile("" ::: "memory");
}
__device__ __forceinline__ void phase_prologue(const Frame& F, const Prm& p) {
    float* sil = (float*)F.lds;
    for (int i = F.tid; i < 9 * 1024; i += NTHR) { const int r = i >> 10, k = i & 1023; const float v = (r < 8) ? p.c[r * 1024 + k] : p.cctx[k]; sil[i] = silu_f(v); }
    __syncthreads();
    float* MOD = (float*)(p.ws + WS_MOD);
    if (F.bid < 192) {
        const int layer = F.bid / 96, n = (F.bid % 96) * 64 + F.lane; const float* W = p.ada_w + (size_t)layer * 1024 * 6144 + n;
        float acc[9];
#pragma unroll
        for (int r = 0; r < 9; ++r) acc[r] = 0.f;
        const int kb = F.wave * 128;
#pragma unroll 4
        for (int k = kb; k < kb + 128; k += 4) {
            const float w0 = W[(size_t)k * 6144], w1 = W[(size_t)(k + 1) * 6144], w2 = W[(size_t)(k + 2) * 6144], w3 = W[(size_t)(k + 3) * 6144];
#pragma unroll
            for (int r = 0; r < 9; ++r) { const f32x4 s = *(const f32x4*)(sil + r * 1024 + k); acc[r] += s.x * w0 + s.y * w1 + s.z * w2 + s.w * w3; }
        }
        float* red = (float*)(F.lds + 36864 + 8 * 8704);
#pragma unroll
        for (int r = 0; r < 9; ++r) red[(F.wave * 9 + r) * 64 + F.lane] = acc[r];
        __syncthreads();
        if (F.wave == 0) { const float bb = p.ada_b[layer * 6144 + n];
#pragma unroll
            for (int r = 0; r < 9; ++r) { float t = bb;
#pragma unroll
                for (int w = 0; w < 8; ++w) t += red[(w * 9 + r) * 64 + F.lane];
                MOD[(layer * 9 + r) * 6144 + n] = t; } }
    }
    float* misc = (float*)(p.ws + WS_MISC);
    if (F.bid == 255 % F.G && F.wave == 1) {
        const float a = wave_sum(p.lam[F.lane] * p.lam[64 + F.lane]), b = wave_sum(p.lam[128 + F.lane] * p.lam[192 + F.lane]);
        if (F.lane == 0) misc[0] = __expf(a) - __expf(b) + LAMBDA_INIT0;
        for (int i = F.lane; i < 1024; i += 64) { const int pos = i >> 4, f = i & 15; const float inv = powf(10000.f, -(float)f / 16.f); const float ang = (float)pos * inv;
            misc[1024 + 2 * i] = cosf(ang); misc[1024 + 2 * i + 1] = sinf(ang); }
    }
    float* scr = (float*)(F.lds + 36864 + F.wave * 8704);
    const int gw = F.bid * NWAVES + F.wave, NGW = F.G * NWAVES;
    constexpr int I_QKV = 16 * 96, I_SQ = 16 * 32, I_G = 16 * 16, I_D = 8 * 32;
    constexpr int I_MOE = 2 * I_G + I_D;
    constexpr int NITEMS = 2 * I_QKV + 2 * I_SQ + 32 * I_MOE;
    bf16* ws16 = (bf16*)p.ws;
    for (int it = gw; it < NITEMS; it += NGW) {
        int r = it;
        if (r < I_QKV) { if ((r % 96) < 64) p0_transpose_item8<0>(p.w_qkv, 1024, 3072, p.ws + WS_WQKV, scr, r, F.lane); else p0_transpose_item8<3>(p.w_qkv, 1024, 3072, p.ws + WS_WQKV, scr, r, F.lane); continue; } r -= I_QKV;
        if (r < I_QKV) { p0_transpose_item8<3>(p.gw_in, 1024, 3072, p.ws + WS_WIN, scr, r, F.lane); continue; } r -= I_QKV;
        if (r < I_SQ) { p0_transpose_item8<3>(p.w_o, 1024, 1024, p.ws + WS_WO, scr, r, F.lane); continue; } r -= I_SQ;
        if (r < I_SQ) { p0_transpose_item8<3>(p.gw_o, 1024, 1024, p.ws + WS_WGO, scr, r, F.lane); continue; } r -= I_SQ;
        const int le = r / I_MOE, layer = le >> 4, e = le & 15; r -= le * I_MOE;
        unsigned char* GU = p.ws + (layer ? WS_GU1 : WS_GU0) + (size_t)e * 1024 * 1024; unsigned char* DN = p.ws + (layer ? WS_DN1 : WS_DN0) + (size_t)e * 1024 * 512;
        if (r < I_G) { p0_transpose_item8<1>(p.mg + (size_t)le * 1024 * 512, 1024, 512, GU, scr, r, F.lane); continue; } r -= I_G;
        if (r < I_G) { p0_transpose_item8<2>(p.mu + (size_t)le * 1024 * 512, 1024, 512, GU, scr, r, F.lane); continue; } r -= I_G;
        p0_transpose_item8<3>(p.md + (size_t)le * 512 * 1024, 512, 1024, DN, scr, r, F.lane);
    }
    (void)ws16;
    unsigned char* WIN = p.ws + WS_WIN;
    for (int i = gw * 64 + F.lane; i < 32 * 256; i += NGW * 64) { const int rr = i >> 8, k = (i & 255) * 4, dir = rr >> 4, j = rr & 15; const float* s = p.gwg_down + (size_t)dir * 1024 * 16 + j;
        *(unsigned*)(WIN + (size_t)(3072 + rr) * 1024 + k) = pk4_fp8(s[(size_t)k * 16] * W8_SCALE, s[(size_t)(k + 1) * 16] * W8_SCALE, s[(size_t)(k + 2) * 16] * W8_SCALE, s[(size_t)(k + 3) * 16] * W8_SCALE); }
    for (int i = gw * 64 + F.lane; i < 224 * 1024 / 16; i += NGW * 64) *(u32x4*)(WIN + (size_t)3104 * 1024 + (size_t)i * 16) = (u32x4){0u, 0u, 0u, 0u};
}

__device__ __forceinline__ void phase_modulate0(const Frame& F, const Prm& p) {
    const float* MOD = (const float*)(p.ws + WS_MOD); unsigned char* H = p.ws + WS_H;
    const int gw = F.bid * NWAVES + F.wave, NGW = F.G * NWAVES, per = (NTOK + NGW - 1) / NGW;
    int curmod = -1; f32x4 sh[4], sc[4];
    const int t0 = gw * per, t1 = min(NTOK, (gw + 1) * per);
    f32x4 v[4], vn[4];
    if (t0 < t1) ld_row_f32(t0 < NLAT ? p.x + (size_t)t0 * DM : p.ctx + (size_t)(t0 - NLAT) * DM, F.lane, v);
    for (int tok = t0; tok < t1; ++tok) {
        if (tok + 1 < t1) ld_row_f32(tok + 1 < NLAT ? p.x + (size_t)(tok + 1) * DM : p.ctx + (size_t)(tok + 1 - NLAT) * DM, F.lane, vn);
        const int mr = tok < NLAT ? tok / SEQ : 8;
        if (mr != curmod) { curmod = mr; ld_row_f32(MOD + mr * 6144, F.lane, sh); ld_row_f32(MOD + mr * 6144 + 1024, F.lane, sc); }
#pragma unroll
        for (int j = 0; j < 4; ++j) v[j] = v[j] * (1.f + sc[j]) + sh[j];
        st_row_fp8(H + (size_t)tok * DM, F.lane, v);
#pragma unroll
        for (int j = 0; j < 4; ++j) v[j] = vn[j];
    }
}

__device__ __forceinline__ void phase_attn_combine(const Frame& F, const Prm& p) {
    const bf16* O1 = (const bf16*)(p.ws + WS_O1); const bf16* O2 = (const bf16*)(p.ws + WS_O2); unsigned char* A2 = p.ws + WS_A2;
    const float lam = ((const float*)(p.ws + WS_MISC))[0];
    const f32x4 sg = *(const f32x4*)(p.subln + 4 * (F.lane & 31));
    const int gw = F.bid * NWAVES + F.wave, NGW = F.G * NWAVES;
    f32x4 a[4], b[4], an[4], bn[4];
    if (gw < NTOK) { ld_row_bf16(O1 + (size_t)gw * DM, F.lane, a); ld_row_bf16(O2 + (size_t)gw * DM, F.lane, b); }
    for (int tok = gw; tok < NTOK; tok += NGW) {
        if (tok + NGW < NTOK) { ld_row_bf16(O1 + (size_t)(tok + NGW) * DM, F.lane, an); ld_row_bf16(O2 + (size_t)(tok + NGW) * DM, F.lane, bn); }
#pragma unroll
        for (int j = 0; j < 4; ++j) {
            f32x4 o = a[j] - lam * b[j]; float q = (o.x * o.x + o.y * o.y) + (o.z * o.z + o.w * o.w);
#pragma unroll
            for (int s = 1; s < 32; s <<= 1) q += __shfl_xor(q, s);
            const float rr = (1.f - LAMBDA_INIT0) / sqrtf(q * (1.f / 128.f) + LN_EPS);
            a[j] = o * rr * sg;
        }
        st_row_fp8(A2 + (size_t)tok * DM, F.lane, a);
#pragma unroll
        for (int j = 0; j < 4; ++j) { a[j] = an[j]; b[j] = bn[j]; }
    }
}

__device__ __forceinline__ void phase_ln_route(const Frame& F, const Prm& p, int layer) {
    const int nrows = layer ? NLAT : NTOK;
    const float* MOD = (const float*)(p.ws + WS_MOD) + layer * 9 * 6144;
    const bf16* Y = (const bf16*)(p.ws + WS_Y); unsigned char* HF = p.ws + WS_H;
    bf16* XB = (bf16*)(p.ws + WS_XB);
    int* LIST = (int*)(p.ws + WS_LIST); int* TOKR = (int*)(p.ws + WS_TOKR);
    unsigned* CNT = F.ctl + CW_CNT + layer * 16;
    float* WrT = (float*)F.lds;
    int* rec = (int*)(F.lds + 65536);
    unsigned* lcnt = (unsigned*)(F.lds + 65536 + 8192); unsigned* lbase = lcnt + 16;
    for (int i = F.tid; i < 16 * 1024; i += NTHR) { const int k = i >> 4, e = i & 15; WrT[e * 1024 + k] = p.rw[i]; }
    if (F.tid < 16) lcnt[F.tid] = 0u;
    __syncthreads();
    const int per_wg = (nrows + F.G - 1) / F.G, per_w = (per_wg + NWAVES - 1) / NWAVES;
    const int row_lo = F.bid * per_wg, row_hi = min(nrows, row_lo + per_wg);
    const float* lng = p.ln_g + (layer * 2 + 0) * DM; const float* lnb = p.ln_b + (layer * 2 + 0) * DM;
    float rb[16];
#pragma unroll
    for (int e = 0; e < 16; ++e) rb[e] = p.rb[e];
    int curmod = -1; f32x4 gm[4], shf[4], scf[4];
    f32x4 v[4], y[4], vn[4], yn[4];
#define LNR_LOAD(tok_, V, Yv) do { if (layer) ld_row_bf16(XB + (size_t)(tok_) * DM, F.lane, V); else ld_row_f32((tok_) < NLAT ? p.x + (size_t)(tok_) * DM : p.ctx + (size_t)((tok_) - NLAT) * DM, F.lane, V); \
        ld_row_bf16(Y + (size_t)(tok_) * DM, F.lane, Yv); } while (0)
    if (row_lo + F.wave * per_w < row_hi) LNR_LOAD(row_lo + F.wave * per_w, v, y);
    for (int i = 0; i < per_w; ++i) {
        const int lr = F.wave * per_w + i, tok = row_lo + lr; if (tok >= row_hi) break;
        if (i + 1 < per_w && tok + 1 < row_hi) LNR_LOAD(tok + 1, vn, yn);
        const int mr = tok < NLAT ? tok / SEQ : 8;
        if (mr != curmod) { curmod = mr; ld_row_f32(MOD + mr * 6144 + 2048, F.lane, gm); ld_row_f32(MOD + mr * 6144 + 3072, F.lane, shf); ld_row_f32(MOD + mr * 6144 + 4096, F.lane, scf); }
        bf16* xdst = XB + (size_t)tok * DM;
#pragma unroll
        for (int j = 0; j < 4; ++j) v[j] = ALPHA * v[j] + gm[j] * y[j];
        ln_row(v, lng, lnb, F.lane);
        st_row_bf16(xdst, F.lane, v);
#pragma unroll
        for (int j = 0; j < 4; ++j) v[j] = v[j] * (1.f + scf[j]) + shf[j];
        st_row_fp8(HF + (size_t)tok * DM, F.lane, v);
        float part[16];
#pragma unroll
        for (int e = 0; e < 16; ++e) { float s = 0.f;
#pragma unroll
            for (int j = 0; j < 4; ++j) { const f32x4 w = *(const f32x4*)(WrT + e * 1024 + 4 * F.lane + 256 * j); s += (v[j].x * w.x + v[j].y * w.y) + (v[j].z * w.z + v[j].w * w.w); }
            part[e] = s; }
        {
#pragma unroll
            for (int e = 0; e < 8; ++e) { const bool up = (F.lane & 32) != 0; const float keep = up ? part[e + 8] : part[e], send = up ? part[e] : part[e + 8]; part[e] = keep + __shfl_xor(send, 32); }
#pragma unroll
            for (int e = 0; e < 4; ++e) { const bool up = (F.lane & 16) != 0; const float keep = up ? part[e + 4] : part[e], send = up ? part[e] : part[e + 4]; part[e] = keep + __shfl_xor(send, 16); }
#pragma unroll
            for (int e = 0; e < 2; ++e) { const bool up = (F.lane & 8) != 0; const float keep = up ? part[e + 2] : part[e], send = up ? part[e] : part[e + 2]; part[e] = keep + __shfl_xor(send, 8); }
            { const bool up = (F.lane & 4) != 0; const float keep = up ? part[1] : part[0], send = up ? part[0] : part[1]; part[0] = keep + __shfl_xor(send, 4); }
            part[0] += __shfl_xor(part[0], 2); part[0] += __shfl_xor(part[0], 1);
        }
        float aff[16], sel[16];
#pragma unroll
        for (int e = 0; e < 16; ++e) { const int src = ((e >> 3) & 1) * 32 + ((e >> 2) & 1) * 16 + ((e >> 1) & 1) * 8 + (e & 1) * 4; const float lg = __shfl(part[0], src); aff[e] = 1.f / (1.f + __expf(-lg)); sel[e] = aff[e] + rb[e]; }
        int bg = 0; float bgs = -3.0e38f;
#pragma unroll
        for (int g = 0; g < 4; ++g) { float m1 = -3.0e38f, m2 = -3.0e38f;
#pragma unroll
            for (int k = 0; k < 4; ++k) { const float s = sel[4 * g + k]; if (s > m1) { m2 = m1; m1 = s; } else if (s > m2) m2 = s; }
            const float gs = m1 + m2; if (gs > bgs) { bgs = gs; bg = g; } }
        int i1 = 0, i2 = 0; float s1 = -3.0e38f, s2 = -3.0e38f, a1 = 0.f, a2 = 0.f;
#pragma unroll
        for (int g = 0; g < 4; ++g) if (g == bg) {
#pragma unroll
            for (int k = 0; k < 4; ++k) { const float s = sel[4 * g + k], a = aff[4 * g + k];
                if (s > s1) { s2 = s1; i2 = i1; a2 = a1; s1 = s; i1 = 4 * g + k; a1 = a; } else if (s > s2) { s2 = s; i2 = 4 * g + k; a2 = a; } } }
        const float wsum = a1 + a2, w1 = a1 / wsum, w2 = a2 / wsum;
        if (F.lane == 0) { const unsigned l1 = atomicAdd(&lcnt[i1], 1u), l2 = atomicAdd(&lcnt[i2], 1u);
            rec[lr * 6 + 0] = i1; rec[lr * 6 + 1] = i2; rec[lr * 6 + 2] = (int)l1; rec[lr * 6 + 3] = (int)l2; rec[lr * 6 + 4] = __float_as_int(w1); rec[lr * 6 + 5] = __float_as_int(w2); }
#pragma unroll
        for (int j = 0; j < 4; ++j) { v[j] = vn[j]; y[j] = yn[j]; }
    }
#undef LNR_LOAD
    __syncthreads();
    if (F.tid < 16) lbase[F.tid] = __hip_atomic_fetch_add(&CNT[F.tid], lcnt[F.tid], __ATOMIC_RELAXED, __HIP_MEMORY_SCOPE_AGENT);
    __syncthreads();
    for (int lr = F.tid; lr < row_hi - row_lo; lr += NTHR) { const int tok = row_lo + lr;
        const int e0 = rec[lr * 6], e1 = rec[lr * 6 + 1]; const int p0 = (int)lbase[e0] + rec[lr * 6 + 2], p1 = (int)lbase[e1] + rec[lr * 6 + 3];
        LIST[e0 * NTOK + p0] = tok; LIST[e1 * NTOK + p1] = tok;
        int* tr = TOKR + (size_t)tok * 8; tr[0] = e0; tr[1] = p0; tr[2] = e1; tr[3] = p1; tr[4] = rec[lr * 6 + 4]; tr[5] = rec[lr * 6 + 5]; }
    __syncthreads();
}

__device__ __forceinline__ void pad_bases(const unsigned* cnt, int (&pb)[17]) {
    int acc = 0;
#pragma unroll
    for (int e = 0; e < 16; ++e) { pb[e] = acc; const int c = (int)__hip_atomic_load(cnt + e, __ATOMIC_RELAXED, __HIP_MEMORY_SCOPE_AGENT); acc += (c + 255) & ~255; }
    pb[16] = acc;
}

__device__ __forceinline__ void phase_moe_combine(const Frame& F, const Prm& p, int layer) {
    const int nrows = layer ? NLAT : NTOK;
    const float* MOD = (const float*)(p.ws + WS_MOD) + layer * 9 * 6144; const float* MOD1 = (const float*)(p.ws + WS_MOD) + 9 * 6144;
    const unsigned char* YM = p.ws + WS_YM;   unsigned char* H = p.ws + WS_H;   bf16* XB = (bf16*)(p.ws + WS_XB); const int* TOKR = (const int*)(p.ws + WS_TOKR);
    int pb[17]; pad_bases(F.ctl + CW_CNT + layer * 16, pb);
    int* pbl = (int*)F.lds; if (F.tid < 17) { int v = 0;
#pragma unroll
        for (int e = 0; e < 17; ++e) if (e == F.tid) v = pb[e];
        pbl[F.tid] = v; }
    __syncthreads();
    const float* lng = p.ln_g + (layer * 2 + 1) * DM; const float* lnb = p.ln_b + (layer * 2 + 1) * DM;
    const int gw = F.bid * NWAVES + F.wave, NGW = F.G * NWAVES, per = (nrows + NGW - 1) / NGW;
    int curmod = -1; f32x4 gf[4], sh1[4], sc1[4];
    typedef int i32x4r __attribute__((ext_vector_type(4)));
    const int t0 = gw * per, t1 = min(nrows, (gw + 1) * per);
    i32x4r ra = {0, 0, 0, 0}, rb = {0, 0, 0, 0}, rc = {0, 0, 0, 0}; f32x2 wa = {0.f, 0.f}, wb = {0.f, 0.f}, wc = {0.f, 0.f};
#define MC_REC(tok_, R, W) do { const int* tr_ = TOKR + (size_t)(tok_) * 8; R = *(const i32x4r*)tr_; W = *(const f32x2*)(tr_ + 4); } while (0)
#define MC_ROWS(tok_, R, V, A, B) do { ld_row_bf16(XB + (size_t)(tok_) * DM, F.lane, V); ld_row_fp8(YM + (size_t)(pbl[R.x] + R.y) * DM, F.lane, A); ld_row_fp8(YM + (size_t)(pbl[R.z] + R.w) * DM, F.lane, B); } while (0)
    f32x4 v[4], a[4], b[4], vn[4], an[4], bn[4];
    if (t0 < t1) { MC_REC(t0, ra, wa); if (t0 + 1 < t1) MC_REC(t0 + 1, rb, wb); MC_ROWS(t0, ra, v, a, b); }
    for (int tok = t0; tok < t1; ++tok) {
        if (tok + 1 < t1) MC_ROWS(tok + 1, rb, vn, an, bn);
        if (tok + 2 < t1) MC_REC(tok + 2, rc, wc);
        const int mr = tok < NLAT ? tok / SEQ : 8;
        if (mr != curmod) { curmod = mr; ld_row_f32(MOD + mr * 6144 + 5120, F.lane, gf); if (!layer) { ld_row_f32(MOD1 + mr * 6144, F.lane, sh1); ld_row_f32(MOD1 + mr * 6144 + 1024, F.lane, sc1); } }
        const float w0 = wa.x, w1 = wa.y;
        bf16* xp = XB + (size_t)tok * DM;
#pragma unroll
        for (int j = 0; j < 4; ++j) v[j] = ALPHA * v[j] + gf[j] * (w0 * a[j] + w1 * b[j]);
        ln_row(v, lng, lnb, F.lane);
        if (layer) st_row_f32(p.out + (size_t)tok * DM, F.lane, v); else st_row_bf16(xp, F.lane, v);
        if (!layer) {
#pragma unroll
            for (int j = 0; j < 4; ++j) v[j] = v[j] * (1.f + sc1[j]) + sh1[j];
            st_row_fp8(H + (size_t)tok * DM, F.lane, v);
        }
#pragma unroll
        for (int j = 0; j < 4; ++j) { v[j] = vn[j]; a[j] = an[j]; b[j] = bn[j]; }
        ra = rb; wa = wb; rb = rc; wb = wc;
    }
#undef MC_REC
#undef MC_ROWS
}

__device__ __forceinline__ void phase_gla_prep(const Frame& F, const Prm& p) {
    typedef short bf16x8v __attribute__((ext_vector_type(8))); typedef float f32x16v __attribute__((ext_vector_type(16)));
    const bf16* QR = (const bf16*)(p.ws + WS_QR); const bf16* KR = (const bf16*)(p.ws + WS_KR); const float* ZZ = (const float*)(p.ws + WS_ZZ);
    bf16* QT = (bf16*)(p.ws + WS_QT); bf16* KT = (bf16*)(p.ws + WS_KT); float* DEC = (float*)(p.ws + WS_DEC);
    const int gw = F.bid * NWAVES + F.wave, NGW = F.G * NWAVES, r = F.lane & 31, hh = F.lane >> 5;
    for (int task = gw; task < 2 * NCHUNK * 8; task += NGW) {
        const int dh = task & 7, chunk = (task >> 3) % NCHUNK, dir = __builtin_amdgcn_readfirstlane(task / (8 * NCHUNK));
        const int tok0 = chunk * 64;
        bf16x8v af[2], bfr[2];
#pragma unroll
        for (int tb = 0; tb < 2; ++tb) { const float* zp = ZZ + (size_t)(tok0 + 32 * tb + r) * 32 + dir * 16 + 8 * hh; const f32x4 z0 = *(const f32x4*)zp, z1 = *(const f32x4*)(zp + 4);
            u32x4 w; w.x = pk2(z0.x, z0.y); w.y = pk2(z0.z, z0.w); w.z = pk2(z1.x, z1.y); w.w = pk2(z1.z, z1.w); af[tb] = __builtin_bit_cast(bf16x8v, w); }
        float bgv[2];
#pragma unroll
        for (int cb = 0; cb < 2; ++cb) { const float* wp = p.gwg_up + (size_t)dir * 16 * 512 + (size_t)(8 * hh) * 512 + dh * 64 + 2 * r + cb; float wv[8];
#pragma unroll
            for (int i = 0; i < 8; ++i) wv[i] = wp[(size_t)i * 512];
            u32x4 w; w.x = pk2(wv[0], wv[1]); w.y = pk2(wv[2], wv[3]); w.z = pk2(wv[4], wv[5]); w.w = pk2(wv[6], wv[7]); bfr[cb] = __builtin_bit_cast(bf16x8v, w);
            bgv[cb] = p.gbg[dir * 512 + dh * 64 + 2 * r + cb]; }
        f32x16v Z[2][2];
#pragma unroll
        for (int tb = 0; tb < 2; ++tb)
#pragma unroll
            for (int cb = 0; cb < 2; ++cb) { const f32x16v zero = {}; Z[tb][cb] = __builtin_amdgcn_mfma_f32_32x32x16_bf16(af[tb], bfr[cb], zero, 0, 0, 0); }
#pragma unroll
        for (int tb = 0; tb < 2; ++tb)
#pragma unroll
            for (int cb = 0; cb < 2; ++cb)
#pragma unroll
                for (int i = 0; i < 16; ++i) { const float z = Z[tb][cb][i] + bgv[cb]; Z[tb][cb][i] = (fminf(z, 0.f) - __logf(1.f + __expf(-fabsf(z)))) * (1.f / 16.f); }
        float tot[2];
#pragma unroll
        for (int cb = 0; cb < 2; ++cb) {
            float T[2][4], PT[2][4];
            if (!dir) {
#pragma unroll
                for (int tb = 0; tb < 2; ++tb)
#pragma unroll
                    for (int gi = 0; gi < 4; ++gi) { float run = 0.f;
#pragma unroll
                        for (int w = 0; w < 4; ++w) { run += Z[tb][cb][4 * gi + w]; Z[tb][cb][4 * gi + w] = run; }
                        T[tb][gi] = run; }
            } else {
#pragma unroll
                for (int tb = 0; tb < 2; ++tb)
#pragma unroll
                    for (int gi = 0; gi < 4; ++gi) { float run = 0.f;
#pragma unroll
                        for (int w = 3; w >= 0; --w) { run += Z[tb][cb][4 * gi + w]; Z[tb][cb][4 * gi + w] = run; }
                        T[tb][gi] = run; }
            }
#pragma unroll
            for (int tb = 0; tb < 2; ++tb)
#pragma unroll
                for (int gi = 0; gi < 4; ++gi) PT[tb][gi] = __shfl_xor(T[tb][gi], 32);
            float running = 0.f;
            if (!dir) {
#pragma unroll
                for (int tb = 0; tb < 2; ++tb)
#pragma unroll
                    for (int gi = 0; gi < 4; ++gi) { const float first = hh ? PT[tb][gi] : T[tb][gi], second = hh ? T[tb][gi] : PT[tb][gi];
                        const float mine = hh ? running + first : running; running += first + second;
#pragma unroll
                        for (int w = 0; w < 4; ++w) Z[tb][cb][4 * gi + w] += mine; }
            } else {
#pragma unroll
                for (int tb = 1; tb >= 0; --tb)
#pragma unroll
                    for (int gi = 3; gi >= 0; --gi) { const float first = hh ? T[tb][gi] : PT[tb][gi], second = hh ? PT[tb][gi] : T[tb][gi];
                        const float mine = hh ? running : running + first; running += first + second;
#pragma unroll
                        for (int w = 0; w < 4; ++w) Z[tb][cb][4 * gi + w] += mine; }
            }
            tot[cb] = running;
        }
        if (hh == 0) {
#pragma unroll
            for (int cb = 0; cb < 2; ++cb) DEC[((size_t)dir * NCHUNK + chunk) * 512 + dh * 64 + 2 * r + cb] = __expf(tot[cb]);
        }
        const bf16* qi = QR + ((size_t)dh * NTOK + tok0) * 64 + 2 * r; const bf16* ki = KR + ((size_t)dh * NTOK + tok0) * 64 + 2 * r;
        bf16* qo = QT + (((size_t)dir * 8 + dh) * NTOK + tok0) * 64 + 2 * r; bf16* ko = KT + (((size_t)dir * 8 + dh) * NTOK + tok0) * 64 + 2 * r;
#pragma unroll
        for (int tb = 0; tb < 2; ++tb) {
            unsigned qv[16], kv[16];
#pragma unroll
            for (int i = 0; i < 16; ++i) { const int t = 32 * tb + (i & 3) + 8 * (i >> 2) + 4 * hh; qv[i] = *(const unsigned*)(qi + (size_t)t * 64); kv[i] = *(const unsigned*)(ki + (size_t)t * 64); }
#pragma unroll
            for (int i = 0; i < 16; ++i) { const int t = 32 * tb + (i & 3) + 8 * (i >> 2) + 4 * hh;
                const float e0 = __expf(Z[tb][0][i]), e1 = __expf(Z[tb][1][i]), i0 = __builtin_amdgcn_rcpf(e0), i1 = __builtin_amdgcn_rcpf(e1);
                *(unsigned*)(qo + (size_t)t * 64) = pk2(bf2f(qv[i] & 0xffffu) * e0, bf2f(qv[i] >> 16) * e1);
                *(unsigned*)(ko + (size_t)t * 64) = pk2(bf2f(kv[i] & 0xffffu) * i0, bf2f(kv[i] >> 16) * i1); }
        }
    }
}

__device__ __forceinline__ void phase_gla_post(const Frame& F, const Prm& p) {
    const bf16* OF = (const bf16*)p.out; const bf16* OB = (const bf16*)((const unsigned char*)p.out + OUT_OGB); const bf16* R = (const bf16*)(p.ws + WS_R); unsigned char* A2 = p.ws + WS_A2B;
    const f32x4 ng = *(const f32x4*)(p.gnorm + 4 * F.lane);
    const int gw = F.bid * NWAVES + F.wave, NGW = F.G * NWAVES;
    f32x4 a[4], b[4], r[4], an[4], bn[4], rn[4];
    if (gw < NLAT) { ld_row_bf16(OF + (size_t)gw * DM, F.lane, a); ld_row_bf16(OB + (size_t)gw * DM, F.lane, b); ld_row_bf16(R + (size_t)gw * DM, F.lane, r); }
    for (int tok = gw; tok < NLAT; tok += NGW) {
        if (tok + NGW < NLAT) { ld_row_bf16(OF + (size_t)(tok + NGW) * DM, F.lane, an); ld_row_bf16(OB + (size_t)(tok + NGW) * DM, F.lane, bn); ld_row_bf16(R + (size_t)(tok + NGW) * DM, F.lane, rn); }
#pragma unroll
        for (int j = 0; j < 4; ++j) {
            const f32x4 o = a[j] + b[j]; const float q = wave_sum((o.x * o.x + o.y * o.y) + (o.z * o.z + o.w * o.w));
            const float rs = 1.f / sqrtf(q * (1.f / 256.f) + LN_EPS);
            a[j] = (f32x4){o.x * rs * ng.x * silu_f(r[j].x), o.y * rs * ng.y * silu_f(r[j].y), o.z * rs * ng.z * silu_f(r[j].z), o.w * rs * ng.w * silu_f(r[j].w)};
        }
        st_row_fp8(A2 + (size_t)tok * DM, F.lane, a);
#pragma unroll
        for (int j = 0; j < 4; ++j) { a[j] = an[j]; b[j] = bn[j]; r[j] = rn[j]; }
    }
}
namespace pg8 {
typedef short bf16x8 __attribute__((ext_vector_type(8)));
constexpr int BM = 256, BK = 64, HALF = 128, HTB = HALF * BK * 2, STAGE_BYTES = 8 * HTB, NXCD = 8, WGM = 8;
__host__ __device__ __forceinline__ int lds_byte(int r, int c) { const int st = (r >> 4) * 2 + (c >> 5), rr = r & 15, cc = c & 31, ob = rr * 64 + cc * 2; return st * 1024 + (ob ^ (((ob >> 9) & 1) << 5)); }
__host__ __device__ __forceinline__ void stage_rc(int b, int& R, int& C) { const int st = b / 1024, sb = b % 1024, swz = sb ^ (((sb >> 9) & 1) << 5); R = (st >> 1) * 16 + swz / 64; C = (st & 1) * 32 + (swz % 64) / 2; }
typedef float f32x2_t __attribute__((ext_vector_type(2))); typedef __bf16 bf16x2_t __attribute__((ext_vector_type(2)));
__device__ __forceinline__ unsigned cvt_pk_bf16(float lo, float hi) { f32x2_t v = {lo, hi}; bf16x2_t b = __builtin_convertvector(v, bf16x2_t); return __builtin_bit_cast(unsigned, b); }

struct Unit { int pm, pn; int row0; int e; int cnt; const bf16* Bt; };

struct DenseOrder {
    int nM, nN, nwg, G, c, K; const bf16* Bt;
    __device__ void init(int M, int N, int K_, const bf16* Bt_, int G_, int c_) { nM = M / BM; nN = N / BM; nwg = nM * nN; G = G_; c = c_; K = K_; Bt = Bt_; }
    __device__ bool next(int i, Unit& u) const {
        const long L = (long)i * G + c; if (L >= nwg) return false;
        int wgid = (int)L; { const int q = nwg / NXCD, r = nwg % NXCD, xcd = wgid % NXCD, off = wgid / NXCD; wgid = (xcd < r ? xcd * (q + 1) : r * (q + 1) + (xcd - r) * q) + off; }
        const int nig = WGM * nN, gid = wgid / nig, fm = gid * WGM, gsz = (nM - fm) < WGM ? (nM - fm) : WGM;
        u.pm = fm + ((wgid % nig) % gsz); u.pn = (wgid % nig) / gsz; u.row0 = u.pm * BM; u.e = 0; u.cnt = 0; u.Bt = Bt; return true;
    }
    __device__ __forceinline__ unsigned arow(const Unit& u, int r) const { return (unsigned)(u.row0 + r) * (unsigned)(K * 2); }
};
template <bool GATHER> struct MoeOrder {
    int cnt[16]; int nN, G, c, K; const bf16* Bt0; size_t bstride; const int* LIST;
    __device__ void init(const unsigned* cntw, int N, int K_, const bf16* Bt0_, const int* LIST_, int G_, int c_) {
#pragma unroll
        for (int e = 0; e < 16; ++e) cnt[e] = (int)__hip_atomic_load(cntw + e, __ATOMIC_RELAXED, __HIP_MEMORY_SCOPE_AGENT);
        nN = N / BM; G = G_; c = c_; K = K_; Bt0 = Bt0_; bstride = (size_t)N * K_; LIST = LIST_; }
    __device__ bool next(int i, Unit& u) const {
        int L = i * G + c, base = 0; bool found = false; u.pm = 0; u.pn = 0; u.row0 = 0; u.e = 0; u.cnt = 0; u.Bt = Bt0;
#pragma unroll
        for (int e = 0; e < 16; ++e) { const int mt = (cnt[e] + 255) >> 8, nu = mt * nN;
            if (!found) { if (L < nu) { found = true; u.e = e; u.cnt = cnt[e]; u.pm = L / nN; u.pn = L % nN; u.row0 = base + u.pm * BM; u.Bt = Bt0 + (size_t)e * bstride; } else { L -= nu; base += mt * BM; } } }
        return found;
    }
    __device__ __forceinline__ unsigned arow(const Unit& u, int r) const {
        if (GATHER) { const int li = u.pm * BM + r; int tok = 0; if (li < u.cnt) tok = LIST[u.e * NTOK + li];
            return (unsigned)tok * (unsigned)(K * 2); }
        return (unsigned)(u.row0 + r) * (unsigned)(K * 2);
    }
};

typedef f32x4 Acc[2][2][4][2];
__device__ __forceinline__ void st4bf(bf16* p, f32x4 v) { u32x2 w; w.x = cvt_pk_bf16(v.x, v.y); w.y = cvt_pk_bf16(v.z, v.w); *(u32x2*)p = w; }
__device__ __forceinline__ void sink4(f32x4 v) { u32x2 w; w.x = cvt_pk_bf16(v.x, v.y); w.y = cvt_pk_bf16(v.z, v.w); asm volatile("" :: "v"(w)); }
__device__ __forceinline__ void st8bf(bf16* p, f32x4 a, f32x4 b) { u32x4 w; w.x = cvt_pk_bf16(a.x, a.y); w.y = cvt_pk_bf16(a.z, a.w); w.z = cvt_pk_bf16(b.x, b.y); w.w = cvt_pk_bf16(b.z, b.w); *(u32x4*)p = w; }

struct EpiQKV {
    bf16 *Q; const LAS float* rope; float wsc; unsigned* km; bool nostore;
    __device__ __forceinline__ void operator()(const Acc& acc, const Unit& u, int wr, int wc, int fr, int fq) const {
        const int reg = u.pn >> 2; bf16* O = Q + (size_t)reg * ((WS_K - WS_Q) / 2);
        if (reg == 2) { const int cbase = (u.pn & 3) * BM + wc * 32 + 8 * fq;
#pragma unroll
            for (int ai = 0; ai < 2; ++ai)
#pragma unroll
                for (int m = 0; m < 4; ++m) { bf16* rowp = O + (size_t)(u.row0 + ai * HALF + wr * 64 + m * 16 + fr) * DM + cbase;
#pragma unroll
                    for (int bj = 0; bj < 2; ++bj) { if (nostore) { sink4(acc[ai][bj][m][0] * wsc); sink4(acc[ai][bj][m][1] * wsc); } else st8bf(rowp + bj * HALF, acc[ai][bj][m][0] * wsc, acc[ai][bj][m][1] * wsc); } }
            return; }
        const int cbase = (u.pn & 3) * BM + wc * 32 + 4 * fq;
        const bool dorope = (u.row0 < NLAT); const float sc = (reg == 0 ? C2 : 1.f) * wsc; float kn[2] = {0.f, 0.f};
#pragma unroll
        for (int ai = 0; ai < 2; ++ai)
#pragma unroll
            for (int m = 0; m < 4; ++m) { const int row = u.row0 + ai * HALF + wr * 64 + m * 16 + fr; bf16* rowp = O + (size_t)row * DM + cbase;
                f32x4 cs = {1.f, 1.f, 1.f, 1.f}, sn = {0.f, 0.f, 0.f, 0.f};
                if (dorope) { const int s = row & (SEQ - 1), pos = (wc & 1) ? (s & 63) : (s >> 6); const f32x4 t0 = *(const LAS f32x4*)(rope + (pos * 16 + 4 * fq) * 2), t1 = *(const LAS f32x4*)(rope + (pos * 16 + 4 * fq) * 2 + 4);
                    cs = (f32x4){t0.x, t0.z, t1.x, t1.z}; sn = (f32x4){t0.y, t0.w, t1.y, t1.w}; }
#pragma unroll
                for (int bj = 0; bj < 2; ++bj) { const f32x4 a0 = acc[ai][bj][m][0], a1 = acc[ai][bj][m][1];
                    const f32x4 o0 = (a0 * cs - a1 * sn) * sc, o1 = (a1 * cs + a0 * sn) * sc;
                    if (nostore) { sink4(o0); sink4(o1); } else { st4bf(rowp + bj * HALF, o0); st4bf(rowp + bj * HALF + 16, o1); }
                    if (reg == 1) { const float ps = (o0.x * o0.x + o0.y * o0.y) + (o0.z * o0.z + o0.w * o0.w) + (o1.x * o1.x + o1.y * o1.y) + (o1.z * o1.z + o1.w * o1.w);
                        kn[bj] = fmaxf(kn[bj], ps); } } }
        if (reg == 1) {
            const int b = u.row0 < NLAT ? u.row0 / SEQ : (u.row0 - NLAT) / CTXL;
#pragma unroll
            for (int bj = 0; bj < 2; ++bj) { float v = kn[bj];
#pragma unroll
                for (int s = 1; s < 64; s <<= 1) v = fmaxf(v, __shfl_xor(v, s));
                if (fr == 0 && fq == 0) __hip_atomic_fetch_max(km + b * 16 + 4 * (u.pn & 3) + 2 * bj + (wc >> 1), __float_as_uint(8.f * v), __ATOMIC_RELAXED, __HIP_MEMORY_SCOPE_AGENT); } }
    }
};
struct EpiPlain {
    bf16* O; float sc;
    __device__ __forceinline__ void operator()(const Acc& acc, const Unit& u, int wr, int wc, int fr, int fq) const {
        const int cbase = u.pn * BM + wc * 32 + 8 * fq;
#pragma unroll
        for (int ai = 0; ai < 2; ++ai)
#pragma unroll
            for (int m = 0; m < 4; ++m) { bf16* rowp = O + (size_t)(u.row0 + ai * HALF + wr * 64 + m * 16 + fr) * DM + cbase;
#pragma unroll
                for (int bj = 0; bj < 2; ++bj) st8bf(rowp + bj * HALF, acc[ai][bj][m][0] * sc, acc[ai][bj][m][1] * sc); }
    }
};
struct EpiPlain8 {
    unsigned char* O; float sc;
    __device__ __forceinline__ void operator()(const Acc& acc, const Unit& u, int wr, int wc, int fr, int fq) const {
        const int cbase = u.pn * BM + wc * 32 + 8 * fq;
#pragma unroll
        for (int ai = 0; ai < 2; ++ai)
#pragma unroll
            for (int m = 0; m < 4; ++m) { unsigned char* rowp = O + (size_t)(u.row0 + ai * HALF + wr * 64 + m * 16 + fr) * DM + cbase;
#pragma unroll
                for (int bj = 0; bj < 2; ++bj) { const f32x4 a = acc[ai][bj][m][0] * sc, b = acc[ai][bj][m][1] * sc; u32x2 w; w.x = pk4_fp8(a.x, a.y, a.z, a.w); w.y = pk4_fp8(b.x, b.y, b.z, b.w); *(u32x2*)(rowp + bj * HALF) = w; } }
    }
};
struct EpiInproj {
    bf16 *QR, *KR, *V, *R; float* ZZ; float wsc;
    __device__ __forceinline__ void operator()(const Acc& acc, const Unit& u, int wr, int wc, int fr, int fq) const {
        const int pn = u.pn;
        if (pn == 12) { if (wc == 0) {
#pragma unroll
            for (int ai = 0; ai < 2; ++ai)
#pragma unroll
                for (int m = 0; m < 4; ++m) { float* rowp = ZZ + (size_t)(u.row0 + ai * HALF + wr * 64 + m * 16 + fr) * 32 + 4 * fq;
                    *(f32x4*)rowp = acc[ai][0][m][0] * wsc; *(f32x4*)(rowp + 16) = acc[ai][0][m][1] * wsc; } }
            return; }
        float sc = wsc;
        if (pn < 4) {
            bf16* O = pn < 2 ? QR : KR; if (pn < 2) sc = 0.08838834764831845f * wsc;
            const int cb = (pn & 1) * BM + wc * 32 + 8 * fq;
#pragma unroll
            for (int ai = 0; ai < 2; ++ai)
#pragma unroll
                for (int m = 0; m < 4; ++m) { const size_t row = (size_t)(u.row0 + ai * HALF + wr * 64 + m * 16 + fr);
#pragma unroll
                    for (int bj = 0; bj < 2; ++bj) { const int col = cb + bj * HALF; st8bf(O + ((size_t)(col >> 6) * NTOK + row) * 64 + (col & 63), acc[ai][bj][m][0] * sc, acc[ai][bj][m][1] * sc); } }
            return; }
        bf16* O; int c0;
        if (pn < 8) { O = V; c0 = (pn - 4) * BM; } else { O = R; c0 = (pn - 8) * BM; }
        const int cbase = c0 + wc * 32 + 8 * fq;
#pragma unroll
        for (int ai = 0; ai < 2; ++ai)
#pragma unroll
            for (int m = 0; m < 4; ++m) { bf16* rowp = O + (size_t)(u.row0 + ai * HALF + wr * 64 + m * 16 + fr) * DM + cbase;
#pragma unroll
                for (int bj = 0; bj < 2; ++bj) st8bf(rowp + bj * HALF, acc[ai][bj][m][0] * sc, acc[ai][bj][m][1] * sc); }
    }
};
struct EpiGateUp {
    unsigned char* ACT;
    __device__ __forceinline__ void operator()(const Acc& acc, const Unit& u, int wr, int wc, int fr, int fq) const {
        const int obase = (u.pn * BM + wc * 32) / 2 + 4 * fq;
#pragma unroll
        for (int ai = 0; ai < 2; ++ai)
#pragma unroll
            for (int m = 0; m < 4; ++m) { unsigned char* rowp = ACT + (size_t)(u.row0 + ai * HALF + wr * 64 + m * 16 + fr) * DEXP + obase;
#pragma unroll
                for (int bj = 0; bj < 2; ++bj) { const f32x4 g = acc[ai][bj][m][0] * W8_INV, up = acc[ai][bj][m][1] * W8_INV; f32x4 o;
#pragma unroll
                    for (int j = 0; j < 4; ++j) o[j] = g[j] * __builtin_amdgcn_rcpf(1.f + __expf(-g[j])) * up[j];
                    *(unsigned*)(rowp + bj * (HALF / 2)) = pk4_fp8(o[0], o[1], o[2], o[3]); } }
    }
};

typedef int i32x8 __attribute__((ext_vector_type(8)));
typedef int i32x4 __attribute__((ext_vector_type(4)));
__device__ __forceinline__ i32x8 cat8(bf16x8 lo, bf16x8 hi) { return __builtin_shufflevector(__builtin_bit_cast(i32x4, lo), __builtin_bit_cast(i32x4, hi), 0, 1, 2, 3, 4, 5, 6, 7); }
template <class Epi, class Sched, bool FP8 = false>
__device__ __forceinline__ void gemm_phase(unsigned char* ldsg, const bf16* A, int K, const Sched& S, const Epi& E) {
    LAS unsigned char* lds = (LAS unsigned char*)ldsg;
    const int tid = threadIdx.x, wid = __builtin_amdgcn_readfirstlane(tid >> 6), lane = tid & 63, wr = wid >> 2, wc = wid & 3, fr = lane & 15, fq = lane >> 4;
    const int nt = K / BK;
    int Rr[2]; unsigned colb[2], voffB[2];
#pragma unroll
    for (int i = 0; i < 2; ++i) { int R, C; stage_rc(tid * 16 + i * 8192, R, C); Rr[i] = R; colb[i] = (unsigned)C * 2u; voffB[i] = (unsigned)(R * K + C) * 2u; }
    const size_t kstep = (size_t)(BK * 2);
    const size_t hstep = (size_t)HALF * K * 2;
    const size_t tstep = 2 * hstep;
    const unsigned ldsw = (unsigned)wid * 1024u;
    const int aoff = lds_byte(wr * 64 + fr, fq * 8), boff = lds_byte(wc * 32 + fr, fq * 8);
#define PG8_SA(b, h) (((b) * 2 + (h)) * HTB)
#define PG8_SB(b, h) ((4 + (b) * 2 + (h)) * HTB)
#define PG8_STAGE(bufoff, gbase, voff) do { _Pragma("unroll") for (int _i = 0; _i < 2; ++_i) \
        __builtin_amdgcn_global_load_lds((const unsigned*)((const char*)(gbase) + (voff)[_i]), (LAS unsigned*)(lds + (bufoff) + ldsw + _i * 8192), 16, 0, 0); } while (0)
#define PG8_LDA(dst, b, h) do { if constexpr (FP8) { _Pragma("unroll") for (int m = 0; m < 4; ++m) dst##8[m] = cat8(*(const LAS bf16x8*)(lds + PG8_SA(b, h) + aoff + m * 2048), *(const LAS bf16x8*)(lds + PG8_SA(b, h) + aoff + m * 2048 + 1024)); } \
        else { _Pragma("unroll") for (int m = 0; m < 4; ++m) _Pragma("unroll") for (int k = 0; k < 2; ++k) dst[m][k] = *(const LAS bf16x8*)(lds + PG8_SA(b, h) + aoff + m * 2048 + k * 1024); } } while (0)
#define PG8_LDB(dst, b, h) do { if constexpr (FP8) { _Pragma("unroll") for (int n = 0; n < 2; ++n) dst##8[n] = cat8(*(const LAS bf16x8*)(lds + PG8_SB(b, h) + boff + n * 2048), *(const LAS bf16x8*)(lds + PG8_SB(b, h) + boff + n * 2048 + 1024)); } \
        else { _Pragma("unroll") for (int n = 0; n < 2; ++n) _Pragma("unroll") for (int k = 0; k < 2; ++k) dst[n][k] = *(const LAS bf16x8*)(lds + PG8_SB(b, h) + boff + n * 2048 + k * 1024); } } while (0)
#define PG8_MMA(ai, bj, At, Bt) do { __builtin_amdgcn_s_setprio(1); \
        if constexpr (FP8) { _Pragma("unroll") for (int m = 0; m < 4; ++m) _Pragma("unroll") for (int n = 0; n < 2; ++n) \
            asm volatile("v_mfma_scale_f32_16x16x128_f8f6f4 %0, %1, %2, %0, %3, %3 op_sel_hi:[0,0,0]" : "+v"(acc[ai][bj][m][n]) : "v"(Bt##8[n]), "v"(At##8[m]), "v"(sc8)); } \
        else { _Pragma("unroll") for (int m = 0; m < 4; ++m) _Pragma("unroll") for (int n = 0; n < 2; ++n) _Pragma("unroll") for (int k = 0; k < 2; ++k) \
            acc[ai][bj][m][n] = __builtin_amdgcn_mfma_f32_16x16x32_bf16(Bt[n][k], At[m][k], acc[ai][bj][m][n], 0, 0, 0); } \
        __builtin_amdgcn_s_setprio(0); } while (0)
#define PG8_WAIT_V(n) asm volatile("s_waitcnt vmcnt(" #n ")" ::: "memory")
#define PG8_WAIT_L(n) asm volatile("s_waitcnt lgkmcnt(" #n ")" ::: "memory")
#define PG8_BAR __builtin_amdgcn_s_barrier()
#define PG8_SCHED __builtin_amdgcn_sched_barrier(0)
    Unit cur, nxt; int ui = 0;
    if (!S.next(0, cur)) return;
    Acc acc;
#pragma unroll
    for (int a = 0; a < 2; ++a)
#pragma unroll
        for (int b = 0; b < 2; ++b)
#pragma unroll
            for (int m = 0; m < 4; ++m)
#pragma unroll
                for (int n = 0; n < 2; ++n) acc[a][b][m][n] = (f32x4){0.f, 0.f, 0.f, 0.f};
    const int sc8 = 0x7f7f7f7f;
    bf16x8 At[4][2], B0[2][2], B1[2][2]; i32x8 At8[4], B08[2], B18[2];
    unsigned aC0[2], aC1[2], aN0[2], aN1[2];
#pragma unroll
    for (int i = 0; i < 2; ++i) { aC0[i] = S.arow(cur, Rr[i]) + colb[i]; aC1[i] = S.arow(cur, HALF + Rr[i]) + colb[i]; }
    const char* Ab = (const char*)A;
    const char* cB = (const char*)cur.Bt + (size_t)cur.pn * tstep;
    PG8_STAGE(PG8_SB(0, 0), cB, voffB); PG8_STAGE(PG8_SB(0, 1), cB + hstep, voffB); PG8_STAGE(PG8_SA(0, 0), Ab, aC0); PG8_STAGE(PG8_SA(0, 1), Ab, aC1);
    if (wr == 1) PG8_BAR;
    PG8_WAIT_V(2); PG8_BAR;
    PG8_STAGE(PG8_SB(1, 0), cB + kstep, voffB); PG8_STAGE(PG8_SA(1, 0), Ab + kstep, aC0); PG8_STAGE(PG8_SB(1, 1), cB + hstep + kstep, voffB);
    PG8_WAIT_V(6); PG8_BAR;
    for (;;) {
        const bool has_next = S.next(ui + 1, nxt);
        if (has_next) {
#pragma unroll
            for (int i = 0; i < 2; ++i) { aN0[i] = S.arow(nxt, Rr[i]) + colb[i]; aN1[i] = S.arow(nxt, HALF + Rr[i]) + colb[i]; }
        } else {
#pragma unroll
            for (int i = 0; i < 2; ++i) { aN0[i] = aC0[i]; aN1[i] = aC1[i]; }
        }
        const char* nB = has_next ? (const char*)nxt.Bt + (size_t)nxt.pn * tstep : cB;
        for (int t = 0; t < nt; t += 2) {
            const bool last = (t == nt - 2);
            const char* a1 = Ab + (size_t)(t + 1) * kstep;
            const char* a2 = last ? Ab : Ab + (size_t)(t + 2) * kstep; const char* b2 = last ? nB : cB + (size_t)(t + 2) * kstep;
            const char* a3 = a2 + kstep; const char* b3 = b2 + kstep;
            unsigned x0[2], x1[2];
#pragma unroll
            for (int i = 0; i < 2; ++i) { x0[i] = last ? aN0[i] : aC0[i]; x1[i] = last ? aN1[i] : aC1[i]; }
            PG8_LDB(B0, 0, 0); PG8_LDB(B1, 0, 1); PG8_SCHED; PG8_LDA(At, 0, 0); PG8_STAGE(PG8_SA(1, 1), a1, aC1);
            PG8_WAIT_V(8); PG8_WAIT_L(0); PG8_BAR; PG8_MMA(0, 0, At, B0); PG8_MMA(0, 1, At, B1); PG8_BAR; PG8_SCHED;
            PG8_LDA(At, 0, 1); PG8_STAGE(PG8_SB(0, 0), b2, voffB); PG8_STAGE(PG8_SB(0, 1), b2 + hstep, voffB); PG8_STAGE(PG8_SA(0, 0), a2, x0);
            PG8_WAIT_V(8); PG8_WAIT_L(0); PG8_BAR; PG8_MMA(1, 0, At, B0); PG8_MMA(1, 1, At, B1); PG8_BAR; PG8_SCHED;
            PG8_LDB(B0, 1, 0); PG8_LDB(B1, 1, 1); PG8_SCHED; PG8_LDA(At, 1, 0); PG8_STAGE(PG8_SA(0, 1), a2, x1);
            PG8_WAIT_V(8); PG8_WAIT_L(0); PG8_BAR; PG8_MMA(0, 0, At, B0); PG8_MMA(0, 1, At, B1); PG8_BAR; PG8_SCHED;
            PG8_LDA(At, 1, 1); PG8_STAGE(PG8_SB(1, 0), b3, voffB); PG8_STAGE(PG8_SB(1, 1), b3 + hstep, voffB); PG8_STAGE(PG8_SA(1, 0), a3, x0);
            PG8_WAIT_V(8); PG8_WAIT_L(0); PG8_BAR; PG8_MMA(1, 0, At, B0); PG8_MMA(1, 1, At, B1); PG8_BAR; PG8_SCHED;
        }
        if (wr == 0) PG8_BAR;
        if constexpr (FP8) asm volatile("s_nop 15\n\ts_nop 7" ::: "memory");
        E(acc, cur, wr, wc, fr, fq);
        if (!has_next) break;
#pragma unroll
        for (int a = 0; a < 2; ++a)
#pragma unroll
            for (int b = 0; b < 2; ++b)
#pragma unroll
                for (int m = 0; m < 4; ++m)
#pragma unroll
                    for (int n = 0; n < 2; ++n) acc[a][b][m][n] = (f32x4){0.f, 0.f, 0.f, 0.f};
        cur = nxt; cB = nB; ++ui;
#pragma unroll
        for (int i = 0; i < 2; ++i) { aC0[i] = aN0[i]; aC1[i] = aN1[i]; }
        if (wr == 1) PG8_BAR;
    }
    PG8_WAIT_V(0);
    PG8_BAR;
#undef PG8_SA
#undef PG8_SB
#undef PG8_STAGE
#undef PG8_LDA
#undef PG8_LDB
#undef PG8_MMA
#undef PG8_WAIT_V
#undef PG8_WAIT_L
#undef PG8_BAR
#undef PG8_SCHED
}
}

__device__ __forceinline__ int vcu_of(const Frame& F) { return (F.G % 8 == 0) ? (F.bid % 8) * (F.G / 8) + F.bid / 8 : F.bid; }
__device__ __forceinline__ void phase_qkv_opt(const Frame& F, const Prm& p, bool nostore = false) {
    pg8::DenseOrder S; S.init(NTOK, 3072, 512, (const bf16*)(p.ws + WS_WQKV), F.G, F.bid);
    static_assert(WS_V - WS_K == WS_K - WS_Q, "Q|K|V equally spaced");
    LAS float* ropel = (LAS float*)((LAS unsigned char*)F.lds + LDSX_OFF);
    const float* ropeg = (const float*)(p.ws + WS_MISC) + 1024;
    for (int i = F.tid; i < 2048; i += NTHR) ropel[i] = ropeg[i];
    __syncthreads();
    pg8::EpiQKV E{(bf16*)(p.ws + WS_Q), ropel, W8_INV, F.ctl + CW_KM, nostore};
    pg8::gemm_phase<pg8::EpiQKV, pg8::DenseOrder, true>(F.lds, (const bf16*)(p.ws + WS_H), 512, S, E);
}
__device__ __forceinline__ void phase_wo_opt(const Frame& F, const Prm& p, int layer) {
    if (layer) {
        pg8::DenseOrder S; S.init(NLAT, 1024, 512, (const bf16*)(p.ws + WS_WGO), F.G, F.bid);
        pg8::EpiPlain E{(bf16*)(p.ws + WS_Y), W8_INV};
        pg8::gemm_phase<pg8::EpiPlain, pg8::DenseOrder, true>(F.lds, (const bf16*)(p.ws + WS_A2B), 512, S, E);
    } else {
        pg8::DenseOrder S; S.init(NTOK, 1024, 512, (const bf16*)(p.ws + WS_WO), F.G, F.bid);
        pg8::EpiPlain E{(bf16*)(p.ws + WS_Y), W8_INV};
        pg8::gemm_phase<pg8::EpiPlain, pg8::DenseOrder, true>(F.lds, (const bf16*)(p.ws + WS_A2), 512, S, E);
    }
}
__device__ __forceinline__ void phase_inproj_opt(const Frame& F, const Prm& p) {
    pg8::DenseOrder S; S.init(NTOK, NIN, 512, (const bf16*)(p.ws + WS_WIN), F.G, F.bid);
    pg8::EpiInproj E{(bf16*)(p.ws + WS_QR), (bf16*)(p.ws + WS_KR), (bf16*)(p.ws + WS_V1), (bf16*)(p.ws + WS_R), (float*)(p.ws + WS_ZZ), W8_INV};
    pg8::gemm_phase<pg8::EpiInproj, pg8::DenseOrder, true>(F.lds, (const bf16*)(p.ws + WS_H), 512, S, E);
}
__device__ __forceinline__ void phase_moe1_opt(const Frame& F, const Prm& p, int layer) {
    pg8::MoeOrder<true> S; S.init(F.ctl + CW_CNT + layer * 16, 1024, 512, (const bf16*)(p.ws + (layer ? WS_GU1 : WS_GU0)), (const int*)(p.ws + WS_LIST), F.G, vcu_of(F));
    pg8::EpiGateUp E{p.ws + WS_ACT};
    pg8::gemm_phase<pg8::EpiGateUp, pg8::MoeOrder<true>, true>(F.lds, (const bf16*)(p.ws + WS_H), 512, S, E);
}
__device__ __forceinline__ void phase_moe2_opt(const Frame& F, const Prm& p, int layer) {
    pg8::MoeOrder<false> S; S.init(F.ctl + CW_CNT + layer * 16, 1024, 256, (const bf16*)(p.ws + (layer ? WS_DN1 : WS_DN0)), nullptr, F.G, vcu_of(F));
    pg8::EpiPlain8 E{p.ws + WS_YM, W8_INV};
    pg8::gemm_phase<pg8::EpiPlain8, pg8::MoeOrder<false>, true>(F.lds, (const bf16*)(p.ws + WS_ACT), 256, S, E);
}
namespace attn_body {
using bf16=unsigned short;
using bf16x8=__attribute__((ext_vector_type(8)))short;
using s16x4=__attribute__((ext_vector_type(4)))short;
using f32x16=__attribute__((ext_vector_type(16)))float;
using u32x4=__attribute__((ext_vector_type(4)))unsigned;
constexpr int D=64,DM=1024;
constexpr int NW=8,QBLK=32,QB=QBLK*NW,KVBLK=64;
constexpr int ATTN_PITCH=DM, ATTN_UNIT_ROWS=QB;
__device__ __forceinline__ int crow(int r,int hi){return (r&3)+8*(r>>2)+4*hi;}
#define SBAR() __builtin_amdgcn_sched_barrier(0)
__device__ __forceinline__ void cmask(f32x16&p0,f32x16&p1,int jb,int qrel,int hi){
  const float NEG=-INFINITY; int kb=64*jb+4*hi;
  #pragma unroll
  for(int r=0;r<16;++r){int kv=kb+(r&3)+8*(r>>2); if(kv>qrel)p0[r]=NEG; if(kv+32>qrel)p1[r]=NEG;}
}

constexpr int NSLOT=3, SLOTB=8192;
constexpr int LDS_K=0, LDS_V=NSLOT*SLOTB, LDS_WS=2*NSLOT*SLOTB, LDS_OST=LDS_WS+NW*64*4, LDS_BYTES=LDS_OST+NW*4096;
constexpr float C2=0.125f*1.4426950408889634f;
__device__ __forceinline__ void glds16(const void*gsrc,unsigned lds_dst){unsigned keep;
  asm volatile("s_mov_b32 %0, m0\n\ts_mov_b32 m0, %2\n\ts_nop 0\n\tglobal_load_lds_dwordx4 %1, off\n\ts_mov_b32 m0, %0":"=&s"(keep):"v"(gsrc),"s"(lds_dst):"memory");}
__device__ __forceinline__ float max3f(float a,float b,float c){float r;asm("v_max3_f32 %0, %1, %2, %3":"=v"(r):"v"(a),"v"(b),"v"(c));return r;}
__device__ __forceinline__ float max2f(float a,float b){float r;asm("v_max_f32_e32 %0, %1, %2":"=v"(r):"v"(a),"v"(b));return r;}
__device__ __forceinline__ float fadd_s(float a,float b){float r;asm("v_add_f32_e32 %0, %1, %2":"=v"(r):"v"(a),"v"(b));return r;}
__device__ __forceinline__ float fsub_s(float a,float b){float r;asm("v_sub_f32_e32 %0, %1, %2":"=v"(r):"v"(a),"v"(b));return r;}
typedef float f32x2_t __attribute__((ext_vector_type(2))); typedef __bf16 bf16x2_t __attribute__((ext_vector_type(2)));
__device__ __forceinline__ unsigned cvtpk_s(float lo,float hi){f32x2_t v={lo,hi};bf16x2_t b=__builtin_convertvector(v,bf16x2_t);return __builtin_bit_cast(unsigned,b);}
#define WAIT_BAR(N) asm volatile("s_waitcnt vmcnt(" #N ") lgkmcnt(0)\n\ts_barrier":::"memory")

__device__ __forceinline__ void qkt(f32x16&p0,f32x16&p1,const char*Kslot,const bf16x8*qr,const f32x16&negm,int r32,int hi){
  const char*kb=Kslot+hi*1024+r32*16;
  #pragma unroll
  for(int d0=0;d0<4;++d0){
    const bf16x8 b0=*reinterpret_cast<const bf16x8*>(kb+d0*2048);
    const bf16x8 b1=*reinterpret_cast<const bf16x8*>(kb+d0*2048+512);
    if(d0==0){p0=__builtin_amdgcn_mfma_f32_32x32x16_bf16(b0,qr[0],negm,0,0,0);p1=__builtin_amdgcn_mfma_f32_32x32x16_bf16(b1,qr[0],negm,0,0,0);}
    else{p0=__builtin_amdgcn_mfma_f32_32x32x16_bf16(b0,qr[d0],p0,0,0,0);p1=__builtin_amdgcn_mfma_f32_32x32x16_bf16(b1,qr[d0],p1,0,0,0);}}
}
typedef __attribute__((address_space(3))) const char* lds_cptr;
typedef short v4i16_t __attribute__((ext_vector_type(4)));
__device__ __forceinline__ void kload8(bf16x8*kf,lds_cptr kp){
  kf[0]=*(const __attribute__((address_space(3))) bf16x8*)(kp);      kf[1]=*(const __attribute__((address_space(3))) bf16x8*)(kp+512);
  kf[2]=*(const __attribute__((address_space(3))) bf16x8*)(kp+2048); kf[3]=*(const __attribute__((address_space(3))) bf16x8*)(kp+2560);
  kf[4]=*(const __attribute__((address_space(3))) bf16x8*)(kp+4096); kf[5]=*(const __attribute__((address_space(3))) bf16x8*)(kp+4608);
  kf[6]=*(const __attribute__((address_space(3))) bf16x8*)(kp+6144); kf[7]=*(const __attribute__((address_space(3))) bf16x8*)(kp+6656);
}
__device__ __forceinline__ void kload2(bf16x8*kf,lds_cptr kp,int j){ kf[2*j]=*(const __attribute__((address_space(3))) bf16x8*)(kp+j*2048); kf[2*j+1]=*(const __attribute__((address_space(3))) bf16x8*)(kp+j*2048+512); }
__device__ __forceinline__ s16x4 vtr(lds_cptr p){ return __builtin_bit_cast(s16x4,__builtin_amdgcn_ds_read_tr16_b64_v4i16((__attribute__((address_space(3))) v4i16_t*)p)); }
__device__ __forceinline__ float rowmax(const f32x16&p0,const f32x16&p1){
  float a=max3f(p0[0],p0[1],p1[0]),b=max3f(p0[2],p0[3],p1[1]);a=max3f(a,p1[2],p1[3]);
  #pragma unroll
  for(int r=4;r<16;r+=4){a=max3f(a,p0[r],p0[r+1]);b=max3f(b,p0[r+2],p0[r+3]);a=max3f(a,p1[r],p1[r+1]);b=max3f(b,p1[r+2],p1[r+3]);}
  const float m=max2f(a,b);
  auto rr=__builtin_amdgcn_permlane32_swap(__float_as_uint(m),__float_as_uint(m),false,false);
  return max2f(__uint_as_float(rr[0]),__uint_as_float(rr[1]));
}
__device__ __forceinline__ void pv(f32x16*o,int vb,bf16x8 pa0,bf16x8 pa1,bf16x8 pa2,bf16x8 pa3){
  #pragma unroll
  for(int d0=0;d0<2;++d0){s16x4 lo[4],hi[4];
    #pragma unroll
    for(int ks=0;ks<4;++ks){
      asm volatile("ds_read_b64_tr_b16 %0,%1 offset:%c2":"=&v"(lo[ks]):"v"(vb),"i"(d0*4096+ks*1024):"memory");
      asm volatile("ds_read_b64_tr_b16 %0,%1 offset:%c2":"=&v"(hi[ks]):"v"(vb),"i"(d0*4096+ks*1024+512):"memory");}
    asm volatile("s_waitcnt lgkmcnt(0)":::"memory");SBAR();
    #define PK(k) (bf16x8){lo[k][0],lo[k][1],lo[k][2],lo[k][3],hi[k][0],hi[k][1],hi[k][2],hi[k][3]}
    o[d0]=__builtin_amdgcn_mfma_f32_32x32x16_bf16(pa0,PK(0),o[d0],0,0,0);
    o[d0]=__builtin_amdgcn_mfma_f32_32x32x16_bf16(pa1,PK(1),o[d0],0,0,0);
    o[d0]=__builtin_amdgcn_mfma_f32_32x32x16_bf16(pa2,PK(2),o[d0],0,0,0);
    o[d0]=__builtin_amdgcn_mfma_f32_32x32x16_bf16(pa3,PK(3),o[d0],0,0,0);
    #undef PK
  }
}

#ifndef ATTN_STORE16
#define ATTN_STORE16(p,v) (*(u32x4*)(p)=(v))
#endif
template<int THRL> __device__ __forceinline__ void attn_unit(long qrow0,int qcol,int vcol,long kctx,long klat,int NT,const bf16*Q,const bf16*__restrict__ K,const bf16*__restrict__ V,bf16*O,char*shm){
  const int tid=threadIdx.x,lane=tid&63,r32=lane&31,hi=lane>>5; const int wid=__builtin_amdgcn_readfirstlane(tid>>6);

  const bf16*Qw=Q+(qrow0+wid*QBLK)*DM+qcol;
  const bf16*Kh=K+qcol,*Vh=V+vcol;
  const unsigned lds0=(unsigned)(uintptr_t)shm;
  float*wsf=(float*)(shm+LDS_WS)+wid*64;
  const bf16*ksrc=Kh+(long)lane*DM+wid*8;
  const bf16*vsrc=Vh+(long)(16*(wid&3)+(lane>>2))*DM+(wid>>2)*32+(lane&3)*8;
  const unsigned kdst=lds0+LDS_K+wid*1024, vdst=lds0+LDS_V+wid*1024;
  #define KVROW(t) ((t)<4?kctx+(long)(t)*KVBLK:klat+(long)((t)-4)*KVBLK)
  #define DMA_K(t,slot) glds16(ksrc+KVROW(t)*DM,(unsigned)__builtin_amdgcn_readfirstlane(kdst+(slot)))
  #define DMA_V(t,slot) glds16(vsrc+KVROW(t)*DM,(unsigned)__builtin_amdgcn_readfirstlane(vdst+(slot)))
  const int vb0=(int)(lds0+LDS_V)+((lane>>4)&1)*32+(lane&3)*8+(4*hi+((lane&15)>>2))*64;
  const char*Kbase=shm+LDS_K; bf16x8 kf[8];
  const lds_cptr shm3=(lds_cptr)shm; const lds_cptr kp0=shm3+LDS_K+hi*1024+r32*16; const lds_cptr vp0=shm3+LDS_V+((lane>>4)&1)*32+(lane&3)*8+(4*hi+((lane&15)>>2))*64;
  DMA_K(0,0);DMA_V(0,0);DMA_K(1,SLOTB);
  bf16x8 qr[4];
  #pragma unroll
  for(int d0=0;d0<4;++d0)qr[d0]=*reinterpret_cast<const bf16x8*>(&Qw[(long)r32*DM+d0*16+hi*8]);
  float mhat=0.f,l_reg=0.f;f32x16 o[2];o[0]=f32x16{};o[1]=f32x16{};f32x16 negm=f32x16{};asm volatile("":"+v"(negm));
  const int qrel=wid*QBLK+r32;
  #define CMASK(P0,P1,t) do{}while(0)
  bool resc=false;
  #define START(P0,P1) do{ const float rm=rowmax(P0,P1); resc=false; \
    { const float dl=rm; mhat=fadd_s(mhat,dl); \
      _Pragma("unroll") for(int r=0;r<16;++r){P0[r]=fsub_s(P0[r],dl);P1[r]=fsub_s(P1[r],dl);} \
      _Pragma("unroll") for(int r=0;r<16;++r)negm[r]=-mhat; asm volatile("":"+v"(negm)); } \
    _Pragma("unroll") for(int r=0;r<16;++r)P0[r]=__builtin_amdgcn_exp2f(P0[r]); }while(0)
  #define RESC() do{ if(resc){ asm volatile("s_waitcnt lgkmcnt(0)":::"memory"); \
      _Pragma("unroll") for(int d_=0;d_<2;++d_) _Pragma("unroll") for(int r=0;r<16;++r)o[d_][r]*=wsf[crow(r,hi)]; } }while(0)
  f32x16 pA0,pA1,pB0,pB1;
  int sl_prev=0,sl_cur=0,sl_next=SLOTB;
  #define ROT() do{sl_prev=sl_cur;sl_cur=sl_next;sl_next=(sl_next==(NSLOT-1)*SLOTB)?0:sl_next+SLOTB;}while(0)
  DMA_K(2,2*SLOTB);
  WAIT_BAR(3);
  qkt(pA0,pA1,Kbase,qr,negm,r32,hi);asm volatile("s_nop 15\n\ts_nop 7":"+v"(pA0),"+v"(pA1));CMASK(pA0,pA1,0);
  START(pA0,pA1);
  _Pragma("unroll") for(int r=0;r<16;++r)pA1[r]=__builtin_amdgcn_exp2f(pA1[r]);
  WAIT_BAR(0);
  DMA_K(3,0);DMA_V(1,SLOTB);
  ROT();
  kload8(kf,kp0+sl_cur);
  WAIT_BAR(2);
  s16x4 vlo[8],vhi[8]; u32x4 pw0,pw1,pw2,pw3;
  #define PKW(P,B) cvtpk_s(P[B],P[B+1])
  #define PAF(k) __builtin_bit_cast(bf16x8,pw##k)
  #define VFR(i) (bf16x8){vlo[i][0],vlo[i][1],vlo[i][2],vlo[i][3],vhi[i][0],vhi[i][1],vhi[i][2],vhi[i][3]}
  #define PIN(x) asm volatile("":"+v"(x))
  #define MX3(a,b,c) __builtin_fmaxf(__builtin_fmaxf((a),(b)),(c))
  #define GAPA(MF,A0,A1,A2,A3,W0,W1,PW) do{ MF; sacc+=A0; sacc+=A1; sacc+=A2; sacc+=A3; PIN(sacc); W0; W1; PIN(PW); SBAR(); }while(0)
  #define EX(v) __builtin_amdgcn_exp2f(v)
  #define GAPB(MF,X,B) do{ MF; X[B]=EX(X[B]); X[B+1]=EX(X[B+1]); X[B+2]=EX(X[B+2]); X[B+3]=EX(X[B+3]); PIN(X); SBAR(); }while(0)
  #define VRD(i) do{ vlo[i]=vtr(vp_+(((i)>>2)*4096+((i)&3)*1024)); vhi[i]=vtr(vp_+(((i)>>2)*4096+((i)&3)*1024+512)); }while(0)
  #define KRD(G,j) do{ if(G){ kload2(kf,kp0+sl_next,j); SBAR(); } }while(0)
  #define STEP(C0,C1,P0,P1,t,GK,GV,GL) do{ SBAR(); \
    const lds_cptr vp_=vp0+sl_prev; \
    VRD(0); SBAR(); float sacc=(P0[0]+P0[1]); \
    GAPA(C0=__builtin_amdgcn_mfma_f32_32x32x16_bf16(kf[0],qr[0],negm,0,0,0), P0[2],P0[3],P0[4],P0[5],     pw0[0]=PKW(P0,0), pw0[1]=PKW(P0,2), pw0); \
    VRD(4); SBAR(); GAPA(C1=__builtin_amdgcn_mfma_f32_32x32x16_bf16(kf[1],qr[0],negm,0,0,0), P0[6],P0[7],P0[8],P0[9],     pw0[2]=PKW(P0,4), pw0[3]=PKW(P0,6), pw0); \
    VRD(1); SBAR(); GAPA(C0=__builtin_amdgcn_mfma_f32_32x32x16_bf16(kf[2],qr[1],C0,0,0,0),   P0[10],P0[11],P0[12],P0[13], pw1[0]=PKW(P0,8), pw1[1]=PKW(P0,10), pw1); \
    VRD(5); SBAR(); GAPA(C1=__builtin_amdgcn_mfma_f32_32x32x16_bf16(kf[3],qr[1],C1,0,0,0),   P0[14],P0[15],P1[0],P1[1],   pw1[2]=PKW(P0,12),pw1[3]=PKW(P0,14), pw1); \
    VRD(2); SBAR(); GAPA(C0=__builtin_amdgcn_mfma_f32_32x32x16_bf16(kf[4],qr[2],C0,0,0,0),   P1[2],P1[3],P1[4],P1[5],     pw2[0]=PKW(P1,0), pw2[1]=PKW(P1,2), pw2); \
    VRD(6); SBAR(); GAPA(C1=__builtin_amdgcn_mfma_f32_32x32x16_bf16(kf[5],qr[2],C1,0,0,0),   P1[6],P1[7],P1[8],P1[9],     pw2[2]=PKW(P1,4), pw2[3]=PKW(P1,6), pw2); \
    VRD(3); SBAR(); GAPA(C0=__builtin_amdgcn_mfma_f32_32x32x16_bf16(kf[6],qr[3],C0,0,0,0),   P1[10],P1[11],P1[12],P1[13], pw3[0]=PKW(P1,8), pw3[1]=PKW(P1,10), pw3); \
    VRD(7); SBAR(); GAPA(C1=__builtin_amdgcn_mfma_f32_32x32x16_bf16(kf[7],qr[3],C1,0,0,0),   P1[14],P1[15],0.f,0.f,       pw3[2]=PKW(P1,12),pw3[3]=PKW(P1,14), pw3); \
    l_reg+=sacc; \
    if(GK){DMA_K((t)+3,sl_cur);} if(GV){DMA_V((t)+1,sl_next);} \
    CMASK(C0,C1,t); \
    { float a=MX3(C0[0],C0[1],C1[0]),b=MX3(C0[2],C0[3],C1[1]); a=MX3(a,C1[2],C1[3]); \
      _Pragma("unroll") for(int r=4;r<16;r+=4){a=MX3(a,C0[r],C0[r+1]);b=MX3(b,C0[r+2],C0[r+3]);a=MX3(a,C1[r],C1[r+1]);b=MX3(b,C1[r+2],C1[r+3]);} \
      float rm=__builtin_fmaxf(a,b); { auto rr=__builtin_amdgcn_permlane32_swap(__float_as_uint(rm),__float_as_uint(rm),false,false); rm=__builtin_fmaxf(__uint_as_float(rr[0]),__uint_as_float(rr[1])); } \
      resc=false; \
      if(__builtin_expect(__any(rm>(float)THRL),0)){ const float dl=__builtin_fmaxf(rm,0.f); mhat+=dl; \
        _Pragma("unroll") for(int r=0;r<16;++r){C0[r]-=dl;C1[r]-=dl;} \
        _Pragma("unroll") for(int r=0;r<16;++r)negm[r]=-mhat; asm volatile("":"+v"(negm)); \
        const float f=__builtin_amdgcn_exp2f(-dl); l_reg*=f; if(hi==0)wsf[r32]=f; resc=true; } } \
    SBAR(); \
    GAPB(o[0]=__builtin_amdgcn_mfma_f32_32x32x16_bf16(PAF(0),VFR(0),o[0],0,0,0), C0,0); \
    GAPB(o[1]=__builtin_amdgcn_mfma_f32_32x32x16_bf16(PAF(0),VFR(4),o[1],0,0,0), C0,4); \
    KRD(GL,0); GAPB(o[0]=__builtin_amdgcn_mfma_f32_32x32x16_bf16(PAF(1),VFR(1),o[0],0,0,0), C0,8); \
    KRD(GL,1); GAPB(o[1]=__builtin_amdgcn_mfma_f32_32x32x16_bf16(PAF(1),VFR(5),o[1],0,0,0), C0,12); \
    KRD(GL,2); GAPB(o[0]=__builtin_amdgcn_mfma_f32_32x32x16_bf16(PAF(2),VFR(2),o[0],0,0,0), C1,0); \
    KRD(GL,3); GAPB(o[1]=__builtin_amdgcn_mfma_f32_32x32x16_bf16(PAF(2),VFR(6),o[1],0,0,0), C1,4); \
    GAPB(o[0]=__builtin_amdgcn_mfma_f32_32x32x16_bf16(PAF(3),VFR(3),o[0],0,0,0), C1,8); \
    GAPB(o[1]=__builtin_amdgcn_mfma_f32_32x32x16_bf16(PAF(3),VFR(7),o[1],0,0,0), C1,12); \
    }while(0)
  int t=1;
  #undef CMASK
  #define CMASK(P0,P1,t) do{}while(0)
  for(;t+5<NT;t+=2){
    STEP(pB0,pB1,pA0,pA1,t,true,true,true);     WAIT_BAR(2); RESC(); ROT();
    STEP(pA0,pA1,pB0,pB1,t+1,true,true,true);   WAIT_BAR(2); RESC(); ROT();
  }
  #undef CMASK
  #define CMASK(P0,P1,t) do{}while(0)
  #define ENDW(tt) do{ if((tt)+3<NT){WAIT_BAR(2);} else if((tt)+2<NT){WAIT_BAR(1);} else {WAIT_BAR(0);} }while(0)
  for(;t+1<NT;t+=2){
    STEP(pB0,pB1,pA0,pA1,t,(t+3<NT),(t+1<NT),(t+1<NT));       ENDW(t);   RESC(); ROT();
    STEP(pA0,pA1,pB0,pB1,t+1,(t+4<NT),(t+2<NT),(t+2<NT));     ENDW(t+1); RESC(); ROT();
  }
  STEP(pB0,pB1,pA0,pA1,NT-1,false,false,false); RESC();
  { float sacc=pB0[0]+pB0[1]; _Pragma("unroll") for(int r=2;r<16;++r)sacc+=pB0[r]; _Pragma("unroll") for(int r=0;r<16;++r)sacc+=pB1[r]; l_reg+=sacc;
    pw0=(u32x4){PKW(pB0,0),PKW(pB0,2),PKW(pB0,4),PKW(pB0,6)};pw1=(u32x4){PKW(pB0,8),PKW(pB0,10),PKW(pB0,12),PKW(pB0,14)};pw2=(u32x4){PKW(pB1,0),PKW(pB1,2),PKW(pB1,4),PKW(pB1,6)};pw3=(u32x4){PKW(pB1,8),PKW(pB1,10),PKW(pB1,12),PKW(pB1,14)};
    SBAR(); pv(o,vb0+sl_cur,PAF(0),PAF(1),PAF(2),PAF(3)); }
  #undef PKW
  #undef PAF
  #undef VFR
  #undef PIN
  #undef MX3
  #undef GAPA
  #undef GAPB
  #undef EX
  #undef VRD
  #undef KRD
  #undef STEP
  #undef ENDW
  {auto rr=__builtin_amdgcn_permlane32_swap(__float_as_uint(l_reg),__float_as_uint(l_reg),false,false);l_reg=__uint_as_float(rr[0])+__uint_as_float(rr[1]);}
  if(hi==0)wsf[32+r32]=l_reg;asm volatile("s_waitcnt lgkmcnt(0)":::"memory");
  float rli[16];
  #pragma unroll
  for(int r=0;r<16;++r)rli[r]=__builtin_amdgcn_rcpf(wsf[32+crow(r,hi)]);
  bf16*Ow=O+(qrow0+wid*QBLK)*DM+vcol;
  { bf16*stg=(bf16*)(shm+LDS_OST)+wid*2048;
    #pragma unroll
    for(int r=0;r<16;++r){const int orow=crow(r,hi);
      #pragma unroll
      for(int d0=0;d0<2;++d0)stg[orow*64+d0*32+r32]=(bf16)f2bf(o[d0][r]*rli[r]);}
    asm volatile("s_waitcnt lgkmcnt(0)":::"memory");
    #pragma unroll
    for(int i=0;i<4;++i){const int row=i*8+(lane>>3),ch=lane&7; const u32x4 v=*(const u32x4*)(stg+row*64+ch*8); ATTN_STORE16(Ow+(long)row*DM+ch*8,v);} }
  asm volatile("s_waitcnt lgkmcnt(0)\n\ts_barrier":::"memory");
  #undef DMA_K
  #undef DMA_V
  #undef CMASK
  #undef START
  #undef RESC
  #undef ROT
}
constexpr int ATTN_LDS_BYTES=LDS_BYTES;
#undef SBAR
#undef WAIT_BAR
#undef KVROW
}
namespace attn_body {
constexpr int V2SLOT = 16384;
constexpr int L2_K = 0, L2_V = NSLOT * SLOTB, L2_WS = L2_V + NSLOT * V2SLOT, L2_ST = L2_WS + NW * 64 * 4, L2_BYTES = L2_ST + NW * 8192;
#define SBAR() __builtin_amdgcn_sched_barrier(0)
#define WAIT_BAR(N) asm volatile("s_waitcnt vmcnt(" #N ") lgkmcnt(0)\n\ts_barrier":::"memory")
template<int THRL> __device__ __forceinline__ void attn_unit2(long qrow0,int qcol,int vcol,long kctx,long klat,int NT,const bf16*Q,const bf16*__restrict__ K,const bf16*__restrict__ V,int m,float lam,const float*subln,unsigned char*A2,int acol,float km,char*shm){
  const int tid=threadIdx.x,lane=tid&63,r32=lane&31,hi=lane>>5; const int wid=__builtin_amdgcn_readfirstlane(tid>>6);
  const bf16*Qw=Q+(qrow0+wid*QBLK)*DM+qcol;
  const bf16*Kh=K+qcol,*Vh=V+vcol;
  const unsigned lds0=(unsigned)(uintptr_t)shm;
  float*wsf=(float*)(shm+L2_WS)+wid*64;
  const bf16*ksrc=Kh+(long)lane*DM+wid*8;
  const bf16*vsrc=Vh+(long)(16*(wid&3)+(lane>>2))*DM+(wid>>2)*32+(lane&3)*8;
  const unsigned kdst=lds0+L2_K+wid*1024, vdst=lds0+L2_V+wid*1024;
  #define KVROW(t) ((t)<4?kctx+(long)(t)*KVBLK:klat+(long)((t)-4)*KVBLK)
  #define DMA_K(t,slot) glds16(ksrc+KVROW(t)*DM,(unsigned)__builtin_amdgcn_readfirstlane(kdst+(slot)))
  #define DMA_V(t,slot) do{ glds16(vsrc+KVROW(t)*DM,(unsigned)__builtin_amdgcn_readfirstlane(vdst+2*(slot))); glds16(vsrc+KVROW(t)*DM+64,(unsigned)__builtin_amdgcn_readfirstlane(vdst+2*(slot)+8192)); }while(0)
  const char*Kbase=shm+L2_K; bf16x8 kf[8];
  const lds_cptr shm3=(lds_cptr)shm; const lds_cptr kp0=shm3+L2_K+hi*1024+r32*16; const lds_cptr vp0=shm3+L2_V+((lane>>4)&1)*32+(lane&3)*8+(4*hi+((lane&15)>>2))*64;
  DMA_K(0,0);DMA_V(0,0);DMA_K(1,SLOTB);
  bf16x8 qr[4];
  #pragma unroll
  for(int d0=0;d0<4;++d0)qr[d0]=*reinterpret_cast<const bf16x8*>(&Qw[(long)r32*DM+d0*16+hi*8]);
  bool FAST; { float qn=0.f;
    #pragma unroll
    for(int d0=0;d0<4;++d0){ const u32x4 u=__builtin_bit_cast(u32x4,qr[d0]); const unsigned a4[4]={u.x,u.y,u.z,u.w};
      #pragma unroll
      for(int i=0;i<4;++i){ const float lo=__uint_as_float(a4[i]<<16),h2=__uint_as_float(a4[i]&0xffff0000u); qn+=lo*lo+h2*h2; } }
    qn+=__shfl_xor(qn,32); FAST=__all(qn*km<=96.f*96.f)!=0; }
  float mhat=0.f,l_reg=0.f;f32x16 o[4];o[0]=f32x16{};o[1]=f32x16{};o[2]=f32x16{};o[3]=f32x16{};const f32x16 zero16=f32x16{};
  bool resc=false;
  #define START(P0,P1) do{ resc=false; if(FAST){ mhat=0.f; } else { const float rm=rowmax(P0,P1); mhat=rm; \
    _Pragma("unroll") for(int r=0;r<16;++r){P0[r]=fsub_s(P0[r],rm);P1[r]=fsub_s(P1[r],rm);} } \
    _Pragma("unroll") for(int r=0;r<16;++r)P0[r]=__builtin_amdgcn_exp2f(P0[r]); }while(0)
  #define RESC() do{ if(resc){ asm volatile("s_waitcnt lgkmcnt(0)":::"memory"); \
      _Pragma("unroll") for(int d_=0;d_<4;++d_) _Pragma("unroll") for(int r=0;r<16;++r)o[d_][r]*=wsf[crow(r,hi)]; } }while(0)
  int sl_prev=0,sl_cur=0,sl_next=SLOTB;
  #define ROT() do{sl_prev=sl_cur;sl_cur=sl_next;sl_next=(sl_next==(NSLOT-1)*SLOTB)?0:sl_next+SLOTB;}while(0)
  DMA_K(2,2*SLOTB);
  WAIT_BAR(4);
  #define PKW(P,B) cvtpk_s(P[B],P[B+1])
  u32x4 pwA0,pwA1,pwA2,pwA3,pwB0,pwB1,pwB2,pwB3;
  { f32x16 p0,p1;
    qkt(p0,p1,Kbase,qr,zero16,r32,hi);asm volatile("s_nop 15\n\ts_nop 7":"+v"(p0),"+v"(p1));
    START(p0,p1);
    _Pragma("unroll") for(int r=0;r<16;++r)p1[r]=__builtin_amdgcn_exp2f(p1[r]);
    float sacc=p0[0]+p0[1]; _Pragma("unroll") for(int r=2;r<16;++r)sacc+=p0[r]; _Pragma("unroll") for(int r=0;r<16;++r)sacc+=p1[r]; l_reg+=sacc;
    pwA0=(u32x4){PKW(p0,0),PKW(p0,2),PKW(p0,4),PKW(p0,6)};pwA1=(u32x4){PKW(p0,8),PKW(p0,10),PKW(p0,12),PKW(p0,14)};pwA2=(u32x4){PKW(p1,0),PKW(p1,2),PKW(p1,4),PKW(p1,6)};pwA3=(u32x4){PKW(p1,8),PKW(p1,10),PKW(p1,12),PKW(p1,14)}; }
  WAIT_BAR(0);
  DMA_K(3,0);DMA_V(1,SLOTB);
  ROT();
  kload8(kf,kp0+sl_cur);
  WAIT_BAR(3);
  s16x4 vAl[4],vAh[4],vBl[4],vBh[4];
  #define PAFX(x) __builtin_bit_cast(bf16x8,x)
  #define VF(A,d) (bf16x8){A##l[d][0],A##l[d][1],A##l[d][2],A##l[d][3],A##h[d][0],A##h[d][1],A##h[d][2],A##h[d][3]}
  #define PIN(x) asm volatile("":"+v"(x))
  #define MX3(a,b,c) __builtin_fmaxf(__builtin_fmaxf((a),(b)),(c))
  #define EX(v) __builtin_amdgcn_exp2f(v)
  #define VRDL(A,d,ks) A##l[d]=vtr(vp_+((d)*4096+(ks)*1024))
  #define VRDH(A,d,ks) A##h[d]=vtr(vp_+((d)*4096+(ks)*1024+512))
  #define GAPF(MF,X,B,PWN,W,RD) do{ MF; X[B]=EX(X[B]); X[B+1]=EX(X[B+1]); sacc+=X[B]; sacc+=X[B+1]; PIN(sacc); PWN[W]=cvtpk_s(X[B],X[B+1]); PIN(PWN); RD; SBAR(); }while(0)
  #define GAPP(MF,X,B,PWN,W,RD) do{ MF; X[B]=EX(X[B]-mhat); X[B+1]=EX(X[B+1]-mhat); sacc+=X[B]; sacc+=X[B+1]; PIN(sacc); PWN[W]=cvtpk_s(X[B],X[B+1]); PIN(PWN); RD; SBAR(); }while(0)
  #define MFQ(C,kf_,q_,acc_) C=__builtin_amdgcn_mfma_f32_32x32x16_bf16(kf_,q_,acc_,0,0,0)
  #define MFO(d,PW,A) o[d]=__builtin_amdgcn_mfma_f32_32x32x16_bf16(PAFX(PW),VF(A,d),o[d],0,0,0)
  #define KRD(G,j) do{ if(G){ kload2(kf,kp0+sl_next,j); } }while(0)
  #define PHASEB(G,PI0,PI1,PI2,PI3,PO0,PO1,PO2,PO3,GL) do{ \
    G(MFO(0,PI0,vA),C0,0, PO0,0, VRDL(vB,0,1);VRDH(vB,0,1)); \
    G(MFO(1,PI0,vA),C0,2, PO0,1, VRDL(vB,1,1);VRDH(vB,1,1)); \
    G(MFO(2,PI0,vA),C0,4, PO0,2, VRDL(vB,2,1);VRDH(vB,2,1)); \
    G(MFO(3,PI0,vA),C0,6, PO0,3, VRDL(vB,3,1);VRDH(vB,3,1)); \
    G(MFO(0,PI1,vB),C0,8, PO1,0, VRDL(vA,0,2);VRDH(vA,0,2)); \
    G(MFO(1,PI1,vB),C0,10,PO1,1, VRDL(vA,1,2);VRDH(vA,1,2)); \
    G(MFO(2,PI1,vB),C0,12,PO1,2, VRDL(vA,2,2);VRDH(vA,2,2)); \
    G(MFO(3,PI1,vB),C0,14,PO1,3, VRDL(vA,3,2);VRDH(vA,3,2)); \
    G(MFO(0,PI2,vA),C1,0, PO2,0, VRDL(vB,0,3);VRDH(vB,0,3)); \
    G(MFO(1,PI2,vA),C1,2, PO2,1, VRDL(vB,1,3);VRDH(vB,1,3)); \
    G(MFO(2,PI2,vA),C1,4, PO2,2, VRDL(vB,2,3);VRDH(vB,2,3)); \
    G(MFO(3,PI2,vA),C1,6, PO2,3, VRDL(vB,3,3);VRDH(vB,3,3)); \
    G(MFO(0,PI3,vB),C1,8, PO3,0, KRD(GL,0)); \
    G(MFO(1,PI3,vB),C1,10,PO3,1, KRD(GL,1)); \
    G(MFO(2,PI3,vB),C1,12,PO3,2, KRD(GL,2)); \
    G(MFO(3,PI3,vB),C1,14,PO3,3, KRD(GL,3)); \
    }while(0)
  #define STEP2(t,PI0,PI1,PI2,PI3,PO0,PO1,PO2,PO3,GK,GV,GL) do{ SBAR(); \
    const lds_cptr vp_=vp0+2*sl_prev; f32x16 C0,C1; float sacc=0.f; \
    VRDL(vA,0,0); SBAR(); MFQ(C0,kf[0],qr[0],zero16); SBAR(); \
    VRDH(vA,0,0); SBAR(); MFQ(C1,kf[1],qr[0],zero16); SBAR(); \
    VRDL(vA,1,0); SBAR(); MFQ(C0,kf[2],qr[1],C0); SBAR(); \
    VRDH(vA,1,0); SBAR(); MFQ(C1,kf[3],qr[1],C1); SBAR(); \
    VRDL(vA,2,0); SBAR(); MFQ(C0,kf[4],qr[2],C0); SBAR(); \
    VRDH(vA,2,0); SBAR(); MFQ(C1,kf[5],qr[2],C1); SBAR(); \
    VRDL(vA,3,0); SBAR(); MFQ(C0,kf[6],qr[3],C0); SBAR(); \
    VRDH(vA,3,0); SBAR(); MFQ(C1,kf[7],qr[3],C1); SBAR(); \
    if(GK){DMA_K((t)+3,sl_cur);} if(GV){DMA_V((t)+1,sl_next);} \
    if(!FAST){ float a=MX3(C0[0],C0[1],C1[0]),b=MX3(C0[2],C0[3],C1[1]); a=MX3(a,C1[2],C1[3]); \
      _Pragma("unroll") for(int r=4;r<16;r+=4){a=MX3(a,C0[r],C0[r+1]);b=MX3(b,C0[r+2],C0[r+3]);a=MX3(a,C1[r],C1[r+1]);b=MX3(b,C1[r+2],C1[r+3]);} \
      float rm=__builtin_fmaxf(a,b); { auto rr=__builtin_amdgcn_permlane32_swap(__float_as_uint(rm),__float_as_uint(rm),false,false); rm=__builtin_fmaxf(__uint_as_float(rr[0]),__uint_as_float(rr[1])); } \
      resc=false; \
      if(__builtin_expect(__any(rm-mhat>(float)THRL),0)){ const float dl=__builtin_fmaxf(rm-mhat,0.f); mhat+=dl; \
        const float f=__builtin_amdgcn_exp2f(-dl); l_reg*=f; if(hi==0)wsf[r32]=f; resc=true; } } \
    __builtin_amdgcn_s_setprio(1); SBAR(); \
    PHASEB(GAPP,PI0,PI1,PI2,PI3,PO0,PO1,PO2,PO3,GL); \
    __builtin_amdgcn_s_setprio(0); l_reg+=sacc; \
    }while(0)
  #define ENDW(tt) do{ if((tt)+3<NT){WAIT_BAR(3);} else if((tt)+2<NT){WAIT_BAR(2);} else {WAIT_BAR(0);} }while(0)
  int t=1;
  for(;t+5<NT;t+=2){
    STEP2(t,  pwA0,pwA1,pwA2,pwA3,pwB0,pwB1,pwB2,pwB3,true,true,true); WAIT_BAR(3); RESC(); ROT();
    STEP2(t+1,pwB0,pwB1,pwB2,pwB3,pwA0,pwA1,pwA2,pwA3,true,true,true); WAIT_BAR(3); RESC(); ROT();
  }
  for(;t+1<NT;t+=2){
    STEP2(t,  pwA0,pwA1,pwA2,pwA3,pwB0,pwB1,pwB2,pwB3,(t+3<NT),(t+1<NT),(t+1<NT)); ENDW(t);   RESC(); ROT();
    STEP2(t+1,pwB0,pwB1,pwB2,pwB3,pwA0,pwA1,pwA2,pwA3,(t+4<NT),(t+2<NT),(t+2<NT)); ENDW(t+1); RESC(); ROT();
  }
  STEP2(NT-1,pwA0,pwA1,pwA2,pwA3,pwB0,pwB1,pwB2,pwB3,false,false,false); RESC();
  { const lds_cptr vp_=vp0+2*sl_cur;
    #pragma unroll
    for(int ks=0;ks<4;++ks){
      #pragma unroll
      for(int d=0;d<4;++d){ const s16x4 lo=vtr(vp_+(d*4096+ks*1024)),hh=vtr(vp_+(d*4096+ks*1024+512)); const bf16x8 vf=(bf16x8){lo[0],lo[1],lo[2],lo[3],hh[0],hh[1],hh[2],hh[3]};
        const u32x4 pw=(ks==0)?pwB0:(ks==1)?pwB1:(ks==2)?pwB2:pwB3;
        o[d]=__builtin_amdgcn_mfma_f32_32x32x16_bf16(PAFX(pw),vf,o[d],0,0,0); } } }
  {auto rr=__builtin_amdgcn_permlane32_swap(__float_as_uint(l_reg),__float_as_uint(l_reg),false,false);l_reg=__uint_as_float(rr[0])+__uint_as_float(rr[1]);}
  if(hi==0)wsf[32+r32]=l_reg;asm volatile("s_waitcnt lgkmcnt(0)":::"memory");
  float rli[16];
  #pragma unroll
  for(int r=0;r<16;++r)rli[r]=__builtin_amdgcn_rcpf(wsf[32+crow(r,hi)]);
  unsigned short*stash=(unsigned short*)(shm+L2_ST)+wid*4096;
  if(m==0){
    #pragma unroll
    for(int d0=0;d0<4;++d0){
      #pragma unroll
      for(int r=0;r<16;++r)stash[(d0*16+r)*64+lane]=(unsigned short)f2bf(o[d0][r]*rli[r]);}
    asm volatile("s_waitcnt lgkmcnt(0)":::"memory");
  } else {
    float ss[16];
    #pragma unroll
    for(int r=0;r<16;++r)ss[r]=0.f;
    #pragma unroll
    for(int d0=0;d0<4;++d0){
      #pragma unroll
      for(int r=0;r<16;++r){ const float o1=bf2f(stash[(d0*16+r)*64+lane]); const float df=o1-lam*(o[d0][r]*rli[r]); o[d0][r]=df; ss[r]+=df*df; } }
    #pragma unroll
    for(int r=0;r<16;++r){ float q=ss[r];
      #pragma unroll
      for(int s_=1;s_<32;s_<<=1)q+=__shfl_xor(q,s_);
      ss[r]=(1.f-LAMBDA_INIT0)/sqrtf(q*(1.f/128.f)+LN_EPS); }
    asm volatile("s_waitcnt lgkmcnt(0)":::"memory");
    unsigned char*stg=(unsigned char*)stash;
    #pragma unroll
    for(int d0=0;d0<4;++d0){ const float sgv=subln[d0*32+r32];
      #pragma unroll
      for(int r=0;r<16;++r){ const int w8=__builtin_amdgcn_cvt_pk_fp8_f32(o[d0][r]*ss[r]*sgv,0.f,0,false); stg[crow(r,hi)*128+d0*32+r32]=(unsigned char)(w8&0xff); } }
    asm volatile("s_waitcnt lgkmcnt(0)":::"memory");
    unsigned char*Aw=A2+(qrow0+wid*QBLK)*DM+acol;
    #pragma unroll
    for(int i=0;i<4;++i){const int row=i*8+(lane>>3),ch=lane&7; const u32x4 v=*(const u32x4*)(stg+row*128+ch*16); *(u32x4*)(Aw+(long)row*DM+ch*16)=v;}
    asm volatile("s_waitcnt lgkmcnt(0)":::"memory");
  }
  asm volatile("s_waitcnt lgkmcnt(0)\n\ts_barrier":::"memory");
  #undef KVROW
  #undef DMA_K
  #undef DMA_V
  #undef START
  #undef RESC
  #undef ROT
  #undef PKW
  #undef PAFX
  #undef VF
  #undef PIN
  #undef MX3
  #undef EX
  #undef VRDL
  #undef VRDH
  #undef GAPP
  #undef GAPF
  #undef PHASEB
  #undef MFQ
  #undef MFO
  #undef KRD
  #undef STEP2
  #undef ENDW
}
#undef SBAR
#undef WAIT_BAR
}
__device__ __forceinline__ void phase_attn2(const Frame& F, const Prm& p) {
    const bf16* Q = (const bf16*)(p.ws + WS_Q); const bf16* K = (const bf16*)(p.ws + WS_K); const bf16* V = (const bf16*)(p.ws + WS_V); unsigned char* A2 = p.ws + WS_O1;
    const float lam = ((const float*)(p.ws + WS_MISC))[0];
    for (int v = vcu_of(F); v < 256; v += F.G) {
        const int b = v >> 5, h = (v >> 2) & 7, part = v & 3;
        const long kctx = NLAT + b * CTXL, klat = (long)b * SEQ;
        const int nu = part ? 4 : 5;
        for (int i = 0; i < nu; ++i) {
            const long qrow0 = i < 4 ? klat + (part * 4 + i) * 256 : kctx; const int NT = i < 4 ? 68 : 4;
            for (int m = 0; m < 2; ++m) {
                const int hm = 2 * h + m;
                const float km = __uint_as_float(__hip_atomic_load(F.ctl + CW_KM + b * 16 + hm, __ATOMIC_RELAXED, __HIP_MEMORY_SCOPE_AGENT));
                attn_body::attn_unit2<8>(qrow0, hm * 64, h * 128, kctx, klat, NT, Q, K, V, m, lam, p.subln, A2, h * 128, km, (char*)F.lds);
            }
        }
    }
}
namespace gla3 {
typedef short bf16x8 __attribute__((ext_vector_type(8)));
typedef short s16x4 __attribute__((ext_vector_type(4)));
typedef float f32x16 __attribute__((ext_vector_type(16)));
constexpr int CH = 64 * 16 + 64;
constexpr int L_QS = 0, L_KS = 16 * CH, L_VS = 32 * CH, L_SB = 40 * CH, L_X = 56 * CH, L_DEC = L_X + 16384, L_END = L_DEC + 512;
__device__ __forceinline__ int crow(int i, int hh) { return (i & 3) + 8 * (i >> 2) + 4 * hh; }
typedef float f32x2_t __attribute__((ext_vector_type(2))); typedef __bf16 bf16x2_t __attribute__((ext_vector_type(2)));
__device__ __forceinline__ unsigned pk(float lo, float hi) { f32x2_t v = {lo, hi}; bf16x2_t b = __builtin_convertvector(v, bf16x2_t); return __builtin_bit_cast(unsigned, b); }
typedef short v4i16_t __attribute__((ext_vector_type(4)));
__device__ __forceinline__ s16x4 trrd(LAS const unsigned char* p) { return __builtin_bit_cast(s16x4, __builtin_amdgcn_ds_read_tr16_b64_v4i16((LAS v4i16_t*)p)); }
#define GLA_FR(lo, hi) (bf16x8){lo[0], lo[1], lo[2], lo[3], hi[0], hi[1], hi[2], hi[3]}

__device__ __forceinline__ void scan_unit(const Frame& F, const Prm& p, int unit) {
    const int dvs = unit & 3, dir = (unit >> 2) & 1, h = (unit >> 3) & 3, b = unit >> 5;
    LAS unsigned char* lds = (LAS unsigned char*)F.lds;
    const int lane = F.lane, w = F.wave, tid = F.tid, r = lane & 31, hh = lane >> 5;
    const bf16* QT = (const bf16*)(p.ws + WS_QT) + ((size_t)dir * 8 + 2 * h) * NTOK * 64;
    const bf16* KT = (const bf16*)(p.ws + WS_KT) + ((size_t)dir * 8 + 2 * h) * NTOK * 64;
    const bf16* V = (const bf16*)(p.ws + WS_V1) + h * 256 + dvs * 64;
    const float* DEC = (const float*)(p.ws + WS_DEC) + (size_t)dir * NCHUNK * 512 + h * 128;
    bf16* OG = (bf16*)((unsigned char*)p.out + (dir ? OUT_OGB : 0)) + h * 256 + dvs * 64;
    const int g1 = (lane >> 4) & 1, q4 = (lane & 15) >> 2, p4 = lane & 3;
    const int trb = (2 * g1 + (p4 >> 1)) * CH + q4 * 16 + 8 * (p4 & 1);
    const int trN = trb + 128 * hh, trP = trb + 64 * hh;
    f32x16 S0 = {}, S1 = {};
    for (int i = tid; i < 16 * CH / 16; i += NTHR) *(LAS u32x4*)(lds + L_SB + i * 16) = (u32x4){0u, 0u, 0u, 0u};
    u32x4 pq0[2], pq1[2], pk0[2], pk1[2], pv[2]; float pdec[2] = {0.f, 0.f};
#define GLA_CHUNK(step) ((step) >= 4 ? b * 64 + (dir ? 63 - ((step) - 4) : (step) - 4) : 512 + b * 4 + (dir ? 3 - (step) : (step)))
    const int qrow = 8 * w + (lane >> 4), qch = lane & 15, vrow = 8 * w + (lane >> 3), vch = lane & 7;
    const size_t qgo = (size_t)(qch >> 3) * NTOK * 64 + (qch & 7) * 8;
#define GLA_LOAD(step, u) do { const size_t t0_ = (size_t)GLA_CHUNK(step) * 64; \
        pq0[u] = *(const u32x4*)(QT + qgo + (t0_ + qrow) * 64); pq1[u] = *(const u32x4*)(QT + qgo + (t0_ + qrow + 4) * 64); \
        pk0[u] = *(const u32x4*)(KT + qgo + (t0_ + qrow) * 64); pk1[u] = *(const u32x4*)(KT + qgo + (t0_ + qrow + 4) * 64); \
        pv[u] = *(const u32x4*)(V + (t0_ + vrow) * 1024 + 8 * vch); if (tid < 128) pdec[u] = DEC[(size_t)GLA_CHUNK(step) * 512 + tid]; } while (0)
#define GLA_STORE(u) do { \
        *(LAS u32x4*)(lds + L_QS + qch * CH + qrow * 16) = pq0[u]; *(LAS u32x4*)(lds + L_QS + qch * CH + (qrow + 4) * 16) = pq1[u]; \
        *(LAS u32x4*)(lds + L_KS + qch * CH + qrow * 16) = pk0[u]; *(LAS u32x4*)(lds + L_KS + qch * CH + (qrow + 4) * 16) = pk1[u]; \
        *(LAS u32x4*)(lds + L_VS + vch * CH + vrow * 16) = pv[u]; \
        if (tid < 128) *(LAS float*)(lds + L_DEC + 4 * tid) = pdec[u]; } while (0)
    GLA_LOAD(0, 0);
    GLA_LOAD(1, 1);
    GLA_STORE(0);
    __syncthreads();
    const int tb = (w & 3) >> 1, vb = w & 1;
    for (int sp2 = 0; sp2 < 34; ++sp2) {
#pragma unroll
    for (int u = 0; u < 2; ++u) {
        const int step = 2 * sp2 + u;
        const bool lat = step >= 4; const int chunk = GLA_CHUNK(step);
        if (step + 2 < 68) GLA_LOAD(step + 2, u);
        f32x16 o = {};
        if (w < 4) {
            if (lat) {
                const bool n0 = dir ? (tb == 0) : true, n1 = dir ? true : (tb == 1);
                f32x16 sc0 = {}, sc1 = {};
#define GLA_BQ(ks) (*(const LAS bf16x8*)(lds + L_QS + (2 * (ks) + hh) * CH + (32 * tb + r) * 16))
#define GLA_A0(ks) (*(const LAS bf16x8*)(lds + L_KS + (2 * (ks) + hh) * CH + r * 16))
#define GLA_A1(ks) (*(const LAS bf16x8*)(lds + L_KS + (2 * (ks) + hh) * CH + (32 + r) * 16))
                if (n0 && n1) {
#pragma unroll
                    for (int ks = 0; ks < 8; ++ks) { const bf16x8 bq = GLA_BQ(ks); sc0 = __builtin_amdgcn_mfma_f32_32x32x16_bf16(GLA_A0(ks), bq, sc0, 0, 0, 0); sc1 = __builtin_amdgcn_mfma_f32_32x32x16_bf16(GLA_A1(ks), bq, sc1, 0, 0, 0); }
                } else if (n0) {
#pragma unroll
                    for (int ks = 0; ks < 8; ++ks) sc0 = __builtin_amdgcn_mfma_f32_32x32x16_bf16(GLA_A0(ks), GLA_BQ(ks), sc0, 0, 0, 0);
                } else {
#pragma unroll
                    for (int ks = 0; ks < 8; ++ks) sc1 = __builtin_amdgcn_mfma_f32_32x32x16_bf16(GLA_A1(ks), GLA_BQ(ks), sc1, 0, 0, 0);
                }
#undef GLA_BQ
#undef GLA_A0
#undef GLA_A1
                const int t = 32 * tb + r;
#pragma unroll
                for (int i = 0; i < 16; ++i) { const int s0 = crow(i, hh), s1 = 32 + s0; const bool k0 = dir ? (s0 >= t) : (s0 <= t), k1 = dir ? (s1 >= t) : (s1 <= t); sc0[i] = k0 ? sc0[i] : 0.f; sc1[i] = k1 ? sc1[i] : 0.f; }
#pragma unroll
                for (int sb = 0; sb < 2; ++sb) { if (sb == 0 ? n0 : n1) {
#pragma unroll
                    for (int sp = 0; sp < 2; ++sp) {
                        u32x4 pw;
                        if (sb == 0) { pw.x = pk(sc0[8 * sp + 0], sc0[8 * sp + 1]); pw.y = pk(sc0[8 * sp + 2], sc0[8 * sp + 3]); pw.z = pk(sc0[8 * sp + 4], sc0[8 * sp + 5]); pw.w = pk(sc0[8 * sp + 6], sc0[8 * sp + 7]); }
                        else { pw.x = pk(sc1[8 * sp + 0], sc1[8 * sp + 1]); pw.y = pk(sc1[8 * sp + 2], sc1[8 * sp + 3]); pw.z = pk(sc1[8 * sp + 4], sc1[8 * sp + 5]); pw.w = pk(sc1[8 * sp + 6], sc1[8 * sp + 7]); }
                        LAS const unsigned char* vp = lds + L_VS + trP + (4 * vb) * CH + (32 * sb + 16 * sp) * 16;
                        const s16x4 lo = trrd(vp), hi = trrd(vp + 8 * 16);
                        o = __builtin_amdgcn_mfma_f32_32x32x16_bf16(GLA_FR(lo, hi), __builtin_bit_cast(bf16x8, pw), o, 0, 0, 0);
                    } } }
            }
        } else {
            const int db = w - 4;
            if (lat) {
                f32x16 o2 = {};
#pragma unroll
                for (int ks = 0; ks < 8; ++ks) {
                    const bf16x8 as = *(const LAS bf16x8*)(lds + L_SB + (2 * ks + hh) * CH + (32 * vb + r) * 16);
                    const bf16x8 bq = *(const LAS bf16x8*)(lds + L_QS + (2 * ks + hh) * CH + (32 * tb + r) * 16);
                    o2 = __builtin_amdgcn_mfma_f32_32x32x16_bf16(as, bq, o2, 0, 0, 0);
                }
#pragma unroll
                for (int g = 0; g < 4; ++g) *(LAS f32x4*)(lds + L_X + (w & 3) * 4096 + g * 1024 + lane * 16) = (f32x4){o2[4 * g], o2[4 * g + 1], o2[4 * g + 2], o2[4 * g + 3]};
            }
#pragma unroll
            for (int ks = 0; ks < 4; ++ks) {
                LAS const unsigned char* kp = lds + L_KS + trN + (4 * db) * CH + (16 * ks) * 16;
                LAS const unsigned char* vp = lds + L_VS + trN + (16 * ks) * 16;
                const s16x4 al = trrd(kp), ah = trrd(kp + 4 * 16);
                const s16x4 b0l = trrd(vp), b0h = trrd(vp + 4 * 16), b1l = trrd(vp + 4 * CH), b1h = trrd(vp + 4 * CH + 4 * 16);
                S0 = __builtin_amdgcn_mfma_f32_32x32x16_bf16(GLA_FR(al, ah), GLA_FR(b0l, b0h), S0, 0, 0, 0); S1 = __builtin_amdgcn_mfma_f32_32x32x16_bf16(GLA_FR(al, ah), GLA_FR(b1l, b1h), S1, 0, 0, 0);
            }
#pragma unroll
            for (int i = 0; i < 16; ++i) { const float dc = *(const LAS float*)(lds + L_DEC + 4 * (32 * db + crow(i, hh))); S0[i] *= dc; S1[i] *= dc; }
        }
        __syncthreads();
        if (w < 4 && lat) {
            bf16* orow = OG + ((size_t)chunk * 64 + 32 * tb + r) * DM + 32 * vb + 4 * hh;
#pragma unroll
            for (int g = 0; g < 4; ++g) { const f32x4 x = *(const LAS f32x4*)(lds + L_X + w * 4096 + g * 1024 + lane * 16);
                u32x2 wv; wv.x = pk(o[4 * g] + x.x, o[4 * g + 1] + x.y); wv.y = pk(o[4 * g + 2] + x.z, o[4 * g + 3] + x.w); *(u32x2*)(orow + 8 * g) = wv; }
        }
        if (step + 1 < 68) {
            GLA_STORE(u ^ 1);
            if (w >= 4) { const int db = w - 4;
#pragma unroll
                for (int g = 0; g < 4; ++g) { u32x2 w0, w1; w0.x = pk(S0[4 * g], S0[4 * g + 1]); w0.y = pk(S0[4 * g + 2], S0[4 * g + 3]); w1.x = pk(S1[4 * g], S1[4 * g + 1]); w1.y = pk(S1[4 * g + 2], S1[4 * g + 3]);
                    *(LAS u32x2*)(lds + L_SB + (4 * db + g) * CH + r * 16 + 8 * hh) = w0; *(LAS u32x2*)(lds + L_SB + (4 * db + g) * CH + (32 + r) * 16 + 8 * hh) = w1; } }
        }
        __syncthreads();
    }
    }
#undef GLA_CHUNK
#undef GLA_LOAD
#undef GLA_STORE
}
#undef GLA_FR
}
__device__ __forceinline__ void phase_scan_opt(const Frame& F, const Prm& p) {
    for (int unit = vcu_of(F); unit < 256; unit += F.G) gla3::scan_unit(F, p, unit);
}
#define PHASE_QKV(F, p) phase_qkv_opt(F, p)
#define PHASE_ATTN(F, p) phase_attn2(F, p)
#define PHASE_WO(F, p, l) phase_wo_opt(F, p, l)
#define PHASE_MOE1(F, p, l) phase_moe1_opt(F, p, l)
#define PHASE_MOE2(F, p, l) phase_moe2_opt(F, p, l)
#define PHASE_INPROJ(F, p) phase_inproj_opt(F, p)
#define PHASE_SCAN(F, p) phase_scan_opt(F, p)
typedef GAS unsigned gu32;
#define XB_TMO      128
#define XB_XCNT(j)  (256  + 64 * (j))
#define XB_XSUB(j)  (1280 + 64 * (j))
#define XB_XGEN(j)  (2304 + 64 * (j))
#define XB_TOP      3328
#define XB_TOPGEN   3392
#define XCD_BAR_WORDS 3456
#define XB_SPIN_CAP (1u << 20)
__device__ __forceinline__ unsigned xb_ld(unsigned* p)              { return __hip_atomic_load(p, __ATOMIC_RELAXED, __HIP_MEMORY_SCOPE_AGENT); }
__device__ __forceinline__ unsigned xb_add(unsigned* p, unsigned v) { return __hip_atomic_fetch_add(p, v, __ATOMIC_RELAXED, __HIP_MEMORY_SCOPE_AGENT); }
__device__ __forceinline__ unsigned xb_xcc_id() { return (unsigned)__builtin_amdgcn_s_getreg((3 << 11) | 20) & 0xFu; }
#define XB_SPIN(cond, bar) do { unsigned _sp = 0; while (cond) { __builtin_amdgcn_s_sleep(1); \
    if ((++_sp & 255u) == 0u) { if (xb_ld(&(bar)[XB_TMO])) break; if (_sp > XB_SPIN_CAP) { atomicAdd(&(bar)[XB_TMO], 1u); break; } } } } while (0)
struct XcdBarrier { unsigned* bar; unsigned x; volatile LAS unsigned* st; };
__device__ __forceinline__ XcdBarrier xcd_barrier_post(unsigned* bar, volatile LAS unsigned* st) {
    XcdBarrier b; b.bar = bar; b.x = xb_xcc_id(); b.st = st;
    if (threadIdx.x == 0) (void)xb_add(&bar[XB_XCNT(b.x)], 1u);
    return b;
}
__device__ __forceinline__ void xcd_barrier_complete(unsigned* bar, unsigned x, unsigned& nloc, unsigned& nx) {
    const unsigned G = gridDim.x * gridDim.y * gridDim.z;
    unsigned sum, cnt, mine, sp = 0u;
    for (;;) {
        sum = 0u; cnt = 0u; mine = 0u;
#pragma unroll
        for (unsigned j = 0; j < 16; ++j) { const unsigned c = xb_ld(&bar[XB_XCNT(j)]); sum += c; cnt += (c > 0u) ? 1u : 0u; mine = (j == x) ? c : mine; }
        if (sum == G) break;
        __builtin_amdgcn_s_sleep(1);
        if ((++sp & 255u) == 0u) { if (xb_ld(&bar[XB_TMO])) break; if (sp > XB_SPIN_CAP) { atomicAdd(&bar[XB_TMO], 1u); break; } }
    }
    nloc = mine > 0u ? mine : 1u; nx = cnt > 0u ? cnt : 1u;
}
__device__ __forceinline__ void xcd_barrier(const XcdBarrier& b) {
    asm volatile("s_waitcnt vmcnt(0)" ::: "memory");
    __syncthreads();
    if (threadIdx.x == 0) {
        unsigned* bar = b.bar;
        __builtin_amdgcn_s_waitcnt(0);
        unsigned nloc = b.st[0], nx = b.st[1];
        if (nloc == 0u) { xcd_barrier_complete(bar, b.x, nloc, nx); b.st[0] = nloc; b.st[1] = nx; }
        const unsigned old = xb_add(&bar[XB_XSUB(b.x)], 1u);
        const unsigned gen = old / nloc;
        if (old + 1u == (gen + 1u) * nloc) {
            __builtin_amdgcn_fence(__ATOMIC_RELEASE, "agent");
            asm volatile("s_waitcnt vmcnt(0)" ::: "memory");
            const unsigned og = xb_add(&bar[XB_TOP], 1u);
            const unsigned tg = og / nx;
            if (og + 1u == (tg + 1u) * nx) xb_add(&bar[XB_TOPGEN], 1u);
            else XB_SPIN(xb_ld(&bar[XB_TOPGEN]) == tg, bar);
            __builtin_amdgcn_fence(__ATOMIC_ACQUIRE, "agent");
            xb_add(&bar[XB_XGEN(b.x)], 1u);
            asm volatile("s_waitcnt vmcnt(0)" ::: "memory");
        } else {
            XB_SPIN(xb_ld(&bar[XB_XGEN(b.x)]) == gen, bar);
            __builtin_amdgcn_fence(__ATOMIC_ACQUIRE, "agent");
            asm volatile("s_waitcnt vmcnt(0)" ::: "memory");
        }
    }
    __syncthreads();
}

constexpr int NPHASE = 19;
#ifndef OPT_MASK
#define OPT_MASK 0u
#endif
__global__ void __launch_bounds__(NTHR, 2) mega_fwd(Prm p) {
    extern __shared__ __attribute__((aligned(16))) unsigned char lds[];
    Frame F; F.lds = lds; F.ctl = (unsigned*)(p.ws + WS_CTL);
    F.tid = threadIdx.x; F.lane = F.tid & 63; F.wave = __builtin_amdgcn_readfirstlane(F.tid >> 6); F.G = gridDim.x; F.bid = blockIdx.x;
    for (int u = F.tid; u < (LDS_BYTES - LDSCTL_OFF) / 4; u += NTHR) ((LAS unsigned*)(lds + LDSCTL_OFF))[u] = 0u;
    __syncthreads();
    const int lo = p.ph_lo, hi = p.ph_hi;
    const bool multi = (hi - lo) > 1;
    XcdBarrier bar; bar.bar = F.ctl + CW_BAR + p.li * XCD_BAR_WORDS; bar.x = 0; bar.st = nullptr;
    if (multi) bar = xcd_barrier_post(F.ctl + CW_BAR + p.li * XCD_BAR_WORDS, (volatile LAS unsigned*)(lds + MISC_OFF) + 8);
#define IN(k) (lo <= (k) && (k) < hi)
#define SEAM(k) do { if (IN(k) && IN((k) + 1)) xcd_barrier(bar); } while (0)
#ifndef REP_MASK
#define REP_MASK 0u
#endif
#define REP(k, call) do { if (((REP_MASK) >> (k)) & 1u) { xcd_barrier(bar); call; } } while (0)
    if (IN(0)) { phase_prologue(F, p); REP(0, phase_prologue(F, p)); } SEAM(0);
    if (IN(1)) { phase_modulate0(F, p); REP(1, phase_modulate0(F, p)); } SEAM(1);
#ifdef PROBE_QKV_NOSTORE
    if (IN(2)) { PHASE_QKV(F, p); xcd_barrier(bar); phase_qkv_opt(F, p, true); } SEAM(2);
#else
    if (IN(2)) { PHASE_QKV(F, p); REP(2, PHASE_QKV(F, p)); } SEAM(2);
#endif
    if (IN(3)) { PHASE_ATTN(F, p); REP(3, PHASE_ATTN(F, p)); } SEAM(3);
    if (IN(5)) { PHASE_WO(F, p, 0); REP(5, PHASE_WO(F, p, 0)); } SEAM(5);
    if (IN(6)) { phase_ln_route(F, p, 0); REP(6, phase_ln_route(F, p, 0)); } SEAM(6);
    if (IN(7)) { PHASE_MOE1(F, p, 0); REP(7, PHASE_MOE1(F, p, 0)); } SEAM(7);
    if (IN(8)) { PHASE_MOE2(F, p, 0); REP(8, PHASE_MOE2(F, p, 0)); } SEAM(8);
    if (IN(9)) { phase_moe_combine(F, p, 0); REP(9, phase_moe_combine(F, p, 0)); } SEAM(9);
    if (IN(10)) { PHASE_INPROJ(F, p); REP(10, PHASE_INPROJ(F, p)); } SEAM(10);
    if (IN(11)) { phase_gla_prep(F, p); REP(11, phase_gla_prep(F, p)); } SEAM(11);
    if (IN(12)) { PHASE_SCAN(F, p); REP(12, PHASE_SCAN(F, p)); } SEAM(12);
    if (IN(13)) { phase_gla_post(F, p); REP(13, phase_gla_post(F, p)); } SEAM(13);
    if (IN(14)) { PHASE_WO(F, p, 1); REP(14, PHASE_WO(F, p, 1)); } SEAM(14);
    if (IN(15)) { phase_ln_route(F, p, 1); REP(15, phase_ln_route(F, p, 1)); } SEAM(15);
    if (IN(16)) { PHASE_MOE1(F, p, 1); REP(16, PHASE_MOE1(F, p, 1)); } SEAM(16);
    if (IN(17)) { PHASE_MOE2(F, p, 1); REP(17, PHASE_MOE2(F, p, 1)); } SEAM(17);
    if (IN(18)) { phase_moe_combine(F, p, 1); REP(18, phase_moe_combine(F, p, 1)); }
#undef IN
#undef SEAM
}

extern "C" void kernel_launch(void* const* d_in, const int* in_sizes, int n_in, void* d_out, int out_size, void* d_ws, size_t ws_size, hipStream_t stream) {
    static int grid = 0;
    if (grid == 0) {
        if (n_in != 23 || in_sizes[0] != NLAT * DM || out_size != NLAT * DM || ws_size < WS_END) { fprintf(stderr, "kernel_launch: unexpected shapes (n_in %d, in0 %d, out %d, ws %zu); nothing launched\n", n_in, n_in > 0 ? in_sizes[0] : -1, out_size, ws_size); grid = -1; return; }
        int dev = 0, cus = 0;
        if (hipGetDevice(&dev) != hipSuccess || hipDeviceGetAttribute(&cus, hipDeviceAttributeMultiprocessorCount, dev) != hipSuccess) { grid = -1; return; }
        if (hipFuncSetAttribute((const void*)mega_fwd, hipFuncAttributeMaxDynamicSharedMemorySize, LDS_BYTES) != hipSuccess) { fprintf(stderr, "kernel_launch: hipFuncSetAttribute failed\n"); grid = -1; return; }
        int per_cu = 0;
        if (hipOccupancyMaxActiveBlocksPerMultiprocessor(&per_cu, (const void*)mega_fwd, NTHR, LDS_BYTES) != hipSuccess || per_cu < 1) fprintf(stderr, "kernel_launch: note: occupancy query reports %d\n", per_cu);
        (void)hipGetLastError();
        grid = cus;
    }
    if (grid < 0) return;
    (void)hipMemsetAsync((char*)d_ws + WS_CTL, 0, CTL_ZERO_BYTES, stream);
    Prm p{};
    const float** pp = (const float**)&p;
    for (int i = 0; i < 23; ++i) pp[i] = (const float*)d_in[i];
    p.out = (float*)d_out; p.ws = (unsigned char*)d_ws;
    p.ph_lo = 0; p.ph_hi = NPHASE; p.li = 0;
    hipLaunchKernelGGL(mega_fwd, dim3(grid), dim3(NTHR), LDS_BYTES, stream, p);
}
```

```cpp
#include <hip/hip_runtime.h>
#include <cstdint>
#include <cstdio>

constexpr int BATCH = 8, SEQ = 4096, DM = 1024, CTXL = 256;
constexpr int NLAT = BATCH * SEQ, NCTX = BATCH * CTXL, NTOK = NLAT + NCTX;
constexpr float ALPHA = 1.4142135623730951f;
constexpr float LN_EPS = 1e-5f;
constexpr float LAMBDA_INIT0 = 0.2f;
constexpr float C2 = 0.125f * 1.4426950408889634f;
constexpr int NEXP = 16, DEXP = 512, MAXSLOT = 73728;
constexpr int NCHUNK = NTOK / 64;
constexpr int NIN = 3328;

typedef unsigned short bf16;
typedef float f32x4 __attribute__((ext_vector_type(4)));
typedef float f32x2 __attribute__((ext_vector_type(2)));
typedef unsigned u32x2 __attribute__((ext_vector_type(2)));
typedef unsigned u32x4 __attribute__((ext_vector_type(4)));

constexpr size_t MiB = 1u << 20;
constexpr size_t WS_CTL = 0, CTL_ZERO_BYTES = 1 * MiB;
constexpr size_t WS_MOD = 1 * MiB;
constexpr size_t WS_MISC = 1 * MiB + 512 * 1024;
constexpr size_t WS_WQKV = 2 * MiB, WS_WO = 5 * MiB, WS_GU0 = 6 * MiB, WS_DN0 = 22 * MiB, WS_WIN = 30 * MiB, WS_WGO = 34 * MiB, WS_GU1 = 35 * MiB, WS_DN1 = 51 * MiB;
constexpr size_t WS_XB = 59 * MiB;
constexpr size_t WS_H = 127 * MiB;
constexpr size_t WS_Q = 195 * MiB, WS_K = 263 * MiB, WS_V = 331 * MiB, WS_O2 = 399 * MiB;
constexpr size_t WS_LIST = 467 * MiB;
constexpr size_t WS_TOKR = 470 * MiB;
constexpr size_t WS_DEC = 472 * MiB;
constexpr size_t WS_ZZ = 475 * MiB;
constexpr size_t WS_END = 480 * MiB;
constexpr size_t WS_O1 = WS_H, WS_A2 = WS_H, WS_Y = WS_K;
constexpr size_t WS_YM = 195 * MiB, WS_ACT = 339 * MiB;
constexpr size_t WS_QR = 195 * MiB, WS_KR = 229 * MiB, WS_V1 = 263 * MiB, WS_R = 331 * MiB;
constexpr size_t WS_QT = WS_H, WS_KT = 399 * MiB;
constexpr size_t WS_A2B = WS_H;
constexpr size_t OUT_OGB = 64 * MiB;
constexpr int CW_TMO = 0, CW_CODE = 1;
constexpr int CW_CNT = 64;
constexpr int CW_KM = 128;
constexpr int CW_BAR = 4096;

__device__ __forceinline__ unsigned f2bf(float f) { unsigned u = __builtin_bit_cast(unsigned, f); return (u + 0x7fffu + ((u >> 16) & 1u)) >> 16; }
__device__ __forceinline__ unsigned pk2(float lo, float hi) { return f2bf(lo) | (f2bf(hi) << 16); }
__device__ __forceinline__ float bf2f(unsigned b) { return __builtin_bit_cast(float, b << 16); }
__device__ __forceinline__ float wave_sum(float v) {
#pragma unroll
    for (int o = 1; o < 64; o <<= 1) v += __shfl_xor(v, o);
    return v;
}
__device__ __forceinline__ float silu_f(float v) { return v / (1.f + __expf(-v)); }

struct Prm {
    const float *x, *c, *ctx, *cctx, *ada_w, *ada_b, *ln_g, *ln_b, *w_qkv, *w_o, *lam, *subln, *gw_in, *gwg_down, *gwg_up, *gbg, *gnorm, *gw_o, *rw, *rb, *mg, *mu, *md;
    float* out; unsigned char* ws;
    int ph_lo, ph_hi, li, pad;
};
__device__ __forceinline__ void ld_row_f32(const float* p, int lane, f32x4 (&v)[4]) {
#pragma unroll
    for (int j = 0; j < 4; ++j) v[j] = *(const f32x4*)(p + 4 * lane + 256 * j);
}
__device__ __forceinline__ void st_row_f32(float* p, int lane, const f32x4 (&v)[4]) {
#pragma unroll
    for (int j = 0; j < 4; ++j) *(f32x4*)(p + 4 * lane + 256 * j) = v[j];
}
__device__ __forceinline__ void ld_row_bf16(const bf16* p, int lane, f32x4 (&v)[4]) {
#pragma unroll
    for (int j = 0; j < 4; ++j) { const u32x2 u = *(const u32x2*)(p + 4 * lane + 256 * j); v[j] = (f32x4){bf2f(u.x & 0xffffu), bf2f(u.x >> 16), bf2f(u.y & 0xffffu), bf2f(u.y >> 16)}; }
}
__device__ __forceinline__ void st_row_bf16(bf16* p, int lane, const f32x4 (&v)[4]) {
#pragma unroll
    for (int j = 0; j < 4; ++j) { u32x2 u; u.x = pk2(v[j].x, v[j].y); u.y = pk2(v[j].z, v[j].w); *(u32x2*)(p + 4 * lane + 256 * j) = u; }
}
__device__ __forceinline__ void ln_row(f32x4 (&v)[4], const float* g, const float* b, int lane) {
    float s = 0.f;
#pragma unroll
    for (int j = 0; j < 4; ++j) s += (v[j].x + v[j].y) + (v[j].z + v[j].w);
    const float mean = wave_sum(s) * (1.f / DM); float q = 0.f;
#pragma unroll
    for (int j = 0; j < 4; ++j) { v[j] = v[j] - mean; q += (v[j].x * v[j].x + v[j].y * v[j].y) + (v[j].z * v[j].z + v[j].w * v[j].w); }
    const float rstd = 1.f / sqrtf(wave_sum(q) * (1.f / DM) + LN_EPS);
#pragma unroll
    for (int j = 0; j < 4; ++j) { const f32x4 gg = *(const f32x4*)(g + 4 * lane + 256 * j), bb = *(const f32x4*)(b + 4 * lane + 256 * j); v[j] = v[j] * rstd * gg + bb; }
}
__host__ __device__ __forceinline__ int gu_phys(int other, int sel) { return (other >> 4) * 32 + sel * 16 + (other & 15); }
__host__ __device__ __forceinline__ int perm16b(int L) { return (L & ~31) | (16 * ((L >> 2) & 1) + 4 * ((L >> 3) & 3) + (L & 3)); }
__host__ __device__ __forceinline__ int perm16b_inv(int P) { return (P & ~31) | (8 * ((P >> 2) & 3) + 4 * ((P >> 4) & 1) + (P & 3)); }
__device__ __forceinline__ unsigned pk4_fp8(float a, float b, float c, float d) { int w = 0; w = __builtin_amdgcn_cvt_pk_fp8_f32(a, b, w, false); w = __builtin_amdgcn_cvt_pk_fp8_f32(c, d, w, true); return (unsigned)w; }
constexpr float W8_SCALE = 64.f, W8_INV = 1.f / 64.f;
__device__ __forceinline__ void st_row_fp8(unsigned char* p, int lane, const f32x4 (&v)[4]) {
#pragma unroll
    for (int j = 0; j < 4; ++j) *(unsigned*)(p + 4 * lane + 256 * j) = pk4_fp8(v[j].x, v[j].y, v[j].z, v[j].w);
}
__device__ __forceinline__ void ld_row_fp8(const unsigned char* p, int lane, f32x4 (&v)[4]) {
#pragma unroll
    for (int j = 0; j < 4; ++j) { const int w = *(const int*)(p + 4 * lane + 256 * j); const f32x2 lo = __builtin_amdgcn_cvt_pk_f32_fp8(w, false), hi = __builtin_amdgcn_cvt_pk_f32_fp8(w, true); v[j] = (f32x4){lo.x, lo.y, hi.x, hi.y}; }
}
#define GAS __attribute__((address_space(1)))
#define LAS __attribute__((address_space(3)))
constexpr int NWAVES = 8, NTHR = NWAVES * 64;
constexpr int RING_BYTES = 131072, LDS_BYTES = 147456, LDSCTL_OFF = LDS_BYTES - 1024, MISC_OFF = LDSCTL_OFF + 320;
constexpr int LDSX_OFF = RING_BYTES + 1024;
#define LDS_WAIT() asm volatile("s_waitcnt lgkmcnt(0)" ::: "memory")
#define VM_WAIT() asm volatile("s_waitcnt vmcnt(0)" ::: "memory")

struct Frame {
    unsigned char* lds;
    unsigned* ctl;
    int tid, lane, wave, G, bid;
};

template <int MODE>
__device__ __forceinline__ void p0_transpose_item(const float* W, int K, int N, bf16* WT, int row_off, float* scr, int item, int lane) {
    const int nblk = N / 32, kb = item / nblk, nb = item % nblk, k0 = 64 * kb, n0 = 32 * nb;
    { f32x4 t[8];
#pragma unroll
        for (int i = 0; i < 8; ++i) t[i] = *(const f32x4*)(W + (size_t)(k0 + 8 * i + (lane >> 3)) * N + n0 + 4 * (lane & 7));
#pragma unroll
        for (int i = 0; i < 8; ++i) { float* d = scr + (8 * i + (lane >> 3)) * 33 + 4 * (lane & 7); d[0] = t[i].x; d[1] = t[i].y; d[2] = t[i].z; d[3] = t[i].w; } }
    LDS_WAIT(); asm volatile("" ::: "memory");
    const int c = lane & 7;
#pragma unroll
    for (int j = 0; j < 4; ++j) { const int n = (lane >> 3) + 8 * j; const float* s = scr + (8 * c) * 33 + n;
        u32x4 o; o.x = pk2(s[0 * 33], s[1 * 33]); o.y = pk2(s[2 * 33], s[3 * 33]); o.z = pk2(s[4 * 33], s[5 * 33]); o.w = pk2(s[6 * 33], s[7 * 33]);
        const int nl = n0 + n; const int pr = (MODE == 0) ? (row_off + nl) : (MODE == 3) ? (row_off + perm16b(nl)) : (row_off + gu_phys(nl, MODE - 1));
        *(u32x4*)(WT + (size_t)pr * K + k0 + 8 * c) = o; }
    LDS_WAIT(); asm volatile("" ::: "memory");
}
template <int MODE>
__device__ __forceinline__ void p0_transpose_item8(const float* W, int K, int N, unsigned char* WT, float* scr, int item, int lane) {
    const int nblk = N / 32, kb = item / nblk, nb = item % nblk, k0 = 64 * kb, n0 = 32 * nb;
    { f32x4 t[8];
#pragma unroll
        for (int i = 0; i < 8; ++i) t[i] = *(const f32x4*)(W + (size_t)(k0 + 8 * i + (lane >> 3)) * N + n0 + 4 * (lane & 7));
#pragma unroll
        for (int i = 0; i < 8; ++i) { float* d = scr + (8 * i + (lane >> 3)) * 33 + 4 * (lane & 7); d[0] = t[i].x; d[1] = t[i].y; d[2] = t[i].z; d[3] = t[i].w; } }
    LDS_WAIT(); asm volatile("" ::: "memory");
    const int c = lane & 7;
#pragma unroll
    for (int j = 0; j < 4; ++j) { const int n = (lane >> 3) + 8 * j; const float* s = scr + (8 * c) * 33 + n;
        u32x2 o; o.x = pk4_fp8(s[0 * 33] * W8_SCALE, s[1 * 33] * W8_SCALE, s[2 * 33] * W8_SCALE, s[3 * 33] * W8_SCALE); o.y = pk4_fp8(s[4 * 33] * W8_SCALE, s[5 * 33] * W8_SCALE, s[6 * 33] * W8_SCALE, s[7 * 33] * W8_SCALE);
        const int nl = n0 + n; const int pr = (MODE == 3) ? perm16b(nl) : (MODE == 0) ? nl : gu_phys(nl, MODE - 1);
        *(u32x2*)(WT + (size_t)pr * K + k0 + 8 * c) = o; }
    LDS_WAIT(); asm volatile("" ::: "memory");
}
__device__ __forceinline__ void phase_prologue(const Frame& F, const Prm& p) {
    float* sil = (float*)F.lds;
    for (int i = F.tid; i < 9 * 1024; i += NTHR) { const int r = i >> 10, k = i & 1023; const float v = (r < 8) ? p.c[r * 1024 + k] : p.cctx[k]; sil[i] = silu_f(v); }
    __syncthreads();
    float* MOD = (float*)(p.ws + WS_MOD);
    if (F.bid < 192) {
        const int layer = F.bid / 96, n = (F.bid % 96) * 64 + F.lane; const float* W = p.ada_w + (size_t)layer * 1024 * 6144 + n;
        float acc[9];
#pragma unroll
        for (int r = 0; r < 9; ++r) acc[r] = 0.f;
        const int kb = F.wave * 128;
#pragma unroll 4
        for (int k = kb; k < kb + 128; k += 4) {
            const float w0 = W[(size_t)k * 6144], w1 = W[(size_t)(k + 1) * 6144], w2 = W[(size_t)(k + 2) * 6144], w3 = W[(size_t)(k + 3) * 6144];
#pragma unroll
            for (int r = 0; r < 9; ++r) { const f32x4 s = *(const f32x4*)(sil + r * 1024 + k); acc[r] += s.x * w0 + s.y * w1 + s.z * w2 + s.w * w3; }
        }
        float* red = (float*)(F.lds + 36864 + 8 * 8704);
#pragma unroll
        for (int r = 0; r < 9; ++r) red[(F.wave * 9 + r) * 64 + F.lane] = acc[r];
        __syncthreads();
        if (F.wave == 0) { const float bb = p.ada_b[layer * 6144 + n];
#pragma unroll
            for (int r = 0; r < 9; ++r) { float t = bb;
#pragma unroll
                for (int w = 0; w < 8; ++w) t += red[(w * 9 + r) * 64 + F.lane];
                MOD[(layer * 9 + r) * 6144 + n] = t; } }
    }
    float* misc = (float*)(p.ws + WS_MISC);
    if (F.bid == 255 % F.G && F.wave == 1) {
        const float a = wave_sum(p.lam[F.lane] * p.lam[64 + F.lane]), b = wave_sum(p.lam[128 + F.lane] * p.lam[192 + F.lane]);
        if (F.lane == 0) misc[0] = __expf(a) - __expf(b) + LAMBDA_INIT0;
        for (int i = F.lane; i < 1024; i += 64) { const int pos = i >> 4, f = i & 15; const float inv = powf(10000.f, -(float)f / 16.f); const float ang = (float)pos * inv;
            misc[1024 + 2 * i] = cosf(ang); misc[1024 + 2 * i + 1] = sinf(ang); }
    }
    float* scr = (float*)(F.lds + 36864 + F.wave * 8704);
    const int gw = F.bid * NWAVES + F.wave, NGW = F.G * NWAVES;
    constexpr int I_QKV = 16 * 96, I_SQ = 16 * 32, I_G = 16 * 16, I_D = 8 * 32;
    constexpr int I_MOE = 2 * I_G + I_D;
    constexpr int NITEMS = 2 * I_QKV + 2 * I_SQ + 32 * I_MOE;
    bf16* ws16 = (bf16*)p.ws;
    for (int it = gw; it < NITEMS; it += NGW) {
        int r = it;
        if (r < I_QKV) { if ((r % 96) < 64) p0_transpose_item8<0>(p.w_qkv, 1024, 3072, p.ws + WS_WQKV, scr, r, F.lane); else p0_transpose_item8<3>(p.w_qkv, 1024, 3072, p.ws + WS_WQKV, scr, r, F.lane); continue; } r -= I_QKV;
        if (r < I_QKV) { p0_transpose_item8<3>(p.gw_in, 1024, 3072, p.ws + WS_WIN, scr, r, F.lane); continue; } r -= I_QKV;
        if (r < I_SQ) { p0_transpose_item8<3>(p.w_o, 1024, 1024, p.ws + WS_WO, scr, r, F.lane); continue; } r -= I_SQ;
        if (r < I_SQ) { p0_transpose_item8<3>(p.gw_o, 1024, 1024, p.ws + WS_WGO, scr, r, F.lane); continue; } r -= I_SQ;
        const int le = r / I_MOE, layer = le >> 4, e = le & 15; r -= le * I_MOE;
        unsigned char* GU = p.ws + (layer ? WS_GU1 : WS_GU0) + (size_t)e * 1024 * 1024; unsigned char* DN = p.ws + (layer ? WS_DN1 : WS_DN0) + (size_t)e * 1024 * 512;
        if (r < I_G) { p0_transpose_item8<1>(p.mg + (size_t)le * 1024 * 512, 1024, 512, GU, scr, r, F.lane); continue; } r -= I_G;
        if (r < I_G) { p0_transpose_item8<2>(p.mu + (size_t)le * 1024 * 512, 1024, 512, GU, scr, r, F.lane); continue; } r -= I_G;
        p0_transpose_item8<3>(p.md + (size_t)le * 512 * 1024, 512, 1024, DN, scr, r, F.lane);
    }
    (void)ws16;
    unsigned char* WIN = p.ws + WS_WIN;
    for (int i = gw * 64 + F.lane; i < 32 * 256; i += NGW * 64) { const int rr = i >> 8, k = (i & 255) * 4, dir = rr >> 4, j = rr & 15; const float* s = p.gwg_down + (size_t)dir * 1024 * 16 + j;
        *(unsigned*)(WIN + (size_t)(3072 + rr) * 1024 + k) = pk4_fp8(s[(size_t)k * 16] * W8_SCALE, s[(size_t)(k + 1) * 16] * W8_SCALE, s[(size_t)(k + 2) * 16] * W8_SCALE, s[(size_t)(k + 3) * 16] * W8_SCALE); }
    for (int i = gw * 64 + F.lane; i < 224 * 1024 / 16; i += NGW * 64) *(u32x4*)(WIN + (size_t)3104 * 1024 + (size_t)i * 16) = (u32x4){0u, 0u, 0u, 0u};
}

__device__ __forceinline__ void phase_modulate0(const Frame& F, const Prm& p) {
    const float* MOD = (const float*)(p.ws + WS_MOD); unsigned char* H = p.ws + WS_H;
    const int gw = F.bid * NWAVES + F.wave, NGW = F.G * NWAVES, per = (NTOK + NGW - 1) / NGW;
    int curmod = -1; f32x4 sh[4], sc[4];
    const int t0 = gw * per, t1 = min(NTOK, (gw + 1) * per);
    f32x4 v[4], vn[4];
    if (t0 < t1) ld_row_f32(t0 < NLAT ? p.x + (size_t)t0 * DM : p.ctx + (size_t)(t0 - NLAT) * DM, F.lane, v);
    for (int tok = t0; tok < t1; ++tok) {
        if (tok + 1 < t1) ld_row_f32(tok + 1 < NLAT ? p.x + (size_t)(tok + 1) * DM : p.ctx + (size_t)(tok + 1 - NLAT) * DM, F.lane, vn);
        const int mr = tok < NLAT ? tok / SEQ : 8;
        if (mr != curmod) { curmod = mr; ld_row_f32(MOD + mr * 6144, F.lane, sh); ld_row_f32(MOD + mr * 6144 + 1024, F.lane, sc); }
#pragma unroll
        for (int j = 0; j < 4; ++j) v[j] = v[j] * (1.f + sc[j]) + sh[j];
        st_row_fp8(H + (size_t)tok * DM, F.lane, v);
#pragma unroll
        for (int j = 0; j < 4; ++j) v[j] = vn[j];
    }
}

__device__ __forceinline__ void phase_ln_route(const Frame& F, const Prm& p, int layer) {
    const int nrows = layer ? NLAT : NTOK;
    const float* MOD = (const float*)(p.ws + WS_MOD) + layer * 9 * 6144;
    const bf16* Y = (const bf16*)(p.ws + WS_Y); unsigned char* HF = p.ws + WS_H;
    bf16* XB = (bf16*)(p.ws + WS_XB);
    int* LIST = (int*)(p.ws + WS_LIST); int* TOKR = (int*)(p.ws + WS_TOKR);
    unsigned* CNT = F.ctl + CW_CNT + layer * 16;
    float* WrT = (float*)F.lds;
    int* rec = (int*)(F.lds + 65536);
    unsigned* lcnt = (unsigned*)(F.lds + 65536 + 8192); unsigned* lbase = lcnt + 16;
    for (int i = F.tid; i < 16 * 1024; i += NTHR) { const int k = i >> 4, e = i & 15; WrT[e * 1024 + k] = p.rw[i]; }
    if (F.tid < 16) lcnt[F.tid] = 0u;
    __syncthreads();
    const int per_wg = (nrows + F.G - 1) / F.G, per_w = (per_wg + NWAVES - 1) / NWAVES;
    const int row_lo = F.bid * per_wg, row_hi = min(nrows, row_lo + per_wg);
    const float* lng = p.ln_g + (layer * 2 + 0) * DM; const float* lnb = p.ln_b + (layer * 2 + 0) * DM;
    float rb[16];
#pragma unroll
    for (int e = 0; e < 16; ++e) rb[e] = p.rb[e];
    int curmod = -1; f32x4 gm[4], shf[4], scf[4];
    f32x4 v[4], y[4], vn[4], yn[4];
#define LNR_LOAD(tok_, V, Yv) do { if (layer) ld_row_bf16(XB + (size_t)(tok_) * DM, F.lane, V); else ld_row_f32((tok_) < NLAT ? p.x + (size_t)(tok_) * DM : p.ctx + (size_t)((tok_) - NLAT) * DM, F.lane, V); \
        ld_row_bf16(Y + (size_t)(tok_) * DM, F.lane, Yv); } while (0)
    if (row_lo + F.wave * per_w < row_hi) LNR_LOAD(row_lo + F.wave * per_w, v, y);
    for (int i = 0; i < per_w; ++i) {
        const int lr = F.wave * per_w + i, tok = row_lo + lr; if (tok >= row_hi) break;
        if (i + 1 < per_w && tok + 1 < row_hi) LNR_LOAD(tok + 1, vn, yn);
        const int mr = tok < NLAT ? tok / SEQ : 8;
        if (mr != curmod) { curmod = mr; ld_row_f32(MOD + mr * 6144 + 2048, F.lane, gm); ld_row_f32(MOD + mr * 6144 + 3072, F.lane, shf); ld_row_f32(MOD + mr * 6144 + 4096, F.lane, scf); }
        bf16* xdst = XB + (size_t)tok * DM;
#pragma unroll
        for (int j = 0; j < 4; ++j) v[j] = ALPHA * v[j] + gm[j] * y[j];
        ln_row(v, lng, lnb, F.lane);
        st_row_bf16(xdst, F.lane, v);
#pragma unroll
        for (int j = 0; j < 4; ++j) v[j] = v[j] * (1.f + scf[j]) + shf[j];
        st_row_fp8(HF + (size_t)tok * DM, F.lane, v);
        float part[16];
#pragma unroll
        for (int e = 0; e < 16; ++e) { float s = 0.f;
#pragma unroll
            for (int j = 0; j < 4; ++j) { const f32x4 w = *(const f32x4*)(WrT + e * 1024 + 4 * F.lane + 256 * j); s += (v[j].x * w.x + v[j].y * w.y) + (v[j].z * w.z + v[j].w * w.w); }
            part[e] = s; }
        {
#pragma unroll
            for (int e = 0; e < 8; ++e) { const bool up = (F.lane & 32) != 0; const float keep = up ? part[e + 8] : part[e], send = up ? part[e] : part[e + 8]; part[e] = keep + __shfl_xor(send, 32); }
#pragma unroll
            for (int e = 0; e < 4; ++e) { const bool up = (F.lane & 16) != 0; const float keep = up ? part[e + 4] : part[e], send = up ? part[e] : part[e + 4]; part[e] = keep + __shfl_xor(send, 16); }
#pragma unroll
            for (int e = 0; e < 2; ++e) { const bool up = (F.lane & 8) != 0; const float keep = up ? part[e + 2] : part[e], send = up ? part[e] : part[e + 2]; part[e] = keep + __shfl_xor(send, 8); }
            { const bool up = (F.lane & 4) != 0; const float keep = up ? part[1] : part[0], send = up ? part[0] : part[1]; part[0] = keep + __shfl_xor(send, 4); }
            part[0] += __shfl_xor(part[0], 2); part[0] += __shfl_xor(part[0], 1);
        }
        float aff[16], sel[16];
#pragma unroll
        for (int e = 0; e < 16; ++e) { const int src = ((e >> 3) & 1) * 32 + ((e >> 2) & 1) * 16 + ((e >> 1) & 1) * 8 + (e & 1) * 4; const float lg = __shfl(part[0], src); aff[e] = 1.f / (1.f + __expf(-lg)); sel[e] = aff[e] + rb[e]; }
        int bg = 0; float bgs = -3.0e38f;
#pragma unroll
        for (int g = 0; g < 4; ++g) { float m1 = -3.0e38f, m2 = -3.0e38f;
#pragma unroll
            for (int k = 0; k < 4; ++k) { const float s = sel[4 * g + k]; if (s > m1) { m2 = m1; m1 = s; } else if (s > m2) m2 = s; }
            const float gs = m1 + m2; if (gs > bgs) { bgs = gs; bg = g; } }
        int i1 = 0, i2 = 0; float s1 = -3.0e38f, s2 = -3.0e38f, a1 = 0.f, a2 = 0.f;
#pragma unroll
        for (int g = 0; g < 4; ++g) if (g == bg) {
#pragma unroll
            for (int k = 0; k < 4; ++k) { const float s = sel[4 * g + k], a = aff[4 * g + k];
                if (s > s1) { s2 = s1; i2 = i1; a2 = a1; s1 = s; i1 = 4 * g + k; a1 = a; } else if (s > s2) { s2 = s; i2 = 4 * g + k; a2 = a; } } }
        const float wsum = a1 + a2, w1 = a1 / wsum, w2 = a2 / wsum;
        if (F.lane == 0) { const unsigned l1 = atomicAdd(&lcnt[i1], 1u), l2 = atomicAdd(&lcnt[i2], 1u);
            rec[lr * 6 + 0] = i1; rec[lr * 6 + 1] = i2; rec[lr * 6 + 2] = (int)l1; rec[lr * 6 + 3] = (int)l2; rec[lr * 6 + 4] = __float_as_int(w1); rec[lr * 6 + 5] = __float_as_int(w2); }
#pragma unroll
        for (int j = 0; j < 4; ++j) { v[j] = vn[j]; y[j] = yn[j]; }
    }
#undef LNR_LOAD
    __syncthreads();
    if (F.tid < 16) lbase[F.tid] = __hip_atomic_fetch_add(&CNT[F.tid], lcnt[F.tid], __ATOMIC_RELAXED, __HIP_MEMORY_SCOPE_AGENT);
    __syncthreads();
    for (int lr = F.tid; lr < row_hi - row_lo; lr += NTHR) { const int tok = row_lo + lr;
        const int e0 = rec[lr * 6], e1 = rec[lr * 6 + 1]; const int p0 = (int)lbase[e0] + rec[lr * 6 + 2], p1 = (int)lbase[e1] + rec[lr * 6 + 3];
        LIST[e0 * NTOK + p0] = tok; LIST[e1 * NTOK + p1] = tok;
        int* tr = TOKR + (size_t)tok * 8; tr[0] = e0; tr[1] = p0; tr[2] = e1; tr[3] = p1; tr[4] = rec[lr * 6 + 4]; tr[5] = rec[lr * 6 + 5]; }
    __syncthreads();
}

__device__ __forceinline__ void pad_bases(const unsigned* cnt, int (&pb)[17]) {
    int acc = 0;
#pragma unroll
    for (int e = 0; e < 16; ++e) { pb[e] = acc; const int c = (int)__hip_atomic_load(cnt + e, __ATOMIC_RELAXED, __HIP_MEMORY_SCOPE_AGENT); acc += (c + 255) & ~255; }
    pb[16] = acc;
}

__device__ __forceinline__ void phase_moe_combine(const Frame& F, const Prm& p, int layer) {
    const int nrows = layer ? NLAT : NTOK;
    const float* MOD = (const float*)(p.ws + WS_MOD) + layer * 9 * 6144; const float* MOD1 = (const float*)(p.ws + WS_MOD) + 9 * 6144;
    const unsigned char* YM = p.ws + WS_YM;   unsigned char* H = p.ws + WS_H;   bf16* XB = (bf16*)(p.ws + WS_XB); const int* TOKR = (const int*)(p.ws + WS_TOKR);
    int pb[17]; pad_bases(F.ctl + CW_CNT + layer * 16, pb);
    int* pbl = (int*)F.lds; if (F.tid < 17) { int v = 0;
#pragma unroll
        for (int e = 0; e < 17; ++e) if (e == F.tid) v = pb[e];
        pbl[F.tid] = v; }
    __syncthreads();
    const float* lng = p.ln_g + (layer * 2 + 1) * DM; const float* lnb = p.ln_b + (layer * 2 + 1) * DM;
    const int gw = F.bid * NWAVES + F.wave, NGW = F.G * NWAVES, per = (nrows + NGW - 1) / NGW;
    int curmod = -1; f32x4 gf[4], sh1[4], sc1[4];
    typedef int i32x4r __attribute__((ext_vector_type(4)));
    const int t0 = gw * per, t1 = min(nrows, (gw + 1) * per);
    i32x4r ra = {0, 0, 0, 0}, rb = {0, 0, 0, 0}, rc = {0, 0, 0, 0}; f32x2 wa = {0.f, 0.f}, wb = {0.f, 0.f}, wc = {0.f, 0.f};
#define MC_REC(tok_, R, W) do { const int* tr_ = TOKR + (size_t)(tok_) * 8; R = *(const i32x4r*)tr_; W = *(const f32x2*)(tr_ + 4); } while (0)
#define MC_ROWS(tok_, R, V, A, B) do { ld_row_bf16(XB + (size_t)(tok_) * DM, F.lane, V); ld_row_fp8(YM + (size_t)(pbl[R.x] + R.y) * DM, F.lane, A); ld_row_fp8(YM + (size_t)(pbl[R.z] + R.w) * DM, F.lane, B); } while (0)
    f32x4 v[4], a[4], b[4], vn[4], an[4], bn[4];
    if (t0 < t1) { MC_REC(t0, ra, wa); if (t0 + 1 < t1) MC_REC(t0 + 1, rb, wb); MC_ROWS(t0, ra, v, a, b); }
    for (int tok = t0; tok < t1; ++tok) {
        if (tok + 1 < t1) MC_ROWS(tok + 1, rb, vn, an, bn);
        if (tok + 2 < t1) MC_REC(tok + 2, rc, wc);
        const int mr = tok < NLAT ? tok / SEQ : 8;
        if (mr != curmod) { curmod = mr; ld_row_f32(MOD + mr * 6144 + 5120, F.lane, gf); if (!layer) { ld_row_f32(MOD1 + mr * 6144, F.lane, sh1); ld_row_f32(MOD1 + mr * 6144 + 1024, F.lane, sc1); } }
        const float w0 = wa.x, w1 = wa.y;
        bf16* xp = XB + (size_t)tok * DM;
#pragma unroll
        for (int j = 0; j < 4; ++j) v[j] = ALPHA * v[j] + gf[j] * (w0 * a[j] + w1 * b[j]);
        ln_row(v, lng, lnb, F.lane);
        if (layer) st_row_f32(p.out + (size_t)tok * DM, F.lane, v); else st_row_bf16(xp, F.lane, v);
        if (!layer) {
#pragma unroll
            for (int j = 0; j < 4; ++j) v[j] = v[j] * (1.f + sc1[j]) + sh1[j];
            st_row_fp8(H + (size_t)tok * DM, F.lane, v);
        }
#pragma unroll
        for (int j = 0; j < 4; ++j) { v[j] = vn[j]; a[j] = an[j]; b[j] = bn[j]; }
        ra = rb; wa = wb; rb = rc; wb = wc;
    }
#undef MC_REC
#undef MC_ROWS
}

__device__ __forceinline__ void phase_gla_prep(const Frame& F, const Prm& p) {
    typedef short bf16x8v __attribute__((ext_vector_type(8))); typedef float f32x16v __attribute__((ext_vector_type(16)));
    const bf16* QR = (const bf16*)(p.ws + WS_QR); const bf16* KR = (const bf16*)(p.ws + WS_KR); const float* ZZ = (const float*)(p.ws + WS_ZZ);
    bf16* QT = (bf16*)(p.ws + WS_QT); bf16* KT = (bf16*)(p.ws + WS_KT); float* DEC = (float*)(p.ws + WS_DEC);
    const int gw = F.bid * NWAVES + F.wave, NGW = F.G * NWAVES, r = F.lane & 31, hh = F.lane >> 5;
    for (int task = gw; task < 2 * NCHUNK * 8; task += NGW) {
        const int dh = task & 7, chunk = (task >> 3) % NCHUNK, dir = __builtin_amdgcn_readfirstlane(task / (8 * NCHUNK));
        const int tok0 = chunk * 64;
        bf16x8v af[2], bfr[2];
#pragma unroll
        for (int tb = 0; tb < 2; ++tb) { const float* zp = ZZ + (size_t)(tok0 + 32 * tb + r) * 32 + dir * 16 + 8 * hh; const f32x4 z0 = *(const f32x4*)zp, z1 = *(const f32x4*)(zp + 4);
            u32x4 w; w.x = pk2(z0.x, z0.y); w.y = pk2(z0.z, z0.w); w.z = pk2(z1.x, z1.y); w.w = pk2(z1.z, z1.w); af[tb] = __builtin_bit_cast(bf16x8v, w); }
        float bgv[2];
#pragma unroll
        for (int cb = 0; cb < 2; ++cb) { const float* wp = p.gwg_up + (size_t)dir * 16 * 512 + (size_t)(8 * hh) * 512 + dh * 64 + 2 * r + cb; float wv[8];
#pragma unroll
            for (int i = 0; i < 8; ++i) wv[i] = wp[(size_t)i * 512];
            u32x4 w; w.x = pk2(wv[0], wv[1]); w.y = pk2(wv[2], wv[3]); w.z = pk2(wv[4], wv[5]); w.w = pk2(wv[6], wv[7]); bfr[cb] = __builtin_bit_cast(bf16x8v, w);
            bgv[cb] = p.gbg[dir * 512 + dh * 64 + 2 * r + cb]; }
        f32x16v Z[2][2];
#pragma unroll
        for (int tb = 0; tb < 2; ++tb)
#pragma unroll
            for (int cb = 0; cb < 2; ++cb) { const f32x16v zero = {}; Z[tb][cb] = __builtin_amdgcn_mfma_f32_32x32x16_bf16(af[tb], bfr[cb], zero, 0, 0, 0); }
#pragma unroll
        for (int tb = 0; tb < 2; ++tb)
#pragma unroll
            for (int cb = 0; cb < 2; ++cb)
#pragma unroll
                for (int i = 0; i < 16; ++i) { const float z = Z[tb][cb][i] + bgv[cb]; Z[tb][cb][i] = (fminf(z, 0.f) - __logf(1.f + __expf(-fabsf(z)))) * (1.f / 16.f); }
        float tot[2];
#pragma unroll
        for (int cb = 0; cb < 2; ++cb) {
            float T[2][4], PT[2][4];
            if (!dir) {
#pragma unroll
                for (int tb = 0; tb < 2; ++tb)
#pragma unroll
                    for (int gi = 0; gi < 4; ++gi) { float run = 0.f;
#pragma unroll
                        for (int w = 0; w < 4; ++w) { run += Z[tb][cb][4 * gi + w]; Z[tb][cb][4 * gi + w] = run; }
                        T[tb][gi] = run; }
            } else {
#pragma unroll
                for (int tb = 0; tb < 2; ++tb)
#pragma unroll
                    for (int gi = 0; gi < 4; ++gi) { float run = 0.f;
#pragma unroll
                        for (int w = 3; w >= 0; --w) { run += Z[tb][cb][4 * gi + w]; Z[tb][cb][4 * gi + w] = run; }
                        T[tb][gi] = run; }
            }
#pragma unroll
            for (int tb = 0; tb < 2; ++tb)
#pragma unroll
                for (int gi = 0; gi < 4; ++gi) PT[tb][gi] = __shfl_xor(T[tb][gi], 32);
            float running = 0.f;
            if (!dir) {
#pragma unroll
                for (int tb = 0; tb < 2; ++tb)
#pragma unroll
                    for (int gi = 0; gi < 4; ++gi) { const float first = hh ? PT[tb][gi] : T[tb][gi], second = hh ? T[tb][gi] : PT[tb][gi];
                        const float mine = hh ? running + first : running; running += first + second;
#pragma unroll
                        for (int w = 0; w < 4; ++w) Z[tb][cb][4 * gi + w] += mine; }
            } else {
#pragma unroll
                for (int tb = 1; tb >= 0; --tb)
#pragma unroll
                    for (int gi = 3; gi >= 0; --gi) { const float first = hh ? T[tb][gi] : PT[tb][gi], second = hh ? PT[tb][gi] : T[tb][gi];
                        const float mine = hh ? running : running + first; running += first + second;
#pragma unroll
                        for (int w = 0; w < 4; ++w) Z[tb][cb][4 * gi + w] += mine; }
            }
            tot[cb] = running;
        }
        if (hh == 0) {
#pragma unroll
            for (int cb = 0; cb < 2; ++cb) DEC[((size_t)dir * NCHUNK + chunk) * 512 + dh * 64 + 2 * r + cb] = __expf(tot[cb]);
        }
        const bf16* qi = QR + ((size_t)dh * NTOK + tok0) * 64 + 2 * r; const bf16* ki = KR + ((size_t)dh * NTOK + tok0) * 64 + 2 * r;
        bf16* qo = QT + (((size_t)dir * 8 + dh) * NTOK + tok0) * 64 + 2 * r; bf16* ko = KT + (((size_t)dir * 8 + dh) * NTOK + tok0) * 64 + 2 * r;
#pragma unroll
        for (int tb = 0; tb < 2; ++tb) {
            unsigned qv[16], kv[16];
#pragma unroll
            for (int i = 0; i < 16; ++i) { const int t = 32 * tb + (i & 3) + 8 * (i >> 2) + 4 * hh; qv[i] = *(const unsigned*)(qi + (size_t)t * 64); kv[i] = *(const unsigned*)(ki + (size_t)t * 64); }
#pragma unroll
            for (int i = 0; i < 16; ++i) { const int t = 32 * tb + (i & 3) + 8 * (i >> 2) + 4 * hh;
                const float e0 = __expf(Z[tb][0][i]), e1 = __expf(Z[tb][1][i]), i0 = __builtin_amdgcn_rcpf(e0), i1 = __builtin_amdgcn_rcpf(e1);
                *(unsigned*)(qo + (size_t)t * 64) = pk2(bf2f(qv[i] & 0xffffu) * e0, bf2f(qv[i] >> 16) * e1);
                *(unsigned*)(ko + (size_t)t * 64) = pk2(bf2f(kv[i] & 0xffffu) * i0, bf2f(kv[i] >> 16) * i1); }
        }
    }
}

__device__ __forceinline__ void phase_gla_post(const Frame& F, const Prm& p) {
    const bf16* OF = (const bf16*)p.out; const bf16* OB = (const bf16*)((const unsigned char*)p.out + OUT_OGB); const bf16* R = (const bf16*)(p.ws + WS_R); unsigned char* A2 = p.ws + WS_A2B;
    const f32x4 ng = *(const f32x4*)(p.gnorm + 4 * F.lane);
    const int gw = F.bid * NWAVES + F.wave, NGW = F.G * NWAVES;
    f32x4 a[4], b[4], r[4], an[4], bn[4], rn[4];
    if (gw < NLAT) { ld_row_bf16(OF + (size_t)gw * DM, F.lane, a); ld_row_bf16(OB + (size_t)gw * DM, F.lane, b); ld_row_bf16(R + (size_t)gw * DM, F.lane, r); }
    for (int tok = gw; tok < NLAT; tok += NGW) {
        if (tok + NGW < NLAT) { ld_row_bf16(OF + (size_t)(tok + NGW) * DM, F.lane, an); ld_row_bf16(OB + (size_t)(tok + NGW) * DM, F.lane, bn); ld_row_bf16(R + (size_t)(tok + NGW) * DM, F.lane, rn); }
#pragma unroll
        for (int j = 0; j < 4; ++j) {
            const f32x4 o = a[j] + b[j]; const float q = wave_sum((o.x * o.x + o.y * o.y) + (o.z * o.z + o.w * o.w));
            const float rs = 1.f / sqrtf(q * (1.f / 256.f) + LN_EPS);
            a[j] = (f32x4){o.x * rs * ng.x * silu_f(r[j].x), o.y * rs * ng.y * silu_f(r[j].y), o.z * rs * ng.z * silu_f(r[j].z), o.w * rs * ng.w * silu_f(r[j].w)};
        }
        st_row_fp8(A2 + (size_t)tok * DM, F.lane, a);
#pragma unroll
        for (int j = 0; j < 4; ++j) { a[j] = an[j]; b[j] = bn[j]; r[j] = rn[j]; }
    }
}
namespace pg8 {
typedef short bf16x8 __attribute__((ext_vector_type(8)));
constexpr int BM = 256, BK = 64, HALF = 128, HTB = HALF * BK * 2, STAGE_BYTES = 8 * HTB, NXCD = 8, WGM = 8;
__host__ __device__ __forceinline__ int lds_byte(int r, int c) { const int st = (r >> 4) * 2 + (c >> 5), rr = r & 15, cc = c & 31, ob = rr * 64 + cc * 2; return st * 1024 + (ob ^ (((ob >> 9) & 1) << 5)); }
__host__ __device__ __forceinline__ void stage_rc(int b, int& R, int& C) { const int st = b / 1024, sb = b % 1024, swz = sb ^ (((sb >> 9) & 1) << 5); R = (st >> 1) * 16 + swz / 64; C = (st & 1) * 32 + (swz % 64) / 2; }
typedef float f32x2_t __attribute__((ext_vector_type(2))); typedef __bf16 bf16x2_t __attribute__((ext_vector_type(2)));
__device__ __forceinline__ unsigned cvt_pk_bf16(float lo, float hi) { f32x2_t v = {lo, hi}; bf16x2_t b = __builtin_convertvector(v, bf16x2_t); return __builtin_bit_cast(unsigned, b); }

struct Unit { int pm, pn; int row0; int e; int cnt; const bf16* Bt; };

struct DenseOrder {
    int nM, nN, nwg, G, c, K; const bf16* Bt;
    __device__ void init(int M, int N, int K_, const bf16* Bt_, int G_, int c_) { nM = M / BM; nN = N / BM; nwg = nM * nN; G = G_; c = c_; K = K_; Bt = Bt_; }
    __device__ bool next(int i, Unit& u) const {
        const long L = (long)i * G + c; if (L >= nwg) return false;
        int wgid = (int)L; { const int q = nwg / NXCD, r = nwg % NXCD, xcd = wgid % NXCD, off = wgid / NXCD; wgid = (xcd < r ? xcd * (q + 1) : r * (q + 1) + (xcd - r) * q) + off; }
        const int nig = WGM * nN, gid = wgid / nig, fm = gid * WGM, gsz = (nM - fm) < WGM ? (nM - fm) : WGM;
        u.pm = fm + ((wgid % nig) % gsz); u.pn = (wgid % nig) / gsz; u.row0 = u.pm * BM; u.e = 0; u.cnt = 0; u.Bt = Bt; return true;
    }
    __device__ __forceinline__ unsigned arow(const Unit& u, int r) const { return (unsigned)(u.row0 + r) * (unsigned)(K * 2); }
};
template <bool GATHER> struct MoeOrder {
    int cnt[16]; int nN, G, c, K; const bf16* Bt0; size_t bstride; const int* LIST;
    __device__ void init(const unsigned* cntw, int N, int K_, const bf16* Bt0_, const int* LIST_, int G_, int c_) {
#pragma unroll
        for (int e = 0; e < 16; ++e) cnt[e] = (int)__hip_atomic_load(cntw + e, __ATOMIC_RELAXED, __HIP_MEMORY_SCOPE_AGENT);
        nN = N / BM; G = G_; c = c_; K = K_; Bt0 = Bt0_; bstride = (size_t)N * K_; LIST = LIST_; }
    __device__ bool next(int i, Unit& u) const {
        int L = i * G + c, base = 0; bool found = false; u.pm = 0; u.pn = 0; u.row0 = 0; u.e = 0; u.cnt = 0; u.Bt = Bt0;
#pragma unroll
        for (int e = 0; e < 16; ++e) { const int mt = (cnt[e] + 255) >> 8, nu = mt * nN;
            if (!found) { if (L < nu) { found = true; u.e = e; u.cnt = cnt[e]; u.pm = L / nN; u.pn = L % nN; u.row0 = base + u.pm * BM; u.Bt = Bt0 + (size_t)e * bstride; } else { L -= nu; base += mt * BM; } } }
        return found;
    }
    __device__ __forceinline__ unsigned arow(const Unit& u, int r) const {
        if (GATHER) { const int li = u.pm * BM + r; int tok = 0; if (li < u.cnt) tok = LIST[u.e * NTOK + li];
            return (unsigned)tok * (unsigned)(K * 2); }
        return (unsigned)(u.row0 + r) * (unsigned)(K * 2);
    }
};

typedef f32x4 Acc[2][2][4][2];
__device__ __forceinline__ void st4bf(bf16* p, f32x4 v) { u32x2 w; w.x = cvt_pk_bf16(v.x, v.y); w.y = cvt_pk_bf16(v.z, v.w); *(u32x2*)p = w; }
__device__ __forceinline__ void st8bf(bf16* p, f32x4 a, f32x4 b) { u32x4 w; w.x = cvt_pk_bf16(a.x, a.y); w.y = cvt_pk_bf16(a.z, a.w); w.z = cvt_pk_bf16(b.x, b.y); w.w = cvt_pk_bf16(b.z, b.w); *(u32x4*)p = w; }

struct EpiQKV {
    bf16 *Q; const LAS float* rope; float wsc; unsigned* km;
    __device__ __forceinline__ void operator()(const Acc& acc, const Unit& u, int wr, int wc, int fr, int fq) const {
        const int reg = u.pn >> 2; bf16* O = Q + (size_t)reg * ((WS_K - WS_Q) / 2);
        if (reg == 2) { const int cbase = (u.pn & 3) * BM + wc * 32 + 8 * fq;
#pragma unroll
            for (int ai = 0; ai < 2; ++ai)
#pragma unroll
                for (int m = 0; m < 4; ++m) { bf16* rowp = O + (size_t)(u.row0 + ai * HALF + wr * 64 + m * 16 + fr) * DM + cbase;
#pragma unroll
                    for (int bj = 0; bj < 2; ++bj) st8bf(rowp + bj * HALF, acc[ai][bj][m][0] * wsc, acc[ai][bj][m][1] * wsc); }
            return; }
        const int cbase = (u.pn & 3) * BM + wc * 32 + 4 * fq;
        const bool dorope = (u.row0 < NLAT); const float sc = (reg == 0 ? C2 : 1.f) * wsc; float kn[2] = {0.f, 0.f};
#pragma unroll
        for (int ai = 0; ai < 2; ++ai)
#pragma unroll
            for (int m = 0; m < 4; ++m) { const int row = u.row0 + ai * HALF + wr * 64 + m * 16 + fr; bf16* rowp = O + (size_t)row * DM + cbase;
                f32x4 cs = {1.f, 1.f, 1.f, 1.f}, sn = {0.f, 0.f, 0.f, 0.f};
                if (dorope) { const int s = row & (SEQ - 1), pos = (wc & 1) ? (s & 63) : (s >> 6); const f32x4 t0 = *(const LAS f32x4*)(rope + (pos * 16 + 4 * fq) * 2), t1 = *(const LAS f32x4*)(rope + (pos * 16 + 4 * fq) * 2 + 4);
                    cs = (f32x4){t0.x, t0.z, t1.x, t1.z}; sn = (f32x4){t0.y, t0.w, t1.y, t1.w}; }
#pragma unroll
                for (int bj = 0; bj < 2; ++bj) { const f32x4 a0 = acc[ai][bj][m][0], a1 = acc[ai][bj][m][1];
                    const f32x4 o0 = (a0 * cs - a1 * sn) * sc, o1 = (a1 * cs + a0 * sn) * sc;
                    st4bf(rowp + bj * HALF, o0); st4bf(rowp + bj * HALF + 16, o1);
                    if (reg == 1) { const float ps = (o0.x * o0.x + o0.y * o0.y) + (o0.z * o0.z + o0.w * o0.w) + (o1.x * o1.x + o1.y * o1.y) + (o1.z * o1.z + o1.w * o1.w);
                        kn[bj] = fmaxf(kn[bj], ps); } } }
        if (reg == 1) {
            const int b = u.row0 < NLAT ? u.row0 / SEQ : (u.row0 - NLAT) / CTXL;
#pragma unroll
            for (int bj = 0; bj < 2; ++bj) { float v = kn[bj];
#pragma unroll
                for (int s = 1; s < 64; s <<= 1) v = fmaxf(v, __shfl_xor(v, s));
                if (fr == 0 && fq == 0) __hip_atomic_fetch_max(km + b * 16 + 4 * (u.pn & 3) + 2 * bj + (wc >> 1), __float_as_uint(8.f * v), __ATOMIC_RELAXED, __HIP_MEMORY_SCOPE_AGENT); } }
    }
};
struct EpiPlain {
    bf16* O; float sc;
    __device__ __forceinline__ void operator()(const Acc& acc, const Unit& u, int wr, int wc, int fr, int fq) const {
        const int cbase = u.pn * BM + wc * 32 + 8 * fq;
#pragma unroll
        for (int ai = 0; ai < 2; ++ai)
#pragma unroll
            for (int m = 0; m < 4; ++m) { bf16* rowp = O + (size_t)(u.row0 + ai * HALF + wr * 64 + m * 16 + fr) * DM + cbase;
#pragma unroll
                for (int bj = 0; bj < 2; ++bj) st8bf(rowp + bj * HALF, acc[ai][bj][m][0] * sc, acc[ai][bj][m][1] * sc); }
    }
};
struct EpiPlain8 {
    unsigned char* O; float sc;
    __device__ __forceinline__ void operator()(const Acc& acc, const Unit& u, int wr, int wc, int fr, int fq) const {
        const int cbase = u.pn * BM + wc * 32 + 8 * fq;
#pragma unroll
        for (int ai = 0; ai < 2; ++ai)
#pragma unroll
            for (int m = 0; m < 4; ++m) { unsigned char* rowp = O + (size_t)(u.row0 + ai * HALF + wr * 64 + m * 16 + fr) * DM + cbase;
#pragma unroll
                for (int bj = 0; bj < 2; ++bj) { const f32x4 a = acc[ai][bj][m][0] * sc, b = acc[ai][bj][m][1] * sc; u32x2 w; w.x = pk4_fp8(a.x, a.y, a.z, a.w); w.y = pk4_fp8(b.x, b.y, b.z, b.w); *(u32x2*)(rowp + bj * HALF) = w; } }
    }
};
struct EpiInproj {
    bf16 *QR, *KR, *V, *R; float* ZZ; float wsc;
    __device__ __forceinline__ void operator()(const Acc& acc, const Unit& u, int wr, int wc, int fr, int fq) const {
        const int pn = u.pn;
        if (pn == 12) { if (wc == 0) {
#pragma unroll
            for (int ai = 0; ai < 2; ++ai)
#pragma unroll
                for (int m = 0; m < 4; ++m) { float* rowp = ZZ + (size_t)(u.row0 + ai * HALF + wr * 64 + m * 16 + fr) * 32 + 4 * fq;
                    *(f32x4*)rowp = acc[ai][0][m][0] * wsc; *(f32x4*)(rowp + 16) = acc[ai][0][m][1] * wsc; } }
            return; }
        float sc = wsc;
        if (pn < 4) {
            bf16* O = pn < 2 ? QR : KR; if (pn < 2) sc = 0.08838834764831845f * wsc;
            const int cb = (pn & 1) * BM + wc * 32 + 8 * fq;
#pragma unroll
            for (int ai = 0; ai < 2; ++ai)
#pragma unroll
                for (int m = 0; m < 4; ++m) { const size_t row = (size_t)(u.row0 + ai * HALF + wr * 64 + m * 16 + fr);
#pragma unroll
                    for (int bj = 0; bj < 2; ++bj) { const int col = cb + bj * HALF; st8bf(O + ((size_t)(col >> 6) * NTOK + row) * 64 + (col & 63), acc[ai][bj][m][0] * sc, acc[ai][bj][m][1] * sc); } }
            return; }
        bf16* O; int c0;
        if (pn < 8) { O = V; c0 = (pn - 4) * BM; } else { O = R; c0 = (pn - 8) * BM; }
        const int cbase = c0 + wc * 32 + 8 * fq;
#pragma unroll
        for (int ai = 0; ai < 2; ++ai)
#pragma unroll
            for (int m = 0; m < 4; ++m) { bf16* rowp = O + (size_t)(u.row0 + ai * HALF + wr * 64 + m * 16 + fr) * DM + cbase;
#pragma unroll
                for (int bj = 0; bj < 2; ++bj) st8bf(rowp + bj * HALF, acc[ai][bj][m][0] * sc, acc[ai][bj][m][1] * sc); }
    }
};
struct EpiGateUp {
    unsigned char* ACT;
    __device__ __forceinline__ void operator()(const Acc& acc, const Unit& u, int wr, int wc, int fr, int fq) const {
        const int obase = (u.pn * BM + wc * 32) / 2 + 4 * fq;
#pragma unroll
        for (int ai = 0; ai < 2; ++ai)
#pragma unroll
            for (int m = 0; m < 4; ++m) { unsigned char* rowp = ACT + (size_t)(u.row0 + ai * HALF + wr * 64 + m * 16 + fr) * DEXP + obase;
#pragma unroll
                for (int bj = 0; bj < 2; ++bj) { const f32x4 g = acc[ai][bj][m][0] * W8_INV, up = acc[ai][bj][m][1] * W8_INV; f32x4 o;
#pragma unroll
                    for (int j = 0; j < 4; ++j) o[j] = g[j] * __builtin_amdgcn_rcpf(1.f + __expf(-g[j])) * up[j];
                    *(unsigned*)(rowp + bj * (HALF / 2)) = pk4_fp8(o[0], o[1], o[2], o[3]); } }
    }
};

typedef int i32x8 __attribute__((ext_vector_type(8)));
typedef int i32x4 __attribute__((ext_vector_type(4)));
__device__ __forceinline__ i32x8 cat8(bf16x8 lo, bf16x8 hi) { return __builtin_shufflevector(__builtin_bit_cast(i32x4, lo), __builtin_bit_cast(i32x4, hi), 0, 1, 2, 3, 4, 5, 6, 7); }
template <class Epi, class Sched, bool FP8 = false>
__device__ __forceinline__ void gemm_phase(unsigned char* ldsg, const bf16* A, int K, const Sched& S, const Epi& E) {
    LAS unsigned char* lds = (LAS unsigned char*)ldsg;
    const int tid = threadIdx.x, wid = __builtin_amdgcn_readfirstlane(tid >> 6), lane = tid & 63, wr = wid >> 2, wc = wid & 3, fr = lane & 15, fq = lane >> 4;
    const int nt = K / BK;
    int Rr[2]; unsigned colb[2], voffB[2];
#pragma unroll
    for (int i = 0; i < 2; ++i) { int R, C; stage_rc(tid * 16 + i * 8192, R, C); Rr[i] = R; colb[i] = (unsigned)C * 2u; voffB[i] = (unsigned)(R * K + C) * 2u; }
    const size_t kstep = (size_t)(BK * 2);
    const size_t hstep = (size_t)HALF * K * 2;
    const size_t tstep = 2 * hstep;
    const unsigned ldsw = (unsigned)wid * 1024u;
    const int aoff = lds_byte(wr * 64 + fr, fq * 8), boff = lds_byte(wc * 32 + fr, fq * 8);
#define PG8_SA(b, h) (((b) * 2 + (h)) * HTB)
#define PG8_SB(b, h) ((4 + (b) * 2 + (h)) * HTB)
#define PG8_STAGE(bufoff, gbase, voff) do { _Pragma("unroll") for (int _i = 0; _i < 2; ++_i) \
        __builtin_amdgcn_global_load_lds((const unsigned*)((const char*)(gbase) + (voff)[_i]), (LAS unsigned*)(lds + (bufoff) + ldsw + _i * 8192), 16, 0, 0); } while (0)
#define PG8_LDA(dst, b, h) do { if constexpr (FP8) { _Pragma("unroll") for (int m = 0; m < 4; ++m) dst##8[m] = cat8(*(const LAS bf16x8*)(lds + PG8_SA(b, h) + aoff + m * 2048), *(const LAS bf16x8*)(lds + PG8_SA(b, h) + aoff + m * 2048 + 1024)); } \
        else { _Pragma("unroll") for (int m = 0; m < 4; ++m) _Pragma("unroll") for (int k = 0; k < 2; ++k) dst[m][k] = *(const LAS bf16x8*)(lds + PG8_SA(b, h) + aoff + m * 2048 + k * 1024); } } while (0)
#define PG8_LDB(dst, b, h) do { if constexpr (FP8) { _Pragma("unroll") for (int n = 0; n < 2; ++n) dst##8[n] = cat8(*(const LAS bf16x8*)(lds + PG8_SB(b, h) + boff + n * 2048), *(const LAS bf16x8*)(lds + PG8_SB(b, h) + boff + n * 2048 + 1024)); } \
        else { _Pragma("unroll") for (int n = 0; n < 2; ++n) _Pragma("unroll") for (int k = 0; k < 2; ++k) dst[n][k] = *(const LAS bf16x8*)(lds + PG8_SB(b, h) + boff + n * 2048 + k * 1024); } } while (0)
#define PG8_MMA(ai, bj, At, Bt) do { __builtin_amdgcn_s_setprio(1); \
        if constexpr (FP8) { _Pragma("unroll") for (int m = 0; m < 4; ++m) _Pragma("unroll") for (int n = 0; n < 2; ++n) \
            asm volatile("v_mfma_scale_f32_16x16x128_f8f6f4 %0, %1, %2, %0, %3, %3 op_sel_hi:[0,0,0]" : "+v"(acc[ai][bj][m][n]) : "v"(Bt##8[n]), "v"(At##8[m]), "v"(sc8)); } \
        else { _Pragma("unroll") for (int m = 0; m < 4; ++m) _Pragma("unroll") for (int n = 0; n < 2; ++n) _Pragma("unroll") for (int k = 0; k < 2; ++k) \
            acc[ai][bj][m][n] = __builtin_amdgcn_mfma_f32_16x16x32_bf16(Bt[n][k], At[m][k], acc[ai][bj][m][n], 0, 0, 0); } \
        __builtin_amdgcn_s_setprio(0); } while (0)
#define PG8_WAIT_V(n) asm volatile("s_waitcnt vmcnt(" #n ")" ::: "memory")
#define PG8_WAIT_L(n) asm volatile("s_waitcnt lgkmcnt(" #n ")" ::: "memory")
#define PG8_BAR __builtin_amdgcn_s_barrier()
#define PG8_SCHED __builtin_amdgcn_sched_barrier(0)
    Unit cur, nxt; int ui = 0;
    if (!S.next(0, cur)) return;
    Acc acc;
#pragma unroll
    for (int a = 0; a < 2; ++a)
#pragma unroll
        for (int b = 0; b < 2; ++b)
#pragma unroll
            for (int m = 0; m < 4; ++m)
#pragma unroll
                for (int n = 0; n < 2; ++n) acc[a][b][m][n] = (f32x4){0.f, 0.f, 0.f, 0.f};
    const int sc8 = 0x7f7f7f7f;
    bf16x8 At[4][2], B0[2][2], B1[2][2]; i32x8 At8[4], B08[2], B18[2];
    unsigned aC0[2], aC1[2], aN0[2], aN1[2];
#pragma unroll
    for (int i = 0; i < 2; ++i) { aC0[i] = S.arow(cur, Rr[i]) + colb[i]; aC1[i] = S.arow(cur, HALF + Rr[i]) + colb[i]; }
    const char* Ab = (const char*)A;
    const char* cB = (const char*)cur.Bt + (size_t)cur.pn * tstep;
    PG8_STAGE(PG8_SB(0, 0), cB, voffB); PG8_STAGE(PG8_SB(0, 1), cB + hstep, voffB); PG8_STAGE(PG8_SA(0, 0), Ab, aC0); PG8_STAGE(PG8_SA(0, 1), Ab, aC1);
    if (wr == 1) PG8_BAR;
    PG8_WAIT_V(2); PG8_BAR;
    PG8_STAGE(PG8_SB(1, 0), cB + kstep, voffB); PG8_STAGE(PG8_SA(1, 0), Ab + kstep, aC0); PG8_STAGE(PG8_SB(1, 1), cB + hstep + kstep, voffB);
    PG8_WAIT_V(6); PG8_BAR;
    for (;;) {
        const bool has_next = S.next(ui + 1, nxt);
        if (has_next) {
#pragma unroll
            for (int i = 0; i < 2; ++i) { aN0[i] = S.arow(nxt, Rr[i]) + colb[i]; aN1[i] = S.arow(nxt, HALF + Rr[i]) + colb[i]; }
        } else {
#pragma unroll
            for (int i = 0; i < 2; ++i) { aN0[i] = aC0[i]; aN1[i] = aC1[i]; }
        }
        const char* nB = has_next ? (const char*)nxt.Bt + (size_t)nxt.pn * tstep : cB;
        for (int t = 0; t < nt; t += 2) {
            const bool last = (t == nt - 2);
            const char* a1 = Ab + (size_t)(t + 1) * kstep;
            const char* a2 = last ? Ab : Ab + (size_t)(t + 2) * kstep; const char* b2 = last ? nB : cB + (size_t)(t + 2) * kstep;
            const char* a3 = a2 + kstep; const char* b3 = b2 + kstep;
            unsigned x0[2], x1[2];
#pragma unroll
            for (int i = 0; i < 2; ++i) { x0[i] = last ? aN0[i] : aC0[i]; x1[i] = last ? aN1[i] : aC1[i]; }
            PG8_LDB(B0, 0, 0); PG8_LDB(B1, 0, 1); PG8_SCHED; PG8_LDA(At, 0, 0); PG8_STAGE(PG8_SA(1, 1), a1, aC1);
            PG8_WAIT_V(8); PG8_WAIT_L(0); PG8_BAR; PG8_MMA(0, 0, At, B0); PG8_MMA(0, 1, At, B1); PG8_BAR; PG8_SCHED;
            PG8_LDA(At, 0, 1); PG8_STAGE(PG8_SB(0, 0), b2, voffB); PG8_STAGE(PG8_SB(0, 1), b2 + hstep, voffB); PG8_STAGE(PG8_SA(0, 0), a2, x0);
            PG8_WAIT_V(8); PG8_WAIT_L(0); PG8_BAR; PG8_MMA(1, 0, At, B0); PG8_MMA(1, 1, At, B1); PG8_BAR; PG8_SCHED;
            PG8_LDB(B0, 1, 0); PG8_LDB(B1, 1, 1); PG8_SCHED; PG8_LDA(At, 1, 0); PG8_STAGE(PG8_SA(0, 1), a2, x1);
            PG8_WAIT_V(8); PG8_WAIT_L(0); PG8_BAR; PG8_MMA(0, 0, At, B0); PG8_MMA(0, 1, At, B1); PG8_BAR; PG8_SCHED;
            PG8_LDA(At, 1, 1); PG8_STAGE(PG8_SB(1, 0), b3, voffB); PG8_STAGE(PG8_SB(1, 1), b3 + hstep, voffB); PG8_STAGE(PG8_SA(1, 0), a3, x0);
            PG8_WAIT_V(8); PG8_WAIT_L(0); PG8_BAR; PG8_MMA(1, 0, At, B0); PG8_MMA(1, 1, At, B1); PG8_BAR; PG8_SCHED;
        }
        if (wr == 0) PG8_BAR;
        if constexpr (FP8) asm volatile("s_nop 15\n\ts_nop 7" ::: "memory");
        E(acc, cur, wr, wc, fr, fq);
        if (!has_next) break;
#pragma unroll
        for (int a = 0; a < 2; ++a)
#pragma unroll
            for (int b = 0; b < 2; ++b)
#pragma unroll
                for (int m = 0; m < 4; ++m)
#pragma unroll
                    for (int n = 0; n < 2; ++n) acc[a][b][m][n] = (f32x4){0.f, 0.f, 0.f, 0.f};
        cur = nxt; cB = nB; ++ui;
#pragma unroll
        for (int i = 0; i < 2; ++i) { aC0[i] = aN0[i]; aC1[i] = aN1[i]; }
        if (wr == 1) PG8_BAR;
    }
    PG8_WAIT_V(0);
    PG8_BAR;
#undef PG8_SA
#undef PG8_SB
#undef PG8_STAGE
#undef PG8_LDA
#undef PG8_LDB
#undef PG8_MMA
#undef PG8_WAIT_V
#undef PG8_WAIT_L
#undef PG8_BAR
#undef PG8_SCHED
}
}

__device__ __forceinline__ int vcu_of(const Frame& F) { return (F.G % 8 == 0) ? (F.bid % 8) * (F.G / 8) + F.bid / 8 : F.bid; }
__device__ __forceinline__ void phase_qkv_opt(const Frame& F, const Prm& p) {
    pg8::DenseOrder S; S.init(NTOK, 3072, 512, (const bf16*)(p.ws + WS_WQKV), F.G, F.bid);
    static_assert(WS_V - WS_K == WS_K - WS_Q, "Q|K|V equally spaced");
    LAS float* ropel = (LAS float*)((LAS unsigned char*)F.lds + LDSX_OFF);
    const float* ropeg = (const float*)(p.ws + WS_MISC) + 1024;
    for (int i = F.tid; i < 2048; i += NTHR) ropel[i] = ropeg[i];
    __syncthreads();
    pg8::EpiQKV E{(bf16*)(p.ws + WS_Q), ropel, W8_INV, F.ctl + CW_KM};
    pg8::gemm_phase<pg8::EpiQKV, pg8::DenseOrder, true>(F.lds, (const bf16*)(p.ws + WS_H), 512, S, E);
}
__device__ __forceinline__ void phase_wo_opt(const Frame& F, const Prm& p, int layer) {
    if (layer) {
        pg8::DenseOrder S; S.init(NLAT, 1024, 512, (const bf16*)(p.ws + WS_WGO), F.G, F.bid);
        pg8::EpiPlain E{(bf16*)(p.ws + WS_Y), W8_INV};
        pg8::gemm_phase<pg8::EpiPlain, pg8::DenseOrder, true>(F.lds, (const bf16*)(p.ws + WS_A2B), 512, S, E);
    } else {
        pg8::DenseOrder S; S.init(NTOK, 1024, 512, (const bf16*)(p.ws + WS_WO), F.G, F.bid);
        pg8::EpiPlain E{(bf16*)(p.ws + WS_Y), W8_INV};
        pg8::gemm_phase<pg8::EpiPlain, pg8::DenseOrder, true>(F.lds, (const bf16*)(p.ws + WS_A2), 512, S, E);
    }
}
__device__ __forceinline__ void phase_inproj_opt(const Frame& F, const Prm& p) {
    pg8::DenseOrder S; S.init(NTOK, NIN, 512, (const bf16*)(p.ws + WS_WIN), F.G, F.bid);
    pg8::EpiInproj E{(bf16*)(p.ws + WS_QR), (bf16*)(p.ws + WS_KR), (bf16*)(p.ws + WS_V1), (bf16*)(p.ws + WS_R), (float*)(p.ws + WS_ZZ), W8_INV};
    pg8::gemm_phase<pg8::EpiInproj, pg8::DenseOrder, true>(F.lds, (const bf16*)(p.ws + WS_H), 512, S, E);
}
__device__ __forceinline__ void phase_moe1_opt(const Frame& F, const Prm& p, int layer) {
    pg8::MoeOrder<true> S; S.init(F.ctl + CW_CNT + layer * 16, 1024, 512, (const bf16*)(p.ws + (layer ? WS_GU1 : WS_GU0)), (const int*)(p.ws + WS_LIST), F.G, vcu_of(F));
    pg8::EpiGateUp E{p.ws + WS_ACT};
    pg8::gemm_phase<pg8::EpiGateUp, pg8::MoeOrder<true>, true>(F.lds, (const bf16*)(p.ws + WS_H), 512, S, E);
}
__device__ __forceinline__ void phase_moe2_opt(const Frame& F, const Prm& p, int layer) {
    pg8::MoeOrder<false> S; S.init(F.ctl + CW_CNT + layer * 16, 1024, 256, (const bf16*)(p.ws + (layer ? WS_DN1 : WS_DN0)), nullptr, F.G, vcu_of(F));
    pg8::EpiPlain8 E{p.ws + WS_YM, W8_INV};
    pg8::gemm_phase<pg8::EpiPlain8, pg8::MoeOrder<false>, true>(F.lds, (const bf16*)(p.ws + WS_ACT), 256, S, E);
}
namespace attn_body {
using bf16=unsigned short;
using bf16x8=__attribute__((ext_vector_type(8)))short;
using s16x4=__attribute__((ext_vector_type(4)))short;
using f32x16=__attribute__((ext_vector_type(16)))float;
using u32x4=__attribute__((ext_vector_type(4)))unsigned;
constexpr int D=64,DM=1024;
constexpr int NW=8,QBLK=32,QB=QBLK*NW,KVBLK=64;
constexpr int ATTN_PITCH=DM, ATTN_UNIT_ROWS=QB;
__device__ __forceinline__ int crow(int r,int hi){return (r&3)+8*(r>>2)+4*hi;}
#define SBAR() __builtin_amdgcn_sched_barrier(0)

constexpr int NSLOT=3, SLOTB=8192;
constexpr int LDS_K=0, LDS_V=NSLOT*SLOTB, LDS_WS=2*NSLOT*SLOTB, LDS_OST=LDS_WS+NW*64*4, LDS_BYTES=LDS_OST+NW*4096;
constexpr float C2=0.125f*1.4426950408889634f;
__device__ __forceinline__ void glds16(const void*gsrc,unsigned lds_dst){unsigned keep;
  asm volatile("s_mov_b32 %0, m0\n\ts_mov_b32 m0, %2\n\ts_nop 0\n\tglobal_load_lds_dwordx4 %1, off\n\ts_mov_b32 m0, %0":"=&s"(keep):"v"(gsrc),"s"(lds_dst):"memory");}
__device__ __forceinline__ float max3f(float a,float b,float c){float r;asm("v_max3_f32 %0, %1, %2, %3":"=v"(r):"v"(a),"v"(b),"v"(c));return r;}
__device__ __forceinline__ float max2f(float a,float b){float r;asm("v_max_f32_e32 %0, %1, %2":"=v"(r):"v"(a),"v"(b));return r;}
__device__ __forceinline__ float fadd_s(float a,float b){float r;asm("v_add_f32_e32 %0, %1, %2":"=v"(r):"v"(a),"v"(b));return r;}
__device__ __forceinline__ float fsub_s(float a,float b){float r;asm("v_sub_f32_e32 %0, %1, %2":"=v"(r):"v"(a),"v"(b));return r;}
typedef float f32x2_t __attribute__((ext_vector_type(2))); typedef __bf16 bf16x2_t __attribute__((ext_vector_type(2)));
__device__ __forceinline__ unsigned cvtpk_s(float lo,float hi){f32x2_t v={lo,hi};bf16x2_t b=__builtin_convertvector(v,bf16x2_t);return __builtin_bit_cast(unsigned,b);}
#define WAIT_BAR(N) asm volatile("s_waitcnt vmcnt(" #N ") lgkmcnt(0)\n\ts_barrier":::"memory")

__device__ __forceinline__ void qkt(f32x16&p0,f32x16&p1,const char*Kslot,const bf16x8*qr,const f32x16&negm,int r32,int hi){
  const char*kb=Kslot+hi*1024+r32*16;
  #pragma unroll
  for(int d0=0;d0<4;++d0){
    const bf16x8 b0=*reinterpret_cast<const bf16x8*>(kb+d0*2048);
    const bf16x8 b1=*reinterpret_cast<const bf16x8*>(kb+d0*2048+512);
    if(d0==0){p0=__builtin_amdgcn_mfma_f32_32x32x16_bf16(b0,qr[0],negm,0,0,0);p1=__builtin_amdgcn_mfma_f32_32x32x16_bf16(b1,qr[0],negm,0,0,0);}
    else{p0=__builtin_amdgcn_mfma_f32_32x32x16_bf16(b0,qr[d0],p0,0,0,0);p1=__builtin_amdgcn_mfma_f32_32x32x16_bf16(b1,qr[d0],p1,0,0,0);}}
}
typedef __attribute__((address_space(3))) const char* lds_cptr;
typedef short v4i16_t __attribute__((ext_vector_type(4)));
__device__ __forceinline__ void kload8(bf16x8*kf,lds_cptr kp){
  kf[0]=*(const __attribute__((address_space(3))) bf16x8*)(kp);      kf[1]=*(const __attribute__((address_space(3))) bf16x8*)(kp+512);
  kf[2]=*(const __attribute__((address_space(3))) bf16x8*)(kp+2048); kf[3]=*(const __attribute__((address_space(3))) bf16x8*)(kp+2560);
  kf[4]=*(const __attribute__((address_space(3))) bf16x8*)(kp+4096); kf[5]=*(const __attribute__((address_space(3))) bf16x8*)(kp+4608);
  kf[6]=*(const __attribute__((address_space(3))) bf16x8*)(kp+6144); kf[7]=*(const __attribute__((address_space(3))) bf16x8*)(kp+6656);
}
__device__ __forceinline__ void kload2(bf16x8*kf,lds_cptr kp,int j){ kf[2*j]=*(const __attribute__((address_space(3))) bf16x8*)(kp+j*2048); kf[2*j+1]=*(const __attribute__((address_space(3))) bf16x8*)(kp+j*2048+512); }
__device__ __forceinline__ s16x4 vtr(lds_cptr p){ return __builtin_bit_cast(s16x4,__builtin_amdgcn_ds_read_tr16_b64_v4i16((__attribute__((address_space(3))) v4i16_t*)p)); }
__device__ __forceinline__ float rowmax(const f32x16&p0,const f32x16&p1){
  float a=max3f(p0[0],p0[1],p1[0]),b=max3f(p0[2],p0[3],p1[1]);a=max3f(a,p1[2],p1[3]);
  #pragma unroll
  for(int r=4;r<16;r+=4){a=max3f(a,p0[r],p0[r+1]);b=max3f(b,p0[r+2],p0[r+3]);a=max3f(a,p1[r],p1[r+1]);b=max3f(b,p1[r+2],p1[r+3]);}
  const float m=max2f(a,b);
  auto rr=__builtin_amdgcn_permlane32_swap(__float_as_uint(m),__float_as_uint(m),false,false);
  return max2f(__uint_as_float(rr[0]),__uint_as_float(rr[1]));
}
#undef SBAR
#undef WAIT_BAR
#undef KVROW
}
namespace attn_body {
constexpr int V2SLOT = 16384;
constexpr int L2_K = 0, L2_V = NSLOT * SLOTB, L2_WS = L2_V + NSLOT * V2SLOT, L2_ST = L2_WS + NW * 64 * 4, L2_BYTES = L2_ST + NW * 8192;
#define SBAR() __builtin_amdgcn_sched_barrier(0)
#define WAIT_BAR(N) asm volatile("s_waitcnt vmcnt(" #N ") lgkmcnt(0)\n\ts_barrier":::"memory")
template<int THRL> __device__ __forceinline__ void attn_unit2(long qrow0,int qcol,int vcol,long kctx,long klat,int NT,const bf16*Q,const bf16*__restrict__ K,const bf16*__restrict__ V,int m,float lam,const float*subln,unsigned char*A2,int acol,float km,char*shm){
  const int tid=threadIdx.x,lane=tid&63,r32=lane&31,hi=lane>>5; const int wid=__builtin_amdgcn_readfirstlane(tid>>6);
  const bf16*Qw=Q+(qrow0+wid*QBLK)*DM+qcol;
  const bf16*Kh=K+qcol,*Vh=V+vcol;
  const unsigned lds0=(unsigned)(uintptr_t)shm;
  float*wsf=(float*)(shm+L2_WS)+wid*64;
  const bf16*ksrc=Kh+(long)lane*DM+wid*8;
  const bf16*vsrc=Vh+(long)(16*(wid&3)+(lane>>2))*DM+(wid>>2)*32+(lane&3)*8;
  const unsigned kdst=lds0+L2_K+wid*1024, vdst=lds0+L2_V+wid*1024;
  #define KVROW(t) ((t)<4?kctx+(long)(t)*KVBLK:klat+(long)((t)-4)*KVBLK)
  #define DMA_K(t,slot) glds16(ksrc+KVROW(t)*DM,(unsigned)__builtin_amdgcn_readfirstlane(kdst+(slot)))
  #define DMA_V(t,slot) do{ glds16(vsrc+KVROW(t)*DM,(unsigned)__builtin_amdgcn_readfirstlane(vdst+2*(slot))); glds16(vsrc+KVROW(t)*DM+64,(unsigned)__builtin_amdgcn_readfirstlane(vdst+2*(slot)+8192)); }while(0)
  const char*Kbase=shm+L2_K; bf16x8 kf[8];
  const lds_cptr shm3=(lds_cptr)shm; const lds_cptr kp0=shm3+L2_K+hi*1024+r32*16; const lds_cptr vp0=shm3+L2_V+((lane>>4)&1)*32+(lane&3)*8+(4*hi+((lane&15)>>2))*64;
  DMA_K(0,0);DMA_V(0,0);DMA_K(1,SLOTB);
  bf16x8 qr[4];
  #pragma unroll
  for(int d0=0;d0<4;++d0)qr[d0]=*reinterpret_cast<const bf16x8*>(&Qw[(long)r32*DM+d0*16+hi*8]);
  bool FAST; { float qn=0.f;
    #pragma unroll
    for(int d0=0;d0<4;++d0){ const u32x4 u=__builtin_bit_cast(u32x4,qr[d0]); const unsigned a4[4]={u.x,u.y,u.z,u.w};
      #pragma unroll
      for(int i=0;i<4;++i){ const float lo=__uint_as_float(a4[i]<<16),h2=__uint_as_float(a4[i]&0xffff0000u); qn+=lo*lo+h2*h2; } }
    qn+=__shfl_xor(qn,32); FAST=__all(qn*km<=96.f*96.f)!=0; }
  float mhat=0.f,l_reg=0.f;f32x16 o[4];o[0]=f32x16{};o[1]=f32x16{};o[2]=f32x16{};o[3]=f32x16{};const f32x16 zero16=f32x16{};
  bool resc=false;
  #define START(P0,P1) do{ resc=false; if(FAST){ mhat=0.f; } else { const float rm=rowmax(P0,P1); mhat=rm; \
    _Pragma("unroll") for(int r=0;r<16;++r){P0[r]=fsub_s(P0[r],rm);P1[r]=fsub_s(P1[r],rm);} } \
    _Pragma("unroll") for(int r=0;r<16;++r)P0[r]=__builtin_amdgcn_exp2f(P0[r]); }while(0)
  #define RESC() do{ if(resc){ asm volatile("s_waitcnt lgkmcnt(0)":::"memory"); \
      _Pragma("unroll") for(int d_=0;d_<4;++d_) _Pragma("unroll") for(int r=0;r<16;++r)o[d_][r]*=wsf[crow(r,hi)]; } }while(0)
  int sl_prev=0,sl_cur=0,sl_next=SLOTB;
  #define ROT() do{sl_prev=sl_cur;sl_cur=sl_next;sl_next=(sl_next==(NSLOT-1)*SLOTB)?0:sl_next+SLOTB;}while(0)
  DMA_K(2,2*SLOTB);
  WAIT_BAR(4);
  #define PKW(P,B) cvtpk_s(P[B],P[B+1])
  u32x4 pwA0,pwA1,pwA2,pwA3,pwB0,pwB1,pwB2,pwB3;
  { f32x16 p0,p1;
    qkt(p0,p1,Kbase,qr,zero16,r32,hi);asm volatile("s_nop 15\n\ts_nop 7":"+v"(p0),"+v"(p1));
    START(p0,p1);
    _Pragma("unroll") for(int r=0;r<16;++r)p1[r]=__builtin_amdgcn_exp2f(p1[r]);
    float sacc=p0[0]+p0[1]; _Pragma("unroll") for(int r=2;r<16;++r)sacc+=p0[r]; _Pragma("unroll") for(int r=0;r<16;++r)sacc+=p1[r]; l_reg+=sacc;
    pwA0=(u32x4){PKW(p0,0),PKW(p0,2),PKW(p0,4),PKW(p0,6)};pwA1=(u32x4){PKW(p0,8),PKW(p0,10),PKW(p0,12),PKW(p0,14)};pwA2=(u32x4){PKW(p1,0),PKW(p1,2),PKW(p1,4),PKW(p1,6)};pwA3=(u32x4){PKW(p1,8),PKW(p1,10),PKW(p1,12),PKW(p1,14)}; }
  WAIT_BAR(0);
  DMA_K(3,0);DMA_V(1,SLOTB);
  ROT();
  kload8(kf,kp0+sl_cur);
  WAIT_BAR(3);
  s16x4 vAl[4],vAh[4],vBl[4],vBh[4];
  #define PAFX(x) __builtin_bit_cast(bf16x8,x)
  #define VF(A,d) (bf16x8){A##l[d][0],A##l[d][1],A##l[d][2],A##l[d][3],A##h[d][0],A##h[d][1],A##h[d][2],A##h[d][3]}
  #define PIN(x) asm volatile("":"+v"(x))
  #define MX3(a,b,c) __builtin_fmaxf(__builtin_fmaxf((a),(b)),(c))
  #define EX(v) __builtin_amdgcn_exp2f(v)
  #define VRDL(A,d,ks) A##l[d]=vtr(vp_+((d)*4096+(ks)*1024))
  #define VRDH(A,d,ks) A##h[d]=vtr(vp_+((d)*4096+(ks)*1024+512))
  #define GAPF(MF,X,B,PWN,W,RD) do{ MF; X[B]=EX(X[B]); X[B+1]=EX(X[B+1]); sacc+=X[B]; sacc+=X[B+1]; PIN(sacc); PWN[W]=cvtpk_s(X[B],X[B+1]); PIN(PWN); RD; SBAR(); }while(0)
  #define GAPP(MF,X,B,PWN,W,RD) do{ MF; X[B]=EX(X[B]-mhat); X[B+1]=EX(X[B+1]-mhat); sacc+=X[B]; sacc+=X[B+1]; PIN(sacc); PWN[W]=cvtpk_s(X[B],X[B+1]); PIN(PWN); RD; SBAR(); }while(0)
  #define MFQ(C,kf_,q_,acc_) C=__builtin_amdgcn_mfma_f32_32x32x16_bf16(kf_,q_,acc_,0,0,0)
  #define MFO(d,PW,A) o[d]=__builtin_amdgcn_mfma_f32_32x32x16_bf16(PAFX(PW),VF(A,d),o[d],0,0,0)
  #define KRD(G,j) do{ if(G){ kload2(kf,kp0+sl_next,j); } }while(0)
  #define PHASEB(G,PI0,PI1,PI2,PI3,PO0,PO1,PO2,PO3,GL) do{ \
    G(MFO(0,PI0,vA),C0,0, PO0,0, VRDL(vB,0,1);VRDH(vB,0,1)); \
    G(MFO(1,PI0,vA),C0,2, PO0,1, VRDL(vB,1,1);VRDH(vB,1,1)); \
    G(MFO(2,PI0,vA),C0,4, PO0,2, VRDL(vB,2,1);VRDH(vB,2,1)); \
    G(MFO(3,PI0,vA),C0,6, PO0,3, VRDL(vB,3,1);VRDH(vB,3,1)); \
    G(MFO(0,PI1,vB),C0,8, PO1,0, VRDL(vA,0,2);VRDH(vA,0,2)); \
    G(MFO(1,PI1,vB),C0,10,PO1,1, VRDL(vA,1,2);VRDH(vA,1,2)); \
    G(MFO(2,PI1,vB),C0,12,PO1,2, VRDL(vA,2,2);VRDH(vA,2,2)); \
    G(MFO(3,PI1,vB),C0,14,PO1,3, VRDL(vA,3,2);VRDH(vA,3,2)); \
    G(MFO(0,PI2,vA),C1,0, PO2,0, VRDL(vB,0,3);VRDH(vB,0,3)); \
    G(MFO(1,PI2,vA),C1,2, PO2,1, VRDL(vB,1,3);VRDH(vB,1,3)); \
    G(MFO(2,PI2,vA),C1,4, PO2,2, VRDL(vB,2,3);VRDH(vB,2,3)); \
    G(MFO(3,PI2,vA),C1,6, PO2,3, VRDL(vB,3,3);VRDH(vB,3,3)); \
    G(MFO(0,PI3,vB),C1,8, PO3,0, KRD(GL,0)); \
    G(MFO(1,PI3,vB),C1,10,PO3,1, KRD(GL,1)); \
    G(MFO(2,PI3,vB),C1,12,PO3,2, KRD(GL,2)); \
    G(MFO(3,PI3,vB),C1,14,PO3,3, KRD(GL,3)); \
    }while(0)
  #define STEP2(t,PI0,PI1,PI2,PI3,PO0,PO1,PO2,PO3,GK,GV,GL) do{ SBAR(); \
    const lds_cptr vp_=vp0+2*sl_prev; f32x16 C0,C1; float sacc=0.f; \
    VRDL(vA,0,0); SBAR(); MFQ(C0,kf[0],qr[0],zero16); SBAR(); \
    VRDH(vA,0,0); SBAR(); MFQ(C1,kf[1],qr[0],zero16); SBAR(); \
    VRDL(vA,1,0); SBAR(); MFQ(C0,kf[2],qr[1],C0); SBAR(); \
    VRDH(vA,1,0); SBAR(); MFQ(C1,kf[3],qr[1],C1); SBAR(); \
    VRDL(vA,2,0); SBAR(); MFQ(C0,kf[4],qr[2],C0); SBAR(); \
    VRDH(vA,2,0); SBAR(); MFQ(C1,kf[5],qr[2],C1); SBAR(); \
    VRDL(vA,3,0); SBAR(); MFQ(C0,kf[6],qr[3],C0); SBAR(); \
    VRDH(vA,3,0); SBAR(); MFQ(C1,kf[7],qr[3],C1); SBAR(); \
    if(GK){DMA_K((t)+3,sl_cur);} if(GV){DMA_V((t)+1,sl_next);} \
    if(!FAST){ float a=MX3(C0[0],C0[1],C1[0]),b=MX3(C0[2],C0[3],C1[1]); a=MX3(a,C1[2],C1[3]); \
      _Pragma("unroll") for(int r=4;r<16;r+=4){a=MX3(a,C0[r],C0[r+1]);b=MX3(b,C0[r+2],C0[r+3]);a=MX3(a,C1[r],C1[r+1]);b=MX3(b,C1[r+2],C1[r+3]);} \
      float rm=__builtin_fmaxf(a,b); { auto rr=__builtin_amdgcn_permlane32_swap(__float_as_uint(rm),__float_as_uint(rm),false,false); rm=__builtin_fmaxf(__uint_as_float(rr[0]),__uint_as_float(rr[1])); } \
      resc=false; \
      if(__builtin_expect(__any(rm-mhat>(float)THRL),0)){ const float dl=__builtin_fmaxf(rm-mhat,0.f); mhat+=dl; \
        const float f=__builtin_amdgcn_exp2f(-dl); l_reg*=f; if(hi==0)wsf[r32]=f; resc=true; } } \
    __builtin_amdgcn_s_setprio(1); SBAR(); \
    PHASEB(GAPP,PI0,PI1,PI2,PI3,PO0,PO1,PO2,PO3,GL); \
    __builtin_amdgcn_s_setprio(0); l_reg+=sacc; \
    }while(0)
  #define ENDW(tt) do{ if((tt)+3<NT){WAIT_BAR(3);} else if((tt)+2<NT){WAIT_BAR(2);} else {WAIT_BAR(0);} }while(0)
  int t=1;
  for(;t+5<NT;t+=2){
    STEP2(t,  pwA0,pwA1,pwA2,pwA3,pwB0,pwB1,pwB2,pwB3,true,true,true); WAIT_BAR(3); RESC(); ROT();
    STEP2(t+1,pwB0,pwB1,pwB2,pwB3,pwA0,pwA1,pwA2,pwA3,true,true,true); WAIT_BAR(3); RESC(); ROT();
  }
  for(;t+1<NT;t+=2){
    STEP2(t,  pwA0,pwA1,pwA2,pwA3,pwB0,pwB1,pwB2,pwB3,(t+3<NT),(t+1<NT),(t+1<NT)); ENDW(t);   RESC(); ROT();
    STEP2(t+1,pwB0,pwB1,pwB2,pwB3,pwA0,pwA1,pwA2,pwA3,(t+4<NT),(t+2<NT),(t+2<NT)); ENDW(t+1); RESC(); ROT();
  }
  STEP2(NT-1,pwA0,pwA1,pwA2,pwA3,pwB0,pwB1,pwB2,pwB3,false,false,false); RESC();
  { const lds_cptr vp_=vp0+2*sl_cur;
    #pragma unroll
    for(int ks=0;ks<4;++ks){
      #pragma unroll
      for(int d=0;d<4;++d){ const s16x4 lo=vtr(vp_+(d*4096+ks*1024)),hh=vtr(vp_+(d*4096+ks*1024+512)); const bf16x8 vf=(bf16x8){lo[0],lo[1],lo[2],lo[3],hh[0],hh[1],hh[2],hh[3]};
        const u32x4 pw=(ks==0)?pwB0:(ks==1)?pwB1:(ks==2)?pwB2:pwB3;
        o[d]=__builtin_amdgcn_mfma_f32_32x32x16_bf16(PAFX(pw),vf,o[d],0,0,0); } } }
  {auto rr=__builtin_amdgcn_permlane32_swap(__float_as_uint(l_reg),__float_as_uint(l_reg),false,false);l_reg=__uint_as_float(rr[0])+__uint_as_float(rr[1]);}
  if(hi==0)wsf[32+r32]=l_reg;asm volatile("s_waitcnt lgkmcnt(0)":::"memory");
  float rli[16];
  #pragma unroll
  for(int r=0;r<16;++r)rli[r]=__builtin_amdgcn_rcpf(wsf[32+crow(r,hi)]);
  unsigned short*stash=(unsigned short*)(shm+L2_ST)+wid*4096;
  if(m==0){
    #pragma unroll
    for(int d0=0;d0<4;++d0){
      #pragma unroll
      for(int r=0;r<16;++r)stash[(d0*16+r)*64+lane]=(unsigned short)f2bf(o[d0][r]*rli[r]);}
    asm volatile("s_waitcnt lgkmcnt(0)":::"memory");
  } else {
    float ss[16];
    #pragma unroll
    for(int r=0;r<16;++r)ss[r]=0.f;
    #pragma unroll
    for(int d0=0;d0<4;++d0){
      #pragma unroll
      for(int r=0;r<16;++r){ const float o1=bf2f(stash[(d0*16+r)*64+lane]); const float df=o1-lam*(o[d0][r]*rli[r]); o[d0][r]=df; ss[r]+=df*df; } }
    #pragma unroll
    for(int r=0;r<16;++r){ float q=ss[r];
      #pragma unroll
      for(int s_=1;s_<32;s_<<=1)q+=__shfl_xor(q,s_);
      ss[r]=(1.f-LAMBDA_INIT0)/sqrtf(q*(1.f/128.f)+LN_EPS); }
    asm volatile("s_waitcnt lgkmcnt(0)":::"memory");
    unsigned char*stg=(unsigned char*)stash;
    #pragma unroll
    for(int d0=0;d0<4;++d0){ const float sgv=subln[d0*32+r32];
      #pragma unroll
      for(int r=0;r<16;++r){ const int w8=__builtin_amdgcn_cvt_pk_fp8_f32(o[d0][r]*ss[r]*sgv,0.f,0,false); stg[crow(r,hi)*128+d0*32+r32]=(unsigned char)(w8&0xff); } }
    asm volatile("s_waitcnt lgkmcnt(0)":::"memory");
    unsigned char*Aw=A2+(qrow0+wid*QBLK)*DM+acol;
    #pragma unroll
    for(int i=0;i<4;++i){const int row=i*8+(lane>>3),ch=lane&7; const u32x4 v=*(const u32x4*)(stg+row*128+ch*16); *(u32x4*)(Aw+(long)row*DM+ch*16)=v;}
    asm volatile("s_waitcnt lgkmcnt(0)":::"memory");
  }
  asm volatile("s_waitcnt lgkmcnt(0)\n\ts_barrier":::"memory");
  #undef KVROW
  #undef DMA_K
  #undef DMA_V
  #undef START
  #undef RESC
  #undef ROT
  #undef PKW
  #undef PAFX
  #undef VF
  #undef PIN
  #undef MX3
  #undef EX
  #undef VRDL
  #undef VRDH
  #undef GAPP
  #undef GAPF
  #undef PHASEB
  #undef MFQ
  #undef MFO
  #undef KRD
  #undef STEP2
  #undef ENDW
}
#undef SBAR
#undef WAIT_BAR
}
__device__ __forceinline__ void phase_attn2(const Frame& F, const Prm& p) {
    const bf16* Q = (const bf16*)(p.ws + WS_Q); const bf16* K = (const bf16*)(p.ws + WS_K); const bf16* V = (const bf16*)(p.ws + WS_V); unsigned char* A2 = p.ws + WS_O1;
    const float lam = ((const float*)(p.ws + WS_MISC))[0];
    for (int v = vcu_of(F); v < 256; v += F.G) {
        const int b = v >> 5, h = (v >> 2) & 7, part = v & 3;
        const long kctx = NLAT + b * CTXL, klat = (long)b * SEQ;
        const int nu = part ? 4 : 5;
        for (int i = 0; i < nu; ++i) {
            const long qrow0 = i < 4 ? klat + (part * 4 + i) * 256 : kctx; const int NT = i < 4 ? 68 : 4;
            for (int m = 0; m < 2; ++m) {
                const int hm = 2 * h + m;
                const float km = __uint_as_float(__hip_atomic_load(F.ctl + CW_KM + b * 16 + hm, __ATOMIC_RELAXED, __HIP_MEMORY_SCOPE_AGENT));
                attn_body::attn_unit2<8>(qrow0, hm * 64, h * 128, kctx, klat, NT, Q, K, V, m, lam, p.subln, A2, h * 128, km, (char*)F.lds);
            }
        }
    }
}
namespace gla3 {
typedef short bf16x8 __attribute__((ext_vector_type(8)));
typedef short s16x4 __attribute__((ext_vector_type(4)));
typedef float f32x16 __attribute__((ext_vector_type(16)));
constexpr int CH = 64 * 16 + 64;
constexpr int L_QS = 0, L_KS = 16 * CH, L_VS = 32 * CH, L_SB = 40 * CH, L_X = 56 * CH, L_DEC = L_X + 16384, L_END = L_DEC + 512;
__device__ __forceinline__ int crow(int i, int hh) { return (i & 3) + 8 * (i >> 2) + 4 * hh; }
typedef float f32x2_t __attribute__((ext_vector_type(2))); typedef __bf16 bf16x2_t __attribute__((ext_vector_type(2)));
__device__ __forceinline__ unsigned pk(float lo, float hi) { f32x2_t v = {lo, hi}; bf16x2_t b = __builtin_convertvector(v, bf16x2_t); return __builtin_bit_cast(unsigned, b); }
typedef short v4i16_t __attribute__((ext_vector_type(4)));
__device__ __forceinline__ s16x4 trrd(LAS const unsigned char* p) { return __builtin_bit_cast(s16x4, __builtin_amdgcn_ds_read_tr16_b64_v4i16((LAS v4i16_t*)p)); }
#define GLA_FR(lo, hi) (bf16x8){lo[0], lo[1], lo[2], lo[3], hi[0], hi[1], hi[2], hi[3]}

__device__ __forceinline__ void scan_unit(const Frame& F, const Prm& p, int unit) {
    const int dvs = unit & 3, dir = (unit >> 2) & 1, h = (unit >> 3) & 3, b = unit >> 5;
    LAS unsigned char* lds = (LAS unsigned char*)F.lds;
    const int lane = F.lane, w = F.wave, tid = F.tid, r = lane & 31, hh = lane >> 5;
    const bf16* QT = (const bf16*)(p.ws + WS_QT) + ((size_t)dir * 8 + 2 * h) * NTOK * 64;
    const bf16* KT = (const bf16*)(p.ws + WS_KT) + ((size_t)dir * 8 + 2 * h) * NTOK * 64;
    const bf16* V = (const bf16*)(p.ws + WS_V1) + h * 256 + dvs * 64;
    const float* DEC = (const float*)(p.ws + WS_DEC) + (size_t)dir * NCHUNK * 512 + h * 128;
    bf16* OG = (bf16*)((unsigned char*)p.out + (dir ? OUT_OGB : 0)) + h * 256 + dvs * 64;
    const int g1 = (lane >> 4) & 1, q4 = (lane & 15) >> 2, p4 = lane & 3;
    const int trb = (2 * g1 + (p4 >> 1)) * CH + q4 * 16 + 8 * (p4 & 1);
    const int trN = trb + 128 * hh, trP = trb + 64 * hh;
    f32x16 S0 = {}, S1 = {};
    for (int i = tid; i < 16 * CH / 16; i += NTHR) *(LAS u32x4*)(lds + L_SB + i * 16) = (u32x4){0u, 0u, 0u, 0u};
    u32x4 pq0[2], pq1[2], pk0[2], pk1[2], pv[2]; float pdec[2] = {0.f, 0.f};
#define GLA_CHUNK(step) ((step) >= 4 ? b * 64 + (dir ? 63 - ((step) - 4) : (step) - 4) : 512 + b * 4 + (dir ? 3 - (step) : (step)))
    const int qrow = 8 * w + (lane >> 4), qch = lane & 15, vrow = 8 * w + (lane >> 3), vch = lane & 7;
    const size_t qgo = (size_t)(qch >> 3) * NTOK * 64 + (qch & 7) * 8;
#define GLA_LOAD(step, u) do { const size_t t0_ = (size_t)GLA_CHUNK(step) * 64; \
        pq0[u] = *(const u32x4*)(QT + qgo + (t0_ + qrow) * 64); pq1[u] = *(const u32x4*)(QT + qgo + (t0_ + qrow + 4) * 64); \
        pk0[u] = *(const u32x4*)(KT + qgo + (t0_ + qrow) * 64); pk1[u] = *(const u32x4*)(KT + qgo + (t0_ + qrow + 4) * 64); \
        pv[u] = *(const u32x4*)(V + (t0_ + vrow) * 1024 + 8 * vch); if (tid < 128) pdec[u] = DEC[(size_t)GLA_CHUNK(step) * 512 + tid]; } while (0)
#define GLA_STORE(u) do { \
        *(LAS u32x4*)(lds + L_QS + qch * CH + qrow * 16) = pq0[u]; *(LAS u32x4*)(lds + L_QS + qch * CH + (qrow + 4) * 16) = pq1[u]; \
        *(LAS u32x4*)(lds + L_KS + qch * CH + qrow * 16) = pk0[u]; *(LAS u32x4*)(lds + L_KS + qch * CH + (qrow + 4) * 16) = pk1[u]; \
        *(LAS u32x4*)(lds + L_VS + vch * CH + vrow * 16) = pv[u]; \
        if (tid < 128) *(LAS float*)(lds + L_DEC + 4 * tid) = pdec[u]; } while (0)
    GLA_LOAD(0, 0);
    GLA_LOAD(1, 1);
    GLA_STORE(0);
    __syncthreads();
    const int tb = (w & 3) >> 1, vb = w & 1;
    for (int sp2 = 0; sp2 < 34; ++sp2) {
#pragma unroll
    for (int u = 0; u < 2; ++u) {
        const int step = 2 * sp2 + u;
        const bool lat = step >= 4; const int chunk = GLA_CHUNK(step);
        if (step + 2 < 68) GLA_LOAD(step + 2, u);
        f32x16 o = {};
        if (w < 4) {
            if (lat) {
                const bool n0 = dir ? (tb == 0) : true, n1 = dir ? true : (tb == 1);
                f32x16 sc0 = {}, sc1 = {};
#define GLA_BQ(ks) (*(const LAS bf16x8*)(lds + L_QS + (2 * (ks) + hh) * CH + (32 * tb + r) * 16))
#define GLA_A0(ks) (*(const LAS bf16x8*)(lds + L_KS + (2 * (ks) + hh) * CH + r * 16))
#define GLA_A1(ks) (*(const LAS bf16x8*)(lds + L_KS + (2 * (ks) + hh) * CH + (32 + r) * 16))
                if (n0 && n1) {
#pragma unroll
                    for (int ks = 0; ks < 8; ++ks) { const bf16x8 bq = GLA_BQ(ks); sc0 = __builtin_amdgcn_mfma_f32_32x32x16_bf16(GLA_A0(ks), bq, sc0, 0, 0, 0); sc1 = __builtin_amdgcn_mfma_f32_32x32x16_bf16(GLA_A1(ks), bq, sc1, 0, 0, 0); }
                } else if (n0) {
#pragma unroll
                    for (int ks = 0; ks < 8; ++ks) sc0 = __builtin_amdgcn_mfma_f32_32x32x16_bf16(GLA_A0(ks), GLA_BQ(ks), sc0, 0, 0, 0);
                } else {
#pragma unroll
                    for (int ks = 0; ks < 8; ++ks) sc1 = __builtin_amdgcn_mfma_f32_32x32x16_bf16(GLA_A1(ks), GLA_BQ(ks), sc1, 0, 0, 0);
                }
#undef GLA_BQ
#undef GLA_A0
#undef GLA_A1
                const int t = 32 * tb + r;
#pragma unroll
                for (int i = 0; i < 16; ++i) { const int s0 = crow(i, hh), s1 = 32 + s0; const bool k0 = dir ? (s0 >= t) : (s0 <= t), k1 = dir ? (s1 >= t) : (s1 <= t); sc0[i] = k0 ? sc0[i] : 0.f; sc1[i] = k1 ? sc1[i] : 0.f; }
#pragma unroll
                for (int sb = 0; sb < 2; ++sb) { if (sb == 0 ? n0 : n1) {
#pragma unroll
                    for (int sp = 0; sp < 2; ++sp) {
                        u32x4 pw;
                        if (sb == 0) { pw.x = pk(sc0[8 * sp + 0], sc0[8 * sp + 1]); pw.y = pk(sc0[8 * sp + 2], sc0[8 * sp + 3]); pw.z = pk(sc0[8 * sp + 4], sc0[8 * sp + 5]); pw.w = pk(sc0[8 * sp + 6], sc0[8 * sp + 7]); }
                        else { pw.x = pk(sc1[8 * sp + 0], sc1[8 * sp + 1]); pw.y = pk(sc1[8 * sp + 2], sc1[8 * sp + 3]); pw.z = pk(sc1[8 * sp + 4], sc1[8 * sp + 5]); pw.w = pk(sc1[8 * sp + 6], sc1[8 * sp + 7]); }
                        LAS const unsigned char* vp = lds + L_VS + trP + (4 * vb) * CH + (32 * sb + 16 * sp) * 16;
                        const s16x4 lo = trrd(vp), hi = trrd(vp + 8 * 16);
                        o = __builtin_amdgcn_mfma_f32_32x32x16_bf16(GLA_FR(lo, hi), __builtin_bit_cast(bf16x8, pw), o, 0, 0, 0);
                    } } }
            }
        } else {
            const int db = w - 4;
            if (lat) {
                f32x16 o2 = {};
#pragma unroll
                for (int ks = 0; ks < 8; ++ks) {
                    const bf16x8 as = *(const LAS bf16x8*)(lds + L_SB + (2 * ks + hh) * CH + (32 * vb + r) * 16);
                    const bf16x8 bq = *(const LAS bf16x8*)(lds + L_QS + (2 * ks + hh) * CH + (32 * tb + r) * 16);
                    o2 = __builtin_amdgcn_mfma_f32_32x32x16_bf16(as, bq, o2, 0, 0, 0);
                }
#pragma unroll
                for (int g = 0; g < 4; ++g) *(LAS f32x4*)(lds + L_X + (w & 3) * 4096 + g * 1024 + lane * 16) = (f32x4){o2[4 * g], o2[4 * g + 1], o2[4 * g + 2], o2[4 * g + 3]};
            }
#pragma unroll
            for (int ks = 0; ks < 4; ++ks) {
                LAS const unsigned char* kp = lds + L_KS + trN + (4 * db) * CH + (16 * ks) * 16;
                LAS const unsigned char* vp = lds + L_VS + trN + (16 * ks) * 16;
                const s16x4 al = trrd(kp), ah = trrd(kp + 4 * 16);
                const s16x4 b0l = trrd(vp), b0h = trrd(vp + 4 * 16), b1l = trrd(vp + 4 * CH), b1h = trrd(vp + 4 * CH + 4 * 16);
                S0 = __builtin_amdgcn_mfma_f32_32x32x16_bf16(GLA_FR(al, ah), GLA_FR(b0l, b0h), S0, 0, 0, 0); S1 = __builtin_amdgcn_mfma_f32_32x32x16_bf16(GLA_FR(al, ah), GLA_FR(b1l, b1h), S1, 0, 0, 0);
            }
#pragma unroll
            for (int i = 0; i < 16; ++i) { const float dc = *(const LAS float*)(lds + L_DEC + 4 * (32 * db + crow(i, hh))); S0[i] *= dc; S1[i] *= dc; }
        }
        __syncthreads();
        if (w < 4 && lat) {
            bf16* orow = OG + ((size_t)chunk * 64 + 32 * tb + r) * DM + 32 * vb + 4 * hh;
#pragma unroll
            for (int g = 0; g < 4; ++g) { const f32x4 x = *(const LAS f32x4*)(lds + L_X + w * 4096 + g * 1024 + lane * 16);
                u32x2 wv; wv.x = pk(o[4 * g] + x.x, o[4 * g + 1] + x.y); wv.y = pk(o[4 * g + 2] + x.z, o[4 * g + 3] + x.w); *(u32x2*)(orow + 8 * g) = wv; }
        }
        if (step + 1 < 68) {
            GLA_STORE(u ^ 1);
            if (w >= 4) { const int db = w - 4;
#pragma unroll
                for (int g = 0; g < 4; ++g) { u32x2 w0, w1; w0.x = pk(S0[4 * g], S0[4 * g + 1]); w0.y = pk(S0[4 * g + 2], S0[4 * g + 3]); w1.x = pk(S1[4 * g], S1[4 * g + 1]); w1.y = pk(S1[4 * g + 2], S1[4 * g + 3]);
                    *(LAS u32x2*)(lds + L_SB + (4 * db + g) * CH + r * 16 + 8 * hh) = w0; *(LAS u32x2*)(lds + L_SB + (4 * db + g) * CH + (32 + r) * 16 + 8 * hh) = w1; } }
        }
        __syncthreads();
    }
    }
#undef GLA_CHUNK
#undef GLA_LOAD
#undef GLA_STORE
}
#undef GLA_FR
}
__device__ __forceinline__ void phase_scan_opt(const Frame& F, const Prm& p) {
    for (int unit = vcu_of(F); unit < 256; unit += F.G) gla3::scan_unit(F, p, unit);
}
#define PHASE_QKV(F, p) phase_qkv_opt(F, p)
#define PHASE_ATTN(F, p) phase_attn2(F, p)
#define PHASE_WO(F, p, l) phase_wo_opt(F, p, l)
#define PHASE_MOE1(F, p, l) phase_moe1_opt(F, p, l)
#define PHASE_MOE2(F, p, l) phase_moe2_opt(F, p, l)
#define PHASE_INPROJ(F, p) phase_inproj_opt(F, p)
#define PHASE_SCAN(F, p) phase_scan_opt(F, p)
typedef GAS unsigned gu32;
#define XB_TMO      128
#define XB_XCNT(j)  (256  + 64 * (j))
#define XB_XSUB(j)  (1280 + 64 * (j))
#define XB_XGEN(j)  (2304 + 64 * (j))
#define XB_TOP      3328
#define XB_TOPGEN   3392
#define XCD_BAR_WORDS 3456
#define XB_SPIN_CAP (1u << 20)
__device__ __forceinline__ unsigned xb_ld(unsigned* p)              { return __hip_atomic_load(p, __ATOMIC_RELAXED, __HIP_MEMORY_SCOPE_AGENT); }
__device__ __forceinline__ unsigned xb_add(unsigned* p, unsigned v) { return __hip_atomic_fetch_add(p, v, __ATOMIC_RELAXED, __HIP_MEMORY_SCOPE_AGENT); }
__device__ __forceinline__ unsigned xb_xcc_id() { return (unsigned)__builtin_amdgcn_s_getreg((3 << 11) | 20) & 0xFu; }
#define XB_SPIN(cond, bar) do { unsigned _sp = 0; while (cond) { __builtin_amdgcn_s_sleep(1); \
    if ((++_sp & 255u) == 0u) { if (xb_ld(&(bar)[XB_TMO])) break; if (_sp > XB_SPIN_CAP) { atomicAdd(&(bar)[XB_TMO], 1u); break; } } } } while (0)
struct XcdBarrier { unsigned* bar; unsigned x; volatile LAS unsigned* st; };
__device__ __forceinline__ XcdBarrier xcd_barrier_post(unsigned* bar, volatile LAS unsigned* st) {
    XcdBarrier b; b.bar = bar; b.x = xb_xcc_id(); b.st = st;
    if (threadIdx.x == 0) (void)xb_add(&bar[XB_XCNT(b.x)], 1u);
    return b;
}
__device__ __forceinline__ void xcd_barrier_complete(unsigned* bar, unsigned x, unsigned& nloc, unsigned& nx) {
    const unsigned G = gridDim.x * gridDim.y * gridDim.z;
    unsigned sum, cnt, mine, sp = 0u;
    for (;;) {
        sum = 0u; cnt = 0u; mine = 0u;
#pragma unroll
        for (unsigned j = 0; j < 16; ++j) { const unsigned c = xb_ld(&bar[XB_XCNT(j)]); sum += c; cnt += (c > 0u) ? 1u : 0u; mine = (j == x) ? c : mine; }
        if (sum == G) break;
        __builtin_amdgcn_s_sleep(1);
        if ((++sp & 255u) == 0u) { if (xb_ld(&bar[XB_TMO])) break; if (sp > XB_SPIN_CAP) { atomicAdd(&bar[XB_TMO], 1u); break; } }
    }
    nloc = mine > 0u ? mine : 1u; nx = cnt > 0u ? cnt : 1u;
}
__device__ __forceinline__ void xcd_barrier(const XcdBarrier& b) {
    asm volatile("s_waitcnt vmcnt(0)" ::: "memory");
    __syncthreads();
    if (threadIdx.x == 0) {
        unsigned* bar = b.bar;
        __builtin_amdgcn_s_waitcnt(0);
        unsigned nloc = b.st[0], nx = b.st[1];
        if (nloc == 0u) { xcd_barrier_complete(bar, b.x, nloc, nx); b.st[0] = nloc; b.st[1] = nx; }
        const unsigned old = xb_add(&bar[XB_XSUB(b.x)], 1u);
        const unsigned gen = old / nloc;
        if (old + 1u == (gen + 1u) * nloc) {
            __builtin_amdgcn_fence(__ATOMIC_RELEASE, "agent");
            asm volatile("s_waitcnt vmcnt(0)" ::: "memory");
            const unsigned og = xb_add(&bar[XB_TOP], 1u);
            const unsigned tg = og / nx;
            if (og + 1u == (tg + 1u) * nx) xb_add(&bar[XB_TOPGEN], 1u);
            else XB_SPIN(xb_ld(&bar[XB_TOPGEN]) == tg, bar);
            __builtin_amdgcn_fence(__ATOMIC_ACQUIRE, "agent");
            xb_add(&bar[XB_XGEN(b.x)], 1u);
            asm volatile("s_waitcnt vmcnt(0)" ::: "memory");
        } else {
            XB_SPIN(xb_ld(&bar[XB_XGEN(b.x)]) == gen, bar);
            __builtin_amdgcn_fence(__ATOMIC_ACQUIRE, "agent");
            asm volatile("s_waitcnt vmcnt(0)" ::: "memory");
        }
    }
    __syncthreads();
}

constexpr int NPHASE = 19;
__global__ void __launch_bounds__(NTHR, 2) mega_fwd(Prm p) {
    extern __shared__ __attribute__((aligned(16))) unsigned char lds[];
    Frame F; F.lds = lds; F.ctl = (unsigned*)(p.ws + WS_CTL);
    F.tid = threadIdx.x; F.lane = F.tid & 63; F.wave = __builtin_amdgcn_readfirstlane(F.tid >> 6); F.G = gridDim.x; F.bid = blockIdx.x;
    for (int u = F.tid; u < (LDS_BYTES - LDSCTL_OFF) / 4; u += NTHR) ((LAS unsigned*)(lds + LDSCTL_OFF))[u] = 0u;
    __syncthreads();
    const int lo = p.ph_lo, hi = p.ph_hi;
    const bool multi = (hi - lo) > 1;
    XcdBarrier bar; bar.bar = F.ctl + CW_BAR + p.li * XCD_BAR_WORDS; bar.x = 0; bar.st = nullptr;
    if (multi) bar = xcd_barrier_post(F.ctl + CW_BAR + p.li * XCD_BAR_WORDS, (volatile LAS unsigned*)(lds + MISC_OFF) + 8);
#define IN(k) (lo <= (k) && (k) < hi)
#define SEAM(k) do { if (IN(k) && IN((k) + 1)) xcd_barrier(bar); } while (0)
    if (IN(0)) { phase_prologue(F, p); } SEAM(0);
    if (IN(1)) { phase_modulate0(F, p); } SEAM(1);
    if (IN(2)) { PHASE_QKV(F, p); } SEAM(2);
    if (IN(3)) { PHASE_ATTN(F, p); } SEAM(3);
    if (IN(5)) { PHASE_WO(F, p, 0); } SEAM(5);
    if (IN(6)) { phase_ln_route(F, p, 0); } SEAM(6);
    if (IN(7)) { PHASE_MOE1(F, p, 0); } SEAM(7);
    if (IN(8)) { PHASE_MOE2(F, p, 0); } SEAM(8);
    if (IN(9)) { phase_moe_combine(F, p, 0); } SEAM(9);
    if (IN(10)) { PHASE_INPROJ(F, p); } SEAM(10);
    if (IN(11)) { phase_gla_prep(F, p); } SEAM(11);
    if (IN(12)) { PHASE_SCAN(F, p); } SEAM(12);
    if (IN(13)) { phase_gla_post(F, p); } SEAM(13);
    if (IN(14)) { PHASE_WO(F, p, 1); } SEAM(14);
    if (IN(15)) { phase_ln_route(F, p, 1); } SEAM(15);
    if (IN(16)) { PHASE_MOE1(F, p, 1); } SEAM(16);
    if (IN(17)) { PHASE_MOE2(F, p, 1); } SEAM(17);
    if (IN(18)) { phase_moe_combine(F, p, 1); }
#undef IN
#undef SEAM
}

extern "C" void kernel_launch(void* const* d_in, const int* in_sizes, int n_in, void* d_out, int out_size, void* d_ws, size_t ws_size, hipStream_t stream) {
    static int grid = 0;
    if (grid == 0) {
        if (n_in != 23 || in_sizes[0] != NLAT * DM || out_size != NLAT * DM || ws_size < WS_END) { fprintf(stderr, "kernel_launch: unexpected shapes (n_in %d, in0 %d, out %d, ws %zu); nothing launched\n", n_in, n_in > 0 ? in_sizes[0] : -1, out_size, ws_size); grid = -1; return; }
        int dev = 0, cus = 0;
        if (hipGetDevice(&dev) != hipSuccess || hipDeviceGetAttribute(&cus, hipDeviceAttributeMultiprocessorCount, dev) != hipSuccess) { grid = -1; return; }
        if (hipFuncSetAttribute((const void*)mega_fwd, hipFuncAttributeMaxDynamicSharedMemorySize, LDS_BYTES) != hipSuccess) { fprintf(stderr, "kernel_launch: hipFuncSetAttribute failed\n"); grid = -1; return; }
        int per_cu = 0;
        if (hipOccupancyMaxActiveBlocksPerMultiprocessor(&per_cu, (const void*)mega_fwd, NTHR, LDS_BYTES) != hipSuccess || per_cu < 1) fprintf(stderr, "kernel_launch: note: occupancy query reports %d\n", per_cu);
        (void)hipGetLastError();
        grid = cus;
    }
    if (grid < 0) return;
    (void)hipMemsetAsync((char*)d_ws + WS_CTL, 0, CTL_ZERO_BYTES, stream);
    Prm p{};
    const float** pp = (const float**)&p;
    for (int i = 0; i < 23; ++i) pp[i] = (const float*)d_in[i];
    p.out = (float*)d_out; p.ws = (unsigned char*)d_ws;
    p.ph_lo = 0; p.ph_hi = NPHASE; p.li = 0;
    hipLaunchKernelGGL(mega_fwd, dim3(grid), dim3(NTHR), LDS_BYTES, stream, p);
}
```

```cpp
#include <hip/hip_runtime.h>
#include <cstdint>
#include <cstdio>

constexpr int BATCH = 8, SEQ = 4096, DM = 1024, CTXL = 256;
constexpr int NLAT = BATCH * SEQ, NCTX = BATCH * CTXL, NTOK = NLAT + NCTX;
constexpr float ALPHA = 1.4142135623730951f;
constexpr float LN_EPS = 1e-5f;
constexpr float LAMBDA_INIT0 = 0.2f;
constexpr float C2 = 0.125f * 1.4426950408889634f;
constexpr int NEXP = 16, DEXP = 512, MAXSLOT = 73728;
constexpr int NCHUNK = NTOK / 64;
constexpr int NIN = 3328;

typedef unsigned short bf16;
typedef float f32x4 __attribute__((ext_vector_type(4)));
typedef float f32x2 __attribute__((ext_vector_type(2)));
typedef unsigned u32x2 __attribute__((ext_vector_type(2)));
typedef unsigned u32x4 __attribute__((ext_vector_type(4)));

constexpr size_t MiB = 1u << 20;
constexpr size_t WS_CTL = 0, CTL_ZERO_BYTES = 1 * MiB;
constexpr size_t WS_MOD = 1 * MiB;
constexpr size_t WS_MISC = 1 * MiB + 512 * 1024;
constexpr size_t WS_WQKV = 2 * MiB, WS_WO = 5 * MiB, WS_GU0 = 6 * MiB, WS_DN0 = 22 * MiB, WS_WIN = 30 * MiB, WS_WGO = 34 * MiB, WS_GU1 = 35 * MiB, WS_DN1 = 51 * MiB;
constexpr size_t WS_XB = 59 * MiB;
constexpr size_t WS_H = 127 * MiB;
constexpr size_t WS_Q = 195 * MiB, WS_K = 263 * MiB, WS_V = 331 * MiB, WS_O2 = 399 * MiB;
constexpr size_t WS_LIST = 467 * MiB;
constexpr size_t WS_TOKR = 470 * MiB;
constexpr size_t WS_DEC = 472 * MiB;
constexpr size_t WS_ZZ = 475 * MiB;
constexpr size_t WS_END = 480 * MiB;
constexpr size_t WS_O1 = WS_H, WS_A2 = WS_H, WS_Y = WS_K;
constexpr size_t WS_YM = 195 * MiB, WS_ACT = 339 * MiB;
constexpr size_t WS_QR = 195 * MiB, WS_KR = 229 * MiB, WS_V1 = 263 * MiB, WS_R = 331 * MiB;
constexpr size_t WS_QT = WS_H, WS_KT = 399 * MiB;
constexpr size_t WS_A2B = WS_H;
constexpr size_t OUT_OGB = 64 * MiB;
constexpr int CW_TMO = 0, CW_CODE = 1;
constexpr int CW_CNT = 64;
constexpr int CW_KM = 128;
constexpr int CW_BAR = 4096;

__device__ __forceinline__ unsigned f2bf(float f) { unsigned u = __builtin_bit_cast(unsigned, f); return (u + 0x7fffu + ((u >> 16) & 1u)) >> 16; }
__device__ __forceinline__ unsigned pk2(float lo, float hi) { return f2bf(lo) | (f2bf(hi) << 16); }
__device__ __forceinline__ float bf2f(unsigned b) { return __builtin_bit_cast(float, b << 16); }
__device__ __forceinline__ float wave_sum(float v) {
#pragma unroll
    for (int o = 1; o < 64; o <<= 1) v += __shfl_xor(v, o);
    return v;
}
__device__ __forceinline__ float silu_f(float v) { return v / (1.f + __expf(-v)); }

struct Prm {
    const float *x, *c, *ctx, *cctx, *ada_w, *ada_b, *ln_g, *ln_b, *w_qkv, *w_o, *lam, *subln, *gw_in, *gwg_down, *gwg_up, *gbg, *gnorm, *gw_o, *rw, *rb, *mg, *mu, *md;
    float* out; unsigned char* ws;
    int ph_lo, ph_hi, li, pad;
};
__device__ __forceinline__ void ld_row_f32(const float* p, int lane, f32x4 (&v)[4]) {
#pragma unroll
    for (int j = 0; j < 4; ++j) v[j] = *(const f32x4*)(p + 4 * lane + 256 * j);
}
__device__ __forceinline__ void st_row_f32(float* p, int lane, const f32x4 (&v)[4]) {
#pragma unroll
    for (int j = 0; j < 4; ++j) *(f32x4*)(p + 4 * lane + 256 * j) = v[j];
}
__device__ __forceinline__ void ld_row_bf16(const bf16* p, int lane, f32x4 (&v)[4]) {
#pragma unroll
    for (int j = 0; j < 4; ++j) { const u32x2 u = *(const u32x2*)(p + 4 * lane + 256 * j); v[j] = (f32x4){bf2f(u.x & 0xffffu), bf2f(u.x >> 16), bf2f(u.y & 0xffffu), bf2f(u.y >> 16)}; }
}
__device__ __forceinline__ void st_row_bf16(bf16* p, int lane, const f32x4 (&v)[4]) {
#pragma unroll
    for (int j = 0; j < 4; ++j) { u32x2 u; u.x = pk2(v[j].x, v[j].y); u.y = pk2(v[j].z, v[j].w); *(u32x2*)(p + 4 * lane + 256 * j) = u; }
}
__device__ __forceinline__ void ln_row(f32x4 (&v)[4], const float* g, const float* b, int lane) {
    float s = 0.f;
#pragma unroll
    for (int j = 0; j < 4; ++j) s += (v[j].x + v[j].y) + (v[j].z + v[j].w);
    const float mean = wave_sum(s) * (1.f / DM); float q = 0.f;
#pragma unroll
    for (int j = 0; j < 4; ++j) { v[j] = v[j] - mean; q += (v[j].x * v[j].x + v[j].y * v[j].y) + (v[j].z * v[j].z + v[j].w * v[j].w); }
    const float rstd = 1.f / sqrtf(wave_sum(q) * (1.f / DM) + LN_EPS);
#pragma unroll
    for (int j = 0; j < 4; ++j) { const f32x4 gg = *(const f32x4*)(g + 4 * lane + 256 * j), bb = *(const f32x4*)(b + 4 * lane + 256 * j); v[j] = v[j] * rstd * gg + bb; }
}
__host__ __device__ __forceinline__ int gu_phys(int other, int sel) { return (other >> 4) * 32 + sel * 16 + (other & 15); }
__host__ __device__ __forceinline__ int perm16b(int L) { return (L & ~31) | (16 * ((L >> 2) & 1) + 4 * ((L >> 3) & 3) + (L & 3)); }
__host__ __device__ __forceinline__ int perm16b_inv(int P) { return (P & ~31) | (8 * ((P >> 2) & 3) + 4 * ((P >> 4) & 1) + (P & 3)); }
__device__ __forceinline__ unsigned pk4_fp8(float a, float b, float c, float d) { int w = 0; w = __builtin_amdgcn_cvt_pk_fp8_f32(a, b, w, false); w = __builtin_amdgcn_cvt_pk_fp8_f32(c, d, w, true); return (unsigned)w; }
constexpr float W8_SCALE = 64.f, W8_INV = 1.f / 64.f;
__device__ __forceinline__ void st_row_fp8(unsigned char* p, int lane, const f32x4 (&v)[4]) {
#pragma unroll
    for (int j = 0; j < 4; ++j) *(unsigned*)(p + 4 * lane + 256 * j) = pk4_fp8(v[j].x, v[j].y, v[j].z, v[j].w);
}
__device__ __forceinline__ void ld_row_fp8(const unsigned char* p, int lane, f32x4 (&v)[4]) {
#pragma unroll
    for (int j = 0; j < 4; ++j) { const int w = *(const int*)(p + 4 * lane + 256 * j); const f32x2 lo = __builtin_amdgcn_cvt_pk_f32_fp8(w, false), hi = __builtin_amdgcn_cvt_pk_f32_fp8(w, true); v[j] = (f32x4){lo.x, lo.y, hi.x, hi.y}; }
}
#define GAS __attribute__((address_space(1)))
#define LAS __attribute__((address_space(3)))
constexpr int NWAVES = 8, NTHR = NWAVES * 64;
constexpr int RING_BYTES = 131072, LDS_BYTES = 147456, LDSCTL_OFF = LDS_BYTES - 1024, MISC_OFF = LDSCTL_OFF + 320;
constexpr int LDSX_OFF = RING_BYTES + 1024;
#define LDS_WAIT() asm volatile("s_waitcnt lgkmcnt(0)" ::: "memory")
#define VM_WAIT() asm volatile("s_waitcnt vmcnt(0)" ::: "memory")

struct Frame {
    unsigned char* lds;
    unsigned* ctl;
    int tid, lane, wave, G, bid;
};

template <int MODE>
__device__ __forceinline__ void p0_transpose_item(const float* W, int K, int N, bf16* WT, int row_off, float* scr, int item, int lane) {
    const int nblk = N / 32, kb = item / nblk, nb = item % nblk, k0 = 64 * kb, n0 = 32 * nb;
    { f32x4 t[8];
#pragma unroll
        for (int i = 0; i < 8; ++i) t[i] = *(const f32x4*)(W + (size_t)(k0 + 8 * i + (lane >> 3)) * N + n0 + 4 * (lane & 7));
#pragma unroll
        for (int i = 0; i < 8; ++i) { float* d = scr + (8 * i + (lane >> 3)) * 33 + 4 * (lane & 7); d[0] = t[i].x; d[1] = t[i].y; d[2] = t[i].z; d[3] = t[i].w; } }
    LDS_WAIT(); asm volatile("" ::: "memory");
    const int c = lane & 7;
#pragma unroll
    for (int j = 0; j < 4; ++j) { const int n = (lane >> 3) + 8 * j; const float* s = scr + (8 * c) * 33 + n;
        u32x4 o; o.x = pk2(s[0 * 33], s[1 * 33]); o.y = pk2(s[2 * 33], s[3 * 33]); o.z = pk2(s[4 * 33], s[5 * 33]); o.w = pk2(s[6 * 33], s[7 * 33]);
        const int nl = n0 + n; const int pr = (MODE == 0) ? (row_off + nl) : (MODE == 3) ? (row_off + perm16b(nl)) : (row_off + gu_phys(nl, MODE - 1));
        *(u32x4*)(WT + (size_t)pr * K + k0 + 8 * c) = o; }
    LDS_WAIT(); asm volatile("" ::: "memory");
}
template <int MODE>
__device__ __forceinline__ void p0_transpose_item8(const float* W, int K, int N, unsigned char* WT, float* scr, int item, int lane) {
    const int nblk = N / 32, kb = item / nblk, nb = item % nblk, k0 = 64 * kb, n0 = 32 * nb;
    { f32x4 t[8];
#pragma unroll
        for (int i = 0; i < 8; ++i) t[i] = *(const f32x4*)(W + (size_t)(k0 + 8 * i + (lane >> 3)) * N + n0 + 4 * (lane & 7));
#pragma unroll
        for (int i = 0; i < 8; ++i) { float* d = scr + (8 * i + (lane >> 3)) * 33 + 4 * (lane & 7); d[0] = t[i].x; d[1] = t[i].y; d[2] = t[i].z; d[3] = t[i].w; } }
    LDS_WAIT(); asm volatile("" ::: "memory");
    const int c = lane & 7;
#pragma unroll
    for (int j = 0; j < 4; ++j) { const int n = (lane >> 3) + 8 * j; const float* s = scr + (8 * c) * 33 + n;
        u32x2 o; o.x = pk4_fp8(s[0 * 33] * W8_SCALE, s[1 * 33] * W8_SCALE, s[2 * 33] * W8_SCALE, s[3 * 33] * W8_SCALE); o.y = pk4_fp8(s[4 * 33] * W8_SCALE, s[5 * 33] * W8_SCALE, s[6 * 33] * W8_SCALE, s[7 * 33] * W8_SCALE);
        const int nl = n0 + n; const int pr = (MODE == 3) ? perm16b(nl) : (MODE == 0) ? nl : gu_phys(nl, MODE - 1);
        *(u32x2*)(WT + (size_t)pr * K + k0 + 8 * c) = o; }
    LDS_WAIT(); asm volatile("" ::: "memory");
}
__device__ __forceinline__ void phase_prologue(const Frame& F, const Prm& p) {
    float* sil = (float*)F.lds;
    for (int i = F.tid; i < 9 * 1024; i += NTHR) { const int r = i >> 10, k = i & 1023; const float v = (r < 8) ? p.c[r * 1024 + k] : p.cctx[k]; sil[i] = silu_f(v); }
    __syncthreads();
    float* MOD = (float*)(p.ws + WS_MOD);
    if (F.bid < 192) {
        const int layer = F.bid / 96, n = (F.bid % 96) * 64 + F.lane; const float* W = p.ada_w + (size_t)layer * 1024 * 6144 + n;
        float acc[9];
#pragma unroll
        for (int r = 0; r < 9; ++r) acc[r] = 0.f;
        const int kb = F.wave * 128;
#pragma unroll 4
        for (int k = kb; k < kb + 128; k += 4) {
            const float w0 = W[(size_t)k * 6144], w1 = W[(size_t)(k + 1) * 6144], w2 = W[(size_t)(k + 2) * 6144], w3 = W[(size_t)(k + 3) * 6144];
#pragma unroll
            for (int r = 0; r < 9; ++r) { const f32x4 s = *(const f32x4*)(sil + r * 1024 + k); acc[r] += s.x * w0 + s.y * w1 + s.z * w2 + s.w * w3; }
        }
        float* red = (float*)(F.lds + 36864 + 8 * 8704);
#pragma unroll
        for (int r = 0; r < 9; ++r) red[(F.wave * 9 + r) * 64 + F.lane] = acc[r];
        __syncthreads();
        if (F.wave == 0) { const float bb = p.ada_b[layer * 6144 + n];
#pragma unroll
            for (int r = 0; r < 9; ++r) { float t = bb;
#pragma unroll
                for (int w = 0; w < 8; ++w) t += red[(w * 9 + r) * 64 + F.lane];
                MOD[(layer * 9 + r) * 6144 + n] = t; } }
    }
    float* misc = (float*)(p.ws + WS_MISC);
    if (F.bid == 255 % F.G && F.wave == 1) {
        const float a = wave_sum(p.lam[F.lane] * p.lam[64 + F.lane]), b = wave_sum(p.lam[128 + F.lane] * p.lam[192 + F.lane]);
        if (F.lane == 0) misc[0] = __expf(a) - __expf(b) + LAMBDA_INIT0;
        for (int i = F.lane; i < 1024; i += 64) { const int pos = i >> 4, f = i & 15; const float inv = powf(10000.f, -(float)f / 16.f); const float ang = (float)pos * inv;
            misc[1024 + 2 * i] = cosf(ang); misc[1024 + 2 * i + 1] = sinf(ang); }
    }
    float* scr = (float*)(F.lds + 36864 + F.wave * 8704);
    const int gw = F.bid * NWAVES + F.wave, NGW = F.G * NWAVES;
    constexpr int I_QKV = 16 * 96, I_SQ = 16 * 32, I_G = 16 * 16, I_D = 8 * 32;
    constexpr int I_MOE = 2 * I_G + I_D;
    constexpr int NITEMS = 2 * I_QKV + 2 * I_SQ + 32 * I_MOE;
    bf16* ws16 = (bf16*)p.ws;
    for (int it = gw; it < NITEMS; it += NGW) {
        int r = it;
        if (r < I_QKV) { if ((r % 96) < 64) p0_transpose_item8<0>(p.w_qkv, 1024, 3072, p.ws + WS_WQKV, scr, r, F.lane); else p0_transpose_item8<3>(p.w_qkv, 1024, 3072, p.ws + WS_WQKV, scr, r, F.lane); continue; } r -= I_QKV;
        if (r < I_QKV) { p0_transpose_item8<3>(p.gw_in, 1024, 3072, p.ws + WS_WIN, scr, r, F.lane); continue; } r -= I_QKV;
        if (r < I_SQ) { p0_transpose_item8<3>(p.w_o, 1024, 1024, p.ws + WS_WO, scr, r, F.lane); continue; } r -= I_SQ;
        if (r < I_SQ) { p0_transpose_item8<3>(p.gw_o, 1024, 1024, p.ws + WS_WGO, scr, r, F.lane); continue; } r -= I_SQ;
        const int le = r / I_MOE, layer = le >> 4, e = le & 15; r -= le * I_MOE;
        unsigned char* GU = p.ws + (layer ? WS_GU1 : WS_GU0) + (size_t)e * 1024 * 1024; unsigned char* DN = p.ws + (layer ? WS_DN1 : WS_DN0) + (size_t)e * 1024 * 512;
        if (r < I_G) { p0_transpose_item8<1>(p.mg + (size_t)le * 1024 * 512, 1024, 512, GU, scr, r, F.lane); continue; } r -= I_G;
        if (r < I_G) { p0_transpose_item8<2>(p.mu + (size_t)le * 1024 * 512, 1024, 512, GU, scr, r, F.lane); continue; } r -= I_G;
        p0_transpose_item8<3>(p.md + (size_t)le * 512 * 1024, 512, 1024, DN, scr, r, F.lane);
    }
    (void)ws16;
    unsigned char* WIN = p.ws + WS_WIN;
    for (int i = gw * 64 + F.lane; i < 32 * 256; i += NGW * 64) { const int rr = i >> 8, k = (i & 255) * 4, dir = rr >> 4, j = rr & 15; const float* s = p.gwg_down + (size_t)dir * 1024 * 16 + j;
        *(unsigned*)(WIN + (size_t)(3072 + rr) * 1024 + k) = pk4_fp8(s[(size_t)k * 16] * W8_SCALE, s[(size_t)(k + 1) * 16] * W8_SCALE, s[(size_t)(k + 2) * 16] * W8_SCALE, s[(size_t)(k + 3) * 16] * W8_SCALE); }
    for (int i = gw * 64 + F.lane; i < 224 * 1024 / 16; i += NGW * 64) *(u32x4*)(WIN + (size_t)3104 * 1024 + (size_t)i * 16) = (u32x4){0u, 0u, 0u, 0u};
}

__device__ __forceinline__ void phase_modulate0(const Frame& F, const Prm& p) {
    const float* MOD = (const float*)(p.ws + WS_MOD); unsigned char* H = p.ws + WS_H;
    const int gw = F.bid * NWAVES + F.wave, NGW = F.G * NWAVES, per = (NTOK + NGW - 1) / NGW;
    int curmod = -1; f32x4 sh[4], sc[4];
    const int t0 = gw * per, t1 = min(NTOK, (gw + 1) * per);
    f32x4 v[4], vn[4];
    if (t0 < t1) ld_row_f32(t0 < NLAT ? p.x + (size_t)t0 * DM : p.ctx + (size_t)(t0 - NLAT) * DM, F.lane, v);
    for (int tok = t0; tok < t1; ++tok) {
        if (tok + 1 < t1) ld_row_f32(tok + 1 < NLAT ? p.x + (size_t)(tok + 1) * DM : p.ctx + (size_t)(tok + 1 - NLAT) * DM, F.lane, vn);
        const int mr = tok < NLAT ? tok / SEQ : 8;
        if (mr != curmod) { curmod = mr; ld_row_f32(MOD + mr * 6144, F.lane, sh); ld_row_f32(MOD + mr * 6144 + 1024, F.lane, sc); }
#pragma unroll
        for (int j = 0; j < 4; ++j) v[j] = v[j] * (1.f + sc[j]) + sh[j];
        st_row_fp8(H + (size_t)tok * DM, F.lane, v);
#pragma unroll
        for (int j = 0; j < 4; ++j) v[j] = vn[j];
    }
}

__device__ __forceinline__ void phase_ln_route(const Frame& F, const Prm& p, int layer) {
    const int nrows = layer ? NLAT : NTOK;
    const float* MOD = (const float*)(p.ws + WS_MOD) + layer * 9 * 6144;
    const bf16* Y = (const bf16*)(p.ws + WS_Y); unsigned char* HF = p.ws + WS_H;
    bf16* XB = (bf16*)(p.ws + WS_XB);
    int* LIST = (int*)(p.ws + WS_LIST); int* TOKR = (int*)(p.ws + WS_TOKR);
    unsigned* CNT = F.ctl + CW_CNT + layer * 16;
    float* WrT = (float*)F.lds;
    int* rec = (int*)(F.lds + 65536);
    unsigned* lcnt = (unsigned*)(F.lds + 65536 + 8192); unsigned* lbase = lcnt + 16;
    for (int i = F.tid; i < 16 * 1024; i += NTHR) { const int k = i >> 4, e = i & 15; WrT[e * 1024 + k] = p.rw[i]; }
    if (F.tid < 16) lcnt[F.tid] = 0u;
    __syncthreads();
    const int per_wg = (nrows + F.G - 1) / F.G, per_w = (per_wg + NWAVES - 1) / NWAVES;
    const int row_lo = F.bid * per_wg, row_hi = min(nrows, row_lo + per_wg);
    const float* lng = p.ln_g + (layer * 2 + 0) * DM; const float* lnb = p.ln_b + (layer * 2 + 0) * DM;
    float rb[16];
#pragma unroll
    for (int e = 0; e < 16; ++e) rb[e] = p.rb[e];
    int curmod = -1; f32x4 gm[4], shf[4], scf[4];
    f32x4 v[4], y[4], vn[4], yn[4];
#define LNR_LOAD(tok_, V, Yv) do { if (layer) ld_row_bf16(XB + (size_t)(tok_) * DM, F.lane, V); else ld_row_f32((tok_) < NLAT ? p.x + (size_t)(tok_) * DM : p.ctx + (size_t)((tok_) - NLAT) * DM, F.lane, V); \
        ld_row_bf16(Y + (size_t)(tok_) * DM, F.lane, Yv); } while (0)
    if (row_lo + F.wave * per_w < row_hi) LNR_LOAD(row_lo + F.wave * per_w, v, y);
    for (int i = 0; i < per_w; ++i) {
        const int lr = F.wave * per_w + i, tok = row_lo + lr; if (tok >= row_hi) break;
        if (i + 1 < per_w && tok + 1 < row_hi) LNR_LOAD(tok + 1, vn, yn);
        const int mr = tok < NLAT ? tok / SEQ : 8;
        if (mr != curmod) { curmod = mr; ld_row_f32(MOD + mr * 6144 + 2048, F.lane, gm); ld_row_f32(MOD + mr * 6144 + 3072, F.lane, shf); ld_row_f32(MOD + mr * 6144 + 4096, F.lane, scf); }
        bf16* xdst = XB + (size_t)tok * DM;
#pragma unroll
        for (int j = 0; j < 4; ++j) v[j] = ALPHA * v[j] + gm[j] * y[j];
        ln_row(v, lng, lnb, F.lane);
        st_row_bf16(xdst, F.lane, v);
#pragma unroll
        for (int j = 0; j < 4; ++j) v[j] = v[j] * (1.f + scf[j]) + shf[j];
        st_row_fp8(HF + (size_t)tok * DM, F.lane, v);
        float part[16];
#pragma unroll
        for (int e = 0; e < 16; ++e) { float s = 0.f;
#pragma unroll
            for (int j = 0; j < 4; ++j) { const f32x4 w = *(const f32x4*)(WrT + e * 1024 + 4 * F.lane + 256 * j); s += (v[j].x * w.x + v[j].y * w.y) + (v[j].z * w.z + v[j].w * w.w); }
            part[e] = s; }
        {
#pragma unroll
            for (int e = 0; e < 8; ++e) { const bool up = (F.lane & 32) != 0; const float keep = up ? part[e + 8] : part[e], send = up ? part[e] : part[e + 8]; part[e] = keep + __shfl_xor(send, 32); }
#pragma unroll
            for (int e = 0; e < 4; ++e) { const bool up = (F.lane & 16) != 0; const float keep = up ? part[e + 4] : part[e], send = up ? part[e] : part[e + 4]; part[e] = keep + __shfl_xor(send, 16); }
#pragma unroll
            for (int e = 0; e < 2; ++e) { const bool up = (F.lane & 8) != 0; const float keep = up ? part[e + 2] : part[e], send = up ? part[e] : part[e + 2]; part[e] = keep + __shfl_xor(send, 8); }
            { const bool up = (F.lane & 4) != 0; const float keep = up ? part[1] : part[0], send = up ? part[0] : part[1]; part[0] = keep + __shfl_xor(send, 4); }
            part[0] += __shfl_xor(part[0], 2); part[0] += __shfl_xor(part[0], 1);
        }
        float aff[16], sel[16];
#pragma unroll
        for (int e = 0; e < 16; ++e) { const int src = ((e >> 3) & 1) * 32 + ((e >> 2) & 1) * 16 + ((e >> 1) & 1) * 8 + (e & 1) * 4; const float lg = __shfl(part[0], src); aff[e] = 1.f / (1.f + __expf(-lg)); sel[e] = aff[e] + rb[e]; }
        int bg = 0; float bgs = -3.0e38f;
#pragma unroll
        for (int g = 0; g < 4; ++g) { float m1 = -3.0e38f, m2 = -3.0e38f;
#pragma unroll
            for (int k = 0; k < 4; ++k) { const float s = sel[4 * g + k]; if (s > m1) { m2 = m1; m1 = s; } else if (s > m2) m2 = s; }
            const float gs = m1 + m2; if (gs > bgs) { bgs = gs; bg = g; } }
        int i1 = 0, i2 = 0; float s1 = -3.0e38f, s2 = -3.0e38f, a1 = 0.f, a2 = 0.f;
#pragma unroll
        for (int g = 0; g < 4; ++g) if (g == bg) {
#pragma unroll
            for (int k = 0; k < 4; ++k) { const float s = sel[4 * g + k], a = aff[4 * g + k];
                if (s > s1) { s2 = s1; i2 = i1; a2 = a1; s1 = s; i1 = 4 * g + k; a1 = a; } else if (s > s2) { s2 = s; i2 = 4 * g + k; a2 = a; } } }
        const float wsum = a1 + a2, w1 = a1 / wsum, w2 = a2 / wsum;
        if (F.lane == 0) { const unsigned l1 = atomicAdd(&lcnt[i1], 1u), l2 = atomicAdd(&lcnt[i2], 1u);
            rec[lr * 6 + 0] = i1; rec[lr * 6 + 1] = i2; rec[lr * 6 + 2] = (int)l1; rec[lr * 6 + 3] = (int)l2; rec[lr * 6 + 4] = __float_as_int(w1); rec[lr * 6 + 5] = __float_as_int(w2); }
#pragma unroll
        for (int j = 0; j < 4; ++j) { v[j] = vn[j]; y[j] = yn[j]; }
    }
#undef LNR_LOAD
    __syncthreads();
    if (F.tid < 16) lbase[F.tid] = __hip_atomic_fetch_add(&CNT[F.tid], lcnt[F.tid], __ATOMIC_RELAXED, __HIP_MEMORY_SCOPE_AGENT);
    __syncthreads();
    for (int lr = F.tid; lr < row_hi - row_lo; lr += NTHR) { const int tok = row_lo + lr;
        const int e0 = rec[lr * 6], e1 = rec[lr * 6 + 1]; const int p0 = (int)lbase[e0] + rec[lr * 6 + 2], p1 = (int)lbase[e1] + rec[lr * 6 + 3];
        LIST[e0 * NTOK + p0] = tok; LIST[e1 * NTOK + p1] = tok;
        int* tr = TOKR + (size_t)tok * 8; tr[0] = e0; tr[1] = p0; tr[2] = e1; tr[3] = p1; tr[4] = rec[lr * 6 + 4]; tr[5] = rec[lr * 6 + 5]; }
    __syncthreads();
}

__device__ __forceinline__ void pad_bases(const unsigned* cnt, int (&pb)[17]) {
    int acc = 0;
#pragma unroll
    for (int e = 0; e < 16; ++e) { pb[e] = acc; const int c = (int)__hip_atomic_load(cnt + e, __ATOMIC_RELAXED, __HIP_MEMORY_SCOPE_AGENT); acc += (c + 255) & ~255; }
    pb[16] = acc;
}

__device__ __forceinline__ void phase_moe_combine(const Frame& F, const Prm& p, int layer) {
    const int nrows = layer ? NLAT : NTOK;
    const float* MOD = (const float*)(p.ws + WS_MOD) + layer * 9 * 6144; const float* MOD1 = (const float*)(p.ws + WS_MOD) + 9 * 6144;
    const unsigned char* YM = p.ws + WS_YM;   unsigned char* H = p.ws + WS_H;   bf16* XB = (bf16*)(p.ws + WS_XB); const int* TOKR = (const int*)(p.ws + WS_TOKR);
    int pb[17]; pad_bases(F.ctl + CW_CNT + layer * 16, pb);
    int* pbl = (int*)F.lds; if (F.tid < 17) { int v = 0;
#pragma unroll
        for (int e = 0; e < 17; ++e) if (e == F.tid) v = pb[e];
        pbl[F.tid] = v; }
    __syncthreads();
    const float* lng = p.ln_g + (layer * 2 + 1) * DM; const float* lnb = p.ln_b + (layer * 2 + 1) * DM;
    const int gw = F.bid * NWAVES + F.wave, NGW = F.G * NWAVES, per = (nrows + NGW - 1) / NGW;
    int curmod = -1; f32x4 gf[4], sh1[4], sc1[4];
    typedef int i32x4r __attribute__((ext_vector_type(4)));
    const int t0 = gw * per, t1 = min(nrows, (gw + 1) * per);
    i32x4r ra = {0, 0, 0, 0}, rb = {0, 0, 0, 0}, rc = {0, 0, 0, 0}; f32x2 wa = {0.f, 0.f}, wb = {0.f, 0.f}, wc = {0.f, 0.f};
#define MC_REC(tok_, R, W) do { const int* tr_ = TOKR + (size_t)(tok_) * 8; R = *(const i32x4r*)tr_; W = *(const f32x2*)(tr_ + 4); } while (0)
#define MC_ROWS(tok_, R, V, A, B) do { ld_row_bf16(XB + (size_t)(tok_) * DM, F.lane, V); ld_row_fp8(YM + (size_t)(pbl[R.x] + R.y) * DM, F.lane, A); ld_row_fp8(YM + (size_t)(pbl[R.z] + R.w) * DM, F.lane, B); } while (0)
    f32x4 v[4], a[4], b[4], vn[4], an[4], bn[4];
    if (t0 < t1) { MC_REC(t0, ra, wa); if (t0 + 1 < t1) MC_REC(t0 + 1, rb, wb); MC_ROWS(t0, ra, v, a, b); }
    for (int tok = t0; tok < t1; ++tok) {
        if (tok + 1 < t1) MC_ROWS(tok + 1, rb, vn, an, bn);
        if (tok + 2 < t1) MC_REC(tok + 2, rc, wc);
        const int mr = tok < NLAT ? tok / SEQ : 8;
        if (mr != curmod) { curmod = mr; ld_row_f32(MOD + mr * 6144 + 5120, F.lane, gf); if (!layer) { ld_row_f32(MOD1 + mr * 6144, F.lane, sh1); ld_row_f32(MOD1 + mr * 6144 + 1024, F.lane, sc1); } }
        const float w0 = wa.x, w1 = wa.y;
        bf16* xp = XB + (size_t)tok * DM;
#pragma unroll
        for (int j = 0; j < 4; ++j) v[j] = ALPHA * v[j] + gf[j] * (w0 * a[j] + w1 * b[j]);
        ln_row(v, lng, lnb, F.lane);
        if (layer) st_row_f32(p.out + (size_t)tok * DM, F.lane, v); else st_row_bf16(xp, F.lane, v);
        if (!layer) {
#pragma unroll
            for (int j = 0; j < 4; ++j) v[j] = v[j] * (1.f + sc1[j]) + sh1[j];
            st_row_fp8(H + (size_t)tok * DM, F.lane, v);
        }
#pragma unroll
        for (int j = 0; j < 4; ++j) { v[j] = vn[j]; a[j] = an[j]; b[j] = bn[j]; }
        ra = rb; wa = wb; rb = rc; wb = wc;
    }
#undef MC_REC
#undef MC_ROWS
}

__device__ __forceinline__ void phase_gla_prep(const Frame& F, const Prm& p) {
    typedef short bf16x8v __attribute__((ext_vector_type(8))); typedef float f32x16v __attribute__((ext_vector_type(16)));
    const bf16* QR = (const bf16*)(p.ws + WS_QR); const bf16* KR = (const bf16*)(p.ws + WS_KR); const float* ZZ = (const float*)(p.ws + WS_ZZ);
    bf16* QT = (bf16*)(p.ws + WS_QT); bf16* KT = (bf16*)(p.ws + WS_KT); float* DEC = (float*)(p.ws + WS_DEC);
    const int gw = F.bid * NWAVES + F.wave, NGW = F.G * NWAVES, r = F.lane & 31, hh = F.lane >> 5;
    for (int task = gw; task < 2 * NCHUNK * 8; task += NGW) {
        const int dh = task & 7, chunk = (task >> 3) % NCHUNK, dir = __builtin_amdgcn_readfirstlane(task / (8 * NCHUNK));
        const int tok0 = chunk * 64;
        bf16x8v af[2], bfr[2];
#pragma unroll
        for (int tb = 0; tb < 2; ++tb) { const float* zp = ZZ + (size_t)(tok0 + 32 * tb + r) * 32 + dir * 16 + 8 * hh; const f32x4 z0 = *(const f32x4*)zp, z1 = *(const f32x4*)(zp + 4);
            u32x4 w; w.x = pk2(z0.x, z0.y); w.y = pk2(z0.z, z0.w); w.z = pk2(z1.x, z1.y); w.w = pk2(z1.z, z1.w); af[tb] = __builtin_bit_cast(bf16x8v, w); }
        float bgv[2];
#pragma unroll
        for (int cb = 0; cb < 2; ++cb) { const float* wp = p.gwg_up + (size_t)dir * 16 * 512 + (size_t)(8 * hh) * 512 + dh * 64 + 2 * r + cb; float wv[8];
#pragma unroll
            for (int i = 0; i < 8; ++i) wv[i] = wp[(size_t)i * 512];
            u32x4 w; w.x = pk2(wv[0], wv[1]); w.y = pk2(wv[2], wv[3]); w.z = pk2(wv[4], wv[5]); w.w = pk2(wv[6], wv[7]); bfr[cb] = __builtin_bit_cast(bf16x8v, w);
            bgv[cb] = p.gbg[dir * 512 + dh * 64 + 2 * r + cb]; }
        f32x16v Z[2][2];
#pragma unroll
        for (int tb = 0; tb < 2; ++tb)
#pragma unroll
            for (int cb = 0; cb < 2; ++cb) { const f32x16v zero = {}; Z[tb][cb] = __builtin_amdgcn_mfma_f32_32x32x16_bf16(af[tb], bfr[cb], zero, 0, 0, 0); }
#pragma unroll
        for (int tb = 0; tb < 2; ++tb)
#pragma unroll
            for (int cb = 0; cb < 2; ++cb)
#pragma unroll
                for (int i = 0; i < 16; ++i) { const float z = Z[tb][cb][i] + bgv[cb]; Z[tb][cb][i] = (fminf(z, 0.f) - __logf(1.f + __expf(-fabsf(z)))) * (1.f / 16.f); }
        float tot[2];
#pragma unroll
        for (int cb = 0; cb < 2; ++cb) {
            float T[2][4], PT[2][4];
            if (!dir) {
#pragma unroll
                for (int tb = 0; tb < 2; ++tb)
#pragma unroll
                    for (int gi = 0; gi < 4; ++gi) { float run = 0.f;
#pragma unroll
                        for (int w = 0; w < 4; ++w) { run += Z[tb][cb][4 * gi + w]; Z[tb][cb][4 * gi + w] = run; }
                        T[tb][gi] = run; }
            } else {
#pragma unroll
                for (int tb = 0; tb < 2; ++tb)
#pragma unroll
                    for (int gi = 0; gi < 4; ++gi) { float run = 0.f;
#pragma unroll
                        for (int w = 3; w >= 0; --w) { run += Z[tb][cb][4 * gi + w]; Z[tb][cb][4 * gi + w] = run; }
                        T[tb][gi] = run; }
            }
#pragma unroll
            for (int tb = 0; tb < 2; ++tb)
#pragma unroll
                for (int gi = 0; gi < 4; ++gi) PT[tb][gi] = __shfl_xor(T[tb][gi], 32);
            float running = 0.f;
            if (!dir) {
#pragma unroll
                for (int tb = 0; tb < 2; ++tb)
#pragma unroll
                    for (int gi = 0; gi < 4; ++gi) { const float first = hh ? PT[tb][gi] : T[tb][gi], second = hh ? T[tb][gi] : PT[tb][gi];
                        const float mine = hh ? running + first : running; running += first + second;
#pragma unroll
                        for (int w = 0; w < 4; ++w) Z[tb][cb][4 * gi + w] += mine; }
            } else {
#pragma unroll
                for (int tb = 1; tb >= 0; --tb)
#pragma unroll
                    for (int gi = 3; gi >= 0; --gi) { const float first = hh ? T[tb][gi] : PT[tb][gi], second = hh ? PT[tb][gi] : T[tb][gi];
                        const float mine = hh ? running : running + first; running += first + second;
#pragma unroll
                        for (int w = 0; w < 4; ++w) Z[tb][cb][4 * gi + w] += mine; }
            }
            tot[cb] = running;
        }
        if (hh == 0) {
#pragma unroll
            for (int cb = 0; cb < 2; ++cb) DEC[((size_t)dir * NCHUNK + chunk) * 512 + dh * 64 + 2 * r + cb] = __expf(tot[cb]);
        }
        const bf16* qi = QR + ((size_t)dh * NTOK + tok0) * 64 + 2 * r; const bf16* ki = KR + ((size_t)dh * NTOK + tok0) * 64 + 2 * r;
        bf16* qo = QT + (((size_t)dir * 8 + dh) * NTOK + tok0) * 64 + 2 * r; bf16* ko = KT + (((size_t)dir * 8 + dh) * NTOK + tok0) * 64 + 2 * r;
#pragma unroll
        for (int tb = 0; tb < 2; ++tb) {
            unsigned qv[16], kv[16];
#pragma unroll
            for (int i = 0; i < 16; ++i) { const int t = 32 * tb + (i & 3) + 8 * (i >> 2) + 4 * hh; qv[i] = *(const unsigned*)(qi + (size_t)t * 64); kv[i] = *(const unsigned*)(ki + (size_t)t * 64); }
#pragma unroll
            for (int i = 0; i < 16; ++i) { const int t = 32 * tb + (i & 3) + 8 * (i >> 2) + 4 * hh;
                const float e0 = __expf(Z[tb][0][i]), e1 = __expf(Z[tb][1][i]), i0 = __builtin_amdgcn_rcpf(e0), i1 = __builtin_amdgcn_rcpf(e1);
                *(unsigned*)(qo + (size_t)t * 64) = pk2(bf2f(qv[i] & 0xffffu) * e0, bf2f(qv[i] >> 16) * e1);
                *(unsigned*)(ko + (size_t)t * 64) = pk2(bf2f(kv[i] & 0xffffu) * i0, bf2f(kv[i] >> 16) * i1); }
        }
    }
}

__device__ __forceinline__ void phase_gla_post(const Frame& F, const Prm& p) {
    const bf16* OF = (const bf16*)p.out; const bf16* OB = (const bf16*)((const unsigned char*)p.out + OUT_OGB); const bf16* R = (const bf16*)(p.ws + WS_R); unsigned char* A2 = p.ws + WS_A2B;
    const f32x4 ng = *(const f32x4*)(p.gnorm + 4 * F.lane);
    const int gw = F.bid * NWAVES + F.wave, NGW = F.G * NWAVES;
    f32x4 a[4], b[4], r[4], an[4], bn[4], rn[4];
    if (gw < NLAT) { ld_row_bf16(OF + (size_t)gw * DM, F.lane, a); ld_row_bf16(OB + (size_t)gw * DM, F.lane, b); ld_row_bf16(R + (size_t)gw * DM, F.lane, r); }
    for (int tok = gw; tok < NLAT; tok += NGW) {
        if (tok + NGW < NLAT) { ld_row_bf16(OF + (size_t)(tok + NGW) * DM, F.lane, an); ld_row_bf16(OB + (size_t)(tok + NGW) * DM, F.lane, bn); ld_row_bf16(R + (size_t)(tok + NGW) * DM, F.lane, rn); }
#pragma unroll
        for (int j = 0; j < 4; ++j) {
            const f32x4 o = a[j] + b[j]; const float q = wave_sum((o.x * o.x + o.y * o.y) + (o.z * o.z + o.w * o.w));
            const float rs = 1.f / sqrtf(q * (1.f / 256.f) + LN_EPS);
            a[j] = (f32x4){o.x * rs * ng.x * silu_f(r[j].x), o.y * rs * ng.y * silu_f(r[j].y), o.z * rs * ng.z * silu_f(r[j].z), o.w * rs * ng.w * silu_f(r[j].w)};
        }
        st_row_fp8(A2 + (size_t)tok * DM, F.lane, a);
#pragma unroll
        for (int j = 0; j < 4; ++j) { a[j] = an[j]; b[j] = bn[j]; r[j] = rn[j]; }
    }
}
namespace pg8 {
typedef short bf16x8 __attribute__((ext_vector_type(8)));
constexpr int BM = 256, BK = 64, HALF = 128, HTB = HALF * BK * 2, STAGE_BYTES = 8 * HTB, NXCD = 8, WGM = 8;
__host__ __device__ __forceinline__ int lds_byte(int r, int c) { const int st = (r >> 4) * 2 + (c >> 5), rr = r & 15, cc = c & 31, ob = rr * 64 + cc * 2; return st * 1024 + (ob ^ (((ob >> 9) & 1) << 5)); }
__host__ __device__ __forceinline__ void stage_rc(int b, int& R, int& C) { const int st = b / 1024, sb = b % 1024, swz = sb ^ (((sb >> 9) & 1) << 5); R = (st >> 1) * 16 + swz / 64; C = (st & 1) * 32 + (swz % 64) / 2; }
typedef float f32x2_t __attribute__((ext_vector_type(2))); typedef __bf16 bf16x2_t __attribute__((ext_vector_type(2)));
__device__ __forceinline__ unsigned cvt_pk_bf16(float lo, float hi) { f32x2_t v = {lo, hi}; bf16x2_t b = __builtin_convertvector(v, bf16x2_t); return __builtin_bit_cast(unsigned, b); }

struct Unit { int pm, pn; int row0; int e; int cnt; const bf16* Bt; };

struct DenseOrder {
    int nM, nN, nwg, G, c, K; const bf16* Bt;
    __device__ void init(int M, int N, int K_, const bf16* Bt_, int G_, int c_) { nM = M / BM; nN = N / BM; nwg = nM * nN; G = G_; c = c_; K = K_; Bt = Bt_; }
    __device__ bool next(int i, Unit& u) const {
        const long L = (long)i * G + c; if (L >= nwg) return false;
        int wgid = (int)L; { const int q = nwg / NXCD, r = nwg % NXCD, xcd = wgid % NXCD, off = wgid / NXCD; wgid = (xcd < r ? xcd * (q + 1) : r * (q + 1) + (xcd - r) * q) + off; }
        const int nig = WGM * nN, gid = wgid / nig, fm = gid * WGM, gsz = (nM - fm) < WGM ? (nM - fm) : WGM;
        u.pm = fm + ((wgid % nig) % gsz); u.pn = (wgid % nig) / gsz; u.row0 = u.pm * BM; u.e = 0; u.cnt = 0; u.Bt = Bt; return true;
    }
    __device__ __forceinline__ unsigned arow(const Unit& u, int r) const { return (unsigned)(u.row0 + r) * (unsigned)(K * 2); }
};
template <bool GATHER> struct MoeOrder {
    int cnt[16]; int nN, G, c, K; const bf16* Bt0; size_t bstride; const int* LIST;
    __device__ void init(const unsigned* cntw, int N, int K_, const bf16* Bt0_, const int* LIST_, int G_, int c_) {
#pragma unroll
        for (int e = 0; e < 16; ++e) cnt[e] = (int)__hip_atomic_load(cntw + e, __ATOMIC_RELAXED, __HIP_MEMORY_SCOPE_AGENT);
        nN = N / BM; G = G_; c = c_; K = K_; Bt0 = Bt0_; bstride = (size_t)N * K_; LIST = LIST_; }
    __device__ bool next(int i, Unit& u) const {
        int L = i * G + c, base = 0; bool found = false; u.pm = 0; u.pn = 0; u.row0 = 0; u.e = 0; u.cnt = 0; u.Bt = Bt0;
#pragma unroll
        for (int e = 0; e < 16; ++e) { const int mt = (cnt[e] + 255) >> 8, nu = mt * nN;
            if (!found) { if (L < nu) { found = true; u.e = e; u.cnt = cnt[e]; u.pm = L / nN; u.pn = L % nN; u.row0 = base + u.pm * BM; u.Bt = Bt0 + (size_t)e * bstride; } else { L -= nu; base += mt * BM; } } }
        return found;
    }
    __device__ __forceinline__ unsigned arow(const Unit& u, int r) const {
        if (GATHER) { const int li = u.pm * BM + r; int tok = 0; if (li < u.cnt) tok = LIST[u.e * NTOK + li];
            return (unsigned)tok * (unsigned)(K * 2); }
        return (unsigned)(u.row0 + r) * (unsigned)(K * 2);
    }
};

typedef f32x4 Acc[2][2][4][2];
__device__ __forceinline__ void st4bf(bf16* p, f32x4 v) { u32x2 w; w.x = cvt_pk_bf16(v.x, v.y); w.y = cvt_pk_bf16(v.z, v.w); *(u32x2*)p = w; }
__device__ __forceinline__ void st8bf(bf16* p, f32x4 a, f32x4 b) { u32x4 w; w.x = cvt_pk_bf16(a.x, a.y); w.y = cvt_pk_bf16(a.z, a.w); w.z = cvt_pk_bf16(b.x, b.y); w.w = cvt_pk_bf16(b.z, b.w); *(u32x4*)p = w; }

struct EpiQKV {
    bf16 *Q; const LAS float* rope; float wsc; unsigned* km;
    __device__ __forceinline__ void operator()(const Acc& acc, const Unit& u, int wr, int wc, int fr, int fq) const {
        const int reg = u.pn >> 2; bf16* O = Q + (size_t)reg * ((WS_K - WS_Q) / 2);
        if (reg == 2) { const int cbase = (u.pn & 3) * BM + wc * 32 + 8 * fq;
#pragma unroll
            for (int ai = 0; ai < 2; ++ai)
#pragma unroll
                for (int m = 0; m < 4; ++m) { bf16* rowp = O + (size_t)(u.row0 + ai * HALF + wr * 64 + m * 16 + fr) * DM + cbase;
#pragma unroll
                    for (int bj = 0; bj < 2; ++bj) st8bf(rowp + bj * HALF, acc[ai][bj][m][0] * wsc, acc[ai][bj][m][1] * wsc); }
            return; }
        const int cbase = (u.pn & 3) * BM + wc * 32 + 4 * fq;
        const bool dorope = (u.row0 < NLAT); const float sc = (reg == 0 ? C2 : 1.f) * wsc; float kn[2] = {0.f, 0.f};
#pragma unroll
        for (int ai = 0; ai < 2; ++ai)
#pragma unroll
            for (int m = 0; m < 4; ++m) { const int row = u.row0 + ai * HALF + wr * 64 + m * 16 + fr; bf16* rowp = O + (size_t)row * DM + cbase;
                f32x4 cs = {1.f, 1.f, 1.f, 1.f}, sn = {0.f, 0.f, 0.f, 0.f};
                if (dorope) { const int s = row & (SEQ - 1), pos = (wc & 1) ? (s & 63) : (s >> 6); const f32x4 t0 = *(const LAS f32x4*)(rope + (pos * 16 + 4 * fq) * 2), t1 = *(const LAS f32x4*)(rope + (pos * 16 + 4 * fq) * 2 + 4);
                    cs = (f32x4){t0.x, t0.z, t1.x, t1.z}; sn = (f32x4){t0.y, t0.w, t1.y, t1.w}; }
#pragma unroll
                for (int bj = 0; bj < 2; ++bj) { const f32x4 a0 = acc[ai][bj][m][0], a1 = acc[ai][bj][m][1];
                    const f32x4 o0 = (a0 * cs - a1 * sn) * sc, o1 = (a1 * cs + a0 * sn) * sc;
                    st4bf(rowp + bj * HALF, o0); st4bf(rowp + bj * HALF + 16, o1);
                    if (reg == 1) { const float ps = (o0.x * o0.x + o0.y * o0.y) + (o0.z * o0.z + o0.w * o0.w) + (o1.x * o1.x + o1.y * o1.y) + (o1.z * o1.z + o1.w * o1.w);
                        kn[bj] = fmaxf(kn[bj], ps); } } }
        if (reg == 1) {
            const int b = u.row0 < NLAT ? u.row0 / SEQ : (u.row0 - NLAT) / CTXL;
#pragma unroll
            for (int bj = 0; bj < 2; ++bj) { float v = kn[bj];
#pragma unroll
                for (int s = 1; s < 64; s <<= 1) v = fmaxf(v, __shfl_xor(v, s));
                if (fr == 0 && fq == 0) __hip_atomic_fetch_max(km + b * 16 + 4 * (u.pn & 3) + 2 * bj + (wc >> 1), __float_as_uint(8.f * v), __ATOMIC_RELAXED, __HIP_MEMORY_SCOPE_AGENT); } }
    }
};
struct EpiPlain {
    bf16* O; float sc;
    __device__ __forceinline__ void operator()(const Acc& acc, const Unit& u, int wr, int wc, int fr, int fq) const {
        const int cbase = u.pn * BM + wc * 32 + 8 * fq;
#pragma unroll
        for (int ai = 0; ai < 2; ++ai)
#pragma unroll
            for (int m = 0; m < 4; ++m) { bf16* rowp = O + (size_t)(u.row0 + ai * HALF + wr * 64 + m * 16 + fr) * DM + cbase;
#pragma unroll
                for (int bj = 0; bj < 2; ++bj) st8bf(rowp + bj * HALF, acc[ai][bj][m][0] * sc, acc[ai][bj][m][1] * sc); }
    }
};
struct EpiPlain8 {
    unsigned char* O; float sc;
    __device__ __forceinline__ void operator()(const Acc& acc, const Unit& u, int wr, int wc, int fr, int fq) const {
        const int cbase = u.pn * BM + wc * 32 + 8 * fq;
#pragma unroll
        for (int ai = 0; ai < 2; ++ai)
#pragma unroll
            for (int m = 0; m < 4; ++m) { unsigned char* rowp = O + (size_t)(u.row0 + ai * HALF + wr * 64 + m * 16 + fr) * DM + cbase;
#pragma unroll
                for (int bj = 0; bj < 2; ++bj) { const f32x4 a = acc[ai][bj][m][0] * sc, b = acc[ai][bj][m][1] * sc; u32x2 w; w.x = pk4_fp8(a.x, a.y, a.z, a.w); w.y = pk4_fp8(b.x, b.y, b.z, b.w); *(u32x2*)(rowp + bj * HALF) = w; } }
    }
};
struct EpiInproj {
    bf16 *QR, *KR, *V, *R; float* ZZ; float wsc;
    __device__ __forceinline__ void operator()(const Acc& acc, const Unit& u, int wr, int wc, int fr, int fq) const {
        const int pn = u.pn;
        if (pn == 12) { if (wc == 0) {
#pragma unroll
            for (int ai = 0; ai < 2; ++ai)
#pragma unroll
                for (int m = 0; m < 4; ++m) { float* rowp = ZZ + (size_t)(u.row0 + ai * HALF + wr * 64 + m * 16 + fr) * 32 + 4 * fq;
                    *(f32x4*)rowp = acc[ai][0][m][0] * wsc; *(f32x4*)(rowp + 16) = acc[ai][0][m][1] * wsc; } }
            return; }
        float sc = wsc;
        if (pn < 4) {
            bf16* O = pn < 2 ? QR : KR; if (pn < 2) sc = 0.08838834764831845f * wsc;
            const int cb = (pn & 1) * BM + wc * 32 + 8 * fq;
#pragma unroll
            for (int ai = 0; ai < 2; ++ai)
#pragma unroll
                for (int m = 0; m < 4; ++m) { const size_t row = (size_t)(u.row0 + ai * HALF + wr * 64 + m * 16 + fr);
#pragma unroll
                    for (int bj = 0; bj < 2; ++bj) { const int col = cb + bj * HALF; st8bf(O + ((size_t)(col >> 6) * NTOK + row) * 64 + (col & 63), acc[ai][bj][m][0] * sc, acc[ai][bj][m][1] * sc); } }
            return; }
        bf16* O; int c0;
        if (pn < 8) { O = V; c0 = (pn - 4) * BM; } else { O = R; c0 = (pn - 8) * BM; }
        const int cbase = c0 + wc * 32 + 8 * fq;
#pragma unroll
        for (int ai = 0; ai < 2; ++ai)
#pragma unroll
            for (int m = 0; m < 4; ++m) { bf16* rowp = O + (size_t)(u.row0 + ai * HALF + wr * 64 + m * 16 + fr) * DM + cbase;
#pragma unroll
                for (int bj = 0; bj < 2; ++bj) st8bf(rowp + bj * HALF, acc[ai][bj][m][0] * sc, acc[ai][bj][m][1] * sc); }
    }
};
struct EpiGateUp {
    unsigned char* ACT;
    __device__ __forceinline__ void operator()(const Acc& acc, const Unit& u, int wr, int wc, int fr, int fq) const {
        const int obase = (u.pn * BM + wc * 32) / 2 + 4 * fq;
#pragma unroll
        for (int ai = 0; ai < 2; ++ai)
#pragma unroll
            for (int m = 0; m < 4; ++m) { unsigned char* rowp = ACT + (size_t)(u.row0 + ai * HALF + wr * 64 + m * 16 + fr) * DEXP + obase;
#pragma unroll
                for (int bj = 0; bj < 2; ++bj) { const f32x4 g = acc[ai][bj][m][0] * W8_INV, up = acc[ai][bj][m][1] * W8_INV; f32x4 o;
#pragma unroll
                    for (int j = 0; j < 4; ++j) o[j] = g[j] * __builtin_amdgcn_rcpf(1.f + __expf(-g[j])) * up[j];
                    *(unsigned*)(rowp + bj * (HALF / 2)) = pk4_fp8(o[0], o[1], o[2], o[3]); } }
    }
};

typedef int i32x8 __attribute__((ext_vector_type(8)));
typedef int i32x4 __attribute__((ext_vector_type(4)));
__device__ __forceinline__ i32x8 cat8(bf16x8 lo, bf16x8 hi) { return __builtin_shufflevector(__builtin_bit_cast(i32x4, lo), __builtin_bit_cast(i32x4, hi), 0, 1, 2, 3, 4, 5, 6, 7); }
template <class Epi, class Sched, bool FP8 = false>
__device__ __forceinline__ void gemm_phase(unsigned char* ldsg, const bf16* A, int K, const Sched& S, const Epi& E) {
    LAS unsigned char* lds = (LAS unsigned char*)ldsg;
    const int tid = threadIdx.x, wid = __builtin_amdgcn_readfirstlane(tid >> 6), lane = tid & 63, wr = wid >> 2, wc = wid & 3, fr = lane & 15, fq = lane >> 4;
    const int nt = K / BK;
    int Rr[2]; unsigned colb[2], voffB[2];
#pragma unroll
    for (int i = 0; i < 2; ++i) { int R, C; stage_rc(tid * 16 + i * 8192, R, C); Rr[i] = R; colb[i] = (unsigned)C * 2u; voffB[i] = (unsigned)(R * K + C) * 2u; }
    const size_t kstep = (size_t)(BK * 2);
    const size_t hstep = (size_t)HALF * K * 2;
    const size_t tstep = 2 * hstep;
    const unsigned ldsw = (unsigned)wid * 1024u;
    const int aoff = lds_byte(wr * 64 + fr, fq * 8), boff = lds_byte(wc * 32 + fr, fq * 8);
#define PG8_SA(b, h) (((b) * 2 + (h)) * HTB)
#define PG8_SB(b, h) ((4 + (b) * 2 + (h)) * HTB)
#define PG8_STAGE(bufoff, gbase, voff) do { _Pragma("unroll") for (int _i = 0; _i < 2; ++_i) \
        __builtin_amdgcn_global_load_lds((const unsigned*)((const char*)(gbase) + (voff)[_i]), (LAS unsigned*)(lds + (bufoff) + ldsw + _i * 8192), 16, 0, 0); } while (0)
#define PG8_LDA(dst, b, h) do { if constexpr (FP8) { _Pragma("unroll") for (int m = 0; m < 4; ++m) dst##8[m] = cat8(*(const LAS bf16x8*)(lds + PG8_SA(b, h) + aoff + m * 2048), *(const LAS bf16x8*)(lds + PG8_SA(b, h) + aoff + m * 2048 + 1024)); } \
        else { _Pragma("unroll") for (int m = 0; m < 4; ++m) _Pragma("unroll") for (int k = 0; k < 2; ++k) dst[m][k] = *(const LAS bf16x8*)(lds + PG8_SA(b, h) + aoff + m * 2048 + k * 1024); } } while (0)
#define PG8_LDB(dst, b, h) do { if constexpr (FP8) { _Pragma("unroll") for (int n = 0; n < 2; ++n) dst##8[n] = cat8(*(const LAS bf16x8*)(lds + PG8_SB(b, h) + boff + n * 2048), *(const LAS bf16x8*)(lds + PG8_SB(b, h) + boff + n * 2048 + 1024)); } \
        else { _Pragma("unroll") for (int n = 0; n < 2; ++n) _Pragma("unroll") for (int k = 0; k < 2; ++k) dst[n][k] = *(const LAS bf16x8*)(lds + PG8_SB(b, h) + boff + n * 2048 + k * 1024); } } while (0)
#define PG8_MMA(ai, bj, At, Bt) do { __builtin_amdgcn_s_setprio(1); \
        if constexpr (FP8) { _Pragma("unroll") for (int m = 0; m < 4; ++m) _Pragma("unroll") for (int n = 0; n < 2; ++n) \
            asm volatile("v_mfma_scale_f32_16x16x128_f8f6f4 %0, %1, %2, %0, %3, %3 op_sel_hi:[0,0,0]" : "+v"(acc[ai][bj][m][n]) : "v"(Bt##8[n]), "v"(At##8[m]), "v"(sc8)); } \
        else { _Pragma("unroll") for (int m = 0; m < 4; ++m) _Pragma("unroll") for (int n = 0; n < 2; ++n) _Pragma("unroll") for (int k = 0; k < 2; ++k) \
            acc[ai][bj][m][n] = __builtin_amdgcn_mfma_f32_16x16x32_bf16(Bt[n][k], At[m][k], acc[ai][bj][m][n], 0, 0, 0); } \
        __builtin_amdgcn_s_setprio(0); } while (0)
#define PG8_WAIT_V(n) asm volatile("s_waitcnt vmcnt(" #n ")" ::: "memory")
#define PG8_WAIT_L(n) asm volatile("s_waitcnt lgkmcnt(" #n ")" ::: "memory")
#define PG8_BAR __builtin_amdgcn_s_barrier()
#define PG8_SCHED __builtin_amdgcn_sched_barrier(0)
    Unit cur, nxt; int ui = 0;
    if (!S.next(0, cur)) return;
    Acc acc;
#pragma unroll
    for (int a = 0; a < 2; ++a)
#pragma unroll
        for (int b = 0; b < 2; ++b)
#pragma unroll
            for (int m = 0; m < 4; ++m)
#pragma unroll
                for (int n = 0; n < 2; ++n) acc[a][b][m][n] = (f32x4){0.f, 0.f, 0.f, 0.f};
    const int sc8 = 0x7f7f7f7f;
    bf16x8 At[4][2], B0[2][2], B1[2][2]; i32x8 At8[4], B08[2], B18[2];
    unsigned aC0[2], aC1[2], aN0[2], aN1[2];
#pragma unroll
    for (int i = 0; i < 2; ++i) { aC0[i] = S.arow(cur, Rr[i]) + colb[i]; aC1[i] = S.arow(cur, HALF + Rr[i]) + colb[i]; }
    const char* Ab = (const char*)A;
    const char* cB = (const char*)cur.Bt + (size_t)cur.pn * tstep;
    PG8_STAGE(PG8_SB(0, 0), cB, voffB); PG8_STAGE(PG8_SB(0, 1), cB + hstep, voffB); PG8_STAGE(PG8_SA(0, 0), Ab, aC0); PG8_STAGE(PG8_SA(0, 1), Ab, aC1);
    if (wr == 1) PG8_BAR;
    PG8_WAIT_V(2); PG8_BAR;
    PG8_STAGE(PG8_SB(1, 0), cB + kstep, voffB); PG8_STAGE(PG8_SA(1, 0), Ab + kstep, aC0); PG8_STAGE(PG8_SB(1, 1), cB + hstep + kstep, voffB);
    PG8_WAIT_V(6); PG8_BAR;
    for (;;) {
        const bool has_next = S.next(ui + 1, nxt);
        if (has_next) {
#pragma unroll
            for (int i = 0; i < 2; ++i) { aN0[i] = S.arow(nxt, Rr[i]) + colb[i]; aN1[i] = S.arow(nxt, HALF + Rr[i]) + colb[i]; }
        } else {
#pragma unroll
            for (int i = 0; i < 2; ++i) { aN0[i] = aC0[i]; aN1[i] = aC1[i]; }
        }
        const char* nB = has_next ? (const char*)nxt.Bt + (size_t)nxt.pn * tstep : cB;
        for (int t = 0; t < nt; t += 2) {
            const bool last = (t == nt - 2);
            const char* a1 = Ab + (size_t)(t + 1) * kstep;
            const char* a2 = last ? Ab : Ab + (size_t)(t + 2) * kstep; const char* b2 = last ? nB : cB + (size_t)(t + 2) * kstep;
            const char* a3 = a2 + kstep; const char* b3 = b2 + kstep;
            unsigned x0[2], x1[2];
#pragma unroll
            for (int i = 0; i < 2; ++i) { x0[i] = last ? aN0[i] : aC0[i]; x1[i] = last ? aN1[i] : aC1[i]; }
            PG8_LDB(B0, 0, 0); PG8_LDB(B1, 0, 1); PG8_SCHED; PG8_LDA(At, 0, 0); PG8_STAGE(PG8_SA(1, 1), a1, aC1);
            PG8_WAIT_V(8); PG8_WAIT_L(0); PG8_BAR; PG8_MMA(0, 0, At, B0); PG8_MMA(0, 1, At, B1); PG8_BAR; PG8_SCHED;
            PG8_LDA(At, 0, 1); PG8_STAGE(PG8_SB(0, 0), b2, voffB); PG8_STAGE(PG8_SB(0, 1), b2 + hstep, voffB); PG8_STAGE(PG8_SA(0, 0), a2, x0);
            PG8_WAIT_V(8); PG8_WAIT_L(0); PG8_BAR; PG8_MMA(1, 0, At, B0); PG8_MMA(1, 1, At, B1); PG8_BAR; PG8_SCHED;
            PG8_LDB(B0, 1, 0); PG8_LDB(B1, 1, 1); PG8_SCHED; PG8_LDA(At, 1, 0); PG8_STAGE(PG8_SA(0, 1), a2, x1);
            PG8_WAIT_V(8); PG8_WAIT_L(0); PG8_BAR; PG8_MMA(0, 0, At, B0); PG8_MMA(0, 1, At, B1); PG8_BAR; PG8_SCHED;
            PG8_LDA(At, 1, 1); PG8_STAGE(PG8_SB(1, 0), b3, voffB); PG8_STAGE(PG8_SB(1, 1), b3 + hstep, voffB); PG8_STAGE(PG8_SA(1, 0), a3, x0);
            PG8_WAIT_V(8); PG8_WAIT_L(0); PG8_BAR; PG8_MMA(1, 0, At, B0); PG8_MMA(1, 1, At, B1); PG8_BAR; PG8_SCHED;
        }
        if (wr == 0) PG8_BAR;
        if constexpr (FP8) asm volatile("s_nop 15\n\ts_nop 7" ::: "memory");
        E(acc, cur, wr, wc, fr, fq);
        if (!has_next) break;
#pragma unroll
        for (int a = 0; a < 2; ++a)
#pragma unroll
            for (int b = 0; b < 2; ++b)
#pragma unroll
                for (int m = 0; m < 4; ++m)
#pragma unroll
                    for (int n = 0; n < 2; ++n) acc[a][b][m][n] = (f32x4){0.f, 0.f, 0.f, 0.f};
        cur = nxt; cB = nB; ++ui;
#pragma unroll
        for (int i = 0; i < 2; ++i) { aC0[i] = aN0[i]; aC1[i] = aN1[i]; }
        if (wr == 1) PG8_BAR;
    }
    PG8_WAIT_V(0);
    PG8_BAR;
#undef PG8_SA
#undef PG8_SB
#undef PG8_STAGE
#undef PG8_LDA
#undef PG8_LDB
#undef PG8_MMA
#undef PG8_WAIT_V
#undef PG8_WAIT_L
#undef PG8_BAR
#undef PG8_SCHED
}
}

__device__ __forceinline__ int vcu_of(const Frame& F) { return (F.G % 8 == 0) ? (F.bid % 8) * (F.G / 8) + F.bid / 8 : F.bid; }
__device__ __forceinline__ void phase_qkv_opt(const Frame& F, const Prm& p) {
    pg8::DenseOrder S; S.init(NTOK, 3072, 512, (const bf16*)(p.ws + WS_WQKV), F.G, F.bid);
    static_assert(WS_V - WS_K == WS_K - WS_Q, "Q|K|V equally spaced");
    LAS float* ropel = (LAS float*)((LAS unsigned char*)F.lds + LDSX_OFF);
    const float* ropeg = (const float*)(p.ws + WS_MISC) + 1024;
    for (int i = F.tid; i < 2048; i += NTHR) ropel[i] = ropeg[i];
    __syncthreads();
    pg8::EpiQKV E{(bf16*)(p.ws + WS_Q), ropel, W8_INV, F.ctl + CW_KM};
    pg8::gemm_phase<pg8::EpiQKV, pg8::DenseOrder, true>(F.lds, (const bf16*)(p.ws + WS_H), 512, S, E);
}
__device__ __forceinline__ void phase_wo_opt(const Frame& F, const Prm& p, int layer) {
    if (layer) {
        pg8::DenseOrder S; S.init(NLAT, 1024, 512, (const bf16*)(p.ws + WS_WGO), F.G, F.bid);
        pg8::EpiPlain E{(bf16*)(p.ws + WS_Y), W8_INV};
        pg8::gemm_phase<pg8::EpiPlain, pg8::DenseOrder, true>(F.lds, (const bf16*)(p.ws + WS_A2B), 512, S, E);
    } else {
        pg8::DenseOrder S; S.init(NTOK, 1024, 512, (const bf16*)(p.ws + WS_WO), F.G, F.bid);
        pg8::EpiPlain E{(bf16*)(p.ws + WS_Y), W8_INV};
        pg8::gemm_phase<pg8::EpiPlain, pg8::DenseOrder, true>(F.lds, (const bf16*)(p.ws + WS_A2), 512, S, E);
    }
}
__device__ __forceinline__ void phase_inproj_opt(const Frame& F, const Prm& p) {
    pg8::DenseOrder S; S.init(NTOK, NIN, 512, (const bf16*)(p.ws + WS_WIN), F.G, F.bid);
    pg8::EpiInproj E{(bf16*)(p.ws + WS_QR), (bf16*)(p.ws + WS_KR), (bf16*)(p.ws + WS_V1), (bf16*)(p.ws + WS_R), (float*)(p.ws + WS_ZZ), W8_INV};
    pg8::gemm_phase<pg8::EpiInproj, pg8::DenseOrder, true>(F.lds, (const bf16*)(p.ws + WS_H), 512, S, E);
}
__device__ __forceinline__ void phase_moe1_opt(const Frame& F, const Prm& p, int layer) {
    pg8::MoeOrder<true> S; S.init(F.ctl + CW_CNT + layer * 16, 1024, 512, (const bf16*)(p.ws + (layer ? WS_GU1 : WS_GU0)), (const int*)(p.ws + WS_LIST), F.G, vcu_of(F));
    pg8::EpiGateUp E{p.ws + WS_ACT};
    pg8::gemm_phase<pg8::EpiGateUp, pg8::MoeOrder<true>, true>(F.lds, (const bf16*)(p.ws + WS_H), 512, S, E);
}
__device__ __forceinline__ void phase_moe2_opt(const Frame& F, const Prm& p, int layer) {
    pg8::MoeOrder<false> S; S.init(F.ctl + CW_CNT + layer * 16, 1024, 256, (const bf16*)(p.ws + (layer ? WS_DN1 : WS_DN0)), nullptr, F.G, vcu_of(F));
    pg8::EpiPlain8 E{p.ws + WS_YM, W8_INV};
    pg8::gemm_phase<pg8::EpiPlain8, pg8::MoeOrder<false>, true>(F.lds, (const bf16*)(p.ws + WS_ACT), 256, S, E);
}
namespace attn_body {
using bf16=unsigned short;
using bf16x8=__attribute__((ext_vector_type(8)))short;
using s16x4=__attribute__((ext_vector_type(4)))short;
using f32x16=__attribute__((ext_vector_type(16)))float;
using u32x4=__attribute__((ext_vector_type(4)))unsigned;
constexpr int D=64,DM=1024;
constexpr int NW=8,QBLK=32,QB=QBLK*NW,KVBLK=64;
constexpr int ATTN_PITCH=DM, ATTN_UNIT_ROWS=QB;
__device__ __forceinline__ int crow(int r,int hi){return (r&3)+8*(r>>2)+4*hi;}
#define SBAR() __builtin_amdgcn_sched_barrier(0)

constexpr int NSLOT=3, SLOTB=8192;
constexpr int LDS_K=0, LDS_V=NSLOT*SLOTB, LDS_WS=2*NSLOT*SLOTB, LDS_OST=LDS_WS+NW*64*4, LDS_BYTES=LDS_OST+NW*4096;
constexpr float C2=0.125f*1.4426950408889634f;
__device__ __forceinline__ void glds16(const void*gsrc,unsigned lds_dst){unsigned keep;
  asm volatile("s_mov_b32 %0, m0\n\ts_mov_b32 m0, %2\n\ts_nop 0\n\tglobal_load_lds_dwordx4 %1, off\n\ts_mov_b32 m0, %0":"=&s"(keep):"v"(gsrc),"s"(lds_dst):"memory");}
__device__ __forceinline__ void glds16s(const void*sbase,unsigned voff,unsigned lds_dst){unsigned keep;
  asm volatile("s_mov_b32 %0, m0\n\ts_mov_b32 m0, %3\n\ts_nop 0\n\tglobal_load_lds_dwordx4 %1, %2\n\ts_mov_b32 m0, %0":"=&s"(keep):"v"(voff),"s"(sbase),"s"(lds_dst):"memory");}
__device__ __forceinline__ void glds16s128(const void*sbase,unsigned voff,unsigned lds_dst){unsigned keep;
  asm volatile("s_mov_b32 %0, m0\n\ts_mov_b32 m0, %3\n\ts_nop 0\n\tglobal_load_lds_dwordx4 %1, %2 offset:128\n\ts_mov_b32 m0, %0":"=&s"(keep):"v"(voff),"s"(sbase),"s"(lds_dst):"memory");}
__device__ __forceinline__ float max3f(float a,float b,float c){float r;asm("v_max3_f32 %0, %1, %2, %3":"=v"(r):"v"(a),"v"(b),"v"(c));return r;}
__device__ __forceinline__ float max2f(float a,float b){float r;asm("v_max_f32_e32 %0, %1, %2":"=v"(r):"v"(a),"v"(b));return r;}
__device__ __forceinline__ float fadd_s(float a,float b){float r;asm("v_add_f32_e32 %0, %1, %2":"=v"(r):"v"(a),"v"(b));return r;}
__device__ __forceinline__ float fsub_s(float a,float b){float r;asm("v_sub_f32_e32 %0, %1, %2":"=v"(r):"v"(a),"v"(b));return r;}
typedef float f32x2_t __attribute__((ext_vector_type(2))); typedef __bf16 bf16x2_t __attribute__((ext_vector_type(2)));
__device__ __forceinline__ unsigned cvtpk_s(float lo,float hi){f32x2_t v={lo,hi};bf16x2_t b=__builtin_convertvector(v,bf16x2_t);return __builtin_bit_cast(unsigned,b);}
#define WAIT_BAR(N) asm volatile("s_waitcnt vmcnt(" #N ") lgkmcnt(0)\n\ts_barrier":::"memory")

__device__ __forceinline__ void qkt(f32x16&p0,f32x16&p1,const char*Kslot,const bf16x8*qr,const f32x16&negm,int r32,int hi){
  const char*kb=Kslot+hi*1024+r32*16;
  #pragma unroll
  for(int d0=0;d0<4;++d0){
    const bf16x8 b0=*reinterpret_cast<const bf16x8*>(kb+d0*2048);
    const bf16x8 b1=*reinterpret_cast<const bf16x8*>(kb+d0*2048+512);
    if(d0==0){p0=__builtin_amdgcn_mfma_f32_32x32x16_bf16(b0,qr[0],negm,0,0,0);p1=__builtin_amdgcn_mfma_f32_32x32x16_bf16(b1,qr[0],negm,0,0,0);}
    else{p0=__builtin_amdgcn_mfma_f32_32x32x16_bf16(b0,qr[d0],p0,0,0,0);p1=__builtin_amdgcn_mfma_f32_32x32x16_bf16(b1,qr[d0],p1,0,0,0);}}
}
typedef __attribute__((address_space(3))) const char* lds_cptr;
typedef short v4i16_t __attribute__((ext_vector_type(4)));
__device__ __forceinline__ void kload8(bf16x8*kf,lds_cptr kp){
  kf[0]=*(const __attribute__((address_space(3))) bf16x8*)(kp);      kf[1]=*(const __attribute__((address_space(3))) bf16x8*)(kp+512);
  kf[2]=*(const __attribute__((address_space(3))) bf16x8*)(kp+2048); kf[3]=*(const __attribute__((address_space(3))) bf16x8*)(kp+2560);
  kf[4]=*(const __attribute__((address_space(3))) bf16x8*)(kp+4096); kf[5]=*(const __attribute__((address_space(3))) bf16x8*)(kp+4608);
  kf[6]=*(const __attribute__((address_space(3))) bf16x8*)(kp+6144); kf[7]=*(const __attribute__((address_space(3))) bf16x8*)(kp+6656);
}
__device__ __forceinline__ void kload2(bf16x8*kf,lds_cptr kp,int j){ kf[2*j]=*(const __attribute__((address_space(3))) bf16x8*)(kp+j*2048); kf[2*j+1]=*(const __attribute__((address_space(3))) bf16x8*)(kp+j*2048+512); }
__device__ __forceinline__ s16x4 vtr(lds_cptr p){ return __builtin_bit_cast(s16x4,__builtin_amdgcn_ds_read_tr16_b64_v4i16((__attribute__((address_space(3))) v4i16_t*)p)); }
__device__ __forceinline__ float rowmax(const f32x16&p0,const f32x16&p1){
  float a=max3f(p0[0],p0[1],p1[0]),b=max3f(p0[2],p0[3],p1[1]);a=max3f(a,p1[2],p1[3]);
  #pragma unroll
  for(int r=4;r<16;r+=4){a=max3f(a,p0[r],p0[r+1]);b=max3f(b,p0[r+2],p0[r+3]);a=max3f(a,p1[r],p1[r+1]);b=max3f(b,p1[r+2],p1[r+3]);}
  const float m=max2f(a,b);
  auto rr=__builtin_amdgcn_permlane32_swap(__float_as_uint(m),__float_as_uint(m),false,false);
  return max2f(__uint_as_float(rr[0]),__uint_as_float(rr[1]));
}
#undef SBAR
#undef WAIT_BAR
#undef KVROW
}
namespace attn_body {
constexpr int V2SLOT = 16384;
constexpr int L2_K = 0, L2_V = NSLOT * SLOTB, L2_WS = L2_V + NSLOT * V2SLOT, L2_ST = L2_WS + NW * 64 * 4, L2_BYTES = L2_ST + NW * 8192;
#define SBAR() __builtin_amdgcn_sched_barrier(0)
#define WAIT_BAR(N) asm volatile("s_waitcnt vmcnt(" #N ") lgkmcnt(0)\n\ts_barrier":::"memory")
template<int THRL> __device__ __forceinline__ void attn_unit2(long qrow0,int qcol,int vcol,long kctx,long klat,int NT,const bf16*Q,const bf16*__restrict__ K,const bf16*__restrict__ V,int m,float lam,const float*subln,unsigned char*A2,int acol,float km,char*shm){
  const int tid=threadIdx.x,lane=tid&63,r32=lane&31,hi=lane>>5; const int wid=__builtin_amdgcn_readfirstlane(tid>>6);
  const bf16*Qw=Q+(qrow0+wid*QBLK)*DM+qcol;
  const bf16*Kh=K+qcol,*Vh=V+vcol;
  const unsigned lds0=(unsigned)(uintptr_t)shm;
  float*wsf=(float*)(shm+L2_WS)+wid*64;
  const unsigned koff=(unsigned)(lane*DM+wid*8)*2u;
  const unsigned voff=(unsigned)((16*(wid&3)+(lane>>2))*DM+(wid>>2)*32+(lane&3)*8)*2u;
  const unsigned kdst=lds0+L2_K+wid*1024, vdst=lds0+L2_V+wid*1024;
  #define KVROW(t) ((t)<4?kctx+(long)(t)*KVBLK:klat+(long)((t)-4)*KVBLK)
  #define DMA_K(t,slot) glds16s(Kh+KVROW(t)*DM,koff,(unsigned)__builtin_amdgcn_readfirstlane(kdst+(slot)))
  #define DMA_V(t,slot) do{ const bf16*vb_=Vh+KVROW(t)*DM; glds16s(vb_,voff,(unsigned)__builtin_amdgcn_readfirstlane(vdst+2*(slot))); glds16s(vb_+64,voff,(unsigned)__builtin_amdgcn_readfirstlane(vdst+2*(slot)+8192)); }while(0)
  const char*Kbase=shm+L2_K; bf16x8 kf[8];
  const lds_cptr shm3=(lds_cptr)shm; const lds_cptr kp0=shm3+L2_K+hi*1024+r32*16; const lds_cptr vp0=shm3+L2_V+((lane>>4)&1)*32+(lane&3)*8+(4*hi+((lane&15)>>2))*64;
  DMA_K(0,0);DMA_V(0,0);DMA_K(1,SLOTB);
  bf16x8 qr[4];
  #pragma unroll
  for(int d0=0;d0<4;++d0)qr[d0]=*reinterpret_cast<const bf16x8*>(&Qw[(long)r32*DM+d0*16+hi*8]);
  bool FAST; { float qn=0.f;
    #pragma unroll
    for(int d0=0;d0<4;++d0){ const u32x4 u=__builtin_bit_cast(u32x4,qr[d0]); const unsigned a4[4]={u.x,u.y,u.z,u.w};
      #pragma unroll
      for(int i=0;i<4;++i){ const float lo=__uint_as_float(a4[i]<<16),h2=__uint_as_float(a4[i]&0xffff0000u); qn+=lo*lo+h2*h2; } }
    qn+=__shfl_xor(qn,32); FAST=__all(qn*km<=96.f*96.f)!=0; }
  float mhat=0.f,l_reg=0.f;f32x16 o[4];o[0]=f32x16{};o[1]=f32x16{};o[2]=f32x16{};o[3]=f32x16{};const f32x16 zero16=f32x16{};
  bool resc=false;
  #define START(P0,P1) do{ resc=false; if(FAST){ mhat=0.f; } else { const float rm=rowmax(P0,P1); mhat=rm; \
    _Pragma("unroll") for(int r=0;r<16;++r){P0[r]=fsub_s(P0[r],rm);P1[r]=fsub_s(P1[r],rm);} } \
    _Pragma("unroll") for(int r=0;r<16;++r)P0[r]=__builtin_amdgcn_exp2f(P0[r]); }while(0)
  #define RESC() do{ if(resc){ asm volatile("s_waitcnt lgkmcnt(0)":::"memory"); \
      _Pragma("unroll") for(int d_=0;d_<4;++d_) _Pragma("unroll") for(int r=0;r<16;++r)o[d_][r]*=wsf[crow(r,hi)]; } }while(0)
  int sl_prev=0,sl_cur=0,sl_next=SLOTB;
  #define ROT() do{sl_prev=sl_cur;sl_cur=sl_next;sl_next=(sl_next==(NSLOT-1)*SLOTB)?0:sl_next+SLOTB;}while(0)
  DMA_K(2,2*SLOTB);
  WAIT_BAR(4);
  #define PKW(P,B) cvtpk_s(P[B],P[B+1])
  u32x4 pwA0,pwA1,pwA2,pwA3,pwB0,pwB1,pwB2,pwB3;
  { f32x16 p0,p1;
    qkt(p0,p1,Kbase,qr,zero16,r32,hi);asm volatile("s_nop 15\n\ts_nop 7":"+v"(p0),"+v"(p1));
    START(p0,p1);
    _Pragma("unroll") for(int r=0;r<16;++r)p1[r]=__builtin_amdgcn_exp2f(p1[r]);
    float sacc=p0[0]+p0[1]; _Pragma("unroll") for(int r=2;r<16;++r)sacc+=p0[r]; _Pragma("unroll") for(int r=0;r<16;++r)sacc+=p1[r]; l_reg+=sacc;
    pwA0=(u32x4){PKW(p0,0),PKW(p0,2),PKW(p0,4),PKW(p0,6)};pwA1=(u32x4){PKW(p0,8),PKW(p0,10),PKW(p0,12),PKW(p0,14)};pwA2=(u32x4){PKW(p1,0),PKW(p1,2),PKW(p1,4),PKW(p1,6)};pwA3=(u32x4){PKW(p1,8),PKW(p1,10),PKW(p1,12),PKW(p1,14)}; }
  WAIT_BAR(0);
  DMA_K(3,0);DMA_V(1,SLOTB);
  ROT();
  kload8(kf,kp0+sl_cur);
  WAIT_BAR(3);
  s16x4 vAl[4],vAh[4],vBl[4],vBh[4];
  #define PAFX(x) __builtin_bit_cast(bf16x8,x)
  #define VF(A,d) (bf16x8){A##l[d][0],A##l[d][1],A##l[d][2],A##l[d][3],A##h[d][0],A##h[d][1],A##h[d][2],A##h[d][3]}
  #define PIN(x) asm volatile("":"+v"(x))
  #define MX3(a,b,c) __builtin_fmaxf(__builtin_fmaxf((a),(b)),(c))
  #define EX(v) __builtin_amdgcn_exp2f(v)
  #define VRDL(A,d,ks) A##l[d]=vtr(vp_+((d)*4096+(ks)*1024))
  #define VRDH(A,d,ks) A##h[d]=vtr(vp_+((d)*4096+(ks)*1024+512))
  #define GAPF(MF,X,B,PWN,W,RD) do{ MF; X[B]=EX(X[B]); X[B+1]=EX(X[B+1]); sacc+=X[B]; sacc+=X[B+1]; PIN(sacc); PWN[W]=cvtpk_s(X[B],X[B+1]); PIN(PWN); RD; SBAR(); }while(0)
  #define GAPP(MF,X,B,PWN,W,RD) do{ MF; X[B]=EX(X[B]-mhat); X[B+1]=EX(X[B+1]-mhat); sacc+=X[B]; sacc+=X[B+1]; PIN(sacc); PWN[W]=cvtpk_s(X[B],X[B+1]); PIN(PWN); RD; SBAR(); }while(0)
  #define MFQ(C,kf_,q_,acc_) C=__builtin_amdgcn_mfma_f32_32x32x16_bf16(kf_,q_,acc_,0,0,0)
  #define MFO(d,PW,A) o[d]=__builtin_amdgcn_mfma_f32_32x32x16_bf16(PAFX(PW),VF(A,d),o[d],0,0,0)
  #define KRD(G,j) do{ if(G){ kload2(kf,kp0+sl_next,j); } }while(0)
  #define PHASEB(G,PI0,PI1,PI2,PI3,PO0,PO1,PO2,PO3,GL) do{ \
    G(MFO(0,PI0,vA),C0,0, PO0,0, VRDL(vB,0,1);VRDH(vB,0,1)); \
    G(MFO(1,PI0,vA),C0,2, PO0,1, VRDL(vB,1,1);VRDH(vB,1,1)); \
    G(MFO(2,PI0,vA),C0,4, PO0,2, VRDL(vB,2,1);VRDH(vB,2,1)); \
    G(MFO(3,PI0,vA),C0,6, PO0,3, VRDL(vB,3,1);VRDH(vB,3,1)); \
    G(MFO(0,PI1,vB),C0,8, PO1,0, VRDL(vA,0,2);VRDH(vA,0,2)); \
    G(MFO(1,PI1,vB),C0,10,PO1,1, VRDL(vA,1,2);VRDH(vA,1,2)); \
    G(MFO(2,PI1,vB),C0,12,PO1,2, VRDL(vA,2,2);VRDH(vA,2,2)); \
    G(MFO(3,PI1,vB),C0,14,PO1,3, VRDL(vA,3,2);VRDH(vA,3,2)); \
    G(MFO(0,PI2,vA),C1,0, PO2,0, VRDL(vB,0,3);VRDH(vB,0,3)); \
    G(MFO(1,PI2,vA),C1,2, PO2,1, VRDL(vB,1,3);VRDH(vB,1,3)); \
    G(MFO(2,PI2,vA),C1,4, PO2,2, VRDL(vB,2,3);VRDH(vB,2,3)); \
    G(MFO(3,PI2,vA),C1,6, PO2,3, VRDL(vB,3,3);VRDH(vB,3,3)); \
    G(MFO(0,PI3,vB),C1,8, PO3,0, KRD(GL,0)); \
    G(MFO(1,PI3,vB),C1,10,PO3,1, KRD(GL,1)); \
    G(MFO(2,PI3,vB),C1,12,PO3,2, KRD(GL,2)); \
    G(MFO(3,PI3,vB),C1,14,PO3,3, KRD(GL,3)); \
    }while(0)
  #define STEP2(t,PI0,PI1,PI2,PI3,PO0,PO1,PO2,PO3,GK,GV,GL) do{ SBAR(); \
    const lds_cptr vp_=vp0+2*sl_prev; f32x16 C0,C1; float sacc=0.f; \
    VRDL(vA,0,0); SBAR(); MFQ(C0,kf[0],qr[0],zero16); SBAR(); \
    VRDH(vA,0,0); SBAR(); MFQ(C1,kf[1],qr[0],zero16); SBAR(); \
    VRDL(vA,1,0); SBAR(); MFQ(C0,kf[2],qr[1],C0); SBAR(); \
    VRDH(vA,1,0); SBAR(); MFQ(C1,kf[3],qr[1],C1); SBAR(); \
    VRDL(vA,2,0); SBAR(); MFQ(C0,kf[4],qr[2],C0); SBAR(); \
    VRDH(vA,2,0); SBAR(); MFQ(C1,kf[5],qr[2],C1); SBAR(); \
    VRDL(vA,3,0); SBAR(); MFQ(C0,kf[6],qr[3],C0); SBAR(); \
    VRDH(vA,3,0); SBAR(); MFQ(C1,kf[7],qr[3],C1); SBAR(); \
    if(GK){DMA_K((t)+3,sl_cur);} if(GV){DMA_V((t)+1,sl_next);} \
    if(!FAST){ float a=MX3(C0[0],C0[1],C1[0]),b=MX3(C0[2],C0[3],C1[1]); a=MX3(a,C1[2],C1[3]); \
      _Pragma("unroll") for(int r=4;r<16;r+=4){a=MX3(a,C0[r],C0[r+1]);b=MX3(b,C0[r+2],C0[r+3]);a=MX3(a,C1[r],C1[r+1]);b=MX3(b,C1[r+2],C1[r+3]);} \
      float rm=__builtin_fmaxf(a,b); { auto rr=__builtin_amdgcn_permlane32_swap(__float_as_uint(rm),__float_as_uint(rm),false,false); rm=__builtin_fmaxf(__uint_as_float(rr[0]),__uint_as_float(rr[1])); } \
      resc=false; \
      if(__builtin_expect(__any(rm-mhat>(float)THRL),0)){ const float dl=__builtin_fmaxf(rm-mhat,0.f); mhat+=dl; \
        const float f=__builtin_amdgcn_exp2f(-dl); l_reg*=f; if(hi==0)wsf[r32]=f; resc=true; } } \
    __builtin_amdgcn_s_setprio(1); SBAR(); \
    PHASEB(GAPP,PI0,PI1,PI2,PI3,PO0,PO1,PO2,PO3,GL); \
    __builtin_amdgcn_s_setprio(0); l_reg+=sacc; \
    }while(0)
  #define ENDW(tt) do{ if((tt)+3<NT){WAIT_BAR(3);} else if((tt)+2<NT){WAIT_BAR(2);} else {WAIT_BAR(0);} }while(0)
  int t=1;
  for(;t+5<NT;t+=2){
    STEP2(t,  pwA0,pwA1,pwA2,pwA3,pwB0,pwB1,pwB2,pwB3,true,true,true); WAIT_BAR(3); RESC(); ROT();
    STEP2(t+1,pwB0,pwB1,pwB2,pwB3,pwA0,pwA1,pwA2,pwA3,true,true,true); WAIT_BAR(3); RESC(); ROT();
  }
  for(;t+1<NT;t+=2){
    STEP2(t,  pwA0,pwA1,pwA2,pwA3,pwB0,pwB1,pwB2,pwB3,(t+3<NT),(t+1<NT),(t+1<NT)); ENDW(t);   RESC(); ROT();
    STEP2(t+1,pwB0,pwB1,pwB2,pwB3,pwA0,pwA1,pwA2,pwA3,(t+4<NT),(t+2<NT),(t+2<NT)); ENDW(t+1); RESC(); ROT();
  }
  STEP2(NT-1,pwA0,pwA1,pwA2,pwA3,pwB0,pwB1,pwB2,pwB3,false,false,false); RESC();
  { const lds_cptr vp_=vp0+2*sl_cur;
    #pragma unroll
    for(int ks=0;ks<4;++ks){
      #pragma unroll
      for(int d=0;d<4;++d){ const s16x4 lo=vtr(vp_+(d*4096+ks*1024)),hh=vtr(vp_+(d*4096+ks*1024+512)); const bf16x8 vf=(bf16x8){lo[0],lo[1],lo[2],lo[3],hh[0],hh[1],hh[2],hh[3]};
        const u32x4 pw=(ks==0)?pwB0:(ks==1)?pwB1:(ks==2)?pwB2:pwB3;
        o[d]=__builtin_amdgcn_mfma_f32_32x32x16_bf16(PAFX(pw),vf,o[d],0,0,0); } } }
  {auto rr=__builtin_amdgcn_permlane32_swap(__float_as_uint(l_reg),__float_as_uint(l_reg),false,false);l_reg=__uint_as_float(rr[0])+__uint_as_float(rr[1]);}
  if(hi==0)wsf[32+r32]=l_reg;asm volatile("s_waitcnt lgkmcnt(0)":::"memory");
  float rli[16];
  #pragma unroll
  for(int r=0;r<16;++r)rli[r]=__builtin_amdgcn_rcpf(wsf[32+crow(r,hi)]);
  unsigned short*stash=(unsigned short*)(shm+L2_ST)+wid*4096;
  if(m==0){
    #pragma unroll
    for(int d0=0;d0<4;++d0){
      #pragma unroll
      for(int r=0;r<16;++r)stash[(d0*16+r)*64+lane]=(unsigned short)f2bf(o[d0][r]*rli[r]);}
    asm volatile("s_waitcnt lgkmcnt(0)":::"memory");
  } else {
    float ss[16];
    #pragma unroll
    for(int r=0;r<16;++r)ss[r]=0.f;
    #pragma unroll
    for(int d0=0;d0<4;++d0){
      #pragma unroll
      for(int r=0;r<16;++r){ const float o1=bf2f(stash[(d0*16+r)*64+lane]); const float df=o1-lam*(o[d0][r]*rli[r]); o[d0][r]=df; ss[r]+=df*df; } }
    #pragma unroll
    for(int r=0;r<16;++r){ float q=ss[r];
      #pragma unroll
      for(int s_=1;s_<32;s_<<=1)q+=__shfl_xor(q,s_);
      ss[r]=(1.f-LAMBDA_INIT0)/sqrtf(q*(1.f/128.f)+LN_EPS); }
    asm volatile("s_waitcnt lgkmcnt(0)":::"memory");
    unsigned char*stg=(unsigned char*)stash;
    #pragma unroll
    for(int d0=0;d0<4;++d0){ const float sgv=subln[d0*32+r32];
      #pragma unroll
      for(int r=0;r<16;++r){ const int w8=__builtin_amdgcn_cvt_pk_fp8_f32(o[d0][r]*ss[r]*sgv,0.f,0,false); stg[crow(r,hi)*128+d0*32+r32]=(unsigned char)(w8&0xff); } }
    asm volatile("s_waitcnt lgkmcnt(0)":::"memory");
    unsigned char*Aw=A2+(qrow0+wid*QBLK)*DM+acol;
    #pragma unroll
    for(int i=0;i<4;++i){const int row=i*8+(lane>>3),ch=lane&7; const u32x4 v=*(const u32x4*)(stg+row*128+ch*16); *(u32x4*)(Aw+(long)row*DM+ch*16)=v;}
    asm volatile("s_waitcnt lgkmcnt(0)":::"memory");
  }
  asm volatile("s_waitcnt lgkmcnt(0)\n\ts_barrier":::"memory");
  #undef KVROW
  #undef DMA_K
  #undef DMA_V
  #undef START
  #undef RESC
  #undef ROT
  #undef PKW
  #undef PAFX
  #undef VF
  #undef PIN
  #undef MX3
  #undef EX
  #undef VRDL
  #undef VRDH
  #undef GAPP
  #undef GAPF
  #undef PHASEB
  #undef MFQ
  #undef MFO
  #undef KRD
  #undef STEP2
  #undef ENDW
}
#undef SBAR
#undef WAIT_BAR
}
__device__ __forceinline__ void phase_attn2(const Frame& F, const Prm& p) {
    const bf16* Q = (const bf16*)(p.ws + WS_Q); const bf16* K = (const bf16*)(p.ws + WS_K); const bf16* V = (const bf16*)(p.ws + WS_V); unsigned char* A2 = p.ws + WS_O1;
    const float lam = ((const float*)(p.ws + WS_MISC))[0];
    for (int v = vcu_of(F); v < 256; v += F.G) {
        const int b = v >> 5, h = (v >> 2) & 7, part = v & 3;
        const long kctx = NLAT + b * CTXL, klat = (long)b * SEQ;
        const int nu = part ? 4 : 5;
        for (int i = 0; i < nu; ++i) {
            const long qrow0 = i < 4 ? klat + (part * 4 + i) * 256 : kctx; const int NT = i < 4 ? 68 : 4;
            for (int m = 0; m < 2; ++m) {
                const int hm = 2 * h + m;
                const float km = __uint_as_float(__hip_atomic_load(F.ctl + CW_KM + b * 16 + hm, __ATOMIC_RELAXED, __HIP_MEMORY_SCOPE_AGENT));
                attn_body::attn_unit2<8>(qrow0, hm * 64, h * 128, kctx, klat, NT, Q, K, V, m, lam, p.subln, A2, h * 128, km, (char*)F.lds);
            }
        }
    }
}
namespace gla3 {
typedef short bf16x8 __attribute__((ext_vector_type(8)));
typedef short s16x4 __attribute__((ext_vector_type(4)));
typedef float f32x16 __attribute__((ext_vector_type(16)));
constexpr int CH = 64 * 16 + 64;
constexpr int L_QS = 0, L_KS = 16 * CH, L_VS = 32 * CH, L_SB = 40 * CH, L_X = 56 * CH, L_DEC = L_X + 16384, L_END = L_DEC + 512;
__device__ __forceinline__ int crow(int i, int hh) { return (i & 3) + 8 * (i >> 2) + 4 * hh; }
typedef float f32x2_t __attribute__((ext_vector_type(2))); typedef __bf16 bf16x2_t __attribute__((ext_vector_type(2)));
__device__ __forceinline__ unsigned pk(float lo, float hi) { f32x2_t v = {lo, hi}; bf16x2_t b = __builtin_convertvector(v, bf16x2_t); return __builtin_bit_cast(unsigned, b); }
typedef short v4i16_t __attribute__((ext_vector_type(4)));
__device__ __forceinline__ s16x4 trrd(LAS const unsigned char* p) { return __builtin_bit_cast(s16x4, __builtin_amdgcn_ds_read_tr16_b64_v4i16((LAS v4i16_t*)p)); }
#define GLA_FR(lo, hi) (bf16x8){lo[0], lo[1], lo[2], lo[3], hi[0], hi[1], hi[2], hi[3]}

__device__ __forceinline__ void scan_unit(const Frame& F, const Prm& p, int unit) {
    const int dvs = unit & 3, dir = (unit >> 2) & 1, h = (unit >> 3) & 3, b = unit >> 5;
    LAS unsigned char* lds = (LAS unsigned char*)F.lds;
    const int lane = F.lane, w = F.wave, tid = F.tid, r = lane & 31, hh = lane >> 5;
    const bf16* QT = (const bf16*)(p.ws + WS_QT) + ((size_t)dir * 8 + 2 * h) * NTOK * 64;
    const bf16* KT = (const bf16*)(p.ws + WS_KT) + ((size_t)dir * 8 + 2 * h) * NTOK * 64;
    const bf16* V = (const bf16*)(p.ws + WS_V1) + h * 256 + dvs * 64;
    const float* DEC = (const float*)(p.ws + WS_DEC) + (size_t)dir * NCHUNK * 512 + h * 128;
    bf16* OG = (bf16*)((unsigned char*)p.out + (dir ? OUT_OGB : 0)) + h * 256 + dvs * 64;
    const int g1 = (lane >> 4) & 1, q4 = (lane & 15) >> 2, p4 = lane & 3;
    const int trb = (2 * g1 + (p4 >> 1)) * CH + q4 * 16 + 8 * (p4 & 1);
    const int trN = trb + 128 * hh, trP = trb + 64 * hh;
    f32x16 S0 = {}, S1 = {};
    for (int i = tid; i < 16 * CH / 16; i += NTHR) *(LAS u32x4*)(lds + L_SB + i * 16) = (u32x4){0u, 0u, 0u, 0u};
    u32x4 pq0[2], pq1[2], pk0[2], pk1[2], pv[2]; float pdec[2] = {0.f, 0.f};
#define GLA_CHUNK(step) ((step) >= 4 ? b * 64 + (dir ? 63 - ((step) - 4) : (step) - 4) : 512 + b * 4 + (dir ? 3 - (step) : (step)))
    const int qrow = 8 * w + (lane >> 4), qch = lane & 15, vrow = 8 * w + (lane >> 3), vch = lane & 7;
    const size_t qgo = (size_t)(qch >> 3) * NTOK * 64 + (qch & 7) * 8;
#define GLA_LOAD(step, u) do { const size_t t0_ = (size_t)GLA_CHUNK(step) * 64; \
        pq0[u] = *(const u32x4*)(QT + qgo + (t0_ + qrow) * 64); pq1[u] = *(const u32x4*)(QT + qgo + (t0_ + qrow + 4) * 64); \
        pk0[u] = *(const u32x4*)(KT + qgo + (t0_ + qrow) * 64); pk1[u] = *(const u32x4*)(KT + qgo + (t0_ + qrow + 4) * 64); \
        pv[u] = *(const u32x4*)(V + (t0_ + vrow) * 1024 + 8 * vch); if (tid < 128) pdec[u] = DEC[(size_t)GLA_CHUNK(step) * 512 + tid]; } while (0)
#define GLA_STORE(u) do { \
        *(LAS u32x4*)(lds + L_QS + qch * CH + qrow * 16) = pq0[u]; *(LAS u32x4*)(lds + L_QS + qch * CH + (qrow + 4) * 16) = pq1[u]; \
        *(LAS u32x4*)(lds + L_KS + qch * CH + qrow * 16) = pk0[u]; *(LAS u32x4*)(lds + L_KS + qch * CH + (qrow + 4) * 16) = pk1[u]; \
        *(LAS u32x4*)(lds + L_VS + vch * CH + vrow * 16) = pv[u]; \
        if (tid < 128) *(LAS float*)(lds + L_DEC + 4 * tid) = pdec[u]; } while (0)
    GLA_LOAD(0, 0);
    GLA_LOAD(1, 1);
    GLA_STORE(0);
    __syncthreads();
    const int tb = (w & 3) >> 1, vb = w & 1;
    for (int sp2 = 0; sp2 < 34; ++sp2) {
#pragma unroll
    for (int u = 0; u < 2; ++u) {
        const int step = 2 * sp2 + u;
        const bool lat = step >= 4; const int chunk = GLA_CHUNK(step);
        if (step + 2 < 68) GLA_LOAD(step + 2, u);
        f32x16 o = {};
        if (w < 4) {
            if (lat) {
                const bool n0 = dir ? (tb == 0) : true, n1 = dir ? true : (tb == 1);
                f32x16 sc0 = {}, sc1 = {};
#define GLA_BQ(ks) (*(const LAS bf16x8*)(lds + L_QS + (2 * (ks) + hh) * CH + (32 * tb + r) * 16))
#define GLA_A0(ks) (*(const LAS bf16x8*)(lds + L_KS + (2 * (ks) + hh) * CH + r * 16))
#define GLA_A1(ks) (*(const LAS bf16x8*)(lds + L_KS + (2 * (ks) + hh) * CH + (32 + r) * 16))
                if (n0 && n1) {
#pragma unroll
                    for (int ks = 0; ks < 8; ++ks) { const bf16x8 bq = GLA_BQ(ks); sc0 = __builtin_amdgcn_mfma_f32_32x32x16_bf16(GLA_A0(ks), bq, sc0, 0, 0, 0); sc1 = __builtin_amdgcn_mfma_f32_32x32x16_bf16(GLA_A1(ks), bq, sc1, 0, 0, 0); }
                } else if (n0) {
#pragma unroll
                    for (int ks = 0; ks < 8; ++ks) sc0 = __builtin_amdgcn_mfma_f32_32x32x16_bf16(GLA_A0(ks), GLA_BQ(ks), sc0, 0, 0, 0);
                } else {
#pragma unroll
                    for (int ks = 0; ks < 8; ++ks) sc1 = __builtin_amdgcn_mfma_f32_32x32x16_bf16(GLA_A1(ks), GLA_BQ(ks), sc1, 0, 0, 0);
                }
#undef GLA_BQ
#undef GLA_A0
#undef GLA_A1
                const int t = 32 * tb + r;
#pragma unroll
                for (int i = 0; i < 16; ++i) { const int s0 = crow(i, hh), s1 = 32 + s0; const bool k0 = dir ? (s0 >= t) : (s0 <= t), k1 = dir ? (s1 >= t) : (s1 <= t); sc0[i] = k0 ? sc0[i] : 0.f; sc1[i] = k1 ? sc1[i] : 0.f; }
#pragma unroll
                for (int sb = 0; sb < 2; ++sb) { if (sb == 0 ? n0 : n1) {
#pragma unroll
                    for (int sp = 0; sp < 2; ++sp) {
                        u32x4 pw;
                        if (sb == 0) { pw.x = pk(sc0[8 * sp + 0], sc0[8 * sp + 1]); pw.y = pk(sc0[8 * sp + 2], sc0[8 * sp + 3]); pw.z = pk(sc0[8 * sp + 4], sc0[8 * sp + 5]); pw.w = pk(sc0[8 * sp + 6], sc0[8 * sp + 7]); }
                        else { pw.x = pk(sc1[8 * sp + 0], sc1[8 * sp + 1]); pw.y = pk(sc1[8 * sp + 2], sc1[8 * sp + 3]); pw.z = pk(sc1[8 * sp + 4], sc1[8 * sp + 5]); pw.w = pk(sc1[8 * sp + 6], sc1[8 * sp + 7]); }
                        LAS const unsigned char* vp = lds + L_VS + trP + (4 * vb) * CH + (32 * sb + 16 * sp) * 16;
                        const s16x4 lo = trrd(vp), hi = trrd(vp + 8 * 16);
                        o = __builtin_amdgcn_mfma_f32_32x32x16_bf16(GLA_FR(lo, hi), __builtin_bit_cast(bf16x8, pw), o, 0, 0, 0);
                    } } }
            }
        } else {
            const int db = w - 4;
            if (lat) {
                f32x16 o2 = {};
#pragma unroll
                for (int ks = 0; ks < 8; ++ks) {
                    const bf16x8 as = *(const LAS bf16x8*)(lds + L_SB + (2 * ks + hh) * CH + (32 * vb + r) * 16);
                    const bf16x8 bq = *(const LAS bf16x8*)(lds + L_QS + (2 * ks + hh) * CH + (32 * tb + r) * 16);
                    o2 = __builtin_amdgcn_mfma_f32_32x32x16_bf16(as, bq, o2, 0, 0, 0);
                }
#pragma unroll
                for (int g = 0; g < 4; ++g) *(LAS f32x4*)(lds + L_X + (w & 3) * 4096 + g * 1024 + lane * 16) = (f32x4){o2[4 * g], o2[4 * g + 1], o2[4 * g + 2], o2[4 * g + 3]};
            }
#pragma unroll
            for (int ks = 0; ks < 4; ++ks) {
                LAS const unsigned char* kp = lds + L_KS + trN + (4 * db) * CH + (16 * ks) * 16;
                LAS const unsigned char* vp = lds + L_VS + trN + (16 * ks) * 16;
                const s16x4 al = trrd(kp), ah = trrd(kp + 4 * 16);
                const s16x4 b0l = trrd(vp), b0h = trrd(vp + 4 * 16), b1l = trrd(vp + 4 * CH), b1h = trrd(vp + 4 * CH + 4 * 16);
                S0 = __builtin_amdgcn_mfma_f32_32x32x16_bf16(GLA_FR(al, ah), GLA_FR(b0l, b0h), S0, 0, 0, 0); S1 = __builtin_amdgcn_mfma_f32_32x32x16_bf16(GLA_FR(al, ah), GLA_FR(b1l, b1h), S1, 0, 0, 0);
            }
#pragma unroll
            for (int i = 0; i < 16; ++i) { const float dc = *(const LAS float*)(lds + L_DEC + 4 * (32 * db + crow(i, hh))); S0[i] *= dc; S1[i] *= dc; }
        }
        __syncthreads();
        if (w < 4 && lat) {
            bf16* orow = OG + ((size_t)chunk * 64 + 32 * tb + r) * DM + 32 * vb + 4 * hh;
#pragma unroll
            for (int g = 0; g < 4; ++g) { const f32x4 x = *(const LAS f32x4*)(lds + L_X + w * 4096 + g * 1024 + lane * 16);
                u32x2 wv; wv.x = pk(o[4 * g] + x.x, o[4 * g + 1] + x.y); wv.y = pk(o[4 * g + 2] + x.z, o[4 * g + 3] + x.w); *(u32x2*)(orow + 8 * g) = wv; }
        }
        if (step + 1 < 68) {
            GLA_STORE(u ^ 1);
            if (w >= 4) { const int db = w - 4;
#pragma unroll
                for (int g = 0; g < 4; ++g) { u32x2 w0, w1; w0.x = pk(S0[4 * g], S0[4 * g + 1]); w0.y = pk(S0[4 * g + 2], S0[4 * g + 3]); w1.x = pk(S1[4 * g], S1[4 * g + 1]); w1.y = pk(S1[4 * g + 2], S1[4 * g + 3]);
                    *(LAS u32x2*)(lds + L_SB + (4 * db + g) * CH + r * 16 + 8 * hh) = w0; *(LAS u32x2*)(lds + L_SB + (4 * db + g) * CH + (32 + r) * 16 + 8 * hh) = w1; } }
        }
        __syncthreads();
    }
    }
#undef GLA_CHUNK
#undef GLA_LOAD
#undef GLA_STORE
}
#undef GLA_FR
}
__device__ __forceinline__ void phase_scan_opt(const Frame& F, const Prm& p) {
    for (int unit = vcu_of(F); unit < 256; unit += F.G) gla3::scan_unit(F, p, unit);
}
#define PHASE_QKV(F, p) phase_qkv_opt(F, p)
#define PHASE_ATTN(F, p) phase_attn2(F, p)
#define PHASE_WO(F, p, l) phase_wo_opt(F, p, l)
#define PHASE_MOE1(F, p, l) phase_moe1_opt(F, p, l)
#define PHASE_MOE2(F, p, l) phase_moe2_opt(F, p, l)
#define PHASE_INPROJ(F, p) phase_inproj_opt(F, p)
#define PHASE_SCAN(F, p) phase_scan_opt(F, p)
typedef GAS unsigned gu32;
#define XB_TMO      128
#define XB_XCNT(j)  (256  + 64 * (j))
#define XB_XSUB(j)  (1280 + 64 * (j))
#define XB_XGEN(j)  (2304 + 64 * (j))
#define XB_TOP      3328
#define XB_TOPGEN   3392
#define XCD_BAR_WORDS 3456
#define XB_SPIN_CAP (1u << 20)
__device__ __forceinline__ unsigned xb_ld(unsigned* p)              { return __hip_atomic_load(p, __ATOMIC_RELAXED, __HIP_MEMORY_SCOPE_AGENT); }
__device__ __forceinline__ unsigned xb_add(unsigned* p, unsigned v) { return __hip_atomic_fetch_add(p, v, __ATOMIC_RELAXED, __HIP_MEMORY_SCOPE_AGENT); }
__device__ __forceinline__ unsigned xb_xcc_id() { return (unsigned)__builtin_amdgcn_s_getreg((3 << 11) | 20) & 0xFu; }
#define XB_SPIN(cond, bar) do { unsigned _sp = 0; while (cond) { __builtin_amdgcn_s_sleep(1); \
    if ((++_sp & 255u) == 0u) { if (xb_ld(&(bar)[XB_TMO])) break; if (_sp > XB_SPIN_CAP) { atomicAdd(&(bar)[XB_TMO], 1u); break; } } } } while (0)
struct XcdBarrier { unsigned* bar; unsigned x; volatile LAS unsigned* st; };
__device__ __forceinline__ XcdBarrier xcd_barrier_post(unsigned* bar, volatile LAS unsigned* st) {
    XcdBarrier b; b.bar = bar; b.x = xb_xcc_id(); b.st = st;
    if (threadIdx.x == 0) (void)xb_add(&bar[XB_XCNT(b.x)], 1u);
    return b;
}
__device__ __forceinline__ void xcd_barrier_complete(unsigned* bar, unsigned x, unsigned& nloc, unsigned& nx) {
    const unsigned G = gridDim.x * gridDim.y * gridDim.z;
    unsigned sum, cnt, mine, sp = 0u;
    for (;;) {
        sum = 0u; cnt = 0u; mine = 0u;
#pragma unroll
        for (unsigned j = 0; j < 16; ++j) { const unsigned c = xb_ld(&bar[XB_XCNT(j)]); sum += c; cnt += (c > 0u) ? 1u : 0u; mine = (j == x) ? c : mine; }
        if (sum == G) break;
        __builtin_amdgcn_s_sleep(1);
        if ((++sp & 255u) == 0u) { if (xb_ld(&bar[XB_TMO])) break; if (sp > XB_SPIN_CAP) { atomicAdd(&bar[XB_TMO], 1u); break; } }
    }
    nloc = mine > 0u ? mine : 1u; nx = cnt > 0u ? cnt : 1u;
}
__device__ __forceinline__ void xcd_barrier(const XcdBarrier& b) {
    asm volatile("s_waitcnt vmcnt(0)" ::: "memory");
    __syncthreads();
    if (threadIdx.x == 0) {
        unsigned* bar = b.bar;
        __builtin_amdgcn_s_waitcnt(0);
        unsigned nloc = b.st[0], nx = b.st[1];
        if (nloc == 0u) { xcd_barrier_complete(bar, b.x, nloc, nx); b.st[0] = nloc; b.st[1] = nx; }
        const unsigned old = xb_add(&bar[XB_XSUB(b.x)], 1u);
        const unsigned gen = old / nloc;
        if (old + 1u == (gen + 1u) * nloc) {
            __builtin_amdgcn_fence(__ATOMIC_RELEASE, "agent");
            asm volatile("s_waitcnt vmcnt(0)" ::: "memory");
            const unsigned og = xb_add(&bar[XB_TOP], 1u);
            const unsigned tg = og / nx;
            if (og + 1u == (tg + 1u) * nx) xb_add(&bar[XB_TOPGEN], 1u);
            else XB_SPIN(xb_ld(&bar[XB_TOPGEN]) == tg, bar);
            __builtin_amdgcn_fence(__ATOMIC_ACQUIRE, "agent");
            xb_add(&bar[XB_XGEN(b.x)], 1u);
            asm volatile("s_waitcnt vmcnt(0)" ::: "memory");
        } else {
            XB_SPIN(xb_ld(&bar[XB_XGEN(b.x)]) == gen, bar);
            __builtin_amdgcn_fence(__ATOMIC_ACQUIRE, "agent");
            asm volatile("s_waitcnt vmcnt(0)" ::: "memory");
        }
    }
    __syncthreads();
}

constexpr int NPHASE = 19;
__global__ void __launch_bounds__(NTHR, 2) mega_fwd(Prm p) {
    extern __shared__ __attribute__((aligned(16))) unsigned char lds[];
    Frame F; F.lds = lds; F.ctl = (unsigned*)(p.ws + WS_CTL);
    F.tid = threadIdx.x; F.lane = F.tid & 63; F.wave = __builtin_amdgcn_readfirstlane(F.tid >> 6); F.G = gridDim.x; F.bid = blockIdx.x;
    for (int u = F.tid; u < (LDS_BYTES - LDSCTL_OFF) / 4; u += NTHR) ((LAS unsigned*)(lds + LDSCTL_OFF))[u] = 0u;
    __syncthreads();
    const int lo = p.ph_lo, hi = p.ph_hi;
    const bool multi = (hi - lo) > 1;
    XcdBarrier bar; bar.bar = F.ctl + CW_BAR + p.li * XCD_BAR_WORDS; bar.x = 0; bar.st = nullptr;
    if (multi) bar = xcd_barrier_post(F.ctl + CW_BAR + p.li * XCD_BAR_WORDS, (volatile LAS unsigned*)(lds + MISC_OFF) + 8);
#define IN(k) (lo <= (k) && (k) < hi)
#define SEAM(k) do { if (IN(k) && IN((k) + 1)) xcd_barrier(bar); } while (0)
    if (IN(0)) { phase_prologue(F, p); } SEAM(0);
    if (IN(1)) { phase_modulate0(F, p); } SEAM(1);
    if (IN(2)) { PHASE_QKV(F, p); } SEAM(2);
    if (IN(3)) { PHASE_ATTN(F, p); } SEAM(3);
    if (IN(5)) { PHASE_WO(F, p, 0); } SEAM(5);
    if (IN(6)) { phase_ln_route(F, p, 0); } SEAM(6);
    if (IN(7)) { PHASE_MOE1(F, p, 0); } SEAM(7);
    if (IN(8)) { PHASE_MOE2(F, p, 0); } SEAM(8);
    if (IN(9)) { phase_moe_combine(F, p, 0); } SEAM(9);
    if (IN(10)) { PHASE_INPROJ(F, p); } SEAM(10);
    if (IN(11)) { phase_gla_prep(F, p); } SEAM(11);
    if (IN(12)) { PHASE_SCAN(F, p); } SEAM(12);
    if (IN(13)) { phase_gla_post(F, p); } SEAM(13);
    if (IN(14)) { PHASE_WO(F, p, 1); } SEAM(14);
    if (IN(15)) { phase_ln_route(F, p, 1); } SEAM(15);
    if (IN(16)) { PHASE_MOE1(F, p, 1); } SEAM(16);
    if (IN(17)) { PHASE_MOE2(F, p, 1); } SEAM(17);
    if (IN(18)) { phase_moe_combine(F, p, 1); }
#undef IN
#undef SEAM
}

extern "C" void kernel_launch(void* const* d_in, const int* in_sizes, int n_in, void* d_out, int out_size, void* d_ws, size_t ws_size, hipStream_t stream) {
    static int grid = 0;
    if (grid == 0) {
        if (n_in != 23 || in_sizes[0] != NLAT * DM || out_size != NLAT * DM || ws_size < WS_END) { fprintf(stderr, "kernel_launch: unexpected shapes (n_in %d, in0 %d, out %d, ws %zu); nothing launched\n", n_in, n_in > 0 ? in_sizes[0] : -1, out_size, ws_size); grid = -1; return; }
        int dev = 0, cus = 0;
        if (hipGetDevice(&dev) != hipSuccess || hipDeviceGetAttribute(&cus, hipDeviceAttributeMultiprocessorCount, dev) != hipSuccess) { grid = -1; return; }
        if (hipFuncSetAttribute((const void*)mega_fwd, hipFuncAttributeMaxDynamicSharedMemorySize, LDS_BYTES) != hipSuccess) { fprintf(stderr, "kernel_launch: hipFuncSetAttribute failed\n"); grid = -1; return; }
        int per_cu = 0;
        if (hipOccupancyMaxActiveBlocksPerMultiprocessor(&per_cu, (const void*)mega_fwd, NTHR, LDS_BYTES) != hipSuccess || per_cu < 1) fprintf(stderr, "kernel_launch: note: occupancy query reports %d\n", per_cu);
        (void)hipGetLastError();
        grid = cus;
    }
    if (grid < 0) return;
    (void)hipMemsetAsync((char*)d_ws + WS_CTL, 0, CTL_ZERO_BYTES, stream);
    Prm p{};
    const float** pp = (const float**)&p;
    for (int i = 0; i < 23; ++i) pp[i] = (const float*)d_in[i];
    p.out = (float*)d_out; p.ws = (unsigned char*)d_ws;
    p.ph_lo = 0; p.ph_hi = NPHASE; p.li = 0;
    hipLaunchKernelGGL(mega_fwd, dim3(grid), dim3(NTHR), LDS_BYTES, stream, p);
}
```

```cpp
#include <hip/hip_runtime.h>
#include <cstdint>
#include <cstdio>

constexpr int BATCH = 8, SEQ = 4096, DM = 1024, CTXL = 256;
constexpr int NLAT = BATCH * SEQ, NCTX = BATCH * CTXL, NTOK = NLAT + NCTX;
constexpr float ALPHA = 1.4142135623730951f;
constexpr float LN_EPS = 1e-5f;
constexpr float LAMBDA_INIT0 = 0.2f;
constexpr float C2 = 0.125f * 1.4426950408889634f;
constexpr int NEXP = 16, DEXP = 512, MAXSLOT = 73728;
constexpr int NCHUNK = NTOK / 64;
constexpr int NIN = 3328;

typedef unsigned short bf16;
typedef float f32x4 __attribute__((ext_vector_type(4)));
typedef float f32x2 __attribute__((ext_vector_type(2)));
typedef unsigned u32x2 __attribute__((ext_vector_type(2)));
typedef unsigned u32x4 __attribute__((ext_vector_type(4)));

constexpr size_t MiB = 1u << 20;
constexpr size_t WS_CTL = 0, CTL_ZERO_BYTES = 1 * MiB;
constexpr size_t WS_MOD = 1 * MiB;
constexpr size_t WS_MISC = 1 * MiB + 512 * 1024;
constexpr size_t WS_WQKV = 2 * MiB, WS_WO = 5 * MiB, WS_GU0 = 6 * MiB, WS_DN0 = 22 * MiB, WS_WIN = 30 * MiB, WS_WGO = 34 * MiB, WS_GU1 = 35 * MiB, WS_DN1 = 51 * MiB;
constexpr size_t WS_XB = 59 * MiB;
constexpr size_t WS_H = 127 * MiB;
constexpr size_t WS_Q = 195 * MiB, WS_K = 263 * MiB, WS_V = 331 * MiB, WS_O2 = 399 * MiB;
constexpr size_t WS_LIST = 467 * MiB;
constexpr size_t WS_TOKR = 470 * MiB;
constexpr size_t WS_DEC = 472 * MiB;
constexpr size_t WS_ZZ = 475 * MiB;
constexpr size_t WS_END = 480 * MiB;
constexpr size_t WS_O1 = WS_H, WS_A2 = WS_H, WS_Y = WS_K;
constexpr size_t WS_YM = 195 * MiB, WS_ACT = 339 * MiB;
constexpr size_t WS_QR = 195 * MiB, WS_KR = 229 * MiB, WS_V1 = 263 * MiB, WS_R = 331 * MiB;
constexpr size_t WS_QT = WS_H, WS_KT = 399 * MiB;
constexpr size_t WS_A2B = WS_H;
constexpr size_t OUT_OGB = 64 * MiB;
constexpr int CW_TMO = 0, CW_CODE = 1;
constexpr int CW_CNT = 64;
constexpr int CW_KM = 128;
constexpr int CW_BAR = 4096;

__device__ __forceinline__ unsigned f2bf(float f) { unsigned u = __builtin_bit_cast(unsigned, f); return (u + 0x7fffu + ((u >> 16) & 1u)) >> 16; }
__device__ __forceinline__ unsigned pk2(float lo, float hi) { return f2bf(lo) | (f2bf(hi) << 16); }
__device__ __forceinline__ float bf2f(unsigned b) { return __builtin_bit_cast(float, b << 16); }
__device__ __forceinline__ float wave_sum(float v) {
#pragma unroll
    for (int o = 1; o < 64; o <<= 1) v += __shfl_xor(v, o);
    return v;
}
__device__ __forceinline__ float silu_f(float v) { return v / (1.f + __expf(-v)); }

struct Prm {
    const float *x, *c, *ctx, *cctx, *ada_w, *ada_b, *ln_g, *ln_b, *w_qkv, *w_o, *lam, *subln, *gw_in, *gwg_down, *gwg_up, *gbg, *gnorm, *gw_o, *rw, *rb, *mg, *mu, *md;
    float* out; unsigned char* ws;
    int ph_lo, ph_hi, li, pad;
};
__device__ __forceinline__ void ld_row_f32(const float* p, int lane, f32x4 (&v)[4]) {
#pragma unroll
    for (int j = 0; j < 4; ++j) v[j] = *(const f32x4*)(p + 4 * lane + 256 * j);
}
__device__ __forceinline__ void st_row_f32(float* p, int lane, const f32x4 (&v)[4]) {
#pragma unroll
    for (int j = 0; j < 4; ++j) *(f32x4*)(p + 4 * lane + 256 * j) = v[j];
}
__device__ __forceinline__ void ld_row_bf16(const bf16* p, int lane, f32x4 (&v)[4]) {
#pragma unroll
    for (int j = 0; j < 4; ++j) { const u32x2 u = *(const u32x2*)(p + 4 * lane + 256 * j); v[j] = (f32x4){bf2f(u.x & 0xffffu), bf2f(u.x >> 16), bf2f(u.y & 0xffffu), bf2f(u.y >> 16)}; }
}
__device__ __forceinline__ void st_row_bf16(bf16* p, int lane, const f32x4 (&v)[4]) {
#pragma unroll
    for (int j = 0; j < 4; ++j) { u32x2 u; u.x = pk2(v[j].x, v[j].y); u.y = pk2(v[j].z, v[j].w); *(u32x2*)(p + 4 * lane + 256 * j) = u; }
}
__device__ __forceinline__ void ln_row(f32x4 (&v)[4], const float* g, const float* b, int lane) {
    float s = 0.f;
#pragma unroll
    for (int j = 0; j < 4; ++j) s += (v[j].x + v[j].y) + (v[j].z + v[j].w);
    const float mean = wave_sum(s) * (1.f / DM); float q = 0.f;
#pragma unroll
    for (int j = 0; j < 4; ++j) { v[j] = v[j] - mean; q += (v[j].x * v[j].x + v[j].y * v[j].y) + (v[j].z * v[j].z + v[j].w * v[j].w); }
    const float rstd = 1.f / sqrtf(wave_sum(q) * (1.f / DM) + LN_EPS);
#pragma unroll
    for (int j = 0; j < 4; ++j) { const f32x4 gg = *(const f32x4*)(g + 4 * lane + 256 * j), bb = *(const f32x4*)(b + 4 * lane + 256 * j); v[j] = v[j] * rstd * gg + bb; }
}
__host__ __device__ __forceinline__ int gu_phys(int other, int sel) { return (other >> 4) * 32 + sel * 16 + (other & 15); }
__host__ __device__ __forceinline__ int perm16b(int L) { return (L & ~31) | (16 * ((L >> 2) & 1) + 4 * ((L >> 3) & 3) + (L & 3)); }
__host__ __device__ __forceinline__ int perm16b_inv(int P) { return (P & ~31) | (8 * ((P >> 2) & 3) + 4 * ((P >> 4) & 1) + (P & 3)); }
__device__ __forceinline__ unsigned pk4_fp8(float a, float b, float c, float d) { int w = 0; w = __builtin_amdgcn_cvt_pk_fp8_f32(a, b, w, false); w = __builtin_amdgcn_cvt_pk_fp8_f32(c, d, w, true); return (unsigned)w; }
constexpr float W8_SCALE = 64.f, W8_INV = 1.f / 64.f;
__device__ __forceinline__ void st_row_fp8(unsigned char* p, int lane, const f32x4 (&v)[4]) {
#pragma unroll
    for (int j = 0; j < 4; ++j) *(unsigned*)(p + 4 * lane + 256 * j) = pk4_fp8(v[j].x, v[j].y, v[j].z, v[j].w);
}
__device__ __forceinline__ void ld_row_fp8(const unsigned char* p, int lane, f32x4 (&v)[4]) {
#pragma unroll
    for (int j = 0; j < 4; ++j) { const int w = *(const int*)(p + 4 * lane + 256 * j); const f32x2 lo = __builtin_amdgcn_cvt_pk_f32_fp8(w, false), hi = __builtin_amdgcn_cvt_pk_f32_fp8(w, true); v[j] = (f32x4){lo.x, lo.y, hi.x, hi.y}; }
}
#define GAS __attribute__((address_space(1)))
#define LAS __attribute__((address_space(3)))
constexpr int NWAVES = 8, NTHR = NWAVES * 64;
constexpr int RING_BYTES = 131072, LDS_BYTES = 147456, LDSCTL_OFF = LDS_BYTES - 1024, MISC_OFF = LDSCTL_OFF + 320;
constexpr int LDSX_OFF = RING_BYTES + 1024;
#define LDS_WAIT() asm volatile("s_waitcnt lgkmcnt(0)" ::: "memory")
#define VM_WAIT() asm volatile("s_waitcnt vmcnt(0)" ::: "memory")

struct Frame {
    unsigned char* lds;
    unsigned* ctl;
    int tid, lane, wave, G, bid;
};

template <int MODE>
__device__ __forceinline__ void p0_transpose_item(const float* W, int K, int N, bf16* WT, int row_off, float* scr, int item, int lane) {
    const int nblk = N / 32, kb = item / nblk, nb = item % nblk, k0 = 64 * kb, n0 = 32 * nb;
    { f32x4 t[8];
#pragma unroll
        for (int i = 0; i < 8; ++i) t[i] = *(const f32x4*)(W + (size_t)(k0 + 8 * i + (lane >> 3)) * N + n0 + 4 * (lane & 7));
#pragma unroll
        for (int i = 0; i < 8; ++i) { float* d = scr + (8 * i + (lane >> 3)) * 33 + 4 * (lane & 7); d[0] = t[i].x; d[1] = t[i].y; d[2] = t[i].z; d[3] = t[i].w; } }
    LDS_WAIT(); asm volatile("" ::: "memory");
    const int c = lane & 7;
#pragma unroll
    for (int j = 0; j < 4; ++j) { const int n = (lane >> 3) + 8 * j; const float* s = scr + (8 * c) * 33 + n;
        u32x4 o; o.x = pk2(s[0 * 33], s[1 * 33]); o.y = pk2(s[2 * 33], s[3 * 33]); o.z = pk2(s[4 * 33], s[5 * 33]); o.w = pk2(s[6 * 33], s[7 * 33]);
        const int nl = n0 + n; const int pr = (MODE == 0) ? (row_off + nl) : (MODE == 3) ? (row_off + perm16b(nl)) : (row_off + gu_phys(nl, MODE - 1));
        *(u32x4*)(WT + (size_t)pr * K + k0 + 8 * c) = o; }
    LDS_WAIT(); asm volatile("" ::: "memory");
}
template <int MODE>
__device__ __forceinline__ void p0_transpose_item8(const float* W, int K, int N, unsigned char* WT, float* scr, int item, int lane) {
    const int nblk = N / 32, kb = item / nblk, nb = item % nblk, k0 = 64 * kb, n0 = 32 * nb;
    { f32x4 t[8];
#pragma unroll
        for (int i = 0; i < 8; ++i) t[i] = *(const f32x4*)(W + (size_t)(k0 + 8 * i + (lane >> 3)) * N + n0 + 4 * (lane & 7));
#pragma unroll
        for (int i = 0; i < 8; ++i) { float* d = scr + (8 * i + (lane >> 3)) * 33 + 4 * (lane & 7); d[0] = t[i].x; d[1] = t[i].y; d[2] = t[i].z; d[3] = t[i].w; } }
    LDS_WAIT(); asm volatile("" ::: "memory");
    const int c = lane & 7;
#pragma unroll
    for (int j = 0; j < 4; ++j) { const int n = (lane >> 3) + 8 * j; const float* s = scr + (8 * c) * 33 + n;
        u32x2 o; o.x = pk4_fp8(s[0 * 33] * W8_SCALE, s[1 * 33] * W8_SCALE, s[2 * 33] * W8_SCALE, s[3 * 33] * W8_SCALE); o.y = pk4_fp8(s[4 * 33] * W8_SCALE, s[5 * 33] * W8_SCALE, s[6 * 33] * W8_SCALE, s[7 * 33] * W8_SCALE);
        const int nl = n0 + n; const int pr = (MODE == 3) ? perm16b(nl) : (MODE == 0) ? nl : gu_phys(nl, MODE - 1);
        *(u32x2*)(WT + (size_t)pr * K + k0 + 8 * c) = o; }
    LDS_WAIT(); asm volatile("" ::: "memory");
}
__device__ __forceinline__ void phase_prologue(const Frame& F, const Prm& p) {
    float* sil = (float*)F.lds;
    for (int i = F.tid; i < 9 * 1024; i += NTHR) { const int r = i >> 10, k = i & 1023; const float v = (r < 8) ? p.c[r * 1024 + k] : p.cctx[k]; sil[i] = silu_f(v); }
    __syncthreads();
    float* MOD = (float*)(p.ws + WS_MOD);
    if (F.bid < 192) {
        const int layer = F.bid / 96, n = (F.bid % 96) * 64 + F.lane; const float* W = p.ada_w + (size_t)layer * 1024 * 6144 + n;
        float acc[9];
#pragma unroll
        for (int r = 0; r < 9; ++r) acc[r] = 0.f;
        const int kb = F.wave * 128;
#pragma unroll 4
        for (int k = kb; k < kb + 128; k += 4) {
            const float w0 = W[(size_t)k * 6144], w1 = W[(size_t)(k + 1) * 6144], w2 = W[(size_t)(k + 2) * 6144], w3 = W[(size_t)(k + 3) * 6144];
#pragma unroll
            for (int r = 0; r < 9; ++r) { const f32x4 s = *(const f32x4*)(sil + r * 1024 + k); acc[r] += s.x * w0 + s.y * w1 + s.z * w2 + s.w * w3; }
        }
        float* red = (float*)(F.lds + 36864 + 8 * 8704);
#pragma unroll
        for (int r = 0; r < 9; ++r) red[(F.wave * 9 + r) * 64 + F.lane] = acc[r];
        __syncthreads();
        if (F.wave == 0) { const float bb = p.ada_b[layer * 6144 + n];
#pragma unroll
            for (int r = 0; r < 9; ++r) { float t = bb;
#pragma unroll
                for (int w = 0; w < 8; ++w) t += red[(w * 9 + r) * 64 + F.lane];
                MOD[(layer * 9 + r) * 6144 + n] = t; } }
    }
    float* misc = (float*)(p.ws + WS_MISC);
    if (F.bid == 255 % F.G && F.wave == 1) {
        const float a = wave_sum(p.lam[F.lane] * p.lam[64 + F.lane]), b = wave_sum(p.lam[128 + F.lane] * p.lam[192 + F.lane]);
        if (F.lane == 0) misc[0] = __expf(a) - __expf(b) + LAMBDA_INIT0;
        for (int i = F.lane; i < 1024; i += 64) { const int pos = i >> 4, f = i & 15; const float inv = powf(10000.f, -(float)f / 16.f); const float ang = (float)pos * inv;
            misc[1024 + 2 * i] = cosf(ang); misc[1024 + 2 * i + 1] = sinf(ang); }
    }
    float* scr = (float*)(F.lds + 36864 + F.wave * 8704);
    const int gw = F.bid * NWAVES + F.wave, NGW = F.G * NWAVES;
    constexpr int I_QKV = 16 * 96, I_SQ = 16 * 32, I_G = 16 * 16, I_D = 8 * 32;
    constexpr int I_MOE = 2 * I_G + I_D;
    constexpr int NITEMS = 2 * I_QKV + 2 * I_SQ + 32 * I_MOE;
    bf16* ws16 = (bf16*)p.ws;
    for (int it = gw; it < NITEMS; it += NGW) {
        int r = it;
        if (r < I_QKV) { if ((r % 96) < 64) p0_transpose_item8<0>(p.w_qkv, 1024, 3072, p.ws + WS_WQKV, scr, r, F.lane); else p0_transpose_item8<3>(p.w_qkv, 1024, 3072, p.ws + WS_WQKV, scr, r, F.lane); continue; } r -= I_QKV;
        if (r < I_QKV) { p0_transpose_item8<3>(p.gw_in, 1024, 3072, p.ws + WS_WIN, scr, r, F.lane); continue; } r -= I_QKV;
        if (r < I_SQ) { p0_transpose_item8<3>(p.w_o, 1024, 1024, p.ws + WS_WO, scr, r, F.lane); continue; } r -= I_SQ;
        if (r < I_SQ) { p0_transpose_item8<3>(p.gw_o, 1024, 1024, p.ws + WS_WGO, scr, r, F.lane); continue; } r -= I_SQ;
        const int le = r / I_MOE, layer = le >> 4, e = le & 15; r -= le * I_MOE;
        unsigned char* GU = p.ws + (layer ? WS_GU1 : WS_GU0) + (size_t)e * 1024 * 1024; unsigned char* DN = p.ws + (layer ? WS_DN1 : WS_DN0) + (size_t)e * 1024 * 512;
        if (r < I_G) { p0_transpose_item8<1>(p.mg + (size_t)le * 1024 * 512, 1024, 512, GU, scr, r, F.lane); continue; } r -= I_G;
        if (r < I_G) { p0_transpose_item8<2>(p.mu + (size_t)le * 1024 * 512, 1024, 512, GU, scr, r, F.lane); continue; } r -= I_G;
        p0_transpose_item8<3>(p.md + (size_t)le * 512 * 1024, 512, 1024, DN, scr, r, F.lane);
    }
    (void)ws16;
    unsigned char* WIN = p.ws + WS_WIN;
    for (int i = gw * 64 + F.lane; i < 32 * 256; i += NGW * 64) { const int rr = i >> 8, k = (i & 255) * 4, dir = rr >> 4, j = rr & 15; const float* s = p.gwg_down + (size_t)dir * 1024 * 16 + j;
        *(unsigned*)(WIN + (size_t)(3072 + rr) * 1024 + k) = pk4_fp8(s[(size_t)k * 16] * W8_SCALE, s[(size_t)(k + 1) * 16] * W8_SCALE, s[(size_t)(k + 2) * 16] * W8_SCALE, s[(size_t)(k + 3) * 16] * W8_SCALE); }
    for (int i = gw * 64 + F.lane; i < 224 * 1024 / 16; i += NGW * 64) *(u32x4*)(WIN + (size_t)3104 * 1024 + (size_t)i * 16) = (u32x4){0u, 0u, 0u, 0u};
}

__device__ __forceinline__ void phase_modulate0(const Frame& F, const Prm& p) {
    const float* MOD = (const float*)(p.ws + WS_MOD); unsigned char* H = p.ws + WS_H;
    const int gw = F.bid * NWAVES + F.wave, NGW = F.G * NWAVES, per = (NTOK + NGW - 1) / NGW;
    int curmod = -1; f32x4 sh[4], sc[4];
    const int t0 = gw * per, t1 = min(NTOK, (gw + 1) * per);
    f32x4 v[4], vn[4];
    if (t0 < t1) ld_row_f32(t0 < NLAT ? p.x + (size_t)t0 * DM : p.ctx + (size_t)(t0 - NLAT) * DM, F.lane, v);
    for (int tok = t0; tok < t1; ++tok) {
        if (tok + 1 < t1) ld_row_f32(tok + 1 < NLAT ? p.x + (size_t)(tok + 1) * DM : p.ctx + (size_t)(tok + 1 - NLAT) * DM, F.lane, vn);
        const int mr = tok < NLAT ? tok / SEQ : 8;
        if (mr != curmod) { curmod = mr; ld_row_f32(MOD + mr * 6144, F.lane, sh); ld_row_f32(MOD + mr * 6144 + 1024, F.lane, sc); }
#pragma unroll
        for (int j = 0; j < 4; ++j) v[j] = v[j] * (1.f + sc[j]) + sh[j];
        st_row_fp8(H + (size_t)tok * DM, F.lane, v);
#pragma unroll
        for (int j = 0; j < 4; ++j) v[j] = vn[j];
    }
}

__device__ __forceinline__ void phase_ln_route(const Frame& F, const Prm& p, int layer) {
    const int nrows = layer ? NLAT : NTOK;
    const float* MOD = (const float*)(p.ws + WS_MOD) + layer * 9 * 6144;
    const bf16* Y = (const bf16*)(p.ws + WS_Y); unsigned char* HF = p.ws + WS_H;
    bf16* XB = (bf16*)(p.ws + WS_XB);
    int* LIST = (int*)(p.ws + WS_LIST); int* TOKR = (int*)(p.ws + WS_TOKR);
    unsigned* CNT = F.ctl + CW_CNT + layer * 16;
    float* WrT = (float*)F.lds;
    int* rec = (int*)(F.lds + 65536);
    unsigned* lcnt = (unsigned*)(F.lds + 65536 + 8192); unsigned* lbase = lcnt + 16;
    for (int i = F.tid; i < 16 * 1024; i += NTHR) { const int k = i >> 4, e = i & 15; WrT[e * 1024 + k] = p.rw[i]; }
    if (F.tid < 16) lcnt[F.tid] = 0u;
    __syncthreads();
    const int per_wg = (nrows + F.G - 1) / F.G, per_w = (per_wg + NWAVES - 1) / NWAVES;
    const int row_lo = F.bid * per_wg, row_hi = min(nrows, row_lo + per_wg);
    const float* lng = p.ln_g + (layer * 2 + 0) * DM; const float* lnb = p.ln_b + (layer * 2 + 0) * DM;
    float rb[16];
#pragma unroll
    for (int e = 0; e < 16; ++e) rb[e] = p.rb[e];
    int curmod = -1; f32x4 gm[4], shf[4], scf[4];
    f32x4 v[4], y[4], vn[4], yn[4];
#define LNR_LOAD(tok_, V, Yv) do { if (layer) ld_row_bf16(XB + (size_t)(tok_) * DM, F.lane, V); else ld_row_f32((tok_) < NLAT ? p.x + (size_t)(tok_) * DM : p.ctx + (size_t)((tok_) - NLAT) * DM, F.lane, V); \
        ld_row_bf16(Y + (size_t)(tok_) * DM, F.lane, Yv); } while (0)
    if (row_lo + F.wave * per_w < row_hi) LNR_LOAD(row_lo + F.wave * per_w, v, y);
    for (int i = 0; i < per_w; ++i) {
        const int lr = F.wave * per_w + i, tok = row_lo + lr; if (tok >= row_hi) break;
        if (i + 1 < per_w && tok + 1 < row_hi) LNR_LOAD(tok + 1, vn, yn);
        const int mr = tok < NLAT ? tok / SEQ : 8;
        if (mr != curmod) { curmod = mr; ld_row_f32(MOD + mr * 6144 + 2048, F.lane, gm); ld_row_f32(MOD + mr * 6144 + 3072, F.lane, shf); ld_row_f32(MOD + mr * 6144 + 4096, F.lane, scf); }
        bf16* xdst = XB + (size_t)tok * DM;
#pragma unroll
        for (int j = 0; j < 4; ++j) v[j] = ALPHA * v[j] + gm[j] * y[j];
        ln_row(v, lng, lnb, F.lane);
        st_row_bf16(xdst, F.lane, v);
#pragma unroll
        for (int j = 0; j < 4; ++j) v[j] = v[j] * (1.f + scf[j]) + shf[j];
        st_row_fp8(HF + (size_t)tok * DM, F.lane, v);
        float part[16];
#pragma unroll
        for (int e = 0; e < 16; ++e) { float s = 0.f;
#pragma unroll
            for (int j = 0; j < 4; ++j) { const f32x4 w = *(const f32x4*)(WrT + e * 1024 + 4 * F.lane + 256 * j); s += (v[j].x * w.x + v[j].y * w.y) + (v[j].z * w.z + v[j].w * w.w); }
            part[e] = s; }
        {
#pragma unroll
            for (int e = 0; e < 8; ++e) { const bool up = (F.lane & 32) != 0; const float keep = up ? part[e + 8] : part[e], send = up ? part[e] : part[e + 8]; part[e] = keep + __shfl_xor(send, 32); }
#pragma unroll
            for (int e = 0; e < 4; ++e) { const bool up = (F.lane & 16) != 0; const float keep = up ? part[e + 4] : part[e], send = up ? part[e] : part[e + 4]; part[e] = keep + __shfl_xor(send, 16); }
#pragma unroll
            for (int e = 0; e < 2; ++e) { const bool up = (F.lane & 8) != 0; const float keep = up ? part[e + 2] : part[e], send = up ? part[e] : part[e + 2]; part[e] = keep + __shfl_xor(send, 8); }
            { const bool up = (F.lane & 4) != 0; const float keep = up ? part[1] : part[0], send = up ? part[0] : part[1]; part[0] = keep + __shfl_xor(send, 4); }
            part[0] += __shfl_xor(part[0], 2); part[0] += __shfl_xor(part[0], 1);
        }
        float aff[16], sel[16];
#pragma unroll
        for (int e = 0; e < 16; ++e) { const int src = ((e >> 3) & 1) * 32 + ((e >> 2) & 1) * 16 + ((e >> 1) & 1) * 8 + (e & 1) * 4; const float lg = __shfl(part[0], src); aff[e] = 1.f / (1.f + __expf(-lg)); sel[e] = aff[e] + rb[e]; }
        int bg = 0; float bgs = -3.0e38f;
#pragma unroll
        for (int g = 0; g < 4; ++g) { float m1 = -3.0e38f, m2 = -3.0e38f;
#pragma unroll
            for (int k = 0; k < 4; ++k) { const float s = sel[4 * g + k]; if (s > m1) { m2 = m1; m1 = s; } else if (s > m2) m2 = s; }
            const float gs = m1 + m2; if (gs > bgs) { bgs = gs; bg = g; } }
        int i1 = 0, i2 = 0; float s1 = -3.0e38f, s2 = -3.0e38f, a1 = 0.f, a2 = 0.f;
#pragma unroll
        for (int g = 0; g < 4; ++g) if (g == bg) {
#pragma unroll
            for (int k = 0; k < 4; ++k) { const float s = sel[4 * g + k], a = aff[4 * g + k];
                if (s > s1) { s2 = s1; i2 = i1; a2 = a1; s1 = s; i1 = 4 * g + k; a1 = a; } else if (s > s2) { s2 = s; i2 = 4 * g + k; a2 = a; } } }
        const float wsum = a1 + a2, w1 = a1 / wsum, w2 = a2 / wsum;
        if (F.lane == 0) { const unsigned l1 = atomicAdd(&lcnt[i1], 1u), l2 = atomicAdd(&lcnt[i2], 1u);
            rec[lr * 6 + 0] = i1; rec[lr * 6 + 1] = i2; rec[lr * 6 + 2] = (int)l1; rec[lr * 6 + 3] = (int)l2; rec[lr * 6 + 4] = __float_as_int(w1); rec[lr * 6 + 5] = __float_as_int(w2); }
#pragma unroll
        for (int j = 0; j < 4; ++j) { v[j] = vn[j]; y[j] = yn[j]; }
    }
#undef LNR_LOAD
    __syncthreads();
    if (F.tid < 16) lbase[F.tid] = __hip_atomic_fetch_add(&CNT[F.tid], lcnt[F.tid], __ATOMIC_RELAXED, __HIP_MEMORY_SCOPE_AGENT);
    __syncthreads();
    for (int lr = F.tid; lr < row_hi - row_lo; lr += NTHR) { const int tok = row_lo + lr;
        const int e0 = rec[lr * 6], e1 = rec[lr * 6 + 1]; const int p0 = (int)lbase[e0] + rec[lr * 6 + 2], p1 = (int)lbase[e1] + rec[lr * 6 + 3];
        LIST[e0 * NTOK + p0] = tok; LIST[e1 * NTOK + p1] = tok;
        int* tr = TOKR + (size_t)tok * 8; tr[0] = e0; tr[1] = p0; tr[2] = e1; tr[3] = p1; tr[4] = rec[lr * 6 + 4]; tr[5] = rec[lr * 6 + 5]; }
    __syncthreads();
}

__device__ __forceinline__ void pad_bases(const unsigned* cnt, int (&pb)[17]) {
    int acc = 0;
#pragma unroll
    for (int e = 0; e < 16; ++e) { pb[e] = acc; const int c = (int)__hip_atomic_load(cnt + e, __ATOMIC_RELAXED, __HIP_MEMORY_SCOPE_AGENT); acc += (c + 255) & ~255; }
    pb[16] = acc;
}

__device__ __forceinline__ void phase_moe_combine(const Frame& F, const Prm& p, int layer) {
    const int nrows = layer ? NLAT : NTOK;
    const float* MOD = (const float*)(p.ws + WS_MOD) + layer * 9 * 6144; const float* MOD1 = (const float*)(p.ws + WS_MOD) + 9 * 6144;
    const unsigned char* YM = p.ws + WS_YM;   unsigned char* H = p.ws + WS_H;   bf16* XB = (bf16*)(p.ws + WS_XB); const int* TOKR = (const int*)(p.ws + WS_TOKR);
    int pb[17]; pad_bases(F.ctl + CW_CNT + layer * 16, pb);
    int* pbl = (int*)F.lds; if (F.tid < 17) { int v = 0;
#pragma unroll
        for (int e = 0; e < 17; ++e) if (e == F.tid) v = pb[e];
        pbl[F.tid] = v; }
    __syncthreads();
    const float* lng = p.ln_g + (layer * 2 + 1) * DM; const float* lnb = p.ln_b + (layer * 2 + 1) * DM;
    const int gw = F.bid * NWAVES + F.wave, NGW = F.G * NWAVES, per = (nrows + NGW - 1) / NGW;
    int curmod = -1; f32x4 gf[4], sh1[4], sc1[4];
    typedef int i32x4r __attribute__((ext_vector_type(4)));
    const int t0 = gw * per, t1 = min(nrows, (gw + 1) * per);
    i32x4r ra = {0, 0, 0, 0}, rb = {0, 0, 0, 0}, rc = {0, 0, 0, 0}; f32x2 wa = {0.f, 0.f}, wb = {0.f, 0.f}, wc = {0.f, 0.f};
#define MC_REC(tok_, R, W) do { const int* tr_ = TOKR + (size_t)(tok_) * 8; R = *(const i32x4r*)tr_; W = *(const f32x2*)(tr_ + 4); } while (0)
#define MC_ROWS(tok_, R, V, A, B) do { ld_row_bf16(XB + (size_t)(tok_) * DM, F.lane, V); ld_row_fp8(YM + (size_t)(pbl[R.x] + R.y) * DM, F.lane, A); ld_row_fp8(YM + (size_t)(pbl[R.z] + R.w) * DM, F.lane, B); } while (0)
    f32x4 v[4], a[4], b[4], vn[4], an[4], bn[4];
    if (t0 < t1) { MC_REC(t0, ra, wa); if (t0 + 1 < t1) MC_REC(t0 + 1, rb, wb); MC_ROWS(t0, ra, v, a, b); }
    for (int tok = t0; tok < t1; ++tok) {
        if (tok + 1 < t1) MC_ROWS(tok + 1, rb, vn, an, bn);
        if (tok + 2 < t1) MC_REC(tok + 2, rc, wc);
        const int mr = tok < NLAT ? tok / SEQ : 8;
        if (mr != curmod) { curmod = mr; ld_row_f32(MOD + mr * 6144 + 5120, F.lane, gf); if (!layer) { ld_row_f32(MOD1 + mr * 6144, F.lane, sh1); ld_row_f32(MOD1 + mr * 6144 + 1024, F.lane, sc1); } }
        const float w0 = wa.x, w1 = wa.y;
        bf16* xp = XB + (size_t)tok * DM;
#pragma unroll
        for (int j = 0; j < 4; ++j) v[j] = ALPHA * v[j] + gf[j] * (w0 * a[j] + w1 * b[j]);
        ln_row(v, lng, lnb, F.lane);
        if (layer) st_row_f32(p.out + (size_t)tok * DM, F.lane, v); else st_row_bf16(xp, F.lane, v);
        if (!layer) {
#pragma unroll
            for (int j = 0; j < 4; ++j) v[j] = v[j] * (1.f + sc1[j]) + sh1[j];
            st_row_fp8(H + (size_t)tok * DM, F.lane, v);
        }
#pragma unroll
        for (int j = 0; j < 4; ++j) { v[j] = vn[j]; a[j] = an[j]; b[j] = bn[j]; }
        ra = rb; wa = wb; rb = rc; wb = wc;
    }
#undef MC_REC
#undef MC_ROWS
}

__device__ __forceinline__ void phase_gla_prep(const Frame& F, const Prm& p) {
    typedef short bf16x8v __attribute__((ext_vector_type(8))); typedef float f32x16v __attribute__((ext_vector_type(16)));
    const bf16* QR = (const bf16*)(p.ws + WS_QR); const bf16* KR = (const bf16*)(p.ws + WS_KR); const float* ZZ = (const float*)(p.ws + WS_ZZ);
    bf16* QT = (bf16*)(p.ws + WS_QT); bf16* KT = (bf16*)(p.ws + WS_KT); float* DEC = (float*)(p.ws + WS_DEC);
    const int gw = F.bid * NWAVES + F.wave, NGW = F.G * NWAVES, r = F.lane & 31, hh = F.lane >> 5;
    for (int task = gw; task < 2 * NCHUNK * 8; task += NGW) {
        const int dh = task & 7, chunk = (task >> 3) % NCHUNK, dir = __builtin_amdgcn_readfirstlane(task / (8 * NCHUNK));
        const int tok0 = chunk * 64;
        bf16x8v af[2], bfr[2];
#pragma unroll
        for (int tb = 0; tb < 2; ++tb) { const float* zp = ZZ + (size_t)(tok0 + 32 * tb + r) * 32 + dir * 16 + 8 * hh; const f32x4 z0 = *(const f32x4*)zp, z1 = *(const f32x4*)(zp + 4);
            u32x4 w; w.x = pk2(z0.x, z0.y); w.y = pk2(z0.z, z0.w); w.z = pk2(z1.x, z1.y); w.w = pk2(z1.z, z1.w); af[tb] = __builtin_bit_cast(bf16x8v, w); }
        float bgv[2];
#pragma unroll
        for (int cb = 0; cb < 2; ++cb) { const float* wp = p.gwg_up + (size_t)dir * 16 * 512 + (size_t)(8 * hh) * 512 + dh * 64 + 2 * r + cb; float wv[8];
#pragma unroll
            for (int i = 0; i < 8; ++i) wv[i] = wp[(size_t)i * 512];
            u32x4 w; w.x = pk2(wv[0], wv[1]); w.y = pk2(wv[2], wv[3]); w.z = pk2(wv[4], wv[5]); w.w = pk2(wv[6], wv[7]); bfr[cb] = __builtin_bit_cast(bf16x8v, w);
            bgv[cb] = p.gbg[dir * 512 + dh * 64 + 2 * r + cb]; }
        f32x16v Z[2][2];
#pragma unroll
        for (int tb = 0; tb < 2; ++tb)
#pragma unroll
            for (int cb = 0; cb < 2; ++cb) { const f32x16v zero = {}; Z[tb][cb] = __builtin_amdgcn_mfma_f32_32x32x16_bf16(af[tb], bfr[cb], zero, 0, 0, 0); }
#pragma unroll
        for (int tb = 0; tb < 2; ++tb)
#pragma unroll
            for (int cb = 0; cb < 2; ++cb)
#pragma unroll
                for (int i = 0; i < 16; ++i) { const float z = Z[tb][cb][i] + bgv[cb]; Z[tb][cb][i] = (fminf(z, 0.f) - __logf(1.f + __expf(-fabsf(z)))) * (1.f / 16.f); }
        float tot[2];
#pragma unroll
        for (int cb = 0; cb < 2; ++cb) {
            float T[2][4], PT[2][4];
            if (!dir) {
#pragma unroll
                for (int tb = 0; tb < 2; ++tb)
#pragma unroll
                    for (int gi = 0; gi < 4; ++gi) { float run = 0.f;
#pragma unroll
                        for (int w = 0; w < 4; ++w) { run += Z[tb][cb][4 * gi + w]; Z[tb][cb][4 * gi + w] = run; }
                        T[tb][gi] = run; }
            } else {
#pragma unroll
                for (int tb = 0; tb < 2; ++tb)
#pragma unroll
                    for (int gi = 0; gi < 4; ++gi) { float run = 0.f;
#pragma unroll
                        for (int w = 3; w >= 0; --w) { run += Z[tb][cb][4 * gi + w]; Z[tb][cb][4 * gi + w] = run; }
                        T[tb][gi] = run; }
            }
#pragma unroll
            for (int tb = 0; tb < 2; ++tb)
#pragma unroll
                for (int gi = 0; gi < 4; ++gi) PT[tb][gi] = __shfl_xor(T[tb][gi], 32);
            float running = 0.f;
            if (!dir) {
#pragma unroll
                for (int tb = 0; tb < 2; ++tb)
#pragma unroll
                    for (int gi = 0; gi < 4; ++gi) { const float first = hh ? PT[tb][gi] : T[tb][gi], second = hh ? T[tb][gi] : PT[tb][gi];
                        const float mine = hh ? running + first : running; running += first + second;
#pragma unroll
                        for (int w = 0; w < 4; ++w) Z[tb][cb][4 * gi + w] += mine; }
            } else {
#pragma unroll
                for (int tb = 1; tb >= 0; --tb)
#pragma unroll
                    for (int gi = 3; gi >= 0; --gi) { const float first = hh ? T[tb][gi] : PT[tb][gi], second = hh ? PT[tb][gi] : T[tb][gi];
                        const float mine = hh ? running : running + first; running += first + second;
#pragma unroll
                        for (int w = 0; w < 4; ++w) Z[tb][cb][4 * gi + w] += mine; }
            }
            tot[cb] = running;
        }
        if (hh == 0) {
#pragma unroll
            for (int cb = 0; cb < 2; ++cb) DEC[((size_t)dir * NCHUNK + chunk) * 512 + dh * 64 + 2 * r + cb] = __expf(tot[cb]);
        }
        const bf16* qi = QR + ((size_t)dh * NTOK + tok0) * 64 + 2 * r; const bf16* ki = KR + ((size_t)dh * NTOK + tok0) * 64 + 2 * r;
        bf16* qo = QT + (((size_t)dir * 8 + dh) * NTOK + tok0) * 64 + 2 * r; bf16* ko = KT + (((size_t)dir * 8 + dh) * NTOK + tok0) * 64 + 2 * r;
#pragma unroll
        for (int tb = 0; tb < 2; ++tb) {
            unsigned qv[16], kv[16];
#pragma unroll
            for (int i = 0; i < 16; ++i) { const int t = 32 * tb + (i & 3) + 8 * (i >> 2) + 4 * hh; qv[i] = *(const unsigned*)(qi + (size_t)t * 64); kv[i] = *(const unsigned*)(ki + (size_t)t * 64); }
#pragma unroll
            for (int i = 0; i < 16; ++i) { const int t = 32 * tb + (i & 3) + 8 * (i >> 2) + 4 * hh;
                const float e0 = __expf(Z[tb][0][i]), e1 = __expf(Z[tb][1][i]), i0 = __builtin_amdgcn_rcpf(e0), i1 = __builtin_amdgcn_rcpf(e1);
                *(unsigned*)(qo + (size_t)t * 64) = pk2(bf2f(qv[i] & 0xffffu) * e0, bf2f(qv[i] >> 16) * e1);
                *(unsigned*)(ko + (size_t)t * 64) = pk2(bf2f(kv[i] & 0xffffu) * i0, bf2f(kv[i] >> 16) * i1); }
        }
    }
}

__device__ __forceinline__ void phase_gla_post(const Frame& F, const Prm& p) {
    const bf16* OF = (const bf16*)p.out; const bf16* OB = (const bf16*)((const unsigned char*)p.out + OUT_OGB); const bf16* R = (const bf16*)(p.ws + WS_R); unsigned char* A2 = p.ws + WS_A2B;
    const f32x4 ng = *(const f32x4*)(p.gnorm + 4 * F.lane);
    const int gw = F.bid * NWAVES + F.wave, NGW = F.G * NWAVES;
    f32x4 a[4], b[4], r[4], an[4], bn[4], rn[4];
    if (gw < NLAT) { ld_row_bf16(OF + (size_t)gw * DM, F.lane, a); ld_row_bf16(OB + (size_t)gw * DM, F.lane, b); ld_row_bf16(R + (size_t)gw * DM, F.lane, r); }
    for (int tok = gw; tok < NLAT; tok += NGW) {
        if (tok + NGW < NLAT) { ld_row_bf16(OF + (size_t)(tok + NGW) * DM, F.lane, an); ld_row_bf16(OB + (size_t)(tok + NGW) * DM, F.lane, bn); ld_row_bf16(R + (size_t)(tok + NGW) * DM, F.lane, rn); }
#pragma unroll
        for (int j = 0; j < 4; ++j) {
            const f32x4 o = a[j] + b[j]; const float q = wave_sum((o.x * o.x + o.y * o.y) + (o.z * o.z + o.w * o.w));
            const float rs = 1.f / sqrtf(q * (1.f / 256.f) + LN_EPS);
            a[j] = (f32x4){o.x * rs * ng.x * silu_f(r[j].x), o.y * rs * ng.y * silu_f(r[j].y), o.z * rs * ng.z * silu_f(r[j].z), o.w * rs * ng.w * silu_f(r[j].w)};
        }
        st_row_fp8(A2 + (size_t)tok * DM, F.lane, a);
#pragma unroll
        for (int j = 0; j < 4; ++j) { a[j] = an[j]; b[j] = bn[j]; r[j] = rn[j]; }
    }
}
namespace pg8 {
typedef short bf16x8 __attribute__((ext_vector_type(8)));
constexpr int BM = 256, BK = 64, HALF = 128, HTB = HALF * BK * 2, STAGE_BYTES = 8 * HTB, NXCD = 8, WGM = 8;
__host__ __device__ __forceinline__ int lds_byte(int r, int c) { const int st = (r >> 4) * 2 + (c >> 5), rr = r & 15, cc = c & 31, ob = rr * 64 + cc * 2; return st * 1024 + (ob ^ (((ob >> 9) & 1) << 5)); }
__host__ __device__ __forceinline__ void stage_rc(int b, int& R, int& C) { const int st = b / 1024, sb = b % 1024, swz = sb ^ (((sb >> 9) & 1) << 5); R = (st >> 1) * 16 + swz / 64; C = (st & 1) * 32 + (swz % 64) / 2; }
typedef float f32x2_t __attribute__((ext_vector_type(2))); typedef __bf16 bf16x2_t __attribute__((ext_vector_type(2)));
__device__ __forceinline__ unsigned cvt_pk_bf16(float lo, float hi) { f32x2_t v = {lo, hi}; bf16x2_t b = __builtin_convertvector(v, bf16x2_t); return __builtin_bit_cast(unsigned, b); }

struct Unit { int pm, pn; int row0; int e; int cnt; const bf16* Bt; };

struct DenseOrder {
    int nM, nN, nwg, G, c, K; const bf16* Bt;
    __device__ void init(int M, int N, int K_, const bf16* Bt_, int G_, int c_) { nM = M / BM; nN = N / BM; nwg = nM * nN; G = G_; c = c_; K = K_; Bt = Bt_; }
    __device__ bool next(int i, Unit& u) const {
        const long L = (long)i * G + c; if (L >= nwg) return false;
        int wgid = (int)L; { const int q = nwg / NXCD, r = nwg % NXCD, xcd = wgid % NXCD, off = wgid / NXCD; wgid = (xcd < r ? xcd * (q + 1) : r * (q + 1) + (xcd - r) * q) + off; }
        const int nig = WGM * nN, gid = wgid / nig, fm = gid * WGM, gsz = (nM - fm) < WGM ? (nM - fm) : WGM;
        u.pm = fm + ((wgid % nig) % gsz); u.pn = (wgid % nig) / gsz; u.row0 = u.pm * BM; u.e = 0; u.cnt = 0; u.Bt = Bt; return true;
    }
    __device__ __forceinline__ unsigned arow(const Unit& u, int r) const { return (unsigned)(u.row0 + r) * (unsigned)(K * 2); }
};
template <bool GATHER> struct MoeOrder {
    int cnt[16]; int nN, G, c, K; const bf16* Bt0; size_t bstride; const int* LIST;
    __device__ void init(const unsigned* cntw, int N, int K_, const bf16* Bt0_, const int* LIST_, int G_, int c_) {
#pragma unroll
        for (int e = 0; e < 16; ++e) cnt[e] = (int)__hip_atomic_load(cntw + e, __ATOMIC_RELAXED, __HIP_MEMORY_SCOPE_AGENT);
        nN = N / BM; G = G_; c = c_; K = K_; Bt0 = Bt0_; bstride = (size_t)N * K_; LIST = LIST_; }
    __device__ bool next(int i, Unit& u) const {
        int L = i * G + c, base = 0; bool found = false; u.pm = 0; u.pn = 0; u.row0 = 0; u.e = 0; u.cnt = 0; u.Bt = Bt0;
#pragma unroll
        for (int e = 0; e < 16; ++e) { const int mt = (cnt[e] + 255) >> 8, nu = mt * nN;
            if (!found) { if (L < nu) { found = true; u.e = e; u.cnt = cnt[e]; u.pm = L / nN; u.pn = L % nN; u.row0 = base + u.pm * BM; u.Bt = Bt0 + (size_t)e * bstride; } else { L -= nu; base += mt * BM; } } }
        return found;
    }
    __device__ __forceinline__ unsigned arow(const Unit& u, int r) const {
        if (GATHER) { const int li = u.pm * BM + r; int tok = 0; if (li < u.cnt) tok = LIST[u.e * NTOK + li];
            return (unsigned)tok * (unsigned)(K * 2); }
        return (unsigned)(u.row0 + r) * (unsigned)(K * 2);
    }
};

typedef f32x4 Acc[2][2][4][2];
__device__ __forceinline__ void st4bf(bf16* p, f32x4 v) { u32x2 w; w.x = cvt_pk_bf16(v.x, v.y); w.y = cvt_pk_bf16(v.z, v.w); *(u32x2*)p = w; }
__device__ __forceinline__ void st8bf(bf16* p, f32x4 a, f32x4 b) { u32x4 w; w.x = cvt_pk_bf16(a.x, a.y); w.y = cvt_pk_bf16(a.z, a.w); w.z = cvt_pk_bf16(b.x, b.y); w.w = cvt_pk_bf16(b.z, b.w); *(u32x4*)p = w; }

struct EpiQKV {
    bf16 *Q; const LAS float* rope; float wsc; unsigned* km;
    __device__ __forceinline__ void operator()(const Acc& acc, const Unit& u, int wr, int wc, int fr, int fq) const {
        const int reg = u.pn >> 2; bf16* O = Q + (size_t)reg * ((WS_K - WS_Q) / 2);
        if (reg == 2) { const int cbase = (u.pn & 3) * BM + wc * 32 + 8 * fq;
#pragma unroll
            for (int ai = 0; ai < 2; ++ai)
#pragma unroll
                for (int m = 0; m < 4; ++m) { bf16* rowp = O + (size_t)(u.row0 + ai * HALF + wr * 64 + m * 16 + fr) * DM + cbase;
#pragma unroll
                    for (int bj = 0; bj < 2; ++bj) st8bf(rowp + bj * HALF, acc[ai][bj][m][0] * wsc, acc[ai][bj][m][1] * wsc); }
            return; }
        const int cbase = (u.pn & 3) * BM + wc * 32 + 4 * fq;
        const bool dorope = (u.row0 < NLAT); const float sc = (reg == 0 ? C2 : 1.f) * wsc; float kn[2] = {0.f, 0.f};
#pragma unroll
        for (int ai = 0; ai < 2; ++ai)
#pragma unroll
            for (int m = 0; m < 4; ++m) { const int row = u.row0 + ai * HALF + wr * 64 + m * 16 + fr; bf16* rowp = O + (size_t)row * DM + cbase;
                f32x4 cs = {1.f, 1.f, 1.f, 1.f}, sn = {0.f, 0.f, 0.f, 0.f};
                if (dorope) { const int s = row & (SEQ - 1), pos = (wc & 1) ? (s & 63) : (s >> 6); const f32x4 t0 = *(const LAS f32x4*)(rope + (pos * 16 + 4 * fq) * 2), t1 = *(const LAS f32x4*)(rope + (pos * 16 + 4 * fq) * 2 + 4);
                    cs = (f32x4){t0.x, t0.z, t1.x, t1.z}; sn = (f32x4){t0.y, t0.w, t1.y, t1.w}; }
#pragma unroll
                for (int bj = 0; bj < 2; ++bj) { const f32x4 a0 = acc[ai][bj][m][0], a1 = acc[ai][bj][m][1];
                    const f32x4 o0 = (a0 * cs - a1 * sn) * sc, o1 = (a1 * cs + a0 * sn) * sc;
                    st4bf(rowp + bj * HALF, o0); st4bf(rowp + bj * HALF + 16, o1);
                    if (reg == 1) { const float ps = (o0.x * o0.x + o0.y * o0.y) + (o0.z * o0.z + o0.w * o0.w) + (o1.x * o1.x + o1.y * o1.y) + (o1.z * o1.z + o1.w * o1.w);
                        kn[bj] = fmaxf(kn[bj], ps); } } }
        if (reg == 1) {
            const int b = u.row0 < NLAT ? u.row0 / SEQ : (u.row0 - NLAT) / CTXL;
#pragma unroll
            for (int bj = 0; bj < 2; ++bj) { float v = kn[bj];
#pragma unroll
                for (int s = 1; s < 64; s <<= 1) v = fmaxf(v, __shfl_xor(v, s));
                if (fr == 0 && fq == 0) __hip_atomic_fetch_max(km + b * 16 + 4 * (u.pn & 3) + 2 * bj + (wc >> 1), __float_as_uint(8.f * v), __ATOMIC_RELAXED, __HIP_MEMORY_SCOPE_AGENT); } }
    }
};
struct EpiPlain {
    bf16* O; float sc;
    __device__ __forceinline__ void operator()(const Acc& acc, const Unit& u, int wr, int wc, int fr, int fq) const {
        const int cbase = u.pn * BM + wc * 32 + 8 * fq;
#pragma unroll
        for (int ai = 0; ai < 2; ++ai)
#pragma unroll
            for (int m = 0; m < 4; ++m) { bf16* rowp = O + (size_t)(u.row0 + ai * HALF + wr * 64 + m * 16 + fr) * DM + cbase;
#pragma unroll
                for (int bj = 0; bj < 2; ++bj) st8bf(rowp + bj * HALF, acc[ai][bj][m][0] * sc, acc[ai][bj][m][1] * sc); }
    }
};
struct EpiPlain8 {
    unsigned char* O; float sc;
    __device__ __forceinline__ void operator()(const Acc& acc, const Unit& u, int wr, int wc, int fr, int fq) const {
        const int cbase = u.pn * BM + wc * 32 + 8 * fq;
#pragma unroll
        for (int ai = 0; ai < 2; ++ai)
#pragma unroll
            for (int m = 0; m < 4; ++m) { unsigned char* rowp = O + (size_t)(u.row0 + ai * HALF + wr * 64 + m * 16 + fr) * DM + cbase;
#pragma unroll
                for (int bj = 0; bj < 2; ++bj) { const f32x4 a = acc[ai][bj][m][0] * sc, b = acc[ai][bj][m][1] * sc; u32x2 w; w.x = pk4_fp8(a.x, a.y, a.z, a.w); w.y = pk4_fp8(b.x, b.y, b.z, b.w); *(u32x2*)(rowp + bj * HALF) = w; } }
    }
};
struct EpiInproj {
    bf16 *QR, *KR, *V, *R; float* ZZ; float wsc;
    __device__ __forceinline__ void operator()(const Acc& acc, const Unit& u, int wr, int wc, int fr, int fq) const {
        const int pn = u.pn;
        if (pn == 12) { if (wc == 0) {
#pragma unroll
            for (int ai = 0; ai < 2; ++ai)
#pragma unroll
                for (int m = 0; m < 4; ++m) { float* rowp = ZZ + (size_t)(u.row0 + ai * HALF + wr * 64 + m * 16 + fr) * 32 + 4 * fq;
                    *(f32x4*)rowp = acc[ai][0][m][0] * wsc; *(f32x4*)(rowp + 16) = acc[ai][0][m][1] * wsc; } }
            return; }
        float sc = wsc;
        if (pn < 4) {
            bf16* O = pn < 2 ? QR : KR; if (pn < 2) sc = 0.08838834764831845f * wsc;
            const int cb = (pn & 1) * BM + wc * 32 + 8 * fq;
#pragma unroll
            for (int ai = 0; ai < 2; ++ai)
#pragma unroll
                for (int m = 0; m < 4; ++m) { const size_t row = (size_t)(u.row0 + ai * HALF + wr * 64 + m * 16 + fr);
#pragma unroll
                    for (int bj = 0; bj < 2; ++bj) { const int col = cb + bj * HALF; st8bf(O + ((size_t)(col >> 6) * NTOK + row) * 64 + (col & 63), acc[ai][bj][m][0] * sc, acc[ai][bj][m][1] * sc); } }
            return; }
        bf16* O; int c0;
        if (pn < 8) { O = V; c0 = (pn - 4) * BM; } else { O = R; c0 = (pn - 8) * BM; }
        const int cbase = c0 + wc * 32 + 8 * fq;
#pragma unroll
        for (int ai = 0; ai < 2; ++ai)
#pragma unroll
            for (int m = 0; m < 4; ++m) { bf16* rowp = O + (size_t)(u.row0 + ai * HALF + wr * 64 + m * 16 + fr) * DM + cbase;
#pragma unroll
                for (int bj = 0; bj < 2; ++bj) st8bf(rowp + bj * HALF, acc[ai][bj][m][0] * sc, acc[ai][bj][m][1] * sc); }
    }
};
struct EpiGateUp {
    unsigned char* ACT;
    __device__ __forceinline__ void operator()(const Acc& acc, const Unit& u, int wr, int wc, int fr, int fq) const {
        const int obase = (u.pn * BM + wc * 32) / 2 + 4 * fq;
#pragma unroll
        for (int ai = 0; ai < 2; ++ai)
#pragma unroll
            for (int m = 0; m < 4; ++m) { unsigned char* rowp = ACT + (size_t)(u.row0 + ai * HALF + wr * 64 + m * 16 + fr) * DEXP + obase;
#pragma unroll
                for (int bj = 0; bj < 2; ++bj) { const f32x4 g = acc[ai][bj][m][0] * W8_INV, up = acc[ai][bj][m][1] * W8_INV; f32x4 o;
#pragma unroll
                    for (int j = 0; j < 4; ++j) o[j] = g[j] * __builtin_amdgcn_rcpf(1.f + __expf(-g[j])) * up[j];
                    *(unsigned*)(rowp + bj * (HALF / 2)) = pk4_fp8(o[0], o[1], o[2], o[3]); } }
    }
};

typedef int i32x8 __attribute__((ext_vector_type(8)));
typedef int i32x4 __attribute__((ext_vector_type(4)));
__device__ __forceinline__ i32x8 cat8(bf16x8 lo, bf16x8 hi) { return __builtin_shufflevector(__builtin_bit_cast(i32x4, lo), __builtin_bit_cast(i32x4, hi), 0, 1, 2, 3, 4, 5, 6, 7); }
template <class Epi, class Sched, bool FP8 = false>
__device__ __forceinline__ void gemm_phase(unsigned char* ldsg, const bf16* A, int K, const Sched& S, const Epi& E, int tid_in) {
    LAS unsigned char* lds = (LAS unsigned char*)ldsg;
    const int tid = tid_in, wid = __builtin_amdgcn_readfirstlane(tid >> 6), lane = tid & 63, wr = wid >> 2, wc = wid & 3, fr = lane & 15, fq = lane >> 4;
    const int nt = K / BK;
    int Rr[2]; unsigned colb[2], voffB[2];
#pragma unroll
    for (int i = 0; i < 2; ++i) { int R, C; stage_rc(tid * 16 + i * 8192, R, C); Rr[i] = R; colb[i] = (unsigned)C * 2u; voffB[i] = (unsigned)(R * K + C) * 2u; }
    const size_t kstep = (size_t)(BK * 2);
    const size_t hstep = (size_t)HALF * K * 2;
    const size_t tstep = 2 * hstep;
    const unsigned ldsw = (unsigned)wid * 1024u;
    const int aoff = lds_byte(wr * 64 + fr, fq * 8), boff = lds_byte(wc * 32 + fr, fq * 8);
#define PG8_SA(b, h) (((b) * 2 + (h)) * HTB)
#define PG8_SB(b, h) ((4 + (b) * 2 + (h)) * HTB)
#define PG8_STAGE(bufoff, gbase, voff) do { _Pragma("unroll") for (int _i = 0; _i < 2; ++_i) \
        __builtin_amdgcn_global_load_lds((const unsigned*)((const char*)(gbase) + (voff)[_i]), (LAS unsigned*)(lds + (bufoff) + ldsw + _i * 8192), 16, 0, 0); } while (0)
#define PG8_LDA(dst, b, h) do { if constexpr (FP8) { _Pragma("unroll") for (int m = 0; m < 4; ++m) dst##8[m] = cat8(*(const LAS bf16x8*)(lds + PG8_SA(b, h) + aoff + m * 2048), *(const LAS bf16x8*)(lds + PG8_SA(b, h) + aoff + m * 2048 + 1024)); } \
        else { _Pragma("unroll") for (int m = 0; m < 4; ++m) _Pragma("unroll") for (int k = 0; k < 2; ++k) dst[m][k] = *(const LAS bf16x8*)(lds + PG8_SA(b, h) + aoff + m * 2048 + k * 1024); } } while (0)
#define PG8_LDB(dst, b, h) do { if constexpr (FP8) { _Pragma("unroll") for (int n = 0; n < 2; ++n) dst##8[n] = cat8(*(const LAS bf16x8*)(lds + PG8_SB(b, h) + boff + n * 2048), *(const LAS bf16x8*)(lds + PG8_SB(b, h) + boff + n * 2048 + 1024)); } \
        else { _Pragma("unroll") for (int n = 0; n < 2; ++n) _Pragma("unroll") for (int k = 0; k < 2; ++k) dst[n][k] = *(const LAS bf16x8*)(lds + PG8_SB(b, h) + boff + n * 2048 + k * 1024); } } while (0)
#define PG8_MMA(ai, bj, At, Bt) do { __builtin_amdgcn_s_setprio(1); \
        if constexpr (FP8) { _Pragma("unroll") for (int m = 0; m < 4; ++m) _Pragma("unroll") for (int n = 0; n < 2; ++n) \
            asm volatile("v_mfma_scale_f32_16x16x128_f8f6f4 %0, %1, %2, %0, %3, %3 op_sel_hi:[0,0,0]" : "+v"(acc[ai][bj][m][n]) : "v"(Bt##8[n]), "v"(At##8[m]), "v"(sc8)); } \
        else { _Pragma("unroll") for (int m = 0; m < 4; ++m) _Pragma("unroll") for (int n = 0; n < 2; ++n) _Pragma("unroll") for (int k = 0; k < 2; ++k) \
            acc[ai][bj][m][n] = __builtin_amdgcn_mfma_f32_16x16x32_bf16(Bt[n][k], At[m][k], acc[ai][bj][m][n], 0, 0, 0); } \
        __builtin_amdgcn_s_setprio(0); } while (0)
#define PG8_WAIT_V(n) asm volatile("s_waitcnt vmcnt(" #n ")" ::: "memory")
#define PG8_WAIT_L(n) asm volatile("s_waitcnt lgkmcnt(" #n ")" ::: "memory")
#define PG8_BAR __builtin_amdgcn_s_barrier()
#define PG8_SCHED __builtin_amdgcn_sched_barrier(0)
    Unit cur, nxt; int ui = 0;
    if (!S.next(0, cur)) return;
    Acc acc;
#pragma unroll
    for (int a = 0; a < 2; ++a)
#pragma unroll
        for (int b = 0; b < 2; ++b)
#pragma unroll
            for (int m = 0; m < 4; ++m)
#pragma unroll
                for (int n = 0; n < 2; ++n) acc[a][b][m][n] = (f32x4){0.f, 0.f, 0.f, 0.f};
    const int sc8 = 0x7f7f7f7f;
    bf16x8 At[4][2], B0[2][2], B1[2][2]; i32x8 At8[4], B08[2], B18[2];
    unsigned aC0[2], aC1[2], aN0[2], aN1[2];
#pragma unroll
    for (int i = 0; i < 2; ++i) { aC0[i] = S.arow(cur, Rr[i]) + colb[i]; aC1[i] = S.arow(cur, HALF + Rr[i]) + colb[i]; }
    const char* Ab = (const char*)A;
    const char* cB = (const char*)cur.Bt + (size_t)cur.pn * tstep;
    PG8_STAGE(PG8_SB(0, 0), cB, voffB); PG8_STAGE(PG8_SB(0, 1), cB + hstep, voffB); PG8_STAGE(PG8_SA(0, 0), Ab, aC0); PG8_STAGE(PG8_SA(0, 1), Ab, aC1);
    if (wr == 1) PG8_BAR;
    PG8_WAIT_V(2); PG8_BAR;
    PG8_STAGE(PG8_SB(1, 0), cB + kstep, voffB); PG8_STAGE(PG8_SA(1, 0), Ab + kstep, aC0); PG8_STAGE(PG8_SB(1, 1), cB + hstep + kstep, voffB);
    PG8_WAIT_V(6); PG8_BAR;
    for (;;) {
        const bool has_next = S.next(ui + 1, nxt);
        if (has_next) {
#pragma unroll
            for (int i = 0; i < 2; ++i) { aN0[i] = S.arow(nxt, Rr[i]) + colb[i]; aN1[i] = S.arow(nxt, HALF + Rr[i]) + colb[i]; }
        } else {
#pragma unroll
            for (int i = 0; i < 2; ++i) { aN0[i] = aC0[i]; aN1[i] = aC1[i]; }
        }
        const char* nB = has_next ? (const char*)nxt.Bt + (size_t)nxt.pn * tstep : cB;
        for (int t = 0; t < nt; t += 2) {
            const bool last = (t == nt - 2);
            const char* a1 = Ab + (size_t)(t + 1) * kstep;
            const char* a2 = last ? Ab : Ab + (size_t)(t + 2) * kstep; const char* b2 = last ? nB : cB + (size_t)(t + 2) * kstep;
            const char* a3 = a2 + kstep; const char* b3 = b2 + kstep;
            unsigned x0[2], x1[2];
#pragma unroll
            for (int i = 0; i < 2; ++i) { x0[i] = last ? aN0[i] : aC0[i]; x1[i] = last ? aN1[i] : aC1[i]; }
            PG8_LDB(B0, 0, 0); PG8_LDB(B1, 0, 1); PG8_SCHED; PG8_LDA(At, 0, 0); PG8_STAGE(PG8_SA(1, 1), a1, aC1);
            PG8_WAIT_V(8); PG8_WAIT_L(0); PG8_BAR; PG8_MMA(0, 0, At, B0); PG8_MMA(0, 1, At, B1); PG8_BAR; PG8_SCHED;
            PG8_LDA(At, 0, 1); PG8_STAGE(PG8_SB(0, 0), b2, voffB); PG8_STAGE(PG8_SB(0, 1), b2 + hstep, voffB); PG8_STAGE(PG8_SA(0, 0), a2, x0);
            PG8_WAIT_V(8); PG8_WAIT_L(0); PG8_BAR; PG8_MMA(1, 0, At, B0); PG8_MMA(1, 1, At, B1); PG8_BAR; PG8_SCHED;
            PG8_LDB(B0, 1, 0); PG8_LDB(B1, 1, 1); PG8_SCHED; PG8_LDA(At, 1, 0); PG8_STAGE(PG8_SA(0, 1), a2, x1);
            PG8_WAIT_V(8); PG8_WAIT_L(0); PG8_BAR; PG8_MMA(0, 0, At, B0); PG8_MMA(0, 1, At, B1); PG8_BAR; PG8_SCHED;
            PG8_LDA(At, 1, 1); PG8_STAGE(PG8_SB(1, 0), b3, voffB); PG8_STAGE(PG8_SB(1, 1), b3 + hstep, voffB); PG8_STAGE(PG8_SA(1, 0), a3, x0);
            PG8_WAIT_V(8); PG8_WAIT_L(0); PG8_BAR; PG8_MMA(1, 0, At, B0); PG8_MMA(1, 1, At, B1); PG8_BAR; PG8_SCHED;
        }
        if (wr == 0) PG8_BAR;
        if constexpr (FP8) asm volatile("s_nop 15\n\ts_nop 7" ::: "memory");
        E(acc, cur, wr, wc, fr, fq);
        if (!has_next) break;
#pragma unroll
        for (int a = 0; a < 2; ++a)
#pragma unroll
            for (int b = 0; b < 2; ++b)
#pragma unroll
                for (int m = 0; m < 4; ++m)
#pragma unroll
                    for (int n = 0; n < 2; ++n) acc[a][b][m][n] = (f32x4){0.f, 0.f, 0.f, 0.f};
        cur = nxt; cB = nB; ++ui;
#pragma unroll
        for (int i = 0; i < 2; ++i) { aC0[i] = aN0[i]; aC1[i] = aN1[i]; }
        if (wr == 1) PG8_BAR;
    }
    PG8_WAIT_V(0);
    PG8_BAR;
#undef PG8_SA
#undef PG8_SB
#undef PG8_STAGE
#undef PG8_LDA
#undef PG8_LDB
#undef PG8_MMA
#undef PG8_WAIT_V
#undef PG8_WAIT_L
#undef PG8_BAR
#undef PG8_SCHED
}
}

__device__ __forceinline__ int vcu_of(const Frame& F) { return (F.G % 8 == 0) ? (F.bid % 8) * (F.G / 8) + F.bid / 8 : F.bid; }
__device__ __forceinline__ void phase_qkv_opt(const Frame& F, const Prm& p) {
    pg8::DenseOrder S; S.init(NTOK, 3072, 512, (const bf16*)(p.ws + WS_WQKV), F.G, F.bid);
    static_assert(WS_V - WS_K == WS_K - WS_Q, "Q|K|V equally spaced");
    LAS float* ropel = (LAS float*)((LAS unsigned char*)F.lds + LDSX_OFF);
    const float* ropeg = (const float*)(p.ws + WS_MISC) + 1024;
    for (int i = F.tid; i < 2048; i += NTHR) ropel[i] = ropeg[i];
    __syncthreads();
    pg8::EpiQKV E{(bf16*)(p.ws + WS_Q), ropel, W8_INV, F.ctl + CW_KM};
    pg8::gemm_phase<pg8::EpiQKV, pg8::DenseOrder, true>(F.lds, (const bf16*)(p.ws + WS_H), 512, S, E, F.tid);
}
__device__ __forceinline__ void phase_wo_opt(const Frame& F, const Prm& p, int layer) {
    if (layer) {
        pg8::DenseOrder S; S.init(NLAT, 1024, 512, (const bf16*)(p.ws + WS_WGO), F.G, F.bid);
        pg8::EpiPlain E{(bf16*)(p.ws + WS_Y), W8_INV};
        pg8::gemm_phase<pg8::EpiPlain, pg8::DenseOrder, true>(F.lds, (const bf16*)(p.ws + WS_A2B), 512, S, E, F.tid);
    } else {
        pg8::DenseOrder S; S.init(NTOK, 1024, 512, (const bf16*)(p.ws + WS_WO), F.G, F.bid);
        pg8::EpiPlain E{(bf16*)(p.ws + WS_Y), W8_INV};
        pg8::gemm_phase<pg8::EpiPlain, pg8::DenseOrder, true>(F.lds, (const bf16*)(p.ws + WS_A2), 512, S, E, F.tid);
    }
}
__device__ __forceinline__ void phase_inproj_opt(const Frame& F, const Prm& p) {
    pg8::DenseOrder S; S.init(NTOK, NIN, 512, (const bf16*)(p.ws + WS_WIN), F.G, F.bid);
    pg8::EpiInproj E{(bf16*)(p.ws + WS_QR), (bf16*)(p.ws + WS_KR), (bf16*)(p.ws + WS_V1), (bf16*)(p.ws + WS_R), (float*)(p.ws + WS_ZZ), W8_INV};
    pg8::gemm_phase<pg8::EpiInproj, pg8::DenseOrder, true>(F.lds, (const bf16*)(p.ws + WS_H), 512, S, E, F.tid);
}
__device__ __forceinline__ void phase_moe1_opt(const Frame& F, const Prm& p, int layer) {
    pg8::MoeOrder<true> S; S.init(F.ctl + CW_CNT + layer * 16, 1024, 512, (const bf16*)(p.ws + (layer ? WS_GU1 : WS_GU0)), (const int*)(p.ws + WS_LIST), F.G, vcu_of(F));
    pg8::EpiGateUp E{p.ws + WS_ACT};
    pg8::gemm_phase<pg8::EpiGateUp, pg8::MoeOrder<true>, true>(F.lds, (const bf16*)(p.ws + WS_H), 512, S, E, F.tid);
}
__device__ __forceinline__ void phase_moe2_opt(const Frame& F, const Prm& p, int layer) {
    pg8::MoeOrder<false> S; S.init(F.ctl + CW_CNT + layer * 16, 1024, 256, (const bf16*)(p.ws + (layer ? WS_DN1 : WS_DN0)), nullptr, F.G, vcu_of(F));
    pg8::EpiPlain8 E{p.ws + WS_YM, W8_INV};
    pg8::gemm_phase<pg8::EpiPlain8, pg8::MoeOrder<false>, true>(F.lds, (const bf16*)(p.ws + WS_ACT), 256, S, E, F.tid);
}
namespace attn_body {
using bf16=unsigned short;
using bf16x8=__attribute__((ext_vector_type(8)))short;
using s16x4=__attribute__((ext_vector_type(4)))short;
using f32x16=__attribute__((ext_vector_type(16)))float;
using u32x4=__attribute__((ext_vector_type(4)))unsigned;
constexpr int D=64,DM=1024;
constexpr int NW=8,QBLK=32,QB=QBLK*NW,KVBLK=64;
constexpr int ATTN_PITCH=DM, ATTN_UNIT_ROWS=QB;
__device__ __forceinline__ int crow(int r,int hi){return (r&3)+8*(r>>2)+4*hi;}
#define SBAR() __builtin_amdgcn_sched_barrier(0)

constexpr int NSLOT=3, SLOTB=8192;
constexpr int LDS_K=0, LDS_V=NSLOT*SLOTB, LDS_WS=2*NSLOT*SLOTB, LDS_OST=LDS_WS+NW*64*4, LDS_BYTES=LDS_OST+NW*4096;
constexpr float C2=0.125f*1.4426950408889634f;
__device__ __forceinline__ void glds16(const void*gsrc,unsigned lds_dst){unsigned keep;
  asm volatile("s_mov_b32 %0, m0\n\ts_mov_b32 m0, %2\n\ts_nop 0\n\tglobal_load_lds_dwordx4 %1, off\n\ts_mov_b32 m0, %0":"=&s"(keep):"v"(gsrc),"s"(lds_dst):"memory");}
__device__ __forceinline__ void glds16s(const void*sbase,unsigned voff,unsigned lds_dst){unsigned keep;
  asm volatile("s_mov_b32 %0, m0\n\ts_mov_b32 m0, %3\n\ts_nop 0\n\tglobal_load_lds_dwordx4 %1, %2\n\ts_mov_b32 m0, %0":"=&s"(keep):"v"(voff),"s"(sbase),"s"(lds_dst):"memory");}
__device__ __forceinline__ void glds16s128(const void*sbase,unsigned voff,unsigned lds_dst){unsigned keep;
  asm volatile("s_mov_b32 %0, m0\n\ts_mov_b32 m0, %3\n\ts_nop 0\n\tglobal_load_lds_dwordx4 %1, %2 offset:128\n\ts_mov_b32 m0, %0":"=&s"(keep):"v"(voff),"s"(sbase),"s"(lds_dst):"memory");}
__device__ __forceinline__ float max3f(float a,float b,float c){float r;asm("v_max3_f32 %0, %1, %2, %3":"=v"(r):"v"(a),"v"(b),"v"(c));return r;}
__device__ __forceinline__ float max2f(float a,float b){float r;asm("v_max_f32_e32 %0, %1, %2":"=v"(r):"v"(a),"v"(b));return r;}
__device__ __forceinline__ float fadd_s(float a,float b){float r;asm("v_add_f32_e32 %0, %1, %2":"=v"(r):"v"(a),"v"(b));return r;}
__device__ __forceinline__ float fsub_s(float a,float b){float r;asm("v_sub_f32_e32 %0, %1, %2":"=v"(r):"v"(a),"v"(b));return r;}
typedef float f32x2_t __attribute__((ext_vector_type(2))); typedef __bf16 bf16x2_t __attribute__((ext_vector_type(2)));
__device__ __forceinline__ unsigned cvtpk_s(float lo,float hi){f32x2_t v={lo,hi};bf16x2_t b=__builtin_convertvector(v,bf16x2_t);return __builtin_bit_cast(unsigned,b);}
#define WAIT_BAR(N) asm volatile("s_waitcnt vmcnt(" #N ") lgkmcnt(0)\n\ts_barrier":::"memory")

__device__ __forceinline__ void qkt(f32x16&p0,f32x16&p1,const char*Kslot,const bf16x8*qr,const f32x16&negm,int r32,int hi){
  const char*kb=Kslot+hi*1024+r32*16;
  #pragma unroll
  for(int d0=0;d0<4;++d0){
    const bf16x8 b0=*reinterpret_cast<const bf16x8*>(kb+d0*2048);
    const bf16x8 b1=*reinterpret_cast<const bf16x8*>(kb+d0*2048+512);
    if(d0==0){p0=__builtin_amdgcn_mfma_f32_32x32x16_bf16(b0,qr[0],negm,0,0,0);p1=__builtin_amdgcn_mfma_f32_32x32x16_bf16(b1,qr[0],negm,0,0,0);}
    else{p0=__builtin_amdgcn_mfma_f32_32x32x16_bf16(b0,qr[d0],p0,0,0,0);p1=__builtin_amdgcn_mfma_f32_32x32x16_bf16(b1,qr[d0],p1,0,0,0);}}
}
typedef __attribute__((address_space(3))) const char* lds_cptr;
typedef short v4i16_t __attribute__((ext_vector_type(4)));
__device__ __forceinline__ void kload8(bf16x8*kf,lds_cptr kp){
  kf[0]=*(const __attribute__((address_space(3))) bf16x8*)(kp);      kf[1]=*(const __attribute__((address_space(3))) bf16x8*)(kp+512);
  kf[2]=*(const __attribute__((address_space(3))) bf16x8*)(kp+2048); kf[3]=*(const __attribute__((address_space(3))) bf16x8*)(kp+2560);
  kf[4]=*(const __attribute__((address_space(3))) bf16x8*)(kp+4096); kf[5]=*(const __attribute__((address_space(3))) bf16x8*)(kp+4608);
  kf[6]=*(const __attribute__((address_space(3))) bf16x8*)(kp+6144); kf[7]=*(const __attribute__((address_space(3))) bf16x8*)(kp+6656);
}
__device__ __forceinline__ void kload2(bf16x8*kf,lds_cptr kp,int j){ kf[2*j]=*(const __attribute__((address_space(3))) bf16x8*)(kp+j*2048); kf[2*j+1]=*(const __attribute__((address_space(3))) bf16x8*)(kp+j*2048+512); }
__device__ __forceinline__ s16x4 vtr(lds_cptr p){ return __builtin_bit_cast(s16x4,__builtin_amdgcn_ds_read_tr16_b64_v4i16((__attribute__((address_space(3))) v4i16_t*)p)); }
__device__ __forceinline__ float rowmax(const f32x16&p0,const f32x16&p1){
  float a=max3f(p0[0],p0[1],p1[0]),b=max3f(p0[2],p0[3],p1[1]);a=max3f(a,p1[2],p1[3]);
  #pragma unroll
  for(int r=4;r<16;r+=4){a=max3f(a,p0[r],p0[r+1]);b=max3f(b,p0[r+2],p0[r+3]);a=max3f(a,p1[r],p1[r+1]);b=max3f(b,p1[r+2],p1[r+3]);}
  const float m=max2f(a,b);
  auto rr=__builtin_amdgcn_permlane32_swap(__float_as_uint(m),__float_as_uint(m),false,false);
  return max2f(__uint_as_float(rr[0]),__uint_as_float(rr[1]));
}
#undef SBAR
#undef WAIT_BAR
#undef KVROW
}
namespace attn_body {
constexpr int V2SLOT = 16384;
constexpr int L2_K = 0, L2_V = NSLOT * SLOTB, L2_WS = L2_V + NSLOT * V2SLOT, L2_ST = L2_WS + NW * 64 * 4, L2_BYTES = L2_ST + NW * 8192;
#define SBAR() __builtin_amdgcn_sched_barrier(0)
#define WAIT_BAR(N) asm volatile("s_waitcnt vmcnt(" #N ") lgkmcnt(0)\n\ts_barrier":::"memory")
template<int THRL> __device__ __forceinline__ void attn_unit2(long qrow0,int qcol,int vcol,long kctx,long klat,int NT,const bf16*Q,const bf16*__restrict__ K,const bf16*__restrict__ V,int m,const float*lamp,const float*subln,unsigned char*A2,int acol,float km,char*shm,int wid_s){
  int lane_u; asm volatile("v_mbcnt_lo_u32_b32 %0, -1, 0\n\tv_mbcnt_hi_u32_b32 %0, -1, %0":"=v"(lane_u));
  const int lane=lane_u,r32=lane&31,hi=lane>>5; const int wid=wid_s;
  const bf16*Qw=Q+(qrow0+wid*QBLK)*DM+qcol;
  const bf16*Kh=K+qcol,*Vh=V+vcol;
  const unsigned lds0=(unsigned)(uintptr_t)shm;
  float*wsf=(float*)(shm+L2_WS)+wid*64;
  const unsigned wsf_lds=(unsigned)(lds0+L2_WS+wid*256);
  const unsigned koff=(unsigned)(lane*DM+wid*8)*2u;
  const unsigned voff=(unsigned)((16*(wid&3)+(lane>>2))*DM+(wid>>2)*32+(lane&3)*8)*2u;
  const unsigned kdst=lds0+L2_K+wid*1024, vdst=lds0+L2_V+wid*1024;
  #define KVROW(t) ((t)<4?kctx+(long)(t)*KVBLK:klat+(long)((t)-4)*KVBLK)
  #define DMA_K(t,slot) glds16s(Kh+KVROW(t)*DM,koff,(unsigned)(kdst+(slot)))
  #define DMA_V(t,slot) do{ const bf16*vb_=Vh+KVROW(t)*DM; glds16s(vb_,voff,(unsigned)(vdst+2*(slot))); glds16s(vb_+64,voff,(unsigned)(vdst+2*(slot)+8192)); }while(0)
  const char*Kbase=shm+L2_K; bf16x8 kf[8];
  const lds_cptr shm3=(lds_cptr)shm; const lds_cptr kp0=shm3+L2_K+hi*1024+r32*16; const lds_cptr vp0=shm3+L2_V+((lane>>4)&1)*32+(lane&3)*8+(4*hi+((lane&15)>>2))*64;
  DMA_K(0,0);DMA_V(0,0);DMA_K(1,SLOTB);
  bf16x8 qr[4];
  #pragma unroll
  for(int d0=0;d0<4;++d0)qr[d0]=*reinterpret_cast<const bf16x8*>(&Qw[(long)r32*DM+d0*16+hi*8]);
  bool FAST; { float qn=0.f;
    #pragma unroll
    for(int d0=0;d0<4;++d0){ const u32x4 u=__builtin_bit_cast(u32x4,qr[d0]); const unsigned a4[4]={u.x,u.y,u.z,u.w};
      #pragma unroll
      for(int i=0;i<4;++i){ const float lo=__uint_as_float(a4[i]<<16),h2=__uint_as_float(a4[i]&0xffff0000u); qn+=lo*lo+h2*h2; } }
    { auto rq=__builtin_amdgcn_permlane32_swap(__float_as_uint(qn),__float_as_uint(qn),false,false); qn=__uint_as_float(rq[0])+__uint_as_float(rq[1]); } FAST=__all(qn*km<=96.f*96.f)!=0; }
  float mhat=0.f,l_reg=0.f;f32x16 o[4];o[0]=f32x16{};o[1]=f32x16{};o[2]=f32x16{};o[3]=f32x16{};const f32x16 zero16=f32x16{};
  bool resc=false;
  #define START(P0,P1) do{ resc=false; if(FAST){ mhat=0.f; } else { const float rm=rowmax(P0,P1); mhat=rm; \
    _Pragma("unroll") for(int r=0;r<16;++r){P0[r]=fsub_s(P0[r],rm);P1[r]=fsub_s(P1[r],rm);} } \
    _Pragma("unroll") for(int r=0;r<16;++r)P0[r]=__builtin_amdgcn_exp2f(P0[r]); }while(0)
  #define RESC() do{ if(resc){ asm volatile("s_waitcnt lgkmcnt(0)":::"memory"); \
      int l3_=lane; asm volatile("":"+v"(l3_)); const int hi3_=l3_>>5; \
      _Pragma("unroll") for(int d_=0;d_<4;++d_) _Pragma("unroll") for(int r=0;r<16;++r)o[d_][r]*=wsf[crow(r,hi3_)]; } }while(0)
  int sl_prev=0,sl_cur=0,sl_next=SLOTB;
  #define ROT() do{sl_prev=sl_cur;sl_cur=sl_next;sl_next=(sl_next==(NSLOT-1)*SLOTB)?0:sl_next+SLOTB;}while(0)
  DMA_K(2,2*SLOTB);
  WAIT_BAR(4);
  #define PKW(P,B) cvtpk_s(P[B],P[B+1])
  u32x4 pwA0,pwA1,pwA2,pwA3,pwB0,pwB1,pwB2,pwB3;
  { f32x16 p0,p1;
    qkt(p0,p1,Kbase,qr,zero16,r32,hi);asm volatile("s_nop 15\n\ts_nop 7":"+v"(p0),"+v"(p1));
    START(p0,p1);
    _Pragma("unroll") for(int r=0;r<16;++r)p1[r]=__builtin_amdgcn_exp2f(p1[r]);
    float sacc=p0[0]+p0[1]; _Pragma("unroll") for(int r=2;r<16;++r)sacc+=p0[r]; _Pragma("unroll") for(int r=0;r<16;++r)sacc+=p1[r]; l_reg+=sacc;
    pwA0=(u32x4){PKW(p0,0),PKW(p0,2),PKW(p0,4),PKW(p0,6)};pwA1=(u32x4){PKW(p0,8),PKW(p0,10),PKW(p0,12),PKW(p0,14)};pwA2=(u32x4){PKW(p1,0),PKW(p1,2),PKW(p1,4),PKW(p1,6)};pwA3=(u32x4){PKW(p1,8),PKW(p1,10),PKW(p1,12),PKW(p1,14)}; }
  WAIT_BAR(0);
  DMA_K(3,0);DMA_V(1,SLOTB);
  ROT();
  kload8(kf,kp0+sl_cur);
  WAIT_BAR(3);
  s16x4 vAl[4],vAh[4],vBl[4],vBh[4];
  #define PAFX(x) __builtin_bit_cast(bf16x8,x)
  #define VF(A,d) (bf16x8){A##l[d][0],A##l[d][1],A##l[d][2],A##l[d][3],A##h[d][0],A##h[d][1],A##h[d][2],A##h[d][3]}
  #define PIN(x) asm volatile("":"+v"(x))
  #define MX3(a,b,c) __builtin_fmaxf(__builtin_fmaxf((a),(b)),(c))
  #define EX(v) __builtin_amdgcn_exp2f(v)
  #define VRDL(A,d,ks) A##l[d]=vtr(vp_+((d)*4096+(ks)*1024))
  #define VRDH(A,d,ks) A##h[d]=vtr(vp_+((d)*4096+(ks)*1024+512))
  #define GAPF(MF,X,B,PWN,W,RD) do{ MF; X[B]=EX(X[B]); X[B+1]=EX(X[B+1]); sacc+=X[B]; sacc+=X[B+1]; PIN(sacc); PWN[W]=cvtpk_s(X[B],X[B+1]); PIN(PWN); RD; SBAR(); }while(0)
  #define GAPP(MF,X,B,PWN,W,RD) do{ MF; X[B]=EX(X[B]-mhat); X[B+1]=EX(X[B+1]-mhat); sacc+=X[B]; sacc+=X[B+1]; PIN(sacc); PWN[W]=cvtpk_s(X[B],X[B+1]); PIN(PWN); RD; SBAR(); }while(0)
  #define MFQ(C,kf_,q_,acc_) C=__builtin_amdgcn_mfma_f32_32x32x16_bf16(kf_,q_,acc_,0,0,0)
  #define MFO(d,PW,A) o[d]=__builtin_amdgcn_mfma_f32_32x32x16_bf16(PAFX(PW),VF(A,d),o[d],0,0,0)
  #define KRD(G,j) do{ if(G){ kload2(kf,kp0+sl_next,j); } }while(0)
  #define PHASEB(G,PI0,PI1,PI2,PI3,PO0,PO1,PO2,PO3,GL) do{ \
    G(MFO(0,PI0,vA),C0,0, PO0,0, VRDL(vB,0,1);VRDH(vB,0,1)); \
    G(MFO(1,PI0,vA),C0,2, PO0,1, VRDL(vB,1,1);VRDH(vB,1,1)); \
    G(MFO(2,PI0,vA),C0,4, PO0,2, VRDL(vB,2,1);VRDH(vB,2,1)); \
    G(MFO(3,PI0,vA),C0,6, PO0,3, VRDL(vB,3,1);VRDH(vB,3,1)); \
    G(MFO(0,PI1,vB),C0,8, PO1,0, VRDL(vA,0,2);VRDH(vA,0,2)); \
    G(MFO(1,PI1,vB),C0,10,PO1,1, VRDL(vA,1,2);VRDH(vA,1,2)); \
    G(MFO(2,PI1,vB),C0,12,PO1,2, VRDL(vA,2,2);VRDH(vA,2,2)); \
    G(MFO(3,PI1,vB),C0,14,PO1,3, VRDL(vA,3,2);VRDH(vA,3,2)); \
    G(MFO(0,PI2,vA),C1,0, PO2,0, VRDL(vB,0,3);VRDH(vB,0,3)); \
    G(MFO(1,PI2,vA),C1,2, PO2,1, VRDL(vB,1,3);VRDH(vB,1,3)); \
    G(MFO(2,PI2,vA),C1,4, PO2,2, VRDL(vB,2,3);VRDH(vB,2,3)); \
    G(MFO(3,PI2,vA),C1,6, PO2,3, VRDL(vB,3,3);VRDH(vB,3,3)); \
    G(MFO(0,PI3,vB),C1,8, PO3,0, KRD(GL,0)); \
    G(MFO(1,PI3,vB),C1,10,PO3,1, KRD(GL,1)); \
    G(MFO(2,PI3,vB),C1,12,PO3,2, KRD(GL,2)); \
    G(MFO(3,PI3,vB),C1,14,PO3,3, KRD(GL,3)); \
    }while(0)
  #define PHASEB_NF(G,PI0,PI1,PI2,PI3,PO0,PO1,PO2,PO3,GL) do{ \
    G(MFO(0,PI0,vA),C0,0, PO0,0, (void)0); \
    G(MFO(1,PI0,vA),C0,2, PO0,1, (void)0); \
    G(MFO(2,PI0,vA),C0,4, PO0,2, (void)0); \
    G(MFO(3,PI0,vA),C0,6, PO0,3, VRDL(vA,0,1);VRDH(vA,0,1);VRDL(vA,1,1);VRDH(vA,1,1);VRDL(vA,2,1);VRDH(vA,2,1);VRDL(vA,3,1);VRDH(vA,3,1)); \
    G(MFO(0,PI1,vA),C0,8, PO1,0, (void)0); \
    G(MFO(1,PI1,vA),C0,10,PO1,1, (void)0); \
    G(MFO(2,PI1,vA),C0,12,PO1,2, (void)0); \
    G(MFO(3,PI1,vA),C0,14,PO1,3, VRDL(vA,0,2);VRDH(vA,0,2);VRDL(vA,1,2);VRDH(vA,1,2);VRDL(vA,2,2);VRDH(vA,2,2);VRDL(vA,3,2);VRDH(vA,3,2)); \
    G(MFO(0,PI2,vA),C1,0, PO2,0, (void)0); \
    G(MFO(1,PI2,vA),C1,2, PO2,1, (void)0); \
    G(MFO(2,PI2,vA),C1,4, PO2,2, (void)0); \
    G(MFO(3,PI2,vA),C1,6, PO2,3, VRDL(vA,0,3);VRDH(vA,0,3);VRDL(vA,1,3);VRDH(vA,1,3);VRDL(vA,2,3);VRDH(vA,2,3);VRDL(vA,3,3);VRDH(vA,3,3)); \
    G(MFO(0,PI3,vA),C1,8, PO3,0, KRD(GL,0)); \
    G(MFO(1,PI3,vA),C1,10,PO3,1, KRD(GL,1)); \
    G(MFO(2,PI3,vA),C1,12,PO3,2, KRD(GL,2)); \
    G(MFO(3,PI3,vA),C1,14,PO3,3, KRD(GL,3)); \
    }while(0)
  #define STEP2(t,PI0,PI1,PI2,PI3,PO0,PO1,PO2,PO3,GK,GV,GL,GAPM,MB,PHB) do{ SBAR(); \
    const lds_cptr vp_=vp0+2*sl_prev; f32x16 C0,C1; float sacc=0.f; \
    VRDL(vA,0,0); SBAR(); MFQ(C0,kf[0],qr[0],zero16); SBAR(); \
    VRDH(vA,0,0); SBAR(); MFQ(C1,kf[1],qr[0],zero16); SBAR(); \
    VRDL(vA,1,0); SBAR(); MFQ(C0,kf[2],qr[1],C0); SBAR(); \
    VRDH(vA,1,0); SBAR(); MFQ(C1,kf[3],qr[1],C1); SBAR(); \
    VRDL(vA,2,0); SBAR(); MFQ(C0,kf[4],qr[2],C0); SBAR(); \
    VRDH(vA,2,0); SBAR(); MFQ(C1,kf[5],qr[2],C1); SBAR(); \
    VRDL(vA,3,0); SBAR(); MFQ(C0,kf[6],qr[3],C0); SBAR(); \
    VRDH(vA,3,0); SBAR(); MFQ(C1,kf[7],qr[3],C1); SBAR(); \
    if(GK){DMA_K((t)+3,sl_cur);} if(GV){DMA_V((t)+1,sl_next);} \
    if(MB){ float a=MX3(C0[0],C0[1],C1[0]),b=MX3(C0[2],C0[3],C1[1]); a=MX3(a,C1[2],C1[3]); \
      _Pragma("unroll") for(int r=4;r<16;r+=4){a=MX3(a,C0[r],C0[r+1]);b=MX3(b,C0[r+2],C0[r+3]);a=MX3(a,C1[r],C1[r+1]);b=MX3(b,C1[r+2],C1[r+3]);} \
      float rm=__builtin_fmaxf(a,b); { auto rr=__builtin_amdgcn_permlane32_swap(__float_as_uint(rm),__float_as_uint(rm),false,false); rm=__builtin_fmaxf(__uint_as_float(rr[0]),__uint_as_float(rr[1])); } \
      resc=false; \
      if(__builtin_expect(__any(rm-mhat>(float)THRL),0)){ const float dl=__builtin_fmaxf(rm-mhat,0.f); mhat+=dl; \
        const float f=__builtin_amdgcn_exp2f(-dl); l_reg*=f; { unsigned keep_; asm volatile("s_mov_b32 %0, m0\n\ts_mov_b32 m0, %2\n\ts_nop 0\n\tds_write_addtid_b32 %1\n\ts_mov_b32 m0, %0":"=&s"(keep_):"v"(f),"s"(wsf_lds):"memory"); } resc=true; } } \
    __builtin_amdgcn_s_setprio(1); SBAR(); \
    PHB(GAPM,PI0,PI1,PI2,PI3,PO0,PO1,PO2,PO3,GL); \
    __builtin_amdgcn_s_setprio(0); l_reg+=sacc; \
    }while(0)
  #define ENDW(tt) do{ if((tt)+3<NT){WAIT_BAR(3);} else if((tt)+2<NT){WAIT_BAR(2);} else {WAIT_BAR(0);} }while(0)
  #define LOOPS(GAPM,MB,RS,PHB) do{ int t=1; \
    for(;t+5<NT;t+=2){ \
      STEP2(t,  pwA0,pwA1,pwA2,pwA3,pwB0,pwB1,pwB2,pwB3,true,true,true,GAPM,MB,PHB); WAIT_BAR(3); RS; ROT(); \
      STEP2(t+1,pwB0,pwB1,pwB2,pwB3,pwA0,pwA1,pwA2,pwA3,true,true,true,GAPM,MB,PHB); WAIT_BAR(3); RS; ROT(); \
    } \
    for(;t+1<NT;t+=2){ \
      STEP2(t,  pwA0,pwA1,pwA2,pwA3,pwB0,pwB1,pwB2,pwB3,(t+3<NT),(t+1<NT),(t+1<NT),GAPM,MB,PHB); ENDW(t);   RS; ROT(); \
      STEP2(t+1,pwB0,pwB1,pwB2,pwB3,pwA0,pwA1,pwA2,pwA3,(t+4<NT),(t+2<NT),(t+2<NT),GAPM,MB,PHB); ENDW(t+1); RS; ROT(); \
    } \
    STEP2(NT-1,pwA0,pwA1,pwA2,pwA3,pwB0,pwB1,pwB2,pwB3,false,false,false,GAPM,MB,PHB); RS; }while(0)
  auto finish=[&]() __attribute__((always_inline)) {
  { const lds_cptr vp_=vp0+2*sl_cur;
    #pragma unroll
    for(int ks=0;ks<4;++ks){
      #pragma unroll
      for(int d=0;d<4;++d){ const s16x4 lo=vtr(vp_+(d*4096+ks*1024)),hh=vtr(vp_+(d*4096+ks*1024+512)); const bf16x8 vf=(bf16x8){lo[0],lo[1],lo[2],lo[3],hh[0],hh[1],hh[2],hh[3]};
        const u32x4 pw=(ks==0)?pwB0:(ks==1)?pwB1:(ks==2)?pwB2:pwB3;
        o[d]=__builtin_amdgcn_mfma_f32_32x32x16_bf16(PAFX(pw),vf,o[d],0,0,0); } } }
  { int lane_l=lane; asm volatile("":"+v"(lane_l));
  { const int lane=lane_l,r32=lane&31,hi=lane>>5;
  {auto rr=__builtin_amdgcn_permlane32_swap(__float_as_uint(l_reg),__float_as_uint(l_reg),false,false);l_reg=__uint_as_float(rr[0])+__uint_as_float(rr[1]);}
  if(hi==0)wsf[32+r32]=l_reg;asm volatile("s_waitcnt lgkmcnt(0)":::"memory");
  float rli[16];
  #pragma unroll
  for(int r=0;r<16;++r)rli[r]=__builtin_amdgcn_rcpf(wsf[32+crow(r,hi)]);
  unsigned short*stash=(unsigned short*)(shm+L2_ST)+wid*4096;
  if(m==0){
    #pragma unroll
    for(int d0=0;d0<4;++d0){
      #pragma unroll
      for(int r=0;r<16;++r)stash[(d0*16+r)*64+lane]=(unsigned short)f2bf(o[d0][r]*rli[r]);}
    asm volatile("s_waitcnt lgkmcnt(0)":::"memory");
  } else {
    const float lam=__uint_as_float(__hip_atomic_load((const unsigned*)lamp,__ATOMIC_RELAXED,__HIP_MEMORY_SCOPE_AGENT));
    float ss[16];
    #pragma unroll
    for(int r=0;r<16;++r)ss[r]=0.f;
    #pragma unroll
    for(int d0=0;d0<4;++d0){
      #pragma unroll
      for(int r=0;r<16;++r){ const float o1=bf2f(stash[(d0*16+r)*64+lane]); const float df=o1-lam*(o[d0][r]*rli[r]); o[d0][r]=df; ss[r]+=df*df; } }
    #pragma unroll
    for(int r=0;r<16;++r){ float q=ss[r];
      q+=__int_as_float(__builtin_amdgcn_ds_swizzle(__float_as_int(q),0x41f));
      q+=__int_as_float(__builtin_amdgcn_ds_swizzle(__float_as_int(q),0x81f));
      q+=__int_as_float(__builtin_amdgcn_ds_swizzle(__float_as_int(q),0x101f));
      q+=__int_as_float(__builtin_amdgcn_ds_swizzle(__float_as_int(q),0x201f));
      q+=__int_as_float(__builtin_amdgcn_ds_swizzle(__float_as_int(q),0x401f));
      ss[r]=(1.f-LAMBDA_INIT0)/sqrtf(q*(1.f/128.f)+LN_EPS); }
    asm volatile("s_waitcnt lgkmcnt(0)":::"memory");
    unsigned char*stg=(unsigned char*)stash;
    #pragma unroll
    for(int d0=0;d0<4;++d0){ const float sgv=subln[d0*32+r32];
      #pragma unroll
      for(int r=0;r<16;++r){ const int w8=__builtin_amdgcn_cvt_pk_fp8_f32(o[d0][r]*ss[r]*sgv,0.f,0,false); stg[crow(r,hi)*128+d0*32+r32]=(unsigned char)(w8&0xff); } }
    asm volatile("s_waitcnt lgkmcnt(0)":::"memory");
    unsigned char*Aw=A2+(qrow0+wid*QBLK)*DM+acol;
    #pragma unroll
    for(int i=0;i<4;++i){const int row=i*8+(lane>>3),ch=lane&7; const u32x4 v=*(const u32x4*)(stg+row*128+ch*16); *(u32x4*)(Aw+(long)row*DM+ch*16)=v;}
    asm volatile("s_waitcnt lgkmcnt(0)":::"memory");
  }
  } }
  };
  if(FAST){ LOOPS(GAPF,false,(void)0,PHASEB); finish(); } else { LOOPS(GAPP,true,RESC(),PHASEB_NF); finish(); }
  #undef LOOPS
  asm volatile("s_waitcnt lgkmcnt(0)\n\ts_barrier":::"memory");
  #undef KVROW
  #undef DMA_K
  #undef DMA_V
  #undef START
  #undef RESC
  #undef ROT
  #undef PKW
  #undef PAFX
  #undef VF
  #undef PIN
  #undef MX3
  #undef EX
  #undef VRDL
  #undef VRDH
  #undef GAPP
  #undef GAPF
  #undef PHASEB
  #undef PHASEB_NF
  #undef MFQ
  #undef MFO
  #undef KRD
  #undef STEP2
  #undef ENDW
}
#undef SBAR
#undef WAIT_BAR
}
__device__ __forceinline__ void phase_attn2(const Frame& F, const Prm& p) {
    const bf16* Q = (const bf16*)(p.ws + WS_Q); const bf16* K = (const bf16*)(p.ws + WS_K); const bf16* V = (const bf16*)(p.ws + WS_V); unsigned char* A2 = p.ws + WS_O1;
    const float* lamp = (const float*)(p.ws + WS_MISC);
    for (int v = vcu_of(F); v < 256; v += F.G) {
        const int b = v >> 5, h = (v >> 2) & 7, part = v & 3;
        const long kctx = NLAT + b * CTXL, klat = (long)b * SEQ;
        const int nu = part ? 4 : 5;
        for (int i = 0; i < nu; ++i) {
            const long qrow0 = i < 4 ? klat + (part * 4 + i) * 256 : kctx; const int NT = i < 4 ? 68 : 4;
            for (int m = 0; m < 2; ++m) {
                const int hm = 2 * h + m;
                const float km = __uint_as_float(__hip_atomic_load(F.ctl + CW_KM + b * 16 + hm, __ATOMIC_RELAXED, __HIP_MEMORY_SCOPE_AGENT));
                attn_body::attn_unit2<8>(qrow0, hm * 64, h * 128, kctx, klat, NT, Q, K, V, m, lamp, p.subln, A2, h * 128, km, (char*)F.lds, F.wave);
            }
        }
    }
}
namespace gla3 {
typedef short bf16x8 __attribute__((ext_vector_type(8)));
typedef short s16x4 __attribute__((ext_vector_type(4)));
typedef float f32x16 __attribute__((ext_vector_type(16)));
constexpr int CH = 64 * 16 + 64;
constexpr int L_QS = 0, L_KS = 16 * CH, L_VS = 32 * CH, L_SB = 40 * CH, L_X = 56 * CH, L_DEC = L_X + 16384, L_END = L_DEC + 512;
__device__ __forceinline__ int crow(int i, int hh) { return (i & 3) + 8 * (i >> 2) + 4 * hh; }
typedef float f32x2_t __attribute__((ext_vector_type(2))); typedef __bf16 bf16x2_t __attribute__((ext_vector_type(2)));
__device__ __forceinline__ unsigned pk(float lo, float hi) { f32x2_t v = {lo, hi}; bf16x2_t b = __builtin_convertvector(v, bf16x2_t); return __builtin_bit_cast(unsigned, b); }
typedef short v4i16_t __attribute__((ext_vector_type(4)));
__device__ __forceinline__ s16x4 trrd(LAS const unsigned char* p) { return __builtin_bit_cast(s16x4, __builtin_amdgcn_ds_read_tr16_b64_v4i16((LAS v4i16_t*)p)); }
#define GLA_FR(lo, hi) (bf16x8){lo[0], lo[1], lo[2], lo[3], hi[0], hi[1], hi[2], hi[3]}

__device__ __forceinline__ void scan_unit(const Frame& F, const Prm& p, int unit) {
    const int dvs = unit & 3, dir = (unit >> 2) & 1, h = (unit >> 3) & 3, b = unit >> 5;
    LAS unsigned char* lds = (LAS unsigned char*)F.lds;
    const int lane = F.lane, w = F.wave, tid = F.tid, r = lane & 31, hh = lane >> 5;
    const bf16* QT = (const bf16*)(p.ws + WS_QT) + ((size_t)dir * 8 + 2 * h) * NTOK * 64;
    const bf16* KT = (const bf16*)(p.ws + WS_KT) + ((size_t)dir * 8 + 2 * h) * NTOK * 64;
    const bf16* V = (const bf16*)(p.ws + WS_V1) + h * 256 + dvs * 64;
    const float* DEC = (const float*)(p.ws + WS_DEC) + (size_t)dir * NCHUNK * 512 + h * 128;
    bf16* OG = (bf16*)((unsigned char*)p.out + (dir ? OUT_OGB : 0)) + h * 256 + dvs * 64;
    const int g1 = (lane >> 4) & 1, q4 = (lane & 15) >> 2, p4 = lane & 3;
    const int trb = (2 * g1 + (p4 >> 1)) * CH + q4 * 16 + 8 * (p4 & 1);
    const int trN = trb + 128 * hh, trP = trb + 64 * hh;
    f32x16 S0 = {}, S1 = {};
    for (int i = tid; i < 16 * CH / 16; i += NTHR) *(LAS u32x4*)(lds + L_SB + i * 16) = (u32x4){0u, 0u, 0u, 0u};
    u32x4 pq0[2], pq1[2], pk0[2], pk1[2], pv[2]; float pdec[2] = {0.f, 0.f};
#define GLA_CHUNK(step) ((step) >= 4 ? b * 64 + (dir ? 63 - ((step) - 4) : (step) - 4) : 512 + b * 4 + (dir ? 3 - (step) : (step)))
    const int qrow = 8 * w + (lane >> 4), qch = lane & 15, vrow = 8 * w + (lane >> 3), vch = lane & 7;
    const size_t qgo = (size_t)(qch >> 3) * NTOK * 64 + (qch & 7) * 8;
#define GLA_LOAD(step, u) do { const size_t t0_ = (size_t)GLA_CHUNK(step) * 64; \
        pq0[u] = *(const u32x4*)(QT + qgo + (t0_ + qrow) * 64); pq1[u] = *(const u32x4*)(QT + qgo + (t0_ + qrow + 4) * 64); \
        pk0[u] = *(const u32x4*)(KT + qgo + (t0_ + qrow) * 64); pk1[u] = *(const u32x4*)(KT + qgo + (t0_ + qrow + 4) * 64); \
        pv[u] = *(const u32x4*)(V + (t0_ + vrow) * 1024 + 8 * vch); if (tid < 128) pdec[u] = DEC[(size_t)GLA_CHUNK(step) * 512 + tid]; } while (0)
#define GLA_STORE(u) do { \
        *(LAS u32x4*)(lds + L_QS + qch * CH + qrow * 16) = pq0[u]; *(LAS u32x4*)(lds + L_QS + qch * CH + (qrow + 4) * 16) = pq1[u]; \
        *(LAS u32x4*)(lds + L_KS + qch * CH + qrow * 16) = pk0[u]; *(LAS u32x4*)(lds + L_KS + qch * CH + (qrow + 4) * 16) = pk1[u]; \
        *(LAS u32x4*)(lds + L_VS + vch * CH + vrow * 16) = pv[u]; \
        if (tid < 128) *(LAS float*)(lds + L_DEC + 4 * tid) = pdec[u]; } while (0)
    GLA_LOAD(0, 0);
    GLA_LOAD(1, 1);
    GLA_STORE(0);
    __syncthreads();
    const int tb = (w & 3) >> 1, vb = w & 1;
    for (int sp2 = 0; sp2 < 34; ++sp2) {
#pragma unroll
    for (int u = 0; u < 2; ++u) {
        const int step = 2 * sp2 + u;
        const bool lat = step >= 4; const int chunk = GLA_CHUNK(step);
        if (step + 2 < 68) GLA_LOAD(step + 2, u);
        f32x16 o = {};
        if (w < 4) {
            if (lat) {
                const bool n0 = dir ? (tb == 0) : true, n1 = dir ? true : (tb == 1);
                f32x16 sc0 = {}, sc1 = {};
#define GLA_BQ(ks) (*(const LAS bf16x8*)(lds + L_QS + (2 * (ks) + hh) * CH + (32 * tb + r) * 16))
#define GLA_A0(ks) (*(const LAS bf16x8*)(lds + L_KS + (2 * (ks) + hh) * CH + r * 16))
#define GLA_A1(ks) (*(const LAS bf16x8*)(lds + L_KS + (2 * (ks) + hh) * CH + (32 + r) * 16))
                if (n0 && n1) {
#pragma unroll
                    for (int ks = 0; ks < 8; ++ks) { const bf16x8 bq = GLA_BQ(ks); sc0 = __builtin_amdgcn_mfma_f32_32x32x16_bf16(GLA_A0(ks), bq, sc0, 0, 0, 0); sc1 = __builtin_amdgcn_mfma_f32_32x32x16_bf16(GLA_A1(ks), bq, sc1, 0, 0, 0); }
                } else if (n0) {
#pragma unroll
                    for (int ks = 0; ks < 8; ++ks) sc0 = __builtin_amdgcn_mfma_f32_32x32x16_bf16(GLA_A0(ks), GLA_BQ(ks), sc0, 0, 0, 0);
                } else {
#pragma unroll
                    for (int ks = 0; ks < 8; ++ks) sc1 = __builtin_amdgcn_mfma_f32_32x32x16_bf16(GLA_A1(ks), GLA_BQ(ks), sc1, 0, 0, 0);
                }
#undef GLA_BQ
#undef GLA_A0
#undef GLA_A1
                const int t = 32 * tb + r;
#pragma unroll
                for (int i = 0; i < 16; ++i) { const int s0 = crow(i, hh), s1 = 32 + s0; const bool k0 = dir ? (s0 >= t) : (s0 <= t), k1 = dir ? (s1 >= t) : (s1 <= t); sc0[i] = k0 ? sc0[i] : 0.f; sc1[i] = k1 ? sc1[i] : 0.f; }
#pragma unroll
                for (int sb = 0; sb < 2; ++sb) { if (sb == 0 ? n0 : n1) {
#pragma unroll
                    for (int sp = 0; sp < 2; ++sp) {
                        u32x4 pw;
                        if (sb == 0) { pw.x = pk(sc0[8 * sp + 0], sc0[8 * sp + 1]); pw.y = pk(sc0[8 * sp + 2], sc0[8 * sp + 3]); pw.z = pk(sc0[8 * sp + 4], sc0[8 * sp + 5]); pw.w = pk(sc0[8 * sp + 6], sc0[8 * sp + 7]); }
                        else { pw.x = pk(sc1[8 * sp + 0], sc1[8 * sp + 1]); pw.y = pk(sc1[8 * sp + 2], sc1[8 * sp + 3]); pw.z = pk(sc1[8 * sp + 4], sc1[8 * sp + 5]); pw.w = pk(sc1[8 * sp + 6], sc1[8 * sp + 7]); }
                        LAS const unsigned char* vp = lds + L_VS + trP + (4 * vb) * CH + (32 * sb + 16 * sp) * 16;
                        const s16x4 lo = trrd(vp), hi = trrd(vp + 8 * 16);
                        o = __builtin_amdgcn_mfma_f32_32x32x16_bf16(GLA_FR(lo, hi), __builtin_bit_cast(bf16x8, pw), o, 0, 0, 0);
                    } } }
            }
        } else {
            const int db = w - 4;
            if (lat) {
                f32x16 o2 = {};
#pragma unroll
                for (int ks = 0; ks < 8; ++ks) {
                    const bf16x8 as = *(const LAS bf16x8*)(lds + L_SB + (2 * ks + hh) * CH + (32 * vb + r) * 16);
                    const bf16x8 bq = *(const LAS bf16x8*)(lds + L_QS + (2 * ks + hh) * CH + (32 * tb + r) * 16);
                    o2 = __builtin_amdgcn_mfma_f32_32x32x16_bf16(as, bq, o2, 0, 0, 0);
                }
#pragma unroll
                for (int g = 0; g < 4; ++g) *(LAS f32x4*)(lds + L_X + (w & 3) * 4096 + g * 1024 + lane * 16) = (f32x4){o2[4 * g], o2[4 * g + 1], o2[4 * g + 2], o2[4 * g + 3]};
            }
#pragma unroll
            for (int ks = 0; ks < 4; ++ks) {
                LAS const unsigned char* kp = lds + L_KS + trN + (4 * db) * CH + (16 * ks) * 16;
                LAS const unsigned char* vp = lds + L_VS + trN + (16 * ks) * 16;
                const s16x4 al = trrd(kp), ah = trrd(kp + 4 * 16);
                const s16x4 b0l = trrd(vp), b0h = trrd(vp + 4 * 16), b1l = trrd(vp + 4 * CH), b1h = trrd(vp + 4 * CH + 4 * 16);
                S0 = __builtin_amdgcn_mfma_f32_32x32x16_bf16(GLA_FR(al, ah), GLA_FR(b0l, b0h), S0, 0, 0, 0); S1 = __builtin_amdgcn_mfma_f32_32x32x16_bf16(GLA_FR(al, ah), GLA_FR(b1l, b1h), S1, 0, 0, 0);
            }
#pragma unroll
            for (int i = 0; i < 16; ++i) { const float dc = *(const LAS float*)(lds + L_DEC + 4 * (32 * db + crow(i, hh))); S0[i] *= dc; S1[i] *= dc; }
        }
        __syncthreads();
        if (w < 4 && lat) {
            bf16* orow = OG + ((size_t)chunk * 64 + 32 * tb + r) * DM + 32 * vb + 4 * hh;
#pragma unroll
            for (int g = 0; g < 4; ++g) { const f32x4 x = *(const LAS f32x4*)(lds + L_X + w * 4096 + g * 1024 + lane * 16);
                u32x2 wv; wv.x = pk(o[4 * g] + x.x, o[4 * g + 1] + x.y); wv.y = pk(o[4 * g + 2] + x.z, o[4 * g + 3] + x.w); *(u32x2*)(orow + 8 * g) = wv; }
        }
        if (step + 1 < 68) {
            GLA_STORE(u ^ 1);
            if (w >= 4) { const int db = w - 4;
#pragma unroll
                for (int g = 0; g < 4; ++g) { u32x2 w0, w1; w0.x = pk(S0[4 * g], S0[4 * g + 1]); w0.y = pk(S0[4 * g + 2], S0[4 * g + 3]); w1.x = pk(S1[4 * g], S1[4 * g + 1]); w1.y = pk(S1[4 * g + 2], S1[4 * g + 3]);
                    *(LAS u32x2*)(lds + L_SB + (4 * db + g) * CH + r * 16 + 8 * hh) = w0; *(LAS u32x2*)(lds + L_SB + (4 * db + g) * CH + (32 + r) * 16 + 8 * hh) = w1; } }
        }
        __syncthreads();
    }
    }
#undef GLA_CHUNK
#undef GLA_LOAD
#undef GLA_STORE
}
#undef GLA_FR
}
__device__ __forceinline__ void phase_scan_opt(const Frame& F, const Prm& p) {
    for (int unit = vcu_of(F); unit < 256; unit += F.G) gla3::scan_unit(F, p, unit);
}
#define PHASE_QKV(F, p) phase_qkv_opt(F, p)
#define PHASE_ATTN(F, p) phase_attn2(F, p)
#define PHASE_WO(F, p, l) phase_wo_opt(F, p, l)
#define PHASE_MOE1(F, p, l) phase_moe1_opt(F, p, l)
#define PHASE_MOE2(F, p, l) phase_moe2_opt(F, p, l)
#define PHASE_INPROJ(F, p) phase_inproj_opt(F, p)
#define PHASE_SCAN(F, p) phase_scan_opt(F, p)
typedef GAS unsigned gu32;
#define XB_TMO      128
#define XB_XCNT(j)  (256  + 64 * (j))
#define XB_XSUB(j)  (1280 + 64 * (j))
#define XB_XGEN(j)  (2304 + 64 * (j))
#define XB_TOP      3328
#define XB_TOPGEN   3392
#define XCD_BAR_WORDS 3456
#define XB_SPIN_CAP (1u << 20)
__device__ __forceinline__ unsigned xb_ld(unsigned* p)              { return __hip_atomic_load(p, __ATOMIC_RELAXED, __HIP_MEMORY_SCOPE_AGENT); }
__device__ __forceinline__ unsigned xb_add(unsigned* p, unsigned v) { return __hip_atomic_fetch_add(p, v, __ATOMIC_RELAXED, __HIP_MEMORY_SCOPE_AGENT); }
__device__ __forceinline__ unsigned xb_xcc_id() { return (unsigned)__builtin_amdgcn_s_getreg((3 << 11) | 20) & 0xFu; }
#define XB_SPIN(cond, bar) do { unsigned _sp = 0; while (cond) { __builtin_amdgcn_s_sleep(1); \
    if ((++_sp & 255u) == 0u) { if (xb_ld(&(bar)[XB_TMO])) break; if (_sp > XB_SPIN_CAP) { atomicAdd(&(bar)[XB_TMO], 1u); break; } } } } while (0)
struct XcdBarrier { unsigned* bar; unsigned x; volatile LAS unsigned* st; };
__device__ __forceinline__ XcdBarrier xcd_barrier_post(unsigned* bar, volatile LAS unsigned* st) {
    XcdBarrier b; b.bar = bar; b.x = xb_xcc_id(); b.st = st;
    if (threadIdx.x == 0) (void)xb_add(&bar[XB_XCNT(b.x)], 1u);
    return b;
}
__device__ __forceinline__ void xcd_barrier_complete(unsigned* bar, unsigned x, unsigned& nloc, unsigned& nx) {
    const unsigned G = gridDim.x * gridDim.y * gridDim.z;
    unsigned sum, cnt, mine, sp = 0u;
    for (;;) {
        sum = 0u; cnt = 0u; mine = 0u;
#pragma unroll
        for (unsigned j = 0; j < 16; ++j) { const unsigned c = xb_ld(&bar[XB_XCNT(j)]); sum += c; cnt += (c > 0u) ? 1u : 0u; mine = (j == x) ? c : mine; }
        if (sum == G) break;
        __builtin_amdgcn_s_sleep(1);
        if ((++sp & 255u) == 0u) { if (xb_ld(&bar[XB_TMO])) break; if (sp > XB_SPIN_CAP) { atomicAdd(&bar[XB_TMO], 1u); break; } }
    }
    nloc = mine > 0u ? mine : 1u; nx = cnt > 0u ? cnt : 1u;
}
__device__ __forceinline__ void xcd_barrier(const XcdBarrier& b, int tid) {
    asm volatile("s_waitcnt vmcnt(0)" ::: "memory");
    __syncthreads();
    if (tid == 0) {
        unsigned* bar = b.bar;
        __builtin_amdgcn_s_waitcnt(0);
        unsigned nloc = b.st[0], nx = b.st[1];
        if (nloc == 0u) { xcd_barrier_complete(bar, b.x, nloc, nx); b.st[0] = nloc; b.st[1] = nx; }
        const unsigned old = xb_add(&bar[XB_XSUB(b.x)], 1u);
        const unsigned gen = old / nloc;
        if (old + 1u == (gen + 1u) * nloc) {
            __builtin_amdgcn_fence(__ATOMIC_RELEASE, "agent");
            asm volatile("s_waitcnt vmcnt(0)" ::: "memory");
            const unsigned og = xb_add(&bar[XB_TOP], 1u);
            const unsigned tg = og / nx;
            if (og + 1u == (tg + 1u) * nx) xb_add(&bar[XB_TOPGEN], 1u);
            else XB_SPIN(xb_ld(&bar[XB_TOPGEN]) == tg, bar);
            __builtin_amdgcn_fence(__ATOMIC_ACQUIRE, "agent");
            xb_add(&bar[XB_XGEN(b.x)], 1u);
            asm volatile("s_waitcnt vmcnt(0)" ::: "memory");
        } else {
            XB_SPIN(xb_ld(&bar[XB_XGEN(b.x)]) == gen, bar);
            __builtin_amdgcn_fence(__ATOMIC_ACQUIRE, "agent");
            asm volatile("s_waitcnt vmcnt(0)" ::: "memory");
        }
    }
    __syncthreads();
}

constexpr int NPHASE = 19;
__global__ void __launch_bounds__(NTHR, 2) mega_fwd(Prm p) {
    extern __shared__ __attribute__((aligned(16))) unsigned char lds[];
    Frame F; F.lds = lds; F.ctl = (unsigned*)(p.ws + WS_CTL);
    F.tid = threadIdx.x; F.lane = F.tid & 63; F.wave = __builtin_amdgcn_readfirstlane(F.tid >> 6); F.G = gridDim.x; F.bid = blockIdx.x;
    for (int u = F.tid; u < (LDS_BYTES - LDSCTL_OFF) / 4; u += NTHR) ((LAS unsigned*)(lds + LDSCTL_OFF))[u] = 0u;
    __syncthreads();
    const int lo = p.ph_lo, hi = p.ph_hi;
    const bool multi = (hi - lo) > 1;
    XcdBarrier bar; bar.bar = F.ctl + CW_BAR + p.li * XCD_BAR_WORDS; bar.x = 0; bar.st = nullptr;
    if (multi) bar = xcd_barrier_post(F.ctl + CW_BAR + p.li * XCD_BAR_WORDS, (volatile LAS unsigned*)(lds + MISC_OFF) + 8);
#define IN(k) (lo <= (k) && (k) < hi)
#define SEAM(k) do { if (IN(k) && IN((k) + 1)) xcd_barrier(bar, F.tid); } while (0)
    if (IN(0)) { phase_prologue(F, p); } SEAM(0);
    if (IN(1)) { phase_modulate0(F, p); } SEAM(1);
    if (IN(2)) { PHASE_QKV(F, p); } SEAM(2);
    if (IN(3)) { PHASE_ATTN(F, p); }
    {
        int l_; asm volatile("v_mbcnt_lo_u32_b32 %0, -1, 0\n\tv_mbcnt_hi_u32_b32 %0, -1, %0" : "=v"(l_)); F.lane = l_; F.tid = F.wave * 64 + l_; }
    SEAM(3);
    if (IN(5)) { PHASE_WO(F, p, 0); } SEAM(5);
    if (IN(6)) { phase_ln_route(F, p, 0); } SEAM(6);
    if (IN(7)) { PHASE_MOE1(F, p, 0); } SEAM(7);
    if (IN(8)) { PHASE_MOE2(F, p, 0); } SEAM(8);
    if (IN(9)) { phase_moe_combine(F, p, 0); } SEAM(9);
    if (IN(10)) { PHASE_INPROJ(F, p); } SEAM(10);
    if (IN(11)) { phase_gla_prep(F, p); } SEAM(11);
    if (IN(12)) { PHASE_SCAN(F, p); } SEAM(12);
    if (IN(13)) { phase_gla_post(F, p); } SEAM(13);
    if (IN(14)) { PHASE_WO(F, p, 1); } SEAM(14);
    if (IN(15)) { phase_ln_route(F, p, 1); } SEAM(15);
    if (IN(16)) { PHASE_MOE1(F, p, 1); } SEAM(16);
    if (IN(17)) { PHASE_MOE2(F, p, 1); } SEAM(17);
    if (IN(18)) { phase_moe_combine(F, p, 1); }
#undef IN
#undef SEAM
}

extern "C" void kernel_launch(void* const* d_in, const int* in_sizes, int n_in, void* d_out, int out_size, void* d_ws, size_t ws_size, hipStream_t stream) {
    static int grid = 0;
    if (grid == 0) {
        if (n_in != 23 || in_sizes[0] != NLAT * DM || out_size != NLAT * DM || ws_size < WS_END) { fprintf(stderr, "kernel_launch: unexpected shapes (n_in %d, in0 %d, out %d, ws %zu); nothing launched\n", n_in, n_in > 0 ? in_sizes[0] : -1, out_size, ws_size); grid = -1; return; }
        int dev = 0, cus = 0;
        if (hipGetDevice(&dev) != hipSuccess || hipDeviceGetAttribute(&cus, hipDeviceAttributeMultiprocessorCount, dev) != hipSuccess) { grid = -1; return; }
        if (hipFuncSetAttribute((const void*)mega_fwd, hipFuncAttributeMaxDynamicSharedMemorySize, LDS_BYTES) != hipSuccess) { fprintf(stderr, "kernel_launch: hipFuncSetAttribute failed\n"); grid = -1; return; }
        int per_cu = 0;
        if (hipOccupancyMaxActiveBlocksPerMultiprocessor(&per_cu, (const void*)mega_fwd, NTHR, LDS_BYTES) != hipSuccess || per_cu < 1) fprintf(stderr, "kernel_launch: note: occupancy query reports %d\n", per_cu);
        (void)hipGetLastError();
        grid = cus;
    }
    if (grid < 0) return;
    (void)hipMemsetAsync((char*)d_ws + WS_CTL, 0, CTL_ZERO_BYTES, stream);
    Prm p{};
    const float** pp = (const float**)&p;
    for (int i = 0; i < 23; ++i) pp[i] = (const float*)d_in[i];
    p.out = (float*)d_out; p.ws = (unsigned char*)d_ws;
    p.ph_lo = 0; p.ph_hi = NPHASE; p.li = 0;
    hipLaunchKernelGGL(mega_fwd, dim3(grid), dim3(NTHR), LDS_BYTES, stream, p);
}
```

```cpp
#include <hip/hip_runtime.h>
#include <cstdint>
#include <cstdio>

constexpr int BATCH = 8, SEQ = 4096, DM = 1024, CTXL = 256;
constexpr int NLAT = BATCH * SEQ, NCTX = BATCH * CTXL, NTOK = NLAT + NCTX;
constexpr float ALPHA = 1.4142135623730951f;
constexpr float LN_EPS = 1e-5f;
constexpr float LAMBDA_INIT0 = 0.2f;
constexpr float C2 = 0.125f * 1.4426950408889634f;
constexpr int NEXP = 16, DEXP = 512, MAXSLOT = 73728;
constexpr int NCHUNK = NTOK / 64;
constexpr int NIN = 3328;

typedef unsigned short bf16;
typedef float f32x4 __attribute__((ext_vector_type(4)));
typedef float f32x2 __attribute__((ext_vector_type(2)));
typedef unsigned u32x2 __attribute__((ext_vector_type(2)));
typedef unsigned u32x4 __attribute__((ext_vector_type(4)));

constexpr size_t MiB = 1u << 20;
constexpr size_t WS_CTL = 0, CTL_ZERO_BYTES = 1 * MiB;
constexpr size_t WS_MOD = 1 * MiB;
constexpr size_t WS_MISC = 1 * MiB + 512 * 1024;
constexpr size_t WS_WQKV = 2 * MiB, WS_WO = 5 * MiB, WS_GU0 = 6 * MiB, WS_DN0 = 22 * MiB, WS_WIN = 30 * MiB, WS_WGO = 34 * MiB, WS_GU1 = 35 * MiB, WS_DN1 = 51 * MiB;
constexpr size_t WS_XB = 59 * MiB;
constexpr size_t WS_H = 127 * MiB;
constexpr size_t WS_Q = 195 * MiB, WS_K = 263 * MiB, WS_V = 331 * MiB, WS_O2 = 399 * MiB;
constexpr size_t WS_LIST = 467 * MiB;
constexpr size_t WS_TOKR = 470 * MiB;
constexpr size_t WS_DEC = 472 * MiB;
constexpr size_t WS_ZZ = 475 * MiB;
constexpr size_t WS_END = 480 * MiB;
constexpr size_t WS_O1 = WS_H, WS_A2 = WS_H, WS_Y = WS_K;
constexpr size_t WS_YM = 195 * MiB, WS_ACT = 339 * MiB;
constexpr size_t WS_QR = 195 * MiB, WS_KR = 229 * MiB, WS_V1 = 263 * MiB, WS_R = 331 * MiB;
constexpr size_t WS_QT = WS_H, WS_KT = 399 * MiB;
constexpr size_t WS_A2B = WS_H;
constexpr size_t OUT_OGB = 64 * MiB;
constexpr int CW_TMO = 0, CW_CODE = 1;
constexpr int CW_CNT = 64;
constexpr int CW_KM = 128;
constexpr int CW_BAR = 4096;

__device__ __forceinline__ unsigned f2bf(float f) { unsigned u = __builtin_bit_cast(unsigned, f); return (u + 0x7fffu + ((u >> 16) & 1u)) >> 16; }
__device__ __forceinline__ unsigned pk2(float lo, float hi) { return f2bf(lo) | (f2bf(hi) << 16); }
__device__ __forceinline__ float bf2f(unsigned b) { return __builtin_bit_cast(float, b << 16); }
__device__ __forceinline__ float wave_sum(float v) {
#pragma unroll
    for (int o = 1; o < 64; o <<= 1) v += __shfl_xor(v, o);
    return v;
}
__device__ __forceinline__ float silu_f(float v) { return v / (1.f + __expf(-v)); }

struct Prm {
    const float *x, *c, *ctx, *cctx, *ada_w, *ada_b, *ln_g, *ln_b, *w_qkv, *w_o, *lam, *subln, *gw_in, *gwg_down, *gwg_up, *gbg, *gnorm, *gw_o, *rw, *rb, *mg, *mu, *md;
    float* out; unsigned char* ws;
    int ph_lo, ph_hi, li, pad;
};
__device__ __forceinline__ void ld_row_f32(const float* p, int lane, f32x4 (&v)[4]) {
#pragma unroll
    for (int j = 0; j < 4; ++j) v[j] = *(const f32x4*)(p + 4 * lane + 256 * j);
}
__device__ __forceinline__ void st_row_f32(float* p, int lane, const f32x4 (&v)[4]) {
#pragma unroll
    for (int j = 0; j < 4; ++j) *(f32x4*)(p + 4 * lane + 256 * j) = v[j];
}
__device__ __forceinline__ void ld_row_bf16(const bf16* p, int lane, f32x4 (&v)[4]) {
#pragma unroll
    for (int j = 0; j < 4; ++j) { const u32x2 u = *(const u32x2*)(p + 4 * lane + 256 * j); v[j] = (f32x4){bf2f(u.x & 0xffffu), bf2f(u.x >> 16), bf2f(u.y & 0xffffu), bf2f(u.y >> 16)}; }
}
__device__ __forceinline__ void st_row_bf16(bf16* p, int lane, const f32x4 (&v)[4]) {
#pragma unroll
    for (int j = 0; j < 4; ++j) { u32x2 u; u.x = pk2(v[j].x, v[j].y); u.y = pk2(v[j].z, v[j].w); *(u32x2*)(p + 4 * lane + 256 * j) = u; }
}
__device__ __forceinline__ void ln_row(f32x4 (&v)[4], const float* g, const float* b, int lane) {
    float s = 0.f;
#pragma unroll
    for (int j = 0; j < 4; ++j) s += (v[j].x + v[j].y) + (v[j].z + v[j].w);
    const float mean = wave_sum(s) * (1.f / DM); float q = 0.f;
#pragma unroll
    for (int j = 0; j < 4; ++j) { v[j] = v[j] - mean; q += (v[j].x * v[j].x + v[j].y * v[j].y) + (v[j].z * v[j].z + v[j].w * v[j].w); }
    const float rstd = 1.f / sqrtf(wave_sum(q) * (1.f / DM) + LN_EPS);
#pragma unroll
    for (int j = 0; j < 4; ++j) { const f32x4 gg = *(const f32x4*)(g + 4 * lane + 256 * j), bb = *(const f32x4*)(b + 4 * lane + 256 * j); v[j] = v[j] * rstd * gg + bb; }
}
__host__ __device__ __forceinline__ int gu_phys(int other, int sel) { return (other >> 4) * 32 + sel * 16 + (other & 15); }
__host__ __device__ __forceinline__ int perm16b(int L) { return (L & ~31) | (16 * ((L >> 2) & 1) + 4 * ((L >> 3) & 3) + (L & 3)); }
__host__ __device__ __forceinline__ int perm16b_inv(int P) { return (P & ~31) | (8 * ((P >> 2) & 3) + 4 * ((P >> 4) & 1) + (P & 3)); }
__device__ __forceinline__ unsigned pk4_fp8(float a, float b, float c, float d) { int w = 0; w = __builtin_amdgcn_cvt_pk_fp8_f32(a, b, w, false); w = __builtin_amdgcn_cvt_pk_fp8_f32(c, d, w, true); return (unsigned)w; }
constexpr float W8_SCALE = 64.f, W8_INV = 1.f / 64.f;
__device__ __forceinline__ void st_row_fp8(unsigned char* p, int lane, const f32x4 (&v)[4]) {
#pragma unroll
    for (int j = 0; j < 4; ++j) *(unsigned*)(p + 4 * lane + 256 * j) = pk4_fp8(v[j].x, v[j].y, v[j].z, v[j].w);
}
__device__ __forceinline__ void ld_row_fp8(const unsigned char* p, int lane, f32x4 (&v)[4]) {
#pragma unroll
    for (int j = 0; j < 4; ++j) { const int w = *(const int*)(p + 4 * lane + 256 * j); const f32x2 lo = __builtin_amdgcn_cvt_pk_f32_fp8(w, false), hi = __builtin_amdgcn_cvt_pk_f32_fp8(w, true); v[j] = (f32x4){lo.x, lo.y, hi.x, hi.y}; }
}
#define GAS __attribute__((address_space(1)))
#define LAS __attribute__((address_space(3)))
constexpr int NWAVES = 8, NTHR = NWAVES * 64;
constexpr int RING_BYTES = 131072, LDS_BYTES = 147456, LDSCTL_OFF = LDS_BYTES - 1024, MISC_OFF = LDSCTL_OFF + 320;
constexpr int LDSX_OFF = RING_BYTES + 1024;
#define LDS_WAIT() asm volatile("s_waitcnt lgkmcnt(0)" ::: "memory")
#define VM_WAIT() asm volatile("s_waitcnt vmcnt(0)" ::: "memory")

struct Frame {
    unsigned char* lds;
    unsigned* ctl;
    int tid, lane, wave, G, bid;
};

template <int MODE>
__device__ __forceinline__ void p0_transpose_item(const float* W, int K, int N, bf16* WT, int row_off, float* scr, int item, int lane) {
    const int nblk = N / 32, kb = item / nblk, nb = item % nblk, k0 = 64 * kb, n0 = 32 * nb;
    { f32x4 t[8];
#pragma unroll
        for (int i = 0; i < 8; ++i) t[i] = *(const f32x4*)(W + (size_t)(k0 + 8 * i + (lane >> 3)) * N + n0 + 4 * (lane & 7));
#pragma unroll
        for (int i = 0; i < 8; ++i) { float* d = scr + (8 * i + (lane >> 3)) * 33 + 4 * (lane & 7); d[0] = t[i].x; d[1] = t[i].y; d[2] = t[i].z; d[3] = t[i].w; } }
    LDS_WAIT(); asm volatile("" ::: "memory");
    const int c = lane & 7;
#pragma unroll
    for (int j = 0; j < 4; ++j) { const int n = (lane >> 3) + 8 * j; const float* s = scr + (8 * c) * 33 + n;
        u32x4 o; o.x = pk2(s[0 * 33], s[1 * 33]); o.y = pk2(s[2 * 33], s[3 * 33]); o.z = pk2(s[4 * 33], s[5 * 33]); o.w = pk2(s[6 * 33], s[7 * 33]);
        const int nl = n0 + n; const int pr = (MODE == 0) ? (row_off + nl) : (MODE == 3) ? (row_off + perm16b(nl)) : (row_off + gu_phys(nl, MODE - 1));
        *(u32x4*)(WT + (size_t)pr * K + k0 + 8 * c) = o; }
    LDS_WAIT(); asm volatile("" ::: "memory");
}
template <int MODE>
__device__ __forceinline__ void p0_transpose_item8(const float* W, int K, int N, unsigned char* WT, float* scr, int item, int lane) {
    const int nblk = N / 32, kb = item / nblk, nb = item % nblk, k0 = 64 * kb, n0 = 32 * nb;
    { f32x4 t[8];
#pragma unroll
        for (int i = 0; i < 8; ++i) t[i] = *(const f32x4*)(W + (size_t)(k0 + 8 * i + (lane >> 3)) * N + n0 + 4 * (lane & 7));
#pragma unroll
        for (int i = 0; i < 8; ++i) { float* d = scr + (8 * i + (lane >> 3)) * 33 + 4 * (lane & 7); d[0] = t[i].x; d[1] = t[i].y; d[2] = t[i].z; d[3] = t[i].w; } }
    LDS_WAIT(); asm volatile("" ::: "memory");
    const int c = lane & 7;
#pragma unroll
    for (int j = 0; j < 4; ++j) { const int n = (lane >> 3) + 8 * j; const float* s = scr + (8 * c) * 33 + n;
        u32x2 o; o.x = pk4_fp8(s[0 * 33] * W8_SCALE, s[1 * 33] * W8_SCALE, s[2 * 33] * W8_SCALE, s[3 * 33] * W8_SCALE); o.y = pk4_fp8(s[4 * 33] * W8_SCALE, s[5 * 33] * W8_SCALE, s[6 * 33] * W8_SCALE, s[7 * 33] * W8_SCALE);
        const int nl = n0 + n; const int pr = (MODE == 3) ? perm16b(nl) : (MODE == 0) ? nl : gu_phys(nl, MODE - 1);
        *(u32x2*)(WT + (size_t)pr * K + k0 + 8 * c) = o; }
    LDS_WAIT(); asm volatile("" ::: "memory");
}
__device__ __forceinline__ void phase_prologue(const Frame& F, const Prm& p) {
    float* sil = (float*)F.lds;
    for (int i = F.tid; i < 9 * 1024; i += NTHR) { const int r = i >> 10, k = i & 1023; const float v = (r < 8) ? p.c[r * 1024 + k] : p.cctx[k]; sil[i] = silu_f(v); }
    __syncthreads();
    float* MOD = (float*)(p.ws + WS_MOD);
    if (F.bid < 192) {
        const int layer = F.bid / 96, n = (F.bid % 96) * 64 + F.lane; const float* W = p.ada_w + (size_t)layer * 1024 * 6144 + n;
        float acc[9];
#pragma unroll
        for (int r = 0; r < 9; ++r) acc[r] = 0.f;
        const int kb = F.wave * 128;
#pragma unroll 4
        for (int k = kb; k < kb + 128; k += 4) {
            const float w0 = W[(size_t)k * 6144], w1 = W[(size_t)(k + 1) * 6144], w2 = W[(size_t)(k + 2) * 6144], w3 = W[(size_t)(k + 3) * 6144];
#pragma unroll
            for (int r = 0; r < 9; ++r) { const f32x4 s = *(const f32x4*)(sil + r * 1024 + k); acc[r] += s.x * w0 + s.y * w1 + s.z * w2 + s.w * w3; }
        }
        float* red = (float*)(F.lds + 36864 + 8 * 8704);
#pragma unroll
        for (int r = 0; r < 9; ++r) red[(F.wave * 9 + r) * 64 + F.lane] = acc[r];
        __syncthreads();
        if (F.wave == 0) { const float bb = p.ada_b[layer * 6144 + n];
#pragma unroll
            for (int r = 0; r < 9; ++r) { float t = bb;
#pragma unroll
                for (int w = 0; w < 8; ++w) t += red[(w * 9 + r) * 64 + F.lane];
                MOD[(layer * 9 + r) * 6144 + n] = t; } }
    }
    float* misc = (float*)(p.ws + WS_MISC);
    if (F.bid == 255 % F.G && F.wave == 1) {
        const float a = wave_sum(p.lam[F.lane] * p.lam[64 + F.lane]), b = wave_sum(p.lam[128 + F.lane] * p.lam[192 + F.lane]);
        if (F.lane == 0) misc[0] = __expf(a) - __expf(b) + LAMBDA_INIT0;
        for (int i = F.lane; i < 1024; i += 64) { const int pos = i >> 4, f = i & 15; const float inv = powf(10000.f, -(float)f / 16.f); const float ang = (float)pos * inv;
            misc[1024 + 2 * i] = cosf(ang); misc[1024 + 2 * i + 1] = sinf(ang); }
    }
    float* scr = (float*)(F.lds + 36864 + F.wave * 8704);
    const int gw = F.bid * NWAVES + F.wave, NGW = F.G * NWAVES;
    constexpr int I_QKV = 16 * 96, I_SQ = 16 * 32, I_G = 16 * 16, I_D = 8 * 32;
    constexpr int I_MOE = 2 * I_G + I_D;
    constexpr int NITEMS = 2 * I_QKV + 2 * I_SQ + 32 * I_MOE;
    bf16* ws16 = (bf16*)p.ws;
    for (int it = gw; it < NITEMS; it += NGW) {
        int r = it;
        if (r < I_QKV) { if ((r % 96) < 64) p0_transpose_item8<0>(p.w_qkv, 1024, 3072, p.ws + WS_WQKV, scr, r, F.lane); else p0_transpose_item8<3>(p.w_qkv, 1024, 3072, p.ws + WS_WQKV, scr, r, F.lane); continue; } r -= I_QKV;
        if (r < I_QKV) { p0_transpose_item8<3>(p.gw_in, 1024, 3072, p.ws + WS_WIN, scr, r, F.lane); continue; } r -= I_QKV;
        if (r < I_SQ) { p0_transpose_item8<3>(p.w_o, 1024, 1024, p.ws + WS_WO, scr, r, F.lane); continue; } r -= I_SQ;
        if (r < I_SQ) { p0_transpose_item8<3>(p.gw_o, 1024, 1024, p.ws + WS_WGO, scr, r, F.lane); continue; } r -= I_SQ;
        const int le = r / I_MOE, layer = le >> 4, e = le & 15; r -= le * I_MOE;
        unsigned char* GU = p.ws + (layer ? WS_GU1 : WS_GU0) + (size_t)e * 1024 * 1024; unsigned char* DN = p.ws + (layer ? WS_DN1 : WS_DN0) + (size_t)e * 1024 * 512;
        if (r < I_G) { p0_transpose_item8<1>(p.mg + (size_t)le * 1024 * 512, 1024, 512, GU, scr, r, F.lane); continue; } r -= I_G;
        if (r < I_G) { p0_transpose_item8<2>(p.mu + (size_t)le * 1024 * 512, 1024, 512, GU, scr, r, F.lane); continue; } r -= I_G;
        p0_transpose_item8<3>(p.md + (size_t)le * 512 * 1024, 512, 1024, DN, scr, r, F.lane);
    }
    (void)ws16;
    unsigned char* WIN = p.ws + WS_WIN;
    for (int i = gw * 64 + F.lane; i < 32 * 256; i += NGW * 64) { const int rr = i >> 8, k = (i & 255) * 4, dir = rr >> 4, j = rr & 15; const float* s = p.gwg_down + (size_t)dir * 1024 * 16 + j;
        *(unsigned*)(WIN + (size_t)(3072 + rr) * 1024 + k) = pk4_fp8(s[(size_t)k * 16] * W8_SCALE, s[(size_t)(k + 1) * 16] * W8_SCALE, s[(size_t)(k + 2) * 16] * W8_SCALE, s[(size_t)(k + 3) * 16] * W8_SCALE); }
    for (int i = gw * 64 + F.lane; i < 224 * 1024 / 16; i += NGW * 64) *(u32x4*)(WIN + (size_t)3104 * 1024 + (size_t)i * 16) = (u32x4){0u, 0u, 0u, 0u};
}

__device__ __forceinline__ void phase_modulate0(const Frame& F, const Prm& p) {
    const float* MOD = (const float*)(p.ws + WS_MOD); unsigned char* H = p.ws + WS_H;
    const int gw = F.bid * NWAVES + F.wave, NGW = F.G * NWAVES, per = (NTOK + NGW - 1) / NGW;
    int curmod = -1; f32x4 sh[4], sc[4];
    const int t0 = gw * per, t1 = min(NTOK, (gw + 1) * per);
    f32x4 v[4], vn[4];
    if (t0 < t1) ld_row_f32(t0 < NLAT ? p.x + (size_t)t0 * DM : p.ctx + (size_t)(t0 - NLAT) * DM, F.lane, v);
    for (int tok = t0; tok < t1; ++tok) {
        if (tok + 1 < t1) ld_row_f32(tok + 1 < NLAT ? p.x + (size_t)(tok + 1) * DM : p.ctx + (size_t)(tok + 1 - NLAT) * DM, F.lane, vn);
        const int mr = tok < NLAT ? tok / SEQ : 8;
        if (mr != curmod) { curmod = mr; ld_row_f32(MOD + mr * 6144, F.lane, sh); ld_row_f32(MOD + mr * 6144 + 1024, F.lane, sc); }
#pragma unroll
        for (int j = 0; j < 4; ++j) v[j] = v[j] * (1.f + sc[j]) + sh[j];
        st_row_fp8(H + (size_t)tok * DM, F.lane, v);
#pragma unroll
        for (int j = 0; j < 4; ++j) v[j] = vn[j];
    }
}

__device__ __forceinline__ void phase_ln_route(const Frame& F, const Prm& p, int layer) {
    const int nrows = layer ? NLAT : NTOK;
    const float* MOD = (const float*)(p.ws + WS_MOD) + layer * 9 * 6144;
    const bf16* Y = (const bf16*)(p.ws + WS_Y); unsigned char* HF = p.ws + WS_H;
    bf16* XB = (bf16*)(p.ws + WS_XB);
    int* LIST = (int*)(p.ws + WS_LIST); int* TOKR = (int*)(p.ws + WS_TOKR);
    unsigned* CNT = F.ctl + CW_CNT + layer * 16;
    float* WrT = (float*)F.lds;
    int* rec = (int*)(F.lds + 65536);
    unsigned* lcnt = (unsigned*)(F.lds + 65536 + 8192); unsigned* lbase = lcnt + 16;
    for (int i = F.tid; i < 16 * 1024; i += NTHR) { const int k = i >> 4, e = i & 15; WrT[e * 1024 + k] = p.rw[i]; }
    if (F.tid < 16) lcnt[F.tid] = 0u;
    __syncthreads();
    const int per_wg = (nrows + F.G - 1) / F.G, per_w = (per_wg + NWAVES - 1) / NWAVES;
    const int row_lo = F.bid * per_wg, row_hi = min(nrows, row_lo + per_wg);
    const float* lng = p.ln_g + (layer * 2 + 0) * DM; const float* lnb = p.ln_b + (layer * 2 + 0) * DM;
    float rb[16];
#pragma unroll
    for (int e = 0; e < 16; ++e) rb[e] = p.rb[e];
    int curmod = -1; f32x4 gm[4], shf[4], scf[4];
    f32x4 v[4], y[4], vn[4], yn[4];
#define LNR_LOAD(tok_, V, Yv) do { if (layer) ld_row_bf16(XB + (size_t)(tok_) * DM, F.lane, V); else ld_row_f32((tok_) < NLAT ? p.x + (size_t)(tok_) * DM : p.ctx + (size_t)((tok_) - NLAT) * DM, F.lane, V); \
        ld_row_bf16(Y + (size_t)(tok_) * DM, F.lane, Yv); } while (0)
    if (row_lo + F.wave * per_w < row_hi) LNR_LOAD(row_lo + F.wave * per_w, v, y);
    for (int i = 0; i < per_w; ++i) {
        const int lr = F.wave * per_w + i, tok = row_lo + lr; if (tok >= row_hi) break;
        if (i + 1 < per_w && tok + 1 < row_hi) LNR_LOAD(tok + 1, vn, yn);
        const int mr = tok < NLAT ? tok / SEQ : 8;
        if (mr != curmod) { curmod = mr; ld_row_f32(MOD + mr * 6144 + 2048, F.lane, gm); ld_row_f32(MOD + mr * 6144 + 3072, F.lane, shf); ld_row_f32(MOD + mr * 6144 + 4096, F.lane, scf); }
        bf16* xdst = XB + (size_t)tok * DM;
#pragma unroll
        for (int j = 0; j < 4; ++j) v[j] = ALPHA * v[j] + gm[j] * y[j];
        ln_row(v, lng, lnb, F.lane);
        st_row_bf16(xdst, F.lane, v);
#pragma unroll
        for (int j = 0; j < 4; ++j) v[j] = v[j] * (1.f + scf[j]) + shf[j];
        st_row_fp8(HF + (size_t)tok * DM, F.lane, v);
        float part[16];
#pragma unroll
        for (int e = 0; e < 16; ++e) { float s = 0.f;
#pragma unroll
            for (int j = 0; j < 4; ++j) { const f32x4 w = *(const f32x4*)(WrT + e * 1024 + 4 * F.lane + 256 * j); s += (v[j].x * w.x + v[j].y * w.y) + (v[j].z * w.z + v[j].w * w.w); }
            part[e] = s; }
        {
#pragma unroll
            for (int e = 0; e < 8; ++e) { const bool up = (F.lane & 32) != 0; const float keep = up ? part[e + 8] : part[e], send = up ? part[e] : part[e + 8]; part[e] = keep + __shfl_xor(send, 32); }
#pragma unroll
            for (int e = 0; e < 4; ++e) { const bool up = (F.lane & 16) != 0; const float keep = up ? part[e + 4] : part[e], send = up ? part[e] : part[e + 4]; part[e] = keep + __shfl_xor(send, 16); }
#pragma unroll
            for (int e = 0; e < 2; ++e) { const bool up = (F.lane & 8) != 0; const float keep = up ? part[e + 2] : part[e], send = up ? part[e] : part[e + 2]; part[e] = keep + __shfl_xor(send, 8); }
            { const bool up = (F.lane & 4) != 0; const float keep = up ? part[1] : part[0], send = up ? part[0] : part[1]; part[0] = keep + __shfl_xor(send, 4); }
            part[0] += __shfl_xor(part[0], 2); part[0] += __shfl_xor(part[0], 1);
        }
        float aff[16], sel[16];
#pragma unroll
        for (int e = 0; e < 16; ++e) { const int src = ((e >> 3) & 1) * 32 + ((e >> 2) & 1) * 16 + ((e >> 1) & 1) * 8 + (e & 1) * 4; const float lg = __shfl(part[0], src); aff[e] = 1.f / (1.f + __expf(-lg)); sel[e] = aff[e] + rb[e]; }
        int bg = 0; float bgs = -3.0e38f;
#pragma unroll
        for (int g = 0; g < 4; ++g) { float m1 = -3.0e38f, m2 = -3.0e38f;
#pragma unroll
            for (int k = 0; k < 4; ++k) { const float s = sel[4 * g + k]; if (s > m1) { m2 = m1; m1 = s; } else if (s > m2) m2 = s; }
            const float gs = m1 + m2; if (gs > bgs) { bgs = gs; bg = g; } }
        int i1 = 0, i2 = 0; float s1 = -3.0e38f, s2 = -3.0e38f, a1 = 0.f, a2 = 0.f;
#pragma unroll
        for (int g = 0; g < 4; ++g) if (g == bg) {
#pragma unroll
            for (int k = 0; k < 4; ++k) { const float s = sel[4 * g + k], a = aff[4 * g + k];
                if (s > s1) { s2 = s1; i2 = i1; a2 = a1; s1 = s; i1 = 4 * g + k; a1 = a; } else if (s > s2) { s2 = s; i2 = 4 * g + k; a2 = a; } } }
        const float wsum = a1 + a2, w1 = a1 / wsum, w2 = a2 / wsum;
        if (F.lane == 0) { const unsigned l1 = atomicAdd(&lcnt[i1], 1u), l2 = atomicAdd(&lcnt[i2], 1u);
            rec[lr * 6 + 0] = i1; rec[lr * 6 + 1] = i2; rec[lr * 6 + 2] = (int)l1; rec[lr * 6 + 3] = (int)l2; rec[lr * 6 + 4] = __float_as_int(w1); rec[lr * 6 + 5] = __float_as_int(w2); }
#pragma unroll
        for (int j = 0; j < 4; ++j) { v[j] = vn[j]; y[j] = yn[j]; }
    }
#undef LNR_LOAD
    __syncthreads();
    if (F.tid < 16) lbase[F.tid] = __hip_atomic_fetch_add(&CNT[F.tid], lcnt[F.tid], __ATOMIC_RELAXED, __HIP_MEMORY_SCOPE_AGENT);
    __syncthreads();
    for (int lr = F.tid; lr < row_hi - row_lo; lr += NTHR) { const int tok = row_lo + lr;
        const int e0 = rec[lr * 6], e1 = rec[lr * 6 + 1]; const int p0 = (int)lbase[e0] + rec[lr * 6 + 2], p1 = (int)lbase[e1] + rec[lr * 6 + 3];
        LIST[e0 * NTOK + p0] = tok; LIST[e1 * NTOK + p1] = tok;
        int* tr = TOKR + (size_t)tok * 8; tr[0] = e0; tr[1] = p0; tr[2] = e1; tr[3] = p1; tr[4] = rec[lr * 6 + 4]; tr[5] = rec[lr * 6 + 5]; }
    __syncthreads();
}

__device__ __forceinline__ void pad_bases(const unsigned* cnt, int (&pb)[17]) {
    int acc = 0;
#pragma unroll
    for (int e = 0; e < 16; ++e) { pb[e] = acc; const int c = (int)__hip_atomic_load(cnt + e, __ATOMIC_RELAXED, __HIP_MEMORY_SCOPE_AGENT); acc += (c + 255) & ~255; }
    pb[16] = acc;
}

__device__ __forceinline__ void phase_moe_combine(const Frame& F, const Prm& p, int layer) {
    const int nrows = layer ? NLAT : NTOK;
    const float* MOD = (const float*)(p.ws + WS_MOD) + layer * 9 * 6144; const float* MOD1 = (const float*)(p.ws + WS_MOD) + 9 * 6144;
    const unsigned char* YM = p.ws + WS_YM;   unsigned char* H = p.ws + WS_H;   bf16* XB = (bf16*)(p.ws + WS_XB); const int* TOKR = (const int*)(p.ws + WS_TOKR);
    int pb[17]; pad_bases(F.ctl + CW_CNT + layer * 16, pb);
    int* pbl = (int*)F.lds; if (F.tid < 17) { int v = 0;
#pragma unroll
        for (int e = 0; e < 17; ++e) if (e == F.tid) v = pb[e];
        pbl[F.tid] = v; }
    __syncthreads();
    const float* lng = p.ln_g + (layer * 2 + 1) * DM; const float* lnb = p.ln_b + (layer * 2 + 1) * DM;
    const int gw = F.bid * NWAVES + F.wave, NGW = F.G * NWAVES, per = (nrows + NGW - 1) / NGW;
    int curmod = -1; f32x4 gf[4], sh1[4], sc1[4];
    typedef int i32x4r __attribute__((ext_vector_type(4)));
    const int t0 = gw * per, t1 = min(nrows, (gw + 1) * per);
    i32x4r ra = {0, 0, 0, 0}, rb = {0, 0, 0, 0}, rc = {0, 0, 0, 0}; f32x2 wa = {0.f, 0.f}, wb = {0.f, 0.f}, wc = {0.f, 0.f};
#define MC_REC(tok_, R, W) do { const int* tr_ = TOKR + (size_t)(tok_) * 8; R = *(const i32x4r*)tr_; W = *(const f32x2*)(tr_ + 4); } while (0)
#define MC_ROWS(tok_, R, V, A, B) do { ld_row_bf16(XB + (size_t)(tok_) * DM, F.lane, V); ld_row_fp8(YM + (size_t)(pbl[R.x] + R.y) * DM, F.lane, A); ld_row_fp8(YM + (size_t)(pbl[R.z] + R.w) * DM, F.lane, B); } while (0)
    f32x4 v[4], a[4], b[4], vn[4], an[4], bn[4];
    if (t0 < t1) { MC_REC(t0, ra, wa); if (t0 + 1 < t1) MC_REC(t0 + 1, rb, wb); MC_ROWS(t0, ra, v, a, b); }
    for (int tok = t0; tok < t1; ++tok) {
        if (tok + 1 < t1) MC_ROWS(tok + 1, rb, vn, an, bn);
        if (tok + 2 < t1) MC_REC(tok + 2, rc, wc);
        const int mr = tok < NLAT ? tok / SEQ : 8;
        if (mr != curmod) { curmod = mr; ld_row_f32(MOD + mr * 6144 + 5120, F.lane, gf); if (!layer) { ld_row_f32(MOD1 + mr * 6144, F.lane, sh1); ld_row_f32(MOD1 + mr * 6144 + 1024, F.lane, sc1); } }
        const float w0 = wa.x, w1 = wa.y;
        bf16* xp = XB + (size_t)tok * DM;
#pragma unroll
        for (int j = 0; j < 4; ++j) v[j] = ALPHA * v[j] + gf[j] * (w0 * a[j] + w1 * b[j]);
        ln_row(v, lng, lnb, F.lane);
        if (layer) st_row_f32(p.out + (size_t)tok * DM, F.lane, v); else st_row_bf16(xp, F.lane, v);
        if (!layer) {
#pragma unroll
            for (int j = 0; j < 4; ++j) v[j] = v[j] * (1.f + sc1[j]) + sh1[j];
            st_row_fp8(H + (size_t)tok * DM, F.lane, v);
        }
#pragma unroll
        for (int j = 0; j < 4; ++j) { v[j] = vn[j]; a[j] = an[j]; b[j] = bn[j]; }
        ra = rb; wa = wb; rb = rc; wb = wc;
    }
#undef MC_REC
#undef MC_ROWS
}

__device__ __forceinline__ void phase_gla_prep(const Frame& F, const Prm& p) {
    typedef short bf16x8v __attribute__((ext_vector_type(8))); typedef float f32x16v __attribute__((ext_vector_type(16)));
    const bf16* QR = (const bf16*)(p.ws + WS_QR); const bf16* KR = (const bf16*)(p.ws + WS_KR); const float* ZZ = (const float*)(p.ws + WS_ZZ);
    bf16* QT = (bf16*)(p.ws + WS_QT); bf16* KT = (bf16*)(p.ws + WS_KT); float* DEC = (float*)(p.ws + WS_DEC);
    const int gw = F.bid * NWAVES + F.wave, NGW = F.G * NWAVES, r = F.lane & 31, hh = F.lane >> 5;
    for (int task = gw; task < 2 * NCHUNK * 8; task += NGW) {
        const int dh = task & 7, chunk = (task >> 3) % NCHUNK, dir = __builtin_amdgcn_readfirstlane(task / (8 * NCHUNK));
        const int tok0 = chunk * 64;
        bf16x8v af[2], bfr[2];
#pragma unroll
        for (int tb = 0; tb < 2; ++tb) { const float* zp = ZZ + (size_t)(tok0 + 32 * tb + r) * 32 + dir * 16 + 8 * hh; const f32x4 z0 = *(const f32x4*)zp, z1 = *(const f32x4*)(zp + 4);
            u32x4 w; w.x = pk2(z0.x, z0.y); w.y = pk2(z0.z, z0.w); w.z = pk2(z1.x, z1.y); w.w = pk2(z1.z, z1.w); af[tb] = __builtin_bit_cast(bf16x8v, w); }
        float bgv[2];
#pragma unroll
        for (int cb = 0; cb < 2; ++cb) { const float* wp = p.gwg_up + (size_t)dir * 16 * 512 + (size_t)(8 * hh) * 512 + dh * 64 + 2 * r + cb; float wv[8];
#pragma unroll
            for (int i = 0; i < 8; ++i) wv[i] = wp[(size_t)i * 512];
            u32x4 w; w.x = pk2(wv[0], wv[1]); w.y = pk2(wv[2], wv[3]); w.z = pk2(wv[4], wv[5]); w.w = pk2(wv[6], wv[7]); bfr[cb] = __builtin_bit_cast(bf16x8v, w);
            bgv[cb] = p.gbg[dir * 512 + dh * 64 + 2 * r + cb]; }
        f32x16v Z[2][2];
#pragma unroll
        for (int tb = 0; tb < 2; ++tb)
#pragma unroll
            for (int cb = 0; cb < 2; ++cb) { const f32x16v zero = {}; Z[tb][cb] = __builtin_amdgcn_mfma_f32_32x32x16_bf16(af[tb], bfr[cb], zero, 0, 0, 0); }
#pragma unroll
        for (int tb = 0; tb < 2; ++tb)
#pragma unroll
            for (int cb = 0; cb < 2; ++cb)
#pragma unroll
                for (int i = 0; i < 16; ++i) { const float z = Z[tb][cb][i] + bgv[cb]; Z[tb][cb][i] = (fminf(z, 0.f) - __logf(1.f + __expf(-fabsf(z)))) * (1.f / 16.f); }
        float tot[2];
#pragma unroll
        for (int cb = 0; cb < 2; ++cb) {
            float T[2][4], PT[2][4];
            if (!dir) {
#pragma unroll
                for (int tb = 0; tb < 2; ++tb)
#pragma unroll
                    for (int gi = 0; gi < 4; ++gi) { float run = 0.f;
#pragma unroll
                        for (int w = 0; w < 4; ++w) { run += Z[tb][cb][4 * gi + w]; Z[tb][cb][4 * gi + w] = run; }
                        T[tb][gi] = run; }
            } else {
#pragma unroll
                for (int tb = 0; tb < 2; ++tb)
#pragma unroll
                    for (int gi = 0; gi < 4; ++gi) { float run = 0.f;
#pragma unroll
                        for (int w = 3; w >= 0; --w) { run += Z[tb][cb][4 * gi + w]; Z[tb][cb][4 * gi + w] = run; }
                        T[tb][gi] = run; }
            }
#pragma unroll
            for (int tb = 0; tb < 2; ++tb)
#pragma unroll
                for (int gi = 0; gi < 4; ++gi) PT[tb][gi] = __shfl_xor(T[tb][gi], 32);
            float running = 0.f;
            if (!dir) {
#pragma unroll
                for (int tb = 0; tb < 2; ++tb)
#pragma unroll
                    for (int gi = 0; gi < 4; ++gi) { const float first = hh ? PT[tb][gi] : T[tb][gi], second = hh ? T[tb][gi] : PT[tb][gi];
                        const float mine = hh ? running + first : running; running += first + second;
#pragma unroll
                        for (int w = 0; w < 4; ++w) Z[tb][cb][4 * gi + w] += mine; }
            } else {
#pragma unroll
                for (int tb = 1; tb >= 0; --tb)
#pragma unroll
                    for (int gi = 3; gi >= 0; --gi) { const float first = hh ? T[tb][gi] : PT[tb][gi], second = hh ? PT[tb][gi] : T[tb][gi];
                        const float mine = hh ? running : running + first; running += first + second;
#pragma unroll
                        for (int w = 0; w < 4; ++w) Z[tb][cb][4 * gi + w] += mine; }
            }
            tot[cb] = running;
        }
        if (hh == 0) {
#pragma unroll
            for (int cb = 0; cb < 2; ++cb) DEC[((size_t)dir * NCHUNK + chunk) * 512 + dh * 64 + 2 * r + cb] = __expf(tot[cb]);
        }
        const bf16* qi = QR + ((size_t)dh * NTOK + tok0) * 64 + 2 * r; const bf16* ki = KR + ((size_t)dh * NTOK + tok0) * 64 + 2 * r;
        bf16* qo = QT + (((size_t)dir * 8 + dh) * NTOK + tok0) * 64 + 2 * r; bf16* ko = KT + (((size_t)dir * 8 + dh) * NTOK + tok0) * 64 + 2 * r;
#pragma unroll
        for (int tb = 0; tb < 2; ++tb) {
            unsigned qv[16], kv[16];
#pragma unroll
            for (int i = 0; i < 16; ++i) { const int t = 32 * tb + (i & 3) + 8 * (i >> 2) + 4 * hh; qv[i] = *(const unsigned*)(qi + (size_t)t * 64); kv[i] = *(const unsigned*)(ki + (size_t)t * 64); }
#pragma unroll
            for (int i = 0; i < 16; ++i) { const int t = 32 * tb + (i & 3) + 8 * (i >> 2) + 4 * hh;
                const float e0 = __expf(Z[tb][0][i]), e1 = __expf(Z[tb][1][i]), i0 = __builtin_amdgcn_rcpf(e0), i1 = __builtin_amdgcn_rcpf(e1);
                *(unsigned*)(qo + (size_t)t * 64) = pk2(bf2f(qv[i] & 0xffffu) * e0, bf2f(qv[i] >> 16) * e1);
                *(unsigned*)(ko + (size_t)t * 64) = pk2(bf2f(kv[i] & 0xffffu) * i0, bf2f(kv[i] >> 16) * i1); }
        }
    }
}

__device__ __forceinline__ void phase_gla_post(const Frame& F, const Prm& p) {
    const bf16* OF = (const bf16*)p.out; const bf16* OB = (const bf16*)((const unsigned char*)p.out + OUT_OGB); const bf16* R = (const bf16*)(p.ws + WS_R); unsigned char* A2 = p.ws + WS_A2B;
    const f32x4 ng = *(const f32x4*)(p.gnorm + 4 * F.lane);
    const int gw = F.bid * NWAVES + F.wave, NGW = F.G * NWAVES;
    f32x4 a[4], b[4], r[4], an[4], bn[4], rn[4];
    if (gw < NLAT) { ld_row_bf16(OF + (size_t)gw * DM, F.lane, a); ld_row_bf16(OB + (size_t)gw * DM, F.lane, b); ld_row_bf16(R + (size_t)gw * DM, F.lane, r); }
    for (int tok = gw; tok < NLAT; tok += NGW) {
        if (tok + NGW < NLAT) { ld_row_bf16(OF + (size_t)(tok + NGW) * DM, F.lane, an); ld_row_bf16(OB + (size_t)(tok + NGW) * DM, F.lane, bn); ld_row_bf16(R + (size_t)(tok + NGW) * DM, F.lane, rn); }
#pragma unroll
        for (int j = 0; j < 4; ++j) {
            const f32x4 o = a[j] + b[j]; const float q = wave_sum((o.x * o.x + o.y * o.y) + (o.z * o.z + o.w * o.w));
            const float rs = 1.f / sqrtf(q * (1.f / 256.f) + LN_EPS);
            a[j] = (f32x4){o.x * rs * ng.x * silu_f(r[j].x), o.y * rs * ng.y * silu_f(r[j].y), o.z * rs * ng.z * silu_f(r[j].z), o.w * rs * ng.w * silu_f(r[j].w)};
        }
        st_row_fp8(A2 + (size_t)tok * DM, F.lane, a);
#pragma unroll
        for (int j = 0; j < 4; ++j) { a[j] = an[j]; b[j] = bn[j]; r[j] = rn[j]; }
    }
}
namespace pg8 {
typedef short bf16x8 __attribute__((ext_vector_type(8)));
constexpr int BM = 256, BK = 64, HALF = 128, HTB = HALF * BK * 2, STAGE_BYTES = 8 * HTB, NXCD = 8, WGM = 8;
__host__ __device__ __forceinline__ int lds_byte(int r, int c) { const int st = (r >> 4) * 2 + (c >> 5), rr = r & 15, cc = c & 31, ob = rr * 64 + cc * 2; return st * 1024 + (ob ^ (((ob >> 9) & 1) << 5)); }
__host__ __device__ __forceinline__ void stage_rc(int b, int& R, int& C) { const int st = b / 1024, sb = b % 1024, swz = sb ^ (((sb >> 9) & 1) << 5); R = (st >> 1) * 16 + swz / 64; C = (st & 1) * 32 + (swz % 64) / 2; }
typedef float f32x2_t __attribute__((ext_vector_type(2))); typedef __bf16 bf16x2_t __attribute__((ext_vector_type(2)));
__device__ __forceinline__ unsigned cvt_pk_bf16(float lo, float hi) { f32x2_t v = {lo, hi}; bf16x2_t b = __builtin_convertvector(v, bf16x2_t); return __builtin_bit_cast(unsigned, b); }

struct Unit { int pm, pn; int row0; int e; int cnt; const bf16* Bt; };

struct DenseOrder {
    int nM, nN, nwg, G, c, K; const bf16* Bt;
    __device__ void init(int M, int N, int K_, const bf16* Bt_, int G_, int c_) { nM = M / BM; nN = N / BM; nwg = nM * nN; G = G_; c = c_; K = K_; Bt = Bt_; }
    __device__ bool next(int i, Unit& u) const {
        const long L = (long)i * G + c; if (L >= nwg) return false;
        int wgid = (int)L; { const int q = nwg / NXCD, r = nwg % NXCD, xcd = wgid % NXCD, off = wgid / NXCD; wgid = (xcd < r ? xcd * (q + 1) : r * (q + 1) + (xcd - r) * q) + off; }
        const int nig = WGM * nN, gid = wgid / nig, fm = gid * WGM, gsz = (nM - fm) < WGM ? (nM - fm) : WGM;
        u.pm = fm + ((wgid % nig) % gsz); u.pn = (wgid % nig) / gsz; u.row0 = u.pm * BM; u.e = 0; u.cnt = 0; u.Bt = Bt; return true;
    }
    __device__ __forceinline__ unsigned arow(const Unit& u, int r) const { return (unsigned)(u.row0 + r) * (unsigned)(K * 2); }
};
template <bool GATHER> struct MoeOrder {
    int cnt[16]; int nN, G, c, K; const bf16* Bt0; size_t bstride; const int* LIST;
    __device__ void init(const unsigned* cntw, int N, int K_, const bf16* Bt0_, const int* LIST_, int G_, int c_) {
#pragma unroll
        for (int e = 0; e < 16; ++e) cnt[e] = (int)__hip_atomic_load(cntw + e, __ATOMIC_RELAXED, __HIP_MEMORY_SCOPE_AGENT);
        nN = N / BM; G = G_; c = c_; K = K_; Bt0 = Bt0_; bstride = (size_t)N * K_; LIST = LIST_; }
    __device__ bool next(int i, Unit& u) const {
        int L = i * G + c, base = 0; bool found = false; u.pm = 0; u.pn = 0; u.row0 = 0; u.e = 0; u.cnt = 0; u.Bt = Bt0;
#pragma unroll
        for (int e = 0; e < 16; ++e) { const int mt = (cnt[e] + 255) >> 8, nu = mt * nN;
            if (!found) { if (L < nu) { found = true; u.e = e; u.cnt = cnt[e]; u.pm = L / nN; u.pn = L % nN; u.row0 = base + u.pm * BM; u.Bt = Bt0 + (size_t)e * bstride; } else { L -= nu; base += mt * BM; } } }
        return found;
    }
    __device__ __forceinline__ unsigned arow(const Unit& u, int r) const {
        if (GATHER) { const int li = u.pm * BM + r; int tok = 0; if (li < u.cnt) tok = LIST[u.e * NTOK + li];
            return (unsigned)tok * (unsigned)(K * 2); }
        return (unsigned)(u.row0 + r) * (unsigned)(K * 2);
    }
};

typedef f32x4 Acc[2][2][4][2];
__device__ __forceinline__ void st4bf(bf16* p, f32x4 v) { u32x2 w; w.x = cvt_pk_bf16(v.x, v.y); w.y = cvt_pk_bf16(v.z, v.w); *(u32x2*)p = w; }
__device__ __forceinline__ void st8bf(bf16* p, f32x4 a, f32x4 b) { u32x4 w; w.x = cvt_pk_bf16(a.x, a.y); w.y = cvt_pk_bf16(a.z, a.w); w.z = cvt_pk_bf16(b.x, b.y); w.w = cvt_pk_bf16(b.z, b.w); *(u32x4*)p = w; }

struct EpiQKV {
    bf16 *Q; const LAS float* rope; float wsc; unsigned* km;
    __device__ __forceinline__ void operator()(const Acc& acc, const Unit& u, int wr, int wc, int fr, int fq) const {
        const int reg = u.pn >> 2; bf16* O = Q + (size_t)reg * ((WS_K - WS_Q) / 2);
        if (reg == 2) { const int cbase = (u.pn & 3) * BM + wc * 32 + 8 * fq;
#pragma unroll
            for (int ai = 0; ai < 2; ++ai)
#pragma unroll
                for (int m = 0; m < 4; ++m) { bf16* rowp = O + (size_t)(u.row0 + ai * HALF + wr * 64 + m * 16 + fr) * DM + cbase;
#pragma unroll
                    for (int bj = 0; bj < 2; ++bj) st8bf(rowp + bj * HALF, acc[ai][bj][m][0] * wsc, acc[ai][bj][m][1] * wsc); }
            return; }
        const int cbase = (u.pn & 3) * BM + wc * 32 + 4 * fq;
        const bool dorope = (u.row0 < NLAT); const float sc = (reg == 0 ? C2 : 1.f) * wsc; float kn[2] = {0.f, 0.f};
#pragma unroll
        for (int ai = 0; ai < 2; ++ai)
#pragma unroll
            for (int m = 0; m < 4; ++m) { const int row = u.row0 + ai * HALF + wr * 64 + m * 16 + fr; bf16* rowp = O + (size_t)row * DM + cbase;
                f32x4 cs = {1.f, 1.f, 1.f, 1.f}, sn = {0.f, 0.f, 0.f, 0.f};
                if (dorope) { const int s = row & (SEQ - 1), pos = (wc & 1) ? (s & 63) : (s >> 6); const f32x4 t0 = *(const LAS f32x4*)(rope + (pos * 16 + 4 * fq) * 2), t1 = *(const LAS f32x4*)(rope + (pos * 16 + 4 * fq) * 2 + 4);
                    cs = (f32x4){t0.x, t0.z, t1.x, t1.z}; sn = (f32x4){t0.y, t0.w, t1.y, t1.w}; }
#pragma unroll
                for (int bj = 0; bj < 2; ++bj) { const f32x4 a0 = acc[ai][bj][m][0], a1 = acc[ai][bj][m][1];
                    const f32x4 o0 = (a0 * cs - a1 * sn) * sc, o1 = (a1 * cs + a0 * sn) * sc;
                    st4bf(rowp + bj * HALF, o0); st4bf(rowp + bj * HALF + 16, o1);
                    if (reg == 1) { const float ps = (o0.x * o0.x + o0.y * o0.y) + (o0.z * o0.z + o0.w * o0.w) + (o1.x * o1.x + o1.y * o1.y) + (o1.z * o1.z + o1.w * o1.w);
                        kn[bj] = fmaxf(kn[bj], ps); } } }
        if (reg == 1) {
            const int b = u.row0 < NLAT ? u.row0 / SEQ : (u.row0 - NLAT) / CTXL;
#pragma unroll
            for (int bj = 0; bj < 2; ++bj) { float v = kn[bj];
#pragma unroll
                for (int s = 1; s < 64; s <<= 1) v = fmaxf(v, __shfl_xor(v, s));
                if (fr == 0 && fq == 0) __hip_atomic_fetch_max(km + b * 16 + 4 * (u.pn & 3) + 2 * bj + (wc >> 1), __float_as_uint(8.f * v), __ATOMIC_RELAXED, __HIP_MEMORY_SCOPE_AGENT); } }
    }
};
struct EpiPlain {
    bf16* O; float sc;
    __device__ __forceinline__ void operator()(const Acc& acc, const Unit& u, int wr, int wc, int fr, int fq) const {
        const int cbase = u.pn * BM + wc * 32 + 8 * fq;
#pragma unroll
        for (int ai = 0; ai < 2; ++ai)
#pragma unroll
            for (int m = 0; m < 4; ++m) { bf16* rowp = O + (size_t)(u.row0 + ai * HALF + wr * 64 + m * 16 + fr) * DM + cbase;
#pragma unroll
                for (int bj = 0; bj < 2; ++bj) st8bf(rowp + bj * HALF, acc[ai][bj][m][0] * sc, acc[ai][bj][m][1] * sc); }
    }
};
struct EpiPlain8 {
    unsigned char* O; float sc;
    __device__ __forceinline__ void operator()(const Acc& acc, const Unit& u, int wr, int wc, int fr, int fq) const {
        const int cbase = u.pn * BM + wc * 32 + 8 * fq;
#pragma unroll
        for (int ai = 0; ai < 2; ++ai)
#pragma unroll
            for (int m = 0; m < 4; ++m) { unsigned char* rowp = O + (size_t)(u.row0 + ai * HALF + wr * 64 + m * 16 + fr) * DM + cbase;
#pragma unroll
                for (int bj = 0; bj < 2; ++bj) { const f32x4 a = acc[ai][bj][m][0] * sc, b = acc[ai][bj][m][1] * sc; u32x2 w; w.x = pk4_fp8(a.x, a.y, a.z, a.w); w.y = pk4_fp8(b.x, b.y, b.z, b.w); *(u32x2*)(rowp + bj * HALF) = w; } }
    }
};
struct EpiInproj {
    bf16 *QR, *KR, *V, *R; float* ZZ; float wsc;
    __device__ __forceinline__ void operator()(const Acc& acc, const Unit& u, int wr, int wc, int fr, int fq) const {
        const int pn = u.pn;
        if (pn == 12) { if (wc == 0) {
#pragma unroll
            for (int ai = 0; ai < 2; ++ai)
#pragma unroll
                for (int m = 0; m < 4; ++m) { float* rowp = ZZ + (size_t)(u.row0 + ai * HALF + wr * 64 + m * 16 + fr) * 32 + 4 * fq;
                    *(f32x4*)rowp = acc[ai][0][m][0] * wsc; *(f32x4*)(rowp + 16) = acc[ai][0][m][1] * wsc; } }
            return; }
        float sc = wsc;
        if (pn < 4) {
            bf16* O = pn < 2 ? QR : KR; if (pn < 2) sc = 0.08838834764831845f * wsc;
            const int cb = (pn & 1) * BM + wc * 32 + 8 * fq;
#pragma unroll
            for (int ai = 0; ai < 2; ++ai)
#pragma unroll
                for (int m = 0; m < 4; ++m) { const size_t row = (size_t)(u.row0 + ai * HALF + wr * 64 + m * 16 + fr);
#pragma unroll
                    for (int bj = 0; bj < 2; ++bj) { const int col = cb + bj * HALF; st8bf(O + ((size_t)(col >> 6) * NTOK + row) * 64 + (col & 63), acc[ai][bj][m][0] * sc, acc[ai][bj][m][1] * sc); } }
            return; }
        bf16* O; int c0;
        if (pn < 8) { O = V; c0 = (pn - 4) * BM; } else { O = R; c0 = (pn - 8) * BM; }
        const int cbase = c0 + wc * 32 + 8 * fq;
#pragma unroll
        for (int ai = 0; ai < 2; ++ai)
#pragma unroll
            for (int m = 0; m < 4; ++m) { bf16* rowp = O + (size_t)(u.row0 + ai * HALF + wr * 64 + m * 16 + fr) * DM + cbase;
#pragma unroll
                for (int bj = 0; bj < 2; ++bj) st8bf(rowp + bj * HALF, acc[ai][bj][m][0] * sc, acc[ai][bj][m][1] * sc); }
    }
};
struct EpiGateUp {
    unsigned char* ACT;
    __device__ __forceinline__ void operator()(const Acc& acc, const Unit& u, int wr, int wc, int fr, int fq) const {
        const int obase = (u.pn * BM + wc * 32) / 2 + 4 * fq;
#pragma unroll
        for (int ai = 0; ai < 2; ++ai)
#pragma unroll
            for (int m = 0; m < 4; ++m) { unsigned char* rowp = ACT + (size_t)(u.row0 + ai * HALF + wr * 64 + m * 16 + fr) * DEXP + obase;
#pragma unroll
                for (int bj = 0; bj < 2; ++bj) { const f32x4 g = acc[ai][bj][m][0], up = acc[ai][bj][m][1]; f32x4 o;
#pragma unroll
                    for (int j = 0; j < 4; ++j) o[j] = g[j] * __builtin_amdgcn_rcpf(1.f + __expf(-g[j])) * up[j];
                    *(unsigned*)(rowp + bj * (HALF / 2)) = pk4_fp8(o[0], o[1], o[2], o[3]); } }
    }
};

typedef int i32x8 __attribute__((ext_vector_type(8)));
typedef int i32x4 __attribute__((ext_vector_type(4)));
__device__ __forceinline__ i32x8 cat8(bf16x8 lo, bf16x8 hi) { return __builtin_shufflevector(__builtin_bit_cast(i32x4, lo), __builtin_bit_cast(i32x4, hi), 0, 1, 2, 3, 4, 5, 6, 7); }
template <class Epi, class Sched, bool FP8 = false>
__device__ __forceinline__ void gemm_phase(unsigned char* ldsg, const bf16* A, int K, const Sched& S, const Epi& E, int tid_in) {
    LAS unsigned char* lds = (LAS unsigned char*)ldsg;
    const int tid = tid_in, wid = __builtin_amdgcn_readfirstlane(tid >> 6), lane = tid & 63, wr = wid >> 2, wc = wid & 3, fr = lane & 15, fq = lane >> 4;
    const int nt = K / BK;
    int Rr[2]; unsigned colb[2], voffB[2];
#pragma unroll
    for (int i = 0; i < 2; ++i) { int R, C; stage_rc(tid * 16 + i * 8192, R, C); Rr[i] = R; colb[i] = (unsigned)C * 2u; voffB[i] = (unsigned)(R * K + C) * 2u; }
    const size_t kstep = (size_t)(BK * 2);
    const size_t hstep = (size_t)HALF * K * 2;
    const size_t tstep = 2 * hstep;
    const unsigned ldsw = (unsigned)wid * 1024u;
    const int aoff = lds_byte(wr * 64 + fr, fq * 8), boff = lds_byte(wc * 32 + fr, fq * 8);
#define PG8_SA(b, h) (((b) * 2 + (h)) * HTB)
#define PG8_SB(b, h) ((4 + (b) * 2 + (h)) * HTB)
#define PG8_STAGE(bufoff, gbase, voff) do { _Pragma("unroll") for (int _i = 0; _i < 2; ++_i) \
        __builtin_amdgcn_global_load_lds((const unsigned*)((const char*)(gbase) + (voff)[_i]), (LAS unsigned*)(lds + (bufoff) + ldsw + _i * 8192), 16, 0, 0); } while (0)
#define PG8_LDA(dst, b, h) do { if constexpr (FP8) { _Pragma("unroll") for (int m = 0; m < 4; ++m) dst##8[m] = cat8(*(const LAS bf16x8*)(lds + PG8_SA(b, h) + aoff + m * 2048), *(const LAS bf16x8*)(lds + PG8_SA(b, h) + aoff + m * 2048 + 1024)); } \
        else { _Pragma("unroll") for (int m = 0; m < 4; ++m) _Pragma("unroll") for (int k = 0; k < 2; ++k) dst[m][k] = *(const LAS bf16x8*)(lds + PG8_SA(b, h) + aoff + m * 2048 + k * 1024); } } while (0)
#define PG8_LDB(dst, b, h) do { if constexpr (FP8) { _Pragma("unroll") for (int n = 0; n < 2; ++n) dst##8[n] = cat8(*(const LAS bf16x8*)(lds + PG8_SB(b, h) + boff + n * 2048), *(const LAS bf16x8*)(lds + PG8_SB(b, h) + boff + n * 2048 + 1024)); } \
        else { _Pragma("unroll") for (int n = 0; n < 2; ++n) _Pragma("unroll") for (int k = 0; k < 2; ++k) dst[n][k] = *(const LAS bf16x8*)(lds + PG8_SB(b, h) + boff + n * 2048 + k * 1024); } } while (0)
#define PG8_MMA(ai, bj, At, Bt) do { __builtin_amdgcn_s_setprio(1); \
        if constexpr (FP8) { _Pragma("unroll") for (int m = 0; m < 4; ++m) _Pragma("unroll") for (int n = 0; n < 2; ++n) \
            asm volatile("v_mfma_scale_f32_16x16x128_f8f6f4 %0, %1, %2, %0, %3, %3 op_sel:[0,1,0] op_sel_hi:[0,0,0]" : "+v"(acc[ai][bj][m][n]) : "v"(Bt##8[n]), "v"(At##8[m]), "v"(sc8)); } \
        else { _Pragma("unroll") for (int m = 0; m < 4; ++m) _Pragma("unroll") for (int n = 0; n < 2; ++n) _Pragma("unroll") for (int k = 0; k < 2; ++k) \
            acc[ai][bj][m][n] = __builtin_amdgcn_mfma_f32_16x16x32_bf16(Bt[n][k], At[m][k], acc[ai][bj][m][n], 0, 0, 0); } \
        __builtin_amdgcn_s_setprio(0); } while (0)
#define PG8_WAIT_V(n) asm volatile("s_waitcnt vmcnt(" #n ")" ::: "memory")
#define PG8_WAIT_L(n) asm volatile("s_waitcnt lgkmcnt(" #n ")" ::: "memory")
#define PG8_BAR __builtin_amdgcn_s_barrier()
#define PG8_SCHED __builtin_amdgcn_sched_barrier(0)
    Unit cur, nxt; int ui = 0;
    if (!S.next(0, cur)) return;
    Acc acc;
#pragma unroll
    for (int a = 0; a < 2; ++a)
#pragma unroll
        for (int b = 0; b < 2; ++b)
#pragma unroll
            for (int m = 0; m < 4; ++m)
#pragma unroll
                for (int n = 0; n < 2; ++n) acc[a][b][m][n] = (f32x4){0.f, 0.f, 0.f, 0.f};
    const int sc8 = 0x7f7f7f79;
    bf16x8 At[4][2], B0[2][2], B1[2][2]; i32x8 At8[4], B08[2], B18[2];
    unsigned aC0[2], aC1[2], aN0[2], aN1[2];
#pragma unroll
    for (int i = 0; i < 2; ++i) { aC0[i] = S.arow(cur, Rr[i]) + colb[i]; aC1[i] = S.arow(cur, HALF + Rr[i]) + colb[i]; }
    const char* Ab = (const char*)A;
    const char* cB = (const char*)cur.Bt + (size_t)cur.pn * tstep;
    PG8_STAGE(PG8_SB(0, 0), cB, voffB); PG8_STAGE(PG8_SB(0, 1), cB + hstep, voffB); PG8_STAGE(PG8_SA(0, 0), Ab, aC0); PG8_STAGE(PG8_SA(0, 1), Ab, aC1);
    if (wr == 1) PG8_BAR;
    PG8_WAIT_V(2); PG8_BAR;
    PG8_STAGE(PG8_SB(1, 0), cB + kstep, voffB); PG8_STAGE(PG8_SA(1, 0), Ab + kstep, aC0); PG8_STAGE(PG8_SB(1, 1), cB + hstep + kstep, voffB);
    PG8_WAIT_V(6); PG8_BAR;
    for (;;) {
        const bool has_next = S.next(ui + 1, nxt);
        if (has_next) {
#pragma unroll
            for (int i = 0; i < 2; ++i) { aN0[i] = S.arow(nxt, Rr[i]) + colb[i]; aN1[i] = S.arow(nxt, HALF + Rr[i]) + colb[i]; }
        } else {
#pragma unroll
            for (int i = 0; i < 2; ++i) { aN0[i] = aC0[i]; aN1[i] = aC1[i]; }
        }
        const char* nB = has_next ? (const char*)nxt.Bt + (size_t)nxt.pn * tstep : cB;
        for (int t = 0; t < nt; t += 2) {
            const bool last = (t == nt - 2);
            const char* a1 = Ab + (size_t)(t + 1) * kstep;
            const char* a2 = last ? Ab : Ab + (size_t)(t + 2) * kstep; const char* b2 = last ? nB : cB + (size_t)(t + 2) * kstep;
            const char* a3 = a2 + kstep; const char* b3 = b2 + kstep;
            unsigned x0[2], x1[2];
#pragma unroll
            for (int i = 0; i < 2; ++i) { x0[i] = last ? aN0[i] : aC0[i]; x1[i] = last ? aN1[i] : aC1[i]; }
            PG8_LDB(B0, 0, 0); PG8_LDB(B1, 0, 1); PG8_SCHED; PG8_LDA(At, 0, 0); PG8_STAGE(PG8_SA(1, 1), a1, aC1);
            PG8_WAIT_V(8); PG8_WAIT_L(0); PG8_BAR; PG8_MMA(0, 0, At, B0); PG8_MMA(0, 1, At, B1); PG8_BAR; PG8_SCHED;
            PG8_LDA(At, 0, 1); PG8_STAGE(PG8_SB(0, 0), b2, voffB); PG8_STAGE(PG8_SB(0, 1), b2 + hstep, voffB); PG8_STAGE(PG8_SA(0, 0), a2, x0);
            PG8_WAIT_V(8); PG8_WAIT_L(0); PG8_BAR; PG8_MMA(1, 0, At, B0); PG8_MMA(1, 1, At, B1); PG8_BAR; PG8_SCHED;
            PG8_LDB(B0, 1, 0); PG8_LDB(B1, 1, 1); PG8_SCHED; PG8_LDA(At, 1, 0); PG8_STAGE(PG8_SA(0, 1), a2, x1);
            PG8_WAIT_V(8); PG8_WAIT_L(0); PG8_BAR; PG8_MMA(0, 0, At, B0); PG8_MMA(0, 1, At, B1); PG8_BAR; PG8_SCHED;
            PG8_LDA(At, 1, 1); PG8_STAGE(PG8_SB(1, 0), b3, voffB); PG8_STAGE(PG8_SB(1, 1), b3 + hstep, voffB); PG8_STAGE(PG8_SA(1, 0), a3, x0);
            PG8_WAIT_V(8); PG8_WAIT_L(0); PG8_BAR; PG8_MMA(1, 0, At, B0); PG8_MMA(1, 1, At, B1); PG8_BAR; PG8_SCHED;
        }
        if (wr == 0) PG8_BAR;
        if constexpr (FP8) asm volatile("s_nop 15\n\ts_nop 7" ::: "memory");
        E(acc, cur, wr, wc, fr, fq);
        if (!has_next) break;
#pragma unroll
        for (int a = 0; a < 2; ++a)
#pragma unroll
            for (int b = 0; b < 2; ++b)
#pragma unroll
                for (int m = 0; m < 4; ++m)
#pragma unroll
                    for (int n = 0; n < 2; ++n) acc[a][b][m][n] = (f32x4){0.f, 0.f, 0.f, 0.f};
        cur = nxt; cB = nB; ++ui;
#pragma unroll
        for (int i = 0; i < 2; ++i) { aC0[i] = aN0[i]; aC1[i] = aN1[i]; }
        if (wr == 1) PG8_BAR;
    }
    PG8_WAIT_V(0);
    PG8_BAR;
#undef PG8_SA
#undef PG8_SB
#undef PG8_STAGE
#undef PG8_LDA
#undef PG8_LDB
#undef PG8_MMA
#undef PG8_WAIT_V
#undef PG8_WAIT_L
#undef PG8_BAR
#undef PG8_SCHED
}
}

__device__ __forceinline__ int vcu_of(const Frame& F) { return (F.G % 8 == 0) ? (F.bid % 8) * (F.G / 8) + F.bid / 8 : F.bid; }
__device__ __forceinline__ void phase_qkv_opt(const Frame& F, const Prm& p) {
    pg8::DenseOrder S; S.init(NTOK, 3072, 512, (const bf16*)(p.ws + WS_WQKV), F.G, F.bid);
    static_assert(WS_V - WS_K == WS_K - WS_Q, "Q|K|V equally spaced");
    LAS float* ropel = (LAS float*)((LAS unsigned char*)F.lds + LDSX_OFF);
    const float* ropeg = (const float*)(p.ws + WS_MISC) + 1024;
    for (int i = F.tid; i < 2048; i += NTHR) ropel[i] = ropeg[i];
    __syncthreads();
    pg8::EpiQKV E{(bf16*)(p.ws + WS_Q), ropel, 1.f, F.ctl + CW_KM};
    pg8::gemm_phase<pg8::EpiQKV, pg8::DenseOrder, true>(F.lds, (const bf16*)(p.ws + WS_H), 512, S, E, F.tid);
}
__device__ __forceinline__ void phase_wo_opt(const Frame& F, const Prm& p, int layer) {
    if (layer) {
        pg8::DenseOrder S; S.init(NLAT, 1024, 512, (const bf16*)(p.ws + WS_WGO), F.G, F.bid);
        pg8::EpiPlain E{(bf16*)(p.ws + WS_Y), 1.f};
        pg8::gemm_phase<pg8::EpiPlain, pg8::DenseOrder, true>(F.lds, (const bf16*)(p.ws + WS_A2B), 512, S, E, F.tid);
    } else {
        pg8::DenseOrder S; S.init(NTOK, 1024, 512, (const bf16*)(p.ws + WS_WO), F.G, F.bid);
        pg8::EpiPlain E{(bf16*)(p.ws + WS_Y), 1.f};
        pg8::gemm_phase<pg8::EpiPlain, pg8::DenseOrder, true>(F.lds, (const bf16*)(p.ws + WS_A2), 512, S, E, F.tid);
    }
}
__device__ __forceinline__ void phase_inproj_opt(const Frame& F, const Prm& p) {
    pg8::DenseOrder S; S.init(NTOK, NIN, 512, (const bf16*)(p.ws + WS_WIN), F.G, F.bid);
    pg8::EpiInproj E{(bf16*)(p.ws + WS_QR), (bf16*)(p.ws + WS_KR), (bf16*)(p.ws + WS_V1), (bf16*)(p.ws + WS_R), (float*)(p.ws + WS_ZZ), 1.f};
    pg8::gemm_phase<pg8::EpiInproj, pg8::DenseOrder, true>(F.lds, (const bf16*)(p.ws + WS_H), 512, S, E, F.tid);
}
__device__ __forceinline__ void phase_moe1_opt(const Frame& F, const Prm& p, int layer) {
    pg8::MoeOrder<true> S; S.init(F.ctl + CW_CNT + layer * 16, 1024, 512, (const bf16*)(p.ws + (layer ? WS_GU1 : WS_GU0)), (const int*)(p.ws + WS_LIST), F.G, vcu_of(F));
    pg8::EpiGateUp E{p.ws + WS_ACT};
    pg8::gemm_phase<pg8::EpiGateUp, pg8::MoeOrder<true>, true>(F.lds, (const bf16*)(p.ws + WS_H), 512, S, E, F.tid);
}
__device__ __forceinline__ void phase_moe2_opt(const Frame& F, const Prm& p, int layer) {
    pg8::MoeOrder<false> S; S.init(F.ctl + CW_CNT + layer * 16, 1024, 256, (const bf16*)(p.ws + (layer ? WS_DN1 : WS_DN0)), nullptr, F.G, vcu_of(F));
    pg8::EpiPlain8 E{p.ws + WS_YM, 1.f};
    pg8::gemm_phase<pg8::EpiPlain8, pg8::MoeOrder<false>, true>(F.lds, (const bf16*)(p.ws + WS_ACT), 256, S, E, F.tid);
}
namespace attn_body {
using bf16=unsigned short;
using bf16x8=__attribute__((ext_vector_type(8)))short;
using s16x4=__attribute__((ext_vector_type(4)))short;
using f32x16=__attribute__((ext_vector_type(16)))float;
using u32x4=__attribute__((ext_vector_type(4)))unsigned;
constexpr int D=64,DM=1024;
constexpr int NW=8,QBLK=32,QB=QBLK*NW,KVBLK=64;
constexpr int ATTN_PITCH=DM, ATTN_UNIT_ROWS=QB;
__device__ __forceinline__ int crow(int r,int hi){return (r&3)+8*(r>>2)+4*hi;}
#define SBAR() __builtin_amdgcn_sched_barrier(0)

constexpr int NSLOT=3, SLOTB=8192;
constexpr int LDS_K=0, LDS_V=NSLOT*SLOTB, LDS_WS=2*NSLOT*SLOTB, LDS_OST=LDS_WS+NW*64*4, LDS_BYTES=LDS_OST+NW*4096;
constexpr float C2=0.125f*1.4426950408889634f;
__device__ __forceinline__ void glds16(const void*gsrc,unsigned lds_dst){unsigned keep;
  asm volatile("s_mov_b32 %0, m0\n\ts_mov_b32 m0, %2\n\ts_nop 0\n\tglobal_load_lds_dwordx4 %1, off\n\ts_mov_b32 m0, %0":"=&s"(keep):"v"(gsrc),"s"(lds_dst):"memory");}
__device__ __forceinline__ void glds16s(const void*sbase,unsigned voff,unsigned lds_dst){unsigned keep;
  asm volatile("s_mov_b32 %0, m0\n\ts_mov_b32 m0, %3\n\ts_nop 0\n\tglobal_load_lds_dwordx4 %1, %2\n\ts_mov_b32 m0, %0":"=&s"(keep):"v"(voff),"s"(sbase),"s"(lds_dst):"memory");}
__device__ __forceinline__ void glds16s128(const void*sbase,unsigned voff,unsigned lds_dst){unsigned keep;
  asm volatile("s_mov_b32 %0, m0\n\ts_mov_b32 m0, %3\n\ts_nop 0\n\tglobal_load_lds_dwordx4 %1, %2 offset:128\n\ts_mov_b32 m0, %0":"=&s"(keep):"v"(voff),"s"(sbase),"s"(lds_dst):"memory");}
__device__ __forceinline__ float max3f(float a,float b,float c){float r;asm("v_max3_f32 %0, %1, %2, %3":"=v"(r):"v"(a),"v"(b),"v"(c));return r;}
__device__ __forceinline__ float max2f(float a,float b){float r;asm("v_max_f32_e32 %0, %1, %2":"=v"(r):"v"(a),"v"(b));return r;}
__device__ __forceinline__ float fadd_s(float a,float b){float r;asm("v_add_f32_e32 %0, %1, %2":"=v"(r):"v"(a),"v"(b));return r;}
__device__ __forceinline__ float fsub_s(float a,float b){float r;asm("v_sub_f32_e32 %0, %1, %2":"=v"(r):"v"(a),"v"(b));return r;}
typedef float f32x2_t __attribute__((ext_vector_type(2))); typedef __bf16 bf16x2_t __attribute__((ext_vector_type(2)));
__device__ __forceinline__ unsigned cvtpk_s(float lo,float hi){f32x2_t v={lo,hi};bf16x2_t b=__builtin_convertvector(v,bf16x2_t);return __builtin_bit_cast(unsigned,b);}
#define WAIT_BAR(N) asm volatile("s_waitcnt vmcnt(" #N ") lgkmcnt(0)\n\ts_barrier":::"memory")

__device__ __forceinline__ void qkt(f32x16&p0,f32x16&p1,const char*Kslot,const bf16x8*qr,const f32x16&negm,int r32,int hi){
  const char*kb=Kslot+hi*1024+r32*16;
  #pragma unroll
  for(int d0=0;d0<4;++d0){
    const bf16x8 b0=*reinterpret_cast<const bf16x8*>(kb+d0*2048);
    const bf16x8 b1=*reinterpret_cast<const bf16x8*>(kb+d0*2048+512);
    if(d0==0){p0=__builtin_amdgcn_mfma_f32_32x32x16_bf16(b0,qr[0],negm,0,0,0);p1=__builtin_amdgcn_mfma_f32_32x32x16_bf16(b1,qr[0],negm,0,0,0);}
    else{p0=__builtin_amdgcn_mfma_f32_32x32x16_bf16(b0,qr[d0],p0,0,0,0);p1=__builtin_amdgcn_mfma_f32_32x32x16_bf16(b1,qr[d0],p1,0,0,0);}}
}
typedef __attribute__((address_space(3))) const char* lds_cptr;
typedef short v4i16_t __attribute__((ext_vector_type(4)));
__device__ __forceinline__ void kload8(bf16x8*kf,lds_cptr kp){
  kf[0]=*(const __attribute__((address_space(3))) bf16x8*)(kp);      kf[1]=*(const __attribute__((address_space(3))) bf16x8*)(kp+512);
  kf[2]=*(const __attribute__((address_space(3))) bf16x8*)(kp+2048); kf[3]=*(const __attribute__((address_space(3))) bf16x8*)(kp+2560);
  kf[4]=*(const __attribute__((address_space(3))) bf16x8*)(kp+4096); kf[5]=*(const __attribute__((address_space(3))) bf16x8*)(kp+4608);
  kf[6]=*(const __attribute__((address_space(3))) bf16x8*)(kp+6144); kf[7]=*(const __attribute__((address_space(3))) bf16x8*)(kp+6656);
}
__device__ __forceinline__ void kload2(bf16x8*kf,lds_cptr kp,int j){ kf[2*j]=*(const __attribute__((address_space(3))) bf16x8*)(kp+j*2048); kf[2*j+1]=*(const __attribute__((address_space(3))) bf16x8*)(kp+j*2048+512); }
__device__ __forceinline__ s16x4 vtr(lds_cptr p){ return __builtin_bit_cast(s16x4,__builtin_amdgcn_ds_read_tr16_b64_v4i16((__attribute__((address_space(3))) v4i16_t*)p)); }
__device__ __forceinline__ float rowmax(const f32x16&p0,const f32x16&p1){
  float a=max3f(p0[0],p0[1],p1[0]),b=max3f(p0[2],p0[3],p1[1]);a=max3f(a,p1[2],p1[3]);
  #pragma unroll
  for(int r=4;r<16;r+=4){a=max3f(a,p0[r],p0[r+1]);b=max3f(b,p0[r+2],p0[r+3]);a=max3f(a,p1[r],p1[r+1]);b=max3f(b,p1[r+2],p1[r+3]);}
  const float m=max2f(a,b);
  auto rr=__builtin_amdgcn_permlane32_swap(__float_as_uint(m),__float_as_uint(m),false,false);
  return max2f(__uint_as_float(rr[0]),__uint_as_float(rr[1]));
}
#undef SBAR
#undef WAIT_BAR
#undef KVROW
}
namespace attn_body {
constexpr int V2SLOT = 16384;
constexpr int L2_K = 0, L2_V = NSLOT * SLOTB, L2_WS = L2_V + NSLOT * V2SLOT, L2_ST = L2_WS + NW * 64 * 4, L2_BYTES = L2_ST + NW * 8192;
#define SBAR() __builtin_amdgcn_sched_barrier(0)
#define WAIT_BAR(N) asm volatile("s_waitcnt vmcnt(" #N ") lgkmcnt(0)\n\ts_barrier":::"memory")
template<int THRL> __device__ __forceinline__ void attn_unit2(long qrow0,int qcol,int vcol,long kctx,long klat,int NT,const bf16*Q,const bf16*__restrict__ K,const bf16*__restrict__ V,int m,const float*lamp,const float*subln,unsigned char*A2,int acol,float km,char*shm,int wid_s){
  int lane_u; asm volatile("v_mbcnt_lo_u32_b32 %0, -1, 0\n\tv_mbcnt_hi_u32_b32 %0, -1, %0":"=v"(lane_u));
  const int lane=lane_u,r32=lane&31,hi=lane>>5; const int wid=wid_s;
  const bf16*Qw=Q+(qrow0+wid*QBLK)*DM+qcol;
  const bf16*Kh=K+qcol,*Vh=V+vcol;
  const unsigned lds0=(unsigned)(uintptr_t)shm;
  float*wsf=(float*)(shm+L2_WS)+wid*64;
  const unsigned wsf_lds=(unsigned)(lds0+L2_WS+wid*256);
  const unsigned koff=(unsigned)(lane*DM+wid*8)*2u;
  const unsigned voff=(unsigned)((16*(wid&3)+(lane>>2))*DM+(wid>>2)*32+(lane&3)*8)*2u;
  const unsigned kdst=lds0+L2_K+wid*1024, vdst=lds0+L2_V+wid*1024;
  #define KVROW(t) ((t)<4?kctx+(long)(t)*KVBLK:klat+(long)((t)-4)*KVBLK)
  #define DMA_K(t,slot) glds16s(Kh+KVROW(t)*DM,koff,(unsigned)(kdst+(slot)))
  #define DMA_V(t,slot) do{ const bf16*vb_=Vh+KVROW(t)*DM; glds16s(vb_,voff,(unsigned)(vdst+2*(slot))); glds16s(vb_+64,voff,(unsigned)(vdst+2*(slot)+8192)); }while(0)
  const char*Kbase=shm+L2_K; bf16x8 kf[8];
  const lds_cptr shm3=(lds_cptr)shm; const lds_cptr kp0=shm3+L2_K+hi*1024+r32*16; const lds_cptr vp0=shm3+L2_V+((lane>>4)&1)*32+(lane&3)*8+(4*hi+((lane&15)>>2))*64;
  DMA_K(0,0);DMA_V(0,0);DMA_K(1,SLOTB);
  bf16x8 qr[4];
  #pragma unroll
  for(int d0=0;d0<4;++d0)qr[d0]=*reinterpret_cast<const bf16x8*>(&Qw[(long)r32*DM+d0*16+hi*8]);
  bool FAST; { float qn=0.f;
    #pragma unroll
    for(int d0=0;d0<4;++d0){ const u32x4 u=__builtin_bit_cast(u32x4,qr[d0]); const unsigned a4[4]={u.x,u.y,u.z,u.w};
      #pragma unroll
      for(int i=0;i<4;++i){ const float lo=__uint_as_float(a4[i]<<16),h2=__uint_as_float(a4[i]&0xffff0000u); qn+=lo*lo+h2*h2; } }
    { auto rq=__builtin_amdgcn_permlane32_swap(__float_as_uint(qn),__float_as_uint(qn),false,false); qn=__uint_as_float(rq[0])+__uint_as_float(rq[1]); } FAST=__all(qn*km<=96.f*96.f)!=0; }
  float mhat=0.f,l_reg=0.f;f32x16 o[4];o[0]=f32x16{};o[1]=f32x16{};o[2]=f32x16{};o[3]=f32x16{};const f32x16 zero16=f32x16{};
  bool resc=false;
  #define START(P0,P1) do{ resc=false; if(FAST){ mhat=0.f; } else { const float rm=rowmax(P0,P1); mhat=rm; \
    _Pragma("unroll") for(int r=0;r<16;++r){P0[r]=fsub_s(P0[r],rm);P1[r]=fsub_s(P1[r],rm);} } \
    _Pragma("unroll") for(int r=0;r<16;++r)P0[r]=__builtin_amdgcn_exp2f(P0[r]); }while(0)
  #define RESC() do{ if(resc){ asm volatile("s_waitcnt lgkmcnt(0)":::"memory"); \
      int l3_=lane; asm volatile("":"+v"(l3_)); const int hi3_=l3_>>5; \
      _Pragma("unroll") for(int d_=0;d_<4;++d_) _Pragma("unroll") for(int r=0;r<16;++r)o[d_][r]*=wsf[crow(r,hi3_)]; } }while(0)
  int sl_prev=0,sl_cur=0,sl_next=SLOTB;
  #define ROT() do{sl_prev=sl_cur;sl_cur=sl_next;sl_next=(sl_next==(NSLOT-1)*SLOTB)?0:sl_next+SLOTB;}while(0)
  DMA_K(2,2*SLOTB);
  WAIT_BAR(4);
  #define PKW(P,B) cvtpk_s(P[B],P[B+1])
  u32x4 pwA0,pwA1,pwA2,pwA3,pwB0,pwB1,pwB2,pwB3;
  { f32x16 p0,p1;
    qkt(p0,p1,Kbase,qr,zero16,r32,hi);asm volatile("s_nop 15\n\ts_nop 7":"+v"(p0),"+v"(p1));
    START(p0,p1);
    _Pragma("unroll") for(int r=0;r<16;++r)p1[r]=__builtin_amdgcn_exp2f(p1[r]);
    float sacc=p0[0]+p0[1]; _Pragma("unroll") for(int r=2;r<16;++r)sacc+=p0[r]; _Pragma("unroll") for(int r=0;r<16;++r)sacc+=p1[r]; l_reg+=sacc;
    pwA0=(u32x4){PKW(p0,0),PKW(p0,2),PKW(p0,4),PKW(p0,6)};pwA1=(u32x4){PKW(p0,8),PKW(p0,10),PKW(p0,12),PKW(p0,14)};pwA2=(u32x4){PKW(p1,0),PKW(p1,2),PKW(p1,4),PKW(p1,6)};pwA3=(u32x4){PKW(p1,8),PKW(p1,10),PKW(p1,12),PKW(p1,14)}; }
  WAIT_BAR(0);
  DMA_K(3,0);DMA_V(1,SLOTB);
  ROT();
  kload8(kf,kp0+sl_cur);
  WAIT_BAR(3);
  s16x4 vAl[4],vAh[4],vBl[4],vBh[4];
  #define PAFX(x) __builtin_bit_cast(bf16x8,x)
  #define VF(A,d) (bf16x8){A##l[d][0],A##l[d][1],A##l[d][2],A##l[d][3],A##h[d][0],A##h[d][1],A##h[d][2],A##h[d][3]}
  #define PIN(x) asm volatile("":"+v"(x))
  #define MX3(a,b,c) __builtin_fmaxf(__builtin_fmaxf((a),(b)),(c))
  #define EX(v) __builtin_amdgcn_exp2f(v)
  #define VRDL(A,d,ks) A##l[d]=vtr(vp_+((d)*4096+(ks)*1024))
  #define VRDH(A,d,ks) A##h[d]=vtr(vp_+((d)*4096+(ks)*1024+512))
  #define GAPF(MF,X,B,PWN,W,RD) do{ MF; X[B]=EX(X[B]); X[B+1]=EX(X[B+1]); sacc+=X[B]; sacc+=X[B+1]; PIN(sacc); PWN[W]=cvtpk_s(X[B],X[B+1]); PIN(PWN); RD; SBAR(); }while(0)
  #define GAPP(MF,X,B,PWN,W,RD) do{ MF; X[B]=EX(X[B]-mhat); X[B+1]=EX(X[B+1]-mhat); sacc+=X[B]; sacc+=X[B+1]; PIN(sacc); PWN[W]=cvtpk_s(X[B],X[B+1]); PIN(PWN); RD; SBAR(); }while(0)
  #define MFQ(C,kf_,q_,acc_) C=__builtin_amdgcn_mfma_f32_32x32x16_bf16(kf_,q_,acc_,0,0,0)
  #define MFO(d,PW,A) o[d]=__builtin_amdgcn_mfma_f32_32x32x16_bf16(PAFX(PW),VF(A,d),o[d],0,0,0)
  #define KRD(G,j) do{ if(G){ kload2(kf,kp0+sl_next,j); } }while(0)
  #define PHASEB(G,PI0,PI1,PI2,PI3,PO0,PO1,PO2,PO3,GL) do{ \
    G(MFO(0,PI0,vA),C0,0, PO0,0, VRDL(vB,0,1);VRDH(vB,0,1)); \
    G(MFO(1,PI0,vA),C0,2, PO0,1, VRDL(vB,1,1);VRDH(vB,1,1)); \
    G(MFO(2,PI0,vA),C0,4, PO0,2, VRDL(vB,2,1);VRDH(vB,2,1)); \
    G(MFO(3,PI0,vA),C0,6, PO0,3, VRDL(vB,3,1);VRDH(vB,3,1)); \
    G(MFO(0,PI1,vB),C0,8, PO1,0, VRDL(vA,0,2);VRDH(vA,0,2)); \
    G(MFO(1,PI1,vB),C0,10,PO1,1, VRDL(vA,1,2);VRDH(vA,1,2)); \
    G(MFO(2,PI1,vB),C0,12,PO1,2, VRDL(vA,2,2);VRDH(vA,2,2)); \
    G(MFO(3,PI1,vB),C0,14,PO1,3, VRDL(vA,3,2);VRDH(vA,3,2)); \
    G(MFO(0,PI2,vA),C1,0, PO2,0, VRDL(vB,0,3);VRDH(vB,0,3)); \
    G(MFO(1,PI2,vA),C1,2, PO2,1, VRDL(vB,1,3);VRDH(vB,1,3)); \
    G(MFO(2,PI2,vA),C1,4, PO2,2, VRDL(vB,2,3);VRDH(vB,2,3)); \
    G(MFO(3,PI2,vA),C1,6, PO2,3, VRDL(vB,3,3);VRDH(vB,3,3)); \
    G(MFO(0,PI3,vB),C1,8, PO3,0, KRD(GL,0)); \
    G(MFO(1,PI3,vB),C1,10,PO3,1, KRD(GL,1)); \
    G(MFO(2,PI3,vB),C1,12,PO3,2, KRD(GL,2)); \
    G(MFO(3,PI3,vB),C1,14,PO3,3, KRD(GL,3)); \
    }while(0)
  #define PHASEB_NF(G,PI0,PI1,PI2,PI3,PO0,PO1,PO2,PO3,GL) do{ \
    G(MFO(0,PI0,vA),C0,0, PO0,0, (void)0); \
    G(MFO(1,PI0,vA),C0,2, PO0,1, (void)0); \
    G(MFO(2,PI0,vA),C0,4, PO0,2, (void)0); \
    G(MFO(3,PI0,vA),C0,6, PO0,3, VRDL(vA,0,1);VRDH(vA,0,1);VRDL(vA,1,1);VRDH(vA,1,1);VRDL(vA,2,1);VRDH(vA,2,1);VRDL(vA,3,1);VRDH(vA,3,1)); \
    G(MFO(0,PI1,vA),C0,8, PO1,0, (void)0); \
    G(MFO(1,PI1,vA),C0,10,PO1,1, (void)0); \
    G(MFO(2,PI1,vA),C0,12,PO1,2, (void)0); \
    G(MFO(3,PI1,vA),C0,14,PO1,3, VRDL(vA,0,2);VRDH(vA,0,2);VRDL(vA,1,2);VRDH(vA,1,2);VRDL(vA,2,2);VRDH(vA,2,2);VRDL(vA,3,2);VRDH(vA,3,2)); \
    G(MFO(0,PI2,vA),C1,0, PO2,0, (void)0); \
    G(MFO(1,PI2,vA),C1,2, PO2,1, (void)0); \
    G(MFO(2,PI2,vA),C1,4, PO2,2, (void)0); \
    G(MFO(3,PI2,vA),C1,6, PO2,3, VRDL(vA,0,3);VRDH(vA,0,3);VRDL(vA,1,3);VRDH(vA,1,3);VRDL(vA,2,3);VRDH(vA,2,3);VRDL(vA,3,3);VRDH(vA,3,3)); \
    G(MFO(0,PI3,vA),C1,8, PO3,0, KRD(GL,0)); \
    G(MFO(1,PI3,vA),C1,10,PO3,1, KRD(GL,1)); \
    G(MFO(2,PI3,vA),C1,12,PO3,2, KRD(GL,2)); \
    G(MFO(3,PI3,vA),C1,14,PO3,3, KRD(GL,3)); \
    }while(0)
  #define STEP2(t,PI0,PI1,PI2,PI3,PO0,PO1,PO2,PO3,GK,GV,GL,GAPM,MB,PHB) do{ SBAR(); \
    const lds_cptr vp_=vp0+2*sl_prev; f32x16 C0,C1; float sacc=0.f; \
    VRDL(vA,0,0); SBAR(); MFQ(C0,kf[0],qr[0],zero16); SBAR(); \
    VRDH(vA,0,0); SBAR(); MFQ(C1,kf[1],qr[0],zero16); SBAR(); \
    VRDL(vA,1,0); SBAR(); MFQ(C0,kf[2],qr[1],C0); SBAR(); \
    VRDH(vA,1,0); SBAR(); MFQ(C1,kf[3],qr[1],C1); SBAR(); \
    VRDL(vA,2,0); SBAR(); MFQ(C0,kf[4],qr[2],C0); SBAR(); \
    VRDH(vA,2,0); SBAR(); MFQ(C1,kf[5],qr[2],C1); SBAR(); \
    VRDL(vA,3,0); SBAR(); MFQ(C0,kf[6],qr[3],C0); SBAR(); \
    VRDH(vA,3,0); SBAR(); MFQ(C1,kf[7],qr[3],C1); SBAR(); \
    if(GK){DMA_K((t)+3,sl_cur);} if(GV){DMA_V((t)+1,sl_next);} \
    if(MB){ float a=MX3(C0[0],C0[1],C1[0]),b=MX3(C0[2],C0[3],C1[1]); a=MX3(a,C1[2],C1[3]); \
      _Pragma("unroll") for(int r=4;r<16;r+=4){a=MX3(a,C0[r],C0[r+1]);b=MX3(b,C0[r+2],C0[r+3]);a=MX3(a,C1[r],C1[r+1]);b=MX3(b,C1[r+2],C1[r+3]);} \
      float rm=__builtin_fmaxf(a,b); { auto rr=__builtin_amdgcn_permlane32_swap(__float_as_uint(rm),__float_as_uint(rm),false,false); rm=__builtin_fmaxf(__uint_as_float(rr[0]),__uint_as_float(rr[1])); } \
      resc=false; \
      if(__builtin_expect(__any(rm-mhat>(float)THRL),0)){ const float dl=__builtin_fmaxf(rm-mhat,0.f); mhat+=dl; \
        const float f=__builtin_amdgcn_exp2f(-dl); l_reg*=f; { unsigned keep_; asm volatile("s_mov_b32 %0, m0\n\ts_mov_b32 m0, %2\n\ts_nop 0\n\tds_write_addtid_b32 %1\n\ts_mov_b32 m0, %0":"=&s"(keep_):"v"(f),"s"(wsf_lds):"memory"); } resc=true; } } \
    __builtin_amdgcn_s_setprio(1); SBAR(); \
    PHB(GAPM,PI0,PI1,PI2,PI3,PO0,PO1,PO2,PO3,GL); \
    __builtin_amdgcn_s_setprio(0); l_reg+=sacc; \
    }while(0)
  #define ENDW(tt) do{ if((tt)+3<NT){WAIT_BAR(3);} else if((tt)+2<NT){WAIT_BAR(2);} else {WAIT_BAR(0);} }while(0)
  #define LOOPS(GAPM,MB,RS,PHB) do{ int t=1; \
    for(;t+5<NT;t+=2){ \
      STEP2(t,  pwA0,pwA1,pwA2,pwA3,pwB0,pwB1,pwB2,pwB3,true,true,true,GAPM,MB,PHB); WAIT_BAR(3); RS; ROT(); \
      STEP2(t+1,pwB0,pwB1,pwB2,pwB3,pwA0,pwA1,pwA2,pwA3,true,true,true,GAPM,MB,PHB); WAIT_BAR(3); RS; ROT(); \
    } \
    for(;t+1<NT;t+=2){ \
      STEP2(t,  pwA0,pwA1,pwA2,pwA3,pwB0,pwB1,pwB2,pwB3,(t+3<NT),(t+1<NT),(t+1<NT),GAPM,MB,PHB); ENDW(t);   RS; ROT(); \
      STEP2(t+1,pwB0,pwB1,pwB2,pwB3,pwA0,pwA1,pwA2,pwA3,(t+4<NT),(t+2<NT),(t+2<NT),GAPM,MB,PHB); ENDW(t+1); RS; ROT(); \
    } \
    STEP2(NT-1,pwA0,pwA1,pwA2,pwA3,pwB0,pwB1,pwB2,pwB3,false,false,false,GAPM,MB,PHB); RS; }while(0)
  auto finish=[&]() __attribute__((always_inline)) {
  { const lds_cptr vp_=vp0+2*sl_cur;
    #pragma unroll
    for(int ks=0;ks<4;++ks){
      #pragma unroll
      for(int d=0;d<4;++d){ const s16x4 lo=vtr(vp_+(d*4096+ks*1024)),hh=vtr(vp_+(d*4096+ks*1024+512)); const bf16x8 vf=(bf16x8){lo[0],lo[1],lo[2],lo[3],hh[0],hh[1],hh[2],hh[3]};
        const u32x4 pw=(ks==0)?pwB0:(ks==1)?pwB1:(ks==2)?pwB2:pwB3;
        o[d]=__builtin_amdgcn_mfma_f32_32x32x16_bf16(PAFX(pw),vf,o[d],0,0,0); } } }
  { int lane_l=lane; asm volatile("":"+v"(lane_l));
  { const int lane=lane_l,r32=lane&31,hi=lane>>5;
  {auto rr=__builtin_amdgcn_permlane32_swap(__float_as_uint(l_reg),__float_as_uint(l_reg),false,false);l_reg=__uint_as_float(rr[0])+__uint_as_float(rr[1]);}
  if(hi==0)wsf[32+r32]=l_reg;asm volatile("s_waitcnt lgkmcnt(0)":::"memory");
  float rli[16];
  #pragma unroll
  for(int r=0;r<16;++r)rli[r]=__builtin_amdgcn_rcpf(wsf[32+crow(r,hi)]);
  unsigned short*stash=(unsigned short*)(shm+L2_ST)+wid*4096;
  if(m==0){
    #pragma unroll
    for(int d0=0;d0<4;++d0){
      #pragma unroll
      for(int r=0;r<16;++r)stash[(d0*16+r)*64+lane]=(unsigned short)f2bf(o[d0][r]*rli[r]);}
    asm volatile("s_waitcnt lgkmcnt(0)":::"memory");
  } else {
    const float lam=__uint_as_float(__hip_atomic_load((const unsigned*)lamp,__ATOMIC_RELAXED,__HIP_MEMORY_SCOPE_AGENT));
    float ss[16];
    #pragma unroll
    for(int r=0;r<16;++r)ss[r]=0.f;
    #pragma unroll
    for(int d0=0;d0<4;++d0){
      #pragma unroll
      for(int r=0;r<16;++r){ const float o1=bf2f(stash[(d0*16+r)*64+lane]); const float df=o1-lam*(o[d0][r]*rli[r]); o[d0][r]=df; ss[r]+=df*df; } }
    #pragma unroll
    for(int r=0;r<16;++r){ float q=ss[r];
      q+=__int_as_float(__builtin_amdgcn_ds_swizzle(__float_as_int(q),0x41f));
      q+=__int_as_float(__builtin_amdgcn_ds_swizzle(__float_as_int(q),0x81f));
      q+=__int_as_float(__builtin_amdgcn_ds_swizzle(__float_as_int(q),0x101f));
      q+=__int_as_float(__builtin_amdgcn_ds_swizzle(__float_as_int(q),0x201f));
      q+=__int_as_float(__builtin_amdgcn_ds_swizzle(__float_as_int(q),0x401f));
      ss[r]=(1.f-LAMBDA_INIT0)/sqrtf(q*(1.f/128.f)+LN_EPS); }
    asm volatile("s_waitcnt lgkmcnt(0)":::"memory");
    unsigned char*stg=(unsigned char*)stash;
    #pragma unroll
    for(int d0=0;d0<4;++d0){ const float sgv=subln[d0*32+r32];
      #pragma unroll
      for(int r=0;r<16;++r){ const int w8=__builtin_amdgcn_cvt_pk_fp8_f32(o[d0][r]*ss[r]*sgv,0.f,0,false); stg[crow(r,hi)*128+d0*32+r32]=(unsigned char)(w8&0xff); } }
    asm volatile("s_waitcnt lgkmcnt(0)":::"memory");
    unsigned char*Aw=A2+(qrow0+wid*QBLK)*DM+acol;
    #pragma unroll
    for(int i=0;i<4;++i){const int row=i*8+(lane>>3),ch=lane&7; const u32x4 v=*(const u32x4*)(stg+row*128+ch*16); *(u32x4*)(Aw+(long)row*DM+ch*16)=v;}
    asm volatile("s_waitcnt lgkmcnt(0)":::"memory");
  }
  } }
  };
  if(FAST){ LOOPS(GAPF,false,(void)0,PHASEB); finish(); } else { LOOPS(GAPP,true,RESC(),PHASEB_NF); finish(); }
  #undef LOOPS
  asm volatile("s_waitcnt lgkmcnt(0)\n\ts_barrier":::"memory");
  #undef KVROW
  #undef DMA_K
  #undef DMA_V
  #undef START
  #undef RESC
  #undef ROT
  #undef PKW
  #undef PAFX
  #undef VF
  #undef PIN
  #undef MX3
  #undef EX
  #undef VRDL
  #undef VRDH
  #undef GAPP
  #undef GAPF
  #undef PHASEB
  #undef PHASEB_NF
  #undef MFQ
  #undef MFO
  #undef KRD
  #undef STEP2
  #undef ENDW
}
#undef SBAR
#undef WAIT_BAR
}
__device__ __forceinline__ void phase_attn2(const Frame& F, const Prm& p) {
    const bf16* Q = (const bf16*)(p.ws + WS_Q); const bf16* K = (const bf16*)(p.ws + WS_K); const bf16* V = (const bf16*)(p.ws + WS_V); unsigned char* A2 = p.ws + WS_O1;
    const float* lamp = (const float*)(p.ws + WS_MISC);
    for (int v = vcu_of(F); v < 256; v += F.G) {
        const int b = v >> 5, h = (v >> 2) & 7, part = v & 3;
        const long kctx = NLAT + b * CTXL, klat = (long)b * SEQ;
        const int nu = part ? 4 : 5;
        for (int i = 0; i < nu; ++i) {
            const long qrow0 = i < 4 ? klat + (part * 4 + i) * 256 : kctx; const int NT = i < 4 ? 68 : 4;
            for (int m = 0; m < 2; ++m) {
                const int hm = 2 * h + m;
                const float km = __uint_as_float(__hip_atomic_load(F.ctl + CW_KM + b * 16 + hm, __ATOMIC_RELAXED, __HIP_MEMORY_SCOPE_AGENT));
                attn_body::attn_unit2<8>(qrow0, hm * 64, h * 128, kctx, klat, NT, Q, K, V, m, lamp, p.subln, A2, h * 128, km, (char*)F.lds, F.wave);
            }
        }
    }
}
namespace gla3 {
typedef short bf16x8 __attribute__((ext_vector_type(8)));
typedef short s16x4 __attribute__((ext_vector_type(4)));
typedef float f32x16 __attribute__((ext_vector_type(16)));
constexpr int CH = 64 * 16 + 64;
constexpr int L_QS = 0, L_KS = 16 * CH, L_VS = 32 * CH, L_SB = 40 * CH, L_X = 56 * CH, L_DEC = L_X + 16384, L_END = L_DEC + 512;
__device__ __forceinline__ int crow(int i, int hh) { return (i & 3) + 8 * (i >> 2) + 4 * hh; }
typedef float f32x2_t __attribute__((ext_vector_type(2))); typedef __bf16 bf16x2_t __attribute__((ext_vector_type(2)));
__device__ __forceinline__ unsigned pk(float lo, float hi) { f32x2_t v = {lo, hi}; bf16x2_t b = __builtin_convertvector(v, bf16x2_t); return __builtin_bit_cast(unsigned, b); }
typedef short v4i16_t __attribute__((ext_vector_type(4)));
__device__ __forceinline__ s16x4 trrd(LAS const unsigned char* p) { return __builtin_bit_cast(s16x4, __builtin_amdgcn_ds_read_tr16_b64_v4i16((LAS v4i16_t*)p)); }
#define GLA_FR(lo, hi) (bf16x8){lo[0], lo[1], lo[2], lo[3], hi[0], hi[1], hi[2], hi[3]}

__device__ __forceinline__ void scan_unit(const Frame& F, const Prm& p, int unit) {
    const int dvs = unit & 3, dir = (unit >> 2) & 1, h = (unit >> 3) & 3, b = unit >> 5;
    LAS unsigned char* lds = (LAS unsigned char*)F.lds;
    const int lane = F.lane, w = F.wave, tid = F.tid, r = lane & 31, hh = lane >> 5;
    const bf16* QT = (const bf16*)(p.ws + WS_QT) + ((size_t)dir * 8 + 2 * h) * NTOK * 64;
    const bf16* KT = (const bf16*)(p.ws + WS_KT) + ((size_t)dir * 8 + 2 * h) * NTOK * 64;
    const bf16* V = (const bf16*)(p.ws + WS_V1) + h * 256 + dvs * 64;
    const float* DEC = (const float*)(p.ws + WS_DEC) + (size_t)dir * NCHUNK * 512 + h * 128;
    bf16* OG = (bf16*)((unsigned char*)p.out + (dir ? OUT_OGB : 0)) + h * 256 + dvs * 64;
    const int g1 = (lane >> 4) & 1, q4 = (lane & 15) >> 2, p4 = lane & 3;
    const int trb = (2 * g1 + (p4 >> 1)) * CH + q4 * 16 + 8 * (p4 & 1);
    const int trN = trb + 128 * hh, trP = trb + 64 * hh;
    f32x16 S0 = {}, S1 = {};
    for (int i = tid; i < 16 * CH / 16; i += NTHR) *(LAS u32x4*)(lds + L_SB + i * 16) = (u32x4){0u, 0u, 0u, 0u};
    u32x4 pq0[2], pq1[2], pk0[2], pk1[2], pv[2]; float pdec[2] = {0.f, 0.f};
#define GLA_CHUNK(step) ((step) >= 4 ? b * 64 + (dir ? 63 - ((step) - 4) : (step) - 4) : 512 + b * 4 + (dir ? 3 - (step) : (step)))
    const int qrow = 8 * w + (lane >> 4), qch = lane & 15, vrow = 8 * w + (lane >> 3), vch = lane & 7;
    const size_t qgo = (size_t)(qch >> 3) * NTOK * 64 + (qch & 7) * 8;
#define GLA_LOAD(step, u) do { const size_t t0_ = (size_t)GLA_CHUNK(step) * 64; \
        pq0[u] = *(const u32x4*)(QT + qgo + (t0_ + qrow) * 64); pq1[u] = *(const u32x4*)(QT + qgo + (t0_ + qrow + 4) * 64); \
        pk0[u] = *(const u32x4*)(KT + qgo + (t0_ + qrow) * 64); pk1[u] = *(const u32x4*)(KT + qgo + (t0_ + qrow + 4) * 64); \
        pv[u] = *(const u32x4*)(V + (t0_ + vrow) * 1024 + 8 * vch); if (tid < 128) pdec[u] = DEC[(size_t)GLA_CHUNK(step) * 512 + tid]; } while (0)
#define GLA_STORE(u) do { \
        *(LAS u32x4*)(lds + L_QS + qch * CH + qrow * 16) = pq0[u]; *(LAS u32x4*)(lds + L_QS + qch * CH + (qrow + 4) * 16) = pq1[u]; \
        *(LAS u32x4*)(lds + L_KS + qch * CH + qrow * 16) = pk0[u]; *(LAS u32x4*)(lds + L_KS + qch * CH + (qrow + 4) * 16) = pk1[u]; \
        *(LAS u32x4*)(lds + L_VS + vch * CH + vrow * 16) = pv[u]; \
        if (tid < 128) *(LAS float*)(lds + L_DEC + 4 * tid) = pdec[u]; } while (0)
    GLA_LOAD(0, 0);
    GLA_LOAD(1, 1);
    GLA_STORE(0);
    __syncthreads();
    const int tb = (w & 3) >> 1, vb = w & 1;
    for (int sp2 = 0; sp2 < 34; ++sp2) {
#pragma unroll
    for (int u = 0; u < 2; ++u) {
        const int step = 2 * sp2 + u;
        const bool lat = step >= 4; const int chunk = GLA_CHUNK(step);
        if (step + 2 < 68) GLA_LOAD(step + 2, u);
        f32x16 o = {};
        if (w < 4) {
            if (lat) {
                const bool n0 = dir ? (tb == 0) : true, n1 = dir ? true : (tb == 1);
                f32x16 sc0 = {}, sc1 = {};
#define GLA_BQ(ks) (*(const LAS bf16x8*)(lds + L_QS + (2 * (ks) + hh) * CH + (32 * tb + r) * 16))
#define GLA_A0(ks) (*(const LAS bf16x8*)(lds + L_KS + (2 * (ks) + hh) * CH + r * 16))
#define GLA_A1(ks) (*(const LAS bf16x8*)(lds + L_KS + (2 * (ks) + hh) * CH + (32 + r) * 16))
                if (n0 && n1) {
#pragma unroll
                    for (int ks = 0; ks < 8; ++ks) { const bf16x8 bq = GLA_BQ(ks); sc0 = __builtin_amdgcn_mfma_f32_32x32x16_bf16(GLA_A0(ks), bq, sc0, 0, 0, 0); sc1 = __builtin_amdgcn_mfma_f32_32x32x16_bf16(GLA_A1(ks), bq, sc1, 0, 0, 0); }
                } else if (n0) {
#pragma unroll
                    for (int ks = 0; ks < 8; ++ks) sc0 = __builtin_amdgcn_mfma_f32_32x32x16_bf16(GLA_A0(ks), GLA_BQ(ks), sc0, 0, 0, 0);
                } else {
#pragma unroll
                    for (int ks = 0; ks < 8; ++ks) sc1 = __builtin_amdgcn_mfma_f32_32x32x16_bf16(GLA_A1(ks), GLA_BQ(ks), sc1, 0, 0, 0);
                }
#undef GLA_BQ
#undef GLA_A0
#undef GLA_A1
                const int t = 32 * tb + r;
#pragma unroll
                for (int i = 0; i < 16; ++i) { const int s0 = crow(i, hh), s1 = 32 + s0; const bool k0 = dir ? (s0 >= t) : (s0 <= t), k1 = dir ? (s1 >= t) : (s1 <= t); sc0[i] = k0 ? sc0[i] : 0.f; sc1[i] = k1 ? sc1[i] : 0.f; }
#pragma unroll
                for (int sb = 0; sb < 2; ++sb) { if (sb == 0 ? n0 : n1) {
#pragma unroll
                    for (int sp = 0; sp < 2; ++sp) {
                        u32x4 pw;
                        if (sb == 0) { pw.x = pk(sc0[8 * sp + 0], sc0[8 * sp + 1]); pw.y = pk(sc0[8 * sp + 2], sc0[8 * sp + 3]); pw.z = pk(sc0[8 * sp + 4], sc0[8 * sp + 5]); pw.w = pk(sc0[8 * sp + 6], sc0[8 * sp + 7]); }
                        else { pw.x = pk(sc1[8 * sp + 0], sc1[8 * sp + 1]); pw.y = pk(sc1[8 * sp + 2], sc1[8 * sp + 3]); pw.z = pk(sc1[8 * sp + 4], sc1[8 * sp + 5]); pw.w = pk(sc1[8 * sp + 6], sc1[8 * sp + 7]); }
                        LAS const unsigned char* vp = lds + L_VS + trP + (4 * vb) * CH + (32 * sb + 16 * sp) * 16;
                        const s16x4 lo = trrd(vp), hi = trrd(vp + 8 * 16);
                        o = __builtin_amdgcn_mfma_f32_32x32x16_bf16(GLA_FR(lo, hi), __builtin_bit_cast(bf16x8, pw), o, 0, 0, 0);
                    } } }
            }
        } else {
            const int db = w - 4;
            if (lat) {
                f32x16 o2 = {};
#pragma unroll
                for (int ks = 0; ks < 8; ++ks) {
                    const bf16x8 as = *(const LAS bf16x8*)(lds + L_SB + (2 * ks + hh) * CH + (32 * vb + r) * 16);
                    const bf16x8 bq = *(const LAS bf16x8*)(lds + L_QS + (2 * ks + hh) * CH + (32 * tb + r) * 16);
                    o2 = __builtin_amdgcn_mfma_f32_32x32x16_bf16(as, bq, o2, 0, 0, 0);
                }
#pragma unroll
                for (int g = 0; g < 4; ++g) *(LAS f32x4*)(lds + L_X + (w & 3) * 4096 + g * 1024 + lane * 16) = (f32x4){o2[4 * g], o2[4 * g + 1], o2[4 * g + 2], o2[4 * g + 3]};
            }
#pragma unroll
            for (int ks = 0; ks < 4; ++ks) {
                LAS const unsigned char* kp = lds + L_KS + trN + (4 * db) * CH + (16 * ks) * 16;
                LAS const unsigned char* vp = lds + L_VS + trN + (16 * ks) * 16;
                const s16x4 al = trrd(kp), ah = trrd(kp + 4 * 16);
                const s16x4 b0l = trrd(vp), b0h = trrd(vp + 4 * 16), b1l = trrd(vp + 4 * CH), b1h = trrd(vp + 4 * CH + 4 * 16);
                S0 = __builtin_amdgcn_mfma_f32_32x32x16_bf16(GLA_FR(al, ah), GLA_FR(b0l, b0h), S0, 0, 0, 0); S1 = __builtin_amdgcn_mfma_f32_32x32x16_bf16(GLA_FR(al, ah), GLA_FR(b1l, b1h), S1, 0, 0, 0);
            }
#pragma unroll
            for (int i = 0; i < 16; ++i) { const float dc = *(const LAS float*)(lds + L_DEC + 4 * (32 * db + crow(i, hh))); S0[i] *= dc; S1[i] *= dc; }
        }
        __syncthreads();
        if (w < 4 && lat) {
            bf16* orow = OG + ((size_t)chunk * 64 + 32 * tb + r) * DM + 32 * vb + 4 * hh;
#pragma unroll
            for (int g = 0; g < 4; ++g) { const f32x4 x = *(const LAS f32x4*)(lds + L_X + w * 4096 + g * 1024 + lane * 16);
                u32x2 wv; wv.x = pk(o[4 * g] + x.x, o[4 * g + 1] + x.y); wv.y = pk(o[4 * g + 2] + x.z, o[4 * g + 3] + x.w); *(u32x2*)(orow + 8 * g) = wv; }
        }
        if (step + 1 < 68) {
            GLA_STORE(u ^ 1);
            if (w >= 4) { const int db = w - 4;
#pragma unroll
                for (int g = 0; g < 4; ++g) { u32x2 w0, w1; w0.x = pk(S0[4 * g], S0[4 * g + 1]); w0.y = pk(S0[4 * g + 2], S0[4 * g + 3]); w1.x = pk(S1[4 * g], S1[4 * g + 1]); w1.y = pk(S1[4 * g + 2], S1[4 * g + 3]);
                    *(LAS u32x2*)(lds + L_SB + (4 * db + g) * CH + r * 16 + 8 * hh) = w0; *(LAS u32x2*)(lds + L_SB + (4 * db + g) * CH + (32 + r) * 16 + 8 * hh) = w1; } }
        }
        __syncthreads();
    }
    }
#undef GLA_CHUNK
#undef GLA_LOAD
#undef GLA_STORE
}
#undef GLA_FR
}
__device__ __forceinline__ void phase_scan_opt(const Frame& F, const Prm& p) {
    for (int unit = vcu_of(F); unit < 256; unit += F.G) gla3::scan_unit(F, p, unit);
}
#define PHASE_QKV(F, p) phase_qkv_opt(F, p)
#define PHASE_ATTN(F, p) phase_attn2(F, p)
#define PHASE_WO(F, p, l) phase_wo_opt(F, p, l)
#define PHASE_MOE1(F, p, l) phase_moe1_opt(F, p, l)
#define PHASE_MOE2(F, p, l) phase_moe2_opt(F, p, l)
#define PHASE_INPROJ(F, p) phase_inproj_opt(F, p)
#define PHASE_SCAN(F, p) phase_scan_opt(F, p)
typedef GAS unsigned gu32;
#define XB_TMO      128
#define XB_XCNT(j)  (256  + 64 * (j))
#define XB_XSUB(j)  (1280 + 64 * (j))
#define XB_XGEN(j)  (2304 + 64 * (j))
#define XB_TOP      3328
#define XB_TOPGEN   3392
#define XCD_BAR_WORDS 3456
#define XB_SPIN_CAP (1u << 20)
__device__ __forceinline__ unsigned xb_ld(unsigned* p)              { return __hip_atomic_load(p, __ATOMIC_RELAXED, __HIP_MEMORY_SCOPE_AGENT); }
__device__ __forceinline__ unsigned xb_add(unsigned* p, unsigned v) { return __hip_atomic_fetch_add(p, v, __ATOMIC_RELAXED, __HIP_MEMORY_SCOPE_AGENT); }
__device__ __forceinline__ unsigned xb_xcc_id() { return (unsigned)__builtin_amdgcn_s_getreg((3 << 11) | 20) & 0xFu; }
#define XB_SPIN(cond, bar) do { unsigned _sp = 0; while (cond) { __builtin_amdgcn_s_sleep(1); \
    if ((++_sp & 255u) == 0u) { if (xb_ld(&(bar)[XB_TMO])) break; if (_sp > XB_SPIN_CAP) { atomicAdd(&(bar)[XB_TMO], 1u); break; } } } } while (0)
struct XcdBarrier { unsigned* bar; unsigned x; volatile LAS unsigned* st; };
__device__ __forceinline__ XcdBarrier xcd_barrier_post(unsigned* bar, volatile LAS unsigned* st) {
    XcdBarrier b; b.bar = bar; b.x = xb_xcc_id(); b.st = st;
    if (threadIdx.x == 0) (void)xb_add(&bar[XB_XCNT(b.x)], 1u);
    return b;
}
__device__ __forceinline__ void xcd_barrier_complete(unsigned* bar, unsigned x, unsigned& nloc, unsigned& nx) {
    const unsigned G = gridDim.x * gridDim.y * gridDim.z;
    unsigned sum, cnt, mine, sp = 0u;
    for (;;) {
        sum = 0u; cnt = 0u; mine = 0u;
#pragma unroll
        for (unsigned j = 0; j < 16; ++j) { const unsigned c = xb_ld(&bar[XB_XCNT(j)]); sum += c; cnt += (c > 0u) ? 1u : 0u; mine = (j == x) ? c : mine; }
        if (sum == G) break;
        __builtin_amdgcn_s_sleep(1);
        if ((++sp & 255u) == 0u) { if (xb_ld(&bar[XB_TMO])) break; if (sp > XB_SPIN_CAP) { atomicAdd(&bar[XB_TMO], 1u); break; } }
    }
    nloc = mine > 0u ? mine : 1u; nx = cnt > 0u ? cnt : 1u;
}
__device__ __forceinline__ void xcd_barrier(const XcdBarrier& b, int tid) {
    asm volatile("s_waitcnt vmcnt(0)" ::: "memory");
    __syncthreads();
    if (tid == 0) {
        unsigned* bar = b.bar;
        __builtin_amdgcn_s_waitcnt(0);
        unsigned nloc = b.st[0], nx = b.st[1];
        if (nloc == 0u) { xcd_barrier_complete(bar, b.x, nloc, nx); b.st[0] = nloc; b.st[1] = nx; }
        const unsigned old = xb_add(&bar[XB_XSUB(b.x)], 1u);
        const unsigned gen = old / nloc;
        if (old + 1u == (gen + 1u) * nloc) {
            __builtin_amdgcn_fence(__ATOMIC_RELEASE, "agent");
            asm volatile("s_waitcnt vmcnt(0)" ::: "memory");
            const unsigned og = xb_add(&bar[XB_TOP], 1u);
            const unsigned tg = og / nx;
            if (og + 1u == (tg + 1u) * nx) xb_add(&bar[XB_TOPGEN], 1u);
            else XB_SPIN(xb_ld(&bar[XB_TOPGEN]) == tg, bar);
            __builtin_amdgcn_fence(__ATOMIC_ACQUIRE, "agent");
            xb_add(&bar[XB_XGEN(b.x)], 1u);
            asm volatile("s_waitcnt vmcnt(0)" ::: "memory");
        } else {
            XB_SPIN(xb_ld(&bar[XB_XGEN(b.x)]) == gen, bar);
            __builtin_amdgcn_fence(__ATOMIC_ACQUIRE, "agent");
            asm volatile("s_waitcnt vmcnt(0)" ::: "memory");
        }
    }
    __syncthreads();
}

constexpr int NPHASE = 19;
__global__ void __launch_bounds__(NTHR, 2) mega_fwd(Prm p) {
    extern __shared__ __attribute__((aligned(16))) unsigned char lds[];
    Frame F; F.lds = lds; F.ctl = (unsigned*)(p.ws + WS_CTL);
    F.tid = threadIdx.x; F.lane = F.tid & 63; F.wave = __builtin_amdgcn_readfirstlane(F.tid >> 6); F.G = gridDim.x; F.bid = blockIdx.x;
    for (int u = F.tid; u < (LDS_BYTES - LDSCTL_OFF) / 4; u += NTHR) ((LAS unsigned*)(lds + LDSCTL_OFF))[u] = 0u;
    __syncthreads();
    const int lo = p.ph_lo, hi = p.ph_hi;
    const bool multi = (hi - lo) > 1;
    XcdBarrier bar; bar.bar = F.ctl + CW_BAR + p.li * XCD_BAR_WORDS; bar.x = 0; bar.st = nullptr;
    if (multi) bar = xcd_barrier_post(F.ctl + CW_BAR + p.li * XCD_BAR_WORDS, (volatile LAS unsigned*)(lds + MISC_OFF) + 8);
#define IN(k) (lo <= (k) && (k) < hi)
#define SEAM(k) do { if (IN(k) && IN((k) + 1)) xcd_barrier(bar, F.tid); } while (0)
    if (IN(0)) { phase_prologue(F, p); } SEAM(0);
    if (IN(1)) { phase_modulate0(F, p); } SEAM(1);
    if (IN(2)) { PHASE_QKV(F, p); } SEAM(2);
    if (IN(3)) { PHASE_ATTN(F, p); }
    {
        int l_; asm volatile("v_mbcnt_lo_u32_b32 %0, -1, 0\n\tv_mbcnt_hi_u32_b32 %0, -1, %0" : "=v"(l_)); F.lane = l_; F.tid = F.wave * 64 + l_; }
    SEAM(3);
    if (IN(5)) { PHASE_WO(F, p, 0); } SEAM(5);
    if (IN(6)) { phase_ln_route(F, p, 0); } SEAM(6);
    if (IN(7)) { PHASE_MOE1(F, p, 0); } SEAM(7);
    if (IN(8)) { PHASE_MOE2(F, p, 0); } SEAM(8);
    if (IN(9)) { phase_moe_combine(F, p, 0); } SEAM(9);
    if (IN(10)) { PHASE_INPROJ(F, p); } SEAM(10);
    if (IN(11)) { phase_gla_prep(F, p); } SEAM(11);
    if (IN(12)) { PHASE_SCAN(F, p); } SEAM(12);
    if (IN(13)) { phase_gla_post(F, p); } SEAM(13);
    if (IN(14)) { PHASE_WO(F, p, 1); } SEAM(14);
    if (IN(15)) { phase_ln_route(F, p, 1); } SEAM(15);
    if (IN(16)) { PHASE_MOE1(F, p, 1); } SEAM(16);
    if (IN(17)) { PHASE_MOE2(F, p, 1); } SEAM(17);
    if (IN(18)) { phase_moe_combine(F, p, 1); }
#undef IN
#undef SEAM
}

extern "C" void kernel_launch(void* const* d_in, const int* in_sizes, int n_in, void* d_out, int out_size, void* d_ws, size_t ws_size, hipStream_t stream) {
    static int grid = 0;
    if (grid == 0) {
        if (n_in != 23 || in_sizes[0] != NLAT * DM || out_size != NLAT * DM || ws_size < WS_END) { fprintf(stderr, "kernel_launch: unexpected shapes (n_in %d, in0 %d, out %d, ws %zu); nothing launched\n", n_in, n_in > 0 ? in_sizes[0] : -1, out_size, ws_size); grid = -1; return; }
        int dev = 0, cus = 0;
        if (hipGetDevice(&dev) != hipSuccess || hipDeviceGetAttribute(&cus, hipDeviceAttributeMultiprocessorCount, dev) != hipSuccess) { grid = -1; return; }
        if (hipFuncSetAttribute((const void*)mega_fwd, hipFuncAttributeMaxDynamicSharedMemorySize, LDS_BYTES) != hipSuccess) { fprintf(stderr, "kernel_launch: hipFuncSetAttribute failed\n"); grid = -1; return; }
        int per_cu = 0;
        if (hipOccupancyMaxActiveBlocksPerMultiprocessor(&per_cu, (const void*)mega_fwd, NTHR, LDS_BYTES) != hipSuccess || per_cu < 1) fprintf(stderr, "kernel_launch: note: occupancy query reports %d\n", per_cu);
        (void)hipGetLastError();
        grid = cus;
    }
    if (grid < 0) return;
    (void)hipMemsetAsync((char*)d_ws + WS_CTL, 0, CTL_ZERO_BYTES, stream);
    Prm p{};
    const float** pp = (const float**)&p;
    for (int i = 0; i < 23; ++i) pp[i] = (const float*)d_in[i];
    p.out = (float*)d_out; p.ws = (unsigned char*)d_ws;
    p.ph_lo = 0; p.ph_hi = NPHASE; p.li = 0;
    hipLaunchKernelGGL(mega_fwd, dim3(grid), dim3(NTHR), LDS_BYTES, stream, p);
}
```

```cpp
#include <hip/hip_runtime.h>
#include <cstdint>
#include <cstdio>

constexpr int BATCH = 8, SEQ = 4096, DM = 1024, CTXL = 256;
constexpr int NLAT = BATCH * SEQ, NCTX = BATCH * CTXL, NTOK = NLAT + NCTX;
constexpr float ALPHA = 1.4142135623730951f;
constexpr float LN_EPS = 1e-5f;
constexpr float LAMBDA_INIT0 = 0.2f;
constexpr float C2 = 0.125f * 1.4426950408889634f;
constexpr int NEXP = 16, DEXP = 512, MAXSLOT = 73728;
constexpr int NCHUNK = NTOK / 64;
constexpr int NIN = 3328;

typedef unsigned short bf16;
typedef float f32x4 __attribute__((ext_vector_type(4)));
typedef float f32x2 __attribute__((ext_vector_type(2)));
typedef unsigned u32x2 __attribute__((ext_vector_type(2)));
typedef unsigned u32x4 __attribute__((ext_vector_type(4)));

constexpr size_t MiB = 1u << 20;
constexpr size_t WS_CTL = 0, CTL_ZERO_BYTES = 1 * MiB;
constexpr size_t WS_MOD = 1 * MiB;
constexpr size_t WS_MISC = 1 * MiB + 512 * 1024;
constexpr size_t WS_WQKV = 2 * MiB, WS_WO = 5 * MiB, WS_GU0 = 6 * MiB, WS_DN0 = 22 * MiB, WS_WIN = 30 * MiB, WS_WGO = 34 * MiB, WS_GU1 = 35 * MiB, WS_DN1 = 51 * MiB;
constexpr size_t WS_XB = 59 * MiB;
constexpr size_t WS_H = 127 * MiB;
constexpr size_t WS_Q = 195 * MiB, WS_K = 263 * MiB, WS_V = 331 * MiB, WS_O2 = 399 * MiB;
constexpr size_t WS_LIST = 467 * MiB;
constexpr size_t WS_TOKR = 470 * MiB;
constexpr size_t WS_DEC = 472 * MiB;
constexpr size_t WS_ZZ = 475 * MiB;
constexpr size_t WS_END = 480 * MiB;
constexpr size_t WS_O1 = WS_H, WS_A2 = WS_H, WS_Y = WS_K;
constexpr size_t WS_YM = 195 * MiB, WS_ACT = 339 * MiB;
constexpr size_t WS_QR = 195 * MiB, WS_KR = 229 * MiB, WS_V1 = 263 * MiB, WS_R = 331 * MiB;
constexpr size_t WS_QT = WS_H, WS_KT = 399 * MiB;
constexpr size_t WS_A2B = WS_H;
constexpr size_t OUT_OGB = 64 * MiB;
constexpr int CW_TMO = 0, CW_CODE = 1;
constexpr int CW_CNT = 64;
constexpr int CW_KM = 128;
constexpr int CW_BAR = 4096;

__device__ __forceinline__ unsigned f2bf(float f) { unsigned u = __builtin_bit_cast(unsigned, f); return (u + 0x7fffu + ((u >> 16) & 1u)) >> 16; }
__device__ __forceinline__ unsigned pk2(float lo, float hi) { return f2bf(lo) | (f2bf(hi) << 16); }
__device__ __forceinline__ float bf2f(unsigned b) { return __builtin_bit_cast(float, b << 16); }
__device__ __forceinline__ float wave_sum(float v) {
#pragma unroll
    for (int o = 1; o < 64; o <<= 1) v += __shfl_xor(v, o);
    return v;
}
__device__ __forceinline__ float silu_f(float v) { return v / (1.f + __expf(-v)); }

struct Prm {
    const float *x, *c, *ctx, *cctx, *ada_w, *ada_b, *ln_g, *ln_b, *w_qkv, *w_o, *lam, *subln, *gw_in, *gwg_down, *gwg_up, *gbg, *gnorm, *gw_o, *rw, *rb, *mg, *mu, *md;
    float* out; unsigned char* ws;
    int ph_lo, ph_hi, li, pad;
};
__device__ __forceinline__ void ld_row_f32(const float* p, int lane, f32x4 (&v)[4]) {
#pragma unroll
    for (int j = 0; j < 4; ++j) v[j] = *(const f32x4*)(p + 4 * lane + 256 * j);
}
__device__ __forceinline__ void st_row_f32(float* p, int lane, const f32x4 (&v)[4]) {
#pragma unroll
    for (int j = 0; j < 4; ++j) *(f32x4*)(p + 4 * lane + 256 * j) = v[j];
}
__device__ __forceinline__ void ld_row_bf16(const bf16* p, int lane, f32x4 (&v)[4]) {
#pragma unroll
    for (int j = 0; j < 4; ++j) { const u32x2 u = *(const u32x2*)(p + 4 * lane + 256 * j); v[j] = (f32x4){bf2f(u.x & 0xffffu), bf2f(u.x >> 16), bf2f(u.y & 0xffffu), bf2f(u.y >> 16)}; }
}
__device__ __forceinline__ void st_row_bf16(bf16* p, int lane, const f32x4 (&v)[4]) {
#pragma unroll
    for (int j = 0; j < 4; ++j) { u32x2 u; u.x = pk2(v[j].x, v[j].y); u.y = pk2(v[j].z, v[j].w); *(u32x2*)(p + 4 * lane + 256 * j) = u; }
}
__device__ __forceinline__ void ln_row(f32x4 (&v)[4], const float* g, const float* b, int lane) {
    float s = 0.f;
#pragma unroll
    for (int j = 0; j < 4; ++j) s += (v[j].x + v[j].y) + (v[j].z + v[j].w);
    const float mean = wave_sum(s) * (1.f / DM); float q = 0.f;
#pragma unroll
    for (int j = 0; j < 4; ++j) { v[j] = v[j] - mean; q += (v[j].x * v[j].x + v[j].y * v[j].y) + (v[j].z * v[j].z + v[j].w * v[j].w); }
    const float rstd = 1.f / sqrtf(wave_sum(q) * (1.f / DM) + LN_EPS);
#pragma unroll
    for (int j = 0; j < 4; ++j) { const f32x4 gg = *(const f32x4*)(g + 4 * lane + 256 * j), bb = *(const f32x4*)(b + 4 * lane + 256 * j); v[j] = v[j] * rstd * gg + bb; }
}
__host__ __device__ __forceinline__ int gu_phys(int other, int sel) { return (other >> 4) * 32 + sel * 16 + (other & 15); }
__host__ __device__ __forceinline__ int perm16b(int L) { return (L & ~31) | (16 * ((L >> 2) & 1) + 4 * ((L >> 3) & 3) + (L & 3)); }
__host__ __device__ __forceinline__ int perm16b_inv(int P) { return (P & ~31) | (8 * ((P >> 2) & 3) + 4 * ((P >> 4) & 1) + (P & 3)); }
__device__ __forceinline__ unsigned pk4_fp8(float a, float b, float c, float d) { int w = 0; w = __builtin_amdgcn_cvt_pk_fp8_f32(a, b, w, false); w = __builtin_amdgcn_cvt_pk_fp8_f32(c, d, w, true); return (unsigned)w; }
constexpr float W8_SCALE = 64.f, W8_INV = 1.f / 64.f;
__device__ __forceinline__ void st_row_fp8(unsigned char* p, int lane, const f32x4 (&v)[4]) {
#pragma unroll
    for (int j = 0; j < 4; ++j) *(unsigned*)(p + 4 * lane + 256 * j) = pk4_fp8(v[j].x, v[j].y, v[j].z, v[j].w);
}
__device__ __forceinline__ void ld_row_fp8(const unsigned char* p, int lane, f32x4 (&v)[4]) {
#pragma unroll
    for (int j = 0; j < 4; ++j) { const int w = *(const int*)(p + 4 * lane + 256 * j); const f32x2 lo = __builtin_amdgcn_cvt_pk_f32_fp8(w, false), hi = __builtin_amdgcn_cvt_pk_f32_fp8(w, true); v[j] = (f32x4){lo.x, lo.y, hi.x, hi.y}; }
}
#define GAS __attribute__((address_space(1)))
#define LAS __attribute__((address_space(3)))
constexpr int NWAVES = 8, NTHR = NWAVES * 64;
constexpr int RING_BYTES = 131072, LDS_BYTES = 147456, LDSCTL_OFF = LDS_BYTES - 1024, MISC_OFF = LDSCTL_OFF + 320;
constexpr int LDSX_OFF = RING_BYTES + 1024;
#define LDS_WAIT() asm volatile("s_waitcnt lgkmcnt(0)" ::: "memory")
#define VM_WAIT() asm volatile("s_waitcnt vmcnt(0)" ::: "memory")

struct Frame {
    unsigned char* lds;
    unsigned* ctl;
    int tid, lane, wave, G, bid;
};

template <int MODE>
__device__ __forceinline__ void p0_transpose_item(const float* W, int K, int N, bf16* WT, int row_off, float* scr, int item, int lane) {
    const int nblk = N / 32, kb = item / nblk, nb = item % nblk, k0 = 64 * kb, n0 = 32 * nb;
    { f32x4 t[8];
#pragma unroll
        for (int i = 0; i < 8; ++i) t[i] = *(const f32x4*)(W + (size_t)(k0 + 8 * i + (lane >> 3)) * N + n0 + 4 * (lane & 7));
#pragma unroll
        for (int i = 0; i < 8; ++i) { float* d = scr + (8 * i + (lane >> 3)) * 33 + 4 * (lane & 7); d[0] = t[i].x; d[1] = t[i].y; d[2] = t[i].z; d[3] = t[i].w; } }
    LDS_WAIT(); asm volatile("" ::: "memory");
    const int c = lane & 7;
#pragma unroll
    for (int j = 0; j < 4; ++j) { const int n = (lane >> 3) + 8 * j; const float* s = scr + (8 * c) * 33 + n;
        u32x4 o; o.x = pk2(s[0 * 33], s[1 * 33]); o.y = pk2(s[2 * 33], s[3 * 33]); o.z = pk2(s[4 * 33], s[5 * 33]); o.w = pk2(s[6 * 33], s[7 * 33]);
        const int nl = n0 + n; const int pr = (MODE == 0) ? (row_off + nl) : (MODE == 3) ? (row_off + perm16b(nl)) : (row_off + gu_phys(nl, MODE - 1));
        *(u32x4*)(WT + (size_t)pr * K + k0 + 8 * c) = o; }
    LDS_WAIT(); asm volatile("" ::: "memory");
}
template <int MODE>
__device__ __forceinline__ void p0_transpose_item8(const float* W, int K, int N, unsigned char* WT, float* scr, int item, int lane) {
    const int nblk = N / 32, kb = item / nblk, nb = item % nblk, k0 = 64 * kb, n0 = 32 * nb;
    { f32x4 t[8];
#pragma unroll
        for (int i = 0; i < 8; ++i) t[i] = *(const f32x4*)(W + (size_t)(k0 + 8 * i + (lane >> 3)) * N + n0 + 4 * (lane & 7));
#pragma unroll
        for (int i = 0; i < 8; ++i) { float* d = scr + (8 * i + (lane >> 3)) * 33 + 4 * (lane & 7); d[0] = t[i].x; d[1] = t[i].y; d[2] = t[i].z; d[3] = t[i].w; } }
    LDS_WAIT(); asm volatile("" ::: "memory");
    const int c = lane & 7;
#pragma unroll
    for (int j = 0; j < 4; ++j) { const int n = (lane >> 3) + 8 * j; const float* s = scr + (8 * c) * 33 + n;
        u32x2 o; o.x = pk4_fp8(s[0 * 33] * W8_SCALE, s[1 * 33] * W8_SCALE, s[2 * 33] * W8_SCALE, s[3 * 33] * W8_SCALE); o.y = pk4_fp8(s[4 * 33] * W8_SCALE, s[5 * 33] * W8_SCALE, s[6 * 33] * W8_SCALE, s[7 * 33] * W8_SCALE);
        const int nl = n0 + n; const int pr = (MODE == 3) ? perm16b(nl) : (MODE == 0) ? nl : gu_phys(nl, MODE - 1);
        *(u32x2*)(WT + (size_t)pr * K + k0 + 8 * c) = o; }
    LDS_WAIT(); asm volatile("" ::: "memory");
}
__device__ __forceinline__ void phase_prologue(const Frame& F, const Prm& p) {
    float* sil = (float*)F.lds;
    for (int i = F.tid; i < 9 * 1024; i += NTHR) { const int r = i >> 10, k = i & 1023; const float v = (r < 8) ? p.c[r * 1024 + k] : p.cctx[k]; sil[i] = silu_f(v); }
    __syncthreads();
    float* MOD = (float*)(p.ws + WS_MOD);
    if (F.bid < 192) {
        const int layer = F.bid / 96, n = (F.bid % 96) * 64 + F.lane; const float* W = p.ada_w + (size_t)layer * 1024 * 6144 + n;
        float acc[9];
#pragma unroll
        for (int r = 0; r < 9; ++r) acc[r] = 0.f;
        const int kb = F.wave * 128;
#pragma unroll 4
        for (int k = kb; k < kb + 128; k += 4) {
            const float w0 = W[(size_t)k * 6144], w1 = W[(size_t)(k + 1) * 6144], w2 = W[(size_t)(k + 2) * 6144], w3 = W[(size_t)(k + 3) * 6144];
#pragma unroll
            for (int r = 0; r < 9; ++r) { const f32x4 s = *(const f32x4*)(sil + r * 1024 + k); acc[r] += s.x * w0 + s.y * w1 + s.z * w2 + s.w * w3; }
        }
        float* red = (float*)(F.lds + 36864 + 8 * 8704);
#pragma unroll
        for (int r = 0; r < 9; ++r) red[(F.wave * 9 + r) * 64 + F.lane] = acc[r];
        __syncthreads();
        if (F.wave == 0) { const float bb = p.ada_b[layer * 6144 + n];
#pragma unroll
            for (int r = 0; r < 9; ++r) { float t = bb;
#pragma unroll
                for (int w = 0; w < 8; ++w) t += red[(w * 9 + r) * 64 + F.lane];
                MOD[(layer * 9 + r) * 6144 + n] = t; } }
    }
    float* misc = (float*)(p.ws + WS_MISC);
    if (F.bid == 255 % F.G && F.wave == 1) {
        const float a = wave_sum(p.lam[F.lane] * p.lam[64 + F.lane]), b = wave_sum(p.lam[128 + F.lane] * p.lam[192 + F.lane]);
        if (F.lane == 0) misc[0] = __expf(a) - __expf(b) + LAMBDA_INIT0;
        for (int i = F.lane; i < 1024; i += 64) { const int pos = i >> 4, f = i & 15; const float inv = powf(10000.f, -(float)f / 16.f); const float ang = (float)pos * inv;
            misc[1024 + 2 * i] = cosf(ang); misc[1024 + 2 * i + 1] = sinf(ang); }
    }
    float* scr = (float*)(F.lds + 36864 + F.wave * 8704);
    const int gw = F.bid * NWAVES + F.wave, NGW = F.G * NWAVES;
    constexpr int I_QKV = 16 * 96, I_SQ = 16 * 32, I_G = 16 * 16, I_D = 8 * 32;
    constexpr int I_MOE = 2 * I_G + I_D;
    constexpr int NITEMS = 2 * I_QKV + 2 * I_SQ + 32 * I_MOE;
    bf16* ws16 = (bf16*)p.ws;
    for (int it = gw; it < NITEMS; it += NGW) {
        int r = it;
        if (r < I_QKV) { if ((r % 96) < 64) p0_transpose_item8<0>(p.w_qkv, 1024, 3072, p.ws + WS_WQKV, scr, r, F.lane); else p0_transpose_item8<3>(p.w_qkv, 1024, 3072, p.ws + WS_WQKV, scr, r, F.lane); continue; } r -= I_QKV;
        if (r < I_QKV) { p0_transpose_item8<3>(p.gw_in, 1024, 3072, p.ws + WS_WIN, scr, r, F.lane); continue; } r -= I_QKV;
        if (r < I_SQ) { p0_transpose_item8<3>(p.w_o, 1024, 1024, p.ws + WS_WO, scr, r, F.lane); continue; } r -= I_SQ;
        if (r < I_SQ) { p0_transpose_item8<3>(p.gw_o, 1024, 1024, p.ws + WS_WGO, scr, r, F.lane); continue; } r -= I_SQ;
        const int le = r / I_MOE, layer = le >> 4, e = le & 15; r -= le * I_MOE;
        unsigned char* GU = p.ws + (layer ? WS_GU1 : WS_GU0) + (size_t)e * 1024 * 1024; unsigned char* DN = p.ws + (layer ? WS_DN1 : WS_DN0) + (size_t)e * 1024 * 512;
        if (r < I_G) { p0_transpose_item8<1>(p.mg + (size_t)le * 1024 * 512, 1024, 512, GU, scr, r, F.lane); continue; } r -= I_G;
        if (r < I_G) { p0_transpose_item8<2>(p.mu + (size_t)le * 1024 * 512, 1024, 512, GU, scr, r, F.lane); continue; } r -= I_G;
        p0_transpose_item8<3>(p.md + (size_t)le * 512 * 1024, 512, 1024, DN, scr, r, F.lane);
    }
    (void)ws16;
    unsigned char* WIN = p.ws + WS_WIN;
    for (int i = gw * 64 + F.lane; i < 32 * 256; i += NGW * 64) { const int rr = i >> 8, k = (i & 255) * 4, dir = rr >> 4, j = rr & 15; const float* s = p.gwg_down + (size_t)dir * 1024 * 16 + j;
        *(unsigned*)(WIN + (size_t)(3072 + rr) * 1024 + k) = pk4_fp8(s[(size_t)k * 16] * W8_SCALE, s[(size_t)(k + 1) * 16] * W8_SCALE, s[(size_t)(k + 2) * 16] * W8_SCALE, s[(size_t)(k + 3) * 16] * W8_SCALE); }
    for (int i = gw * 64 + F.lane; i < 224 * 1024 / 16; i += NGW * 64) *(u32x4*)(WIN + (size_t)3104 * 1024 + (size_t)i * 16) = (u32x4){0u, 0u, 0u, 0u};
}

__device__ __forceinline__ void phase_modulate0(const Frame& F, const Prm& p) {
    const float* MOD = (const float*)(p.ws + WS_MOD); unsigned char* H = p.ws + WS_H;
    const int gw = F.bid * NWAVES + F.wave, NGW = F.G * NWAVES, per = (NTOK + NGW - 1) / NGW;
    int curmod = -1; f32x4 sh[4], sc[4];
    const int t0 = gw * per, t1 = min(NTOK, (gw + 1) * per);
    f32x4 v[4], vn[4];
    if (t0 < t1) ld_row_f32(t0 < NLAT ? p.x + (size_t)t0 * DM : p.ctx + (size_t)(t0 - NLAT) * DM, F.lane, v);
    for (int tok = t0; tok < t1; ++tok) {
        if (tok + 1 < t1) ld_row_f32(tok + 1 < NLAT ? p.x + (size_t)(tok + 1) * DM : p.ctx + (size_t)(tok + 1 - NLAT) * DM, F.lane, vn);
        const int mr = tok < NLAT ? tok / SEQ : 8;
        if (mr != curmod) { curmod = mr; ld_row_f32(MOD + mr * 6144, F.lane, sh); ld_row_f32(MOD + mr * 6144 + 1024, F.lane, sc); }
#pragma unroll
        for (int j = 0; j < 4; ++j) v[j] = v[j] * (1.f + sc[j]) + sh[j];
        st_row_fp8(H + (size_t)tok * DM, F.lane, v);
#pragma unroll
        for (int j = 0; j < 4; ++j) v[j] = vn[j];
    }
}

__device__ __forceinline__ void phase_ln_route(const Frame& F, const Prm& p, int layer) {
    const int nrows = layer ? NLAT : NTOK;
    const float* MOD = (const float*)(p.ws + WS_MOD) + layer * 9 * 6144;
    const bf16* Y = (const bf16*)(p.ws + WS_Y); unsigned char* HF = p.ws + WS_H;
    bf16* XB = (bf16*)(p.ws + WS_XB);
    int* LIST = (int*)(p.ws + WS_LIST); int* TOKR = (int*)(p.ws + WS_TOKR);
    unsigned* CNT = F.ctl + CW_CNT + layer * 16;
    float* WrT = (float*)F.lds;
    int* rec = (int*)(F.lds + 65536);
    unsigned* lcnt = (unsigned*)(F.lds + 65536 + 8192); unsigned* lbase = lcnt + 16;
    for (int i = F.tid; i < 16 * 1024; i += NTHR) { const int k = i >> 4, e = i & 15; WrT[e * 1024 + k] = p.rw[i]; }
    if (F.tid < 16) lcnt[F.tid] = 0u;
    __syncthreads();
    const int per_wg = (nrows + F.G - 1) / F.G, per_w = (per_wg + NWAVES - 1) / NWAVES;
    const int row_lo = F.bid * per_wg, row_hi = min(nrows, row_lo + per_wg);
    const float* lng = p.ln_g + (layer * 2 + 0) * DM; const float* lnb = p.ln_b + (layer * 2 + 0) * DM;
    float rb[16];
#pragma unroll
    for (int e = 0; e < 16; ++e) rb[e] = p.rb[e];
    int curmod = -1; f32x4 gm[4], shf[4], scf[4];
    f32x4 v[4], y[4], vn[4], yn[4];
#define LNR_LOAD(tok_, V, Yv) do { if (layer) ld_row_bf16(XB + (size_t)(tok_) * DM, F.lane, V); else ld_row_f32((tok_) < NLAT ? p.x + (size_t)(tok_) * DM : p.ctx + (size_t)((tok_) - NLAT) * DM, F.lane, V); \
        ld_row_bf16(Y + (size_t)(tok_) * DM, F.lane, Yv); } while (0)
    if (row_lo + F.wave * per_w < row_hi) LNR_LOAD(row_lo + F.wave * per_w, v, y);
    for (int i = 0; i < per_w; ++i) {
        const int lr = F.wave * per_w + i, tok = row_lo + lr; if (tok >= row_hi) break;
        if (i + 1 < per_w && tok + 1 < row_hi) LNR_LOAD(tok + 1, vn, yn);
        const int mr = tok < NLAT ? tok / SEQ : 8;
        if (mr != curmod) { curmod = mr; ld_row_f32(MOD + mr * 6144 + 2048, F.lane, gm); ld_row_f32(MOD + mr * 6144 + 3072, F.lane, shf); ld_row_f32(MOD + mr * 6144 + 4096, F.lane, scf); }
        bf16* xdst = XB + (size_t)tok * DM;
#pragma unroll
        for (int j = 0; j < 4; ++j) v[j] = ALPHA * v[j] + gm[j] * y[j];
        ln_row(v, lng, lnb, F.lane);
        st_row_bf16(xdst, F.lane, v);
#pragma unroll
        for (int j = 0; j < 4; ++j) v[j] = v[j] * (1.f + scf[j]) + shf[j];
        st_row_fp8(HF + (size_t)tok * DM, F.lane, v);
        float part[16];
#pragma unroll
        for (int e = 0; e < 16; ++e) { float s = 0.f;
#pragma unroll
            for (int j = 0; j < 4; ++j) { const f32x4 w = *(const f32x4*)(WrT + e * 1024 + 4 * F.lane + 256 * j); s += (v[j].x * w.x + v[j].y * w.y) + (v[j].z * w.z + v[j].w * w.w); }
            part[e] = s; }
        {
#pragma unroll
            for (int e = 0; e < 8; ++e) { const bool up = (F.lane & 32) != 0; const float keep = up ? part[e + 8] : part[e], send = up ? part[e] : part[e + 8]; part[e] = keep + __shfl_xor(send, 32); }
#pragma unroll
            for (int e = 0; e < 4; ++e) { const bool up = (F.lane & 16) != 0; const float keep = up ? part[e + 4] : part[e], send = up ? part[e] : part[e + 4]; part[e] = keep + __shfl_xor(send, 16); }
#pragma unroll
            for (int e = 0; e < 2; ++e) { const bool up = (F.lane & 8) != 0; const float keep = up ? part[e + 2] : part[e], send = up ? part[e] : part[e + 2]; part[e] = keep + __shfl_xor(send, 8); }
            { const bool up = (F.lane & 4) != 0; const float keep = up ? part[1] : part[0], send = up ? part[0] : part[1]; part[0] = keep + __shfl_xor(send, 4); }
            part[0] += __shfl_xor(part[0], 2); part[0] += __shfl_xor(part[0], 1);
        }
        float aff[16], sel[16];
#pragma unroll
        for (int e = 0; e < 16; ++e) { const int src = ((e >> 3) & 1) * 32 + ((e >> 2) & 1) * 16 + ((e >> 1) & 1) * 8 + (e & 1) * 4; const float lg = __shfl(part[0], src); aff[e] = 1.f / (1.f + __expf(-lg)); sel[e] = aff[e] + rb[e]; }
        int bg = 0; float bgs = -3.0e38f;
#pragma unroll
        for (int g = 0; g < 4; ++g) { float m1 = -3.0e38f, m2 = -3.0e38f;
#pragma unroll
            for (int k = 0; k < 4; ++k) { const float s = sel[4 * g + k]; if (s > m1) { m2 = m1; m1 = s; } else if (s > m2) m2 = s; }
            const float gs = m1 + m2; if (gs > bgs) { bgs = gs; bg = g; } }
        int i1 = 0, i2 = 0; float s1 = -3.0e38f, s2 = -3.0e38f, a1 = 0.f, a2 = 0.f;
#pragma unroll
        for (int g = 0; g < 4; ++g) if (g == bg) {
#pragma unroll
            for (int k = 0; k < 4; ++k) { const float s = sel[4 * g + k], a = aff[4 * g + k];
                if (s > s1) { s2 = s1; i2 = i1; a2 = a1; s1 = s; i1 = 4 * g + k; a1 = a; } else if (s > s2) { s2 = s; i2 = 4 * g + k; a2 = a; } } }
        const float wsum = a1 + a2, w1 = a1 / wsum, w2 = a2 / wsum;
        if (F.lane == 0) { const unsigned l1 = atomicAdd(&lcnt[i1], 1u), l2 = atomicAdd(&lcnt[i2], 1u);
            rec[lr * 6 + 0] = i1; rec[lr * 6 + 1] = i2; rec[lr * 6 + 2] = (int)l1; rec[lr * 6 + 3] = (int)l2; rec[lr * 6 + 4] = __float_as_int(w1); rec[lr * 6 + 5] = __float_as_int(w2); }
#pragma unroll
        for (int j = 0; j < 4; ++j) { v[j] = vn[j]; y[j] = yn[j]; }
    }
#undef LNR_LOAD
    __syncthreads();
    if (F.tid < 16) lbase[F.tid] = __hip_atomic_fetch_add(&CNT[F.tid], lcnt[F.tid], __ATOMIC_RELAXED, __HIP_MEMORY_SCOPE_AGENT);
    __syncthreads();
    for (int lr = F.tid; lr < row_hi - row_lo; lr += NTHR) { const int tok = row_lo + lr;
        const int e0 = rec[lr * 6], e1 = rec[lr * 6 + 1]; const int p0 = (int)lbase[e0] + rec[lr * 6 + 2], p1 = (int)lbase[e1] + rec[lr * 6 + 3];
        LIST[e0 * NTOK + p0] = tok; LIST[e1 * NTOK + p1] = tok;
        int* tr = TOKR + (size_t)tok * 8; tr[0] = e0; tr[1] = p0; tr[2] = e1; tr[3] = p1; tr[4] = rec[lr * 6 + 4]; tr[5] = rec[lr * 6 + 5]; }
    __syncthreads();
}

__device__ __forceinline__ void pad_bases(const unsigned* cnt, int (&pb)[17]) {
    int acc = 0;
#pragma unroll
    for (int e = 0; e < 16; ++e) { pb[e] = acc; const int c = (int)__hip_atomic_load(cnt + e, __ATOMIC_RELAXED, __HIP_MEMORY_SCOPE_AGENT); acc += (c + 255) & ~255; }
    pb[16] = acc;
}

__device__ __forceinline__ void phase_moe_combine(const Frame& F, const Prm& p, int layer) {
    const int nrows = layer ? NLAT : NTOK;
    const float* MOD = (const float*)(p.ws + WS_MOD) + layer * 9 * 6144; const float* MOD1 = (const float*)(p.ws + WS_MOD) + 9 * 6144;
    const unsigned char* YM = p.ws + WS_YM;   unsigned char* H = p.ws + WS_H;   bf16* XB = (bf16*)(p.ws + WS_XB); const int* TOKR = (const int*)(p.ws + WS_TOKR);
    int pb[17]; pad_bases(F.ctl + CW_CNT + layer * 16, pb);
    int* pbl = (int*)F.lds; if (F.tid < 17) { int v = 0;
#pragma unroll
        for (int e = 0; e < 17; ++e) if (e == F.tid) v = pb[e];
        pbl[F.tid] = v; }
    __syncthreads();
    const float* lng = p.ln_g + (layer * 2 + 1) * DM; const float* lnb = p.ln_b + (layer * 2 + 1) * DM;
    const int gw = F.bid * NWAVES + F.wave, NGW = F.G * NWAVES, per = (nrows + NGW - 1) / NGW;
    int curmod = -1; f32x4 gf[4], sh1[4], sc1[4];
    typedef int i32x4r __attribute__((ext_vector_type(4)));
    const int t0 = gw * per, t1 = min(nrows, (gw + 1) * per);
    i32x4r ra = {0, 0, 0, 0}, rb = {0, 0, 0, 0}, rc = {0, 0, 0, 0}; f32x2 wa = {0.f, 0.f}, wb = {0.f, 0.f}, wc = {0.f, 0.f};
#define MC_REC(tok_, R, W) do { const int* tr_ = TOKR + (size_t)(tok_) * 8; R = *(const i32x4r*)tr_; W = *(const f32x2*)(tr_ + 4); } while (0)
#define MC_ROWS(tok_, R, V, A, B) do { ld_row_bf16(XB + (size_t)(tok_) * DM, F.lane, V); ld_row_fp8(YM + (size_t)(pbl[R.x] + R.y) * DM, F.lane, A); ld_row_fp8(YM + (size_t)(pbl[R.z] + R.w) * DM, F.lane, B); } while (0)
    f32x4 v[4], a[4], b[4], vn[4], an[4], bn[4];
    if (t0 < t1) { MC_REC(t0, ra, wa); if (t0 + 1 < t1) MC_REC(t0 + 1, rb, wb); MC_ROWS(t0, ra, v, a, b); }
    for (int tok = t0; tok < t1; ++tok) {
        if (tok + 1 < t1) MC_ROWS(tok + 1, rb, vn, an, bn);
        if (tok + 2 < t1) MC_REC(tok + 2, rc, wc);
        const int mr = tok < NLAT ? tok / SEQ : 8;
        if (mr != curmod) { curmod = mr; ld_row_f32(MOD + mr * 6144 + 5120, F.lane, gf); if (!layer) { ld_row_f32(MOD1 + mr * 6144, F.lane, sh1); ld_row_f32(MOD1 + mr * 6144 + 1024, F.lane, sc1); } }
        const float w0 = wa.x, w1 = wa.y;
        bf16* xp = XB + (size_t)tok * DM;
#pragma unroll
        for (int j = 0; j < 4; ++j) v[j] = ALPHA * v[j] + gf[j] * (w0 * a[j] + w1 * b[j]);
        ln_row(v, lng, lnb, F.lane);
        if (layer) st_row_f32(p.out + (size_t)tok * DM, F.lane, v); else st_row_bf16(xp, F.lane, v);
        if (!layer) {
#pragma unroll
            for (int j = 0; j < 4; ++j) v[j] = v[j] * (1.f + sc1[j]) + sh1[j];
            st_row_fp8(H + (size_t)tok * DM, F.lane, v);
        }
#pragma unroll
        for (int j = 0; j < 4; ++j) { v[j] = vn[j]; a[j] = an[j]; b[j] = bn[j]; }
        ra = rb; wa = wb; rb = rc; wb = wc;
    }
#undef MC_REC
#undef MC_ROWS
}

__device__ __forceinline__ void phase_gla_prep(const Frame& F, const Prm& p) {
    typedef short bf16x8v __attribute__((ext_vector_type(8))); typedef float f32x16v __attribute__((ext_vector_type(16)));
    const bf16* QR = (const bf16*)(p.ws + WS_QR); const bf16* KR = (const bf16*)(p.ws + WS_KR); const float* ZZ = (const float*)(p.ws + WS_ZZ);
    bf16* QT = (bf16*)(p.ws + WS_QT); bf16* KT = (bf16*)(p.ws + WS_KT); float* DEC = (float*)(p.ws + WS_DEC);
    const int gw = F.bid * NWAVES + F.wave, NGW = F.G * NWAVES, r = F.lane & 31, hh = F.lane >> 5;
    for (int task = gw; task < 2 * NCHUNK * 8; task += NGW) {
        const int dh = task & 7, chunk = (task >> 3) % NCHUNK, dir = __builtin_amdgcn_readfirstlane(task / (8 * NCHUNK));
        const int tok0 = chunk * 64;
        bf16x8v af[2], bfr[2];
#pragma unroll
        for (int tb = 0; tb < 2; ++tb) { const float* zp = ZZ + (size_t)(tok0 + 32 * tb + r) * 32 + dir * 16 + 8 * hh; const f32x4 z0 = *(const f32x4*)zp, z1 = *(const f32x4*)(zp + 4);
            u32x4 w; w.x = pk2(z0.x, z0.y); w.y = pk2(z0.z, z0.w); w.z = pk2(z1.x, z1.y); w.w = pk2(z1.z, z1.w); af[tb] = __builtin_bit_cast(bf16x8v, w); }
        float bgv[2];
#pragma unroll
        for (int cb = 0; cb < 2; ++cb) { const float* wp = p.gwg_up + (size_t)dir * 16 * 512 + (size_t)(8 * hh) * 512 + dh * 64 + 2 * r + cb; float wv[8];
#pragma unroll
            for (int i = 0; i < 8; ++i) wv[i] = wp[(size_t)i * 512];
            u32x4 w; w.x = pk2(wv[0], wv[1]); w.y = pk2(wv[2], wv[3]); w.z = pk2(wv[4], wv[5]); w.w = pk2(wv[6], wv[7]); bfr[cb] = __builtin_bit_cast(bf16x8v, w);
            bgv[cb] = p.gbg[dir * 512 + dh * 64 + 2 * r + cb]; }
        f32x16v Z[2][2];
#pragma unroll
        for (int tb = 0; tb < 2; ++tb)
#pragma unroll
            for (int cb = 0; cb < 2; ++cb) { const f32x16v zero = {}; Z[tb][cb] = __builtin_amdgcn_mfma_f32_32x32x16_bf16(af[tb], bfr[cb], zero, 0, 0, 0); }
#pragma unroll
        for (int tb = 0; tb < 2; ++tb)
#pragma unroll
            for (int cb = 0; cb < 2; ++cb)
#pragma unroll
                for (int i = 0; i < 16; ++i) { const float z = Z[tb][cb][i] + bgv[cb]; Z[tb][cb][i] = (fminf(z, 0.f) - __logf(1.f + __expf(-fabsf(z)))) * (1.f / 16.f); }
        float tot[2];
#pragma unroll
        for (int cb = 0; cb < 2; ++cb) {
            float T[2][4], PT[2][4];
            if (!dir) {
#pragma unroll
                for (int tb = 0; tb < 2; ++tb)
#pragma unroll
                    for (int gi = 0; gi < 4; ++gi) { float run = 0.f;
#pragma unroll
                        for (int w = 0; w < 4; ++w) { run += Z[tb][cb][4 * gi + w]; Z[tb][cb][4 * gi + w] = run; }
                        T[tb][gi] = run; }
            } else {
#pragma unroll
                for (int tb = 0; tb < 2; ++tb)
#pragma unroll
                    for (int gi = 0; gi < 4; ++gi) { float run = 0.f;
#pragma unroll
                        for (int w = 3; w >= 0; --w) { run += Z[tb][cb][4 * gi + w]; Z[tb][cb][4 * gi + w] = run; }
                        T[tb][gi] = run; }
            }
#pragma unroll
            for (int tb = 0; tb < 2; ++tb)
#pragma unroll
                for (int gi = 0; gi < 4; ++gi) PT[tb][gi] = __shfl_xor(T[tb][gi], 32);
            float running = 0.f;
            if (!dir) {
#pragma unroll
                for (int tb = 0; tb < 2; ++tb)
#pragma unroll
                    for (int gi = 0; gi < 4; ++gi) { const float first = hh ? PT[tb][gi] : T[tb][gi], second = hh ? T[tb][gi] : PT[tb][gi];
                        const float mine = hh ? running + first : running; running += first + second;
#pragma unroll
                        for (int w = 0; w < 4; ++w) Z[tb][cb][4 * gi + w] += mine; }
            } else {
#pragma unroll
                for (int tb = 1; tb >= 0; --tb)
#pragma unroll
                    for (int gi = 3; gi >= 0; --gi) { const float first = hh ? T[tb][gi] : PT[tb][gi], second = hh ? PT[tb][gi] : T[tb][gi];
                        const float mine = hh ? running : running + first; running += first + second;
#pragma unroll
                        for (int w = 0; w < 4; ++w) Z[tb][cb][4 * gi + w] += mine; }
            }
            tot[cb] = running;
        }
        if (hh == 0) {
#pragma unroll
            for (int cb = 0; cb < 2; ++cb) DEC[((size_t)dir * NCHUNK + chunk) * 512 + dh * 64 + 2 * r + cb] = __expf(tot[cb]);
        }
        const bf16* qi = QR + ((size_t)dh * NTOK + tok0) * 64 + 2 * r; const bf16* ki = KR + ((size_t)dh * NTOK + tok0) * 64 + 2 * r;
        bf16* qo = QT + (((size_t)dir * 8 + dh) * NTOK + tok0) * 64 + 2 * r; bf16* ko = KT + (((size_t)dir * 8 + dh) * NTOK + tok0) * 64 + 2 * r;
#pragma unroll
        for (int tb = 0; tb < 2; ++tb) {
            unsigned qv[16], kv[16];
#pragma unroll
            for (int i = 0; i < 16; ++i) { const int t = 32 * tb + (i & 3) + 8 * (i >> 2) + 4 * hh; qv[i] = *(const unsigned*)(qi + (size_t)t * 64); kv[i] = *(const unsigned*)(ki + (size_t)t * 64); }
#pragma unroll
            for (int i = 0; i < 16; ++i) { const int t = 32 * tb + (i & 3) + 8 * (i >> 2) + 4 * hh;
                const float e0 = __expf(Z[tb][0][i]), e1 = __expf(Z[tb][1][i]), i0 = __builtin_amdgcn_rcpf(e0), i1 = __builtin_amdgcn_rcpf(e1);
                *(unsigned*)(qo + (size_t)t * 64) = pk2(bf2f(qv[i] & 0xffffu) * e0, bf2f(qv[i] >> 16) * e1);
                *(unsigned*)(ko + (size_t)t * 64) = pk2(bf2f(kv[i] & 0xffffu) * i0, bf2f(kv[i] >> 16) * i1); }
        }
    }
}

__device__ __forceinline__ void phase_gla_post(const Frame& F, const Prm& p) {
    const bf16* OF = (const bf16*)p.out; const bf16* OB = (const bf16*)((const unsigned char*)p.out + OUT_OGB); const bf16* R = (const bf16*)(p.ws + WS_R); unsigned char* A2 = p.ws + WS_A2B;
    const f32x4 ng = *(const f32x4*)(p.gnorm + 4 * F.lane);
    const int gw = F.bid * NWAVES + F.wave, NGW = F.G * NWAVES;
    f32x4 a[4], b[4], r[4], an[4], bn[4], rn[4];
    if (gw < NLAT) { ld_row_bf16(OF + (size_t)gw * DM, F.lane, a); ld_row_bf16(OB + (size_t)gw * DM, F.lane, b); ld_row_bf16(R + (size_t)gw * DM, F.lane, r); }
    for (int tok = gw; tok < NLAT; tok += NGW) {
        if (tok + NGW < NLAT) { ld_row_bf16(OF + (size_t)(tok + NGW) * DM, F.lane, an); ld_row_bf16(OB + (size_t)(tok + NGW) * DM, F.lane, bn); ld_row_bf16(R + (size_t)(tok + NGW) * DM, F.lane, rn); }
#pragma unroll
        for (int j = 0; j < 4; ++j) {
            const f32x4 o = a[j] + b[j]; const float q = wave_sum((o.x * o.x + o.y * o.y) + (o.z * o.z + o.w * o.w));
            const float rs = 1.f / sqrtf(q * (1.f / 256.f) + LN_EPS);
            a[j] = (f32x4){o.x * rs * ng.x * silu_f(r[j].x), o.y * rs * ng.y * silu_f(r[j].y), o.z * rs * ng.z * silu_f(r[j].z), o.w * rs * ng.w * silu_f(r[j].w)};
        }
        st_row_fp8(A2 + (size_t)tok * DM, F.lane, a);
#pragma unroll
        for (int j = 0; j < 4; ++j) { a[j] = an[j]; b[j] = bn[j]; r[j] = rn[j]; }
    }
}
namespace pg8 {
typedef short bf16x8 __attribute__((ext_vector_type(8)));
constexpr int BM = 256, BK = 64, HALF = 128, HTB = HALF * BK * 2, STAGE_BYTES = 8 * HTB, NXCD = 8, WGM = 8;
__host__ __device__ __forceinline__ int lds_byte(int r, int c) { const int st = (r >> 4) * 2 + (c >> 5), rr = r & 15, cc = c & 31, ob = rr * 64 + cc * 2; return st * 1024 + (ob ^ (((ob >> 9) & 1) << 5)); }
__host__ __device__ __forceinline__ void stage_rc(int b, int& R, int& C) { const int st = b / 1024, sb = b % 1024, swz = sb ^ (((sb >> 9) & 1) << 5); R = (st >> 1) * 16 + swz / 64; C = (st & 1) * 32 + (swz % 64) / 2; }
typedef float f32x2_t __attribute__((ext_vector_type(2))); typedef __bf16 bf16x2_t __attribute__((ext_vector_type(2)));
__device__ __forceinline__ unsigned cvt_pk_bf16(float lo, float hi) { f32x2_t v = {lo, hi}; bf16x2_t b = __builtin_convertvector(v, bf16x2_t); return __builtin_bit_cast(unsigned, b); }

struct Unit { int pm, pn; int row0; int e; int cnt; const bf16* Bt; };

struct DenseOrder {
    int nM, nN, nwg, G, c, K; const bf16* Bt;
    __device__ void init(int M, int N, int K_, const bf16* Bt_, int G_, int c_) { nM = M / BM; nN = N / BM; nwg = nM * nN; G = G_; c = c_; K = K_; Bt = Bt_; }
    __device__ bool next(int i, Unit& u) const {
        const long L = (long)i * G + c; if (L >= nwg) return false;
        int wgid = (int)L; { const int q = nwg / NXCD, r = nwg % NXCD, xcd = wgid % NXCD, off = wgid / NXCD; wgid = (xcd < r ? xcd * (q + 1) : r * (q + 1) + (xcd - r) * q) + off; }
        const int nig = WGM * nN, gid = wgid / nig, fm = gid * WGM, gsz = (nM - fm) < WGM ? (nM - fm) : WGM;
        u.pm = fm + ((wgid % nig) % gsz); u.pn = (wgid % nig) / gsz; u.row0 = u.pm * BM; u.e = 0; u.cnt = 0; u.Bt = Bt; return true;
    }
    __device__ __forceinline__ unsigned arow(const Unit& u, int r) const { return (unsigned)(u.row0 + r) * (unsigned)(K * 2); }
};
template <bool GATHER> struct MoeOrder {
    int cnt[16]; int nN, G, c, K; const bf16* Bt0; size_t bstride; const int* LIST;
    __device__ void init(const unsigned* cntw, int N, int K_, const bf16* Bt0_, const int* LIST_, int G_, int c_) {
#pragma unroll
        for (int e = 0; e < 16; ++e) cnt[e] = (int)__hip_atomic_load(cntw + e, __ATOMIC_RELAXED, __HIP_MEMORY_SCOPE_AGENT);
        nN = N / BM; G = G_; c = c_; K = K_; Bt0 = Bt0_; bstride = (size_t)N * K_; LIST = LIST_; }
    __device__ bool next(int i, Unit& u) const {
        int L = i * G + c, base = 0; bool found = false; u.pm = 0; u.pn = 0; u.row0 = 0; u.e = 0; u.cnt = 0; u.Bt = Bt0;
#pragma unroll
        for (int e = 0; e < 16; ++e) { const int mt = (cnt[e] + 255) >> 8, nu = mt * nN;
            if (!found) { if (L < nu) { found = true; u.e = e; u.cnt = cnt[e]; u.pm = L / nN; u.pn = L % nN; u.row0 = base + u.pm * BM; u.Bt = Bt0 + (size_t)e * bstride; } else { L -= nu; base += mt * BM; } } }
        return found;
    }
    __device__ __forceinline__ unsigned arow(const Unit& u, int r) const {
        if (GATHER) { const int li = u.pm * BM + r; int tok = 0; if (li < u.cnt) tok = LIST[u.e * NTOK + li];
            return (unsigned)tok * (unsigned)(K * 2); }
        return (unsigned)(u.row0 + r) * (unsigned)(K * 2);
    }
};

typedef f32x4 Acc[2][2][4][2];
__device__ __forceinline__ void st4bf(bf16* p, f32x4 v) { u32x2 w; w.x = cvt_pk_bf16(v.x, v.y); w.y = cvt_pk_bf16(v.z, v.w); *(u32x2*)p = w; }
__device__ __forceinline__ void st8bf(bf16* p, f32x4 a, f32x4 b) { u32x4 w; w.x = cvt_pk_bf16(a.x, a.y); w.y = cvt_pk_bf16(a.z, a.w); w.z = cvt_pk_bf16(b.x, b.y); w.w = cvt_pk_bf16(b.z, b.w); *(u32x4*)p = w; }

struct EpiQKV {
    bf16 *Q; const LAS float* rope; float wsc; unsigned* km;
    __device__ __forceinline__ void operator()(const Acc& acc, const Unit& u, int wr, int wc, int fr, int fq) const {
        const int reg = u.pn >> 2; bf16* O = Q + (size_t)reg * ((WS_K - WS_Q) / 2);
        if (reg == 2) { const int cbase = (u.pn & 3) * BM + wc * 32 + 8 * fq;
#pragma unroll
            for (int ai = 0; ai < 2; ++ai)
#pragma unroll
                for (int m = 0; m < 4; ++m) { bf16* rowp = O + (size_t)(u.row0 + ai * HALF + wr * 64 + m * 16 + fr) * DM + cbase;
#pragma unroll
                    for (int bj = 0; bj < 2; ++bj) st8bf(rowp + bj * HALF, acc[ai][bj][m][0] * wsc, acc[ai][bj][m][1] * wsc); }
            return; }
        const int cbase = (u.pn & 3) * BM + wc * 32 + 4 * fq;
        const bool dorope = (u.row0 < NLAT); const float sc = (reg == 0 ? C2 : 1.f) * wsc; float kn[2] = {0.f, 0.f};
#pragma unroll
        for (int ai = 0; ai < 2; ++ai)
#pragma unroll
            for (int m = 0; m < 4; ++m) { const int row = u.row0 + ai * HALF + wr * 64 + m * 16 + fr; bf16* rowp = O + (size_t)row * DM + cbase;
                f32x4 cs = {1.f, 1.f, 1.f, 1.f}, sn = {0.f, 0.f, 0.f, 0.f};
                if (dorope) { const int s = row & (SEQ - 1), pos = (wc & 1) ? (s & 63) : (s >> 6); const f32x4 t0 = *(const LAS f32x4*)(rope + (pos * 16 + 4 * fq) * 2), t1 = *(const LAS f32x4*)(rope + (pos * 16 + 4 * fq) * 2 + 4);
                    cs = (f32x4){t0.x, t0.z, t1.x, t1.z}; sn = (f32x4){t0.y, t0.w, t1.y, t1.w}; }
                { f32x4 c2 = cs, s2 = sn;
#pragma unroll
                  for (int j = 0; j < 4; ++j) { float x0 = c2[j] * sc, x1 = s2[j] * sc; asm("" : "+v"(x0)); asm("" : "+v"(x1)); cs[j] = x0; sn[j] = x1; } }
#pragma unroll
                for (int bj = 0; bj < 2; ++bj) { const f32x4 a0 = acc[ai][bj][m][0], a1 = acc[ai][bj][m][1];
                    f32x4 o0, o1;
#pragma unroll
                    for (int j = 0; j < 4; ++j) { float x0 = __builtin_fmaf(-a1[j], sn[j], a0[j] * cs[j]), x1 = __builtin_fmaf(a0[j], sn[j], a1[j] * cs[j]); asm("" : "+v"(x0)); asm("" : "+v"(x1)); o0[j] = x0; o1[j] = x1; }
                    st4bf(rowp + bj * HALF, o0); st4bf(rowp + bj * HALF + 16, o1);
                    if (reg == 1) { const float ps = (o0.x * o0.x + o0.y * o0.y) + (o0.z * o0.z + o0.w * o0.w) + (o1.x * o1.x + o1.y * o1.y) + (o1.z * o1.z + o1.w * o1.w);
                        kn[bj] = fmaxf(kn[bj], ps); } } }
        if (reg == 1) {
            const int b = u.row0 < NLAT ? u.row0 / SEQ : (u.row0 - NLAT) / CTXL;
#pragma unroll
            for (int bj = 0; bj < 2; ++bj) { float v = kn[bj];
#pragma unroll
                for (int s = 1; s < 64; s <<= 1) v = fmaxf(v, __shfl_xor(v, s));
                if (fr == 0 && fq == 0) __hip_atomic_fetch_max(km + b * 16 + 4 * (u.pn & 3) + 2 * bj + (wc >> 1), __float_as_uint(8.f * v), __ATOMIC_RELAXED, __HIP_MEMORY_SCOPE_AGENT); } }
    }
};
struct EpiPlain {
    bf16* O; float sc;
    __device__ __forceinline__ void operator()(const Acc& acc, const Unit& u, int wr, int wc, int fr, int fq) const {
        const int cbase = u.pn * BM + wc * 32 + 8 * fq;
#pragma unroll
        for (int ai = 0; ai < 2; ++ai)
#pragma unroll
            for (int m = 0; m < 4; ++m) { bf16* rowp = O + (size_t)(u.row0 + ai * HALF + wr * 64 + m * 16 + fr) * DM + cbase;
#pragma unroll
                for (int bj = 0; bj < 2; ++bj) st8bf(rowp + bj * HALF, acc[ai][bj][m][0] * sc, acc[ai][bj][m][1] * sc); }
    }
};
struct EpiPlain8 {
    unsigned char* O; float sc;
    __device__ __forceinline__ void operator()(const Acc& acc, const Unit& u, int wr, int wc, int fr, int fq) const {
        const int cbase = u.pn * BM + wc * 32 + 8 * fq;
#pragma unroll
        for (int ai = 0; ai < 2; ++ai)
#pragma unroll
            for (int m = 0; m < 4; ++m) { unsigned char* rowp = O + (size_t)(u.row0 + ai * HALF + wr * 64 + m * 16 + fr) * DM + cbase;
#pragma unroll
                for (int bj = 0; bj < 2; ++bj) { const f32x4 a = acc[ai][bj][m][0] * sc, b = acc[ai][bj][m][1] * sc; u32x2 w; w.x = pk4_fp8(a.x, a.y, a.z, a.w); w.y = pk4_fp8(b.x, b.y, b.z, b.w); *(u32x2*)(rowp + bj * HALF) = w; } }
    }
};
struct EpiInproj {
    bf16 *QR, *KR, *V, *R; float* ZZ; float wsc;
    __device__ __forceinline__ void operator()(const Acc& acc, const Unit& u, int wr, int wc, int fr, int fq) const {
        const int pn = u.pn;
        if (pn == 12) { if (wc == 0) {
#pragma unroll
            for (int ai = 0; ai < 2; ++ai)
#pragma unroll
                for (int m = 0; m < 4; ++m) { float* rowp = ZZ + (size_t)(u.row0 + ai * HALF + wr * 64 + m * 16 + fr) * 32 + 4 * fq;
                    *(f32x4*)rowp = acc[ai][0][m][0] * wsc; *(f32x4*)(rowp + 16) = acc[ai][0][m][1] * wsc; } }
            return; }
        float sc = wsc;
        if (pn < 4) {
            bf16* O = pn < 2 ? QR : KR; if (pn < 2) sc = 0.08838834764831845f * wsc;
            const int cb = (pn & 1) * BM + wc * 32 + 8 * fq;
#pragma unroll
            for (int ai = 0; ai < 2; ++ai)
#pragma unroll
                for (int m = 0; m < 4; ++m) { const size_t row = (size_t)(u.row0 + ai * HALF + wr * 64 + m * 16 + fr);
#pragma unroll
                    for (int bj = 0; bj < 2; ++bj) { const int col = cb + bj * HALF; st8bf(O + ((size_t)(col >> 6) * NTOK + row) * 64 + (col & 63), acc[ai][bj][m][0] * sc, acc[ai][bj][m][1] * sc); } }
            return; }
        bf16* O; int c0;
        if (pn < 8) { O = V; c0 = (pn - 4) * BM; } else { O = R; c0 = (pn - 8) * BM; }
        const int cbase = c0 + wc * 32 + 8 * fq;
#pragma unroll
        for (int ai = 0; ai < 2; ++ai)
#pragma unroll
            for (int m = 0; m < 4; ++m) { bf16* rowp = O + (size_t)(u.row0 + ai * HALF + wr * 64 + m * 16 + fr) * DM + cbase;
#pragma unroll
                for (int bj = 0; bj < 2; ++bj) st8bf(rowp + bj * HALF, acc[ai][bj][m][0] * sc, acc[ai][bj][m][1] * sc); }
    }
};
struct EpiGateUp {
    unsigned char* ACT;
    __device__ __forceinline__ void operator()(const Acc& acc, const Unit& u, int wr, int wc, int fr, int fq) const {
        const int obase = (u.pn * BM + wc * 32) / 2 + 4 * fq;
#pragma unroll
        for (int ai = 0; ai < 2; ++ai)
#pragma unroll
            for (int m = 0; m < 4; ++m) { unsigned char* rowp = ACT + (size_t)(u.row0 + ai * HALF + wr * 64 + m * 16 + fr) * DEXP + obase;
#pragma unroll
                for (int bj = 0; bj < 2; ++bj) { const f32x4 g = acc[ai][bj][m][0], up = acc[ai][bj][m][1]; f32x4 o;
#pragma unroll
                    for (int j = 0; j < 4; ++j) o[j] = g[j] * __builtin_amdgcn_rcpf(1.f + __expf(-g[j])) * up[j];
                    *(unsigned*)(rowp + bj * (HALF / 2)) = pk4_fp8(o[0], o[1], o[2], o[3]); } }
    }
};

typedef int i32x8 __attribute__((ext_vector_type(8)));
typedef int i32x4 __attribute__((ext_vector_type(4)));
__device__ __forceinline__ i32x8 cat8(bf16x8 lo, bf16x8 hi) { return __builtin_shufflevector(__builtin_bit_cast(i32x4, lo), __builtin_bit_cast(i32x4, hi), 0, 1, 2, 3, 4, 5, 6, 7); }
template <class Epi, class Sched, bool FP8 = false>
__device__ __forceinline__ void gemm_phase(unsigned char* ldsg, const bf16* A, int K, const Sched& S, const Epi& E, int tid_in) {
    LAS unsigned char* lds = (LAS unsigned char*)ldsg;
    const int tid = tid_in, wid = __builtin_amdgcn_readfirstlane(tid >> 6), lane = tid & 63, wr = wid >> 2, wc = wid & 3, fr = lane & 15, fq = lane >> 4;
    const int nt = K / BK;
    int Rr[2]; unsigned colb[2], voffB[2];
#pragma unroll
    for (int i = 0; i < 2; ++i) { int R, C; stage_rc(tid * 16 + i * 8192, R, C); Rr[i] = R; colb[i] = (unsigned)C * 2u; voffB[i] = (unsigned)(R * K + C) * 2u; }
    const size_t kstep = (size_t)(BK * 2);
    const size_t hstep = (size_t)HALF * K * 2;
    const size_t tstep = 2 * hstep;
    const unsigned ldsw = (unsigned)wid * 1024u;
    const int aoff = lds_byte(wr * 64 + fr, fq * 8), boff = lds_byte(wc * 32 + fr, fq * 8);
#define PG8_SA(b, h) (((b) * 2 + (h)) * HTB)
#define PG8_SB(b, h) ((4 + (b) * 2 + (h)) * HTB)
#define PG8_STAGE(bufoff, gbase, voff) do { _Pragma("unroll") for (int _i = 0; _i < 2; ++_i) \
        __builtin_amdgcn_global_load_lds((const unsigned*)((const char*)(gbase) + (voff)[_i]), (LAS unsigned*)(lds + (bufoff) + ldsw + _i * 8192), 16, 0, 0); } while (0)
#define PG8_LDA(dst, b, h) do { if constexpr (FP8) { _Pragma("unroll") for (int m = 0; m < 4; ++m) dst##8[m] = cat8(*(const LAS bf16x8*)(lds + PG8_SA(b, h) + aoff + m * 2048), *(const LAS bf16x8*)(lds + PG8_SA(b, h) + aoff + m * 2048 + 1024)); } \
        else { _Pragma("unroll") for (int m = 0; m < 4; ++m) _Pragma("unroll") for (int k = 0; k < 2; ++k) dst[m][k] = *(const LAS bf16x8*)(lds + PG8_SA(b, h) + aoff + m * 2048 + k * 1024); } } while (0)
#define PG8_LDB(dst, b, h) do { if constexpr (FP8) { _Pragma("unroll") for (int n = 0; n < 2; ++n) dst##8[n] = cat8(*(const LAS bf16x8*)(lds + PG8_SB(b, h) + boff + n * 2048), *(const LAS bf16x8*)(lds + PG8_SB(b, h) + boff + n * 2048 + 1024)); } \
        else { _Pragma("unroll") for (int n = 0; n < 2; ++n) _Pragma("unroll") for (int k = 0; k < 2; ++k) dst[n][k] = *(const LAS bf16x8*)(lds + PG8_SB(b, h) + boff + n * 2048 + k * 1024); } } while (0)
#define PG8_MMA(ai, bj, At, Bt) do { __builtin_amdgcn_s_setprio(1); \
        if constexpr (FP8) { _Pragma("unroll") for (int m = 0; m < 4; ++m) _Pragma("unroll") for (int n = 0; n < 2; ++n) \
            asm volatile("v_mfma_scale_f32_16x16x128_f8f6f4 %0, %1, %2, %0, %3, %3 op_sel:[0,1,0] op_sel_hi:[0,0,0]" : "+v"(acc[ai][bj][m][n]) : "v"(Bt##8[n]), "v"(At##8[m]), "v"(sc8)); } \
        else { _Pragma("unroll") for (int m = 0; m < 4; ++m) _Pragma("unroll") for (int n = 0; n < 2; ++n) _Pragma("unroll") for (int k = 0; k < 2; ++k) \
            acc[ai][bj][m][n] = __builtin_amdgcn_mfma_f32_16x16x32_bf16(Bt[n][k], At[m][k], acc[ai][bj][m][n], 0, 0, 0); } \
        __builtin_amdgcn_s_setprio(0); } while (0)
#define PG8_WAIT_V(n) asm volatile("s_waitcnt vmcnt(" #n ")" ::: "memory")
#define PG8_WAIT_L(n) asm volatile("s_waitcnt lgkmcnt(" #n ")" ::: "memory")
#define PG8_BAR __builtin_amdgcn_s_barrier()
#define PG8_SCHED __builtin_amdgcn_sched_barrier(0)
    Unit cur, nxt; int ui = 0;
    if (!S.next(0, cur)) return;
    Acc acc;
#pragma unroll
    for (int a = 0; a < 2; ++a)
#pragma unroll
        for (int b = 0; b < 2; ++b)
#pragma unroll
            for (int m = 0; m < 4; ++m)
#pragma unroll
                for (int n = 0; n < 2; ++n) acc[a][b][m][n] = (f32x4){0.f, 0.f, 0.f, 0.f};
    const int sc8 = 0x7f7f7f79;
    bf16x8 At[4][2], B0[2][2], B1[2][2]; i32x8 At8[4], B08[2], B18[2];
    unsigned aC0[2], aC1[2], aN0[2], aN1[2];
#pragma unroll
    for (int i = 0; i < 2; ++i) { aC0[i] = S.arow(cur, Rr[i]) + colb[i]; aC1[i] = S.arow(cur, HALF + Rr[i]) + colb[i]; }
    const char* Ab = (const char*)A;
    const char* cB = (const char*)cur.Bt + (size_t)cur.pn * tstep;
    PG8_STAGE(PG8_SB(0, 0), cB, voffB); PG8_STAGE(PG8_SB(0, 1), cB + hstep, voffB); PG8_STAGE(PG8_SA(0, 0), Ab, aC0); PG8_STAGE(PG8_SA(0, 1), Ab, aC1);
    if (wr == 1) PG8_BAR;
    PG8_WAIT_V(2); PG8_BAR;
    PG8_STAGE(PG8_SB(1, 0), cB + kstep, voffB); PG8_STAGE(PG8_SA(1, 0), Ab + kstep, aC0); PG8_STAGE(PG8_SB(1, 1), cB + hstep + kstep, voffB);
    PG8_WAIT_V(6); PG8_BAR;
    for (;;) {
        const bool has_next = S.next(ui + 1, nxt);
        if (has_next) {
#pragma unroll
            for (int i = 0; i < 2; ++i) { aN0[i] = S.arow(nxt, Rr[i]) + colb[i]; aN1[i] = S.arow(nxt, HALF + Rr[i]) + colb[i]; }
        } else {
#pragma unroll
            for (int i = 0; i < 2; ++i) { aN0[i] = aC0[i]; aN1[i] = aC1[i]; }
        }
        const char* nB = has_next ? (const char*)nxt.Bt + (size_t)nxt.pn * tstep : cB;
        for (int t = 0; t < nt; t += 2) {
            const bool last = (t == nt - 2);
            const char* a1 = Ab + (size_t)(t + 1) * kstep;
            const char* a2 = last ? Ab : Ab + (size_t)(t + 2) * kstep; const char* b2 = last ? nB : cB + (size_t)(t + 2) * kstep;
            const char* a3 = a2 + kstep; const char* b3 = b2 + kstep;
            unsigned x0[2], x1[2];
#pragma unroll
            for (int i = 0; i < 2; ++i) { x0[i] = last ? aN0[i] : aC0[i]; x1[i] = last ? aN1[i] : aC1[i]; }
            PG8_LDB(B0, 0, 0); PG8_LDB(B1, 0, 1); PG8_SCHED; PG8_LDA(At, 0, 0); PG8_STAGE(PG8_SA(1, 1), a1, aC1);
            PG8_WAIT_V(8); PG8_WAIT_L(0); PG8_BAR; PG8_MMA(0, 0, At, B0); PG8_MMA(0, 1, At, B1); PG8_BAR; PG8_SCHED;
            PG8_LDA(At, 0, 1); PG8_STAGE(PG8_SB(0, 0), b2, voffB); PG8_STAGE(PG8_SB(0, 1), b2 + hstep, voffB); PG8_STAGE(PG8_SA(0, 0), a2, x0);
            PG8_WAIT_V(8); PG8_WAIT_L(0); PG8_BAR; PG8_MMA(1, 0, At, B0); PG8_MMA(1, 1, At, B1); PG8_BAR; PG8_SCHED;
            PG8_LDB(B0, 1, 0); PG8_LDB(B1, 1, 1); PG8_SCHED; PG8_LDA(At, 1, 0); PG8_STAGE(PG8_SA(0, 1), a2, x1);
            PG8_WAIT_V(8); PG8_WAIT_L(0); PG8_BAR; PG8_MMA(0, 0, At, B0); PG8_MMA(0, 1, At, B1); PG8_BAR; PG8_SCHED;
            PG8_LDA(At, 1, 1); PG8_STAGE(PG8_SB(1, 0), b3, voffB); PG8_STAGE(PG8_SB(1, 1), b3 + hstep, voffB); PG8_STAGE(PG8_SA(1, 0), a3, x0);
            PG8_WAIT_V(8); PG8_WAIT_L(0); PG8_BAR; PG8_MMA(1, 0, At, B0); PG8_MMA(1, 1, At, B1); PG8_BAR; PG8_SCHED;
        }
        if (wr == 0) PG8_BAR;
        if constexpr (FP8) asm volatile("s_nop 15\n\ts_nop 7" ::: "memory");
        E(acc, cur, wr, wc, fr, fq);
        if (!has_next) break;
#pragma unroll
        for (int a = 0; a < 2; ++a)
#pragma unroll
            for (int b = 0; b < 2; ++b)
#pragma unroll
                for (int m = 0; m < 4; ++m)
#pragma unroll
                    for (int n = 0; n < 2; ++n) acc[a][b][m][n] = (f32x4){0.f, 0.f, 0.f, 0.f};
        cur = nxt; cB = nB; ++ui;
#pragma unroll
        for (int i = 0; i < 2; ++i) { aC0[i] = aN0[i]; aC1[i] = aN1[i]; }
        if (wr == 1) PG8_BAR;
    }
    PG8_WAIT_V(0);
    PG8_BAR;
#undef PG8_SA
#undef PG8_SB
#undef PG8_STAGE
#undef PG8_LDA
#undef PG8_LDB
#undef PG8_MMA
#undef PG8_WAIT_V
#undef PG8_WAIT_L
#undef PG8_BAR
#undef PG8_SCHED
}
}

__device__ __forceinline__ int vcu_of(const Frame& F) { return (F.G % 8 == 0) ? (F.bid % 8) * (F.G / 8) + F.bid / 8 : F.bid; }
__device__ __forceinline__ void phase_qkv_opt(const Frame& F, const Prm& p) {
    pg8::DenseOrder S; S.init(NTOK, 3072, 512, (const bf16*)(p.ws + WS_WQKV), F.G, F.bid);
    static_assert(WS_V - WS_K == WS_K - WS_Q, "Q|K|V equally spaced");
    LAS float* ropel = (LAS float*)((LAS unsigned char*)F.lds + LDSX_OFF);
    const float* ropeg = (const float*)(p.ws + WS_MISC) + 1024;
    for (int i = F.tid; i < 2048; i += NTHR) ropel[i] = ropeg[i];
    __syncthreads();
    pg8::EpiQKV E{(bf16*)(p.ws + WS_Q), ropel, 1.f, F.ctl + CW_KM};
    pg8::gemm_phase<pg8::EpiQKV, pg8::DenseOrder, true>(F.lds, (const bf16*)(p.ws + WS_H), 512, S, E, F.tid);
}
__device__ __forceinline__ void phase_wo_opt(const Frame& F, const Prm& p, int layer) {
    if (layer) {
        pg8::DenseOrder S; S.init(NLAT, 1024, 512, (const bf16*)(p.ws + WS_WGO), F.G, F.bid);
        pg8::EpiPlain E{(bf16*)(p.ws + WS_Y), 1.f};
        pg8::gemm_phase<pg8::EpiPlain, pg8::DenseOrder, true>(F.lds, (const bf16*)(p.ws + WS_A2B), 512, S, E, F.tid);
    } else {
        pg8::DenseOrder S; S.init(NTOK, 1024, 512, (const bf16*)(p.ws + WS_WO), F.G, F.bid);
        pg8::EpiPlain E{(bf16*)(p.ws + WS_Y), 1.f};
        pg8::gemm_phase<pg8::EpiPlain, pg8::DenseOrder, true>(F.lds, (const bf16*)(p.ws + WS_A2), 512, S, E, F.tid);
    }
}
__device__ __forceinline__ void phase_inproj_opt(const Frame& F, const Prm& p) {
    pg8::DenseOrder S; S.init(NTOK, NIN, 512, (const bf16*)(p.ws + WS_WIN), F.G, F.bid);
    pg8::EpiInproj E{(bf16*)(p.ws + WS_QR), (bf16*)(p.ws + WS_KR), (bf16*)(p.ws + WS_V1), (bf16*)(p.ws + WS_R), (float*)(p.ws + WS_ZZ), 1.f};
    pg8::gemm_phase<pg8::EpiInproj, pg8::DenseOrder, true>(F.lds, (const bf16*)(p.ws + WS_H), 512, S, E, F.tid);
}
__device__ __forceinline__ void phase_moe1_opt(const Frame& F, const Prm& p, int layer) {
    pg8::MoeOrder<true> S; S.init(F.ctl + CW_CNT + layer * 16, 1024, 512, (const bf16*)(p.ws + (layer ? WS_GU1 : WS_GU0)), (const int*)(p.ws + WS_LIST), F.G, vcu_of(F));
    pg8::EpiGateUp E{p.ws + WS_ACT};
    pg8::gemm_phase<pg8::EpiGateUp, pg8::MoeOrder<true>, true>(F.lds, (const bf16*)(p.ws + WS_H), 512, S, E, F.tid);
}
__device__ __forceinline__ void phase_moe2_opt(const Frame& F, const Prm& p, int layer) {
    pg8::MoeOrder<false> S; S.init(F.ctl + CW_CNT + layer * 16, 1024, 256, (const bf16*)(p.ws + (layer ? WS_DN1 : WS_DN0)), nullptr, F.G, vcu_of(F));
    pg8::EpiPlain8 E{p.ws + WS_YM, 1.f};
    pg8::gemm_phase<pg8::EpiPlain8, pg8::MoeOrder<false>, true>(F.lds, (const bf16*)(p.ws + WS_ACT), 256, S, E, F.tid);
}
namespace attn_body {
using bf16=unsigned short;
using bf16x8=__attribute__((ext_vector_type(8)))short;
using s16x4=__attribute__((ext_vector_type(4)))short;
using f32x16=__attribute__((ext_vector_type(16)))float;
using u32x4=__attribute__((ext_vector_type(4)))unsigned;
constexpr int D=64,DM=1024;
constexpr int NW=8,QBLK=32,QB=QBLK*NW,KVBLK=64;
constexpr int ATTN_PITCH=DM, ATTN_UNIT_ROWS=QB;
__device__ __forceinline__ int crow(int r,int hi){return (r&3)+8*(r>>2)+4*hi;}
#define SBAR() __builtin_amdgcn_sched_barrier(0)

constexpr int NSLOT=3, SLOTB=8192;
constexpr int LDS_K=0, LDS_V=NSLOT*SLOTB, LDS_WS=2*NSLOT*SLOTB, LDS_OST=LDS_WS+NW*64*4, LDS_BYTES=LDS_OST+NW*4096;
constexpr float C2=0.125f*1.4426950408889634f;
__device__ __forceinline__ void glds16(const void*gsrc,unsigned lds_dst){unsigned keep;
  asm volatile("s_mov_b32 %0, m0\n\ts_mov_b32 m0, %2\n\ts_nop 0\n\tglobal_load_lds_dwordx4 %1, off\n\ts_mov_b32 m0, %0":"=&s"(keep):"v"(gsrc),"s"(lds_dst):"memory");}
__device__ __forceinline__ void glds16s(const void*sbase,unsigned voff,unsigned lds_dst){unsigned keep;
  asm volatile("s_mov_b32 %0, m0\n\ts_mov_b32 m0, %3\n\ts_nop 0\n\tglobal_load_lds_dwordx4 %1, %2\n\ts_mov_b32 m0, %0":"=&s"(keep):"v"(voff),"s"(sbase),"s"(lds_dst):"memory");}
__device__ __forceinline__ void glds16s128(const void*sbase,unsigned voff,unsigned lds_dst){unsigned keep;
  asm volatile("s_mov_b32 %0, m0\n\ts_mov_b32 m0, %3\n\ts_nop 0\n\tglobal_load_lds_dwordx4 %1, %2 offset:128\n\ts_mov_b32 m0, %0":"=&s"(keep):"v"(voff),"s"(sbase),"s"(lds_dst):"memory");}
__device__ __forceinline__ float max3f(float a,float b,float c){float r;asm("v_max3_f32 %0, %1, %2, %3":"=v"(r):"v"(a),"v"(b),"v"(c));return r;}
__device__ __forceinline__ float max2f(float a,float b){float r;asm("v_max_f32_e32 %0, %1, %2":"=v"(r):"v"(a),"v"(b));return r;}
__device__ __forceinline__ float fadd_s(float a,float b){float r;asm("v_add_f32_e32 %0, %1, %2":"=v"(r):"v"(a),"v"(b));return r;}
__device__ __forceinline__ float fsub_s(float a,float b){float r;asm("v_sub_f32_e32 %0, %1, %2":"=v"(r):"v"(a),"v"(b));return r;}
typedef float f32x2_t __attribute__((ext_vector_type(2))); typedef __bf16 bf16x2_t __attribute__((ext_vector_type(2)));
__device__ __forceinline__ unsigned cvtpk_s(float lo,float hi){f32x2_t v={lo,hi};bf16x2_t b=__builtin_convertvector(v,bf16x2_t);return __builtin_bit_cast(unsigned,b);}
#define WAIT_BAR(N) asm volatile("s_waitcnt vmcnt(" #N ") lgkmcnt(0)\n\ts_barrier":::"memory")

__device__ __forceinline__ void qkt(f32x16&p0,f32x16&p1,const char*Kslot,const bf16x8*qr,const f32x16&negm,int r32,int hi){
  const char*kb=Kslot+hi*1024+r32*16;
  #pragma unroll
  for(int d0=0;d0<4;++d0){
    const bf16x8 b0=*reinterpret_cast<const bf16x8*>(kb+d0*2048);
    const bf16x8 b1=*reinterpret_cast<const bf16x8*>(kb+d0*2048+512);
    if(d0==0){p0=__builtin_amdgcn_mfma_f32_32x32x16_bf16(b0,qr[0],negm,0,0,0);p1=__builtin_amdgcn_mfma_f32_32x32x16_bf16(b1,qr[0],negm,0,0,0);}
    else{p0=__builtin_amdgcn_mfma_f32_32x32x16_bf16(b0,qr[d0],p0,0,0,0);p1=__builtin_amdgcn_mfma_f32_32x32x16_bf16(b1,qr[d0],p1,0,0,0);}}
}
typedef __attribute__((address_space(3))) const char* lds_cptr;
typedef short v4i16_t __attribute__((ext_vector_type(4)));
__device__ __forceinline__ void kload8(bf16x8*kf,lds_cptr kp){
  kf[0]=*(const __attribute__((address_space(3))) bf16x8*)(kp);      kf[1]=*(const __attribute__((address_space(3))) bf16x8*)(kp+512);
  kf[2]=*(const __attribute__((address_space(3))) bf16x8*)(kp+2048); kf[3]=*(const __attribute__((address_space(3))) bf16x8*)(kp+2560);
  kf[4]=*(const __attribute__((address_space(3))) bf16x8*)(kp+4096); kf[5]=*(const __attribute__((address_space(3))) bf16x8*)(kp+4608);
  kf[6]=*(const __attribute__((address_space(3))) bf16x8*)(kp+6144); kf[7]=*(const __attribute__((address_space(3))) bf16x8*)(kp+6656);
}
__device__ __forceinline__ void kload2(bf16x8*kf,lds_cptr kp,int j){ kf[2*j]=*(const __attribute__((address_space(3))) bf16x8*)(kp+j*2048); kf[2*j+1]=*(const __attribute__((address_space(3))) bf16x8*)(kp+j*2048+512); }
__device__ __forceinline__ s16x4 vtr(lds_cptr p){ return __builtin_bit_cast(s16x4,__builtin_amdgcn_ds_read_tr16_b64_v4i16((__attribute__((address_space(3))) v4i16_t*)p)); }
__device__ __forceinline__ float rowmax(const f32x16&p0,const f32x16&p1){
  float a=max3f(p0[0],p0[1],p1[0]),b=max3f(p0[2],p0[3],p1[1]);a=max3f(a,p1[2],p1[3]);
  #pragma unroll
  for(int r=4;r<16;r+=4){a=max3f(a,p0[r],p0[r+1]);b=max3f(b,p0[r+2],p0[r+3]);a=max3f(a,p1[r],p1[r+1]);b=max3f(b,p1[r+2],p1[r+3]);}
  const float m=max2f(a,b);
  auto rr=__builtin_amdgcn_permlane32_swap(__float_as_uint(m),__float_as_uint(m),false,false);
  return max2f(__uint_as_float(rr[0]),__uint_as_float(rr[1]));
}
#undef SBAR
#undef WAIT_BAR
#undef KVROW
}
namespace attn_body {
constexpr int V2SLOT = 16384;
constexpr int L2_K = 0, L2_V = NSLOT * SLOTB, L2_WS = L2_V + NSLOT * V2SLOT, L2_ST = L2_WS + NW * 64 * 4, L2_BYTES = L2_ST + NW * 8192;
#define SBAR() __builtin_amdgcn_sched_barrier(0)
#define WAIT_BAR(N) asm volatile("s_waitcnt vmcnt(" #N ") lgkmcnt(0)\n\ts_barrier":::"memory")
template<int THRL> __device__ __forceinline__ void attn_unit2(long qrow0,int qcol,int vcol,long kctx,long klat,int NT,const bf16*Q,const bf16*__restrict__ K,const bf16*__restrict__ V,int m,const float*lamp,const float*subln,unsigned char*A2,int acol,float km,char*shm,int wid_s){
  int lane_u; asm volatile("v_mbcnt_lo_u32_b32 %0, -1, 0\n\tv_mbcnt_hi_u32_b32 %0, -1, %0":"=v"(lane_u));
  const int lane=lane_u,r32=lane&31,hi=lane>>5; const int wid=wid_s;
  const bf16*Qw=Q+(qrow0+wid*QBLK)*DM+qcol;
  const bf16*Kh=K+qcol,*Vh=V+vcol;
  const unsigned lds0=(unsigned)(uintptr_t)shm;
  float*wsf=(float*)(shm+L2_WS)+wid*64;
  const unsigned wsf_lds=(unsigned)(lds0+L2_WS+wid*256);
  const unsigned koff=(unsigned)(lane*DM+wid*8)*2u;
  const unsigned voff=(unsigned)((16*(wid&3)+(lane>>2))*DM+(wid>>2)*32+(lane&3)*8)*2u;
  const unsigned kdst=lds0+L2_K+wid*1024, vdst=lds0+L2_V+wid*1024;
  #define KVROW(t) ((t)<4?kctx+(long)(t)*KVBLK:klat+(long)((t)-4)*KVBLK)
  #define DMA_K(t,slot) glds16s(Kh+KVROW(t)*DM,koff,(unsigned)(kdst+(slot)))
  #define DMA_V(t,slot) do{ const bf16*vb_=Vh+KVROW(t)*DM; glds16s(vb_,voff,(unsigned)(vdst+2*(slot))); glds16s(vb_+64,voff,(unsigned)(vdst+2*(slot)+8192)); }while(0)
  const char*Kbase=shm+L2_K; bf16x8 kf[8];
  const lds_cptr shm3=(lds_cptr)shm; const lds_cptr kp0=shm3+L2_K+hi*1024+r32*16; const lds_cptr vp0=shm3+L2_V+((lane>>4)&1)*32+(lane&3)*8+(4*hi+((lane&15)>>2))*64;
  DMA_K(0,0);DMA_V(0,0);DMA_K(1,SLOTB);
  bf16x8 qr[4];
  #pragma unroll
  for(int d0=0;d0<4;++d0)qr[d0]=*reinterpret_cast<const bf16x8*>(&Qw[(long)r32*DM+d0*16+hi*8]);
  bool FAST; { float qn=0.f;
    #pragma unroll
    for(int d0=0;d0<4;++d0){ const u32x4 u=__builtin_bit_cast(u32x4,qr[d0]); const unsigned a4[4]={u.x,u.y,u.z,u.w};
      #pragma unroll
      for(int i=0;i<4;++i){ const float lo=__uint_as_float(a4[i]<<16),h2=__uint_as_float(a4[i]&0xffff0000u); qn+=lo*lo+h2*h2; } }
    { auto rq=__builtin_amdgcn_permlane32_swap(__float_as_uint(qn),__float_as_uint(qn),false,false); qn=__uint_as_float(rq[0])+__uint_as_float(rq[1]); } FAST=__all(qn*km<=96.f*96.f)!=0; }
  float mhat=0.f,l_reg=0.f;f32x16 o[4];o[0]=f32x16{};o[1]=f32x16{};o[2]=f32x16{};o[3]=f32x16{};const f32x16 zero16=f32x16{};
  bool resc=false;
  #define START(P0,P1) do{ resc=false; if(FAST){ mhat=0.f; } else { const float rm=rowmax(P0,P1); mhat=rm; \
    _Pragma("unroll") for(int r=0;r<16;++r){P0[r]=fsub_s(P0[r],rm);P1[r]=fsub_s(P1[r],rm);} } \
    _Pragma("unroll") for(int r=0;r<16;++r)P0[r]=__builtin_amdgcn_exp2f(P0[r]); }while(0)
  #define RESC() do{ if(resc){ asm volatile("s_waitcnt lgkmcnt(0)":::"memory"); \
      int l3_=lane; asm volatile("":"+v"(l3_)); const int hi3_=l3_>>5; \
      _Pragma("unroll") for(int d_=0;d_<4;++d_) _Pragma("unroll") for(int r=0;r<16;++r)o[d_][r]*=wsf[crow(r,hi3_)]; } }while(0)
  int sl_prev=0,sl_cur=0,sl_next=SLOTB;
  #define ROT() do{sl_prev=sl_cur;sl_cur=sl_next;sl_next=(sl_next==(NSLOT-1)*SLOTB)?0:sl_next+SLOTB;}while(0)
  DMA_K(2,2*SLOTB);
  WAIT_BAR(4);
  #define PKW(P,B) cvtpk_s(P[B],P[B+1])
  u32x4 pwA0,pwA1,pwA2,pwA3,pwB0,pwB1,pwB2,pwB3;
  { f32x16 p0,p1;
    qkt(p0,p1,Kbase,qr,zero16,r32,hi);asm volatile("s_nop 15\n\ts_nop 7":"+v"(p0),"+v"(p1));
    START(p0,p1);
    _Pragma("unroll") for(int r=0;r<16;++r)p1[r]=__builtin_amdgcn_exp2f(p1[r]);
    float sacc=p0[0]+p0[1]; _Pragma("unroll") for(int r=2;r<16;++r)sacc+=p0[r]; _Pragma("unroll") for(int r=0;r<16;++r)sacc+=p1[r]; l_reg+=sacc;
    pwA0=(u32x4){PKW(p0,0),PKW(p0,2),PKW(p0,4),PKW(p0,6)};pwA1=(u32x4){PKW(p0,8),PKW(p0,10),PKW(p0,12),PKW(p0,14)};pwA2=(u32x4){PKW(p1,0),PKW(p1,2),PKW(p1,4),PKW(p1,6)};pwA3=(u32x4){PKW(p1,8),PKW(p1,10),PKW(p1,12),PKW(p1,14)}; }
  WAIT_BAR(0);
  DMA_K(3,0);DMA_V(1,SLOTB);
  ROT();
  kload8(kf,kp0+sl_cur);
  WAIT_BAR(3);
  s16x4 vAl[4],vAh[4],vBl[4],vBh[4];
  #define PAFX(x) __builtin_bit_cast(bf16x8,x)
  #define VF(A,d) (bf16x8){A##l[d][0],A##l[d][1],A##l[d][2],A##l[d][3],A##h[d][0],A##h[d][1],A##h[d][2],A##h[d][3]}
  #define PIN(x) asm volatile("":"+v"(x))
  #define MX3(a,b,c) __builtin_fmaxf(__builtin_fmaxf((a),(b)),(c))
  #define EX(v) __builtin_amdgcn_exp2f(v)
  #define VRDL(A,d,ks) A##l[d]=vtr(vp_+((d)*4096+(ks)*1024))
  #define VRDH(A,d,ks) A##h[d]=vtr(vp_+((d)*4096+(ks)*1024+512))
  #define GAPF(MF,X,B,PWN,W,RD) do{ MF; X[B]=EX(X[B]); X[B+1]=EX(X[B+1]); sacc+=X[B]; sacc+=X[B+1]; PIN(sacc); PWN[W]=cvtpk_s(X[B],X[B+1]); PIN(PWN); RD; SBAR(); }while(0)
  #define GAPP(MF,X,B,PWN,W,RD) do{ MF; X[B]=EX(X[B]-mhat); X[B+1]=EX(X[B+1]-mhat); sacc+=X[B]; sacc+=X[B+1]; PIN(sacc); PWN[W]=cvtpk_s(X[B],X[B+1]); PIN(PWN); RD; SBAR(); }while(0)
  #define MFQ(C,kf_,q_,acc_) C=__builtin_amdgcn_mfma_f32_32x32x16_bf16(kf_,q_,acc_,0,0,0)
  #define MFO(d,PW,A) o[d]=__builtin_amdgcn_mfma_f32_32x32x16_bf16(PAFX(PW),VF(A,d),o[d],0,0,0)
  #define KRD(G,j) do{ if(G){ kload2(kf,kp0+sl_next,j); } }while(0)
  #define PHASEB(G,PI0,PI1,PI2,PI3,PO0,PO1,PO2,PO3,GL) do{ \
    G(MFO(0,PI0,vA),C0,0, PO0,0, VRDL(vB,0,1);VRDH(vB,0,1)); \
    G(MFO(1,PI0,vA),C0,2, PO0,1, VRDL(vB,1,1);VRDH(vB,1,1)); \
    G(MFO(2,PI0,vA),C0,4, PO0,2, VRDL(vB,2,1);VRDH(vB,2,1)); \
    G(MFO(3,PI0,vA),C0,6, PO0,3, VRDL(vB,3,1);VRDH(vB,3,1)); \
    G(MFO(0,PI1,vB),C0,8, PO1,0, VRDL(vA,0,2);VRDH(vA,0,2)); \
    G(MFO(1,PI1,vB),C0,10,PO1,1, VRDL(vA,1,2);VRDH(vA,1,2)); \
    G(MFO(2,PI1,vB),C0,12,PO1,2, VRDL(vA,2,2);VRDH(vA,2,2)); \
    G(MFO(3,PI1,vB),C0,14,PO1,3, VRDL(vA,3,2);VRDH(vA,3,2)); \
    G(MFO(0,PI2,vA),C1,0, PO2,0, VRDL(vB,0,3);VRDH(vB,0,3)); \
    G(MFO(1,PI2,vA),C1,2, PO2,1, VRDL(vB,1,3);VRDH(vB,1,3)); \
    G(MFO(2,PI2,vA),C1,4, PO2,2, VRDL(vB,2,3);VRDH(vB,2,3)); \
    G(MFO(3,PI2,vA),C1,6, PO2,3, VRDL(vB,3,3);VRDH(vB,3,3)); \
    G(MFO(0,PI3,vB),C1,8, PO3,0, KRD(GL,0)); \
    G(MFO(1,PI3,vB),C1,10,PO3,1, KRD(GL,1)); \
    G(MFO(2,PI3,vB),C1,12,PO3,2, KRD(GL,2)); \
    G(MFO(3,PI3,vB),C1,14,PO3,3, KRD(GL,3)); \
    }while(0)
  #define PHASEB_NF(G,PI0,PI1,PI2,PI3,PO0,PO1,PO2,PO3,GL) do{ \
    G(MFO(0,PI0,vA),C0,0, PO0,0, (void)0); \
    G(MFO(1,PI0,vA),C0,2, PO0,1, (void)0); \
    G(MFO(2,PI0,vA),C0,4, PO0,2, (void)0); \
    G(MFO(3,PI0,vA),C0,6, PO0,3, VRDL(vA,0,1);VRDH(vA,0,1);VRDL(vA,1,1);VRDH(vA,1,1);VRDL(vA,2,1);VRDH(vA,2,1);VRDL(vA,3,1);VRDH(vA,3,1)); \
    G(MFO(0,PI1,vA),C0,8, PO1,0, (void)0); \
    G(MFO(1,PI1,vA),C0,10,PO1,1, (void)0); \
    G(MFO(2,PI1,vA),C0,12,PO1,2, (void)0); \
    G(MFO(3,PI1,vA),C0,14,PO1,3, VRDL(vA,0,2);VRDH(vA,0,2);VRDL(vA,1,2);VRDH(vA,1,2);VRDL(vA,2,2);VRDH(vA,2,2);VRDL(vA,3,2);VRDH(vA,3,2)); \
    G(MFO(0,PI2,vA),C1,0, PO2,0, (void)0); \
    G(MFO(1,PI2,vA),C1,2, PO2,1, (void)0); \
    G(MFO(2,PI2,vA),C1,4, PO2,2, (void)0); \
    G(MFO(3,PI2,vA),C1,6, PO2,3, VRDL(vA,0,3);VRDH(vA,0,3);VRDL(vA,1,3);VRDH(vA,1,3);VRDL(vA,2,3);VRDH(vA,2,3);VRDL(vA,3,3);VRDH(vA,3,3)); \
    G(MFO(0,PI3,vA),C1,8, PO3,0, KRD(GL,0)); \
    G(MFO(1,PI3,vA),C1,10,PO3,1, KRD(GL,1)); \
    G(MFO(2,PI3,vA),C1,12,PO3,2, KRD(GL,2)); \
    G(MFO(3,PI3,vA),C1,14,PO3,3, KRD(GL,3)); \
    }while(0)
  #define STEP2(t,PI0,PI1,PI2,PI3,PO0,PO1,PO2,PO3,GK,GV,GL,GAPM,MB,PHB) do{ SBAR(); \
    const lds_cptr vp_=vp0+2*sl_prev; f32x16 C0,C1; float sacc=0.f; \
    VRDL(vA,0,0); SBAR(); MFQ(C0,kf[0],qr[0],zero16); SBAR(); \
    VRDH(vA,0,0); SBAR(); MFQ(C1,kf[1],qr[0],zero16); SBAR(); \
    VRDL(vA,1,0); SBAR(); MFQ(C0,kf[2],qr[1],C0); SBAR(); \
    VRDH(vA,1,0); SBAR(); MFQ(C1,kf[3],qr[1],C1); SBAR(); \
    VRDL(vA,2,0); SBAR(); MFQ(C0,kf[4],qr[2],C0); SBAR(); \
    VRDH(vA,2,0); SBAR(); MFQ(C1,kf[5],qr[2],C1); SBAR(); \
    VRDL(vA,3,0); SBAR(); MFQ(C0,kf[6],qr[3],C0); SBAR(); \
    VRDH(vA,3,0); SBAR(); MFQ(C1,kf[7],qr[3],C1); SBAR(); \
    if(GK){DMA_K((t)+3,sl_cur);} if(GV){DMA_V((t)+1,sl_next);} \
    if(MB){ float a=MX3(C0[0],C0[1],C1[0]),b=MX3(C0[2],C0[3],C1[1]); a=MX3(a,C1[2],C1[3]); \
      _Pragma("unroll") for(int r=4;r<16;r+=4){a=MX3(a,C0[r],C0[r+1]);b=MX3(b,C0[r+2],C0[r+3]);a=MX3(a,C1[r],C1[r+1]);b=MX3(b,C1[r+2],C1[r+3]);} \
      float rm=__builtin_fmaxf(a,b); { auto rr=__builtin_amdgcn_permlane32_swap(__float_as_uint(rm),__float_as_uint(rm),false,false); rm=__builtin_fmaxf(__uint_as_float(rr[0]),__uint_as_float(rr[1])); } \
      resc=false; \
      if(__builtin_expect(__any(rm-mhat>(float)THRL),0)){ const float dl=__builtin_fmaxf(rm-mhat,0.f); mhat+=dl; \
        const float f=__builtin_amdgcn_exp2f(-dl); l_reg*=f; { unsigned keep_; asm volatile("s_mov_b32 %0, m0\n\ts_mov_b32 m0, %2\n\ts_nop 0\n\tds_write_addtid_b32 %1\n\ts_mov_b32 m0, %0":"=&s"(keep_):"v"(f),"s"(wsf_lds):"memory"); } resc=true; } } \
    __builtin_amdgcn_s_setprio(1); SBAR(); \
    PHB(GAPM,PI0,PI1,PI2,PI3,PO0,PO1,PO2,PO3,GL); \
    __builtin_amdgcn_s_setprio(0); l_reg+=sacc; \
    }while(0)
  #define ENDW(tt) do{ if((tt)+3<NT){WAIT_BAR(3);} else if((tt)+2<NT){WAIT_BAR(2);} else {WAIT_BAR(0);} }while(0)
  #define LOOPS(GAPM,MB,RS,PHB) do{ int t=1; \
    for(;t+5<NT;t+=2){ \
      STEP2(t,  pwA0,pwA1,pwA2,pwA3,pwB0,pwB1,pwB2,pwB3,true,true,true,GAPM,MB,PHB); WAIT_BAR(3); RS; ROT(); \
      STEP2(t+1,pwB0,pwB1,pwB2,pwB3,pwA0,pwA1,pwA2,pwA3,true,true,true,GAPM,MB,PHB); WAIT_BAR(3); RS; ROT(); \
    } \
    for(;t+1<NT;t+=2){ \
      STEP2(t,  pwA0,pwA1,pwA2,pwA3,pwB0,pwB1,pwB2,pwB3,(t+3<NT),(t+1<NT),(t+1<NT),GAPM,MB,PHB); ENDW(t);   RS; ROT(); \
      STEP2(t+1,pwB0,pwB1,pwB2,pwB3,pwA0,pwA1,pwA2,pwA3,(t+4<NT),(t+2<NT),(t+2<NT),GAPM,MB,PHB); ENDW(t+1); RS; ROT(); \
    } \
    STEP2(NT-1,pwA0,pwA1,pwA2,pwA3,pwB0,pwB1,pwB2,pwB3,false,false,false,GAPM,MB,PHB); RS; }while(0)
  auto finish=[&]() __attribute__((always_inline)) {
  { const lds_cptr vp_=vp0+2*sl_cur;
    #pragma unroll
    for(int ks=0;ks<4;++ks){
      #pragma unroll
      for(int d=0;d<4;++d){ const s16x4 lo=vtr(vp_+(d*4096+ks*1024)),hh=vtr(vp_+(d*4096+ks*1024+512)); const bf16x8 vf=(bf16x8){lo[0],lo[1],lo[2],lo[3],hh[0],hh[1],hh[2],hh[3]};
        const u32x4 pw=(ks==0)?pwB0:(ks==1)?pwB1:(ks==2)?pwB2:pwB3;
        o[d]=__builtin_amdgcn_mfma_f32_32x32x16_bf16(PAFX(pw),vf,o[d],0,0,0); } } }
  { int lane_l=lane; asm volatile("":"+v"(lane_l));
  { const int lane=lane_l,r32=lane&31,hi=lane>>5;
  {auto rr=__builtin_amdgcn_permlane32_swap(__float_as_uint(l_reg),__float_as_uint(l_reg),false,false);l_reg=__uint_as_float(rr[0])+__uint_as_float(rr[1]);}
  if(hi==0)wsf[32+r32]=l_reg;asm volatile("s_waitcnt lgkmcnt(0)":::"memory");
  float rli[16];
  #pragma unroll
  for(int r=0;r<16;++r)rli[r]=__builtin_amdgcn_rcpf(wsf[32+crow(r,hi)]);
  unsigned short*stash=(unsigned short*)(shm+L2_ST)+wid*4096;
  if(m==0){
    #pragma unroll
    for(int d0=0;d0<4;++d0){
      #pragma unroll
      for(int r=0;r<16;++r)stash[(d0*16+r)*64+lane]=(unsigned short)f2bf(o[d0][r]*rli[r]);}
    asm volatile("s_waitcnt lgkmcnt(0)":::"memory");
  } else {
    const float lam=__uint_as_float(__hip_atomic_load((const unsigned*)lamp,__ATOMIC_RELAXED,__HIP_MEMORY_SCOPE_AGENT));
    float ss[16];
    #pragma unroll
    for(int r=0;r<16;++r)ss[r]=0.f;
    #pragma unroll
    for(int d0=0;d0<4;++d0){
      #pragma unroll
      for(int r=0;r<16;++r){ const float o1=bf2f(stash[(d0*16+r)*64+lane]); const float df=o1-lam*(o[d0][r]*rli[r]); o[d0][r]=df; ss[r]+=df*df; } }
    #pragma unroll
    for(int r=0;r<16;++r){ float q=ss[r];
      q+=__int_as_float(__builtin_amdgcn_ds_swizzle(__float_as_int(q),0x41f));
      q+=__int_as_float(__builtin_amdgcn_ds_swizzle(__float_as_int(q),0x81f));
      q+=__int_as_float(__builtin_amdgcn_ds_swizzle(__float_as_int(q),0x101f));
      q+=__int_as_float(__builtin_amdgcn_ds_swizzle(__float_as_int(q),0x201f));
      q+=__int_as_float(__builtin_amdgcn_ds_swizzle(__float_as_int(q),0x401f));
      ss[r]=(1.f-LAMBDA_INIT0)/sqrtf(q*(1.f/128.f)+LN_EPS); }
    asm volatile("s_waitcnt lgkmcnt(0)":::"memory");
    unsigned char*stg=(unsigned char*)stash;
    #pragma unroll
    for(int d0=0;d0<4;++d0){ const float sgv=subln[d0*32+r32];
      #pragma unroll
      for(int r=0;r<16;++r){ const int w8=__builtin_amdgcn_cvt_pk_fp8_f32(o[d0][r]*ss[r]*sgv,0.f,0,false); stg[crow(r,hi)*128+d0*32+r32]=(unsigned char)(w8&0xff); } }
    asm volatile("s_waitcnt lgkmcnt(0)":::"memory");
    unsigned char*Aw=A2+(qrow0+wid*QBLK)*DM+acol;
    #pragma unroll
    for(int i=0;i<4;++i){const int row=i*8+(lane>>3),ch=lane&7; const u32x4 v=*(const u32x4*)(stg+row*128+ch*16); *(u32x4*)(Aw+(long)row*DM+ch*16)=v;}
    asm volatile("s_waitcnt lgkmcnt(0)":::"memory");
  }
  } }
  };
  if(FAST){ LOOPS(GAPF,false,(void)0,PHASEB); finish(); } else { LOOPS(GAPP,true,RESC(),PHASEB_NF); finish(); }
  #undef LOOPS
  asm volatile("s_waitcnt lgkmcnt(0)\n\ts_barrier":::"memory");
  #undef KVROW
  #undef DMA_K
  #undef DMA_V
  #undef START
  #undef RESC
  #undef ROT
  #undef PKW
  #undef PAFX
  #undef VF
  #undef PIN
  #undef MX3
  #undef EX
  #undef VRDL
  #undef VRDH
  #undef GAPP
  #undef GAPF
  #undef PHASEB
  #undef PHASEB_NF
  #undef MFQ
  #undef MFO
  #undef KRD
  #undef STEP2
  #undef ENDW
}
#undef SBAR
#undef WAIT_BAR
}
__device__ __forceinline__ void phase_attn2(const Frame& F, const Prm& p) {
    const bf16* Q = (const bf16*)(p.ws + WS_Q); const bf16* K = (const bf16*)(p.ws + WS_K); const bf16* V = (const bf16*)(p.ws + WS_V); unsigned char* A2 = p.ws + WS_O1;
    const float* lamp = (const float*)(p.ws + WS_MISC);
    for (int v = vcu_of(F); v < 256; v += F.G) {
        const int b = v >> 5, h = (v >> 2) & 7, part = v & 3;
        const long kctx = NLAT + b * CTXL, klat = (long)b * SEQ;
        const int nu = part ? 4 : 5;
        for (int i = 0; i < nu; ++i) {
            const long qrow0 = i < 4 ? klat + (part * 4 + i) * 256 : kctx; const int NT = i < 4 ? 68 : 4;
            for (int m = 0; m < 2; ++m) {
                const int hm = 2 * h + m;
                const float km = __uint_as_float(__hip_atomic_load(F.ctl + CW_KM + b * 16 + hm, __ATOMIC_RELAXED, __HIP_MEMORY_SCOPE_AGENT));
                attn_body::attn_unit2<8>(qrow0, hm * 64, h * 128, kctx, klat, NT, Q, K, V, m, lamp, p.subln, A2, h * 128, km, (char*)F.lds, F.wave);
            }
        }
    }
}
namespace gla3 {
typedef short bf16x8 __attribute__((ext_vector_type(8)));
typedef short s16x4 __attribute__((ext_vector_type(4)));
typedef float f32x16 __attribute__((ext_vector_type(16)));
constexpr int CH = 64 * 16 + 64;
constexpr int L_QS = 0, L_KS = 16 * CH, L_VS = 32 * CH, L_SB = 40 * CH, L_X = 56 * CH, L_DEC = L_X + 16384, L_END = L_DEC + 512;
__device__ __forceinline__ int crow(int i, int hh) { return (i & 3) + 8 * (i >> 2) + 4 * hh; }
typedef float f32x2_t __attribute__((ext_vector_type(2))); typedef __bf16 bf16x2_t __attribute__((ext_vector_type(2)));
__device__ __forceinline__ unsigned pk(float lo, float hi) { f32x2_t v = {lo, hi}; bf16x2_t b = __builtin_convertvector(v, bf16x2_t); return __builtin_bit_cast(unsigned, b); }
typedef short v4i16_t __attribute__((ext_vector_type(4)));
__device__ __forceinline__ s16x4 trrd(LAS const unsigned char* p) { return __builtin_bit_cast(s16x4, __builtin_amdgcn_ds_read_tr16_b64_v4i16((LAS v4i16_t*)p)); }
#define GLA_FR(lo, hi) (bf16x8){lo[0], lo[1], lo[2], lo[3], hi[0], hi[1], hi[2], hi[3]}

__device__ __forceinline__ void scan_unit(const Frame& F, const Prm& p, int unit) {
    const int dvs = unit & 3, dir = (unit >> 2) & 1, h = (unit >> 3) & 3, b = unit >> 5;
    LAS unsigned char* lds = (LAS unsigned char*)F.lds;
    const int lane = F.lane, w = F.wave, tid = F.tid, r = lane & 31, hh = lane >> 5;
    const bf16* QT = (const bf16*)(p.ws + WS_QT) + ((size_t)dir * 8 + 2 * h) * NTOK * 64;
    const bf16* KT = (const bf16*)(p.ws + WS_KT) + ((size_t)dir * 8 + 2 * h) * NTOK * 64;
    const bf16* V = (const bf16*)(p.ws + WS_V1) + h * 256 + dvs * 64;
    const float* DEC = (const float*)(p.ws + WS_DEC) + (size_t)dir * NCHUNK * 512 + h * 128;
    bf16* OG = (bf16*)((unsigned char*)p.out + (dir ? OUT_OGB : 0)) + h * 256 + dvs * 64;
    const int g1 = (lane >> 4) & 1, q4 = (lane & 15) >> 2, p4 = lane & 3;
    const int trb = (2 * g1 + (p4 >> 1)) * CH + q4 * 16 + 8 * (p4 & 1);
    const int trN = trb + 128 * hh, trP = trb + 64 * hh;
    f32x16 S0 = {}, S1 = {};
    for (int i = tid; i < 16 * CH / 16; i += NTHR) *(LAS u32x4*)(lds + L_SB + i * 16) = (u32x4){0u, 0u, 0u, 0u};
    u32x4 pq0[2], pq1[2], pk0[2], pk1[2], pv[2]; float pdec[2] = {0.f, 0.f};
#define GLA_CHUNK(step) ((step) >= 4 ? b * 64 + (dir ? 63 - ((step) - 4) : (step) - 4) : 512 + b * 4 + (dir ? 3 - (step) : (step)))
    const int qrow = 8 * w + (lane >> 4), qch = lane & 15, vrow = 8 * w + (lane >> 3), vch = lane & 7;
    const size_t qgo = (size_t)(qch >> 3) * NTOK * 64 + (qch & 7) * 8;
#define GLA_LOAD(step, u) do { const size_t t0_ = (size_t)GLA_CHUNK(step) * 64; \
        pq0[u] = *(const u32x4*)(QT + qgo + (t0_ + qrow) * 64); pq1[u] = *(const u32x4*)(QT + qgo + (t0_ + qrow + 4) * 64); \
        pk0[u] = *(const u32x4*)(KT + qgo + (t0_ + qrow) * 64); pk1[u] = *(const u32x4*)(KT + qgo + (t0_ + qrow + 4) * 64); \
        pv[u] = *(const u32x4*)(V + (t0_ + vrow) * 1024 + 8 * vch); if (tid < 128) pdec[u] = DEC[(size_t)GLA_CHUNK(step) * 512 + tid]; } while (0)
#define GLA_STORE(u) do { \
        *(LAS u32x4*)(lds + L_QS + qch * CH + qrow * 16) = pq0[u]; *(LAS u32x4*)(lds + L_QS + qch * CH + (qrow + 4) * 16) = pq1[u]; \
        *(LAS u32x4*)(lds + L_KS + qch * CH + qrow * 16) = pk0[u]; *(LAS u32x4*)(lds + L_KS + qch * CH + (qrow + 4) * 16) = pk1[u]; \
        *(LAS u32x4*)(lds + L_VS + vch * CH + vrow * 16) = pv[u]; \
        if (tid < 128) *(LAS float*)(lds + L_DEC + 4 * tid) = pdec[u]; } while (0)
    GLA_LOAD(0, 0);
    GLA_LOAD(1, 1);
    GLA_STORE(0);
    __syncthreads();
    const int tb = (w & 3) >> 1, vb = w & 1;
    for (int sp2 = 0; sp2 < 34; ++sp2) {
#pragma unroll
    for (int u = 0; u < 2; ++u) {
        const int step = 2 * sp2 + u;
        const bool lat = step >= 4; const int chunk = GLA_CHUNK(step);
        if (step + 2 < 68) GLA_LOAD(step + 2, u);
        f32x16 o = {};
        if (w < 4) {
            if (lat) {
                const bool n0 = dir ? (tb == 0) : true, n1 = dir ? true : (tb == 1);
                f32x16 sc0 = {}, sc1 = {};
#define GLA_BQ(ks) (*(const LAS bf16x8*)(lds + L_QS + (2 * (ks) + hh) * CH + (32 * tb + r) * 16))
#define GLA_A0(ks) (*(const LAS bf16x8*)(lds + L_KS + (2 * (ks) + hh) * CH + r * 16))
#define GLA_A1(ks) (*(const LAS bf16x8*)(lds + L_KS + (2 * (ks) + hh) * CH + (32 + r) * 16))
                if (n0 && n1) {
#pragma unroll
                    for (int ks = 0; ks < 8; ++ks) { const bf16x8 bq = GLA_BQ(ks); sc0 = __builtin_amdgcn_mfma_f32_32x32x16_bf16(GLA_A0(ks), bq, sc0, 0, 0, 0); sc1 = __builtin_amdgcn_mfma_f32_32x32x16_bf16(GLA_A1(ks), bq, sc1, 0, 0, 0); }
                } else if (n0) {
#pragma unroll
                    for (int ks = 0; ks < 8; ++ks) sc0 = __builtin_amdgcn_mfma_f32_32x32x16_bf16(GLA_A0(ks), GLA_BQ(ks), sc0, 0, 0, 0);
                } else {
#pragma unroll
                    for (int ks = 0; ks < 8; ++ks) sc1 = __builtin_amdgcn_mfma_f32_32x32x16_bf16(GLA_A1(ks), GLA_BQ(ks), sc1, 0, 0, 0);
                }
#undef GLA_BQ
#undef GLA_A0
#undef GLA_A1
                const int t = 32 * tb + r;
#pragma unroll
                for (int i = 0; i < 16; ++i) { const int s0 = crow(i, hh), s1 = 32 + s0; const bool k0 = dir ? (s0 >= t) : (s0 <= t), k1 = dir ? (s1 >= t) : (s1 <= t); sc0[i] = k0 ? sc0[i] : 0.f; sc1[i] = k1 ? sc1[i] : 0.f; }
#pragma unroll
                for (int sb = 0; sb < 2; ++sb) { if (sb == 0 ? n0 : n1) {
#pragma unroll
                    for (int sp = 0; sp < 2; ++sp) {
                        u32x4 pw;
                        if (sb == 0) { pw.x = pk(sc0[8 * sp + 0], sc0[8 * sp + 1]); pw.y = pk(sc0[8 * sp + 2], sc0[8 * sp + 3]); pw.z = pk(sc0[8 * sp + 4], sc0[8 * sp + 5]); pw.w = pk(sc0[8 * sp + 6], sc0[8 * sp + 7]); }
                        else { pw.x = pk(sc1[8 * sp + 0], sc1[8 * sp + 1]); pw.y = pk(sc1[8 * sp + 2], sc1[8 * sp + 3]); pw.z = pk(sc1[8 * sp + 4], sc1[8 * sp + 5]); pw.w = pk(sc1[8 * sp + 6], sc1[8 * sp + 7]); }
                        LAS const unsigned char* vp = lds + L_VS + trP + (4 * vb) * CH + (32 * sb + 16 * sp) * 16;
                        const s16x4 lo = trrd(vp), hi = trrd(vp + 8 * 16);
                        o = __builtin_amdgcn_mfma_f32_32x32x16_bf16(GLA_FR(lo, hi), __builtin_bit_cast(bf16x8, pw), o, 0, 0, 0);
                    } } }
            }
        } else {
            const int db = w - 4;
            if (lat) {
                f32x16 o2 = {};
#pragma unroll
                for (int ks = 0; ks < 8; ++ks) {
                    const bf16x8 as = *(const LAS bf16x8*)(lds + L_SB + (2 * ks + hh) * CH + (32 * vb + r) * 16);
                    const bf16x8 bq = *(const LAS bf16x8*)(lds + L_QS + (2 * ks + hh) * CH + (32 * tb + r) * 16);
                    o2 = __builtin_amdgcn_mfma_f32_32x32x16_bf16(as, bq, o2, 0, 0, 0);
                }
#pragma unroll
                for (int g = 0; g < 4; ++g) *(LAS f32x4*)(lds + L_X + (w & 3) * 4096 + g * 1024 + lane * 16) = (f32x4){o2[4 * g], o2[4 * g + 1], o2[4 * g + 2], o2[4 * g + 3]};
            }
#pragma unroll
            for (int ks = 0; ks < 4; ++ks) {
                LAS const unsigned char* kp = lds + L_KS + trN + (4 * db) * CH + (16 * ks) * 16;
                LAS const unsigned char* vp = lds + L_VS + trN + (16 * ks) * 16;
                const s16x4 al = trrd(kp), ah = trrd(kp + 4 * 16);
                const s16x4 b0l = trrd(vp), b0h = trrd(vp + 4 * 16), b1l = trrd(vp + 4 * CH), b1h = trrd(vp + 4 * CH + 4 * 16);
                S0 = __builtin_amdgcn_mfma_f32_32x32x16_bf16(GLA_FR(al, ah), GLA_FR(b0l, b0h), S0, 0, 0, 0); S1 = __builtin_amdgcn_mfma_f32_32x32x16_bf16(GLA_FR(al, ah), GLA_FR(b1l, b1h), S1, 0, 0, 0);
            }
#pragma unroll
            for (int i = 0; i < 16; ++i) { const float dc = *(const LAS float*)(lds + L_DEC + 4 * (32 * db + crow(i, hh))); S0[i] *= dc; S1[i] *= dc; }
        }
        __syncthreads();
        if (w < 4 && lat) {
            bf16* orow = OG + ((size_t)chunk * 64 + 32 * tb + r) * DM + 32 * vb + 4 * hh;
#pragma unroll
            for (int g = 0; g < 4; ++g) { const f32x4 x = *(const LAS f32x4*)(lds + L_X + w * 4096 + g * 1024 + lane * 16);
                u32x2 wv; wv.x = pk(o[4 * g] + x.x, o[4 * g + 1] + x.y); wv.y = pk(o[4 * g + 2] + x.z, o[4 * g + 3] + x.w); *(u32x2*)(orow + 8 * g) = wv; }
        }
        if (step + 1 < 68) {
            GLA_STORE(u ^ 1);
            if (w >= 4) { const int db = w - 4;
#pragma unroll
                for (int g = 0; g < 4; ++g) { u32x2 w0, w1; w0.x = pk(S0[4 * g], S0[4 * g + 1]); w0.y = pk(S0[4 * g + 2], S0[4 * g + 3]); w1.x = pk(S1[4 * g], S1[4 * g + 1]); w1.y = pk(S1[4 * g + 2], S1[4 * g + 3]);
                    *(LAS u32x2*)(lds + L_SB + (4 * db + g) * CH + r * 16 + 8 * hh) = w0; *(LAS u32x2*)(lds + L_SB + (4 * db + g) * CH + (32 + r) * 16 + 8 * hh) = w1; } }
        }
        __syncthreads();
    }
    }
#undef GLA_CHUNK
#undef GLA_LOAD
#undef GLA_STORE
}
#undef GLA_FR
}
__device__ __forceinline__ void phase_scan_opt(const Frame& F, const Prm& p) {
    for (int unit = vcu_of(F); unit < 256; unit += F.G) gla3::scan_unit(F, p, unit);
}
#define PHASE_QKV(F, p) phase_qkv_opt(F, p)
#define PHASE_ATTN(F, p) phase_attn2(F, p)
#define PHASE_WO(F, p, l) phase_wo_opt(F, p, l)
#define PHASE_MOE1(F, p, l) phase_moe1_opt(F, p, l)
#define PHASE_MOE2(F, p, l) phase_moe2_opt(F, p, l)
#define PHASE_INPROJ(F, p) phase_inproj_opt(F, p)
#define PHASE_SCAN(F, p) phase_scan_opt(F, p)
typedef GAS unsigned gu32;
#define XB_TMO      128
#define XB_XCNT(j)  (256  + 64 * (j))
#define XB_XSUB(j)  (1280 + 64 * (j))
#define XB_XGEN(j)  (2304 + 64 * (j))
#define XB_TOP      3328
#define XB_TOPGEN   3392
#define XCD_BAR_WORDS 3456
#define XB_SPIN_CAP (1u << 20)
__device__ __forceinline__ unsigned xb_ld(unsigned* p)              { return __hip_atomic_load(p, __ATOMIC_RELAXED, __HIP_MEMORY_SCOPE_AGENT); }
__device__ __forceinline__ unsigned xb_add(unsigned* p, unsigned v) { return __hip_atomic_fetch_add(p, v, __ATOMIC_RELAXED, __HIP_MEMORY_SCOPE_AGENT); }
__device__ __forceinline__ unsigned xb_xcc_id() { return (unsigned)__builtin_amdgcn_s_getreg((3 << 11) | 20) & 0xFu; }
#define XB_SPIN(cond, bar) do { unsigned _sp = 0; while (cond) { __builtin_amdgcn_s_sleep(1); \
    if ((++_sp & 255u) == 0u) { if (xb_ld(&(bar)[XB_TMO])) break; if (_sp > XB_SPIN_CAP) { atomicAdd(&(bar)[XB_TMO], 1u); break; } } } } while (0)
struct XcdBarrier { unsigned* bar; unsigned x; volatile LAS unsigned* st; };
__device__ __forceinline__ XcdBarrier xcd_barrier_post(unsigned* bar, volatile LAS unsigned* st) {
    XcdBarrier b; b.bar = bar; b.x = xb_xcc_id(); b.st = st;
    if (threadIdx.x == 0) (void)xb_add(&bar[XB_XCNT(b.x)], 1u);
    return b;
}
__device__ __forceinline__ void xcd_barrier_complete(unsigned* bar, unsigned x, unsigned& nloc, unsigned& nx) {
    const unsigned G = gridDim.x * gridDim.y * gridDim.z;
    unsigned sum, cnt, mine, sp = 0u;
    for (;;) {
        sum = 0u; cnt = 0u; mine = 0u;
#pragma unroll
        for (unsigned j = 0; j < 16; ++j) { const unsigned c = xb_ld(&bar[XB_XCNT(j)]); sum += c; cnt += (c > 0u) ? 1u : 0u; mine = (j == x) ? c : mine; }
        if (sum == G) break;
        __builtin_amdgcn_s_sleep(1);
        if ((++sp & 255u) == 0u) { if (xb_ld(&bar[XB_TMO])) break; if (sp > XB_SPIN_CAP) { atomicAdd(&bar[XB_TMO], 1u); break; } }
    }
    nloc = mine > 0u ? mine : 1u; nx = cnt > 0u ? cnt : 1u;
}
__device__ __forceinline__ void xcd_barrier(const XcdBarrier& b, int tid) {
    asm volatile("s_waitcnt vmcnt(0)" ::: "memory");
    __syncthreads();
    if (tid == 0) {
        unsigned* bar = b.bar;
        __builtin_amdgcn_s_waitcnt(0);
        unsigned nloc = b.st[0], nx = b.st[1];
        if (nloc == 0u) { xcd_barrier_complete(bar, b.x, nloc, nx); b.st[0] = nloc; b.st[1] = nx; }
        const unsigned old = xb_add(&bar[XB_XSUB(b.x)], 1u);
        const unsigned gen = old / nloc;
        if (old + 1u == (gen + 1u) * nloc) {
            __builtin_amdgcn_fence(__ATOMIC_RELEASE, "agent");
            asm volatile("s_waitcnt vmcnt(0)" ::: "memory");
            const unsigned og = xb_add(&bar[XB_TOP], 1u);
            const unsigned tg = og / nx;
            if (og + 1u == (tg + 1u) * nx) xb_add(&bar[XB_TOPGEN], 1u);
            else XB_SPIN(xb_ld(&bar[XB_TOPGEN]) == tg, bar);
            __builtin_amdgcn_fence(__ATOMIC_ACQUIRE, "agent");
            xb_add(&bar[XB_XGEN(b.x)], 1u);
            asm volatile("s_waitcnt vmcnt(0)" ::: "memory");
        } else {
            XB_SPIN(xb_ld(&bar[XB_XGEN(b.x)]) == gen, bar);
            __builtin_amdgcn_fence(__ATOMIC_ACQUIRE, "agent");
            asm volatile("s_waitcnt vmcnt(0)" ::: "memory");
        }
    }
    __syncthreads();
}

constexpr int NPHASE = 19;
__global__ void __launch_bounds__(NTHR, 2) mega_fwd(Prm p) {
    extern __shared__ __attribute__((aligned(16))) unsigned char lds[];
    Frame F; F.lds = lds; F.ctl = (unsigned*)(p.ws + WS_CTL);
    F.tid = threadIdx.x; F.lane = F.tid & 63; F.wave = __builtin_amdgcn_readfirstlane(F.tid >> 6); F.G = gridDim.x; F.bid = blockIdx.x;
    for (int u = F.tid; u < (LDS_BYTES - LDSCTL_OFF) / 4; u += NTHR) ((LAS unsigned*)(lds + LDSCTL_OFF))[u] = 0u;
    __syncthreads();
    const int lo = p.ph_lo, hi = p.ph_hi;
    const bool multi = (hi - lo) > 1;
    XcdBarrier bar; bar.bar = F.ctl + CW_BAR + p.li * XCD_BAR_WORDS; bar.x = 0; bar.st = nullptr;
    if (multi) bar = xcd_barrier_post(F.ctl + CW_BAR + p.li * XCD_BAR_WORDS, (volatile LAS unsigned*)(lds + MISC_OFF) + 8);
#define IN(k) (lo <= (k) && (k) < hi)
#define SEAM(k) do { if (IN(k) && IN((k) + 1)) xcd_barrier(bar, F.tid); } while (0)
    if (IN(0)) { phase_prologue(F, p); } SEAM(0);
    if (IN(1)) { phase_modulate0(F, p); } SEAM(1);
    if (IN(2)) { PHASE_QKV(F, p); } SEAM(2);
    if (IN(3)) { PHASE_ATTN(F, p); }
    {
        int l_; asm volatile("v_mbcnt_lo_u32_b32 %0, -1, 0\n\tv_mbcnt_hi_u32_b32 %0, -1, %0" : "=v"(l_)); F.lane = l_; F.tid = F.wave * 64 + l_; }
    SEAM(3);
    if (IN(5)) { PHASE_WO(F, p, 0); } SEAM(5);
    if (IN(6)) { phase_ln_route(F, p, 0); } SEAM(6);
    if (IN(7)) { PHASE_MOE1(F, p, 0); } SEAM(7);
    if (IN(8)) { PHASE_MOE2(F, p, 0); } SEAM(8);
    if (IN(9)) { phase_moe_combine(F, p, 0); } SEAM(9);
    if (IN(10)) { PHASE_INPROJ(F, p); } SEAM(10);
    if (IN(11)) { phase_gla_prep(F, p); } SEAM(11);
    if (IN(12)) { PHASE_SCAN(F, p); } SEAM(12);
    if (IN(13)) { phase_gla_post(F, p); } SEAM(13);
    if (IN(14)) { PHASE_WO(F, p, 1); } SEAM(14);
    if (IN(15)) { phase_ln_route(F, p, 1); } SEAM(15);
    if (IN(16)) { PHASE_MOE1(F, p, 1); } SEAM(16);
    if (IN(17)) { PHASE_MOE2(F, p, 1); } SEAM(17);
    if (IN(18)) { phase_moe_combine(F, p, 1); }
#undef IN
#undef SEAM
}

extern "C" void kernel_launch(void* const* d_in, const int* in_sizes, int n_in, void* d_out, int out_size, void* d_ws, size_t ws_size, hipStream_t stream) {
    static int grid = 0;
    if (grid == 0) {
        if (n_in != 23 || in_sizes[0] != NLAT * DM || out_size != NLAT * DM || ws_size < WS_END) { fprintf(stderr, "kernel_launch: unexpected shapes (n_in %d, in0 %d, out %d, ws %zu); nothing launched\n", n_in, n_in > 0 ? in_sizes[0] : -1, out_size, ws_size); grid = -1; return; }
        int dev = 0, cus = 0;
        if (hipGetDevice(&dev) != hipSuccess || hipDeviceGetAttribute(&cus, hipDeviceAttributeMultiprocessorCount, dev) != hipSuccess) { grid = -1; return; }
        if (hipFuncSetAttribute((const void*)mega_fwd, hipFuncAttributeMaxDynamicSharedMemorySize, LDS_BYTES) != hipSuccess) { fprintf(stderr, "kernel_launch: hipFuncSetAttribute failed\n"); grid = -1; return; }
        int per_cu = 0;
        if (hipOccupancyMaxActiveBlocksPerMultiprocessor(&per_cu, (const void*)mega_fwd, NTHR, LDS_BYTES) != hipSuccess || per_cu < 1) fprintf(stderr, "kernel_launch: note: occupancy query reports %d\n", per_cu);
        (void)hipGetLastError();
        grid = cus;
    }
    if (grid < 0) return;
    (void)hipMemsetAsync((char*)d_ws + WS_CTL, 0, CTL_ZERO_BYTES, stream);
    Prm p{};
    const float** pp = (const float**)&p;
    for (int i = 0; i < 23; ++i) pp[i] = (const float*)d_in[i];
    p.out = (float*)d_out; p.ws = (unsigned char*)d_ws;
    p.ph_lo = 0; p.ph_hi = NPHASE; p.li = 0;
    hipLaunchKernelGGL(mega_fwd, dim3(grid), dim3(NTHR), LDS_BYTES, stream, p);
}
```

```cpp
#include <hip/hip_runtime.h>
#include <cstdint>
#include <cstdio>

constexpr int BATCH = 8, SEQ = 4096, DM = 1024, CTXL = 256;
constexpr int NLAT = BATCH * SEQ, NCTX = BATCH * CTXL, NTOK = NLAT + NCTX;
constexpr float ALPHA = 1.4142135623730951f;
constexpr float LN_EPS = 1e-5f;
constexpr float LAMBDA_INIT0 = 0.2f;
constexpr float C2 = 0.125f * 1.4426950408889634f;
constexpr int NEXP = 16, DEXP = 512, MAXSLOT = 73728;
constexpr int NCHUNK = NTOK / 64;
constexpr int NIN = 3328;

typedef unsigned short bf16;
typedef float f32x4 __attribute__((ext_vector_type(4)));
typedef float f32x2 __attribute__((ext_vector_type(2)));
typedef unsigned u32x2 __attribute__((ext_vector_type(2)));
typedef unsigned u32x4 __attribute__((ext_vector_type(4)));

constexpr size_t MiB = 1u << 20;
constexpr size_t WS_CTL = 0, CTL_ZERO_BYTES = 1 * MiB;
constexpr size_t WS_MOD = 1 * MiB;
constexpr size_t WS_MISC = 1 * MiB + 512 * 1024;
constexpr size_t WS_WQKV = 2 * MiB, WS_WO = 5 * MiB, WS_GU0 = 6 * MiB, WS_DN0 = 22 * MiB, WS_WIN = 30 * MiB, WS_WGO = 34 * MiB, WS_GU1 = 35 * MiB, WS_DN1 = 51 * MiB;
constexpr size_t WS_XB = 59 * MiB;
constexpr size_t WS_H = 127 * MiB;
constexpr size_t WS_Q = 195 * MiB, WS_K = 263 * MiB, WS_V = 331 * MiB, WS_O2 = 399 * MiB;
constexpr size_t WS_LIST = 467 * MiB;
constexpr size_t WS_TOKR = 470 * MiB;
constexpr size_t WS_DEC = 472 * MiB;
constexpr size_t WS_ZZ = 475 * MiB;
constexpr size_t WS_END = 480 * MiB;
constexpr size_t WS_O1 = WS_H, WS_A2 = WS_H, WS_Y = WS_K;
constexpr size_t WS_YM = 195 * MiB, WS_ACT = 339 * MiB;
constexpr size_t WS_QR = 195 * MiB, WS_KR = 229 * MiB, WS_V1 = 263 * MiB, WS_R = 331 * MiB;
constexpr size_t WS_QT = WS_H, WS_KT = 399 * MiB;
constexpr size_t WS_A2B = WS_H;
constexpr size_t OUT_OGB = 64 * MiB;
constexpr int CW_TMO = 0, CW_CODE = 1;
constexpr int CW_CNT = 64;
constexpr int CW_KM = 128;
constexpr int CW_BAR = 4096;

__device__ __forceinline__ unsigned f2bf(float f) { unsigned u = __builtin_bit_cast(unsigned, f); return (u + 0x7fffu + ((u >> 16) & 1u)) >> 16; }
__device__ __forceinline__ unsigned pk2(float lo, float hi) { return f2bf(lo) | (f2bf(hi) << 16); }
__device__ __forceinline__ float bf2f(unsigned b) { return __builtin_bit_cast(float, b << 16); }
__device__ __forceinline__ float wave_sum(float v) {
#pragma unroll
    for (int o = 1; o < 64; o <<= 1) v += __shfl_xor(v, o);
    return v;
}
__device__ __forceinline__ float silu_f(float v) { return v / (1.f + __expf(-v)); }

struct Prm {
    const float *x, *c, *ctx, *cctx, *ada_w, *ada_b, *ln_g, *ln_b, *w_qkv, *w_o, *lam, *subln, *gw_in, *gwg_down, *gwg_up, *gbg, *gnorm, *gw_o, *rw, *rb, *mg, *mu, *md;
    float* out; unsigned char* ws;
    int ph_lo, ph_hi, li, pad;
};
__device__ __forceinline__ void ld_row_f32(const float* p, int lane, f32x4 (&v)[4]) {
#pragma unroll
    for (int j = 0; j < 4; ++j) v[j] = *(const f32x4*)(p + 4 * lane + 256 * j);
}
__device__ __forceinline__ void st_row_f32(float* p, int lane, const f32x4 (&v)[4]) {
#pragma unroll
    for (int j = 0; j < 4; ++j) *(f32x4*)(p + 4 * lane + 256 * j) = v[j];
}
__device__ __forceinline__ void ld_row_bf16(const bf16* p, int lane, f32x4 (&v)[4]) {
#pragma unroll
    for (int j = 0; j < 4; ++j) { const u32x2 u = *(const u32x2*)(p + 4 * lane + 256 * j); v[j] = (f32x4){bf2f(u.x & 0xffffu), bf2f(u.x >> 16), bf2f(u.y & 0xffffu), bf2f(u.y >> 16)}; }
}
__device__ __forceinline__ void st_row_bf16(bf16* p, int lane, const f32x4 (&v)[4]) {
#pragma unroll
    for (int j = 0; j < 4; ++j) { u32x2 u; u.x = pk2(v[j].x, v[j].y); u.y = pk2(v[j].z, v[j].w); *(u32x2*)(p + 4 * lane + 256 * j) = u; }
}
__device__ __forceinline__ void ln_row(f32x4 (&v)[4], const float* g, const float* b, int lane) {
    float s = 0.f;
#pragma unroll
    for (int j = 0; j < 4; ++j) s += (v[j].x + v[j].y) + (v[j].z + v[j].w);
    const float mean = wave_sum(s) * (1.f / DM); float q = 0.f;
#pragma unroll
    for (int j = 0; j < 4; ++j) { v[j] = v[j] - mean; q += (v[j].x * v[j].x + v[j].y * v[j].y) + (v[j].z * v[j].z + v[j].w * v[j].w); }
    const float rstd = 1.f / sqrtf(wave_sum(q) * (1.f / DM) + LN_EPS);
#pragma unroll
    for (int j = 0; j < 4; ++j) { const f32x4 gg = *(const f32x4*)(g + 4 * lane + 256 * j), bb = *(const f32x4*)(b + 4 * lane + 256 * j); v[j] = v[j] * rstd * gg + bb; }
}
__host__ __device__ __forceinline__ int gu_phys(int other, int sel) { return (other >> 4) * 32 + sel * 16 + (other & 15); }
__host__ __device__ __forceinline__ int perm16b(int L) { return (L & ~31) | (16 * ((L >> 2) & 1) + 4 * ((L >> 3) & 3) + (L & 3)); }
__host__ __device__ __forceinline__ int perm16b_inv(int P) { return (P & ~31) | (8 * ((P >> 2) & 3) + 4 * ((P >> 4) & 1) + (P & 3)); }
__device__ __forceinline__ unsigned pk4_fp8(float a, float b, float c, float d) { int w = 0; w = __builtin_amdgcn_cvt_pk_fp8_f32(a, b, w, false); w = __builtin_amdgcn_cvt_pk_fp8_f32(c, d, w, true); return (unsigned)w; }
constexpr float W8_SCALE = 64.f, W8_INV = 1.f / 64.f;
__device__ __forceinline__ void st_row_fp8(unsigned char* p, int lane, const f32x4 (&v)[4]) {
#pragma unroll
    for (int j = 0; j < 4; ++j) *(unsigned*)(p + 4 * lane + 256 * j) = pk4_fp8(v[j].x, v[j].y, v[j].z, v[j].w);
}
__device__ __forceinline__ void ld_row_fp8(const unsigned char* p, int lane, f32x4 (&v)[4]) {
#pragma unroll
    for (int j = 0; j < 4; ++j) { const int w = *(const int*)(p + 4 * lane + 256 * j); const f32x2 lo = __builtin_amdgcn_cvt_pk_f32_fp8(w, false), hi = __builtin_amdgcn_cvt_pk_f32_fp8(w, true); v[j] = (f32x4){lo.x, lo.y, hi.x, hi.y}; }
}
#define GAS __attribute__((address_space(1)))
#define LAS __attribute__((address_space(3)))
constexpr int NWAVES = 8, NTHR = NWAVES * 64;
constexpr int RING_BYTES = 131072, LDS_BYTES = 147456, LDSCTL_OFF = LDS_BYTES - 1024, MISC_OFF = LDSCTL_OFF + 320;
constexpr int LDSX_OFF = RING_BYTES + 1024;
#define LDS_WAIT() asm volatile("s_waitcnt lgkmcnt(0)" ::: "memory")
#define VM_WAIT() asm volatile("s_waitcnt vmcnt(0)" ::: "memory")

struct Frame {
    unsigned char* lds;
    unsigned* ctl;
    int tid, lane, wave, G, bid;
};

template <int MODE>
__device__ __forceinline__ void p0_transpose_item(const float* W, int K, int N, bf16* WT, int row_off, float* scr, int item, int lane) {
    const int nblk = N / 32, kb = item / nblk, nb = item % nblk, k0 = 64 * kb, n0 = 32 * nb;
    { f32x4 t[8];
#pragma unroll
        for (int i = 0; i < 8; ++i) t[i] = *(const f32x4*)(W + (size_t)(k0 + 8 * i + (lane >> 3)) * N + n0 + 4 * (lane & 7));
#pragma unroll
        for (int i = 0; i < 8; ++i) { float* d = scr + (8 * i + (lane >> 3)) * 33 + 4 * (lane & 7); d[0] = t[i].x; d[1] = t[i].y; d[2] = t[i].z; d[3] = t[i].w; } }
    LDS_WAIT(); asm volatile("" ::: "memory");
    const int c = lane & 7;
#pragma unroll
    for (int j = 0; j < 4; ++j) { const int n = (lane >> 3) + 8 * j; const float* s = scr + (8 * c) * 33 + n;
        u32x4 o; o.x = pk2(s[0 * 33], s[1 * 33]); o.y = pk2(s[2 * 33], s[3 * 33]); o.z = pk2(s[4 * 33], s[5 * 33]); o.w = pk2(s[6 * 33], s[7 * 33]);
        const int nl = n0 + n; const int pr = (MODE == 0) ? (row_off + nl) : (MODE == 3) ? (row_off + perm16b(nl)) : (row_off + gu_phys(nl, MODE - 1));
        *(u32x4*)(WT + (size_t)pr * K + k0 + 8 * c) = o; }
    LDS_WAIT(); asm volatile("" ::: "memory");
}
template <int MODE>
__device__ __forceinline__ void p0_transpose_item8(const float* W, int K, int N, unsigned char* WT, float* scr, int item, int lane) {
    const int nblk = N / 32, kb = item / nblk, nb = item % nblk, k0 = 64 * kb, n0 = 32 * nb;
    { f32x4 t[8];
#pragma unroll
        for (int i = 0; i < 8; ++i) t[i] = *(const f32x4*)(W + (size_t)(k0 + 8 * i + (lane >> 3)) * N + n0 + 4 * (lane & 7));
#pragma unroll
        for (int i = 0; i < 8; ++i) { float* d = scr + (8 * i + (lane >> 3)) * 33 + 4 * (lane & 7); d[0] = t[i].x; d[1] = t[i].y; d[2] = t[i].z; d[3] = t[i].w; } }
    LDS_WAIT(); asm volatile("" ::: "memory");
    const int c = lane & 7;
#pragma unroll
    for (int j = 0; j < 4; ++j) { const int n = (lane >> 3) + 8 * j; const float* s = scr + (8 * c) * 33 + n;
        u32x2 o; o.x = pk4_fp8(s[0 * 33] * W8_SCALE, s[1 * 33] * W8_SCALE, s[2 * 33] * W8_SCALE, s[3 * 33] * W8_SCALE); o.y = pk4_fp8(s[4 * 33] * W8_SCALE, s[5 * 33] * W8_SCALE, s[6 * 33] * W8_SCALE, s[7 * 33] * W8_SCALE);
        const int nl = n0 + n; const int pr = (MODE == 3 || MODE == 4) ? perm16b(nl) : (MODE == 0) ? nl : gu_phys(nl, MODE - 1);
        if (MODE == 4) {
            unsigned char* d = WT + (size_t)pr * K + (k0 & ~127) + 16 * c + 4 * ((k0 >> 6) & 1);
            *(unsigned*)d = o.x; *(unsigned*)(d + 8) = o.y;
        } else *(u32x2*)(WT + (size_t)pr * K + k0 + 8 * c) = o; }
    LDS_WAIT(); asm volatile("" ::: "memory");
}
__device__ __forceinline__ void phase_prologue(const Frame& F, const Prm& p) {
    float* sil = (float*)F.lds;
    for (int i = F.tid; i < 9 * 1024; i += NTHR) { const int r = i >> 10, k = i & 1023; const float v = (r < 8) ? p.c[r * 1024 + k] : p.cctx[k]; sil[i] = silu_f(v); }
    __syncthreads();
    float* MOD = (float*)(p.ws + WS_MOD);
    if (F.bid < 192) {
        const int layer = F.bid / 96, n = (F.bid % 96) * 64 + F.lane; const float* W = p.ada_w + (size_t)layer * 1024 * 6144 + n;
        float acc[9];
#pragma unroll
        for (int r = 0; r < 9; ++r) acc[r] = 0.f;
        const int kb = F.wave * 128;
#pragma unroll 4
        for (int k = kb; k < kb + 128; k += 4) {
            const float w0 = W[(size_t)k * 6144], w1 = W[(size_t)(k + 1) * 6144], w2 = W[(size_t)(k + 2) * 6144], w3 = W[(size_t)(k + 3) * 6144];
#pragma unroll
            for (int r = 0; r < 9; ++r) { const f32x4 s = *(const f32x4*)(sil + r * 1024 + k); acc[r] += s.x * w0 + s.y * w1 + s.z * w2 + s.w * w3; }
        }
        float* red = (float*)(F.lds + 36864 + 8 * 8704);
#pragma unroll
        for (int r = 0; r < 9; ++r) red[(F.wave * 9 + r) * 64 + F.lane] = acc[r];
        __syncthreads();
        if (F.wave == 0) { const float bb = p.ada_b[layer * 6144 + n];
#pragma unroll
            for (int r = 0; r < 9; ++r) { float t = bb;
#pragma unroll
                for (int w = 0; w < 8; ++w) t += red[(w * 9 + r) * 64 + F.lane];
                MOD[(layer * 9 + r) * 6144 + n] = t; } }
    }
    float* misc = (float*)(p.ws + WS_MISC);
    if (F.bid == 255 % F.G && F.wave == 1) {
        const float a = wave_sum(p.lam[F.lane] * p.lam[64 + F.lane]), b = wave_sum(p.lam[128 + F.lane] * p.lam[192 + F.lane]);
        if (F.lane == 0) misc[0] = __expf(a) - __expf(b) + LAMBDA_INIT0;
        for (int i = F.lane; i < 1024; i += 64) { const int pos = i >> 4, f = i & 15; const float inv = powf(10000.f, -(float)f / 16.f); const float ang = (float)pos * inv;
            misc[1024 + 2 * i] = cosf(ang); misc[1024 + 2 * i + 1] = sinf(ang); }
    }
    float* scr = (float*)(F.lds + 36864 + F.wave * 8704);
    const int gw = F.bid * NWAVES + F.wave, NGW = F.G * NWAVES;
    constexpr int I_QKV = 16 * 96, I_SQ = 16 * 32, I_G = 16 * 16, I_D = 8 * 32;
    constexpr int I_MOE = 2 * I_G + I_D;
    constexpr int NITEMS = 2 * I_QKV + 2 * I_SQ + 32 * I_MOE;
    bf16* ws16 = (bf16*)p.ws;
    for (int it = gw; it < NITEMS; it += NGW) {
        int r = it;
        if (r < I_QKV) { if ((r % 96) < 64) p0_transpose_item8<0>(p.w_qkv, 1024, 3072, p.ws + WS_WQKV, scr, r, F.lane); else p0_transpose_item8<3>(p.w_qkv, 1024, 3072, p.ws + WS_WQKV, scr, r, F.lane); continue; } r -= I_QKV;
        if (r < I_QKV) { p0_transpose_item8<3>(p.gw_in, 1024, 3072, p.ws + WS_WIN, scr, r, F.lane); continue; } r -= I_QKV;
        if (r < I_SQ) { p0_transpose_item8<3>(p.w_o, 1024, 1024, p.ws + WS_WO, scr, r, F.lane); continue; } r -= I_SQ;
        if (r < I_SQ) { p0_transpose_item8<3>(p.gw_o, 1024, 1024, p.ws + WS_WGO, scr, r, F.lane); continue; } r -= I_SQ;
        const int le = r / I_MOE, layer = le >> 4, e = le & 15; r -= le * I_MOE;
        unsigned char* GU = p.ws + (layer ? WS_GU1 : WS_GU0) + (size_t)e * 1024 * 1024; unsigned char* DN = p.ws + (layer ? WS_DN1 : WS_DN0) + (size_t)e * 1024 * 512;
        if (r < I_G) { p0_transpose_item8<1>(p.mg + (size_t)le * 1024 * 512, 1024, 512, GU, scr, r, F.lane); continue; } r -= I_G;
        if (r < I_G) { p0_transpose_item8<2>(p.mu + (size_t)le * 1024 * 512, 1024, 512, GU, scr, r, F.lane); continue; } r -= I_G;
        p0_transpose_item8<4>(p.md + (size_t)le * 512 * 1024, 512, 1024, DN, scr, r, F.lane);
    }
    (void)ws16;
    unsigned char* WIN = p.ws + WS_WIN;
    for (int i = gw * 64 + F.lane; i < 32 * 256; i += NGW * 64) { const int rr = i >> 8, k = (i & 255) * 4, dir = rr >> 4, j = rr & 15; const float* s = p.gwg_down + (size_t)dir * 1024 * 16 + j;
        *(unsigned*)(WIN + (size_t)(3072 + rr) * 1024 + k) = pk4_fp8(s[(size_t)k * 16] * W8_SCALE, s[(size_t)(k + 1) * 16] * W8_SCALE, s[(size_t)(k + 2) * 16] * W8_SCALE, s[(size_t)(k + 3) * 16] * W8_SCALE); }
    for (int i = gw * 64 + F.lane; i < 224 * 1024 / 16; i += NGW * 64) *(u32x4*)(WIN + (size_t)3104 * 1024 + (size_t)i * 16) = (u32x4){0u, 0u, 0u, 0u};
}

__device__ __forceinline__ void phase_modulate0(const Frame& F, const Prm& p) {
    const float* MOD = (const float*)(p.ws + WS_MOD); unsigned char* H = p.ws + WS_H;
    const int gw = F.bid * NWAVES + F.wave, NGW = F.G * NWAVES, per = (NTOK + NGW - 1) / NGW;
    int curmod = -1; f32x4 sh[4], sc[4];
    const int t0 = gw * per, t1 = min(NTOK, (gw + 1) * per);
    f32x4 v[4], vn[4];
    if (t0 < t1) ld_row_f32(t0 < NLAT ? p.x + (size_t)t0 * DM : p.ctx + (size_t)(t0 - NLAT) * DM, F.lane, v);
    for (int tok = t0; tok < t1; ++tok) {
        if (tok + 1 < t1) ld_row_f32(tok + 1 < NLAT ? p.x + (size_t)(tok + 1) * DM : p.ctx + (size_t)(tok + 1 - NLAT) * DM, F.lane, vn);
        const int mr = tok < NLAT ? tok / SEQ : 8;
        if (mr != curmod) { curmod = mr; ld_row_f32(MOD + mr * 6144, F.lane, sh); ld_row_f32(MOD + mr * 6144 + 1024, F.lane, sc); }
#pragma unroll
        for (int j = 0; j < 4; ++j) v[j] = v[j] * (1.f + sc[j]) + sh[j];
        st_row_fp8(H + (size_t)tok * DM, F.lane, v);
#pragma unroll
        for (int j = 0; j < 4; ++j) v[j] = vn[j];
    }
}

__device__ __forceinline__ void phase_ln_route(const Frame& F, const Prm& p, int layer) {
    const int nrows = layer ? NLAT : NTOK;
    const float* MOD = (const float*)(p.ws + WS_MOD) + layer * 9 * 6144;
    const bf16* Y = (const bf16*)(p.ws + WS_Y); unsigned char* HF = p.ws + WS_H;
    bf16* XB = (bf16*)(p.ws + WS_XB);
    int* LIST = (int*)(p.ws + WS_LIST); int* TOKR = (int*)(p.ws + WS_TOKR);
    unsigned* CNT = F.ctl + CW_CNT + layer * 16;
    float* WrT = (float*)F.lds;
    int* rec = (int*)(F.lds + 65536);
    unsigned* lcnt = (unsigned*)(F.lds + 65536 + 8192); unsigned* lbase = lcnt + 16;
    for (int i = F.tid; i < 16 * 1024; i += NTHR) { const int k = i >> 4, e = i & 15; WrT[e * 1024 + k] = p.rw[i]; }
    if (F.tid < 16) lcnt[F.tid] = 0u;
    __syncthreads();
    const int per_wg = (nrows + F.G - 1) / F.G, per_w = (per_wg + NWAVES - 1) / NWAVES;
    const int row_lo = F.bid * per_wg, row_hi = min(nrows, row_lo + per_wg);
    const float* lng = p.ln_g + (layer * 2 + 0) * DM; const float* lnb = p.ln_b + (layer * 2 + 0) * DM;
    float rb[16];
#pragma unroll
    for (int e = 0; e < 16; ++e) rb[e] = p.rb[e];
    int curmod = -1; f32x4 gm[4], shf[4], scf[4];
    f32x4 v[4], y[4], vn[4], yn[4];
#define LNR_LOAD(tok_, V, Yv) do { if (layer) ld_row_bf16(XB + (size_t)(tok_) * DM, F.lane, V); else ld_row_f32((tok_) < NLAT ? p.x + (size_t)(tok_) * DM : p.ctx + (size_t)((tok_) - NLAT) * DM, F.lane, V); \
        ld_row_bf16(Y + (size_t)(tok_) * DM, F.lane, Yv); } while (0)
    if (row_lo + F.wave * per_w < row_hi) LNR_LOAD(row_lo + F.wave * per_w, v, y);
    for (int i = 0; i < per_w; ++i) {
        const int lr = F.wave * per_w + i, tok = row_lo + lr; if (tok >= row_hi) break;
        if (i + 1 < per_w && tok + 1 < row_hi) LNR_LOAD(tok + 1, vn, yn);
        const int mr = tok < NLAT ? tok / SEQ : 8;
        if (mr != curmod) { curmod = mr; ld_row_f32(MOD + mr * 6144 + 2048, F.lane, gm); ld_row_f32(MOD + mr * 6144 + 3072, F.lane, shf); ld_row_f32(MOD + mr * 6144 + 4096, F.lane, scf); }
        bf16* xdst = XB + (size_t)tok * DM;
#pragma unroll
        for (int j = 0; j < 4; ++j) v[j] = ALPHA * v[j] + gm[j] * y[j];
        ln_row(v, lng, lnb, F.lane);
        st_row_bf16(xdst, F.lane, v);
#pragma unroll
        for (int j = 0; j < 4; ++j) v[j] = v[j] * (1.f + scf[j]) + shf[j];
        st_row_fp8(HF + (size_t)tok * DM, F.lane, v);
        float part[16];
#pragma unroll
        for (int e = 0; e < 16; ++e) { float s = 0.f;
#pragma unroll
            for (int j = 0; j < 4; ++j) { const f32x4 w = *(const f32x4*)(WrT + e * 1024 + 4 * F.lane + 256 * j); s += (v[j].x * w.x + v[j].y * w.y) + (v[j].z * w.z + v[j].w * w.w); }
            part[e] = s; }
        {
#pragma unroll
            for (int e = 0; e < 8; ++e) { const bool up = (F.lane & 32) != 0; const float keep = up ? part[e + 8] : part[e], send = up ? part[e] : part[e + 8]; part[e] = keep + __shfl_xor(send, 32); }
#pragma unroll
            for (int e = 0; e < 4; ++e) { const bool up = (F.lane & 16) != 0; const float keep = up ? part[e + 4] : part[e], send = up ? part[e] : part[e + 4]; part[e] = keep + __shfl_xor(send, 16); }
#pragma unroll
            for (int e = 0; e < 2; ++e) { const bool up = (F.lane & 8) != 0; const float keep = up ? part[e + 2] : part[e], send = up ? part[e] : part[e + 2]; part[e] = keep + __shfl_xor(send, 8); }
            { const bool up = (F.lane & 4) != 0; const float keep = up ? part[1] : part[0], send = up ? part[0] : part[1]; part[0] = keep + __shfl_xor(send, 4); }
            part[0] += __shfl_xor(part[0], 2); part[0] += __shfl_xor(part[0], 1);
        }
        float aff[16], sel[16];
#pragma unroll
        for (int e = 0; e < 16; ++e) { const int src = ((e >> 3) & 1) * 32 + ((e >> 2) & 1) * 16 + ((e >> 1) & 1) * 8 + (e & 1) * 4; const float lg = __shfl(part[0], src); aff[e] = 1.f / (1.f + __expf(-lg)); sel[e] = aff[e] + rb[e]; }
        int bg = 0; float bgs = -3.0e38f;
#pragma unroll
        for (int g = 0; g < 4; ++g) { float m1 = -3.0e38f, m2 = -3.0e38f;
#pragma unroll
            for (int k = 0; k < 4; ++k) { const float s = sel[4 * g + k]; if (s > m1) { m2 = m1; m1 = s; } else if (s > m2) m2 = s; }
            const float gs = m1 + m2; if (gs > bgs) { bgs = gs; bg = g; } }
        int i1 = 0, i2 = 0; float s1 = -3.0e38f, s2 = -3.0e38f, a1 = 0.f, a2 = 0.f;
#pragma unroll
        for (int g = 0; g < 4; ++g) if (g == bg) {
#pragma unroll
            for (int k = 0; k < 4; ++k) { const float s = sel[4 * g + k], a = aff[4 * g + k];
                if (s > s1) { s2 = s1; i2 = i1; a2 = a1; s1 = s; i1 = 4 * g + k; a1 = a; } else if (s > s2) { s2 = s; i2 = 4 * g + k; a2 = a; } } }
        const float wsum = a1 + a2, w1 = a1 / wsum, w2 = a2 / wsum;
        if (F.lane == 0) { const unsigned l1 = atomicAdd(&lcnt[i1], 1u), l2 = atomicAdd(&lcnt[i2], 1u);
            rec[lr * 6 + 0] = i1; rec[lr * 6 + 1] = i2; rec[lr * 6 + 2] = (int)l1; rec[lr * 6 + 3] = (int)l2; rec[lr * 6 + 4] = __float_as_int(w1); rec[lr * 6 + 5] = __float_as_int(w2); }
#pragma unroll
        for (int j = 0; j < 4; ++j) { v[j] = vn[j]; y[j] = yn[j]; }
    }
#undef LNR_LOAD
    __syncthreads();
    if (F.tid < 16) lbase[F.tid] = __hip_atomic_fetch_add(&CNT[F.tid], lcnt[F.tid], __ATOMIC_RELAXED, __HIP_MEMORY_SCOPE_AGENT);
    __syncthreads();
    for (int lr = F.tid; lr < row_hi - row_lo; lr += NTHR) { const int tok = row_lo + lr;
        const int e0 = rec[lr * 6], e1 = rec[lr * 6 + 1]; const int p0 = (int)lbase[e0] + rec[lr * 6 + 2], p1 = (int)lbase[e1] + rec[lr * 6 + 3];
        LIST[e0 * NTOK + p0] = tok; LIST[e1 * NTOK + p1] = tok;
        int* tr = TOKR + (size_t)tok * 8; tr[0] = e0; tr[1] = p0; tr[2] = e1; tr[3] = p1; tr[4] = rec[lr * 6 + 4]; tr[5] = rec[lr * 6 + 5]; }
    __syncthreads();
}

__device__ __forceinline__ void pad_bases(const unsigned* cnt, int (&pb)[17]) {
    int acc = 0;
#pragma unroll
    for (int e = 0; e < 16; ++e) { pb[e] = acc; const int c = (int)__hip_atomic_load(cnt + e, __ATOMIC_RELAXED, __HIP_MEMORY_SCOPE_AGENT); acc += (c + 255) & ~255; }
    pb[16] = acc;
}

__device__ __forceinline__ void phase_moe_combine(const Frame& F, const Prm& p, int layer) {
    const int nrows = layer ? NLAT : NTOK;
    const float* MOD = (const float*)(p.ws + WS_MOD) + layer * 9 * 6144; const float* MOD1 = (const float*)(p.ws + WS_MOD) + 9 * 6144;
    const unsigned char* YM = p.ws + WS_YM;   unsigned char* H = p.ws + WS_H;   bf16* XB = (bf16*)(p.ws + WS_XB); const int* TOKR = (const int*)(p.ws + WS_TOKR);
    int pb[17]; pad_bases(F.ctl + CW_CNT + layer * 16, pb);
    int* pbl = (int*)F.lds; if (F.tid < 17) { int v = 0;
#pragma unroll
        for (int e = 0; e < 17; ++e) if (e == F.tid) v = pb[e];
        pbl[F.tid] = v; }
    __syncthreads();
    const float* lng = p.ln_g + (layer * 2 + 1) * DM; const float* lnb = p.ln_b + (layer * 2 + 1) * DM;
    const int gw = F.bid * NWAVES + F.wave, NGW = F.G * NWAVES, per = (nrows + NGW - 1) / NGW;
    int curmod = -1; f32x4 gf[4], sh1[4], sc1[4];
    typedef int i32x4r __attribute__((ext_vector_type(4)));
    const int t0 = gw * per, t1 = min(nrows, (gw + 1) * per);
    i32x4r ra = {0, 0, 0, 0}, rb = {0, 0, 0, 0}, rc = {0, 0, 0, 0}; f32x2 wa = {0.f, 0.f}, wb = {0.f, 0.f}, wc = {0.f, 0.f};
#define MC_REC(tok_, R, W) do { const int* tr_ = TOKR + (size_t)(tok_) * 8; R = *(const i32x4r*)tr_; W = *(const f32x2*)(tr_ + 4); } while (0)
#define MC_ROWS(tok_, R, V, A, B) do { ld_row_bf16(XB + (size_t)(tok_) * DM, F.lane, V); ld_row_fp8(YM + (size_t)(pbl[R.x] + R.y) * DM, F.lane, A); ld_row_fp8(YM + (size_t)(pbl[R.z] + R.w) * DM, F.lane, B); } while (0)
    f32x4 v[4], a[4], b[4], vn[4], an[4], bn[4];
    if (t0 < t1) { MC_REC(t0, ra, wa); if (t0 + 1 < t1) MC_REC(t0 + 1, rb, wb); MC_ROWS(t0, ra, v, a, b); }
    for (int tok = t0; tok < t1; ++tok) {
        if (tok + 1 < t1) MC_ROWS(tok + 1, rb, vn, an, bn);
        if (tok + 2 < t1) MC_REC(tok + 2, rc, wc);
        const int mr = tok < NLAT ? tok / SEQ : 8;
        if (mr != curmod) { curmod = mr; ld_row_f32(MOD + mr * 6144 + 5120, F.lane, gf); if (!layer) { ld_row_f32(MOD1 + mr * 6144, F.lane, sh1); ld_row_f32(MOD1 + mr * 6144 + 1024, F.lane, sc1); } }
        const float w0 = wa.x, w1 = wa.y;
        bf16* xp = XB + (size_t)tok * DM;
#pragma unroll
        for (int j = 0; j < 4; ++j) v[j] = ALPHA * v[j] + gf[j] * (w0 * a[j] + w1 * b[j]);
        ln_row(v, lng, lnb, F.lane);
        if (layer) st_row_f32(p.out + (size_t)tok * DM, F.lane, v); else st_row_bf16(xp, F.lane, v);
        if (!layer) {
#pragma unroll
            for (int j = 0; j < 4; ++j) v[j] = v[j] * (1.f + sc1[j]) + sh1[j];
            st_row_fp8(H + (size_t)tok * DM, F.lane, v);
        }
#pragma unroll
        for (int j = 0; j < 4; ++j) { v[j] = vn[j]; a[j] = an[j]; b[j] = bn[j]; }
        ra = rb; wa = wb; rb = rc; wb = wc;
    }
#undef MC_REC
#undef MC_ROWS
}

__device__ __forceinline__ void phase_gla_prep(const Frame& F, const Prm& p) {
    typedef short bf16x8v __attribute__((ext_vector_type(8))); typedef float f32x16v __attribute__((ext_vector_type(16)));
    const bf16* QR = (const bf16*)(p.ws + WS_QR); const bf16* KR = (const bf16*)(p.ws + WS_KR); const float* ZZ = (const float*)(p.ws + WS_ZZ);
    bf16* QT = (bf16*)(p.ws + WS_QT); bf16* KT = (bf16*)(p.ws + WS_KT); float* DEC = (float*)(p.ws + WS_DEC);
    const int gw = F.bid * NWAVES + F.wave, NGW = F.G * NWAVES, r = F.lane & 31, hh = F.lane >> 5;
    for (int task = gw; task < 2 * NCHUNK * 8; task += NGW) {
        const int dh = task & 7, chunk = (task >> 3) % NCHUNK, dir = __builtin_amdgcn_readfirstlane(task / (8 * NCHUNK));
        const int tok0 = chunk * 64;
        bf16x8v af[2], bfr[2];
#pragma unroll
        for (int tb = 0; tb < 2; ++tb) { const float* zp = ZZ + (size_t)(tok0 + 32 * tb + r) * 32 + dir * 16 + 8 * hh; const f32x4 z0 = *(const f32x4*)zp, z1 = *(const f32x4*)(zp + 4);
            u32x4 w; w.x = pk2(z0.x, z0.y); w.y = pk2(z0.z, z0.w); w.z = pk2(z1.x, z1.y); w.w = pk2(z1.z, z1.w); af[tb] = __builtin_bit_cast(bf16x8v, w); }
        float bgv[2];
#pragma unroll
        for (int cb = 0; cb < 2; ++cb) { const float* wp = p.gwg_up + (size_t)dir * 16 * 512 + (size_t)(8 * hh) * 512 + dh * 64 + 2 * r + cb; float wv[8];
#pragma unroll
            for (int i = 0; i < 8; ++i) wv[i] = wp[(size_t)i * 512];
            u32x4 w; w.x = pk2(wv[0], wv[1]); w.y = pk2(wv[2], wv[3]); w.z = pk2(wv[4], wv[5]); w.w = pk2(wv[6], wv[7]); bfr[cb] = __builtin_bit_cast(bf16x8v, w);
            bgv[cb] = p.gbg[dir * 512 + dh * 64 + 2 * r + cb]; }
        f32x16v Z[2][2];
#pragma unroll
        for (int tb = 0; tb < 2; ++tb)
#pragma unroll
            for (int cb = 0; cb < 2; ++cb) { const f32x16v zero = {}; Z[tb][cb] = __builtin_amdgcn_mfma_f32_32x32x16_bf16(af[tb], bfr[cb], zero, 0, 0, 0); }
#pragma unroll
        for (int tb = 0; tb < 2; ++tb)
#pragma unroll
            for (int cb = 0; cb < 2; ++cb)
#pragma unroll
                for (int i = 0; i < 16; ++i) { const float z = Z[tb][cb][i] + bgv[cb]; Z[tb][cb][i] = (fminf(z, 0.f) - __logf(1.f + __expf(-fabsf(z)))) * (1.f / 16.f); }
        float tot[2];
#pragma unroll
        for (int cb = 0; cb < 2; ++cb) {
            float T[2][4], PT[2][4];
            if (!dir) {
#pragma unroll
                for (int tb = 0; tb < 2; ++tb)
#pragma unroll
                    for (int gi = 0; gi < 4; ++gi) { float run = 0.f;
#pragma unroll
                        for (int w = 0; w < 4; ++w) { run += Z[tb][cb][4 * gi + w]; Z[tb][cb][4 * gi + w] = run; }
                        T[tb][gi] = run; }
            } else {
#pragma unroll
                for (int tb = 0; tb < 2; ++tb)
#pragma unroll
                    for (int gi = 0; gi < 4; ++gi) { float run = 0.f;
#pragma unroll
                        for (int w = 3; w >= 0; --w) { run += Z[tb][cb][4 * gi + w]; Z[tb][cb][4 * gi + w] = run; }
                        T[tb][gi] = run; }
            }
#pragma unroll
            for (int tb = 0; tb < 2; ++tb)
#pragma unroll
                for (int gi = 0; gi < 4; ++gi) PT[tb][gi] = __shfl_xor(T[tb][gi], 32);
            float running = 0.f;
            if (!dir) {
#pragma unroll
                for (int tb = 0; tb < 2; ++tb)
#pragma unroll
                    for (int gi = 0; gi < 4; ++gi) { const float first = hh ? PT[tb][gi] : T[tb][gi], second = hh ? T[tb][gi] : PT[tb][gi];
                        const float mine = hh ? running + first : running; running += first + second;
#pragma unroll
                        for (int w = 0; w < 4; ++w) Z[tb][cb][4 * gi + w] += mine; }
            } else {
#pragma unroll
                for (int tb = 1; tb >= 0; --tb)
#pragma unroll
                    for (int gi = 3; gi >= 0; --gi) { const float first = hh ? T[tb][gi] : PT[tb][gi], second = hh ? PT[tb][gi] : T[tb][gi];
                        const float mine = hh ? running : running + first; running += first + second;
#pragma unroll
                        for (int w = 0; w < 4; ++w) Z[tb][cb][4 * gi + w] += mine; }
            }
            tot[cb] = running;
        }
        if (hh == 0) {
#pragma unroll
            for (int cb = 0; cb < 2; ++cb) DEC[((size_t)dir * NCHUNK + chunk) * 512 + dh * 64 + 2 * r + cb] = __expf(tot[cb]);
        }
        const bf16* qi = QR + ((size_t)dh * NTOK + tok0) * 64 + 2 * r; const bf16* ki = KR + ((size_t)dh * NTOK + tok0) * 64 + 2 * r;
        bf16* qo = QT + (((size_t)dir * 8 + dh) * NTOK + tok0) * 64 + 2 * r; bf16* ko = KT + (((size_t)dir * 8 + dh) * NTOK + tok0) * 64 + 2 * r;
#pragma unroll
        for (int tb = 0; tb < 2; ++tb) {
            unsigned qv[16], kv[16];
#pragma unroll
            for (int i = 0; i < 16; ++i) { const int t = 32 * tb + (i & 3) + 8 * (i >> 2) + 4 * hh; qv[i] = *(const unsigned*)(qi + (size_t)t * 64); kv[i] = *(const unsigned*)(ki + (size_t)t * 64); }
#pragma unroll
            for (int i = 0; i < 16; ++i) { const int t = 32 * tb + (i & 3) + 8 * (i >> 2) + 4 * hh;
                const float e0 = __expf(Z[tb][0][i]), e1 = __expf(Z[tb][1][i]), i0 = __builtin_amdgcn_rcpf(e0), i1 = __builtin_amdgcn_rcpf(e1);
                *(unsigned*)(qo + (size_t)t * 64) = pk2(bf2f(qv[i] & 0xffffu) * e0, bf2f(qv[i] >> 16) * e1);
                *(unsigned*)(ko + (size_t)t * 64) = pk2(bf2f(kv[i] & 0xffffu) * i0, bf2f(kv[i] >> 16) * i1); }
        }
    }
}

__device__ __forceinline__ void phase_gla_post(const Frame& F, const Prm& p) {
    const bf16* OF = (const bf16*)p.out; const bf16* OB = (const bf16*)((const unsigned char*)p.out + OUT_OGB); const bf16* R = (const bf16*)(p.ws + WS_R); unsigned char* A2 = p.ws + WS_A2B;
    const f32x4 ng = *(const f32x4*)(p.gnorm + 4 * F.lane);
    const int gw = F.bid * NWAVES + F.wave, NGW = F.G * NWAVES;
    f32x4 a[4], b[4], r[4], an[4], bn[4], rn[4];
    if (gw < NLAT) { ld_row_bf16(OF + (size_t)gw * DM, F.lane, a); ld_row_bf16(OB + (size_t)gw * DM, F.lane, b); ld_row_bf16(R + (size_t)gw * DM, F.lane, r); }
    for (int tok = gw; tok < NLAT; tok += NGW) {
        if (tok + NGW < NLAT) { ld_row_bf16(OF + (size_t)(tok + NGW) * DM, F.lane, an); ld_row_bf16(OB + (size_t)(tok + NGW) * DM, F.lane, bn); ld_row_bf16(R + (size_t)(tok + NGW) * DM, F.lane, rn); }
#pragma unroll
        for (int j = 0; j < 4; ++j) {
            const f32x4 o = a[j] + b[j]; const float q = wave_sum((o.x * o.x + o.y * o.y) + (o.z * o.z + o.w * o.w));
            const float rs = 1.f / sqrtf(q * (1.f / 256.f) + LN_EPS);
            a[j] = (f32x4){o.x * rs * ng.x * silu_f(r[j].x), o.y * rs * ng.y * silu_f(r[j].y), o.z * rs * ng.z * silu_f(r[j].z), o.w * rs * ng.w * silu_f(r[j].w)};
        }
        st_row_fp8(A2 + (size_t)tok * DM, F.lane, a);
#pragma unroll
        for (int j = 0; j < 4; ++j) { a[j] = an[j]; b[j] = bn[j]; r[j] = rn[j]; }
    }
}
namespace pg8 {
typedef short bf16x8 __attribute__((ext_vector_type(8)));
constexpr int BM = 256, BK = 64, HALF = 128, HTB = HALF * BK * 2, STAGE_BYTES = 8 * HTB, NXCD = 8, WGM = 8;
__host__ __device__ __forceinline__ int lds_byte(int r, int c) { const int st = (r >> 4) * 2 + (c >> 5), rr = r & 15, cc = c & 31, ob = rr * 64 + cc * 2; return st * 1024 + (ob ^ (((ob >> 9) & 1) << 5)); }
__host__ __device__ __forceinline__ void stage_rc(int b, int& R, int& C) { const int st = b / 1024, sb = b % 1024, swz = sb ^ (((sb >> 9) & 1) << 5); R = (st >> 1) * 16 + swz / 64; C = (st & 1) * 32 + (swz % 64) / 2; }
typedef float f32x2_t __attribute__((ext_vector_type(2))); typedef __bf16 bf16x2_t __attribute__((ext_vector_type(2)));
__device__ __forceinline__ unsigned cvt_pk_bf16(float lo, float hi) { f32x2_t v = {lo, hi}; bf16x2_t b = __builtin_convertvector(v, bf16x2_t); return __builtin_bit_cast(unsigned, b); }

struct Unit { int pm, pn; int row0; int e; int cnt; const bf16* Bt; };

struct DenseOrder {
    int nM, nN, nwg, G, c, K; const bf16* Bt;
    __device__ void init(int M, int N, int K_, const bf16* Bt_, int G_, int c_) { nM = M / BM; nN = N / BM; nwg = nM * nN; G = G_; c = c_; K = K_; Bt = Bt_; }
    __device__ bool next(int i, Unit& u) const {
        const long L = (long)i * G + c; if (L >= nwg) return false;
        int wgid = (int)L; { const int q = nwg / NXCD, r = nwg % NXCD, xcd = wgid % NXCD, off = wgid / NXCD; wgid = (xcd < r ? xcd * (q + 1) : r * (q + 1) + (xcd - r) * q) + off; }
        const int nig = WGM * nN, gid = wgid / nig, fm = gid * WGM, gsz = (nM - fm) < WGM ? (nM - fm) : WGM;
        u.pm = fm + ((wgid % nig) % gsz); u.pn = (wgid % nig) / gsz; u.row0 = u.pm * BM; u.e = 0; u.cnt = 0; u.Bt = Bt; return true;
    }
    __device__ __forceinline__ unsigned arow(const Unit& u, int r) const { return (unsigned)(u.row0 + r) * (unsigned)(K * 2); }
};
template <bool GATHER> struct MoeOrder {
    int cnt[16]; int nN, G, c, K; const bf16* Bt0; size_t bstride; const int* LIST;
    __device__ void init(const unsigned* cntw, int N, int K_, const bf16* Bt0_, const int* LIST_, int G_, int c_) {
#pragma unroll
        for (int e = 0; e < 16; ++e) cnt[e] = (int)__hip_atomic_load(cntw + e, __ATOMIC_RELAXED, __HIP_MEMORY_SCOPE_AGENT);
        nN = N / BM; G = G_; c = c_; K = K_; Bt0 = Bt0_; bstride = (size_t)N * K_; LIST = LIST_; }
    __device__ bool next(int i, Unit& u) const {
        int L = i * G + c, base = 0; bool found = false; u.pm = 0; u.pn = 0; u.row0 = 0; u.e = 0; u.cnt = 0; u.Bt = Bt0;
#pragma unroll
        for (int e = 0; e < 16; ++e) { const int mt = (cnt[e] + 255) >> 8, nu = mt * nN;
            if (!found) { if (L < nu) { found = true; u.e = e; u.cnt = cnt[e]; u.pm = L / nN; u.pn = L % nN; u.row0 = base + u.pm * BM; u.Bt = Bt0 + (size_t)e * bstride; } else { L -= nu; base += mt * BM; } } }
        return found;
    }
    __device__ __forceinline__ unsigned arow(const Unit& u, int r) const {
        if (GATHER) { const int li = u.pm * BM + r; int tok = 0; if (li < u.cnt) tok = LIST[u.e * NTOK + li];
            return (unsigned)tok * (unsigned)(K * 2); }
        return (unsigned)(u.row0 + r) * (unsigned)(K * 2);
    }
};

typedef f32x4 Acc[2][2][4][2];
__device__ __forceinline__ void st4bf(bf16* p, f32x4 v) { u32x2 w; w.x = cvt_pk_bf16(v.x, v.y); w.y = cvt_pk_bf16(v.z, v.w); *(u32x2*)p = w; }
__device__ __forceinline__ void st8bf(bf16* p, f32x4 a, f32x4 b) { u32x4 w; w.x = cvt_pk_bf16(a.x, a.y); w.y = cvt_pk_bf16(a.z, a.w); w.z = cvt_pk_bf16(b.x, b.y); w.w = cvt_pk_bf16(b.z, b.w); *(u32x4*)p = w; }

struct EpiQKV {
    bf16 *Q; const LAS float* rope; float wsc; unsigned* km;
    __device__ __forceinline__ void operator()(const Acc& acc, const Unit& u, int wr, int wc, int fr, int fq) const {
        const int reg = u.pn >> 2; bf16* O = Q + (size_t)reg * ((WS_K - WS_Q) / 2);
        if (reg == 2) { const int cbase = (u.pn & 3) * BM + wc * 32 + 8 * fq;
#pragma unroll
            for (int ai = 0; ai < 2; ++ai)
#pragma unroll
                for (int m = 0; m < 4; ++m) { unsigned char* rowp = (unsigned char*)Q + (size_t)2 * (WS_K - WS_Q) + (size_t)(u.row0 + ai * HALF + wr * 64 + m * 16 + fr) * DM + cbase;
#pragma unroll
                    for (int bj = 0; bj < 2; ++bj) { const f32x4 a = acc[ai][bj][m][0] * wsc, b = acc[ai][bj][m][1] * wsc; u32x2 w; w.x = pk4_fp8(a.x, a.y, a.z, a.w); w.y = pk4_fp8(b.x, b.y, b.z, b.w); *(u32x2*)(rowp + bj * HALF) = w; } }
            return; }
        const int cbase = (u.pn & 3) * BM + wc * 32 + 8 * fq;
        const bool dorope = (u.row0 < NLAT); const float sc = (reg == 0 ? C2 : 1.f) * wsc; float kn[2] = {0.f, 0.f};
#pragma unroll
        for (int ai = 0; ai < 2; ++ai)
#pragma unroll
            for (int m = 0; m < 4; ++m) { const int row = u.row0 + ai * HALF + wr * 64 + m * 16 + fr; unsigned char* rowp = (unsigned char*)Q + (size_t)reg * (WS_K - WS_Q) + (size_t)row * DM + cbase;
                f32x4 cs = {1.f, 1.f, 1.f, 1.f}, sn = {0.f, 0.f, 0.f, 0.f};
                if (dorope) { const int s = row & (SEQ - 1), pos = (wc & 1) ? (s & 63) : (s >> 6); const f32x4 t0 = *(const LAS f32x4*)(rope + (pos * 16 + 4 * fq) * 2), t1 = *(const LAS f32x4*)(rope + (pos * 16 + 4 * fq) * 2 + 4);
                    cs = (f32x4){t0.x, t0.z, t1.x, t1.z}; sn = (f32x4){t0.y, t0.w, t1.y, t1.w}; }
                { f32x4 c2 = cs, s2 = sn;
#pragma unroll
                  for (int j = 0; j < 4; ++j) { float x0 = c2[j] * sc, x1 = s2[j] * sc; asm("" : "+v"(x0)); asm("" : "+v"(x1)); cs[j] = x0; sn[j] = x1; } }
#pragma unroll
                for (int bj = 0; bj < 2; ++bj) { const f32x4 a0 = acc[ai][bj][m][0], a1 = acc[ai][bj][m][1];
                    f32x4 o0, o1;
#pragma unroll
                    for (int j = 0; j < 4; ++j) { float x0 = __builtin_fmaf(-a1[j], sn[j], a0[j] * cs[j]), x1 = __builtin_fmaf(a0[j], sn[j], a1[j] * cs[j]); asm("" : "+v"(x0)); asm("" : "+v"(x1)); o0[j] = x0; o1[j] = x1; }
                    { u32x2 w; w.x = pk4_fp8(o0[0], o0[1], o0[2], o0[3]); w.y = pk4_fp8(o1[0], o1[1], o1[2], o1[3]); *(u32x2*)(rowp + bj * HALF) = w; }
                    if (reg == 1) { const float ps = (o0.x * o0.x + o0.y * o0.y) + (o0.z * o0.z + o0.w * o0.w) + (o1.x * o1.x + o1.y * o1.y) + (o1.z * o1.z + o1.w * o1.w);
                        kn[bj] = fmaxf(kn[bj], ps); } } }
        if (reg == 1) {
            const int b = u.row0 < NLAT ? u.row0 / SEQ : (u.row0 - NLAT) / CTXL;
#pragma unroll
            for (int bj = 0; bj < 2; ++bj) { float v = kn[bj];
#pragma unroll
                for (int s = 1; s < 64; s <<= 1) v = fmaxf(v, __shfl_xor(v, s));
                if (fr == 0 && fq == 0) __hip_atomic_fetch_max(km + b * 16 + 4 * (u.pn & 3) + 2 * bj + (wc >> 1), __float_as_uint(9.2f * v), __ATOMIC_RELAXED, __HIP_MEMORY_SCOPE_AGENT); } }
    }
};
struct EpiPlain {
    bf16* O; float sc;
    __device__ __forceinline__ void operator()(const Acc& acc, const Unit& u, int wr, int wc, int fr, int fq) const {
        const int cbase = u.pn * BM + wc * 32 + 8 * fq;
#pragma unroll
        for (int ai = 0; ai < 2; ++ai)
#pragma unroll
            for (int m = 0; m < 4; ++m) { bf16* rowp = O + (size_t)(u.row0 + ai * HALF + wr * 64 + m * 16 + fr) * DM + cbase;
#pragma unroll
                for (int bj = 0; bj < 2; ++bj) st8bf(rowp + bj * HALF, acc[ai][bj][m][0] * sc, acc[ai][bj][m][1] * sc); }
    }
};
struct EpiPlain8 {
    unsigned char* O; float sc;
    __device__ __forceinline__ void operator()(const Acc& acc, const Unit& u, int wr, int wc, int fr, int fq) const {
        const int cbase = u.pn * BM + wc * 32 + 8 * fq;
#pragma unroll
        for (int ai = 0; ai < 2; ++ai)
#pragma unroll
            for (int m = 0; m < 4; ++m) { unsigned char* rowp = O + (size_t)(u.row0 + ai * HALF + wr * 64 + m * 16 + fr) * DM + cbase;
#pragma unroll
                for (int bj = 0; bj < 2; ++bj) { const f32x4 a = acc[ai][bj][m][0] * sc, b = acc[ai][bj][m][1] * sc; u32x2 w; w.x = pk4_fp8(a.x, a.y, a.z, a.w); w.y = pk4_fp8(b.x, b.y, b.z, b.w); *(u32x2*)(rowp + bj * HALF) = w; } }
    }
};
struct EpiInproj {
    bf16 *QR, *KR, *V, *R; float* ZZ; float wsc;
    __device__ __forceinline__ void operator()(const Acc& acc, const Unit& u, int wr, int wc, int fr, int fq) const {
        const int pn = u.pn;
        if (pn == 12) { if (wc == 0) {
#pragma unroll
            for (int ai = 0; ai < 2; ++ai)
#pragma unroll
                for (int m = 0; m < 4; ++m) { float* rowp = ZZ + (size_t)(u.row0 + ai * HALF + wr * 64 + m * 16 + fr) * 32 + 4 * fq;
                    *(f32x4*)rowp = acc[ai][0][m][0] * wsc; *(f32x4*)(rowp + 16) = acc[ai][0][m][1] * wsc; } }
            return; }
        float sc = wsc;
        if (pn < 4) {
            bf16* O = pn < 2 ? QR : KR; if (pn < 2) sc = 0.08838834764831845f * wsc;
            const int cb = (pn & 1) * BM + wc * 32 + 8 * fq;
#pragma unroll
            for (int ai = 0; ai < 2; ++ai)
#pragma unroll
                for (int m = 0; m < 4; ++m) { const size_t row = (size_t)(u.row0 + ai * HALF + wr * 64 + m * 16 + fr);
#pragma unroll
                    for (int bj = 0; bj < 2; ++bj) { const int col = cb + bj * HALF; st8bf(O + ((size_t)(col >> 6) * NTOK + row) * 64 + (col & 63), acc[ai][bj][m][0] * sc, acc[ai][bj][m][1] * sc); } }
            return; }
        bf16* O; int c0;
        if (pn < 8) { O = V; c0 = (pn - 4) * BM; } else { O = R; c0 = (pn - 8) * BM; }
        const int cbase = c0 + wc * 32 + 8 * fq;
#pragma unroll
        for (int ai = 0; ai < 2; ++ai)
#pragma unroll
            for (int m = 0; m < 4; ++m) { bf16* rowp = O + (size_t)(u.row0 + ai * HALF + wr * 64 + m * 16 + fr) * DM + cbase;
#pragma unroll
                for (int bj = 0; bj < 2; ++bj) st8bf(rowp + bj * HALF, acc[ai][bj][m][0] * sc, acc[ai][bj][m][1] * sc); }
    }
};
struct EpiGateUp {
    unsigned char* ACT;
    __device__ __forceinline__ void operator()(const Acc& acc, const Unit& u, int wr, int wc, int fr, int fq) const {
        const int obase = u.pn * (BM / 2) + wc * 32 + 8 * fq;
#pragma unroll
        for (int ai = 0; ai < 2; ++ai)
#pragma unroll
            for (int m = 0; m < 4; ++m) { unsigned char* rowp = ACT + (size_t)(u.row0 + ai * HALF + wr * 64 + m * 16 + fr) * DEXP + obase; u32x2 w;
#pragma unroll
                for (int bj = 0; bj < 2; ++bj) { const f32x4 g = acc[ai][bj][m][0], up = acc[ai][bj][m][1]; f32x4 o;
#pragma unroll
                    for (int j = 0; j < 4; ++j) o[j] = g[j] * __builtin_amdgcn_rcpf(1.f + __expf(-g[j])) * up[j];
                    w[bj] = pk4_fp8(o[0], o[1], o[2], o[3]); }
                *(u32x2*)rowp = w; }
    }
};

typedef int i32x8 __attribute__((ext_vector_type(8)));
typedef int i32x4 __attribute__((ext_vector_type(4)));
__device__ __forceinline__ i32x8 cat8(bf16x8 lo, bf16x8 hi) { return __builtin_shufflevector(__builtin_bit_cast(i32x4, lo), __builtin_bit_cast(i32x4, hi), 0, 1, 2, 3, 4, 5, 6, 7); }
template <class Epi, class Sched, bool FP8 = false>
__device__ __forceinline__ void gemm_phase(unsigned char* ldsg, const bf16* A, int K, const Sched& S, const Epi& E, int tid_in) {
    LAS unsigned char* lds = (LAS unsigned char*)ldsg;
    const int tid = tid_in, wid = __builtin_amdgcn_readfirstlane(tid >> 6), lane = tid & 63, wr = wid >> 2, wc = wid & 3, fr = lane & 15, fq = lane >> 4;
    const int nt = K / BK;
    int Rr[2]; unsigned colb[2], voffB[2];
#pragma unroll
    for (int i = 0; i < 2; ++i) { int R, C; stage_rc(tid * 16 + i * 8192, R, C); Rr[i] = R; colb[i] = (unsigned)C * 2u; voffB[i] = (unsigned)(R * K + C) * 2u; }
    const size_t kstep = (size_t)(BK * 2);
    const size_t hstep = (size_t)HALF * K * 2;
    const size_t tstep = 2 * hstep;
    const unsigned ldsw = (unsigned)wid * 1024u;
    const int aoff = lds_byte(wr * 64 + fr, fq * 8), boff = lds_byte(wc * 32 + fr, fq * 8);
#define PG8_SA(b, h) (((b) * 2 + (h)) * HTB)
#define PG8_SB(b, h) ((4 + (b) * 2 + (h)) * HTB)
#define PG8_STAGE(bufoff, gbase, voff) do { _Pragma("unroll") for (int _i = 0; _i < 2; ++_i) \
        __builtin_amdgcn_global_load_lds((const unsigned*)((const char*)(gbase) + (voff)[_i]), (LAS unsigned*)(lds + (bufoff) + ldsw + _i * 8192), 16, 0, 0); } while (0)
#define PG8_LDA(dst, b, h) do { if constexpr (FP8) { _Pragma("unroll") for (int m = 0; m < 4; ++m) dst##8[m] = cat8(*(const LAS bf16x8*)(lds + PG8_SA(b, h) + aoff + m * 2048), *(const LAS bf16x8*)(lds + PG8_SA(b, h) + aoff + m * 2048 + 1024)); } \
        else { _Pragma("unroll") for (int m = 0; m < 4; ++m) _Pragma("unroll") for (int k = 0; k < 2; ++k) dst[m][k] = *(const LAS bf16x8*)(lds + PG8_SA(b, h) + aoff + m * 2048 + k * 1024); } } while (0)
#define PG8_LDB(dst, b, h) do { if constexpr (FP8) { _Pragma("unroll") for (int n = 0; n < 2; ++n) dst##8[n] = cat8(*(const LAS bf16x8*)(lds + PG8_SB(b, h) + boff + n * 2048), *(const LAS bf16x8*)(lds + PG8_SB(b, h) + boff + n * 2048 + 1024)); } \
        else { _Pragma("unroll") for (int n = 0; n < 2; ++n) _Pragma("unroll") for (int k = 0; k < 2; ++k) dst[n][k] = *(const LAS bf16x8*)(lds + PG8_SB(b, h) + boff + n * 2048 + k * 1024); } } while (0)
#define PG8_MMA(ai, bj, At, Bt) do { __builtin_amdgcn_s_setprio(1); \
        if constexpr (FP8) { _Pragma("unroll") for (int m = 0; m < 4; ++m) _Pragma("unroll") for (int n = 0; n < 2; ++n) \
            asm volatile("v_mfma_scale_f32_16x16x128_f8f6f4 %0, %1, %2, %0, %3, %3 op_sel:[0,1,0] op_sel_hi:[0,0,0]" : "+v"(acc[ai][bj][m][n]) : "v"(Bt##8[n]), "v"(At##8[m]), "v"(sc8)); } \
        else { _Pragma("unroll") for (int m = 0; m < 4; ++m) _Pragma("unroll") for (int n = 0; n < 2; ++n) _Pragma("unroll") for (int k = 0; k < 2; ++k) \
            acc[ai][bj][m][n] = __builtin_amdgcn_mfma_f32_16x16x32_bf16(Bt[n][k], At[m][k], acc[ai][bj][m][n], 0, 0, 0); } \
        __builtin_amdgcn_s_setprio(0); } while (0)
#define PG8_WAIT_V(n) asm volatile("s_waitcnt vmcnt(" #n ")" ::: "memory")
#define PG8_WAIT_L(n) asm volatile("s_waitcnt lgkmcnt(" #n ")" ::: "memory")
#define PG8_BAR __builtin_amdgcn_s_barrier()
#define PG8_SCHED __builtin_amdgcn_sched_barrier(0)
    Unit cur, nxt; int ui = 0;
    if (!S.next(0, cur)) return;
    Acc acc;
#pragma unroll
    for (int a = 0; a < 2; ++a)
#pragma unroll
        for (int b = 0; b < 2; ++b)
#pragma unroll
            for (int m = 0; m < 4; ++m)
#pragma unroll
                for (int n = 0; n < 2; ++n) acc[a][b][m][n] = (f32x4){0.f, 0.f, 0.f, 0.f};
    const int sc8 = 0x7f7f7f79;
    bf16x8 At[4][2], B0[2][2], B1[2][2]; i32x8 At8[4], B08[2], B18[2];
    unsigned aC0[2], aC1[2], aN0[2], aN1[2];
#pragma unroll
    for (int i = 0; i < 2; ++i) { aC0[i] = S.arow(cur, Rr[i]) + colb[i]; aC1[i] = S.arow(cur, HALF + Rr[i]) + colb[i]; }
    const char* Ab = (const char*)A;
    const char* cB = (const char*)cur.Bt + (size_t)cur.pn * tstep;
    PG8_STAGE(PG8_SB(0, 0), cB, voffB); PG8_STAGE(PG8_SB(0, 1), cB + hstep, voffB); PG8_STAGE(PG8_SA(0, 0), Ab, aC0); PG8_STAGE(PG8_SA(0, 1), Ab, aC1);
    if (wr == 1) PG8_BAR;
    PG8_WAIT_V(2); PG8_BAR;
    PG8_STAGE(PG8_SB(1, 0), cB + kstep, voffB); PG8_STAGE(PG8_SA(1, 0), Ab + kstep, aC0); PG8_STAGE(PG8_SB(1, 1), cB + hstep + kstep, voffB);
    PG8_WAIT_V(6); PG8_BAR;
    for (;;) {
        const bool has_next = S.next(ui + 1, nxt);
        if (has_next) {
#pragma unroll
            for (int i = 0; i < 2; ++i) { aN0[i] = S.arow(nxt, Rr[i]) + colb[i]; aN1[i] = S.arow(nxt, HALF + Rr[i]) + colb[i]; }
        } else {
#pragma unroll
            for (int i = 0; i < 2; ++i) { aN0[i] = aC0[i]; aN1[i] = aC1[i]; }
        }
        const char* nB = has_next ? (const char*)nxt.Bt + (size_t)nxt.pn * tstep : cB;
        for (int t = 0; t < nt; t += 2) {
            const bool last = (t == nt - 2);
            const char* a1 = Ab + (size_t)(t + 1) * kstep;
            const char* a2 = last ? Ab : Ab + (size_t)(t + 2) * kstep; const char* b2 = last ? nB : cB + (size_t)(t + 2) * kstep;
            const char* a3 = a2 + kstep; const char* b3 = b2 + kstep;
            unsigned x0[2], x1[2];
#pragma unroll
            for (int i = 0; i < 2; ++i) { x0[i] = last ? aN0[i] : aC0[i]; x1[i] = last ? aN1[i] : aC1[i]; }
            PG8_LDB(B0, 0, 0); PG8_LDB(B1, 0, 1); PG8_SCHED; PG8_LDA(At, 0, 0); PG8_STAGE(PG8_SA(1, 1), a1, aC1);
            PG8_WAIT_V(8); PG8_WAIT_L(0); PG8_BAR; PG8_MMA(0, 0, At, B0); PG8_MMA(0, 1, At, B1); PG8_BAR; PG8_SCHED;
            PG8_LDA(At, 0, 1); PG8_STAGE(PG8_SB(0, 0), b2, voffB); PG8_STAGE(PG8_SB(0, 1), b2 + hstep, voffB); PG8_STAGE(PG8_SA(0, 0), a2, x0);
            PG8_WAIT_V(8); PG8_WAIT_L(0); PG8_BAR; PG8_MMA(1, 0, At, B0); PG8_MMA(1, 1, At, B1); PG8_BAR; PG8_SCHED;
            PG8_LDB(B0, 1, 0); PG8_LDB(B1, 1, 1); PG8_SCHED; PG8_LDA(At, 1, 0); PG8_STAGE(PG8_SA(0, 1), a2, x1);
            PG8_WAIT_V(8); PG8_WAIT_L(0); PG8_BAR; PG8_MMA(0, 0, At, B0); PG8_MMA(0, 1, At, B1); PG8_BAR; PG8_SCHED;
            PG8_LDA(At, 1, 1); PG8_STAGE(PG8_SB(1, 0), b3, voffB); PG8_STAGE(PG8_SB(1, 1), b3 + hstep, voffB); PG8_STAGE(PG8_SA(1, 0), a3, x0);
            PG8_WAIT_V(8); PG8_WAIT_L(0); PG8_BAR; PG8_MMA(1, 0, At, B0); PG8_MMA(1, 1, At, B1); PG8_BAR; PG8_SCHED;
        }
        if (wr == 0) PG8_BAR;
        if constexpr (FP8) asm volatile("s_nop 15\n\ts_nop 7" ::: "memory");
        E(acc, cur, wr, wc, fr, fq);
        if (!has_next) break;
#pragma unroll
        for (int a = 0; a < 2; ++a)
#pragma unroll
            for (int b = 0; b < 2; ++b)
#pragma unroll
                for (int m = 0; m < 4; ++m)
#pragma unroll
                    for (int n = 0; n < 2; ++n) acc[a][b][m][n] = (f32x4){0.f, 0.f, 0.f, 0.f};
        cur = nxt; cB = nB; ++ui;
#pragma unroll
        for (int i = 0; i < 2; ++i) { aC0[i] = aN0[i]; aC1[i] = aN1[i]; }
        if (wr == 1) PG8_BAR;
    }
    PG8_WAIT_V(0);
    PG8_BAR;
#undef PG8_SA
#undef PG8_SB
#undef PG8_STAGE
#undef PG8_LDA
#undef PG8_LDB
#undef PG8_MMA
#undef PG8_WAIT_V
#undef PG8_WAIT_L
#undef PG8_BAR
#undef PG8_SCHED
}
}

__device__ __forceinline__ int vcu_of(const Frame& F) { return (F.G % 8 == 0) ? (F.bid % 8) * (F.G / 8) + F.bid / 8 : F.bid; }
__device__ __forceinline__ void phase_qkv_opt(const Frame& F, const Prm& p) {
    pg8::DenseOrder S; S.init(NTOK, 3072, 512, (const bf16*)(p.ws + WS_WQKV), F.G, F.bid);
    static_assert(WS_V - WS_K == WS_K - WS_Q, "Q|K|V equally spaced");
    LAS float* ropel = (LAS float*)((LAS unsigned char*)F.lds + LDSX_OFF);
    const float* ropeg = (const float*)(p.ws + WS_MISC) + 1024;
    for (int i = F.tid; i < 2048; i += NTHR) ropel[i] = ropeg[i];
    __syncthreads();
    pg8::EpiQKV E{(bf16*)(p.ws + WS_Q), ropel, 1.f, F.ctl + CW_KM};
    pg8::gemm_phase<pg8::EpiQKV, pg8::DenseOrder, true>(F.lds, (const bf16*)(p.ws + WS_H), 512, S, E, F.tid);
}
__device__ __forceinline__ void phase_wo_opt(const Frame& F, const Prm& p, int layer) {
    if (layer) {
        pg8::DenseOrder S; S.init(NLAT, 1024, 512, (const bf16*)(p.ws + WS_WGO), F.G, F.bid);
        pg8::EpiPlain E{(bf16*)(p.ws + WS_Y), 1.f};
        pg8::gemm_phase<pg8::EpiPlain, pg8::DenseOrder, true>(F.lds, (const bf16*)(p.ws + WS_A2B), 512, S, E, F.tid);
    } else {
        pg8::DenseOrder S; S.init(NTOK, 1024, 512, (const bf16*)(p.ws + WS_WO), F.G, F.bid);
        pg8::EpiPlain E{(bf16*)(p.ws + WS_Y), 1.f};
        pg8::gemm_phase<pg8::EpiPlain, pg8::DenseOrder, true>(F.lds, (const bf16*)(p.ws + WS_A2), 512, S, E, F.tid);
    }
}
__device__ __forceinline__ void phase_inproj_opt(const Frame& F, const Prm& p) {
    pg8::DenseOrder S; S.init(NTOK, NIN, 512, (const bf16*)(p.ws + WS_WIN), F.G, F.bid);
    pg8::EpiInproj E{(bf16*)(p.ws + WS_QR), (bf16*)(p.ws + WS_KR), (bf16*)(p.ws + WS_V1), (bf16*)(p.ws + WS_R), (float*)(p.ws + WS_ZZ), 1.f};
    pg8::gemm_phase<pg8::EpiInproj, pg8::DenseOrder, true>(F.lds, (const bf16*)(p.ws + WS_H), 512, S, E, F.tid);
}
__device__ __forceinline__ void phase_moe1_opt(const Frame& F, const Prm& p, int layer) {
    pg8::MoeOrder<true> S; S.init(F.ctl + CW_CNT + layer * 16, 1024, 512, (const bf16*)(p.ws + (layer ? WS_GU1 : WS_GU0)), (const int*)(p.ws + WS_LIST), F.G, vcu_of(F));
    pg8::EpiGateUp E{p.ws + WS_ACT};
    pg8::gemm_phase<pg8::EpiGateUp, pg8::MoeOrder<true>, true>(F.lds, (const bf16*)(p.ws + WS_H), 512, S, E, F.tid);
}
__device__ __forceinline__ void phase_moe2_opt(const Frame& F, const Prm& p, int layer) {
    pg8::MoeOrder<false> S; S.init(F.ctl + CW_CNT + layer * 16, 1024, 256, (const bf16*)(p.ws + (layer ? WS_DN1 : WS_DN0)), nullptr, F.G, vcu_of(F));
    pg8::EpiPlain8 E{p.ws + WS_YM, 1.f};
    pg8::gemm_phase<pg8::EpiPlain8, pg8::MoeOrder<false>, true>(F.lds, (const bf16*)(p.ws + WS_ACT), 256, S, E, F.tid);
}
namespace attn_body {
using bf16=unsigned short;
using bf16x8=__attribute__((ext_vector_type(8)))short;
using s16x4=__attribute__((ext_vector_type(4)))short;
using f32x16=__attribute__((ext_vector_type(16)))float;
using u32x4=__attribute__((ext_vector_type(4)))unsigned;
constexpr int D=64,DM=1024;
constexpr int NW=8,QBLK=32,QB=QBLK*NW,KVBLK=64;
constexpr int ATTN_PITCH=DM, ATTN_UNIT_ROWS=QB;
__device__ __forceinline__ int crow(int r,int hi){return (r&3)+8*(r>>2)+4*hi;}
#define SBAR() __builtin_amdgcn_sched_barrier(0)

constexpr int NSLOT=3, SLOTB=8192;
constexpr int LDS_K=0, LDS_V=NSLOT*SLOTB, LDS_WS=2*NSLOT*SLOTB, LDS_OST=LDS_WS+NW*64*4, LDS_BYTES=LDS_OST+NW*4096;
constexpr float C2=0.125f*1.4426950408889634f;
__device__ __forceinline__ void glds16(const void*gsrc,unsigned lds_dst){unsigned keep;
  asm volatile("s_mov_b32 %0, m0\n\ts_mov_b32 m0, %2\n\ts_nop 0\n\tglobal_load_lds_dwordx4 %1, off\n\ts_mov_b32 m0, %0":"=&s"(keep):"v"(gsrc),"s"(lds_dst):"memory");}
__device__ __forceinline__ void glds16s(const void*sbase,unsigned voff,unsigned lds_dst){unsigned keep;
  asm volatile("s_mov_b32 %0, m0\n\ts_mov_b32 m0, %3\n\ts_nop 0\n\tglobal_load_lds_dwordx4 %1, %2\n\ts_mov_b32 m0, %0":"=&s"(keep):"v"(voff),"s"(sbase),"s"(lds_dst):"memory");}
__device__ __forceinline__ void glds16s128(const void*sbase,unsigned voff,unsigned lds_dst){unsigned keep;
  asm volatile("s_mov_b32 %0, m0\n\ts_mov_b32 m0, %3\n\ts_nop 0\n\tglobal_load_lds_dwordx4 %1, %2 offset:128\n\ts_mov_b32 m0, %0":"=&s"(keep):"v"(voff),"s"(sbase),"s"(lds_dst):"memory");}
__device__ __forceinline__ float max3f(float a,float b,float c){float r;asm("v_max3_f32 %0, %1, %2, %3":"=v"(r):"v"(a),"v"(b),"v"(c));return r;}
__device__ __forceinline__ float max2f(float a,float b){float r;asm("v_max_f32_e32 %0, %1, %2":"=v"(r):"v"(a),"v"(b));return r;}
__device__ __forceinline__ float fadd_s(float a,float b){float r;asm("v_add_f32_e32 %0, %1, %2":"=v"(r):"v"(a),"v"(b));return r;}
__device__ __forceinline__ float fsub_s(float a,float b){float r;asm("v_sub_f32_e32 %0, %1, %2":"=v"(r):"v"(a),"v"(b));return r;}
typedef float f32x2_t __attribute__((ext_vector_type(2))); typedef __bf16 bf16x2_t __attribute__((ext_vector_type(2)));
__device__ __forceinline__ unsigned cvtpk_s(float lo,float hi){f32x2_t v={lo,hi};bf16x2_t b=__builtin_convertvector(v,bf16x2_t);return __builtin_bit_cast(unsigned,b);}
#define WAIT_BAR(N) asm volatile("s_waitcnt vmcnt(" #N ") lgkmcnt(0)\n\ts_barrier":::"memory")

__device__ __forceinline__ void qkt(f32x16&p0,f32x16&p1,const char*Kslot,const bf16x8*qr,const f32x16&negm,int r32,int hi){
  const char*kb=Kslot+hi*1024+r32*16;
  #pragma unroll
  for(int d0=0;d0<4;++d0){
    const bf16x8 b0=*reinterpret_cast<const bf16x8*>(kb+d0*2048);
    const bf16x8 b1=*reinterpret_cast<const bf16x8*>(kb+d0*2048+512);
    if(d0==0){p0=__builtin_amdgcn_mfma_f32_32x32x16_bf16(b0,qr[0],negm,0,0,0);p1=__builtin_amdgcn_mfma_f32_32x32x16_bf16(b1,qr[0],negm,0,0,0);}
    else{p0=__builtin_amdgcn_mfma_f32_32x32x16_bf16(b0,qr[d0],p0,0,0,0);p1=__builtin_amdgcn_mfma_f32_32x32x16_bf16(b1,qr[d0],p1,0,0,0);}}
}
typedef __attribute__((address_space(3))) const char* lds_cptr;
typedef short v4i16_t __attribute__((ext_vector_type(4)));
__device__ __forceinline__ void kload8(bf16x8*kf,lds_cptr kp){
  kf[0]=*(const __attribute__((address_space(3))) bf16x8*)(kp);      kf[1]=*(const __attribute__((address_space(3))) bf16x8*)(kp+512);
  kf[2]=*(const __attribute__((address_space(3))) bf16x8*)(kp+2048); kf[3]=*(const __attribute__((address_space(3))) bf16x8*)(kp+2560);
  kf[4]=*(const __attribute__((address_space(3))) bf16x8*)(kp+4096); kf[5]=*(const __attribute__((address_space(3))) bf16x8*)(kp+4608);
  kf[6]=*(const __attribute__((address_space(3))) bf16x8*)(kp+6144); kf[7]=*(const __attribute__((address_space(3))) bf16x8*)(kp+6656);
}
__device__ __forceinline__ void kload2(bf16x8*kf,lds_cptr kp,int j){ kf[2*j]=*(const __attribute__((address_space(3))) bf16x8*)(kp+j*2048); kf[2*j+1]=*(const __attribute__((address_space(3))) bf16x8*)(kp+j*2048+512); }
__device__ __forceinline__ s16x4 vtr(lds_cptr p){ return __builtin_bit_cast(s16x4,__builtin_amdgcn_ds_read_tr16_b64_v4i16((__attribute__((address_space(3))) v4i16_t*)p)); }
typedef int i32x8 __attribute__((ext_vector_type(8)));
typedef int i32x4a __attribute__((ext_vector_type(4)));
__device__ __forceinline__ i32x8 cat8i(i32x4a lo,i32x4a hi){return __builtin_shufflevector(lo,hi,0,1,2,3,4,5,6,7);}
__device__ __forceinline__ f32x16 mfq8(i32x8 kf,i32x8 q){f32x16 c;asm volatile("v_mfma_f32_32x32x64_f8f6f4 %0, %1, %2, 0":"=&v"(c):"v"(kf),"v"(q));return c;}
__device__ __forceinline__ void kload4(i32x4a*kq,lds_cptr kp){
  kq[0]=*(const __attribute__((address_space(3))) i32x4a*)(kp);      kq[1]=*(const __attribute__((address_space(3))) i32x4a*)(kp+1024);
  kq[2]=*(const __attribute__((address_space(3))) i32x4a*)(kp+2048); kq[3]=*(const __attribute__((address_space(3))) i32x4a*)(kp+3072);}
__device__ __forceinline__ void glds16s_lo(const void*sbase,unsigned voff,unsigned lds_dst){unsigned keep;
  asm volatile("s_mov_b32 %0, m0\n\ts_mov_b32 m0, %3\n\ts_mov_b32 exec_hi, 0\n\tglobal_load_lds_dwordx4 %1, %2\n\ts_mov_b32 exec_hi, -1\n\ts_mov_b32 m0, %0":"=&s"(keep):"v"(voff),"s"(sbase),"s"(lds_dst):"memory");}
__device__ __forceinline__ float rowmax(const f32x16&p0,const f32x16&p1){
  float a=max3f(p0[0],p0[1],p1[0]),b=max3f(p0[2],p0[3],p1[1]);a=max3f(a,p1[2],p1[3]);
  #pragma unroll
  for(int r=4;r<16;r+=4){a=max3f(a,p0[r],p0[r+1]);b=max3f(b,p0[r+2],p0[r+3]);a=max3f(a,p1[r],p1[r+1]);b=max3f(b,p1[r+2],p1[r+3]);}
  const float m=max2f(a,b);
  auto rr=__builtin_amdgcn_permlane32_swap(__float_as_uint(m),__float_as_uint(m),false,false);
  return max2f(__uint_as_float(rr[0]),__uint_as_float(rr[1]));
}
#undef SBAR
#undef WAIT_BAR
#undef KVROW
}
namespace attn_body {
constexpr int V2SLOT = 16384;
constexpr int L2_K = 0, L2_V = NSLOT * SLOTB, L2_WS = L2_V + NSLOT * V2SLOT, L2_ST = L2_WS + NW * 64 * 4, L2_BYTES = L2_ST + NW * 8192;
#define SBAR() __builtin_amdgcn_sched_barrier(0)
#define WAIT_BAR(N) asm volatile("s_waitcnt vmcnt(" #N ") lgkmcnt(0)\n\ts_barrier":::"memory")
typedef int i32x2a __attribute__((ext_vector_type(2)));
__device__ __forceinline__ i32x2a vtr8(lds_cptr p){ return __builtin_amdgcn_ds_read_tr8_b64_v2i32((__attribute__((address_space(3))) i32x2a*)p); }
template<int THRL,bool OPT> __device__ __forceinline__ int attn_unit2(long qrow0,int qcol,int vcol,long kctx,long klat,int NT,const bf16*Q,const bf16*__restrict__ K,const bf16*__restrict__ V,int m,const float*lamp,const float*subln,unsigned char*A2,int acol,float km,char*shm,int wid_s,unsigned*ovf,int s0,bool pre,bool nxt,int nqcol,int nvcol,int nNT){
  int lane_u; asm volatile("v_mbcnt_lo_u32_b32 %0, -1, 0\n\tv_mbcnt_hi_u32_b32 %0, -1, %0":"=v"(lane_u));
  const int lane=lane_u,r32=lane&31,hi=lane>>5; const int wid=wid_s;
  const unsigned char*Qw8=(const unsigned char*)Q+(qrow0+wid*QBLK)*1024+qcol;
  const unsigned char*Kh8=(const unsigned char*)K+qcol; const unsigned char*Vh8=(const unsigned char*)V+vcol;
  const unsigned lds0=(unsigned)(uintptr_t)shm;
  float*wsf=(float*)(shm+L2_WS)+wid*64;
  const unsigned wsf_lds=(unsigned)(lds0+L2_WS+wid*256);
  const unsigned koff=(unsigned)((32*(wid>>2)+(lane&31))*1024+32*(wid&1)+16*((wid>>1)&1));
  const int vpos=32*(wid&1)+(lane>>1); const int vkey=16*(vpos>>4)+4*((vpos>>3)&1)+(vpos&3)+8*((vpos>>2)&1);
  const unsigned voff=(unsigned)(vkey*1024+32*(wid>>1)+16*(lane&1));
  const unsigned kdst=lds0+L2_K+wid*512, vdst=lds0+L2_V+wid*1024;
  #define KVROW(t) ((t)<NT-4?klat+(long)(t)*KVBLK:kctx+(long)((t)-(NT-4))*KVBLK)
  #define DMA_K(t,slot) glds16s_lo(Kh8+KVROW(t)*1024,koff,(unsigned)(kdst+(slot)))
  #define DMA_V(t,slot) glds16s(Vh8+KVROW(t)*1024,voff,(unsigned)(vdst+2*(slot)))
  i32x4a kq[4];
  const lds_cptr shm3=(lds_cptr)shm; const lds_cptr kp0=shm3+L2_K+hi*512+r32*16;
  const lds_cptr vp0=shm3+L2_V+(8*hi+((lane&15)>>1))*32+16*((lane>>4)&1)+8*(lane&1);
  const int S0=s0*SLOTB, S1=(s0==2?0:s0+1)*SLOTB, S2=(s0==0?2:s0-1)*SLOTB;
  if(!pre){ DMA_K(0,S0);DMA_V(0,S0);DMA_K(1,S1); }
  i32x8 q8; { const i32x4a qa=*reinterpret_cast<const i32x4a*>(Qw8+(long)r32*1024+hi*32),qb=*reinterpret_cast<const i32x4a*>(Qw8+(long)r32*1024+hi*32+16); q8=cat8i(qa,qb); }
  bool FAST; { float qn=0.f;
    #pragma unroll
    for(int i=0;i<8;++i){ const f32x2_t lo=__builtin_amdgcn_cvt_pk_f32_fp8(q8[i],false),h2=__builtin_amdgcn_cvt_pk_f32_fp8(q8[i],true); qn+=(lo[0]*lo[0]+lo[1]*lo[1])+(h2[0]*h2[0]+h2[1]*h2[1]); }
    { auto rq=__builtin_amdgcn_permlane32_swap(__float_as_uint(qn),__float_as_uint(qn),false,false); qn=__uint_as_float(rq[0])+__uint_as_float(rq[1]); } FAST=__all(qn*km<=96.f*96.f)!=0; }
  float scl=1.f;
  float mhat=0.f;f32x16 o[4];o[0]=f32x16{};o[1]=f32x16{};o[2]=f32x16{};o[3]=f32x16{};
  f32x16 lacc=f32x16{};
  const i32x8 ones8={0x38383838,0x38383838,0x38383838,0x38383838,0x38383838,0x38383838,0x38383838,0x38383838};
  bool resc=false;
  #define RESC() do{ if(!OPT&&resc){ asm volatile("s_nop 15\n\ts_nop 3\n\ts_waitcnt lgkmcnt(0)":::"memory"); \
      int l3_=lane; asm volatile("":"+v"(l3_)); const int hi3_=l3_>>5; \
      _Pragma("unroll") for(int r=0;r<16;++r){ const float f_=wsf[crow(r,hi3_)]; o[0][r]*=f_; o[1][r]*=f_; o[2][r]*=f_; o[3][r]*=f_; lacc[r]*=f_; } } }while(0)
  int sl_prev=S0,sl_cur=S0,sl_next=S1;
  #define ROT() do{sl_prev=sl_cur;sl_cur=sl_next;sl_next=(sl_next==(NSLOT-1)*SLOTB)?0:sl_next+SLOTB;}while(0)
  if(!pre){ DMA_K(2,S2); WAIT_BAR(3); } else { WAIT_BAR(0); }
  #define EX(v) __builtin_amdgcn_exp2f(v)
  #define PK8(old,a,b,hs) __builtin_amdgcn_cvt_pk_fp8_f32((a),(b),(old),(hs))
  i32x8 pwA,pwB;
  { f32x16 p0,p1;
    kload4(kq,kp0+S0); p0=mfq8(cat8i(kq[0],kq[1]),q8); p1=mfq8(cat8i(kq[2],kq[3]),q8); asm volatile("s_nop 15\n\ts_nop 7":"+v"(p0),"+v"(p1));
    const float rm=__builtin_ceilf(rowmax(p0,p1))+(OPT?4.f:0.f); mhat=rm; typedef short v2i16_t __attribute__((ext_vector_type(2)));
    if(OPT||FAST){ scl=EX(rm);
      #pragma unroll
      for(int r=0;r<16;++r){ p0[r]=EX(p0[r]); p1[r]=EX(p1[r]); }
      #pragma unroll
      for(int w=0;w<4;++w){ v2i16_t a={0,0},b={0,0}; a=__builtin_amdgcn_cvt_scalef32_pk_fp8_f32(a,p0[4*w],p0[4*w+1],scl,false); a=__builtin_amdgcn_cvt_scalef32_pk_fp8_f32(a,p0[4*w+2],p0[4*w+3],scl,true);
        b=__builtin_amdgcn_cvt_scalef32_pk_fp8_f32(b,p1[4*w],p1[4*w+1],scl,false); b=__builtin_amdgcn_cvt_scalef32_pk_fp8_f32(b,p1[4*w+2],p1[4*w+3],scl,true); pwA[w]=__builtin_bit_cast(int,a); pwA[4+w]=__builtin_bit_cast(int,b); }
    } else {
      #pragma unroll
      for(int r=0;r<16;++r){ p0[r]=EX(p0[r]-rm); p1[r]=EX(p1[r]-rm); }
      #pragma unroll
      for(int w=0;w<4;++w){ int a=0,b=0; a=PK8(a,p0[4*w],p0[4*w+1],false); a=PK8(a,p0[4*w+2],p0[4*w+3],true); b=PK8(b,p1[4*w],p1[4*w+1],false); b=PK8(b,p1[4*w+2],p1[4*w+3],true); pwA[w]=a; pwA[4+w]=b; } }
    }
  WAIT_BAR(0);
  DMA_K(3,S0);DMA_V(1,S1);
  ROT();
  kload4(kq,kp0+sl_cur);
  WAIT_BAR(2);
  i32x2a vA[4],vB[4];
  #define VF8(A) (i32x8){A[0][0],A[0][1],A[1][0],A[1][1],A[2][0],A[2][1],A[3][0],A[3][1]}
  #define PIN(x) asm volatile("":"+v"(x))
  #define MX3(a,b,c) __builtin_fmaxf(__builtin_fmaxf((a),(b)),(c))
  #define VR4(A,d) do{ A[0]=vtr8(vp_+(d)*2048); A[1]=vtr8(vp_+(d)*2048+512); A[2]=vtr8(vp_+(d)*2048+1024); A[3]=vtr8(vp_+(d)*2048+1536); }while(0)
  #define MFO8(d,PW,A) asm volatile("s_nop 1\n\tv_mfma_f32_32x32x64_f8f6f4 %0, %1, %2, %0":"+v"(o[d]):"v"(PW),"v"(VF8(A)))
  #define MFOL(PW) asm volatile("s_nop 1\n\tv_mfma_f32_32x32x64_f8f6f4 %0, %1, %2, %0":"+v"(lacc):"v"(PW),"v"(ones8))
  #define KRD(G,j) do{ if(G){ kq[j]=*(const __attribute__((address_space(3))) i32x4a*)(kp0+sl_next+(j)*1024); } }while(0)
  #define SM8(X,B,PO,W) do{ _Pragma("unroll") for(int j_=0;j_<8;++j_){ X[(B)+j_]=EX(X[(B)+j_]-mhat); } \
      { int a_=0,b_=0; a_=PK8(a_,X[(B)],X[(B)+1],false); a_=PK8(a_,X[(B)+2],X[(B)+3],true); b_=PK8(b_,X[(B)+4],X[(B)+5],false); b_=PK8(b_,X[(B)+6],X[(B)+7],true); PO[W]=a_; PO[(W)+1]=b_; } }while(0)
  #define SM8F(X,B,PO,W) do{ _Pragma("unroll") for(int j_=0;j_<8;++j_){ X[(B)+j_]=EX(X[(B)+j_]); } \
      { typedef short v2i16_t __attribute__((ext_vector_type(2))); v2i16_t a_=__builtin_bit_cast(v2i16_t,PO[W]),b_=__builtin_bit_cast(v2i16_t,PO[(W)+1]); \
        a_=__builtin_amdgcn_cvt_scalef32_pk_fp8_f32(a_,X[(B)],X[(B)+1],scl,false); a_=__builtin_amdgcn_cvt_scalef32_pk_fp8_f32(a_,X[(B)+2],X[(B)+3],scl,true); \
        b_=__builtin_amdgcn_cvt_scalef32_pk_fp8_f32(b_,X[(B)+4],X[(B)+5],scl,false); b_=__builtin_amdgcn_cvt_scalef32_pk_fp8_f32(b_,X[(B)+6],X[(B)+7],scl,true); \
        PO[W]=__builtin_bit_cast(int,a_); PO[(W)+1]=__builtin_bit_cast(int,b_); } }while(0)
  #define STEP2(t,PI,PO,GK,GV,GL,SMX,FV) do{ SBAR(); \
    const lds_cptr vp_=vp0+2*sl_prev; f32x16 C0,C1; \
    VR4(vA,0); SBAR(); C0=mfq8(cat8i(kq[0],kq[1]),q8); SBAR(); \
    VR4(vB,1); SBAR(); C1=mfq8(cat8i(kq[2],kq[3]),q8); SBAR(); \
    if(GK){DMA_K((t)+3,sl_cur);} if(GV){DMA_V((t)+1,sl_next);} \
    asm volatile("s_nop 15\n\ts_nop 3":"+v"(C0),"+v"(C1));   \
    if constexpr(!OPT){ float a=MX3(C0[0],C0[1],C1[0]),b=MX3(C0[2],C0[3],C1[1]); a=MX3(a,C1[2],C1[3]); \
      _Pragma("unroll") for(int r=4;r<16;r+=4){a=MX3(a,C0[r],C0[r+1]);b=MX3(b,C0[r+2],C0[r+3]);a=MX3(a,C1[r],C1[r+1]);b=MX3(b,C1[r+2],C1[r+3]);} \
      float rm=__builtin_fmaxf(a,b); { auto rr=__builtin_amdgcn_permlane32_swap(__float_as_uint(rm),__float_as_uint(rm),false,false); rm=__builtin_fmaxf(__uint_as_float(rr[0]),__uint_as_float(rr[1])); } \
      resc=false; \
      if(__builtin_expect(__any(rm-mhat>(float)THRL),0)){ const float dl=__builtin_fmaxf(__builtin_ceilf(rm-mhat)-(THRL?6.f:0.f),0.f); mhat+=dl;   \
        const float f=__builtin_amdgcn_exp2f(-dl); if(FV){ scl=EX(mhat); } { unsigned keep_; asm volatile("s_mov_b32 %0, m0\n\ts_mov_b32 m0, %2\n\ts_nop 0\n\tds_write_addtid_b32 %1\n\ts_mov_b32 m0, %0":"=&s"(keep_):"v"(f),"s"(wsf_lds):"memory"); } resc=true; } } \
    __builtin_amdgcn_s_setprio(1); SBAR(); \
    MFO8(0,PI,vA); SMX(C0,0,PO,0); VR4(vA,2); SBAR(); \
    MFO8(1,PI,vB); SMX(C0,8,PO,2); VR4(vB,3); SBAR(); \
    MFO8(2,PI,vA); SMX(C1,0,PO,4); KRD(GL,0); KRD(GL,1); SBAR(); \
    MFO8(3,PI,vB); SMX(C1,8,PO,6); KRD(GL,2); KRD(GL,3); SBAR(); \
    MFOL(PI); __builtin_amdgcn_s_setprio(0); \
    }while(0)
  #define ENDW(tt) do{ if((tt)+3<NT){WAIT_BAR(2);} else {WAIT_BAR(0);} }while(0)
  #define PREFETCH_NEXT() do{ if(nxt){ const int n0_=(s0+NT)%3, n1_=(n0_==2?0:n0_+1), n2_=(n0_==0?2:n0_-1); const unsigned char*nk_=(const unsigned char*)K+nqcol; const unsigned char*nv_=(const unsigned char*)V+nvcol; \
      const long r0_=(0<nNT-4?klat:kctx), r1_=(1<nNT-4?klat+KVBLK:kctx+(long)(1-(nNT-4))*KVBLK), r2_=(2<nNT-4?klat+2*KVBLK:kctx+(long)(2-(nNT-4))*KVBLK); \
      glds16s_lo(nk_+r0_*1024,koff,(unsigned)(kdst+n0_*SLOTB)); glds16s(nv_+r0_*1024,voff,(unsigned)(vdst+2*n0_*SLOTB)); glds16s_lo(nk_+r1_*1024,koff,(unsigned)(kdst+n1_*SLOTB)); glds16s_lo(nk_+r2_*1024,koff,(unsigned)(kdst+n2_*SLOTB)); } }while(0)
  #define LOOPS(SMX,FV) do{ int t=1; \
    for(;t+5<NT;t+=2){ \
      STEP2(t,  pwA,pwB,true,true,true,SMX,FV); WAIT_BAR(2); RESC(); ROT(); \
      STEP2(t+1,pwB,pwA,true,true,true,SMX,FV); WAIT_BAR(2); RESC(); ROT(); \
    } \
    for(;t+1<NT;t+=2){ \
      STEP2(t,  pwA,pwB,(t+3<NT),(t+1<NT),(t+1<NT),SMX,FV); ENDW(t);   RESC(); ROT(); \
      STEP2(t+1,pwB,pwA,(t+4<NT),(t+2<NT),(t+2<NT),SMX,FV); ENDW(t+1); RESC(); ROT(); \
    } \
    PREFETCH_NEXT(); STEP2(NT-1,pwA,pwB,false,false,false,SMX,FV); RESC(); }while(0)
  if constexpr(OPT){ LOOPS(SM8F,true); } else { if(FAST){ LOOPS(SM8F,true); } else { LOOPS(SM8,false); } }
  #undef LOOPS
  #undef PREFETCH_NEXT
  { const lds_cptr vp_=vp0+2*sl_cur;
    VR4(vA,0); VR4(vB,1); MFO8(0,pwB,vA); MFO8(1,pwB,vB); VR4(vA,2); VR4(vB,3); MFO8(2,pwB,vA); MFO8(3,pwB,vB); MFOL(pwB);
    asm volatile("s_nop 15\n\ts_nop 7":"+v"(o[0]),"+v"(o[1]),"+v"(o[2]),"+v"(o[3]),"+v"(lacc)); }
  if constexpr(OPT){ float bad=lacc[0]; _Pragma("unroll") for(int r=1;r<16;++r)bad+=lacc[r];
    if(__any(!(__builtin_fabsf(bad)<3.0e38f))||!FAST){ *ovf=1u; } }
  { int lane_l=lane; asm volatile("":"+v"(lane_l));
  { const int lane=lane_l,r32=lane&31,hi=lane>>5;
  float rli[16];
  #pragma unroll
  for(int r=0;r<16;++r)rli[r]=__builtin_amdgcn_rcpf(lacc[r]);
  unsigned short*stash=(unsigned short*)(shm+L2_ST)+wid*4096;
  if(m==0){
    #pragma unroll
    for(int d0=0;d0<4;++d0){
      #pragma unroll
      for(int r=0;r<16;++r)stash[(d0*16+r)*64+lane]=(unsigned short)f2bf(o[d0][r]*rli[r]);}
    asm volatile("s_waitcnt lgkmcnt(0)":::"memory");
  } else {
    const float lam=__uint_as_float(__hip_atomic_load((const unsigned*)lamp,__ATOMIC_RELAXED,__HIP_MEMORY_SCOPE_AGENT));
    float ss[16];
    #pragma unroll
    for(int r=0;r<16;++r)ss[r]=0.f;
    #pragma unroll
    for(int d0=0;d0<4;++d0){
      #pragma unroll
      for(int r=0;r<16;++r){ const float o1=bf2f(stash[(d0*16+r)*64+lane]); const float df=o1-lam*(o[d0][r]*rli[r]); o[d0][r]=df; ss[r]+=df*df; } }
    #pragma unroll
    for(int r=0;r<16;++r){ float q=ss[r];
      q+=__int_as_float(__builtin_amdgcn_ds_swizzle(__float_as_int(q),0x41f));
      q+=__int_as_float(__builtin_amdgcn_ds_swizzle(__float_as_int(q),0x81f));
      q+=__int_as_float(__builtin_amdgcn_ds_swizzle(__float_as_int(q),0x101f));
      q+=__int_as_float(__builtin_amdgcn_ds_swizzle(__float_as_int(q),0x201f));
      q+=__int_as_float(__builtin_amdgcn_ds_swizzle(__float_as_int(q),0x401f));
      ss[r]=(1.f-LAMBDA_INIT0)/sqrtf(q*(1.f/128.f)+LN_EPS); }
    asm volatile("s_waitcnt lgkmcnt(0)":::"memory");
    unsigned char*stg=(unsigned char*)stash;
    #pragma unroll
    for(int d0=0;d0<4;++d0){ const float sgv=subln[d0*32+r32];
      #pragma unroll
      for(int r=0;r<16;++r){ const int w8=__builtin_amdgcn_cvt_pk_fp8_f32(o[d0][r]*ss[r]*sgv,0.f,0,false); stg[crow(r,hi)*128+d0*32+r32]=(unsigned char)(w8&0xff); } }
    asm volatile("s_waitcnt lgkmcnt(0)":::"memory");
    unsigned char*Aw=A2+(qrow0+wid*QBLK)*DM+acol;
    #pragma unroll
    for(int i=0;i<4;++i){const int row=i*8+(lane>>3),ch=lane&7; const u32x4 v=*(const u32x4*)(stg+row*128+ch*16); *(u32x4*)(Aw+(long)row*DM+ch*16)=v;}
    asm volatile("s_waitcnt lgkmcnt(0)":::"memory");
  }
  } }
  asm volatile("s_waitcnt lgkmcnt(0)\n\ts_barrier":::"memory");
  int ovfl=0; if constexpr(OPT){ ovfl=__builtin_amdgcn_readfirstlane((int)*(volatile unsigned*)ovf); }
  #undef KVROW
  #undef DMA_K
  #undef DMA_V
  #undef RESC
  #undef ROT
  #undef EX
  #undef PK8
  #undef VF8
  #undef PIN
  #undef MX3
  #undef VR4
  #undef MFO8
  #undef KRD
  #undef MFOL
  #undef SM8
  #undef SM8F
  #undef STEP2
  #undef ENDW
  return ovfl;
}
#undef SBAR
#undef WAIT_BAR
}
__device__ __forceinline__ void phase_attn2(const Frame& F, const Prm& p) {
    const bf16* Q = (const bf16*)(p.ws + WS_Q); const bf16* K = (const bf16*)(p.ws + WS_K); const bf16* V = (const bf16*)(p.ws + WS_V); unsigned char* A2 = p.ws + WS_O1;
    const float* lamp = (const float*)(p.ws + WS_MISC);
    for (int v = vcu_of(F); v < 256; v += F.G) {
        const int b = v >> 5, hs = (v >> 4) & 1, qb = v & 15;
        const long kctx = NLAT + b * CTXL, klat = (long)b * SEQ;
        unsigned* ovf = (unsigned*)(F.lds + LDS_BYTES - 32);
        const int nun = qb < 4 ? 5 : 4;
        int s0 = 0; bool pre = false;
        for (int u = 0; u < nun; ++u) {
            const int uu = (qb < 4 && u > qb) ? u - 1 : u;
            const bool isctx = (qb < 4 && u == qb + 1);
            const int h = 2 * uu + hs; const long qrow0 = isctx ? kctx : klat + qb * 256; const int NT = isctx ? 4 : 68;
            const int un = u + 1; const bool hasn = un < nun; const int uun = (qb < 4 && un > qb) ? un - 1 : un; const bool nctx = (qb < 4 && un == qb + 1);
            const int hn = 2 * uun + hs, NTn = nctx ? 4 : 68;
            int redo = 0;
            for (int m = 0; m < 2; ++m) {
                const int hm = 2 * h + m;
                const float km = __uint_as_float(__hip_atomic_load(F.ctl + CW_KM + b * 16 + hm, __ATOMIC_RELAXED, __HIP_MEMORY_SCOPE_AGENT));
                const bool nx = m == 0 ? true : hasn;
                const int nq = m == 0 ? (hm + 1) * 64 : 2 * hn * 64, nvc = m == 0 ? h * 128 : hn * 128, nnt = m == 0 ? NT : NTn;
                redo |= attn_body::attn_unit2<8, true>(qrow0, hm * 64, h * 128, kctx, klat, NT, Q, K, V, m, lamp, p.subln, A2, h * 128, km, (char*)F.lds, F.wave, ovf, s0, pre, nx, nq, nvc, nnt);
                s0 = (s0 + NT) % 3; pre = nx;
            }
            if (redo) {
                asm volatile("s_waitcnt vmcnt(0)" ::: "memory");
                __syncthreads(); if (F.wave == 0) *ovf = 0u; __syncthreads();
                for (int m = 0; m < 2; ++m) {
                    const int hm = 2 * h + m;
                    const float km = __uint_as_float(__hip_atomic_load(F.ctl + CW_KM + b * 16 + hm, __ATOMIC_RELAXED, __HIP_MEMORY_SCOPE_AGENT));
                    (void)attn_body::attn_unit2<8, false>(qrow0, hm * 64, h * 128, kctx, klat, NT, Q, K, V, m, lamp, p.subln, A2, h * 128, km, (char*)F.lds, F.wave, ovf, 0, false, false, 0, 0, 68);
                }
                s0 = 0; pre = false;
            }
        }
    }
}
namespace gla3 {
typedef short bf16x8 __attribute__((ext_vector_type(8)));
typedef short s16x4 __attribute__((ext_vector_type(4)));
typedef float f32x16 __attribute__((ext_vector_type(16)));
constexpr int CH = 64 * 16 + 64;
constexpr int L_QS = 0, L_KS = 16 * CH, L_VS = 32 * CH, L_SB = 40 * CH, L_X = 56 * CH, L_DEC = L_X + 16384, L_END = L_DEC + 512;
__device__ __forceinline__ int crow(int i, int hh) { return (i & 3) + 8 * (i >> 2) + 4 * hh; }
typedef float f32x2_t __attribute__((ext_vector_type(2))); typedef __bf16 bf16x2_t __attribute__((ext_vector_type(2)));
__device__ __forceinline__ unsigned pk(float lo, float hi) { f32x2_t v = {lo, hi}; bf16x2_t b = __builtin_convertvector(v, bf16x2_t); return __builtin_bit_cast(unsigned, b); }
typedef short v4i16_t __attribute__((ext_vector_type(4)));
__device__ __forceinline__ s16x4 trrd(LAS const unsigned char* p) { return __builtin_bit_cast(s16x4, __builtin_amdgcn_ds_read_tr16_b64_v4i16((LAS v4i16_t*)p)); }
#define GLA_FR(lo, hi) (bf16x8){lo[0], lo[1], lo[2], lo[3], hi[0], hi[1], hi[2], hi[3]}

__device__ __forceinline__ void scan_unit(const Frame& F, const Prm& p, int unit) {
    const int dvs = unit & 3, dir = (unit >> 2) & 1, h = (unit >> 3) & 3, b = unit >> 5;
    LAS unsigned char* lds = (LAS unsigned char*)F.lds;
    const int lane = F.lane, w = F.wave, tid = F.tid, r = lane & 31, hh = lane >> 5;
    const bf16* QT = (const bf16*)(p.ws + WS_QT) + ((size_t)dir * 8 + 2 * h) * NTOK * 64;
    const bf16* KT = (const bf16*)(p.ws + WS_KT) + ((size_t)dir * 8 + 2 * h) * NTOK * 64;
    const bf16* V = (const bf16*)(p.ws + WS_V1) + h * 256 + dvs * 64;
    const float* DEC = (const float*)(p.ws + WS_DEC) + (size_t)dir * NCHUNK * 512 + h * 128;
    bf16* OG = (bf16*)((unsigned char*)p.out + (dir ? OUT_OGB : 0)) + h * 256 + dvs * 64;
    const int g1 = (lane >> 4) & 1, q4 = (lane & 15) >> 2, p4 = lane & 3;
    const int trb = (2 * g1 + (p4 >> 1)) * CH + q4 * 16 + 8 * (p4 & 1);
    const int trN = trb + 128 * hh, trP = trb + 64 * hh;
    f32x16 S0 = {}, S1 = {};
    for (int i = tid; i < 16 * CH / 16; i += NTHR) *(LAS u32x4*)(lds + L_SB + i * 16) = (u32x4){0u, 0u, 0u, 0u};
    u32x4 pq0[2], pq1[2], pk0[2], pk1[2], pv[2]; float pdec[2] = {0.f, 0.f};
#define GLA_CHUNK(step) ((step) >= 4 ? b * 64 + (dir ? 63 - ((step) - 4) : (step) - 4) : 512 + b * 4 + (dir ? 3 - (step) : (step)))
    const int qrow = 8 * w + (lane >> 4), qch = lane & 15, vrow = 8 * w + (lane >> 3), vch = lane & 7;
    const size_t qgo = (size_t)(qch >> 3) * NTOK * 64 + (qch & 7) * 8;
#define GLA_LOAD(step, u) do { const size_t t0_ = (size_t)GLA_CHUNK(step) * 64; \
        pq0[u] = *(const u32x4*)(QT + qgo + (t0_ + qrow) * 64); pq1[u] = *(const u32x4*)(QT + qgo + (t0_ + qrow + 4) * 64); \
        pk0[u] = *(const u32x4*)(KT + qgo + (t0_ + qrow) * 64); pk1[u] = *(const u32x4*)(KT + qgo + (t0_ + qrow + 4) * 64); \
        pv[u] = *(const u32x4*)(V + (t0_ + vrow) * 1024 + 8 * vch); if (tid < 128) pdec[u] = DEC[(size_t)GLA_CHUNK(step) * 512 + tid]; } while (0)
#define GLA_STORE(u) do { \
        *(LAS u32x4*)(lds + L_QS + qch * CH + qrow * 16) = pq0[u]; *(LAS u32x4*)(lds + L_QS + qch * CH + (qrow + 4) * 16) = pq1[u]; \
        *(LAS u32x4*)(lds + L_KS + qch * CH + qrow * 16) = pk0[u]; *(LAS u32x4*)(lds + L_KS + qch * CH + (qrow + 4) * 16) = pk1[u]; \
        *(LAS u32x4*)(lds + L_VS + vch * CH + vrow * 16) = pv[u]; \
        if (tid < 128) *(LAS float*)(lds + L_DEC + 4 * tid) = pdec[u]; } while (0)
    GLA_LOAD(0, 0);
    GLA_LOAD(1, 1);
    GLA_STORE(0);
    __syncthreads();
    const int tb = (w & 3) >> 1, vb = w & 1;
    for (int sp2 = 0; sp2 < 34; ++sp2) {
#pragma unroll
    for (int u = 0; u < 2; ++u) {
        const int step = 2 * sp2 + u;
        const bool lat = step >= 4; const int chunk = GLA_CHUNK(step);
        if (step + 2 < 68) GLA_LOAD(step + 2, u);
        f32x16 o = {};
        if (w < 4) {
            if (lat) {
                const bool n0 = dir ? (tb == 0) : true, n1 = dir ? true : (tb == 1);
                f32x16 sc0 = {}, sc1 = {};
#define GLA_BQ(ks) (*(const LAS bf16x8*)(lds + L_QS + (2 * (ks) + hh) * CH + (32 * tb + r) * 16))
#define GLA_A0(ks) (*(const LAS bf16x8*)(lds + L_KS + (2 * (ks) + hh) * CH + r * 16))
#define GLA_A1(ks) (*(const LAS bf16x8*)(lds + L_KS + (2 * (ks) + hh) * CH + (32 + r) * 16))
                if (n0 && n1) {
#pragma unroll
                    for (int ks = 0; ks < 8; ++ks) { const bf16x8 bq = GLA_BQ(ks); sc0 = __builtin_amdgcn_mfma_f32_32x32x16_bf16(GLA_A0(ks), bq, sc0, 0, 0, 0); sc1 = __builtin_amdgcn_mfma_f32_32x32x16_bf16(GLA_A1(ks), bq, sc1, 0, 0, 0); }
                } else if (n0) {
#pragma unroll
                    for (int ks = 0; ks < 8; ++ks) sc0 = __builtin_amdgcn_mfma_f32_32x32x16_bf16(GLA_A0(ks), GLA_BQ(ks), sc0, 0, 0, 0);
                } else {
#pragma unroll
                    for (int ks = 0; ks < 8; ++ks) sc1 = __builtin_amdgcn_mfma_f32_32x32x16_bf16(GLA_A1(ks), GLA_BQ(ks), sc1, 0, 0, 0);
                }
#undef GLA_BQ
#undef GLA_A0
#undef GLA_A1
                const int t = 32 * tb + r;
#pragma unroll
                for (int i = 0; i < 16; ++i) { const int s0 = crow(i, hh), s1 = 32 + s0; const bool k0 = dir ? (s0 >= t) : (s0 <= t), k1 = dir ? (s1 >= t) : (s1 <= t); sc0[i] = k0 ? sc0[i] : 0.f; sc1[i] = k1 ? sc1[i] : 0.f; }
#pragma unroll
                for (int sb = 0; sb < 2; ++sb) { if (sb == 0 ? n0 : n1) {
#pragma unroll
                    for (int sp = 0; sp < 2; ++sp) {
                        u32x4 pw;
                        if (sb == 0) { pw.x = pk(sc0[8 * sp + 0], sc0[8 * sp + 1]); pw.y = pk(sc0[8 * sp + 2], sc0[8 * sp + 3]); pw.z = pk(sc0[8 * sp + 4], sc0[8 * sp + 5]); pw.w = pk(sc0[8 * sp + 6], sc0[8 * sp + 7]); }
                        else { pw.x = pk(sc1[8 * sp + 0], sc1[8 * sp + 1]); pw.y = pk(sc1[8 * sp + 2], sc1[8 * sp + 3]); pw.z = pk(sc1[8 * sp + 4], sc1[8 * sp + 5]); pw.w = pk(sc1[8 * sp + 6], sc1[8 * sp + 7]); }
                        LAS const unsigned char* vp = lds + L_VS + trP + (4 * vb) * CH + (32 * sb + 16 * sp) * 16;
                        const s16x4 lo = trrd(vp), hi = trrd(vp + 8 * 16);
                        o = __builtin_amdgcn_mfma_f32_32x32x16_bf16(GLA_FR(lo, hi), __builtin_bit_cast(bf16x8, pw), o, 0, 0, 0);
                    } } }
            }
        } else {
            const int db = w - 4;
            if (lat) {
                f32x16 o2 = {};
#pragma unroll
                for (int ks = 0; ks < 8; ++ks) {
                    const bf16x8 as = *(const LAS bf16x8*)(lds + L_SB + (2 * ks + hh) * CH + (32 * vb + r) * 16);
                    const bf16x8 bq = *(const LAS bf16x8*)(lds + L_QS + (2 * ks + hh) * CH + (32 * tb + r) * 16);
                    o2 = __builtin_amdgcn_mfma_f32_32x32x16_bf16(as, bq, o2, 0, 0, 0);
                }
#pragma unroll
                for (int g = 0; g < 4; ++g) *(LAS f32x4*)(lds + L_X + (w & 3) * 4096 + g * 1024 + lane * 16) = (f32x4){o2[4 * g], o2[4 * g + 1], o2[4 * g + 2], o2[4 * g + 3]};
            }
#pragma unroll
            for (int ks = 0; ks < 4; ++ks) {
                LAS const unsigned char* kp = lds + L_KS + trN + (4 * db) * CH + (16 * ks) * 16;
                LAS const unsigned char* vp = lds + L_VS + trN + (16 * ks) * 16;
                const s16x4 al = trrd(kp), ah = trrd(kp + 4 * 16);
                const s16x4 b0l = trrd(vp), b0h = trrd(vp + 4 * 16), b1l = trrd(vp + 4 * CH), b1h = trrd(vp + 4 * CH + 4 * 16);
                S0 = __builtin_amdgcn_mfma_f32_32x32x16_bf16(GLA_FR(al, ah), GLA_FR(b0l, b0h), S0, 0, 0, 0); S1 = __builtin_amdgcn_mfma_f32_32x32x16_bf16(GLA_FR(al, ah), GLA_FR(b1l, b1h), S1, 0, 0, 0);
            }
#pragma unroll
            for (int i = 0; i < 16; ++i) { const float dc = *(const LAS float*)(lds + L_DEC + 4 * (32 * db + crow(i, hh))); S0[i] *= dc; S1[i] *= dc; }
        }
        __syncthreads();
        if (w < 4 && lat) {
            bf16* orow = OG + ((size_t)chunk * 64 + 32 * tb + r) * DM + 32 * vb + 4 * hh;
#pragma unroll
            for (int g = 0; g < 4; ++g) { const f32x4 x = *(const LAS f32x4*)(lds + L_X + w * 4096 + g * 1024 + lane * 16);
                u32x2 wv; wv.x = pk(o[4 * g] + x.x, o[4 * g + 1] + x.y); wv.y = pk(o[4 * g + 2] + x.z, o[4 * g + 3] + x.w); *(u32x2*)(orow + 8 * g) = wv; }
        }
        if (step + 1 < 68) {
            GLA_STORE(u ^ 1);
            if (w >= 4) { const int db = w - 4;
#pragma unroll
                for (int g = 0; g < 4; ++g) { u32x2 w0, w1; w0.x = pk(S0[4 * g], S0[4 * g + 1]); w0.y = pk(S0[4 * g + 2], S0[4 * g + 3]); w1.x = pk(S1[4 * g], S1[4 * g + 1]); w1.y = pk(S1[4 * g + 2], S1[4 * g + 3]);
                    *(LAS u32x2*)(lds + L_SB + (4 * db + g) * CH + r * 16 + 8 * hh) = w0; *(LAS u32x2*)(lds + L_SB + (4 * db + g) * CH + (32 + r) * 16 + 8 * hh) = w1; } }
        }
        __syncthreads();
    }
    }
#undef GLA_CHUNK
#undef GLA_LOAD
#undef GLA_STORE
}
#undef GLA_FR
}
__device__ __forceinline__ void phase_scan_opt(const Frame& F, const Prm& p) {
    for (int unit = vcu_of(F); unit < 256; unit += F.G) gla3::scan_unit(F, p, unit);
}
#define PHASE_QKV(F, p) phase_qkv_opt(F, p)
#define PHASE_ATTN(F, p) phase_attn2(F, p)
#define PHASE_WO(F, p, l) phase_wo_opt(F, p, l)
#define PHASE_MOE1(F, p, l) phase_moe1_opt(F, p, l)
#define PHASE_MOE2(F, p, l) phase_moe2_opt(F, p, l)
#define PHASE_INPROJ(F, p) phase_inproj_opt(F, p)
#define PHASE_SCAN(F, p) phase_scan_opt(F, p)
typedef GAS unsigned gu32;
#define XB_TMO      128
#define XB_XCNT(j)  (256  + 64 * (j))
#define XB_XSUB(j)  (1280 + 64 * (j))
#define XB_XGEN(j)  (2304 + 64 * (j))
#define XB_TOP      3328
#define XB_TOPGEN   3392
#define XCD_BAR_WORDS 3456
#define XB_SPIN_CAP (1u << 20)
__device__ __forceinline__ unsigned xb_ld(unsigned* p)              { return __hip_atomic_load(p, __ATOMIC_RELAXED, __HIP_MEMORY_SCOPE_AGENT); }
__device__ __forceinline__ unsigned xb_add(unsigned* p, unsigned v) { return __hip_atomic_fetch_add(p, v, __ATOMIC_RELAXED, __HIP_MEMORY_SCOPE_AGENT); }
__device__ __forceinline__ unsigned xb_xcc_id() { return (unsigned)__builtin_amdgcn_s_getreg((3 << 11) | 20) & 0xFu; }
#define XB_SPIN(cond, bar) do { unsigned _sp = 0; while (cond) { __builtin_amdgcn_s_sleep(1); \
    if ((++_sp & 255u) == 0u) { if (xb_ld(&(bar)[XB_TMO])) break; if (_sp > XB_SPIN_CAP) { atomicAdd(&(bar)[XB_TMO], 1u); break; } } } } while (0)
struct XcdBarrier { unsigned* bar; unsigned x; volatile LAS unsigned* st; };
__device__ __forceinline__ XcdBarrier xcd_barrier_post(unsigned* bar, volatile LAS unsigned* st) {
    XcdBarrier b; b.bar = bar; b.x = xb_xcc_id(); b.st = st;
    if (threadIdx.x == 0) (void)xb_add(&bar[XB_XCNT(b.x)], 1u);
    return b;
}
__device__ __forceinline__ void xcd_barrier_complete(unsigned* bar, unsigned x, unsigned& nloc, unsigned& nx) {
    const unsigned G = gridDim.x * gridDim.y * gridDim.z;
    unsigned sum, cnt, mine, sp = 0u;
    for (;;) {
        sum = 0u; cnt = 0u; mine = 0u;
#pragma unroll
        for (unsigned j = 0; j < 16; ++j) { const unsigned c = xb_ld(&bar[XB_XCNT(j)]); sum += c; cnt += (c > 0u) ? 1u : 0u; mine = (j == x) ? c : mine; }
        if (sum == G) break;
        __builtin_amdgcn_s_sleep(1);
        if ((++sp & 255u) == 0u) { if (xb_ld(&bar[XB_TMO])) break; if (sp > XB_SPIN_CAP) { atomicAdd(&bar[XB_TMO], 1u); break; } }
    }
    nloc = mine > 0u ? mine : 1u; nx = cnt > 0u ? cnt : 1u;
}
__device__ __forceinline__ void xcd_barrier(const XcdBarrier& b, int tid) {
    asm volatile("s_waitcnt vmcnt(0)" ::: "memory");
    __syncthreads();
    if (tid == 0) {
        unsigned* bar = b.bar;
        __builtin_amdgcn_s_waitcnt(0);
        unsigned nloc = b.st[0], nx = b.st[1];
        if (nloc == 0u) { xcd_barrier_complete(bar, b.x, nloc, nx); b.st[0] = nloc; b.st[1] = nx; }
        const unsigned old = xb_add(&bar[XB_XSUB(b.x)], 1u);
        const unsigned gen = old / nloc;
        if (old + 1u == (gen + 1u) * nloc) {
            __builtin_amdgcn_fence(__ATOMIC_RELEASE, "agent");
            asm volatile("s_waitcnt vmcnt(0)" ::: "memory");
            const unsigned og = xb_add(&bar[XB_TOP], 1u);
            const unsigned tg = og / nx;
            if (og + 1u == (tg + 1u) * nx) xb_add(&bar[XB_TOPGEN], 1u);
            else XB_SPIN(xb_ld(&bar[XB_TOPGEN]) == tg, bar);
            __builtin_amdgcn_fence(__ATOMIC_ACQUIRE, "agent");
            xb_add(&bar[XB_XGEN(b.x)], 1u);
            asm volatile("s_waitcnt vmcnt(0)" ::: "memory");
        } else {
            XB_SPIN(xb_ld(&bar[XB_XGEN(b.x)]) == gen, bar);
            __builtin_amdgcn_fence(__ATOMIC_ACQUIRE, "agent");
            asm volatile("s_waitcnt vmcnt(0)" ::: "memory");
        }
    }
    __syncthreads();
}

constexpr int NPHASE = 19;
__global__ void __launch_bounds__(NTHR, 2) mega_fwd(Prm p) {
    extern __shared__ __attribute__((aligned(16))) unsigned char lds[];
    Frame F; F.lds = lds; F.ctl = (unsigned*)(p.ws + WS_CTL);
    F.tid = threadIdx.x; F.lane = F.tid & 63; F.wave = __builtin_amdgcn_readfirstlane(F.tid >> 6); F.G = gridDim.x; F.bid = blockIdx.x;
    for (int u = F.tid; u < (LDS_BYTES - LDSCTL_OFF) / 4; u += NTHR) ((LAS unsigned*)(lds + LDSCTL_OFF))[u] = 0u;
    __syncthreads();
    const int lo = p.ph_lo, hi = p.ph_hi;
    const bool multi = (hi - lo) > 1;
    XcdBarrier bar; bar.bar = F.ctl + CW_BAR + p.li * XCD_BAR_WORDS; bar.x = 0; bar.st = nullptr;
    if (multi) bar = xcd_barrier_post(F.ctl + CW_BAR + p.li * XCD_BAR_WORDS, (volatile LAS unsigned*)(lds + MISC_OFF) + 8);
#define IN(k) (lo <= (k) && (k) < hi)
#define SEAM(k) do { if (IN(k) && IN((k) + 1)) xcd_barrier(bar, F.tid); } while (0)
    if (IN(0)) { phase_prologue(F, p); } SEAM(0);
    if (IN(1)) { phase_modulate0(F, p); } SEAM(1);
    if (IN(2)) { PHASE_QKV(F, p); } SEAM(2);
    if (IN(3)) { PHASE_ATTN(F, p); }
    {
        int l_; asm volatile("v_mbcnt_lo_u32_b32 %0, -1, 0\n\tv_mbcnt_hi_u32_b32 %0, -1, %0" : "=v"(l_)); F.lane = l_; F.tid = F.wave * 64 + l_; }
    SEAM(3);
    if (IN(5)) { PHASE_WO(F, p, 0); } SEAM(5);
    if (IN(6)) { phase_ln_route(F, p, 0); } SEAM(6);
    if (IN(7)) { PHASE_MOE1(F, p, 0); } SEAM(7);
    if (IN(8)) { PHASE_MOE2(F, p, 0); } SEAM(8);
    if (IN(9)) { phase_moe_combine(F, p, 0); } SEAM(9);
    if (IN(10)) { PHASE_INPROJ(F, p); } SEAM(10);
    if (IN(11)) { phase_gla_prep(F, p); } SEAM(11);
    if (IN(12)) { PHASE_SCAN(F, p); } SEAM(12);
    if (IN(13)) { phase_gla_post(F, p); } SEAM(13);
    if (IN(14)) { PHASE_WO(F, p, 1); } SEAM(14);
    if (IN(15)) { phase_ln_route(F, p, 1); } SEAM(15);
    if (IN(16)) { PHASE_MOE1(F, p, 1); } SEAM(16);
    if (IN(17)) { PHASE_MOE2(F, p, 1); } SEAM(17);
    if (IN(18)) { phase_moe_combine(F, p, 1); }
#undef IN
#undef SEAM
}

extern "C" void kernel_launch(void* const* d_in, const int* in_sizes, int n_in, void* d_out, int out_size, void* d_ws, size_t ws_size, hipStream_t stream) {
    static int grid = 0;
    if (grid == 0) {
        if (n_in != 23 || in_sizes[0] != NLAT * DM || out_size != NLAT * DM || ws_size < WS_END) { fprintf(stderr, "kernel_launch: unexpected shapes (n_in %d, in0 %d, out %d, ws %zu); nothing launched\n", n_in, n_in > 0 ? in_sizes[0] : -1, out_size, ws_size); grid = -1; return; }
        int dev = 0, cus = 0;
        if (hipGetDevice(&dev) != hipSuccess || hipDeviceGetAttribute(&cus, hipDeviceAttributeMultiprocessorCount, dev) != hipSuccess) { grid = -1; return; }
        if (hipFuncSetAttribute((const void*)mega_fwd, hipFuncAttributeMaxDynamicSharedMemorySize, LDS_BYTES) != hipSuccess) { fprintf(stderr, "kernel_launch: hipFuncSetAttribute failed\n"); grid = -1; return; }
        int per_cu = 0;
        if (hipOccupancyMaxActiveBlocksPerMultiprocessor(&per_cu, (const void*)mega_fwd, NTHR, LDS_BYTES) != hipSuccess || per_cu < 1) fprintf(stderr, "kernel_launch: note: occupancy query reports %d\n", per_cu);
        (void)hipGetLastError();
        grid = cus;
    }
    if (grid < 0) return;
    (void)hipMemsetAsync((char*)d_ws + WS_CTL, 0, CTL_ZERO_BYTES, stream);
    Prm p{};
    const float** pp = (const float**)&p;
    for (int i = 0; i < 23; ++i) pp[i] = (const float*)d_in[i];
    p.out = (float*)d_out; p.ws = (unsigned char*)d_ws;
    p.ph_lo = 0; p.ph_hi = NPHASE; p.li = 0;
    hipLaunchKernelGGL(mega_fwd, dim3(grid), dim3(NTHR), LDS_BYTES, stream, p);
}
```

```cpp
#include <hip/hip_runtime.h>
#include <cstdint>
#include <cstdio>

constexpr int BATCH = 8, SEQ = 4096, DM = 1024, CTXL = 256;
constexpr int NLAT = BATCH * SEQ, NCTX = BATCH * CTXL, NTOK = NLAT + NCTX;
constexpr float ALPHA = 1.4142135623730951f;
constexpr float LN_EPS = 1e-5f;
constexpr float LAMBDA_INIT0 = 0.2f;
constexpr float C2 = 0.125f * 1.4426950408889634f;
constexpr int NEXP = 16, DEXP = 512, MAXSLOT = 73728;
constexpr int NCHUNK = NTOK / 64;
constexpr int NIN = 3328;

typedef unsigned short bf16;
typedef float f32x4 __attribute__((ext_vector_type(4)));
typedef float f32x2 __attribute__((ext_vector_type(2)));
typedef unsigned u32x2 __attribute__((ext_vector_type(2)));
typedef unsigned u32x4 __attribute__((ext_vector_type(4)));

constexpr size_t MiB = 1u << 20;
constexpr size_t WS_CTL = 0, CTL_ZERO_BYTES = 1 * MiB;
constexpr size_t WS_MOD = 1 * MiB;
constexpr size_t WS_MISC = 1 * MiB + 512 * 1024;
constexpr size_t WS_WQKV = 2 * MiB, WS_WO = 5 * MiB, WS_GU0 = 6 * MiB, WS_DN0 = 22 * MiB, WS_WIN = 30 * MiB, WS_WGO = 34 * MiB, WS_GU1 = 35 * MiB, WS_DN1 = 51 * MiB;
constexpr size_t WS_XB = 59 * MiB;
constexpr size_t WS_H = 127 * MiB;
constexpr size_t WS_Q = 195 * MiB, WS_K = 263 * MiB, WS_V = 331 * MiB, WS_O2 = 399 * MiB;
constexpr size_t WS_LIST = 467 * MiB;
constexpr size_t WS_TOKR = 470 * MiB;
constexpr size_t WS_DEC = 472 * MiB;
constexpr size_t WS_ZZ = 475 * MiB;
constexpr size_t WS_END = 480 * MiB;
constexpr size_t WS_O1 = WS_H, WS_A2 = WS_H, WS_Y = WS_K;
constexpr size_t WS_YM = 195 * MiB, WS_ACT = 339 * MiB;
constexpr size_t WS_QR = 195 * MiB, WS_KR = 229 * MiB, WS_V1 = 263 * MiB, WS_R = 331 * MiB;
constexpr size_t WS_QT = WS_H, WS_KT = 399 * MiB;
constexpr size_t WS_A2B = WS_H;
constexpr size_t OUT_OGB = 64 * MiB;
constexpr int CW_TMO = 0, CW_CODE = 1;
constexpr int CW_CNT = 64;
constexpr int CW_KM = 128;
constexpr int CW_BAR = 4096;

__device__ __forceinline__ unsigned f2bf(float f) { unsigned u = __builtin_bit_cast(unsigned, f); return (u + 0x7fffu + ((u >> 16) & 1u)) >> 16; }
__device__ __forceinline__ unsigned pk2(float lo, float hi) { return f2bf(lo) | (f2bf(hi) << 16); }
__device__ __forceinline__ float bf2f(unsigned b) { return __builtin_bit_cast(float, b << 16); }
__device__ __forceinline__ float wave_sum(float v) {
#pragma unroll
    for (int o = 1; o < 64; o <<= 1) v += __shfl_xor(v, o);
    return v;
}
__device__ __forceinline__ float silu_f(float v) { return v / (1.f + __expf(-v)); }

struct Prm {
    const float *x, *c, *ctx, *cctx, *ada_w, *ada_b, *ln_g, *ln_b, *w_qkv, *w_o, *lam, *subln, *gw_in, *gwg_down, *gwg_up, *gbg, *gnorm, *gw_o, *rw, *rb, *mg, *mu, *md;
    float* out; unsigned char* ws;
    int ph_lo, ph_hi, li, pad;
};
__device__ __forceinline__ void ld_row_f32(const float* p, int lane, f32x4 (&v)[4]) {
#pragma unroll
    for (int j = 0; j < 4; ++j) v[j] = *(const f32x4*)(p + 4 * lane + 256 * j);
}
__device__ __forceinline__ void st_row_f32(float* p, int lane, const f32x4 (&v)[4]) {
#pragma unroll
    for (int j = 0; j < 4; ++j) *(f32x4*)(p + 4 * lane + 256 * j) = v[j];
}
__device__ __forceinline__ void ld_row_bf16(const bf16* p, int lane, f32x4 (&v)[4]) {
#pragma unroll
    for (int j = 0; j < 4; ++j) { const u32x2 u = *(const u32x2*)(p + 4 * lane + 256 * j); v[j] = (f32x4){bf2f(u.x & 0xffffu), bf2f(u.x >> 16), bf2f(u.y & 0xffffu), bf2f(u.y >> 16)}; }
}
__device__ __forceinline__ void st_row_bf16(bf16* p, int lane, const f32x4 (&v)[4]) {
#pragma unroll
    for (int j = 0; j < 4; ++j) { u32x2 u; u.x = pk2(v[j].x, v[j].y); u.y = pk2(v[j].z, v[j].w); *(u32x2*)(p + 4 * lane + 256 * j) = u; }
}
__device__ __forceinline__ void ln_row(f32x4 (&v)[4], const float* g, const float* b, int lane) {
    float s = 0.f;
#pragma unroll
    for (int j = 0; j < 4; ++j) s += (v[j].x + v[j].y) + (v[j].z + v[j].w);
    const float mean = wave_sum(s) * (1.f / DM); float q = 0.f;
#pragma unroll
    for (int j = 0; j < 4; ++j) { v[j] = v[j] - mean; q += (v[j].x * v[j].x + v[j].y * v[j].y) + (v[j].z * v[j].z + v[j].w * v[j].w); }
    const float rstd = 1.f / sqrtf(wave_sum(q) * (1.f / DM) + LN_EPS);
#pragma unroll
    for (int j = 0; j < 4; ++j) { const f32x4 gg = *(const f32x4*)(g + 4 * lane + 256 * j), bb = *(const f32x4*)(b + 4 * lane + 256 * j); v[j] = v[j] * rstd * gg + bb; }
}
__host__ __device__ __forceinline__ int gu_phys(int other, int sel) { return (other >> 4) * 32 + sel * 16 + (other & 15); }
__host__ __device__ __forceinline__ int perm16b(int L) { return (L & ~31) | (16 * ((L >> 2) & 1) + 4 * ((L >> 3) & 3) + (L & 3)); }
__host__ __device__ __forceinline__ int perm16b_inv(int P) { return (P & ~31) | (8 * ((P >> 2) & 3) + 4 * ((P >> 4) & 1) + (P & 3)); }
__device__ __forceinline__ unsigned pk4_fp8(float a, float b, float c, float d) { int w = 0; w = __builtin_amdgcn_cvt_pk_fp8_f32(a, b, w, false); w = __builtin_amdgcn_cvt_pk_fp8_f32(c, d, w, true); return (unsigned)w; }
constexpr float W8_SCALE = 64.f, W8_INV = 1.f / 64.f;
__device__ __forceinline__ void st_row_fp8(unsigned char* p, int lane, const f32x4 (&v)[4]) {
#pragma unroll
    for (int j = 0; j < 4; ++j) *(unsigned*)(p + 4 * lane + 256 * j) = pk4_fp8(v[j].x, v[j].y, v[j].z, v[j].w);
}
__device__ __forceinline__ void ld_row_fp8(const unsigned char* p, int lane, f32x4 (&v)[4]) {
#pragma unroll
    for (int j = 0; j < 4; ++j) { const int w = *(const int*)(p + 4 * lane + 256 * j); const f32x2 lo = __builtin_amdgcn_cvt_pk_f32_fp8(w, false), hi = __builtin_amdgcn_cvt_pk_f32_fp8(w, true); v[j] = (f32x4){lo.x, lo.y, hi.x, hi.y}; }
}
#define GAS __attribute__((address_space(1)))
#define LAS __attribute__((address_space(3)))
constexpr int NWAVES = 8, NTHR = NWAVES * 64;
constexpr int RING_BYTES = 131072, LDS_BYTES = 147456, LDSCTL_OFF = LDS_BYTES - 1024, MISC_OFF = LDSCTL_OFF + 320;
constexpr int LDSX_OFF = RING_BYTES + 1024;
#define LDS_WAIT() asm volatile("s_waitcnt lgkmcnt(0)" ::: "memory")
#define VM_WAIT() asm volatile("s_waitcnt vmcnt(0)" ::: "memory")

struct Frame {
    unsigned char* lds;
    unsigned* ctl;
    int tid, lane, wave, G, bid;
};

template <int MODE>
__device__ __forceinline__ void p0_transpose_item(const float* W, int K, int N, bf16* WT, int row_off, float* scr, int item, int lane) {
    const int nblk = N / 32, kb = item / nblk, nb = item % nblk, k0 = 64 * kb, n0 = 32 * nb;
    { f32x4 t[8];
#pragma unroll
        for (int i = 0; i < 8; ++i) t[i] = *(const f32x4*)(W + (size_t)(k0 + 8 * i + (lane >> 3)) * N + n0 + 4 * (lane & 7));
#pragma unroll
        for (int i = 0; i < 8; ++i) { float* d = scr + (8 * i + (lane >> 3)) * 33 + 4 * (lane & 7); d[0] = t[i].x; d[1] = t[i].y; d[2] = t[i].z; d[3] = t[i].w; } }
    LDS_WAIT(); asm volatile("" ::: "memory");
    const int c = lane & 7;
#pragma unroll
    for (int j = 0; j < 4; ++j) { const int n = (lane >> 3) + 8 * j; const float* s = scr + (8 * c) * 33 + n;
        u32x4 o; o.x = pk2(s[0 * 33], s[1 * 33]); o.y = pk2(s[2 * 33], s[3 * 33]); o.z = pk2(s[4 * 33], s[5 * 33]); o.w = pk2(s[6 * 33], s[7 * 33]);
        const int nl = n0 + n; const int pr = (MODE == 0) ? (row_off + nl) : (MODE == 3) ? (row_off + perm16b(nl)) : (row_off + gu_phys(nl, MODE - 1));
        *(u32x4*)(WT + (size_t)pr * K + k0 + 8 * c) = o; }
    LDS_WAIT(); asm volatile("" ::: "memory");
}
template <int MODE>
__device__ __forceinline__ void p0_transpose_item8(const float* W, int K, int N, unsigned char* WT, float* scr, int item, int lane) {
    const int nblk = N / 32, kb = item / nblk, nb = item % nblk, k0 = 64 * kb, n0 = 32 * nb;
    { f32x4 t[8];
#pragma unroll
        for (int i = 0; i < 8; ++i) t[i] = *(const f32x4*)(W + (size_t)(k0 + 8 * i + (lane >> 3)) * N + n0 + 4 * (lane & 7));
#pragma unroll
        for (int i = 0; i < 8; ++i) { float* d = scr + (8 * i + (lane >> 3)) * 33 + 4 * (lane & 7); d[0] = t[i].x; d[1] = t[i].y; d[2] = t[i].z; d[3] = t[i].w; } }
    LDS_WAIT(); asm volatile("" ::: "memory");
    const int c = lane & 7;
#pragma unroll
    for (int j = 0; j < 4; ++j) { const int n = (lane >> 3) + 8 * j; const float* s = scr + (8 * c) * 33 + n;
        u32x2 o; o.x = pk4_fp8(s[0 * 33] * W8_SCALE, s[1 * 33] * W8_SCALE, s[2 * 33] * W8_SCALE, s[3 * 33] * W8_SCALE); o.y = pk4_fp8(s[4 * 33] * W8_SCALE, s[5 * 33] * W8_SCALE, s[6 * 33] * W8_SCALE, s[7 * 33] * W8_SCALE);
        const int nl = n0 + n; const int pr = (MODE == 3 || MODE == 4) ? perm16b(nl) : (MODE == 0) ? nl : gu_phys(nl, MODE - 1);
        if (MODE == 4) {
            unsigned char* d = WT + (size_t)pr * K + (k0 & ~127) + 16 * c + 4 * ((k0 >> 6) & 1);
            *(unsigned*)d = o.x; *(unsigned*)(d + 8) = o.y;
        } else *(u32x2*)(WT + (size_t)pr * K + k0 + 8 * c) = o; }
    LDS_WAIT(); asm volatile("" ::: "memory");
}
__device__ __forceinline__ void phase_prologue(const Frame& F, const Prm& p) {
    float* sil = (float*)F.lds;
    for (int i = F.tid; i < 9 * 1024; i += NTHR) { const int r = i >> 10, k = i & 1023; const float v = (r < 8) ? p.c[r * 1024 + k] : p.cctx[k]; sil[i] = silu_f(v); }
    __syncthreads();
    float* MOD = (float*)(p.ws + WS_MOD);
    if (F.bid < 192) {
        const int layer = F.bid / 96, n = (F.bid % 96) * 64 + F.lane; const float* W = p.ada_w + (size_t)layer * 1024 * 6144 + n;
        float acc[9];
#pragma unroll
        for (int r = 0; r < 9; ++r) acc[r] = 0.f;
        const int kb = F.wave * 128;
#pragma unroll 4
        for (int k = kb; k < kb + 128; k += 4) {
            const float w0 = W[(size_t)k * 6144], w1 = W[(size_t)(k + 1) * 6144], w2 = W[(size_t)(k + 2) * 6144], w3 = W[(size_t)(k + 3) * 6144];
#pragma unroll
            for (int r = 0; r < 9; ++r) { const f32x4 s = *(const f32x4*)(sil + r * 1024 + k); acc[r] += s.x * w0 + s.y * w1 + s.z * w2 + s.w * w3; }
        }
        float* red = (float*)(F.lds + 36864 + 8 * 8704);
#pragma unroll
        for (int r = 0; r < 9; ++r) red[(F.wave * 9 + r) * 64 + F.lane] = acc[r];
        __syncthreads();
        if (F.wave == 0) { const float bb = p.ada_b[layer * 6144 + n];
#pragma unroll
            for (int r = 0; r < 9; ++r) { float t = bb;
#pragma unroll
                for (int w = 0; w < 8; ++w) t += red[(w * 9 + r) * 64 + F.lane];
                MOD[(layer * 9 + r) * 6144 + n] = t; } }
    }
    float* misc = (float*)(p.ws + WS_MISC);
    if (F.bid == 255 % F.G && F.wave == 1) {
        const float a = wave_sum(p.lam[F.lane] * p.lam[64 + F.lane]), b = wave_sum(p.lam[128 + F.lane] * p.lam[192 + F.lane]);
        if (F.lane == 0) misc[0] = __expf(a) - __expf(b) + LAMBDA_INIT0;
        for (int i = F.lane; i < 1024; i += 64) { const int pos = i >> 4, f = i & 15; const float inv = powf(10000.f, -(float)f / 16.f); const float ang = (float)pos * inv;
            misc[1024 + 2 * i] = cosf(ang); misc[1024 + 2 * i + 1] = sinf(ang); }
    }
    float* scr = (float*)(F.lds + 36864 + F.wave * 8704);
    const int gw = F.bid * NWAVES + F.wave, NGW = F.G * NWAVES;
    constexpr int I_QKV = 16 * 96, I_SQ = 16 * 32, I_G = 16 * 16, I_D = 8 * 32;
    constexpr int I_MOE = 2 * I_G + I_D;
    constexpr int NITEMS = 2 * I_QKV + 2 * I_SQ + 32 * I_MOE;
    bf16* ws16 = (bf16*)p.ws;
    for (int it = gw; it < NITEMS; it += NGW) {
        int r = it;
        if (r < I_QKV) { if ((r % 96) < 64) p0_transpose_item8<0>(p.w_qkv, 1024, 3072, p.ws + WS_WQKV, scr, r, F.lane); else p0_transpose_item8<3>(p.w_qkv, 1024, 3072, p.ws + WS_WQKV, scr, r, F.lane); continue; } r -= I_QKV;
        if (r < I_QKV) { p0_transpose_item8<3>(p.gw_in, 1024, 3072, p.ws + WS_WIN, scr, r, F.lane); continue; } r -= I_QKV;
        if (r < I_SQ) { p0_transpose_item8<3>(p.w_o, 1024, 1024, p.ws + WS_WO, scr, r, F.lane); continue; } r -= I_SQ;
        if (r < I_SQ) { p0_transpose_item8<3>(p.gw_o, 1024, 1024, p.ws + WS_WGO, scr, r, F.lane); continue; } r -= I_SQ;
        const int le = r / I_MOE, layer = le >> 4, e = le & 15; r -= le * I_MOE;
        unsigned char* GU = p.ws + (layer ? WS_GU1 : WS_GU0) + (size_t)e * 1024 * 1024; unsigned char* DN = p.ws + (layer ? WS_DN1 : WS_DN0) + (size_t)e * 1024 * 512;
        if (r < I_G) { p0_transpose_item8<1>(p.mg + (size_t)le * 1024 * 512, 1024, 512, GU, scr, r, F.lane); continue; } r -= I_G;
        if (r < I_G) { p0_transpose_item8<2>(p.mu + (size_t)le * 1024 * 512, 1024, 512, GU, scr, r, F.lane); continue; } r -= I_G;
        p0_transpose_item8<4>(p.md + (size_t)le * 512 * 1024, 512, 1024, DN, scr, r, F.lane);
    }
    (void)ws16;
    unsigned char* WIN = p.ws + WS_WIN;
    for (int i = gw * 64 + F.lane; i < 32 * 256; i += NGW * 64) { const int rr = i >> 8, k = (i & 255) * 4, dir = rr >> 4, j = rr & 15; const float* s = p.gwg_down + (size_t)dir * 1024 * 16 + j;
        *(unsigned*)(WIN + (size_t)(3072 + rr) * 1024 + k) = pk4_fp8(s[(size_t)k * 16] * W8_SCALE, s[(size_t)(k + 1) * 16] * W8_SCALE, s[(size_t)(k + 2) * 16] * W8_SCALE, s[(size_t)(k + 3) * 16] * W8_SCALE); }
    for (int i = gw * 64 + F.lane; i < 224 * 1024 / 16; i += NGW * 64) *(u32x4*)(WIN + (size_t)3104 * 1024 + (size_t)i * 16) = (u32x4){0u, 0u, 0u, 0u};
}

__device__ __forceinline__ void phase_modulate0(const Frame& F, const Prm& p) {
    const float* MOD = (const float*)(p.ws + WS_MOD); unsigned char* H = p.ws + WS_H;
    const int gw = F.bid * NWAVES + F.wave, NGW = F.G * NWAVES, per = (NTOK + NGW - 1) / NGW;
    int curmod = -1; f32x4 sh[4], sc[4];
    const int t0 = gw * per, t1 = min(NTOK, (gw + 1) * per);
    f32x4 v[4], vn[4];
    if (t0 < t1) ld_row_f32(t0 < NLAT ? p.x + (size_t)t0 * DM : p.ctx + (size_t)(t0 - NLAT) * DM, F.lane, v);
    for (int tok = t0; tok < t1; ++tok) {
        if (tok + 1 < t1) ld_row_f32(tok + 1 < NLAT ? p.x + (size_t)(tok + 1) * DM : p.ctx + (size_t)(tok + 1 - NLAT) * DM, F.lane, vn);
        const int mr = tok < NLAT ? tok / SEQ : 8;
        if (mr != curmod) { curmod = mr; ld_row_f32(MOD + mr * 6144, F.lane, sh); ld_row_f32(MOD + mr * 6144 + 1024, F.lane, sc); }
#pragma unroll
        for (int j = 0; j < 4; ++j) v[j] = v[j] * (1.f + sc[j]) + sh[j];
        st_row_fp8(H + (size_t)tok * DM, F.lane, v);
#pragma unroll
        for (int j = 0; j < 4; ++j) v[j] = vn[j];
    }
}

__device__ __forceinline__ void phase_ln_route(const Frame& F, const Prm& p, int layer) {
    const int nrows = layer ? NLAT : NTOK;
    const float* MOD = (const float*)(p.ws + WS_MOD) + layer * 9 * 6144;
    const bf16* Y = (const bf16*)(p.ws + WS_Y); unsigned char* HF = p.ws + WS_H;
    bf16* XB = (bf16*)(p.ws + WS_XB);
    int* LIST = (int*)(p.ws + WS_LIST); int* TOKR = (int*)(p.ws + WS_TOKR);
    unsigned* CNT = F.ctl + CW_CNT + layer * 16;
    float* WrT = (float*)F.lds;
    int* rec = (int*)(F.lds + 65536);
    unsigned* lcnt = (unsigned*)(F.lds + 65536 + 8192); unsigned* lbase = lcnt + 16;
    for (int i = F.tid; i < 16 * 1024; i += NTHR) { const int k = i >> 4, e = i & 15; WrT[e * 1024 + k] = p.rw[i]; }
    if (F.tid < 16) lcnt[F.tid] = 0u;
    __syncthreads();
    const int per_wg = (nrows + F.G - 1) / F.G, per_w = (per_wg + NWAVES - 1) / NWAVES;
    const int row_lo = F.bid * per_wg, row_hi = min(nrows, row_lo + per_wg);
    const float* lng = p.ln_g + (layer * 2 + 0) * DM; const float* lnb = p.ln_b + (layer * 2 + 0) * DM;
    float rb[16];
#pragma unroll
    for (int e = 0; e < 16; ++e) rb[e] = p.rb[e];
    int curmod = -1; f32x4 gm[4], shf[4], scf[4];
    f32x4 v[4], y[4], vn[4], yn[4];
#define LNR_LOAD(tok_, V, Yv) do { if (layer) ld_row_bf16(XB + (size_t)(tok_) * DM, F.lane, V); else ld_row_f32((tok_) < NLAT ? p.x + (size_t)(tok_) * DM : p.ctx + (size_t)((tok_) - NLAT) * DM, F.lane, V); \
        ld_row_bf16(Y + (size_t)(tok_) * DM, F.lane, Yv); } while (0)
    if (row_lo + F.wave * per_w < row_hi) LNR_LOAD(row_lo + F.wave * per_w, v, y);
    for (int i = 0; i < per_w; ++i) {
        const int lr = F.wave * per_w + i, tok = row_lo + lr; if (tok >= row_hi) break;
        if (i + 1 < per_w && tok + 1 < row_hi) LNR_LOAD(tok + 1, vn, yn);
        const int mr = tok < NLAT ? tok / SEQ : 8;
        if (mr != curmod) { curmod = mr; ld_row_f32(MOD + mr * 6144 + 2048, F.lane, gm); ld_row_f32(MOD + mr * 6144 + 3072, F.lane, shf); ld_row_f32(MOD + mr * 6144 + 4096, F.lane, scf); }
        bf16* xdst = XB + (size_t)tok * DM;
#pragma unroll
        for (int j = 0; j < 4; ++j) v[j] = ALPHA * v[j] + gm[j] * y[j];
        ln_row(v, lng, lnb, F.lane);
        st_row_bf16(xdst, F.lane, v);
#pragma unroll
        for (int j = 0; j < 4; ++j) v[j] = v[j] * (1.f + scf[j]) + shf[j];
        st_row_fp8(HF + (size_t)tok * DM, F.lane, v);
        float part[16];
#pragma unroll
        for (int e = 0; e < 16; ++e) { float s = 0.f;
#pragma unroll
            for (int j = 0; j < 4; ++j) { const f32x4 w = *(const f32x4*)(WrT + e * 1024 + 4 * F.lane + 256 * j); s += (v[j].x * w.x + v[j].y * w.y) + (v[j].z * w.z + v[j].w * w.w); }
            part[e] = s; }
        {
#pragma unroll
            for (int e = 0; e < 8; ++e) { const bool up = (F.lane & 32) != 0; const float keep = up ? part[e + 8] : part[e], send = up ? part[e] : part[e + 8]; part[e] = keep + __shfl_xor(send, 32); }
#pragma unroll
            for (int e = 0; e < 4; ++e) { const bool up = (F.lane & 16) != 0; const float keep = up ? part[e + 4] : part[e], send = up ? part[e] : part[e + 4]; part[e] = keep + __shfl_xor(send, 16); }
#pragma unroll
            for (int e = 0; e < 2; ++e) { const bool up = (F.lane & 8) != 0; const float keep = up ? part[e + 2] : part[e], send = up ? part[e] : part[e + 2]; part[e] = keep + __shfl_xor(send, 8); }
            { const bool up = (F.lane & 4) != 0; const float keep = up ? part[1] : part[0], send = up ? part[0] : part[1]; part[0] = keep + __shfl_xor(send, 4); }
            part[0] += __shfl_xor(part[0], 2); part[0] += __shfl_xor(part[0], 1);
        }
        float aff[16], sel[16];
#pragma unroll
        for (int e = 0; e < 16; ++e) { const int src = ((e >> 3) & 1) * 32 + ((e >> 2) & 1) * 16 + ((e >> 1) & 1) * 8 + (e & 1) * 4; const float lg = __shfl(part[0], src); aff[e] = 1.f / (1.f + __expf(-lg)); sel[e] = aff[e] + rb[e]; }
        int bg = 0; float bgs = -3.0e38f;
#pragma unroll
        for (int g = 0; g < 4; ++g) { float m1 = -3.0e38f, m2 = -3.0e38f;
#pragma unroll
            for (int k = 0; k < 4; ++k) { const float s = sel[4 * g + k]; if (s > m1) { m2 = m1; m1 = s; } else if (s > m2) m2 = s; }
            const float gs = m1 + m2; if (gs > bgs) { bgs = gs; bg = g; } }
        int i1 = 0, i2 = 0; float s1 = -3.0e38f, s2 = -3.0e38f, a1 = 0.f, a2 = 0.f;
#pragma unroll
        for (int g = 0; g < 4; ++g) if (g == bg) {
#pragma unroll
            for (int k = 0; k < 4; ++k) { const float s = sel[4 * g + k], a = aff[4 * g + k];
                if (s > s1) { s2 = s1; i2 = i1; a2 = a1; s1 = s; i1 = 4 * g + k; a1 = a; } else if (s > s2) { s2 = s; i2 = 4 * g + k; a2 = a; } } }
        const float wsum = a1 + a2, w1 = a1 / wsum, w2 = a2 / wsum;
        if (F.lane == 0) { const unsigned l1 = atomicAdd(&lcnt[i1], 1u), l2 = atomicAdd(&lcnt[i2], 1u);
            rec[lr * 6 + 0] = i1; rec[lr * 6 + 1] = i2; rec[lr * 6 + 2] = (int)l1; rec[lr * 6 + 3] = (int)l2; rec[lr * 6 + 4] = __float_as_int(w1); rec[lr * 6 + 5] = __float_as_int(w2); }
#pragma unroll
        for (int j = 0; j < 4; ++j) { v[j] = vn[j]; y[j] = yn[j]; }
    }
#undef LNR_LOAD
    __syncthreads();
    if (F.tid < 16) lbase[F.tid] = __hip_atomic_fetch_add(&CNT[F.tid], lcnt[F.tid], __ATOMIC_RELAXED, __HIP_MEMORY_SCOPE_AGENT);
    __syncthreads();
    for (int lr = F.tid; lr < row_hi - row_lo; lr += NTHR) { const int tok = row_lo + lr;
        const int e0 = rec[lr * 6], e1 = rec[lr * 6 + 1]; const int p0 = (int)lbase[e0] + rec[lr * 6 + 2], p1 = (int)lbase[e1] + rec[lr * 6 + 3];
        LIST[e0 * NTOK + p0] = tok; LIST[e1 * NTOK + p1] = tok;
        int* tr = TOKR + (size_t)tok * 8; tr[0] = e0; tr[1] = p0; tr[2] = e1; tr[3] = p1; tr[4] = rec[lr * 6 + 4]; tr[5] = rec[lr * 6 + 5]; }
    __syncthreads();
}

__device__ __forceinline__ void pad_bases(const unsigned* cnt, int (&pb)[17]) {
    int acc = 0;
#pragma unroll
    for (int e = 0; e < 16; ++e) { pb[e] = acc; const int c = (int)__hip_atomic_load(cnt + e, __ATOMIC_RELAXED, __HIP_MEMORY_SCOPE_AGENT); acc += (c + 255) & ~255; }
    pb[16] = acc;
}

__device__ __forceinline__ void phase_moe_combine(const Frame& F, const Prm& p, int layer) {
    const int nrows = layer ? NLAT : NTOK;
    const float* MOD = (const float*)(p.ws + WS_MOD) + layer * 9 * 6144; const float* MOD1 = (const float*)(p.ws + WS_MOD) + 9 * 6144;
    const unsigned char* YM = p.ws + WS_YM;   unsigned char* H = p.ws + WS_H;   bf16* XB = (bf16*)(p.ws + WS_XB); const int* TOKR = (const int*)(p.ws + WS_TOKR);
    int pb[17]; pad_bases(F.ctl + CW_CNT + layer * 16, pb);
    int* pbl = (int*)F.lds; if (F.tid < 17) { int v = 0;
#pragma unroll
        for (int e = 0; e < 17; ++e) if (e == F.tid) v = pb[e];
        pbl[F.tid] = v; }
    __syncthreads();
    const float* lng = p.ln_g + (layer * 2 + 1) * DM; const float* lnb = p.ln_b + (layer * 2 + 1) * DM;
    const int gw = F.bid * NWAVES + F.wave, NGW = F.G * NWAVES, per = (nrows + NGW - 1) / NGW;
    int curmod = -1; f32x4 gf[4], sh1[4], sc1[4];
    typedef int i32x4r __attribute__((ext_vector_type(4)));
    const int t0 = gw * per, t1 = min(nrows, (gw + 1) * per);
    i32x4r ra = {0, 0, 0, 0}, rb = {0, 0, 0, 0}, rc = {0, 0, 0, 0}; f32x2 wa = {0.f, 0.f}, wb = {0.f, 0.f}, wc = {0.f, 0.f};
#define MC_REC(tok_, R, W) do { const int* tr_ = TOKR + (size_t)(tok_) * 8; R = *(const i32x4r*)tr_; W = *(const f32x2*)(tr_ + 4); } while (0)
#define MC_ROWS(tok_, R, V, A, B) do { ld_row_bf16(XB + (size_t)(tok_) * DM, F.lane, V); ld_row_fp8(YM + (size_t)(pbl[R.x] + R.y) * DM, F.lane, A); ld_row_fp8(YM + (size_t)(pbl[R.z] + R.w) * DM, F.lane, B); } while (0)
    f32x4 v[4], a[4], b[4], vn[4], an[4], bn[4];
    if (t0 < t1) { MC_REC(t0, ra, wa); if (t0 + 1 < t1) MC_REC(t0 + 1, rb, wb); MC_ROWS(t0, ra, v, a, b); }
    for (int tok = t0; tok < t1; ++tok) {
        if (tok + 1 < t1) MC_ROWS(tok + 1, rb, vn, an, bn);
        if (tok + 2 < t1) MC_REC(tok + 2, rc, wc);
        const int mr = tok < NLAT ? tok / SEQ : 8;
        if (mr != curmod) { curmod = mr; ld_row_f32(MOD + mr * 6144 + 5120, F.lane, gf); if (!layer) { ld_row_f32(MOD1 + mr * 6144, F.lane, sh1); ld_row_f32(MOD1 + mr * 6144 + 1024, F.lane, sc1); } }
        const float w0 = wa.x, w1 = wa.y;
        bf16* xp = XB + (size_t)tok * DM;
#pragma unroll
        for (int j = 0; j < 4; ++j) v[j] = ALPHA * v[j] + gf[j] * (w0 * a[j] + w1 * b[j]);
        ln_row(v, lng, lnb, F.lane);
        if (layer) st_row_f32(p.out + (size_t)tok * DM, F.lane, v); else st_row_bf16(xp, F.lane, v);
        if (!layer) {
#pragma unroll
            for (int j = 0; j < 4; ++j) v[j] = v[j] * (1.f + sc1[j]) + sh1[j];
            st_row_fp8(H + (size_t)tok * DM, F.lane, v);
        }
#pragma unroll
        for (int j = 0; j < 4; ++j) { v[j] = vn[j]; a[j] = an[j]; b[j] = bn[j]; }
        ra = rb; wa = wb; rb = rc; wb = wc;
    }
#undef MC_REC
#undef MC_ROWS
}

__device__ __forceinline__ void phase_gla_prep(const Frame& F, const Prm& p) {
    typedef short bf16x8v __attribute__((ext_vector_type(8))); typedef float f32x16v __attribute__((ext_vector_type(16)));
    const bf16* QR = (const bf16*)(p.ws + WS_QR); const bf16* KR = (const bf16*)(p.ws + WS_KR); const float* ZZ = (const float*)(p.ws + WS_ZZ);
    bf16* QT = (bf16*)(p.ws + WS_QT); bf16* KT = (bf16*)(p.ws + WS_KT); float* DEC = (float*)(p.ws + WS_DEC);
    const int gw = F.bid * NWAVES + F.wave, NGW = F.G * NWAVES, r = F.lane & 31, hh = F.lane >> 5;
    for (int task = gw; task < 2 * NCHUNK * 8; task += NGW) {
        const int dh = task & 7, chunk = (task >> 3) % NCHUNK, dir = __builtin_amdgcn_readfirstlane(task / (8 * NCHUNK));
        const int tok0 = chunk * 64;
        bf16x8v af[2], bfr[2];
#pragma unroll
        for (int tb = 0; tb < 2; ++tb) { const float* zp = ZZ + (size_t)(tok0 + 32 * tb + r) * 32 + dir * 16 + 8 * hh; const f32x4 z0 = *(const f32x4*)zp, z1 = *(const f32x4*)(zp + 4);
            u32x4 w; w.x = pk2(z0.x, z0.y); w.y = pk2(z0.z, z0.w); w.z = pk2(z1.x, z1.y); w.w = pk2(z1.z, z1.w); af[tb] = __builtin_bit_cast(bf16x8v, w); }
        float bgv[2];
#pragma unroll
        for (int cb = 0; cb < 2; ++cb) { const float* wp = p.gwg_up + (size_t)dir * 16 * 512 + (size_t)(8 * hh) * 512 + dh * 64 + 2 * r + cb; float wv[8];
#pragma unroll
            for (int i = 0; i < 8; ++i) wv[i] = wp[(size_t)i * 512];
            u32x4 w; w.x = pk2(wv[0], wv[1]); w.y = pk2(wv[2], wv[3]); w.z = pk2(wv[4], wv[5]); w.w = pk2(wv[6], wv[7]); bfr[cb] = __builtin_bit_cast(bf16x8v, w);
            bgv[cb] = p.gbg[dir * 512 + dh * 64 + 2 * r + cb]; }
        f32x16v Z[2][2];
#pragma unroll
        for (int tb = 0; tb < 2; ++tb)
#pragma unroll
            for (int cb = 0; cb < 2; ++cb) { const f32x16v zero = {}; Z[tb][cb] = __builtin_amdgcn_mfma_f32_32x32x16_bf16(af[tb], bfr[cb], zero, 0, 0, 0); }
#pragma unroll
        for (int tb = 0; tb < 2; ++tb)
#pragma unroll
            for (int cb = 0; cb < 2; ++cb)
#pragma unroll
                for (int i = 0; i < 16; ++i) { const float z = Z[tb][cb][i] + bgv[cb]; Z[tb][cb][i] = (fminf(z, 0.f) - __logf(1.f + __expf(-fabsf(z)))) * (1.f / 16.f); }
        float tot[2];
#pragma unroll
        for (int cb = 0; cb < 2; ++cb) {
            float T[2][4], PT[2][4];
            if (!dir) {
#pragma unroll
                for (int tb = 0; tb < 2; ++tb)
#pragma unroll
                    for (int gi = 0; gi < 4; ++gi) { float run = 0.f;
#pragma unroll
                        for (int w = 0; w < 4; ++w) { run += Z[tb][cb][4 * gi + w]; Z[tb][cb][4 * gi + w] = run; }
                        T[tb][gi] = run; }
            } else {
#pragma unroll
                for (int tb = 0; tb < 2; ++tb)
#pragma unroll
                    for (int gi = 0; gi < 4; ++gi) { float run = 0.f;
#pragma unroll
                        for (int w = 3; w >= 0; --w) { run += Z[tb][cb][4 * gi + w]; Z[tb][cb][4 * gi + w] = run; }
                        T[tb][gi] = run; }
            }
#pragma unroll
            for (int tb = 0; tb < 2; ++tb)
#pragma unroll
                for (int gi = 0; gi < 4; ++gi) PT[tb][gi] = __shfl_xor(T[tb][gi], 32);
            float running = 0.f;
            if (!dir) {
#pragma unroll
                for (int tb = 0; tb < 2; ++tb)
#pragma unroll
                    for (int gi = 0; gi < 4; ++gi) { const float first = hh ? PT[tb][gi] : T[tb][gi], second = hh ? T[tb][gi] : PT[tb][gi];
                        const float mine = hh ? running + first : running; running += first + second;
#pragma unroll
                        for (int w = 0; w < 4; ++w) Z[tb][cb][4 * gi + w] += mine; }
            } else {
#pragma unroll
                for (int tb = 1; tb >= 0; --tb)
#pragma unroll
                    for (int gi = 3; gi >= 0; --gi) { const float first = hh ? T[tb][gi] : PT[tb][gi], second = hh ? PT[tb][gi] : T[tb][gi];
                        const float mine = hh ? running : running + first; running += first + second;
#pragma unroll
                        for (int w = 0; w < 4; ++w) Z[tb][cb][4 * gi + w] += mine; }
            }
            tot[cb] = running;
        }
        if (hh == 0) {
#pragma unroll
            for (int cb = 0; cb < 2; ++cb) DEC[((size_t)dir * NCHUNK + chunk) * 512 + dh * 64 + 2 * r + cb] = __expf(tot[cb]);
        }
        const bf16* qi = QR + ((size_t)dh * NTOK + tok0) * 64 + 2 * r; const bf16* ki = KR + ((size_t)dh * NTOK + tok0) * 64 + 2 * r;
        bf16* qo = QT + (((size_t)dir * 8 + dh) * NTOK + tok0) * 64 + 2 * r; bf16* ko = KT + (((size_t)dir * 8 + dh) * NTOK + tok0) * 64 + 2 * r;
#pragma unroll
        for (int tb = 0; tb < 2; ++tb) {
            unsigned qv[16], kv[16];
#pragma unroll
            for (int i = 0; i < 16; ++i) { const int t = 32 * tb + (i & 3) + 8 * (i >> 2) + 4 * hh; qv[i] = *(const unsigned*)(qi + (size_t)t * 64); kv[i] = *(const unsigned*)(ki + (size_t)t * 64); }
#pragma unroll
            for (int i = 0; i < 16; ++i) { const int t = 32 * tb + (i & 3) + 8 * (i >> 2) + 4 * hh;
                const float e0 = __expf(Z[tb][0][i]), e1 = __expf(Z[tb][1][i]), i0 = __builtin_amdgcn_rcpf(e0), i1 = __builtin_amdgcn_rcpf(e1);
                *(unsigned*)(qo + (size_t)t * 64) = pk2(bf2f(qv[i] & 0xffffu) * e0, bf2f(qv[i] >> 16) * e1);
                *(unsigned*)(ko + (size_t)t * 64) = pk2(bf2f(kv[i] & 0xffffu) * i0, bf2f(kv[i] >> 16) * i1); }
        }
    }
}

__device__ __forceinline__ void phase_gla_post(const Frame& F, const Prm& p) {
    const bf16* OF = (const bf16*)p.out; const bf16* OB = (const bf16*)((const unsigned char*)p.out + OUT_OGB); const bf16* R = (const bf16*)(p.ws + WS_R); unsigned char* A2 = p.ws + WS_A2B;
    const f32x4 ng = *(const f32x4*)(p.gnorm + 4 * F.lane);
    const int gw = F.bid * NWAVES + F.wave, NGW = F.G * NWAVES;
    f32x4 a[4], b[4], r[4], an[4], bn[4], rn[4];
    if (gw < NLAT) { ld_row_bf16(OF + (size_t)gw * DM, F.lane, a); ld_row_bf16(OB + (size_t)gw * DM, F.lane, b); ld_row_bf16(R + (size_t)gw * DM, F.lane, r); }
    for (int tok = gw; tok < NLAT; tok += NGW) {
        if (tok + NGW < NLAT) { ld_row_bf16(OF + (size_t)(tok + NGW) * DM, F.lane, an); ld_row_bf16(OB + (size_t)(tok + NGW) * DM, F.lane, bn); ld_row_bf16(R + (size_t)(tok + NGW) * DM, F.lane, rn); }
#pragma unroll
        for (int j = 0; j < 4; ++j) {
            const f32x4 o = a[j] + b[j]; const float q = wave_sum((o.x * o.x + o.y * o.y) + (o.z * o.z + o.w * o.w));
            const float rs = 1.f / sqrtf(q * (1.f / 256.f) + LN_EPS);
            a[j] = (f32x4){o.x * rs * ng.x * silu_f(r[j].x), o.y * rs * ng.y * silu_f(r[j].y), o.z * rs * ng.z * silu_f(r[j].z), o.w * rs * ng.w * silu_f(r[j].w)};
        }
        st_row_fp8(A2 + (size_t)tok * DM, F.lane, a);
#pragma unroll
        for (int j = 0; j < 4; ++j) { a[j] = an[j]; b[j] = bn[j]; r[j] = rn[j]; }
    }
}
namespace pg8 {
typedef short bf16x8 __attribute__((ext_vector_type(8)));
constexpr int BM = 256, BK = 64, HALF = 128, HTB = HALF * BK * 2, STAGE_BYTES = 8 * HTB, NXCD = 8, WGM = 8;
__host__ __device__ __forceinline__ int lds_byte(int r, int c) { const int st = (r >> 4) * 2 + (c >> 5), rr = r & 15, cc = c & 31, ob = rr * 64 + cc * 2; return st * 1024 + (ob ^ (((ob >> 9) & 1) << 5)); }
__host__ __device__ __forceinline__ void stage_rc(int b, int& R, int& C) { const int st = b / 1024, sb = b % 1024, swz = sb ^ (((sb >> 9) & 1) << 5); R = (st >> 1) * 16 + swz / 64; C = (st & 1) * 32 + (swz % 64) / 2; }
typedef float f32x2_t __attribute__((ext_vector_type(2))); typedef __bf16 bf16x2_t __attribute__((ext_vector_type(2)));
__device__ __forceinline__ unsigned cvt_pk_bf16(float lo, float hi) { f32x2_t v = {lo, hi}; bf16x2_t b = __builtin_convertvector(v, bf16x2_t); return __builtin_bit_cast(unsigned, b); }

struct Unit { int pm, pn; int row0; int e; int cnt; const bf16* Bt; };

struct DenseOrder {
    int nM, nN, nwg, G, c, K; const bf16* Bt;
    __device__ void init(int M, int N, int K_, const bf16* Bt_, int G_, int c_) { nM = M / BM; nN = N / BM; nwg = nM * nN; G = G_; c = c_; K = K_; Bt = Bt_; }
    __device__ bool next(int i, Unit& u) const {
        const long L = (long)i * G + c; if (L >= nwg) return false;
        int wgid = (int)L; { const int q = nwg / NXCD, r = nwg % NXCD, xcd = wgid % NXCD, off = wgid / NXCD; wgid = (xcd < r ? xcd * (q + 1) : r * (q + 1) + (xcd - r) * q) + off; }
        const int nig = WGM * nN, gid = wgid / nig, fm = gid * WGM, gsz = (nM - fm) < WGM ? (nM - fm) : WGM;
        u.pm = fm + ((wgid % nig) % gsz); u.pn = (wgid % nig) / gsz; u.row0 = u.pm * BM; u.e = 0; u.cnt = 0; u.Bt = Bt; return true;
    }
    __device__ __forceinline__ unsigned arow(const Unit& u, int r) const { return (unsigned)(u.row0 + r) * (unsigned)(K * 2); }
};
template <bool GATHER> struct MoeOrder {
    int cnt[16]; int nN, G, c, K; const bf16* Bt0; size_t bstride; const int* LIST;
    __device__ void init(const unsigned* cntw, int N, int K_, const bf16* Bt0_, const int* LIST_, int G_, int c_) {
#pragma unroll
        for (int e = 0; e < 16; ++e) cnt[e] = (int)__hip_atomic_load(cntw + e, __ATOMIC_RELAXED, __HIP_MEMORY_SCOPE_AGENT);
        nN = N / BM; G = G_; c = c_; K = K_; Bt0 = Bt0_; bstride = (size_t)N * K_; LIST = LIST_; }
    __device__ bool next(int i, Unit& u) const {
        int L = i * G + c, base = 0; bool found = false; u.pm = 0; u.pn = 0; u.row0 = 0; u.e = 0; u.cnt = 0; u.Bt = Bt0;
#pragma unroll
        for (int e = 0; e < 16; ++e) { const int mt = (cnt[e] + 255) >> 8, nu = mt * nN;
            if (!found) { if (L < nu) { found = true; u.e = e; u.cnt = cnt[e]; u.pm = L / nN; u.pn = L % nN; u.row0 = base + u.pm * BM; u.Bt = Bt0 + (size_t)e * bstride; } else { L -= nu; base += mt * BM; } } }
        return found;
    }
    __device__ __forceinline__ unsigned arow(const Unit& u, int r) const {
        if (GATHER) { const int li = u.pm * BM + r; int tok = 0; if (li < u.cnt) tok = LIST[u.e * NTOK + li];
            return (unsigned)tok * (unsigned)(K * 2); }
        return (unsigned)(u.row0 + r) * (unsigned)(K * 2);
    }
};

typedef f32x4 Acc[2][2][4][2];
__device__ __forceinline__ void st4bf(bf16* p, f32x4 v) { u32x2 w; w.x = cvt_pk_bf16(v.x, v.y); w.y = cvt_pk_bf16(v.z, v.w); *(u32x2*)p = w; }
__device__ __forceinline__ void st8bf(bf16* p, f32x4 a, f32x4 b) { u32x4 w; w.x = cvt_pk_bf16(a.x, a.y); w.y = cvt_pk_bf16(a.z, a.w); w.z = cvt_pk_bf16(b.x, b.y); w.w = cvt_pk_bf16(b.z, b.w); *(u32x4*)p = w; }

struct EpiQKV {
    bf16 *Q; const LAS float* rope; float wsc; unsigned* km;
    __device__ __forceinline__ void operator()(const Acc& acc, const Unit& u, int wr, int wc, int fr, int fq) const {
        const int reg = u.pn >> 2; bf16* O = Q + (size_t)reg * ((WS_K - WS_Q) / 2);
        if (reg == 2) { const int cbase = (u.pn & 3) * BM + wc * 32 + 8 * fq;
#pragma unroll
            for (int ai = 0; ai < 2; ++ai)
#pragma unroll
                for (int m = 0; m < 4; ++m) { unsigned char* rowp = (unsigned char*)Q + (size_t)2 * (WS_K - WS_Q) + (size_t)(u.row0 + ai * HALF + wr * 64 + m * 16 + fr) * DM + cbase;
#pragma unroll
                    for (int bj = 0; bj < 2; ++bj) { const f32x4 a = acc[ai][bj][m][0] * wsc, b = acc[ai][bj][m][1] * wsc; u32x2 w; w.x = pk4_fp8(a.x, a.y, a.z, a.w); w.y = pk4_fp8(b.x, b.y, b.z, b.w); *(u32x2*)(rowp + bj * HALF) = w; } }
            return; }
        const int cbase = (u.pn & 3) * BM + wc * 32 + 8 * fq;
        const bool dorope = (u.row0 < NLAT); const float sc = (reg == 0 ? C2 : 1.f) * wsc; float kn[2] = {0.f, 0.f};
#pragma unroll
        for (int ai = 0; ai < 2; ++ai)
#pragma unroll
            for (int m = 0; m < 4; ++m) { const int row = u.row0 + ai * HALF + wr * 64 + m * 16 + fr; unsigned char* rowp = (unsigned char*)Q + (size_t)reg * (WS_K - WS_Q) + (size_t)row * DM + cbase;
                f32x4 cs = {1.f, 1.f, 1.f, 1.f}, sn = {0.f, 0.f, 0.f, 0.f};
                if (dorope) { const int s = row & (SEQ - 1), pos = (wc & 1) ? (s & 63) : (s >> 6); const f32x4 t0 = *(const LAS f32x4*)(rope + (pos * 16 + 4 * fq) * 2), t1 = *(const LAS f32x4*)(rope + (pos * 16 + 4 * fq) * 2 + 4);
                    cs = (f32x4){t0.x, t0.z, t1.x, t1.z}; sn = (f32x4){t0.y, t0.w, t1.y, t1.w}; }
                { f32x4 c2 = cs, s2 = sn;
#pragma unroll
                  for (int j = 0; j < 4; ++j) { float x0 = c2[j] * sc, x1 = s2[j] * sc; asm("" : "+v"(x0)); asm("" : "+v"(x1)); cs[j] = x0; sn[j] = x1; } }
#pragma unroll
                for (int bj = 0; bj < 2; ++bj) { const f32x4 a0 = acc[ai][bj][m][0], a1 = acc[ai][bj][m][1];
                    f32x4 o0, o1;
#pragma unroll
                    for (int j = 0; j < 4; ++j) { float x0 = __builtin_fmaf(-a1[j], sn[j], a0[j] * cs[j]), x1 = __builtin_fmaf(a0[j], sn[j], a1[j] * cs[j]); asm("" : "+v"(x0)); asm("" : "+v"(x1)); o0[j] = x0; o1[j] = x1; }
                    { u32x2 w; w.x = pk4_fp8(o0[0], o0[1], o0[2], o0[3]); w.y = pk4_fp8(o1[0], o1[1], o1[2], o1[3]); *(u32x2*)(rowp + bj * HALF) = w; }
                    if (reg == 1) { const float ps = (o0.x * o0.x + o0.y * o0.y) + (o0.z * o0.z + o0.w * o0.w) + (o1.x * o1.x + o1.y * o1.y) + (o1.z * o1.z + o1.w * o1.w);
                        kn[bj] = fmaxf(kn[bj], ps); } } }
        if (reg == 1) {
            const int b = u.row0 < NLAT ? u.row0 / SEQ : (u.row0 - NLAT) / CTXL;
#pragma unroll
            for (int bj = 0; bj < 2; ++bj) { float v = kn[bj];
#pragma unroll
                for (int s = 1; s < 64; s <<= 1) v = fmaxf(v, __shfl_xor(v, s));
                if (fr == 0 && fq == 0) __hip_atomic_fetch_max(km + b * 16 + 4 * (u.pn & 3) + 2 * bj + (wc >> 1), __float_as_uint(9.2f * v), __ATOMIC_RELAXED, __HIP_MEMORY_SCOPE_AGENT); } }
    }
};
struct EpiPlain {
    bf16* O; float sc;
    __device__ __forceinline__ void operator()(const Acc& acc, const Unit& u, int wr, int wc, int fr, int fq) const {
        const int cbase = u.pn * BM + wc * 32 + 8 * fq;
#pragma unroll
        for (int ai = 0; ai < 2; ++ai)
#pragma unroll
            for (int m = 0; m < 4; ++m) { bf16* rowp = O + (size_t)(u.row0 + ai * HALF + wr * 64 + m * 16 + fr) * DM + cbase;
#pragma unroll
                for (int bj = 0; bj < 2; ++bj) st8bf(rowp + bj * HALF, acc[ai][bj][m][0] * sc, acc[ai][bj][m][1] * sc); }
    }
};
struct EpiPlain8 {
    unsigned char* O; float sc;
    __device__ __forceinline__ void operator()(const Acc& acc, const Unit& u, int wr, int wc, int fr, int fq) const {
        const int cbase = u.pn * BM + wc * 32 + 8 * fq;
#pragma unroll
        for (int ai = 0; ai < 2; ++ai)
#pragma unroll
            for (int m = 0; m < 4; ++m) { unsigned char* rowp = O + (size_t)(u.row0 + ai * HALF + wr * 64 + m * 16 + fr) * DM + cbase;
#pragma unroll
                for (int bj = 0; bj < 2; ++bj) { const f32x4 a = acc[ai][bj][m][0] * sc, b = acc[ai][bj][m][1] * sc; u32x2 w; w.x = pk4_fp8(a.x, a.y, a.z, a.w); w.y = pk4_fp8(b.x, b.y, b.z, b.w); *(u32x2*)(rowp + bj * HALF) = w; } }
    }
};
struct EpiInproj {
    bf16 *QR, *KR, *V, *R; float* ZZ; float wsc;
    __device__ __forceinline__ void operator()(const Acc& acc, const Unit& u, int wr, int wc, int fr, int fq) const {
        const int pn = u.pn;
        if (pn == 12) { if (wc == 0) {
#pragma unroll
            for (int ai = 0; ai < 2; ++ai)
#pragma unroll
                for (int m = 0; m < 4; ++m) { float* rowp = ZZ + (size_t)(u.row0 + ai * HALF + wr * 64 + m * 16 + fr) * 32 + 4 * fq;
                    *(f32x4*)rowp = acc[ai][0][m][0] * wsc; *(f32x4*)(rowp + 16) = acc[ai][0][m][1] * wsc; } }
            return; }
        float sc = wsc;
        if (pn < 4) {
            bf16* O = pn < 2 ? QR : KR; if (pn < 2) sc = 0.08838834764831845f * wsc;
            const int cb = (pn & 1) * BM + wc * 32 + 8 * fq;
#pragma unroll
            for (int ai = 0; ai < 2; ++ai)
#pragma unroll
                for (int m = 0; m < 4; ++m) { const size_t row = (size_t)(u.row0 + ai * HALF + wr * 64 + m * 16 + fr);
#pragma unroll
                    for (int bj = 0; bj < 2; ++bj) { const int col = cb + bj * HALF; st8bf(O + ((size_t)(col >> 6) * NTOK + row) * 64 + (col & 63), acc[ai][bj][m][0] * sc, acc[ai][bj][m][1] * sc); } }
            return; }
        bf16* O; int c0;
        if (pn < 8) { O = V; c0 = (pn - 4) * BM; } else { O = R; c0 = (pn - 8) * BM; }
        const int cbase = c0 + wc * 32 + 8 * fq;
#pragma unroll
        for (int ai = 0; ai < 2; ++ai)
#pragma unroll
            for (int m = 0; m < 4; ++m) { bf16* rowp = O + (size_t)(u.row0 + ai * HALF + wr * 64 + m * 16 + fr) * DM + cbase;
#pragma unroll
                for (int bj = 0; bj < 2; ++bj) st8bf(rowp + bj * HALF, acc[ai][bj][m][0] * sc, acc[ai][bj][m][1] * sc); }
    }
};
struct EpiGateUp {
    unsigned char* ACT;
    __device__ __forceinline__ void operator()(const Acc& acc, const Unit& u, int wr, int wc, int fr, int fq) const {
        const int obase = u.pn * (BM / 2) + wc * 32 + 8 * fq;
#pragma unroll
        for (int ai = 0; ai < 2; ++ai)
#pragma unroll
            for (int m = 0; m < 4; ++m) { unsigned char* rowp = ACT + (size_t)(u.row0 + ai * HALF + wr * 64 + m * 16 + fr) * DEXP + obase; u32x2 w;
#pragma unroll
                for (int bj = 0; bj < 2; ++bj) { const f32x4 g = acc[ai][bj][m][0], up = acc[ai][bj][m][1]; f32x4 o;
#pragma unroll
                    for (int j = 0; j < 4; ++j) o[j] = g[j] * __builtin_amdgcn_rcpf(1.f + __expf(-g[j])) * up[j];
                    w[bj] = pk4_fp8(o[0], o[1], o[2], o[3]); }
                *(u32x2*)rowp = w; }
    }
};

typedef int i32x8 __attribute__((ext_vector_type(8)));
typedef int i32x4 __attribute__((ext_vector_type(4)));
__device__ __forceinline__ i32x8 cat8(bf16x8 lo, bf16x8 hi) { return __builtin_shufflevector(__builtin_bit_cast(i32x4, lo), __builtin_bit_cast(i32x4, hi), 0, 1, 2, 3, 4, 5, 6, 7); }
template <class Epi, class Sched, bool FP8 = false>
__device__ __forceinline__ void gemm_phase(unsigned char* ldsg, const bf16* A, int K, const Sched& S, const Epi& E, int tid_in) {
    LAS unsigned char* lds = (LAS unsigned char*)ldsg;
    const int tid = tid_in, wid = __builtin_amdgcn_readfirstlane(tid >> 6), lane = tid & 63, wr = wid >> 2, wc = wid & 3, fr = lane & 15, fq = lane >> 4;
    const int nt = K / BK;
    int Rr[2]; unsigned colb[2], voffB[2];
#pragma unroll
    for (int i = 0; i < 2; ++i) { int R, C; stage_rc(tid * 16 + i * 8192, R, C); Rr[i] = R; colb[i] = (unsigned)C * 2u; voffB[i] = (unsigned)(R * K + C) * 2u; }
    const size_t kstep = (size_t)(BK * 2);
    const size_t hstep = (size_t)HALF * K * 2;
    const size_t tstep = 2 * hstep;
    const unsigned ldsw = (unsigned)wid * 1024u;
    const int aoff = lds_byte(wr * 64 + fr, fq * 8), boff = lds_byte(wc * 32 + fr, fq * 8);
#define PG8_SA(b, h) (((b) * 2 + (h)) * HTB)
#define PG8_SB(b, h) ((4 + (b) * 2 + (h)) * HTB)
#define PG8_STAGE(bufoff, gbase, voff) do { _Pragma("unroll") for (int _i = 0; _i < 2; ++_i) \
        __builtin_amdgcn_global_load_lds((const unsigned*)((const char*)(gbase) + (voff)[_i]), (LAS unsigned*)(lds + (bufoff) + ldsw + _i * 8192), 16, 0, 0); } while (0)
#define PG8_LDA(dst, b, h) do { if constexpr (FP8) { _Pragma("unroll") for (int m = 0; m < 4; ++m) dst##8[m] = cat8(*(const LAS bf16x8*)(lds + PG8_SA(b, h) + aoff + m * 2048), *(const LAS bf16x8*)(lds + PG8_SA(b, h) + aoff + m * 2048 + 1024)); } \
        else { _Pragma("unroll") for (int m = 0; m < 4; ++m) _Pragma("unroll") for (int k = 0; k < 2; ++k) dst[m][k] = *(const LAS bf16x8*)(lds + PG8_SA(b, h) + aoff + m * 2048 + k * 1024); } } while (0)
#define PG8_LDB(dst, b, h) do { if constexpr (FP8) { _Pragma("unroll") for (int n = 0; n < 2; ++n) dst##8[n] = cat8(*(const LAS bf16x8*)(lds + PG8_SB(b, h) + boff + n * 2048), *(const LAS bf16x8*)(lds + PG8_SB(b, h) + boff + n * 2048 + 1024)); } \
        else { _Pragma("unroll") for (int n = 0; n < 2; ++n) _Pragma("unroll") for (int k = 0; k < 2; ++k) dst[n][k] = *(const LAS bf16x8*)(lds + PG8_SB(b, h) + boff + n * 2048 + k * 1024); } } while (0)
#define PG8_MMA(ai, bj, At, Bt) do { __builtin_amdgcn_s_setprio(1); \
        if constexpr (FP8) { _Pragma("unroll") for (int m = 0; m < 4; ++m) _Pragma("unroll") for (int n = 0; n < 2; ++n) \
            asm volatile("v_mfma_scale_f32_16x16x128_f8f6f4 %0, %1, %2, %0, %3, %3 op_sel:[0,1,0] op_sel_hi:[0,0,0]" : "+v"(acc[ai][bj][m][n]) : "v"(Bt##8[n]), "v"(At##8[m]), "v"(sc8)); } \
        else { _Pragma("unroll") for (int m = 0; m < 4; ++m) _Pragma("unroll") for (int n = 0; n < 2; ++n) _Pragma("unroll") for (int k = 0; k < 2; ++k) \
            acc[ai][bj][m][n] = __builtin_amdgcn_mfma_f32_16x16x32_bf16(Bt[n][k], At[m][k], acc[ai][bj][m][n], 0, 0, 0); } \
        __builtin_amdgcn_s_setprio(0); } while (0)
#define PG8_WAIT_V(n) asm volatile("s_waitcnt vmcnt(" #n ")" ::: "memory")
#define PG8_WAIT_L(n) asm volatile("s_waitcnt lgkmcnt(" #n ")" ::: "memory")
#define PG8_BAR __builtin_amdgcn_s_barrier()
#define PG8_SCHED __builtin_amdgcn_sched_barrier(0)
    Unit cur, nxt; int ui = 0;
    if (!S.next(0, cur)) return;
    Acc acc;
#pragma unroll
    for (int a = 0; a < 2; ++a)
#pragma unroll
        for (int b = 0; b < 2; ++b)
#pragma unroll
            for (int m = 0; m < 4; ++m)
#pragma unroll
                for (int n = 0; n < 2; ++n) acc[a][b][m][n] = (f32x4){0.f, 0.f, 0.f, 0.f};
    const int sc8 = 0x7f7f7f79;
    bf16x8 At[4][2], B0[2][2], B1[2][2]; i32x8 At8[4], B08[2], B18[2];
    unsigned aC0[2], aC1[2], aN0[2], aN1[2];
#pragma unroll
    for (int i = 0; i < 2; ++i) { aC0[i] = S.arow(cur, Rr[i]) + colb[i]; aC1[i] = S.arow(cur, HALF + Rr[i]) + colb[i]; }
    const char* Ab = (const char*)A;
    const char* cB = (const char*)cur.Bt + (size_t)cur.pn * tstep;
    PG8_STAGE(PG8_SB(0, 0), cB, voffB); PG8_STAGE(PG8_SB(0, 1), cB + hstep, voffB); PG8_STAGE(PG8_SA(0, 0), Ab, aC0); PG8_STAGE(PG8_SA(0, 1), Ab, aC1);
    if (wr == 1) PG8_BAR;
    PG8_WAIT_V(2); PG8_BAR;
    PG8_STAGE(PG8_SB(1, 0), cB + kstep, voffB); PG8_STAGE(PG8_SA(1, 0), Ab + kstep, aC0); PG8_STAGE(PG8_SB(1, 1), cB + hstep + kstep, voffB);
    PG8_WAIT_V(6); PG8_BAR;
    for (;;) {
        const bool has_next = S.next(ui + 1, nxt);
        if (has_next) {
#pragma unroll
            for (int i = 0; i < 2; ++i) { aN0[i] = S.arow(nxt, Rr[i]) + colb[i]; aN1[i] = S.arow(nxt, HALF + Rr[i]) + colb[i]; }
        } else {
#pragma unroll
            for (int i = 0; i < 2; ++i) { aN0[i] = aC0[i]; aN1[i] = aC1[i]; }
        }
        const char* nB = has_next ? (const char*)nxt.Bt + (size_t)nxt.pn * tstep : cB;
        for (int t = 0; t < nt; t += 2) {
            const bool last = (t == nt - 2);
            const char* a1 = Ab + (size_t)(t + 1) * kstep;
            const char* a2 = last ? Ab : Ab + (size_t)(t + 2) * kstep; const char* b2 = last ? nB : cB + (size_t)(t + 2) * kstep;
            const char* a3 = a2 + kstep; const char* b3 = b2 + kstep;
            unsigned x0[2], x1[2];
#pragma unroll
            for (int i = 0; i < 2; ++i) { x0[i] = last ? aN0[i] : aC0[i]; x1[i] = last ? aN1[i] : aC1[i]; }
            PG8_LDB(B0, 0, 0); PG8_LDB(B1, 0, 1); PG8_SCHED; PG8_LDA(At, 0, 0); PG8_STAGE(PG8_SA(1, 1), a1, aC1);
            PG8_WAIT_V(8); PG8_WAIT_L(0); PG8_BAR; PG8_MMA(0, 0, At, B0); PG8_MMA(0, 1, At, B1); PG8_BAR; PG8_SCHED;
            PG8_LDA(At, 0, 1); PG8_STAGE(PG8_SB(0, 0), b2, voffB); PG8_STAGE(PG8_SB(0, 1), b2 + hstep, voffB); PG8_STAGE(PG8_SA(0, 0), a2, x0);
            PG8_WAIT_V(8); PG8_WAIT_L(0); PG8_BAR; PG8_MMA(1, 0, At, B0); PG8_MMA(1, 1, At, B1); PG8_BAR; PG8_SCHED;
            PG8_LDB(B0, 1, 0); PG8_LDB(B1, 1, 1); PG8_SCHED; PG8_LDA(At, 1, 0); PG8_STAGE(PG8_SA(0, 1), a2, x1);
            PG8_WAIT_V(8); PG8_WAIT_L(0); PG8_BAR; PG8_MMA(0, 0, At, B0); PG8_MMA(0, 1, At, B1); PG8_BAR; PG8_SCHED;
            PG8_LDA(At, 1, 1); PG8_STAGE(PG8_SB(1, 0), b3, voffB); PG8_STAGE(PG8_SB(1, 1), b3 + hstep, voffB); PG8_STAGE(PG8_SA(1, 0), a3, x0);
            PG8_WAIT_V(8); PG8_WAIT_L(0); PG8_BAR; PG8_MMA(1, 0, At, B0); PG8_MMA(1, 1, At, B1); PG8_BAR; PG8_SCHED;
        }
        if (wr == 0) PG8_BAR;
        if constexpr (FP8) asm volatile("s_nop 15\n\ts_nop 7" ::: "memory");
        E(acc, cur, wr, wc, fr, fq);
        if (!has_next) break;
#pragma unroll
        for (int a = 0; a < 2; ++a)
#pragma unroll
            for (int b = 0; b < 2; ++b)
#pragma unroll
                for (int m = 0; m < 4; ++m)
#pragma unroll
                    for (int n = 0; n < 2; ++n) acc[a][b][m][n] = (f32x4){0.f, 0.f, 0.f, 0.f};
        cur = nxt; cB = nB; ++ui;
#pragma unroll
        for (int i = 0; i < 2; ++i) { aC0[i] = aN0[i]; aC1[i] = aN1[i]; }
        if (wr == 1) PG8_BAR;
    }
    PG8_WAIT_V(0);
    PG8_BAR;
#undef PG8_SA
#undef PG8_SB
#undef PG8_STAGE
#undef PG8_LDA
#undef PG8_LDB
#undef PG8_MMA
#undef PG8_WAIT_V
#undef PG8_WAIT_L
#undef PG8_BAR
#undef PG8_SCHED
}
}

__device__ __forceinline__ int vcu_of(const Frame& F) { return (F.G % 8 == 0) ? (F.bid % 8) * (F.G / 8) + F.bid / 8 : F.bid; }
__device__ __forceinline__ void phase_qkv_opt(const Frame& F, const Prm& p) {
    pg8::DenseOrder S; S.init(NTOK, 3072, 512, (const bf16*)(p.ws + WS_WQKV), F.G, F.bid);
    static_assert(WS_V - WS_K == WS_K - WS_Q, "Q|K|V equally spaced");
    LAS float* ropel = (LAS float*)((LAS unsigned char*)F.lds + LDSX_OFF);
    const float* ropeg = (const float*)(p.ws + WS_MISC) + 1024;
    for (int i = F.tid; i < 2048; i += NTHR) ropel[i] = ropeg[i];
    __syncthreads();
    pg8::EpiQKV E{(bf16*)(p.ws + WS_Q), ropel, 1.f, F.ctl + CW_KM};
    pg8::gemm_phase<pg8::EpiQKV, pg8::DenseOrder, true>(F.lds, (const bf16*)(p.ws + WS_H), 512, S, E, F.tid);
}
__device__ __forceinline__ void phase_wo_opt(const Frame& F, const Prm& p, int layer) {
    if (layer) {
        pg8::DenseOrder S; S.init(NLAT, 1024, 512, (const bf16*)(p.ws + WS_WGO), F.G, F.bid);
        pg8::EpiPlain E{(bf16*)(p.ws + WS_Y), 1.f};
        pg8::gemm_phase<pg8::EpiPlain, pg8::DenseOrder, true>(F.lds, (const bf16*)(p.ws + WS_A2B), 512, S, E, F.tid);
    } else {
        pg8::DenseOrder S; S.init(NTOK, 1024, 512, (const bf16*)(p.ws + WS_WO), F.G, F.bid);
        pg8::EpiPlain E{(bf16*)(p.ws + WS_Y), 1.f};
        pg8::gemm_phase<pg8::EpiPlain, pg8::DenseOrder, true>(F.lds, (const bf16*)(p.ws + WS_A2), 512, S, E, F.tid);
    }
}
__device__ __forceinline__ void phase_inproj_opt(const Frame& F, const Prm& p) {
    pg8::DenseOrder S; S.init(NTOK, NIN, 512, (const bf16*)(p.ws + WS_WIN), F.G, F.bid);
    pg8::EpiInproj E{(bf16*)(p.ws + WS_QR), (bf16*)(p.ws + WS_KR), (bf16*)(p.ws + WS_V1), (bf16*)(p.ws + WS_R), (float*)(p.ws + WS_ZZ), 1.f};
    pg8::gemm_phase<pg8::EpiInproj, pg8::DenseOrder, true>(F.lds, (const bf16*)(p.ws + WS_H), 512, S, E, F.tid);
}
__device__ __forceinline__ void phase_moe1_opt(const Frame& F, const Prm& p, int layer) {
    pg8::MoeOrder<true> S; S.init(F.ctl + CW_CNT + layer * 16, 1024, 512, (const bf16*)(p.ws + (layer ? WS_GU1 : WS_GU0)), (const int*)(p.ws + WS_LIST), F.G, vcu_of(F));
    pg8::EpiGateUp E{p.ws + WS_ACT};
    pg8::gemm_phase<pg8::EpiGateUp, pg8::MoeOrder<true>, true>(F.lds, (const bf16*)(p.ws + WS_H), 512, S, E, F.tid);
}
__device__ __forceinline__ void phase_moe2_opt(const Frame& F, const Prm& p, int layer) {
    pg8::MoeOrder<false> S; S.init(F.ctl + CW_CNT + layer * 16, 1024, 256, (const bf16*)(p.ws + (layer ? WS_DN1 : WS_DN0)), nullptr, F.G, vcu_of(F));
    pg8::EpiPlain8 E{p.ws + WS_YM, 1.f};
    pg8::gemm_phase<pg8::EpiPlain8, pg8::MoeOrder<false>, true>(F.lds, (const bf16*)(p.ws + WS_ACT), 256, S, E, F.tid);
}
namespace attn_body {
using bf16=unsigned short;
using bf16x8=__attribute__((ext_vector_type(8)))short;
using s16x4=__attribute__((ext_vector_type(4)))short;
using f32x16=__attribute__((ext_vector_type(16)))float;
using u32x4=__attribute__((ext_vector_type(4)))unsigned;
constexpr int D=64,DM=1024;
constexpr int NW=8,QBLK=32,QB=QBLK*NW,KVBLK=64;
constexpr int ATTN_PITCH=DM, ATTN_UNIT_ROWS=QB;
__device__ __forceinline__ int crow(int r,int hi){return (r&3)+8*(r>>2)+4*hi;}
#define SBAR() __builtin_amdgcn_sched_barrier(0)

constexpr int NSLOT=3, SLOTB=8192;
constexpr int LDS_K=0, LDS_V=NSLOT*SLOTB, LDS_WS=2*NSLOT*SLOTB, LDS_OST=LDS_WS+NW*64*4, LDS_BYTES=LDS_OST+NW*4096;
constexpr float C2=0.125f*1.4426950408889634f;
__device__ __forceinline__ void glds16(const void*gsrc,unsigned lds_dst){unsigned keep;
  asm volatile("s_mov_b32 %0, m0\n\ts_mov_b32 m0, %2\n\ts_nop 0\n\tglobal_load_lds_dwordx4 %1, off\n\ts_mov_b32 m0, %0":"=&s"(keep):"v"(gsrc),"s"(lds_dst):"memory");}
__device__ __forceinline__ void glds16s(const void*sbase,unsigned voff,unsigned lds_dst){unsigned keep;
  asm volatile("s_mov_b32 %0, m0\n\ts_mov_b32 m0, %3\n\ts_nop 0\n\tglobal_load_lds_dwordx4 %1, %2\n\ts_mov_b32 m0, %0":"=&s"(keep):"v"(voff),"s"(sbase),"s"(lds_dst):"memory");}
__device__ __forceinline__ void glds16s128(const void*sbase,unsigned voff,unsigned lds_dst){unsigned keep;
  asm volatile("s_mov_b32 %0, m0\n\ts_mov_b32 m0, %3\n\ts_nop 0\n\tglobal_load_lds_dwordx4 %1, %2 offset:128\n\ts_mov_b32 m0, %0":"=&s"(keep):"v"(voff),"s"(sbase),"s"(lds_dst):"memory");}
__device__ __forceinline__ float max3f(float a,float b,float c){float r;asm("v_max3_f32 %0, %1, %2, %3":"=v"(r):"v"(a),"v"(b),"v"(c));return r;}
__device__ __forceinline__ float max2f(float a,float b){float r;asm("v_max_f32_e32 %0, %1, %2":"=v"(r):"v"(a),"v"(b));return r;}
__device__ __forceinline__ float fadd_s(float a,float b){float r;asm("v_add_f32_e32 %0, %1, %2":"=v"(r):"v"(a),"v"(b));return r;}
__device__ __forceinline__ float fsub_s(float a,float b){float r;asm("v_sub_f32_e32 %0, %1, %2":"=v"(r):"v"(a),"v"(b));return r;}
typedef float f32x2_t __attribute__((ext_vector_type(2))); typedef __bf16 bf16x2_t __attribute__((ext_vector_type(2)));
__device__ __forceinline__ unsigned cvtpk_s(float lo,float hi){f32x2_t v={lo,hi};bf16x2_t b=__builtin_convertvector(v,bf16x2_t);return __builtin_bit_cast(unsigned,b);}
#define WAIT_BAR(N) asm volatile("s_waitcnt vmcnt(" #N ") lgkmcnt(0)\n\ts_barrier":::"memory")

__device__ __forceinline__ void qkt(f32x16&p0,f32x16&p1,const char*Kslot,const bf16x8*qr,const f32x16&negm,int r32,int hi){
  const char*kb=Kslot+hi*1024+r32*16;
  #pragma unroll
  for(int d0=0;d0<4;++d0){
    const bf16x8 b0=*reinterpret_cast<const bf16x8*>(kb+d0*2048);
    const bf16x8 b1=*reinterpret_cast<const bf16x8*>(kb+d0*2048+512);
    if(d0==0){p0=__builtin_amdgcn_mfma_f32_32x32x16_bf16(b0,qr[0],negm,0,0,0);p1=__builtin_amdgcn_mfma_f32_32x32x16_bf16(b1,qr[0],negm,0,0,0);}
    else{p0=__builtin_amdgcn_mfma_f32_32x32x16_bf16(b0,qr[d0],p0,0,0,0);p1=__builtin_amdgcn_mfma_f32_32x32x16_bf16(b1,qr[d0],p1,0,0,0);}}
}
typedef __attribute__((address_space(3))) const char* lds_cptr;
typedef short v4i16_t __attribute__((ext_vector_type(4)));
__device__ __forceinline__ void kload8(bf16x8*kf,lds_cptr kp){
  kf[0]=*(const __attribute__((address_space(3))) bf16x8*)(kp);      kf[1]=*(const __attribute__((address_space(3))) bf16x8*)(kp+512);
  kf[2]=*(const __attribute__((address_space(3))) bf16x8*)(kp+2048); kf[3]=*(const __attribute__((address_space(3))) bf16x8*)(kp+2560);
  kf[4]=*(const __attribute__((address_space(3))) bf16x8*)(kp+4096); kf[5]=*(const __attribute__((address_space(3))) bf16x8*)(kp+4608);
  kf[6]=*(const __attribute__((address_space(3))) bf16x8*)(kp+6144); kf[7]=*(const __attribute__((address_space(3))) bf16x8*)(kp+6656);
}
__device__ __forceinline__ void kload2(bf16x8*kf,lds_cptr kp,int j){ kf[2*j]=*(const __attribute__((address_space(3))) bf16x8*)(kp+j*2048); kf[2*j+1]=*(const __attribute__((address_space(3))) bf16x8*)(kp+j*2048+512); }
__device__ __forceinline__ s16x4 vtr(lds_cptr p){ return __builtin_bit_cast(s16x4,__builtin_amdgcn_ds_read_tr16_b64_v4i16((__attribute__((address_space(3))) v4i16_t*)p)); }
typedef int i32x8 __attribute__((ext_vector_type(8)));
typedef int i32x4a __attribute__((ext_vector_type(4)));
__device__ __forceinline__ i32x8 cat8i(i32x4a lo,i32x4a hi){return __builtin_shufflevector(lo,hi,0,1,2,3,4,5,6,7);}
__device__ __forceinline__ f32x16 mfq8(i32x8 kf,i32x8 q){f32x16 c;asm volatile("v_mfma_f32_32x32x64_f8f6f4 %0, %1, %2, 0":"=&v"(c):"v"(kf),"v"(q));return c;}
__device__ __forceinline__ void kload4(i32x4a*kq,lds_cptr kp){
  kq[0]=*(const __attribute__((address_space(3))) i32x4a*)(kp);      kq[1]=*(const __attribute__((address_space(3))) i32x4a*)(kp+1024);
  kq[2]=*(const __attribute__((address_space(3))) i32x4a*)(kp+2048); kq[3]=*(const __attribute__((address_space(3))) i32x4a*)(kp+3072);}
__device__ __forceinline__ void glds16s_lo(const void*sbase,unsigned voff,unsigned lds_dst){unsigned keep;
  asm volatile("s_mov_b32 %0, m0\n\ts_mov_b32 m0, %3\n\ts_mov_b32 exec_hi, 0\n\tglobal_load_lds_dwordx4 %1, %2\n\ts_mov_b32 exec_hi, -1\n\ts_mov_b32 m0, %0":"=&s"(keep):"v"(voff),"s"(sbase),"s"(lds_dst):"memory");}
__device__ __forceinline__ float rowmax(const f32x16&p0,const f32x16&p1){
  float a=max3f(p0[0],p0[1],p1[0]),b=max3f(p0[2],p0[3],p1[1]);a=max3f(a,p1[2],p1[3]);
  #pragma unroll
  for(int r=4;r<16;r+=4){a=max3f(a,p0[r],p0[r+1]);b=max3f(b,p0[r+2],p0[r+3]);a=max3f(a,p1[r],p1[r+1]);b=max3f(b,p1[r+2],p1[r+3]);}
  const float m=max2f(a,b);
  auto rr=__builtin_amdgcn_permlane32_swap(__float_as_uint(m),__float_as_uint(m),false,false);
  return max2f(__uint_as_float(rr[0]),__uint_as_float(rr[1]));
}
#undef SBAR
#undef WAIT_BAR
#undef KVROW
}
namespace attn_body {
constexpr int V2SLOT = 16384;
constexpr int L2_K = 0, L2_V = NSLOT * SLOTB, L2_WS = L2_V + NSLOT * V2SLOT, L2_ST = L2_WS + NW * 64 * 4, L2_BYTES = L2_ST + NW * 8192;
#define SBAR() __builtin_amdgcn_sched_barrier(0)
#define WAIT_BAR(N) asm volatile("s_waitcnt vmcnt(" #N ") lgkmcnt(0)\n\ts_barrier":::"memory")
typedef int i32x2a __attribute__((ext_vector_type(2)));
__device__ __forceinline__ i32x2a vtr8(lds_cptr p){ return __builtin_amdgcn_ds_read_tr8_b64_v2i32((__attribute__((address_space(3))) i32x2a*)p); }
template<int THRL,bool OPT> __device__ __forceinline__ int attn_unit2(long qrow0,int qcol,int vcol,long kctx,long klat,int NT,const bf16*Q,const bf16*__restrict__ K,const bf16*__restrict__ V,int m,const float*lamp,const float*subln,unsigned char*A2,int acol,float km,char*shm,int wid_s,unsigned*ovf){
  int lane_u; asm volatile("v_mbcnt_lo_u32_b32 %0, -1, 0\n\tv_mbcnt_hi_u32_b32 %0, -1, %0":"=v"(lane_u));
  const int lane=lane_u,r32=lane&31,hi=lane>>5; const int wid=wid_s;
  const unsigned char*Qw8=(const unsigned char*)Q+(qrow0+wid*QBLK)*1024+qcol;
  const unsigned char*Kh8=(const unsigned char*)K+qcol; const unsigned char*Vh8=(const unsigned char*)V+vcol;
  const unsigned lds0=(unsigned)(uintptr_t)shm;
  float*wsf=(float*)(shm+L2_WS)+wid*64;
  const unsigned wsf_lds=(unsigned)(lds0+L2_WS+wid*256);
  const unsigned koff=(unsigned)((32*(wid>>2)+(lane&31))*1024+32*(wid&1)+16*((wid>>1)&1));
  const int vpos=32*(wid&1)+(lane>>1); const int vkey=16*(vpos>>4)+4*((vpos>>3)&1)+(vpos&3)+8*((vpos>>2)&1);
  const unsigned voff=(unsigned)(vkey*1024+32*(wid>>1)+16*(lane&1));
  const unsigned kdst=lds0+L2_K+wid*512, vdst=lds0+L2_V+wid*1024;
  #define KVROW(t) ((t)<NT-4?klat+(long)(t)*KVBLK:kctx+(long)((t)-(NT-4))*KVBLK)
  const unsigned char*KbL=Kh8+klat*1024,*KbC=Kh8+(kctx-(long)(NT-4)*KVBLK)*1024,*VbL=Vh8+klat*1024,*VbC=Vh8+(kctx-(long)(NT-4)*KVBLK)*1024;
  #define DMA_K(t,slot) glds16s_lo(((t)<NT-4?KbL:KbC)+((long)(t)<<16),koff,(unsigned)(kdst+(slot)))
  #define DMA_V(t,slot) glds16s(((t)<NT-4?VbL:VbC)+((long)(t)<<16),voff,(unsigned)(vdst+2*(slot)))
  i32x4a kq[4];
  const lds_cptr shm3=(lds_cptr)shm; const lds_cptr kp0=shm3+L2_K+hi*512+r32*16;
  const lds_cptr vp0=shm3+L2_V+(8*hi+((lane&15)>>1))*32+16*((lane>>4)&1)+8*(lane&1);
  DMA_K(0,0);DMA_V(0,0);DMA_K(1,SLOTB);
  i32x8 q8; { const i32x4a qa=*reinterpret_cast<const i32x4a*>(Qw8+(long)r32*1024+hi*32),qb=*reinterpret_cast<const i32x4a*>(Qw8+(long)r32*1024+hi*32+16); q8=cat8i(qa,qb); }
  bool FAST; { float qn=0.f;
    #pragma unroll
    for(int i=0;i<8;++i){ const f32x2_t lo=__builtin_amdgcn_cvt_pk_f32_fp8(q8[i],false),h2=__builtin_amdgcn_cvt_pk_f32_fp8(q8[i],true); qn+=(lo[0]*lo[0]+lo[1]*lo[1])+(h2[0]*h2[0]+h2[1]*h2[1]); }
    { auto rq=__builtin_amdgcn_permlane32_swap(__float_as_uint(qn),__float_as_uint(qn),false,false); qn=__uint_as_float(rq[0])+__uint_as_float(rq[1]); } FAST=__all(qn*km<=96.f*96.f)!=0; }
  float scl=1.f;
  float mhat=0.f;f32x16 o[4];o[0]=f32x16{};o[1]=f32x16{};o[2]=f32x16{};o[3]=f32x16{};
  f32x16 lacc=f32x16{};
  const i32x8 ones8={0x38383838,0x38383838,0x38383838,0x38383838,0x38383838,0x38383838,0x38383838,0x38383838};
  bool resc=false;
  #define RESC() do{ if(!OPT&&resc){ asm volatile("s_nop 15\n\ts_nop 3\n\ts_waitcnt lgkmcnt(0)":::"memory"); \
      int l3_=lane; asm volatile("":"+v"(l3_)); const int hi3_=l3_>>5; \
      _Pragma("unroll") for(int r=0;r<16;++r){ const float f_=wsf[crow(r,hi3_)]; o[0][r]*=f_; o[1][r]*=f_; o[2][r]*=f_; o[3][r]*=f_; lacc[r]*=f_; } } }while(0)
  int sl_prev=0,sl_cur=0,sl_next=SLOTB;
  #define ROT() do{sl_prev=sl_cur;sl_cur=sl_next;sl_next=(sl_next==(NSLOT-1)*SLOTB)?0:sl_next+SLOTB;}while(0)
  DMA_K(2,2*SLOTB);
  WAIT_BAR(3);
  #define EX(v) __builtin_amdgcn_exp2f(v)
  #define PK8(old,a,b,hs) __builtin_amdgcn_cvt_pk_fp8_f32((a),(b),(old),(hs))
  i32x8 pwA,pwB;
  { f32x16 p0,p1;
    kload4(kq,kp0); p0=mfq8(cat8i(kq[0],kq[1]),q8); p1=mfq8(cat8i(kq[2],kq[3]),q8); asm volatile("s_nop 15\n\ts_nop 7":"+v"(p0),"+v"(p1));
    const float rm=__builtin_ceilf(rowmax(p0,p1))+(OPT?4.f:0.f); mhat=rm; typedef short v2i16_t __attribute__((ext_vector_type(2)));
    if(OPT||FAST){ scl=EX(rm);
      #pragma unroll
      for(int r=0;r<16;++r){ p0[r]=EX(p0[r]); p1[r]=EX(p1[r]); }
      #pragma unroll
      for(int w=0;w<4;++w){ v2i16_t a={0,0},b={0,0}; a=__builtin_amdgcn_cvt_scalef32_pk_fp8_f32(a,p0[4*w],p0[4*w+1],scl,false); a=__builtin_amdgcn_cvt_scalef32_pk_fp8_f32(a,p0[4*w+2],p0[4*w+3],scl,true);
        b=__builtin_amdgcn_cvt_scalef32_pk_fp8_f32(b,p1[4*w],p1[4*w+1],scl,false); b=__builtin_amdgcn_cvt_scalef32_pk_fp8_f32(b,p1[4*w+2],p1[4*w+3],scl,true); pwA[w]=__builtin_bit_cast(int,a); pwA[4+w]=__builtin_bit_cast(int,b); }
    } else {
      #pragma unroll
      for(int r=0;r<16;++r){ p0[r]=EX(p0[r]-rm); p1[r]=EX(p1[r]-rm); }
      #pragma unroll
      for(int w=0;w<4;++w){ int a=0,b=0; a=PK8(a,p0[4*w],p0[4*w+1],false); a=PK8(a,p0[4*w+2],p0[4*w+3],true); b=PK8(b,p1[4*w],p1[4*w+1],false); b=PK8(b,p1[4*w+2],p1[4*w+3],true); pwA[w]=a; pwA[4+w]=b; } }
    }
  WAIT_BAR(0);
  DMA_K(3,0);DMA_V(1,SLOTB);
  ROT();
  kload4(kq,kp0+sl_cur);
  WAIT_BAR(2);
  i32x2a vA[4],vB[4];
  #define VF8(A) (i32x8){A[0][0],A[0][1],A[1][0],A[1][1],A[2][0],A[2][1],A[3][0],A[3][1]}
  #define PIN(x) asm volatile("":"+v"(x))
  #define MX3(a,b,c) __builtin_fmaxf(__builtin_fmaxf((a),(b)),(c))
  #define VR4(A,d) do{ A[0]=vtr8(vp_+(d)*2048); A[1]=vtr8(vp_+(d)*2048+512); A[2]=vtr8(vp_+(d)*2048+1024); A[3]=vtr8(vp_+(d)*2048+1536); }while(0)
  #define MFO8(d,PW,A) asm volatile("s_nop 1\n\tv_mfma_f32_32x32x64_f8f6f4 %0, %1, %2, %0":"+v"(o[d]):"v"(PW),"v"(VF8(A)))
  #define MFOL(PW) asm volatile("s_nop 1\n\tv_mfma_f32_32x32x64_f8f6f4 %0, %1, %2, %0":"+v"(lacc):"v"(PW),"v"(ones8))
  #define KRD(G,j) do{ if(G){ kq[j]=*(const __attribute__((address_space(3))) i32x4a*)(kp0+sl_next+(j)*1024); } }while(0)
  #define SM8(X,B,PO,W) do{ _Pragma("unroll") for(int j_=0;j_<8;++j_){ X[(B)+j_]=EX(X[(B)+j_]-mhat); } \
      { int a_=0,b_=0; a_=PK8(a_,X[(B)],X[(B)+1],false); a_=PK8(a_,X[(B)+2],X[(B)+3],true); b_=PK8(b_,X[(B)+4],X[(B)+5],false); b_=PK8(b_,X[(B)+6],X[(B)+7],true); PO[W]=a_; PO[(W)+1]=b_; } }while(0)
  #define SM8F(X,B,PO,W) do{ _Pragma("unroll") for(int j_=0;j_<8;++j_){ X[(B)+j_]=EX(X[(B)+j_]); } \
      { typedef short v2i16_t __attribute__((ext_vector_type(2))); v2i16_t a_,b_; asm("":"=v"(a_),"=v"(b_));   \
        a_=__builtin_amdgcn_cvt_scalef32_pk_fp8_f32(a_,X[(B)],X[(B)+1],scl,false); a_=__builtin_amdgcn_cvt_scalef32_pk_fp8_f32(a_,X[(B)+2],X[(B)+3],scl,true); \
        b_=__builtin_amdgcn_cvt_scalef32_pk_fp8_f32(b_,X[(B)+4],X[(B)+5],scl,false); b_=__builtin_amdgcn_cvt_scalef32_pk_fp8_f32(b_,X[(B)+6],X[(B)+7],scl,true); \
        PO[W]=__builtin_bit_cast(int,a_); PO[(W)+1]=__builtin_bit_cast(int,b_); } }while(0)
  #define STEP2(t,PI,PO,GK,GV,GL,SMX,FV) do{ SBAR(); \
    const lds_cptr vp_=vp0+2*sl_prev; f32x16 C0,C1; \
    VR4(vA,0); SBAR(); C0=mfq8(cat8i(kq[0],kq[1]),q8); SBAR(); \
    VR4(vB,1); SBAR(); C1=mfq8(cat8i(kq[2],kq[3]),q8); SBAR(); \
    if(GK){DMA_K((t)+3,sl_cur);} if(GV){DMA_V((t)+1,sl_next);} \
    asm volatile("s_nop 15\n\ts_nop 3":"+v"(C0),"+v"(C1));   \
    if constexpr(!OPT){ float a=MX3(C0[0],C0[1],C1[0]),b=MX3(C0[2],C0[3],C1[1]); a=MX3(a,C1[2],C1[3]); \
      _Pragma("unroll") for(int r=4;r<16;r+=4){a=MX3(a,C0[r],C0[r+1]);b=MX3(b,C0[r+2],C0[r+3]);a=MX3(a,C1[r],C1[r+1]);b=MX3(b,C1[r+2],C1[r+3]);} \
      float rm=__builtin_fmaxf(a,b); { auto rr=__builtin_amdgcn_permlane32_swap(__float_as_uint(rm),__float_as_uint(rm),false,false); rm=__builtin_fmaxf(__uint_as_float(rr[0]),__uint_as_float(rr[1])); } \
      resc=false; \
      if(__builtin_expect(__any(rm-mhat>(float)THRL),0)){ const float dl=__builtin_fmaxf(__builtin_ceilf(rm-mhat)-(THRL?6.f:0.f),0.f); mhat+=dl;   \
        const float f=__builtin_amdgcn_exp2f(-dl); if(FV){ scl=EX(mhat); } { unsigned keep_; asm volatile("s_mov_b32 %0, m0\n\ts_mov_b32 m0, %2\n\ts_nop 0\n\tds_write_addtid_b32 %1\n\ts_mov_b32 m0, %0":"=&s"(keep_):"v"(f),"s"(wsf_lds):"memory"); } resc=true; } } \
    __builtin_amdgcn_s_setprio(1); SBAR(); \
    MFO8(0,PI,vA); SMX(C0,0,PO,0); VR4(vA,2); SBAR(); \
    MFO8(1,PI,vB); SMX(C0,8,PO,2); VR4(vB,3); SBAR(); \
    MFO8(2,PI,vA); SMX(C1,0,PO,4); KRD(GL,0); KRD(GL,1); SBAR(); \
    MFO8(3,PI,vB); SMX(C1,8,PO,6); KRD(GL,2); KRD(GL,3); SBAR(); \
    MFOL(PI); __builtin_amdgcn_s_setprio(0); \
    }while(0)
  #define ENDW(tt) do{ if((tt)+3<NT){WAIT_BAR(2);} else {WAIT_BAR(0);} }while(0)
  #define LOOPS(SMX,FV) do{ int t=1; \
    for(;t+5<NT;t+=2){ \
      STEP2(t,  pwA,pwB,true,true,true,SMX,FV); WAIT_BAR(2); RESC(); ROT(); \
      STEP2(t+1,pwB,pwA,true,true,true,SMX,FV); WAIT_BAR(2); RESC(); ROT(); \
    } \
    for(;t+1<NT;t+=2){ \
      STEP2(t,  pwA,pwB,(t+3<NT),(t+1<NT),(t+1<NT),SMX,FV); ENDW(t);   RESC(); ROT(); \
      STEP2(t+1,pwB,pwA,(t+4<NT),(t+2<NT),(t+2<NT),SMX,FV); ENDW(t+1); RESC(); ROT(); \
    } \
    STEP2(NT-1,pwA,pwB,false,false,false,SMX,FV); RESC(); }while(0)
  if constexpr(OPT){ LOOPS(SM8F,true); } else { if(FAST){ LOOPS(SM8F,true); } else { LOOPS(SM8,false); } }
  #undef LOOPS
  { const lds_cptr vp_=vp0+2*sl_cur;
    VR4(vA,0); VR4(vB,1); MFO8(0,pwB,vA); MFO8(1,pwB,vB); VR4(vA,2); VR4(vB,3); MFO8(2,pwB,vA); MFO8(3,pwB,vB); MFOL(pwB);
    asm volatile("s_nop 15\n\ts_nop 7":"+v"(o[0]),"+v"(o[1]),"+v"(o[2]),"+v"(o[3]),"+v"(lacc)); }
  if constexpr(OPT){ float bad=lacc[0]; _Pragma("unroll") for(int r=1;r<16;++r)bad+=lacc[r];
    if(__any(!(__builtin_fabsf(bad)<3.0e38f))||!FAST){ *ovf=1u; } }
  { int lane_l=lane; asm volatile("":"+v"(lane_l));
  { const int lane=lane_l,r32=lane&31,hi=lane>>5;
  float rli[16];
  #pragma unroll
  for(int r=0;r<16;++r)rli[r]=__builtin_amdgcn_rcpf(lacc[r]);
  unsigned short*stash=(unsigned short*)(shm+L2_ST)+wid*4096;
  if(m==0){
    #pragma unroll
    for(int d0=0;d0<4;++d0){
      #pragma unroll
      for(int r=0;r<16;++r)stash[(d0*16+r)*64+lane]=(unsigned short)f2bf(o[d0][r]*rli[r]);}
    asm volatile("s_waitcnt lgkmcnt(0)":::"memory");
  } else {
    const float lam=__uint_as_float(__hip_atomic_load((const unsigned*)lamp,__ATOMIC_RELAXED,__HIP_MEMORY_SCOPE_AGENT));
    float ss[16];
    #pragma unroll
    for(int r=0;r<16;++r)ss[r]=0.f;
    #pragma unroll
    for(int d0=0;d0<4;++d0){
      #pragma unroll
      for(int r=0;r<16;++r){ const float o1=bf2f(stash[(d0*16+r)*64+lane]); const float df=o1-lam*(o[d0][r]*rli[r]); o[d0][r]=df; ss[r]+=df*df; } }
    #pragma unroll
    for(int r=0;r<16;++r){ float q=ss[r];
      q+=__int_as_float(__builtin_amdgcn_ds_swizzle(__float_as_int(q),0x41f));
      q+=__int_as_float(__builtin_amdgcn_ds_swizzle(__float_as_int(q),0x81f));
      q+=__int_as_float(__builtin_amdgcn_ds_swizzle(__float_as_int(q),0x101f));
      q+=__int_as_float(__builtin_amdgcn_ds_swizzle(__float_as_int(q),0x201f));
      q+=__int_as_float(__builtin_amdgcn_ds_swizzle(__float_as_int(q),0x401f));
      ss[r]=(1.f-LAMBDA_INIT0)/sqrtf(q*(1.f/128.f)+LN_EPS); }
    asm volatile("s_waitcnt lgkmcnt(0)":::"memory");
    unsigned char*stg=(unsigned char*)stash;
    #pragma unroll
    for(int d0=0;d0<4;++d0){ const float sgv=subln[d0*32+r32];
      #pragma unroll
      for(int r=0;r<16;++r){ const int w8=__builtin_amdgcn_cvt_pk_fp8_f32(o[d0][r]*ss[r]*sgv,0.f,0,false); stg[crow(r,hi)*128+d0*32+r32]=(unsigned char)(w8&0xff); } }
    asm volatile("s_waitcnt lgkmcnt(0)":::"memory");
    unsigned char*Aw=A2+(qrow0+wid*QBLK)*DM+acol;
    #pragma unroll
    for(int i=0;i<4;++i){const int row=i*8+(lane>>3),ch=lane&7; const u32x4 v=*(const u32x4*)(stg+row*128+ch*16); *(u32x4*)(Aw+(long)row*DM+ch*16)=v;}
    asm volatile("s_waitcnt lgkmcnt(0)":::"memory");
  }
  } }
  asm volatile("s_waitcnt lgkmcnt(0)\n\ts_barrier":::"memory");
  int ovfl=0; if constexpr(OPT){ ovfl=__builtin_amdgcn_readfirstlane((int)*(volatile unsigned*)ovf); }
  #undef KVROW
  #undef DMA_K
  #undef DMA_V
  #undef RESC
  #undef ROT
  #undef EX
  #undef PK8
  #undef VF8
  #undef PIN
  #undef MX3
  #undef VR4
  #undef MFO8
  #undef KRD
  #undef MFOL
  #undef SM8
  #undef SM8F
  #undef STEP2
  #undef ENDW
  return ovfl;
}
#undef SBAR
#undef WAIT_BAR
}
__device__ __forceinline__ void phase_attn2(const Frame& F, const Prm& p) {
    const bf16* Q = (const bf16*)(p.ws + WS_Q); const bf16* K = (const bf16*)(p.ws + WS_K); const bf16* V = (const bf16*)(p.ws + WS_V); unsigned char* A2 = p.ws + WS_O1;
    const float* lamp = (const float*)(p.ws + WS_MISC);
    for (int v = vcu_of(F); v < 256; v += F.G) {
        const int b = v >> 5, hs = (v >> 4) & 1, qb = v & 15;
        const long kctx = NLAT + b * CTXL, klat = (long)b * SEQ;
        for (int hr = 0; hr < 4; ++hr) {
            const int h = 2 * hr + hs;
            const int nu = (qb == hr) ? 2 : 1;
            for (int i = 0; i < nu; ++i) {
                const long qrow0 = i == 0 ? klat + qb * 256 : kctx; const int NT = i == 0 ? 68 : 4;
                unsigned* ovf = (unsigned*)(F.lds + LDS_BYTES - 32);
                int redo = 0;
                for (int m = 0; m < 2; ++m) {
                    const int hm = 2 * h + m;
                    const float km = __uint_as_float(__hip_atomic_load(F.ctl + CW_KM + b * 16 + hm, __ATOMIC_RELAXED, __HIP_MEMORY_SCOPE_AGENT));
                    redo |= attn_body::attn_unit2<8, true>(qrow0, hm * 64, h * 128, kctx, klat, NT, Q, K, V, m, lamp, p.subln, A2, h * 128, km, (char*)F.lds, F.wave, ovf);
                }
                if (redo) {
                    __syncthreads(); if (F.wave == 0) *ovf = 0u; __syncthreads();
                    for (int m = 0; m < 2; ++m) {
                        const int hm = 2 * h + m;
                        const float km = __uint_as_float(__hip_atomic_load(F.ctl + CW_KM + b * 16 + hm, __ATOMIC_RELAXED, __HIP_MEMORY_SCOPE_AGENT));
                        (void)attn_body::attn_unit2<8, false>(qrow0, hm * 64, h * 128, kctx, klat, NT, Q, K, V, m, lamp, p.subln, A2, h * 128, km, (char*)F.lds, F.wave, ovf);
                    }
                }
            }
        }
    }
}
namespace gla3 {
typedef short bf16x8 __attribute__((ext_vector_type(8)));
typedef short s16x4 __attribute__((ext_vector_type(4)));
typedef float f32x16 __attribute__((ext_vector_type(16)));
constexpr int CH = 64 * 16 + 64;
constexpr int L_QS = 0, L_KS = 16 * CH, L_VS = 32 * CH, L_SB = 40 * CH, L_X = 56 * CH, L_DEC = L_X + 16384, L_END = L_DEC + 512;
__device__ __forceinline__ int crow(int i, int hh) { return (i & 3) + 8 * (i >> 2) + 4 * hh; }
typedef float f32x2_t __attribute__((ext_vector_type(2))); typedef __bf16 bf16x2_t __attribute__((ext_vector_type(2)));
__device__ __forceinline__ unsigned pk(float lo, float hi) { f32x2_t v = {lo, hi}; bf16x2_t b = __builtin_convertvector(v, bf16x2_t); return __builtin_bit_cast(unsigned, b); }
typedef short v4i16_t __attribute__((ext_vector_type(4)));
__device__ __forceinline__ s16x4 trrd(LAS const unsigned char* p) { return __builtin_bit_cast(s16x4, __builtin_amdgcn_ds_read_tr16_b64_v4i16((LAS v4i16_t*)p)); }
#define GLA_FR(lo, hi) (bf16x8){lo[0], lo[1], lo[2], lo[3], hi[0], hi[1], hi[2], hi[3]}

__device__ __forceinline__ void scan_unit(const Frame& F, const Prm& p, int unit) {
    const int dvs = unit & 3, dir = (unit >> 2) & 1, h = (unit >> 3) & 3, b = unit >> 5;
    LAS unsigned char* lds = (LAS unsigned char*)F.lds;
    const int lane = F.lane, w = F.wave, tid = F.tid, r = lane & 31, hh = lane >> 5;
    const bf16* QT = (const bf16*)(p.ws + WS_QT) + ((size_t)dir * 8 + 2 * h) * NTOK * 64;
    const bf16* KT = (const bf16*)(p.ws + WS_KT) + ((size_t)dir * 8 + 2 * h) * NTOK * 64;
    const bf16* V = (const bf16*)(p.ws + WS_V1) + h * 256 + dvs * 64;
    const float* DEC = (const float*)(p.ws + WS_DEC) + (size_t)dir * NCHUNK * 512 + h * 128;
    bf16* OG = (bf16*)((unsigned char*)p.out + (dir ? OUT_OGB : 0)) + h * 256 + dvs * 64;
    const int g1 = (lane >> 4) & 1, q4 = (lane & 15) >> 2, p4 = lane & 3;
    const int trb = (2 * g1 + (p4 >> 1)) * CH + q4 * 16 + 8 * (p4 & 1);
    const int trN = trb + 128 * hh, trP = trb + 64 * hh;
    f32x16 S0 = {}, S1 = {};
    for (int i = tid; i < 16 * CH / 16; i += NTHR) *(LAS u32x4*)(lds + L_SB + i * 16) = (u32x4){0u, 0u, 0u, 0u};
    u32x4 pq0[2], pq1[2], pk0[2], pk1[2], pv[2]; float pdec[2] = {0.f, 0.f};
#define GLA_CHUNK(step) ((step) >= 4 ? b * 64 + (dir ? 63 - ((step) - 4) : (step) - 4) : 512 + b * 4 + (dir ? 3 - (step) : (step)))
    const int qrow = 8 * w + (lane >> 4), qch = lane & 15, vrow = 8 * w + (lane >> 3), vch = lane & 7;
    const size_t qgo = (size_t)(qch >> 3) * NTOK * 64 + (qch & 7) * 8;
#define GLA_LOAD(step, u) do { const size_t t0_ = (size_t)GLA_CHUNK(step) * 64; \
        pq0[u] = *(const u32x4*)(QT + qgo + (t0_ + qrow) * 64); pq1[u] = *(const u32x4*)(QT + qgo + (t0_ + qrow + 4) * 64); \
        pk0[u] = *(const u32x4*)(KT + qgo + (t0_ + qrow) * 64); pk1[u] = *(const u32x4*)(KT + qgo + (t0_ + qrow + 4) * 64); \
        pv[u] = *(const u32x4*)(V + (t0_ + vrow) * 1024 + 8 * vch); if (tid < 128) pdec[u] = DEC[(size_t)GLA_CHUNK(step) * 512 + tid]; } while (0)
#define GLA_STORE(u) do { \
        *(LAS u32x4*)(lds + L_QS + qch * CH + qrow * 16) = pq0[u]; *(LAS u32x4*)(lds + L_QS + qch * CH + (qrow + 4) * 16) = pq1[u]; \
        *(LAS u32x4*)(lds + L_KS + qch * CH + qrow * 16) = pk0[u]; *(LAS u32x4*)(lds + L_KS + qch * CH + (qrow + 4) * 16) = pk1[u]; \
        *(LAS u32x4*)(lds + L_VS + vch * CH + vrow * 16) = pv[u]; \
        if (tid < 128) *(LAS float*)(lds + L_DEC + 4 * tid) = pdec[u]; } while (0)
    GLA_LOAD(0, 0);
    GLA_LOAD(1, 1);
    GLA_STORE(0);
    __syncthreads();
    const int tb = (w & 3) >> 1, vb = w & 1;
    for (int sp2 = 0; sp2 < 34; ++sp2) {
#pragma unroll
    for (int u = 0; u < 2; ++u) {
        const int step = 2 * sp2 + u;
        const bool lat = step >= 4; const int chunk = GLA_CHUNK(step);
        if (step + 2 < 68) GLA_LOAD(step + 2, u);
        f32x16 o = {};
        if (w < 4) {
            if (lat) {
                const bool n0 = dir ? (tb == 0) : true, n1 = dir ? true : (tb == 1);
                f32x16 sc0 = {}, sc1 = {};
#define GLA_BQ(ks) (*(const LAS bf16x8*)(lds + L_QS + (2 * (ks) + hh) * CH + (32 * tb + r) * 16))
#define GLA_A0(ks) (*(const LAS bf16x8*)(lds + L_KS + (2 * (ks) + hh) * CH + r * 16))
#define GLA_A1(ks) (*(const LAS bf16x8*)(lds + L_KS + (2 * (ks) + hh) * CH + (32 + r) * 16))
                if (n0 && n1) {
#pragma unroll
                    for (int ks = 0; ks < 8; ++ks) { const bf16x8 bq = GLA_BQ(ks); sc0 = __builtin_amdgcn_mfma_f32_32x32x16_bf16(GLA_A0(ks), bq, sc0, 0, 0, 0); sc1 = __builtin_amdgcn_mfma_f32_32x32x16_bf16(GLA_A1(ks), bq, sc1, 0, 0, 0); }
                } else if (n0) {
#pragma unroll
                    for (int ks = 0; ks < 8; ++ks) sc0 = __builtin_amdgcn_mfma_f32_32x32x16_bf16(GLA_A0(ks), GLA_BQ(ks), sc0, 0, 0, 0);
                } else {
#pragma unroll
                    for (int ks = 0; ks < 8; ++ks) sc1 = __builtin_amdgcn_mfma_f32_32x32x16_bf16(GLA_A1(ks), GLA_BQ(ks), sc1, 0, 0, 0);
                }
#undef GLA_BQ
#undef GLA_A0
#undef GLA_A1
                const int t = 32 * tb + r;
#pragma unroll
                for (int i = 0; i < 16; ++i) { const int s0 = crow(i, hh), s1 = 32 + s0; const bool k0 = dir ? (s0 >= t) : (s0 <= t), k1 = dir ? (s1 >= t) : (s1 <= t); sc0[i] = k0 ? sc0[i] : 0.f; sc1[i] = k1 ? sc1[i] : 0.f; }
#pragma unroll
                for (int sb = 0; sb < 2; ++sb) { if (sb == 0 ? n0 : n1) {
#pragma unroll
                    for (int sp = 0; sp < 2; ++sp) {
                        u32x4 pw;
                        if (sb == 0) { pw.x = pk(sc0[8 * sp + 0], sc0[8 * sp + 1]); pw.y = pk(sc0[8 * sp + 2], sc0[8 * sp + 3]); pw.z = pk(sc0[8 * sp + 4], sc0[8 * sp + 5]); pw.w = pk(sc0[8 * sp + 6], sc0[8 * sp + 7]); }
                        else { pw.x = pk(sc1[8 * sp + 0], sc1[8 * sp + 1]); pw.y = pk(sc1[8 * sp + 2], sc1[8 * sp + 3]); pw.z = pk(sc1[8 * sp + 4], sc1[8 * sp + 5]); pw.w = pk(sc1[8 * sp + 6], sc1[8 * sp + 7]); }
                        LAS const unsigned char* vp = lds + L_VS + trP + (4 * vb) * CH + (32 * sb + 16 * sp) * 16;
                        const s16x4 lo = trrd(vp), hi = trrd(vp + 8 * 16);
                        o = __builtin_amdgcn_mfma_f32_32x32x16_bf16(GLA_FR(lo, hi), __builtin_bit_cast(bf16x8, pw), o, 0, 0, 0);
                    } } }
            }
        } else {
            const int db = w - 4;
            if (lat) {
                f32x16 o2 = {};
#pragma unroll
                for (int ks = 0; ks < 8; ++ks) {
                    const bf16x8 as = *(const LAS bf16x8*)(lds + L_SB + (2 * ks + hh) * CH + (32 * vb + r) * 16);
                    const bf16x8 bq = *(const LAS bf16x8*)(lds + L_QS + (2 * ks + hh) * CH + (32 * tb + r) * 16);
                    o2 = __builtin_amdgcn_mfma_f32_32x32x16_bf16(as, bq, o2, 0, 0, 0);
                }
#pragma unroll
                for (int g = 0; g < 4; ++g) *(LAS f32x4*)(lds + L_X + (w & 3) * 4096 + g * 1024 + lane * 16) = (f32x4){o2[4 * g], o2[4 * g + 1], o2[4 * g + 2], o2[4 * g + 3]};
            }
#pragma unroll
            for (int ks = 0; ks < 4; ++ks) {
                LAS const unsigned char* kp = lds + L_KS + trN + (4 * db) * CH + (16 * ks) * 16;
                LAS const unsigned char* vp = lds + L_VS + trN + (16 * ks) * 16;
                const s16x4 al = trrd(kp), ah = trrd(kp + 4 * 16);
                const s16x4 b0l = trrd(vp), b0h = trrd(vp + 4 * 16), b1l = trrd(vp + 4 * CH), b1h = trrd(vp + 4 * CH + 4 * 16);
                S0 = __builtin_amdgcn_mfma_f32_32x32x16_bf16(GLA_FR(al, ah), GLA_FR(b0l, b0h), S0, 0, 0, 0); S1 = __builtin_amdgcn_mfma_f32_32x32x16_bf16(GLA_FR(al, ah), GLA_FR(b1l, b1h), S1, 0, 0, 0);
            }
#pragma unroll
            for (int i = 0; i < 16; ++i) { const float dc = *(const LAS float*)(lds + L_DEC + 4 * (32 * db + crow(i, hh))); S0[i] *= dc; S1[i] *= dc; }
        }
        __syncthreads();
        if (w < 4 && lat) {
            bf16* orow = OG + ((size_t)chunk * 64 + 32 * tb + r) * DM + 32 * vb + 4 * hh;
#pragma unroll
            for (int g = 0; g < 4; ++g) { const f32x4 x = *(const LAS f32x4*)(lds + L_X + w * 4096 + g * 1024 + lane * 16);
                u32x2 wv; wv.x = pk(o[4 * g] + x.x, o[4 * g + 1] + x.y); wv.y = pk(o[4 * g + 2] + x.z, o[4 * g + 3] + x.w); *(u32x2*)(orow + 8 * g) = wv; }
        }
        if (step + 1 < 68) {
            GLA_STORE(u ^ 1);
            if (w >= 4) { const int db = w - 4;
#pragma unroll
                for (int g = 0; g < 4; ++g) { u32x2 w0, w1; w0.x = pk(S0[4 * g], S0[4 * g + 1]); w0.y = pk(S0[4 * g + 2], S0[4 * g + 3]); w1.x = pk(S1[4 * g], S1[4 * g + 1]); w1.y = pk(S1[4 * g + 2], S1[4 * g + 3]);
                    *(LAS u32x2*)(lds + L_SB + (4 * db + g) * CH + r * 16 + 8 * hh) = w0; *(LAS u32x2*)(lds + L_SB + (4 * db + g) * CH + (32 + r) * 16 + 8 * hh) = w1; } }
        }
        __syncthreads();
    }
    }
#undef GLA_CHUNK
#undef GLA_LOAD
#undef GLA_STORE
}
#undef GLA_FR
}
__device__ __forceinline__ void phase_scan_opt(const Frame& F, const Prm& p) {
    for (int unit = vcu_of(F); unit < 256; unit += F.G) gla3::scan_unit(F, p, unit);
}
#define PHASE_QKV(F, p) phase_qkv_opt(F, p)
#define PHASE_ATTN(F, p) phase_attn2(F, p)
#define PHASE_WO(F, p, l) phase_wo_opt(F, p, l)
#define PHASE_MOE1(F, p, l) phase_moe1_opt(F, p, l)
#define PHASE_MOE2(F, p, l) phase_moe2_opt(F, p, l)
#define PHASE_INPROJ(F, p) phase_inproj_opt(F, p)
#define PHASE_SCAN(F, p) phase_scan_opt(F, p)
typedef GAS unsigned gu32;
#define XB_TMO      128
#define XB_XCNT(j)  (256  + 64 * (j))
#define XB_XSUB(j)  (1280 + 64 * (j))
#define XB_XGEN(j)  (2304 + 64 * (j))
#define XB_TOP      3328
#define XB_TOPGEN   3392
#define XCD_BAR_WORDS 3456
#define XB_SPIN_CAP (1u << 20)
__device__ __forceinline__ unsigned xb_ld(unsigned* p)              { return __hip_atomic_load(p, __ATOMIC_RELAXED, __HIP_MEMORY_SCOPE_AGENT); }
__device__ __forceinline__ unsigned xb_add(unsigned* p, unsigned v) { return __hip_atomic_fetch_add(p, v, __ATOMIC_RELAXED, __HIP_MEMORY_SCOPE_AGENT); }
__device__ __forceinline__ unsigned xb_xcc_id() { return (unsigned)__builtin_amdgcn_s_getreg((3 << 11) | 20) & 0xFu; }
#define XB_SPIN(cond, bar) do { unsigned _sp = 0; while (cond) { __builtin_amdgcn_s_sleep(1); \
    if ((++_sp & 255u) == 0u) { if (xb_ld(&(bar)[XB_TMO])) break; if (_sp > XB_SPIN_CAP) { atomicAdd(&(bar)[XB_TMO], 1u); break; } } } } while (0)
struct XcdBarrier { unsigned* bar; unsigned x; volatile LAS unsigned* st; };
__device__ __forceinline__ XcdBarrier xcd_barrier_post(unsigned* bar, volatile LAS unsigned* st) {
    XcdBarrier b; b.bar = bar; b.x = xb_xcc_id(); b.st = st;
    if (threadIdx.x == 0) (void)xb_add(&bar[XB_XCNT(b.x)], 1u);
    return b;
}
__device__ __forceinline__ void xcd_barrier_complete(unsigned* bar, unsigned x, unsigned& nloc, unsigned& nx) {
    const unsigned G = gridDim.x * gridDim.y * gridDim.z;
    unsigned sum, cnt, mine, sp = 0u;
    for (;;) {
        sum = 0u; cnt = 0u; mine = 0u;
#pragma unroll
        for (unsigned j = 0; j < 16; ++j) { const unsigned c = xb_ld(&bar[XB_XCNT(j)]); sum += c; cnt += (c > 0u) ? 1u : 0u; mine = (j == x) ? c : mine; }
        if (sum == G) break;
        __builtin_amdgcn_s_sleep(1);
        if ((++sp & 255u) == 0u) { if (xb_ld(&bar[XB_TMO])) break; if (sp > XB_SPIN_CAP) { atomicAdd(&bar[XB_TMO], 1u); break; } }
    }
    nloc = mine > 0u ? mine : 1u; nx = cnt > 0u ? cnt : 1u;
}
__device__ __forceinline__ void xcd_barrier(const XcdBarrier& b, int tid) {
    asm volatile("s_waitcnt vmcnt(0)" ::: "memory");
    __syncthreads();
    if (tid == 0) {
        unsigned* bar = b.bar;
        __builtin_amdgcn_s_waitcnt(0);
        unsigned nloc = b.st[0], nx = b.st[1];
        if (nloc == 0u) { xcd_barrier_complete(bar, b.x, nloc, nx); b.st[0] = nloc; b.st[1] = nx; }
        const unsigned old = xb_add(&bar[XB_XSUB(b.x)], 1u);
        const unsigned gen = old / nloc;
        if (old + 1u == (gen + 1u) * nloc) {
            __builtin_amdgcn_fence(__ATOMIC_RELEASE, "agent");
            asm volatile("s_waitcnt vmcnt(0)" ::: "memory");
            const unsigned og = xb_add(&bar[XB_TOP], 1u);
            const unsigned tg = og / nx;
            if (og + 1u == (tg + 1u) * nx) xb_add(&bar[XB_TOPGEN], 1u);
            else XB_SPIN(xb_ld(&bar[XB_TOPGEN]) == tg, bar);
            __builtin_amdgcn_fence(__ATOMIC_ACQUIRE, "agent");
            xb_add(&bar[XB_XGEN(b.x)], 1u);
            asm volatile("s_waitcnt vmcnt(0)" ::: "memory");
        } else {
            XB_SPIN(xb_ld(&bar[XB_XGEN(b.x)]) == gen, bar);
            __builtin_amdgcn_fence(__ATOMIC_ACQUIRE, "agent");
            asm volatile("s_waitcnt vmcnt(0)" ::: "memory");
        }
    }
    __syncthreads();
}

constexpr int NPHASE = 19;
__global__ void __launch_bounds__(NTHR, 2) mega_fwd(Prm p) {
    extern __shared__ __attribute__((aligned(16))) unsigned char lds[];
    Frame F; F.lds = lds; F.ctl = (unsigned*)(p.ws + WS_CTL);
    F.tid = threadIdx.x; F.lane = F.tid & 63; F.wave = __builtin_amdgcn_readfirstlane(F.tid >> 6); F.G = gridDim.x; F.bid = blockIdx.x;
    for (int u = F.tid; u < (LDS_BYTES - LDSCTL_OFF) / 4; u += NTHR) ((LAS unsigned*)(lds + LDSCTL_OFF))[u] = 0u;
    __syncthreads();
    const int lo = p.ph_lo, hi = p.ph_hi;
    const bool multi = (hi - lo) > 1;
    XcdBarrier bar; bar.bar = F.ctl + CW_BAR + p.li * XCD_BAR_WORDS; bar.x = 0; bar.st = nullptr;
    if (multi) bar = xcd_barrier_post(F.ctl + CW_BAR + p.li * XCD_BAR_WORDS, (volatile LAS unsigned*)(lds + MISC_OFF) + 8);
#define IN(k) (lo <= (k) && (k) < hi)
#define SEAM(k) do { if (IN(k) && IN((k) + 1)) xcd_barrier(bar, F.tid); } while (0)
    if (IN(0)) { phase_prologue(F, p); } SEAM(0);
    if (IN(1)) { phase_modulate0(F, p); } SEAM(1);
    if (IN(2)) { PHASE_QKV(F, p); } SEAM(2);
    if (IN(3)) { PHASE_ATTN(F, p); }
    {
        int l_; asm volatile("v_mbcnt_lo_u32_b32 %0, -1, 0\n\tv_mbcnt_hi_u32_b32 %0, -1, %0" : "=v"(l_)); F.lane = l_; F.tid = F.wave * 64 + l_; }
    SEAM(3);
    if (IN(5)) { PHASE_WO(F, p, 0); } SEAM(5);
    if (IN(6)) { phase_ln_route(F, p, 0); } SEAM(6);
    if (IN(7)) { PHASE_MOE1(F, p, 0); } SEAM(7);
    if (IN(8)) { PHASE_MOE2(F, p, 0); } SEAM(8);
    if (IN(9)) { phase_moe_combine(F, p, 0); } SEAM(9);
    if (IN(10)) { PHASE_INPROJ(F, p); } SEAM(10);
    if (IN(11)) { phase_gla_prep(F, p); } SEAM(11);
    if (IN(12)) { PHASE_SCAN(F, p); } SEAM(12);
    if (IN(13)) { phase_gla_post(F, p); } SEAM(13);
    if (IN(14)) { PHASE_WO(F, p, 1); } SEAM(14);
    if (IN(15)) { phase_ln_route(F, p, 1); } SEAM(15);
    if (IN(16)) { PHASE_MOE1(F, p, 1); } SEAM(16);
    if (IN(17)) { PHASE_MOE2(F, p, 1); } SEAM(17);
    if (IN(18)) { phase_moe_combine(F, p, 1); }
#undef IN
#undef SEAM
}

extern "C" void kernel_launch(void* const* d_in, const int* in_sizes, int n_in, void* d_out, int out_size, void* d_ws, size_t ws_size, hipStream_t stream) {
    static int grid = 0;
    if (grid == 0) {
        if (n_in != 23 || in_sizes[0] != NLAT * DM || out_size != NLAT * DM || ws_size < WS_END) { fprintf(stderr, "kernel_launch: unexpected shapes (n_in %d, in0 %d, out %d, ws %zu); nothing launched\n", n_in, n_in > 0 ? in_sizes[0] : -1, out_size, ws_size); grid = -1; return; }
        int dev = 0, cus = 0;
        if (hipGetDevice(&dev) != hipSuccess || hipDeviceGetAttribute(&cus, hipDeviceAttributeMultiprocessorCount, dev) != hipSuccess) { grid = -1; return; }
        if (hipFuncSetAttribute((const void*)mega_fwd, hipFuncAttributeMaxDynamicSharedMemorySize, LDS_BYTES) != hipSuccess) { fprintf(stderr, "kernel_launch: hipFuncSetAttribute failed\n"); grid = -1; return; }
        int per_cu = 0;
        if (hipOccupancyMaxActiveBlocksPerMultiprocessor(&per_cu, (const void*)mega_fwd, NTHR, LDS_BYTES) != hipSuccess || per_cu < 1) fprintf(stderr, "kernel_launch: note: occupancy query reports %d\n", per_cu);
        (void)hipGetLastError();
        grid = cus;
    }
    if (grid < 0) return;
    (void)hipMemsetAsync((char*)d_ws + WS_CTL, 0, CTL_ZERO_BYTES, stream);
    Prm p{};
    const float** pp = (const float**)&p;
    for (int i = 0; i < 23; ++i) pp[i] = (const float*)d_in[i];
    p.out = (float*)d_out; p.ws = (unsigned char*)d_ws;
    p.ph_lo = 0; p.ph_hi = NPHASE; p.li = 0;
    hipLaunchKernelGGL(mega_fwd, dim3(grid), dim3(NTHR), LDS_BYTES, stream, p);
}
```

```cpp
#include <hip/hip_runtime.h>
#include <cstdint>
#include <cstdio>

constexpr int BATCH = 8, SEQ = 4096, DM = 1024, CTXL = 256;
constexpr int NLAT = BATCH * SEQ, NCTX = BATCH * CTXL, NTOK = NLAT + NCTX;
constexpr float ALPHA = 1.4142135623730951f;
constexpr float LN_EPS = 1e-5f;
constexpr float LAMBDA_INIT0 = 0.2f;
constexpr float C2 = 0.125f * 1.4426950408889634f;
constexpr int NEXP = 16, DEXP = 512, MAXSLOT = 73728;
constexpr int NCHUNK = NTOK / 64;
constexpr int NIN = 3328;

typedef unsigned short bf16;
typedef float f32x4 __attribute__((ext_vector_type(4)));
typedef float f32x2 __attribute__((ext_vector_type(2)));
typedef unsigned u32x2 __attribute__((ext_vector_type(2)));
typedef unsigned u32x4 __attribute__((ext_vector_type(4)));

constexpr size_t MiB = 1u << 20;
constexpr size_t WS_CTL = 0, CTL_ZERO_BYTES = 1 * MiB;
constexpr size_t WS_MOD = 1 * MiB;
constexpr size_t WS_MISC = 1 * MiB + 512 * 1024;
constexpr size_t WS_WQKV = 2 * MiB, WS_WO = 5 * MiB, WS_GU0 = 6 * MiB, WS_DN0 = 22 * MiB, WS_WIN = 30 * MiB, WS_WGO = 34 * MiB, WS_GU1 = 35 * MiB, WS_DN1 = 51 * MiB;
constexpr size_t WS_XB = 59 * MiB;
constexpr size_t WS_H = 127 * MiB;
constexpr size_t WS_Q = 195 * MiB, WS_K = 263 * MiB, WS_V = 331 * MiB, WS_O2 = 399 * MiB;
constexpr size_t WS_LIST = 467 * MiB;
constexpr size_t WS_TOKR = 470 * MiB;
constexpr size_t WS_DEC = 472 * MiB;
constexpr size_t WS_ZZ = 475 * MiB;
constexpr size_t WS_END = 480 * MiB;
constexpr size_t WS_O1 = WS_H, WS_A2 = WS_H, WS_Y = WS_K;
constexpr size_t WS_YM = 195 * MiB, WS_ACT = 339 * MiB;
constexpr size_t WS_QR = 195 * MiB, WS_KR = 229 * MiB, WS_V1 = 263 * MiB, WS_R = 331 * MiB;
constexpr size_t WS_QT = WS_H, WS_KT = 399 * MiB;
constexpr size_t WS_A2B = WS_H;
constexpr size_t OUT_OGB = 64 * MiB;
constexpr int CW_TMO = 0, CW_CODE = 1;
constexpr int CW_CNT = 64;
constexpr int CW_KM = 128;
constexpr int CW_BAR = 4096;

__device__ __forceinline__ unsigned f2bf(float f) { unsigned u = __builtin_bit_cast(unsigned, f); return (u + 0x7fffu + ((u >> 16) & 1u)) >> 16; }
__device__ __forceinline__ unsigned pk2(float lo, float hi) { return f2bf(lo) | (f2bf(hi) << 16); }
__device__ __forceinline__ float bf2f(unsigned b) { return __builtin_bit_cast(float, b << 16); }
__device__ __forceinline__ float wave_sum(float v) {
#pragma unroll
    for (int o = 1; o < 64; o <<= 1) v += __shfl_xor(v, o);
    return v;
}
__device__ __forceinline__ float silu_f(float v) { return v / (1.f + __expf(-v)); }

struct Prm {
    const float *x, *c, *ctx, *cctx, *ada_w, *ada_b, *ln_g, *ln_b, *w_qkv, *w_o, *lam, *subln, *gw_in, *gwg_down, *gwg_up, *gbg, *gnorm, *gw_o, *rw, *rb, *mg, *mu, *md;
    float* out; unsigned char* ws;
    int ph_lo, ph_hi, li, pad;
};
__device__ __forceinline__ void ld_row_f32(const float* p, int lane, f32x4 (&v)[4]) {
#pragma unroll
    for (int j = 0; j < 4; ++j) v[j] = *(const f32x4*)(p + 4 * lane + 256 * j);
}
__device__ __forceinline__ void st_row_f32(float* p, int lane, const f32x4 (&v)[4]) {
#pragma unroll
    for (int j = 0; j < 4; ++j) *(f32x4*)(p + 4 * lane + 256 * j) = v[j];
}
__device__ __forceinline__ void ld_row_bf16(const bf16* p, int lane, f32x4 (&v)[4]) {
#pragma unroll
    for (int j = 0; j < 4; ++j) { const u32x2 u = *(const u32x2*)(p + 4 * lane + 256 * j); v[j] = (f32x4){bf2f(u.x & 0xffffu), bf2f(u.x >> 16), bf2f(u.y & 0xffffu), bf2f(u.y >> 16)}; }
}
__device__ __forceinline__ void st_row_bf16(bf16* p, int lane, const f32x4 (&v)[4]) {
#pragma unroll
    for (int j = 0; j < 4; ++j) { u32x2 u; u.x = pk2(v[j].x, v[j].y); u.y = pk2(v[j].z, v[j].w); *(u32x2*)(p + 4 * lane + 256 * j) = u; }
}
__device__ __forceinline__ void ln_row(f32x4 (&v)[4], const float* g, const float* b, int lane) {
    float s = 0.f;
#pragma unroll
    for (int j = 0; j < 4; ++j) s += (v[j].x + v[j].y) + (v[j].z + v[j].w);
    const float mean = wave_sum(s) * (1.f / DM); float q = 0.f;
#pragma unroll
    for (int j = 0; j < 4; ++j) { v[j] = v[j] - mean; q += (v[j].x * v[j].x + v[j].y * v[j].y) + (v[j].z * v[j].z + v[j].w * v[j].w); }
    const float rstd = 1.f / sqrtf(wave_sum(q) * (1.f / DM) + LN_EPS);
#pragma unroll
    for (int j = 0; j < 4; ++j) { const f32x4 gg = *(const f32x4*)(g + 4 * lane + 256 * j), bb = *(const f32x4*)(b + 4 * lane + 256 * j); v[j] = v[j] * rstd * gg + bb; }
}
__host__ __device__ __forceinline__ int gu_phys(int other, int sel) { return (other >> 4) * 32 + sel * 16 + (other & 15); }
__host__ __device__ __forceinline__ int perm16b(int L) { return (L & ~31) | (16 * ((L >> 2) & 1) + 4 * ((L >> 3) & 3) + (L & 3)); }
__host__ __device__ __forceinline__ int perm16b_inv(int P) { return (P & ~31) | (8 * ((P >> 2) & 3) + 4 * ((P >> 4) & 1) + (P & 3)); }
__device__ __forceinline__ unsigned pk4_fp8(float a, float b, float c, float d) { int w = 0; w = __builtin_amdgcn_cvt_pk_fp8_f32(a, b, w, false); w = __builtin_amdgcn_cvt_pk_fp8_f32(c, d, w, true); return (unsigned)w; }
constexpr float W8_SCALE = 64.f, W8_INV = 1.f / 64.f;
__device__ __forceinline__ void st_row_fp8(unsigned char* p, int lane, const f32x4 (&v)[4]) {
#pragma unroll
    for (int j = 0; j < 4; ++j) *(unsigned*)(p + 4 * lane + 256 * j) = pk4_fp8(v[j].x, v[j].y, v[j].z, v[j].w);
}
__device__ __forceinline__ void ld_row_fp8(const unsigned char* p, int lane, f32x4 (&v)[4]) {
#pragma unroll
    for (int j = 0; j < 4; ++j) { const int w = *(const int*)(p + 4 * lane + 256 * j); const f32x2 lo = __builtin_amdgcn_cvt_pk_f32_fp8(w, false), hi = __builtin_amdgcn_cvt_pk_f32_fp8(w, true); v[j] = (f32x4){lo.x, lo.y, hi.x, hi.y}; }
}
#define GAS __attribute__((address_space(1)))
#define LAS __attribute__((address_space(3)))
constexpr int NWAVES = 8, NTHR = NWAVES * 64;
constexpr int RING_BYTES = 131072, LDS_BYTES = 163840, LDSCTL_OFF = LDS_BYTES - 1024, MISC_OFF = LDSCTL_OFF + 320;
constexpr int LDSX_OFF = RING_BYTES + 1024;
#define LDS_WAIT() asm volatile("s_waitcnt lgkmcnt(0)" ::: "memory")
#define VM_WAIT() asm volatile("s_waitcnt vmcnt(0)" ::: "memory")

struct Frame {
    unsigned char* lds;
    unsigned* ctl;
    int tid, lane, wave, G, bid;
};

template <int MODE>
__device__ __forceinline__ void p0_transpose_item(const float* W, int K, int N, bf16* WT, int row_off, float* scr, int item, int lane) {
    const int nblk = N / 32, kb = item / nblk, nb = item % nblk, k0 = 64 * kb, n0 = 32 * nb;
    { f32x4 t[8];
#pragma unroll
        for (int i = 0; i < 8; ++i) t[i] = *(const f32x4*)(W + (size_t)(k0 + 8 * i + (lane >> 3)) * N + n0 + 4 * (lane & 7));
#pragma unroll
        for (int i = 0; i < 8; ++i) { float* d = scr + (8 * i + (lane >> 3)) * 33 + 4 * (lane & 7); d[0] = t[i].x; d[1] = t[i].y; d[2] = t[i].z; d[3] = t[i].w; } }
    LDS_WAIT(); asm volatile("" ::: "memory");
    const int c = lane & 7;
#pragma unroll
    for (int j = 0; j < 4; ++j) { const int n = (lane >> 3) + 8 * j; const float* s = scr + (8 * c) * 33 + n;
        u32x4 o; o.x = pk2(s[0 * 33], s[1 * 33]); o.y = pk2(s[2 * 33], s[3 * 33]); o.z = pk2(s[4 * 33], s[5 * 33]); o.w = pk2(s[6 * 33], s[7 * 33]);
        const int nl = n0 + n; const int pr = (MODE == 0) ? (row_off + nl) : (MODE == 3) ? (row_off + perm16b(nl)) : (row_off + gu_phys(nl, MODE - 1));
        *(u32x4*)(WT + (size_t)pr * K + k0 + 8 * c) = o; }
    LDS_WAIT(); asm volatile("" ::: "memory");
}
template <int MODE>
__device__ __forceinline__ void p0_transpose_item8(const float* W, int K, int N, unsigned char* WT, float* scr, int item, int lane) {
    const int nblk = N / 32, kb = item / nblk, nb = item % nblk, k0 = 64 * kb, n0 = 32 * nb;
    { f32x4 t[8];
#pragma unroll
        for (int i = 0; i < 8; ++i) t[i] = *(const f32x4*)(W + (size_t)(k0 + 8 * i + (lane >> 3)) * N + n0 + 4 * (lane & 7));
#pragma unroll
        for (int i = 0; i < 8; ++i) { float* d = scr + (8 * i + (lane >> 3)) * 33 + 4 * (lane & 7); d[0] = t[i].x; d[1] = t[i].y; d[2] = t[i].z; d[3] = t[i].w; } }
    LDS_WAIT(); asm volatile("" ::: "memory");
    const int c = lane & 7;
#pragma unroll
    for (int j = 0; j < 4; ++j) { const int n = (lane >> 3) + 8 * j; const float* s = scr + (8 * c) * 33 + n;
        u32x2 o; o.x = pk4_fp8(s[0 * 33] * W8_SCALE, s[1 * 33] * W8_SCALE, s[2 * 33] * W8_SCALE, s[3 * 33] * W8_SCALE); o.y = pk4_fp8(s[4 * 33] * W8_SCALE, s[5 * 33] * W8_SCALE, s[6 * 33] * W8_SCALE, s[7 * 33] * W8_SCALE);
        const int nl = n0 + n; const int pr = (MODE == 3 || MODE == 4) ? perm16b(nl) : (MODE == 0) ? nl : gu_phys(nl, MODE - 1);
        if (MODE == 4) {
            unsigned char* d = WT + (size_t)pr * K + (k0 & ~127) + 16 * c + 4 * ((k0 >> 6) & 1);
            *(unsigned*)d = o.x; *(unsigned*)(d + 8) = o.y;
        } else *(u32x2*)(WT + (size_t)pr * K + k0 + 8 * c) = o; }
    LDS_WAIT(); asm volatile("" ::: "memory");
}
__device__ __forceinline__ void phase_prologue(const Frame& F, const Prm& p) {
    float* sil = (float*)F.lds;
    for (int i = F.tid; i < 9 * 1024; i += NTHR) { const int r = i >> 10, k = i & 1023; const float v = (r < 8) ? p.c[r * 1024 + k] : p.cctx[k]; sil[i] = silu_f(v); }
    __syncthreads();
    float* MOD = (float*)(p.ws + WS_MOD);
    if (F.bid < 192) {
        const int layer = F.bid / 96, n = (F.bid % 96) * 64 + F.lane; const float* W = p.ada_w + (size_t)layer * 1024 * 6144 + n;
        float acc[9];
#pragma unroll
        for (int r = 0; r < 9; ++r) acc[r] = 0.f;
        const int kb = F.wave * 128;
#pragma unroll 4
        for (int k = kb; k < kb + 128; k += 4) {
            const float w0 = W[(size_t)k * 6144], w1 = W[(size_t)(k + 1) * 6144], w2 = W[(size_t)(k + 2) * 6144], w3 = W[(size_t)(k + 3) * 6144];
#pragma unroll
            for (int r = 0; r < 9; ++r) { const f32x4 s = *(const f32x4*)(sil + r * 1024 + k); acc[r] += s.x * w0 + s.y * w1 + s.z * w2 + s.w * w3; }
        }
        float* red = (float*)(F.lds + 36864 + 8 * 8704);
#pragma unroll
        for (int r = 0; r < 9; ++r) red[(F.wave * 9 + r) * 64 + F.lane] = acc[r];
        __syncthreads();
        if (F.wave == 0) { const float bb = p.ada_b[layer * 6144 + n];
#pragma unroll
            for (int r = 0; r < 9; ++r) { float t = bb;
#pragma unroll
                for (int w = 0; w < 8; ++w) t += red[(w * 9 + r) * 64 + F.lane];
                MOD[(layer * 9 + r) * 6144 + n] = t; } }
    }
    float* misc = (float*)(p.ws + WS_MISC);
    if (F.bid == 255 % F.G && F.wave == 1) {
        const float a = wave_sum(p.lam[F.lane] * p.lam[64 + F.lane]), b = wave_sum(p.lam[128 + F.lane] * p.lam[192 + F.lane]);
        if (F.lane == 0) misc[0] = __expf(a) - __expf(b) + LAMBDA_INIT0;
        for (int i = F.lane; i < 1024; i += 64) { const int pos = i >> 4, f = i & 15; const float inv = powf(10000.f, -(float)f / 16.f); const float ang = (float)pos * inv;
            misc[1024 + 2 * i] = cosf(ang); misc[1024 + 2 * i + 1] = sinf(ang); }
    }
    float* scr = (float*)(F.lds + 36864 + F.wave * 8704);
    const int gw = F.bid * NWAVES + F.wave, NGW = F.G * NWAVES;
    constexpr int I_QKV = 16 * 96, I_SQ = 16 * 32, I_G = 16 * 16, I_D = 8 * 32;
    constexpr int I_MOE = 2 * I_G + I_D;
    constexpr int NITEMS = 2 * I_QKV + 2 * I_SQ + 32 * I_MOE;
    bf16* ws16 = (bf16*)p.ws;
    for (int it = gw; it < NITEMS; it += NGW) {
        int r = it;
        if (r < I_QKV) { if ((r % 96) < 64) p0_transpose_item8<0>(p.w_qkv, 1024, 3072, p.ws + WS_WQKV, scr, r, F.lane); else p0_transpose_item8<3>(p.w_qkv, 1024, 3072, p.ws + WS_WQKV, scr, r, F.lane); continue; } r -= I_QKV;
        if (r < I_QKV) { p0_transpose_item8<3>(p.gw_in, 1024, 3072, p.ws + WS_WIN, scr, r, F.lane); continue; } r -= I_QKV;
        if (r < I_SQ) { p0_transpose_item8<3>(p.w_o, 1024, 1024, p.ws + WS_WO, scr, r, F.lane); continue; } r -= I_SQ;
        if (r < I_SQ) { p0_transpose_item8<3>(p.gw_o, 1024, 1024, p.ws + WS_WGO, scr, r, F.lane); continue; } r -= I_SQ;
        const int le = r / I_MOE, layer = le >> 4, e = le & 15; r -= le * I_MOE;
        unsigned char* GU = p.ws + (layer ? WS_GU1 : WS_GU0) + (size_t)e * 1024 * 1024; unsigned char* DN = p.ws + (layer ? WS_DN1 : WS_DN0) + (size_t)e * 1024 * 512;
        if (r < I_G) { p0_transpose_item8<1>(p.mg + (size_t)le * 1024 * 512, 1024, 512, GU, scr, r, F.lane); continue; } r -= I_G;
        if (r < I_G) { p0_transpose_item8<2>(p.mu + (size_t)le * 1024 * 512, 1024, 512, GU, scr, r, F.lane); continue; } r -= I_G;
        p0_transpose_item8<4>(p.md + (size_t)le * 512 * 1024, 512, 1024, DN, scr, r, F.lane);
    }
    (void)ws16;
    unsigned char* WIN = p.ws + WS_WIN;
    for (int i = gw * 64 + F.lane; i < 32 * 256; i += NGW * 64) { const int rr = i >> 8, k = (i & 255) * 4, dir = rr >> 4, j = rr & 15; const float* s = p.gwg_down + (size_t)dir * 1024 * 16 + j;
        *(unsigned*)(WIN + (size_t)(3072 + rr) * 1024 + k) = pk4_fp8(s[(size_t)k * 16] * W8_SCALE, s[(size_t)(k + 1) * 16] * W8_SCALE, s[(size_t)(k + 2) * 16] * W8_SCALE, s[(size_t)(k + 3) * 16] * W8_SCALE); }
    for (int i = gw * 64 + F.lane; i < 224 * 1024 / 16; i += NGW * 64) *(u32x4*)(WIN + (size_t)3104 * 1024 + (size_t)i * 16) = (u32x4){0u, 0u, 0u, 0u};
}

__device__ __forceinline__ void phase_modulate0(const Frame& F, const Prm& p) {
    const float* MOD = (const float*)(p.ws + WS_MOD); unsigned char* H = p.ws + WS_H;
    const int gw = F.bid * NWAVES + F.wave, NGW = F.G * NWAVES, per = (NTOK + NGW - 1) / NGW;
    int curmod = -1; f32x4 sh[4], sc[4];
    const int t0 = gw * per, t1 = min(NTOK, (gw + 1) * per);
    f32x4 v[4], vn[4];
    if (t0 < t1) ld_row_f32(t0 < NLAT ? p.x + (size_t)t0 * DM : p.ctx + (size_t)(t0 - NLAT) * DM, F.lane, v);
    for (int tok = t0; tok < t1; ++tok) {
        if (tok + 1 < t1) ld_row_f32(tok + 1 < NLAT ? p.x + (size_t)(tok + 1) * DM : p.ctx + (size_t)(tok + 1 - NLAT) * DM, F.lane, vn);
        const int mr = tok < NLAT ? tok / SEQ : 8;
        if (mr != curmod) { curmod = mr; ld_row_f32(MOD + mr * 6144, F.lane, sh); ld_row_f32(MOD + mr * 6144 + 1024, F.lane, sc); }
#pragma unroll
        for (int j = 0; j < 4; ++j) v[j] = v[j] * (1.f + sc[j]) + sh[j];
        st_row_fp8(H + (size_t)tok * DM, F.lane, v);
#pragma unroll
        for (int j = 0; j < 4; ++j) v[j] = vn[j];
    }
}

__device__ __forceinline__ void phase_ln_route(const Frame& F, const Prm& p, int layer) {
    const int nrows = layer ? NLAT : NTOK;
    const float* MOD = (const float*)(p.ws + WS_MOD) + layer * 9 * 6144;
    const bf16* Y = (const bf16*)(p.ws + WS_Y); unsigned char* HF = p.ws + WS_H;
    bf16* XB = (bf16*)(p.ws + WS_XB);
    int* LIST = (int*)(p.ws + WS_LIST); int* TOKR = (int*)(p.ws + WS_TOKR);
    unsigned* CNT = F.ctl + CW_CNT + layer * 16;
    float* WrT = (float*)F.lds;
    int* rec = (int*)(F.lds + 65536);
    unsigned* lcnt = (unsigned*)(F.lds + 65536 + 8192); unsigned* lbase = lcnt + 16;
    for (int i = F.tid; i < 16 * 1024; i += NTHR) { const int k = i >> 4, e = i & 15; WrT[e * 1024 + k] = p.rw[i]; }
    if (F.tid < 16) lcnt[F.tid] = 0u;
    __syncthreads();
    const int per_wg = (nrows + F.G - 1) / F.G, per_w = (per_wg + NWAVES - 1) / NWAVES;
    const int row_lo = F.bid * per_wg, row_hi = min(nrows, row_lo + per_wg);
    const float* lng = p.ln_g + (layer * 2 + 0) * DM; const float* lnb = p.ln_b + (layer * 2 + 0) * DM;
    float rb[16];
#pragma unroll
    for (int e = 0; e < 16; ++e) rb[e] = p.rb[e];
    int curmod = -1; f32x4 gm[4], shf[4], scf[4];
    f32x4 v[4], y[4], vn[4], yn[4];
#define LNR_LOAD(tok_, V, Yv) do { if (layer) ld_row_bf16(XB + (size_t)(tok_) * DM, F.lane, V); else ld_row_f32((tok_) < NLAT ? p.x + (size_t)(tok_) * DM : p.ctx + (size_t)((tok_) - NLAT) * DM, F.lane, V); \
        ld_row_bf16(Y + (size_t)(tok_) * DM, F.lane, Yv); } while (0)
    if (row_lo + F.wave * per_w < row_hi) LNR_LOAD(row_lo + F.wave * per_w, v, y);
    for (int i = 0; i < per_w; ++i) {
        const int lr = F.wave * per_w + i, tok = row_lo + lr; if (tok >= row_hi) break;
        if (i + 1 < per_w && tok + 1 < row_hi) LNR_LOAD(tok + 1, vn, yn);
        const int mr = tok < NLAT ? tok / SEQ : 8;
        if (mr != curmod) { curmod = mr; ld_row_f32(MOD + mr * 6144 + 2048, F.lane, gm); ld_row_f32(MOD + mr * 6144 + 3072, F.lane, shf); ld_row_f32(MOD + mr * 6144 + 4096, F.lane, scf); }
        bf16* xdst = XB + (size_t)tok * DM;
#pragma unroll
        for (int j = 0; j < 4; ++j) v[j] = ALPHA * v[j] + gm[j] * y[j];
        ln_row(v, lng, lnb, F.lane);
        st_row_bf16(xdst, F.lane, v);
#pragma unroll
        for (int j = 0; j < 4; ++j) v[j] = v[j] * (1.f + scf[j]) + shf[j];
        st_row_fp8(HF + (size_t)tok * DM, F.lane, v);
        float part[16];
#pragma unroll
        for (int e = 0; e < 16; ++e) { float s = 0.f;
#pragma unroll
            for (int j = 0; j < 4; ++j) { const f32x4 w = *(const f32x4*)(WrT + e * 1024 + 4 * F.lane + 256 * j); s += (v[j].x * w.x + v[j].y * w.y) + (v[j].z * w.z + v[j].w * w.w); }
            part[e] = s; }
        {
#pragma unroll
            for (int e = 0; e < 8; ++e) { const bool up = (F.lane & 32) != 0; const float keep = up ? part[e + 8] : part[e], send = up ? part[e] : part[e + 8]; part[e] = keep + __shfl_xor(send, 32); }
#pragma unroll
            for (int e = 0; e < 4; ++e) { const bool up = (F.lane & 16) != 0; const float keep = up ? part[e + 4] : part[e], send = up ? part[e] : part[e + 4]; part[e] = keep + __shfl_xor(send, 16); }
#pragma unroll
            for (int e = 0; e < 2; ++e) { const bool up = (F.lane & 8) != 0; const float keep = up ? part[e + 2] : part[e], send = up ? part[e] : part[e + 2]; part[e] = keep + __shfl_xor(send, 8); }
            { const bool up = (F.lane & 4) != 0; const float keep = up ? part[1] : part[0], send = up ? part[0] : part[1]; part[0] = keep + __shfl_xor(send, 4); }
            part[0] += __shfl_xor(part[0], 2); part[0] += __shfl_xor(part[0], 1);
        }
        float aff[16], sel[16];
#pragma unroll
        for (int e = 0; e < 16; ++e) { const int src = ((e >> 3) & 1) * 32 + ((e >> 2) & 1) * 16 + ((e >> 1) & 1) * 8 + (e & 1) * 4; const float lg = __shfl(part[0], src); aff[e] = 1.f / (1.f + __expf(-lg)); sel[e] = aff[e] + rb[e]; }
        int bg = 0; float bgs = -3.0e38f;
#pragma unroll
        for (int g = 0; g < 4; ++g) { float m1 = -3.0e38f, m2 = -3.0e38f;
#pragma unroll
            for (int k = 0; k < 4; ++k) { const float s = sel[4 * g + k]; if (s > m1) { m2 = m1; m1 = s; } else if (s > m2) m2 = s; }
            const float gs = m1 + m2; if (gs > bgs) { bgs = gs; bg = g; } }
        int i1 = 0, i2 = 0; float s1 = -3.0e38f, s2 = -3.0e38f, a1 = 0.f, a2 = 0.f;
#pragma unroll
        for (int g = 0; g < 4; ++g) if (g == bg) {
#pragma unroll
            for (int k = 0; k < 4; ++k) { const float s = sel[4 * g + k], a = aff[4 * g + k];
                if (s > s1) { s2 = s1; i2 = i1; a2 = a1; s1 = s; i1 = 4 * g + k; a1 = a; } else if (s > s2) { s2 = s; i2 = 4 * g + k; a2 = a; } } }
        const float wsum = a1 + a2, w1 = a1 / wsum, w2 = a2 / wsum;
        if (F.lane == 0) { const unsigned l1 = atomicAdd(&lcnt[i1], 1u), l2 = atomicAdd(&lcnt[i2], 1u);
            rec[lr * 6 + 0] = i1; rec[lr * 6 + 1] = i2; rec[lr * 6 + 2] = (int)l1; rec[lr * 6 + 3] = (int)l2; rec[lr * 6 + 4] = __float_as_int(w1); rec[lr * 6 + 5] = __float_as_int(w2); }
#pragma unroll
        for (int j = 0; j < 4; ++j) { v[j] = vn[j]; y[j] = yn[j]; }
    }
#undef LNR_LOAD
    __syncthreads();
    if (F.tid < 16) lbase[F.tid] = __hip_atomic_fetch_add(&CNT[F.tid], lcnt[F.tid], __ATOMIC_RELAXED, __HIP_MEMORY_SCOPE_AGENT);
    __syncthreads();
    for (int lr = F.tid; lr < row_hi - row_lo; lr += NTHR) { const int tok = row_lo + lr;
        const int e0 = rec[lr * 6], e1 = rec[lr * 6 + 1]; const int p0 = (int)lbase[e0] + rec[lr * 6 + 2], p1 = (int)lbase[e1] + rec[lr * 6 + 3];
        LIST[e0 * NTOK + p0] = tok; LIST[e1 * NTOK + p1] = tok;
        int* tr = TOKR + (size_t)tok * 8; tr[0] = e0; tr[1] = p0; tr[2] = e1; tr[3] = p1; tr[4] = rec[lr * 6 + 4]; tr[5] = rec[lr * 6 + 5]; }
    __syncthreads();
}

__device__ __forceinline__ void pad_bases(const unsigned* cnt, int (&pb)[17]) {
    int acc = 0;
#pragma unroll
    for (int e = 0; e < 16; ++e) { pb[e] = acc; const int c = (int)__hip_atomic_load(cnt + e, __ATOMIC_RELAXED, __HIP_MEMORY_SCOPE_AGENT); acc += (c + 255) & ~255; }
    pb[16] = acc;
}

__device__ __forceinline__ void phase_moe_combine(const Frame& F, const Prm& p, int layer) {
    const int nrows = layer ? NLAT : NTOK;
    const float* MOD = (const float*)(p.ws + WS_MOD) + layer * 9 * 6144; const float* MOD1 = (const float*)(p.ws + WS_MOD) + 9 * 6144;
    const unsigned char* YM = p.ws + WS_YM;   unsigned char* H = p.ws + WS_H;   bf16* XB = (bf16*)(p.ws + WS_XB); const int* TOKR = (const int*)(p.ws + WS_TOKR);
    int pb[17]; pad_bases(F.ctl + CW_CNT + layer * 16, pb);
    int* pbl = (int*)F.lds; if (F.tid < 17) { int v = 0;
#pragma unroll
        for (int e = 0; e < 17; ++e) if (e == F.tid) v = pb[e];
        pbl[F.tid] = v; }
    __syncthreads();
    const float* lng = p.ln_g + (layer * 2 + 1) * DM; const float* lnb = p.ln_b + (layer * 2 + 1) * DM;
    const int gw = F.bid * NWAVES + F.wave, NGW = F.G * NWAVES, per = (nrows + NGW - 1) / NGW;
    int curmod = -1; f32x4 gf[4], sh1[4], sc1[4];
    typedef int i32x4r __attribute__((ext_vector_type(4)));
    const int t0 = gw * per, t1 = min(nrows, (gw + 1) * per);
    i32x4r ra = {0, 0, 0, 0}, rb = {0, 0, 0, 0}, rc = {0, 0, 0, 0}; f32x2 wa = {0.f, 0.f}, wb = {0.f, 0.f}, wc = {0.f, 0.f};
#define MC_REC(tok_, R, W) do { const int* tr_ = TOKR + (size_t)(tok_) * 8; R = *(const i32x4r*)tr_; W = *(const f32x2*)(tr_ + 4); } while (0)
#define MC_ROWS(tok_, R, V, A, B) do { ld_row_bf16(XB + (size_t)(tok_) * DM, F.lane, V); ld_row_fp8(YM + (size_t)(pbl[R.x] + R.y) * DM, F.lane, A); ld_row_fp8(YM + (size_t)(pbl[R.z] + R.w) * DM, F.lane, B); } while (0)
    f32x4 v[4], a[4], b[4], vn[4], an[4], bn[4];
    if (t0 < t1) { MC_REC(t0, ra, wa); if (t0 + 1 < t1) MC_REC(t0 + 1, rb, wb); MC_ROWS(t0, ra, v, a, b); }
    for (int tok = t0; tok < t1; ++tok) {
        if (tok + 1 < t1) MC_ROWS(tok + 1, rb, vn, an, bn);
        if (tok + 2 < t1) MC_REC(tok + 2, rc, wc);
        const int mr = tok < NLAT ? tok / SEQ : 8;
        if (mr != curmod) { curmod = mr; ld_row_f32(MOD + mr * 6144 + 5120, F.lane, gf); if (!layer) { ld_row_f32(MOD1 + mr * 6144, F.lane, sh1); ld_row_f32(MOD1 + mr * 6144 + 1024, F.lane, sc1); } }
        const float w0 = wa.x, w1 = wa.y;
        bf16* xp = XB + (size_t)tok * DM;
#pragma unroll
        for (int j = 0; j < 4; ++j) v[j] = ALPHA * v[j] + gf[j] * (w0 * a[j] + w1 * b[j]);
        ln_row(v, lng, lnb, F.lane);
        if (layer) st_row_f32(p.out + (size_t)tok * DM, F.lane, v); else st_row_bf16(xp, F.lane, v);
        if (!layer) {
#pragma unroll
            for (int j = 0; j < 4; ++j) v[j] = v[j] * (1.f + sc1[j]) + sh1[j];
            st_row_fp8(H + (size_t)tok * DM, F.lane, v);
        }
#pragma unroll
        for (int j = 0; j < 4; ++j) { v[j] = vn[j]; a[j] = an[j]; b[j] = bn[j]; }
        ra = rb; wa = wb; rb = rc; wb = wc;
    }
#undef MC_REC
#undef MC_ROWS
}

__device__ __forceinline__ void phase_gla_prep(const Frame& F, const Prm& p) {
    typedef short bf16x8v __attribute__((ext_vector_type(8))); typedef float f32x16v __attribute__((ext_vector_type(16)));
    const bf16* QR = (const bf16*)(p.ws + WS_QR); const bf16* KR = (const bf16*)(p.ws + WS_KR); const float* ZZ = (const float*)(p.ws + WS_ZZ);
    bf16* QT = (bf16*)(p.ws + WS_QT); bf16* KT = (bf16*)(p.ws + WS_KT); float* DEC = (float*)(p.ws + WS_DEC);
    const int gw = F.bid * NWAVES + F.wave, NGW = F.G * NWAVES, r = F.lane & 31, hh = F.lane >> 5;
    for (int task = gw; task < 2 * NCHUNK * 8; task += NGW) {
        const int dh = task & 7, chunk = (task >> 3) % NCHUNK, dir = __builtin_amdgcn_readfirstlane(task / (8 * NCHUNK));
        const int tok0 = chunk * 64;
        bf16x8v af[2], bfr[2];
#pragma unroll
        for (int tb = 0; tb < 2; ++tb) { const float* zp = ZZ + (size_t)(tok0 + 32 * tb + r) * 32 + dir * 16 + 8 * hh; const f32x4 z0 = *(const f32x4*)zp, z1 = *(const f32x4*)(zp + 4);
            u32x4 w; w.x = pk2(z0.x, z0.y); w.y = pk2(z0.z, z0.w); w.z = pk2(z1.x, z1.y); w.w = pk2(z1.z, z1.w); af[tb] = __builtin_bit_cast(bf16x8v, w); }
        float bgv[2];
#pragma unroll
        for (int cb = 0; cb < 2; ++cb) { const float* wp = p.gwg_up + (size_t)dir * 16 * 512 + (size_t)(8 * hh) * 512 + dh * 64 + 2 * r + cb; float wv[8];
#pragma unroll
            for (int i = 0; i < 8; ++i) wv[i] = wp[(size_t)i * 512];
            u32x4 w; w.x = pk2(wv[0], wv[1]); w.y = pk2(wv[2], wv[3]); w.z = pk2(wv[4], wv[5]); w.w = pk2(wv[6], wv[7]); bfr[cb] = __builtin_bit_cast(bf16x8v, w);
            bgv[cb] = p.gbg[dir * 512 + dh * 64 + 2 * r + cb]; }
        f32x16v Z[2][2];
#pragma unroll
        for (int tb = 0; tb < 2; ++tb)
#pragma unroll
            for (int cb = 0; cb < 2; ++cb) { const f32x16v zero = {}; Z[tb][cb] = __builtin_amdgcn_mfma_f32_32x32x16_bf16(af[tb], bfr[cb], zero, 0, 0, 0); }
#pragma unroll
        for (int tb = 0; tb < 2; ++tb)
#pragma unroll
            for (int cb = 0; cb < 2; ++cb)
#pragma unroll
                for (int i = 0; i < 16; ++i) { const float z = Z[tb][cb][i] + bgv[cb]; Z[tb][cb][i] = (fminf(z, 0.f) - __logf(1.f + __expf(-fabsf(z)))) * (1.f / 16.f); }
        float tot[2];
#pragma unroll
        for (int cb = 0; cb < 2; ++cb) {
            float T[2][4], PT[2][4];
            if (!dir) {
#pragma unroll
                for (int tb = 0; tb < 2; ++tb)
#pragma unroll
                    for (int gi = 0; gi < 4; ++gi) { float run = 0.f;
#pragma unroll
                        for (int w = 0; w < 4; ++w) { run += Z[tb][cb][4 * gi + w]; Z[tb][cb][4 * gi + w] = run; }
                        T[tb][gi] = run; }
            } else {
#pragma unroll
                for (int tb = 0; tb < 2; ++tb)
#pragma unroll
                    for (int gi = 0; gi < 4; ++gi) { float run = 0.f;
#pragma unroll
                        for (int w = 3; w >= 0; --w) { run += Z[tb][cb][4 * gi + w]; Z[tb][cb][4 * gi + w] = run; }
                        T[tb][gi] = run; }
            }
#pragma unroll
            for (int tb = 0; tb < 2; ++tb)
#pragma unroll
                for (int gi = 0; gi < 4; ++gi) PT[tb][gi] = __shfl_xor(T[tb][gi], 32);
            float running = 0.f;
            if (!dir) {
#pragma unroll
                for (int tb = 0; tb < 2; ++tb)
#pragma unroll
                    for (int gi = 0; gi < 4; ++gi) { const float first = hh ? PT[tb][gi] : T[tb][gi], second = hh ? T[tb][gi] : PT[tb][gi];
                        const float mine = hh ? running + first : running; running += first + second;
#pragma unroll
                        for (int w = 0; w < 4; ++w) Z[tb][cb][4 * gi + w] += mine; }
            } else {
#pragma unroll
                for (int tb = 1; tb >= 0; --tb)
#pragma unroll
                    for (int gi = 3; gi >= 0; --gi) { const float first = hh ? T[tb][gi] : PT[tb][gi], second = hh ? PT[tb][gi] : T[tb][gi];
                        const float mine = hh ? running : running + first; running += first + second;
#pragma unroll
                        for (int w = 0; w < 4; ++w) Z[tb][cb][4 * gi + w] += mine; }
            }
            tot[cb] = running;
        }
        if (hh == 0) {
#pragma unroll
            for (int cb = 0; cb < 2; ++cb) DEC[((size_t)dir * NCHUNK + chunk) * 512 + dh * 64 + 2 * r + cb] = __expf(tot[cb]);
        }
        const bf16* qi = QR + ((size_t)dh * NTOK + tok0) * 64 + 2 * r; const bf16* ki = KR + ((size_t)dh * NTOK + tok0) * 64 + 2 * r;
        bf16* qo = QT + (((size_t)dir * 8 + dh) * NTOK + tok0) * 64 + 2 * r; bf16* ko = KT + (((size_t)dir * 8 + dh) * NTOK + tok0) * 64 + 2 * r;
#pragma unroll
        for (int tb = 0; tb < 2; ++tb) {
            unsigned qv[16], kv[16];
#pragma unroll
            for (int i = 0; i < 16; ++i) { const int t = 32 * tb + (i & 3) + 8 * (i >> 2) + 4 * hh; qv[i] = *(const unsigned*)(qi + (size_t)t * 64); kv[i] = *(const unsigned*)(ki + (size_t)t * 64); }
#pragma unroll
            for (int i = 0; i < 16; ++i) { const int t = 32 * tb + (i & 3) + 8 * (i >> 2) + 4 * hh;
                const float e0 = __expf(Z[tb][0][i]), e1 = __expf(Z[tb][1][i]), i0 = __builtin_amdgcn_rcpf(e0), i1 = __builtin_amdgcn_rcpf(e1);
                *(unsigned*)(qo + (size_t)t * 64) = pk2(bf2f(qv[i] & 0xffffu) * e0, bf2f(qv[i] >> 16) * e1);
                *(unsigned*)(ko + (size_t)t * 64) = pk2(bf2f(kv[i] & 0xffffu) * i0, bf2f(kv[i] >> 16) * i1); }
        }
    }
}

__device__ __forceinline__ void phase_gla_post(const Frame& F, const Prm& p) {
    const bf16* OF = (const bf16*)p.out; const bf16* OB = (const bf16*)((const unsigned char*)p.out + OUT_OGB); const bf16* R = (const bf16*)(p.ws + WS_R); unsigned char* A2 = p.ws + WS_A2B;
    const f32x4 ng = *(const f32x4*)(p.gnorm + 4 * F.lane);
    const int gw = F.bid * NWAVES + F.wave, NGW = F.G * NWAVES;
    f32x4 a[4], b[4], r[4], an[4], bn[4], rn[4];
    if (gw < NLAT) { ld_row_bf16(OF + (size_t)gw * DM, F.lane, a); ld_row_bf16(OB + (size_t)gw * DM, F.lane, b); ld_row_bf16(R + (size_t)gw * DM, F.lane, r); }
    for (int tok = gw; tok < NLAT; tok += NGW) {
        if (tok + NGW < NLAT) { ld_row_bf16(OF + (size_t)(tok + NGW) * DM, F.lane, an); ld_row_bf16(OB + (size_t)(tok + NGW) * DM, F.lane, bn); ld_row_bf16(R + (size_t)(tok + NGW) * DM, F.lane, rn); }
#pragma unroll
        for (int j = 0; j < 4; ++j) {
            const f32x4 o = a[j] + b[j]; const float q = wave_sum((o.x * o.x + o.y * o.y) + (o.z * o.z + o.w * o.w));
            const float rs = 1.f / sqrtf(q * (1.f / 256.f) + LN_EPS);
            a[j] = (f32x4){o.x * rs * ng.x * silu_f(r[j].x), o.y * rs * ng.y * silu_f(r[j].y), o.z * rs * ng.z * silu_f(r[j].z), o.w * rs * ng.w * silu_f(r[j].w)};
        }
        st_row_fp8(A2 + (size_t)tok * DM, F.lane, a);
#pragma unroll
        for (int j = 0; j < 4; ++j) { a[j] = an[j]; b[j] = bn[j]; r[j] = rn[j]; }
    }
}
namespace pg8 {
typedef short bf16x8 __attribute__((ext_vector_type(8)));
constexpr int BM = 256, BK = 64, HALF = 128, HTB = HALF * BK * 2, STAGE_BYTES = 8 * HTB, NXCD = 8, WGM = 8;
__host__ __device__ __forceinline__ int lds_byte(int r, int c) { const int st = (r >> 4) * 2 + (c >> 5), rr = r & 15, cc = c & 31, ob = rr * 64 + cc * 2; return st * 1024 + (ob ^ (((ob >> 9) & 1) << 5)); }
__host__ __device__ __forceinline__ void stage_rc(int b, int& R, int& C) { const int st = b / 1024, sb = b % 1024, swz = sb ^ (((sb >> 9) & 1) << 5); R = (st >> 1) * 16 + swz / 64; C = (st & 1) * 32 + (swz % 64) / 2; }
typedef float f32x2_t __attribute__((ext_vector_type(2))); typedef __bf16 bf16x2_t __attribute__((ext_vector_type(2)));
__device__ __forceinline__ unsigned cvt_pk_bf16(float lo, float hi) { f32x2_t v = {lo, hi}; bf16x2_t b = __builtin_convertvector(v, bf16x2_t); return __builtin_bit_cast(unsigned, b); }

struct Unit { int pm, pn; int row0; int e; int cnt; const bf16* Bt; };

struct DenseOrder {
    int nM, nN, nwg, G, c, K; const bf16* Bt;
    __device__ void init(int M, int N, int K_, const bf16* Bt_, int G_, int c_) { nM = M / BM; nN = N / BM; nwg = nM * nN; G = G_; c = c_; K = K_; Bt = Bt_; }
    __device__ bool next(int i, Unit& u) const {
        const long L = (long)i * G + c; if (L >= nwg) return false;
        int wgid = (int)L; { const int q = nwg / NXCD, r = nwg % NXCD, xcd = wgid % NXCD, off = wgid / NXCD; wgid = (xcd < r ? xcd * (q + 1) : r * (q + 1) + (xcd - r) * q) + off; }
        const int nig = WGM * nN, gid = wgid / nig, fm = gid * WGM, gsz = (nM - fm) < WGM ? (nM - fm) : WGM;
        u.pm = fm + ((wgid % nig) % gsz); u.pn = (wgid % nig) / gsz; u.row0 = u.pm * BM; u.e = 0; u.cnt = 0; u.Bt = Bt; return true;
    }
    __device__ __forceinline__ unsigned arow(const Unit& u, int r) const { return (unsigned)(u.row0 + r) * (unsigned)(K * 2); }
};
template <bool GATHER> struct MoeOrder {
    int cnt[16]; int nN, G, c, K; const bf16* Bt0; size_t bstride; const int* LIST;
    __device__ void init(const unsigned* cntw, int N, int K_, const bf16* Bt0_, const int* LIST_, int G_, int c_) {
#pragma unroll
        for (int e = 0; e < 16; ++e) cnt[e] = (int)__hip_atomic_load(cntw + e, __ATOMIC_RELAXED, __HIP_MEMORY_SCOPE_AGENT);
        nN = N / BM; G = G_; c = c_; K = K_; Bt0 = Bt0_; bstride = (size_t)N * K_; LIST = LIST_; }
    __device__ bool next(int i, Unit& u) const {
        int L = i * G + c, base = 0; bool found = false; u.pm = 0; u.pn = 0; u.row0 = 0; u.e = 0; u.cnt = 0; u.Bt = Bt0;
#pragma unroll
        for (int e = 0; e < 16; ++e) { const int mt = (cnt[e] + 255) >> 8, nu = mt * nN;
            if (!found) { if (L < nu) { found = true; u.e = e; u.cnt = cnt[e]; u.pm = L / nN; u.pn = L % nN; u.row0 = base + u.pm * BM; u.Bt = Bt0 + (size_t)e * bstride; } else { L -= nu; base += mt * BM; } } }
        return found;
    }
    __device__ __forceinline__ unsigned arow(const Unit& u, int r) const {
        if (GATHER) { const int li = u.pm * BM + r; int tok = 0; if (li < u.cnt) tok = LIST[u.e * NTOK + li];
            return (unsigned)tok * (unsigned)(K * 2); }
        return (unsigned)(u.row0 + r) * (unsigned)(K * 2);
    }
};

typedef f32x4 Acc[2][2][4][2];
__device__ __forceinline__ void st4bf(bf16* p, f32x4 v) { u32x2 w; w.x = cvt_pk_bf16(v.x, v.y); w.y = cvt_pk_bf16(v.z, v.w); *(u32x2*)p = w; }
__device__ __forceinline__ void st8bf(bf16* p, f32x4 a, f32x4 b) { u32x4 w; w.x = cvt_pk_bf16(a.x, a.y); w.y = cvt_pk_bf16(a.z, a.w); w.z = cvt_pk_bf16(b.x, b.y); w.w = cvt_pk_bf16(b.z, b.w); *(u32x4*)p = w; }

struct EpiQKV {
    bf16 *Q; const LAS float* rope; float wsc; unsigned* km;
    __device__ __forceinline__ void operator()(const Acc& acc, const Unit& u, int wr, int wc, int fr, int fq) const {
        const int reg = u.pn >> 2; bf16* O = Q + (size_t)reg * ((WS_K - WS_Q) / 2);
        if (reg == 2) { const int cbase = (u.pn & 3) * BM + wc * 32 + 8 * fq;
#pragma unroll
            for (int ai = 0; ai < 2; ++ai)
#pragma unroll
                for (int m = 0; m < 4; ++m) { unsigned char* rowp = (unsigned char*)Q + (size_t)2 * (WS_K - WS_Q) + (size_t)(u.row0 + ai * HALF + wr * 64 + m * 16 + fr) * DM + cbase;
#pragma unroll
                    for (int bj = 0; bj < 2; ++bj) { const f32x4 a = acc[ai][bj][m][0] * wsc, b = acc[ai][bj][m][1] * wsc; u32x2 w; w.x = pk4_fp8(a.x, a.y, a.z, a.w); w.y = pk4_fp8(b.x, b.y, b.z, b.w); *(u32x2*)(rowp + bj * HALF) = w; } }
            return; }
        const int cbase = (u.pn & 3) * BM + wc * 32 + 8 * fq;
        const bool dorope = (u.row0 < NLAT); const float sc = (reg == 0 ? C2 : 1.f) * wsc; float kn[2] = {0.f, 0.f};
#pragma unroll
        for (int ai = 0; ai < 2; ++ai)
#pragma unroll
            for (int m = 0; m < 4; ++m) { const int row = u.row0 + ai * HALF + wr * 64 + m * 16 + fr; unsigned char* rowp = (unsigned char*)Q + (size_t)reg * (WS_K - WS_Q) + (size_t)row * DM + cbase;
                f32x4 cs = {1.f, 1.f, 1.f, 1.f}, sn = {0.f, 0.f, 0.f, 0.f};
                if (dorope) { const int s = row & (SEQ - 1), pos = (wc & 1) ? (s & 63) : (s >> 6); const f32x4 t0 = *(const LAS f32x4*)(rope + (pos * 16 + 4 * fq) * 2), t1 = *(const LAS f32x4*)(rope + (pos * 16 + 4 * fq) * 2 + 4);
                    cs = (f32x4){t0.x, t0.z, t1.x, t1.z}; sn = (f32x4){t0.y, t0.w, t1.y, t1.w}; }
                { f32x4 c2 = cs, s2 = sn;
#pragma unroll
                  for (int j = 0; j < 4; ++j) { float x0 = c2[j] * sc, x1 = s2[j] * sc; asm("" : "+v"(x0)); asm("" : "+v"(x1)); cs[j] = x0; sn[j] = x1; } }
#pragma unroll
                for (int bj = 0; bj < 2; ++bj) { const f32x4 a0 = acc[ai][bj][m][0], a1 = acc[ai][bj][m][1];
                    f32x4 o0, o1;
#pragma unroll
                    for (int j = 0; j < 4; ++j) { float x0 = __builtin_fmaf(-a1[j], sn[j], a0[j] * cs[j]), x1 = __builtin_fmaf(a0[j], sn[j], a1[j] * cs[j]); asm("" : "+v"(x0)); asm("" : "+v"(x1)); o0[j] = x0; o1[j] = x1; }
                    { u32x2 w; w.x = pk4_fp8(o0[0], o0[1], o0[2], o0[3]); w.y = pk4_fp8(o1[0], o1[1], o1[2], o1[3]); *(u32x2*)(rowp + bj * HALF) = w; }
                    if (reg == 1) { const float ps = (o0.x * o0.x + o0.y * o0.y) + (o0.z * o0.z + o0.w * o0.w) + (o1.x * o1.x + o1.y * o1.y) + (o1.z * o1.z + o1.w * o1.w);
                        kn[bj] = fmaxf(kn[bj], ps); } } }
        if (reg == 1) {
            const int b = u.row0 < NLAT ? u.row0 / SEQ : (u.row0 - NLAT) / CTXL;
#pragma unroll
            for (int bj = 0; bj < 2; ++bj) { float v = kn[bj];
#pragma unroll
                for (int s = 1; s < 64; s <<= 1) v = fmaxf(v, __shfl_xor(v, s));
                if (fr == 0 && fq == 0) __hip_atomic_fetch_max(km + b * 16 + 4 * (u.pn & 3) + 2 * bj + (wc >> 1), __float_as_uint(9.2f * v), __ATOMIC_RELAXED, __HIP_MEMORY_SCOPE_AGENT); } }
    }
};
struct EpiPlain {
    bf16* O; float sc;
    __device__ __forceinline__ void operator()(const Acc& acc, const Unit& u, int wr, int wc, int fr, int fq) const {
        const int cbase = u.pn * BM + wc * 32 + 8 * fq;
#pragma unroll
        for (int ai = 0; ai < 2; ++ai)
#pragma unroll
            for (int m = 0; m < 4; ++m) { bf16* rowp = O + (size_t)(u.row0 + ai * HALF + wr * 64 + m * 16 + fr) * DM + cbase;
#pragma unroll
                for (int bj = 0; bj < 2; ++bj) st8bf(rowp + bj * HALF, acc[ai][bj][m][0] * sc, acc[ai][bj][m][1] * sc); }
    }
};
struct EpiPlain8 {
    unsigned char* O; float sc;
    __device__ __forceinline__ void operator()(const Acc& acc, const Unit& u, int wr, int wc, int fr, int fq) const {
        const int cbase = u.pn * BM + wc * 32 + 8 * fq;
#pragma unroll
        for (int ai = 0; ai < 2; ++ai)
#pragma unroll
            for (int m = 0; m < 4; ++m) { unsigned char* rowp = O + (size_t)(u.row0 + ai * HALF + wr * 64 + m * 16 + fr) * DM + cbase;
#pragma unroll
                for (int bj = 0; bj < 2; ++bj) { const f32x4 a = acc[ai][bj][m][0] * sc, b = acc[ai][bj][m][1] * sc; u32x2 w; w.x = pk4_fp8(a.x, a.y, a.z, a.w); w.y = pk4_fp8(b.x, b.y, b.z, b.w); *(u32x2*)(rowp + bj * HALF) = w; } }
    }
};
struct EpiInproj {
    bf16 *QR, *KR, *V, *R; float* ZZ; float wsc;
    __device__ __forceinline__ void operator()(const Acc& acc, const Unit& u, int wr, int wc, int fr, int fq) const {
        const int pn = u.pn;
        if (pn == 12) { if (wc == 0) {
#pragma unroll
            for (int ai = 0; ai < 2; ++ai)
#pragma unroll
                for (int m = 0; m < 4; ++m) { float* rowp = ZZ + (size_t)(u.row0 + ai * HALF + wr * 64 + m * 16 + fr) * 32 + 4 * fq;
                    *(f32x4*)rowp = acc[ai][0][m][0] * wsc; *(f32x4*)(rowp + 16) = acc[ai][0][m][1] * wsc; } }
            return; }
        float sc = wsc;
        if (pn < 4) {
            bf16* O = pn < 2 ? QR : KR; if (pn < 2) sc = 0.08838834764831845f * wsc;
            const int cb = (pn & 1) * BM + wc * 32 + 8 * fq;
#pragma unroll
            for (int ai = 0; ai < 2; ++ai)
#pragma unroll
                for (int m = 0; m < 4; ++m) { const size_t row = (size_t)(u.row0 + ai * HALF + wr * 64 + m * 16 + fr);
#pragma unroll
                    for (int bj = 0; bj < 2; ++bj) { const int col = cb + bj * HALF; st8bf(O + ((size_t)(col >> 6) * NTOK + row) * 64 + (col & 63), acc[ai][bj][m][0] * sc, acc[ai][bj][m][1] * sc); } }
            return; }
        bf16* O; int c0;
        if (pn < 8) { O = V; c0 = (pn - 4) * BM; } else { O = R; c0 = (pn - 8) * BM; }
        const int cbase = c0 + wc * 32 + 8 * fq;
#pragma unroll
        for (int ai = 0; ai < 2; ++ai)
#pragma unroll
            for (int m = 0; m < 4; ++m) { bf16* rowp = O + (size_t)(u.row0 + ai * HALF + wr * 64 + m * 16 + fr) * DM + cbase;
#pragma unroll
                for (int bj = 0; bj < 2; ++bj) st8bf(rowp + bj * HALF, acc[ai][bj][m][0] * sc, acc[ai][bj][m][1] * sc); }
    }
};
struct EpiGateUp {
    unsigned char* ACT;
    __device__ __forceinline__ void operator()(const Acc& acc, const Unit& u, int wr, int wc, int fr, int fq) const {
        const int obase = u.pn * (BM / 2) + wc * 32 + 8 * fq;
#pragma unroll
        for (int ai = 0; ai < 2; ++ai)
#pragma unroll
            for (int m = 0; m < 4; ++m) { unsigned char* rowp = ACT + (size_t)(u.row0 + ai * HALF + wr * 64 + m * 16 + fr) * DEXP + obase; u32x2 w;
#pragma unroll
                for (int bj = 0; bj < 2; ++bj) { const f32x4 g = acc[ai][bj][m][0], up = acc[ai][bj][m][1]; f32x4 o;
#pragma unroll
                    for (int j = 0; j < 4; ++j) o[j] = g[j] * __builtin_amdgcn_rcpf(1.f + __expf(-g[j])) * up[j];
                    w[bj] = pk4_fp8(o[0], o[1], o[2], o[3]); }
                *(u32x2*)rowp = w; }
    }
};

typedef int i32x8 __attribute__((ext_vector_type(8)));
typedef int i32x4 __attribute__((ext_vector_type(4)));
__device__ __forceinline__ i32x8 cat8(bf16x8 lo, bf16x8 hi) { return __builtin_shufflevector(__builtin_bit_cast(i32x4, lo), __builtin_bit_cast(i32x4, hi), 0, 1, 2, 3, 4, 5, 6, 7); }
template <class Epi, class Sched, bool FP8 = false>
__device__ __forceinline__ void gemm_phase(unsigned char* ldsg, const bf16* A, int K, const Sched& S, const Epi& E, int tid_in) {
    LAS unsigned char* lds = (LAS unsigned char*)ldsg;
    const int tid = tid_in, wid = __builtin_amdgcn_readfirstlane(tid >> 6), lane = tid & 63, wr = wid >> 2, wc = wid & 3, fr = lane & 15, fq = lane >> 4;
    const int nt = K / BK;
    int Rr[2]; unsigned colb[2], voffB[2];
#pragma unroll
    for (int i = 0; i < 2; ++i) { int R, C; stage_rc(tid * 16 + i * 8192, R, C); Rr[i] = R; colb[i] = (unsigned)C * 2u; voffB[i] = (unsigned)(R * K + C) * 2u; }
    const size_t kstep = (size_t)(BK * 2);
    const size_t hstep = (size_t)HALF * K * 2;
    const size_t tstep = 2 * hstep;
    const unsigned ldsw = (unsigned)wid * 1024u;
    const int aoff = lds_byte(wr * 64 + fr, fq * 8), boff = lds_byte(wc * 32 + fr, fq * 8);
#define PG8_SA(b, h) (((b) * 2 + (h)) * HTB)
#define PG8_SB(b, h) ((4 + (b) * 2 + (h)) * HTB)
#define PG8_STAGE(bufoff, gbase, voff) do { _Pragma("unroll") for (int _i = 0; _i < 2; ++_i) \
        __builtin_amdgcn_global_load_lds((const unsigned*)((const char*)(gbase) + (voff)[_i]), (LAS unsigned*)(lds + (bufoff) + ldsw + _i * 8192), 16, 0, 0); } while (0)
#define PG8_LDA(dst, b, h) do { if constexpr (FP8) { _Pragma("unroll") for (int m = 0; m < 4; ++m) dst##8[m] = cat8(*(const LAS bf16x8*)(lds + PG8_SA(b, h) + aoff + m * 2048), *(const LAS bf16x8*)(lds + PG8_SA(b, h) + aoff + m * 2048 + 1024)); } \
        else { _Pragma("unroll") for (int m = 0; m < 4; ++m) _Pragma("unroll") for (int k = 0; k < 2; ++k) dst[m][k] = *(const LAS bf16x8*)(lds + PG8_SA(b, h) + aoff + m * 2048 + k * 1024); } } while (0)
#define PG8_LDB(dst, b, h) do { if constexpr (FP8) { _Pragma("unroll") for (int n = 0; n < 2; ++n) dst##8[n] = cat8(*(const LAS bf16x8*)(lds + PG8_SB(b, h) + boff + n * 2048), *(const LAS bf16x8*)(lds + PG8_SB(b, h) + boff + n * 2048 + 1024)); } \
        else { _Pragma("unroll") for (int n = 0; n < 2; ++n) _Pragma("unroll") for (int k = 0; k < 2; ++k) dst[n][k] = *(const LAS bf16x8*)(lds + PG8_SB(b, h) + boff + n * 2048 + k * 1024); } } while (0)
#define PG8_MMA(ai, bj, At, Bt) do { __builtin_amdgcn_s_setprio(1); \
        if constexpr (FP8) { _Pragma("unroll") for (int m = 0; m < 4; ++m) _Pragma("unroll") for (int n = 0; n < 2; ++n) \
            asm volatile("v_mfma_scale_f32_16x16x128_f8f6f4 %0, %1, %2, %0, %3, %3 op_sel:[0,1,0] op_sel_hi:[0,0,0]" : "+v"(acc[ai][bj][m][n]) : "v"(Bt##8[n]), "v"(At##8[m]), "v"(sc8)); } \
        else { _Pragma("unroll") for (int m = 0; m < 4; ++m) _Pragma("unroll") for (int n = 0; n < 2; ++n) _Pragma("unroll") for (int k = 0; k < 2; ++k) \
            acc[ai][bj][m][n] = __builtin_amdgcn_mfma_f32_16x16x32_bf16(Bt[n][k], At[m][k], acc[ai][bj][m][n], 0, 0, 0); } \
        __builtin_amdgcn_s_setprio(0); } while (0)
#define PG8_WAIT_V(n) asm volatile("s_waitcnt vmcnt(" #n ")" ::: "memory")
#define PG8_WAIT_L(n) asm volatile("s_waitcnt lgkmcnt(" #n ")" ::: "memory")
#define PG8_BAR __builtin_amdgcn_s_barrier()
#define PG8_SCHED __builtin_amdgcn_sched_barrier(0)
    Unit cur, nxt; int ui = 0;
    if (!S.next(0, cur)) return;
    Acc acc;
#pragma unroll
    for (int a = 0; a < 2; ++a)
#pragma unroll
        for (int b = 0; b < 2; ++b)
#pragma unroll
            for (int m = 0; m < 4; ++m)
#pragma unroll
                for (int n = 0; n < 2; ++n) acc[a][b][m][n] = (f32x4){0.f, 0.f, 0.f, 0.f};
    const int sc8 = 0x7f7f7f79;
    bf16x8 At[4][2], B0[2][2], B1[2][2]; i32x8 At8[4], B08[2], B18[2];
    unsigned aC0[2], aC1[2], aN0[2], aN1[2];
#pragma unroll
    for (int i = 0; i < 2; ++i) { aC0[i] = S.arow(cur, Rr[i]) + colb[i]; aC1[i] = S.arow(cur, HALF + Rr[i]) + colb[i]; }
    const char* Ab = (const char*)A;
    const char* cB = (const char*)cur.Bt + (size_t)cur.pn * tstep;
    PG8_STAGE(PG8_SB(0, 0), cB, voffB); PG8_STAGE(PG8_SB(0, 1), cB + hstep, voffB); PG8_STAGE(PG8_SA(0, 0), Ab, aC0); PG8_STAGE(PG8_SA(0, 1), Ab, aC1);
    if (wr == 1) PG8_BAR;
    PG8_WAIT_V(2); PG8_BAR;
    PG8_STAGE(PG8_SB(1, 0), cB + kstep, voffB); PG8_STAGE(PG8_SA(1, 0), Ab + kstep, aC0); PG8_STAGE(PG8_SB(1, 1), cB + hstep + kstep, voffB);
    PG8_WAIT_V(6); PG8_BAR;
    for (;;) {
        const bool has_next = S.next(ui + 1, nxt);
        if (has_next) {
#pragma unroll
            for (int i = 0; i < 2; ++i) { aN0[i] = S.arow(nxt, Rr[i]) + colb[i]; aN1[i] = S.arow(nxt, HALF + Rr[i]) + colb[i]; }
        } else {
#pragma unroll
            for (int i = 0; i < 2; ++i) { aN0[i] = aC0[i]; aN1[i] = aC1[i]; }
        }
        const char* nB = has_next ? (const char*)nxt.Bt + (size_t)nxt.pn * tstep : cB;
        for (int t = 0; t < nt; t += 2) {
            const bool last = (t == nt - 2);
            const char* a1 = Ab + (size_t)(t + 1) * kstep;
            const char* a2 = last ? Ab : Ab + (size_t)(t + 2) * kstep; const char* b2 = last ? nB : cB + (size_t)(t + 2) * kstep;
            const char* a3 = a2 + kstep; const char* b3 = b2 + kstep;
            unsigned x0[2], x1[2];
#pragma unroll
            for (int i = 0; i < 2; ++i) { x0[i] = last ? aN0[i] : aC0[i]; x1[i] = last ? aN1[i] : aC1[i]; }
            PG8_LDB(B0, 0, 0); PG8_LDB(B1, 0, 1); PG8_SCHED; PG8_LDA(At, 0, 0); PG8_STAGE(PG8_SA(1, 1), a1, aC1);
            PG8_WAIT_V(8); PG8_WAIT_L(0); PG8_BAR; PG8_MMA(0, 0, At, B0); PG8_MMA(0, 1, At, B1); PG8_BAR; PG8_SCHED;
            PG8_LDA(At, 0, 1); PG8_STAGE(PG8_SB(0, 0), b2, voffB); PG8_STAGE(PG8_SB(0, 1), b2 + hstep, voffB); PG8_STAGE(PG8_SA(0, 0), a2, x0);
            PG8_WAIT_V(8); PG8_WAIT_L(0); PG8_BAR; PG8_MMA(1, 0, At, B0); PG8_MMA(1, 1, At, B1); PG8_BAR; PG8_SCHED;
            PG8_LDB(B0, 1, 0); PG8_LDB(B1, 1, 1); PG8_SCHED; PG8_LDA(At, 1, 0); PG8_STAGE(PG8_SA(0, 1), a2, x1);
            PG8_WAIT_V(8); PG8_WAIT_L(0); PG8_BAR; PG8_MMA(0, 0, At, B0); PG8_MMA(0, 1, At, B1); PG8_BAR; PG8_SCHED;
            PG8_LDA(At, 1, 1); PG8_STAGE(PG8_SB(1, 0), b3, voffB); PG8_STAGE(PG8_SB(1, 1), b3 + hstep, voffB); PG8_STAGE(PG8_SA(1, 0), a3, x0);
            PG8_WAIT_V(8); PG8_WAIT_L(0); PG8_BAR; PG8_MMA(1, 0, At, B0); PG8_MMA(1, 1, At, B1); PG8_BAR; PG8_SCHED;
        }
        if (wr == 0) PG8_BAR;
        if constexpr (FP8) asm volatile("s_nop 15\n\ts_nop 7" ::: "memory");
        E(acc, cur, wr, wc, fr, fq);
        if (!has_next) break;
#pragma unroll
        for (int a = 0; a < 2; ++a)
#pragma unroll
            for (int b = 0; b < 2; ++b)
#pragma unroll
                for (int m = 0; m < 4; ++m)
#pragma unroll
                    for (int n = 0; n < 2; ++n) acc[a][b][m][n] = (f32x4){0.f, 0.f, 0.f, 0.f};
        cur = nxt; cB = nB; ++ui;
#pragma unroll
        for (int i = 0; i < 2; ++i) { aC0[i] = aN0[i]; aC1[i] = aN1[i]; }
        if (wr == 1) PG8_BAR;
    }
    PG8_WAIT_V(0);
    PG8_BAR;
#undef PG8_SA
#undef PG8_SB
#undef PG8_STAGE
#undef PG8_LDA
#undef PG8_LDB
#undef PG8_MMA
#undef PG8_WAIT_V
#undef PG8_WAIT_L
#undef PG8_BAR
#undef PG8_SCHED
}
}

__device__ __forceinline__ int vcu_of(const Frame& F) { return (F.G % 8 == 0) ? (F.bid % 8) * (F.G / 8) + F.bid / 8 : F.bid; }
__device__ __forceinline__ void phase_qkv_opt(const Frame& F, const Prm& p) {
    pg8::DenseOrder S; S.init(NTOK, 3072, 512, (const bf16*)(p.ws + WS_WQKV), F.G, F.bid);
    static_assert(WS_V - WS_K == WS_K - WS_Q, "Q|K|V equally spaced");
    LAS float* ropel = (LAS float*)((LAS unsigned char*)F.lds + LDSX_OFF);
    const float* ropeg = (const float*)(p.ws + WS_MISC) + 1024;
    for (int i = F.tid; i < 2048; i += NTHR) ropel[i] = ropeg[i];
    __syncthreads();
    pg8::EpiQKV E{(bf16*)(p.ws + WS_Q), ropel, 1.f, F.ctl + CW_KM};
    pg8::gemm_phase<pg8::EpiQKV, pg8::DenseOrder, true>(F.lds, (const bf16*)(p.ws + WS_H), 512, S, E, F.tid);
}
__device__ __forceinline__ void phase_wo_opt(const Frame& F, const Prm& p, int layer) {
    if (layer) {
        pg8::DenseOrder S; S.init(NLAT, 1024, 512, (const bf16*)(p.ws + WS_WGO), F.G, F.bid);
        pg8::EpiPlain E{(bf16*)(p.ws + WS_Y), 1.f};
        pg8::gemm_phase<pg8::EpiPlain, pg8::DenseOrder, true>(F.lds, (const bf16*)(p.ws + WS_A2B), 512, S, E, F.tid);
    } else {
        pg8::DenseOrder S; S.init(NTOK, 1024, 512, (const bf16*)(p.ws + WS_WO), F.G, F.bid);
        pg8::EpiPlain E{(bf16*)(p.ws + WS_Y), 1.f};
        pg8::gemm_phase<pg8::EpiPlain, pg8::DenseOrder, true>(F.lds, (const bf16*)(p.ws + WS_A2), 512, S, E, F.tid);
    }
}
__device__ __forceinline__ void phase_inproj_opt(const Frame& F, const Prm& p) {
    pg8::DenseOrder S; S.init(NTOK, NIN, 512, (const bf16*)(p.ws + WS_WIN), F.G, F.bid);
    pg8::EpiInproj E{(bf16*)(p.ws + WS_QR), (bf16*)(p.ws + WS_KR), (bf16*)(p.ws + WS_V1), (bf16*)(p.ws + WS_R), (float*)(p.ws + WS_ZZ), 1.f};
    pg8::gemm_phase<pg8::EpiInproj, pg8::DenseOrder, true>(F.lds, (const bf16*)(p.ws + WS_H), 512, S, E, F.tid);
}
__device__ __forceinline__ void phase_moe1_opt(const Frame& F, const Prm& p, int layer) {
    pg8::MoeOrder<true> S; S.init(F.ctl + CW_CNT + layer * 16, 1024, 512, (const bf16*)(p.ws + (layer ? WS_GU1 : WS_GU0)), (const int*)(p.ws + WS_LIST), F.G, vcu_of(F));
    pg8::EpiGateUp E{p.ws + WS_ACT};
    pg8::gemm_phase<pg8::EpiGateUp, pg8::MoeOrder<true>, true>(F.lds, (const bf16*)(p.ws + WS_H), 512, S, E, F.tid);
}
__device__ __forceinline__ void phase_moe2_opt(const Frame& F, const Prm& p, int layer) {
    pg8::MoeOrder<false> S; S.init(F.ctl + CW_CNT + layer * 16, 1024, 256, (const bf16*)(p.ws + (layer ? WS_DN1 : WS_DN0)), nullptr, F.G, vcu_of(F));
    pg8::EpiPlain8 E{p.ws + WS_YM, 1.f};
    pg8::gemm_phase<pg8::EpiPlain8, pg8::MoeOrder<false>, true>(F.lds, (const bf16*)(p.ws + WS_ACT), 256, S, E, F.tid);
}
namespace attn_body {
using bf16=unsigned short;
using bf16x8=__attribute__((ext_vector_type(8)))short;
using s16x4=__attribute__((ext_vector_type(4)))short;
using f32x16=__attribute__((ext_vector_type(16)))float;
using u32x4=__attribute__((ext_vector_type(4)))unsigned;
constexpr int D=64,DM=1024;
constexpr int NW=8,QBLK=32,QB=QBLK*NW,KVBLK=64;
constexpr int ATTN_PITCH=DM, ATTN_UNIT_ROWS=QB;
__device__ __forceinline__ int crow(int r,int hi){return (r&3)+8*(r>>2)+4*hi;}
#define SBAR() __builtin_amdgcn_sched_barrier(0)

constexpr int NSLOT=3, SLOTB=8192;
constexpr int LDS_K=0, LDS_V=NSLOT*SLOTB, LDS_WS=2*NSLOT*SLOTB, LDS_OST=LDS_WS+NW*64*4, LDS_BYTES=LDS_OST+NW*4096;
constexpr float C2=0.125f*1.4426950408889634f;
__device__ __forceinline__ void glds16(const void*gsrc,unsigned lds_dst){unsigned keep;
  asm volatile("s_mov_b32 %0, m0\n\ts_mov_b32 m0, %2\n\ts_nop 0\n\tglobal_load_lds_dwordx4 %1, off\n\ts_mov_b32 m0, %0":"=&s"(keep):"v"(gsrc),"s"(lds_dst):"memory");}
__device__ __forceinline__ void glds16s(const void*sbase,unsigned voff,unsigned lds_dst){unsigned keep;
  asm volatile("s_mov_b32 %0, m0\n\ts_mov_b32 m0, %3\n\ts_nop 0\n\tglobal_load_lds_dwordx4 %1, %2\n\ts_mov_b32 m0, %0":"=&s"(keep):"v"(voff),"s"(sbase),"s"(lds_dst):"memory");}
__device__ __forceinline__ void glds16s128(const void*sbase,unsigned voff,unsigned lds_dst){unsigned keep;
  asm volatile("s_mov_b32 %0, m0\n\ts_mov_b32 m0, %3\n\ts_nop 0\n\tglobal_load_lds_dwordx4 %1, %2 offset:128\n\ts_mov_b32 m0, %0":"=&s"(keep):"v"(voff),"s"(sbase),"s"(lds_dst):"memory");}
__device__ __forceinline__ float max3f(float a,float b,float c){float r;asm("v_max3_f32 %0, %1, %2, %3":"=v"(r):"v"(a),"v"(b),"v"(c));return r;}
__device__ __forceinline__ float max2f(float a,float b){float r;asm("v_max_f32_e32 %0, %1, %2":"=v"(r):"v"(a),"v"(b));return r;}
__device__ __forceinline__ float fadd_s(float a,float b){float r;asm("v_add_f32_e32 %0, %1, %2":"=v"(r):"v"(a),"v"(b));return r;}
__device__ __forceinline__ float fsub_s(float a,float b){float r;asm("v_sub_f32_e32 %0, %1, %2":"=v"(r):"v"(a),"v"(b));return r;}
typedef float f32x2_t __attribute__((ext_vector_type(2))); typedef __bf16 bf16x2_t __attribute__((ext_vector_type(2)));
__device__ __forceinline__ unsigned cvtpk_s(float lo,float hi){f32x2_t v={lo,hi};bf16x2_t b=__builtin_convertvector(v,bf16x2_t);return __builtin_bit_cast(unsigned,b);}
#define WAIT_BAR(N) asm volatile("s_waitcnt vmcnt(" #N ") lgkmcnt(0)\n\ts_barrier":::"memory")

__device__ __forceinline__ void qkt(f32x16&p0,f32x16&p1,const char*Kslot,const bf16x8*qr,const f32x16&negm,int r32,int hi){
  const char*kb=Kslot+hi*1024+r32*16;
  #pragma unroll
  for(int d0=0;d0<4;++d0){
    const bf16x8 b0=*reinterpret_cast<const bf16x8*>(kb+d0*2048);
    const bf16x8 b1=*reinterpret_cast<const bf16x8*>(kb+d0*2048+512);
    if(d0==0){p0=__builtin_amdgcn_mfma_f32_32x32x16_bf16(b0,qr[0],negm,0,0,0);p1=__builtin_amdgcn_mfma_f32_32x32x16_bf16(b1,qr[0],negm,0,0,0);}
    else{p0=__builtin_amdgcn_mfma_f32_32x32x16_bf16(b0,qr[d0],p0,0,0,0);p1=__builtin_amdgcn_mfma_f32_32x32x16_bf16(b1,qr[d0],p1,0,0,0);}}
}
typedef __attribute__((address_space(3))) const char* lds_cptr;
typedef short v4i16_t __attribute__((ext_vector_type(4)));
__device__ __forceinline__ void kload8(bf16x8*kf,lds_cptr kp){
  kf[0]=*(const __attribute__((address_space(3))) bf16x8*)(kp);      kf[1]=*(const __attribute__((address_space(3))) bf16x8*)(kp+512);
  kf[2]=*(const __attribute__((address_space(3))) bf16x8*)(kp+2048); kf[3]=*(const __attribute__((address_space(3))) bf16x8*)(kp+2560);
  kf[4]=*(const __attribute__((address_space(3))) bf16x8*)(kp+4096); kf[5]=*(const __attribute__((address_space(3))) bf16x8*)(kp+4608);
  kf[6]=*(const __attribute__((address_space(3))) bf16x8*)(kp+6144); kf[7]=*(const __attribute__((address_space(3))) bf16x8*)(kp+6656);
}
__device__ __forceinline__ void kload2(bf16x8*kf,lds_cptr kp,int j){ kf[2*j]=*(const __attribute__((address_space(3))) bf16x8*)(kp+j*2048); kf[2*j+1]=*(const __attribute__((address_space(3))) bf16x8*)(kp+j*2048+512); }
__device__ __forceinline__ s16x4 vtr(lds_cptr p){ return __builtin_bit_cast(s16x4,__builtin_amdgcn_ds_read_tr16_b64_v4i16((__attribute__((address_space(3))) v4i16_t*)p)); }
typedef int i32x8 __attribute__((ext_vector_type(8)));
typedef int i32x4a __attribute__((ext_vector_type(4)));
__device__ __forceinline__ i32x8 cat8i(i32x4a lo,i32x4a hi){return __builtin_shufflevector(lo,hi,0,1,2,3,4,5,6,7);}
__device__ __forceinline__ f32x16 mfq8(i32x8 kf,i32x8 q){f32x16 c;asm volatile("v_mfma_f32_32x32x64_f8f6f4 %0, %1, %2, 0":"=&v"(c):"v"(kf),"v"(q));return c;}
__device__ __forceinline__ void kload4(i32x4a*kq,lds_cptr kp){
  kq[0]=*(const __attribute__((address_space(3))) i32x4a*)(kp);      kq[1]=*(const __attribute__((address_space(3))) i32x4a*)(kp+1024);
  kq[2]=*(const __attribute__((address_space(3))) i32x4a*)(kp+2048); kq[3]=*(const __attribute__((address_space(3))) i32x4a*)(kp+3072);}
__device__ __forceinline__ void glds16s_lo(const void*sbase,unsigned voff,unsigned lds_dst){unsigned keep;
  asm volatile("s_mov_b32 %0, m0\n\ts_mov_b32 m0, %3\n\ts_mov_b32 exec_hi, 0\n\tglobal_load_lds_dwordx4 %1, %2\n\ts_mov_b32 exec_hi, -1\n\ts_mov_b32 m0, %0":"=&s"(keep):"v"(voff),"s"(sbase),"s"(lds_dst):"memory");}
__device__ __forceinline__ float rowmax(const f32x16&p0,const f32x16&p1){
  float a=max3f(p0[0],p0[1],p1[0]),b=max3f(p0[2],p0[3],p1[1]);a=max3f(a,p1[2],p1[3]);
  #pragma unroll
  for(int r=4;r<16;r+=4){a=max3f(a,p0[r],p0[r+1]);b=max3f(b,p0[r+2],p0[r+3]);a=max3f(a,p1[r],p1[r+1]);b=max3f(b,p1[r+2],p1[r+3]);}
  const float m=max2f(a,b);
  auto rr=__builtin_amdgcn_permlane32_swap(__float_as_uint(m),__float_as_uint(m),false,false);
  return max2f(__uint_as_float(rr[0]),__uint_as_float(rr[1]));
}
#undef SBAR
#undef WAIT_BAR
#undef KVROW
}
namespace attn_body {
constexpr int V2SLOT = 16384;
constexpr int L2_K = 0, L2_V = NSLOT * SLOTB, L2_WS = L2_V + NSLOT * V2SLOT, L2_ST = L2_WS + NW * 64 * 4, L2_BYTES = L2_ST + NW * 8192;
#define SBAR() __builtin_amdgcn_sched_barrier(0)
#define WAIT_BAR(N) asm volatile("s_waitcnt vmcnt(" #N ") lgkmcnt(0)\n\ts_barrier":::"memory")
typedef int i32x2a __attribute__((ext_vector_type(2)));
__device__ __forceinline__ i32x2a vtr8(lds_cptr p){ return __builtin_amdgcn_ds_read_tr8_b64_v2i32((__attribute__((address_space(3))) i32x2a*)p); }
template<int THRL,bool OPT> __device__ __forceinline__ int attn_unit2(long qrow0,int qcol,int vcol,long kctx,long klat,int NT,const bf16*Q,const bf16*__restrict__ K,const bf16*__restrict__ V,int m,const float*lamp,const float*subln,unsigned char*A2,int acol,float km,char*shm,int wid_s,unsigned*ovf){
  int lane_u; asm volatile("v_mbcnt_lo_u32_b32 %0, -1, 0\n\tv_mbcnt_hi_u32_b32 %0, -1, %0":"=v"(lane_u));
  const int lane=lane_u,r32=lane&31,hi=lane>>5; const int wid=wid_s;
  const unsigned char*Qw8=(const unsigned char*)Q+(qrow0+wid*QBLK)*1024+qcol;
  const unsigned char*Kh8=(const unsigned char*)K+qcol; const unsigned char*Vh8=(const unsigned char*)V+vcol;
  const unsigned lds0=(unsigned)(uintptr_t)shm;
  float*wsf=(float*)(shm+L2_WS)+wid*64;
  const unsigned wsf_lds=(unsigned)(lds0+L2_WS+wid*256);
  const unsigned koff=(unsigned)((32*(wid>>2)+(lane&31))*1024+32*(wid&1)+16*((wid>>1)&1));
  const int vpos=32*(wid&1)+(lane>>1); const int vkey=16*(vpos>>4)+4*((vpos>>3)&1)+(vpos&3)+8*((vpos>>2)&1);
  const unsigned voff=(unsigned)(vkey*1024+32*(wid>>1)+16*(lane&1));
  const unsigned kdst=lds0+L2_K+wid*512, vdst=lds0+L2_V+wid*1024;
  #define KVROW(t) ((t)<NT-4?klat+(long)(t)*KVBLK:kctx+(long)((t)-(NT-4))*KVBLK)
  #define DMA_K(t,slot) glds16s_lo(Kh8+KVROW(t)*1024,koff,(unsigned)(kdst+(slot)))
  #define DMA_V(t,slot) glds16s(Vh8+KVROW(t)*1024,voff,(unsigned)(vdst+2*(slot)))
  i32x4a kq[4];
  const lds_cptr shm3=(lds_cptr)shm; const lds_cptr kp0=shm3+L2_K+hi*512+r32*16;
  const lds_cptr vp0=shm3+L2_V+(8*hi+((lane&15)>>1))*32+16*((lane>>4)&1)+8*(lane&1);
  DMA_K(0,0);DMA_V(0,0);DMA_K(1,SLOTB);
  i32x8 q8; { const i32x4a qa=*reinterpret_cast<const i32x4a*>(Qw8+(long)r32*1024+hi*32),qb=*reinterpret_cast<const i32x4a*>(Qw8+(long)r32*1024+hi*32+16); q8=cat8i(qa,qb); }
  bool FAST; { float qn=0.f;
    #pragma unroll
    for(int i=0;i<8;++i){ const f32x2_t lo=__builtin_amdgcn_cvt_pk_f32_fp8(q8[i],false),h2=__builtin_amdgcn_cvt_pk_f32_fp8(q8[i],true); qn+=(lo[0]*lo[0]+lo[1]*lo[1])+(h2[0]*h2[0]+h2[1]*h2[1]); }
    { auto rq=__builtin_amdgcn_permlane32_swap(__float_as_uint(qn),__float_as_uint(qn),false,false); qn=__uint_as_float(rq[0])+__uint_as_float(rq[1]); } FAST=__all(qn*km<=96.f*96.f)!=0; }
  float scl=1.f;
  float mhat=0.f;f32x16 o[4];o[0]=f32x16{};o[1]=f32x16{};o[2]=f32x16{};o[3]=f32x16{};
  f32x16 lacc=f32x16{};
  const i32x8 ones8={0x38383838,0x38383838,0x38383838,0x38383838,0x38383838,0x38383838,0x38383838,0x38383838};
  bool resc=false;
  #define RESC() do{ if(!OPT&&resc){ asm volatile("s_nop 15\n\ts_nop 3\n\ts_waitcnt lgkmcnt(0)":::"memory"); \
      int l3_=lane; asm volatile("":"+v"(l3_)); const int hi3_=l3_>>5; \
      _Pragma("unroll") for(int r=0;r<16;++r){ const float f_=wsf[crow(r,hi3_)]; o[0][r]*=f_; o[1][r]*=f_; o[2][r]*=f_; o[3][r]*=f_; lacc[r]*=f_; } } }while(0)
  int sl_prev=0,sl_cur=0,sl_next=SLOTB;
  #define ROT() do{sl_prev=sl_cur;sl_cur=sl_next;sl_next=(sl_next==(NSLOT-1)*SLOTB)?0:sl_next+SLOTB;}while(0)
  DMA_K(2,2*SLOTB);
  WAIT_BAR(3);
  #define EX(v) __builtin_amdgcn_exp2f(v)
  #define PK8(old,a,b,hs) __builtin_amdgcn_cvt_pk_fp8_f32((a),(b),(old),(hs))
  i32x8 pwA,pwB;
  { f32x16 p0,p1;
    kload4(kq,kp0); p0=mfq8(cat8i(kq[0],kq[1]),q8); p1=mfq8(cat8i(kq[2],kq[3]),q8); asm volatile("s_nop 15\n\ts_nop 7":"+v"(p0),"+v"(p1));
    const float rm=__builtin_ceilf(rowmax(p0,p1))+(OPT?4.f:0.f); mhat=rm; typedef short v2i16_t __attribute__((ext_vector_type(2)));
    if(OPT||FAST){ scl=EX(rm);
      #pragma unroll
      for(int r=0;r<16;++r){ p0[r]=EX(p0[r]); p1[r]=EX(p1[r]); }
      #pragma unroll
      for(int w=0;w<4;++w){ v2i16_t a={0,0},b={0,0}; a=__builtin_amdgcn_cvt_scalef32_pk_fp8_f32(a,p0[4*w],p0[4*w+1],scl,false); a=__builtin_amdgcn_cvt_scalef32_pk_fp8_f32(a,p0[4*w+2],p0[4*w+3],scl,true);
        b=__builtin_amdgcn_cvt_scalef32_pk_fp8_f32(b,p1[4*w],p1[4*w+1],scl,false); b=__builtin_amdgcn_cvt_scalef32_pk_fp8_f32(b,p1[4*w+2],p1[4*w+3],scl,true); pwA[w]=__builtin_bit_cast(int,a); pwA[4+w]=__builtin_bit_cast(int,b); }
    } else {
      #pragma unroll
      for(int r=0;r<16;++r){ p0[r]=EX(p0[r]-rm); p1[r]=EX(p1[r]-rm); }
      #pragma unroll
      for(int w=0;w<4;++w){ int a=0,b=0; a=PK8(a,p0[4*w],p0[4*w+1],false); a=PK8(a,p0[4*w+2],p0[4*w+3],true); b=PK8(b,p1[4*w],p1[4*w+1],false); b=PK8(b,p1[4*w+2],p1[4*w+3],true); pwA[w]=a; pwA[4+w]=b; } }
    }
  WAIT_BAR(0);
  DMA_K(3,0);DMA_V(1,SLOTB);
  ROT();
  kload4(kq,kp0+sl_cur);
  WAIT_BAR(2);
  i32x2a vA[4],vB[4];
  #define VF8(A) (i32x8){A[0][0],A[0][1],A[1][0],A[1][1],A[2][0],A[2][1],A[3][0],A[3][1]}
  #define PIN(x) asm volatile("":"+v"(x))
  #define MX3(a,b,c) __builtin_fmaxf(__builtin_fmaxf((a),(b)),(c))
  #define VR4(A,d) do{ A[0]=vtr8(vp_+(d)*2048); A[1]=vtr8(vp_+(d)*2048+512); A[2]=vtr8(vp_+(d)*2048+1024); A[3]=vtr8(vp_+(d)*2048+1536); }while(0)
  #define MFO8(d,PW,A) asm volatile("s_nop 1\n\tv_mfma_f32_32x32x64_f8f6f4 %0, %1, %2, %0":"+v"(o[d]):"v"(PW),"v"(VF8(A)))
  #define MFOL(PW) asm volatile("s_nop 1\n\tv_mfma_f32_32x32x64_f8f6f4 %0, %1, %2, %0":"+v"(lacc):"v"(PW),"v"(ones8))
  #define KRD(G,j) do{ if(G){ kq[j]=*(const __attribute__((address_space(3))) i32x4a*)(kp0+sl_next+(j)*1024); } }while(0)
  #define SM8(X,B,PO,W) do{ _Pragma("unroll") for(int j_=0;j_<8;++j_){ X[(B)+j_]=EX(X[(B)+j_]-mhat); } \
      { int a_=0,b_=0; a_=PK8(a_,X[(B)],X[(B)+1],false); a_=PK8(a_,X[(B)+2],X[(B)+3],true); b_=PK8(b_,X[(B)+4],X[(B)+5],false); b_=PK8(b_,X[(B)+6],X[(B)+7],true); PO[W]=a_; PO[(W)+1]=b_; } }while(0)
  #define SM8F(X,B,PO,W) do{ _Pragma("unroll") for(int j_=0;j_<8;++j_){ X[(B)+j_]=EX(X[(B)+j_]); } \
      { typedef short v2i16_t __attribute__((ext_vector_type(2))); v2i16_t a_=__builtin_bit_cast(v2i16_t,PO[W]),b_=__builtin_bit_cast(v2i16_t,PO[(W)+1]); \
        a_=__builtin_amdgcn_cvt_scalef32_pk_fp8_f32(a_,X[(B)],X[(B)+1],scl,false); a_=__builtin_amdgcn_cvt_scalef32_pk_fp8_f32(a_,X[(B)+2],X[(B)+3],scl,true); \
        b_=__builtin_amdgcn_cvt_scalef32_pk_fp8_f32(b_,X[(B)+4],X[(B)+5],scl,false); b_=__builtin_amdgcn_cvt_scalef32_pk_fp8_f32(b_,X[(B)+6],X[(B)+7],scl,true); \
        PO[W]=__builtin_bit_cast(int,a_); PO[(W)+1]=__builtin_bit_cast(int,b_); } }while(0)
  #define STEP2(t,PI,PO,GK,GV,GL,SMX,FV) do{ SBAR(); \
    const lds_cptr vp_=vp0+2*sl_prev; f32x16 C0,C1; \
    VR4(vA,0); SBAR(); C0=mfq8(cat8i(kq[0],kq[1]),q8); SBAR(); \
    VR4(vB,1); SBAR(); C1=mfq8(cat8i(kq[2],kq[3]),q8); SBAR(); \
    if(GK){DMA_K((t)+3,sl_cur);} if(GV){DMA_V((t)+1,sl_next);} \
    asm volatile("s_nop 15\n\ts_nop 3":"+v"(C0),"+v"(C1));   \
    if constexpr(!OPT){ float a=MX3(C0[0],C0[1],C1[0]),b=MX3(C0[2],C0[3],C1[1]); a=MX3(a,C1[2],C1[3]); \
      _Pragma("unroll") for(int r=4;r<16;r+=4){a=MX3(a,C0[r],C0[r+1]);b=MX3(b,C0[r+2],C0[r+3]);a=MX3(a,C1[r],C1[r+1]);b=MX3(b,C1[r+2],C1[r+3]);} \
      float rm=__builtin_fmaxf(a,b); { auto rr=__builtin_amdgcn_permlane32_swap(__float_as_uint(rm),__float_as_uint(rm),false,false); rm=__builtin_fmaxf(__uint_as_float(rr[0]),__uint_as_float(rr[1])); } \
      resc=false; \
      if(__builtin_expect(__any(rm-mhat>(float)THRL),0)){ const float dl=__builtin_fmaxf(__builtin_ceilf(rm-mhat)-(THRL?6.f:0.f),0.f); mhat+=dl;   \
        const float f=__builtin_amdgcn_exp2f(-dl); if(FV){ scl=EX(mhat); } { unsigned keep_; asm volatile("s_mov_b32 %0, m0\n\ts_mov_b32 m0, %2\n\ts_nop 0\n\tds_write_addtid_b32 %1\n\ts_mov_b32 m0, %0":"=&s"(keep_):"v"(f),"s"(wsf_lds):"memory"); } resc=true; } } \
    __builtin_amdgcn_s_setprio(1); SBAR(); \
    MFO8(0,PI,vA); SMX(C0,0,PO,0); VR4(vA,2); SBAR(); \
    MFO8(1,PI,vB); SMX(C0,8,PO,2); VR4(vB,3); SBAR(); \
    MFO8(2,PI,vA); SMX(C1,0,PO,4); KRD(GL,0); KRD(GL,1); SBAR(); \
    MFO8(3,PI,vB); SMX(C1,8,PO,6); KRD(GL,2); KRD(GL,3); SBAR(); \
    MFOL(PI); __builtin_amdgcn_s_setprio(0); \
    }while(0)
  #define ENDW(tt) do{ if((tt)+3<NT){WAIT_BAR(2);} else {WAIT_BAR(0);} }while(0)
  #define LOOPS(SMX,FV) do{ int t=1; \
    for(;t+5<NT;t+=2){ \
      STEP2(t,  pwA,pwB,true,true,true,SMX,FV); WAIT_BAR(2); RESC(); ROT(); \
      STEP2(t+1,pwB,pwA,true,true,true,SMX,FV); WAIT_BAR(2); RESC(); ROT(); \
    } \
    for(;t+1<NT;t+=2){ \
      STEP2(t,  pwA,pwB,(t+3<NT),(t+1<NT),(t+1<NT),SMX,FV); ENDW(t);   RESC(); ROT(); \
      STEP2(t+1,pwB,pwA,(t+4<NT),(t+2<NT),(t+2<NT),SMX,FV); ENDW(t+1); RESC(); ROT(); \
    } \
    STEP2(NT-1,pwA,pwB,false,false,false,SMX,FV); RESC(); }while(0)
  if constexpr(OPT){ LOOPS(SM8F,true); } else { if(FAST){ LOOPS(SM8F,true); } else { LOOPS(SM8,false); } }
  #undef LOOPS
  { const lds_cptr vp_=vp0+2*sl_cur;
    VR4(vA,0); VR4(vB,1); MFO8(0,pwB,vA); MFO8(1,pwB,vB); VR4(vA,2); VR4(vB,3); MFO8(2,pwB,vA); MFO8(3,pwB,vB); MFOL(pwB);
    asm volatile("s_nop 15\n\ts_nop 7":"+v"(o[0]),"+v"(o[1]),"+v"(o[2]),"+v"(o[3]),"+v"(lacc)); }
  if constexpr(OPT){ float bad=lacc[0]; _Pragma("unroll") for(int r=1;r<16;++r)bad+=lacc[r];
    if(__any(!(__builtin_fabsf(bad)<3.0e38f))||!FAST){ *ovf=1u; } }
  { int lane_l=lane; asm volatile("":"+v"(lane_l));
  { const int lane=lane_l,r32=lane&31,hi=lane>>5;
  float rli[16];
  #pragma unroll
  for(int r=0;r<16;++r)rli[r]=__builtin_amdgcn_rcpf(lacc[r]);
  unsigned short*stash=(unsigned short*)(shm+L2_ST)+wid*4096;
  if(m==0){
    #pragma unroll
    for(int d0=0;d0<4;++d0){
      #pragma unroll
      for(int r=0;r<16;++r)stash[(d0*16+r)*64+lane]=(unsigned short)f2bf(o[d0][r]*rli[r]);}
    asm volatile("s_waitcnt lgkmcnt(0)":::"memory");
  } else {
    const float lam=__uint_as_float(__hip_atomic_load((const unsigned*)lamp,__ATOMIC_RELAXED,__HIP_MEMORY_SCOPE_AGENT));
    float ss[16];
    #pragma unroll
    for(int r=0;r<16;++r)ss[r]=0.f;
    #pragma unroll
    for(int d0=0;d0<4;++d0){
      #pragma unroll
      for(int r=0;r<16;++r){ const float o1=bf2f(stash[(d0*16+r)*64+lane]); const float df=o1-lam*(o[d0][r]*rli[r]); o[d0][r]=df; ss[r]+=df*df; } }
    #pragma unroll
    for(int r=0;r<16;++r){ float q=ss[r];
      q+=__int_as_float(__builtin_amdgcn_ds_swizzle(__float_as_int(q),0x41f));
      q+=__int_as_float(__builtin_amdgcn_ds_swizzle(__float_as_int(q),0x81f));
      q+=__int_as_float(__builtin_amdgcn_ds_swizzle(__float_as_int(q),0x101f));
      q+=__int_as_float(__builtin_amdgcn_ds_swizzle(__float_as_int(q),0x201f));
      q+=__int_as_float(__builtin_amdgcn_ds_swizzle(__float_as_int(q),0x401f));
      ss[r]=(1.f-LAMBDA_INIT0)/sqrtf(q*(1.f/128.f)+LN_EPS); }
    asm volatile("s_waitcnt lgkmcnt(0)":::"memory");
    unsigned char*stg=(unsigned char*)stash;
    #pragma unroll
    for(int d0=0;d0<4;++d0){ const float sgv=subln[d0*32+r32];
      #pragma unroll
      for(int r=0;r<16;++r){ const int w8=__builtin_amdgcn_cvt_pk_fp8_f32(o[d0][r]*ss[r]*sgv,0.f,0,false); stg[crow(r,hi)*128+d0*32+r32]=(unsigned char)(w8&0xff); } }
    asm volatile("s_waitcnt lgkmcnt(0)":::"memory");
    unsigned char*Aw=A2+(qrow0+wid*QBLK)*DM+acol;
    #pragma unroll
    for(int i=0;i<4;++i){const int row=i*8+(lane>>3),ch=lane&7; const u32x4 v=*(const u32x4*)(stg+row*128+ch*16); *(u32x4*)(Aw+(long)row*DM+ch*16)=v;}
    asm volatile("s_waitcnt lgkmcnt(0)":::"memory");
  }
  } }
  asm volatile("s_waitcnt lgkmcnt(0)\n\ts_barrier":::"memory");
  int ovfl=0; if constexpr(OPT){ ovfl=__builtin_amdgcn_readfirstlane((int)*(volatile unsigned*)ovf); }
  #undef KVROW
  #undef DMA_K
  #undef DMA_V
  #undef RESC
  #undef ROT
  #undef EX
  #undef PK8
  #undef VF8
  #undef PIN
  #undef MX3
  #undef VR4
  #undef MFO8
  #undef KRD
  #undef MFOL
  #undef SM8
  #undef SM8F
  #undef STEP2
  #undef ENDW
  return ovfl;
}
#undef SBAR
#undef WAIT_BAR
}
__device__ __forceinline__ void phase_attn2(const Frame& F, const Prm& p) {
    const bf16* Q = (const bf16*)(p.ws + WS_Q); const bf16* K = (const bf16*)(p.ws + WS_K); const bf16* V = (const bf16*)(p.ws + WS_V); unsigned char* A2 = p.ws + WS_O1;
    const float* lamp = (const float*)(p.ws + WS_MISC);
    for (int v = vcu_of(F); v < 256; v += F.G) {
        const int b = v >> 5, hs = (v >> 4) & 1, qb = v & 15;
        const long kctx = NLAT + b * CTXL, klat = (long)b * SEQ;
        for (int hr = 0; hr < 4; ++hr) {
            const int h = 2 * hr + hs;
            const int nu = (qb == hr) ? 2 : 1;
            for (int i = 0; i < nu; ++i) {
                const long qrow0 = i == 0 ? klat + qb * 256 : kctx; const int NT = i == 0 ? 68 : 4;
                unsigned* ovf = (unsigned*)(F.lds + LDS_BYTES - 32);
                int redo = 0;
                for (int m = 0; m < 2; ++m) {
                    const int hm = 2 * h + m;
                    const float km = __uint_as_float(__hip_atomic_load(F.ctl + CW_KM + b * 16 + hm, __ATOMIC_RELAXED, __HIP_MEMORY_SCOPE_AGENT));
                    redo |= attn_body::attn_unit2<8, true>(qrow0, hm * 64, h * 128, kctx, klat, NT, Q, K, V, m, lamp, p.subln, A2, h * 128, km, (char*)F.lds, F.wave, ovf);
                }
                if (redo) {
                    __syncthreads(); if (F.wave == 0) *ovf = 0u; __syncthreads();
                    for (int m = 0; m < 2; ++m) {
                        const int hm = 2 * h + m;
                        const float km = __uint_as_float(__hip_atomic_load(F.ctl + CW_KM + b * 16 + hm, __ATOMIC_RELAXED, __HIP_MEMORY_SCOPE_AGENT));
                        (void)attn_body::attn_unit2<8, false>(qrow0, hm * 64, h * 128, kctx, klat, NT, Q, K, V, m, lamp, p.subln, A2, h * 128, km, (char*)F.lds, F.wave, ovf);
                    }
                }
            }
        }
    }
}
namespace gla3 {
typedef short bf16x8 __attribute__((ext_vector_type(8)));
typedef short s16x4 __attribute__((ext_vector_type(4)));
typedef float f32x16 __attribute__((ext_vector_type(16)));
constexpr int CH = 64 * 16 + 64;
constexpr int L_QS = 0, L_KS = 16 * CH, L_VS = 32 * CH, L_BUF = 40 * CH, L_SB = 2 * L_BUF, L_SBS = 16 * CH, L_X = L_SB + 2 * L_SBS, L_DEC = L_X + 2 * 16384, L_END = L_DEC + 1024;
__device__ __forceinline__ int crow(int i, int hh) { return (i & 3) + 8 * (i >> 2) + 4 * hh; }
typedef float f32x2_t __attribute__((ext_vector_type(2))); typedef __bf16 bf16x2_t __attribute__((ext_vector_type(2)));
__device__ __forceinline__ unsigned pk(float lo, float hi) { f32x2_t v = {lo, hi}; bf16x2_t b = __builtin_convertvector(v, bf16x2_t); return __builtin_bit_cast(unsigned, b); }
typedef short v4i16_t __attribute__((ext_vector_type(4)));
__device__ __forceinline__ s16x4 trrd(LAS const unsigned char* p) { return __builtin_bit_cast(s16x4, __builtin_amdgcn_ds_read_tr16_b64_v4i16((LAS v4i16_t*)p)); }
#define GLA_FR(lo, hi) (bf16x8){lo[0], lo[1], lo[2], lo[3], hi[0], hi[1], hi[2], hi[3]}

__device__ __forceinline__ void scan_unit(const Frame& F, const Prm& p, int unit) {
    const int dvs = unit & 3, dir = (unit >> 2) & 1, h = (unit >> 3) & 3, b = unit >> 5;
    LAS unsigned char* lds = (LAS unsigned char*)F.lds;
    const int lane = F.lane, w = F.wave, tid = F.tid, r = lane & 31, hh = lane >> 5;
    const bf16* QT = (const bf16*)(p.ws + WS_QT) + ((size_t)dir * 8 + 2 * h) * NTOK * 64;
    const bf16* KT = (const bf16*)(p.ws + WS_KT) + ((size_t)dir * 8 + 2 * h) * NTOK * 64;
    const bf16* V = (const bf16*)(p.ws + WS_V1) + h * 256 + dvs * 64;
    const float* DEC = (const float*)(p.ws + WS_DEC) + (size_t)dir * NCHUNK * 512 + h * 128;
    bf16* OG = (bf16*)((unsigned char*)p.out + (dir ? OUT_OGB : 0)) + h * 256 + dvs * 64;
    const int g1 = (lane >> 4) & 1, q4 = (lane & 15) >> 2, p4 = lane & 3;
    const int trb = (2 * g1 + (p4 >> 1)) * CH + q4 * 16 + 8 * (p4 & 1);
    const int trN = trb + 128 * hh, trP = trb + 64 * hh;
    f32x16 S0 = {}, S1 = {};
    for (int i = tid; i < 16 * CH / 16; i += NTHR) *(LAS u32x4*)(lds + L_SB + i * 16) = (u32x4){0u, 0u, 0u, 0u};
    u32x4 pq0[2], pq1[2], pk0[2], pk1[2], pv[2]; float pdec[2] = {0.f, 0.f};
#define GLA_CHUNK(step) ((step) >= 4 ? b * 64 + (dir ? 63 - ((step) - 4) : (step) - 4) : 512 + b * 4 + (dir ? 3 - (step) : (step)))
    const int qrow = 8 * w + (lane >> 4), qch = lane & 15, vrow = 8 * w + (lane >> 3), vch = lane & 7;
    const size_t qgo = (size_t)(qch >> 3) * NTOK * 64 + (qch & 7) * 8;
#define GLA_LOAD(step, u) do { const size_t t0_ = (size_t)GLA_CHUNK(step) * 64; \
        pq0[u] = *(const u32x4*)(QT + qgo + (t0_ + qrow) * 64); pq1[u] = *(const u32x4*)(QT + qgo + (t0_ + qrow + 4) * 64); \
        pk0[u] = *(const u32x4*)(KT + qgo + (t0_ + qrow) * 64); pk1[u] = *(const u32x4*)(KT + qgo + (t0_ + qrow + 4) * 64); \
        pv[u] = *(const u32x4*)(V + (t0_ + vrow) * 1024 + 8 * vch); if (tid < 128) pdec[u] = DEC[(size_t)GLA_CHUNK(step) * 512 + tid]; } while (0)
#define GLA_STORE(u, bi) do { \
        *(LAS u32x4*)(lds + (bi) * L_BUF + L_QS + qch * CH + qrow * 16) = pq0[u]; *(LAS u32x4*)(lds + (bi) * L_BUF + L_QS + qch * CH + (qrow + 4) * 16) = pq1[u]; \
        *(LAS u32x4*)(lds + (bi) * L_BUF + L_KS + qch * CH + qrow * 16) = pk0[u]; *(LAS u32x4*)(lds + (bi) * L_BUF + L_KS + qch * CH + (qrow + 4) * 16) = pk1[u]; \
        *(LAS u32x4*)(lds + (bi) * L_BUF + L_VS + vch * CH + vrow * 16) = pv[u]; \
        if (tid < 128) *(LAS float*)(lds + L_DEC + (bi) * 512 + 4 * tid) = pdec[u]; } while (0)
    GLA_LOAD(0, 0);
    GLA_LOAD(1, 1);
    GLA_STORE(0, 0);
    __syncthreads();
    const int tb = (w & 3) >> 1, vb = w & 1;
    for (int sp2 = 0; sp2 < 34; ++sp2) {
#pragma unroll
    for (int u = 0; u < 2; ++u) {
        const int step = 2 * sp2 + u;
        const bool lat = step >= 4; const int chunk = GLA_CHUNK(step);
        if (step + 1 < 68) GLA_STORE(u ^ 1, u ^ 1);
        if (step + 2 < 68) GLA_LOAD(step + 2, u);
        LAS unsigned char* img = lds + u * L_BUF;
        f32x16 o = {};
        if (w < 4) {
            if (lat) {
                const bool n0 = dir ? (tb == 0) : true, n1 = dir ? true : (tb == 1);
                f32x16 sc0 = {}, sc1 = {};
#define GLA_BQ(ks) (*(const LAS bf16x8*)(img + L_QS + (2 * (ks) + hh) * CH + (32 * tb + r) * 16))
#define GLA_A0(ks) (*(const LAS bf16x8*)(img + L_KS + (2 * (ks) + hh) * CH + r * 16))
#define GLA_A1(ks) (*(const LAS bf16x8*)(img + L_KS + (2 * (ks) + hh) * CH + (32 + r) * 16))
                if (n0 && n1) {
#pragma unroll
                    for (int ks = 0; ks < 8; ++ks) { const bf16x8 bq = GLA_BQ(ks); sc0 = __builtin_amdgcn_mfma_f32_32x32x16_bf16(GLA_A0(ks), bq, sc0, 0, 0, 0); sc1 = __builtin_amdgcn_mfma_f32_32x32x16_bf16(GLA_A1(ks), bq, sc1, 0, 0, 0); }
                } else if (n0) {
#pragma unroll
                    for (int ks = 0; ks < 8; ++ks) sc0 = __builtin_amdgcn_mfma_f32_32x32x16_bf16(GLA_A0(ks), GLA_BQ(ks), sc0, 0, 0, 0);
                } else {
#pragma unroll
                    for (int ks = 0; ks < 8; ++ks) sc1 = __builtin_amdgcn_mfma_f32_32x32x16_bf16(GLA_A1(ks), GLA_BQ(ks), sc1, 0, 0, 0);
                }
#undef GLA_BQ
#undef GLA_A0
#undef GLA_A1
                const int t = 32 * tb + r;
#pragma unroll
                for (int i = 0; i < 16; ++i) { const int s0 = crow(i, hh), s1 = 32 + s0; const bool k0 = dir ? (s0 >= t) : (s0 <= t), k1 = dir ? (s1 >= t) : (s1 <= t); sc0[i] = k0 ? sc0[i] : 0.f; sc1[i] = k1 ? sc1[i] : 0.f; }
#pragma unroll
                for (int sb = 0; sb < 2; ++sb) { if (sb == 0 ? n0 : n1) {
#pragma unroll
                    for (int sp = 0; sp < 2; ++sp) {
                        u32x4 pw;
                        if (sb == 0) { pw.x = pk(sc0[8 * sp + 0], sc0[8 * sp + 1]); pw.y = pk(sc0[8 * sp + 2], sc0[8 * sp + 3]); pw.z = pk(sc0[8 * sp + 4], sc0[8 * sp + 5]); pw.w = pk(sc0[8 * sp + 6], sc0[8 * sp + 7]); }
                        else { pw.x = pk(sc1[8 * sp + 0], sc1[8 * sp + 1]); pw.y = pk(sc1[8 * sp + 2], sc1[8 * sp + 3]); pw.z = pk(sc1[8 * sp + 4], sc1[8 * sp + 5]); pw.w = pk(sc1[8 * sp + 6], sc1[8 * sp + 7]); }
                        LAS const unsigned char* vp = img + L_VS + trP + (4 * vb) * CH + (32 * sb + 16 * sp) * 16;
                        const s16x4 lo = trrd(vp), hi = trrd(vp + 8 * 16);
                        o = __builtin_amdgcn_mfma_f32_32x32x16_bf16(GLA_FR(lo, hi), __builtin_bit_cast(bf16x8, pw), o, 0, 0, 0);
                    } } }
            }
        } else {
            const int db = w - 4;
            if (lat) {
                f32x16 o2 = {};
#pragma unroll
                for (int ks = 0; ks < 8; ++ks) {
                    const bf16x8 as = *(const LAS bf16x8*)(lds + L_SB + u * L_SBS + (2 * ks + hh) * CH + (32 * vb + r) * 16);
                    const bf16x8 bq = *(const LAS bf16x8*)(img + L_QS + (2 * ks + hh) * CH + (32 * tb + r) * 16);
                    o2 = __builtin_amdgcn_mfma_f32_32x32x16_bf16(as, bq, o2, 0, 0, 0);
                }
#pragma unroll
                for (int g = 0; g < 4; ++g) *(LAS f32x4*)(lds + L_X + u * 16384 + (w & 3) * 4096 + g * 1024 + lane * 16) = (f32x4){o2[4 * g], o2[4 * g + 1], o2[4 * g + 2], o2[4 * g + 3]};
            }
#pragma unroll
            for (int ks = 0; ks < 4; ++ks) {
                LAS const unsigned char* kp = img + L_KS + trN + (4 * db) * CH + (16 * ks) * 16;
                LAS const unsigned char* vp = img + L_VS + trN + (16 * ks) * 16;
                const s16x4 al = trrd(kp), ah = trrd(kp + 4 * 16);
                const s16x4 b0l = trrd(vp), b0h = trrd(vp + 4 * 16), b1l = trrd(vp + 4 * CH), b1h = trrd(vp + 4 * CH + 4 * 16);
                S0 = __builtin_amdgcn_mfma_f32_32x32x16_bf16(GLA_FR(al, ah), GLA_FR(b0l, b0h), S0, 0, 0, 0); S1 = __builtin_amdgcn_mfma_f32_32x32x16_bf16(GLA_FR(al, ah), GLA_FR(b1l, b1h), S1, 0, 0, 0);
            }
#pragma unroll
            for (int i = 0; i < 16; ++i) { const float dc = *(const LAS float*)(lds + L_DEC + u * 512 + 4 * (32 * db + crow(i, hh))); S0[i] *= dc; S1[i] *= dc; }
            if (step + 1 < 68) {
#pragma unroll
                for (int g = 0; g < 4; ++g) { u32x2 w0, w1; w0.x = pk(S0[4 * g], S0[4 * g + 1]); w0.y = pk(S0[4 * g + 2], S0[4 * g + 3]); w1.x = pk(S1[4 * g], S1[4 * g + 1]); w1.y = pk(S1[4 * g + 2], S1[4 * g + 3]);
                    *(LAS u32x2*)(lds + L_SB + (u ^ 1) * L_SBS + (4 * db + g) * CH + r * 16 + 8 * hh) = w0; *(LAS u32x2*)(lds + L_SB + (u ^ 1) * L_SBS + (4 * db + g) * CH + (32 + r) * 16 + 8 * hh) = w1; } }
        }
        __syncthreads();
        if (w < 4 && lat) {
            bf16* orow = OG + ((size_t)chunk * 64 + 32 * tb + r) * DM + 32 * vb + 4 * hh;
#pragma unroll
            for (int g = 0; g < 4; ++g) { const f32x4 x = *(const LAS f32x4*)(lds + L_X + u * 16384 + w * 4096 + g * 1024 + lane * 16);
                u32x2 wv; wv.x = pk(o[4 * g] + x.x, o[4 * g + 1] + x.y); wv.y = pk(o[4 * g + 2] + x.z, o[4 * g + 3] + x.w); *(u32x2*)(orow + 8 * g) = wv; }
        }
    }
    }
#undef GLA_CHUNK
#undef GLA_LOAD
#undef GLA_STORE
}
#undef GLA_FR
}
__device__ __forceinline__ void phase_scan_opt(const Frame& F, const Prm& p) {
    for (int unit = vcu_of(F); unit < 256; unit += F.G) gla3::scan_unit(F, p, unit);
}
#define PHASE_QKV(F, p) phase_qkv_opt(F, p)
#define PHASE_ATTN(F, p) phase_attn2(F, p)
#define PHASE_WO(F, p, l) phase_wo_opt(F, p, l)
#define PHASE_MOE1(F, p, l) phase_moe1_opt(F, p, l)
#define PHASE_MOE2(F, p, l) phase_moe2_opt(F, p, l)
#define PHASE_INPROJ(F, p) phase_inproj_opt(F, p)
#define PHASE_SCAN(F, p) phase_scan_opt(F, p)
typedef GAS unsigned gu32;
#define XB_TMO      128
#define XB_XCNT(j)  (256  + 64 * (j))
#define XB_XSUB(j)  (1280 + 64 * (j))
#define XB_XGEN(j)  (2304 + 64 * (j))
#define XB_TOP      3328
#define XB_TOPGEN   3392
#define XCD_BAR_WORDS 3456
#define XB_SPIN_CAP (1u << 20)
__device__ __forceinline__ unsigned xb_ld(unsigned* p)              { return __hip_atomic_load(p, __ATOMIC_RELAXED, __HIP_MEMORY_SCOPE_AGENT); }
__device__ __forceinline__ unsigned xb_add(unsigned* p, unsigned v) { return __hip_atomic_fetch_add(p, v, __ATOMIC_RELAXED, __HIP_MEMORY_SCOPE_AGENT); }
__device__ __forceinline__ unsigned xb_xcc_id() { return (unsigned)__builtin_amdgcn_s_getreg((3 << 11) | 20) & 0xFu; }
#define XB_SPIN(cond, bar) do { unsigned _sp = 0; while (cond) { __builtin_amdgcn_s_sleep(1); \
    if ((++_sp & 255u) == 0u) { if (xb_ld(&(bar)[XB_TMO])) break; if (_sp > XB_SPIN_CAP) { atomicAdd(&(bar)[XB_TMO], 1u); break; } } } } while (0)
struct XcdBarrier { unsigned* bar; unsigned x; volatile LAS unsigned* st; };
__device__ __forceinline__ XcdBarrier xcd_barrier_post(unsigned* bar, volatile LAS unsigned* st) {
    XcdBarrier b; b.bar = bar; b.x = xb_xcc_id(); b.st = st;
    if (threadIdx.x == 0) (void)xb_add(&bar[XB_XCNT(b.x)], 1u);
    return b;
}
__device__ __forceinline__ void xcd_barrier_complete(unsigned* bar, unsigned x, unsigned& nloc, unsigned& nx) {
    const unsigned G = gridDim.x * gridDim.y * gridDim.z;
    unsigned sum, cnt, mine, sp = 0u;
    for (;;) {
        sum = 0u; cnt = 0u; mine = 0u;
#pragma unroll
        for (unsigned j = 0; j < 16; ++j) { const unsigned c = xb_ld(&bar[XB_XCNT(j)]); sum += c; cnt += (c > 0u) ? 1u : 0u; mine = (j == x) ? c : mine; }
        if (sum == G) break;
        __builtin_amdgcn_s_sleep(1);
        if ((++sp & 255u) == 0u) { if (xb_ld(&bar[XB_TMO])) break; if (sp > XB_SPIN_CAP) { atomicAdd(&bar[XB_TMO], 1u); break; } }
    }
    nloc = mine > 0u ? mine : 1u; nx = cnt > 0u ? cnt : 1u;
}
__device__ __forceinline__ void xcd_barrier(const XcdBarrier& b, int tid) {
    asm volatile("s_waitcnt vmcnt(0)" ::: "memory");
    __syncthreads();
    if (tid == 0) {
        unsigned* bar = b.bar;
        __builtin_amdgcn_s_waitcnt(0);
        unsigned nloc = b.st[0], nx = b.st[1];
        if (nloc == 0u) { xcd_barrier_complete(bar, b.x, nloc, nx); b.st[0] = nloc; b.st[1] = nx; }
        const unsigned old = xb_add(&bar[XB_XSUB(b.x)], 1u);
        const unsigned gen = old / nloc;
        if (old + 1u == (gen + 1u) * nloc) {
            __builtin_amdgcn_fence(__ATOMIC_RELEASE, "agent");
            asm volatile("s_waitcnt vmcnt(0)" ::: "memory");
            const unsigned og = xb_add(&bar[XB_TOP], 1u);
            const unsigned tg = og / nx;
            if (og + 1u == (tg + 1u) * nx) xb_add(&bar[XB_TOPGEN], 1u);
            else XB_SPIN(xb_ld(&bar[XB_TOPGEN]) == tg, bar);
            __builtin_amdgcn_fence(__ATOMIC_ACQUIRE, "agent");
            xb_add(&bar[XB_XGEN(b.x)], 1u);
            asm volatile("s_waitcnt vmcnt(0)" ::: "memory");
        } else {
            XB_SPIN(xb_ld(&bar[XB_XGEN(b.x)]) == gen, bar);
            __builtin_amdgcn_fence(__ATOMIC_ACQUIRE, "agent");
            asm volatile("s_waitcnt vmcnt(0)" ::: "memory");
        }
    }
    __syncthreads();
}

constexpr int NPHASE = 19;
__global__ void __launch_bounds__(NTHR, 2) mega_fwd(Prm p) {
    extern __shared__ __attribute__((aligned(16))) unsigned char lds[];
    Frame F; F.lds = lds; F.ctl = (unsigned*)(p.ws + WS_CTL);
    F.tid = threadIdx.x; F.lane = F.tid & 63; F.wave = __builtin_amdgcn_readfirstlane(F.tid >> 6); F.G = gridDim.x; F.bid = blockIdx.x;
    for (int u = F.tid; u < (LDS_BYTES - LDSCTL_OFF) / 4; u += NTHR) ((LAS unsigned*)(lds + LDSCTL_OFF))[u] = 0u;
    __syncthreads();
    const int lo = p.ph_lo, hi = p.ph_hi;
    const bool multi = (hi - lo) > 1;
    XcdBarrier bar; bar.bar = F.ctl + CW_BAR + p.li * XCD_BAR_WORDS; bar.x = 0; bar.st = nullptr;
    if (multi) bar = xcd_barrier_post(F.ctl + CW_BAR + p.li * XCD_BAR_WORDS, (volatile LAS unsigned*)(lds + MISC_OFF) + 8);
#define IN(k) (lo <= (k) && (k) < hi)
#define SEAM(k) do { if (IN(k) && IN((k) + 1)) xcd_barrier(bar, F.tid); } while (0)
    if (IN(0)) { phase_prologue(F, p); } SEAM(0);
    if (IN(1)) { phase_modulate0(F, p); } SEAM(1);
    if (IN(2)) { PHASE_QKV(F, p); } SEAM(2);
    if (IN(3)) { PHASE_ATTN(F, p); }
    {
        int l_; asm volatile("v_mbcnt_lo_u32_b32 %0, -1, 0\n\tv_mbcnt_hi_u32_b32 %0, -1, %0" : "=v"(l_)); F.lane = l_; F.tid = F.wave * 64 + l_; }
    SEAM(3);
    if (IN(5)) { PHASE_WO(F, p, 0); } SEAM(5);
    if (IN(6)) { phase_ln_route(F, p, 0); } SEAM(6);
    if (IN(7)) { PHASE_MOE1(F, p, 0); } SEAM(7);
    if (IN(8)) { PHASE_MOE2(F, p, 0); } SEAM(8);
    if (IN(9)) { phase_moe_combine(F, p, 0); } SEAM(9);
    if (IN(10)) { PHASE_INPROJ(F, p); } SEAM(10);
    if (IN(11)) { phase_gla_prep(F, p); } SEAM(11);
    if (IN(12)) { PHASE_SCAN(F, p); } SEAM(12);
    if (IN(13)) { phase_gla_post(F, p); } SEAM(13);
    if (IN(14)) { PHASE_WO(F, p, 1); } SEAM(14);
    if (IN(15)) { phase_ln_route(F, p, 1); } SEAM(15);
    if (IN(16)) { PHASE_MOE1(F, p, 1); } SEAM(16);
    if (IN(17)) { PHASE_MOE2(F, p, 1); } SEAM(17);
    if (IN(18)) { phase_moe_combine(F, p, 1); }
#undef IN
#undef SEAM
}

extern "C" void kernel_launch(void* const* d_in, const int* in_sizes, int n_in, void* d_out, int out_size, void* d_ws, size_t ws_size, hipStream_t stream) {
    static int grid = 0;
    if (grid == 0) {
        if (n_in != 23 || in_sizes[0] != NLAT * DM || out_size != NLAT * DM || ws_size < WS_END) { fprintf(stderr, "kernel_launch: unexpected shapes (n_in %d, in0 %d, out %d, ws %zu); nothing launched\n", n_in, n_in > 0 ? in_sizes[0] : -1, out_size, ws_size); grid = -1; return; }
        int dev = 0, cus = 0;
        if (hipGetDevice(&dev) != hipSuccess || hipDeviceGetAttribute(&cus, hipDeviceAttributeMultiprocessorCount, dev) != hipSuccess) { grid = -1; return; }
        if (hipFuncSetAttribute((const void*)mega_fwd, hipFuncAttributeMaxDynamicSharedMemorySize, LDS_BYTES) != hipSuccess) { fprintf(stderr, "kernel_launch: hipFuncSetAttribute failed\n"); grid = -1; return; }
        int per_cu = 0;
        if (hipOccupancyMaxActiveBlocksPerMultiprocessor(&per_cu, (const void*)mega_fwd, NTHR, LDS_BYTES) != hipSuccess || per_cu < 1) fprintf(stderr, "kernel_launch: note: occupancy query reports %d\n", per_cu);
        (void)hipGetLastError();
        grid = cus;
    }
    if (grid < 0) return;
    (void)hipMemsetAsync((char*)d_ws + WS_CTL, 0, CTL_ZERO_BYTES, stream);
    Prm p{};
    const float** pp = (const float**)&p;
    for (int i = 0; i < 23; ++i) pp[i] = (const float*)d_in[i];
    p.out = (float*)d_out; p.ws = (unsigned char*)d_ws;
    p.ph_lo = 0; p.ph_hi = NPHASE; p.li = 0;
    hipLaunchKernelGGL(mega_fwd, dim3(grid), dim3(NTHR), LDS_BYTES, stream, p);
}
```

```cpp
#include <hip/hip_runtime.h>
#include <cstdint>
#include <cstdio>

constexpr int BATCH = 8, SEQ = 4096, DM = 1024, CTXL = 256;
constexpr int NLAT = BATCH * SEQ, NCTX = BATCH * CTXL, NTOK = NLAT + NCTX;
constexpr float ALPHA = 1.4142135623730951f;
constexpr float LN_EPS = 1e-5f;
constexpr float LAMBDA_INIT0 = 0.2f;
constexpr float C2 = 0.125f * 1.4426950408889634f;
constexpr int NEXP = 16, DEXP = 512, MAXSLOT = 73728;
constexpr int NCHUNK = NTOK / 64;
constexpr int NIN = 3328;

typedef unsigned short bf16;
typedef float f32x4 __attribute__((ext_vector_type(4)));
typedef float f32x2 __attribute__((ext_vector_type(2)));
typedef unsigned u32x2 __attribute__((ext_vector_type(2)));
typedef unsigned u32x4 __attribute__((ext_vector_type(4)));

constexpr size_t MiB = 1u << 20;
constexpr size_t WS_CTL = 0, CTL_ZERO_BYTES = 1 * MiB;
constexpr size_t WS_MOD = 1 * MiB;
constexpr size_t WS_MISC = 1 * MiB + 512 * 1024;
constexpr size_t WS_WQKV = 2 * MiB, WS_WO = 5 * MiB, WS_GU0 = 6 * MiB, WS_DN0 = 22 * MiB, WS_WIN = 30 * MiB, WS_WGO = 34 * MiB, WS_GU1 = 35 * MiB, WS_DN1 = 51 * MiB;
constexpr size_t WS_XB = 59 * MiB;
constexpr size_t WS_H = 127 * MiB;
constexpr size_t WS_Q = 195 * MiB, WS_K = 263 * MiB, WS_V = 331 * MiB, WS_O2 = 399 * MiB;
constexpr size_t WS_LIST = 467 * MiB;
constexpr size_t WS_TOKR = 470 * MiB;
constexpr size_t WS_DEC = 472 * MiB;
constexpr size_t WS_ZZ = 475 * MiB;
constexpr size_t WS_END = 480 * MiB;
constexpr size_t WS_O1 = WS_H, WS_A2 = WS_H, WS_Y = WS_K;
constexpr size_t WS_YM = 195 * MiB, WS_ACT = 339 * MiB;
constexpr size_t WS_QR = 195 * MiB, WS_KR = 229 * MiB, WS_V1 = 263 * MiB, WS_R = 331 * MiB;
constexpr size_t WS_QT = WS_H, WS_KT = 399 * MiB;
constexpr size_t WS_A2B = WS_H;
constexpr size_t OUT_OGB = 64 * MiB;
constexpr int CW_TMO = 0, CW_CODE = 1;
constexpr int CW_CNT = 64;
constexpr int CW_KM = 128;
constexpr int CW_BAR = 4096;

__device__ __forceinline__ unsigned f2bf(float f) { unsigned u = __builtin_bit_cast(unsigned, f); return (u + 0x7fffu + ((u >> 16) & 1u)) >> 16; }
typedef float f32x2pk_t __attribute__((ext_vector_type(2))); typedef __bf16 bf16x2pk_t __attribute__((ext_vector_type(2)));
__device__ __forceinline__ unsigned pk2(float lo, float hi) { f32x2pk_t v = {lo, hi}; bf16x2pk_t b = __builtin_convertvector(v, bf16x2pk_t); return __builtin_bit_cast(unsigned, b); }
__device__ __forceinline__ float bf2f(unsigned b) { return __builtin_bit_cast(float, b << 16); }
__device__ __forceinline__ float xshfl1(float v)  { return __int_as_float(__builtin_amdgcn_ds_swizzle(__float_as_int(v), 0x041f)); }
__device__ __forceinline__ float xshfl2(float v)  { return __int_as_float(__builtin_amdgcn_ds_swizzle(__float_as_int(v), 0x081f)); }
__device__ __forceinline__ float xshfl4(float v)  { return __int_as_float(__builtin_amdgcn_ds_swizzle(__float_as_int(v), 0x101f)); }
__device__ __forceinline__ float xshfl8(float v)  { return __int_as_float(__builtin_amdgcn_ds_swizzle(__float_as_int(v), 0x201f)); }
__device__ __forceinline__ float xshfl16(float v) { return __int_as_float(__builtin_amdgcn_ds_swizzle(__float_as_int(v), 0x401f)); }
__device__ __forceinline__ float xshfl32(float v) { const auto r = __builtin_amdgcn_permlane32_swap(__float_as_uint(v), __float_as_uint(v), false, false);
    return (__builtin_amdgcn_mbcnt_hi(~0u, __builtin_amdgcn_mbcnt_lo(~0u, 0u)) & 32u) ? __uint_as_float(r[0]) : __uint_as_float(r[1]); }
__device__ __forceinline__ float wave_sum(float v) {
    v += xshfl1(v); v += xshfl2(v); v += xshfl4(v); v += xshfl8(v); v += xshfl16(v);
    { const auto r = __builtin_amdgcn_permlane32_swap(__float_as_uint(v), __float_as_uint(v), false, false); v = __uint_as_float(r[0]) + __uint_as_float(r[1]); }
    return v;
}
__device__ __forceinline__ float silu_f(float v) { return v / (1.f + __expf(-v)); }

struct Prm {
    const float *x, *c, *ctx, *cctx, *ada_w, *ada_b, *ln_g, *ln_b, *w_qkv, *w_o, *lam, *subln, *gw_in, *gwg_down, *gwg_up, *gbg, *gnorm, *gw_o, *rw, *rb, *mg, *mu, *md;
    float* out; unsigned char* ws;
    int ph_lo, ph_hi, li, pad;
};
__device__ __forceinline__ void ld_row_f32(const float* p, int lane, f32x4 (&v)[4]) {
#pragma unroll
    for (int j = 0; j < 4; ++j) v[j] = *(const f32x4*)(p + 4 * lane + 256 * j);
}
__device__ __forceinline__ void st_row_f32(float* p, int lane, const f32x4 (&v)[4]) {
#pragma unroll
    for (int j = 0; j < 4; ++j) *(f32x4*)(p + 4 * lane + 256 * j) = v[j];
}
__device__ __forceinline__ void ld_row_bf16(const bf16* p, int lane, f32x4 (&v)[4]) {
#pragma unroll
    for (int j = 0; j < 4; ++j) { const u32x2 u = *(const u32x2*)(p + 4 * lane + 256 * j); v[j] = (f32x4){bf2f(u.x & 0xffffu), bf2f(u.x >> 16), bf2f(u.y & 0xffffu), bf2f(u.y >> 16)}; }
}
__device__ __forceinline__ void st_row_bf16(bf16* p, int lane, const f32x4 (&v)[4]) {
#pragma unroll
    for (int j = 0; j < 4; ++j) { u32x2 u; u.x = pk2(v[j].x, v[j].y); u.y = pk2(v[j].z, v[j].w); *(u32x2*)(p + 4 * lane + 256 * j) = u; }
}
__device__ __forceinline__ void ld_row_bf16x(const bf16* p, int lane, f32x4 (&v)[4]) {
#pragma unroll
    for (int h = 0; h < 2; ++h) { const u32x4 u = *(const u32x4*)((const unsigned char*)p + 1024 * h + 16 * lane);
        v[2 * h] = (f32x4){bf2f(u.x & 0xffffu), bf2f(u.x >> 16), bf2f(u.y & 0xffffu), bf2f(u.y >> 16)}; v[2 * h + 1] = (f32x4){bf2f(u.z & 0xffffu), bf2f(u.z >> 16), bf2f(u.w & 0xffffu), bf2f(u.w >> 16)}; }
}
__device__ __forceinline__ void st_row_bf16x(bf16* p, int lane, const f32x4 (&v)[4]) {
#pragma unroll
    for (int h = 0; h < 2; ++h) { u32x4 u; u.x = pk2(v[2 * h].x, v[2 * h].y); u.y = pk2(v[2 * h].z, v[2 * h].w); u.z = pk2(v[2 * h + 1].x, v[2 * h + 1].y); u.w = pk2(v[2 * h + 1].z, v[2 * h + 1].w);
        *(u32x4*)((unsigned char*)p + 1024 * h + 16 * lane) = u; }
}
__device__ __forceinline__ void ln_row(f32x4 (&v)[4], const float* g, const float* b, int lane) {
    float s = 0.f;
#pragma unroll
    for (int j = 0; j < 4; ++j) s += (v[j].x + v[j].y) + (v[j].z + v[j].w);
    const float mean = wave_sum(s) * (1.f / DM); float q = 0.f;
#pragma unroll
    for (int j = 0; j < 4; ++j) { v[j] = v[j] - mean; q += (v[j].x * v[j].x + v[j].y * v[j].y) + (v[j].z * v[j].z + v[j].w * v[j].w); }
    const float rstd = __builtin_amdgcn_rsqf(wave_sum(q) * (1.f / DM) + LN_EPS);
#pragma unroll
    for (int j = 0; j < 4; ++j) { const f32x4 gg = *(const f32x4*)(g + 4 * lane + 256 * j), bb = *(const f32x4*)(b + 4 * lane + 256 * j); v[j] = v[j] * rstd * gg + bb; }
}
__device__ __forceinline__ void ln_row_r(f32x4 (&v)[4], const f32x4 (&gg)[4], const f32x4 (&bb)[4]) {
    float s = 0.f;
#pragma unroll
    for (int j = 0; j < 4; ++j) s += (v[j].x + v[j].y) + (v[j].z + v[j].w);
    const float mean = wave_sum(s) * (1.f / DM); float q = 0.f;
#pragma unroll
    for (int j = 0; j < 4; ++j) { v[j] = v[j] - mean; q += (v[j].x * v[j].x + v[j].y * v[j].y) + (v[j].z * v[j].z + v[j].w * v[j].w); }
    const float rstd = __builtin_amdgcn_rsqf(wave_sum(q) * (1.f / DM) + LN_EPS);
#pragma unroll
    for (int j = 0; j < 4; ++j) v[j] = v[j] * rstd * gg[j] + bb[j];
}
__host__ __device__ __forceinline__ int gu_phys(int other, int sel) { return (other >> 4) * 32 + sel * 16 + (other & 15); }
__host__ __device__ __forceinline__ int perm16b(int L) { return (L & ~31) | (16 * ((L >> 2) & 1) + 4 * ((L >> 3) & 3) + (L & 3)); }
__host__ __device__ __forceinline__ int perm16b_inv(int P) { return (P & ~31) | (8 * ((P >> 2) & 3) + 4 * ((P >> 4) & 1) + (P & 3)); }
__device__ __forceinline__ unsigned pk4_fp8(float a, float b, float c, float d) { int w = 0; w = __builtin_amdgcn_cvt_pk_fp8_f32(a, b, w, false); w = __builtin_amdgcn_cvt_pk_fp8_f32(c, d, w, true); return (unsigned)w; }
constexpr float W8_SCALE = 64.f, W8_INV = 1.f / 64.f;
__device__ __forceinline__ void st_row_fp8(unsigned char* p, int lane, const f32x4 (&v)[4]) {
#pragma unroll
    for (int j = 0; j < 4; ++j) *(unsigned*)(p + 4 * lane + 256 * j) = pk4_fp8(v[j].x, v[j].y, v[j].z, v[j].w);
}
__device__ __forceinline__ int fp8p_off(int lane) { return ((lane >> 3) & 3) * 64 + ((lane >> 1) & 3) * 16 + (lane >> 5) * 8 + (lane & 1) * 4; }
__device__ __forceinline__ void ld_row_fp8p(const unsigned char* p, int lane, f32x4 (&v)[4]) {
    const int po = fp8p_off(lane);
#pragma unroll
    for (int j = 0; j < 4; ++j) { const int w = *(const int*)(p + po + 256 * j); const f32x2 lo = __builtin_amdgcn_cvt_pk_f32_fp8(w, false), hi = __builtin_amdgcn_cvt_pk_f32_fp8(w, true); v[j] = (f32x4){lo.x, lo.y, hi.x, hi.y}; }
}
__device__ __forceinline__ void ld_row_fp8(const unsigned char* p, int lane, f32x4 (&v)[4]) {
#pragma unroll
    for (int j = 0; j < 4; ++j) { const int w = *(const int*)(p + 4 * lane + 256 * j); const f32x2 lo = __builtin_amdgcn_cvt_pk_f32_fp8(w, false), hi = __builtin_amdgcn_cvt_pk_f32_fp8(w, true); v[j] = (f32x4){lo.x, lo.y, hi.x, hi.y}; }
}
#define GAS __attribute__((address_space(1)))
#define LAS __attribute__((address_space(3)))
constexpr int NWAVES = 8, NTHR = NWAVES * 64;
constexpr int RING_BYTES = 131072, LDS_BYTES = 147456, LDSCTL_OFF = LDS_BYTES - 1024, MISC_OFF = LDSCTL_OFF + 320;
constexpr int LDSX_OFF = RING_BYTES + 1024;
#define LDS_WAIT() asm volatile("s_waitcnt lgkmcnt(0)" ::: "memory")
#define VM_WAIT() asm volatile("s_waitcnt vmcnt(0)" ::: "memory")

struct Frame {
    unsigned char* lds;
    unsigned* ctl;
    int tid, lane, wave, G, bid;
};

template <int MODE>
__device__ __forceinline__ void p0_transpose_item(const float* W, int K, int N, bf16* WT, int row_off, float* scr, int item, int lane) {
    const int nblk = N / 32, kb = item / nblk, nb = item % nblk, k0 = 64 * kb, n0 = 32 * nb;
    { f32x4 t[8];
#pragma unroll
        for (int i = 0; i < 8; ++i) t[i] = *(const f32x4*)(W + (size_t)(k0 + 8 * i + (lane >> 3)) * N + n0 + 4 * (lane & 7));
#pragma unroll
        for (int i = 0; i < 8; ++i) { float* d = scr + (8 * i + (lane >> 3)) * 33 + 4 * (lane & 7); d[0] = t[i].x; d[1] = t[i].y; d[2] = t[i].z; d[3] = t[i].w; } }
    LDS_WAIT(); asm volatile("" ::: "memory");
    const int c = lane & 7;
#pragma unroll
    for (int j = 0; j < 4; ++j) { const int n = (lane >> 3) + 8 * j; const float* s = scr + (8 * c) * 33 + n;
        u32x4 o; o.x = pk2(s[0 * 33], s[1 * 33]); o.y = pk2(s[2 * 33], s[3 * 33]); o.z = pk2(s[4 * 33], s[5 * 33]); o.w = pk2(s[6 * 33], s[7 * 33]);
        const int nl = n0 + n; const int pr = (MODE == 0) ? (row_off + nl) : (MODE == 3) ? (row_off + perm16b(nl)) : (row_off + gu_phys(nl, MODE - 1));
        *(u32x4*)(WT + (size_t)pr * K + k0 + 8 * c) = o; }
    LDS_WAIT(); asm volatile("" ::: "memory");
}
template <int MODE>
__device__ __forceinline__ void p0_transpose_item8(const float* W, int K, int N, unsigned char* WT, float* scr, int item, int lane) {
    (void)scr;
    const int nblk = N / 64, kb = item / nblk, nb = item % nblk, k0 = 64 * kb, n0 = 64 * nb;
    const int g = lane >> 4, c = lane & 15;
    f32x4 t[16];
#pragma unroll
    for (int i = 0; i < 16; ++i) t[i] = *(const f32x4*)(W + (size_t)(k0 + 16 * g + i) * N + n0 + 4 * c);
#pragma unroll
    for (int j = 0; j < 4; ++j) {
        u32x4 o;
        o.x = pk4_fp8(t[0][j] * W8_SCALE, t[1][j] * W8_SCALE, t[2][j] * W8_SCALE, t[3][j] * W8_SCALE); o.y = pk4_fp8(t[4][j] * W8_SCALE, t[5][j] * W8_SCALE, t[6][j] * W8_SCALE, t[7][j] * W8_SCALE);
        o.z = pk4_fp8(t[8][j] * W8_SCALE, t[9][j] * W8_SCALE, t[10][j] * W8_SCALE, t[11][j] * W8_SCALE); o.w = pk4_fp8(t[12][j] * W8_SCALE, t[13][j] * W8_SCALE, t[14][j] * W8_SCALE, t[15][j] * W8_SCALE);
        const int nl = n0 + 4 * c + j; const int pr = (MODE == 3 || MODE == 4) ? perm16b(nl) : (MODE == 0) ? nl : gu_phys(nl, MODE - 1);
        if (MODE == 4) {
            unsigned char* d = WT + (size_t)pr * K + (k0 & ~127) + 32 * g + 4 * ((k0 >> 6) & 1);
            *(unsigned*)d = o.x; *(unsigned*)(d + 8) = o.y; *(unsigned*)(d + 16) = o.z; *(unsigned*)(d + 24) = o.w;
        } else *(u32x4*)(WT + (size_t)pr * K + k0 + 16 * g) = o; }
}
__device__ __forceinline__ void phase_prologue(const Frame& F, const Prm& p) {
    float* sil = (float*)F.lds;
    for (int i = F.tid; i < 9 * 1024; i += NTHR) { const int r = i >> 10, k = i & 1023; const float v = (r < 8) ? p.c[r * 1024 + k] : p.cctx[k]; sil[i] = silu_f(v); }
    __syncthreads();
    float* MOD = (float*)(p.ws + WS_MOD);
    if (F.bid < 192) {
        const int layer = F.bid / 96, n = (F.bid % 96) * 64 + F.lane; const float* W = p.ada_w + (size_t)layer * 1024 * 6144 + n;
        float acc[9];
#pragma unroll
        for (int r = 0; r < 9; ++r) acc[r] = 0.f;
        const int kb = F.wave * 128;
#pragma unroll 4
        for (int k = kb; k < kb + 128; k += 4) {
            const float w0 = W[(size_t)k * 6144], w1 = W[(size_t)(k + 1) * 6144], w2 = W[(size_t)(k + 2) * 6144], w3 = W[(size_t)(k + 3) * 6144];
#pragma unroll
            for (int r = 0; r < 9; ++r) { const f32x4 s = *(const f32x4*)(sil + r * 1024 + k); acc[r] += s.x * w0 + s.y * w1 + s.z * w2 + s.w * w3; }
        }
        float* red = (float*)(F.lds + 36864 + 8 * 8704);
#pragma unroll
        for (int r = 0; r < 9; ++r) red[(F.wave * 9 + r) * 64 + F.lane] = acc[r];
        __syncthreads();
        if (F.wave == 0) { const float bb = p.ada_b[layer * 6144 + n];
#pragma unroll
            for (int r = 0; r < 9; ++r) { float t = bb;
#pragma unroll
                for (int w = 0; w < 8; ++w) t += red[(w * 9 + r) * 64 + F.lane];
                MOD[(layer * 9 + r) * 6144 + n] = t; } }
    }
    float* misc = (float*)(p.ws + WS_MISC);
    if (F.bid == 255 % F.G && F.wave == 1) {
        const float a = wave_sum(p.lam[F.lane] * p.lam[64 + F.lane]), b = wave_sum(p.lam[128 + F.lane] * p.lam[192 + F.lane]);
        if (F.lane == 0) misc[0] = __expf(a) - __expf(b) + LAMBDA_INIT0;
    }
    if (F.bid == 255 % F.G) {
        for (int i = F.tid; i < 1024; i += NTHR) { const int pos = i >> 4, f = i & 15; const float inv = powf(10000.f, -(float)f / 16.f); const float ang = (float)pos * inv;
            misc[1024 + 2 * i] = cosf(ang); misc[1024 + 2 * i + 1] = sinf(ang); }
    }
    float* scr = (float*)(F.lds + 36864 + F.wave * 8704);
    const int gw = F.bid * NWAVES + F.wave, NGW = F.G * NWAVES;
    constexpr int I_QKV = 16 * 48, I_SQ = 16 * 16, I_G = 16 * 8, I_D = 8 * 16;
    constexpr int I_MOE = 2 * I_G + I_D;
    constexpr int NITEMS = 2 * I_QKV + 2 * I_SQ + 32 * I_MOE;
    bf16* ws16 = (bf16*)p.ws;
    for (int it = gw; it < NITEMS; it += NGW) {
        int r = it;
        if (r < I_QKV) { if ((r % 48) < 32) p0_transpose_item8<0>(p.w_qkv, 1024, 3072, p.ws + WS_WQKV, scr, r, F.lane); else p0_transpose_item8<3>(p.w_qkv, 1024, 3072, p.ws + WS_WQKV, scr, r, F.lane); continue; } r -= I_QKV;
        if (r < I_QKV) { p0_transpose_item8<3>(p.gw_in, 1024, 3072, p.ws + WS_WIN, scr, r, F.lane); continue; } r -= I_QKV;
        if (r < I_SQ) { p0_transpose_item8<3>(p.w_o, 1024, 1024, p.ws + WS_WO, scr, r, F.lane); continue; } r -= I_SQ;
        if (r < I_SQ) { p0_transpose_item8<3>(p.gw_o, 1024, 1024, p.ws + WS_WGO, scr, r, F.lane); continue; } r -= I_SQ;
        const int le = r / I_MOE, layer = le >> 4, e = le & 15; r -= le * I_MOE;
        unsigned char* GU = p.ws + (layer ? WS_GU1 : WS_GU0) + (size_t)e * 1024 * 1024; unsigned char* DN = p.ws + (layer ? WS_DN1 : WS_DN0) + (size_t)e * 1024 * 512;
        if (r < I_G) { p0_transpose_item8<1>(p.mg + (size_t)le * 1024 * 512, 1024, 512, GU, scr, r, F.lane); continue; } r -= I_G;
        if (r < I_G) { p0_transpose_item8<2>(p.mu + (size_t)le * 1024 * 512, 1024, 512, GU, scr, r, F.lane); continue; } r -= I_G;
        p0_transpose_item8<4>(p.md + (size_t)le * 512 * 1024, 512, 1024, DN, scr, r, F.lane);
    }
    (void)ws16;
    unsigned char* WIN = p.ws + WS_WIN;
    for (int i = gw * 64 + F.lane; i < 32 * 256; i += NGW * 64) { const int rr = i >> 8, k = (i & 255) * 4, dir = rr >> 4, j = rr & 15; const float* s = p.gwg_down + (size_t)dir * 1024 * 16 + j;
        *(unsigned*)(WIN + (size_t)(3072 + rr) * 1024 + k) = pk4_fp8(s[(size_t)k * 16] * W8_SCALE, s[(size_t)(k + 1) * 16] * W8_SCALE, s[(size_t)(k + 2) * 16] * W8_SCALE, s[(size_t)(k + 3) * 16] * W8_SCALE); }
    for (int i = gw * 64 + F.lane; i < 224 * 1024 / 16; i += NGW * 64) *(u32x4*)(WIN + (size_t)3104 * 1024 + (size_t)i * 16) = (u32x4){0u, 0u, 0u, 0u};
}

__device__ __forceinline__ void phase_modulate0(const Frame& F, const Prm& p) {
    const float* MOD = (const float*)(p.ws + WS_MOD); unsigned char* H = p.ws + WS_H;
    const int gw = F.bid * NWAVES + F.wave, NGW = F.G * NWAVES, per = (NTOK + NGW - 1) / NGW;
    int curmod = -1; f32x4 sh[4], sc[4];
    const int t0 = gw * per, t1 = min(NTOK, (gw + 1) * per);
    f32x4 v[4], vn[4];
    if (t0 < t1) ld_row_f32(t0 < NLAT ? p.x + (size_t)t0 * DM : p.ctx + (size_t)(t0 - NLAT) * DM, F.lane, v);
    for (int tok = t0; tok < t1; ++tok) {
        if (tok + 1 < t1) ld_row_f32(tok + 1 < NLAT ? p.x + (size_t)(tok + 1) * DM : p.ctx + (size_t)(tok + 1 - NLAT) * DM, F.lane, vn);
        const int mr = tok < NLAT ? tok / SEQ : 8;
        if (mr != curmod) { curmod = mr; ld_row_f32(MOD + mr * 6144, F.lane, sh); ld_row_f32(MOD + mr * 6144 + 1024, F.lane, sc); }
#pragma unroll
        for (int j = 0; j < 4; ++j) v[j] = v[j] * (1.f + sc[j]) + sh[j];
        st_row_fp8(H + (size_t)tok * DM, F.lane, v);
#pragma unroll
        for (int j = 0; j < 4; ++j) v[j] = vn[j];
    }
}

__device__ __forceinline__ void phase_ln_route(const Frame& F, const Prm& p, int layer) {
    const int nrows = layer ? NLAT : NTOK;
    const float* MOD = (const float*)(p.ws + WS_MOD) + layer * 9 * 6144;
    const unsigned char* Y = p.ws + WS_Y;   unsigned char* HF = p.ws + WS_H;
    bf16* XB = (bf16*)(p.ws + WS_XB);
    int* LIST = (int*)(p.ws + WS_LIST); int* TOKR = (int*)(p.ws + WS_TOKR);
    unsigned* CNT = F.ctl + CW_CNT + layer * 16;
    float* WrT = (float*)F.lds;
    int* rec = (int*)(F.lds + 65536);
    unsigned* lcnt = (unsigned*)(F.lds + 65536 + 8192); unsigned* lbase = lcnt + 16;
    for (int i = F.tid; i < 16 * 1024; i += NTHR) { const int k = i >> 4, e = i & 15; WrT[e * 1024 + k] = p.rw[i]; }
    if (F.tid < 16) lcnt[F.tid] = 0u;
    __syncthreads();
    const int per_wg = (nrows + F.G - 1) / F.G, per_w = (per_wg + NWAVES - 1) / NWAVES;
    const int row_lo = F.bid * per_wg, row_hi = min(nrows, row_lo + per_wg);
    const float* lng = p.ln_g + (layer * 2 + 0) * DM; const float* lnb = p.ln_b + (layer * 2 + 0) * DM;
    f32x4 lngr[4], lnbr[4]; ld_row_f32(lng, F.lane, lngr); ld_row_f32(lnb, F.lane, lnbr);
    float rb[16];
#pragma unroll
    for (int e = 0; e < 16; ++e) rb[e] = p.rb[e];
    int curmod = -1; f32x4 gm[4], shf[4], scf[4];
    f32x4 v[4], y[4], vn[4], yn[4];
    f32x4 vS[4]; int lrS = 0; bool pendS = false;
#define LNR_LOAD(tok_, V, Yv) do { if (layer) ld_row_bf16x(XB + (size_t)(tok_) * DM, F.lane, V); else ld_row_f32((tok_) < NLAT ? p.x + (size_t)(tok_) * DM : p.ctx + (size_t)((tok_) - NLAT) * DM, F.lane, V); \
        ld_row_fp8p(Y + (size_t)(tok_) * DM, F.lane, Yv); } while (0)
    if (row_lo + F.wave * per_w < row_hi) LNR_LOAD(row_lo + F.wave * per_w, v, y);
    for (int i = 0; i < per_w; ++i) {
        const int lr = F.wave * per_w + i, tok = row_lo + lr; if (tok >= row_hi) break;
        if (i + 1 < per_w && tok + 1 < row_hi) LNR_LOAD(tok + 1, vn, yn);
        const int mr = tok < NLAT ? tok / SEQ : 8;
        if (mr != curmod) { curmod = mr; ld_row_f32(MOD + mr * 6144 + 2048, F.lane, gm); ld_row_f32(MOD + mr * 6144 + 3072, F.lane, shf); ld_row_f32(MOD + mr * 6144 + 4096, F.lane, scf); }
        bf16* xdst = XB + (size_t)tok * DM;
#pragma unroll
        for (int j = 0; j < 4; ++j) v[j] = ALPHA * v[j] + gm[j] * y[j];
        ln_row_r(v, lngr, lnbr);
        st_row_bf16x(xdst, F.lane, v);
#pragma unroll
        for (int j = 0; j < 4; ++j) v[j] = v[j] * (1.f + scf[j]) + shf[j];
        st_row_fp8(HF + (size_t)tok * DM, F.lane, v);
#define ROUTE_FINISH(P_, LR_) do { \
        { \
        _Pragma("unroll") \
            for (int e = 0; e < 8; ++e) { const auto sw = __builtin_amdgcn_permlane32_swap(__float_as_uint(P_[e]), __float_as_uint(P_[e + 8]), false, false); P_[e] = __uint_as_float(sw[0]) + __uint_as_float(sw[1]); } \
        _Pragma("unroll") \
            for (int e = 0; e < 4; ++e) { const bool up = (F.lane & 16) != 0; const float keep = up ? P_[e + 4] : P_[e], send = up ? P_[e] : P_[e + 4]; P_[e] = keep + xshfl16(send); } \
        _Pragma("unroll") \
            for (int e = 0; e < 2; ++e) { const bool up = (F.lane & 8) != 0; const float keep = up ? P_[e + 2] : P_[e], send = up ? P_[e] : P_[e + 2]; P_[e] = keep + xshfl8(send); } \
            { const bool up = (F.lane & 4) != 0; const float keep = up ? P_[1] : P_[0], send = up ? P_[0] : P_[1]; P_[0] = keep + xshfl4(send); } \
            P_[0] += xshfl2(P_[0]); P_[0] += xshfl1(P_[0]); \
        } \
        float aff[16], sel[16]; \
        _Pragma("unroll") \
        for (int e = 0; e < 16; ++e) { const int src = ((e >> 3) & 1) * 32 + ((e >> 2) & 1) * 16 + ((e >> 1) & 1) * 8 + (e & 1) * 4; const float lg = __int_as_float(__builtin_amdgcn_readlane(__float_as_int(P_[0]), src)); aff[e] = __builtin_amdgcn_rcpf(1.f + __expf(-lg)); sel[e] = aff[e] + rb[e]; } \
        int bg = 0; float bgs = -3.0e38f; \
        _Pragma("unroll") \
        for (int g = 0; g < 4; ++g) { float m1 = -3.0e38f, m2 = -3.0e38f; \
        _Pragma("unroll") \
            for (int k = 0; k < 4; ++k) { const float s = sel[4 * g + k]; if (s > m1) { m2 = m1; m1 = s; } else if (s > m2) m2 = s; } \
            const float gs = m1 + m2; if (gs > bgs) { bgs = gs; bg = g; } } \
        int i1 = 0, i2 = 0; float s1 = -3.0e38f, s2 = -3.0e38f, a1 = 0.f, a2 = 0.f; \
        _Pragma("unroll") \
        for (int g = 0; g < 4; ++g) if (g == bg) { \
        _Pragma("unroll") \
            for (int k = 0; k < 4; ++k) { const float s = sel[4 * g + k], a = aff[4 * g + k]; \
                if (s > s1) { s2 = s1; i2 = i1; a2 = a1; s1 = s; i1 = 4 * g + k; a1 = a; } else if (s > s2) { s2 = s; i2 = 4 * g + k; a2 = a; } } } \
        const float wsum = a1 + a2, rws = __builtin_amdgcn_rcpf(wsum), w1 = a1 * rws, w2 = a2 * rws; \
        if (F.lane == 0) { const unsigned l1 = atomicAdd(&lcnt[i1], 1u), l2 = atomicAdd(&lcnt[i2], 1u); \
            rec[(LR_) * 6 + 0] = i1; rec[(LR_) * 6 + 1] = i2; rec[(LR_) * 6 + 2] = (int)l1; rec[(LR_) * 6 + 3] = (int)l2; rec[(LR_) * 6 + 4] = __float_as_int(w1); rec[(LR_) * 6 + 5] = __float_as_int(w2); } \
        } while (0)
        if (((i & 1) == 0) && (i + 1 < per_w) && (tok + 1 < row_hi)) {
#pragma unroll
            for (int j = 0; j < 4; ++j) vS[j] = v[j];
            lrS = lr; pendS = true;
        } else {
            float partA[16], partB[16];
            if (pendS) {
#pragma unroll
                for (int e = 0; e < 16; ++e) { float sa = 0.f, sb = 0.f;
#pragma unroll
                    for (int j = 0; j < 4; ++j) { const f32x4 w = *(const f32x4*)(WrT + e * 1024 + 4 * F.lane + 256 * j); sa += (vS[j].x * w.x + vS[j].y * w.y) + (vS[j].z * w.z + vS[j].w * w.w); sb += (v[j].x * w.x + v[j].y * w.y) + (v[j].z * w.z + v[j].w * w.w); }
                    partA[e] = sa; partB[e] = sb; }
            } else {
#pragma unroll
                for (int e = 0; e < 16; ++e) { float s = 0.f;
#pragma unroll
                    for (int j = 0; j < 4; ++j) { const f32x4 w = *(const f32x4*)(WrT + e * 1024 + 4 * F.lane + 256 * j); s += (v[j].x * w.x + v[j].y * w.y) + (v[j].z * w.z + v[j].w * w.w); }
                    partB[e] = s; partA[e] = 0.f; }
            }
            ROUTE_FINISH(partB, lr);
            if (pendS) { ROUTE_FINISH(partA, lrS); pendS = false; }
        }
#undef ROUTE_FINISH
#pragma unroll
        for (int j = 0; j < 4; ++j) { v[j] = vn[j]; y[j] = yn[j]; }
    }
#undef LNR_LOAD
    __syncthreads();
    if (F.tid < 16) lbase[F.tid] = __hip_atomic_fetch_add(&CNT[F.tid], lcnt[F.tid], __ATOMIC_RELAXED, __HIP_MEMORY_SCOPE_AGENT);
    __syncthreads();
    for (int lr = F.tid; lr < row_hi - row_lo; lr += NTHR) { const int tok = row_lo + lr;
        const int e0 = rec[lr * 6], e1 = rec[lr * 6 + 1]; const int p0 = (int)lbase[e0] + rec[lr * 6 + 2], p1 = (int)lbase[e1] + rec[lr * 6 + 3];
        LIST[e0 * NTOK + p0] = tok; LIST[e1 * NTOK + p1] = tok;
        int* tr = TOKR + (size_t)tok * 8; tr[0] = e0; tr[1] = p0; tr[2] = e1; tr[3] = p1; tr[4] = rec[lr * 6 + 4]; tr[5] = rec[lr * 6 + 5]; }
    __syncthreads();
}

__device__ __forceinline__ void pad_bases(const unsigned* cnt, int (&pb)[17]) {
    int acc = 0;
#pragma unroll
    for (int e = 0; e < 16; ++e) { pb[e] = acc; const int c = (int)__hip_atomic_load(cnt + e, __ATOMIC_RELAXED, __HIP_MEMORY_SCOPE_AGENT); acc += (c + 255) & ~255; }
    pb[16] = acc;
}

__device__ __forceinline__ void phase_moe_combine(const Frame& F, const Prm& p, int layer) {
    const int nrows = layer ? NLAT : NTOK;
    const float* MOD = (const float*)(p.ws + WS_MOD) + layer * 9 * 6144; const float* MOD1 = (const float*)(p.ws + WS_MOD) + 9 * 6144;
    const unsigned char* YM = p.ws + WS_YM;   unsigned char* H = p.ws + WS_H;   bf16* XB = (bf16*)(p.ws + WS_XB); const int* TOKR = (const int*)(p.ws + WS_TOKR);
    int pb[17]; pad_bases(F.ctl + CW_CNT + layer * 16, pb);
    int* pbl = (int*)F.lds; if (F.tid < 17) { int v = 0;
#pragma unroll
        for (int e = 0; e < 17; ++e) if (e == F.tid) v = pb[e];
        pbl[F.tid] = v; }
    __syncthreads();
    const float* lng = p.ln_g + (layer * 2 + 1) * DM; const float* lnb = p.ln_b + (layer * 2 + 1) * DM;
    f32x4 lngr[4], lnbr[4]; ld_row_f32(lng, F.lane, lngr); ld_row_f32(lnb, F.lane, lnbr);
    const int gw = F.bid * NWAVES + F.wave, NGW = F.G * NWAVES, per = (nrows + NGW - 1) / NGW;
    int curmod = -1; f32x4 gf[4], sh1[4], sc1[4];
    typedef int i32x4r __attribute__((ext_vector_type(4)));
    const int t0 = gw * per, t1 = min(nrows, (gw + 1) * per);
    i32x4r ra = {0, 0, 0, 0}, rb = {0, 0, 0, 0}, rc = {0, 0, 0, 0}; f32x2 wa = {0.f, 0.f}, wb = {0.f, 0.f}, wc = {0.f, 0.f};
#define MC_REC(tok_, R, W) do { const int* tr_ = TOKR + (size_t)(tok_) * 8; R = *(const i32x4r*)tr_; W = *(const f32x2*)(tr_ + 4); } while (0)
#define MC_ROWS(tok_, R, V, A, B) do { ld_row_bf16x(XB + (size_t)(tok_) * DM, F.lane, V); ld_row_fp8p(YM + (size_t)(pbl[R.x] + R.y) * DM, F.lane, A); ld_row_fp8p(YM + (size_t)(pbl[R.z] + R.w) * DM, F.lane, B); } while (0)
    f32x4 v[4], a[4], b[4], vn[4], an[4], bn[4];
    if (t0 < t1) { MC_REC(t0, ra, wa); if (t0 + 1 < t1) MC_REC(t0 + 1, rb, wb); MC_ROWS(t0, ra, v, a, b); }
    for (int tok = t0; tok < t1; ++tok) {
        if (tok + 1 < t1) MC_ROWS(tok + 1, rb, vn, an, bn);
        if (tok + 2 < t1) MC_REC(tok + 2, rc, wc);
        const int mr = tok < NLAT ? tok / SEQ : 8;
        if (mr != curmod) { curmod = mr; ld_row_f32(MOD + mr * 6144 + 5120, F.lane, gf); if (!layer) { ld_row_f32(MOD1 + mr * 6144, F.lane, sh1); ld_row_f32(MOD1 + mr * 6144 + 1024, F.lane, sc1); } }
        const float w0 = wa.x, w1 = wa.y;
        bf16* xp = XB + (size_t)tok * DM;
#pragma unroll
        for (int j = 0; j < 4; ++j) v[j] = ALPHA * v[j] + gf[j] * (w0 * a[j] + w1 * b[j]);
        ln_row_r(v, lngr, lnbr);
        if (layer) st_row_f32(p.out + (size_t)tok * DM, F.lane, v); else st_row_bf16x(xp, F.lane, v);
        if (!layer) {
#pragma unroll
            for (int j = 0; j < 4; ++j) v[j] = v[j] * (1.f + sc1[j]) + sh1[j];
            st_row_fp8(H + (size_t)tok * DM, F.lane, v);
        }
#pragma unroll
        for (int j = 0; j < 4; ++j) { v[j] = vn[j]; a[j] = an[j]; b[j] = bn[j]; }
        ra = rb; wa = wb; rb = rc; wb = wc;
    }
#undef MC_REC
#undef MC_ROWS
}

__device__ __forceinline__ void phase_gla_prep(const Frame& F, const Prm& p) {
    typedef short bf16x8v __attribute__((ext_vector_type(8))); typedef float f32x16v __attribute__((ext_vector_type(16)));
    const bf16* QR = (const bf16*)(p.ws + WS_QR); const bf16* KR = (const bf16*)(p.ws + WS_KR); const float* ZZ = (const float*)(p.ws + WS_ZZ);
    bf16* QT = (bf16*)(p.ws + WS_QT); bf16* KT = (bf16*)(p.ws + WS_KT); float* DEC = (float*)(p.ws + WS_DEC);
    const int gw = F.bid * NWAVES + F.wave, NGW = F.G * NWAVES, r = F.lane & 31, hh = F.lane >> 5;
    static_assert((NWAVES * 256) % 8 == 0, "task stride keeps the column group"); int curdir = -1; bf16x8v bfrc[2] = {}; float bgvc[2] = {0.f, 0.f};
    for (int task = gw; task < 2 * NCHUNK * 8; task += NGW) {
        const int dh = task & 7, chunk = (task >> 3) % NCHUNK, dir = __builtin_amdgcn_readfirstlane(task / (8 * NCHUNK));
        const int tok0 = chunk * 64;
        bf16x8v af[2], bfr[2];
#pragma unroll
        for (int tb = 0; tb < 2; ++tb) { const float* zp = ZZ + (size_t)(tok0 + 32 * tb + r) * 32 + dir * 16 + 8 * hh; const f32x4 z0 = *(const f32x4*)zp, z1 = *(const f32x4*)(zp + 4);
            u32x4 w; w.x = pk2(z0.x, z0.y); w.y = pk2(z0.z, z0.w); w.z = pk2(z1.x, z1.y); w.w = pk2(z1.z, z1.w); af[tb] = __builtin_bit_cast(bf16x8v, w); }
        if (dir != curdir) { curdir = dir;
#pragma unroll
            for (int cb = 0; cb < 2; ++cb) { const float* wp = p.gwg_up + (size_t)dir * 16 * 512 + (size_t)(8 * hh) * 512 + dh * 64 + 2 * r + cb; float wv[8];
#pragma unroll
                for (int i = 0; i < 8; ++i) wv[i] = wp[(size_t)i * 512];
                u32x4 w; w.x = pk2(wv[0], wv[1]); w.y = pk2(wv[2], wv[3]); w.z = pk2(wv[4], wv[5]); w.w = pk2(wv[6], wv[7]); bfrc[cb] = __builtin_bit_cast(bf16x8v, w);
                bgvc[cb] = p.gbg[dir * 512 + dh * 64 + 2 * r + cb]; } }
        const float bgv[2] = {bgvc[0], bgvc[1]};
        bfr[0] = bfrc[0]; bfr[1] = bfrc[1];
        f32x16v Z[2][2];
#pragma unroll
        for (int tb = 0; tb < 2; ++tb)
#pragma unroll
            for (int cb = 0; cb < 2; ++cb) { const f32x16v zero = {}; Z[tb][cb] = __builtin_amdgcn_mfma_f32_32x32x16_bf16(af[tb], bfr[cb], zero, 0, 0, 0); }
#pragma unroll
        for (int tb = 0; tb < 2; ++tb)
#pragma unroll
            for (int cb = 0; cb < 2; ++cb)
#pragma unroll
                for (int i = 0; i < 16; ++i) { const float z = Z[tb][cb][i] + bgv[cb]; Z[tb][cb][i] = (fminf(z, 0.f) - __logf(1.f + __expf(-fabsf(z)))) * (1.f / 16.f); }
        float tot[2];
#pragma unroll
        for (int cb = 0; cb < 2; ++cb) {
            float T[2][4], PT[2][4];
            if (!dir) {
#pragma unroll
                for (int tb = 0; tb < 2; ++tb)
#pragma unroll
                    for (int gi = 0; gi < 4; ++gi) { float run = 0.f;
#pragma unroll
                        for (int w = 0; w < 4; ++w) { run += Z[tb][cb][4 * gi + w]; Z[tb][cb][4 * gi + w] = run; }
                        T[tb][gi] = run; }
            } else {
#pragma unroll
                for (int tb = 0; tb < 2; ++tb)
#pragma unroll
                    for (int gi = 0; gi < 4; ++gi) { float run = 0.f;
#pragma unroll
                        for (int w = 3; w >= 0; --w) { run += Z[tb][cb][4 * gi + w]; Z[tb][cb][4 * gi + w] = run; }
                        T[tb][gi] = run; }
            }
#pragma unroll
            for (int tb = 0; tb < 2; ++tb)
#pragma unroll
                for (int gi = 0; gi < 4; ++gi) PT[tb][gi] = xshfl32(T[tb][gi]);
            float running = 0.f;
            if (!dir) {
#pragma unroll
                for (int tb = 0; tb < 2; ++tb)
#pragma unroll
                    for (int gi = 0; gi < 4; ++gi) { const float first = hh ? PT[tb][gi] : T[tb][gi], second = hh ? T[tb][gi] : PT[tb][gi];
                        const float mine = hh ? running + first : running; running += first + second;
#pragma unroll
                        for (int w = 0; w < 4; ++w) Z[tb][cb][4 * gi + w] += mine; }
            } else {
#pragma unroll
                for (int tb = 1; tb >= 0; --tb)
#pragma unroll
                    for (int gi = 3; gi >= 0; --gi) { const float first = hh ? T[tb][gi] : PT[tb][gi], second = hh ? PT[tb][gi] : T[tb][gi];
                        const float mine = hh ? running : running + first; running += first + second;
#pragma unroll
                        for (int w = 0; w < 4; ++w) Z[tb][cb][4 * gi + w] += mine; }
            }
            tot[cb] = running;
        }
        if (hh == 0) {
#pragma unroll
            for (int cb = 0; cb < 2; ++cb) DEC[((size_t)dir * NCHUNK + chunk) * 512 + dh * 64 + 2 * r + cb] = __expf(tot[cb]);
        }
        const bf16* qi = QR + ((size_t)dh * NTOK + tok0) * 64 + 2 * r; const bf16* ki = KR + ((size_t)dh * NTOK + tok0) * 64 + 2 * r;
        bf16* qo = QT + (((size_t)dir * 8 + dh) * NTOK + tok0) * 64 + 2 * r; bf16* ko = KT + (((size_t)dir * 8 + dh) * NTOK + tok0) * 64 + 2 * r;
#pragma unroll
        for (int tb = 0; tb < 2; ++tb) {
            unsigned qv[16], kv[16];
#pragma unroll
            for (int i = 0; i < 16; ++i) { const int t = 32 * tb + (i & 3) + 8 * (i >> 2) + 4 * hh; qv[i] = *(const unsigned*)(qi + (size_t)t * 64); kv[i] = *(const unsigned*)(ki + (size_t)t * 64); }
#pragma unroll
            for (int i = 0; i < 16; ++i) { const int t = 32 * tb + (i & 3) + 8 * (i >> 2) + 4 * hh;
                const float e0 = __expf(Z[tb][0][i]), e1 = __expf(Z[tb][1][i]), i0 = __builtin_amdgcn_rcpf(e0), i1 = __builtin_amdgcn_rcpf(e1);
                *(unsigned*)(qo + (size_t)t * 64) = pk2(bf2f(qv[i] & 0xffffu) * e0, bf2f(qv[i] >> 16) * e1);
                *(unsigned*)(ko + (size_t)t * 64) = pk2(bf2f(kv[i] & 0xffffu) * i0, bf2f(kv[i] >> 16) * i1); }
        }
    }
}

__device__ __forceinline__ void phase_gla_post(const Frame& F, const Prm& p) {
    const bf16* OF = (const bf16*)p.out; const bf16* OB = (const bf16*)((const unsigned char*)p.out + OUT_OGB); const unsigned char* R = p.ws + WS_R;   unsigned char* A2 = p.ws + WS_A2B;
    const f32x4 ng = *(const f32x4*)(p.gnorm + 4 * F.lane);
    const int gw = F.bid * NWAVES + F.wave, NGW = F.G * NWAVES;
    f32x4 a[4], b[4], r[4], an[4], bn[4], rn[4];
    if (gw < NLAT) { ld_row_bf16(OF + (size_t)gw * DM, F.lane, a); ld_row_bf16(OB + (size_t)gw * DM, F.lane, b); ld_row_fp8p(R + (size_t)gw * DM, F.lane, r); }
    for (int tok = gw; tok < NLAT; tok += NGW) {
        if (tok + NGW < NLAT) { ld_row_bf16(OF + (size_t)(tok + NGW) * DM, F.lane, an); ld_row_bf16(OB + (size_t)(tok + NGW) * DM, F.lane, bn); ld_row_fp8p(R + (size_t)(tok + NGW) * DM, F.lane, rn); }
#pragma unroll
        for (int j = 0; j < 4; ++j) {
            const f32x4 o = a[j] + b[j]; const float q = wave_sum((o.x * o.x + o.y * o.y) + (o.z * o.z + o.w * o.w));
            const float rs = __builtin_amdgcn_rsqf(q * (1.f / 256.f) + LN_EPS);
#define SILU_R(v_) ((v_) * __builtin_amdgcn_rcpf(1.f + __expf(-(v_))))
            a[j] = (f32x4){o.x * rs * ng.x * SILU_R(r[j].x), o.y * rs * ng.y * SILU_R(r[j].y), o.z * rs * ng.z * SILU_R(r[j].z), o.w * rs * ng.w * SILU_R(r[j].w)};
#undef SILU_R
        }
        st_row_fp8(A2 + (size_t)tok * DM, F.lane, a);
#pragma unroll
        for (int j = 0; j < 4; ++j) { a[j] = an[j]; b[j] = bn[j]; r[j] = rn[j]; }
    }
}
namespace pg8 {
typedef short bf16x8 __attribute__((ext_vector_type(8)));
constexpr int BM = 256, BK = 64, HALF = 128, HTB = HALF * BK * 2, STAGE_BYTES = 8 * HTB, NXCD = 8, WGM = 8;
__host__ __device__ __forceinline__ int lds_byte(int r, int c) { const int st = (r >> 4) * 2 + (c >> 5), rr = r & 15, cc = c & 31, ob = rr * 64 + cc * 2; return st * 1024 + (ob ^ (((ob >> 9) & 1) << 5)); }
__host__ __device__ __forceinline__ void stage_rc(int b, int& R, int& C) { const int st = b / 1024, sb = b % 1024, swz = sb ^ (((sb >> 9) & 1) << 5); R = (st >> 1) * 16 + swz / 64; C = (st & 1) * 32 + (swz % 64) / 2; }
typedef float f32x2_t __attribute__((ext_vector_type(2))); typedef __bf16 bf16x2_t __attribute__((ext_vector_type(2)));
__device__ __forceinline__ unsigned cvt_pk_bf16(float lo, float hi) { f32x2_t v = {lo, hi}; bf16x2_t b = __builtin_convertvector(v, bf16x2_t); return __builtin_bit_cast(unsigned, b); }

struct Unit { int pm, pn; int row0; int e; int cnt; const bf16* Bt; };

struct DenseOrder {
    int nM, nN, nwg, G, c, K; const bf16* Bt;
    __device__ void init(int M, int N, int K_, const bf16* Bt_, int G_, int c_) { nM = M / BM; nN = N / BM; nwg = nM * nN; G = G_; c = c_; K = K_; Bt = Bt_; }
    __device__ bool next(int i, Unit& u) const {
        const long L = (long)i * G + c; if (L >= nwg) return false;
        int wgid = (int)L; { const int q = nwg / NXCD, r = nwg % NXCD, xcd = wgid % NXCD, off = wgid / NXCD; wgid = (xcd < r ? xcd * (q + 1) : r * (q + 1) + (xcd - r) * q) + off; }
        const int nig = WGM * nN, gid = wgid / nig, fm = gid * WGM, gsz = (nM - fm) < WGM ? (nM - fm) : WGM;
        u.pm = fm + ((wgid % nig) % gsz); u.pn = (wgid % nig) / gsz; u.row0 = u.pm * BM; u.e = 0; u.cnt = 0; u.Bt = Bt; return true;
    }
    __device__ __forceinline__ unsigned arow(const Unit& u, int r) const { return (unsigned)(u.row0 + r) * (unsigned)(K * 2); }
};
template <bool GATHER> struct MoeOrder {
    int cnt[16]; int nN, G, c, K; const bf16* Bt0; size_t bstride; const int* LIST;
    __device__ void init(const unsigned* cntw, int N, int K_, const bf16* Bt0_, const int* LIST_, int G_, int c_) {
#pragma unroll
        for (int e = 0; e < 16; ++e) cnt[e] = (int)__hip_atomic_load(cntw + e, __ATOMIC_RELAXED, __HIP_MEMORY_SCOPE_AGENT);
        nN = N / BM; G = G_; c = c_; K = K_; Bt0 = Bt0_; bstride = (size_t)N * K_; LIST = LIST_; }
    __device__ bool next(int i, Unit& u) const {
        int L = i * G + c, base = 0; bool found = false; u.pm = 0; u.pn = 0; u.row0 = 0; u.e = 0; u.cnt = 0; u.Bt = Bt0;
#pragma unroll
        for (int e = 0; e < 16; ++e) { const int mt = (cnt[e] + 255) >> 8, nu = mt * nN;
            if (!found) { if (L < nu) { found = true; u.e = e; u.cnt = cnt[e]; u.pm = L / nN; u.pn = L % nN; u.row0 = base + u.pm * BM; u.Bt = Bt0 + (size_t)e * bstride; } else { L -= nu; base += mt * BM; } } }
        return found;
    }
    __device__ __forceinline__ unsigned arow(const Unit& u, int r) const {
        if (GATHER) { const int li = u.pm * BM + r; int tok = 0; if (li < u.cnt) tok = LIST[u.e * NTOK + li];
            return (unsigned)tok * (unsigned)(K * 2); }
        return (unsigned)(u.row0 + r) * (unsigned)(K * 2);
    }
};

typedef f32x4 Acc[2][2][4][2];
__device__ __forceinline__ void st4bf(bf16* p, f32x4 v) { u32x2 w; w.x = cvt_pk_bf16(v.x, v.y); w.y = cvt_pk_bf16(v.z, v.w); *(u32x2*)p = w; }
__device__ __forceinline__ void st8bf(bf16* p, f32x4 a, f32x4 b) { u32x4 w; w.x = cvt_pk_bf16(a.x, a.y); w.y = cvt_pk_bf16(a.z, a.w); w.z = cvt_pk_bf16(b.x, b.y); w.w = cvt_pk_bf16(b.z, b.w); *(u32x4*)p = w; }

__device__ __forceinline__ void st_pair16(unsigned char* base0, unsigned char* base1, u32x2 w0, u32x2 w1, int fq) {
    const auto sx = __builtin_amdgcn_permlane16_swap(w0.x, w1.x, false, false); const auto sy = __builtin_amdgcn_permlane16_swap(w0.y, w1.y, false, false);
    unsigned char* p = (fq & 1) ? base1 - 8 : base0;
    *(u32x4*)p = (u32x4){sx[0], sy[0], sx[1], sy[1]};
}
struct EpiQKV {
    bf16 *Q; const LAS float* rope; float wsc; unsigned* km;
    __device__ __forceinline__ void operator()(const Acc& acc, const Unit& u, int wr, int wc, int fr, int fq) const {
        const int reg = u.pn >> 2; bf16* O = Q + (size_t)reg * ((WS_K - WS_Q) / 2);
        if (reg == 2) { const int cbase = (u.pn & 3) * BM + wc * 32 + 8 * fq;
#pragma unroll
            for (int ai = 0; ai < 2; ++ai)
#pragma unroll
                for (int m = 0; m < 4; m += 2) { unsigned char* rowp = (unsigned char*)Q + (size_t)2 * (WS_K - WS_Q) + (size_t)(u.row0 + ai * HALF + wr * 64 + m * 16 + fr) * DM + cbase;
#pragma unroll
                    for (int bj = 0; bj < 2; ++bj) { u32x2 w0, w1;
                        { const f32x4 a = acc[ai][bj][m][0] * wsc, b = acc[ai][bj][m][1] * wsc; w0.x = pk4_fp8(a.x, a.y, a.z, a.w); w0.y = pk4_fp8(b.x, b.y, b.z, b.w); }
                        { const f32x4 a = acc[ai][bj][m + 1][0] * wsc, b = acc[ai][bj][m + 1][1] * wsc; w1.x = pk4_fp8(a.x, a.y, a.z, a.w); w1.y = pk4_fp8(b.x, b.y, b.z, b.w); }
                        st_pair16(rowp + bj * HALF, rowp + 16 * DM + bj * HALF, w0, w1, fq); } }
            return; }
        const int cbase = (u.pn & 3) * BM + wc * 32 + 8 * fq;
        const bool dorope = (u.row0 < NLAT); const float sc = (reg == 0 ? C2 : 1.f) * wsc; float kn[2] = {0.f, 0.f}; u32x2 wsv[2] = {{0u, 0u}, {0u, 0u}};
#pragma unroll
        for (int ai = 0; ai < 2; ++ai)
#pragma unroll
            for (int m = 0; m < 4; ++m) { const int row = u.row0 + ai * HALF + wr * 64 + m * 16 + fr; unsigned char* rowp = (unsigned char*)Q + (size_t)reg * (WS_K - WS_Q) + (size_t)row * DM + cbase;
                f32x4 cs = {1.f, 1.f, 1.f, 1.f}, sn = {0.f, 0.f, 0.f, 0.f};
                if (dorope) { const int s = row & (SEQ - 1), pos = (wc & 1) ? (s & 63) : (s >> 6); const f32x4 t0 = *(const LAS f32x4*)(rope + (pos * 16 + 4 * fq) * 2), t1 = *(const LAS f32x4*)(rope + (pos * 16 + 4 * fq) * 2 + 4);
                    cs = (f32x4){t0.x, t0.z, t1.x, t1.z}; sn = (f32x4){t0.y, t0.w, t1.y, t1.w}; }
                { f32x4 c2 = cs, s2 = sn;
#pragma unroll
                  for (int j = 0; j < 4; ++j) { float x0 = c2[j] * sc, x1 = s2[j] * sc; asm("" : "+v"(x0)); asm("" : "+v"(x1)); cs[j] = x0; sn[j] = x1; } }
#pragma unroll
                for (int bj = 0; bj < 2; ++bj) { const f32x4 a0 = acc[ai][bj][m][0], a1 = acc[ai][bj][m][1];
                    f32x4 o0, o1;
#pragma unroll
                    for (int j = 0; j < 4; ++j) { float x0 = __builtin_fmaf(-a1[j], sn[j], a0[j] * cs[j]), x1 = __builtin_fmaf(a0[j], sn[j], a1[j] * cs[j]); asm("" : "+v"(x0)); asm("" : "+v"(x1)); o0[j] = x0; o1[j] = x1; }
                    { u32x2 w; w.x = pk4_fp8(o0[0], o0[1], o0[2], o0[3]); w.y = pk4_fp8(o1[0], o1[1], o1[2], o1[3]);
                      if ((m & 1) == 0) wsv[bj] = w; else st_pair16(rowp - 16 * DM + bj * HALF, rowp + bj * HALF, wsv[bj], w, fq); }
                    if (reg == 1) { const float ps = (o0.x * o0.x + o0.y * o0.y) + (o0.z * o0.z + o0.w * o0.w) + (o1.x * o1.x + o1.y * o1.y) + (o1.z * o1.z + o1.w * o1.w);
                        kn[bj] = fmaxf(kn[bj], ps); } } }
        if (reg == 1) {
            const int b = u.row0 < NLAT ? u.row0 / SEQ : (u.row0 - NLAT) / CTXL;
#pragma unroll
            for (int bj = 0; bj < 2; ++bj) { float v = kn[bj];
#pragma unroll
                for (int s = 1; s < 64; s <<= 1) v = fmaxf(v, __shfl_xor(v, s));
                if (fr == 0 && fq == 0) __hip_atomic_fetch_max(km + b * 16 + 4 * (u.pn & 3) + 2 * bj + (wc >> 1), __float_as_uint(9.2f * v), __ATOMIC_RELAXED, __HIP_MEMORY_SCOPE_AGENT); } }
    }
};
struct EpiPlain {
    bf16* O; float sc;
    __device__ __forceinline__ void operator()(const Acc& acc, const Unit& u, int wr, int wc, int fr, int fq) const {
        const int cbase = u.pn * BM + wc * 32 + 8 * fq;
#pragma unroll
        for (int ai = 0; ai < 2; ++ai)
#pragma unroll
            for (int m = 0; m < 4; ++m) { bf16* rowp = O + (size_t)(u.row0 + ai * HALF + wr * 64 + m * 16 + fr) * DM + cbase;
#pragma unroll
                for (int bj = 0; bj < 2; ++bj) st8bf(rowp + bj * HALF, acc[ai][bj][m][0] * sc, acc[ai][bj][m][1] * sc); }
    }
};
struct EpiPlain8 {
    unsigned char* O; float sc;
    __device__ __forceinline__ void operator()(const Acc& acc, const Unit& u, int wr, int wc, int fr, int fq) const {
        const int cbase = u.pn * BM + wc * 64 + 16 * fq;
#pragma unroll
        for (int ai = 0; ai < 2; ++ai)
#pragma unroll
            for (int m = 0; m < 4; ++m) { unsigned char* rowp = O + (size_t)(u.row0 + ai * HALF + wr * 64 + m * 16 + fr) * DM + cbase; u32x4 w;
                { const f32x4 a = acc[ai][0][m][0] * sc, b = acc[ai][0][m][1] * sc; w.x = pk4_fp8(a.x, a.y, a.z, a.w); w.y = pk4_fp8(b.x, b.y, b.z, b.w); }
                { const f32x4 a = acc[ai][1][m][0] * sc, b = acc[ai][1][m][1] * sc; w.z = pk4_fp8(a.x, a.y, a.z, a.w); w.w = pk4_fp8(b.x, b.y, b.z, b.w); }
                *(u32x4*)rowp = w; }
    }
};
struct EpiInproj {
    bf16 *QR, *KR, *V, *R; float* ZZ; float wsc;
    __device__ __forceinline__ void operator()(const Acc& acc, const Unit& u, int wr, int wc, int fr, int fq) const {
        const int pn = u.pn;
        if (pn == 12) { if (wc == 0) {
#pragma unroll
            for (int ai = 0; ai < 2; ++ai)
#pragma unroll
                for (int m = 0; m < 4; ++m) { float* rowp = ZZ + (size_t)(u.row0 + ai * HALF + wr * 64 + m * 16 + fr) * 32 + 4 * fq;
                    *(f32x4*)rowp = acc[ai][0][m][0] * wsc; *(f32x4*)(rowp + 16) = acc[ai][0][m][1] * wsc; } }
            return; }
        float sc = wsc;
        if (pn < 4) {
            bf16* O = pn < 2 ? QR : KR; if (pn < 2) sc = 0.08838834764831845f * wsc;
            const int cb = (pn & 1) * BM + wc * 32 + 8 * fq;
#pragma unroll
            for (int ai = 0; ai < 2; ++ai)
#pragma unroll
                for (int m = 0; m < 4; ++m) { const size_t row = (size_t)(u.row0 + ai * HALF + wr * 64 + m * 16 + fr);
#pragma unroll
                    for (int bj = 0; bj < 2; ++bj) { const int col = cb + bj * HALF; st8bf(O + ((size_t)(col >> 6) * NTOK + row) * 64 + (col & 63), acc[ai][bj][m][0] * sc, acc[ai][bj][m][1] * sc); } }
            return; }
        if (pn >= 8) {
            const int cbase = (pn - 8) * BM + wc * 64 + 16 * fq;
#pragma unroll
            for (int ai = 0; ai < 2; ++ai)
#pragma unroll
                for (int m = 0; m < 4; ++m) { unsigned char* rowp = (unsigned char*)R + (size_t)(u.row0 + ai * HALF + wr * 64 + m * 16 + fr) * DM + cbase; u32x4 w;
                    { const f32x4 a = acc[ai][0][m][0] * sc, b = acc[ai][0][m][1] * sc; w.x = pk4_fp8(a.x, a.y, a.z, a.w); w.y = pk4_fp8(b.x, b.y, b.z, b.w); }
                    { const f32x4 a = acc[ai][1][m][0] * sc, b = acc[ai][1][m][1] * sc; w.z = pk4_fp8(a.x, a.y, a.z, a.w); w.w = pk4_fp8(b.x, b.y, b.z, b.w); }
                    *(u32x4*)rowp = w; }
            return; }
        const int cbase = (pn - 4) * BM + wc * 32 + 8 * fq;
#pragma unroll
        for (int ai = 0; ai < 2; ++ai)
#pragma unroll
            for (int m = 0; m < 4; ++m) { bf16* rowp = V + (size_t)(u.row0 + ai * HALF + wr * 64 + m * 16 + fr) * DM + cbase;
#pragma unroll
                for (int bj = 0; bj < 2; ++bj) st8bf(rowp + bj * HALF, acc[ai][bj][m][0] * sc, acc[ai][bj][m][1] * sc); }
    }
};
struct EpiGateUp {
    unsigned char* ACT;
    __device__ __forceinline__ void operator()(const Acc& acc, const Unit& u, int wr, int wc, int fr, int fq) const {
        const int obase = u.pn * (BM / 2) + wc * 32 + 8 * fq;
#pragma unroll
        for (int ai = 0; ai < 2; ++ai)
#pragma unroll
            for (int m = 0; m < 4; m += 2) { unsigned char* rowp = ACT + (size_t)(u.row0 + ai * HALF + wr * 64 + m * 16 + fr) * DEXP + obase; u32x2 w2[2];
#pragma unroll
                for (int mm = 0; mm < 2; ++mm)
#pragma unroll
                    for (int bj = 0; bj < 2; ++bj) { const f32x4 g = acc[ai][bj][m + mm][0], up = acc[ai][bj][m + mm][1]; f32x4 o;
#pragma unroll
                        for (int j = 0; j < 4; ++j) o[j] = g[j] * __builtin_amdgcn_rcpf(1.f + __expf(-g[j])) * up[j];
                        w2[mm][bj] = pk4_fp8(o[0], o[1], o[2], o[3]); }
                st_pair16(rowp, rowp + 16 * DEXP, w2[0], w2[1], fq); }
    }
};

typedef int i32x8 __attribute__((ext_vector_type(8)));
typedef int i32x4 __attribute__((ext_vector_type(4)));
__device__ __forceinline__ i32x8 cat8(bf16x8 lo, bf16x8 hi) { return __builtin_shufflevector(__builtin_bit_cast(i32x4, lo), __builtin_bit_cast(i32x4, hi), 0, 1, 2, 3, 4, 5, 6, 7); }
template <class Epi, class Sched, bool FP8 = false>
__device__ __forceinline__ void gemm_phase(unsigned char* ldsg, const bf16* A, int K, const Sched& S, const Epi& E, int tid_in) {
    LAS unsigned char* lds = (LAS unsigned char*)ldsg;
    const int tid = tid_in, wid = __builtin_amdgcn_readfirstlane(tid >> 6), lane = tid & 63, wr = wid >> 2, wc = wid & 3, fr = lane & 15, fq = lane >> 4;
    const int nt = K / BK;
    int Rr[2]; unsigned colb[2], voffB[2];
#pragma unroll
    for (int i = 0; i < 2; ++i) { int R, C; stage_rc(tid * 16 + i * 8192, R, C); Rr[i] = R; colb[i] = (unsigned)C * 2u; voffB[i] = (unsigned)(R * K + C) * 2u; }
    const size_t kstep = (size_t)(BK * 2);
    const size_t hstep = (size_t)HALF * K * 2;
    const size_t tstep = 2 * hstep;
    const unsigned ldsw = (unsigned)wid * 1024u;
    const int aoff = lds_byte(wr * 64 + fr, fq * 8), boff = lds_byte(wc * 32 + fr, fq * 8);
#define PG8_SA(b, h) (((b) * 2 + (h)) * HTB)
#define PG8_SB(b, h) ((4 + (b) * 2 + (h)) * HTB)
#define PG8_STAGE(bufoff, gbase, voff) do { _Pragma("unroll") for (int _i = 0; _i < 2; ++_i) \
        __builtin_amdgcn_global_load_lds((const unsigned*)((const char*)(gbase) + (voff)[_i]), (LAS unsigned*)(lds + (bufoff) + ldsw + _i * 8192), 16, 0, 0); } while (0)
#define PG8_LDA(dst, b, h) do { if constexpr (FP8) { _Pragma("unroll") for (int m = 0; m < 4; ++m) dst##8[m] = cat8(*(const LAS bf16x8*)(lds + PG8_SA(b, h) + aoff + m * 2048), *(const LAS bf16x8*)(lds + PG8_SA(b, h) + aoff + m * 2048 + 1024)); } \
        else { _Pragma("unroll") for (int m = 0; m < 4; ++m) _Pragma("unroll") for (int k = 0; k < 2; ++k) dst[m][k] = *(const LAS bf16x8*)(lds + PG8_SA(b, h) + aoff + m * 2048 + k * 1024); } } while (0)
#define PG8_LDB(dst, b, h) do { if constexpr (FP8) { _Pragma("unroll") for (int n = 0; n < 2; ++n) dst##8[n] = cat8(*(const LAS bf16x8*)(lds + PG8_SB(b, h) + boff + n * 2048), *(const LAS bf16x8*)(lds + PG8_SB(b, h) + boff + n * 2048 + 1024)); } \
        else { _Pragma("unroll") for (int n = 0; n < 2; ++n) _Pragma("unroll") for (int k = 0; k < 2; ++k) dst[n][k] = *(const LAS bf16x8*)(lds + PG8_SB(b, h) + boff + n * 2048 + k * 1024); } } while (0)
#define PG8_MMA(ai, bj, At, Bt) do { __builtin_amdgcn_s_setprio(1); \
        if constexpr (FP8) { _Pragma("unroll") for (int m = 0; m < 4; ++m) _Pragma("unroll") for (int n = 0; n < 2; ++n) \
            asm volatile("v_mfma_scale_f32_16x16x128_f8f6f4 %0, %1, %2, %0, %3, %3 op_sel:[0,1,0] op_sel_hi:[0,0,0]" : "+v"(acc[ai][bj][m][n]) : "v"(Bt##8[n]), "v"(At##8[m]), "v"(sc8)); } \
        else { _Pragma("unroll") for (int m = 0; m < 4; ++m) _Pragma("unroll") for (int n = 0; n < 2; ++n) _Pragma("unroll") for (int k = 0; k < 2; ++k) \
            acc[ai][bj][m][n] = __builtin_amdgcn_mfma_f32_16x16x32_bf16(Bt[n][k], At[m][k], acc[ai][bj][m][n], 0, 0, 0); } \
        __builtin_amdgcn_s_setprio(0); } while (0)
#define PG8_WAIT_V(n) asm volatile("s_waitcnt vmcnt(" #n ")" ::: "memory")
#define PG8_WAIT_L(n) asm volatile("s_waitcnt lgkmcnt(" #n ")" ::: "memory")
#define PG8_BAR __builtin_amdgcn_s_barrier()
#define PG8_SCHED __builtin_amdgcn_sched_barrier(0)
    Unit cur, nxt; int ui = 0;
    if (!S.next(0, cur)) return;
    Acc acc;
#pragma unroll
    for (int a = 0; a < 2; ++a)
#pragma unroll
        for (int b = 0; b < 2; ++b)
#pragma unroll
            for (int m = 0; m < 4; ++m)
#pragma unroll
                for (int n = 0; n < 2; ++n) acc[a][b][m][n] = (f32x4){0.f, 0.f, 0.f, 0.f};
    const int sc8 = 0x7f7f7f79;
    bf16x8 At[4][2], B0[2][2], B1[2][2]; i32x8 At8[4], B08[2], B18[2];
    unsigned aC0[2], aC1[2], aN0[2], aN1[2];
#pragma unroll
    for (int i = 0; i < 2; ++i) { aC0[i] = S.arow(cur, Rr[i]) + colb[i]; aC1[i] = S.arow(cur, HALF + Rr[i]) + colb[i]; }
    const char* Ab = (const char*)A;
    const char* cB = (const char*)cur.Bt + (size_t)cur.pn * tstep;
    PG8_STAGE(PG8_SB(0, 0), cB, voffB); PG8_STAGE(PG8_SB(0, 1), cB + hstep, voffB); PG8_STAGE(PG8_SA(0, 0), Ab, aC0); PG8_STAGE(PG8_SA(0, 1), Ab, aC1);
    if (wr == 1) PG8_BAR;
    PG8_WAIT_V(2); PG8_BAR;
    PG8_STAGE(PG8_SB(1, 0), cB + kstep, voffB); PG8_STAGE(PG8_SA(1, 0), Ab + kstep, aC0); PG8_STAGE(PG8_SB(1, 1), cB + hstep + kstep, voffB);
    PG8_WAIT_V(6); PG8_BAR;
    for (;;) {
        const bool has_next = S.next(ui + 1, nxt);
        if (has_next) {
#pragma unroll
            for (int i = 0; i < 2; ++i) { aN0[i] = S.arow(nxt, Rr[i]) + colb[i]; aN1[i] = S.arow(nxt, HALF + Rr[i]) + colb[i]; }
        } else {
#pragma unroll
            for (int i = 0; i < 2; ++i) { aN0[i] = aC0[i]; aN1[i] = aC1[i]; }
        }
        const char* nB = has_next ? (const char*)nxt.Bt + (size_t)nxt.pn * tstep : cB;
        for (int t = 0; t < nt; t += 2) {
            const bool last = (t == nt - 2);
            const char* a1 = Ab + (size_t)(t + 1) * kstep;
            const char* a2 = last ? Ab : Ab + (size_t)(t + 2) * kstep; const char* b2 = last ? nB : cB + (size_t)(t + 2) * kstep;
            const char* a3 = a2 + kstep; const char* b3 = b2 + kstep;
            unsigned x0[2], x1[2];
#pragma unroll
            for (int i = 0; i < 2; ++i) { x0[i] = last ? aN0[i] : aC0[i]; x1[i] = last ? aN1[i] : aC1[i]; }
            PG8_LDB(B0, 0, 0); PG8_LDB(B1, 0, 1); PG8_SCHED; PG8_LDA(At, 0, 0); PG8_STAGE(PG8_SA(1, 1), a1, aC1);
            PG8_WAIT_V(8); PG8_WAIT_L(0); PG8_BAR; PG8_MMA(0, 0, At, B0); PG8_MMA(0, 1, At, B1); PG8_BAR; PG8_SCHED;
            PG8_LDA(At, 0, 1); PG8_STAGE(PG8_SB(0, 0), b2, voffB); PG8_STAGE(PG8_SB(0, 1), b2 + hstep, voffB); PG8_STAGE(PG8_SA(0, 0), a2, x0);
            PG8_WAIT_V(8); PG8_WAIT_L(0); PG8_BAR; PG8_MMA(1, 0, At, B0); PG8_MMA(1, 1, At, B1); PG8_BAR; PG8_SCHED;
            PG8_LDB(B0, 1, 0); PG8_LDB(B1, 1, 1); PG8_SCHED; PG8_LDA(At, 1, 0); PG8_STAGE(PG8_SA(0, 1), a2, x1);
            PG8_WAIT_V(8); PG8_WAIT_L(0); PG8_BAR; PG8_MMA(0, 0, At, B0); PG8_MMA(0, 1, At, B1); PG8_BAR; PG8_SCHED;
            PG8_LDA(At, 1, 1); PG8_STAGE(PG8_SB(1, 0), b3, voffB); PG8_STAGE(PG8_SB(1, 1), b3 + hstep, voffB); PG8_STAGE(PG8_SA(1, 0), a3, x0);
            PG8_WAIT_V(8); PG8_WAIT_L(0); PG8_BAR; PG8_MMA(1, 0, At, B0); PG8_MMA(1, 1, At, B1); PG8_BAR; PG8_SCHED;
        }
        if (wr == 0) PG8_BAR;
        if constexpr (FP8) asm volatile("s_nop 15\n\ts_nop 7" ::: "memory");
        E(acc, cur, wr, wc, fr, fq);
        if (!has_next) break;
#pragma unroll
        for (int a = 0; a < 2; ++a)
#pragma unroll
            for (int b = 0; b < 2; ++b)
#pragma unroll
                for (int m = 0; m < 4; ++m)
#pragma unroll
                    for (int n = 0; n < 2; ++n) acc[a][b][m][n] = (f32x4){0.f, 0.f, 0.f, 0.f};
        cur = nxt; cB = nB; ++ui;
#pragma unroll
        for (int i = 0; i < 2; ++i) { aC0[i] = aN0[i]; aC1[i] = aN1[i]; }
        if (wr == 1) PG8_BAR;
    }
    PG8_WAIT_V(0);
    PG8_BAR;
#undef PG8_SA
#undef PG8_SB
#undef PG8_STAGE
#undef PG8_LDA
#undef PG8_LDB
#undef PG8_MMA
#undef PG8_WAIT_V
#undef PG8_WAIT_L
#undef PG8_BAR
#undef PG8_SCHED
}
}

__device__ __forceinline__ int vcu_of(const Frame& F) { return (F.G % 8 == 0) ? (F.bid % 8) * (F.G / 8) + F.bid / 8 : F.bid; }
__device__ __forceinline__ void phase_qkv_opt(const Frame& F, const Prm& p) {
    pg8::DenseOrder S; S.init(NTOK, 3072, 512, (const bf16*)(p.ws + WS_WQKV), F.G, F.bid);
    static_assert(WS_V - WS_K == WS_K - WS_Q, "Q|K|V equally spaced");
    LAS float* ropel = (LAS float*)((LAS unsigned char*)F.lds + LDSX_OFF);
    const float* ropeg = (const float*)(p.ws + WS_MISC) + 1024;
    for (int i = F.tid; i < 2048; i += NTHR) ropel[i] = ropeg[i];
    __syncthreads();
    pg8::EpiQKV E{(bf16*)(p.ws + WS_Q), ropel, 1.f, F.ctl + CW_KM};
    pg8::gemm_phase<pg8::EpiQKV, pg8::DenseOrder, true>(F.lds, (const bf16*)(p.ws + WS_H), 512, S, E, F.tid);
}
__device__ __forceinline__ void phase_wo_opt(const Frame& F, const Prm& p, int layer) {
    if (layer) {
        pg8::DenseOrder S; S.init(NLAT, 1024, 512, (const bf16*)(p.ws + WS_WGO), F.G, F.bid);
        pg8::EpiPlain8 E{p.ws + WS_Y, 1.f};
        pg8::gemm_phase<pg8::EpiPlain8, pg8::DenseOrder, true>(F.lds, (const bf16*)(p.ws + WS_A2B), 512, S, E, F.tid);
    } else {
        pg8::DenseOrder S; S.init(NTOK, 1024, 512, (const bf16*)(p.ws + WS_WO), F.G, F.bid);
        pg8::EpiPlain8 E{p.ws + WS_Y, 1.f};
        pg8::gemm_phase<pg8::EpiPlain8, pg8::DenseOrder, true>(F.lds, (const bf16*)(p.ws + WS_A2), 512, S, E, F.tid);
    }
}
__device__ __forceinline__ void phase_inproj_opt(const Frame& F, const Prm& p) {
    pg8::DenseOrder S; S.init(NTOK, NIN, 512, (const bf16*)(p.ws + WS_WIN), F.G, F.bid);
    pg8::EpiInproj E{(bf16*)(p.ws + WS_QR), (bf16*)(p.ws + WS_KR), (bf16*)(p.ws + WS_V1), (bf16*)(p.ws + WS_R), (float*)(p.ws + WS_ZZ), 1.f};
    pg8::gemm_phase<pg8::EpiInproj, pg8::DenseOrder, true>(F.lds, (const bf16*)(p.ws + WS_H), 512, S, E, F.tid);
}
__device__ __forceinline__ void phase_moe1_opt(const Frame& F, const Prm& p, int layer) {
    pg8::MoeOrder<true> S; S.init(F.ctl + CW_CNT + layer * 16, 1024, 512, (const bf16*)(p.ws + (layer ? WS_GU1 : WS_GU0)), (const int*)(p.ws + WS_LIST), F.G, vcu_of(F));
    pg8::EpiGateUp E{p.ws + WS_ACT};
    pg8::gemm_phase<pg8::EpiGateUp, pg8::MoeOrder<true>, true>(F.lds, (const bf16*)(p.ws + WS_H), 512, S, E, F.tid);
}
__device__ __forceinline__ void phase_moe2_opt(const Frame& F, const Prm& p, int layer) {
    pg8::MoeOrder<false> S; S.init(F.ctl + CW_CNT + layer * 16, 1024, 256, (const bf16*)(p.ws + (layer ? WS_DN1 : WS_DN0)), nullptr, F.G, vcu_of(F));
    pg8::EpiPlain8 E{p.ws + WS_YM, 1.f};
    pg8::gemm_phase<pg8::EpiPlain8, pg8::MoeOrder<false>, true>(F.lds, (const bf16*)(p.ws + WS_ACT), 256, S, E, F.tid);
}
namespace attn_body {
using bf16=unsigned short;
using bf16x8=__attribute__((ext_vector_type(8)))short;
using s16x4=__attribute__((ext_vector_type(4)))short;
using f32x16=__attribute__((ext_vector_type(16)))float;
using u32x4=__attribute__((ext_vector_type(4)))unsigned;
constexpr int D=64,DM=1024;
constexpr int NW=8,QBLK=32,QB=QBLK*NW,KVBLK=64;
constexpr int ATTN_PITCH=DM, ATTN_UNIT_ROWS=QB;
__device__ __forceinline__ int crow(int r,int hi){return (r&3)+8*(r>>2)+4*hi;}
#define SBAR() __builtin_amdgcn_sched_barrier(0)

constexpr int NSLOT=3, SLOTB=8192;
constexpr int LDS_K=0, LDS_V=NSLOT*SLOTB, LDS_WS=2*NSLOT*SLOTB, LDS_OST=LDS_WS+NW*64*4, LDS_BYTES=LDS_OST+NW*4096;
constexpr float C2=0.125f*1.4426950408889634f;
__device__ __forceinline__ void glds16(const void*gsrc,unsigned lds_dst){unsigned keep;
  asm volatile("s_mov_b32 %0, m0\n\ts_mov_b32 m0, %2\n\ts_nop 0\n\tglobal_load_lds_dwordx4 %1, off\n\ts_mov_b32 m0, %0":"=&s"(keep):"v"(gsrc),"s"(lds_dst):"memory");}
__device__ __forceinline__ void glds16s(const void*sbase,unsigned voff,unsigned lds_dst){unsigned keep;
  asm volatile("s_mov_b32 %0, m0\n\ts_mov_b32 m0, %3\n\ts_nop 0\n\tglobal_load_lds_dwordx4 %1, %2\n\ts_mov_b32 m0, %0":"=&s"(keep):"v"(voff),"s"(sbase),"s"(lds_dst):"memory");}
__device__ __forceinline__ void glds16s128(const void*sbase,unsigned voff,unsigned lds_dst){unsigned keep;
  asm volatile("s_mov_b32 %0, m0\n\ts_mov_b32 m0, %3\n\ts_nop 0\n\tglobal_load_lds_dwordx4 %1, %2 offset:128\n\ts_mov_b32 m0, %0":"=&s"(keep):"v"(voff),"s"(sbase),"s"(lds_dst):"memory");}
__device__ __forceinline__ float max3f(float a,float b,float c){float r;asm("v_max3_f32 %0, %1, %2, %3":"=v"(r):"v"(a),"v"(b),"v"(c));return r;}
__device__ __forceinline__ float max2f(float a,float b){float r;asm("v_max_f32_e32 %0, %1, %2":"=v"(r):"v"(a),"v"(b));return r;}
__device__ __forceinline__ float fadd_s(float a,float b){float r;asm("v_add_f32_e32 %0, %1, %2":"=v"(r):"v"(a),"v"(b));return r;}
__device__ __forceinline__ float fsub_s(float a,float b){float r;asm("v_sub_f32_e32 %0, %1, %2":"=v"(r):"v"(a),"v"(b));return r;}
typedef float f32x2_t __attribute__((ext_vector_type(2))); typedef __bf16 bf16x2_t __attribute__((ext_vector_type(2)));
__device__ __forceinline__ unsigned cvtpk_s(float lo,float hi){f32x2_t v={lo,hi};bf16x2_t b=__builtin_convertvector(v,bf16x2_t);return __builtin_bit_cast(unsigned,b);}
#define WAIT_BAR(N) asm volatile("s_waitcnt vmcnt(" #N ") lgkmcnt(0)\n\ts_barrier":::"memory")

__device__ __forceinline__ void qkt(f32x16&p0,f32x16&p1,const char*Kslot,const bf16x8*qr,const f32x16&negm,int r32,int hi){
  const char*kb=Kslot+hi*1024+r32*16;
  #pragma unroll
  for(int d0=0;d0<4;++d0){
    const bf16x8 b0=*reinterpret_cast<const bf16x8*>(kb+d0*2048);
    const bf16x8 b1=*reinterpret_cast<const bf16x8*>(kb+d0*2048+512);
    if(d0==0){p0=__builtin_amdgcn_mfma_f32_32x32x16_bf16(b0,qr[0],negm,0,0,0);p1=__builtin_amdgcn_mfma_f32_32x32x16_bf16(b1,qr[0],negm,0,0,0);}
    else{p0=__builtin_amdgcn_mfma_f32_32x32x16_bf16(b0,qr[d0],p0,0,0,0);p1=__builtin_amdgcn_mfma_f32_32x32x16_bf16(b1,qr[d0],p1,0,0,0);}}
}
typedef __attribute__((address_space(3))) const char* lds_cptr;
typedef short v4i16_t __attribute__((ext_vector_type(4)));
__device__ __forceinline__ void kload8(bf16x8*kf,lds_cptr kp){
  kf[0]=*(const __attribute__((address_space(3))) bf16x8*)(kp);      kf[1]=*(const __attribute__((address_space(3))) bf16x8*)(kp+512);
  kf[2]=*(const __attribute__((address_space(3))) bf16x8*)(kp+2048); kf[3]=*(const __attribute__((address_space(3))) bf16x8*)(kp+2560);
  kf[4]=*(const __attribute__((address_space(3))) bf16x8*)(kp+4096); kf[5]=*(const __attribute__((address_space(3))) bf16x8*)(kp+4608);
  kf[6]=*(const __attribute__((address_space(3))) bf16x8*)(kp+6144); kf[7]=*(const __attribute__((address_space(3))) bf16x8*)(kp+6656);
}
__device__ __forceinline__ void kload2(bf16x8*kf,lds_cptr kp,int j){ kf[2*j]=*(const __attribute__((address_space(3))) bf16x8*)(kp+j*2048); kf[2*j+1]=*(const __attribute__((address_space(3))) bf16x8*)(kp+j*2048+512); }
__device__ __forceinline__ s16x4 vtr(lds_cptr p){ return __builtin_bit_cast(s16x4,__builtin_amdgcn_ds_read_tr16_b64_v4i16((__attribute__((address_space(3))) v4i16_t*)p)); }
typedef int i32x8 __attribute__((ext_vector_type(8)));
typedef int i32x4a __attribute__((ext_vector_type(4)));
__device__ __forceinline__ i32x8 cat8i(i32x4a lo,i32x4a hi){return __builtin_shufflevector(lo,hi,0,1,2,3,4,5,6,7);}
__device__ __forceinline__ f32x16 mfq8(i32x8 kf,i32x8 q){f32x16 c;asm volatile("v_mfma_f32_32x32x64_f8f6f4 %0, %1, %2, 0":"=&v"(c):"v"(kf),"v"(q));return c;}
__device__ __forceinline__ void kload4(i32x4a*kq,lds_cptr kp){
  kq[0]=*(const __attribute__((address_space(3))) i32x4a*)(kp);      kq[1]=*(const __attribute__((address_space(3))) i32x4a*)(kp+1024);
  kq[2]=*(const __attribute__((address_space(3))) i32x4a*)(kp+2048); kq[3]=*(const __attribute__((address_space(3))) i32x4a*)(kp+3072);}
__device__ __forceinline__ void glds16s_lo(const void*sbase,unsigned voff,unsigned lds_dst){unsigned keep;
  asm volatile("s_mov_b32 %0, m0\n\ts_mov_b32 m0, %3\n\ts_mov_b32 exec_hi, 0\n\tglobal_load_lds_dwordx4 %1, %2\n\ts_mov_b32 exec_hi, -1\n\ts_mov_b32 m0, %0":"=&s"(keep):"v"(voff),"s"(sbase),"s"(lds_dst):"memory");}
__device__ __forceinline__ float rowmax(const f32x16&p0,const f32x16&p1){
  float a=max3f(p0[0],p0[1],p1[0]),b=max3f(p0[2],p0[3],p1[1]);a=max3f(a,p1[2],p1[3]);
  #pragma unroll
  for(int r=4;r<16;r+=4){a=max3f(a,p0[r],p0[r+1]);b=max3f(b,p0[r+2],p0[r+3]);a=max3f(a,p1[r],p1[r+1]);b=max3f(b,p1[r+2],p1[r+3]);}
  const float m=max2f(a,b);
  auto rr=__builtin_amdgcn_permlane32_swap(__float_as_uint(m),__float_as_uint(m),false,false);
  return max2f(__uint_as_float(rr[0]),__uint_as_float(rr[1]));
}
#undef SBAR
#undef WAIT_BAR
#undef KVROW
}
namespace attn_body {
constexpr int V2SLOT = 16384;
constexpr int L2_K = 0, L2_V = NSLOT * SLOTB, L2_WS = L2_V + NSLOT * V2SLOT, L2_ST = L2_WS + NW * 64 * 4, L2_BYTES = L2_ST + NW * 8192;
#define SBAR() __builtin_amdgcn_sched_barrier(0)
#define WAIT_BAR(N) asm volatile("s_waitcnt vmcnt(" #N ") lgkmcnt(0)\n\ts_barrier":::"memory")
typedef int i32x2a __attribute__((ext_vector_type(2)));
__device__ __forceinline__ i32x2a vtr8(lds_cptr p){ return __builtin_amdgcn_ds_read_tr8_b64_v2i32((__attribute__((address_space(3))) i32x2a*)p); }
template<int THRL,bool OPT> __device__ __forceinline__ int attn_unit2(long qrow0,int qcol,int vcol,long kctx,long klat,int NT,const bf16*Q,const bf16*__restrict__ K,const bf16*__restrict__ V,int m,const float*lamp,const float*subln,unsigned char*A2,int acol,float km,char*shm,int wid_s,unsigned*ovf){
  int lane_u; asm volatile("v_mbcnt_lo_u32_b32 %0, -1, 0\n\tv_mbcnt_hi_u32_b32 %0, -1, %0":"=v"(lane_u));
  const int lane=lane_u,r32=lane&31,hi=lane>>5; const int wid=wid_s;
  const unsigned char*Qw8=(const unsigned char*)Q+(qrow0+wid*QBLK)*1024+qcol;
  const unsigned char*Kh8=(const unsigned char*)K+qcol; const unsigned char*Vh8=(const unsigned char*)V+vcol;
  const unsigned lds0=(unsigned)(uintptr_t)shm;
  float*wsf=(float*)(shm+L2_WS)+wid*64;
  const unsigned wsf_lds=(unsigned)(lds0+L2_WS+wid*256);
  const unsigned koff=(unsigned)((32*(wid>>2)+(lane&31))*1024+32*(wid&1)+16*((wid>>1)&1));
  const int vpos=32*(wid&1)+(lane>>1); const int vkey=16*(vpos>>4)+4*((vpos>>3)&1)+(vpos&3)+8*((vpos>>2)&1);
  const unsigned voff=(unsigned)(vkey*1024+32*(wid>>1)+16*(lane&1));
  const unsigned kdst=lds0+L2_K+wid*512, vdst=lds0+L2_V+wid*1024;
  #define KVROW(t) ((t)<NT-4?klat+(long)(t)*KVBLK:kctx+(long)((t)-(NT-4))*KVBLK)
  #define DMA_K(t,slot) glds16s_lo(Kh8+KVROW(t)*1024,koff,(unsigned)(kdst+(slot)))
  #define DMA_V(t,slot) glds16s(Vh8+KVROW(t)*1024,voff,(unsigned)(vdst+2*(slot)))
  i32x4a kq[4];
  const lds_cptr shm3=(lds_cptr)shm; const lds_cptr kp0=shm3+L2_K+hi*512+r32*16;
  const lds_cptr vp0=shm3+L2_V+(8*hi+((lane&15)>>1))*32+16*((lane>>4)&1)+8*(lane&1);
  DMA_K(0,0);DMA_V(0,0);DMA_K(1,SLOTB);
  i32x8 q8; { const i32x4a qa=*reinterpret_cast<const i32x4a*>(Qw8+(long)r32*1024+hi*32),qb=*reinterpret_cast<const i32x4a*>(Qw8+(long)r32*1024+hi*32+16); q8=cat8i(qa,qb); }
  bool FAST; { float qn=0.f;
    #pragma unroll
    for(int i=0;i<8;++i){ const f32x2_t lo=__builtin_amdgcn_cvt_pk_f32_fp8(q8[i],false),h2=__builtin_amdgcn_cvt_pk_f32_fp8(q8[i],true); qn+=(lo[0]*lo[0]+lo[1]*lo[1])+(h2[0]*h2[0]+h2[1]*h2[1]); }
    { auto rq=__builtin_amdgcn_permlane32_swap(__float_as_uint(qn),__float_as_uint(qn),false,false); qn=__uint_as_float(rq[0])+__uint_as_float(rq[1]); } FAST=__all(qn*km<=96.f*96.f)!=0; }
  float scl=1.f;
  float mhat=0.f;f32x16 o[4];o[0]=f32x16{};o[1]=f32x16{};o[2]=f32x16{};o[3]=f32x16{};
  f32x16 lacc=f32x16{};
  const i32x8 ones8={0x38383838,0x38383838,0x38383838,0x38383838,0x38383838,0x38383838,0x38383838,0x38383838};
  bool resc=false;
  #define RESC() do{ if(!OPT&&resc){ asm volatile("s_nop 15\n\ts_nop 3\n\ts_waitcnt lgkmcnt(0)":::"memory"); \
      int l3_=lane; asm volatile("":"+v"(l3_)); const int hi3_=l3_>>5; \
      _Pragma("unroll") for(int r=0;r<16;++r){ const float f_=wsf[crow(r,hi3_)]; o[0][r]*=f_; o[1][r]*=f_; o[2][r]*=f_; o[3][r]*=f_; lacc[r]*=f_; } } }while(0)
  int sl_prev=0,sl_cur=0,sl_next=SLOTB;
  #define ROT() do{sl_prev=sl_cur;sl_cur=sl_next;sl_next=(sl_next==(NSLOT-1)*SLOTB)?0:sl_next+SLOTB;}while(0)
  DMA_K(2,2*SLOTB);
  WAIT_BAR(3);
  #define EX(v) __builtin_amdgcn_exp2f(v)
  #define PK8(old,a,b,hs) __builtin_amdgcn_cvt_pk_fp8_f32((a),(b),(old),(hs))
  i32x8 pwA,pwB;
  { f32x16 p0,p1;
    kload4(kq,kp0); p0=mfq8(cat8i(kq[0],kq[1]),q8); p1=mfq8(cat8i(kq[2],kq[3]),q8); asm volatile("s_nop 15\n\ts_nop 7":"+v"(p0),"+v"(p1));
    const float rm=__builtin_ceilf(rowmax(p0,p1))+(OPT?4.f:0.f); mhat=rm; typedef short v2i16_t __attribute__((ext_vector_type(2)));
    if(OPT||FAST){ scl=EX(rm);
      #pragma unroll
      for(int r=0;r<16;++r){ p0[r]=EX(p0[r]); p1[r]=EX(p1[r]); }
      #pragma unroll
      for(int w=0;w<4;++w){ v2i16_t a={0,0},b={0,0}; a=__builtin_amdgcn_cvt_scalef32_pk_fp8_f32(a,p0[4*w],p0[4*w+1],scl,false); a=__builtin_amdgcn_cvt_scalef32_pk_fp8_f32(a,p0[4*w+2],p0[4*w+3],scl,true);
        b=__builtin_amdgcn_cvt_scalef32_pk_fp8_f32(b,p1[4*w],p1[4*w+1],scl,false); b=__builtin_amdgcn_cvt_scalef32_pk_fp8_f32(b,p1[4*w+2],p1[4*w+3],scl,true); pwA[w]=__builtin_bit_cast(int,a); pwA[4+w]=__builtin_bit_cast(int,b); }
    } else {
      #pragma unroll
      for(int r=0;r<16;++r){ p0[r]=EX(p0[r]-rm); p1[r]=EX(p1[r]-rm); }
      #pragma unroll
      for(int w=0;w<4;++w){ int a=0,b=0; a=PK8(a,p0[4*w],p0[4*w+1],false); a=PK8(a,p0[4*w+2],p0[4*w+3],true); b=PK8(b,p1[4*w],p1[4*w+1],false); b=PK8(b,p1[4*w+2],p1[4*w+3],true); pwA[w]=a; pwA[4+w]=b; } }
    }
  WAIT_BAR(0);
  DMA_K(3,0);DMA_V(1,SLOTB);
  ROT();
  kload4(kq,kp0+sl_cur);
  WAIT_BAR(2);
  i32x2a vA[4],vB[4];
  #define VF8(A) (i32x8){A[0][0],A[0][1],A[1][0],A[1][1],A[2][0],A[2][1],A[3][0],A[3][1]}
  #define PIN(x) asm volatile("":"+v"(x))
  #define MX3(a,b,c) __builtin_fmaxf(__builtin_fmaxf((a),(b)),(c))
  #define VR4(A,d) do{ A[0]=vtr8(vp_+(d)*2048); A[1]=vtr8(vp_+(d)*2048+512); A[2]=vtr8(vp_+(d)*2048+1024); A[3]=vtr8(vp_+(d)*2048+1536); }while(0)
  #define MFO8(d,PW,A) asm volatile("s_nop 1\n\tv_mfma_f32_32x32x64_f8f6f4 %0, %1, %2, %0":"+v"(o[d]):"v"(PW),"v"(VF8(A)))
  #define MFOL(PW) asm volatile("s_nop 1\n\tv_mfma_f32_32x32x64_f8f6f4 %0, %1, %2, %0":"+v"(lacc):"v"(PW),"v"(ones8))
  #define KRD(G,j) do{ if(G){ kq[j]=*(const __attribute__((address_space(3))) i32x4a*)(kp0+sl_next+(j)*1024); } }while(0)
  #define SM8(X,B,PO,W) do{ _Pragma("unroll") for(int j_=0;j_<8;++j_){ X[(B)+j_]=EX(X[(B)+j_]-mhat); } \
      { int a_=0,b_=0; a_=PK8(a_,X[(B)],X[(B)+1],false); a_=PK8(a_,X[(B)+2],X[(B)+3],true); b_=PK8(b_,X[(B)+4],X[(B)+5],false); b_=PK8(b_,X[(B)+6],X[(B)+7],true); PO[W]=a_; PO[(W)+1]=b_; } }while(0)
  #define SM8F(X,B,PO,W) do{ _Pragma("unroll") for(int j_=0;j_<8;++j_){ X[(B)+j_]=EX(X[(B)+j_]); } \
      { typedef short v2i16_t __attribute__((ext_vector_type(2))); v2i16_t a_=__builtin_bit_cast(v2i16_t,PO[W]),b_=__builtin_bit_cast(v2i16_t,PO[(W)+1]); \
        a_=__builtin_amdgcn_cvt_scalef32_pk_fp8_f32(a_,X[(B)],X[(B)+1],scl,false); a_=__builtin_amdgcn_cvt_scalef32_pk_fp8_f32(a_,X[(B)+2],X[(B)+3],scl,true); \
        b_=__builtin_amdgcn_cvt_scalef32_pk_fp8_f32(b_,X[(B)+4],X[(B)+5],scl,false); b_=__builtin_amdgcn_cvt_scalef32_pk_fp8_f32(b_,X[(B)+6],X[(B)+7],scl,true); \
        PO[W]=__builtin_bit_cast(int,a_); PO[(W)+1]=__builtin_bit_cast(int,b_); } }while(0)
  #define STEP2(t,PI,PO,GK,GV,GL,SMX,FV) do{ SBAR(); \
    const lds_cptr vp_=vp0+2*sl_prev; f32x16 C0,C1; \
    VR4(vA,0); SBAR(); C0=mfq8(cat8i(kq[0],kq[1]),q8); SBAR(); \
    VR4(vB,1); SBAR(); C1=mfq8(cat8i(kq[2],kq[3]),q8); SBAR(); \
    if(GK){DMA_K((t)+3,sl_cur);} if(GV){DMA_V((t)+1,sl_next);} \
    asm volatile("s_nop 15\n\ts_nop 3":"+v"(C0),"+v"(C1));   \
    if constexpr(!OPT){ float a=MX3(C0[0],C0[1],C1[0]),b=MX3(C0[2],C0[3],C1[1]); a=MX3(a,C1[2],C1[3]); \
      _Pragma("unroll") for(int r=4;r<16;r+=4){a=MX3(a,C0[r],C0[r+1]);b=MX3(b,C0[r+2],C0[r+3]);a=MX3(a,C1[r],C1[r+1]);b=MX3(b,C1[r+2],C1[r+3]);} \
      float rm=__builtin_fmaxf(a,b); { auto rr=__builtin_amdgcn_permlane32_swap(__float_as_uint(rm),__float_as_uint(rm),false,false); rm=__builtin_fmaxf(__uint_as_float(rr[0]),__uint_as_float(rr[1])); } \
      resc=false; \
      if(__builtin_expect(__any(rm-mhat>(float)THRL),0)){ const float dl=__builtin_fmaxf(__builtin_ceilf(rm-mhat)-(THRL?6.f:0.f),0.f); mhat+=dl;   \
        const float f=__builtin_amdgcn_exp2f(-dl); if(FV){ scl=EX(mhat); } { unsigned keep_; asm volatile("s_mov_b32 %0, m0\n\ts_mov_b32 m0, %2\n\ts_nop 0\n\tds_write_addtid_b32 %1\n\ts_mov_b32 m0, %0":"=&s"(keep_):"v"(f),"s"(wsf_lds):"memory"); } resc=true; } } \
    __builtin_amdgcn_s_setprio(1); SBAR(); \
    MFO8(0,PI,vA); SMX(C0,0,PO,0); VR4(vA,2); SBAR(); \
    MFO8(1,PI,vB); SMX(C0,8,PO,2); VR4(vB,3); SBAR(); \
    MFO8(2,PI,vA); SMX(C1,0,PO,4); KRD(GL,0); KRD(GL,1); SBAR(); \
    MFO8(3,PI,vB); SMX(C1,8,PO,6); KRD(GL,2); KRD(GL,3); SBAR(); \
    MFOL(PI); __builtin_amdgcn_s_setprio(0); \
    }while(0)
  #define ENDW(tt) do{ if((tt)+3<NT){WAIT_BAR(2);} else {WAIT_BAR(0);} }while(0)
  #define LOOPS(SMX,FV) do{ int t=1; \
    for(;t+5<NT;t+=2){ \
      STEP2(t,  pwA,pwB,true,true,true,SMX,FV); WAIT_BAR(2); RESC(); ROT(); \
      STEP2(t+1,pwB,pwA,true,true,true,SMX,FV); WAIT_BAR(2); RESC(); ROT(); \
    } \
    for(;t+1<NT;t+=2){ \
      STEP2(t,  pwA,pwB,(t+3<NT),(t+1<NT),(t+1<NT),SMX,FV); ENDW(t);   RESC(); ROT(); \
      STEP2(t+1,pwB,pwA,(t+4<NT),(t+2<NT),(t+2<NT),SMX,FV); ENDW(t+1); RESC(); ROT(); \
    } \
    STEP2(NT-1,pwA,pwB,false,false,false,SMX,FV); RESC(); }while(0)
  if constexpr(OPT){ LOOPS(SM8F,true); } else { if(FAST){ LOOPS(SM8F,true); } else { LOOPS(SM8,false); } }
  #undef LOOPS
  { const lds_cptr vp_=vp0+2*sl_cur;
    VR4(vA,0); VR4(vB,1); MFO8(0,pwB,vA); MFO8(1,pwB,vB); VR4(vA,2); VR4(vB,3); MFO8(2,pwB,vA); MFO8(3,pwB,vB); MFOL(pwB);
    asm volatile("s_nop 15\n\ts_nop 7":"+v"(o[0]),"+v"(o[1]),"+v"(o[2]),"+v"(o[3]),"+v"(lacc)); }
  if constexpr(OPT){ float bad=lacc[0]; _Pragma("unroll") for(int r=1;r<16;++r)bad+=lacc[r];
    if(__any(!(__builtin_fabsf(bad)<3.0e38f))||!FAST){ *ovf=1u; } }
  { int lane_l=lane; asm volatile("":"+v"(lane_l));
  { const int lane=lane_l,r32=lane&31,hi=lane>>5;
  float rli[16];
  #pragma unroll
  for(int r=0;r<16;++r)rli[r]=__builtin_amdgcn_rcpf(lacc[r]);
  unsigned short*stash=(unsigned short*)(shm+L2_ST)+wid*4096;
  if(m==0){
    #pragma unroll
    for(int d0=0;d0<4;++d0){
      #pragma unroll
      for(int r=0;r<16;r+=2)((unsigned*)stash)[(d0*8+(r>>1))*64+lane]=cvtpk_s(o[d0][r]*rli[r],o[d0][r+1]*rli[r+1]);}
    asm volatile("s_waitcnt lgkmcnt(0)":::"memory");
  } else {
    const float lam=__uint_as_float(__hip_atomic_load((const unsigned*)lamp,__ATOMIC_RELAXED,__HIP_MEMORY_SCOPE_AGENT));
    float ss[16];
    #pragma unroll
    for(int r=0;r<16;++r)ss[r]=0.f;
    #pragma unroll
    for(int d0=0;d0<4;++d0){
      #pragma unroll
      for(int r=0;r<16;r+=2){ const unsigned u2=((const unsigned*)stash)[(d0*8+(r>>1))*64+lane]; const float o1a=__uint_as_float(u2<<16),o1b=__uint_as_float(u2&0xffff0000u);
        const float dfa=o1a-lam*(o[d0][r]*rli[r]),dfb=o1b-lam*(o[d0][r+1]*rli[r+1]); o[d0][r]=dfa; o[d0][r+1]=dfb; ss[r]+=dfa*dfa; ss[r+1]+=dfb*dfb; } }
    #pragma unroll
    for(int r=0;r<16;++r){ float q=ss[r];
      q+=__int_as_float(__builtin_amdgcn_ds_swizzle(__float_as_int(q),0x41f));
      q+=__int_as_float(__builtin_amdgcn_ds_swizzle(__float_as_int(q),0x81f));
      q+=__int_as_float(__builtin_amdgcn_ds_swizzle(__float_as_int(q),0x101f));
      q+=__int_as_float(__builtin_amdgcn_ds_swizzle(__float_as_int(q),0x201f));
      q+=__int_as_float(__builtin_amdgcn_ds_swizzle(__float_as_int(q),0x401f));
      ss[r]=(1.f-LAMBDA_INIT0)*__builtin_amdgcn_rsqf(q*(1.f/128.f)+LN_EPS); }
    asm volatile("s_waitcnt lgkmcnt(0)":::"memory");
    unsigned char*stg=(unsigned char*)stash;
    #pragma unroll
    for(int d0=0;d0<4;++d0){ const float sgv=subln[d0*32+r32];
      #pragma unroll
      for(int r=0;r<16;++r){ const int w8=__builtin_amdgcn_cvt_pk_fp8_f32(o[d0][r]*ss[r]*sgv,0.f,0,false); stg[crow(r,hi)*128+d0*32+r32]=(unsigned char)(w8&0xff); } }
    asm volatile("s_waitcnt lgkmcnt(0)":::"memory");
    unsigned char*Aw=A2+(qrow0+wid*QBLK)*DM+acol;
    #pragma unroll
    for(int i=0;i<4;++i){const int row=i*8+(lane>>3),ch=lane&7; const u32x4 v=*(const u32x4*)(stg+row*128+ch*16); *(u32x4*)(Aw+(long)row*DM+ch*16)=v;}
    asm volatile("s_waitcnt lgkmcnt(0)":::"memory");
  }
  } }
  asm volatile("s_waitcnt lgkmcnt(0)\n\ts_barrier":::"memory");
  int ovfl=0; if constexpr(OPT){ ovfl=__builtin_amdgcn_readfirstlane((int)*(volatile unsigned*)ovf); }
  #undef KVROW
  #undef DMA_K
  #undef DMA_V
  #undef RESC
  #undef ROT
  #undef EX
  #undef PK8
  #undef VF8
  #undef PIN
  #undef MX3
  #undef VR4
  #undef MFO8
  #undef KRD
  #undef MFOL
  #undef SM8
  #undef SM8F
  #undef STEP2
  #undef ENDW
  return ovfl;
}
#undef SBAR
#undef WAIT_BAR
}
__device__ __forceinline__ void phase_attn2(const Frame& F, const Prm& p) {
    const bf16* Q = (const bf16*)(p.ws + WS_Q); const bf16* K = (const bf16*)(p.ws + WS_K); const bf16* V = (const bf16*)(p.ws + WS_V); unsigned char* A2 = p.ws + WS_O1;
    const float* lamp = (const float*)(p.ws + WS_MISC);
    for (int v = vcu_of(F); v < 256; v += F.G) {
        const int b = v >> 5, hs = (v >> 4) & 1, qb = v & 15;
        const long kctx = NLAT + b * CTXL, klat = (long)b * SEQ;
        for (int hr = 0; hr < 4; ++hr) {
            const int h = 2 * hr + hs;
            const int nu = (qb == hr) ? 2 : 1;
            for (int i = 0; i < nu; ++i) {
                const long qrow0 = i == 0 ? klat + qb * 256 : kctx; const int NT = i == 0 ? 68 : 4;
                unsigned* ovf = (unsigned*)(F.lds + LDS_BYTES - 32);
                int redo = 0;
                for (int m = 0; m < 2; ++m) {
                    const int hm = 2 * h + m;
                    const float km = __uint_as_float(__hip_atomic_load(F.ctl + CW_KM + b * 16 + hm, __ATOMIC_RELAXED, __HIP_MEMORY_SCOPE_AGENT));
                    redo |= attn_body::attn_unit2<8, true>(qrow0, hm * 64, h * 128, kctx, klat, NT, Q, K, V, m, lamp, p.subln, A2, h * 128, km, (char*)F.lds, F.wave, ovf);
                }
                if (redo) {
                    __syncthreads(); if (F.wave == 0) *ovf = 0u; __syncthreads();
                    for (int m = 0; m < 2; ++m) {
                        const int hm = 2 * h + m;
                        const float km = __uint_as_float(__hip_atomic_load(F.ctl + CW_KM + b * 16 + hm, __ATOMIC_RELAXED, __HIP_MEMORY_SCOPE_AGENT));
                        (void)attn_body::attn_unit2<8, false>(qrow0, hm * 64, h * 128, kctx, klat, NT, Q, K, V, m, lamp, p.subln, A2, h * 128, km, (char*)F.lds, F.wave, ovf);
                    }
                }
            }
        }
    }
}
namespace gla3 {
typedef short bf16x8 __attribute__((ext_vector_type(8)));
typedef short s16x4 __attribute__((ext_vector_type(4)));
typedef float f32x16 __attribute__((ext_vector_type(16)));
constexpr int CH = 64 * 16 + 64;
constexpr int L_QS = 0, L_KS = 16 * CH, L_VS = 32 * CH, L_SB = 40 * CH, L_X = 56 * CH, L_DEC = L_X + 16384, L_END = L_DEC + 512;
__device__ __forceinline__ int crow(int i, int hh) { return (i & 3) + 8 * (i >> 2) + 4 * hh; }
typedef float f32x2_t __attribute__((ext_vector_type(2))); typedef __bf16 bf16x2_t __attribute__((ext_vector_type(2)));
__device__ __forceinline__ unsigned pk(float lo, float hi) { f32x2_t v = {lo, hi}; bf16x2_t b = __builtin_convertvector(v, bf16x2_t); return __builtin_bit_cast(unsigned, b); }
typedef short v4i16_t __attribute__((ext_vector_type(4)));
__device__ __forceinline__ s16x4 trrd(LAS const unsigned char* p) { return __builtin_bit_cast(s16x4, __builtin_amdgcn_ds_read_tr16_b64_v4i16((LAS v4i16_t*)p)); }
#define GLA_FR(lo, hi) (bf16x8){lo[0], lo[1], lo[2], lo[3], hi[0], hi[1], hi[2], hi[3]}

__device__ __forceinline__ void scan_unit(const Frame& F, const Prm& p, int unit) {
    const int dvs = unit & 3, dir = (unit >> 2) & 1, h = (unit >> 3) & 3, b = unit >> 5;
    LAS unsigned char* lds = (LAS unsigned char*)F.lds;
    const int lane = F.lane, w = F.wave, tid = F.tid, r = lane & 31, hh = lane >> 5;
    const bf16* QT = (const bf16*)(p.ws + WS_QT) + ((size_t)dir * 8 + 2 * h) * NTOK * 64;
    const bf16* KT = (const bf16*)(p.ws + WS_KT) + ((size_t)dir * 8 + 2 * h) * NTOK * 64;
    const bf16* V = (const bf16*)(p.ws + WS_V1) + h * 256 + dvs * 64;
    const float* DEC = (const float*)(p.ws + WS_DEC) + (size_t)dir * NCHUNK * 512 + h * 128;
    bf16* OG = (bf16*)((unsigned char*)p.out + (dir ? OUT_OGB : 0)) + h * 256 + dvs * 64;
    const int g1 = (lane >> 4) & 1, q4 = (lane & 15) >> 2, p4 = lane & 3;
    const int trb = (2 * g1 + (p4 >> 1)) * CH + q4 * 16 + 8 * (p4 & 1);
    const int trN = trb + 128 * hh, trP = trb + 64 * hh;
    f32x16 S0 = {}, S1 = {};
    for (int i = tid; i < 16 * CH / 16; i += NTHR) *(LAS u32x4*)(lds + L_SB + i * 16) = (u32x4){0u, 0u, 0u, 0u};
    u32x4 pq0[2], pq1[2], pk0[2], pk1[2], pv[2]; float pdec[2] = {0.f, 0.f};
#define GLA_CHUNK(step) ((step) >= 4 ? b * 64 + (dir ? 63 - ((step) - 4) : (step) - 4) : 512 + b * 4 + (dir ? 3 - (step) : (step)))
    const int qrow = 8 * w + (lane >> 4), qch = lane & 15, vrow = 8 * w + (lane >> 3), vch = lane & 7;
    const size_t qgo = (size_t)(qch >> 3) * NTOK * 64 + (qch & 7) * 8;
#define GLA_LOAD(step, u) do { const size_t t0_ = (size_t)GLA_CHUNK(step) * 64; \
        pq0[u] = *(const u32x4*)(QT + qgo + (t0_ + qrow) * 64); pq1[u] = *(const u32x4*)(QT + qgo + (t0_ + qrow + 4) * 64); \
        pk0[u] = *(const u32x4*)(KT + qgo + (t0_ + qrow) * 64); pk1[u] = *(const u32x4*)(KT + qgo + (t0_ + qrow + 4) * 64); \
        pv[u] = *(const u32x4*)(V + (t0_ + vrow) * 1024 + 8 * vch); if (tid < 128) pdec[u] = DEC[(size_t)GLA_CHUNK(step) * 512 + tid]; } while (0)
#define GLA_STORE(u) do { \
        *(LAS u32x4*)(lds + L_QS + qch * CH + qrow * 16) = pq0[u]; *(LAS u32x4*)(lds + L_QS + qch * CH + (qrow + 4) * 16) = pq1[u]; \
        *(LAS u32x4*)(lds + L_KS + qch * CH + qrow * 16) = pk0[u]; *(LAS u32x4*)(lds + L_KS + qch * CH + (qrow + 4) * 16) = pk1[u]; \
        *(LAS u32x4*)(lds + L_VS + vch * CH + vrow * 16) = pv[u]; \
        if (tid < 128) *(LAS float*)(lds + L_DEC + 4 * tid) = pdec[u]; } while (0)
    GLA_LOAD(0, 0);
    GLA_LOAD(1, 1);
    GLA_STORE(0);
    __syncthreads();
    const int tb = (w & 3) >> 1, vb = w & 1;
    for (int sp2 = 0; sp2 < 34; ++sp2) {
#pragma unroll
    for (int u = 0; u < 2; ++u) {
        const int step = 2 * sp2 + u;
        const bool lat = step >= 4; const int chunk = GLA_CHUNK(step);
        if (step + 2 < 68) GLA_LOAD(step + 2, u);
        f32x16 o = {};
        if (w < 4) {
            if (lat) {
                const bool n0 = dir ? (tb == 0) : true, n1 = dir ? true : (tb == 1);
                f32x16 sc0 = {}, sc1 = {};
#define GLA_BQ(ks) (*(const LAS bf16x8*)(lds + L_QS + (2 * (ks) + hh) * CH + (32 * tb + r) * 16))
#define GLA_A0(ks) (*(const LAS bf16x8*)(lds + L_KS + (2 * (ks) + hh) * CH + r * 16))
#define GLA_A1(ks) (*(const LAS bf16x8*)(lds + L_KS + (2 * (ks) + hh) * CH + (32 + r) * 16))
                if (n0 && n1) {
#pragma unroll
                    for (int ks = 0; ks < 8; ++ks) { const bf16x8 bq = GLA_BQ(ks); sc0 = __builtin_amdgcn_mfma_f32_32x32x16_bf16(GLA_A0(ks), bq, sc0, 0, 0, 0); sc1 = __builtin_amdgcn_mfma_f32_32x32x16_bf16(GLA_A1(ks), bq, sc1, 0, 0, 0); }
                } else if (n0) {
#pragma unroll
                    for (int ks = 0; ks < 8; ++ks) sc0 = __builtin_amdgcn_mfma_f32_32x32x16_bf16(GLA_A0(ks), GLA_BQ(ks), sc0, 0, 0, 0);
                } else {
#pragma unroll
                    for (int ks = 0; ks < 8; ++ks) sc1 = __builtin_amdgcn_mfma_f32_32x32x16_bf16(GLA_A1(ks), GLA_BQ(ks), sc1, 0, 0, 0);
                }
#undef GLA_BQ
#undef GLA_A0
#undef GLA_A1
                const int t = 32 * tb + r;
#pragma unroll
                for (int i = 0; i < 16; ++i) { const int s0 = crow(i, hh), s1 = 32 + s0; const bool k0 = dir ? (s0 >= t) : (s0 <= t), k1 = dir ? (s1 >= t) : (s1 <= t); sc0[i] = k0 ? sc0[i] : 0.f; sc1[i] = k1 ? sc1[i] : 0.f; }
#pragma unroll
                for (int sb = 0; sb < 2; ++sb) { if (sb == 0 ? n0 : n1) {
#pragma unroll
                    for (int sp = 0; sp < 2; ++sp) {
                        u32x4 pw;
                        if (sb == 0) { pw.x = pk(sc0[8 * sp + 0], sc0[8 * sp + 1]); pw.y = pk(sc0[8 * sp + 2], sc0[8 * sp + 3]); pw.z = pk(sc0[8 * sp + 4], sc0[8 * sp + 5]); pw.w = pk(sc0[8 * sp + 6], sc0[8 * sp + 7]); }
                        else { pw.x = pk(sc1[8 * sp + 0], sc1[8 * sp + 1]); pw.y = pk(sc1[8 * sp + 2], sc1[8 * sp + 3]); pw.z = pk(sc1[8 * sp + 4], sc1[8 * sp + 5]); pw.w = pk(sc1[8 * sp + 6], sc1[8 * sp + 7]); }
                        LAS const unsigned char* vp = lds + L_VS + trP + (4 * vb) * CH + (32 * sb + 16 * sp) * 16;
                        const s16x4 lo = trrd(vp), hi = trrd(vp + 8 * 16);
                        o = __builtin_amdgcn_mfma_f32_32x32x16_bf16(GLA_FR(lo, hi), __builtin_bit_cast(bf16x8, pw), o, 0, 0, 0);
                    } } }
            }
        } else {
            const int db = w - 4;
            if (lat) {
                f32x16 o2 = {};
#pragma unroll
                for (int ks = 0; ks < 8; ++ks) {
                    const bf16x8 as = *(const LAS bf16x8*)(lds + L_SB + (2 * ks + hh) * CH + (32 * vb + r) * 16);
                    const bf16x8 bq = *(const LAS bf16x8*)(lds + L_QS + (2 * ks + hh) * CH + (32 * tb + r) * 16);
                    o2 = __builtin_amdgcn_mfma_f32_32x32x16_bf16(as, bq, o2, 0, 0, 0);
                }
#pragma unroll
                for (int g = 0; g < 4; ++g) *(LAS f32x4*)(lds + L_X + (w & 3) * 4096 + g * 1024 + lane * 16) = (f32x4){o2[4 * g], o2[4 * g + 1], o2[4 * g + 2], o2[4 * g + 3]};
            }
#pragma unroll
            for (int ks = 0; ks < 4; ++ks) {
                LAS const unsigned char* kp = lds + L_KS + trN + (4 * db) * CH + (16 * ks) * 16;
                LAS const unsigned char* vp = lds + L_VS + trN + (16 * ks) * 16;
                const s16x4 al = trrd(kp), ah = trrd(kp + 4 * 16);
                const s16x4 b0l = trrd(vp), b0h = trrd(vp + 4 * 16), b1l = trrd(vp + 4 * CH), b1h = trrd(vp + 4 * CH + 4 * 16);
                S0 = __builtin_amdgcn_mfma_f32_32x32x16_bf16(GLA_FR(al, ah), GLA_FR(b0l, b0h), S0, 0, 0, 0); S1 = __builtin_amdgcn_mfma_f32_32x32x16_bf16(GLA_FR(al, ah), GLA_FR(b1l, b1h), S1, 0, 0, 0);
            }
#pragma unroll
            for (int i = 0; i < 16; ++i) { const float dc = *(const LAS float*)(lds + L_DEC + 4 * (32 * db + crow(i, hh))); S0[i] *= dc; S1[i] *= dc; }
        }
        __syncthreads();
        if (w < 4 && lat) {
            bf16* orow = OG + ((size_t)chunk * 64 + 32 * tb + r) * DM + 32 * vb + 4 * hh;
#pragma unroll
            for (int g = 0; g < 4; ++g) { const f32x4 x = *(const LAS f32x4*)(lds + L_X + w * 4096 + g * 1024 + lane * 16);
                u32x2 wv; wv.x = pk(o[4 * g] + x.x, o[4 * g + 1] + x.y); wv.y = pk(o[4 * g + 2] + x.z, o[4 * g + 3] + x.w); *(u32x2*)(orow + 8 * g) = wv; }
        }
        if (step + 1 < 68) {
            GLA_STORE(u ^ 1);
            if (w >= 4) { const int db = w - 4;
#pragma unroll
                for (int g = 0; g < 4; ++g) { u32x2 w0, w1; w0.x = pk(S0[4 * g], S0[4 * g + 1]); w0.y = pk(S0[4 * g + 2], S0[4 * g + 3]); w1.x = pk(S1[4 * g], S1[4 * g + 1]); w1.y = pk(S1[4 * g + 2], S1[4 * g + 3]);
                    *(LAS u32x2*)(lds + L_SB + (4 * db + g) * CH + r * 16 + 8 * hh) = w0; *(LAS u32x2*)(lds + L_SB + (4 * db + g) * CH + (32 + r) * 16 + 8 * hh) = w1; } }
        }
        __syncthreads();
    }
    }
#undef GLA_CHUNK
#undef GLA_LOAD
#undef GLA_STORE
}
#undef GLA_FR
}
__device__ __forceinline__ void phase_scan_opt(const Frame& F, const Prm& p) {
    for (int unit = vcu_of(F); unit < 256; unit += F.G) gla3::scan_unit(F, p, unit);
}
#define PHASE_QKV(F, p) phase_qkv_opt(F, p)
#define PHASE_ATTN(F, p) phase_attn2(F, p)
#define PHASE_WO(F, p, l) phase_wo_opt(F, p, l)
#define PHASE_MOE1(F, p, l) phase_moe1_opt(F, p, l)
#define PHASE_MOE2(F, p, l) phase_moe2_opt(F, p, l)
#define PHASE_INPROJ(F, p) phase_inproj_opt(F, p)
#define PHASE_SCAN(F, p) phase_scan_opt(F, p)
typedef GAS unsigned gu32;
#define XB_TMO      128
#define XB_XCNT(j)  (256  + 64 * (j))
#define XB_XSUB(j)  (1280 + 64 * (j))
#define XB_XGEN(j)  (2304 + 64 * (j))
#define XB_TOP      3328
#define XB_TOPGEN   3392
#define XCD_BAR_WORDS 3456
#define XB_SPIN_CAP (1u << 20)
__device__ __forceinline__ unsigned xb_ld(unsigned* p)              { return __hip_atomic_load(p, __ATOMIC_RELAXED, __HIP_MEMORY_SCOPE_AGENT); }
__device__ __forceinline__ unsigned xb_add(unsigned* p, unsigned v) { return __hip_atomic_fetch_add(p, v, __ATOMIC_RELAXED, __HIP_MEMORY_SCOPE_AGENT); }
__device__ __forceinline__ unsigned xb_xcc_id() { return (unsigned)__builtin_amdgcn_s_getreg((3 << 11) | 20) & 0xFu; }
#define XB_SPIN(cond, bar) do { unsigned _sp = 0; while (cond) { __builtin_amdgcn_s_sleep(1); \
    if ((++_sp & 255u) == 0u) { if (xb_ld(&(bar)[XB_TMO])) break; if (_sp > XB_SPIN_CAP) { atomicAdd(&(bar)[XB_TMO], 1u); break; } } } } while (0)
struct XcdBarrier { unsigned* bar; unsigned x; volatile LAS unsigned* st; };
__device__ __forceinline__ XcdBarrier xcd_barrier_post(unsigned* bar, volatile LAS unsigned* st) {
    XcdBarrier b; b.bar = bar; b.x = xb_xcc_id(); b.st = st;
    if (threadIdx.x == 0) (void)xb_add(&bar[XB_XCNT(b.x)], 1u);
    return b;
}
__device__ __forceinline__ void xcd_barrier_complete(unsigned* bar, unsigned x, unsigned& nloc, unsigned& nx) {
    const unsigned G = gridDim.x * gridDim.y * gridDim.z;
    unsigned sum, cnt, mine, sp = 0u;
    for (;;) {
        sum = 0u; cnt = 0u; mine = 0u;
#pragma unroll
        for (unsigned j = 0; j < 16; ++j) { const unsigned c = xb_ld(&bar[XB_XCNT(j)]); sum += c; cnt += (c > 0u) ? 1u : 0u; mine = (j == x) ? c : mine; }
        if (sum == G) break;
        __builtin_amdgcn_s_sleep(1);
        if ((++sp & 255u) == 0u) { if (xb_ld(&bar[XB_TMO])) break; if (sp > XB_SPIN_CAP) { atomicAdd(&bar[XB_TMO], 1u); break; } }
    }
    nloc = mine > 0u ? mine : 1u; nx = cnt > 0u ? cnt : 1u;
}
__device__ __forceinline__ void xcd_barrier(const XcdBarrier& b, int tid) {
    asm volatile("s_waitcnt vmcnt(0)" ::: "memory");
    __syncthreads();
    if (tid == 0) {
        unsigned* bar = b.bar;
        __builtin_amdgcn_s_waitcnt(0);
        unsigned nloc = b.st[0], nx = b.st[1];
        if (nloc == 0u) { xcd_barrier_complete(bar, b.x, nloc, nx); b.st[0] = nloc; b.st[1] = nx; }
        const unsigned old = xb_add(&bar[XB_XSUB(b.x)], 1u);
        const unsigned gen = old / nloc;
        if (old + 1u == (gen + 1u) * nloc) {
            __builtin_amdgcn_fence(__ATOMIC_RELEASE, "agent");
            asm volatile("s_waitcnt vmcnt(0)" ::: "memory");
            const unsigned og = xb_add(&bar[XB_TOP], 1u);
            const unsigned tg = og / nx;
            if (og + 1u == (tg + 1u) * nx) xb_add(&bar[XB_TOPGEN], 1u);
            else XB_SPIN(xb_ld(&bar[XB_TOPGEN]) == tg, bar);
            __builtin_amdgcn_fence(__ATOMIC_ACQUIRE, "agent");
            xb_add(&bar[XB_XGEN(b.x)], 1u);
            asm volatile("s_waitcnt vmcnt(0)" ::: "memory");
        } else {
            XB_SPIN(xb_ld(&bar[XB_XGEN(b.x)]) == gen, bar);
            __builtin_amdgcn_fence(__ATOMIC_ACQUIRE, "agent");
            asm volatile("s_waitcnt vmcnt(0)" ::: "memory");
        }
    }
    __syncthreads();
}

constexpr int NPHASE = 19;
__global__ void __launch_bounds__(NTHR, 2) mega_fwd(Prm p) {
    extern __shared__ __attribute__((aligned(16))) unsigned char lds[];
    Frame F; F.lds = lds; F.ctl = (unsigned*)(p.ws + WS_CTL);
    F.tid = threadIdx.x; F.lane = F.tid & 63; F.wave = __builtin_amdgcn_readfirstlane(F.tid >> 6); F.G = gridDim.x; F.bid = blockIdx.x;
    for (int u = F.tid; u < (LDS_BYTES - LDSCTL_OFF) / 4; u += NTHR) ((LAS unsigned*)(lds + LDSCTL_OFF))[u] = 0u;
    __syncthreads();
    const int lo = p.ph_lo, hi = p.ph_hi;
    const bool multi = (hi - lo) > 1;
    XcdBarrier bar; bar.bar = F.ctl + CW_BAR + p.li * XCD_BAR_WORDS; bar.x = 0; bar.st = nullptr;
    if (multi) bar = xcd_barrier_post(F.ctl + CW_BAR + p.li * XCD_BAR_WORDS, (volatile LAS unsigned*)(lds + MISC_OFF) + 8);
#define IN(k) (lo <= (k) && (k) < hi)
#define SEAM(k) do { if (IN(k) && IN((k) + 1)) xcd_barrier(bar, F.tid); } while (0)
    if (IN(0)) { phase_prologue(F, p); } SEAM(0);
    if (IN(1)) { phase_modulate0(F, p); } SEAM(1);
    if (IN(2)) { PHASE_QKV(F, p); } SEAM(2);
    if (IN(3)) { PHASE_ATTN(F, p); }
    {
        int l_; asm volatile("v_mbcnt_lo_u32_b32 %0, -1, 0\n\tv_mbcnt_hi_u32_b32 %0, -1, %0" : "=v"(l_)); F.lane = l_; F.tid = F.wave * 64 + l_; }
    SEAM(3);
    if (IN(5)) { PHASE_WO(F, p, 0); } SEAM(5);
    if (IN(6)) { phase_ln_route(F, p, 0); } SEAM(6);
    if (IN(7)) { PHASE_MOE1(F, p, 0); } SEAM(7);
    if (IN(8)) { PHASE_MOE2(F, p, 0); } SEAM(8);
    if (IN(9)) { phase_moe_combine(F, p, 0); } SEAM(9);
    if (IN(10)) { PHASE_INPROJ(F, p); } SEAM(10);
    if (IN(11)) { phase_gla_prep(F, p); } SEAM(11);
    if (IN(12)) { PHASE_SCAN(F, p); } SEAM(12);
    if (IN(13)) { phase_gla_post(F, p); } SEAM(13);
    if (IN(14)) { PHASE_WO(F, p, 1); } SEAM(14);
    if (IN(15)) { phase_ln_route(F, p, 1); } SEAM(15);
    if (IN(16)) { PHASE_MOE1(F, p, 1); } SEAM(16);
    if (IN(17)) { PHASE_MOE2(F, p, 1); } SEAM(17);
    if (IN(18)) { phase_moe_combine(F, p, 1); }
#undef IN
#undef SEAM
}

extern "C" void kernel_launch(void* const* d_in, const int* in_sizes, int n_in, void* d_out, int out_size, void* d_ws, size_t ws_size, hipStream_t stream) {
    static int grid = 0;
    if (grid == 0) {
        if (n_in != 23 || in_sizes[0] != NLAT * DM || out_size != NLAT * DM || ws_size < WS_END) { fprintf(stderr, "kernel_launch: unexpected shapes (n_in %d, in0 %d, out %d, ws %zu); nothing launched\n", n_in, n_in > 0 ? in_sizes[0] : -1, out_size, ws_size); grid = -1; return; }
        int dev = 0, cus = 0;
        if (hipGetDevice(&dev) != hipSuccess || hipDeviceGetAttribute(&cus, hipDeviceAttributeMultiprocessorCount, dev) != hipSuccess) { grid = -1; return; }
        if (hipFuncSetAttribute((const void*)mega_fwd, hipFuncAttributeMaxDynamicSharedMemorySize, LDS_BYTES) != hipSuccess) { fprintf(stderr, "kernel_launch: hipFuncSetAttribute failed\n"); grid = -1; return; }
        int per_cu = 0;
        if (hipOccupancyMaxActiveBlocksPerMultiprocessor(&per_cu, (const void*)mega_fwd, NTHR, LDS_BYTES) != hipSuccess || per_cu < 1) fprintf(stderr, "kernel_launch: note: occupancy query reports %d\n", per_cu);
        (void)hipGetLastError();
        grid = cus;
    }
    if (grid < 0) return;
    (void)hipMemsetAsync((char*)d_ws + WS_CTL, 0, CTL_ZERO_BYTES, stream);
    Prm p{};
    const float** pp = (const float**)&p;
    for (int i = 0; i < 23; ++i) pp[i] = (const float*)d_in[i];
    p.out = (float*)d_out; p.ws = (unsigned char*)d_ws;
    p.ph_lo = 0; p.ph_hi = NPHASE; p.li = 0;
    hipLaunchKernelGGL(mega_fwd, dim3(grid), dim3(NTHR), LDS_BYTES, stream, p);
}
```
